# Optimizing an MI355X kernel written in HIP

```python
import math
import jax
import jax.numpy as jnp
from jax import lax
import numpy as np

D_MODEL = 1024
BATCH = 8
SEQ = 4096
DEPTH = 1

F32 = jnp.float32
RMS_EPS = 1e-6
N_ATTN_HEADS = 8
ATTN_HEAD_DIM = 64
ATTN_W = N_ATTN_HEADS * ATTN_HEAD_DIM
IDX_HEADS = 16
IDX_DIM = 32
IDX_Q = IDX_HEADS * IDX_DIM
TOPK_MAX = 256
Q_BLOCK = 64
N_BUCKETS = 32
MAX_DISTANCE = 128
RWKV_HEADS = 8
RWKV_HEAD = 64
RWKV_W = RWKV_HEADS * RWKV_HEAD
DECAY_LORA = 64
ICLR_LORA = 64
GATE_LORA = 128
RWKV_IN = 3 * RWKV_W + DECAY_LORA + ICLR_LORA + GATE_LORA
GN_EPS = 64e-5
RWKV_START = 3 * ATTN_W + IDX_Q + IDX_DIM + IDX_HEADS
N_IN = RWKV_START + RWKV_IN + 2 * D_MODEL
IN_SPLITS = (ATTN_W, 2 * ATTN_W, 3 * ATTN_W, 3 * ATTN_W + IDX_Q,
             3 * ATTN_W + IDX_Q + IDX_DIM, RWKV_START,
             RWKV_START + RWKV_IN, RWKV_START + RWKV_IN + D_MODEL)
RWKV_SPLITS = (RWKV_W, 2 * RWKV_W, 3 * RWKV_W, 3 * RWKV_W + DECAY_LORA,
               3 * RWKV_W + DECAY_LORA + ICLR_LORA)
N_EXPERTS = 64
N_GROUPS = 8
TOPK_GROUPS = 4
MOE_TOPK = 8
EXPERT_FF = 256
ROUTED_SCALE = 2.5
EXPERT_BLOCK = 128

kernel_name = 'hybrid_dsa_rwkv7_moe_block'


def rms_norm(x, g):
    xf = x.astype(F32)
    y = xf * lax.rsqrt(jnp.mean(xf * xf, axis=-1, keepdims=True) + RMS_EPS)
    return (y * g.astype(F32)).astype(x.dtype)


def t5_bucket(rel):
    n = jnp.maximum(rel, 0)
    max_exact = N_BUCKETS // 2
    nf = jnp.maximum(n, 1).astype(F32)
    large = max_exact + (jnp.log(nf / max_exact) / math.log(MAX_DISTANCE / max_exact)
                         * (N_BUCKETS - max_exact)).astype(jnp.int32)
    large = jnp.minimum(large, N_BUCKETS - 1)
    return jnp.where(n < max_exact, n, large)


def dsa_sparse_attention(q, k, v, q_idx, k_idx, w_idx, rel_bias):
    B, S = q.shape[0], q.shape[1]
    top_k = min(TOPK_MAX, S // 4)
    nb = S // Q_BLOCK
    k_flat = k.reshape(B, S, ATTN_W)
    v_flat = v.reshape(B, S, ATTN_W)
    key_pos = jnp.arange(S, dtype=jnp.int32)
    idx_scale = (IDX_HEADS ** -0.5) * (IDX_DIM ** -0.5)

    def to_blocks(t):
        return jnp.moveaxis(t.reshape((B, nb, Q_BLOCK) + t.shape[2:]), 1, 0)

    def block(args):
        qb, qib, wib, start = args
        q_pos = start + jnp.arange(Q_BLOCK, dtype=jnp.int32)
        dots = jnp.einsum('bqhd,bsd->bqhs', qib, k_idx, preferred_element_type=F32)
        idx_score = jnp.einsum('bqhs,bqh->bqs', jax.nn.relu(dots), wib.astype(F32)) * idx_scale
        causal = key_pos[None, :] <= q_pos[:, None]
        idx_score = jnp.where(causal[None], idx_score, -jnp.inf)
        _, sel = lax.top_k(idx_score, top_k)
        kg = jax.vmap(lambda kf, i: kf[i])(k_flat, sel).reshape(B, Q_BLOCK, top_k, N_ATTN_HEADS, ATTN_HEAD_DIM)
        vg = jax.vmap(lambda vf, i: vf[i])(v_flat, sel).reshape(B, Q_BLOCK, top_k, N_ATTN_HEADS, ATTN_HEAD_DIM)
        logits = jnp.einsum('bqhd,bqkhd->bqhk', qb, kg, preferred_element_type=F32) * (ATTN_HEAD_DIM ** -0.5)
        rel = q_pos[None, :, None] - sel
        bias = rel_bias[t5_bucket(rel)].astype(F32)
        logits = logits + jnp.moveaxis(bias, -1, 2)
        valid = sel <= q_pos[None, :, None]
        logits = jnp.where(valid[:, :, None, :], logits, -jnp.inf)
        p = jax.nn.softmax(logits, axis=-1).astype(vg.dtype)
        return jnp.einsum('bqhk,bqkhd->bqhd', p, vg)

    starts = jnp.arange(nb, dtype=jnp.int32) * Q_BLOCK
    out = lax.map(block, (to_blocks(q), to_blocks(q_idx), to_blocks(w_idx), starts))
    return jnp.moveaxis(out, 0, 1).reshape(B, S, ATTN_W)


def wkv7_scan(r, decay, k, v, a, b):
    B, S, H, N = r.shape

    def step(state, inp):
        r_t, w_t, k_t, v_t, a_t, b_t = inp
        sa = jnp.einsum('bhij,bhj->bhi', state, a_t)
        state = state * w_t[:, :, None, :] + sa[..., None] * b_t[:, :, None, :] + v_t[..., None] * k_t[:, :, None, :]
        y = jnp.einsum('bhij,bhj->bhi', state, r_t)
        return state, y

    xs = tuple(jnp.moveaxis(t, 1, 0) for t in (r, decay, k, v, a, b))
    _, ys = lax.scan(step, jnp.zeros((B, H, N, N), F32), xs)
    return jnp.moveaxis(ys, 0, 1)


def rwkv7_branch(z, tshift_mu, decay_w0, decay_up, iclr_a0, iclr_up, gate_up, k_k, k_a, r_k, lnx_g, lnx_b):
    B, S = z.shape[0], z.shape[1]
    z_prev = jnp.pad(z[:, :-1], ((0, 0), (1, 0), (0, 0)))
    z = (z + tshift_mu * (z_prev - z)).astype(F32)
    r, k, v, wd, ad, gd = jnp.split(z, RWKV_SPLITS, axis=-1)
    w_log = -jax.nn.softplus(-(decay_w0.astype(F32) + jnp.tanh(wd) @ decay_up.astype(F32))) - 0.5
    decay = jnp.exp(-jnp.exp(w_log))
    a = jax.nn.sigmoid(iclr_a0.astype(F32) + ad @ iclr_up.astype(F32))
    g = jax.nn.sigmoid(gd) @ gate_up.astype(F32)
    heads = lambda t: t.reshape(B, S, RWKV_HEADS, RWKV_HEAD)
    kk = heads(k * k_k.astype(F32))
    kk = kk / jnp.maximum(jnp.sqrt(jnp.sum(kk * kk, axis=-1, keepdims=True)), 1e-12)
    k = k * (1.0 + (a - 1.0) * k_a.astype(F32))
    r, k, v, decay, a = heads(r), heads(k), heads(v), heads(decay), heads(a)
    y = wkv7_scan(r, decay, k, v, -kk, kk * a)
    mu = jnp.mean(y, axis=-1, keepdims=True)
    var = jnp.mean(jnp.square(y - mu), axis=-1, keepdims=True)
    yn = ((y - mu) * lax.rsqrt(var + GN_EPS)).reshape(B, S, RWKV_W)
    yn = yn * lnx_g.astype(F32) + lnx_b.astype(F32)
    bonus = (jnp.sum(r * k * r_k.astype(F32), axis=-1, keepdims=True) * v).reshape(B, S, RWKV_W)
    return (yn + bonus) * g


def swiglu(h, wg, wu, wd):
    return (jax.nn.silu(h @ wg) * (h @ wu)) @ wd


def moe_ffn(h, router_w, router_bias, exp_gate, exp_up, exp_down, sh_gate, sh_up, sh_down):
    B, S, D = h.shape
    T = B * S
    hf = h.reshape(T, D)
    scores = jax.nn.sigmoid(jnp.einsum('td,de->te', hf, router_w, preferred_element_type=F32))
    choice = scores + router_bias.astype(F32)
    grp_score = lax.top_k(choice.reshape(T, N_GROUPS, N_EXPERTS // N_GROUPS), 2)[0].sum(-1)
    _, top_g = lax.top_k(grp_score, TOPK_GROUPS)
    gmask = jnp.any(top_g[:, :, None] == jnp.arange(N_GROUPS)[None, None, :], axis=1)
    emask = jnp.repeat(gmask, N_EXPERTS // N_GROUPS, axis=1)
    _, top_e = lax.top_k(jnp.where(emask, choice, -jnp.inf), MOE_TOPK)
    gw = jnp.take_along_axis(scores, top_e, axis=1)
    gw = gw / jnp.sum(gw, axis=-1, keepdims=True) * ROUTED_SCALE
    A = T * MOE_TOPK
    flat_e = top_e.reshape(A)
    order = jnp.argsort(flat_e)
    se = flat_e[order]
    counts = jnp.bincount(flat_e, length=N_EXPERTS)
    padded = (counts + EXPERT_BLOCK - 1) // EXPERT_BLOCK * EXPERT_BLOCK
    start = jnp.cumsum(counts) - counts
    pend = jnp.cumsum(padded)
    pstart = pend - padded
    dest = pstart[se] + jnp.arange(A, dtype=jnp.int32) - start[se]
    n_blocks = -(-A // EXPERT_BLOCK) + N_EXPERTS
    P = n_blocks * EXPERT_BLOCK
    slot_tok = jnp.zeros((P,), jnp.int32).at[dest].set((order // MOE_TOPK).astype(jnp.int32))
    slot_w = jnp.zeros((P,), F32).at[dest].set(gw.reshape(A)[order])
    block_start = jnp.arange(n_blocks, dtype=jnp.int32) * EXPERT_BLOCK
    block_e = jnp.minimum(jnp.sum(pend[None, :] <= block_start[:, None], axis=1), N_EXPERTS - 1)

    def step(y, blk):
        tok, wt, e = blk
        out = swiglu(hf[tok], exp_gate[e], exp_up[e], exp_down[e])
        return y.at[tok].add(out.astype(F32) * wt[:, None]), None

    y, _ = lax.scan(step, jnp.zeros((T, D), F32),
                    (slot_tok.reshape(n_blocks, EXPERT_BLOCK), slot_w.reshape(n_blocks, EXPERT_BLOCK), block_e))
    shared = swiglu(hf, sh_gate, sh_up, sh_down)
    return (y.astype(h.dtype) + shared).reshape(B, S, D)


def hybrid_layer(x, c, ada_w, ada_b, norm1_g, w_in, rel_bias, tshift_mu, decay_w0, decay_up,
                 iclr_a0, iclr_up, gate_up, k_k, k_a, r_k, lnx_g, lnx_b, w_attn_br, w_rwkv_br,
                 w_out, norm2_g, router_w, router_bias, exp_gate, exp_up, exp_down,
                 sh_gate, sh_up, sh_down):
    B, S, D = x.shape
    mod = (jax.nn.silu(c.astype(F32)) @ ada_w.astype(F32) + ada_b.astype(F32)).astype(x.dtype)
    sh1, sc1, g1, sh2, sc2, g2 = [m[:, None, :] for m in jnp.split(mod, 6, axis=-1)]
    h = rms_norm(x, norm1_g) * (1 + sc1) + sh1
    z = h @ w_in
    q, k, v, iq, ik, iw, zr, ga, gr = jnp.split(z, IN_SPLITS, axis=-1)
    hs = lambda t: t.reshape(B, S, N_ATTN_HEADS, ATTN_HEAD_DIM)
    attn = dsa_sparse_attention(hs(q), hs(k), hs(v), iq.reshape(B, S, IDX_HEADS, IDX_DIM), ik, iw, rel_bias)
    rw = rwkv7_branch(zr, tshift_mu, decay_w0, decay_up, iclr_a0, iclr_up, gate_up,
                      k_k, k_a, r_k, lnx_g, lnx_b).astype(x.dtype)
    mixed = jax.nn.sigmoid(ga) * (attn @ w_attn_br) + jax.nn.sigmoid(gr) * (rw @ w_rwkv_br)
    x = x + g1 * (mixed @ w_out)
    h2 = rms_norm(x, norm2_g) * (1 + sc2) + sh2
    x = x + g2 * moe_ffn(h2, router_w, router_bias, exp_gate, exp_up, exp_down, sh_gate, sh_up, sh_down)
    return x


def setup_inputs(seed: int = 0) -> dict:
    key = jax.random.key(seed)
    ks = iter(jax.random.split(key, 40))
    L, D = DEPTH, D_MODEL

    def nrm(shape, scale):
        return jax.random.normal(next(ks), shape, F32) * scale

    def uni(shape, lo, hi):
        return jax.random.uniform(next(ks), shape, F32, lo, hi)

    return {
        'x': nrm((BATCH, SEQ, D), 1.0),
        'c': nrm((BATCH, D), 1.0),
        'ada_w': nrm((L, D, 6 * D), 0.5 * D ** -0.5),
        'ada_b': nrm((L, 6 * D), 0.02),
        'norm1_g': 1.0 + nrm((L, D), 0.02),
        'w_in': nrm((L, D, N_IN), D ** -0.5),
        'rel_bias': nrm((N_BUCKETS, N_ATTN_HEADS), 0.5),
        'tshift_mu': uni((L, RWKV_IN), 0.0, 1.0),
        'decay_w0': uni((L, RWKV_W), -3.0, 1.0),
        'decay_up': nrm((L, DECAY_LORA, RWKV_W), 0.1),
        'iclr_a0': nrm((L, RWKV_W), 0.5),
        'iclr_up': nrm((L, ICLR_LORA, RWKV_W), ICLR_LORA ** -0.5),
        'gate_up': nrm((L, GATE_LORA, RWKV_W), GATE_LORA ** -0.5),
        'k_k': 0.85 + nrm((L, RWKV_W), 0.02),
        'k_a': 1.0 + nrm((L, RWKV_W), 0.02),
        'r_k': nrm((L, RWKV_HEADS, RWKV_HEAD), 0.1),
        'lnx_g': 1.0 + nrm((L, RWKV_W), 0.02),
        'lnx_b': nrm((L, RWKV_W), 0.02),
        'w_attn_br': nrm((L, ATTN_W, D), ATTN_W ** -0.5),
        'w_rwkv_br': nrm((L, RWKV_W, D), RWKV_W ** -0.5),
        'w_out': nrm((L, D, D), D ** -0.5),
        'norm2_g': 1.0 + nrm((L, D), 0.02),
        'router_w': nrm((L, D, N_EXPERTS), D ** -0.5),
        'router_bias': nrm((L, N_EXPERTS), 0.01),
        'exp_gate': nrm((L, N_EXPERTS, D, EXPERT_FF), D ** -0.5),
        'exp_up': nrm((L, N_EXPERTS, D, EXPERT_FF), D ** -0.5),
        'exp_down': nrm((L, N_EXPERTS, EXPERT_FF, D), EXPERT_FF ** -0.5),
        'sh_gate': nrm((L, D, EXPERT_FF), D ** -0.5),
        'sh_up': nrm((L, D, EXPERT_FF), D ** -0.5),
        'sh_down': nrm((L, EXPERT_FF, D), EXPERT_FF ** -0.5),
        'final_g': 1.0 + nrm((D,), 0.02),
    }


def reference(x, c, ada_w, ada_b, norm1_g, w_in, rel_bias, tshift_mu, decay_w0, decay_up,
              iclr_a0, iclr_up, gate_up, k_k, k_a, r_k, lnx_g, lnx_b, w_attn_br, w_rwkv_br,
              w_out, norm2_g, router_w, router_bias, exp_gate, exp_up, exp_down,
              sh_gate, sh_up, sh_down, final_g):
    for l in range(DEPTH):
        x = hybrid_layer(x, c, ada_w[l], ada_b[l], norm1_g[l], w_in[l], rel_bias, tshift_mu[l],
                         decay_w0[l], decay_up[l], iclr_a0[l], iclr_up[l], gate_up[l], k_k[l],
                         k_a[l], r_k[l], lnx_g[l], lnx_b[l], w_attn_br[l], w_rwkv_br[l], w_out[l],
                         norm2_g[l], router_w[l], router_bias[l], exp_gate[l], exp_up[l],
                         exp_down[l], sh_gate[l], sh_up[l], sh_down[l])
    return rms_norm(x, final_g)
```

```cpp
#include <hip/hip_runtime.h>
#include <cstdio>
#include <cstdint>
#include <cmath>

#define GAS __attribute__((address_space(1)))
#define LAS __attribute__((address_space(3)))
typedef unsigned short bf16_t;
typedef short bf16x8 __attribute__((ext_vector_type(8)));
typedef float f32x4 __attribute__((ext_vector_type(4)));
typedef float f32x2 __attribute__((ext_vector_type(2)));
typedef float f32x16 __attribute__((ext_vector_type(16)));
typedef unsigned u32x4 __attribute__((ext_vector_type(4)));
typedef unsigned u32x2 __attribute__((ext_vector_type(2)));
typedef GAS unsigned gu32;

__device__ __forceinline__ unsigned cvt_pk_bf16(float lo, float hi) { unsigned r; asm volatile("v_cvt_pk_bf16_f32 %0, %1, %2" : "=v"(r) : "v"(lo), "v"(hi)); return r; }
__device__ __forceinline__ float bf_lo(unsigned w) { return __uint_as_float(w << 16); }
__device__ __forceinline__ float bf_hi(unsigned w) { return __uint_as_float(w & 0xffff0000u); }
__device__ __forceinline__ float bf2f(bf16_t b) { return __uint_as_float(((unsigned)b) << 16); }
__device__ __forceinline__ unsigned f2bf(float f) { unsigned u = __float_as_uint(f); return (u + 0x7fffu + ((u >> 16) & 1u)) >> 16; }
__device__ __forceinline__ unsigned pk2(float lo, float hi) { return f2bf(lo) | (f2bf(hi) << 16); }
__device__ __forceinline__ float fast_sigmoid(float x) { return __builtin_amdgcn_rcpf(1.0f + __builtin_amdgcn_exp2f(-1.4426950408889634f * x)); }
__device__ __forceinline__ float wave_sum(float v) {
#pragma unroll
    for (int o = 1; o < 64; o <<= 1) v += __shfl_xor(v, o);
    return v;
}

namespace pg8 {
constexpr int BM = 256, BK = 64, HALF = 128, HTB = HALF * BK * 2, STAGE_BYTES = 8 * HTB, NXCD = 8, WGM = 8;
__host__ __device__ __forceinline__ int lds_byte(int r, int c) { const int st = (r >> 4) * 2 + (c >> 5), rr = r & 15, cc = c & 31, ob = rr * 64 + cc * 2; return st * 1024 + (ob ^ (((ob >> 9) & 1) << 5)); }
__host__ __device__ __forceinline__ void stage_rc(int b, int& R, int& C) { const int st = b / 1024, sb = b % 1024, swz = sb ^ (((sb >> 9) & 1) << 5); R = (st >> 1) * 16 + swz / 64; C = (st & 1) * 32 + (swz % 64) / 2; }
__host__ __device__ __forceinline__ int perm32(int rho) { const int n = rho >> 4, i = rho & 15; return 8 * (i >> 2) + 4 * n + (i & 3); }

struct Unit { int pm, pn; int aux0, aux1; };

struct StaticOrder {
    int nM, nN, nwg, G, c;
    __host__ __device__ void init(int M, int N, int G_, int c_) { nM = M / BM; nN = N / BM; nwg = nM * nN; G = G_; c = c_; }
    __host__ __device__ bool next(int i, Unit& u) const {
        const long L = (long)i * G + c; if (L >= nwg) return false;
        int wgid = (int)L; { const int q = nwg / NXCD, r = nwg % NXCD, xcd = wgid % NXCD, off = wgid / NXCD; wgid = (xcd < r ? xcd * (q + 1) : r * (q + 1) + (xcd - r) * q) + off; }
        const int nig = WGM * nN, gid = wgid / nig, fm = gid * WGM, gsz = (nM - fm) < WGM ? (nM - fm) : WGM;
        u.pm = fm + ((wgid % nig) % gsz); u.pn = (wgid % nig) / gsz; u.aux0 = 0; u.aux1 = 0; return true;
    }
};

template <int ESZ_> struct DenseSrcT {
    static constexpr int ESZ = ESZ_; static constexpr bool GATHER = false;
    const void* A; const void* Bt; int K;
    __device__ __forceinline__ const char* b_base(const Unit& u) const { return (const char*)Bt + (size_t)u.pn * 256 * K * ESZ; }
    __device__ __forceinline__ const char* a_base(const Unit& u) const { return (const char*)A + (size_t)u.pm * 256 * K * ESZ; }
    __device__ __forceinline__ unsigned a_off(const Unit&, int R, int C) const { return (unsigned)(R * K * ESZ) + (unsigned)C * 2u; }
};
typedef DenseSrcT<2> DenseSrc;
typedef int v8i32 __attribute__((ext_vector_type(8)));

template <class Epi, class Sched, class Src, bool ALIGN_EPI = true>
__device__ __forceinline__ void gemm_phase(LAS unsigned char* lds, const int K, const Sched& S, const Src& G, const Epi& E) {
    const int tid = threadIdx.x, wid = __builtin_amdgcn_readfirstlane(tid >> 6), lane = tid & 63, wr = wid >> 2, wc = wid & 3, fr = lane & 15, fq = lane >> 4;
    constexpr int ESZ = Src::ESZ; const int Kb = K * ESZ;
    const int nt = Kb / (BK * 2);
    unsigned voffB0;
    { int R, C; stage_rc(tid * 16, R, C); const int Rb = Epi::PERM ? ((R & ~31) + perm32(R & 31)) : R; voffB0 = (unsigned)(Rb * Kb) + (unsigned)C * 2u; }
#define PG8_AOFF(u, h, i) ([&]() { int R_, C_; stage_rc(tid * 16 + (i) * 8192, R_, C_); return G.a_off((u), R_ + (h) * HALF, C_); }())
    const size_t kstep = (size_t)(BK * 2);
    const size_t hstepB = (size_t)HALF * Kb;
    const unsigned ldsw = (unsigned)wid * 1024u;
    const int aoff = lds_byte(wr * 64 + fr, fq * 8), boff = lds_byte(wc * 32 + fr, fq * 8);
#define PG8_SA(b, h) (((b) * 2 + (h)) * HTB)
#define PG8_SB(b, h) ((4 + (b) * 2 + (h)) * HTB)
#define PG8_STAGEB(bufoff, gbase) do { _Pragma("unroll") for (int _i = 0; _i < 2; ++_i) { unsigned o_ = voffB0; asm volatile("" : "+v"(o_)); \
        __builtin_amdgcn_global_load_lds((const unsigned*)((const char*)(gbase) + (size_t)_i * 64 * Kb + o_), (LAS unsigned*)(lds + (bufoff) + ldsw + _i * 8192), 16, 0, 0); } } while (0)
#define PG8_STAGEA(bufoff, gbase, vo, h) do { _Pragma("unroll") for (int _i = 0; _i < 2; ++_i) { unsigned o_ = Src::GATHER ? (vo)[h][_i] : (vo)[0][0]; asm volatile("" : "+v"(o_)); \
        __builtin_amdgcn_global_load_lds((const unsigned*)((const char*)(gbase) + (Src::GATHER ? (size_t)0 : (size_t)((h) * 128 + _i * 64) * Kb) + o_), (LAS unsigned*)(lds + (bufoff) + ldsw + _i * 8192), 16, 0, 0); } } while (0)
#define PG8_STAGEA2(bufoff, gbase, h) do { _Pragma("unroll") for (int _i = 0; _i < 2; ++_i) { unsigned o_ = Src::GATHER ? (last ? vn[h][_i] : vc[h][_i]) : vc[0][0]; asm volatile("" : "+v"(o_)); \
        __builtin_amdgcn_global_load_lds((const unsigned*)((const char*)(gbase) + (Src::GATHER ? (size_t)0 : (size_t)((h) * 128 + _i * 64) * Kb) + o_), (LAS unsigned*)(lds + (bufoff) + ldsw + _i * 8192), 16, 0, 0); } } while (0)
#define PG8_LDA(dst, b, h) do { _Pragma("unroll") for (int m = 0; m < 4; ++m) { const u32x4 lo_ = *(const LAS u32x4*)(lds + PG8_SA(b, h) + aoff + m * 2048), hi_ = *(const LAS u32x4*)(lds + PG8_SA(b, h) + aoff + m * 2048 + 1024); \
        dst[m] = __builtin_shufflevector(lo_, hi_, 0, 1, 2, 3, 4, 5, 6, 7); } } while (0)
#define PG8_LDB(dst, b, h) do { _Pragma("unroll") for (int n = 0; n < 2; ++n) { const u32x4 lo_ = *(const LAS u32x4*)(lds + PG8_SB(b, h) + boff + n * 2048), hi_ = *(const LAS u32x4*)(lds + PG8_SB(b, h) + boff + n * 2048 + 1024); \
        dst[n] = __builtin_shufflevector(lo_, hi_, 0, 1, 2, 3, 4, 5, 6, 7); } } while (0)
#define PG8_LO(x) __builtin_bit_cast(bf16x8, __builtin_shufflevector((x), (x), 0, 1, 2, 3))
#define PG8_HI(x) __builtin_bit_cast(bf16x8, __builtin_shufflevector((x), (x), 4, 5, 6, 7))
#define PG8_MMA(ai, bj, At, Bt) do { __builtin_amdgcn_s_setprio(1); _Pragma("unroll") for (int m = 0; m < 4; ++m) _Pragma("unroll") for (int n = 0; n < 2; ++n) { \
        if constexpr (ESZ == 1) acc[ai][bj][m][n] = __builtin_amdgcn_mfma_scale_f32_16x16x128_f8f6f4(__builtin_bit_cast(v8i32, Bt[n]), __builtin_bit_cast(v8i32, At[m]), acc[ai][bj][m][n], 0, 0, 0, 0, 0, 0); \
        else { acc[ai][bj][m][n] = __builtin_amdgcn_mfma_f32_16x16x32_bf16(PG8_LO(Bt[n]), PG8_LO(At[m]), acc[ai][bj][m][n], 0, 0, 0); \
               acc[ai][bj][m][n] = __builtin_amdgcn_mfma_f32_16x16x32_bf16(PG8_HI(Bt[n]), PG8_HI(At[m]), acc[ai][bj][m][n], 0, 0, 0); } } \
        __builtin_amdgcn_s_setprio(0); } while (0)
#define PG8_WAIT_V(n) asm volatile("s_waitcnt vmcnt(" #n ")" ::: "memory")
#define PG8_WAIT_L(n) asm volatile("s_waitcnt lgkmcnt(" #n ")" ::: "memory")
#define PG8_BAR __builtin_amdgcn_s_barrier()
#define PG8_SCHED __builtin_amdgcn_sched_barrier(0)
    Unit cur, nxt; int ui = 0;
    if (!S.next(0, cur)) return;
    f32x4 acc[2][2][4][2];
#pragma unroll
    for (int a = 0; a < 2; ++a)
#pragma unroll
        for (int b = 0; b < 2; ++b)
#pragma unroll
            for (int m = 0; m < 4; ++m)
#pragma unroll
                for (int n = 0; n < 2; ++n) acc[a][b][m][n] = (f32x4){0.f, 0.f, 0.f, 0.f};
    typedef unsigned u32x8 __attribute__((ext_vector_type(8)));
    u32x8 At[4], B0[2], B1[2];
    unsigned vc[2][2], vn[2][2];
#pragma unroll
    for (int h = 0; h < 2; ++h)
#pragma unroll
        for (int i = 0; i < 2; ++i) vc[h][i] = PG8_AOFF(cur, h, i);
    const char* cA = G.a_base(cur); const char* cB = G.b_base(cur);
    PG8_STAGEB(PG8_SB(0, 0), cB); PG8_STAGEB(PG8_SB(0, 1), cB + hstepB); PG8_STAGEA(PG8_SA(0, 0), cA, vc, 0); PG8_STAGEA(PG8_SA(0, 1), cA, vc, 1);
    if (wr == 1) PG8_BAR;
    PG8_WAIT_V(2); PG8_BAR;
    PG8_STAGEB(PG8_SB(1, 0), cB + kstep); PG8_STAGEA(PG8_SA(1, 0), cA + kstep, vc, 0); PG8_STAGEB(PG8_SB(1, 1), cB + hstepB + kstep);
    PG8_WAIT_V(6); PG8_BAR;
    for (;;) {
        const bool has_next = S.next(ui + 1, nxt);
        const char* nA = has_next ? G.a_base(nxt) : cA; const char* nB = has_next ? G.b_base(nxt) : cB;
        if constexpr (Src::GATHER) {
#pragma unroll
        for (int h = 0; h < 2; ++h)
#pragma unroll
            for (int i = 0; i < 2; ++i) vn[h][i] = has_next ? PG8_AOFF(nxt, h, i) : vc[h][i]; }
#pragma clang loop unroll(disable)
        for (int t = 0; t < nt; t += 2) {
            const bool last = (t == nt - 2);
            const char* a1 = cA + (size_t)(t + 1) * kstep;
            const char* a2 = last ? nA : cA + (size_t)(t + 2) * kstep; const char* b2 = last ? nB : cB + (size_t)(t + 2) * kstep;
            const char* a3 = a2 + kstep; const char* b3 = b2 + kstep;
            PG8_LDB(B0, 0, 0); PG8_LDB(B1, 0, 1); PG8_SCHED; PG8_LDA(At, 0, 0); PG8_STAGEA(PG8_SA(1, 1), a1, vc, 1);
            PG8_WAIT_V(8); PG8_WAIT_L(0); PG8_BAR; PG8_MMA(0, 0, At, B0); PG8_MMA(0, 1, At, B1); PG8_BAR; PG8_SCHED;
            PG8_LDA(At, 0, 1); PG8_STAGEB(PG8_SB(0, 0), b2); PG8_STAGEB(PG8_SB(0, 1), b2 + hstepB); PG8_STAGEA2(PG8_SA(0, 0), a2, 0);
            PG8_WAIT_V(8); PG8_WAIT_L(0); PG8_BAR; PG8_MMA(1, 0, At, B0); PG8_MMA(1, 1, At, B1); PG8_BAR; PG8_SCHED;
            PG8_LDB(B0, 1, 0); PG8_LDB(B1, 1, 1); PG8_SCHED; PG8_LDA(At, 1, 0); PG8_STAGEA2(PG8_SA(0, 1), a2, 1);
            PG8_WAIT_V(8); PG8_WAIT_L(0); PG8_BAR; PG8_MMA(0, 0, At, B0); PG8_MMA(0, 1, At, B1); PG8_BAR; PG8_SCHED;
            PG8_LDA(At, 1, 1); PG8_STAGEB(PG8_SB(1, 0), b3); PG8_STAGEB(PG8_SB(1, 1), b3 + hstepB); PG8_STAGEA2(PG8_SA(1, 0), a3, 0);
            PG8_WAIT_V(8); PG8_WAIT_L(0); PG8_BAR; PG8_MMA(1, 0, At, B0); PG8_MMA(1, 1, At, B1); PG8_BAR; PG8_SCHED;
        }
        if constexpr (ALIGN_EPI) { if (wr == 0) PG8_BAR; }
        { int ln_; asm volatile("v_mbcnt_lo_u32_b32 %0, -1, 0\n\tv_mbcnt_hi_u32_b32 %0, -1, %0" : "=v"(ln_)); E(acc, cur, wr, wc, ln_ & 15, ln_ >> 4); }
        if (!has_next) break;
#pragma unroll
        for (int a = 0; a < 2; ++a)
#pragma unroll
            for (int b = 0; b < 2; ++b)
#pragma unroll
                for (int m = 0; m < 4; ++m)
#pragma unroll
                    for (int n = 0; n < 2; ++n) acc[a][b][m][n] = (f32x4){0.f, 0.f, 0.f, 0.f};
        cur = nxt; cA = nA; cB = nB; ++ui;
        if constexpr (Src::GATHER) {
#pragma unroll
        for (int h = 0; h < 2; ++h)
#pragma unroll
            for (int i = 0; i < 2; ++i) vc[h][i] = vn[h][i]; }
        if constexpr (ALIGN_EPI) { if (wr == 1) PG8_BAR; }
    }
    PG8_WAIT_V(0);
    if constexpr (!ALIGN_EPI) { if (wr == 0) PG8_BAR; }
    PG8_BAR;
#undef PG8_SA
#undef PG8_AOFF
#undef PG8_SB
#undef PG8_STAGEA
#undef PG8_STAGEA2
#undef PG8_STAGEB
#undef PG8_LDA
#undef PG8_LDB
#undef PG8_MMA
#undef PG8_LO
#undef PG8_HI
#undef PG8_WAIT_V
#undef PG8_WAIT_L
#undef PG8_BAR
#undef PG8_SCHED
}
}
#define RLX_AGENT __ATOMIC_RELAXED, __HIP_MEMORY_SCOPE_AGENT
#define LDS_WAIT() asm volatile("s_waitcnt lgkmcnt(0)" ::: "memory")
#define VM_WAIT() asm volatile("s_waitcnt vmcnt(0)" ::: "memory")
#define XB_TMO      128
#define XB_XCNT(j)  (256  + 64 * (j))
#define XB_XSUB(j)  (1280 + 64 * (j))
#define XB_XGEN(j)  (2304 + 64 * (j))
#define XB_TOP      3328
#define XB_TOPGEN   3392
#define XCD_BAR_WORDS 3456
#define XB_SPIN_CAP (1u << 18)

__device__ __forceinline__ unsigned xb_ld(unsigned* p)              { return __hip_atomic_load(p, __ATOMIC_RELAXED, __HIP_MEMORY_SCOPE_AGENT); }
__device__ __forceinline__ unsigned xb_add(unsigned* p, unsigned v) { return __hip_atomic_fetch_add(p, v, __ATOMIC_RELAXED, __HIP_MEMORY_SCOPE_AGENT); }
__device__ __forceinline__ unsigned xb_xcc_id() { return (unsigned)__builtin_amdgcn_s_getreg((3 << 11) | 20) & 0xFu; }
#define XB_SPIN(cond, bar) do { unsigned _sp = 0; while (cond) { __builtin_amdgcn_s_sleep(1); \
    if ((++_sp & 255u) == 0u) { if (xb_ld(&(bar)[XB_TMO])) break; if (_sp > XB_SPIN_CAP) { atomicAdd(&(bar)[XB_TMO], 1u); break; } } } } while (0)

struct XcdBarrier {
    unsigned* bar; unsigned x;
    volatile LAS unsigned* st;
};

__device__ __forceinline__ XcdBarrier xcd_barrier_post(unsigned* bar, volatile LAS unsigned* st) {
    XcdBarrier b; b.bar = bar; b.x = xb_xcc_id(); b.st = st;
    if (threadIdx.x == 0) (void)xb_add(&bar[XB_XCNT(b.x)], 1u);
    return b;
}
__device__ __forceinline__ void xcd_barrier_complete(unsigned* bar, unsigned x, unsigned& nloc, unsigned& nx) {
    const unsigned G = gridDim.x * gridDim.y * gridDim.z;
    unsigned sum, cnt, mine, sp = 0u;
    for (;;) {
        sum = 0u; cnt = 0u; mine = 0u;
#pragma unroll
        for (unsigned j = 0; j < 16; ++j) { const unsigned c = xb_ld(&bar[XB_XCNT(j)]); sum += c; cnt += (c > 0u) ? 1u : 0u; mine = (j == x) ? c : mine; }
        if (sum == G) break;
        __builtin_amdgcn_s_sleep(1);
        if ((++sp & 255u) == 0u) { if (xb_ld(&bar[XB_TMO])) break; if (sp > XB_SPIN_CAP) { atomicAdd(&bar[XB_TMO], 1u); break; } }
    }
    nloc = mine > 0u ? mine : 1u; nx = cnt > 0u ? cnt : 1u;
}

__device__ __forceinline__ void xcd_barrier(const XcdBarrier& b) {
    asm volatile("s_waitcnt vmcnt(0)" ::: "memory");
    __syncthreads();
    if (threadIdx.x == 0) {
        unsigned* bar = b.bar;
        __builtin_amdgcn_s_waitcnt(0);
        unsigned nloc = b.st[0], nx = b.st[1];
        if (nloc == 0u) { xcd_barrier_complete(bar, b.x, nloc, nx); b.st[0] = nloc; b.st[1] = nx; }
        const unsigned old = xb_add(&bar[XB_XSUB(b.x)], 1u);
        const unsigned gen = old / nloc;
        if (old + 1u == (gen + 1u) * nloc) {
            __builtin_amdgcn_fence(__ATOMIC_RELEASE, "agent");
            asm volatile("s_waitcnt vmcnt(0)" ::: "memory");
            const unsigned og = xb_add(&bar[XB_TOP], 1u);
            const unsigned tg = og / nx;
            if (og + 1u == (tg + 1u) * nx) xb_add(&bar[XB_TOPGEN], 1u);
            else XB_SPIN(xb_ld(&bar[XB_TOPGEN]) == tg, bar);
            __builtin_amdgcn_fence(__ATOMIC_ACQUIRE, "agent");
            xb_add(&bar[XB_XGEN(b.x)], 1u);
            asm volatile("s_waitcnt vmcnt(0)" ::: "memory");
        } else {
            XB_SPIN(xb_ld(&bar[XB_XGEN(b.x)]) == gen, bar);
            __builtin_amdgcn_fence(__ATOMIC_ACQUIRE, "agent");
            asm volatile("s_waitcnt vmcnt(0)" ::: "memory");
        }
    }
    __syncthreads();
}
constexpr int NB = 8, SEQ = 4096, D = 1024, M = NB * SEQ;
constexpr int NIN_SRC = 5936, NIN = 6144;
constexpr int ZW = 4096;
constexpr int ZQ = 0, ZK = 512, ZV = 1024, ZIQ = 1536, ZIK = 2048, ZIW = 2080, ZR = 2304;
constexpr int ZR_R = ZR, ZR_K = ZR + 512, ZR_V = ZR + 1024, ZR_WD = ZR + 1536, ZR_AD = ZR + 1600, ZR_GD = ZR + 1664;
constexpr int GW = 2048;
constexpr int NEXP = 64, FF = 256, TOPK = 8;
constexpr float RMS_EPS = 1e-6f, GN_EPS = 64e-5f;
constexpr float QSCALE = 0.125f * 1.4426950408889634f;
constexpr int NWAVES = 8, NTHR = 512;

constexpr size_t MiB = 1u << 20;
constexpr size_t WS_CTL = 0, CTL_ZERO_BYTES = 1 * MiB;
constexpr size_t WS_MOD = 1 * MiB;
constexpr size_t WS_DUT = 1 * MiB + 256 * 1024;
constexpr size_t WS_IUT = WS_DUT + 64 * 1024;
constexpr size_t WS_GUT = WS_IUT + 64 * 1024;
constexpr size_t WS_WIN = 2 * MiB;
constexpr size_t WS_WA = 14 * MiB, WS_WR = 15 * MiB;
constexpr size_t WS_WO = 16 * MiB;
constexpr size_t WS_WRT = 18 * MiB;
constexpr size_t WS_WSH1 = 19 * MiB;
constexpr size_t WS_WSH2 = 20 * MiB;
constexpr size_t WS_BRS = 21 * MiB, WS_KRS = 22 * MiB;
constexpr size_t WS_TOPE = 23 * MiB, WS_TOPW = 24 * MiB;
constexpr size_t WS_LOGIT = 25 * MiB;
constexpr size_t WS_Z = 36 * MiB;
constexpr size_t WS_H0 = 292 * MiB, WS_H1 = 324 * MiB;
constexpr size_t WS_SEL = 356 * MiB;
constexpr size_t WS_R0 = 372 * MiB, WS_R1 = 404 * MiB, WS_R2 = 436 * MiB, WS_R3 = 468 * MiB;
constexpr size_t WS_W2T = 36 * MiB;
constexpr size_t WS_ACT = 68 * MiB;
constexpr size_t WS_ACTS = 196 * MiB;
constexpr size_t WS_STOK = 212 * MiB, WS_SW = 213 * MiB;
constexpr size_t WS_W1T = 214 * MiB;
constexpr size_t WS_H2 = 278 * MiB;
constexpr size_t WS_SLOT = 214 * MiB;
constexpr size_t WS_END = 502 * MiB;
constexpr int CW_TMO = 0, CW_BAR = 4096, CW_CNT = 32768, CW_CUR = 32768 + 128, CW_Q = 32768 + 512;

constexpr int RING_BYTES = 131072;
constexpr int LDSCTL_OFF = RING_BYTES, MISC_OFF = LDSCTL_OFF + 320;
constexpr int LDS_TILETAB = RING_BYTES + 1024;
constexpr int LDS_PTAB = RING_BYTES + 512;
constexpr int LDS_PARA = 118800;
constexpr int LDS_PARB = LDS_TILETAB;
constexpr int LDS_BYTES = 147456;
#define AIN(i) ain_ptr(F.lds, (i))

struct Args { const float* in[31]; float* out; unsigned char* ws; int ph_lo, ph_hi, li, pad; };
struct Frame {
    LAS unsigned char* lds;
    volatile LAS unsigned* MISC;
    unsigned* ctl;
    int tid, lane, wave, vcu, G, gw, NGW;
    float* out; unsigned char* ws;
};

__device__ __forceinline__ const float* ain_ptr(LAS unsigned char* lds, int i) {
    const u32x2 w = *(const LAS u32x2*)(lds + LDS_PTAB + 8 * i);
    const unsigned lo = (unsigned)__builtin_amdgcn_readfirstlane((int)w.x), hi = (unsigned)__builtin_amdgcn_readfirstlane((int)w.y);
    return (const float*)(((unsigned long long)hi << 32) | lo);
}
struct TrSrc { const float* base; int nsrc; };
template <int FP8, class ColFn>
__device__ __forceinline__ void transpose_item(const ColFn& colfn, int K, bf16_t* WT, LAS float* scr, int kb, int nb, int lane) {
    const int k0 = 64 * kb, n0 = 32 * nb;
    const TrSrc s = colfn(n0 + (lane & 31));
    float v_[32];
#pragma unroll
    for (int i = 0; i < 32; ++i) { const int kk = 2 * i + (lane >> 5); v_[i] = s.base ? s.base[(size_t)(k0 + kk) * s.nsrc] : 0.f; }
#pragma unroll
    for (int i = 0; i < 32; ++i) { const int kk = 2 * i + (lane >> 5); scr[kk * 33 + (lane & 31)] = v_[i]; }
    LDS_WAIT(); asm volatile("" ::: "memory");
    const int c = lane & 7;
#pragma unroll
    for (int j = 0; j < 4; ++j) { const int n = (lane >> 3) + 8 * j; const LAS float* sp = scr + (8 * c) * 33 + n;
        if constexpr (FP8) { constexpr float S8 = 32.0f;
            int lo = __builtin_amdgcn_cvt_pk_fp8_f32(sp[0 * 33] * S8, sp[1 * 33] * S8, 0, false); lo = __builtin_amdgcn_cvt_pk_fp8_f32(sp[2 * 33] * S8, sp[3 * 33] * S8, lo, true);
            int hi = __builtin_amdgcn_cvt_pk_fp8_f32(sp[4 * 33] * S8, sp[5 * 33] * S8, 0, false); hi = __builtin_amdgcn_cvt_pk_fp8_f32(sp[6 * 33] * S8, sp[7 * 33] * S8, hi, true);
            *(GAS u32x2*)((unsigned char*)WT + (size_t)(n0 + n) * K + k0 + 8 * c) = (u32x2){(unsigned)lo, (unsigned)hi}; }
        else { u32x4 o; o.x = pk2(sp[0 * 33], sp[1 * 33]); o.y = pk2(sp[2 * 33], sp[3 * 33]); o.z = pk2(sp[4 * 33], sp[5 * 33]); o.w = pk2(sp[6 * 33], sp[7 * 33]);
            *(GAS u32x4*)(WT + (size_t)(n0 + n) * K + k0 + 8 * c) = o; } }
    LDS_WAIT(); asm volatile("" ::: "memory");
}

__device__ __forceinline__ void p0_mod(const Args& args, Frame& F, int task) {
    LAS float* sc = (LAS float*)F.lds;
    LAS float* red = (LAS float*)(F.lds + 32768);
    const float* c = AIN(1);
    for (int i = F.tid; i < 8192; i += NTHR) { const float v = c[i]; sc[i] = v * fast_sigmoid(v); }
    __syncthreads();
    const float* aw = AIN(2) + 64 * task + F.lane;
    float acc[8];
#pragma unroll
    for (int b = 0; b < 8; ++b) acc[b] = 0.f;
    const int kb = 128 * F.wave;
#pragma unroll 4
    for (int k = 0; k < 128; ++k) { const float a = aw[(size_t)(kb + k) * 6144];
#pragma unroll
        for (int b = 0; b < 8; ++b) acc[b] += sc[b * 1024 + kb + k] * a; }
#pragma unroll
    for (int b = 0; b < 8; ++b) red[(F.wave * 8 + b) * 64 + F.lane] = acc[b];
    __syncthreads();
    { const int b = F.wave; float s = AIN(3)[64 * task + F.lane];
#pragma unroll
      for (int w = 0; w < 8; ++w) s += red[(w * 8 + b) * 64 + F.lane];
      ((float*)(F.ws + WS_MOD))[b * 6144 + 64 * task + F.lane] = s; }
    __syncthreads();
}

__device__ __forceinline__ void p0_prologue(const Args& args, Frame& F) {
    if (blockIdx.x < 96) p0_mod(args, F, blockIdx.x);
    LAS float* scr = (LAS float*)(F.lds + F.wave * 16384);
    bf16_t* const ws16 = (bf16_t*)F.ws;
    constexpr int I_WIN = 16 * 192, I_WA = 8 * 32, I_WO = 16 * 32, I_WRT = 16 * 8, I_SH1 = 16 * 16, I_SH2 = 4 * 32, I_DU = 16, I_GU = 32;
    constexpr int NIT = I_WIN + 2 * I_WA + I_WO + I_WRT + I_SH1 + I_SH2 + 2 * I_DU + I_GU;
    for (int it = F.gw; it < NIT; it += F.NGW) {
        int r = it;
        if (r < I_WIN) { const float* w = AIN(5);
            transpose_item<1>([=](int n) { TrSrc s; const bool ok = (n < 2096) || (n >= 2304); const int col = n < 2096 ? n : n - 208; s.base = ok ? w + col : nullptr; s.nsrc = NIN_SRC; return s; },
                           1024, (bf16_t*)(F.ws + WS_WIN), scr, r / 192, r % 192, F.lane); continue; } r -= I_WIN;
        if (r < I_WA) { const float* w = AIN(18); transpose_item<0>([=](int n) { TrSrc s; s.base = w + n; s.nsrc = 1024; return s; }, 512, (bf16_t*)(F.ws + WS_WA), scr, r / 32, r % 32, F.lane); continue; } r -= I_WA;
        if (r < I_WA) { const float* w = AIN(19); transpose_item<0>([=](int n) { TrSrc s; s.base = w + n; s.nsrc = 1024; return s; }, 512, (bf16_t*)(F.ws + WS_WR), scr, r / 32, r % 32, F.lane); continue; } r -= I_WA;
        if (r < I_WO) { const float* w = AIN(20); transpose_item<1>([=](int n) { TrSrc s; s.base = w + n; s.nsrc = 1024; return s; }, 1024, (bf16_t*)(F.ws + WS_WO), scr, r / 32, r % 32, F.lane); continue; } r -= I_WO;
        if (r < I_WRT) { const float* w = AIN(22); transpose_item<0>([=](int n) { TrSrc s; s.base = n < 64 ? w + n : nullptr; s.nsrc = 64; return s; }, 1024, (bf16_t*)(F.ws + WS_WRT), scr, r / 8, r % 8, F.lane); continue; } r -= I_WRT;
        if (r < I_SH1) { const float* wg = AIN(27); const float* wu = AIN(28);
            transpose_item<0>([=](int n) { TrSrc s; const int j = n >> 8, sel = (n >> 7) & 1, cc = n & 127; s.base = (sel ? wu : wg) + 128 * j + cc; s.nsrc = 256; return s; }, 1024, (bf16_t*)(F.ws + WS_WSH1), scr, r / 16, r % 16, F.lane); continue; } r -= I_SH1;
        if (r < I_SH2) { const float* w = AIN(29); transpose_item<0>([=](int n) { TrSrc s; s.base = w + n; s.nsrc = 1024; return s; }, 256, (bf16_t*)(F.ws + WS_WSH2), scr, r / 32, r % 32, F.lane); continue; } r -= I_SH2;
        if (r < I_DU) { const float* w = AIN(9); transpose_item<0>([=](int n) { TrSrc s; s.base = w + n; s.nsrc = 512; return s; }, 64, (bf16_t*)(F.ws + WS_DUT), scr, 0, r, F.lane); continue; } r -= I_DU;
        if (r < I_DU) { const float* w = AIN(11); transpose_item<0>([=](int n) { TrSrc s; s.base = w + n; s.nsrc = 512; return s; }, 64, (bf16_t*)(F.ws + WS_IUT), scr, 0, r, F.lane); continue; } r -= I_DU;
        { const float* w = AIN(12); transpose_item<0>([=](int n) { TrSrc s; s.base = w + n; s.nsrc = 512; return s; }, 128, (bf16_t*)(F.ws + WS_GUT), scr, r / 16, r % 16, F.lane); }
    }
    (void)ws16;
}

__device__ __forceinline__ void convert_experts(const Args& args, Frame& F) {
    LAS float* scr = (LAS float*)(F.lds + F.wave * 16384);
    constexpr int I1 = 16 * 16, I2 = 4 * 32, PER = I1 + I2, NIT = 64 * PER;
    for (int it = F.gw; it < NIT; it += F.NGW) {
        const int e = it / PER; int r = it % PER;
        if (r < I1) { const float* wg = AIN(24) + (size_t)e * 1024 * 256; const float* wu = AIN(25) + (size_t)e * 1024 * 256;
            transpose_item<0>([=](int n) { TrSrc s; const int j = n >> 8, sel = (n >> 7) & 1, cc = n & 127; s.base = (sel ? wu : wg) + 128 * j + cc; s.nsrc = 256; return s; }, 1024, (bf16_t*)(F.ws + WS_W1T) + (size_t)e * 512 * 1024, scr, r / 16, r % 16, F.lane); }
        else { r -= I1; const float* w = AIN(26) + (size_t)e * 256 * 1024;
            transpose_item<0>([=](int n) { TrSrc s; s.base = w + n; s.nsrc = 1024; return s; }, 256, (bf16_t*)(F.ws + WS_W2T) + (size_t)e * 1024 * 256, scr, r / 32, r % 32, F.lane); }
    }
}

__device__ __forceinline__ void norm_mod_rows(const Args& args, Frame& F, const float* X, const float* g, int sh_off, int sc_off, bf16_t* O, unsigned char* O8) {
    const int row0 = F.gw * 16, b = row0 / SEQ;
    const float* mod = (const float*)(F.ws + WS_MOD) + b * 6144;
    f32x4 mul[4], add[4];
#pragma unroll
    for (int j = 0; j < 4; ++j) { const int c = 4 * F.lane + 256 * j; const f32x4 gv = *(const f32x4*)(g + c), sc = *(const f32x4*)(mod + sc_off + c); add[j] = *(const f32x4*)(mod + sh_off + c); mul[j] = gv * (sc + 1.0f); }
    for (int r = 0; r < 16; ++r) {
        const GAS f32x4* xr = (const GAS f32x4*)(X + (size_t)(row0 + r) * D) + F.lane;
        f32x4 v[4]; float s = 0.f;
#pragma unroll
        for (int j = 0; j < 4; ++j) { v[j] = xr[64 * j]; s += (v[j].x * v[j].x + v[j].y * v[j].y) + (v[j].z * v[j].z + v[j].w * v[j].w); }
        const float rstd = 1.0f / sqrtf(wave_sum(s) * (1.0f / D) + RMS_EPS);
#pragma unroll
        for (int j = 0; j < 4; ++j) { const f32x4 y = v[j] * rstd * mul[j] + add[j];
            if (O) { u32x2 w; w.x = cvt_pk_bf16(y.x, y.y); w.y = cvt_pk_bf16(y.z, y.w); ((GAS u32x2*)(O + (size_t)(row0 + r) * D) + F.lane)[64 * j] = w; }
            if (O8) { int w8 = __builtin_amdgcn_cvt_pk_fp8_f32(y.x, y.y, 0, false); w8 = __builtin_amdgcn_cvt_pk_fp8_f32(y.z, y.w, w8, true); ((GAS unsigned*)(O8 + (size_t)(row0 + r) * D) + F.lane)[64 * j] = (unsigned)w8; } }
    }
}
using pg8::Unit;
constexpr float WSCALE8 = 32.0f;
typedef const f32x4 (&AccRef)[2][2][4][2];

struct EpiInProj {
    static constexpr bool PERM = true;
    bf16_t* Z; bf16_t* Gt;
    __device__ __forceinline__ void operator()(AccRef acc, const Unit& u, int wr, int wc, int fr, int fq) const {
        asm volatile("" : "+v"(fr), "+v"(fq));
        const int row0 = u.pm * 256 + wr * 64 + fr;
        const bool gate = u.pn >= 16;
        const float sc = ((u.pn < 2) ? QSCALE : 1.0f) * (1.0f / WSCALE8);
        bf16_t* base = gate ? Gt + (size_t)(u.pn - 16) * 256 : Z + (size_t)u.pn * 256;
        const int ldc = gate ? GW : ZW;
#pragma unroll
        for (int ai = 0; ai < 2; ++ai)
#pragma unroll
            for (int m = 0; m < 4; ++m) { bf16_t* rowp = base + (size_t)(row0 + ai * 128 + m * 16) * ldc + wc * 32 + 8 * fq;
#pragma unroll
                for (int bj = 0; bj < 2; ++bj) { f32x4 v0 = acc[ai][bj][m][0], v1 = acc[ai][bj][m][1];
                    if (gate) {
#pragma unroll
                        for (int j = 0; j < 4; ++j) { v0[j] = fast_sigmoid(v0[j] * sc); v1[j] = fast_sigmoid(v1[j] * sc); } }
                    else { v0 = v0 * sc; v1 = v1 * sc; }
                    u32x4 w; w.x = cvt_pk_bf16(v0[0], v0[1]); w.y = cvt_pk_bf16(v0[2], v0[3]); w.z = cvt_pk_bf16(v1[0], v1[1]); w.w = cvt_pk_bf16(v1[2], v1[3]);
                    *(u32x4*)(rowp + bj * 128) = w; } }
    }
};

constexpr float ATT_S8 = 16.0f, RW_S8 = 8.0f, MIX_S8 = 16.0f;
template <int SECOND> struct EpiMerge {
    static constexpr bool PERM = true;
    bf16_t* Mx; unsigned char* Mx8; const bf16_t* Gt; float bs;
    __device__ __forceinline__ void operator()(AccRef acc, const Unit& u, int wr, int wc, int fr, int fq) const {
        asm volatile("" : "+v"(fr), "+v"(fq));
        const int row0 = u.pm * 256 + wr * 64 + fr, col0 = u.pn * 256 + wc * 32 + 8 * fq;
#pragma unroll
        for (int ai = 0; ai < 2; ++ai)
#pragma unroll
            for (int m = 0; m < 4; ++m) { const size_t r = (size_t)(row0 + ai * 128 + m * 16);
#pragma unroll
                for (int bj = 0; bj < 2; ++bj) { const int c = col0 + bj * 128;
                    const u32x4 g = *(const u32x4*)(Gt + r * GW + SECOND * 1024 + c);
                    f32x4 v0 = acc[ai][bj][m][0] * bs, v1 = acc[ai][bj][m][1] * bs;
                    v0[0] *= bf_lo(g.x); v0[1] *= bf_hi(g.x); v0[2] *= bf_lo(g.y); v0[3] *= bf_hi(g.y);
                    v1[0] *= bf_lo(g.z); v1[1] *= bf_hi(g.z); v1[2] *= bf_lo(g.w); v1[3] *= bf_hi(g.w);
                    if (SECOND) { const u32x4 p = *(const u32x4*)(Mx + r * D + c);
                        v0[0] += bf_lo(p.x); v0[1] += bf_hi(p.x); v0[2] += bf_lo(p.y); v0[3] += bf_hi(p.y);
                        v1[0] += bf_lo(p.z); v1[1] += bf_hi(p.z); v1[2] += bf_lo(p.w); v1[3] += bf_hi(p.w);
                        v0 = v0 * MIX_S8; v1 = v1 * MIX_S8;
                        int lo = __builtin_amdgcn_cvt_pk_fp8_f32(v0[0], v0[1], 0, false); lo = __builtin_amdgcn_cvt_pk_fp8_f32(v0[2], v0[3], lo, true);
                        int hi = __builtin_amdgcn_cvt_pk_fp8_f32(v1[0], v1[1], 0, false); hi = __builtin_amdgcn_cvt_pk_fp8_f32(v1[2], v1[3], hi, true);
                        *(u32x2*)(Mx8 + r * D + c) = (u32x2){(unsigned)lo, (unsigned)hi}; }
                    else { u32x4 w; w.x = cvt_pk_bf16(v0[0], v0[1]); w.y = cvt_pk_bf16(v0[2], v0[3]); w.z = cvt_pk_bf16(v1[0], v1[1]); w.w = cvt_pk_bf16(v1[2], v1[3]);
                        *(u32x4*)(Mx + r * D + c) = w; } } }
    }
};

struct EpiOutProj {
    static constexpr bool PERM = false;
    const float* X; float* O; const float* mod;
    __device__ __forceinline__ void operator()(AccRef acc, const Unit& u, int wr, int wc, int fr, int fq) const {
        asm volatile("" : "+v"(fr), "+v"(fq));
        const int row0 = u.pm * 256 + wr * 64 + fr, col0 = u.pn * 256 + wc * 32 + 4 * fq;
        const float* g1 = mod + (size_t)((u.pm * 256) / SEQ) * 6144 + 2048;
        f32x4 gv[2][2];
#pragma unroll
        for (int bj = 0; bj < 2; ++bj)
#pragma unroll
            for (int n = 0; n < 2; ++n) gv[bj][n] = *(const f32x4*)(g1 + col0 + bj * 128 + n * 16);
#pragma unroll
        for (int ai = 0; ai < 2; ++ai)
#pragma unroll
            for (int m = 0; m < 4; ++m) { const size_t off = (size_t)(row0 + ai * 128 + m * 16) * D + col0;
#pragma unroll
                for (int bj = 0; bj < 2; ++bj)
#pragma unroll
                    for (int n = 0; n < 2; ++n) { const f32x4 xv = *(const f32x4*)(X + off + bj * 128 + n * 16);
                        *(f32x4*)(O + off + bj * 128 + n * 16) = xv + gv[bj][n] * acc[ai][bj][m][n] * (1.0f / (MIX_S8 * WSCALE8)); }
                if (m & 1) asm volatile("" ::: "memory"); }
    }
};

struct EpiRouter {
    static constexpr bool PERM = false;
    float* L;
    __device__ __forceinline__ void operator()(AccRef acc, const Unit& u, int wr, int wc, int fr, int fq) const {
        asm volatile("" : "+v"(fr), "+v"(fq));
        if (wc >= 2) return;
        const int row0 = u.pm * 256 + wr * 64 + fr, col0 = wc * 32 + 4 * fq;
#pragma unroll
        for (int ai = 0; ai < 2; ++ai)
#pragma unroll
            for (int m = 0; m < 4; ++m)
#pragma unroll
                for (int n = 0; n < 2; ++n) *(f32x4*)(L + (size_t)(row0 + ai * 128 + m * 16) * 64 + col0 + n * 16) = acc[ai][0][m][n];
    }
};

struct MoeSched1 {
    const LAS unsigned* tab; int ntiles, G, c;
    __device__ __forceinline__ bool next(int i, Unit& u) const {
        const int L = i * G + c; if (L >= 256 + 2 * ntiles) return false;
        u.pn = L & 1;
        if (L < 256) { u.pm = L >> 1; u.aux0 = (u.pm * 256) | (64 << 20); u.aux1 = 256; }
        else { const int t = (L - 256) >> 1; u.pm = t; u.aux0 = __builtin_amdgcn_readfirstlane((int)tab[2 * t]); u.aux1 = __builtin_amdgcn_readfirstlane((int)tab[2 * t + 1]); }
        return true;
    }
};
struct MoeSrc1 {
    static constexpr int ESZ = 2; static constexpr bool GATHER = true;
    const unsigned char* ws;
    __device__ __forceinline__ const char* a_base(const Unit&) const { return (const char*)(ws + WS_H2); }
    __device__ __forceinline__ const char* b_base(const Unit& u) const { const int e = u.aux0 >> 20;
        const size_t off = (e == 64 ? WS_WSH1 : WS_W1T + (size_t)e * 512 * 1024 * 2) + (size_t)u.pn * 256 * 1024 * 2; return (const char*)ws + off; }
    __device__ __forceinline__ unsigned a_off(const Unit& u, int R, int C) const {
        const int e = u.aux0 >> 20, pos0 = u.aux0 & 0xFFFFF; int tok;
        if (e == 64) tok = pos0 + R; else tok = (R < u.aux1) ? (((const int*)(ws + WS_STOK))[pos0 + R] >> 3) : 0;
        return (unsigned)tok * 2048u + (unsigned)C * 2u; }
};
struct EpiMoe1 {
    static constexpr bool PERM = true;
    unsigned char* ws;
    __device__ __forceinline__ void operator()(AccRef acc, const Unit& u, int wr, int wc, int fr, int fq) const {
        asm volatile("" : "+v"(fr), "+v"(fq));
        const int e = u.aux0 >> 20, pos0 = u.aux0 & 0xFFFFF;
        bf16_t* base = (bf16_t*)(ws + (e == 64 ? WS_ACTS : WS_ACT)) + (size_t)pos0 * FF + u.pn * 128 + wc * 32 + 8 * fq;
#pragma unroll
        for (int ai = 0; ai < 2; ++ai)
#pragma unroll
            for (int m = 0; m < 4; ++m) { const int r = ai * 128 + wr * 64 + m * 16 + fr;
                float o[8];
#pragma unroll
                for (int n = 0; n < 2; ++n)
#pragma unroll
                    for (int j = 0; j < 4; ++j) { const float g = acc[ai][0][m][n][j], up = acc[ai][1][m][n][j]; o[4 * n + j] = g * fast_sigmoid(g) * up; }
                u32x4 w; w.x = cvt_pk_bf16(o[0], o[1]); w.y = cvt_pk_bf16(o[2], o[3]); w.z = cvt_pk_bf16(o[4], o[5]); w.w = cvt_pk_bf16(o[6], o[7]);
                if (r < u.aux1) *(u32x4*)(base + (size_t)r * FF) = w; }
    }
};
struct MoeSched2 {
    const LAS unsigned* tab; int t0, ntiles, nsh, G, c;
    __device__ __forceinline__ bool next(int i, Unit& u) const {
        const int L = i * G + c; if (L >= nsh + 4 * ntiles) return false;
        u.pn = L & 3;
        if (L < nsh) { u.pm = L >> 2; u.aux0 = (u.pm * 256) | (64 << 20); u.aux1 = 256; }
        else { const int t = t0 + ((L - nsh) >> 2); u.pm = t; u.aux0 = __builtin_amdgcn_readfirstlane((int)tab[2 * t]); u.aux1 = __builtin_amdgcn_readfirstlane((int)tab[2 * t + 1]); }
        return true;
    }
};
struct MoeSrc2 {
    static constexpr int ESZ = 2; static constexpr bool GATHER = true;
    const unsigned char* ws;
    __device__ __forceinline__ const char* a_base(const Unit& u) const { return (const char*)ws + ((u.aux0 >> 20) == 64 ? WS_ACTS : WS_ACT); }
    __device__ __forceinline__ const char* b_base(const Unit& u) const { const int e = u.aux0 >> 20;
        const size_t off = (e == 64 ? WS_WSH2 : WS_W2T + (size_t)e * 1024 * 256 * 2) + (size_t)u.pn * 256 * 256 * 2; return (const char*)ws + off; }
    __device__ __forceinline__ unsigned a_off(const Unit& u, int R, int C) const {
        const int pos0 = u.aux0 & 0xFFFFF; const int rr = R < u.aux1 ? R : u.aux1 - 1;
        return (unsigned)(pos0 + rr) * 512u + (unsigned)C * 2u; }
};
constexpr float SLOT_SCALE = 16.0f;
constexpr int NSLOT = 9;
struct EpiMoe2 {
    static constexpr bool PERM = true;
    unsigned char* ws; float* X1; int tokbase;
    __device__ __forceinline__ void operator()(AccRef acc, const Unit& u, int wr, int wc, int fr, int fq) const {
        asm volatile("" : "+v"(fr), "+v"(fq));
        const int e = u.aux0 >> 20, pos0 = u.aux0 & 0xFFFFF; const int col0 = u.pn * 256 + wc * 32 + 8 * fq;
        if (e == 64) {
#pragma unroll
            for (int ai = 0; ai < 2; ++ai)
#pragma unroll
                for (int m = 0; m < 4; ++m) { unsigned char* rowp = (unsigned char*)(ws + WS_SLOT) + ((size_t)(pos0 + ai * 128 + wr * 64 + m * 16 + fr) * NSLOT + 8) * D + u.pn * 256 + wc * 64 + fq * 16;
                    u32x4 o;
#pragma unroll
                    for (int bj = 0; bj < 2; ++bj) { const f32x4 v0 = acc[ai][bj][m][0] * SLOT_SCALE, v1 = acc[ai][bj][m][1] * SLOT_SCALE;
                        int lo = __builtin_amdgcn_cvt_pk_fp8_f32(v0[0], v0[1], 0, false); lo = __builtin_amdgcn_cvt_pk_fp8_f32(v0[2], v0[3], lo, true);
                        int hi = __builtin_amdgcn_cvt_pk_fp8_f32(v1[0], v1[1], 0, false); hi = __builtin_amdgcn_cvt_pk_fp8_f32(v1[2], v1[3], hi, true);
                        if (bj == 0) { o.x = (unsigned)lo; o.y = (unsigned)hi; } else { o.z = (unsigned)lo; o.w = (unsigned)hi; } }
                    *(u32x4*)rowp = o;
                    asm volatile("" ::: "memory"); }
        } else {
#pragma unroll
            for (int ai = 0; ai < 2; ++ai)
#pragma unroll
                for (int m = 0; m < 4; ++m) { const int r = ai * 128 + wr * 64 + m * 16 + fr;
                    if (r < u.aux1) { const int tk = ((const int*)(ws + WS_STOK))[pos0 + r]; const float w = ((const float*)(ws + WS_SW))[pos0 + r] * SLOT_SCALE;
                        unsigned char* rowp = (unsigned char*)(ws + WS_SLOT) + ((size_t)(tk >> 3) * NSLOT + (tk & 7)) * D + u.pn * 256 + wc * 64 + fq * 16;
                        u32x4 o;
#pragma unroll
                        for (int bj = 0; bj < 2; ++bj) { const f32x4 v0 = acc[ai][bj][m][0] * w, v1 = acc[ai][bj][m][1] * w;
                            int lo = __builtin_amdgcn_cvt_pk_fp8_f32(v0[0], v0[1], 0, false); lo = __builtin_amdgcn_cvt_pk_fp8_f32(v0[2], v0[3], lo, true);
                            int hi = __builtin_amdgcn_cvt_pk_fp8_f32(v1[0], v1[1], 0, false); hi = __builtin_amdgcn_cvt_pk_fp8_f32(v1[2], v1[3], hi, true);
                            if (bj == 0) { o.x = (unsigned)lo; o.y = (unsigned)hi; } else { o.z = (unsigned)lo; o.w = (unsigned)hi; } }
                        *(u32x4*)rowp = o; }
                    asm volatile("" ::: "memory"); }
        }
    }
};
__device__ __forceinline__ unsigned ord_key(float x) { const unsigned b = __float_as_uint(x); return (b & 0x80000000u) ? ~b : (b | 0x80000000u); }

__device__ __forceinline__ void indexer_unit(const Args& args, Frame& F, int b, int q0) {
    const bf16_t* Z = (const bf16_t*)(F.ws + WS_Z) + (size_t)b * SEQ * ZW;
    unsigned* SELM = (unsigned*)(F.ws + WS_SEL) + (size_t)b * SEQ * 128;
    int tid = F.tid; asm volatile("" : "+v"(tid));
    const int lane = tid & 63, kl = lane & 31, hl = lane >> 5, w = F.wave;
    const int qa = q0 + 2 * w;
    const int myq = qa + hl;
    bf16x8 A0, A1;
    { const int aq = (kl >> 2) & 1, ah = 4 * (kl >> 3) + (kl & 3);
      const bf16_t* p = Z + (size_t)(qa + aq) * ZW + ZIQ + ah * 32 + 8 * hl;
      A0 = *(const bf16x8*)p; A1 = *(const bf16x8*)(p + 16); }
    float wq[16];
    { const bf16_t* p = Z + (size_t)myq * ZW + ZIW; const u32x4 a = *(const u32x4*)p, c = *(const u32x4*)(p + 8);
      wq[0] = bf_lo(a.x); wq[1] = bf_hi(a.x); wq[2] = bf_lo(a.y); wq[3] = bf_hi(a.y); wq[4] = bf_lo(a.z); wq[5] = bf_hi(a.z); wq[6] = bf_lo(a.w); wq[7] = bf_hi(a.w);
      wq[8] = bf_lo(c.x); wq[9] = bf_hi(c.x); wq[10] = bf_lo(c.y); wq[11] = bf_hi(c.y); wq[12] = bf_lo(c.z); wq[13] = bf_hi(c.z); wq[14] = bf_lo(c.w); wq[15] = bf_hi(c.w); }
    unsigned key[128];
    const int nchunk = (q0 + 15) / 1024 + 1;
#define IDX_LOAD(ch, buf) do { _Pragma("unroll") for (int _h = 0; _h < 2; ++_h) { u32x4 v_[4]; \
        _Pragma("unroll") for (int _i = 0; _i < 4; ++_i) { const int pc = tid + 512 * (4 * _h + _i); const int kk = pc >> 2, c4 = pc & 3; v_[_i] = *(const u32x4*)(Z + (size_t)((ch) * 1024 + kk) * ZW + ZIK + 8 * c4); } \
        _Pragma("unroll") for (int _i = 0; _i < 4; ++_i) { const int pc = tid + 512 * (4 * _h + _i); const int kk = pc >> 2, c4 = pc & 3; *(LAS u32x4*)(F.lds + (buf) * 65536 + (c4 * 1024 + kk) * 16) = v_[_i]; } \
        asm volatile("" ::: "memory"); } } while (0)
    IDX_LOAD(0, 0);
    __syncthreads();
#pragma unroll
    for (int ch = 0; ch < 4; ++ch) {
        if (ch < nchunk) {
            if (ch + 1 < nchunk) IDX_LOAD(ch + 1, (ch + 1) & 1);
            LAS unsigned char* kbl = F.lds + (ch & 1) * 65536 + hl * 16384 + kl * 16; asm volatile("" : "+v"(kbl));
#pragma unroll
            for (int tt = 0; tt < 32; tt += 2) {
                const int t = ch * 32 + tt;
                if (32 * t <= qa + 1) {
                    bf16x8 B0[2], B1[2]; f32x16 acc[2];
#pragma unroll
                    for (int j = 0; j < 2; ++j) { B0[j] = *(const LAS bf16x8*)(kbl + 512 * (tt + j)); B1[j] = *(const LAS bf16x8*)(kbl + 32768 + 512 * (tt + j)); }
#pragma unroll
                    for (int j = 0; j < 2; ++j) { acc[j] = f32x16{}; acc[j] = __builtin_amdgcn_mfma_f32_32x32x16_bf16(A0, B0[j], acc[j], 0, 0, 0); }
#pragma unroll
                    for (int j = 0; j < 2; ++j) acc[j] = __builtin_amdgcn_mfma_f32_32x32x16_bf16(A1, B1[j], acc[j], 0, 0, 0);
#pragma unroll
                    for (int j = 0; j < 2; ++j) { float s = 0.f;
#pragma unroll
                        for (int i = 0; i < 16; ++i) s += __builtin_fmaxf(acc[j][i], 0.f) * wq[i];
                        key[t + j] = (32 * (t + j) + kl <= myq) ? ord_key(s) : 0u; }
                } else {
#pragma unroll
                    for (int j = 0; j < 2; ++j) key[t + j] = 0u;
                }
            }
            __syncthreads();
        } else {
#pragma unroll
            for (int tt = 0; tt < 32; ++tt) key[ch * 32 + tt] = 0u;
        }
    }
#undef IDX_LOAD
    unsigned T = 0u; bool done = (myq + 1 <= 256);
    if (done) T = 1u;
#define IDX_COUNT(cand_, cnt_) do { cnt_ = 0; _Pragma("unroll") for (int blk_ = 0; blk_ < 8; ++blk_) { if (blk_ * 512 <= qa + 1) { \
            _Pragma("unroll") for (int t = blk_ * 16; t < blk_ * 16 + 16; ++t) cnt_ += (key[t] >= (cand_)) ? 1u : 0u; } } \
        _Pragma("unroll") for (int o = 1; o < 32; o <<= 1) cnt_ += __shfl_xor(cnt_, o); } while (0)
    if (!__all(done)) {
        unsigned mx = 0u;
#pragma unroll
        for (int t = 0; t < 128; ++t) mx = key[t] > mx ? key[t] : mx;
#pragma unroll
        for (int o = 1; o < 32; o <<= 1) { const unsigned v = __shfl_xor(mx, o); mx = v > mx ? v : mx; }
        for (int bit = 31; bit >= 0; --bit) {
            if (__all(done)) break;
            const unsigned cand = T | (1u << bit);
            if (__all(done || cand > mx)) continue;
            unsigned cnt; IDX_COUNT(cand, cnt);
            if (!done && cnt >= 256u) { T = cand; if (cnt == 256u) done = true; }
        }
    }
#undef IDX_COUNT
    unsigned mw[4] = {0u, 0u, 0u, 0u};
#pragma unroll
    for (int t = 0; t < 128; ++t) {
        const unsigned long long bal = __ballot(key[t] >= T);
        const unsigned word = hl ? (unsigned)(bal >> 32) : (unsigned)bal;
        if (kl == (t & 31)) mw[t >> 5] = word;
        if ((t & 3) == 3) __builtin_amdgcn_sched_barrier(0);
    }
#pragma unroll
    for (int j = 0; j < 4; ++j) SELM[(size_t)myq * 128 + kl + 32 * j] = mw[j];
}

__device__ __forceinline__ void indexer_phase(const Args& args, Frame& F) {
    const int c = blockIdx.x;
    for (int i = 0; i < 8; ++i) {
        for (int u = c + i * F.G; u < 2048 && i < 8; u += 2048) {
            const int b = u >> 8, pos = u & 255, blk = (b & 1) ? 255 - pos : pos;
            indexer_unit(args, F, b, blk * 16);
        }
    }
}
namespace att {
constexpr int DM = ZW, QB = 256, KVB = 64, SLOTB = 8192;
constexpr int L_K = 0, L_V = 2 * SLOTB, L_MASK = 4 * SLOTB, L_WSF = L_MASK + 8 * 2048, L_OST = L_WSF + 8 * 256, L_BT = L_OST + 8 * 4096, L_END = L_BT + 512;
__device__ __forceinline__ int crow(int r, int hi) { return (r & 3) + 8 * (r >> 2) + 4 * hi; }
__device__ __forceinline__ void glds16(const void* gsrc, unsigned lds_dst) { unsigned keep;
    asm volatile("s_mov_b32 %0, m0\n\ts_mov_b32 m0, %2\n\ts_nop 0\n\tglobal_load_lds_dwordx4 %1, off\n\ts_mov_b32 m0, %0" : "=&s"(keep) : "v"(gsrc), "s"(lds_dst) : "memory"); }
__device__ __forceinline__ unsigned cvtpk(float lo, float hi) { return cvt_pk_bf16(lo, hi); }
typedef short s16x4 __attribute__((ext_vector_type(4)));

__device__ __forceinline__ void attn_unit(const Args& args, Frame& F, int b, int h, int qb) {
    const int lane = F.lane, r32 = lane & 31, hi = lane >> 5, wid = F.wave;
    const bf16_t* Zb = (const bf16_t*)(F.ws + WS_Z) + (size_t)b * SEQ * DM;
    const int q0 = qb * QB;
    const bf16_t* Qw = Zb + (size_t)(q0 + wid * 32) * DM + ZQ + h * 64;
    const bf16_t* Kh = Zb + ZK + h * 64; const bf16_t* Vh = Zb + ZV + h * 64;
    LAS unsigned char* shm = F.lds;
    const unsigned lds0 = (unsigned)(uintptr_t)shm;
    LAS float* wsf = (LAS float*)(shm + L_WSF) + wid * 64;
    LAS float* bt = (LAS float*)(shm + L_BT);
    if (F.tid < 128) { const int rel = F.tid; int bk;
        if (rel < 16) bk = rel; else { bk = 16 + (int)(logf((float)rel / 16.0f) / logf(8.0f) * 16.0f); bk = bk < 31 ? bk : 31; }
        bt[rel] = (AIN(6)[bk * 8 + h] - AIN(6)[31 * 8 + h]) * 1.4426950408889634f; }
    const bf16_t* ksrc = Kh + (size_t)lane * DM + wid * 8;
    const bf16_t* vsrc = Vh + (size_t)(16 * (wid & 3) + (lane >> 2)) * DM + (wid >> 2) * 32 + (lane & 3) * 8;
    const unsigned kdst = lds0 + L_K + wid * 1024, vdst = lds0 + L_V + wid * 1024;
    const unsigned* SELM = (const unsigned*)(F.ws + WS_SEL) + (size_t)(b * SEQ + q0 + wid * 32 + r32) * 128 + 4 * hi;
    const unsigned mdst = lds0 + L_MASK + wid * 2048;
#define DMA_K(t, slot) glds16(ksrc + (size_t)(t) * KVB * DM, (unsigned)__builtin_amdgcn_readfirstlane(kdst + (slot) * SLOTB))
#define DMA_V(t, slot) glds16(vsrc + (size_t)(t) * KVB * DM, (unsigned)__builtin_amdgcn_readfirstlane(vdst + (slot) * SLOTB))
#define DMA_M(g) glds16(SELM + 8 * (g), (unsigned)__builtin_amdgcn_readfirstlane(mdst + ((g) & 1) * 1024))
    const int NT = (q0 + QB) / KVB;
    bf16x8 qr[4];
#pragma unroll
    for (int d0 = 0; d0 < 4; ++d0) qr[d0] = *(const bf16x8*)(Qw + (size_t)r32 * DM + d0 * 16 + hi * 8);
    asm volatile("s_waitcnt vmcnt(0)" ::: "memory");
    __syncthreads();
    DMA_M(0); DMA_K(0, 0); DMA_V(0, 0);
    float m_run = -1e30f, l_run = 0.f; f32x16 o[2]; o[0] = f32x16{}; o[1] = f32x16{};
    const int qpos = q0 + wid * 32 + r32;
    const int vb0 = (int)(lds0 + L_V) + ((lane >> 4) & 1) * 32 + (lane & 3) * 8 + (4 * hi + ((lane & 15) >> 2)) * 64;
    for (int t = 0; t < NT; ++t) {
        const int slot = t & 1, g = t >> 2, tq = t & 3;
        if (t + 1 < NT) {
            DMA_K(t + 1, slot ^ 1); DMA_V(t + 1, slot ^ 1);
            if (tq == 0) { DMA_M(g + 1); asm volatile("s_waitcnt vmcnt(3)" ::: "memory"); }
            else if (tq == 1) asm volatile("s_waitcnt vmcnt(3)" ::: "memory");
            else asm volatile("s_waitcnt vmcnt(2)" ::: "memory");
        } else asm volatile("s_waitcnt vmcnt(0)" ::: "memory");
        __builtin_amdgcn_s_barrier(); asm volatile("" ::: "memory");
        f32x16 p0 = {}, p1 = {};
        { const LAS unsigned char* kb = shm + L_K + slot * SLOTB + hi * 1024 + r32 * 16;
#pragma unroll
          for (int d0 = 0; d0 < 4; ++d0) { const bf16x8 b0 = *(const LAS bf16x8*)(kb + d0 * 2048); const bf16x8 b1 = *(const LAS bf16x8*)(kb + d0 * 2048 + 512);
              p0 = __builtin_amdgcn_mfma_f32_32x32x16_bf16(b0, qr[d0], p0, 0, 0, 0); p1 = __builtin_amdgcn_mfma_f32_32x32x16_bf16(b1, qr[d0], p1, 0, 0, 0); } }
        const u32x2 mwv = *(const LAS u32x2*)(shm + L_MASK + wid * 2048 + (g & 1) * 1024 + (tq >> 1) * 512 + r32 * 16 + (tq & 1) * 8);
        if (64 * t + 63 + 112 >= q0 + wid * 32) {
#pragma unroll
            for (int r = 0; r < 16; ++r) { const int kv = 64 * t + crow(r, hi); int r0 = qpos - kv, r1 = r0 - 32;
                r0 = r0 < 0 ? 0 : (r0 > 127 ? 127 : r0); r1 = r1 < 0 ? 0 : (r1 > 127 ? 127 : r1);
                p0[r] += bt[r0]; p1[r] += bt[r1]; }
        }
        const float NEG = -INFINITY;
#pragma unroll
        for (int r = 0; r < 16; ++r) { const int bitp = crow(r, hi);
            if (!((mwv.x >> bitp) & 1u)) p0[r] = NEG;
            if (!((mwv.y >> bitp) & 1u)) p1[r] = NEG; }
        float rm = p0[0];
#pragma unroll
        for (int r = 1; r < 16; ++r) rm = __builtin_fmaxf(rm, p0[r]);
#pragma unroll
        for (int r = 0; r < 16; ++r) rm = __builtin_fmaxf(rm, p1[r]);
        rm = __builtin_fmaxf(rm, __shfl_xor(rm, 32));
        const float m_new = __builtin_fmaxf(m_run, rm);
        const float f = __builtin_amdgcn_exp2f(m_run - m_new);
        m_run = m_new;
        float sacc = 0.f;
#pragma unroll
        for (int r = 0; r < 16; ++r) { p0[r] = __builtin_amdgcn_exp2f(p0[r] - m_new); p1[r] = __builtin_amdgcn_exp2f(p1[r] - m_new); sacc += p0[r] + p1[r]; }
        l_run = l_run * f + sacc;
        if (hi == 0) wsf[r32] = f;
        asm volatile("s_waitcnt lgkmcnt(0)" ::: "memory");
#pragma unroll
        for (int d = 0; d < 2; ++d)
#pragma unroll
            for (int r = 0; r < 16; ++r) o[d][r] *= wsf[crow(r, hi)];
        u32x4 pw0, pw1, pw2, pw3;
        pw0 = (u32x4){cvtpk(p0[0], p0[1]), cvtpk(p0[2], p0[3]), cvtpk(p0[4], p0[5]), cvtpk(p0[6], p0[7])};
        pw1 = (u32x4){cvtpk(p0[8], p0[9]), cvtpk(p0[10], p0[11]), cvtpk(p0[12], p0[13]), cvtpk(p0[14], p0[15])};
        pw2 = (u32x4){cvtpk(p1[0], p1[1]), cvtpk(p1[2], p1[3]), cvtpk(p1[4], p1[5]), cvtpk(p1[6], p1[7])};
        pw3 = (u32x4){cvtpk(p1[8], p1[9]), cvtpk(p1[10], p1[11]), cvtpk(p1[12], p1[13]), cvtpk(p1[14], p1[15])};
        { const int vb = vb0 + slot * SLOTB;
#pragma unroll
          for (int d0 = 0; d0 < 2; ++d0) { s16x4 lo[4], hh[4];
#pragma unroll
              for (int ks = 0; ks < 4; ++ks) {
                  asm volatile("ds_read_b64_tr_b16 %0,%1 offset:%c2" : "=&v"(lo[ks]) : "v"(vb), "i"(d0 * 4096 + ks * 1024) : "memory");
                  asm volatile("ds_read_b64_tr_b16 %0,%1 offset:%c2" : "=&v"(hh[ks]) : "v"(vb), "i"(d0 * 4096 + ks * 1024 + 512) : "memory"); }
              asm volatile("s_waitcnt lgkmcnt(0)" ::: "memory"); __builtin_amdgcn_sched_barrier(0);
#define PKV(k) (bf16x8){lo[k][0], lo[k][1], lo[k][2], lo[k][3], hh[k][0], hh[k][1], hh[k][2], hh[k][3]}
              o[d0] = __builtin_amdgcn_mfma_f32_32x32x16_bf16(__builtin_bit_cast(bf16x8, pw0), PKV(0), o[d0], 0, 0, 0);
              o[d0] = __builtin_amdgcn_mfma_f32_32x32x16_bf16(__builtin_bit_cast(bf16x8, pw1), PKV(1), o[d0], 0, 0, 0);
              o[d0] = __builtin_amdgcn_mfma_f32_32x32x16_bf16(__builtin_bit_cast(bf16x8, pw2), PKV(2), o[d0], 0, 0, 0);
              o[d0] = __builtin_amdgcn_mfma_f32_32x32x16_bf16(__builtin_bit_cast(bf16x8, pw3), PKV(3), o[d0], 0, 0, 0);
#undef PKV
          } }
        asm volatile("s_waitcnt lgkmcnt(0)" ::: "memory");
        __builtin_amdgcn_s_barrier(); asm volatile("" ::: "memory");
    }
    l_run += __shfl_xor(l_run, 32);
    if (hi == 0) wsf[32 + r32] = l_run;
    asm volatile("s_waitcnt lgkmcnt(0)" ::: "memory");
    bf16_t* Ow = (bf16_t*)(F.ws + WS_R1) + (size_t)(b * SEQ + q0 + wid * 32) * 512 + h * 64;
    { LAS bf16_t* stg = (LAS bf16_t*)(shm + L_OST) + wid * 2048;
#pragma unroll
      for (int r = 0; r < 16; ++r) { const int orow = crow(r, hi); const float rl = __builtin_amdgcn_rcpf(wsf[32 + orow]);
#pragma unroll
          for (int d0 = 0; d0 < 2; ++d0) stg[orow * 64 + d0 * 32 + r32] = (bf16_t)f2bf(o[d0][r] * rl); }
      asm volatile("s_waitcnt lgkmcnt(0)" ::: "memory");
#pragma unroll
      for (int i = 0; i < 4; ++i) { const int row = i * 8 + (lane >> 3), chn = lane & 7; const u32x4 v = *(const LAS u32x4*)(stg + row * 64 + chn * 8); *(u32x4*)(Ow + (size_t)row * 512 + chn * 8) = v; } }
    asm volatile("s_waitcnt lgkmcnt(0)" ::: "memory");
#undef DMA_K
#undef DMA_V
#undef DMA_M
}

__device__ __forceinline__ void attn_phase(const Args& args, Frame& F) {
    const int v = F.vcu;
    for (int i = 0; i < 4; ++i) {
        for (int uu = v; uu < 256; uu += F.G) {
            const int bh = uu >> 2, s = uu & 3; const int qb = (i == 0) ? s : (i == 1) ? 7 - s : (i == 2) ? 8 + s : 15 - s;
            attn_unit(args, F, bh >> 3, bh & 7, qb);
        }
    }
}
}
#ifndef PROBE_NO_STATE
#define PROBE_NO_STATE 0
#endif
#ifndef PROBE_TINV_ID
#define PROBE_TINV_ID 0
#endif
namespace rk {
typedef __bf16 bf16x2_t __attribute__((ext_vector_type(2)));
__device__ __forceinline__ unsigned cvtpk(float lo, float hi) { f32x2 v = {lo, hi}; bf16x2_t b = __builtin_convertvector(v, bf16x2_t); return __builtin_bit_cast(unsigned, b); }
template <int S> __device__ __forceinline__ bf16x8 frag(const f32x16& x) {
    u32x4 o; o.x = cvtpk(x[8 * S + 0], x[8 * S + 1]); o.y = cvtpk(x[8 * S + 2], x[8 * S + 3]); o.z = cvtpk(x[8 * S + 4], x[8 * S + 5]); o.w = cvtpk(x[8 * S + 6], x[8 * S + 7]);
    return __builtin_bit_cast(bf16x8, o); }
template <int S> __device__ __forceinline__ void unfrag(f32x16& x, bf16x8 f) { const u32x4 o = __builtin_bit_cast(u32x4, f);
    x[8 * S + 0] = bf_lo(o.x); x[8 * S + 1] = bf_hi(o.x); x[8 * S + 2] = bf_lo(o.y); x[8 * S + 3] = bf_hi(o.y); x[8 * S + 4] = bf_lo(o.z); x[8 * S + 5] = bf_hi(o.z); x[8 * S + 6] = bf_lo(o.w); x[8 * S + 7] = bf_hi(o.w); }
#define RK_MF(a, b, c) __builtin_amdgcn_mfma_f32_32x32x16_bf16((a), (b), (c), 0, 0, 0)
__device__ __forceinline__ float dppf(float v, const int ctrl_is_const_dummy);
#define RK_DPP(v, ctrl, rmask, bc) __builtin_bit_cast(float, __builtin_amdgcn_update_dpp(0, __builtin_bit_cast(int, (v)), (ctrl), (rmask), 0xF, (bc)))
__device__ __forceinline__ float scan32(float v) {
#ifdef PROBE_SHFL_SCAN
    const int l32 = threadIdx.x & 31;
#pragma unroll
    for (int o = 1; o < 32; o <<= 1) { const float t = __shfl_up(v, o, 32); if (l32 >= o) v += t; }
    return v;
#endif
    v += RK_DPP(v, 0x111, 0xF, true); v += RK_DPP(v, 0x112, 0xF, true); v += RK_DPP(v, 0x114, 0xF, true); v += RK_DPP(v, 0x118, 0xF, true);
    v += RK_DPP(v, 0x142, 0xA, false);
    return v; }
__device__ __forceinline__ float ex2(float x) { return __builtin_amdgcn_exp2f(x); }
constexpr int PZ = 3600;
constexpr size_t SZ_G = 8192, SZ_H = 8192, SZ_Q = 4096, SZ_Y = 4096;
constexpr float L2E = 1.4426950408889634f;

__device__ __forceinline__ void mk_id(bf16x8 (&fId)[2], int r, int h) {
    asm volatile("" : "+v"(r), "+v"(h));
#pragma unroll
    for (int s = 0; s < 2; ++s) { unsigned short e8[8];
#pragma unroll
        for (int jj = 0; jj < 8; ++jj) e8[jj] = (16 * s + 8 * (jj >> 2) + 4 * h + (jj & 3) == r) ? (unsigned short)0x3F80 : (unsigned short)0;
        fId[s] = __builtin_bit_cast(bf16x8, (u32x4){(unsigned)e8[0] | ((unsigned)e8[1] << 16), (unsigned)e8[2] | ((unsigned)e8[3] << 16), (unsigned)e8[4] | ((unsigned)e8[5] << 16), (unsigned)e8[6] | ((unsigned)e8[7] << 16)}); }
}

__device__ __forceinline__ void load_params(const Args& args, Frame& F) {
    LAS float* pra = (LAS float*)(F.lds + LDS_PARA); LAS float* prb = (LAS float*)(F.lds + LDS_PARB);
    const float* mu = AIN(7); const float* w0 = AIN(8); const float* a0 = AIN(10); const float* kk = AIN(13); const float* ka = AIN(14); const float* rk = AIN(15);
    for (int i = F.tid; i < 4096; i += NTHR) { const int a = i >> 9, c = i & 511;
        const float v_ = a < 3 ? mu[a * 512 + c] : (a == 3 ? w0[c] : (a == 4 ? a0[c] : (a == 5 ? kk[c] : (a == 6 ? ka[c] : rk[c]))));
        if (a < 4) pra[c * 4 + a] = v_; else prb[c * 4 + a - 4] = v_; }
    __syncthreads();
}
struct ElemCtx { const LAS unsigned char* rowc; const LAS unsigned char* rowp; const bf16_t* DUt; const bf16_t* IUt; const LAS float* pra; const LAS float* prb; int hd, r, h; float inv; };
template <int MODE> __device__ __forceinline__ void r1_elem(const ElemCtx& C, int jt, bf16x8 (&o0)[2], bf16x8 (&o1)[2], bf16x8 (&o2)[2], bf16x8 (&o3)[2], float& bns, float& pcd) {
    const int r = C.r, h = C.h, hd = C.hd;
    f32x16 lw_ = f32x16{}, la_ = f32x16{};
#pragma unroll
    for (int ks = 0; ks < 4; ++ks) { const int k0 = 16 * ks + 8 * h;
        const bf16x8 bw = *(const LAS bf16x8*)(C.rowc + (1536 + k0) * 2), ba = *(const LAS bf16x8*)(C.rowc + (1600 + k0) * 2);
        const bf16x8 fa = *(const bf16x8*)(C.DUt + (size_t)(32 * jt + r) * 64 + k0), fi = *(const bf16x8*)(C.IUt + (size_t)(32 * jt + r) * 64 + k0);
        lw_ = RK_MF(fa, bw, lw_); la_ = RK_MF(fi, ba, la_); }
    float d = 0.f;
#pragma unroll
    for (int s = 0; s < 2; ++s) { float x0[8], x1[8], x2[8], x3[8];
#pragma unroll
        for (int g2 = 0; g2 < 2; ++g2) { const int g = 2 * s + g2, cj = hd * 64 + 32 * jt + 8 * g + 4 * h;
            float kc[4], kq[4], xc[4], xq[4];
            { const u32x2 a = *(const LAS u32x2*)(C.rowc + (512 + cj) * 2), p = *(const LAS u32x2*)(C.rowp + (512 + cj) * 2);
              kc[0] = bf_lo(a.x); kc[1] = bf_hi(a.x); kc[2] = bf_lo(a.y); kc[3] = bf_hi(a.y); kq[0] = bf_lo(p.x); kq[1] = bf_hi(p.x); kq[2] = bf_lo(p.y); kq[3] = bf_hi(p.y); }
            { const int xo = MODE ? 1024 : 0; const u32x2 a = *(const LAS u32x2*)(C.rowc + (xo + cj) * 2), p = *(const LAS u32x2*)(C.rowp + (xo + cj) * 2);
              xc[0] = bf_lo(a.x); xc[1] = bf_hi(a.x); xc[2] = bf_lo(a.y); xc[3] = bf_hi(a.y); xq[0] = bf_lo(p.x); xq[1] = bf_hi(p.x); xq[2] = bf_lo(p.y); xq[3] = bf_hi(p.y); }
            const LAS f32x4* ppa = (const LAS f32x4*)(C.pra + cj * 4); const LAS f32x4* ppb = (const LAS f32x4*)(C.prb + cj * 4);
#pragma unroll
            for (int q = 0; q < 4; ++q) { const int i = 4 * g + q, o = 4 * g2 + q;
                const f32x4 pa = ppa[q], pb = ppb[q];
                const float e_ = 0.6065306597126334f * fast_sigmoid(pa[3] + lw_[i]); const float L = scan32(e_);
                const float l0 = __builtin_bit_cast(float, __builtin_amdgcn_readlane(__builtin_bit_cast(int, L), 31)), l1 = __builtin_bit_cast(float, __builtin_amdgcn_readlane(__builtin_bit_cast(int, L), 63));
                const float Lend = h ? l1 : l0; if (i == 4 * (r >> 3) + (r & 3)) d = Lend;
                const float x_ = xc[q] + (MODE ? pa[2] : pa[0]) * (xq[q] - xc[q]), k_ = kc[q] + pa[1] * (kq[q] - kc[q]);
                const float ic = fast_sigmoid(pb[0] + la_[i]);
                const float kk = k_ * pb[1] * C.inv, kpn = k_ * (1.0f + (ic - 1.0f) * pb[2]), bv = kk * ic;
                if (MODE) { const float Qe = ex2(L2E * (L - Lend)); x0[o] = bv * Qe; x1[o] = kpn * Qe; x2[o] = x_; x3[o] = 0.f; }
                else { const float P = ex2(-L2E * L), Pi = ex2(L2E * L), Pm = ex2(-L2E * (L - e_)); bns += x_ * kpn * pb[3]; x0[o] = -kk * Pm; x1[o] = x_ * P; x2[o] = bv * Pi; x3[o] = kpn * Pi; } }
            asm volatile("" ::: "memory"); }
        o0[s] = __builtin_bit_cast(bf16x8, (u32x4){cvtpk(x0[0], x0[1]), cvtpk(x0[2], x0[3]), cvtpk(x0[4], x0[5]), cvtpk(x0[6], x0[7])});
        o1[s] = __builtin_bit_cast(bf16x8, (u32x4){cvtpk(x1[0], x1[1]), cvtpk(x1[2], x1[3]), cvtpk(x1[4], x1[5]), cvtpk(x1[6], x1[7])});
        o2[s] = __builtin_bit_cast(bf16x8, (u32x4){cvtpk(x2[0], x2[1]), cvtpk(x2[2], x2[3]), cvtpk(x2[4], x2[5]), cvtpk(x2[6], x2[7])});
        if (!MODE) o3[s] = __builtin_bit_cast(bf16x8, (u32x4){cvtpk(x3[0], x3[1]), cvtpk(x3[2], x3[3]), cvtpk(x3[4], x3[5]), cvtpk(x3[6], x3[7])}); }
    if (MODE) pcd = ex2(-L2E * d);
}


__device__ __forceinline__ void r1_unit(const Args& args, Frame& F, int b, int c) {
    LAS unsigned char* IMG = F.lds;
    const bf16_t* Z = (const bf16_t*)(F.ws + WS_Z);
    const int t0 = 32 * c; const size_t m0 = (size_t)b * SEQ + t0;
    const float* mu = AIN(7);
    int tid = F.tid; asm volatile("" : "+v"(tid));
    __syncthreads();
    for (int p = tid; p < 33 * 224; p += NTHR) { const int rr = p / 224, pc = p - rr * 224; u32x4 v = {0u, 0u, 0u, 0u};
        if (rr > 0 || t0 > 0) v = *(const u32x4*)(Z + (m0 + rr - 1) * ZW + ZR + 8 * pc);
        *(LAS u32x4*)(IMG + rr * PZ + 16 * pc) = v; }
    __syncthreads();
    { u32x4 actv[2];
#pragma unroll
      for (int i = 0; i < 2; ++i) { const int q = tid + NTHR * i, t = q >> 5, kp = q & 31;
          const u32x4 cw = *(const LAS u32x4*)(IMG + (t + 1) * PZ + (1536 + 8 * kp) * 2), pw = *(const LAS u32x4*)(IMG + t * PZ + (1536 + 8 * kp) * 2);
          const f32x4 m0v = *(const f32x4*)(mu + 1536 + 8 * kp), m1v = *(const f32x4*)(mu + 1536 + 8 * kp + 4);
          const unsigned cwa[4] = {cw.x, cw.y, cw.z, cw.w}, pwa[4] = {pw.x, pw.y, pw.z, pw.w}; float x[8];
#pragma unroll
          for (int j = 0; j < 4; ++j) { const float c0 = bf_lo(cwa[j]), c1 = bf_hi(cwa[j]), p0 = bf_lo(pwa[j]), p1 = bf_hi(pwa[j]);
              const float mu0 = j < 2 ? m0v[2 * j] : m1v[2 * j - 4], mu1 = j < 2 ? m0v[2 * j + 1] : m1v[2 * j - 3];
              x[2 * j] = c0 + mu0 * (p0 - c0); x[2 * j + 1] = c1 + mu1 * (p1 - c1); }
#pragma unroll
          for (int j = 0; j < 8; ++j) { if (kp < 8) { const float e2 = ex2(2.885390081777927f * x[j]); x[j] = 1.0f - 2.0f * __builtin_amdgcn_rcpf(e2 + 1.0f); } else if (kp >= 16) x[j] = fast_sigmoid(x[j]); }
          actv[i] = (u32x4){cvtpk(x[0], x[1]), cvtpk(x[2], x[3]), cvtpk(x[4], x[5]), cvtpk(x[6], x[7])}; }
      __syncthreads();
#pragma unroll
      for (int i = 0; i < 2; ++i) { const int q = tid + NTHR * i, t = q >> 5, kp = q & 31; *(LAS u32x4*)(IMG + (t + 1) * PZ + (1536 + 8 * kp) * 2) = actv[i]; }
      __syncthreads(); }
    const int hd = F.wave; int r = tid & 31, h = (tid >> 5) & 1;
    const LAS unsigned char* rowc = IMG + (r + 1) * PZ; const LAS unsigned char* rowp = IMG + r * PZ;
    const bf16_t* DUt = (const bf16_t*)(F.ws + WS_DUT) + (size_t)hd * 4096; const bf16_t* IUt = (const bf16_t*)(F.ws + WS_IUT) + (size_t)hd * 4096;
    const LAS float* pra = (const LAS float*)(F.lds + LDS_PARA); const LAS float* prb = (const LAS float*)(F.lds + LDS_PARB);
    float n2 = 0.f;
#pragma unroll
    for (int jt = 0; jt < 2; ++jt)
#pragma unroll
        for (int g = 0; g < 4; ++g) { const int cj = hd * 64 + 32 * jt + 8 * g + 4 * h;
            const u32x2 a = *(const LAS u32x2*)(rowc + (512 + cj) * 2), p = *(const LAS u32x2*)(rowp + (512 + cj) * 2);
            const float kc[4] = {bf_lo(a.x), bf_hi(a.x), bf_lo(a.y), bf_hi(a.y)}, kq[4] = {bf_lo(p.x), bf_hi(p.x), bf_lo(p.y), bf_hi(p.y)};
            #pragma unroll
            for (int q = 0; q < 4; ++q) { const float muk = pra[(cj + q) * 4 + 1], kkp = prb[(cj + q) * 4 + 1]; const float k_ = kc[q] + muk * (kq[q] - kc[q]); const float kk_ = k_ * kkp; n2 += kk_ * kk_; } }
    n2 += __shfl_xor(n2, 32);
    const float inv = 1.0f / __builtin_fmaxf(sqrtf(n2), 1e-12f);
    float pcd[2] = {0.f, 0.f};
    float bns = 0.f;
    const ElemCtx EC{rowc, rowp, DUt, IUt, pra, prb, hd, r, h, inv};
    f32x16 Aab = f32x16{}, Aak = f32x16{}, Arb = f32x16{}, Ark = f32x16{};
    bf16x8 fRt[2][2], tAt[2][2];
    { bf16x8 fId[2]; mk_id(fId, r, h);
#pragma unroll
    for (int jt = 0; jt < 2; ++jt) { bf16x8 fA[2], fB[2], fK[2]; float pd_ = 0.f;
        r1_elem<0>(EC, jt, fA, fRt[jt], fB, fK, bns, pd_);
        const bf16x8 fA0 = fA[0], fA1 = fA[1], fB0 = fB[0], fB1 = fB[1], fK0 = fK[0], fK1 = fK[1];
        Aab = RK_MF(fB0, fA0, Aab); Aab = RK_MF(fB1, fA1, Aab); Aak = RK_MF(fK0, fA0, Aak); Aak = RK_MF(fK1, fA1, Aak);
        Arb = RK_MF(fB0, fRt[jt][0], Arb); Arb = RK_MF(fB1, fRt[jt][1], Arb); Ark = RK_MF(fK0, fRt[jt][0], Ark); Ark = RK_MF(fK1, fRt[jt][1], Ark);
        { f32x16 t_ = f32x16{}; t_ = RK_MF(fA0, fId[0], t_); t_ = RK_MF(fA1, fId[1], t_); tAt[jt][0] = frag<0>(t_); tAt[jt][1] = frag<1>(t_); } } }
    bns += __shfl_xor(bns, 32);
    if (h == 0) ((float*)(F.ws + WS_TOPW))[(m0 + r) * 8 + hd] = bns;
    LAS unsigned char* stash = IMG + (1 + ((tid & 63) >> 3)) * PZ + hd * 128 + (tid & 7) * 16;
#pragma unroll
    for (int p = 0; p < 4; ++p) *(LAS u32x4*)(stash + 8 * p * PZ) = __builtin_bit_cast(u32x4, fRt[p >> 1][p & 1]);
#pragma unroll
    for (int i = 0; i < 16; ++i) { const int s = 8 * (i >> 2) + 4 * h + (i & 3);
        if (!(s < r)) { Aab[i] = 0.f; Aak[i] = 0.f; } if (!(s <= r)) { Arb[i] = 0.f; Ark[i] = 0.f; } }
    const bf16x8 fAak[2] = {frag<0>(Aak), frag<1>(Aak)}, fArb[2] = {frag<0>(Arb), frag<1>(Arb)}, fArk[2] = {frag<0>(Ark), frag<1>(Ark)};
    bf16x8 fT[2];
    asm volatile("" ::: "memory"); __builtin_amdgcn_sched_barrier(0);
    { float T[32];
#pragma unroll
      for (int s = 31; s >= 0; --s) { float acc = (r == s) ? 1.0f : 0.f; const int is = 4 * (s >> 3) + (s & 3), hs = (s >> 2) & 1;
#pragma unroll
          for (int u = s + 1; u < (PROBE_TINV_ID ? 0 : 32); ++u) { const float a_us = __builtin_bit_cast(float, __builtin_amdgcn_readlane(__builtin_bit_cast(int, Aab[is]), u + 32 * hs)); acc += T[u] * a_us; }
          T[s] = acc; }
#pragma unroll
      for (int s = 0; s < 2; ++s) { float e8[8];
#pragma unroll
          for (int jj = 0; jj < 8; ++jj) { const int i0 = 16 * s + 8 * (jj >> 2) + (jj & 3); float ta = T[i0], tb = T[i0 + 4]; asm volatile("" : "+v"(ta), "+v"(tb)); e8[jj] = h ? tb : ta; }
          fT[s] = __builtin_bit_cast(bf16x8, (u32x4){cvtpk(e8[0], e8[1]), cvtpk(e8[2], e8[3]), cvtpk(e8[4], e8[5]), cvtpk(e8[6], e8[7])}); } }
    asm volatile("" ::: "memory"); __builtin_amdgcn_sched_barrier(0);
    const size_t uid = ((size_t)(b * 8 + hd) * 128 + c);
    unsigned char* gG = F.ws + WS_R0 + uid * SZ_G; unsigned char* gH = F.ws + WS_R2 + uid * SZ_H; unsigned char* gQ = F.ws + WS_H0 + uid * SZ_Q; unsigned char* gY = F.ws + WS_H1 + uid * SZ_Y;
#define RK_ST(base, piece, f) (*(u32x4*)((base) + (piece) * 1024 + (tid & 63) * 16) = __builtin_bit_cast(u32x4, (f)))
    bf16x8 fWt[2][2];
#pragma unroll
    for (int jt = 0; jt < 2; ++jt) { f32x16 w_ = f32x16{}; w_ = RK_MF(fT[0], tAt[jt][0], w_); w_ = RK_MF(fT[1], tAt[jt][1], w_); fWt[jt][0] = frag<0>(w_); fWt[jt][1] = frag<1>(w_);
        f32x16 q_; unfrag<0>(q_, __builtin_bit_cast(bf16x8, *(const LAS u32x4*)(stash + 8 * (2 * jt) * PZ))); unfrag<1>(q_, __builtin_bit_cast(bf16x8, *(const LAS u32x4*)(stash + 8 * (2 * jt + 1) * PZ)));
        q_ = RK_MF(fWt[jt][0], fArb[0], q_); q_ = RK_MF(fWt[jt][1], fArb[1], q_); RK_ST(gQ, 2 * jt, frag<0>(q_)); RK_ST(gQ, 2 * jt + 1, frag<1>(q_)); }
    bf16x8 tBh[2][2], tKh[2][2], tV[2][2];
    { bf16x8 fId[2]; mk_id(fId, r, h);
#pragma unroll
    for (int jt = 0; jt < 2; ++jt) { bf16x8 fBh[2], fKh[2], fV[2], fdum[2]; float bdum = 0.f;
        r1_elem<1>(EC, jt, fBh, fKh, fV, fdum, bdum, pcd[jt]);
        { f32x16 t_ = f32x16{}; t_ = RK_MF(fBh[0], fId[0], t_); t_ = RK_MF(fBh[1], fId[1], t_); tBh[jt][0] = frag<0>(t_); tBh[jt][1] = frag<1>(t_); }
        { f32x16 t_ = f32x16{}; t_ = RK_MF(fKh[0], fId[0], t_); t_ = RK_MF(fKh[1], fId[1], t_); tKh[jt][0] = frag<0>(t_); tKh[jt][1] = frag<1>(t_); }
        { f32x16 t_ = f32x16{}; t_ = RK_MF(fV[0], fId[0], t_); t_ = RK_MF(fV[1], fId[1], t_); tV[jt][0] = frag<0>(t_); tV[jt][1] = frag<1>(t_); } } }
    bf16x8 fUt[2][2];
#pragma unroll
    for (int it = 0; it < 2; ++it) { f32x16 av = f32x16{}; av = RK_MF(fAak[0], tV[it][0], av); av = RK_MF(fAak[1], tV[it][1], av);
        const bf16x8 fav0 = frag<0>(av), fav1 = frag<1>(av); f32x16 u_ = f32x16{}; u_ = RK_MF(fT[0], fav0, u_); u_ = RK_MF(fT[1], fav1, u_); fUt[it][0] = frag<0>(u_); fUt[it][1] = frag<1>(u_); }
#pragma unroll
    for (int it = 0; it < 2; ++it) { f32x16 y_ = f32x16{}; y_ = RK_MF(fUt[it][0], fArb[0], y_); y_ = RK_MF(fUt[it][1], fArb[1], y_); y_ = RK_MF(tV[it][0], fArk[0], y_); y_ = RK_MF(tV[it][1], fArk[1], y_);
        RK_ST(gY, 2 * it, frag<0>(y_)); RK_ST(gY, 2 * it + 1, frag<1>(y_)); }
#pragma unroll
    for (int jt = 0; jt < 2; ++jt)
#pragma unroll
        for (int j2 = 0; j2 < 2; ++j2) { f32x16 g_ = f32x16{}; g_ = RK_MF(fWt[jt][0], tBh[j2][0], g_); g_ = RK_MF(fWt[jt][1], tBh[j2][1], g_);
            if (jt == j2) {
#pragma unroll
                for (int i = 0; i < 16; ++i) if (i == 4 * (r >> 3) + (r & 3) && h == ((r >> 2) & 1)) g_[i] += pcd[jt]; }
            RK_ST(gG, 2 * (jt * 2 + j2), frag<0>(g_)); RK_ST(gG, 2 * (jt * 2 + j2) + 1, frag<1>(g_)); }
#pragma unroll
    for (int j2 = 0; j2 < 2; ++j2)
#pragma unroll
        for (int it = 0; it < 2; ++it) { f32x16 h_ = f32x16{}; h_ = RK_MF(tBh[j2][0], fUt[it][0], h_); h_ = RK_MF(tBh[j2][1], fUt[it][1], h_); h_ = RK_MF(tKh[j2][0], tV[it][0], h_); h_ = RK_MF(tKh[j2][1], tV[it][1], h_);
            RK_ST(gH, 2 * (j2 * 2 + it), frag<0>(h_)); RK_ST(gH, 2 * (j2 * 2 + it) + 1, frag<1>(h_)); }
}

__device__ __forceinline__ void r2_task(const Args& args, Frame& F, int task) {
    const int bh = task >> 1, it = task & 1;
    f32x16 St[2]; St[0] = f32x16{}; St[1] = f32x16{};
    const unsigned char* gG0 = F.ws + WS_R0 + (size_t)bh * 128 * SZ_G + F.lane * 16; unsigned char* gH0 = F.ws + WS_R2 + (size_t)bh * 128 * SZ_H + F.lane * 16;
    bf16x8 fG[2][2][2], fH[2][2], nG[2][2][2], nH[2][2];
#define R2_LOAD(G_, H_, c_) do { _Pragma("unroll") for (int jt = 0; jt < 2; ++jt) _Pragma("unroll") for (int j2 = 0; j2 < 2; ++j2) _Pragma("unroll") for (int s = 0; s < 2; ++s) \
            G_[jt][j2][s] = __builtin_bit_cast(bf16x8, *(const u32x4*)(gG0 + (size_t)(c_) * SZ_G + (2 * (jt * 2 + j2) + s) * 1024)); \
        _Pragma("unroll") for (int j2 = 0; j2 < 2; ++j2) _Pragma("unroll") for (int s = 0; s < 2; ++s) H_[j2][s] = __builtin_bit_cast(bf16x8, *(const u32x4*)(gH0 + (size_t)(c_) * SZ_H + (2 * (j2 * 2 + it) + s) * 1024)); } while (0)
    R2_LOAD(fG, fH, 0);
    for (int c = 0; c < 128; ++c) {
        const int cn = c + 1 < 128 ? c + 1 : c;
        R2_LOAD(nG, nH, cn);
        const bf16x8 fS[2][2] = {{frag<0>(St[0]), frag<1>(St[0])}, {frag<0>(St[1]), frag<1>(St[1])}};
        f32x16 nw[2];
#pragma unroll
        for (int j2 = 0; j2 < 2; ++j2) { unfrag<0>(nw[j2], fH[j2][0]); unfrag<1>(nw[j2], fH[j2][1]);
#pragma unroll
            for (int jt = 0; jt < 2; ++jt) { nw[j2] = RK_MF(fG[jt][j2][0], fS[jt][0], nw[j2]); nw[j2] = RK_MF(fG[jt][j2][1], fS[jt][1], nw[j2]); } }
#pragma unroll
        for (int jt = 0; jt < 2; ++jt)
#pragma unroll
            for (int s = 0; s < 2; ++s) *(u32x4*)(gH0 + (size_t)c * SZ_H + (2 * (jt * 2 + it) + s) * 1024) = __builtin_bit_cast(u32x4, fS[jt][s]);
        St[0] = nw[0]; St[1] = nw[1];
#pragma unroll
        for (int jt = 0; jt < 2; ++jt)
#pragma unroll
            for (int j2 = 0; j2 < 2; ++j2)
#pragma unroll
                for (int s = 0; s < 2; ++s) fG[jt][j2][s] = nG[jt][j2][s];
#pragma unroll
        for (int j2 = 0; j2 < 2; ++j2)
#pragma unroll
            for (int s = 0; s < 2; ++s) fH[j2][s] = nH[j2][s];
    }
#undef R2_LOAD
}

constexpr int PV2 = 1296;
__device__ __forceinline__ void r3_unit(const Args& args, Frame& F, int b, int c) {
    LAS unsigned char* IMG = F.lds;
    const bf16_t* Z = (const bf16_t*)(F.ws + WS_Z);
    const int t0 = 32 * c; const size_t m0 = (size_t)b * SEQ + t0;
    const float* mu = AIN(7);
    int tid = F.tid; asm volatile("" : "+v"(tid));
    __syncthreads();
    for (int p = tid; p < 33 * 80; p += NTHR) { const int rr = p / 80, pc = p - rr * 80; u32x4 v = {0u, 0u, 0u, 0u};
        const int col = pc < 64 ? ZR_V + 8 * pc : ZR_GD + 8 * (pc - 64);
        if (rr > 0 || t0 > 0) v = *(const u32x4*)(Z + (m0 + rr - 1) * ZW + col);
        *(LAS u32x4*)(IMG + rr * PV2 + 16 * pc) = v; }
    __syncthreads();
    { const int t = tid >> 4, kp = tid & 15;
      const u32x4 cw = *(const LAS u32x4*)(IMG + (t + 1) * PV2 + 1024 + 16 * kp), pw = *(const LAS u32x4*)(IMG + t * PV2 + 1024 + 16 * kp);
      const f32x4 m0v = *(const f32x4*)(mu + 1664 + 8 * kp), m1v = *(const f32x4*)(mu + 1664 + 8 * kp + 4);
      const unsigned cwa[4] = {cw.x, cw.y, cw.z, cw.w}, pwa[4] = {pw.x, pw.y, pw.z, pw.w}; float x[8];
#pragma unroll
      for (int j = 0; j < 4; ++j) { const float c0 = bf_lo(cwa[j]), c1 = bf_hi(cwa[j]), p0 = bf_lo(pwa[j]), p1 = bf_hi(pwa[j]);
          const float mu0 = j < 2 ? m0v[2 * j] : m1v[2 * j - 4], mu1 = j < 2 ? m0v[2 * j + 1] : m1v[2 * j - 3];
          x[2 * j] = fast_sigmoid(c0 + mu0 * (p0 - c0)); x[2 * j + 1] = fast_sigmoid(c1 + mu1 * (p1 - c1)); }
      const u32x4 o = {cvtpk(x[0], x[1]), cvtpk(x[2], x[3]), cvtpk(x[4], x[5]), cvtpk(x[6], x[7])};
      __syncthreads();
      *(LAS u32x4*)(IMG + (t + 1) * PV2 + 1024 + 16 * kp) = o;
      __syncthreads(); }
    const int hd = F.wave; int r = tid & 31, h = (tid >> 5) & 1;
    const LAS unsigned char* rowc = IMG + (r + 1) * PV2; const LAS unsigned char* rowp = IMG + r * PV2;
    const size_t uid = ((size_t)(b * 8 + hd) * 128 + c);
    const unsigned char* gS = F.ws + WS_R2 + uid * SZ_H; const unsigned char* gQ = F.ws + WS_H0 + uid * SZ_Q; const unsigned char* gY = F.ws + WS_H1 + uid * SZ_Y;
#define RK_LD(base, piece) __builtin_bit_cast(bf16x8, *(const u32x4*)((base) + (piece) * 1024 + (tid & 63) * 16))
    f32x16 gl[2]; gl[0] = f32x16{}; gl[1] = f32x16{};
    { const bf16_t* GUt = (const bf16_t*)(F.ws + WS_GUT) + (size_t)hd * 64 * 128;
#pragma unroll
      for (int ks = 0; ks < 8; ++ks) { const int k0 = 16 * ks + 8 * h; const bf16x8 bg = *(const LAS bf16x8*)(rowc + 1024 + k0 * 2);
#pragma unroll
          for (int it = 0; it < 2; ++it) { const bf16x8 fg = *(const bf16x8*)(GUt + (size_t)(32 * it + r) * 128 + k0); gl[it] = RK_MF(fg, bg, gl[it]); } } }
    f32x16 Y[2];
    { const bf16x8 fQ[2][2] = {{RK_LD(gQ, 0), RK_LD(gQ, 1)}, {RK_LD(gQ, 2), RK_LD(gQ, 3)}};
#pragma unroll
      for (int it = 0; it < 2; ++it) { unfrag<0>(Y[it], RK_LD(gY, 2 * it)); unfrag<1>(Y[it], RK_LD(gY, 2 * it + 1));
#pragma unroll
          for (int jt = 0; jt < 2; ++jt) { if (PROBE_NO_STATE) continue; Y[it] = RK_MF(RK_LD(gS, 2 * (jt * 2 + it)), fQ[jt][0], Y[it]); Y[it] = RK_MF(RK_LD(gS, 2 * (jt * 2 + it) + 1), fQ[jt][1], Y[it]); } } }
    float s1 = 0.f;
#pragma unroll
    for (int it = 0; it < 2; ++it)
#pragma unroll
        for (int i = 0; i < 16; ++i) s1 += Y[it][i];
    s1 += __shfl_xor(s1, 32); const float mean = s1 * (1.0f / 64.0f); float s2 = 0.f;
#pragma unroll
    for (int it = 0; it < 2; ++it)
#pragma unroll
        for (int i = 0; i < 16; ++i) { const float d = Y[it][i] - mean; s2 += d * d; }
    s2 += __shfl_xor(s2, 32); const float rstd = 1.0f / sqrtf(s2 * (1.0f / 64.0f) + GN_EPS);
    const float bn = ((const float*)(F.ws + WS_TOPW))[(m0 + r) * 8 + hd];
    LAS unsigned char* stg = F.lds + 49152 + F.wave * 4608;
#pragma unroll
    for (int it = 0; it < 2; ++it)
#pragma unroll
        for (int g = 0; g < 4; ++g) { const int cl = 32 * it + 8 * g + 4 * h, cj = hd * 64 + cl;
            const u32x2 a = *(const LAS u32x2*)(rowc + cj * 2), p = *(const LAS u32x2*)(rowp + cj * 2);
            const float vc[4] = {bf_lo(a.x), bf_hi(a.x), bf_lo(a.y), bf_hi(a.y)}, vq[4] = {bf_lo(p.x), bf_hi(p.x), bf_lo(p.y), bf_hi(p.y)};
            const f32x4 muv = *(const f32x4*)(mu + 1024 + cj), lg = *(const f32x4*)(AIN(16) + cj), lb = *(const f32x4*)(AIN(17) + cj);
            float o[4];
#pragma unroll
            for (int q = 0; q < 4; ++q) { const int i = 4 * g + q; const float v_ = vc[q] + muv[q] * (vq[q] - vc[q]);
                o[q] = ((Y[it][i] - mean) * rstd * lg[q] + lb[q] + bn * v_) * gl[it][i]; }
            *(LAS u32x2*)(stg + r * 144 + cl * 2) = (u32x2){cvtpk(o[0], o[1]), cvtpk(o[2], o[3])}; }
    asm volatile("s_waitcnt lgkmcnt(0)" ::: "memory");
    bf16_t* OUT = (bf16_t*)(F.ws + WS_R0) + m0 * 512 + hd * 64;
#pragma unroll
    for (int i = 0; i < 4; ++i) { const int row = i * 8 + ((tid & 63) >> 3), chn = tid & 7; const u32x4 v = *(const LAS u32x4*)(stg + row * 144 + chn * 16); *(u32x4*)(OUT + (size_t)row * 512 + chn * 8) = v; }
#undef RK_LD
#undef RK_ST
}
}
__device__ __forceinline__ void route_phase(const Args& args, Frame& F) {
    LAS unsigned* lcnt = (LAS unsigned*)(F.lds);
    if (F.tid < 128) lcnt[F.tid] = 0u;
    __syncthreads();
    const float* LG = (const float*)(F.ws + WS_LOGIT); int* TE = (int*)(F.ws + WS_TOPE); float* TW = (float*)(F.ws + WS_TOPW);
    const int lane = F.lane; const float bias = AIN(23)[lane];
    for (int tok = F.gw; tok < M; tok += F.NGW) {
        const float lg = LG[(size_t)tok * 64 + lane];
        const float s = 1.0f / (1.0f + expf(-lg));
        const float c = s + bias;
        const unsigned long long kc = ((unsigned long long)ord_key(c) << 6) | (unsigned)(63 - lane);
        int rk = 0;
#pragma unroll 1
        for (int d = 1; d < 8; ++d) { const unsigned long long o = __shfl_xor(kc, d); rk += (o > kc) ? 1 : 0; }
        float gs = rk < 2 ? c : 0.f;
        gs += __shfl_xor(gs, 1); gs += __shfl_xor(gs, 2); gs += __shfl_xor(gs, 4);
        const int grp = lane >> 3;
        const unsigned long long kg = ((unsigned long long)ord_key(gs) << 6) | (unsigned)(63 - grp);
        int grk = 0;
#pragma unroll 1
        for (int d = 1; d < 8; ++d) { const unsigned long long o = __shfl_xor(kg, 8 * d); grk += (o > kg) ? 1 : 0; }
        const unsigned long long km = grk < 4 ? kc : (unsigned long long)(63 - lane);
        int erk = 0;
#pragma unroll 1
        for (int d = 1; d < 64; ++d) { const unsigned long long o = __shfl_xor(km, d); erk += (o > km) ? 1 : 0; }
        const bool sel = erk < 8;
        const float ssum = wave_sum(sel ? s : 0.f);
        if (sel) { TE[(size_t)tok * 8 + erk] = lane; TW[(size_t)tok * 8 + erk] = s / ssum * 2.5f; atomicAdd((unsigned*)&lcnt[(tok >= M / 2 ? 64 : 0) + lane], 1u); }
    }
    __syncthreads();
    if (F.tid < 128 && lcnt[F.tid]) atomicAdd(F.ctl + CW_CNT + F.tid, lcnt[F.tid]);
    __syncthreads();
}

struct MoeTab { int ntiles0, ntiles; };
__device__ __forceinline__ MoeTab build_tiles(const Args& args, Frame& F) {
    LAS unsigned* tab = (LAS unsigned*)(F.lds + LDS_TILETAB);
    LAS unsigned* offs = tab + 2432; LAS unsigned* tpre = tab + 2560;
    if (F.tid == 0) { unsigned o = 0, tp = 0;
        for (int l = 0; l < 128; ++l) { const unsigned c = __hip_atomic_load(F.ctl + CW_CNT + l, RLX_AGENT); offs[l] = o; tpre[l] = tp; o += c; tp += (c + 255u) >> 8; }
        tpre[128] = tp; }
    __syncthreads();
    if (F.tid < 128) { const int l = F.tid; const unsigned c = __hip_atomic_load(F.ctl + CW_CNT + l, RLX_AGENT); const unsigned o = offs[l], t0 = tpre[l], nt = (c + 255u) >> 8;
        for (unsigned i = 0; i < nt; ++i) { const unsigned rows = (c - 256u * i) < 256u ? (c - 256u * i) : 256u; tab[2 * (t0 + i)] = (o + 256u * i) | ((unsigned)(l & 63) << 20); tab[2 * (t0 + i) + 1] = rows; } }
    __syncthreads();
    MoeTab r; r.ntiles0 = (int)tpre[64]; r.ntiles = (int)tpre[128]; return r;
}
__device__ __forceinline__ void scatter_phase(const Args& args, Frame& F) {
    LAS unsigned* tab = (LAS unsigned*)(F.lds + LDS_TILETAB); LAS unsigned* offs = tab + 2432;
    LAS unsigned* lcnt = (LAS unsigned*)(F.lds); LAS unsigned* lbase = lcnt + 128;
    const int* TE = (const int*)(F.ws + WS_TOPE); const float* TW = (const float*)(F.ws + WS_TOPW);
    int* ST = (int*)(F.ws + WS_STOK); float* SW = (float*)(F.ws + WS_SW);
    for (int blk = blockIdx.x; blk < M / 128; blk += F.G) {
        if (F.tid < 128) lcnt[F.tid] = 0u;
        __syncthreads();
        const int tok0 = blk * 128, hf = tok0 >= M / 2 ? 64 : 0;
        int lst[2]; unsigned rnk[2];
#pragma unroll
        for (int i = 0; i < 2; ++i) { const int p = F.tid + 512 * i; lst[i] = hf + TE[(size_t)tok0 * 8 + p]; rnk[i] = atomicAdd((unsigned*)&lcnt[lst[i]], 1u); }
        __syncthreads();
        if (F.tid < 128) lbase[F.tid] = lcnt[F.tid] ? atomicAdd(F.ctl + CW_CUR + F.tid, lcnt[F.tid]) : 0u;
        __syncthreads();
#pragma unroll
        for (int i = 0; i < 2; ++i) { const int p = F.tid + 512 * i; const unsigned pos = offs[lst[i]] + lbase[lst[i]] + rnk[i];
            ST[pos] = tok0 * 8 + p; SW[pos] = TW[(size_t)tok0 * 8 + p]; }
        __syncthreads();
    }
}

__device__ __forceinline__ void final_rows(const Args& args, Frame& F, int row_lo, int row_hi, int tokbase) {
    const unsigned char* SL = (const unsigned char*)(F.ws + WS_SLOT);
    const int cA = 256 * (F.lane >> 4) + 32 * ((F.lane >> 2) & 3) + 8 * (F.lane & 3), cB = cA + 128;
    for (int blk = F.gw; blk < (row_hi - row_lo) / 16; blk += F.NGW) {
        const int r0 = row_lo + blk * 16, b = r0 / SEQ;
        const float* g2 = (const float*)(F.ws + WS_MOD) + b * 6144 + 5120; const float* fgp = AIN(30);
        f32x4 gv[4], fg[4];
#pragma unroll
        for (int j = 0; j < 4; ++j) { const int c = (j < 2 ? cA : cB) + 4 * (j & 1); gv[j] = *(const f32x4*)(g2 + c) * (1.0f / SLOT_SCALE); fg[j] = *(const f32x4*)(fgp + c); }
        for (int r = 0; r < 16; ++r) { const size_t m = (size_t)(r0 + r);
            f32x4 acc[4];
#pragma unroll
            for (int j = 0; j < 4; ++j) acc[j] = (f32x4){0.f, 0.f, 0.f, 0.f};
            const unsigned char* sp = SL + (m - tokbase) * NSLOT * D + 16 * F.lane;
            u32x4 w[NSLOT];
#pragma unroll
            for (int k = 0; k < NSLOT; ++k) w[k] = *(const u32x4*)(sp + (size_t)k * D);
#pragma unroll
            for (int k = 0; k < NSLOT; ++k) { const unsigned ww[4] = {w[k].x, w[k].y, w[k].z, w[k].w};
#pragma unroll
                for (int j = 0; j < 4; ++j) { const f32x2 a = __builtin_amdgcn_cvt_pk_f32_fp8((int)ww[j], false), c = __builtin_amdgcn_cvt_pk_f32_fp8((int)ww[j], true); acc[j] += (f32x4){a.x, a.y, c.x, c.y}; } }
            float* xr = F.out + m * D; f32x4 v[4]; float s = 0.f;
#pragma unroll
            for (int j = 0; j < 4; ++j) { const int c = (j < 2 ? cA : cB) + 4 * (j & 1); v[j] = *(const f32x4*)(xr + c) + gv[j] * acc[j]; s += (v[j].x * v[j].x + v[j].y * v[j].y) + (v[j].z * v[j].z + v[j].w * v[j].w); }
            const float rstd = 1.0f / sqrtf(wave_sum(s) * (1.0f / D) + RMS_EPS);
#pragma unroll
            for (int j = 0; j < 4; ++j) { const int c = (j < 2 ? cA : cB) + 4 * (j & 1); *(f32x4*)(xr + c) = v[j] * rstd * fg[j]; }
        }
    }
}
constexpr int N_PHASES = 15;
#ifndef PROBE_ATT_SCALE
#define PROBE_ATT_SCALE 1.0f
#endif
#ifndef PROBE_RW_SCALE
#define PROBE_RW_SCALE 1.0f
#endif

__global__ void __launch_bounds__(NTHR, 2) fwd_kernel(Args args) {
    extern __shared__ __attribute__((aligned(16))) unsigned char lds_raw[];
    Frame F;
    F.lds = (LAS unsigned char*)lds_raw;
    F.MISC = (volatile LAS unsigned*)(F.lds + MISC_OFF);
    F.tid = threadIdx.x; F.lane = F.tid & 63; F.wave = __builtin_amdgcn_readfirstlane(F.tid >> 6);
    F.G = gridDim.x; { const int bx = blockIdx.x; F.vcu = (F.G % 8 == 0) ? (bx % 8) * (F.G / 8) + bx / 8 : bx; }
    F.gw = blockIdx.x * NWAVES + F.wave; F.NGW = F.G * NWAVES;
    F.ws = args.ws; F.out = args.out; F.ctl = (unsigned*)(args.ws + WS_CTL);
    for (int u = F.tid; u < (LDS_BYTES - LDSCTL_OFF) / 4; u += NTHR) ((LAS unsigned*)(F.lds + LDSCTL_OFF))[u] = 0u;
    __syncthreads();
    if (F.tid == 0) {
#pragma unroll
        for (int i = 0; i < 31; ++i) *(LAS unsigned long long*)(F.lds + LDS_PTAB + 8 * i) = (unsigned long long)args.in[i];
        *(LAS unsigned long long*)(F.lds + LDS_PTAB + 8 * 31) = (unsigned long long)args.out; *(LAS unsigned long long*)(F.lds + LDS_PTAB + 8 * 32) = (unsigned long long)args.ws; }
    __syncthreads();
    XcdBarrier bar = xcd_barrier_post(F.ctl + CW_BAR + args.li * XCD_BAR_WORDS, F.MISC + 8);
    const int lo = args.ph_lo, hi = args.ph_hi;
#ifndef PHASE_MASK
#define PHASE_MASK 0xFFFFFFFFu
#endif
#define IN(k) ((((PHASE_MASK) >> (k)) & 1u) && lo <= (k) && (k) < hi)
#define PB() do { F.ws = (unsigned char*)ain_ptr(F.lds, 32); F.out = (float*)ain_ptr(F.lds, 31); F.ctl = (unsigned*)(F.ws + WS_CTL); \
        F.lane = (int)__builtin_amdgcn_mbcnt_hi(~0u, __builtin_amdgcn_mbcnt_lo(~0u, 0u)); F.tid = F.wave * 64 + F.lane; } while (0)
#define ZB ((bf16_t*)(F.ws + WS_Z))
#define GATES ((bf16_t*)F.out)
#define MOD ((const float*)(F.ws + WS_MOD))
#define SEAM(k) do { if (IN(k) && IN((k) + 1)) xcd_barrier(bar); } while (0)

    if (IN(0)) { PB(); p0_prologue(args, F); } SEAM(0);
    if (IN(1)) { PB(); norm_mod_rows(args, F, AIN(0), AIN(4), 0, 1024, nullptr, F.ws + WS_H0); } SEAM(1);
    if (IN(2)) { PB(); pg8::StaticOrder S; S.init(M, NIN, F.G, (int)blockIdx.x); pg8::DenseSrcT<1> G{F.ws + WS_H0, F.ws + WS_WIN, 1024};
        EpiInProj E{ZB, GATES}; pg8::gemm_phase<EpiInProj, pg8::StaticOrder, pg8::DenseSrcT<1>>(F.lds, 1024, S, G, E); } SEAM(2);
    if (IN(3)) { PB(); rk::load_params(args, F); for (int u = blockIdx.x; u < 1024; u += F.G) rk::r1_unit(args, F, u >> 7, u & 127); __syncthreads(); } SEAM(3);
    if (IN(4)) { PB();
        if (blockIdx.x < 16) rk::r2_task(args, F, blockIdx.x * 8 + F.wave);
        for (;;) {
            __syncthreads();
            if (F.tid == 0) F.MISC[12] = atomicAdd(F.ctl + CW_Q, 1u);
            __syncthreads();
            const int u = (int)F.MISC[12];
            if (u >= 2048) break;
            indexer_unit(args, F, u & 7, (255 - (u >> 3)) * 16);
        } } SEAM(4);
    if (IN(5)) { PB(); for (int u = blockIdx.x; u < 1024; u += F.G) rk::r3_unit(args, F, u >> 7, u & 127); __syncthreads();
        for (int i = 0; i < 4; ++i) for (int uu = F.vcu; uu < 256; uu += F.G) { const int bh = uu >> 2, s = uu & 3; const int qb = (i == 0) ? s : (i == 1) ? 7 - s : (i == 2) ? 8 + s : 15 - s;
            att::attn_unit(args, F, bh >> 3, bh & 7, qb); } __syncthreads(); } SEAM(5);
    if (IN(6)) { PB(); pg8::StaticOrder S; S.init(M, D, F.G, (int)blockIdx.x);
        { pg8::DenseSrc G{F.ws + WS_R1, F.ws + WS_WA, 512}; EpiMerge<0> E{(bf16_t*)(F.ws + WS_R2), F.ws + WS_H0, GATES, PROBE_ATT_SCALE}; pg8::gemm_phase<EpiMerge<0>, pg8::StaticOrder, pg8::DenseSrc>(F.lds, 512, S, G, E); }
        { pg8::DenseSrc G{F.ws + WS_R0, F.ws + WS_WR, 512}; EpiMerge<1> E{(bf16_t*)(F.ws + WS_R2), F.ws + WS_H0, GATES, PROBE_RW_SCALE}; pg8::gemm_phase<EpiMerge<1>, pg8::StaticOrder, pg8::DenseSrc>(F.lds, 512, S, G, E); } } SEAM(6);
    if (IN(7)) { PB(); pg8::StaticOrder S; S.init(M, D, F.G, (int)blockIdx.x); pg8::DenseSrcT<1> G{F.ws + WS_H0, F.ws + WS_WO, 1024};
        EpiOutProj E{AIN(0), F.out, MOD}; pg8::gemm_phase<EpiOutProj, pg8::StaticOrder, pg8::DenseSrcT<1>>(F.lds, 1024, S, G, E); } SEAM(7);
    if (IN(8)) { PB(); norm_mod_rows(args, F, F.out, AIN(21), 3072, 4096, (bf16_t*)(F.ws + WS_H2), nullptr); convert_experts(args, F); } SEAM(8);
    if (IN(9)) { PB(); pg8::StaticOrder S; S.init(M, 256, F.G, (int)blockIdx.x); pg8::DenseSrc G{(const bf16_t*)(F.ws + WS_H2), (const bf16_t*)(F.ws + WS_WRT), 1024};
        EpiRouter E{(float*)(F.ws + WS_LOGIT)}; pg8::gemm_phase<EpiRouter, pg8::StaticOrder, pg8::DenseSrc>(F.lds, 1024, S, G, E); } SEAM(9);
    if (IN(10)) { PB(); route_phase(args, F); } SEAM(10);
    MoeTab mt{0, 0};
    if (lo <= 13 && hi > 13) { PB(); mt = build_tiles(args, F); scatter_phase(args, F); } else if (hi > 13) { PB(); mt = build_tiles(args, F); }
    SEAM(11);
    const LAS unsigned* tab = (const LAS unsigned*)(F.lds + LDS_TILETAB);
    if (IN(12)) { PB(); MoeSched1 S{tab, mt.ntiles, F.G, (int)blockIdx.x}; MoeSrc1 G{F.ws};
        EpiMoe1 E{F.ws}; pg8::gemm_phase<EpiMoe1, MoeSched1, MoeSrc1>(F.lds, 1024, S, G, E); } SEAM(12);
    if (IN(13)) { PB(); MoeSched2 S{tab, 0, mt.ntiles, 512, F.G, (int)blockIdx.x}; MoeSrc2 G{F.ws}; EpiMoe2 E{F.ws, F.out, 0};
        pg8::gemm_phase<EpiMoe2, MoeSched2, MoeSrc2>(F.lds, 256, S, G, E); } SEAM(13);
    if (IN(14)) { PB(); final_rows(args, F, 0, M, 0); }
#undef IN
#undef SEAM
#undef PB
}

extern "C" void kernel_launch(void* const* d_in, const int* in_sizes, int n_in, void* d_out, int out_size, void* d_ws, size_t ws_size, hipStream_t stream) {
    static int grid = 0;
    if (grid == 0) {
        if (n_in != 31 || out_size != M * D || ws_size < WS_END) { fprintf(stderr, "kernel_launch: unexpected problem (n_in %d, out %d, ws %zu)\n", n_in, out_size, ws_size); grid = -1; return; }
        int dev = 0, cus = 0, per_cu = 0;
        if (hipGetDevice(&dev) != hipSuccess || hipDeviceGetAttribute(&cus, hipDeviceAttributeMultiprocessorCount, dev) != hipSuccess) { grid = -1; return; }
        if (hipFuncSetAttribute((const void*)fwd_kernel, hipFuncAttributeMaxDynamicSharedMemorySize, LDS_BYTES) != hipSuccess) { fprintf(stderr, "kernel_launch: hipFuncSetAttribute failed\n"); grid = -1; return; }
        if (hipOccupancyMaxActiveBlocksPerMultiprocessor(&per_cu, (const void*)fwd_kernel, NTHR, LDS_BYTES) != hipSuccess || per_cu < 1) fprintf(stderr, "kernel_launch: occupancy query reports %d\n", per_cu);
        (void)hipGetLastError();
        grid = cus;
        if (grid != 256) fprintf(stderr, "kernel_launch: %d CUs (built for 256)\n", grid);
    }
    if (grid < 0) return;
    (void)in_sizes;
    if (hipMemsetAsync((char*)d_ws + WS_CTL, 0, CTL_ZERO_BYTES, stream) != hipSuccess) return;
    Args a{};
    for (int i = 0; i < 31; ++i) a.in[i] = (const float*)d_in[i];
    a.out = (float*)d_out; a.ws = (unsigned char*)d_ws;
#ifndef PROBE_REPEAT
#define PROBE_REPEAT -1
#endif
    int li = 0;
    auto go = [&](int lo_, int hi_) { a.ph_lo = lo_; a.ph_hi = hi_; a.li = li++; hipLaunchKernelGGL(fwd_kernel, dim3(grid), dim3(NTHR), LDS_BYTES, stream, a); };
    if (PROBE_REPEAT < 0) go(0, N_PHASES);
    else { go(0, PROBE_REPEAT + 1); go(PROBE_REPEAT, PROBE_REPEAT + 1); if (PROBE_REPEAT + 1 < N_PHASES) go(PROBE_REPEAT + 1, N_PHASES); }
}
```

```cpp
#include <hip/hip_runtime.h>
#include <cstdio>
#include <cstdint>
#include <cmath>

#define GAS __attribute__((address_space(1)))
#define LAS __attribute__((address_space(3)))
typedef unsigned short bf16_t;
typedef short bf16x8 __attribute__((ext_vector_type(8)));
typedef float f32x4 __attribute__((ext_vector_type(4)));
typedef float f32x2 __attribute__((ext_vector_type(2)));
typedef float f32x16 __attribute__((ext_vector_type(16)));
typedef unsigned u32x4 __attribute__((ext_vector_type(4)));
typedef unsigned u32x2 __attribute__((ext_vector_type(2)));
typedef GAS unsigned gu32;

__device__ __forceinline__ unsigned cvt_pk_bf16(float lo, float hi) { unsigned r; asm volatile("v_cvt_pk_bf16_f32 %0, %1, %2" : "=v"(r) : "v"(lo), "v"(hi)); return r; }
__device__ __forceinline__ float bf_lo(unsigned w) { return __uint_as_float(w << 16); }
__device__ __forceinline__ float bf_hi(unsigned w) { return __uint_as_float(w & 0xffff0000u); }
__device__ __forceinline__ float bf2f(bf16_t b) { return __uint_as_float(((unsigned)b) << 16); }
__device__ __forceinline__ unsigned f2bf(float f) { unsigned u = __float_as_uint(f); return (u + 0x7fffu + ((u >> 16) & 1u)) >> 16; }
__device__ __forceinline__ unsigned pk2(float lo, float hi) { return f2bf(lo) | (f2bf(hi) << 16); }
__device__ __forceinline__ float fast_sigmoid(float x) { return __builtin_amdgcn_rcpf(1.0f + __builtin_amdgcn_exp2f(-1.4426950408889634f * x)); }
__device__ __forceinline__ float wave_sum(float v) {
#pragma unroll
    for (int o = 1; o < 64; o <<= 1) v += __shfl_xor(v, o);
    return v;
}

namespace pg8 {
constexpr int BM = 256, BK = 64, HALF = 128, HTB = HALF * BK * 2, STAGE_BYTES = 8 * HTB, NXCD = 8, WGM = 8;
__host__ __device__ __forceinline__ int lds_byte(int r, int c) { const int st = (r >> 4) * 2 + (c >> 5), rr = r & 15, cc = c & 31, ob = rr * 64 + cc * 2; return st * 1024 + (ob ^ (((ob >> 9) & 1) << 5)); }
__host__ __device__ __forceinline__ void stage_rc(int b, int& R, int& C) { const int st = b / 1024, sb = b % 1024, swz = sb ^ (((sb >> 9) & 1) << 5); R = (st >> 1) * 16 + swz / 64; C = (st & 1) * 32 + (swz % 64) / 2; }
__host__ __device__ __forceinline__ int perm32(int rho) { const int n = rho >> 4, i = rho & 15; return 8 * (i >> 2) + 4 * n + (i & 3); }

struct Unit { int pm, pn; int aux0, aux1; };

struct StaticOrder {
    int nM, nN, nwg, G, c;
    __host__ __device__ void init(int M, int N, int G_, int c_) { nM = M / BM; nN = N / BM; nwg = nM * nN; G = G_; c = c_; }
    __host__ __device__ bool next(int i, Unit& u) const {
        const long L = (long)i * G + c; if (L >= nwg) return false;
        int wgid = (int)L; { const int q = nwg / NXCD, r = nwg % NXCD, xcd = wgid % NXCD, off = wgid / NXCD; wgid = (xcd < r ? xcd * (q + 1) : r * (q + 1) + (xcd - r) * q) + off; }
        const int nig = WGM * nN, gid = wgid / nig, fm = gid * WGM, gsz = (nM - fm) < WGM ? (nM - fm) : WGM;
        u.pm = fm + ((wgid % nig) % gsz); u.pn = (wgid % nig) / gsz; u.aux0 = 0; u.aux1 = 0; return true;
    }
};

template <int ESZ_> struct DenseSrcT {
    static constexpr int ESZ = ESZ_; static constexpr bool GATHER = false;
    const void* A; const void* Bt; int K;
    __device__ __forceinline__ const char* b_base(const Unit& u) const { return (const char*)Bt + (size_t)u.pn * 256 * K * ESZ; }
    __device__ __forceinline__ const char* a_base(const Unit& u) const { return (const char*)A + (size_t)u.pm * 256 * K * ESZ; }
    __device__ __forceinline__ unsigned a_off(const Unit&, int R, int C) const { return (unsigned)(R * K * ESZ) + (unsigned)C * 2u; }
};
typedef DenseSrcT<2> DenseSrc;
typedef int v8i32 __attribute__((ext_vector_type(8)));

template <class Epi, class Sched, class Src, bool ALIGN_EPI = true>
__device__ __forceinline__ void gemm_phase(LAS unsigned char* lds, const int K, const Sched& S, const Src& G, const Epi& E) {
    const int tid = threadIdx.x, wid = __builtin_amdgcn_readfirstlane(tid >> 6), lane = tid & 63, wr = wid >> 2, wc = wid & 3, fr = lane & 15, fq = lane >> 4;
    constexpr int ESZ = Src::ESZ; const int Kb = K * ESZ;
    const int nt = Kb / (BK * 2);
    unsigned voffB0;
    { int R, C; stage_rc(tid * 16, R, C); const int Rb = Epi::PERM ? ((R & ~31) + perm32(R & 31)) : R; voffB0 = (unsigned)(Rb * Kb) + (unsigned)C * 2u; }
#define PG8_AOFF(u, h, i) ([&]() { int R_, C_; stage_rc(tid * 16 + (i) * 8192, R_, C_); return G.a_off((u), R_ + (h) * HALF, C_); }())
    const size_t kstep = (size_t)(BK * 2);
    const size_t hstepB = (size_t)HALF * Kb;
    const unsigned ldsw = (unsigned)wid * 1024u;
    const int aoff = lds_byte(wr * 64 + fr, fq * 8), boff = lds_byte(wc * 32 + fr, fq * 8);
#define PG8_SA(b, h) (((b) * 2 + (h)) * HTB)
#define PG8_SB(b, h) ((4 + (b) * 2 + (h)) * HTB)
#define PG8_STAGEB(bufoff, gbase) do { _Pragma("unroll") for (int _i = 0; _i < 2; ++_i) { unsigned o_ = voffB0; asm volatile("" : "+v"(o_)); \
        __builtin_amdgcn_global_load_lds((const unsigned*)((const char*)(gbase) + (size_t)_i * 64 * Kb + o_), (LAS unsigned*)(lds + (bufoff) + ldsw + _i * 8192), 16, 0, 0); } } while (0)
#define PG8_STAGEA(bufoff, gbase, vo, h) do { _Pragma("unroll") for (int _i = 0; _i < 2; ++_i) { unsigned o_ = Src::GATHER ? (vo)[h][_i] : (vo)[0][0]; asm volatile("" : "+v"(o_)); \
        __builtin_amdgcn_global_load_lds((const unsigned*)((const char*)(gbase) + (Src::GATHER ? (size_t)0 : (size_t)((h) * 128 + _i * 64) * Kb) + o_), (LAS unsigned*)(lds + (bufoff) + ldsw + _i * 8192), 16, 0, 0); } } while (0)
#define PG8_STAGEA2(bufoff, gbase, h) do { _Pragma("unroll") for (int _i = 0; _i < 2; ++_i) { unsigned o_ = Src::GATHER ? (last ? vn[h][_i] : vc[h][_i]) : vc[0][0]; asm volatile("" : "+v"(o_)); \
        __builtin_amdgcn_global_load_lds((const unsigned*)((const char*)(gbase) + (Src::GATHER ? (size_t)0 : (size_t)((h) * 128 + _i * 64) * Kb) + o_), (LAS unsigned*)(lds + (bufoff) + ldsw + _i * 8192), 16, 0, 0); } } while (0)
#define PG8_LDA(dst, b, h) do { _Pragma("unroll") for (int m = 0; m < 4; ++m) { const u32x4 lo_ = *(const LAS u32x4*)(lds + PG8_SA(b, h) + aoff + m * 2048), hi_ = *(const LAS u32x4*)(lds + PG8_SA(b, h) + aoff + m * 2048 + 1024); \
        dst[m] = __builtin_shufflevector(lo_, hi_, 0, 1, 2, 3, 4, 5, 6, 7); } } while (0)
#define PG8_LDB(dst, b, h) do { _Pragma("unroll") for (int n = 0; n < 2; ++n) { const u32x4 lo_ = *(const LAS u32x4*)(lds + PG8_SB(b, h) + boff + n * 2048), hi_ = *(const LAS u32x4*)(lds + PG8_SB(b, h) + boff + n * 2048 + 1024); \
        dst[n] = __builtin_shufflevector(lo_, hi_, 0, 1, 2, 3, 4, 5, 6, 7); } } while (0)
#define PG8_LO(x) __builtin_bit_cast(bf16x8, __builtin_shufflevector((x), (x), 0, 1, 2, 3))
#define PG8_HI(x) __builtin_bit_cast(bf16x8, __builtin_shufflevector((x), (x), 4, 5, 6, 7))
#define PG8_MMA(ai, bj, At, Bt) do { __builtin_amdgcn_s_setprio(1); _Pragma("unroll") for (int m = 0; m < 4; ++m) _Pragma("unroll") for (int n = 0; n < 2; ++n) { \
        if constexpr (ESZ == 1) acc[ai][bj][m][n] = __builtin_amdgcn_mfma_scale_f32_16x16x128_f8f6f4(__builtin_bit_cast(v8i32, Bt[n]), __builtin_bit_cast(v8i32, At[m]), acc[ai][bj][m][n], 0, 0, 0, 0, 0, 0); \
        else { acc[ai][bj][m][n] = __builtin_amdgcn_mfma_f32_16x16x32_bf16(PG8_LO(Bt[n]), PG8_LO(At[m]), acc[ai][bj][m][n], 0, 0, 0); \
               acc[ai][bj][m][n] = __builtin_amdgcn_mfma_f32_16x16x32_bf16(PG8_HI(Bt[n]), PG8_HI(At[m]), acc[ai][bj][m][n], 0, 0, 0); } } \
        __builtin_amdgcn_s_setprio(0); } while (0)
#define PG8_WAIT_V(n) asm volatile("s_waitcnt vmcnt(" #n ")" ::: "memory")
#define PG8_WAIT_L(n) asm volatile("s_waitcnt lgkmcnt(" #n ")" ::: "memory")
#define PG8_BAR __builtin_amdgcn_s_barrier()
#define PG8_SCHED __builtin_amdgcn_sched_barrier(0)
    Unit cur, nxt; int ui = 0;
    if (!S.next(0, cur)) return;
    f32x4 acc[2][2][4][2];
#pragma unroll
    for (int a = 0; a < 2; ++a)
#pragma unroll
        for (int b = 0; b < 2; ++b)
#pragma unroll
            for (int m = 0; m < 4; ++m)
#pragma unroll
                for (int n = 0; n < 2; ++n) acc[a][b][m][n] = (f32x4){0.f, 0.f, 0.f, 0.f};
    typedef unsigned u32x8 __attribute__((ext_vector_type(8)));
    u32x8 At[4], B0[2], B1[2];
    unsigned vc[2][2], vn[2][2];
#pragma unroll
    for (int h = 0; h < 2; ++h)
#pragma unroll
        for (int i = 0; i < 2; ++i) vc[h][i] = PG8_AOFF(cur, h, i);
    const char* cA = G.a_base(cur); const char* cB = G.b_base(cur);
    PG8_STAGEB(PG8_SB(0, 0), cB); PG8_STAGEB(PG8_SB(0, 1), cB + hstepB); PG8_STAGEA(PG8_SA(0, 0), cA, vc, 0); PG8_STAGEA(PG8_SA(0, 1), cA, vc, 1);
    if (wr == 1) PG8_BAR;
    PG8_WAIT_V(2); PG8_BAR;
    PG8_STAGEB(PG8_SB(1, 0), cB + kstep); PG8_STAGEA(PG8_SA(1, 0), cA + kstep, vc, 0); PG8_STAGEB(PG8_SB(1, 1), cB + hstepB + kstep);
    PG8_WAIT_V(6); PG8_BAR;
    for (;;) {
        const bool has_next = S.next(ui + 1, nxt);
        const char* nA = has_next ? G.a_base(nxt) : cA; const char* nB = has_next ? G.b_base(nxt) : cB;
        if constexpr (Src::GATHER) {
#pragma unroll
        for (int h = 0; h < 2; ++h)
#pragma unroll
            for (int i = 0; i < 2; ++i) vn[h][i] = has_next ? PG8_AOFF(nxt, h, i) : vc[h][i]; }
#pragma clang loop unroll(disable)
        for (int t = 0; t < nt; t += 2) {
            const bool last = (t == nt - 2);
            const char* a1 = cA + (size_t)(t + 1) * kstep;
            const char* a2 = last ? nA : cA + (size_t)(t + 2) * kstep; const char* b2 = last ? nB : cB + (size_t)(t + 2) * kstep;
            const char* a3 = a2 + kstep; const char* b3 = b2 + kstep;
            PG8_LDB(B0, 0, 0); PG8_LDB(B1, 0, 1); PG8_SCHED; PG8_LDA(At, 0, 0); PG8_STAGEA(PG8_SA(1, 1), a1, vc, 1);
            PG8_WAIT_V(8); PG8_WAIT_L(0); PG8_BAR; PG8_MMA(0, 0, At, B0); PG8_MMA(0, 1, At, B1); PG8_BAR; PG8_SCHED;
            PG8_LDA(At, 0, 1); PG8_STAGEB(PG8_SB(0, 0), b2); PG8_STAGEB(PG8_SB(0, 1), b2 + hstepB); PG8_STAGEA2(PG8_SA(0, 0), a2, 0);
            PG8_WAIT_V(8); PG8_WAIT_L(0); PG8_BAR; PG8_MMA(1, 0, At, B0); PG8_MMA(1, 1, At, B1); PG8_BAR; PG8_SCHED;
            PG8_LDB(B0, 1, 0); PG8_LDB(B1, 1, 1); PG8_SCHED; PG8_LDA(At, 1, 0); PG8_STAGEA2(PG8_SA(0, 1), a2, 1);
            PG8_WAIT_V(8); PG8_WAIT_L(0); PG8_BAR; PG8_MMA(0, 0, At, B0); PG8_MMA(0, 1, At, B1); PG8_BAR; PG8_SCHED;
            PG8_LDA(At, 1, 1); PG8_STAGEB(PG8_SB(1, 0), b3); PG8_STAGEB(PG8_SB(1, 1), b3 + hstepB); PG8_STAGEA2(PG8_SA(1, 0), a3, 0);
            PG8_WAIT_V(8); PG8_WAIT_L(0); PG8_BAR; PG8_MMA(1, 0, At, B0); PG8_MMA(1, 1, At, B1); PG8_BAR; PG8_SCHED;
        }
        if constexpr (ALIGN_EPI) { if (wr == 0) PG8_BAR; }
        { int ln_; asm volatile("v_mbcnt_lo_u32_b32 %0, -1, 0\n\tv_mbcnt_hi_u32_b32 %0, -1, %0" : "=v"(ln_)); E(acc, cur, wr, wc, ln_ & 15, ln_ >> 4); }
        if (!has_next) break;
#pragma unroll
        for (int a = 0; a < 2; ++a)
#pragma unroll
            for (int b = 0; b < 2; ++b)
#pragma unroll
                for (int m = 0; m < 4; ++m)
#pragma unroll
                    for (int n = 0; n < 2; ++n) acc[a][b][m][n] = (f32x4){0.f, 0.f, 0.f, 0.f};
        cur = nxt; cA = nA; cB = nB; ++ui;
        if constexpr (Src::GATHER) {
#pragma unroll
        for (int h = 0; h < 2; ++h)
#pragma unroll
            for (int i = 0; i < 2; ++i) vc[h][i] = vn[h][i]; }
        if constexpr (ALIGN_EPI) { if (wr == 1) PG8_BAR; }
    }
    PG8_WAIT_V(0);
    if constexpr (!ALIGN_EPI) { if (wr == 0) PG8_BAR; }
    PG8_BAR;
#undef PG8_SA
#undef PG8_AOFF
#undef PG8_SB
#undef PG8_STAGEA
#undef PG8_STAGEA2
#undef PG8_STAGEB
#undef PG8_LDA
#undef PG8_LDB
#undef PG8_MMA
#undef PG8_LO
#undef PG8_HI
#undef PG8_WAIT_V
#undef PG8_WAIT_L
#undef PG8_BAR
#undef PG8_SCHED
}
}
#define RLX_AGENT __ATOMIC_RELAXED, __HIP_MEMORY_SCOPE_AGENT
#define LDS_WAIT() asm volatile("s_waitcnt lgkmcnt(0)" ::: "memory")
#define VM_WAIT() asm volatile("s_waitcnt vmcnt(0)" ::: "memory")
#define XB_TMO      128
#define XB_XCNT(j)  (256  + 64 * (j))
#define XB_XSUB(j)  (1280 + 64 * (j))
#define XB_XGEN(j)  (2304 + 64 * (j))
#define XB_TOP      3328
#define XB_TOPGEN   3392
#define XCD_BAR_WORDS 3456
#define XB_SPIN_CAP (1u << 18)

__device__ __forceinline__ unsigned xb_ld(unsigned* p)              { return __hip_atomic_load(p, __ATOMIC_RELAXED, __HIP_MEMORY_SCOPE_AGENT); }
__device__ __forceinline__ unsigned xb_add(unsigned* p, unsigned v) { return __hip_atomic_fetch_add(p, v, __ATOMIC_RELAXED, __HIP_MEMORY_SCOPE_AGENT); }
__device__ __forceinline__ unsigned xb_xcc_id() { return (unsigned)__builtin_amdgcn_s_getreg((3 << 11) | 20) & 0xFu; }
#define XB_SPIN(cond, bar) do { unsigned _sp = 0; while (cond) { __builtin_amdgcn_s_sleep(1); \
    if ((++_sp & 255u) == 0u) { if (xb_ld(&(bar)[XB_TMO])) break; if (_sp > XB_SPIN_CAP) { atomicAdd(&(bar)[XB_TMO], 1u); break; } } } } while (0)

struct XcdBarrier {
    unsigned* bar; unsigned x;
    volatile LAS unsigned* st;
};

__device__ __forceinline__ XcdBarrier xcd_barrier_post(unsigned* bar, volatile LAS unsigned* st) {
    XcdBarrier b; b.bar = bar; b.x = xb_xcc_id(); b.st = st;
    if (threadIdx.x == 0) (void)xb_add(&bar[XB_XCNT(b.x)], 1u);
    return b;
}
__device__ __forceinline__ void xcd_barrier_complete(unsigned* bar, unsigned x, unsigned& nloc, unsigned& nx) {
    const unsigned G = gridDim.x * gridDim.y * gridDim.z;
    unsigned sum, cnt, mine, sp = 0u;
    for (;;) {
        sum = 0u; cnt = 0u; mine = 0u;
#pragma unroll
        for (unsigned j = 0; j < 16; ++j) { const unsigned c = xb_ld(&bar[XB_XCNT(j)]); sum += c; cnt += (c > 0u) ? 1u : 0u; mine = (j == x) ? c : mine; }
        if (sum == G) break;
        __builtin_amdgcn_s_sleep(1);
        if ((++sp & 255u) == 0u) { if (xb_ld(&bar[XB_TMO])) break; if (sp > XB_SPIN_CAP) { atomicAdd(&bar[XB_TMO], 1u); break; } }
    }
    nloc = mine > 0u ? mine : 1u; nx = cnt > 0u ? cnt : 1u;
}

__device__ __forceinline__ void xcd_barrier(const XcdBarrier& b) {
    asm volatile("s_waitcnt vmcnt(0)" ::: "memory");
    __syncthreads();
    if (threadIdx.x == 0) {
        unsigned* bar = b.bar;
        __builtin_amdgcn_s_waitcnt(0);
        unsigned nloc = b.st[0], nx = b.st[1];
        if (nloc == 0u) { xcd_barrier_complete(bar, b.x, nloc, nx); b.st[0] = nloc; b.st[1] = nx; }
        const unsigned old = xb_add(&bar[XB_XSUB(b.x)], 1u);
        const unsigned gen = old / nloc;
        if (old + 1u == (gen + 1u) * nloc) {
            __builtin_amdgcn_fence(__ATOMIC_RELEASE, "agent");
            asm volatile("s_waitcnt vmcnt(0)" ::: "memory");
            const unsigned og = xb_add(&bar[XB_TOP], 1u);
            const unsigned tg = og / nx;
            if (og + 1u == (tg + 1u) * nx) xb_add(&bar[XB_TOPGEN], 1u);
            else XB_SPIN(xb_ld(&bar[XB_TOPGEN]) == tg, bar);
            __builtin_amdgcn_fence(__ATOMIC_ACQUIRE, "agent");
            xb_add(&bar[XB_XGEN(b.x)], 1u);
            asm volatile("s_waitcnt vmcnt(0)" ::: "memory");
        } else {
            XB_SPIN(xb_ld(&bar[XB_XGEN(b.x)]) == gen, bar);
            __builtin_amdgcn_fence(__ATOMIC_ACQUIRE, "agent");
            asm volatile("s_waitcnt vmcnt(0)" ::: "memory");
        }
    }
    __syncthreads();
}
constexpr int NB = 8, SEQ = 4096, D = 1024, M = NB * SEQ;
constexpr int NIN_SRC = 5936, NIN = 6144;
constexpr int ZW = 4096;
constexpr int ZQ = 0, ZK = 512, ZV = 1024, ZIQ = 1536, ZIK = 2048, ZIW = 2080, ZR = 2304;
constexpr int ZR_R = ZR, ZR_K = ZR + 512, ZR_V = ZR + 1024, ZR_WD = ZR + 1536, ZR_AD = ZR + 1600, ZR_GD = ZR + 1664;
constexpr int GW = 2048;
constexpr int NEXP = 64, FF = 256, TOPK = 8;
constexpr float RMS_EPS = 1e-6f, GN_EPS = 64e-5f;
constexpr float QSCALE = 0.125f * 1.4426950408889634f;
constexpr int NWAVES = 8, NTHR = 512;

constexpr size_t MiB = 1u << 20;
constexpr size_t WS_CTL = 0, CTL_ZERO_BYTES = 1 * MiB;
constexpr size_t WS_MOD = 1 * MiB;
constexpr size_t WS_DUT = 1 * MiB + 256 * 1024;
constexpr size_t WS_IUT = WS_DUT + 64 * 1024;
constexpr size_t WS_GUT = WS_IUT + 64 * 1024;
constexpr size_t WS_WIN = 2 * MiB;
constexpr size_t WS_WA = 14 * MiB, WS_WR = 15 * MiB;
constexpr size_t WS_WO = 16 * MiB;
constexpr size_t WS_WRT = 18 * MiB;
constexpr size_t WS_WSH1 = 19 * MiB;
constexpr size_t WS_WSH2 = 20 * MiB;
constexpr size_t WS_BRS = 21 * MiB, WS_KRS = 22 * MiB;
constexpr size_t WS_TOPE = 23 * MiB, WS_TOPW = 24 * MiB;
constexpr size_t WS_LOGIT = 25 * MiB;
constexpr size_t WS_Z = 36 * MiB;
constexpr size_t WS_H0 = 292 * MiB, WS_H1 = 324 * MiB;
constexpr size_t WS_SEL = 356 * MiB;
constexpr size_t WS_R0 = 372 * MiB, WS_R1 = 404 * MiB, WS_R2 = 436 * MiB, WS_R3 = 468 * MiB;
constexpr size_t WS_W2T = 36 * MiB;
constexpr size_t WS_ACT = 68 * MiB;
constexpr size_t WS_ACTS = 196 * MiB;
constexpr size_t WS_STOK = 212 * MiB, WS_SW = 213 * MiB;
constexpr size_t WS_W1T = 214 * MiB;
constexpr size_t WS_H2 = 278 * MiB;
constexpr size_t WS_SLOT = 214 * MiB;
constexpr size_t WS_END = 502 * MiB;
constexpr int CW_TMO = 0, CW_BAR = 4096, CW_CNT = 32768, CW_CUR = 32768 + 128, CW_Q = 32768 + 512;

constexpr int RING_BYTES = 131072;
constexpr int LDSCTL_OFF = RING_BYTES, MISC_OFF = LDSCTL_OFF + 320;
constexpr int LDS_TILETAB = RING_BYTES + 1024;
constexpr int LDS_PTAB = RING_BYTES + 512;
constexpr int LDS_PARA = 118800;
constexpr int LDS_PARB = LDS_TILETAB;
constexpr int LDS_BYTES = 147456;
#define AIN(i) ain_ptr(F.lds, (i))

struct Args { const float* in[31]; float* out; unsigned char* ws; int ph_lo, ph_hi, li, pad; };
struct Frame {
    LAS unsigned char* lds;
    volatile LAS unsigned* MISC;
    unsigned* ctl;
    int tid, lane, wave, vcu, G, gw, NGW;
    float* out; unsigned char* ws;
};

__device__ __forceinline__ const float* ain_ptr(LAS unsigned char* lds, int i) {
    const u32x2 w = *(const LAS u32x2*)(lds + LDS_PTAB + 8 * i);
    const unsigned lo = (unsigned)__builtin_amdgcn_readfirstlane((int)w.x), hi = (unsigned)__builtin_amdgcn_readfirstlane((int)w.y);
    return (const float*)(((unsigned long long)hi << 32) | lo);
}
struct TrSrc { const float* base; int nsrc; };
template <int FP8, class ColFn>
__device__ __forceinline__ void transpose_item(const ColFn& colfn, int K, bf16_t* WT, LAS float* scr, int kb, int nb, int lane) {
    const int k0 = 64 * kb, n0 = 32 * nb;
    const TrSrc s = colfn(n0 + (lane & 31));
    float v_[32];
#pragma unroll
    for (int i = 0; i < 32; ++i) { const int kk = 2 * i + (lane >> 5); v_[i] = s.base ? s.base[(size_t)(k0 + kk) * s.nsrc] : 0.f; }
#pragma unroll
    for (int i = 0; i < 32; ++i) { const int kk = 2 * i + (lane >> 5); scr[kk * 33 + (lane & 31)] = v_[i]; }
    LDS_WAIT(); asm volatile("" ::: "memory");
    const int c = lane & 7;
#pragma unroll
    for (int j = 0; j < 4; ++j) { const int n = (lane >> 3) + 8 * j; const LAS float* sp = scr + (8 * c) * 33 + n;
        if constexpr (FP8) { constexpr float S8 = 32.0f;
            int lo = __builtin_amdgcn_cvt_pk_fp8_f32(sp[0 * 33] * S8, sp[1 * 33] * S8, 0, false); lo = __builtin_amdgcn_cvt_pk_fp8_f32(sp[2 * 33] * S8, sp[3 * 33] * S8, lo, true);
            int hi = __builtin_amdgcn_cvt_pk_fp8_f32(sp[4 * 33] * S8, sp[5 * 33] * S8, 0, false); hi = __builtin_amdgcn_cvt_pk_fp8_f32(sp[6 * 33] * S8, sp[7 * 33] * S8, hi, true);
            *(GAS u32x2*)((unsigned char*)WT + (size_t)(n0 + n) * K + k0 + 8 * c) = (u32x2){(unsigned)lo, (unsigned)hi}; }
        else { u32x4 o; o.x = pk2(sp[0 * 33], sp[1 * 33]); o.y = pk2(sp[2 * 33], sp[3 * 33]); o.z = pk2(sp[4 * 33], sp[5 * 33]); o.w = pk2(sp[6 * 33], sp[7 * 33]);
            *(GAS u32x4*)(WT + (size_t)(n0 + n) * K + k0 + 8 * c) = o; } }
    LDS_WAIT(); asm volatile("" ::: "memory");
}

__device__ __forceinline__ void p0_mod(const Args& args, Frame& F, int task) {
    LAS float* sc = (LAS float*)F.lds;
    LAS float* red = (LAS float*)(F.lds + 32768);
    const float* c = AIN(1);
    for (int i = F.tid; i < 8192; i += NTHR) { const float v = c[i]; sc[i] = v * fast_sigmoid(v); }
    __syncthreads();
    const float* aw = AIN(2) + 64 * task + F.lane;
    float acc[8];
#pragma unroll
    for (int b = 0; b < 8; ++b) acc[b] = 0.f;
    const int kb = 128 * F.wave;
#pragma unroll 4
    for (int k = 0; k < 128; ++k) { const float a = aw[(size_t)(kb + k) * 6144];
#pragma unroll
        for (int b = 0; b < 8; ++b) acc[b] += sc[b * 1024 + kb + k] * a; }
#pragma unroll
    for (int b = 0; b < 8; ++b) red[(F.wave * 8 + b) * 64 + F.lane] = acc[b];
    __syncthreads();
    { const int b = F.wave; float s = AIN(3)[64 * task + F.lane];
#pragma unroll
      for (int w = 0; w < 8; ++w) s += red[(w * 8 + b) * 64 + F.lane];
      ((float*)(F.ws + WS_MOD))[b * 6144 + 64 * task + F.lane] = s; }
    __syncthreads();
}

__device__ __forceinline__ void p0_prologue(const Args& args, Frame& F) {
    if (blockIdx.x < 96) p0_mod(args, F, blockIdx.x);
    LAS float* scr = (LAS float*)(F.lds + F.wave * 16384);
    bf16_t* const ws16 = (bf16_t*)F.ws;
    constexpr int I_WIN = 16 * 192, I_WA = 8 * 32, I_WO = 16 * 32, I_WRT = 16 * 8, I_SH1 = 16 * 16, I_SH2 = 4 * 32, I_DU = 16, I_GU = 32;
    constexpr int NIT = I_WIN + 2 * I_WA + I_WO + I_WRT + I_SH1 + I_SH2 + 2 * I_DU + I_GU;
    for (int it = F.gw; it < NIT; it += F.NGW) {
        int r = it;
        if (r < I_WIN) { const float* w = AIN(5);
            transpose_item<1>([=](int n) { TrSrc s; const bool ok = (n < 2096) || (n >= 2304); const int col = n < 2096 ? n : n - 208; s.base = ok ? w + col : nullptr; s.nsrc = NIN_SRC; return s; },
                           1024, (bf16_t*)(F.ws + WS_WIN), scr, r / 192, r % 192, F.lane); continue; } r -= I_WIN;
        if (r < I_WA) { const float* w = AIN(18); transpose_item<0>([=](int n) { TrSrc s; s.base = w + n; s.nsrc = 1024; return s; }, 512, (bf16_t*)(F.ws + WS_WA), scr, r / 32, r % 32, F.lane); continue; } r -= I_WA;
        if (r < I_WA) { const float* w = AIN(19); transpose_item<0>([=](int n) { TrSrc s; s.base = w + n; s.nsrc = 1024; return s; }, 512, (bf16_t*)(F.ws + WS_WR), scr, r / 32, r % 32, F.lane); continue; } r -= I_WA;
        if (r < I_WO) { const float* w = AIN(20); transpose_item<1>([=](int n) { TrSrc s; s.base = w + n; s.nsrc = 1024; return s; }, 1024, (bf16_t*)(F.ws + WS_WO), scr, r / 32, r % 32, F.lane); continue; } r -= I_WO;
        if (r < I_WRT) { const float* w = AIN(22); transpose_item<0>([=](int n) { TrSrc s; s.base = n < 64 ? w + n : nullptr; s.nsrc = 64; return s; }, 1024, (bf16_t*)(F.ws + WS_WRT), scr, r / 8, r % 8, F.lane); continue; } r -= I_WRT;
        if (r < I_SH1) { const float* wg = AIN(27); const float* wu = AIN(28);
            transpose_item<0>([=](int n) { TrSrc s; const int j = n >> 8, sel = (n >> 7) & 1, cc = n & 127; s.base = (sel ? wu : wg) + 128 * j + cc; s.nsrc = 256; return s; }, 1024, (bf16_t*)(F.ws + WS_WSH1), scr, r / 16, r % 16, F.lane); continue; } r -= I_SH1;
        if (r < I_SH2) { const float* w = AIN(29); transpose_item<0>([=](int n) { TrSrc s; s.base = w + n; s.nsrc = 1024; return s; }, 256, (bf16_t*)(F.ws + WS_WSH2), scr, r / 32, r % 32, F.lane); continue; } r -= I_SH2;
        if (r < I_DU) { const float* w = AIN(9); transpose_item<0>([=](int n) { TrSrc s; s.base = w + n; s.nsrc = 512; return s; }, 64, (bf16_t*)(F.ws + WS_DUT), scr, 0, r, F.lane); continue; } r -= I_DU;
        if (r < I_DU) { const float* w = AIN(11); transpose_item<0>([=](int n) { TrSrc s; s.base = w + n; s.nsrc = 512; return s; }, 64, (bf16_t*)(F.ws + WS_IUT), scr, 0, r, F.lane); continue; } r -= I_DU;
        { const float* w = AIN(12); transpose_item<0>([=](int n) { TrSrc s; s.base = w + n; s.nsrc = 512; return s; }, 128, (bf16_t*)(F.ws + WS_GUT), scr, r / 16, r % 16, F.lane); }
    }
    (void)ws16;
}

__device__ __forceinline__ void convert_experts(const Args& args, Frame& F) {
    LAS float* scr = (LAS float*)(F.lds + F.wave * 16384);
    constexpr int I1 = 16 * 16, I2 = 4 * 32, PER = I1 + I2, NIT = 64 * PER;
    for (int it = F.gw; it < NIT; it += F.NGW) {
        const int e = it / PER; int r = it % PER;
        if (r < I1) { const float* wg = AIN(24) + (size_t)e * 1024 * 256; const float* wu = AIN(25) + (size_t)e * 1024 * 256;
            transpose_item<0>([=](int n) { TrSrc s; const int j = n >> 8, sel = (n >> 7) & 1, cc = n & 127; s.base = (sel ? wu : wg) + 128 * j + cc; s.nsrc = 256; return s; }, 1024, (bf16_t*)(F.ws + WS_W1T) + (size_t)e * 512 * 1024, scr, r / 16, r % 16, F.lane); }
        else { r -= I1; const float* w = AIN(26) + (size_t)e * 256 * 1024;
            transpose_item<0>([=](int n) { TrSrc s; s.base = w + n; s.nsrc = 1024; return s; }, 256, (bf16_t*)(F.ws + WS_W2T) + (size_t)e * 1024 * 256, scr, r / 32, r % 32, F.lane); }
    }
}

__device__ __forceinline__ void norm_mod_rows(const Args& args, Frame& F, const float* X, const float* g, int sh_off, int sc_off, bf16_t* O, unsigned char* O8) {
    const int row0 = F.gw * 16, b = row0 / SEQ;
    const float* mod = (const float*)(F.ws + WS_MOD) + b * 6144;
    f32x4 mul[4], add[4];
#pragma unroll
    for (int j = 0; j < 4; ++j) { const int c = 4 * F.lane + 256 * j; const f32x4 gv = *(const f32x4*)(g + c), sc = *(const f32x4*)(mod + sc_off + c); add[j] = *(const f32x4*)(mod + sh_off + c); mul[j] = gv * (sc + 1.0f); }
    for (int r = 0; r < 16; ++r) {
        const GAS f32x4* xr = (const GAS f32x4*)(X + (size_t)(row0 + r) * D) + F.lane;
        f32x4 v[4]; float s = 0.f;
#pragma unroll
        for (int j = 0; j < 4; ++j) { v[j] = xr[64 * j]; s += (v[j].x * v[j].x + v[j].y * v[j].y) + (v[j].z * v[j].z + v[j].w * v[j].w); }
        const float rstd = 1.0f / sqrtf(wave_sum(s) * (1.0f / D) + RMS_EPS);
#pragma unroll
        for (int j = 0; j < 4; ++j) { const f32x4 y = v[j] * rstd * mul[j] + add[j];
            if (O) { u32x2 w; w.x = cvt_pk_bf16(y.x, y.y); w.y = cvt_pk_bf16(y.z, y.w); ((GAS u32x2*)(O + (size_t)(row0 + r) * D) + F.lane)[64 * j] = w; }
            if (O8) { int w8 = __builtin_amdgcn_cvt_pk_fp8_f32(y.x, y.y, 0, false); w8 = __builtin_amdgcn_cvt_pk_fp8_f32(y.z, y.w, w8, true); ((GAS unsigned*)(O8 + (size_t)(row0 + r) * D) + F.lane)[64 * j] = (unsigned)w8; } }
    }
}
using pg8::Unit;
constexpr float WSCALE8 = 32.0f;
typedef const f32x4 (&AccRef)[2][2][4][2];

struct EpiInProj {
    static constexpr bool PERM = true;
    bf16_t* Z; bf16_t* Gt;
    __device__ __forceinline__ void operator()(AccRef acc, const Unit& u, int wr, int wc, int fr, int fq) const {
        asm volatile("" : "+v"(fr), "+v"(fq));
        const int row0 = u.pm * 256 + wr * 64 + fr;
        const bool gate = u.pn >= 16;
        const float sc = ((u.pn < 2) ? QSCALE : 1.0f) * (1.0f / WSCALE8);
        bf16_t* base = gate ? Gt + (size_t)(u.pn - 16) * 256 : Z + (size_t)u.pn * 256;
        const int ldc = gate ? GW : ZW;
#pragma unroll
        for (int ai = 0; ai < 2; ++ai)
#pragma unroll
            for (int m = 0; m < 4; ++m) { bf16_t* rowp = base + (size_t)(row0 + ai * 128 + m * 16) * ldc + wc * 32 + 8 * fq;
#pragma unroll
                for (int bj = 0; bj < 2; ++bj) { f32x4 v0 = acc[ai][bj][m][0], v1 = acc[ai][bj][m][1];
                    if (gate) {
#pragma unroll
                        for (int j = 0; j < 4; ++j) { v0[j] = fast_sigmoid(v0[j] * sc); v1[j] = fast_sigmoid(v1[j] * sc); } }
                    else { v0 = v0 * sc; v1 = v1 * sc; }
                    u32x4 w; w.x = cvt_pk_bf16(v0[0], v0[1]); w.y = cvt_pk_bf16(v0[2], v0[3]); w.z = cvt_pk_bf16(v1[0], v1[1]); w.w = cvt_pk_bf16(v1[2], v1[3]);
                    *(u32x4*)(rowp + bj * 128) = w; } }
    }
};

constexpr float ATT_S8 = 16.0f, RW_S8 = 8.0f, MIX_S8 = 16.0f;
template <int SECOND> struct EpiMerge {
    static constexpr bool PERM = true;
    bf16_t* Mx; unsigned char* Mx8; const bf16_t* Gt; float bs;
    __device__ __forceinline__ void operator()(AccRef acc, const Unit& u, int wr, int wc, int fr, int fq) const {
        asm volatile("" : "+v"(fr), "+v"(fq));
        const int row0 = u.pm * 256 + wr * 64 + fr, col0 = u.pn * 256 + wc * 32 + 8 * fq;
#pragma unroll
        for (int ai = 0; ai < 2; ++ai)
#pragma unroll
            for (int m = 0; m < 4; ++m) { const size_t r = (size_t)(row0 + ai * 128 + m * 16);
#pragma unroll
                for (int bj = 0; bj < 2; ++bj) { const int c = col0 + bj * 128;
                    const u32x4 g = *(const u32x4*)(Gt + r * GW + SECOND * 1024 + c);
                    f32x4 v0 = acc[ai][bj][m][0] * bs, v1 = acc[ai][bj][m][1] * bs;
                    v0[0] *= bf_lo(g.x); v0[1] *= bf_hi(g.x); v0[2] *= bf_lo(g.y); v0[3] *= bf_hi(g.y);
                    v1[0] *= bf_lo(g.z); v1[1] *= bf_hi(g.z); v1[2] *= bf_lo(g.w); v1[3] *= bf_hi(g.w);
                    if (SECOND) { const u32x4 p = *(const u32x4*)(Mx + r * D + c);
                        v0[0] += bf_lo(p.x); v0[1] += bf_hi(p.x); v0[2] += bf_lo(p.y); v0[3] += bf_hi(p.y);
                        v1[0] += bf_lo(p.z); v1[1] += bf_hi(p.z); v1[2] += bf_lo(p.w); v1[3] += bf_hi(p.w);
                        v0 = v0 * MIX_S8; v1 = v1 * MIX_S8;
                        int lo = __builtin_amdgcn_cvt_pk_fp8_f32(v0[0], v0[1], 0, false); lo = __builtin_amdgcn_cvt_pk_fp8_f32(v0[2], v0[3], lo, true);
                        int hi = __builtin_amdgcn_cvt_pk_fp8_f32(v1[0], v1[1], 0, false); hi = __builtin_amdgcn_cvt_pk_fp8_f32(v1[2], v1[3], hi, true);
                        *(u32x2*)(Mx8 + r * D + c) = (u32x2){(unsigned)lo, (unsigned)hi}; }
                    else { u32x4 w; w.x = cvt_pk_bf16(v0[0], v0[1]); w.y = cvt_pk_bf16(v0[2], v0[3]); w.z = cvt_pk_bf16(v1[0], v1[1]); w.w = cvt_pk_bf16(v1[2], v1[3]);
                        *(u32x4*)(Mx + r * D + c) = w; } } }
    }
};

struct EpiOutProj {
    static constexpr bool PERM = false;
    const float* X; float* O; const float* mod;
    __device__ __forceinline__ void operator()(AccRef acc, const Unit& u, int wr, int wc, int fr, int fq) const {
        asm volatile("" : "+v"(fr), "+v"(fq));
        const int row0 = u.pm * 256 + wr * 64 + fr, col0 = u.pn * 256 + wc * 32 + 4 * fq;
        const float* g1 = mod + (size_t)((u.pm * 256) / SEQ) * 6144 + 2048;
        f32x4 gv[2][2];
#pragma unroll
        for (int bj = 0; bj < 2; ++bj)
#pragma unroll
            for (int n = 0; n < 2; ++n) gv[bj][n] = *(const f32x4*)(g1 + col0 + bj * 128 + n * 16);
#pragma unroll
        for (int ai = 0; ai < 2; ++ai)
#pragma unroll
            for (int m = 0; m < 4; ++m) { const size_t off = (size_t)(row0 + ai * 128 + m * 16) * D + col0;
#pragma unroll
                for (int bj = 0; bj < 2; ++bj)
#pragma unroll
                    for (int n = 0; n < 2; ++n) { const f32x4 xv = *(const f32x4*)(X + off + bj * 128 + n * 16);
                        *(f32x4*)(O + off + bj * 128 + n * 16) = xv + gv[bj][n] * acc[ai][bj][m][n] * (1.0f / (MIX_S8 * WSCALE8)); }
                if (m & 1) asm volatile("" ::: "memory"); }
    }
};

struct EpiRouter {
    static constexpr bool PERM = false;
    float* L;
    __device__ __forceinline__ void operator()(AccRef acc, const Unit& u, int wr, int wc, int fr, int fq) const {
        asm volatile("" : "+v"(fr), "+v"(fq));
        if (wc >= 2) return;
        const int row0 = u.pm * 256 + wr * 64 + fr, col0 = wc * 32 + 4 * fq;
#pragma unroll
        for (int ai = 0; ai < 2; ++ai)
#pragma unroll
            for (int m = 0; m < 4; ++m)
#pragma unroll
                for (int n = 0; n < 2; ++n) *(f32x4*)(L + (size_t)(row0 + ai * 128 + m * 16) * 64 + col0 + n * 16) = acc[ai][0][m][n];
    }
};

struct MoeSched1 {
    const LAS unsigned* tab; int ntiles, G, c;
    __device__ __forceinline__ bool next(int i, Unit& u) const {
        const int L = i * G + c; if (L >= 256 + 2 * ntiles) return false;
        u.pn = L & 1;
        if (L < 256) { u.pm = L >> 1; u.aux0 = (u.pm * 256) | (64 << 20); u.aux1 = 256; }
        else { const int t = (L - 256) >> 1; u.pm = t; u.aux0 = __builtin_amdgcn_readfirstlane((int)tab[2 * t]); u.aux1 = __builtin_amdgcn_readfirstlane((int)tab[2 * t + 1]); }
        return true;
    }
};
struct MoeSrc1 {
    static constexpr int ESZ = 2; static constexpr bool GATHER = true;
    const unsigned char* ws;
    __device__ __forceinline__ const char* a_base(const Unit&) const { return (const char*)(ws + WS_H2); }
    __device__ __forceinline__ const char* b_base(const Unit& u) const { const int e = u.aux0 >> 20;
        const size_t off = (e == 64 ? WS_WSH1 : WS_W1T + (size_t)e * 512 * 1024 * 2) + (size_t)u.pn * 256 * 1024 * 2; return (const char*)ws + off; }
    __device__ __forceinline__ unsigned a_off(const Unit& u, int R, int C) const {
        const int e = u.aux0 >> 20, pos0 = u.aux0 & 0xFFFFF; int tok;
        if (e == 64) tok = pos0 + R; else tok = (R < u.aux1) ? (((const int*)(ws + WS_STOK))[pos0 + R] >> 3) : 0;
        return (unsigned)tok * 2048u + (unsigned)C * 2u; }
};
struct EpiMoe1 {
    static constexpr bool PERM = true;
    unsigned char* ws;
    __device__ __forceinline__ void operator()(AccRef acc, const Unit& u, int wr, int wc, int fr, int fq) const {
        asm volatile("" : "+v"(fr), "+v"(fq));
        const int e = u.aux0 >> 20, pos0 = u.aux0 & 0xFFFFF;
        bf16_t* base = (bf16_t*)(ws + (e == 64 ? WS_ACTS : WS_ACT)) + (size_t)pos0 * FF + u.pn * 128 + wc * 32 + 8 * fq;
#pragma unroll
        for (int ai = 0; ai < 2; ++ai)
#pragma unroll
            for (int m = 0; m < 4; ++m) { const int r = ai * 128 + wr * 64 + m * 16 + fr;
                float o[8];
#pragma unroll
                for (int n = 0; n < 2; ++n)
#pragma unroll
                    for (int j = 0; j < 4; ++j) { const float g = acc[ai][0][m][n][j], up = acc[ai][1][m][n][j]; o[4 * n + j] = g * fast_sigmoid(g) * up; }
                u32x4 w; w.x = cvt_pk_bf16(o[0], o[1]); w.y = cvt_pk_bf16(o[2], o[3]); w.z = cvt_pk_bf16(o[4], o[5]); w.w = cvt_pk_bf16(o[6], o[7]);
                if (r < u.aux1) *(u32x4*)(base + (size_t)r * FF) = w; }
    }
};
struct MoeSched2 {
    const LAS unsigned* tab; int t0, ntiles, nsh, G, c;
    __device__ __forceinline__ bool next(int i, Unit& u) const {
        const int L = i * G + c; if (L >= nsh + 4 * ntiles) return false;
        u.pn = L & 3;
        if (L < nsh) { u.pm = L >> 2; u.aux0 = (u.pm * 256) | (64 << 20); u.aux1 = 256; }
        else { const int t = t0 + ((L - nsh) >> 2); u.pm = t; u.aux0 = __builtin_amdgcn_readfirstlane((int)tab[2 * t]); u.aux1 = __builtin_amdgcn_readfirstlane((int)tab[2 * t + 1]); }
        return true;
    }
};
struct MoeSrc2 {
    static constexpr int ESZ = 2; static constexpr bool GATHER = true;
    const unsigned char* ws;
    __device__ __forceinline__ const char* a_base(const Unit& u) const { return (const char*)ws + ((u.aux0 >> 20) == 64 ? WS_ACTS : WS_ACT); }
    __device__ __forceinline__ const char* b_base(const Unit& u) const { const int e = u.aux0 >> 20;
        const size_t off = (e == 64 ? WS_WSH2 : WS_W2T + (size_t)e * 1024 * 256 * 2) + (size_t)u.pn * 256 * 256 * 2; return (const char*)ws + off; }
    __device__ __forceinline__ unsigned a_off(const Unit& u, int R, int C) const {
        const int pos0 = u.aux0 & 0xFFFFF; const int rr = R < u.aux1 ? R : u.aux1 - 1;
        return (unsigned)(pos0 + rr) * 512u + (unsigned)C * 2u; }
};
constexpr float SLOT_SCALE = 16.0f;
constexpr int NSLOT = 9;
struct EpiMoe2 {
    static constexpr bool PERM = true;
    unsigned char* ws; float* X1; int tokbase;
    __device__ __forceinline__ void operator()(AccRef acc, const Unit& u, int wr, int wc, int fr, int fq) const {
        asm volatile("" : "+v"(fr), "+v"(fq));
        const int e = u.aux0 >> 20, pos0 = u.aux0 & 0xFFFFF; const int col0 = u.pn * 256 + wc * 32 + 8 * fq;
        if (e == 64) {
#pragma unroll
            for (int ai = 0; ai < 2; ++ai)
#pragma unroll
                for (int m = 0; m < 4; ++m) { unsigned char* rowp = (unsigned char*)(ws + WS_SLOT) + ((size_t)(pos0 + ai * 128 + wr * 64 + m * 16 + fr) * NSLOT + 8) * D + u.pn * 256 + wc * 64 + fq * 16;
                    u32x4 o;
#pragma unroll
                    for (int bj = 0; bj < 2; ++bj) { const f32x4 v0 = acc[ai][bj][m][0] * SLOT_SCALE, v1 = acc[ai][bj][m][1] * SLOT_SCALE;
                        int lo = __builtin_amdgcn_cvt_pk_fp8_f32(v0[0], v0[1], 0, false); lo = __builtin_amdgcn_cvt_pk_fp8_f32(v0[2], v0[3], lo, true);
                        int hi = __builtin_amdgcn_cvt_pk_fp8_f32(v1[0], v1[1], 0, false); hi = __builtin_amdgcn_cvt_pk_fp8_f32(v1[2], v1[3], hi, true);
                        if (bj == 0) { o.x = (unsigned)lo; o.y = (unsigned)hi; } else { o.z = (unsigned)lo; o.w = (unsigned)hi; } }
                    *(u32x4*)rowp = o;
                    asm volatile("" ::: "memory"); }
        } else {
#pragma unroll
            for (int ai = 0; ai < 2; ++ai)
#pragma unroll
                for (int m = 0; m < 4; ++m) { const int r = ai * 128 + wr * 64 + m * 16 + fr;
                    if (r < u.aux1) { const int tk = ((const int*)(ws + WS_STOK))[pos0 + r]; const float w = ((const float*)(ws + WS_SW))[pos0 + r] * SLOT_SCALE;
                        unsigned char* rowp = (unsigned char*)(ws + WS_SLOT) + ((size_t)(tk >> 3) * NSLOT + (tk & 7)) * D + u.pn * 256 + wc * 64 + fq * 16;
                        u32x4 o;
#pragma unroll
                        for (int bj = 0; bj < 2; ++bj) { const f32x4 v0 = acc[ai][bj][m][0] * w, v1 = acc[ai][bj][m][1] * w;
                            int lo = __builtin_amdgcn_cvt_pk_fp8_f32(v0[0], v0[1], 0, false); lo = __builtin_amdgcn_cvt_pk_fp8_f32(v0[2], v0[3], lo, true);
                            int hi = __builtin_amdgcn_cvt_pk_fp8_f32(v1[0], v1[1], 0, false); hi = __builtin_amdgcn_cvt_pk_fp8_f32(v1[2], v1[3], hi, true);
                            if (bj == 0) { o.x = (unsigned)lo; o.y = (unsigned)hi; } else { o.z = (unsigned)lo; o.w = (unsigned)hi; } }
                        *(u32x4*)rowp = o; }
                    asm volatile("" ::: "memory"); }
        }
    }
};
__device__ __forceinline__ unsigned ord_key(float x) { const unsigned b = __float_as_uint(x); return (b & 0x80000000u) ? ~b : (b | 0x80000000u); }

__device__ __forceinline__ void indexer_unit(const Args& args, Frame& F, int b, int q0) {
    const bf16_t* Z = (const bf16_t*)(F.ws + WS_Z) + (size_t)b * SEQ * ZW;
    unsigned* SELM = (unsigned*)(F.ws + WS_SEL) + (size_t)b * SEQ * 128;
    int tid = F.tid; asm volatile("" : "+v"(tid));
    const int lane = tid & 63, kl = lane & 31, hl = lane >> 5, w = F.wave;
    const int qa = q0 + 2 * w;
    const int myq = qa + hl;
    bf16x8 A0, A1;
    { const int aq = (kl >> 2) & 1, ah = 4 * (kl >> 3) + (kl & 3);
      const bf16_t* p = Z + (size_t)(qa + aq) * ZW + ZIQ + ah * 32 + 8 * hl;
      A0 = *(const bf16x8*)p; A1 = *(const bf16x8*)(p + 16); }
    float wq[16];
    { const bf16_t* p = Z + (size_t)myq * ZW + ZIW; const u32x4 a = *(const u32x4*)p, c = *(const u32x4*)(p + 8);
      wq[0] = bf_lo(a.x); wq[1] = bf_hi(a.x); wq[2] = bf_lo(a.y); wq[3] = bf_hi(a.y); wq[4] = bf_lo(a.z); wq[5] = bf_hi(a.z); wq[6] = bf_lo(a.w); wq[7] = bf_hi(a.w);
      wq[8] = bf_lo(c.x); wq[9] = bf_hi(c.x); wq[10] = bf_lo(c.y); wq[11] = bf_hi(c.y); wq[12] = bf_lo(c.z); wq[13] = bf_hi(c.z); wq[14] = bf_lo(c.w); wq[15] = bf_hi(c.w); }
    unsigned key[128];
    const int nchunk = (q0 + 15) / 1024 + 1;
#define IDX_LOAD(ch, buf) do { _Pragma("unroll") for (int _h = 0; _h < 2; ++_h) { u32x4 v_[4]; \
        _Pragma("unroll") for (int _i = 0; _i < 4; ++_i) { const int pc = tid + 512 * (4 * _h + _i); const int kk = pc >> 2, c4 = pc & 3; v_[_i] = *(const u32x4*)(Z + (size_t)((ch) * 1024 + kk) * ZW + ZIK + 8 * c4); } \
        _Pragma("unroll") for (int _i = 0; _i < 4; ++_i) { const int pc = tid + 512 * (4 * _h + _i); const int kk = pc >> 2, c4 = pc & 3; *(LAS u32x4*)(F.lds + (buf) * 65536 + (c4 * 1024 + kk) * 16) = v_[_i]; } \
        asm volatile("" ::: "memory"); } } while (0)
    IDX_LOAD(0, 0);
    __syncthreads();
#pragma unroll
    for (int ch = 0; ch < 4; ++ch) {
        if (ch < nchunk) {
            if (ch + 1 < nchunk) IDX_LOAD(ch + 1, (ch + 1) & 1);
            LAS unsigned char* kbl = F.lds + (ch & 1) * 65536 + hl * 16384 + kl * 16; asm volatile("" : "+v"(kbl));
#pragma unroll
            for (int tt = 0; tt < 32; tt += 2) {
                const int t = ch * 32 + tt;
                if (32 * t <= qa + 1) {
                    bf16x8 B0[2], B1[2]; f32x16 acc[2];
#pragma unroll
                    for (int j = 0; j < 2; ++j) { B0[j] = *(const LAS bf16x8*)(kbl + 512 * (tt + j)); B1[j] = *(const LAS bf16x8*)(kbl + 32768 + 512 * (tt + j)); }
#pragma unroll
                    for (int j = 0; j < 2; ++j) { acc[j] = f32x16{}; acc[j] = __builtin_amdgcn_mfma_f32_32x32x16_bf16(A0, B0[j], acc[j], 0, 0, 0); }
#pragma unroll
                    for (int j = 0; j < 2; ++j) acc[j] = __builtin_amdgcn_mfma_f32_32x32x16_bf16(A1, B1[j], acc[j], 0, 0, 0);
#pragma unroll
                    for (int j = 0; j < 2; ++j) { float s = 0.f;
#pragma unroll
                        for (int i = 0; i < 16; ++i) { const float av_ = acc[j][i]; const int xb_ = __float_as_int(av_); s += __int_as_float(xb_ > 0 ? xb_ : 0) * wq[i]; }
                        key[t + j] = (32 * (t + j) + kl <= myq) ? ord_key(s) : 0u; }
                } else {
#pragma unroll
                    for (int j = 0; j < 2; ++j) key[t + j] = 0u;
                }
            }
            __syncthreads();
        } else {
#pragma unroll
            for (int tt = 0; tt < 32; ++tt) key[ch * 32 + tt] = 0u;
        }
    }
#undef IDX_LOAD
    unsigned T = 0u; bool done = (myq + 1 <= 256);
    if (done) T = 1u;
#define IDX_COUNT(cand_, cnt_) do { cnt_ = 0; _Pragma("unroll") for (int blk_ = 0; blk_ < 8; ++blk_) { if (blk_ * 512 <= qa + 1) { \
            _Pragma("unroll") for (int t = blk_ * 16; t < blk_ * 16 + 16; ++t) cnt_ += (key[t] >= (cand_)) ? 1u : 0u; } } \
        _Pragma("unroll") for (int o = 1; o < 32; o <<= 1) cnt_ += __shfl_xor(cnt_, o); } while (0)
    if (!__all(done)) {
        unsigned mx = 0u;
#pragma unroll
        for (int t = 0; t < 128; ++t) mx = key[t] > mx ? key[t] : mx;
#pragma unroll
        for (int o = 1; o < 32; o <<= 1) { const unsigned v = __shfl_xor(mx, o); mx = v > mx ? v : mx; }
        for (int bit = 31; bit >= 0; --bit) {
            if (__all(done)) break;
            const unsigned cand = T | (1u << bit);
            if (__all(done || cand > mx)) continue;
            unsigned cnt; IDX_COUNT(cand, cnt);
            if (!done && cnt >= 256u) { T = cand; if (cnt == 256u) done = true; }
        }
    }
#undef IDX_COUNT
    unsigned mw[4] = {0u, 0u, 0u, 0u};
#pragma unroll
    for (int t = 0; t < 128; ++t) {
        const unsigned long long bal = __ballot(key[t] >= T);
        const unsigned word = hl ? (unsigned)(bal >> 32) : (unsigned)bal;
        if (kl == (t & 31)) mw[t >> 5] = word;
        if ((t & 3) == 3) __builtin_amdgcn_sched_barrier(0);
    }
#pragma unroll
    for (int j = 0; j < 4; ++j) SELM[(size_t)myq * 128 + kl + 32 * j] = mw[j];
}

__device__ __forceinline__ void indexer_phase(const Args& args, Frame& F) {
    const int c = blockIdx.x;
    for (int i = 0; i < 8; ++i) {
        for (int u = c + i * F.G; u < 2048 && i < 8; u += 2048) {
            const int b = u >> 8, pos = u & 255, blk = (b & 1) ? 255 - pos : pos;
            indexer_unit(args, F, b, blk * 16);
        }
    }
}
namespace att {
constexpr int DM = ZW, QB = 256, KVB = 64, SLOTB = 8192;
constexpr int L_K = 0, L_V = 2 * SLOTB, L_MASK = 4 * SLOTB, L_WSF = L_MASK + 8 * 2048, L_OST = L_WSF + 8 * 256, L_BT = L_OST + 8 * 4096, L_END = L_BT + 512;
__device__ __forceinline__ int crow(int r, int hi) { return (r & 3) + 8 * (r >> 2) + 4 * hi; }
__device__ __forceinline__ void glds16(const void* gsrc, unsigned lds_dst) { unsigned keep;
    asm volatile("s_mov_b32 %0, m0\n\ts_mov_b32 m0, %2\n\ts_nop 0\n\tglobal_load_lds_dwordx4 %1, off\n\ts_mov_b32 m0, %0" : "=&s"(keep) : "v"(gsrc), "s"(lds_dst) : "memory"); }
__device__ __forceinline__ unsigned cvtpk(float lo, float hi) { return cvt_pk_bf16(lo, hi); }
typedef short s16x4 __attribute__((ext_vector_type(4)));

__device__ __forceinline__ void attn_unit(const Args& args, Frame& F, int b, int h, int qb) {
    const int lane = F.lane, r32 = lane & 31, hi = lane >> 5, wid = F.wave;
    const bf16_t* Zb = (const bf16_t*)(F.ws + WS_Z) + (size_t)b * SEQ * DM;
    const int q0 = qb * QB;
    const bf16_t* Qw = Zb + (size_t)(q0 + wid * 32) * DM + ZQ + h * 64;
    const bf16_t* Kh = Zb + ZK + h * 64; const bf16_t* Vh = Zb + ZV + h * 64;
    LAS unsigned char* shm = F.lds;
    const unsigned lds0 = (unsigned)(uintptr_t)shm;
    LAS float* wsf = (LAS float*)(shm + L_WSF) + wid * 64;
    LAS float* bt = (LAS float*)(shm + L_BT);
    if (F.tid < 128) { const int rel = F.tid; int bk;
        if (rel < 16) bk = rel; else { bk = 16 + (int)(logf((float)rel / 16.0f) / logf(8.0f) * 16.0f); bk = bk < 31 ? bk : 31; }
        bt[rel] = (AIN(6)[bk * 8 + h] - AIN(6)[31 * 8 + h]) * 1.4426950408889634f; }
    const bf16_t* ksrc = Kh + (size_t)lane * DM + wid * 8;
    const bf16_t* vsrc = Vh + (size_t)(16 * (wid & 3) + (lane >> 2)) * DM + (wid >> 2) * 32 + (lane & 3) * 8;
    const unsigned kdst = lds0 + L_K + wid * 1024, vdst = lds0 + L_V + wid * 1024;
    const unsigned* SELM = (const unsigned*)(F.ws + WS_SEL) + (size_t)(b * SEQ + q0 + wid * 32 + r32) * 128 + 4 * hi;
    const unsigned mdst = lds0 + L_MASK + wid * 2048;
#define DMA_K(t, slot) glds16(ksrc + (size_t)(t) * KVB * DM, (unsigned)__builtin_amdgcn_readfirstlane(kdst + (slot) * SLOTB))
#define DMA_V(t, slot) glds16(vsrc + (size_t)(t) * KVB * DM, (unsigned)__builtin_amdgcn_readfirstlane(vdst + (slot) * SLOTB))
#define DMA_M(g) glds16(SELM + 8 * (g), (unsigned)__builtin_amdgcn_readfirstlane(mdst + ((g) & 1) * 1024))
    const int NT = (q0 + QB) / KVB;
    bf16x8 qr[4];
#pragma unroll
    for (int d0 = 0; d0 < 4; ++d0) qr[d0] = *(const bf16x8*)(Qw + (size_t)r32 * DM + d0 * 16 + hi * 8);
    asm volatile("s_waitcnt vmcnt(0)" ::: "memory");
    __syncthreads();
    DMA_M(0); DMA_K(0, 0); DMA_V(0, 0);
    float m_run = -1e30f, l_run = 0.f; f32x16 o[2]; o[0] = f32x16{}; o[1] = f32x16{};
    const int qpos = q0 + wid * 32 + r32;
    const int vb0 = (int)(lds0 + L_V) + ((lane >> 4) & 1) * 32 + (lane & 3) * 8 + (4 * hi + ((lane & 15) >> 2)) * 64;
    for (int t = 0; t < NT; ++t) {
        const int slot = t & 1, g = t >> 2, tq = t & 3;
        if (t + 1 < NT) {
            DMA_K(t + 1, slot ^ 1); DMA_V(t + 1, slot ^ 1);
            if (tq == 0) { DMA_M(g + 1); asm volatile("s_waitcnt vmcnt(3)" ::: "memory"); }
            else if (tq == 1) asm volatile("s_waitcnt vmcnt(3)" ::: "memory");
            else asm volatile("s_waitcnt vmcnt(2)" ::: "memory");
        } else asm volatile("s_waitcnt vmcnt(0)" ::: "memory");
        __builtin_amdgcn_s_barrier(); asm volatile("" ::: "memory");
        f32x16 p0 = {}, p1 = {};
        { const LAS unsigned char* kb = shm + L_K + slot * SLOTB + hi * 1024 + r32 * 16;
#pragma unroll
          for (int d0 = 0; d0 < 4; ++d0) { const bf16x8 b0 = *(const LAS bf16x8*)(kb + d0 * 2048); const bf16x8 b1 = *(const LAS bf16x8*)(kb + d0 * 2048 + 512);
              p0 = __builtin_amdgcn_mfma_f32_32x32x16_bf16(b0, qr[d0], p0, 0, 0, 0); p1 = __builtin_amdgcn_mfma_f32_32x32x16_bf16(b1, qr[d0], p1, 0, 0, 0); } }
        const u32x2 mwv = *(const LAS u32x2*)(shm + L_MASK + wid * 2048 + (g & 1) * 1024 + (tq >> 1) * 512 + r32 * 16 + (tq & 1) * 8);
        if (64 * t + 63 + 112 >= q0 + wid * 32) {
#pragma unroll
            for (int r = 0; r < 16; ++r) { const int kv = 64 * t + crow(r, hi); int r0 = qpos - kv, r1 = r0 - 32;
                r0 = r0 < 0 ? 0 : (r0 > 127 ? 127 : r0); r1 = r1 < 0 ? 0 : (r1 > 127 ? 127 : r1);
                p0[r] += bt[r0]; p1[r] += bt[r1]; }
        }
        const float NEG = -INFINITY;
#pragma unroll
        for (int r = 0; r < 16; ++r) { const int bitp = crow(r, hi);
            if (!((mwv.x >> bitp) & 1u)) p0[r] = NEG;
            if (!((mwv.y >> bitp) & 1u)) p1[r] = NEG; }
        float rm = p0[0];
#pragma unroll
        for (int r = 1; r < 16; ++r) rm = __builtin_fmaxf(rm, p0[r]);
#pragma unroll
        for (int r = 0; r < 16; ++r) rm = __builtin_fmaxf(rm, p1[r]);
        rm = __builtin_fmaxf(rm, __shfl_xor(rm, 32));
        const float m_new = __builtin_fmaxf(m_run, rm);
        const float f = __builtin_amdgcn_exp2f(m_run - m_new);
        m_run = m_new;
        float sacc = 0.f;
#pragma unroll
        for (int r = 0; r < 16; ++r) { p0[r] = __builtin_amdgcn_exp2f(p0[r] - m_new); p1[r] = __builtin_amdgcn_exp2f(p1[r] - m_new); sacc += p0[r] + p1[r]; }
        l_run = l_run * f + sacc;
        if (hi == 0) wsf[r32] = f;
        asm volatile("s_waitcnt lgkmcnt(0)" ::: "memory");
#pragma unroll
        for (int d = 0; d < 2; ++d)
#pragma unroll
            for (int r = 0; r < 16; ++r) o[d][r] *= wsf[crow(r, hi)];
        u32x4 pw0, pw1, pw2, pw3;
        pw0 = (u32x4){cvtpk(p0[0], p0[1]), cvtpk(p0[2], p0[3]), cvtpk(p0[4], p0[5]), cvtpk(p0[6], p0[7])};
        pw1 = (u32x4){cvtpk(p0[8], p0[9]), cvtpk(p0[10], p0[11]), cvtpk(p0[12], p0[13]), cvtpk(p0[14], p0[15])};
        pw2 = (u32x4){cvtpk(p1[0], p1[1]), cvtpk(p1[2], p1[3]), cvtpk(p1[4], p1[5]), cvtpk(p1[6], p1[7])};
        pw3 = (u32x4){cvtpk(p1[8], p1[9]), cvtpk(p1[10], p1[11]), cvtpk(p1[12], p1[13]), cvtpk(p1[14], p1[15])};
        { const int vb = vb0 + slot * SLOTB;
#pragma unroll
          for (int d0 = 0; d0 < 2; ++d0) { s16x4 lo[4], hh[4];
#pragma unroll
              for (int ks = 0; ks < 4; ++ks) {
                  asm volatile("ds_read_b64_tr_b16 %0,%1 offset:%c2" : "=&v"(lo[ks]) : "v"(vb), "i"(d0 * 4096 + ks * 1024) : "memory");
                  asm volatile("ds_read_b64_tr_b16 %0,%1 offset:%c2" : "=&v"(hh[ks]) : "v"(vb), "i"(d0 * 4096 + ks * 1024 + 512) : "memory"); }
              asm volatile("s_waitcnt lgkmcnt(0)" ::: "memory"); __builtin_amdgcn_sched_barrier(0);
#define PKV(k) (bf16x8){lo[k][0], lo[k][1], lo[k][2], lo[k][3], hh[k][0], hh[k][1], hh[k][2], hh[k][3]}
              o[d0] = __builtin_amdgcn_mfma_f32_32x32x16_bf16(__builtin_bit_cast(bf16x8, pw0), PKV(0), o[d0], 0, 0, 0);
              o[d0] = __builtin_amdgcn_mfma_f32_32x32x16_bf16(__builtin_bit_cast(bf16x8, pw1), PKV(1), o[d0], 0, 0, 0);
              o[d0] = __builtin_amdgcn_mfma_f32_32x32x16_bf16(__builtin_bit_cast(bf16x8, pw2), PKV(2), o[d0], 0, 0, 0);
              o[d0] = __builtin_amdgcn_mfma_f32_32x32x16_bf16(__builtin_bit_cast(bf16x8, pw3), PKV(3), o[d0], 0, 0, 0);
#undef PKV
          } }
        asm volatile("s_waitcnt lgkmcnt(0)" ::: "memory");
        __builtin_amdgcn_s_barrier(); asm volatile("" ::: "memory");
    }
    l_run += __shfl_xor(l_run, 32);
    if (hi == 0) wsf[32 + r32] = l_run;
    asm volatile("s_waitcnt lgkmcnt(0)" ::: "memory");
    bf16_t* Ow = (bf16_t*)(F.ws + WS_R1) + (size_t)(b * SEQ + q0 + wid * 32) * 512 + h * 64;
    { LAS bf16_t* stg = (LAS bf16_t*)(shm + L_OST) + wid * 2048;
#pragma unroll
      for (int r = 0; r < 16; ++r) { const int orow = crow(r, hi); const float rl = __builtin_amdgcn_rcpf(wsf[32 + orow]);
#pragma unroll
          for (int d0 = 0; d0 < 2; ++d0) stg[orow * 64 + d0 * 32 + r32] = (bf16_t)f2bf(o[d0][r] * rl); }
      asm volatile("s_waitcnt lgkmcnt(0)" ::: "memory");
#pragma unroll
      for (int i = 0; i < 4; ++i) { const int row = i * 8 + (lane >> 3), chn = lane & 7; const u32x4 v = *(const LAS u32x4*)(stg + row * 64 + chn * 8); *(u32x4*)(Ow + (size_t)row * 512 + chn * 8) = v; } }
    asm volatile("s_waitcnt lgkmcnt(0)" ::: "memory");
#undef DMA_K
#undef DMA_V
#undef DMA_M
}

__device__ __forceinline__ void attn_phase(const Args& args, Frame& F) {
    const int v = F.vcu;
    for (int i = 0; i < 4; ++i) {
        for (int uu = v; uu < 256; uu += F.G) {
            const int bh = uu >> 2, s = uu & 3; const int qb = (i == 0) ? s : (i == 1) ? 7 - s : (i == 2) ? 8 + s : 15 - s;
            attn_unit(args, F, bh >> 3, bh & 7, qb);
        }
    }
}
}
#ifndef PROBE_NO_STATE
#define PROBE_NO_STATE 0
#endif
#ifndef PROBE_TINV_ID
#define PROBE_TINV_ID 0
#endif
namespace rk {
typedef __bf16 bf16x2_t __attribute__((ext_vector_type(2)));
__device__ __forceinline__ unsigned cvtpk(float lo, float hi) { f32x2 v = {lo, hi}; bf16x2_t b = __builtin_convertvector(v, bf16x2_t); return __builtin_bit_cast(unsigned, b); }
template <int S> __device__ __forceinline__ bf16x8 frag(const f32x16& x) {
    u32x4 o; o.x = cvtpk(x[8 * S + 0], x[8 * S + 1]); o.y = cvtpk(x[8 * S + 2], x[8 * S + 3]); o.z = cvtpk(x[8 * S + 4], x[8 * S + 5]); o.w = cvtpk(x[8 * S + 6], x[8 * S + 7]);
    return __builtin_bit_cast(bf16x8, o); }
template <int S> __device__ __forceinline__ void unfrag(f32x16& x, bf16x8 f) { const u32x4 o = __builtin_bit_cast(u32x4, f);
    x[8 * S + 0] = bf_lo(o.x); x[8 * S + 1] = bf_hi(o.x); x[8 * S + 2] = bf_lo(o.y); x[8 * S + 3] = bf_hi(o.y); x[8 * S + 4] = bf_lo(o.z); x[8 * S + 5] = bf_hi(o.z); x[8 * S + 6] = bf_lo(o.w); x[8 * S + 7] = bf_hi(o.w); }
#define RK_MF(a, b, c) __builtin_amdgcn_mfma_f32_32x32x16_bf16((a), (b), (c), 0, 0, 0)
__device__ __forceinline__ float dppf(float v, const int ctrl_is_const_dummy);
#define RK_DPP(v, ctrl, rmask, bc) __builtin_bit_cast(float, __builtin_amdgcn_update_dpp(0, __builtin_bit_cast(int, (v)), (ctrl), (rmask), 0xF, (bc)))
__device__ __forceinline__ float scan32(float v) {
#ifdef PROBE_SHFL_SCAN
    const int l32 = threadIdx.x & 31;
#pragma unroll
    for (int o = 1; o < 32; o <<= 1) { const float t = __shfl_up(v, o, 32); if (l32 >= o) v += t; }
    return v;
#endif
    v += RK_DPP(v, 0x111, 0xF, true); v += RK_DPP(v, 0x112, 0xF, true); v += RK_DPP(v, 0x114, 0xF, true); v += RK_DPP(v, 0x118, 0xF, true);
    v += RK_DPP(v, 0x142, 0xA, false);
    return v; }
__device__ __forceinline__ float ex2(float x) { return __builtin_amdgcn_exp2f(x); }
constexpr int PZ = 3600;
constexpr size_t SZ_G = 8192, SZ_H = 8192, SZ_Q = 4096, SZ_Y = 4096;
constexpr float L2E = 1.4426950408889634f;

__device__ __forceinline__ void mk_id(bf16x8 (&fId)[2], int r, int h) {
    asm volatile("" : "+v"(r), "+v"(h));
#pragma unroll
    for (int s = 0; s < 2; ++s) { unsigned short e8[8];
#pragma unroll
        for (int jj = 0; jj < 8; ++jj) e8[jj] = (16 * s + 8 * (jj >> 2) + 4 * h + (jj & 3) == r) ? (unsigned short)0x3F80 : (unsigned short)0;
        fId[s] = __builtin_bit_cast(bf16x8, (u32x4){(unsigned)e8[0] | ((unsigned)e8[1] << 16), (unsigned)e8[2] | ((unsigned)e8[3] << 16), (unsigned)e8[4] | ((unsigned)e8[5] << 16), (unsigned)e8[6] | ((unsigned)e8[7] << 16)}); }
}

__device__ __forceinline__ void load_params(const Args& args, Frame& F) {
    LAS float* pra = (LAS float*)(F.lds + LDS_PARA); LAS float* prb = (LAS float*)(F.lds + LDS_PARB);
    const float* mu = AIN(7); const float* w0 = AIN(8); const float* a0 = AIN(10); const float* kk = AIN(13); const float* ka = AIN(14); const float* rk = AIN(15);
    for (int i = F.tid; i < 4096; i += NTHR) { const int a = i >> 9, c = i & 511;
        const float v_ = a < 3 ? mu[a * 512 + c] : (a == 3 ? w0[c] : (a == 4 ? a0[c] : (a == 5 ? kk[c] : (a == 6 ? ka[c] : rk[c]))));
        if (a < 4) pra[c * 4 + a] = v_; else prb[c * 4 + a - 4] = v_; }
    __syncthreads();
}
struct ElemCtx { const LAS unsigned char* rowc; const LAS unsigned char* rowp; const bf16_t* DUt; const bf16_t* IUt; const LAS float* pra; const LAS float* prb; int hd, r, h; float inv; };
template <int MODE> __device__ __forceinline__ void r1_elem(const ElemCtx& C, int jt, bf16x8 (&o0)[2], bf16x8 (&o1)[2], bf16x8 (&o2)[2], bf16x8 (&o3)[2], float& bns, float& pcd) {
    const int r = C.r, h = C.h, hd = C.hd;
    f32x16 lw_ = f32x16{}, la_ = f32x16{};
#pragma unroll
    for (int ks = 0; ks < 4; ++ks) { const int k0 = 16 * ks + 8 * h;
        const bf16x8 bw = *(const LAS bf16x8*)(C.rowc + (1536 + k0) * 2), ba = *(const LAS bf16x8*)(C.rowc + (1600 + k0) * 2);
        const bf16x8 fa = *(const bf16x8*)(C.DUt + (size_t)(32 * jt + r) * 64 + k0), fi = *(const bf16x8*)(C.IUt + (size_t)(32 * jt + r) * 64 + k0);
        lw_ = RK_MF(fa, bw, lw_); la_ = RK_MF(fi, ba, la_); }
    float d = 0.f;
#pragma unroll
    for (int s = 0; s < 2; ++s) { float x0[8], x1[8], x2[8], x3[8];
#pragma unroll
        for (int g2 = 0; g2 < 2; ++g2) { const int g = 2 * s + g2, cj = hd * 64 + 32 * jt + 8 * g + 4 * h;
            float kc[4], kq[4], xc[4], xq[4];
            { const u32x2 a = *(const LAS u32x2*)(C.rowc + (512 + cj) * 2), p = *(const LAS u32x2*)(C.rowp + (512 + cj) * 2);
              kc[0] = bf_lo(a.x); kc[1] = bf_hi(a.x); kc[2] = bf_lo(a.y); kc[3] = bf_hi(a.y); kq[0] = bf_lo(p.x); kq[1] = bf_hi(p.x); kq[2] = bf_lo(p.y); kq[3] = bf_hi(p.y); }
            { const int xo = MODE ? 1024 : 0; const u32x2 a = *(const LAS u32x2*)(C.rowc + (xo + cj) * 2), p = *(const LAS u32x2*)(C.rowp + (xo + cj) * 2);
              xc[0] = bf_lo(a.x); xc[1] = bf_hi(a.x); xc[2] = bf_lo(a.y); xc[3] = bf_hi(a.y); xq[0] = bf_lo(p.x); xq[1] = bf_hi(p.x); xq[2] = bf_lo(p.y); xq[3] = bf_hi(p.y); }
            const LAS f32x4* ppa = (const LAS f32x4*)(C.pra + cj * 4); const LAS f32x4* ppb = (const LAS f32x4*)(C.prb + cj * 4);
#pragma unroll
            for (int q = 0; q < 4; ++q) { const int i = 4 * g + q, o = 4 * g2 + q;
                const f32x4 pa = ppa[q], pb = ppb[q];
                const float e_ = 0.6065306597126334f * fast_sigmoid(pa[3] + lw_[i]); const float L = scan32(e_);
                const float l0 = __builtin_bit_cast(float, __builtin_amdgcn_readlane(__builtin_bit_cast(int, L), 31)), l1 = __builtin_bit_cast(float, __builtin_amdgcn_readlane(__builtin_bit_cast(int, L), 63));
                const float Lend = h ? l1 : l0; if (i == 4 * (r >> 3) + (r & 3)) d = Lend;
                const float x_ = xc[q] + (MODE ? pa[2] : pa[0]) * (xq[q] - xc[q]), k_ = kc[q] + pa[1] * (kq[q] - kc[q]);
                const float ic = fast_sigmoid(pb[0] + la_[i]);
                const float kk = k_ * pb[1] * C.inv, kpn = k_ * (1.0f + (ic - 1.0f) * pb[2]), bv = kk * ic;
                if (MODE) { const float Qe = ex2(L2E * (L - Lend)); x0[o] = bv * Qe; x1[o] = kpn * Qe; x2[o] = x_; x3[o] = 0.f; }
                else { const float P = ex2(-L2E * L), Pi = ex2(L2E * L), Pm = ex2(-L2E * (L - e_)); bns += x_ * kpn * pb[3]; x0[o] = -kk * Pm; x1[o] = x_ * P; x2[o] = bv * Pi; x3[o] = kpn * Pi; } }
            asm volatile("" ::: "memory"); }
        o0[s] = __builtin_bit_cast(bf16x8, (u32x4){cvtpk(x0[0], x0[1]), cvtpk(x0[2], x0[3]), cvtpk(x0[4], x0[5]), cvtpk(x0[6], x0[7])});
        o1[s] = __builtin_bit_cast(bf16x8, (u32x4){cvtpk(x1[0], x1[1]), cvtpk(x1[2], x1[3]), cvtpk(x1[4], x1[5]), cvtpk(x1[6], x1[7])});
        o2[s] = __builtin_bit_cast(bf16x8, (u32x4){cvtpk(x2[0], x2[1]), cvtpk(x2[2], x2[3]), cvtpk(x2[4], x2[5]), cvtpk(x2[6], x2[7])});
        if (!MODE) o3[s] = __builtin_bit_cast(bf16x8, (u32x4){cvtpk(x3[0], x3[1]), cvtpk(x3[2], x3[3]), cvtpk(x3[4], x3[5]), cvtpk(x3[6], x3[7])}); }
    if (MODE) pcd = ex2(-L2E * d);
}


__device__ __forceinline__ void r1_unit(const Args& args, Frame& F, int b, int c) {
    LAS unsigned char* IMG = F.lds;
    const bf16_t* Z = (const bf16_t*)(F.ws + WS_Z);
    const int t0 = 32 * c; const size_t m0 = (size_t)b * SEQ + t0;
    const float* mu = AIN(7);
    int tid = F.tid; asm volatile("" : "+v"(tid));
    __syncthreads();
    for (int p = tid; p < 33 * 224; p += NTHR) { const int rr = p / 224, pc = p - rr * 224; u32x4 v = {0u, 0u, 0u, 0u};
        if (rr > 0 || t0 > 0) v = *(const u32x4*)(Z + (m0 + rr - 1) * ZW + ZR + 8 * pc);
        *(LAS u32x4*)(IMG + rr * PZ + 16 * pc) = v; }
    __syncthreads();
    { u32x4 actv[2];
#pragma unroll
      for (int i = 0; i < 2; ++i) { const int q = tid + NTHR * i, t = q >> 5, kp = q & 31;
          const u32x4 cw = *(const LAS u32x4*)(IMG + (t + 1) * PZ + (1536 + 8 * kp) * 2), pw = *(const LAS u32x4*)(IMG + t * PZ + (1536 + 8 * kp) * 2);
          const f32x4 m0v = *(const f32x4*)(mu + 1536 + 8 * kp), m1v = *(const f32x4*)(mu + 1536 + 8 * kp + 4);
          const unsigned cwa[4] = {cw.x, cw.y, cw.z, cw.w}, pwa[4] = {pw.x, pw.y, pw.z, pw.w}; float x[8];
#pragma unroll
          for (int j = 0; j < 4; ++j) { const float c0 = bf_lo(cwa[j]), c1 = bf_hi(cwa[j]), p0 = bf_lo(pwa[j]), p1 = bf_hi(pwa[j]);
              const float mu0 = j < 2 ? m0v[2 * j] : m1v[2 * j - 4], mu1 = j < 2 ? m0v[2 * j + 1] : m1v[2 * j - 3];
              x[2 * j] = c0 + mu0 * (p0 - c0); x[2 * j + 1] = c1 + mu1 * (p1 - c1); }
#pragma unroll
          for (int j = 0; j < 8; ++j) { if (kp < 8) { const float e2 = ex2(2.885390081777927f * x[j]); x[j] = 1.0f - 2.0f * __builtin_amdgcn_rcpf(e2 + 1.0f); } else if (kp >= 16) x[j] = fast_sigmoid(x[j]); }
          actv[i] = (u32x4){cvtpk(x[0], x[1]), cvtpk(x[2], x[3]), cvtpk(x[4], x[5]), cvtpk(x[6], x[7])}; }
      __syncthreads();
#pragma unroll
      for (int i = 0; i < 2; ++i) { const int q = tid + NTHR * i, t = q >> 5, kp = q & 31; *(LAS u32x4*)(IMG + (t + 1) * PZ + (1536 + 8 * kp) * 2) = actv[i]; }
      __syncthreads(); }
    const int hd = F.wave; int r = tid & 31, h = (tid >> 5) & 1;
    const LAS unsigned char* rowc = IMG + (r + 1) * PZ; const LAS unsigned char* rowp = IMG + r * PZ;
    const bf16_t* DUt = (const bf16_t*)(F.ws + WS_DUT) + (size_t)hd * 4096; const bf16_t* IUt = (const bf16_t*)(F.ws + WS_IUT) + (size_t)hd * 4096;
    const LAS float* pra = (const LAS float*)(F.lds + LDS_PARA); const LAS float* prb = (const LAS float*)(F.lds + LDS_PARB);
    float n2 = 0.f;
#pragma unroll
    for (int jt = 0; jt < 2; ++jt)
#pragma unroll
        for (int g = 0; g < 4; ++g) { const int cj = hd * 64 + 32 * jt + 8 * g + 4 * h;
            const u32x2 a = *(const LAS u32x2*)(rowc + (512 + cj) * 2), p = *(const LAS u32x2*)(rowp + (512 + cj) * 2);
            const float kc[4] = {bf_lo(a.x), bf_hi(a.x), bf_lo(a.y), bf_hi(a.y)}, kq[4] = {bf_lo(p.x), bf_hi(p.x), bf_lo(p.y), bf_hi(p.y)};
            #pragma unroll
            for (int q = 0; q < 4; ++q) { const float muk = pra[(cj + q) * 4 + 1], kkp = prb[(cj + q) * 4 + 1]; const float k_ = kc[q] + muk * (kq[q] - kc[q]); const float kk_ = k_ * kkp; n2 += kk_ * kk_; } }
    n2 += __shfl_xor(n2, 32);
    const float inv = 1.0f / __builtin_fmaxf(sqrtf(n2), 1e-12f);
    float pcd[2] = {0.f, 0.f};
    float bns = 0.f;
    const ElemCtx EC{rowc, rowp, DUt, IUt, pra, prb, hd, r, h, inv};
    f32x16 Aab = f32x16{}, Aak = f32x16{}, Arb = f32x16{}, Ark = f32x16{};
    bf16x8 fRt[2][2], tAt[2][2];
    { bf16x8 fId[2]; mk_id(fId, r, h);
#pragma unroll
    for (int jt = 0; jt < 2; ++jt) { bf16x8 fA[2], fB[2], fK[2]; float pd_ = 0.f;
        r1_elem<0>(EC, jt, fA, fRt[jt], fB, fK, bns, pd_);
        const bf16x8 fA0 = fA[0], fA1 = fA[1], fB0 = fB[0], fB1 = fB[1], fK0 = fK[0], fK1 = fK[1];
        Aab = RK_MF(fB0, fA0, Aab); Aab = RK_MF(fB1, fA1, Aab); Aak = RK_MF(fK0, fA0, Aak); Aak = RK_MF(fK1, fA1, Aak);
        Arb = RK_MF(fB0, fRt[jt][0], Arb); Arb = RK_MF(fB1, fRt[jt][1], Arb); Ark = RK_MF(fK0, fRt[jt][0], Ark); Ark = RK_MF(fK1, fRt[jt][1], Ark);
        { f32x16 t_ = f32x16{}; t_ = RK_MF(fA0, fId[0], t_); t_ = RK_MF(fA1, fId[1], t_); tAt[jt][0] = frag<0>(t_); tAt[jt][1] = frag<1>(t_); } } }
    bns += __shfl_xor(bns, 32);
    if (h == 0) ((float*)(F.ws + WS_TOPW))[(m0 + r) * 8 + hd] = bns;
    LAS unsigned char* stash = IMG + (1 + ((tid & 63) >> 3)) * PZ + hd * 128 + (tid & 7) * 16;
#pragma unroll
    for (int p = 0; p < 4; ++p) *(LAS u32x4*)(stash + 8 * p * PZ) = __builtin_bit_cast(u32x4, fRt[p >> 1][p & 1]);
#pragma unroll
    for (int i = 0; i < 16; ++i) { const int s = 8 * (i >> 2) + 4 * h + (i & 3);
        if (!(s < r)) { Aab[i] = 0.f; Aak[i] = 0.f; } if (!(s <= r)) { Arb[i] = 0.f; Ark[i] = 0.f; } }
    const bf16x8 fAak[2] = {frag<0>(Aak), frag<1>(Aak)}, fArb[2] = {frag<0>(Arb), frag<1>(Arb)}, fArk[2] = {frag<0>(Ark), frag<1>(Ark)};
    bf16x8 fT[2];
    asm volatile("" ::: "memory"); __builtin_amdgcn_sched_barrier(0);
    { float T[32];
#pragma unroll
      for (int s = 31; s >= 0; --s) { float acc = (r == s) ? 1.0f : 0.f; const int is = 4 * (s >> 3) + (s & 3), hs = (s >> 2) & 1;
          const float acol_ = Aab[is]; const int acol_i = __float_as_int(acol_);
#pragma unroll
          for (int u = s + 1; u < (PROBE_TINV_ID ? 0 : 32); ++u) { int sv_; asm volatile("v_readlane_b32 %0, %1, %2" : "=s"(sv_) : "v"(acol_i), "n"(u + 32 * hs)); acc = __builtin_fmaf(T[u], __int_as_float(sv_), acc); }
          T[s] = acc; __builtin_amdgcn_sched_barrier(0); }
#pragma unroll
      for (int s = 0; s < 2; ++s) { float e8[8];
#pragma unroll
          for (int jj = 0; jj < 8; ++jj) { const int i0 = 16 * s + 8 * (jj >> 2) + (jj & 3); float ta = T[i0], tb = T[i0 + 4]; asm volatile("" : "+v"(ta), "+v"(tb)); e8[jj] = h ? tb : ta; }
          fT[s] = __builtin_bit_cast(bf16x8, (u32x4){cvtpk(e8[0], e8[1]), cvtpk(e8[2], e8[3]), cvtpk(e8[4], e8[5]), cvtpk(e8[6], e8[7])}); } }
    asm volatile("" ::: "memory"); __builtin_amdgcn_sched_barrier(0);
    const size_t uid = ((size_t)(b * 8 + hd) * 128 + c);
    unsigned char* gG = F.ws + WS_R0 + uid * SZ_G; unsigned char* gH = F.ws + WS_R2 + uid * SZ_H; unsigned char* gQ = F.ws + WS_H0 + uid * SZ_Q; unsigned char* gY = F.ws + WS_H1 + uid * SZ_Y;
#define RK_ST(base, piece, f) (*(u32x4*)((base) + (piece) * 1024 + (tid & 63) * 16) = __builtin_bit_cast(u32x4, (f)))
    bf16x8 fWt[2][2];
#pragma unroll
    for (int jt = 0; jt < 2; ++jt) { f32x16 w_ = f32x16{}; w_ = RK_MF(fT[0], tAt[jt][0], w_); w_ = RK_MF(fT[1], tAt[jt][1], w_); fWt[jt][0] = frag<0>(w_); fWt[jt][1] = frag<1>(w_);
        f32x16 q_; unfrag<0>(q_, __builtin_bit_cast(bf16x8, *(const LAS u32x4*)(stash + 8 * (2 * jt) * PZ))); unfrag<1>(q_, __builtin_bit_cast(bf16x8, *(const LAS u32x4*)(stash + 8 * (2 * jt + 1) * PZ)));
        q_ = RK_MF(fWt[jt][0], fArb[0], q_); q_ = RK_MF(fWt[jt][1], fArb[1], q_); RK_ST(gQ, 2 * jt, frag<0>(q_)); RK_ST(gQ, 2 * jt + 1, frag<1>(q_)); }
    bf16x8 tBh[2][2], tKh[2][2], tV[2][2];
    { bf16x8 fId[2]; mk_id(fId, r, h);
#pragma unroll
    for (int jt = 0; jt < 2; ++jt) { bf16x8 fBh[2], fKh[2], fV[2], fdum[2]; float bdum = 0.f;
        r1_elem<1>(EC, jt, fBh, fKh, fV, fdum, bdum, pcd[jt]);
        { f32x16 t_ = f32x16{}; t_ = RK_MF(fBh[0], fId[0], t_); t_ = RK_MF(fBh[1], fId[1], t_); tBh[jt][0] = frag<0>(t_); tBh[jt][1] = frag<1>(t_); }
        { f32x16 t_ = f32x16{}; t_ = RK_MF(fKh[0], fId[0], t_); t_ = RK_MF(fKh[1], fId[1], t_); tKh[jt][0] = frag<0>(t_); tKh[jt][1] = frag<1>(t_); }
        { f32x16 t_ = f32x16{}; t_ = RK_MF(fV[0], fId[0], t_); t_ = RK_MF(fV[1], fId[1], t_); tV[jt][0] = frag<0>(t_); tV[jt][1] = frag<1>(t_); } } }
    bf16x8 fUt[2][2];
#pragma unroll
    for (int it = 0; it < 2; ++it) { f32x16 av = f32x16{}; av = RK_MF(fAak[0], tV[it][0], av); av = RK_MF(fAak[1], tV[it][1], av);
        const bf16x8 fav0 = frag<0>(av), fav1 = frag<1>(av); f32x16 u_ = f32x16{}; u_ = RK_MF(fT[0], fav0, u_); u_ = RK_MF(fT[1], fav1, u_); fUt[it][0] = frag<0>(u_); fUt[it][1] = frag<1>(u_); }
#pragma unroll
    for (int it = 0; it < 2; ++it) { f32x16 y_ = f32x16{}; y_ = RK_MF(fUt[it][0], fArb[0], y_); y_ = RK_MF(fUt[it][1], fArb[1], y_); y_ = RK_MF(tV[it][0], fArk[0], y_); y_ = RK_MF(tV[it][1], fArk[1], y_);
        RK_ST(gY, 2 * it, frag<0>(y_)); RK_ST(gY, 2 * it + 1, frag<1>(y_)); }
#pragma unroll
    for (int jt = 0; jt < 2; ++jt)
#pragma unroll
        for (int j2 = 0; j2 < 2; ++j2) { f32x16 g_ = f32x16{}; g_ = RK_MF(fWt[jt][0], tBh[j2][0], g_); g_ = RK_MF(fWt[jt][1], tBh[j2][1], g_);
            if (jt == j2) {
#pragma unroll
                for (int i = 0; i < 16; ++i) if (i == 4 * (r >> 3) + (r & 3) && h == ((r >> 2) & 1)) g_[i] += pcd[jt]; }
            RK_ST(gG, 2 * (jt * 2 + j2), frag<0>(g_)); RK_ST(gG, 2 * (jt * 2 + j2) + 1, frag<1>(g_)); }
#pragma unroll
    for (int j2 = 0; j2 < 2; ++j2)
#pragma unroll
        for (int it = 0; it < 2; ++it) { f32x16 h_ = f32x16{}; h_ = RK_MF(tBh[j2][0], fUt[it][0], h_); h_ = RK_MF(tBh[j2][1], fUt[it][1], h_); h_ = RK_MF(tKh[j2][0], tV[it][0], h_); h_ = RK_MF(tKh[j2][1], tV[it][1], h_);
            RK_ST(gH, 2 * (j2 * 2 + it), frag<0>(h_)); RK_ST(gH, 2 * (j2 * 2 + it) + 1, frag<1>(h_)); }
}

__device__ __forceinline__ void r2_task(const Args& args, Frame& F, int task) {
    const int bh = task >> 1, it = task & 1;
    f32x16 St[2]; St[0] = f32x16{}; St[1] = f32x16{};
    const unsigned char* gG0 = F.ws + WS_R0 + (size_t)bh * 128 * SZ_G + F.lane * 16; unsigned char* gH0 = F.ws + WS_R2 + (size_t)bh * 128 * SZ_H + F.lane * 16;
    bf16x8 fG[2][2][2], fH[2][2], nG[2][2][2], nH[2][2];
#define R2_LOAD(G_, H_, c_) do { _Pragma("unroll") for (int jt = 0; jt < 2; ++jt) _Pragma("unroll") for (int j2 = 0; j2 < 2; ++j2) _Pragma("unroll") for (int s = 0; s < 2; ++s) \
            G_[jt][j2][s] = __builtin_bit_cast(bf16x8, *(const u32x4*)(gG0 + (size_t)(c_) * SZ_G + (2 * (jt * 2 + j2) + s) * 1024)); \
        _Pragma("unroll") for (int j2 = 0; j2 < 2; ++j2) _Pragma("unroll") for (int s = 0; s < 2; ++s) H_[j2][s] = __builtin_bit_cast(bf16x8, *(const u32x4*)(gH0 + (size_t)(c_) * SZ_H + (2 * (j2 * 2 + it) + s) * 1024)); } while (0)
    R2_LOAD(fG, fH, 0);
    for (int c = 0; c < 128; ++c) {
        const int cn = c + 1 < 128 ? c + 1 : c;
        R2_LOAD(nG, nH, cn);
        const bf16x8 fS[2][2] = {{frag<0>(St[0]), frag<1>(St[0])}, {frag<0>(St[1]), frag<1>(St[1])}};
        f32x16 nw[2];
#pragma unroll
        for (int j2 = 0; j2 < 2; ++j2) { unfrag<0>(nw[j2], fH[j2][0]); unfrag<1>(nw[j2], fH[j2][1]);
#pragma unroll
            for (int jt = 0; jt < 2; ++jt) { nw[j2] = RK_MF(fG[jt][j2][0], fS[jt][0], nw[j2]); nw[j2] = RK_MF(fG[jt][j2][1], fS[jt][1], nw[j2]); } }
#pragma unroll
        for (int jt = 0; jt < 2; ++jt)
#pragma unroll
            for (int s = 0; s < 2; ++s) *(u32x4*)(gH0 + (size_t)c * SZ_H + (2 * (jt * 2 + it) + s) * 1024) = __builtin_bit_cast(u32x4, fS[jt][s]);
        St[0] = nw[0]; St[1] = nw[1];
#pragma unroll
        for (int jt = 0; jt < 2; ++jt)
#pragma unroll
            for (int j2 = 0; j2 < 2; ++j2)
#pragma unroll
                for (int s = 0; s < 2; ++s) fG[jt][j2][s] = nG[jt][j2][s];
#pragma unroll
        for (int j2 = 0; j2 < 2; ++j2)
#pragma unroll
            for (int s = 0; s < 2; ++s) fH[j2][s] = nH[j2][s];
    }
#undef R2_LOAD
}

constexpr int PV2 = 1296;
__device__ __forceinline__ void r3_unit(const Args& args, Frame& F, int b, int c) {
    LAS unsigned char* IMG = F.lds;
    const bf16_t* Z = (const bf16_t*)(F.ws + WS_Z);
    const int t0 = 32 * c; const size_t m0 = (size_t)b * SEQ + t0;
    const float* mu = AIN(7);
    int tid = F.tid; asm volatile("" : "+v"(tid));
    __syncthreads();
    for (int p = tid; p < 33 * 80; p += NTHR) { const int rr = p / 80, pc = p - rr * 80; u32x4 v = {0u, 0u, 0u, 0u};
        const int col = pc < 64 ? ZR_V + 8 * pc : ZR_GD + 8 * (pc - 64);
        if (rr > 0 || t0 > 0) v = *(const u32x4*)(Z + (m0 + rr - 1) * ZW + col);
        *(LAS u32x4*)(IMG + rr * PV2 + 16 * pc) = v; }
    __syncthreads();
    { const int t = tid >> 4, kp = tid & 15;
      const u32x4 cw = *(const LAS u32x4*)(IMG + (t + 1) * PV2 + 1024 + 16 * kp), pw = *(const LAS u32x4*)(IMG + t * PV2 + 1024 + 16 * kp);
      const f32x4 m0v = *(const f32x4*)(mu + 1664 + 8 * kp), m1v = *(const f32x4*)(mu + 1664 + 8 * kp + 4);
      const unsigned cwa[4] = {cw.x, cw.y, cw.z, cw.w}, pwa[4] = {pw.x, pw.y, pw.z, pw.w}; float x[8];
#pragma unroll
      for (int j = 0; j < 4; ++j) { const float c0 = bf_lo(cwa[j]), c1 = bf_hi(cwa[j]), p0 = bf_lo(pwa[j]), p1 = bf_hi(pwa[j]);
          const float mu0 = j < 2 ? m0v[2 * j] : m1v[2 * j - 4], mu1 = j < 2 ? m0v[2 * j + 1] : m1v[2 * j - 3];
          x[2 * j] = fast_sigmoid(c0 + mu0 * (p0 - c0)); x[2 * j + 1] = fast_sigmoid(c1 + mu1 * (p1 - c1)); }
      const u32x4 o = {cvtpk(x[0], x[1]), cvtpk(x[2], x[3]), cvtpk(x[4], x[5]), cvtpk(x[6], x[7])};
      __syncthreads();
      *(LAS u32x4*)(IMG + (t + 1) * PV2 + 1024 + 16 * kp) = o;
      __syncthreads(); }
    const int hd = F.wave; int r = tid & 31, h = (tid >> 5) & 1;
    const LAS unsigned char* rowc = IMG + (r + 1) * PV2; const LAS unsigned char* rowp = IMG + r * PV2;
    const size_t uid = ((size_t)(b * 8 + hd) * 128 + c);
    const unsigned char* gS = F.ws + WS_R2 + uid * SZ_H; const unsigned char* gQ = F.ws + WS_H0 + uid * SZ_Q; const unsigned char* gY = F.ws + WS_H1 + uid * SZ_Y;
#define RK_LD(base, piece) __builtin_bit_cast(bf16x8, *(const u32x4*)((base) + (piece) * 1024 + (tid & 63) * 16))
    f32x16 gl[2]; gl[0] = f32x16{}; gl[1] = f32x16{};
    { const bf16_t* GUt = (const bf16_t*)(F.ws + WS_GUT) + (size_t)hd * 64 * 128;
#pragma unroll
      for (int ks = 0; ks < 8; ++ks) { const int k0 = 16 * ks + 8 * h; const bf16x8 bg = *(const LAS bf16x8*)(rowc + 1024 + k0 * 2);
#pragma unroll
          for (int it = 0; it < 2; ++it) { const bf16x8 fg = *(const bf16x8*)(GUt + (size_t)(32 * it + r) * 128 + k0); gl[it] = RK_MF(fg, bg, gl[it]); } } }
    f32x16 Y[2];
    { const bf16x8 fQ[2][2] = {{RK_LD(gQ, 0), RK_LD(gQ, 1)}, {RK_LD(gQ, 2), RK_LD(gQ, 3)}};
#pragma unroll
      for (int it = 0; it < 2; ++it) { unfrag<0>(Y[it], RK_LD(gY, 2 * it)); unfrag<1>(Y[it], RK_LD(gY, 2 * it + 1));
#pragma unroll
          for (int jt = 0; jt < 2; ++jt) { if (PROBE_NO_STATE) continue; Y[it] = RK_MF(RK_LD(gS, 2 * (jt * 2 + it)), fQ[jt][0], Y[it]); Y[it] = RK_MF(RK_LD(gS, 2 * (jt * 2 + it) + 1), fQ[jt][1], Y[it]); } } }
    float s1 = 0.f;
#pragma unroll
    for (int it = 0; it < 2; ++it)
#pragma unroll
        for (int i = 0; i < 16; ++i) s1 += Y[it][i];
    s1 += __shfl_xor(s1, 32); const float mean = s1 * (1.0f / 64.0f); float s2 = 0.f;
#pragma unroll
    for (int it = 0; it < 2; ++it)
#pragma unroll
        for (int i = 0; i < 16; ++i) { const float d = Y[it][i] - mean; s2 += d * d; }
    s2 += __shfl_xor(s2, 32); const float rstd = 1.0f / sqrtf(s2 * (1.0f / 64.0f) + GN_EPS);
    const float bn = ((const float*)(F.ws + WS_TOPW))[(m0 + r) * 8 + hd];
    LAS unsigned char* stg = F.lds + 49152 + F.wave * 4608;
#pragma unroll
    for (int it = 0; it < 2; ++it)
#pragma unroll
        for (int g = 0; g < 4; ++g) { const int cl = 32 * it + 8 * g + 4 * h, cj = hd * 64 + cl;
            const u32x2 a = *(const LAS u32x2*)(rowc + cj * 2), p = *(const LAS u32x2*)(rowp + cj * 2);
            const float vc[4] = {bf_lo(a.x), bf_hi(a.x), bf_lo(a.y), bf_hi(a.y)}, vq[4] = {bf_lo(p.x), bf_hi(p.x), bf_lo(p.y), bf_hi(p.y)};
            const f32x4 muv = *(const f32x4*)(mu + 1024 + cj), lg = *(const f32x4*)(AIN(16) + cj), lb = *(const f32x4*)(AIN(17) + cj);
            float o[4];
#pragma unroll
            for (int q = 0; q < 4; ++q) { const int i = 4 * g + q; const float v_ = vc[q] + muv[q] * (vq[q] - vc[q]);
                o[q] = ((Y[it][i] - mean) * rstd * lg[q] + lb[q] + bn * v_) * gl[it][i]; }
            *(LAS u32x2*)(stg + r * 144 + cl * 2) = (u32x2){cvtpk(o[0], o[1]), cvtpk(o[2], o[3])}; }
    asm volatile("s_waitcnt lgkmcnt(0)" ::: "memory");
    bf16_t* OUT = (bf16_t*)(F.ws + WS_R0) + m0 * 512 + hd * 64;
#pragma unroll
    for (int i = 0; i < 4; ++i) { const int row = i * 8 + ((tid & 63) >> 3), chn = tid & 7; const u32x4 v = *(const LAS u32x4*)(stg + row * 144 + chn * 16); *(u32x4*)(OUT + (size_t)row * 512 + chn * 8) = v; }
#undef RK_LD
#undef RK_ST
}
}
__device__ __forceinline__ void route_phase(const Args& args, Frame& F) {
    LAS unsigned* lcnt = (LAS unsigned*)(F.lds);
    if (F.tid < 128) lcnt[F.tid] = 0u;
    __syncthreads();
    const float* LG = (const float*)(F.ws + WS_LOGIT); int* TE = (int*)(F.ws + WS_TOPE); float* TW = (float*)(F.ws + WS_TOPW);
    const int lane = F.lane; const float bias = AIN(23)[lane];
    for (int tok = F.gw; tok < M; tok += F.NGW) {
        const float lg = LG[(size_t)tok * 64 + lane];
        const float s = 1.0f / (1.0f + expf(-lg));
        const float c = s + bias;
        const unsigned long long kc = ((unsigned long long)ord_key(c) << 6) | (unsigned)(63 - lane);
        int rk = 0;
#pragma unroll 1
        for (int d = 1; d < 8; ++d) { const unsigned long long o = __shfl_xor(kc, d); rk += (o > kc) ? 1 : 0; }
        float gs = rk < 2 ? c : 0.f;
        gs += __shfl_xor(gs, 1); gs += __shfl_xor(gs, 2); gs += __shfl_xor(gs, 4);
        const int grp = lane >> 3;
        const unsigned long long kg = ((unsigned long long)ord_key(gs) << 6) | (unsigned)(63 - grp);
        int grk = 0;
#pragma unroll 1
        for (int d = 1; d < 8; ++d) { const unsigned long long o = __shfl_xor(kg, 8 * d); grk += (o > kg) ? 1 : 0; }
        const unsigned long long km = grk < 4 ? kc : (unsigned long long)(63 - lane);
        int erk = 0;
#pragma unroll 1
        for (int d = 1; d < 64; ++d) { const unsigned long long o = __shfl_xor(km, d); erk += (o > km) ? 1 : 0; }
        const bool sel = erk < 8;
        const float ssum = wave_sum(sel ? s : 0.f);
        if (sel) { TE[(size_t)tok * 8 + erk] = lane; TW[(size_t)tok * 8 + erk] = s / ssum * 2.5f; atomicAdd((unsigned*)&lcnt[(tok >= M / 2 ? 64 : 0) + lane], 1u); }
    }
    __syncthreads();
    if (F.tid < 128 && lcnt[F.tid]) atomicAdd(F.ctl + CW_CNT + F.tid, lcnt[F.tid]);
    __syncthreads();
}

struct MoeTab { int ntiles0, ntiles; };
__device__ __forceinline__ MoeTab build_tiles(const Args& args, Frame& F) {
    LAS unsigned* tab = (LAS unsigned*)(F.lds + LDS_TILETAB);
    LAS unsigned* offs = tab + 2432; LAS unsigned* tpre = tab + 2560;
    if (F.tid == 0) { unsigned o = 0, tp = 0;
        for (int l = 0; l < 128; ++l) { const unsigned c = __hip_atomic_load(F.ctl + CW_CNT + l, RLX_AGENT); offs[l] = o; tpre[l] = tp; o += c; tp += (c + 255u) >> 8; }
        tpre[128] = tp; }
    __syncthreads();
    if (F.tid < 128) { const int l = F.tid; const unsigned c = __hip_atomic_load(F.ctl + CW_CNT + l, RLX_AGENT); const unsigned o = offs[l], t0 = tpre[l], nt = (c + 255u) >> 8;
        for (unsigned i = 0; i < nt; ++i) { const unsigned rows = (c - 256u * i) < 256u ? (c - 256u * i) : 256u; tab[2 * (t0 + i)] = (o + 256u * i) | ((unsigned)(l & 63) << 20); tab[2 * (t0 + i) + 1] = rows; } }
    __syncthreads();
    MoeTab r; r.ntiles0 = (int)tpre[64]; r.ntiles = (int)tpre[128]; return r;
}
__device__ __forceinline__ void scatter_phase(const Args& args, Frame& F) {
    LAS unsigned* tab = (LAS unsigned*)(F.lds + LDS_TILETAB); LAS unsigned* offs = tab + 2432;
    LAS unsigned* lcnt = (LAS unsigned*)(F.lds); LAS unsigned* lbase = lcnt + 128;
    const int* TE = (const int*)(F.ws + WS_TOPE); const float* TW = (const float*)(F.ws + WS_TOPW);
    int* ST = (int*)(F.ws + WS_STOK); float* SW = (float*)(F.ws + WS_SW);
    for (int blk = blockIdx.x; blk < M / 128; blk += F.G) {
        if (F.tid < 128) lcnt[F.tid] = 0u;
        __syncthreads();
        const int tok0 = blk * 128, hf = tok0 >= M / 2 ? 64 : 0;
        int lst[2]; unsigned rnk[2];
#pragma unroll
        for (int i = 0; i < 2; ++i) { const int p = F.tid + 512 * i; lst[i] = hf + TE[(size_t)tok0 * 8 + p]; rnk[i] = atomicAdd((unsigned*)&lcnt[lst[i]], 1u); }
        __syncthreads();
        if (F.tid < 128) lbase[F.tid] = lcnt[F.tid] ? atomicAdd(F.ctl + CW_CUR + F.tid, lcnt[F.tid]) : 0u;
        __syncthreads();
#pragma unroll
        for (int i = 0; i < 2; ++i) { const int p = F.tid + 512 * i; const unsigned pos = offs[lst[i]] + lbase[lst[i]] + rnk[i];
            ST[pos] = tok0 * 8 + p; SW[pos] = TW[(size_t)tok0 * 8 + p]; }
        __syncthreads();
    }
}

__device__ __forceinline__ void final_rows(const Args& args, Frame& F, int row_lo, int row_hi, int tokbase) {
    const unsigned char* SL = (const unsigned char*)(F.ws + WS_SLOT);
    const int cA = 256 * (F.lane >> 4) + 32 * ((F.lane >> 2) & 3) + 8 * (F.lane & 3), cB = cA + 128;
    for (int blk = F.gw; blk < (row_hi - row_lo) / 16; blk += F.NGW) {
        const int r0 = row_lo + blk * 16, b = r0 / SEQ;
        const float* g2 = (const float*)(F.ws + WS_MOD) + b * 6144 + 5120; const float* fgp = AIN(30);
        f32x4 gv[4], fg[4];
#pragma unroll
        for (int j = 0; j < 4; ++j) { const int c = (j < 2 ? cA : cB) + 4 * (j & 1); gv[j] = *(const f32x4*)(g2 + c) * (1.0f / SLOT_SCALE); fg[j] = *(const f32x4*)(fgp + c); }
        for (int r = 0; r < 16; ++r) { const size_t m = (size_t)(r0 + r);
            f32x4 acc[4];
#pragma unroll
            for (int j = 0; j < 4; ++j) acc[j] = (f32x4){0.f, 0.f, 0.f, 0.f};
            const unsigned char* sp = SL + (m - tokbase) * NSLOT * D + 16 * F.lane;
            u32x4 w[NSLOT];
#pragma unroll
            for (int k = 0; k < NSLOT; ++k) w[k] = *(const u32x4*)(sp + (size_t)k * D);
#pragma unroll
            for (int k = 0; k < NSLOT; ++k) { const unsigned ww[4] = {w[k].x, w[k].y, w[k].z, w[k].w};
#pragma unroll
                for (int j = 0; j < 4; ++j) { const f32x2 a = __builtin_amdgcn_cvt_pk_f32_fp8((int)ww[j], false), c = __builtin_amdgcn_cvt_pk_f32_fp8((int)ww[j], true); acc[j] += (f32x4){a.x, a.y, c.x, c.y}; } }
            float* xr = F.out + m * D; f32x4 v[4]; float s = 0.f;
#pragma unroll
            for (int j = 0; j < 4; ++j) { const int c = (j < 2 ? cA : cB) + 4 * (j & 1); v[j] = *(const f32x4*)(xr + c) + gv[j] * acc[j]; s += (v[j].x * v[j].x + v[j].y * v[j].y) + (v[j].z * v[j].z + v[j].w * v[j].w); }
            const float rstd = 1.0f / sqrtf(wave_sum(s) * (1.0f / D) + RMS_EPS);
#pragma unroll
            for (int j = 0; j < 4; ++j) { const int c = (j < 2 ? cA : cB) + 4 * (j & 1); *(f32x4*)(xr + c) = v[j] * rstd * fg[j]; }
        }
    }
}
constexpr int N_PHASES = 15;
#ifndef PROBE_ATT_SCALE
#define PROBE_ATT_SCALE 1.0f
#endif
#ifndef PROBE_IDX_REP
#define PROBE_IDX_REP 1
#endif
#ifndef PROBE_RW_SCALE
#define PROBE_RW_SCALE 1.0f
#endif

__global__ void __launch_bounds__(NTHR, 2) fwd_kernel(Args args) {
    extern __shared__ __attribute__((aligned(16))) unsigned char lds_raw[];
    Frame F;
    F.lds = (LAS unsigned char*)lds_raw;
    F.MISC = (volatile LAS unsigned*)(F.lds + MISC_OFF);
    F.tid = threadIdx.x; F.lane = F.tid & 63; F.wave = __builtin_amdgcn_readfirstlane(F.tid >> 6);
    F.G = gridDim.x; { const int bx = blockIdx.x; F.vcu = (F.G % 8 == 0) ? (bx % 8) * (F.G / 8) + bx / 8 : bx; }
    F.gw = blockIdx.x * NWAVES + F.wave; F.NGW = F.G * NWAVES;
    F.ws = args.ws; F.out = args.out; F.ctl = (unsigned*)(args.ws + WS_CTL);
    for (int u = F.tid; u < (LDS_BYTES - LDSCTL_OFF) / 4; u += NTHR) ((LAS unsigned*)(F.lds + LDSCTL_OFF))[u] = 0u;
    __syncthreads();
    if (F.tid == 0) {
#pragma unroll
        for (int i = 0; i < 31; ++i) *(LAS unsigned long long*)(F.lds + LDS_PTAB + 8 * i) = (unsigned long long)args.in[i];
        *(LAS unsigned long long*)(F.lds + LDS_PTAB + 8 * 31) = (unsigned long long)args.out; *(LAS unsigned long long*)(F.lds + LDS_PTAB + 8 * 32) = (unsigned long long)args.ws; }
    __syncthreads();
    XcdBarrier bar = xcd_barrier_post(F.ctl + CW_BAR + args.li * XCD_BAR_WORDS, F.MISC + 8);
    const int lo = args.ph_lo, hi = args.ph_hi;
#ifndef PHASE_MASK
#define PHASE_MASK 0xFFFFFFFFu
#endif
#define IN(k) ((((PHASE_MASK) >> (k)) & 1u) && lo <= (k) && (k) < hi)
#define PB() do { F.ws = (unsigned char*)ain_ptr(F.lds, 32); F.out = (float*)ain_ptr(F.lds, 31); F.ctl = (unsigned*)(F.ws + WS_CTL); \
        F.lane = (int)__builtin_amdgcn_mbcnt_hi(~0u, __builtin_amdgcn_mbcnt_lo(~0u, 0u)); F.tid = F.wave * 64 + F.lane; } while (0)
#define ZB ((bf16_t*)(F.ws + WS_Z))
#define GATES ((bf16_t*)F.out)
#define MOD ((const float*)(F.ws + WS_MOD))
#define SEAM(k) do { if (IN(k) && IN((k) + 1)) xcd_barrier(bar); } while (0)

    if (IN(0)) { PB(); p0_prologue(args, F); } SEAM(0);
    if (IN(1)) { PB(); norm_mod_rows(args, F, AIN(0), AIN(4), 0, 1024, nullptr, F.ws + WS_H0); } SEAM(1);
    if (IN(2)) { PB(); pg8::StaticOrder S; S.init(M, NIN, F.G, (int)blockIdx.x); pg8::DenseSrcT<1> G{F.ws + WS_H0, F.ws + WS_WIN, 1024};
        EpiInProj E{ZB, GATES}; pg8::gemm_phase<EpiInProj, pg8::StaticOrder, pg8::DenseSrcT<1>>(F.lds, 1024, S, G, E); } SEAM(2);
    if (IN(3)) { PB(); rk::load_params(args, F); for (int u = blockIdx.x; u < 1024; u += F.G) rk::r1_unit(args, F, u >> 7, u & 127); __syncthreads(); } SEAM(3);
    if (IN(4)) { PB();
        if (blockIdx.x < 16) rk::r2_task(args, F, blockIdx.x * 8 + F.wave);
#pragma unroll 1
        for (int rep = 0; rep < PROBE_IDX_REP; ++rep)
        for (;;) {
            __syncthreads();
            if (F.tid == 0) F.MISC[12] = atomicAdd(F.ctl + CW_Q + rep, 1u);
            __syncthreads();
            const int u = (int)F.MISC[12];
            if (u >= 2048) break;
            indexer_unit(args, F, u & 7, (255 - (u >> 3)) * 16);
        } } SEAM(4);
    if (IN(5)) { PB(); for (int u = blockIdx.x; u < 1024; u += F.G) rk::r3_unit(args, F, u >> 7, u & 127); __syncthreads();
        for (int i = 0; i < 4; ++i) for (int uu = F.vcu; uu < 256; uu += F.G) { const int bh = uu >> 2, s = uu & 3; const int qb = (i == 0) ? s : (i == 1) ? 7 - s : (i == 2) ? 8 + s : 15 - s;
            att::attn_unit(args, F, bh >> 3, bh & 7, qb); } __syncthreads(); } SEAM(5);
    if (IN(6)) { PB(); pg8::StaticOrder S; S.init(M, D, F.G, (int)blockIdx.x);
        { pg8::DenseSrc G{F.ws + WS_R1, F.ws + WS_WA, 512}; EpiMerge<0> E{(bf16_t*)(F.ws + WS_R2), F.ws + WS_H0, GATES, PROBE_ATT_SCALE}; pg8::gemm_phase<EpiMerge<0>, pg8::StaticOrder, pg8::DenseSrc>(F.lds, 512, S, G, E); }
        { pg8::DenseSrc G{F.ws + WS_R0, F.ws + WS_WR, 512}; EpiMerge<1> E{(bf16_t*)(F.ws + WS_R2), F.ws + WS_H0, GATES, PROBE_RW_SCALE}; pg8::gemm_phase<EpiMerge<1>, pg8::StaticOrder, pg8::DenseSrc>(F.lds, 512, S, G, E); } } SEAM(6);
    if (IN(7)) { PB(); pg8::StaticOrder S; S.init(M, D, F.G, (int)blockIdx.x); pg8::DenseSrcT<1> G{F.ws + WS_H0, F.ws + WS_WO, 1024};
        EpiOutProj E{AIN(0), F.out, MOD}; pg8::gemm_phase<EpiOutProj, pg8::StaticOrder, pg8::DenseSrcT<1>>(F.lds, 1024, S, G, E); } SEAM(7);
    if (IN(8)) { PB(); norm_mod_rows(args, F, F.out, AIN(21), 3072, 4096, (bf16_t*)(F.ws + WS_H2), nullptr); convert_experts(args, F); } SEAM(8);
    if (IN(9)) { PB(); pg8::StaticOrder S; S.init(M, 256, F.G, (int)blockIdx.x); pg8::DenseSrc G{(const bf16_t*)(F.ws + WS_H2), (const bf16_t*)(F.ws + WS_WRT), 1024};
        EpiRouter E{(float*)(F.ws + WS_LOGIT)}; pg8::gemm_phase<EpiRouter, pg8::StaticOrder, pg8::DenseSrc>(F.lds, 1024, S, G, E); } SEAM(9);
    if (IN(10)) { PB(); route_phase(args, F); } SEAM(10);
    MoeTab mt{0, 0};
    if (lo <= 13 && hi > 13) { PB(); mt = build_tiles(args, F); scatter_phase(args, F); } else if (hi > 13) { PB(); mt = build_tiles(args, F); }
    SEAM(11);
    const LAS unsigned* tab = (const LAS unsigned*)(F.lds + LDS_TILETAB);
    if (IN(12)) { PB(); MoeSched1 S{tab, mt.ntiles, F.G, (int)blockIdx.x}; MoeSrc1 G{F.ws};
        EpiMoe1 E{F.ws}; pg8::gemm_phase<EpiMoe1, MoeSched1, MoeSrc1>(F.lds, 1024, S, G, E); } SEAM(12);
    if (IN(13)) { PB(); MoeSched2 S{tab, 0, mt.ntiles, 512, F.G, (int)blockIdx.x}; MoeSrc2 G{F.ws}; EpiMoe2 E{F.ws, F.out, 0};
        pg8::gemm_phase<EpiMoe2, MoeSched2, MoeSrc2>(F.lds, 256, S, G, E); } SEAM(13);
    if (IN(14)) { PB(); final_rows(args, F, 0, M, 0); }
#undef IN
#undef SEAM
#undef PB
}

extern "C" void kernel_launch(void* const* d_in, const int* in_sizes, int n_in, void* d_out, int out_size, void* d_ws, size_t ws_size, hipStream_t stream) {
    static int grid = 0;
    if (grid == 0) {
        if (n_in != 31 || out_size != M * D || ws_size < WS_END) { fprintf(stderr, "kernel_launch: unexpected problem (n_in %d, out %d, ws %zu)\n", n_in, out_size, ws_size); grid = -1; return; }
        int dev = 0, cus = 0, per_cu = 0;
        if (hipGetDevice(&dev) != hipSuccess || hipDeviceGetAttribute(&cus, hipDeviceAttributeMultiprocessorCount, dev) != hipSuccess) { grid = -1; return; }
        if (hipFuncSetAttribute((const void*)fwd_kernel, hipFuncAttributeMaxDynamicSharedMemorySize, LDS_BYTES) != hipSuccess) { fprintf(stderr, "kernel_launch: hipFuncSetAttribute failed\n"); grid = -1; return; }
        if (hipOccupancyMaxActiveBlocksPerMultiprocessor(&per_cu, (const void*)fwd_kernel, NTHR, LDS_BYTES) != hipSuccess || per_cu < 1) fprintf(stderr, "kernel_launch: occupancy query reports %d\n", per_cu);
        (void)hipGetLastError();
        grid = cus;
        if (grid != 256) fprintf(stderr, "kernel_launch: %d CUs (built for 256)\n", grid);
    }
    if (grid < 0) return;
    (void)in_sizes;
    if (hipMemsetAsync((char*)d_ws + WS_CTL, 0, CTL_ZERO_BYTES, stream) != hipSuccess) return;
    Args a{};
    for (int i = 0; i < 31; ++i) a.in[i] = (const float*)d_in[i];
    a.out = (float*)d_out; a.ws = (unsigned char*)d_ws;
#ifndef PROBE_REPEAT
#define PROBE_REPEAT -1
#endif
    int li = 0;
    auto go = [&](int lo_, int hi_) { a.ph_lo = lo_; a.ph_hi = hi_; a.li = li++; hipLaunchKernelGGL(fwd_kernel, dim3(grid), dim3(NTHR), LDS_BYTES, stream, a); };
    if (PROBE_REPEAT < 0) go(0, N_PHASES);
    else { go(0, PROBE_REPEAT + 1); go(PROBE_REPEAT, PROBE_REPEAT + 1); if (PROBE_REPEAT + 1 < N_PHASES) go(PROBE_REPEAT + 1, N_PHASES); }
}
```

```cpp
#include <hip/hip_runtime.h>
#include <cstdio>
#include <cstdint>
#include <cmath>

#define GAS __attribute__((address_space(1)))
#define LAS __attribute__((address_space(3)))
typedef unsigned short bf16_t;
typedef short bf16x8 __attribute__((ext_vector_type(8)));
typedef float f32x4 __attribute__((ext_vector_type(4)));
typedef float f32x2 __attribute__((ext_vector_type(2)));
typedef float f32x16 __attribute__((ext_vector_type(16)));
typedef unsigned u32x4 __attribute__((ext_vector_type(4)));
typedef unsigned u32x2 __attribute__((ext_vector_type(2)));
typedef GAS unsigned gu32;

__device__ __forceinline__ unsigned cvt_pk_bf16(float lo, float hi) { unsigned r; asm volatile("v_cvt_pk_bf16_f32 %0, %1, %2" : "=v"(r) : "v"(lo), "v"(hi)); return r; }
__device__ __forceinline__ float bf_lo(unsigned w) { return __uint_as_float(w << 16); }
__device__ __forceinline__ float bf_hi(unsigned w) { return __uint_as_float(w & 0xffff0000u); }
__device__ __forceinline__ float bf2f(bf16_t b) { return __uint_as_float(((unsigned)b) << 16); }
__device__ __forceinline__ unsigned f2bf(float f) { unsigned u = __float_as_uint(f); return (u + 0x7fffu + ((u >> 16) & 1u)) >> 16; }
__device__ __forceinline__ unsigned pk2(float lo, float hi) { return f2bf(lo) | (f2bf(hi) << 16); }
__device__ __forceinline__ float fast_sigmoid(float x) { return __builtin_amdgcn_rcpf(1.0f + __builtin_amdgcn_exp2f(-1.4426950408889634f * x)); }
__device__ __forceinline__ float wave_sum(float v) {
#pragma unroll
    for (int o = 1; o < 64; o <<= 1) v += __shfl_xor(v, o);
    return v;
}

namespace pg8 {
constexpr int BM = 256, BK = 64, HALF = 128, HTB = HALF * BK * 2, STAGE_BYTES = 8 * HTB, NXCD = 8, WGM = 8;
__host__ __device__ __forceinline__ int lds_byte(int r, int c) { const int st = (r >> 4) * 2 + (c >> 5), rr = r & 15, cc = c & 31, ob = rr * 64 + cc * 2; return st * 1024 + (ob ^ (((ob >> 9) & 1) << 5)); }
__host__ __device__ __forceinline__ void stage_rc(int b, int& R, int& C) { const int st = b / 1024, sb = b % 1024, swz = sb ^ (((sb >> 9) & 1) << 5); R = (st >> 1) * 16 + swz / 64; C = (st & 1) * 32 + (swz % 64) / 2; }
__host__ __device__ __forceinline__ int perm32(int rho) { const int n = rho >> 4, i = rho & 15; return 8 * (i >> 2) + 4 * n + (i & 3); }

struct Unit { int pm, pn; int aux0, aux1; };

struct StaticOrder {
    int nM, nN, nwg, G, c;
    __host__ __device__ void init(int M, int N, int G_, int c_) { nM = M / BM; nN = N / BM; nwg = nM * nN; G = G_; c = c_; }
    __host__ __device__ bool next(int i, Unit& u) const {
        const long L = (long)i * G + c; if (L >= nwg) return false;
        int wgid = (int)L; { const int q = nwg / NXCD, r = nwg % NXCD, xcd = wgid % NXCD, off = wgid / NXCD; wgid = (xcd < r ? xcd * (q + 1) : r * (q + 1) + (xcd - r) * q) + off; }
        const int nig = WGM * nN, gid = wgid / nig, fm = gid * WGM, gsz = (nM - fm) < WGM ? (nM - fm) : WGM;
        u.pm = fm + ((wgid % nig) % gsz); u.pn = (wgid % nig) / gsz; u.aux0 = 0; u.aux1 = 0; return true;
    }
};

template <int ESZ_> struct DenseSrcT {
    static constexpr int ESZ = ESZ_; static constexpr bool GATHER = false;
    const void* A; const void* Bt; int K;
    __device__ __forceinline__ const char* b_base(const Unit& u) const { return (const char*)Bt + (size_t)u.pn * 256 * K * ESZ; }
    __device__ __forceinline__ const char* a_base(const Unit& u) const { return (const char*)A + (size_t)u.pm * 256 * K * ESZ; }
    __device__ __forceinline__ unsigned a_off(const Unit&, int R, int C) const { return (unsigned)(R * K * ESZ) + (unsigned)C * 2u; }
};
typedef DenseSrcT<2> DenseSrc;
typedef int v8i32 __attribute__((ext_vector_type(8)));

template <class Epi, class Sched, class Src, bool ALIGN_EPI = true>
__device__ __forceinline__ void gemm_phase(LAS unsigned char* lds, const int K, const Sched& S, const Src& G, const Epi& E) {
    const int tid = threadIdx.x, wid = __builtin_amdgcn_readfirstlane(tid >> 6), lane = tid & 63, wr = wid >> 2, wc = wid & 3, fr = lane & 15, fq = lane >> 4;
    constexpr int ESZ = Src::ESZ; const int Kb = K * ESZ;
    const int nt = Kb / (BK * 2);
    unsigned voffB0;
    { int R, C; stage_rc(tid * 16, R, C); const int Rb = Epi::PERM ? ((R & ~31) + perm32(R & 31)) : R; voffB0 = (unsigned)(Rb * Kb) + (unsigned)C * 2u; }
#define PG8_AOFF(u, h, i) ([&]() { int R_, C_; stage_rc(tid * 16 + (i) * 8192, R_, C_); return G.a_off((u), R_ + (h) * HALF, C_); }())
    const size_t kstep = (size_t)(BK * 2);
    const size_t hstepB = (size_t)HALF * Kb;
    const unsigned ldsw = (unsigned)wid * 1024u;
    const int aoff = lds_byte(wr * 64 + fr, fq * 8), boff = lds_byte(wc * 32 + fr, fq * 8);
#define PG8_SA(b, h) (((b) * 2 + (h)) * HTB)
#define PG8_SB(b, h) ((4 + (b) * 2 + (h)) * HTB)
#define PG8_STAGEB(bufoff, gbase) do { _Pragma("unroll") for (int _i = 0; _i < 2; ++_i) { unsigned o_ = voffB0; asm volatile("" : "+v"(o_)); \
        __builtin_amdgcn_global_load_lds((const unsigned*)((const char*)(gbase) + (size_t)_i * 64 * Kb + o_), (LAS unsigned*)(lds + (bufoff) + ldsw + _i * 8192), 16, 0, 0); } } while (0)
#define PG8_STAGEA(bufoff, gbase, vo, h) do { _Pragma("unroll") for (int _i = 0; _i < 2; ++_i) { unsigned o_ = Src::GATHER ? (vo)[h][_i] : (vo)[0][0]; asm volatile("" : "+v"(o_)); \
        __builtin_amdgcn_global_load_lds((const unsigned*)((const char*)(gbase) + (Src::GATHER ? (size_t)0 : (size_t)((h) * 128 + _i * 64) * Kb) + o_), (LAS unsigned*)(lds + (bufoff) + ldsw + _i * 8192), 16, 0, 0); } } while (0)
#define PG8_STAGEA2(bufoff, gbase, h) do { _Pragma("unroll") for (int _i = 0; _i < 2; ++_i) { unsigned o_ = Src::GATHER ? (last ? vn[h][_i] : vc[h][_i]) : vc[0][0]; asm volatile("" : "+v"(o_)); \
        __builtin_amdgcn_global_load_lds((const unsigned*)((const char*)(gbase) + (Src::GATHER ? (size_t)0 : (size_t)((h) * 128 + _i * 64) * Kb) + o_), (LAS unsigned*)(lds + (bufoff) + ldsw + _i * 8192), 16, 0, 0); } } while (0)
#define PG8_LDA(dst, b, h) do { _Pragma("unroll") for (int m = 0; m < 4; ++m) { const u32x4 lo_ = *(const LAS u32x4*)(lds + PG8_SA(b, h) + aoff + m * 2048), hi_ = *(const LAS u32x4*)(lds + PG8_SA(b, h) + aoff + m * 2048 + 1024); \
        dst[m] = __builtin_shufflevector(lo_, hi_, 0, 1, 2, 3, 4, 5, 6, 7); } } while (0)
#define PG8_LDB(dst, b, h) do { _Pragma("unroll") for (int n = 0; n < 2; ++n) { const u32x4 lo_ = *(const LAS u32x4*)(lds + PG8_SB(b, h) + boff + n * 2048), hi_ = *(const LAS u32x4*)(lds + PG8_SB(b, h) + boff + n * 2048 + 1024); \
        dst[n] = __builtin_shufflevector(lo_, hi_, 0, 1, 2, 3, 4, 5, 6, 7); } } while (0)
#define PG8_LO(x) __builtin_bit_cast(bf16x8, __builtin_shufflevector((x), (x), 0, 1, 2, 3))
#define PG8_HI(x) __builtin_bit_cast(bf16x8, __builtin_shufflevector((x), (x), 4, 5, 6, 7))
#define PG8_MMA(ai, bj, At, Bt) do { __builtin_amdgcn_s_setprio(1); _Pragma("unroll") for (int m = 0; m < 4; ++m) _Pragma("unroll") for (int n = 0; n < 2; ++n) { \
        if constexpr (ESZ == 1) acc[ai][bj][m][n] = __builtin_amdgcn_mfma_scale_f32_16x16x128_f8f6f4(__builtin_bit_cast(v8i32, Bt[n]), __builtin_bit_cast(v8i32, At[m]), acc[ai][bj][m][n], 0, 0, 0, 0, 0, 0); \
        else { acc[ai][bj][m][n] = __builtin_amdgcn_mfma_f32_16x16x32_bf16(PG8_LO(Bt[n]), PG8_LO(At[m]), acc[ai][bj][m][n], 0, 0, 0); \
               acc[ai][bj][m][n] = __builtin_amdgcn_mfma_f32_16x16x32_bf16(PG8_HI(Bt[n]), PG8_HI(At[m]), acc[ai][bj][m][n], 0, 0, 0); } } \
        __builtin_amdgcn_s_setprio(0); } while (0)
#define PG8_WAIT_V(n) asm volatile("s_waitcnt vmcnt(" #n ")" ::: "memory")
#define PG8_WAIT_L(n) asm volatile("s_waitcnt lgkmcnt(" #n ")" ::: "memory")
#define PG8_BAR __builtin_amdgcn_s_barrier()
#define PG8_SCHED __builtin_amdgcn_sched_barrier(0)
    Unit cur, nxt; int ui = 0;
    if (!S.next(0, cur)) return;
    f32x4 acc[2][2][4][2];
#pragma unroll
    for (int a = 0; a < 2; ++a)
#pragma unroll
        for (int b = 0; b < 2; ++b)
#pragma unroll
            for (int m = 0; m < 4; ++m)
#pragma unroll
                for (int n = 0; n < 2; ++n) acc[a][b][m][n] = (f32x4){0.f, 0.f, 0.f, 0.f};
    typedef unsigned u32x8 __attribute__((ext_vector_type(8)));
    u32x8 At[4], B0[2], B1[2];
    unsigned vc[2][2], vn[2][2];
#pragma unroll
    for (int h = 0; h < 2; ++h)
#pragma unroll
        for (int i = 0; i < 2; ++i) vc[h][i] = PG8_AOFF(cur, h, i);
    const char* cA = G.a_base(cur); const char* cB = G.b_base(cur);
    PG8_STAGEB(PG8_SB(0, 0), cB); PG8_STAGEB(PG8_SB(0, 1), cB + hstepB); PG8_STAGEA(PG8_SA(0, 0), cA, vc, 0); PG8_STAGEA(PG8_SA(0, 1), cA, vc, 1);
    if (wr == 1) PG8_BAR;
    PG8_WAIT_V(2); PG8_BAR;
    PG8_STAGEB(PG8_SB(1, 0), cB + kstep); PG8_STAGEA(PG8_SA(1, 0), cA + kstep, vc, 0); PG8_STAGEB(PG8_SB(1, 1), cB + hstepB + kstep);
    PG8_WAIT_V(6); PG8_BAR;
    for (;;) {
        const bool has_next = S.next(ui + 1, nxt);
        const char* nA = has_next ? G.a_base(nxt) : cA; const char* nB = has_next ? G.b_base(nxt) : cB;
        if constexpr (Src::GATHER) {
#pragma unroll
        for (int h = 0; h < 2; ++h)
#pragma unroll
            for (int i = 0; i < 2; ++i) vn[h][i] = has_next ? PG8_AOFF(nxt, h, i) : vc[h][i]; }
#pragma clang loop unroll(disable)
        for (int t = 0; t < nt; t += 2) {
            const bool last = (t == nt - 2);
            const char* a1 = cA + (size_t)(t + 1) * kstep;
            const char* a2 = last ? nA : cA + (size_t)(t + 2) * kstep; const char* b2 = last ? nB : cB + (size_t)(t + 2) * kstep;
            const char* a3 = a2 + kstep; const char* b3 = b2 + kstep;
            PG8_LDB(B0, 0, 0); PG8_LDB(B1, 0, 1); PG8_SCHED; PG8_LDA(At, 0, 0); PG8_STAGEA(PG8_SA(1, 1), a1, vc, 1);
            PG8_WAIT_V(8); PG8_WAIT_L(0); PG8_BAR; PG8_MMA(0, 0, At, B0); PG8_MMA(0, 1, At, B1); PG8_BAR; PG8_SCHED;
            PG8_LDA(At, 0, 1); PG8_STAGEB(PG8_SB(0, 0), b2); PG8_STAGEB(PG8_SB(0, 1), b2 + hstepB); PG8_STAGEA2(PG8_SA(0, 0), a2, 0);
            PG8_WAIT_V(8); PG8_WAIT_L(0); PG8_BAR; PG8_MMA(1, 0, At, B0); PG8_MMA(1, 1, At, B1); PG8_BAR; PG8_SCHED;
            PG8_LDB(B0, 1, 0); PG8_LDB(B1, 1, 1); PG8_SCHED; PG8_LDA(At, 1, 0); PG8_STAGEA2(PG8_SA(0, 1), a2, 1);
            PG8_WAIT_V(8); PG8_WAIT_L(0); PG8_BAR; PG8_MMA(0, 0, At, B0); PG8_MMA(0, 1, At, B1); PG8_BAR; PG8_SCHED;
            PG8_LDA(At, 1, 1); PG8_STAGEB(PG8_SB(1, 0), b3); PG8_STAGEB(PG8_SB(1, 1), b3 + hstepB); PG8_STAGEA2(PG8_SA(1, 0), a3, 0);
            PG8_WAIT_V(8); PG8_WAIT_L(0); PG8_BAR; PG8_MMA(1, 0, At, B0); PG8_MMA(1, 1, At, B1); PG8_BAR; PG8_SCHED;
        }
        if constexpr (ALIGN_EPI) { if (wr == 0) PG8_BAR; }
        { int ln_; asm volatile("v_mbcnt_lo_u32_b32 %0, -1, 0\n\tv_mbcnt_hi_u32_b32 %0, -1, %0" : "=v"(ln_)); E(acc, cur, wr, wc, ln_ & 15, ln_ >> 4); }
        if (!has_next) break;
#pragma unroll
        for (int a = 0; a < 2; ++a)
#pragma unroll
            for (int b = 0; b < 2; ++b)
#pragma unroll
                for (int m = 0; m < 4; ++m)
#pragma unroll
                    for (int n = 0; n < 2; ++n) acc[a][b][m][n] = (f32x4){0.f, 0.f, 0.f, 0.f};
        cur = nxt; cA = nA; cB = nB; ++ui;
        if constexpr (Src::GATHER) {
#pragma unroll
        for (int h = 0; h < 2; ++h)
#pragma unroll
            for (int i = 0; i < 2; ++i) vc[h][i] = vn[h][i]; }
        if constexpr (ALIGN_EPI) { if (wr == 1) PG8_BAR; }
    }
    PG8_WAIT_V(0);
    if constexpr (!ALIGN_EPI) { if (wr == 0) PG8_BAR; }
    PG8_BAR;
#undef PG8_SA
#undef PG8_AOFF
#undef PG8_SB
#undef PG8_STAGEA
#undef PG8_STAGEA2
#undef PG8_STAGEB
#undef PG8_LDA
#undef PG8_LDB
#undef PG8_MMA
#undef PG8_LO
#undef PG8_HI
#undef PG8_WAIT_V
#undef PG8_WAIT_L
#undef PG8_BAR
#undef PG8_SCHED
}
}
#define RLX_AGENT __ATOMIC_RELAXED, __HIP_MEMORY_SCOPE_AGENT
#define LDS_WAIT() asm volatile("s_waitcnt lgkmcnt(0)" ::: "memory")
#define VM_WAIT() asm volatile("s_waitcnt vmcnt(0)" ::: "memory")
#define XB_TMO      128
#define XB_XCNT(j)  (256  + 64 * (j))
#define XB_XSUB(j)  (1280 + 64 * (j))
#define XB_XGEN(j)  (2304 + 64 * (j))
#define XB_TOP      3328
#define XB_TOPGEN   3392
#define XCD_BAR_WORDS 3456
#define XB_SPIN_CAP (1u << 18)

__device__ __forceinline__ unsigned xb_ld(unsigned* p)              { return __hip_atomic_load(p, __ATOMIC_RELAXED, __HIP_MEMORY_SCOPE_AGENT); }
__device__ __forceinline__ unsigned xb_add(unsigned* p, unsigned v) { return __hip_atomic_fetch_add(p, v, __ATOMIC_RELAXED, __HIP_MEMORY_SCOPE_AGENT); }
__device__ __forceinline__ unsigned xb_xcc_id() { return (unsigned)__builtin_amdgcn_s_getreg((3 << 11) | 20) & 0xFu; }
#define XB_SPIN(cond, bar) do { unsigned _sp = 0; while (cond) { __builtin_amdgcn_s_sleep(1); \
    if ((++_sp & 255u) == 0u) { if (xb_ld(&(bar)[XB_TMO])) break; if (_sp > XB_SPIN_CAP) { atomicAdd(&(bar)[XB_TMO], 1u); break; } } } } while (0)

struct XcdBarrier {
    unsigned* bar; unsigned x;
    volatile LAS unsigned* st;
};

__device__ __forceinline__ XcdBarrier xcd_barrier_post(unsigned* bar, volatile LAS unsigned* st) {
    XcdBarrier b; b.bar = bar; b.x = xb_xcc_id(); b.st = st;
    if (threadIdx.x == 0) (void)xb_add(&bar[XB_XCNT(b.x)], 1u);
    return b;
}
__device__ __forceinline__ void xcd_barrier_complete(unsigned* bar, unsigned x, unsigned& nloc, unsigned& nx) {
    const unsigned G = gridDim.x * gridDim.y * gridDim.z;
    unsigned sum, cnt, mine, sp = 0u;
    for (;;) {
        sum = 0u; cnt = 0u; mine = 0u;
#pragma unroll
        for (unsigned j = 0; j < 16; ++j) { const unsigned c = xb_ld(&bar[XB_XCNT(j)]); sum += c; cnt += (c > 0u) ? 1u : 0u; mine = (j == x) ? c : mine; }
        if (sum == G) break;
        __builtin_amdgcn_s_sleep(1);
        if ((++sp & 255u) == 0u) { if (xb_ld(&bar[XB_TMO])) break; if (sp > XB_SPIN_CAP) { atomicAdd(&bar[XB_TMO], 1u); break; } }
    }
    nloc = mine > 0u ? mine : 1u; nx = cnt > 0u ? cnt : 1u;
}

__device__ __forceinline__ void xcd_barrier(const XcdBarrier& b) {
    asm volatile("s_waitcnt vmcnt(0)" ::: "memory");
    __syncthreads();
    if (threadIdx.x == 0) {
        unsigned* bar = b.bar;
        __builtin_amdgcn_s_waitcnt(0);
        unsigned nloc = b.st[0], nx = b.st[1];
        if (nloc == 0u) { xcd_barrier_complete(bar, b.x, nloc, nx); b.st[0] = nloc; b.st[1] = nx; }
        const unsigned old = xb_add(&bar[XB_XSUB(b.x)], 1u);
        const unsigned gen = old / nloc;
        if (old + 1u == (gen + 1u) * nloc) {
            __builtin_amdgcn_fence(__ATOMIC_RELEASE, "agent");
            asm volatile("s_waitcnt vmcnt(0)" ::: "memory");
            const unsigned og = xb_add(&bar[XB_TOP], 1u);
            const unsigned tg = og / nx;
            if (og + 1u == (tg + 1u) * nx) xb_add(&bar[XB_TOPGEN], 1u);
            else XB_SPIN(xb_ld(&bar[XB_TOPGEN]) == tg, bar);
            __builtin_amdgcn_fence(__ATOMIC_ACQUIRE, "agent");
            xb_add(&bar[XB_XGEN(b.x)], 1u);
            asm volatile("s_waitcnt vmcnt(0)" ::: "memory");
        } else {
            XB_SPIN(xb_ld(&bar[XB_XGEN(b.x)]) == gen, bar);
            __builtin_amdgcn_fence(__ATOMIC_ACQUIRE, "agent");
            asm volatile("s_waitcnt vmcnt(0)" ::: "memory");
        }
    }
    __syncthreads();
}
constexpr int NB = 8, SEQ = 4096, D = 1024, M = NB * SEQ;
constexpr int NIN_SRC = 5936, NIN = 6144;
constexpr int ZW = 4096;
constexpr int ZQ = 0, ZK = 512, ZV = 1024, ZIQ = 1536, ZIK = 2048, ZIW = 2080, ZR = 2304;
constexpr int ZR_R = ZR, ZR_K = ZR + 512, ZR_V = ZR + 1024, ZR_WD = ZR + 1536, ZR_AD = ZR + 1600, ZR_GD = ZR + 1664;
constexpr int GW = 2048;
constexpr int NEXP = 64, FF = 256, TOPK = 8;
constexpr float RMS_EPS = 1e-6f, GN_EPS = 64e-5f;
constexpr float QSCALE = 0.125f * 1.4426950408889634f;
constexpr int NWAVES = 8, NTHR = 512;

constexpr size_t MiB = 1u << 20;
constexpr size_t WS_CTL = 0, CTL_ZERO_BYTES = 1 * MiB;
constexpr size_t WS_MOD = 1 * MiB;
constexpr size_t WS_DUT = 1 * MiB + 256 * 1024;
constexpr size_t WS_IUT = WS_DUT + 64 * 1024;
constexpr size_t WS_GUT = WS_IUT + 64 * 1024;
constexpr size_t WS_WIN = 2 * MiB;
constexpr size_t WS_WA = 14 * MiB, WS_WR = 15 * MiB;
constexpr size_t WS_WO = 16 * MiB;
constexpr size_t WS_WRT = 18 * MiB;
constexpr size_t WS_WSH1 = 19 * MiB;
constexpr size_t WS_WSH2 = 20 * MiB;
constexpr size_t WS_BRS = 21 * MiB, WS_KRS = 22 * MiB;
constexpr size_t WS_TOPE = 23 * MiB, WS_TOPW = 24 * MiB;
constexpr size_t WS_LOGIT = 25 * MiB;
constexpr size_t WS_Z = 36 * MiB;
constexpr size_t WS_H0 = 292 * MiB, WS_H1 = 324 * MiB;
constexpr size_t WS_SEL = 356 * MiB;
constexpr size_t WS_R0 = 372 * MiB, WS_R1 = 404 * MiB, WS_R2 = 436 * MiB, WS_R3 = 468 * MiB;
constexpr size_t WS_W2T = 36 * MiB;
constexpr size_t WS_ACT = 68 * MiB;
constexpr size_t WS_ACTS = 196 * MiB;
constexpr size_t WS_STOK = 212 * MiB, WS_SW = 213 * MiB;
constexpr size_t WS_W1T = 214 * MiB;
constexpr size_t WS_H2 = 278 * MiB;
constexpr size_t WS_SLOT = 214 * MiB;
constexpr size_t WS_END = 502 * MiB;
constexpr int CW_TMO = 0, CW_BAR = 4096, CW_CNT = 32768, CW_CUR = 32768 + 128, CW_Q = 32768 + 512;

constexpr int RING_BYTES = 131072;
constexpr int LDSCTL_OFF = RING_BYTES, MISC_OFF = LDSCTL_OFF + 320;
constexpr int LDS_TILETAB = RING_BYTES + 1024;
constexpr int LDS_PTAB = RING_BYTES + 512;
constexpr int LDS_PARA = 118800;
constexpr int LDS_PARB = LDS_TILETAB;
constexpr int LDS_BYTES = 147456;
#define AIN(i) ain_ptr(F.lds, (i))

struct Args { const float* in[31]; float* out; unsigned char* ws; int ph_lo, ph_hi, li, pad; };
struct Frame {
    LAS unsigned char* lds;
    volatile LAS unsigned* MISC;
    unsigned* ctl;
    int tid, lane, wave, vcu, G, gw, NGW;
    float* out; unsigned char* ws;
};

__device__ __forceinline__ const float* ain_ptr(LAS unsigned char* lds, int i) {
    const u32x2 w = *(const LAS u32x2*)(lds + LDS_PTAB + 8 * i);
    const unsigned lo = (unsigned)__builtin_amdgcn_readfirstlane((int)w.x), hi = (unsigned)__builtin_amdgcn_readfirstlane((int)w.y);
    return (const float*)(((unsigned long long)hi << 32) | lo);
}
struct TrSrc { const float* base; int nsrc; };
template <int FP8, class ColFn>
__device__ __forceinline__ void transpose_item(const ColFn& colfn, int K, bf16_t* WT, LAS float* scr, int kb, int nb, int lane) {
    const int k0 = 64 * kb, n0 = 32 * nb;
    const TrSrc s = colfn(n0 + (lane & 31));
    float v_[32];
#pragma unroll
    for (int i = 0; i < 32; ++i) { const int kk = 2 * i + (lane >> 5); v_[i] = s.base ? s.base[(size_t)(k0 + kk) * s.nsrc] : 0.f; }
#pragma unroll
    for (int i = 0; i < 32; ++i) { const int kk = 2 * i + (lane >> 5); scr[kk * 33 + (lane & 31)] = v_[i]; }
    LDS_WAIT(); asm volatile("" ::: "memory");
    const int c = lane & 7;
#pragma unroll
    for (int j = 0; j < 4; ++j) { const int n = (lane >> 3) + 8 * j; const LAS float* sp = scr + (8 * c) * 33 + n;
        if constexpr (FP8) { constexpr float S8 = 32.0f;
            int lo = __builtin_amdgcn_cvt_pk_fp8_f32(sp[0 * 33] * S8, sp[1 * 33] * S8, 0, false); lo = __builtin_amdgcn_cvt_pk_fp8_f32(sp[2 * 33] * S8, sp[3 * 33] * S8, lo, true);
            int hi = __builtin_amdgcn_cvt_pk_fp8_f32(sp[4 * 33] * S8, sp[5 * 33] * S8, 0, false); hi = __builtin_amdgcn_cvt_pk_fp8_f32(sp[6 * 33] * S8, sp[7 * 33] * S8, hi, true);
            *(GAS u32x2*)((unsigned char*)WT + (size_t)(n0 + n) * K + k0 + 8 * c) = (u32x2){(unsigned)lo, (unsigned)hi}; }
        else { u32x4 o; o.x = pk2(sp[0 * 33], sp[1 * 33]); o.y = pk2(sp[2 * 33], sp[3 * 33]); o.z = pk2(sp[4 * 33], sp[5 * 33]); o.w = pk2(sp[6 * 33], sp[7 * 33]);
            *(GAS u32x4*)(WT + (size_t)(n0 + n) * K + k0 + 8 * c) = o; } }
    LDS_WAIT(); asm volatile("" ::: "memory");
}

__device__ __forceinline__ void p0_mod(const Args& args, Frame& F, int task) {
    LAS float* sc = (LAS float*)F.lds;
    LAS float* red = (LAS float*)(F.lds + 32768);
    const float* c = AIN(1);
    for (int i = F.tid; i < 8192; i += NTHR) { const float v = c[i]; sc[i] = v * fast_sigmoid(v); }
    __syncthreads();
    const float* aw = AIN(2) + 64 * task + F.lane;
    float acc[8];
#pragma unroll
    for (int b = 0; b < 8; ++b) acc[b] = 0.f;
    const int kb = 128 * F.wave;
#pragma unroll 4
    for (int k = 0; k < 128; ++k) { const float a = aw[(size_t)(kb + k) * 6144];
#pragma unroll
        for (int b = 0; b < 8; ++b) acc[b] += sc[b * 1024 + kb + k] * a; }
#pragma unroll
    for (int b = 0; b < 8; ++b) red[(F.wave * 8 + b) * 64 + F.lane] = acc[b];
    __syncthreads();
    { const int b = F.wave; float s = AIN(3)[64 * task + F.lane];
#pragma unroll
      for (int w = 0; w < 8; ++w) s += red[(w * 8 + b) * 64 + F.lane];
      ((float*)(F.ws + WS_MOD))[b * 6144 + 64 * task + F.lane] = s; }
    __syncthreads();
}

__device__ __forceinline__ void p0_prologue(const Args& args, Frame& F) {
    if (blockIdx.x < 96) p0_mod(args, F, blockIdx.x);
    LAS float* scr = (LAS float*)(F.lds + F.wave * 16384);
    bf16_t* const ws16 = (bf16_t*)F.ws;
    constexpr int I_WIN = 16 * 192, I_WA = 8 * 32, I_WO = 16 * 32, I_WRT = 16 * 8, I_SH1 = 16 * 16, I_SH2 = 4 * 32, I_DU = 16, I_GU = 32;
    constexpr int NIT = I_WIN + 2 * I_WA + I_WO + I_WRT + I_SH1 + I_SH2 + 2 * I_DU + I_GU;
    for (int it = F.gw; it < NIT; it += F.NGW) {
        int r = it;
        if (r < I_WIN) { const float* w = AIN(5);
            transpose_item<1>([=](int n) { TrSrc s; const bool ok = (n < 2096) || (n >= 2304); const int col = n < 2096 ? n : n - 208; s.base = ok ? w + col : nullptr; s.nsrc = NIN_SRC; return s; },
                           1024, (bf16_t*)(F.ws + WS_WIN), scr, r / 192, r % 192, F.lane); continue; } r -= I_WIN;
        if (r < I_WA) { const float* w = AIN(18); transpose_item<0>([=](int n) { TrSrc s; s.base = w + n; s.nsrc = 1024; return s; }, 512, (bf16_t*)(F.ws + WS_WA), scr, r / 32, r % 32, F.lane); continue; } r -= I_WA;
        if (r < I_WA) { const float* w = AIN(19); transpose_item<0>([=](int n) { TrSrc s; s.base = w + n; s.nsrc = 1024; return s; }, 512, (bf16_t*)(F.ws + WS_WR), scr, r / 32, r % 32, F.lane); continue; } r -= I_WA;
        if (r < I_WO) { const float* w = AIN(20); transpose_item<1>([=](int n) { TrSrc s; s.base = w + n; s.nsrc = 1024; return s; }, 1024, (bf16_t*)(F.ws + WS_WO), scr, r / 32, r % 32, F.lane); continue; } r -= I_WO;
        if (r < I_WRT) { const float* w = AIN(22); transpose_item<0>([=](int n) { TrSrc s; s.base = n < 64 ? w + n : nullptr; s.nsrc = 64; return s; }, 1024, (bf16_t*)(F.ws + WS_WRT), scr, r / 8, r % 8, F.lane); continue; } r -= I_WRT;
        if (r < I_SH1) { const float* wg = AIN(27); const float* wu = AIN(28);
            transpose_item<0>([=](int n) { TrSrc s; const int j = n >> 8, sel = (n >> 7) & 1, cc = n & 127; s.base = (sel ? wu : wg) + 128 * j + cc; s.nsrc = 256; return s; }, 1024, (bf16_t*)(F.ws + WS_WSH1), scr, r / 16, r % 16, F.lane); continue; } r -= I_SH1;
        if (r < I_SH2) { const float* w = AIN(29); transpose_item<0>([=](int n) { TrSrc s; s.base = w + n; s.nsrc = 1024; return s; }, 256, (bf16_t*)(F.ws + WS_WSH2), scr, r / 32, r % 32, F.lane); continue; } r -= I_SH2;
        if (r < I_DU) { const float* w = AIN(9); transpose_item<0>([=](int n) { TrSrc s; s.base = w + n; s.nsrc = 512; return s; }, 64, (bf16_t*)(F.ws + WS_DUT), scr, 0, r, F.lane); continue; } r -= I_DU;
        if (r < I_DU) { const float* w = AIN(11); transpose_item<0>([=](int n) { TrSrc s; s.base = w + n; s.nsrc = 512; return s; }, 64, (bf16_t*)(F.ws + WS_IUT), scr, 0, r, F.lane); continue; } r -= I_DU;
        { const float* w = AIN(12); transpose_item<0>([=](int n) { TrSrc s; s.base = w + n; s.nsrc = 512; return s; }, 128, (bf16_t*)(F.ws + WS_GUT), scr, r / 16, r % 16, F.lane); }
    }
    (void)ws16;
}

__device__ __forceinline__ void convert_experts(const Args& args, Frame& F) {
    LAS float* scr = (LAS float*)(F.lds + F.wave * 16384);
    constexpr int I1 = 16 * 16, I2 = 4 * 32, PER = I1 + I2, NIT = 64 * PER;
    for (int it = F.gw; it < NIT; it += F.NGW) {
        const int e = it / PER; int r = it % PER;
        if (r < I1) { const float* wg = AIN(24) + (size_t)e * 1024 * 256; const float* wu = AIN(25) + (size_t)e * 1024 * 256;
            transpose_item<0>([=](int n) { TrSrc s; const int j = n >> 8, sel = (n >> 7) & 1, cc = n & 127; s.base = (sel ? wu : wg) + 128 * j + cc; s.nsrc = 256; return s; }, 1024, (bf16_t*)(F.ws + WS_W1T) + (size_t)e * 512 * 1024, scr, r / 16, r % 16, F.lane); }
        else { r -= I1; const float* w = AIN(26) + (size_t)e * 256 * 1024;
            transpose_item<0>([=](int n) { TrSrc s; s.base = w + n; s.nsrc = 1024; return s; }, 256, (bf16_t*)(F.ws + WS_W2T) + (size_t)e * 1024 * 256, scr, r / 32, r % 32, F.lane); }
    }
}

__device__ __forceinline__ void norm_mod_rows(const Args& args, Frame& F, const float* X, const float* g, int sh_off, int sc_off, bf16_t* O, unsigned char* O8) {
    const int row0 = F.gw * 16, b = row0 / SEQ;
    const float* mod = (const float*)(F.ws + WS_MOD) + b * 6144;
    f32x4 mul[4], add[4];
#pragma unroll
    for (int j = 0; j < 4; ++j) { const int c = 4 * F.lane + 256 * j; const f32x4 gv = *(const f32x4*)(g + c), sc = *(const f32x4*)(mod + sc_off + c); add[j] = *(const f32x4*)(mod + sh_off + c); mul[j] = gv * (sc + 1.0f); }
    for (int r = 0; r < 16; ++r) {
        const GAS f32x4* xr = (const GAS f32x4*)(X + (size_t)(row0 + r) * D) + F.lane;
        f32x4 v[4]; float s = 0.f;
#pragma unroll
        for (int j = 0; j < 4; ++j) { v[j] = xr[64 * j]; s += (v[j].x * v[j].x + v[j].y * v[j].y) + (v[j].z * v[j].z + v[j].w * v[j].w); }
        const float rstd = 1.0f / sqrtf(wave_sum(s) * (1.0f / D) + RMS_EPS);
#pragma unroll
        for (int j = 0; j < 4; ++j) { const f32x4 y = v[j] * rstd * mul[j] + add[j];
            if (O) { u32x2 w; w.x = cvt_pk_bf16(y.x, y.y); w.y = cvt_pk_bf16(y.z, y.w); ((GAS u32x2*)(O + (size_t)(row0 + r) * D) + F.lane)[64 * j] = w; }
            if (O8) { int w8 = __builtin_amdgcn_cvt_pk_fp8_f32(y.x, y.y, 0, false); w8 = __builtin_amdgcn_cvt_pk_fp8_f32(y.z, y.w, w8, true); ((GAS unsigned*)(O8 + (size_t)(row0 + r) * D) + F.lane)[64 * j] = (unsigned)w8; } }
    }
}
using pg8::Unit;
constexpr float WSCALE8 = 32.0f;
typedef const f32x4 (&AccRef)[2][2][4][2];

struct EpiInProj {
    static constexpr bool PERM = true;
    bf16_t* Z; bf16_t* Gt;
    __device__ __forceinline__ void operator()(AccRef acc, const Unit& u, int wr, int wc, int fr, int fq) const {
        asm volatile("" : "+v"(fr), "+v"(fq));
        const int row0 = u.pm * 256 + wr * 64 + fr;
        const bool gate = u.pn >= 16;
        const float sc = ((u.pn < 2) ? QSCALE : 1.0f) * (1.0f / WSCALE8);
        bf16_t* base = gate ? Gt + (size_t)(u.pn - 16) * 256 : Z + (size_t)u.pn * 256;
        const int ldc = gate ? GW : ZW;
#pragma unroll
        for (int ai = 0; ai < 2; ++ai)
#pragma unroll
            for (int m = 0; m < 4; ++m) { bf16_t* rowp = base + (size_t)(row0 + ai * 128 + m * 16) * ldc + wc * 32 + 8 * fq;
#pragma unroll
                for (int bj = 0; bj < 2; ++bj) { f32x4 v0 = acc[ai][bj][m][0], v1 = acc[ai][bj][m][1];
                    if (gate) {
#pragma unroll
                        for (int j = 0; j < 4; ++j) { v0[j] = fast_sigmoid(v0[j] * sc); v1[j] = fast_sigmoid(v1[j] * sc); } }
                    else { v0 = v0 * sc; v1 = v1 * sc; }
                    u32x4 w; w.x = cvt_pk_bf16(v0[0], v0[1]); w.y = cvt_pk_bf16(v0[2], v0[3]); w.z = cvt_pk_bf16(v1[0], v1[1]); w.w = cvt_pk_bf16(v1[2], v1[3]);
                    *(u32x4*)(rowp + bj * 128) = w; } }
    }
};

constexpr float ATT_S8 = 16.0f, RW_S8 = 8.0f, MIX_S8 = 16.0f;
template <int SECOND> struct EpiMerge {
    static constexpr bool PERM = true;
    bf16_t* Mx; unsigned char* Mx8; const bf16_t* Gt; float bs;
    __device__ __forceinline__ void operator()(AccRef acc, const Unit& u, int wr, int wc, int fr, int fq) const {
        asm volatile("" : "+v"(fr), "+v"(fq));
        const int row0 = u.pm * 256 + wr * 64 + fr, col0 = u.pn * 256 + wc * 32 + 8 * fq;
#pragma unroll
        for (int ai = 0; ai < 2; ++ai)
#pragma unroll
            for (int m = 0; m < 4; ++m) { const size_t r = (size_t)(row0 + ai * 128 + m * 16);
#pragma unroll
                for (int bj = 0; bj < 2; ++bj) { const int c = col0 + bj * 128;
                    const u32x4 g = *(const u32x4*)(Gt + r * GW + SECOND * 1024 + c);
                    f32x4 v0 = acc[ai][bj][m][0] * bs, v1 = acc[ai][bj][m][1] * bs;
                    v0[0] *= bf_lo(g.x); v0[1] *= bf_hi(g.x); v0[2] *= bf_lo(g.y); v0[3] *= bf_hi(g.y);
                    v1[0] *= bf_lo(g.z); v1[1] *= bf_hi(g.z); v1[2] *= bf_lo(g.w); v1[3] *= bf_hi(g.w);
                    if (SECOND) { const u32x4 p = *(const u32x4*)(Mx + r * D + c);
                        v0[0] += bf_lo(p.x); v0[1] += bf_hi(p.x); v0[2] += bf_lo(p.y); v0[3] += bf_hi(p.y);
                        v1[0] += bf_lo(p.z); v1[1] += bf_hi(p.z); v1[2] += bf_lo(p.w); v1[3] += bf_hi(p.w);
                        v0 = v0 * MIX_S8; v1 = v1 * MIX_S8;
                        int lo = __builtin_amdgcn_cvt_pk_fp8_f32(v0[0], v0[1], 0, false); lo = __builtin_amdgcn_cvt_pk_fp8_f32(v0[2], v0[3], lo, true);
                        int hi = __builtin_amdgcn_cvt_pk_fp8_f32(v1[0], v1[1], 0, false); hi = __builtin_amdgcn_cvt_pk_fp8_f32(v1[2], v1[3], hi, true);
                        *(u32x2*)(Mx8 + r * D + c) = (u32x2){(unsigned)lo, (unsigned)hi}; }
                    else { u32x4 w; w.x = cvt_pk_bf16(v0[0], v0[1]); w.y = cvt_pk_bf16(v0[2], v0[3]); w.z = cvt_pk_bf16(v1[0], v1[1]); w.w = cvt_pk_bf16(v1[2], v1[3]);
                        *(u32x4*)(Mx + r * D + c) = w; } } }
    }
};

struct EpiOutProj {
    static constexpr bool PERM = false;
    const float* X; float* O; const float* mod;
    __device__ __forceinline__ void operator()(AccRef acc, const Unit& u, int wr, int wc, int fr, int fq) const {
        asm volatile("" : "+v"(fr), "+v"(fq));
        const int row0 = u.pm * 256 + wr * 64 + fr, col0 = u.pn * 256 + wc * 32 + 4 * fq;
        const float* g1 = mod + (size_t)((u.pm * 256) / SEQ) * 6144 + 2048;
        f32x4 gv[2][2];
#pragma unroll
        for (int bj = 0; bj < 2; ++bj)
#pragma unroll
            for (int n = 0; n < 2; ++n) gv[bj][n] = *(const f32x4*)(g1 + col0 + bj * 128 + n * 16);
#pragma unroll
        for (int ai = 0; ai < 2; ++ai)
#pragma unroll
            for (int m = 0; m < 4; ++m) { const size_t off = (size_t)(row0 + ai * 128 + m * 16) * D + col0;
#pragma unroll
                for (int bj = 0; bj < 2; ++bj)
#pragma unroll
                    for (int n = 0; n < 2; ++n) { const f32x4 xv = *(const f32x4*)(X + off + bj * 128 + n * 16);
                        *(f32x4*)(O + off + bj * 128 + n * 16) = xv + gv[bj][n] * acc[ai][bj][m][n] * (1.0f / (MIX_S8 * WSCALE8)); }
                if (m & 1) asm volatile("" ::: "memory"); }
    }
};

struct EpiRouter {
    static constexpr bool PERM = false;
    float* L;
    __device__ __forceinline__ void operator()(AccRef acc, const Unit& u, int wr, int wc, int fr, int fq) const {
        asm volatile("" : "+v"(fr), "+v"(fq));
        if (wc >= 2) return;
        const int row0 = u.pm * 256 + wr * 64 + fr, col0 = wc * 32 + 4 * fq;
#pragma unroll
        for (int ai = 0; ai < 2; ++ai)
#pragma unroll
            for (int m = 0; m < 4; ++m)
#pragma unroll
                for (int n = 0; n < 2; ++n) *(f32x4*)(L + (size_t)(row0 + ai * 128 + m * 16) * 64 + col0 + n * 16) = acc[ai][0][m][n];
    }
};

struct MoeSched1 {
    const LAS unsigned* tab; int ntiles, G, c;
    __device__ __forceinline__ bool next(int i, Unit& u) const {
        const int L = i * G + c; if (L >= 256 + 2 * ntiles) return false;
        u.pn = L & 1;
        if (L < 256) { u.pm = L >> 1; u.aux0 = (u.pm * 256) | (64 << 20); u.aux1 = 256; }
        else { const int t = (L - 256) >> 1; u.pm = t; u.aux0 = __builtin_amdgcn_readfirstlane((int)tab[2 * t]); u.aux1 = __builtin_amdgcn_readfirstlane((int)tab[2 * t + 1]); }
        return true;
    }
};
struct MoeSrc1 {
    static constexpr int ESZ = 2; static constexpr bool GATHER = true;
    const unsigned char* ws;
    __device__ __forceinline__ const char* a_base(const Unit&) const { return (const char*)(ws + WS_H2); }
    __device__ __forceinline__ const char* b_base(const Unit& u) const { const int e = u.aux0 >> 20;
        const size_t off = (e == 64 ? WS_WSH1 : WS_W1T + (size_t)e * 512 * 1024 * 2) + (size_t)u.pn * 256 * 1024 * 2; return (const char*)ws + off; }
    __device__ __forceinline__ unsigned a_off(const Unit& u, int R, int C) const {
        const int e = u.aux0 >> 20, pos0 = u.aux0 & 0xFFFFF; int tok;
        if (e == 64) tok = pos0 + R; else tok = (R < u.aux1) ? (((const int*)(ws + WS_STOK))[pos0 + R] >> 3) : 0;
        return (unsigned)tok * 2048u + (unsigned)C * 2u; }
};
struct EpiMoe1 {
    static constexpr bool PERM = true;
    unsigned char* ws;
    __device__ __forceinline__ void operator()(AccRef acc, const Unit& u, int wr, int wc, int fr, int fq) const {
        asm volatile("" : "+v"(fr), "+v"(fq));
        const int e = u.aux0 >> 20, pos0 = u.aux0 & 0xFFFFF;
        bf16_t* base = (bf16_t*)(ws + (e == 64 ? WS_ACTS : WS_ACT)) + (size_t)pos0 * FF + u.pn * 128 + wc * 32 + 8 * fq;
#pragma unroll
        for (int ai = 0; ai < 2; ++ai)
#pragma unroll
            for (int m = 0; m < 4; ++m) { const int r = ai * 128 + wr * 64 + m * 16 + fr;
                float o[8];
#pragma unroll
                for (int n = 0; n < 2; ++n)
#pragma unroll
                    for (int j = 0; j < 4; ++j) { const float g = acc[ai][0][m][n][j], up = acc[ai][1][m][n][j]; o[4 * n + j] = g * fast_sigmoid(g) * up; }
                u32x4 w; w.x = cvt_pk_bf16(o[0], o[1]); w.y = cvt_pk_bf16(o[2], o[3]); w.z = cvt_pk_bf16(o[4], o[5]); w.w = cvt_pk_bf16(o[6], o[7]);
                if (r < u.aux1) *(u32x4*)(base + (size_t)r * FF) = w; }
    }
};
struct MoeSched2 {
    const LAS unsigned* tab; int t0, ntiles, nsh, G, c;
    __device__ __forceinline__ bool next(int i, Unit& u) const {
        const int L = i * G + c; if (L >= nsh + 4 * ntiles) return false;
        u.pn = L & 3;
        if (L < nsh) { u.pm = L >> 2; u.aux0 = (u.pm * 256) | (64 << 20); u.aux1 = 256; }
        else { const int t = t0 + ((L - nsh) >> 2); u.pm = t; u.aux0 = __builtin_amdgcn_readfirstlane((int)tab[2 * t]); u.aux1 = __builtin_amdgcn_readfirstlane((int)tab[2 * t + 1]); }
        return true;
    }
};
struct MoeSrc2 {
    static constexpr int ESZ = 2; static constexpr bool GATHER = true;
    const unsigned char* ws;
    __device__ __forceinline__ const char* a_base(const Unit& u) const { return (const char*)ws + ((u.aux0 >> 20) == 64 ? WS_ACTS : WS_ACT); }
    __device__ __forceinline__ const char* b_base(const Unit& u) const { const int e = u.aux0 >> 20;
        const size_t off = (e == 64 ? WS_WSH2 : WS_W2T + (size_t)e * 1024 * 256 * 2) + (size_t)u.pn * 256 * 256 * 2; return (const char*)ws + off; }
    __device__ __forceinline__ unsigned a_off(const Unit& u, int R, int C) const {
        const int pos0 = u.aux0 & 0xFFFFF; const int rr = R < u.aux1 ? R : u.aux1 - 1;
        return (unsigned)(pos0 + rr) * 512u + (unsigned)C * 2u; }
};
constexpr float SLOT_SCALE = 16.0f;
constexpr int NSLOT = 9;
struct EpiMoe2 {
    static constexpr bool PERM = true;
    unsigned char* ws; float* X1; int tokbase;
    __device__ __forceinline__ void operator()(AccRef acc, const Unit& u, int wr, int wc, int fr, int fq) const {
        asm volatile("" : "+v"(fr), "+v"(fq));
        const int e = u.aux0 >> 20, pos0 = u.aux0 & 0xFFFFF; const int col0 = u.pn * 256 + wc * 32 + 8 * fq;
        if (e == 64) {
#pragma unroll
            for (int ai = 0; ai < 2; ++ai)
#pragma unroll
                for (int m = 0; m < 4; ++m) { unsigned char* rowp = (unsigned char*)(ws + WS_SLOT) + ((size_t)(pos0 + ai * 128 + wr * 64 + m * 16 + fr) * NSLOT + 8) * D + u.pn * 256 + wc * 64 + fq * 16;
                    u32x4 o;
#pragma unroll
                    for (int bj = 0; bj < 2; ++bj) { const f32x4 v0 = acc[ai][bj][m][0] * SLOT_SCALE, v1 = acc[ai][bj][m][1] * SLOT_SCALE;
                        int lo = __builtin_amdgcn_cvt_pk_fp8_f32(v0[0], v0[1], 0, false); lo = __builtin_amdgcn_cvt_pk_fp8_f32(v0[2], v0[3], lo, true);
                        int hi = __builtin_amdgcn_cvt_pk_fp8_f32(v1[0], v1[1], 0, false); hi = __builtin_amdgcn_cvt_pk_fp8_f32(v1[2], v1[3], hi, true);
                        if (bj == 0) { o.x = (unsigned)lo; o.y = (unsigned)hi; } else { o.z = (unsigned)lo; o.w = (unsigned)hi; } }
                    *(u32x4*)rowp = o;
                    asm volatile("" ::: "memory"); }
        } else {
#pragma unroll
            for (int ai = 0; ai < 2; ++ai)
#pragma unroll
                for (int m = 0; m < 4; ++m) { const int r = ai * 128 + wr * 64 + m * 16 + fr;
                    if (r < u.aux1) { const int tk = ((const int*)(ws + WS_STOK))[pos0 + r]; const float w = ((const float*)(ws + WS_SW))[pos0 + r] * SLOT_SCALE;
                        unsigned char* rowp = (unsigned char*)(ws + WS_SLOT) + ((size_t)(tk >> 3) * NSLOT + (tk & 7)) * D + u.pn * 256 + wc * 64 + fq * 16;
                        u32x4 o;
#pragma unroll
                        for (int bj = 0; bj < 2; ++bj) { const f32x4 v0 = acc[ai][bj][m][0] * w, v1 = acc[ai][bj][m][1] * w;
                            int lo = __builtin_amdgcn_cvt_pk_fp8_f32(v0[0], v0[1], 0, false); lo = __builtin_amdgcn_cvt_pk_fp8_f32(v0[2], v0[3], lo, true);
                            int hi = __builtin_amdgcn_cvt_pk_fp8_f32(v1[0], v1[1], 0, false); hi = __builtin_amdgcn_cvt_pk_fp8_f32(v1[2], v1[3], hi, true);
                            if (bj == 0) { o.x = (unsigned)lo; o.y = (unsigned)hi; } else { o.z = (unsigned)lo; o.w = (unsigned)hi; } }
                        *(u32x4*)rowp = o; }
                    asm volatile("" ::: "memory"); }
        }
    }
};
__device__ __forceinline__ unsigned ord_key(float x) { const unsigned b = __float_as_uint(x); return (b & 0x80000000u) ? ~b : (b | 0x80000000u); }

__device__ __forceinline__ void indexer_unit(const Args& args, Frame& F, int b, int q0) {
    const bf16_t* Z = (const bf16_t*)(F.ws + WS_Z) + (size_t)b * SEQ * ZW;
    unsigned* SELM = (unsigned*)(F.ws + WS_SEL) + (size_t)b * SEQ * 128;
    int tid = F.tid; asm volatile("" : "+v"(tid));
    const int lane = tid & 63, kl = lane & 31, hl = lane >> 5, w = F.wave;
    const int qa = q0 + 2 * w;
    const int myq = qa + hl;
    bf16x8 A0, A1;
    { const int aq = (kl >> 2) & 1, ah = 4 * (kl >> 3) + (kl & 3);
      const bf16_t* p = Z + (size_t)(qa + aq) * ZW + ZIQ + ah * 32 + 8 * hl;
      A0 = *(const bf16x8*)p; A1 = *(const bf16x8*)(p + 16); }
    float wq[16];
    { const bf16_t* p = Z + (size_t)myq * ZW + ZIW; const u32x4 a = *(const u32x4*)p, c = *(const u32x4*)(p + 8);
      wq[0] = bf_lo(a.x); wq[1] = bf_hi(a.x); wq[2] = bf_lo(a.y); wq[3] = bf_hi(a.y); wq[4] = bf_lo(a.z); wq[5] = bf_hi(a.z); wq[6] = bf_lo(a.w); wq[7] = bf_hi(a.w);
      wq[8] = bf_lo(c.x); wq[9] = bf_hi(c.x); wq[10] = bf_lo(c.y); wq[11] = bf_hi(c.y); wq[12] = bf_lo(c.z); wq[13] = bf_hi(c.z); wq[14] = bf_lo(c.w); wq[15] = bf_hi(c.w); }
    unsigned key[128];
    const int nchunk = (q0 + 15) / 1024 + 1;
#define IDX_LOAD(ch, buf) do { _Pragma("unroll") for (int _h = 0; _h < 2; ++_h) { u32x4 v_[4]; \
        _Pragma("unroll") for (int _i = 0; _i < 4; ++_i) { const int pc = tid + 512 * (4 * _h + _i); const int kk = pc >> 2, c4 = pc & 3; v_[_i] = *(const u32x4*)(Z + (size_t)((ch) * 1024 + kk) * ZW + ZIK + 8 * c4); } \
        _Pragma("unroll") for (int _i = 0; _i < 4; ++_i) { const int pc = tid + 512 * (4 * _h + _i); const int kk = pc >> 2, c4 = pc & 3; *(LAS u32x4*)(F.lds + (buf) * 65536 + (c4 * 1024 + kk) * 16) = v_[_i]; } \
        asm volatile("" ::: "memory"); } } while (0)
    IDX_LOAD(0, 0);
    __syncthreads();
#pragma unroll
    for (int ch = 0; ch < 4; ++ch) {
        if (ch < nchunk) {
            if (ch + 1 < nchunk) IDX_LOAD(ch + 1, (ch + 1) & 1);
            LAS unsigned char* kbl = F.lds + (ch & 1) * 65536 + hl * 16384 + kl * 16; asm volatile("" : "+v"(kbl));
#pragma unroll
            for (int tt = 0; tt < 32; tt += 2) {
                const int t = ch * 32 + tt;
                if (32 * t <= qa + 1) {
                    bf16x8 B0[2], B1[2]; f32x16 acc[2];
#pragma unroll
                    for (int j = 0; j < 2; ++j) { B0[j] = *(const LAS bf16x8*)(kbl + 512 * (tt + j)); B1[j] = *(const LAS bf16x8*)(kbl + 32768 + 512 * (tt + j)); }
#pragma unroll
                    for (int j = 0; j < 2; ++j) { acc[j] = f32x16{}; acc[j] = __builtin_amdgcn_mfma_f32_32x32x16_bf16(A0, B0[j], acc[j], 0, 0, 0); }
#pragma unroll
                    for (int j = 0; j < 2; ++j) acc[j] = __builtin_amdgcn_mfma_f32_32x32x16_bf16(A1, B1[j], acc[j], 0, 0, 0);
#pragma unroll
                    for (int j = 0; j < 2; ++j) { float s = 0.f;
#pragma unroll
                        for (int i = 0; i < 16; ++i) { const float av_ = acc[j][i]; const int xb_ = __float_as_int(av_); s += __int_as_float(xb_ > 0 ? xb_ : 0) * wq[i]; }
                        key[t + j] = (32 * (t + j) + kl <= myq) ? ord_key(s) : 0u; }
                } else {
#pragma unroll
                    for (int j = 0; j < 2; ++j) key[t + j] = 0u;
                }
            }
            __syncthreads();
        } else {
#pragma unroll
            for (int tt = 0; tt < 32; ++tt) key[ch * 32 + tt] = 0u;
        }
    }
#undef IDX_LOAD
#pragma unroll
    for (int w = 0; w < 4; ++w) {
        if (1024 * w <= qa + 1) {
#pragma unroll
            for (int k = 0; k < 16; ++k) { const unsigned lo = key[32 * w + k], hi_ = key[32 * w + k + 16];
                key[32 * w + k] = __builtin_amdgcn_perm(hi_, lo, 0x05040100u); key[32 * w + k + 16] = __builtin_amdgcn_perm(hi_, lo, 0x07060302u); }
#pragma unroll
            for (int k = 0; k < 32; ++k) if (!(k & 8)) { const unsigned lo = key[32 * w + k], hi_ = key[32 * w + k + 8];
                key[32 * w + k] = __builtin_amdgcn_perm(hi_, lo, 0x06020400u); key[32 * w + k + 8] = __builtin_amdgcn_perm(hi_, lo, 0x07030501u); }
#pragma unroll
            for (int k = 0; k < 32; ++k) if (!(k & 4)) { const unsigned lo = key[32 * w + k], hi_ = key[32 * w + k + 4]; const unsigned m = 0x0F0F0F0Fu;
                key[32 * w + k] = (lo & m) | ((hi_ << 4) & ~m); key[32 * w + k + 4] = ((lo >> 4) & m) | (hi_ & ~m); }
#pragma unroll
            for (int k = 0; k < 32; ++k) if (!(k & 2)) { const unsigned lo = key[32 * w + k], hi_ = key[32 * w + k + 2]; const unsigned m = 0x33333333u;
                key[32 * w + k] = (lo & m) | ((hi_ << 2) & ~m); key[32 * w + k + 2] = ((lo >> 2) & m) | (hi_ & ~m); }
#pragma unroll
            for (int k = 0; k < 32; ++k) if (!(k & 1)) { const unsigned lo = key[32 * w + k], hi_ = key[32 * w + k + 1]; const unsigned m = 0x55555555u;
                key[32 * w + k] = (lo & m) | ((hi_ << 1) & ~m); key[32 * w + k + 1] = ((lo >> 1) & m) | (hi_ & ~m); }
        }
    }
    unsigned Al[4] = {~0u, ~0u, ~0u, ~0u}, Gt[4] = {0u, 0u, 0u, 0u};
    int ab0 = 0, ab1 = 0; unsigned T0 = 0u, T1 = 0u; bool dn0 = false, dn1 = false;
#define IDX_DPP(v, ctrl) __builtin_amdgcn_update_dpp(0, (v), (ctrl), 0xF, 0xF, true)
#pragma unroll
    for (int bit = 31; bit >= 0; --bit) {
        unsigned S_[4]; int c = 0;
#pragma unroll
        for (int w = 0; w < 4; ++w) { S_[w] = Al[w] & key[32 * w + bit]; c += __builtin_popcount(S_[w]); }
        c += IDX_DPP(c, 0xB1); c += IDX_DPP(c, 0x4E); c += IDX_DPP(c, 0x141); c += IDX_DPP(c, 0x140);
        const int cn0 = ab0 + __builtin_amdgcn_readlane(c, 0) + __builtin_amdgcn_readlane(c, 16), cn1 = ab1 + __builtin_amdgcn_readlane(c, 32) + __builtin_amdgcn_readlane(c, 48);
        const bool t0 = cn0 >= 256, t1 = cn1 >= 256;
        if (t0) { T0 |= 1u << bit; dn0 = dn0 || cn0 == 256; } else ab0 = cn0;
        if (t1) { T1 |= 1u << bit; dn1 = dn1 || cn1 == 256; } else ab1 = cn1;
        const unsigned nm = hl ? (t1 ? 0u : ~0u) : (t0 ? 0u : ~0u);
#pragma unroll
        for (int w = 0; w < 4; ++w) { Al[w] &= key[32 * w + bit] ^ nm; Gt[w] |= S_[w] & nm; }
        if (dn0 && dn1) break;
    }
#undef IDX_DPP
    unsigned x[4];
    { const bool nz = hl ? (T1 != 0u) : (T0 != 0u);
#pragma unroll
      for (int w = 0; w < 4; ++w) x[w] = Gt[w] | (nz ? Al[w] : 0u); }
#define IDX_BFLY(d, m) do { const bool up_ = (kl & (d)) != 0; const unsigned km_ = up_ ? ~(m) : (m); const unsigned am_ = up_ ? (unsigned)(d) : 32u - (d); \
        _Pragma("unroll") for (int w = 0; w < 4; ++w) { const unsigned t_ = (unsigned)__builtin_amdgcn_ds_swizzle((int)x[w], 0x1F | ((d) << 10)); \
            const unsigned rot_ = __builtin_amdgcn_alignbit(t_, t_, am_); x[w] = (x[w] & km_) | (rot_ & ~km_); } } while (0)
    IDX_BFLY(16, 0x0000FFFFu); IDX_BFLY(8, 0x00FF00FFu); IDX_BFLY(4, 0x0F0F0F0Fu); IDX_BFLY(2, 0x33333333u); IDX_BFLY(1, 0x55555555u);
#undef IDX_BFLY
#pragma unroll
    for (int j = 0; j < 4; ++j) SELM[(size_t)myq * 128 + kl + 32 * j] = x[j];
}

__device__ __forceinline__ void indexer_phase(const Args& args, Frame& F) {
    const int c = blockIdx.x;
    for (int i = 0; i < 8; ++i) {
        for (int u = c + i * F.G; u < 2048 && i < 8; u += 2048) {
            const int b = u >> 8, pos = u & 255, blk = (b & 1) ? 255 - pos : pos;
            indexer_unit(args, F, b, blk * 16);
        }
    }
}
namespace att {
constexpr int DM = ZW, QB = 256, KVB = 64, SLOTB = 8192;
constexpr int L_K = 0, L_V = 2 * SLOTB, L_MASK = 4 * SLOTB, L_WSF = L_MASK + 8 * 2048, L_OST = L_WSF + 8 * 256, L_BT = L_OST + 8 * 4096, L_END = L_BT + 512;
__device__ __forceinline__ int crow(int r, int hi) { return (r & 3) + 8 * (r >> 2) + 4 * hi; }
__device__ __forceinline__ void glds16(const void* gsrc, unsigned lds_dst) { unsigned keep;
    asm volatile("s_mov_b32 %0, m0\n\ts_mov_b32 m0, %2\n\ts_nop 0\n\tglobal_load_lds_dwordx4 %1, off\n\ts_mov_b32 m0, %0" : "=&s"(keep) : "v"(gsrc), "s"(lds_dst) : "memory"); }
__device__ __forceinline__ unsigned cvtpk(float lo, float hi) { return cvt_pk_bf16(lo, hi); }
typedef short s16x4 __attribute__((ext_vector_type(4)));

__device__ __forceinline__ void attn_unit(const Args& args, Frame& F, int b, int h, int qb) {
    const int lane = F.lane, r32 = lane & 31, hi = lane >> 5, wid = F.wave;
    const bf16_t* Zb = (const bf16_t*)(F.ws + WS_Z) + (size_t)b * SEQ * DM;
    const int q0 = qb * QB;
    const bf16_t* Qw = Zb + (size_t)(q0 + wid * 32) * DM + ZQ + h * 64;
    const bf16_t* Kh = Zb + ZK + h * 64; const bf16_t* Vh = Zb + ZV + h * 64;
    LAS unsigned char* shm = F.lds;
    const unsigned lds0 = (unsigned)(uintptr_t)shm;
    LAS float* wsf = (LAS float*)(shm + L_WSF) + wid * 64;
    LAS float* bt = (LAS float*)(shm + L_BT);
    if (F.tid < 128) { const int rel = F.tid; int bk;
        if (rel < 16) bk = rel; else { bk = 16 + (int)(logf((float)rel / 16.0f) / logf(8.0f) * 16.0f); bk = bk < 31 ? bk : 31; }
        bt[rel] = (AIN(6)[bk * 8 + h] - AIN(6)[31 * 8 + h]) * 1.4426950408889634f; }
    const bf16_t* ksrc = Kh + (size_t)lane * DM + wid * 8;
    const bf16_t* vsrc = Vh + (size_t)(16 * (wid & 3) + (lane >> 2)) * DM + (wid >> 2) * 32 + (lane & 3) * 8;
    const unsigned kdst = lds0 + L_K + wid * 1024, vdst = lds0 + L_V + wid * 1024;
    const unsigned* SELM = (const unsigned*)(F.ws + WS_SEL) + (size_t)(b * SEQ + q0 + wid * 32 + r32) * 128 + 4 * hi;
    const unsigned mdst = lds0 + L_MASK + wid * 2048;
#define DMA_K(t, slot) glds16(ksrc + (size_t)(t) * KVB * DM, (unsigned)__builtin_amdgcn_readfirstlane(kdst + (slot) * SLOTB))
#define DMA_V(t, slot) glds16(vsrc + (size_t)(t) * KVB * DM, (unsigned)__builtin_amdgcn_readfirstlane(vdst + (slot) * SLOTB))
#define DMA_M(g) glds16(SELM + 8 * (g), (unsigned)__builtin_amdgcn_readfirstlane(mdst + ((g) & 1) * 1024))
    const int NT = (q0 + QB) / KVB;
    bf16x8 qr[4];
#pragma unroll
    for (int d0 = 0; d0 < 4; ++d0) qr[d0] = *(const bf16x8*)(Qw + (size_t)r32 * DM + d0 * 16 + hi * 8);
    asm volatile("s_waitcnt vmcnt(0)" ::: "memory");
    __syncthreads();
    DMA_M(0); DMA_K(0, 0); DMA_V(0, 0);
    float m_run = -1e30f, l_run = 0.f; f32x16 o[2]; o[0] = f32x16{}; o[1] = f32x16{};
    const int qpos = q0 + wid * 32 + r32;
    const int vb0 = (int)(lds0 + L_V) + ((lane >> 4) & 1) * 32 + (lane & 3) * 8 + (4 * hi + ((lane & 15) >> 2)) * 64;
    for (int t = 0; t < NT; ++t) {
        const int slot = t & 1, g = t >> 2, tq = t & 3;
        if (t + 1 < NT) {
            DMA_K(t + 1, slot ^ 1); DMA_V(t + 1, slot ^ 1);
            if (tq == 0) { DMA_M(g + 1); asm volatile("s_waitcnt vmcnt(3)" ::: "memory"); }
            else if (tq == 1) asm volatile("s_waitcnt vmcnt(3)" ::: "memory");
            else asm volatile("s_waitcnt vmcnt(2)" ::: "memory");
        } else asm volatile("s_waitcnt vmcnt(0)" ::: "memory");
        __builtin_amdgcn_s_barrier(); asm volatile("" ::: "memory");
        f32x16 p0 = {}, p1 = {};
        { const LAS unsigned char* kb = shm + L_K + slot * SLOTB + hi * 1024 + r32 * 16;
#pragma unroll
          for (int d0 = 0; d0 < 4; ++d0) { const bf16x8 b0 = *(const LAS bf16x8*)(kb + d0 * 2048); const bf16x8 b1 = *(const LAS bf16x8*)(kb + d0 * 2048 + 512);
              p0 = __builtin_amdgcn_mfma_f32_32x32x16_bf16(b0, qr[d0], p0, 0, 0, 0); p1 = __builtin_amdgcn_mfma_f32_32x32x16_bf16(b1, qr[d0], p1, 0, 0, 0); } }
        const u32x2 mwv = *(const LAS u32x2*)(shm + L_MASK + wid * 2048 + (g & 1) * 1024 + (tq >> 1) * 512 + r32 * 16 + (tq & 1) * 8);
        if (64 * t + 63 + 112 >= q0 + wid * 32) {
#pragma unroll
            for (int r = 0; r < 16; ++r) { const int kv = 64 * t + crow(r, hi); int r0 = qpos - kv, r1 = r0 - 32;
                r0 = r0 < 0 ? 0 : (r0 > 127 ? 127 : r0); r1 = r1 < 0 ? 0 : (r1 > 127 ? 127 : r1);
                p0[r] += bt[r0]; p1[r] += bt[r1]; }
        }
        const float NEG = -INFINITY;
#pragma unroll
        for (int r = 0; r < 16; ++r) { const int bitp = crow(r, hi);
            if (!((mwv.x >> bitp) & 1u)) p0[r] = NEG;
            if (!((mwv.y >> bitp) & 1u)) p1[r] = NEG; }
        float rm = p0[0];
#pragma unroll
        for (int r = 1; r < 16; ++r) rm = __builtin_fmaxf(rm, p0[r]);
#pragma unroll
        for (int r = 0; r < 16; ++r) rm = __builtin_fmaxf(rm, p1[r]);
        rm = __builtin_fmaxf(rm, __shfl_xor(rm, 32));
        const float m_new = __builtin_fmaxf(m_run, rm);
        const float f = __builtin_amdgcn_exp2f(m_run - m_new);
        m_run = m_new;
        float sacc = 0.f;
#pragma unroll
        for (int r = 0; r < 16; ++r) { p0[r] = __builtin_amdgcn_exp2f(p0[r] - m_new); p1[r] = __builtin_amdgcn_exp2f(p1[r] - m_new); sacc += p0[r] + p1[r]; }
        l_run = l_run * f + sacc;
        if (hi == 0) wsf[r32] = f;
        asm volatile("s_waitcnt lgkmcnt(0)" ::: "memory");
#pragma unroll
        for (int d = 0; d < 2; ++d)
#pragma unroll
            for (int r = 0; r < 16; ++r) o[d][r] *= wsf[crow(r, hi)];
        u32x4 pw0, pw1, pw2, pw3;
        pw0 = (u32x4){cvtpk(p0[0], p0[1]), cvtpk(p0[2], p0[3]), cvtpk(p0[4], p0[5]), cvtpk(p0[6], p0[7])};
        pw1 = (u32x4){cvtpk(p0[8], p0[9]), cvtpk(p0[10], p0[11]), cvtpk(p0[12], p0[13]), cvtpk(p0[14], p0[15])};
        pw2 = (u32x4){cvtpk(p1[0], p1[1]), cvtpk(p1[2], p1[3]), cvtpk(p1[4], p1[5]), cvtpk(p1[6], p1[7])};
        pw3 = (u32x4){cvtpk(p1[8], p1[9]), cvtpk(p1[10], p1[11]), cvtpk(p1[12], p1[13]), cvtpk(p1[14], p1[15])};
        { const int vb = vb0 + slot * SLOTB;
#pragma unroll
          for (int d0 = 0; d0 < 2; ++d0) { s16x4 lo[4], hh[4];
#pragma unroll
              for (int ks = 0; ks < 4; ++ks) {
                  asm volatile("ds_read_b64_tr_b16 %0,%1 offset:%c2" : "=&v"(lo[ks]) : "v"(vb), "i"(d0 * 4096 + ks * 1024) : "memory");
                  asm volatile("ds_read_b64_tr_b16 %0,%1 offset:%c2" : "=&v"(hh[ks]) : "v"(vb), "i"(d0 * 4096 + ks * 1024 + 512) : "memory"); }
              asm volatile("s_waitcnt lgkmcnt(0)" ::: "memory"); __builtin_amdgcn_sched_barrier(0);
#define PKV(k) (bf16x8){lo[k][0], lo[k][1], lo[k][2], lo[k][3], hh[k][0], hh[k][1], hh[k][2], hh[k][3]}
              o[d0] = __builtin_amdgcn_mfma_f32_32x32x16_bf16(__builtin_bit_cast(bf16x8, pw0), PKV(0), o[d0], 0, 0, 0);
              o[d0] = __builtin_amdgcn_mfma_f32_32x32x16_bf16(__builtin_bit_cast(bf16x8, pw1), PKV(1), o[d0], 0, 0, 0);
              o[d0] = __builtin_amdgcn_mfma_f32_32x32x16_bf16(__builtin_bit_cast(bf16x8, pw2), PKV(2), o[d0], 0, 0, 0);
              o[d0] = __builtin_amdgcn_mfma_f32_32x32x16_bf16(__builtin_bit_cast(bf16x8, pw3), PKV(3), o[d0], 0, 0, 0);
#undef PKV
          } }
        asm volatile("s_waitcnt lgkmcnt(0)" ::: "memory");
        __builtin_amdgcn_s_barrier(); asm volatile("" ::: "memory");
    }
    l_run += __shfl_xor(l_run, 32);
    if (hi == 0) wsf[32 + r32] = l_run;
    asm volatile("s_waitcnt lgkmcnt(0)" ::: "memory");
    bf16_t* Ow = (bf16_t*)(F.ws + WS_R1) + (size_t)(b * SEQ + q0 + wid * 32) * 512 + h * 64;
    { LAS bf16_t* stg = (LAS bf16_t*)(shm + L_OST) + wid * 2048;
#pragma unroll
      for (int r = 0; r < 16; ++r) { const int orow = crow(r, hi); const float rl = __builtin_amdgcn_rcpf(wsf[32 + orow]);
#pragma unroll
          for (int d0 = 0; d0 < 2; ++d0) stg[orow * 64 + d0 * 32 + r32] = (bf16_t)f2bf(o[d0][r] * rl); }
      asm volatile("s_waitcnt lgkmcnt(0)" ::: "memory");
#pragma unroll
      for (int i = 0; i < 4; ++i) { const int row = i * 8 + (lane >> 3), chn = lane & 7; const u32x4 v = *(const LAS u32x4*)(stg + row * 64 + chn * 8); *(u32x4*)(Ow + (size_t)row * 512 + chn * 8) = v; } }
    asm volatile("s_waitcnt lgkmcnt(0)" ::: "memory");
#undef DMA_K
#undef DMA_V
#undef DMA_M
}

__device__ __forceinline__ void attn_phase(const Args& args, Frame& F) {
    const int v = F.vcu;
    for (int i = 0; i < 4; ++i) {
        for (int uu = v; uu < 256; uu += F.G) {
            const int bh = uu >> 2, s = uu & 3; const int qb = (i == 0) ? s : (i == 1) ? 7 - s : (i == 2) ? 8 + s : 15 - s;
            attn_unit(args, F, bh >> 3, bh & 7, qb);
        }
    }
}
}
#ifndef PROBE_NO_STATE
#define PROBE_NO_STATE 0
#endif
#ifndef PROBE_TINV_ID
#define PROBE_TINV_ID 0
#endif
namespace rk {
typedef __bf16 bf16x2_t __attribute__((ext_vector_type(2)));
__device__ __forceinline__ unsigned cvtpk(float lo, float hi) { f32x2 v = {lo, hi}; bf16x2_t b = __builtin_convertvector(v, bf16x2_t); return __builtin_bit_cast(unsigned, b); }
template <int S> __device__ __forceinline__ bf16x8 frag(const f32x16& x) {
    u32x4 o; o.x = cvtpk(x[8 * S + 0], x[8 * S + 1]); o.y = cvtpk(x[8 * S + 2], x[8 * S + 3]); o.z = cvtpk(x[8 * S + 4], x[8 * S + 5]); o.w = cvtpk(x[8 * S + 6], x[8 * S + 7]);
    return __builtin_bit_cast(bf16x8, o); }
template <int S> __device__ __forceinline__ void unfrag(f32x16& x, bf16x8 f) { const u32x4 o = __builtin_bit_cast(u32x4, f);
    x[8 * S + 0] = bf_lo(o.x); x[8 * S + 1] = bf_hi(o.x); x[8 * S + 2] = bf_lo(o.y); x[8 * S + 3] = bf_hi(o.y); x[8 * S + 4] = bf_lo(o.z); x[8 * S + 5] = bf_hi(o.z); x[8 * S + 6] = bf_lo(o.w); x[8 * S + 7] = bf_hi(o.w); }
#define RK_MF(a, b, c) __builtin_amdgcn_mfma_f32_32x32x16_bf16((a), (b), (c), 0, 0, 0)
__device__ __forceinline__ float dppf(float v, const int ctrl_is_const_dummy);
#define RK_DPP(v, ctrl, rmask, bc) __builtin_bit_cast(float, __builtin_amdgcn_update_dpp(0, __builtin_bit_cast(int, (v)), (ctrl), (rmask), 0xF, (bc)))
__device__ __forceinline__ float scan32(float v) {
#ifdef PROBE_SHFL_SCAN
    const int l32 = threadIdx.x & 31;
#pragma unroll
    for (int o = 1; o < 32; o <<= 1) { const float t = __shfl_up(v, o, 32); if (l32 >= o) v += t; }
    return v;
#endif
    v += RK_DPP(v, 0x111, 0xF, true); v += RK_DPP(v, 0x112, 0xF, true); v += RK_DPP(v, 0x114, 0xF, true); v += RK_DPP(v, 0x118, 0xF, true);
    v += RK_DPP(v, 0x142, 0xA, false);
    return v; }
__device__ __forceinline__ float ex2(float x) { return __builtin_amdgcn_exp2f(x); }
constexpr int PZ = 3600;
constexpr size_t SZ_G = 8192, SZ_H = 8192, SZ_Q = 4096, SZ_Y = 4096;
constexpr float L2E = 1.4426950408889634f;

__device__ __forceinline__ void mk_id(bf16x8 (&fId)[2], int r, int h) {
    asm volatile("" : "+v"(r), "+v"(h));
#pragma unroll
    for (int s = 0; s < 2; ++s) { unsigned short e8[8];
#pragma unroll
        for (int jj = 0; jj < 8; ++jj) e8[jj] = (16 * s + 8 * (jj >> 2) + 4 * h + (jj & 3) == r) ? (unsigned short)0x3F80 : (unsigned short)0;
        fId[s] = __builtin_bit_cast(bf16x8, (u32x4){(unsigned)e8[0] | ((unsigned)e8[1] << 16), (unsigned)e8[2] | ((unsigned)e8[3] << 16), (unsigned)e8[4] | ((unsigned)e8[5] << 16), (unsigned)e8[6] | ((unsigned)e8[7] << 16)}); }
}

__device__ __forceinline__ void load_params(const Args& args, Frame& F) {
    LAS float* pra = (LAS float*)(F.lds + LDS_PARA); LAS float* prb = (LAS float*)(F.lds + LDS_PARB);
    const float* mu = AIN(7); const float* w0 = AIN(8); const float* a0 = AIN(10); const float* kk = AIN(13); const float* ka = AIN(14); const float* rk = AIN(15);
    for (int i = F.tid; i < 4096; i += NTHR) { const int a = i >> 9, c = i & 511;
        const float v_ = a < 3 ? mu[a * 512 + c] : (a == 3 ? w0[c] : (a == 4 ? a0[c] : (a == 5 ? kk[c] : (a == 6 ? ka[c] : rk[c]))));
        if (a < 4) pra[c * 4 + a] = v_; else prb[c * 4 + a - 4] = v_; }
    __syncthreads();
}
struct ElemCtx { const LAS unsigned char* rowc; const LAS unsigned char* rowp; const bf16_t* DUt; const bf16_t* IUt; const LAS float* pra; const LAS float* prb; int hd, r, h; float inv; };
template <int MODE> __device__ __forceinline__ void r1_elem(const ElemCtx& C, int jt, bf16x8 (&o0)[2], bf16x8 (&o1)[2], bf16x8 (&o2)[2], bf16x8 (&o3)[2], float& bns, float& pcd) {
    const int r = C.r, h = C.h, hd = C.hd;
    f32x16 lw_ = f32x16{}, la_ = f32x16{};
#pragma unroll
    for (int ks = 0; ks < 4; ++ks) { const int k0 = 16 * ks + 8 * h;
        const bf16x8 bw = *(const LAS bf16x8*)(C.rowc + (1536 + k0) * 2), ba = *(const LAS bf16x8*)(C.rowc + (1600 + k0) * 2);
        const bf16x8 fa = *(const bf16x8*)(C.DUt + (size_t)(32 * jt + r) * 64 + k0), fi = *(const bf16x8*)(C.IUt + (size_t)(32 * jt + r) * 64 + k0);
        lw_ = RK_MF(fa, bw, lw_); la_ = RK_MF(fi, ba, la_); }
    float d = 0.f;
#pragma unroll
    for (int s = 0; s < 2; ++s) { float x0[8], x1[8], x2[8], x3[8];
#pragma unroll
        for (int g2 = 0; g2 < 2; ++g2) { const int g = 2 * s + g2, cj = hd * 64 + 32 * jt + 8 * g + 4 * h;
            float kc[4], kq[4], xc[4], xq[4];
            { const u32x2 a = *(const LAS u32x2*)(C.rowc + (512 + cj) * 2), p = *(const LAS u32x2*)(C.rowp + (512 + cj) * 2);
              kc[0] = bf_lo(a.x); kc[1] = bf_hi(a.x); kc[2] = bf_lo(a.y); kc[3] = bf_hi(a.y); kq[0] = bf_lo(p.x); kq[1] = bf_hi(p.x); kq[2] = bf_lo(p.y); kq[3] = bf_hi(p.y); }
            { const int xo = MODE ? 1024 : 0; const u32x2 a = *(const LAS u32x2*)(C.rowc + (xo + cj) * 2), p = *(const LAS u32x2*)(C.rowp + (xo + cj) * 2);
              xc[0] = bf_lo(a.x); xc[1] = bf_hi(a.x); xc[2] = bf_lo(a.y); xc[3] = bf_hi(a.y); xq[0] = bf_lo(p.x); xq[1] = bf_hi(p.x); xq[2] = bf_lo(p.y); xq[3] = bf_hi(p.y); }
            const LAS f32x4* ppa = (const LAS f32x4*)(C.pra + cj * 4); const LAS f32x4* ppb = (const LAS f32x4*)(C.prb + cj * 4);
#pragma unroll
            for (int q = 0; q < 4; ++q) { const int i = 4 * g + q, o = 4 * g2 + q;
                const f32x4 pa = ppa[q], pb = ppb[q];
                const float e_ = 0.6065306597126334f * fast_sigmoid(pa[3] + lw_[i]); const float L = scan32(e_);
                const float l0 = __builtin_bit_cast(float, __builtin_amdgcn_readlane(__builtin_bit_cast(int, L), 31)), l1 = __builtin_bit_cast(float, __builtin_amdgcn_readlane(__builtin_bit_cast(int, L), 63));
                const float Lend = h ? l1 : l0; if (i == 4 * (r >> 3) + (r & 3)) d = Lend;
                const float x_ = xc[q] + (MODE ? pa[2] : pa[0]) * (xq[q] - xc[q]), k_ = kc[q] + pa[1] * (kq[q] - kc[q]);
                const float ic = fast_sigmoid(pb[0] + la_[i]);
                const float kk = k_ * pb[1] * C.inv, kpn = k_ * (1.0f + (ic - 1.0f) * pb[2]), bv = kk * ic;
                if (MODE) { const float Qe = ex2(L2E * (L - Lend)); x0[o] = bv * Qe; x1[o] = kpn * Qe; x2[o] = x_; x3[o] = 0.f; }
                else { const float P = ex2(-L2E * L), Pi = ex2(L2E * L), Pm = ex2(-L2E * (L - e_)); bns += x_ * kpn * pb[3]; x0[o] = -kk * Pm; x1[o] = x_ * P; x2[o] = bv * Pi; x3[o] = kpn * Pi; } }
            asm volatile("" ::: "memory"); }
        o0[s] = __builtin_bit_cast(bf16x8, (u32x4){cvtpk(x0[0], x0[1]), cvtpk(x0[2], x0[3]), cvtpk(x0[4], x0[5]), cvtpk(x0[6], x0[7])});
        o1[s] = __builtin_bit_cast(bf16x8, (u32x4){cvtpk(x1[0], x1[1]), cvtpk(x1[2], x1[3]), cvtpk(x1[4], x1[5]), cvtpk(x1[6], x1[7])});
        o2[s] = __builtin_bit_cast(bf16x8, (u32x4){cvtpk(x2[0], x2[1]), cvtpk(x2[2], x2[3]), cvtpk(x2[4], x2[5]), cvtpk(x2[6], x2[7])});
        if (!MODE) o3[s] = __builtin_bit_cast(bf16x8, (u32x4){cvtpk(x3[0], x3[1]), cvtpk(x3[2], x3[3]), cvtpk(x3[4], x3[5]), cvtpk(x3[6], x3[7])}); }
    if (MODE) pcd = ex2(-L2E * d);
}


__device__ __forceinline__ void r1_unit(const Args& args, Frame& F, int b, int c) {
    LAS unsigned char* IMG = F.lds;
    const bf16_t* Z = (const bf16_t*)(F.ws + WS_Z);
    const int t0 = 32 * c; const size_t m0 = (size_t)b * SEQ + t0;
    const float* mu = AIN(7);
    int tid = F.tid; asm volatile("" : "+v"(tid));
    __syncthreads();
    for (int p = tid; p < 33 * 224; p += NTHR) { const int rr = p / 224, pc = p - rr * 224; u32x4 v = {0u, 0u, 0u, 0u};
        if (rr > 0 || t0 > 0) v = *(const u32x4*)(Z + (m0 + rr - 1) * ZW + ZR + 8 * pc);
        *(LAS u32x4*)(IMG + rr * PZ + 16 * pc) = v; }
    __syncthreads();
    { u32x4 actv[2];
#pragma unroll
      for (int i = 0; i < 2; ++i) { const int q = tid + NTHR * i, t = q >> 5, kp = q & 31;
          const u32x4 cw = *(const LAS u32x4*)(IMG + (t + 1) * PZ + (1536 + 8 * kp) * 2), pw = *(const LAS u32x4*)(IMG + t * PZ + (1536 + 8 * kp) * 2);
          const f32x4 m0v = *(const f32x4*)(mu + 1536 + 8 * kp), m1v = *(const f32x4*)(mu + 1536 + 8 * kp + 4);
          const unsigned cwa[4] = {cw.x, cw.y, cw.z, cw.w}, pwa[4] = {pw.x, pw.y, pw.z, pw.w}; float x[8];
#pragma unroll
          for (int j = 0; j < 4; ++j) { const float c0 = bf_lo(cwa[j]), c1 = bf_hi(cwa[j]), p0 = bf_lo(pwa[j]), p1 = bf_hi(pwa[j]);
              const float mu0 = j < 2 ? m0v[2 * j] : m1v[2 * j - 4], mu1 = j < 2 ? m0v[2 * j + 1] : m1v[2 * j - 3];
              x[2 * j] = c0 + mu0 * (p0 - c0); x[2 * j + 1] = c1 + mu1 * (p1 - c1); }
#pragma unroll
          for (int j = 0; j < 8; ++j) { if (kp < 8) { const float e2 = ex2(2.885390081777927f * x[j]); x[j] = 1.0f - 2.0f * __builtin_amdgcn_rcpf(e2 + 1.0f); } else if (kp >= 16) x[j] = fast_sigmoid(x[j]); }
          actv[i] = (u32x4){cvtpk(x[0], x[1]), cvtpk(x[2], x[3]), cvtpk(x[4], x[5]), cvtpk(x[6], x[7])}; }
      __syncthreads();
#pragma unroll
      for (int i = 0; i < 2; ++i) { const int q = tid + NTHR * i, t = q >> 5, kp = q & 31; *(LAS u32x4*)(IMG + (t + 1) * PZ + (1536 + 8 * kp) * 2) = actv[i]; }
      __syncthreads(); }
    const int hd = F.wave; int r = tid & 31, h = (tid >> 5) & 1;
    const LAS unsigned char* rowc = IMG + (r + 1) * PZ; const LAS unsigned char* rowp = IMG + r * PZ;
    const bf16_t* DUt = (const bf16_t*)(F.ws + WS_DUT) + (size_t)hd * 4096; const bf16_t* IUt = (const bf16_t*)(F.ws + WS_IUT) + (size_t)hd * 4096;
    const LAS float* pra = (const LAS float*)(F.lds + LDS_PARA); const LAS float* prb = (const LAS float*)(F.lds + LDS_PARB);
    float n2 = 0.f;
#pragma unroll
    for (int jt = 0; jt < 2; ++jt)
#pragma unroll
        for (int g = 0; g < 4; ++g) { const int cj = hd * 64 + 32 * jt + 8 * g + 4 * h;
            const u32x2 a = *(const LAS u32x2*)(rowc + (512 + cj) * 2), p = *(const LAS u32x2*)(rowp + (512 + cj) * 2);
            const float kc[4] = {bf_lo(a.x), bf_hi(a.x), bf_lo(a.y), bf_hi(a.y)}, kq[4] = {bf_lo(p.x), bf_hi(p.x), bf_lo(p.y), bf_hi(p.y)};
            #pragma unroll
            for (int q = 0; q < 4; ++q) { const float muk = pra[(cj + q) * 4 + 1], kkp = prb[(cj + q) * 4 + 1]; const float k_ = kc[q] + muk * (kq[q] - kc[q]); const float kk_ = k_ * kkp; n2 += kk_ * kk_; } }
    n2 += __shfl_xor(n2, 32);
    const float inv = 1.0f / __builtin_fmaxf(sqrtf(n2), 1e-12f);
    float pcd[2] = {0.f, 0.f};
    float bns = 0.f;
    const ElemCtx EC{rowc, rowp, DUt, IUt, pra, prb, hd, r, h, inv};
    f32x16 Aab = f32x16{}, Aak = f32x16{}, Arb = f32x16{}, Ark = f32x16{};
    bf16x8 fRt[2][2], tAt[2][2];
    { bf16x8 fId[2]; mk_id(fId, r, h);
#pragma unroll
    for (int jt = 0; jt < 2; ++jt) { bf16x8 fA[2], fB[2], fK[2]; float pd_ = 0.f;
        r1_elem<0>(EC, jt, fA, fRt[jt], fB, fK, bns, pd_);
        const bf16x8 fA0 = fA[0], fA1 = fA[1], fB0 = fB[0], fB1 = fB[1], fK0 = fK[0], fK1 = fK[1];
        Aab = RK_MF(fB0, fA0, Aab); Aab = RK_MF(fB1, fA1, Aab); Aak = RK_MF(fK0, fA0, Aak); Aak = RK_MF(fK1, fA1, Aak);
        Arb = RK_MF(fB0, fRt[jt][0], Arb); Arb = RK_MF(fB1, fRt[jt][1], Arb); Ark = RK_MF(fK0, fRt[jt][0], Ark); Ark = RK_MF(fK1, fRt[jt][1], Ark);
        { f32x16 t_ = f32x16{}; t_ = RK_MF(fA0, fId[0], t_); t_ = RK_MF(fA1, fId[1], t_); tAt[jt][0] = frag<0>(t_); tAt[jt][1] = frag<1>(t_); } } }
    bns += __shfl_xor(bns, 32);
    if (h == 0) ((float*)(F.ws + WS_TOPW))[(m0 + r) * 8 + hd] = bns;
    LAS unsigned char* stash = IMG + (1 + ((tid & 63) >> 3)) * PZ + hd * 128 + (tid & 7) * 16;
#pragma unroll
    for (int p = 0; p < 4; ++p) *(LAS u32x4*)(stash + 8 * p * PZ) = __builtin_bit_cast(u32x4, fRt[p >> 1][p & 1]);
#pragma unroll
    for (int i = 0; i < 16; ++i) { const int s = 8 * (i >> 2) + 4 * h + (i & 3);
        if (!(s < r)) { Aab[i] = 0.f; Aak[i] = 0.f; } if (!(s <= r)) { Arb[i] = 0.f; Ark[i] = 0.f; } }
    const bf16x8 fAak[2] = {frag<0>(Aak), frag<1>(Aak)}, fArb[2] = {frag<0>(Arb), frag<1>(Arb)}, fArk[2] = {frag<0>(Ark), frag<1>(Ark)};
    bf16x8 fT[2];
    asm volatile("" ::: "memory"); __builtin_amdgcn_sched_barrier(0);
    { float T[32];
#pragma unroll
      for (int s = 31; s >= 0; --s) { float acc = (r == s) ? 1.0f : 0.f; const int is = 4 * (s >> 3) + (s & 3), hs = (s >> 2) & 1;
          const float acol_ = Aab[is]; const int acol_i = __float_as_int(acol_);
#pragma unroll
          for (int u = s + 1; u < (PROBE_TINV_ID ? 0 : 32); ++u) { int sv_; asm volatile("v_readlane_b32 %0, %1, %2" : "=s"(sv_) : "v"(acol_i), "n"(u + 32 * hs)); acc = __builtin_fmaf(T[u], __int_as_float(sv_), acc); }
          T[s] = acc; __builtin_amdgcn_sched_barrier(0); }
#pragma unroll
      for (int s = 0; s < 2; ++s) { float e8[8];
#pragma unroll
          for (int jj = 0; jj < 8; ++jj) { const int i0 = 16 * s + 8 * (jj >> 2) + (jj & 3); float ta = T[i0], tb = T[i0 + 4]; asm volatile("" : "+v"(ta), "+v"(tb)); e8[jj] = h ? tb : ta; }
          fT[s] = __builtin_bit_cast(bf16x8, (u32x4){cvtpk(e8[0], e8[1]), cvtpk(e8[2], e8[3]), cvtpk(e8[4], e8[5]), cvtpk(e8[6], e8[7])}); } }
    asm volatile("" ::: "memory"); __builtin_amdgcn_sched_barrier(0);
    const size_t uid = ((size_t)(b * 8 + hd) * 128 + c);
    unsigned char* gG = F.ws + WS_R0 + uid * SZ_G; unsigned char* gH = F.ws + WS_R2 + uid * SZ_H; unsigned char* gQ = F.ws + WS_H0 + uid * SZ_Q; unsigned char* gY = F.ws + WS_H1 + uid * SZ_Y;
#define RK_ST(base, piece, f) (*(u32x4*)((base) + (piece) * 1024 + (tid & 63) * 16) = __builtin_bit_cast(u32x4, (f)))
    bf16x8 fWt[2][2];
#pragma unroll
    for (int jt = 0; jt < 2; ++jt) { f32x16 w_ = f32x16{}; w_ = RK_MF(fT[0], tAt[jt][0], w_); w_ = RK_MF(fT[1], tAt[jt][1], w_); fWt[jt][0] = frag<0>(w_); fWt[jt][1] = frag<1>(w_);
        f32x16 q_; unfrag<0>(q_, __builtin_bit_cast(bf16x8, *(const LAS u32x4*)(stash + 8 * (2 * jt) * PZ))); unfrag<1>(q_, __builtin_bit_cast(bf16x8, *(const LAS u32x4*)(stash + 8 * (2 * jt + 1) * PZ)));
        q_ = RK_MF(fWt[jt][0], fArb[0], q_); q_ = RK_MF(fWt[jt][1], fArb[1], q_); RK_ST(gQ, 2 * jt, frag<0>(q_)); RK_ST(gQ, 2 * jt + 1, frag<1>(q_)); }
    bf16x8 tBh[2][2], tKh[2][2], tV[2][2];
    { bf16x8 fId[2]; mk_id(fId, r, h);
#pragma unroll
    for (int jt = 0; jt < 2; ++jt) { bf16x8 fBh[2], fKh[2], fV[2], fdum[2]; float bdum = 0.f;
        r1_elem<1>(EC, jt, fBh, fKh, fV, fdum, bdum, pcd[jt]);
        { f32x16 t_ = f32x16{}; t_ = RK_MF(fBh[0], fId[0], t_); t_ = RK_MF(fBh[1], fId[1], t_); tBh[jt][0] = frag<0>(t_); tBh[jt][1] = frag<1>(t_); }
        { f32x16 t_ = f32x16{}; t_ = RK_MF(fKh[0], fId[0], t_); t_ = RK_MF(fKh[1], fId[1], t_); tKh[jt][0] = frag<0>(t_); tKh[jt][1] = frag<1>(t_); }
        { f32x16 t_ = f32x16{}; t_ = RK_MF(fV[0], fId[0], t_); t_ = RK_MF(fV[1], fId[1], t_); tV[jt][0] = frag<0>(t_); tV[jt][1] = frag<1>(t_); } } }
    bf16x8 fUt[2][2];
#pragma unroll
    for (int it = 0; it < 2; ++it) { f32x16 av = f32x16{}; av = RK_MF(fAak[0], tV[it][0], av); av = RK_MF(fAak[1], tV[it][1], av);
        const bf16x8 fav0 = frag<0>(av), fav1 = frag<1>(av); f32x16 u_ = f32x16{}; u_ = RK_MF(fT[0], fav0, u_); u_ = RK_MF(fT[1], fav1, u_); fUt[it][0] = frag<0>(u_); fUt[it][1] = frag<1>(u_); }
#pragma unroll
    for (int it = 0; it < 2; ++it) { f32x16 y_ = f32x16{}; y_ = RK_MF(fUt[it][0], fArb[0], y_); y_ = RK_MF(fUt[it][1], fArb[1], y_); y_ = RK_MF(tV[it][0], fArk[0], y_); y_ = RK_MF(tV[it][1], fArk[1], y_);
        RK_ST(gY, 2 * it, frag<0>(y_)); RK_ST(gY, 2 * it + 1, frag<1>(y_)); }
#pragma unroll
    for (int jt = 0; jt < 2; ++jt)
#pragma unroll
        for (int j2 = 0; j2 < 2; ++j2) { f32x16 g_ = f32x16{}; g_ = RK_MF(fWt[jt][0], tBh[j2][0], g_); g_ = RK_MF(fWt[jt][1], tBh[j2][1], g_);
            if (jt == j2) {
#pragma unroll
                for (int i = 0; i < 16; ++i) if (i == 4 * (r >> 3) + (r & 3) && h == ((r >> 2) & 1)) g_[i] += pcd[jt]; }
            RK_ST(gG, 2 * (jt * 2 + j2), frag<0>(g_)); RK_ST(gG, 2 * (jt * 2 + j2) + 1, frag<1>(g_)); }
#pragma unroll
    for (int j2 = 0; j2 < 2; ++j2)
#pragma unroll
        for (int it = 0; it < 2; ++it) { f32x16 h_ = f32x16{}; h_ = RK_MF(tBh[j2][0], fUt[it][0], h_); h_ = RK_MF(tBh[j2][1], fUt[it][1], h_); h_ = RK_MF(tKh[j2][0], tV[it][0], h_); h_ = RK_MF(tKh[j2][1], tV[it][1], h_);
            RK_ST(gH, 2 * (j2 * 2 + it), frag<0>(h_)); RK_ST(gH, 2 * (j2 * 2 + it) + 1, frag<1>(h_)); }
}

__device__ __forceinline__ void r2_task(const Args& args, Frame& F, int task) {
    const int bh = task >> 1, it = task & 1;
    f32x16 St[2]; St[0] = f32x16{}; St[1] = f32x16{};
    const unsigned char* gG0 = F.ws + WS_R0 + (size_t)bh * 128 * SZ_G + F.lane * 16; unsigned char* gH0 = F.ws + WS_R2 + (size_t)bh * 128 * SZ_H + F.lane * 16;
    bf16x8 fG[2][2][2], fH[2][2], nG[2][2][2], nH[2][2];
#define R2_LOAD(G_, H_, c_) do { _Pragma("unroll") for (int jt = 0; jt < 2; ++jt) _Pragma("unroll") for (int j2 = 0; j2 < 2; ++j2) _Pragma("unroll") for (int s = 0; s < 2; ++s) \
            G_[jt][j2][s] = __builtin_bit_cast(bf16x8, *(const u32x4*)(gG0 + (size_t)(c_) * SZ_G + (2 * (jt * 2 + j2) + s) * 1024)); \
        _Pragma("unroll") for (int j2 = 0; j2 < 2; ++j2) _Pragma("unroll") for (int s = 0; s < 2; ++s) H_[j2][s] = __builtin_bit_cast(bf16x8, *(const u32x4*)(gH0 + (size_t)(c_) * SZ_H + (2 * (j2 * 2 + it) + s) * 1024)); } while (0)
    R2_LOAD(fG, fH, 0);
    for (int c = 0; c < 128; ++c) {
        const int cn = c + 1 < 128 ? c + 1 : c;
        R2_LOAD(nG, nH, cn);
        const bf16x8 fS[2][2] = {{frag<0>(St[0]), frag<1>(St[0])}, {frag<0>(St[1]), frag<1>(St[1])}};
        f32x16 nw[2];
#pragma unroll
        for (int j2 = 0; j2 < 2; ++j2) { unfrag<0>(nw[j2], fH[j2][0]); unfrag<1>(nw[j2], fH[j2][1]);
#pragma unroll
            for (int jt = 0; jt < 2; ++jt) { nw[j2] = RK_MF(fG[jt][j2][0], fS[jt][0], nw[j2]); nw[j2] = RK_MF(fG[jt][j2][1], fS[jt][1], nw[j2]); } }
#pragma unroll
        for (int jt = 0; jt < 2; ++jt)
#pragma unroll
            for (int s = 0; s < 2; ++s) *(u32x4*)(gH0 + (size_t)c * SZ_H + (2 * (jt * 2 + it) + s) * 1024) = __builtin_bit_cast(u32x4, fS[jt][s]);
        St[0] = nw[0]; St[1] = nw[1];
#pragma unroll
        for (int jt = 0; jt < 2; ++jt)
#pragma unroll
            for (int j2 = 0; j2 < 2; ++j2)
#pragma unroll
                for (int s = 0; s < 2; ++s) fG[jt][j2][s] = nG[jt][j2][s];
#pragma unroll
        for (int j2 = 0; j2 < 2; ++j2)
#pragma unroll
            for (int s = 0; s < 2; ++s) fH[j2][s] = nH[j2][s];
    }
#undef R2_LOAD
}

constexpr int PV2 = 1296;
__device__ __forceinline__ void r3_unit(const Args& args, Frame& F, int b, int c) {
    LAS unsigned char* IMG = F.lds;
    const bf16_t* Z = (const bf16_t*)(F.ws + WS_Z);
    const int t0 = 32 * c; const size_t m0 = (size_t)b * SEQ + t0;
    const float* mu = AIN(7);
    int tid = F.tid; asm volatile("" : "+v"(tid));
    __syncthreads();
    for (int p = tid; p < 33 * 80; p += NTHR) { const int rr = p / 80, pc = p - rr * 80; u32x4 v = {0u, 0u, 0u, 0u};
        const int col = pc < 64 ? ZR_V + 8 * pc : ZR_GD + 8 * (pc - 64);
        if (rr > 0 || t0 > 0) v = *(const u32x4*)(Z + (m0 + rr - 1) * ZW + col);
        *(LAS u32x4*)(IMG + rr * PV2 + 16 * pc) = v; }
    __syncthreads();
    { const int t = tid >> 4, kp = tid & 15;
      const u32x4 cw = *(const LAS u32x4*)(IMG + (t + 1) * PV2 + 1024 + 16 * kp), pw = *(const LAS u32x4*)(IMG + t * PV2 + 1024 + 16 * kp);
      const f32x4 m0v = *(const f32x4*)(mu + 1664 + 8 * kp), m1v = *(const f32x4*)(mu + 1664 + 8 * kp + 4);
      const unsigned cwa[4] = {cw.x, cw.y, cw.z, cw.w}, pwa[4] = {pw.x, pw.y, pw.z, pw.w}; float x[8];
#pragma unroll
      for (int j = 0; j < 4; ++j) { const float c0 = bf_lo(cwa[j]), c1 = bf_hi(cwa[j]), p0 = bf_lo(pwa[j]), p1 = bf_hi(pwa[j]);
          const float mu0 = j < 2 ? m0v[2 * j] : m1v[2 * j - 4], mu1 = j < 2 ? m0v[2 * j + 1] : m1v[2 * j - 3];
          x[2 * j] = fast_sigmoid(c0 + mu0 * (p0 - c0)); x[2 * j + 1] = fast_sigmoid(c1 + mu1 * (p1 - c1)); }
      const u32x4 o = {cvtpk(x[0], x[1]), cvtpk(x[2], x[3]), cvtpk(x[4], x[5]), cvtpk(x[6], x[7])};
      __syncthreads();
      *(LAS u32x4*)(IMG + (t + 1) * PV2 + 1024 + 16 * kp) = o;
      __syncthreads(); }
    const int hd = F.wave; int r = tid & 31, h = (tid >> 5) & 1;
    const LAS unsigned char* rowc = IMG + (r + 1) * PV2; const LAS unsigned char* rowp = IMG + r * PV2;
    const size_t uid = ((size_t)(b * 8 + hd) * 128 + c);
    const unsigned char* gS = F.ws + WS_R2 + uid * SZ_H; const unsigned char* gQ = F.ws + WS_H0 + uid * SZ_Q; const unsigned char* gY = F.ws + WS_H1 + uid * SZ_Y;
#define RK_LD(base, piece) __builtin_bit_cast(bf16x8, *(const u32x4*)((base) + (piece) * 1024 + (tid & 63) * 16))
    f32x16 gl[2]; gl[0] = f32x16{}; gl[1] = f32x16{};
    { const bf16_t* GUt = (const bf16_t*)(F.ws + WS_GUT) + (size_t)hd * 64 * 128;
#pragma unroll
      for (int ks = 0; ks < 8; ++ks) { const int k0 = 16 * ks + 8 * h; const bf16x8 bg = *(const LAS bf16x8*)(rowc + 1024 + k0 * 2);
#pragma unroll
          for (int it = 0; it < 2; ++it) { const bf16x8 fg = *(const bf16x8*)(GUt + (size_t)(32 * it + r) * 128 + k0); gl[it] = RK_MF(fg, bg, gl[it]); } } }
    f32x16 Y[2];
    { const bf16x8 fQ[2][2] = {{RK_LD(gQ, 0), RK_LD(gQ, 1)}, {RK_LD(gQ, 2), RK_LD(gQ, 3)}};
#pragma unroll
      for (int it = 0; it < 2; ++it) { unfrag<0>(Y[it], RK_LD(gY, 2 * it)); unfrag<1>(Y[it], RK_LD(gY, 2 * it + 1));
#pragma unroll
          for (int jt = 0; jt < 2; ++jt) { if (PROBE_NO_STATE) continue; Y[it] = RK_MF(RK_LD(gS, 2 * (jt * 2 + it)), fQ[jt][0], Y[it]); Y[it] = RK_MF(RK_LD(gS, 2 * (jt * 2 + it) + 1), fQ[jt][1], Y[it]); } } }
    float s1 = 0.f;
#pragma unroll
    for (int it = 0; it < 2; ++it)
#pragma unroll
        for (int i = 0; i < 16; ++i) s1 += Y[it][i];
    s1 += __shfl_xor(s1, 32); const float mean = s1 * (1.0f / 64.0f); float s2 = 0.f;
#pragma unroll
    for (int it = 0; it < 2; ++it)
#pragma unroll
        for (int i = 0; i < 16; ++i) { const float d = Y[it][i] - mean; s2 += d * d; }
    s2 += __shfl_xor(s2, 32); const float rstd = 1.0f / sqrtf(s2 * (1.0f / 64.0f) + GN_EPS);
    const float bn = ((const float*)(F.ws + WS_TOPW))[(m0 + r) * 8 + hd];
    LAS unsigned char* stg = F.lds + 49152 + F.wave * 4608;
#pragma unroll
    for (int it = 0; it < 2; ++it)
#pragma unroll
        for (int g = 0; g < 4; ++g) { const int cl = 32 * it + 8 * g + 4 * h, cj = hd * 64 + cl;
            const u32x2 a = *(const LAS u32x2*)(rowc + cj * 2), p = *(const LAS u32x2*)(rowp + cj * 2);
            const float vc[4] = {bf_lo(a.x), bf_hi(a.x), bf_lo(a.y), bf_hi(a.y)}, vq[4] = {bf_lo(p.x), bf_hi(p.x), bf_lo(p.y), bf_hi(p.y)};
            const f32x4 muv = *(const f32x4*)(mu + 1024 + cj), lg = *(const f32x4*)(AIN(16) + cj), lb = *(const f32x4*)(AIN(17) + cj);
            float o[4];
#pragma unroll
            for (int q = 0; q < 4; ++q) { const int i = 4 * g + q; const float v_ = vc[q] + muv[q] * (vq[q] - vc[q]);
                o[q] = ((Y[it][i] - mean) * rstd * lg[q] + lb[q] + bn * v_) * gl[it][i]; }
            *(LAS u32x2*)(stg + r * 144 + cl * 2) = (u32x2){cvtpk(o[0], o[1]), cvtpk(o[2], o[3])}; }
    asm volatile("s_waitcnt lgkmcnt(0)" ::: "memory");
    bf16_t* OUT = (bf16_t*)(F.ws + WS_R0) + m0 * 512 + hd * 64;
#pragma unroll
    for (int i = 0; i < 4; ++i) { const int row = i * 8 + ((tid & 63) >> 3), chn = tid & 7; const u32x4 v = *(const LAS u32x4*)(stg + row * 144 + chn * 16); *(u32x4*)(OUT + (size_t)row * 512 + chn * 8) = v; }
#undef RK_LD
#undef RK_ST
}
}
__device__ __forceinline__ void route_phase(const Args& args, Frame& F) {
    LAS unsigned* lcnt = (LAS unsigned*)(F.lds);
    if (F.tid < 128) lcnt[F.tid] = 0u;
    __syncthreads();
    const float* LG = (const float*)(F.ws + WS_LOGIT); int* TE = (int*)(F.ws + WS_TOPE); float* TW = (float*)(F.ws + WS_TOPW);
    const int lane = F.lane; const float bias = AIN(23)[lane];
    for (int tok = F.gw; tok < M; tok += F.NGW) {
        const float lg = LG[(size_t)tok * 64 + lane];
        const float s = 1.0f / (1.0f + expf(-lg));
        const float c = s + bias;
        const unsigned long long kc = ((unsigned long long)ord_key(c) << 6) | (unsigned)(63 - lane);
        int rk = 0;
#pragma unroll 1
        for (int d = 1; d < 8; ++d) { const unsigned long long o = __shfl_xor(kc, d); rk += (o > kc) ? 1 : 0; }
        float gs = rk < 2 ? c : 0.f;
        gs += __shfl_xor(gs, 1); gs += __shfl_xor(gs, 2); gs += __shfl_xor(gs, 4);
        const int grp = lane >> 3;
        const unsigned long long kg = ((unsigned long long)ord_key(gs) << 6) | (unsigned)(63 - grp);
        int grk = 0;
#pragma unroll 1
        for (int d = 1; d < 8; ++d) { const unsigned long long o = __shfl_xor(kg, 8 * d); grk += (o > kg) ? 1 : 0; }
        const unsigned long long km = grk < 4 ? kc : (unsigned long long)(63 - lane);
        int erk = 0;
#pragma unroll 1
        for (int d = 1; d < 64; ++d) { const unsigned long long o = __shfl_xor(km, d); erk += (o > km) ? 1 : 0; }
        const bool sel = erk < 8;
        const float ssum = wave_sum(sel ? s : 0.f);
        if (sel) { TE[(size_t)tok * 8 + erk] = lane; TW[(size_t)tok * 8 + erk] = s / ssum * 2.5f; atomicAdd((unsigned*)&lcnt[(tok >= M / 2 ? 64 : 0) + lane], 1u); }
    }
    __syncthreads();
    if (F.tid < 128 && lcnt[F.tid]) atomicAdd(F.ctl + CW_CNT + F.tid, lcnt[F.tid]);
    __syncthreads();
}

struct MoeTab { int ntiles0, ntiles; };
__device__ __forceinline__ MoeTab build_tiles(const Args& args, Frame& F) {
    LAS unsigned* tab = (LAS unsigned*)(F.lds + LDS_TILETAB);
    LAS unsigned* offs = tab + 2432; LAS unsigned* tpre = tab + 2560;
    if (F.tid == 0) { unsigned o = 0, tp = 0;
        for (int l = 0; l < 128; ++l) { const unsigned c = __hip_atomic_load(F.ctl + CW_CNT + l, RLX_AGENT); offs[l] = o; tpre[l] = tp; o += c; tp += (c + 255u) >> 8; }
        tpre[128] = tp; }
    __syncthreads();
    if (F.tid < 128) { const int l = F.tid; const unsigned c = __hip_atomic_load(F.ctl + CW_CNT + l, RLX_AGENT); const unsigned o = offs[l], t0 = tpre[l], nt = (c + 255u) >> 8;
        for (unsigned i = 0; i < nt; ++i) { const unsigned rows = (c - 256u * i) < 256u ? (c - 256u * i) : 256u; tab[2 * (t0 + i)] = (o + 256u * i) | ((unsigned)(l & 63) << 20); tab[2 * (t0 + i) + 1] = rows; } }
    __syncthreads();
    MoeTab r; r.ntiles0 = (int)tpre[64]; r.ntiles = (int)tpre[128]; return r;
}
__device__ __forceinline__ void scatter_phase(const Args& args, Frame& F) {
    LAS unsigned* tab = (LAS unsigned*)(F.lds + LDS_TILETAB); LAS unsigned* offs = tab + 2432;
    LAS unsigned* lcnt = (LAS unsigned*)(F.lds); LAS unsigned* lbase = lcnt + 128;
    const int* TE = (const int*)(F.ws + WS_TOPE); const float* TW = (const float*)(F.ws + WS_TOPW);
    int* ST = (int*)(F.ws + WS_STOK); float* SW = (float*)(F.ws + WS_SW);
    for (int blk = blockIdx.x; blk < M / 128; blk += F.G) {
        if (F.tid < 128) lcnt[F.tid] = 0u;
        __syncthreads();
        const int tok0 = blk * 128, hf = tok0 >= M / 2 ? 64 : 0;
        int lst[2]; unsigned rnk[2];
#pragma unroll
        for (int i = 0; i < 2; ++i) { const int p = F.tid + 512 * i; lst[i] = hf + TE[(size_t)tok0 * 8 + p]; rnk[i] = atomicAdd((unsigned*)&lcnt[lst[i]], 1u); }
        __syncthreads();
        if (F.tid < 128) lbase[F.tid] = lcnt[F.tid] ? atomicAdd(F.ctl + CW_CUR + F.tid, lcnt[F.tid]) : 0u;
        __syncthreads();
#pragma unroll
        for (int i = 0; i < 2; ++i) { const int p = F.tid + 512 * i; const unsigned pos = offs[lst[i]] + lbase[lst[i]] + rnk[i];
            ST[pos] = tok0 * 8 + p; SW[pos] = TW[(size_t)tok0 * 8 + p]; }
        __syncthreads();
    }
}

__device__ __forceinline__ void final_rows(const Args& args, Frame& F, int row_lo, int row_hi, int tokbase) {
    const unsigned char* SL = (const unsigned char*)(F.ws + WS_SLOT);
    const int cA = 256 * (F.lane >> 4) + 32 * ((F.lane >> 2) & 3) + 8 * (F.lane & 3), cB = cA + 128;
    for (int blk = F.gw; blk < (row_hi - row_lo) / 16; blk += F.NGW) {
        const int r0 = row_lo + blk * 16, b = r0 / SEQ;
        const float* g2 = (const float*)(F.ws + WS_MOD) + b * 6144 + 5120; const float* fgp = AIN(30);
        f32x4 gv[4], fg[4];
#pragma unroll
        for (int j = 0; j < 4; ++j) { const int c = (j < 2 ? cA : cB) + 4 * (j & 1); gv[j] = *(const f32x4*)(g2 + c) * (1.0f / SLOT_SCALE); fg[j] = *(const f32x4*)(fgp + c); }
        for (int r = 0; r < 16; ++r) { const size_t m = (size_t)(r0 + r);
            f32x4 acc[4];
#pragma unroll
            for (int j = 0; j < 4; ++j) acc[j] = (f32x4){0.f, 0.f, 0.f, 0.f};
            const unsigned char* sp = SL + (m - tokbase) * NSLOT * D + 16 * F.lane;
            u32x4 w[NSLOT];
#pragma unroll
            for (int k = 0; k < NSLOT; ++k) w[k] = *(const u32x4*)(sp + (size_t)k * D);
#pragma unroll
            for (int k = 0; k < NSLOT; ++k) { const unsigned ww[4] = {w[k].x, w[k].y, w[k].z, w[k].w};
#pragma unroll
                for (int j = 0; j < 4; ++j) { const f32x2 a = __builtin_amdgcn_cvt_pk_f32_fp8((int)ww[j], false), c = __builtin_amdgcn_cvt_pk_f32_fp8((int)ww[j], true); acc[j] += (f32x4){a.x, a.y, c.x, c.y}; } }
            float* xr = F.out + m * D; f32x4 v[4]; float s = 0.f;
#pragma unroll
            for (int j = 0; j < 4; ++j) { const int c = (j < 2 ? cA : cB) + 4 * (j & 1); v[j] = *(const f32x4*)(xr + c) + gv[j] * acc[j]; s += (v[j].x * v[j].x + v[j].y * v[j].y) + (v[j].z * v[j].z + v[j].w * v[j].w); }
            const float rstd = 1.0f / sqrtf(wave_sum(s) * (1.0f / D) + RMS_EPS);
#pragma unroll
            for (int j = 0; j < 4; ++j) { const int c = (j < 2 ? cA : cB) + 4 * (j & 1); *(f32x4*)(xr + c) = v[j] * rstd * fg[j]; }
        }
    }
}
constexpr int N_PHASES = 15;
#ifndef PROBE_ATT_SCALE
#define PROBE_ATT_SCALE 1.0f
#endif
#ifndef PROBE_IDX_REP
#define PROBE_IDX_REP 1
#endif
#ifndef PROBE_RW_SCALE
#define PROBE_RW_SCALE 1.0f
#endif

__global__ void __launch_bounds__(NTHR, 2) fwd_kernel(Args args) {
    extern __shared__ __attribute__((aligned(16))) unsigned char lds_raw[];
    Frame F;
    F.lds = (LAS unsigned char*)lds_raw;
    F.MISC = (volatile LAS unsigned*)(F.lds + MISC_OFF);
    F.tid = threadIdx.x; F.lane = F.tid & 63; F.wave = __builtin_amdgcn_readfirstlane(F.tid >> 6);
    F.G = gridDim.x; { const int bx = blockIdx.x; F.vcu = (F.G % 8 == 0) ? (bx % 8) * (F.G / 8) + bx / 8 : bx; }
    F.gw = blockIdx.x * NWAVES + F.wave; F.NGW = F.G * NWAVES;
    F.ws = args.ws; F.out = args.out; F.ctl = (unsigned*)(args.ws + WS_CTL);
    for (int u = F.tid; u < (LDS_BYTES - LDSCTL_OFF) / 4; u += NTHR) ((LAS unsigned*)(F.lds + LDSCTL_OFF))[u] = 0u;
    __syncthreads();
    if (F.tid == 0) {
#pragma unroll
        for (int i = 0; i < 31; ++i) *(LAS unsigned long long*)(F.lds + LDS_PTAB + 8 * i) = (unsigned long long)args.in[i];
        *(LAS unsigned long long*)(F.lds + LDS_PTAB + 8 * 31) = (unsigned long long)args.out; *(LAS unsigned long long*)(F.lds + LDS_PTAB + 8 * 32) = (unsigned long long)args.ws; }
    __syncthreads();
    XcdBarrier bar = xcd_barrier_post(F.ctl + CW_BAR + args.li * XCD_BAR_WORDS, F.MISC + 8);
    const int lo = args.ph_lo, hi = args.ph_hi;
#ifndef PHASE_MASK
#define PHASE_MASK 0xFFFFFFFFu
#endif
#define IN(k) ((((PHASE_MASK) >> (k)) & 1u) && lo <= (k) && (k) < hi)
#define PB() do { F.ws = (unsigned char*)ain_ptr(F.lds, 32); F.out = (float*)ain_ptr(F.lds, 31); F.ctl = (unsigned*)(F.ws + WS_CTL); \
        F.lane = (int)__builtin_amdgcn_mbcnt_hi(~0u, __builtin_amdgcn_mbcnt_lo(~0u, 0u)); F.tid = F.wave * 64 + F.lane; } while (0)
#define ZB ((bf16_t*)(F.ws + WS_Z))
#define GATES ((bf16_t*)F.out)
#define MOD ((const float*)(F.ws + WS_MOD))
#define SEAM(k) do { if (IN(k) && IN((k) + 1)) xcd_barrier(bar); } while (0)

    if (IN(0)) { PB(); p0_prologue(args, F); } SEAM(0);
    if (IN(1)) { PB(); norm_mod_rows(args, F, AIN(0), AIN(4), 0, 1024, nullptr, F.ws + WS_H0); } SEAM(1);
    if (IN(2)) { PB(); pg8::StaticOrder S; S.init(M, NIN, F.G, (int)blockIdx.x); pg8::DenseSrcT<1> G{F.ws + WS_H0, F.ws + WS_WIN, 1024};
        EpiInProj E{ZB, GATES}; pg8::gemm_phase<EpiInProj, pg8::StaticOrder, pg8::DenseSrcT<1>>(F.lds, 1024, S, G, E); } SEAM(2);
    if (IN(3)) { PB(); rk::load_params(args, F); for (int u = blockIdx.x; u < 1024; u += F.G) rk::r1_unit(args, F, u >> 7, u & 127); __syncthreads(); } SEAM(3);
    if (IN(4)) { PB();
        if (blockIdx.x < 16) rk::r2_task(args, F, blockIdx.x * 8 + F.wave);
#pragma unroll 1
        for (int rep = 0; rep < PROBE_IDX_REP; ++rep)
        for (;;) {
            __syncthreads();
            if (F.tid == 0) F.MISC[12] = atomicAdd(F.ctl + CW_Q + rep, 1u);
            __syncthreads();
            const int u = (int)F.MISC[12];
            if (u >= 2048) break;
            indexer_unit(args, F, u & 7, (255 - (u >> 3)) * 16);
        } } SEAM(4);
    if (IN(5)) { PB(); for (int u = blockIdx.x; u < 1024; u += F.G) rk::r3_unit(args, F, u >> 7, u & 127); __syncthreads();
        for (int i = 0; i < 4; ++i) for (int uu = F.vcu; uu < 256; uu += F.G) { const int bh = uu >> 2, s = uu & 3; const int qb = (i == 0) ? s : (i == 1) ? 7 - s : (i == 2) ? 8 + s : 15 - s;
            att::attn_unit(args, F, bh >> 3, bh & 7, qb); } __syncthreads(); } SEAM(5);
    if (IN(6)) { PB(); pg8::StaticOrder S; S.init(M, D, F.G, (int)blockIdx.x);
        { pg8::DenseSrc G{F.ws + WS_R1, F.ws + WS_WA, 512}; EpiMerge<0> E{(bf16_t*)(F.ws + WS_R2), F.ws + WS_H0, GATES, PROBE_ATT_SCALE}; pg8::gemm_phase<EpiMerge<0>, pg8::StaticOrder, pg8::DenseSrc>(F.lds, 512, S, G, E); }
        { pg8::DenseSrc G{F.ws + WS_R0, F.ws + WS_WR, 512}; EpiMerge<1> E{(bf16_t*)(F.ws + WS_R2), F.ws + WS_H0, GATES, PROBE_RW_SCALE}; pg8::gemm_phase<EpiMerge<1>, pg8::StaticOrder, pg8::DenseSrc>(F.lds, 512, S, G, E); } } SEAM(6);
    if (IN(7)) { PB(); pg8::StaticOrder S; S.init(M, D, F.G, (int)blockIdx.x); pg8::DenseSrcT<1> G{F.ws + WS_H0, F.ws + WS_WO, 1024};
        EpiOutProj E{AIN(0), F.out, MOD}; pg8::gemm_phase<EpiOutProj, pg8::StaticOrder, pg8::DenseSrcT<1>>(F.lds, 1024, S, G, E); } SEAM(7);
    if (IN(8)) { PB(); norm_mod_rows(args, F, F.out, AIN(21), 3072, 4096, (bf16_t*)(F.ws + WS_H2), nullptr); convert_experts(args, F); } SEAM(8);
    if (IN(9)) { PB(); pg8::StaticOrder S; S.init(M, 256, F.G, (int)blockIdx.x); pg8::DenseSrc G{(const bf16_t*)(F.ws + WS_H2), (const bf16_t*)(F.ws + WS_WRT), 1024};
        EpiRouter E{(float*)(F.ws + WS_LOGIT)}; pg8::gemm_phase<EpiRouter, pg8::StaticOrder, pg8::DenseSrc>(F.lds, 1024, S, G, E); } SEAM(9);
    if (IN(10)) { PB(); route_phase(args, F); } SEAM(10);
    MoeTab mt{0, 0};
    if (lo <= 13 && hi > 13) { PB(); mt = build_tiles(args, F); scatter_phase(args, F); } else if (hi > 13) { PB(); mt = build_tiles(args, F); }
    SEAM(11);
    const LAS unsigned* tab = (const LAS unsigned*)(F.lds + LDS_TILETAB);
    if (IN(12)) { PB(); MoeSched1 S{tab, mt.ntiles, F.G, (int)blockIdx.x}; MoeSrc1 G{F.ws};
        EpiMoe1 E{F.ws}; pg8::gemm_phase<EpiMoe1, MoeSched1, MoeSrc1>(F.lds, 1024, S, G, E); } SEAM(12);
    if (IN(13)) { PB(); MoeSched2 S{tab, 0, mt.ntiles, 512, F.G, (int)blockIdx.x}; MoeSrc2 G{F.ws}; EpiMoe2 E{F.ws, F.out, 0};
        pg8::gemm_phase<EpiMoe2, MoeSched2, MoeSrc2>(F.lds, 256, S, G, E); } SEAM(13);
    if (IN(14)) { PB(); final_rows(args, F, 0, M, 0); }
#undef IN
#undef SEAM
#undef PB
}

extern "C" void kernel_launch(void* const* d_in, const int* in_sizes, int n_in, void* d_out, int out_size, void* d_ws, size_t ws_size, hipStream_t stream) {
    static int grid = 0;
    if (grid == 0) {
        if (n_in != 31 || out_size != M * D || ws_size < WS_END) { fprintf(stderr, "kernel_launch: unexpected problem (n_in %d, out %d, ws %zu)\n", n_in, out_size, ws_size); grid = -1; return; }
        int dev = 0, cus = 0, per_cu = 0;
        if (hipGetDevice(&dev) != hipSuccess || hipDeviceGetAttribute(&cus, hipDeviceAttributeMultiprocessorCount, dev) != hipSuccess) { grid = -1; return; }
        if (hipFuncSetAttribute((const void*)fwd_kernel, hipFuncAttributeMaxDynamicSharedMemorySize, LDS_BYTES) != hipSuccess) { fprintf(stderr, "kernel_launch: hipFuncSetAttribute failed\n"); grid = -1; return; }
        if (hipOccupancyMaxActiveBlocksPerMultiprocessor(&per_cu, (const void*)fwd_kernel, NTHR, LDS_BYTES) != hipSuccess || per_cu < 1) fprintf(stderr, "kernel_launch: occupancy query reports %d\n", per_cu);
        (void)hipGetLastError();
        grid = cus;
        if (grid != 256) fprintf(stderr, "kernel_launch: %d CUs (built for 256)\n", grid);
    }
    if (grid < 0) return;
    (void)in_sizes;
    if (hipMemsetAsync((char*)d_ws + WS_CTL, 0, CTL_ZERO_BYTES, stream) != hipSuccess) return;
    Args a{};
    for (int i = 0; i < 31; ++i) a.in[i] = (const float*)d_in[i];
    a.out = (float*)d_out; a.ws = (unsigned char*)d_ws;
#ifndef PROBE_REPEAT
#define PROBE_REPEAT -1
#endif
    int li = 0;
    auto go = [&](int lo_, int hi_) { a.ph_lo = lo_; a.ph_hi = hi_; a.li = li++; hipLaunchKernelGGL(fwd_kernel, dim3(grid), dim3(NTHR), LDS_BYTES, stream, a); };
    if (PROBE_REPEAT < 0) go(0, N_PHASES);
    else { go(0, PROBE_REPEAT + 1); go(PROBE_REPEAT, PROBE_REPEAT + 1); if (PROBE_REPEAT + 1 < N_PHASES) go(PROBE_REPEAT + 1, N_PHASES); }
}
```

```cpp
#include <hip/hip_runtime.h>
#include <cstdio>
#include <cstdint>
#include <cmath>

#define GAS __attribute__((address_space(1)))
#define LAS __attribute__((address_space(3)))
typedef unsigned short bf16_t;
typedef short bf16x8 __attribute__((ext_vector_type(8)));
typedef float f32x4 __attribute__((ext_vector_type(4)));
typedef float f32x2 __attribute__((ext_vector_type(2)));
typedef float f32x16 __attribute__((ext_vector_type(16)));
typedef unsigned u32x4 __attribute__((ext_vector_type(4)));
typedef unsigned u32x2 __attribute__((ext_vector_type(2)));
typedef GAS unsigned gu32;

__device__ __forceinline__ unsigned cvt_pk_bf16(float lo, float hi) { unsigned r; asm volatile("v_cvt_pk_bf16_f32 %0, %1, %2" : "=v"(r) : "v"(lo), "v"(hi)); return r; }
__device__ __forceinline__ float bf_lo(unsigned w) { return __uint_as_float(w << 16); }
__device__ __forceinline__ float bf_hi(unsigned w) { return __uint_as_float(w & 0xffff0000u); }
__device__ __forceinline__ float bf2f(bf16_t b) { return __uint_as_float(((unsigned)b) << 16); }
__device__ __forceinline__ unsigned f2bf(float f) { unsigned u = __float_as_uint(f); return (u + 0x7fffu + ((u >> 16) & 1u)) >> 16; }
__device__ __forceinline__ unsigned pk2(float lo, float hi) { return f2bf(lo) | (f2bf(hi) << 16); }
__device__ __forceinline__ float fast_sigmoid(float x) { return __builtin_amdgcn_rcpf(1.0f + __builtin_amdgcn_exp2f(-1.4426950408889634f * x)); }
__device__ __forceinline__ float wave_sum(float v) {
#pragma unroll
    for (int o = 1; o < 64; o <<= 1) v += __shfl_xor(v, o);
    return v;
}

namespace pg8 {
constexpr int BM = 256, BK = 64, HALF = 128, HTB = HALF * BK * 2, STAGE_BYTES = 8 * HTB, NXCD = 8, WGM = 8;
__host__ __device__ __forceinline__ int lds_byte(int r, int c) { const int st = (r >> 4) * 2 + (c >> 5), rr = r & 15, cc = c & 31, ob = rr * 64 + cc * 2; return st * 1024 + (ob ^ (((ob >> 9) & 1) << 5)); }
__host__ __device__ __forceinline__ void stage_rc(int b, int& R, int& C) { const int st = b / 1024, sb = b % 1024, swz = sb ^ (((sb >> 9) & 1) << 5); R = (st >> 1) * 16 + swz / 64; C = (st & 1) * 32 + (swz % 64) / 2; }
__host__ __device__ __forceinline__ int perm32(int rho) { const int n = rho >> 4, i = rho & 15; return 8 * (i >> 2) + 4 * n + (i & 3); }

struct Unit { int pm, pn; int aux0, aux1; };

struct StaticOrder {
    int nM, nN, nwg, G, c;
    __host__ __device__ void init(int M, int N, int G_, int c_) { nM = M / BM; nN = N / BM; nwg = nM * nN; G = G_; c = c_; }
    __host__ __device__ bool next(int i, Unit& u) const {
        const long L = (long)i * G + c; if (L >= nwg) return false;
        int wgid = (int)L; { const int q = nwg / NXCD, r = nwg % NXCD, xcd = wgid % NXCD, off = wgid / NXCD; wgid = (xcd < r ? xcd * (q + 1) : r * (q + 1) + (xcd - r) * q) + off; }
        const int nig = WGM * nN, gid = wgid / nig, fm = gid * WGM, gsz = (nM - fm) < WGM ? (nM - fm) : WGM;
        u.pm = fm + ((wgid % nig) % gsz); u.pn = (wgid % nig) / gsz; u.aux0 = 0; u.aux1 = 0; return true;
    }
};

template <int ESZ_> struct DenseSrcT {
    static constexpr int ESZ = ESZ_; static constexpr bool GATHER = false;
    const void* A; const void* Bt; int K;
    __device__ __forceinline__ const char* b_base(const Unit& u) const { return (const char*)Bt + (size_t)u.pn * 256 * K * ESZ; }
    __device__ __forceinline__ const char* a_base(const Unit& u) const { return (const char*)A + (size_t)u.pm * 256 * K * ESZ; }
    __device__ __forceinline__ unsigned a_off(const Unit&, int R, int C) const { return (unsigned)(R * K * ESZ) + (unsigned)C * 2u; }
};
typedef DenseSrcT<2> DenseSrc;
typedef int v8i32 __attribute__((ext_vector_type(8)));

template <class Epi, class Sched, class Src, bool ALIGN_EPI = true>
__device__ __forceinline__ void gemm_phase(LAS unsigned char* lds, const int K, const Sched& S, const Src& G, const Epi& E) {
    const int tid = threadIdx.x, wid = __builtin_amdgcn_readfirstlane(tid >> 6), lane = tid & 63, wr = wid >> 2, wc = wid & 3, fr = lane & 15, fq = lane >> 4;
    constexpr int ESZ = Src::ESZ; const int Kb = K * ESZ;
    const int nt = Kb / (BK * 2);
    unsigned voffB0;
    { int R, C; stage_rc(tid * 16, R, C); const int Rb = Epi::PERM ? ((R & ~31) + perm32(R & 31)) : R; voffB0 = (unsigned)(Rb * Kb) + (unsigned)C * 2u; }
#define PG8_AOFF(u, h, i) ([&]() { int R_, C_; stage_rc(tid * 16 + (i) * 8192, R_, C_); return G.a_off((u), R_ + (h) * HALF, C_); }())
    const size_t kstep = (size_t)(BK * 2);
    const size_t hstepB = (size_t)HALF * Kb;
    const unsigned ldsw = (unsigned)wid * 1024u;
    const int aoff = lds_byte(wr * 64 + fr, fq * 8), boff = lds_byte(wc * 32 + fr, fq * 8);
#define PG8_SA(b, h) (((b) * 2 + (h)) * HTB)
#define PG8_SB(b, h) ((4 + (b) * 2 + (h)) * HTB)
#define PG8_STAGEB(bufoff, gbase) do { _Pragma("unroll") for (int _i = 0; _i < 2; ++_i) { unsigned o_ = voffB0; asm volatile("" : "+v"(o_)); \
        __builtin_amdgcn_global_load_lds((const unsigned*)((const char*)(gbase) + (size_t)_i * 64 * Kb + o_), (LAS unsigned*)(lds + (bufoff) + ldsw + _i * 8192), 16, 0, 0); } } while (0)
#define PG8_STAGEA(bufoff, gbase, vo, h) do { _Pragma("unroll") for (int _i = 0; _i < 2; ++_i) { unsigned o_ = Src::GATHER ? (vo)[h][_i] : (vo)[0][0]; asm volatile("" : "+v"(o_)); \
        __builtin_amdgcn_global_load_lds((const unsigned*)((const char*)(gbase) + (Src::GATHER ? (size_t)0 : (size_t)((h) * 128 + _i * 64) * Kb) + o_), (LAS unsigned*)(lds + (bufoff) + ldsw + _i * 8192), 16, 0, 0); } } while (0)
#define PG8_STAGEA2(bufoff, gbase, h) do { _Pragma("unroll") for (int _i = 0; _i < 2; ++_i) { unsigned o_ = Src::GATHER ? (last ? vn[h][_i] : vc[h][_i]) : vc[0][0]; asm volatile("" : "+v"(o_)); \
        __builtin_amdgcn_global_load_lds((const unsigned*)((const char*)(gbase) + (Src::GATHER ? (size_t)0 : (size_t)((h) * 128 + _i * 64) * Kb) + o_), (LAS unsigned*)(lds + (bufoff) + ldsw + _i * 8192), 16, 0, 0); } } while (0)
#define PG8_LDA(dst, b, h) do { _Pragma("unroll") for (int m = 0; m < 4; ++m) { const u32x4 lo_ = *(const LAS u32x4*)(lds + PG8_SA(b, h) + aoff + m * 2048), hi_ = *(const LAS u32x4*)(lds + PG8_SA(b, h) + aoff + m * 2048 + 1024); \
        dst[m] = __builtin_shufflevector(lo_, hi_, 0, 1, 2, 3, 4, 5, 6, 7); } } while (0)
#define PG8_LDB(dst, b, h) do { _Pragma("unroll") for (int n = 0; n < 2; ++n) { const u32x4 lo_ = *(const LAS u32x4*)(lds + PG8_SB(b, h) + boff + n * 2048), hi_ = *(const LAS u32x4*)(lds + PG8_SB(b, h) + boff + n * 2048 + 1024); \
        dst[n] = __builtin_shufflevector(lo_, hi_, 0, 1, 2, 3, 4, 5, 6, 7); } } while (0)
#define PG8_LO(x) __builtin_bit_cast(bf16x8, __builtin_shufflevector((x), (x), 0, 1, 2, 3))
#define PG8_HI(x) __builtin_bit_cast(bf16x8, __builtin_shufflevector((x), (x), 4, 5, 6, 7))
#define PG8_MMA(ai, bj, At, Bt) do { __builtin_amdgcn_s_setprio(1); _Pragma("unroll") for (int m = 0; m < 4; ++m) _Pragma("unroll") for (int n = 0; n < 2; ++n) { \
        if constexpr (ESZ == 1) acc[ai][bj][m][n] = __builtin_amdgcn_mfma_scale_f32_16x16x128_f8f6f4(__builtin_bit_cast(v8i32, Bt[n]), __builtin_bit_cast(v8i32, At[m]), acc[ai][bj][m][n], 0, 0, 0, 0, 0, 0); \
        else { acc[ai][bj][m][n] = __builtin_amdgcn_mfma_f32_16x16x32_bf16(PG8_LO(Bt[n]), PG8_LO(At[m]), acc[ai][bj][m][n], 0, 0, 0); \
               acc[ai][bj][m][n] = __builtin_amdgcn_mfma_f32_16x16x32_bf16(PG8_HI(Bt[n]), PG8_HI(At[m]), acc[ai][bj][m][n], 0, 0, 0); } } \
        __builtin_amdgcn_s_setprio(0); } while (0)
#define PG8_WAIT_V(n) asm volatile("s_waitcnt vmcnt(" #n ")" ::: "memory")
#define PG8_WAIT_L(n) asm volatile("s_waitcnt lgkmcnt(" #n ")" ::: "memory")
#define PG8_BAR __builtin_amdgcn_s_barrier()
#define PG8_SCHED __builtin_amdgcn_sched_barrier(0)
    Unit cur, nxt; int ui = 0;
    if (!S.next(0, cur)) return;
    f32x4 acc[2][2][4][2];
#pragma unroll
    for (int a = 0; a < 2; ++a)
#pragma unroll
        for (int b = 0; b < 2; ++b)
#pragma unroll
            for (int m = 0; m < 4; ++m)
#pragma unroll
                for (int n = 0; n < 2; ++n) acc[a][b][m][n] = (f32x4){0.f, 0.f, 0.f, 0.f};
    typedef unsigned u32x8 __attribute__((ext_vector_type(8)));
    u32x8 At[4], B0[2], B1[2];
    unsigned vc[2][2], vn[2][2];
#pragma unroll
    for (int h = 0; h < 2; ++h)
#pragma unroll
        for (int i = 0; i < 2; ++i) vc[h][i] = PG8_AOFF(cur, h, i);
    const char* cA = G.a_base(cur); const char* cB = G.b_base(cur);
    PG8_STAGEB(PG8_SB(0, 0), cB); PG8_STAGEB(PG8_SB(0, 1), cB + hstepB); PG8_STAGEA(PG8_SA(0, 0), cA, vc, 0); PG8_STAGEA(PG8_SA(0, 1), cA, vc, 1);
    if (wr == 1) PG8_BAR;
    PG8_WAIT_V(2); PG8_BAR;
    PG8_STAGEB(PG8_SB(1, 0), cB + kstep); PG8_STAGEA(PG8_SA(1, 0), cA + kstep, vc, 0); PG8_STAGEB(PG8_SB(1, 1), cB + hstepB + kstep);
    PG8_WAIT_V(6); PG8_BAR;
    for (;;) {
        const bool has_next = S.next(ui + 1, nxt);
        const char* nA = has_next ? G.a_base(nxt) : cA; const char* nB = has_next ? G.b_base(nxt) : cB;
        if constexpr (Src::GATHER) {
#pragma unroll
        for (int h = 0; h < 2; ++h)
#pragma unroll
            for (int i = 0; i < 2; ++i) vn[h][i] = has_next ? PG8_AOFF(nxt, h, i) : vc[h][i]; }
#pragma clang loop unroll(disable)
        for (int t = 0; t < nt; t += 2) {
            const bool last = (t == nt - 2);
            const char* a1 = cA + (size_t)(t + 1) * kstep;
            const char* a2 = last ? nA : cA + (size_t)(t + 2) * kstep; const char* b2 = last ? nB : cB + (size_t)(t + 2) * kstep;
            const char* a3 = a2 + kstep; const char* b3 = b2 + kstep;
            PG8_LDB(B0, 0, 0); PG8_LDB(B1, 0, 1); PG8_SCHED; PG8_LDA(At, 0, 0); PG8_STAGEA(PG8_SA(1, 1), a1, vc, 1);
            PG8_WAIT_V(8); PG8_WAIT_L(0); PG8_BAR; PG8_MMA(0, 0, At, B0); PG8_MMA(0, 1, At, B1); PG8_BAR; PG8_SCHED;
            PG8_LDA(At, 0, 1); PG8_STAGEB(PG8_SB(0, 0), b2); PG8_STAGEB(PG8_SB(0, 1), b2 + hstepB); PG8_STAGEA2(PG8_SA(0, 0), a2, 0);
            PG8_WAIT_V(8); PG8_WAIT_L(0); PG8_BAR; PG8_MMA(1, 0, At, B0); PG8_MMA(1, 1, At, B1); PG8_BAR; PG8_SCHED;
            PG8_LDB(B0, 1, 0); PG8_LDB(B1, 1, 1); PG8_SCHED; PG8_LDA(At, 1, 0); PG8_STAGEA2(PG8_SA(0, 1), a2, 1);
            PG8_WAIT_V(8); PG8_WAIT_L(0); PG8_BAR; PG8_MMA(0, 0, At, B0); PG8_MMA(0, 1, At, B1); PG8_BAR; PG8_SCHED;
            PG8_LDA(At, 1, 1); PG8_STAGEB(PG8_SB(1, 0), b3); PG8_STAGEB(PG8_SB(1, 1), b3 + hstepB); PG8_STAGEA2(PG8_SA(1, 0), a3, 0);
            PG8_WAIT_V(8); PG8_WAIT_L(0); PG8_BAR; PG8_MMA(1, 0, At, B0); PG8_MMA(1, 1, At, B1); PG8_BAR; PG8_SCHED;
        }
        if constexpr (ALIGN_EPI) { if (wr == 0) PG8_BAR; }
        { int ln_; asm volatile("v_mbcnt_lo_u32_b32 %0, -1, 0\n\tv_mbcnt_hi_u32_b32 %0, -1, %0" : "=v"(ln_)); E(acc, cur, wr, wc, ln_ & 15, ln_ >> 4); }
        if (!has_next) break;
#pragma unroll
        for (int a = 0; a < 2; ++a)
#pragma unroll
            for (int b = 0; b < 2; ++b)
#pragma unroll
                for (int m = 0; m < 4; ++m)
#pragma unroll
                    for (int n = 0; n < 2; ++n) acc[a][b][m][n] = (f32x4){0.f, 0.f, 0.f, 0.f};
        cur = nxt; cA = nA; cB = nB; ++ui;
        if constexpr (Src::GATHER) {
#pragma unroll
        for (int h = 0; h < 2; ++h)
#pragma unroll
            for (int i = 0; i < 2; ++i) vc[h][i] = vn[h][i]; }
        if constexpr (ALIGN_EPI) { if (wr == 1) PG8_BAR; }
    }
    PG8_WAIT_V(0);
    if constexpr (!ALIGN_EPI) { if (wr == 0) PG8_BAR; }
    PG8_BAR;
#undef PG8_SA
#undef PG8_AOFF
#undef PG8_SB
#undef PG8_STAGEA
#undef PG8_STAGEA2
#undef PG8_STAGEB
#undef PG8_LDA
#undef PG8_LDB
#undef PG8_MMA
#undef PG8_LO
#undef PG8_HI
#undef PG8_WAIT_V
#undef PG8_WAIT_L
#undef PG8_BAR
#undef PG8_SCHED
}
}
#define RLX_AGENT __ATOMIC_RELAXED, __HIP_MEMORY_SCOPE_AGENT
#define LDS_WAIT() asm volatile("s_waitcnt lgkmcnt(0)" ::: "memory")
#define VM_WAIT() asm volatile("s_waitcnt vmcnt(0)" ::: "memory")
#define XB_TMO      128
#define XB_XCNT(j)  (256  + 64 * (j))
#define XB_XSUB(j)  (1280 + 64 * (j))
#define XB_XGEN(j)  (2304 + 64 * (j))
#define XB_TOP      3328
#define XB_TOPGEN   3392
#define XCD_BAR_WORDS 3456
#define XB_SPIN_CAP (1u << 18)

__device__ __forceinline__ unsigned xb_ld(unsigned* p)              { return __hip_atomic_load(p, __ATOMIC_RELAXED, __HIP_MEMORY_SCOPE_AGENT); }
__device__ __forceinline__ unsigned xb_add(unsigned* p, unsigned v) { return __hip_atomic_fetch_add(p, v, __ATOMIC_RELAXED, __HIP_MEMORY_SCOPE_AGENT); }
__device__ __forceinline__ unsigned xb_xcc_id() { return (unsigned)__builtin_amdgcn_s_getreg((3 << 11) | 20) & 0xFu; }
#define XB_SPIN(cond, bar) do { unsigned _sp = 0; while (cond) { __builtin_amdgcn_s_sleep(1); \
    if ((++_sp & 255u) == 0u) { if (xb_ld(&(bar)[XB_TMO])) break; if (_sp > XB_SPIN_CAP) { atomicAdd(&(bar)[XB_TMO], 1u); break; } } } } while (0)

struct XcdBarrier {
    unsigned* bar; unsigned x;
    volatile LAS unsigned* st;
};

__device__ __forceinline__ XcdBarrier xcd_barrier_post(unsigned* bar, volatile LAS unsigned* st) {
    XcdBarrier b; b.bar = bar; b.x = xb_xcc_id(); b.st = st;
    if (threadIdx.x == 0) (void)xb_add(&bar[XB_XCNT(b.x)], 1u);
    return b;
}
__device__ __forceinline__ void xcd_barrier_complete(unsigned* bar, unsigned x, unsigned& nloc, unsigned& nx) {
    const unsigned G = gridDim.x * gridDim.y * gridDim.z;
    unsigned sum, cnt, mine, sp = 0u;
    for (;;) {
        sum = 0u; cnt = 0u; mine = 0u;
#pragma unroll
        for (unsigned j = 0; j < 16; ++j) { const unsigned c = xb_ld(&bar[XB_XCNT(j)]); sum += c; cnt += (c > 0u) ? 1u : 0u; mine = (j == x) ? c : mine; }
        if (sum == G) break;
        __builtin_amdgcn_s_sleep(1);
        if ((++sp & 255u) == 0u) { if (xb_ld(&bar[XB_TMO])) break; if (sp > XB_SPIN_CAP) { atomicAdd(&bar[XB_TMO], 1u); break; } }
    }
    nloc = mine > 0u ? mine : 1u; nx = cnt > 0u ? cnt : 1u;
}

__device__ __forceinline__ void xcd_barrier(const XcdBarrier& b) {
    asm volatile("s_waitcnt vmcnt(0)" ::: "memory");
    __syncthreads();
    if (threadIdx.x == 0) {
        unsigned* bar = b.bar;
        __builtin_amdgcn_s_waitcnt(0);
        unsigned nloc = b.st[0], nx = b.st[1];
        if (nloc == 0u) { xcd_barrier_complete(bar, b.x, nloc, nx); b.st[0] = nloc; b.st[1] = nx; }
        const unsigned old = xb_add(&bar[XB_XSUB(b.x)], 1u);
        const unsigned gen = old / nloc;
        if (old + 1u == (gen + 1u) * nloc) {
            __builtin_amdgcn_fence(__ATOMIC_RELEASE, "agent");
            asm volatile("s_waitcnt vmcnt(0)" ::: "memory");
            const unsigned og = xb_add(&bar[XB_TOP], 1u);
            const unsigned tg = og / nx;
            if (og + 1u == (tg + 1u) * nx) xb_add(&bar[XB_TOPGEN], 1u);
            else XB_SPIN(xb_ld(&bar[XB_TOPGEN]) == tg, bar);
            __builtin_amdgcn_fence(__ATOMIC_ACQUIRE, "agent");
            xb_add(&bar[XB_XGEN(b.x)], 1u);
            asm volatile("s_waitcnt vmcnt(0)" ::: "memory");
        } else {
            XB_SPIN(xb_ld(&bar[XB_XGEN(b.x)]) == gen, bar);
            __builtin_amdgcn_fence(__ATOMIC_ACQUIRE, "agent");
            asm volatile("s_waitcnt vmcnt(0)" ::: "memory");
        }
    }
    __syncthreads();
}
constexpr int NB = 8, SEQ = 4096, D = 1024, M = NB * SEQ;
constexpr int NIN_SRC = 5936, NIN = 6144;
constexpr int ZW = 4096;
constexpr int ZQ = 0, ZK = 512, ZV = 1024, ZIQ = 1536, ZIK = 2048, ZIW = 2080, ZR = 2304;
constexpr int ZR_R = ZR, ZR_K = ZR + 512, ZR_V = ZR + 1024, ZR_WD = ZR + 1536, ZR_AD = ZR + 1600, ZR_GD = ZR + 1664;
constexpr int GW = 2048;
constexpr int NEXP = 64, FF = 256, TOPK = 8;
constexpr float RMS_EPS = 1e-6f, GN_EPS = 64e-5f;
constexpr float QSCALE = 0.125f * 1.4426950408889634f;
constexpr int NWAVES = 8, NTHR = 512;

constexpr size_t MiB = 1u << 20;
constexpr size_t WS_CTL = 0, CTL_ZERO_BYTES = 1 * MiB;
constexpr size_t WS_MOD = 1 * MiB;
constexpr size_t WS_DUT = 1 * MiB + 256 * 1024;
constexpr size_t WS_IUT = WS_DUT + 64 * 1024;
constexpr size_t WS_GUT = WS_IUT + 64 * 1024;
constexpr size_t WS_WIN = 2 * MiB;
constexpr size_t WS_WA = 14 * MiB, WS_WR = 15 * MiB;
constexpr size_t WS_WO = 16 * MiB;
constexpr size_t WS_WRT = 18 * MiB;
constexpr size_t WS_WSH1 = 19 * MiB;
constexpr size_t WS_WSH2 = 20 * MiB;
constexpr size_t WS_BRS = 21 * MiB, WS_KRS = 22 * MiB;
constexpr size_t WS_TOPE = 23 * MiB, WS_TOPW = 24 * MiB;
constexpr size_t WS_LOGIT = 25 * MiB;
constexpr size_t WS_Z = 36 * MiB;
constexpr size_t WS_H0 = 292 * MiB, WS_H1 = 324 * MiB;
constexpr size_t WS_SEL = 356 * MiB;
constexpr size_t WS_R0 = 372 * MiB, WS_R1 = 404 * MiB, WS_R2 = 436 * MiB, WS_R3 = 468 * MiB;
constexpr size_t WS_W2T = 36 * MiB;
constexpr size_t WS_ACT = 68 * MiB;
constexpr size_t WS_ACTS = 196 * MiB;
constexpr size_t WS_STOK = 212 * MiB, WS_SW = 213 * MiB;
constexpr size_t WS_W1T = 214 * MiB;
constexpr size_t WS_H2 = 278 * MiB;
constexpr size_t WS_SLOT = 214 * MiB;
constexpr size_t WS_END = 502 * MiB;
constexpr int CW_TMO = 0, CW_BAR = 4096, CW_CNT = 32768, CW_CUR = 32768 + 128, CW_Q = 32768 + 512;

constexpr int RING_BYTES = 131072;
constexpr int LDSCTL_OFF = RING_BYTES, MISC_OFF = LDSCTL_OFF + 320;
constexpr int LDS_TILETAB = RING_BYTES + 1024;
constexpr int LDS_PTAB = RING_BYTES + 512;
constexpr int LDS_PARA = 118800;
constexpr int LDS_PARB = LDS_TILETAB;
constexpr int LDS_BYTES = 147456;
#define AIN(i) ain_ptr(F.lds, (i))

struct Args { const float* in[31]; float* out; unsigned char* ws; int ph_lo, ph_hi, li, pad; };
struct Frame {
    LAS unsigned char* lds;
    volatile LAS unsigned* MISC;
    unsigned* ctl;
    int tid, lane, wave, vcu, G, gw, NGW;
    float* out; unsigned char* ws;
};

__device__ __forceinline__ const float* ain_ptr(LAS unsigned char* lds, int i) {
    const u32x2 w = *(const LAS u32x2*)(lds + LDS_PTAB + 8 * i);
    const unsigned lo = (unsigned)__builtin_amdgcn_readfirstlane((int)w.x), hi = (unsigned)__builtin_amdgcn_readfirstlane((int)w.y);
    return (const float*)(const GAS float*)(((unsigned long long)hi << 32) | lo);
}
struct TrSrc { const float* base; int nsrc; };
template <int FP8, class ColFn>
__device__ __forceinline__ void transpose_item(const ColFn& colfn, int K, bf16_t* WT, LAS float* scr, int kb, int nb, int lane) {
    const int k0 = 64 * kb, n0 = 32 * nb;
    const TrSrc s = colfn(n0 + (lane & 31));
    float v_[32];
#pragma unroll
    for (int i = 0; i < 32; ++i) { const int kk = 2 * i + (lane >> 5); v_[i] = s.base ? s.base[(size_t)(k0 + kk) * s.nsrc] : 0.f; }
#pragma unroll
    for (int i = 0; i < 32; ++i) { const int kk = 2 * i + (lane >> 5); scr[kk * 33 + (lane & 31)] = v_[i]; }
    LDS_WAIT(); asm volatile("" ::: "memory");
    const int c = lane & 7;
#pragma unroll
    for (int j = 0; j < 4; ++j) { const int n = (lane >> 3) + 8 * j; const LAS float* sp = scr + (8 * c) * 33 + n;
        if constexpr (FP8) { constexpr float S8 = 32.0f;
            int lo = __builtin_amdgcn_cvt_pk_fp8_f32(sp[0 * 33] * S8, sp[1 * 33] * S8, 0, false); lo = __builtin_amdgcn_cvt_pk_fp8_f32(sp[2 * 33] * S8, sp[3 * 33] * S8, lo, true);
            int hi = __builtin_amdgcn_cvt_pk_fp8_f32(sp[4 * 33] * S8, sp[5 * 33] * S8, 0, false); hi = __builtin_amdgcn_cvt_pk_fp8_f32(sp[6 * 33] * S8, sp[7 * 33] * S8, hi, true);
            *(GAS u32x2*)((unsigned char*)WT + (size_t)(n0 + n) * K + k0 + 8 * c) = (u32x2){(unsigned)lo, (unsigned)hi}; }
        else { u32x4 o; o.x = pk2(sp[0 * 33], sp[1 * 33]); o.y = pk2(sp[2 * 33], sp[3 * 33]); o.z = pk2(sp[4 * 33], sp[5 * 33]); o.w = pk2(sp[6 * 33], sp[7 * 33]);
            *(GAS u32x4*)(WT + (size_t)(n0 + n) * K + k0 + 8 * c) = o; } }
    LDS_WAIT(); asm volatile("" ::: "memory");
}

__device__ __forceinline__ void p0_mod(const Args& args, Frame& F, int task) {
    LAS float* sc = (LAS float*)F.lds;
    LAS float* red = (LAS float*)(F.lds + 32768);
    const float* c = AIN(1);
    for (int i = F.tid; i < 8192; i += NTHR) { const float v = c[i]; sc[i] = v * fast_sigmoid(v); }
    __syncthreads();
    const float* aw = AIN(2) + 64 * task + F.lane;
    float acc[8];
#pragma unroll
    for (int b = 0; b < 8; ++b) acc[b] = 0.f;
    const int kb = 128 * F.wave;
#pragma unroll 4
    for (int k = 0; k < 128; ++k) { const float a = aw[(size_t)(kb + k) * 6144];
#pragma unroll
        for (int b = 0; b < 8; ++b) acc[b] += sc[b * 1024 + kb + k] * a; }
#pragma unroll
    for (int b = 0; b < 8; ++b) red[(F.wave * 8 + b) * 64 + F.lane] = acc[b];
    __syncthreads();
    { const int b = F.wave; float s = AIN(3)[64 * task + F.lane];
#pragma unroll
      for (int w = 0; w < 8; ++w) s += red[(w * 8 + b) * 64 + F.lane];
      ((float*)(F.ws + WS_MOD))[b * 6144 + 64 * task + F.lane] = s; }
    __syncthreads();
}

__device__ __forceinline__ void p0_prologue(const Args& args, Frame& F) {
    if (blockIdx.x < 96) p0_mod(args, F, blockIdx.x);
    LAS float* scr = (LAS float*)(F.lds + F.wave * 16384);
    bf16_t* const ws16 = (bf16_t*)F.ws;
    constexpr int I_WIN = 16 * 192, I_WA = 8 * 32, I_WO = 16 * 32, I_WRT = 16 * 8, I_SH1 = 16 * 16, I_SH2 = 4 * 32, I_DU = 16, I_GU = 32;
    constexpr int NIT = I_WIN + 2 * I_WA + I_WO + I_WRT + I_SH1 + I_SH2 + 2 * I_DU + I_GU;
    for (int it = F.gw; it < NIT; it += F.NGW) {
        int r = it;
        if (r < I_WIN) { const float* w = AIN(5);
            transpose_item<1>([=](int n) { TrSrc s; const bool ok = (n < 2096) || (n >= 2304); const int col = n < 2096 ? n : n - 208; s.base = ok ? w + col : nullptr; s.nsrc = NIN_SRC; return s; },
                           1024, (bf16_t*)(F.ws + WS_WIN), scr, r / 192, r % 192, F.lane); continue; } r -= I_WIN;
        if (r < I_WA) { const float* w = AIN(18); transpose_item<0>([=](int n) { TrSrc s; s.base = w + n; s.nsrc = 1024; return s; }, 512, (bf16_t*)(F.ws + WS_WA), scr, r / 32, r % 32, F.lane); continue; } r -= I_WA;
        if (r < I_WA) { const float* w = AIN(19); transpose_item<0>([=](int n) { TrSrc s; s.base = w + n; s.nsrc = 1024; return s; }, 512, (bf16_t*)(F.ws + WS_WR), scr, r / 32, r % 32, F.lane); continue; } r -= I_WA;
        if (r < I_WO) { const float* w = AIN(20); transpose_item<1>([=](int n) { TrSrc s; s.base = w + n; s.nsrc = 1024; return s; }, 1024, (bf16_t*)(F.ws + WS_WO), scr, r / 32, r % 32, F.lane); continue; } r -= I_WO;
        if (r < I_WRT) { const float* w = AIN(22); transpose_item<0>([=](int n) { TrSrc s; s.base = n < 64 ? w + n : nullptr; s.nsrc = 64; return s; }, 1024, (bf16_t*)(F.ws + WS_WRT), scr, r / 8, r % 8, F.lane); continue; } r -= I_WRT;
        if (r < I_SH1) { const float* wg = AIN(27); const float* wu = AIN(28);
            transpose_item<0>([=](int n) { TrSrc s; const int j = n >> 8, sel = (n >> 7) & 1, cc = n & 127; s.base = (sel ? wu : wg) + 128 * j + cc; s.nsrc = 256; return s; }, 1024, (bf16_t*)(F.ws + WS_WSH1), scr, r / 16, r % 16, F.lane); continue; } r -= I_SH1;
        if (r < I_SH2) { const float* w = AIN(29); transpose_item<0>([=](int n) { TrSrc s; s.base = w + n; s.nsrc = 1024; return s; }, 256, (bf16_t*)(F.ws + WS_WSH2), scr, r / 32, r % 32, F.lane); continue; } r -= I_SH2;
        if (r < I_DU) { const float* w = AIN(9); transpose_item<0>([=](int n) { TrSrc s; s.base = w + n; s.nsrc = 512; return s; }, 64, (bf16_t*)(F.ws + WS_DUT), scr, 0, r, F.lane); continue; } r -= I_DU;
        if (r < I_DU) { const float* w = AIN(11); transpose_item<0>([=](int n) { TrSrc s; s.base = w + n; s.nsrc = 512; return s; }, 64, (bf16_t*)(F.ws + WS_IUT), scr, 0, r, F.lane); continue; } r -= I_DU;
        { const float* w = AIN(12); transpose_item<0>([=](int n) { TrSrc s; s.base = w + n; s.nsrc = 512; return s; }, 128, (bf16_t*)(F.ws + WS_GUT), scr, r / 16, r % 16, F.lane); }
    }
    (void)ws16;
}

__device__ __forceinline__ void convert_experts(const Args& args, Frame& F) {
    LAS float* scr = (LAS float*)(F.lds + F.wave * 16384);
    constexpr int I1 = 16 * 16, I2 = 4 * 32, PER = I1 + I2, NIT = 64 * PER;
    for (int it = F.gw; it < NIT; it += F.NGW) {
        const int e = it / PER; int r = it % PER;
        if (r < I1) { const float* wg = AIN(24) + (size_t)e * 1024 * 256; const float* wu = AIN(25) + (size_t)e * 1024 * 256;
            transpose_item<0>([=](int n) { TrSrc s; const int j = n >> 8, sel = (n >> 7) & 1, cc = n & 127; s.base = (sel ? wu : wg) + 128 * j + cc; s.nsrc = 256; return s; }, 1024, (bf16_t*)(F.ws + WS_W1T) + (size_t)e * 512 * 1024, scr, r / 16, r % 16, F.lane); }
        else { r -= I1; const float* w = AIN(26) + (size_t)e * 256 * 1024;
            transpose_item<0>([=](int n) { TrSrc s; s.base = w + n; s.nsrc = 1024; return s; }, 256, (bf16_t*)(F.ws + WS_W2T) + (size_t)e * 1024 * 256, scr, r / 32, r % 32, F.lane); }
    }
}

__device__ __forceinline__ void norm_mod_rows(const Args& args, Frame& F, const float* X, const float* g, int sh_off, int sc_off, bf16_t* O, unsigned char* O8) {
    const int row0 = F.gw * 16, b = row0 / SEQ;
    const float* mod = (const float*)(F.ws + WS_MOD) + b * 6144;
    f32x4 mul[4], add[4];
#pragma unroll
    for (int j = 0; j < 4; ++j) { const int c = 4 * F.lane + 256 * j; const f32x4 gv = *(const f32x4*)(g + c), sc = *(const f32x4*)(mod + sc_off + c); add[j] = *(const f32x4*)(mod + sh_off + c); mul[j] = gv * (sc + 1.0f); }
    for (int r = 0; r < 16; ++r) {
        const GAS f32x4* xr = (const GAS f32x4*)(X + (size_t)(row0 + r) * D) + F.lane;
        f32x4 v[4]; float s = 0.f;
#pragma unroll
        for (int j = 0; j < 4; ++j) { v[j] = xr[64 * j]; s += (v[j].x * v[j].x + v[j].y * v[j].y) + (v[j].z * v[j].z + v[j].w * v[j].w); }
        const float rstd = 1.0f / sqrtf(wave_sum(s) * (1.0f / D) + RMS_EPS);
#pragma unroll
        for (int j = 0; j < 4; ++j) { const f32x4 y = v[j] * rstd * mul[j] + add[j];
            if (O) { u32x2 w; w.x = cvt_pk_bf16(y.x, y.y); w.y = cvt_pk_bf16(y.z, y.w); ((GAS u32x2*)(O + (size_t)(row0 + r) * D) + F.lane)[64 * j] = w; }
            if (O8) { int w8 = __builtin_amdgcn_cvt_pk_fp8_f32(y.x, y.y, 0, false); w8 = __builtin_amdgcn_cvt_pk_fp8_f32(y.z, y.w, w8, true); ((GAS unsigned*)(O8 + (size_t)(row0 + r) * D) + F.lane)[64 * j] = (unsigned)w8; } }
    }
}
using pg8::Unit;
constexpr float WSCALE8 = 32.0f;
typedef const f32x4 (&AccRef)[2][2][4][2];

struct EpiInProj {
    static constexpr bool PERM = true;
    bf16_t* Z; bf16_t* Gt;
    __device__ __forceinline__ void operator()(AccRef acc, const Unit& u, int wr, int wc, int fr, int fq) const {
        asm volatile("" : "+v"(fr), "+v"(fq));
        const int row0 = u.pm * 256 + wr * 64 + fr;
        const bool gate = u.pn >= 16;
        const float sc = ((u.pn < 2) ? QSCALE : 1.0f) * (1.0f / WSCALE8);
        bf16_t* base = gate ? Gt + (size_t)(u.pn - 16) * 256 : Z + (size_t)u.pn * 256;
        const int ldc = gate ? GW : ZW;
#pragma unroll
        for (int ai = 0; ai < 2; ++ai)
#pragma unroll
            for (int m = 0; m < 4; ++m) { bf16_t* rowp = base + (size_t)(row0 + ai * 128 + m * 16) * ldc + wc * 32 + 8 * fq;
#pragma unroll
                for (int bj = 0; bj < 2; ++bj) { f32x4 v0 = acc[ai][bj][m][0], v1 = acc[ai][bj][m][1];
                    if (gate) {
#pragma unroll
                        for (int j = 0; j < 4; ++j) { v0[j] = fast_sigmoid(v0[j] * sc); v1[j] = fast_sigmoid(v1[j] * sc); } }
                    else { v0 = v0 * sc; v1 = v1 * sc; }
                    u32x4 w; w.x = cvt_pk_bf16(v0[0], v0[1]); w.y = cvt_pk_bf16(v0[2], v0[3]); w.z = cvt_pk_bf16(v1[0], v1[1]); w.w = cvt_pk_bf16(v1[2], v1[3]);
                    *(u32x4*)(rowp + bj * 128) = w; } }
    }
};

constexpr float ATT_S8 = 16.0f, RW_S8 = 8.0f, MIX_S8 = 16.0f;
template <int SECOND> struct EpiMerge {
    static constexpr bool PERM = true;
    bf16_t* Mx; unsigned char* Mx8; const bf16_t* Gt; float bs;
    __device__ __forceinline__ void operator()(AccRef acc, const Unit& u, int wr, int wc, int fr, int fq) const {
        asm volatile("" : "+v"(fr), "+v"(fq));
        const int row0 = u.pm * 256 + wr * 64 + fr, col0 = u.pn * 256 + wc * 32 + 8 * fq;
#pragma unroll
        for (int ai = 0; ai < 2; ++ai)
#pragma unroll
            for (int m = 0; m < 4; ++m) { const size_t r = (size_t)(row0 + ai * 128 + m * 16);
#pragma unroll
                for (int bj = 0; bj < 2; ++bj) { const int c = col0 + bj * 128;
                    const u32x4 g = *(const u32x4*)(Gt + r * GW + SECOND * 1024 + c);
                    f32x4 v0 = acc[ai][bj][m][0] * bs, v1 = acc[ai][bj][m][1] * bs;
                    v0[0] *= bf_lo(g.x); v0[1] *= bf_hi(g.x); v0[2] *= bf_lo(g.y); v0[3] *= bf_hi(g.y);
                    v1[0] *= bf_lo(g.z); v1[1] *= bf_hi(g.z); v1[2] *= bf_lo(g.w); v1[3] *= bf_hi(g.w);
                    if (SECOND) { const u32x4 p = *(const u32x4*)(Mx + r * D + c);
                        v0[0] += bf_lo(p.x); v0[1] += bf_hi(p.x); v0[2] += bf_lo(p.y); v0[3] += bf_hi(p.y);
                        v1[0] += bf_lo(p.z); v1[1] += bf_hi(p.z); v1[2] += bf_lo(p.w); v1[3] += bf_hi(p.w);
                        v0 = v0 * MIX_S8; v1 = v1 * MIX_S8;
                        int lo = __builtin_amdgcn_cvt_pk_fp8_f32(v0[0], v0[1], 0, false); lo = __builtin_amdgcn_cvt_pk_fp8_f32(v0[2], v0[3], lo, true);
                        int hi = __builtin_amdgcn_cvt_pk_fp8_f32(v1[0], v1[1], 0, false); hi = __builtin_amdgcn_cvt_pk_fp8_f32(v1[2], v1[3], hi, true);
                        *(u32x2*)(Mx8 + r * D + c) = (u32x2){(unsigned)lo, (unsigned)hi}; }
                    else { u32x4 w; w.x = cvt_pk_bf16(v0[0], v0[1]); w.y = cvt_pk_bf16(v0[2], v0[3]); w.z = cvt_pk_bf16(v1[0], v1[1]); w.w = cvt_pk_bf16(v1[2], v1[3]);
                        *(u32x4*)(Mx + r * D + c) = w; } } }
    }
};

struct EpiOutProj {
    static constexpr bool PERM = false;
    const float* X; float* O; const float* mod;
    __device__ __forceinline__ void operator()(AccRef acc, const Unit& u, int wr, int wc, int fr, int fq) const {
        asm volatile("" : "+v"(fr), "+v"(fq));
        const int row0 = u.pm * 256 + wr * 64 + fr, col0 = u.pn * 256 + wc * 32 + 4 * fq;
        const float* g1 = mod + (size_t)((u.pm * 256) / SEQ) * 6144 + 2048;
        f32x4 gv[2][2];
#pragma unroll
        for (int bj = 0; bj < 2; ++bj)
#pragma unroll
            for (int n = 0; n < 2; ++n) gv[bj][n] = *(const f32x4*)(g1 + col0 + bj * 128 + n * 16);
#pragma unroll
        for (int ai = 0; ai < 2; ++ai)
#pragma unroll
            for (int m = 0; m < 4; ++m) { const size_t off = (size_t)(row0 + ai * 128 + m * 16) * D + col0;
#pragma unroll
                for (int bj = 0; bj < 2; ++bj)
#pragma unroll
                    for (int n = 0; n < 2; ++n) { const f32x4 xv = *(const f32x4*)(X + off + bj * 128 + n * 16);
                        *(f32x4*)(O + off + bj * 128 + n * 16) = xv + gv[bj][n] * acc[ai][bj][m][n] * (1.0f / (MIX_S8 * WSCALE8)); }
                if (m & 1) asm volatile("" ::: "memory"); }
    }
};

struct EpiRouter {
    static constexpr bool PERM = false;
    float* L;
    __device__ __forceinline__ void operator()(AccRef acc, const Unit& u, int wr, int wc, int fr, int fq) const {
        asm volatile("" : "+v"(fr), "+v"(fq));
        if (wc >= 2) return;
        const int row0 = u.pm * 256 + wr * 64 + fr, col0 = wc * 32 + 4 * fq;
#pragma unroll
        for (int ai = 0; ai < 2; ++ai)
#pragma unroll
            for (int m = 0; m < 4; ++m)
#pragma unroll
                for (int n = 0; n < 2; ++n) *(f32x4*)(L + (size_t)(row0 + ai * 128 + m * 16) * 64 + col0 + n * 16) = acc[ai][0][m][n];
    }
};

struct MoeSched1 {
    const LAS unsigned* tab; int ntiles, G, c;
    __device__ __forceinline__ bool next(int i, Unit& u) const {
        const int L = i * G + c; if (L >= 256 + 2 * ntiles) return false;
        u.pn = L & 1;
        if (L < 256) { u.pm = L >> 1; u.aux0 = (u.pm * 256) | (64 << 20); u.aux1 = 256; }
        else { const int t = (L - 256) >> 1; u.pm = t; u.aux0 = __builtin_amdgcn_readfirstlane((int)tab[2 * t]); u.aux1 = __builtin_amdgcn_readfirstlane((int)tab[2 * t + 1]); }
        return true;
    }
};
struct MoeSrc1 {
    static constexpr int ESZ = 2; static constexpr bool GATHER = true;
    const unsigned char* ws;
    __device__ __forceinline__ const char* a_base(const Unit&) const { return (const char*)(ws + WS_H2); }
    __device__ __forceinline__ const char* b_base(const Unit& u) const { const int e = u.aux0 >> 20;
        const size_t off = (e == 64 ? WS_WSH1 : WS_W1T + (size_t)e * 512 * 1024 * 2) + (size_t)u.pn * 256 * 1024 * 2; return (const char*)ws + off; }
    __device__ __forceinline__ unsigned a_off(const Unit& u, int R, int C) const {
        const int e = u.aux0 >> 20, pos0 = u.aux0 & 0xFFFFF; int tok;
        if (e == 64) tok = pos0 + R; else tok = (R < u.aux1) ? (((const int*)(ws + WS_STOK))[pos0 + R] >> 3) : 0;
        return (unsigned)tok * 2048u + (unsigned)C * 2u; }
};
struct EpiMoe1 {
    static constexpr bool PERM = true;
    unsigned char* ws;
    __device__ __forceinline__ void operator()(AccRef acc, const Unit& u, int wr, int wc, int fr, int fq) const {
        asm volatile("" : "+v"(fr), "+v"(fq));
        const int e = u.aux0 >> 20, pos0 = u.aux0 & 0xFFFFF;
        bf16_t* base = (bf16_t*)(ws + (e == 64 ? WS_ACTS : WS_ACT)) + (size_t)pos0 * FF + u.pn * 128 + wc * 32 + 8 * fq;
#pragma unroll
        for (int ai = 0; ai < 2; ++ai)
#pragma unroll
            for (int m = 0; m < 4; ++m) { const int r = ai * 128 + wr * 64 + m * 16 + fr;
                float o[8];
#pragma unroll
                for (int n = 0; n < 2; ++n)
#pragma unroll
                    for (int j = 0; j < 4; ++j) { const float g = acc[ai][0][m][n][j], up = acc[ai][1][m][n][j]; o[4 * n + j] = g * fast_sigmoid(g) * up; }
                u32x4 w; w.x = cvt_pk_bf16(o[0], o[1]); w.y = cvt_pk_bf16(o[2], o[3]); w.z = cvt_pk_bf16(o[4], o[5]); w.w = cvt_pk_bf16(o[6], o[7]);
                if (r < u.aux1) *(u32x4*)(base + (size_t)r * FF) = w; }
    }
};
struct MoeSched2 {
    const LAS unsigned* tab; int t0, ntiles, nsh, G, c;
    __device__ __forceinline__ bool next(int i, Unit& u) const {
        const int L = i * G + c; if (L >= nsh + 4 * ntiles) return false;
        u.pn = L & 3;
        if (L < nsh) { u.pm = L >> 2; u.aux0 = (u.pm * 256) | (64 << 20); u.aux1 = 256; }
        else { const int t = t0 + ((L - nsh) >> 2); u.pm = t; u.aux0 = __builtin_amdgcn_readfirstlane((int)tab[2 * t]); u.aux1 = __builtin_amdgcn_readfirstlane((int)tab[2 * t + 1]); }
        return true;
    }
};
struct MoeSrc2 {
    static constexpr int ESZ = 2; static constexpr bool GATHER = true;
    const unsigned char* ws;
    __device__ __forceinline__ const char* a_base(const Unit& u) const { return (const char*)ws + ((u.aux0 >> 20) == 64 ? WS_ACTS : WS_ACT); }
    __device__ __forceinline__ const char* b_base(const Unit& u) const { const int e = u.aux0 >> 20;
        const size_t off = (e == 64 ? WS_WSH2 : WS_W2T + (size_t)e * 1024 * 256 * 2) + (size_t)u.pn * 256 * 256 * 2; return (const char*)ws + off; }
    __device__ __forceinline__ unsigned a_off(const Unit& u, int R, int C) const {
        const int pos0 = u.aux0 & 0xFFFFF; const int rr = R < u.aux1 ? R : u.aux1 - 1;
        return (unsigned)(pos0 + rr) * 512u + (unsigned)C * 2u; }
};
constexpr float SLOT_SCALE = 16.0f;
constexpr int NSLOT = 9;
struct EpiMoe2 {
    static constexpr bool PERM = true;
    unsigned char* ws; float* X1; int tokbase;
    __device__ __forceinline__ void operator()(AccRef acc, const Unit& u, int wr, int wc, int fr, int fq) const {
        asm volatile("" : "+v"(fr), "+v"(fq));
        const int e = u.aux0 >> 20, pos0 = u.aux0 & 0xFFFFF; const int col0 = u.pn * 256 + wc * 32 + 8 * fq;
        if (e == 64) {
#pragma unroll
            for (int ai = 0; ai < 2; ++ai)
#pragma unroll
                for (int m = 0; m < 4; ++m) { unsigned char* rowp = (unsigned char*)(ws + WS_SLOT) + ((size_t)(pos0 + ai * 128 + wr * 64 + m * 16 + fr) * NSLOT + 8) * D + u.pn * 256 + wc * 64 + fq * 16;
                    u32x4 o;
#pragma unroll
                    for (int bj = 0; bj < 2; ++bj) { const f32x4 v0 = acc[ai][bj][m][0] * SLOT_SCALE, v1 = acc[ai][bj][m][1] * SLOT_SCALE;
                        int lo = __builtin_amdgcn_cvt_pk_fp8_f32(v0[0], v0[1], 0, false); lo = __builtin_amdgcn_cvt_pk_fp8_f32(v0[2], v0[3], lo, true);
                        int hi = __builtin_amdgcn_cvt_pk_fp8_f32(v1[0], v1[1], 0, false); hi = __builtin_amdgcn_cvt_pk_fp8_f32(v1[2], v1[3], hi, true);
                        if (bj == 0) { o.x = (unsigned)lo; o.y = (unsigned)hi; } else { o.z = (unsigned)lo; o.w = (unsigned)hi; } }
                    *(u32x4*)rowp = o;
                    asm volatile("" ::: "memory"); }
        } else {
#pragma unroll
            for (int ai = 0; ai < 2; ++ai)
#pragma unroll
                for (int m = 0; m < 4; ++m) { const int r = ai * 128 + wr * 64 + m * 16 + fr;
                    if (r < u.aux1) { const int tk = ((const int*)(ws + WS_STOK))[pos0 + r]; const float w = ((const float*)(ws + WS_SW))[pos0 + r] * SLOT_SCALE;
                        unsigned char* rowp = (unsigned char*)(ws + WS_SLOT) + ((size_t)(tk >> 3) * NSLOT + (tk & 7)) * D + u.pn * 256 + wc * 64 + fq * 16;
                        u32x4 o;
#pragma unroll
                        for (int bj = 0; bj < 2; ++bj) { const f32x4 v0 = acc[ai][bj][m][0] * w, v1 = acc[ai][bj][m][1] * w;
                            int lo = __builtin_amdgcn_cvt_pk_fp8_f32(v0[0], v0[1], 0, false); lo = __builtin_amdgcn_cvt_pk_fp8_f32(v0[2], v0[3], lo, true);
                            int hi = __builtin_amdgcn_cvt_pk_fp8_f32(v1[0], v1[1], 0, false); hi = __builtin_amdgcn_cvt_pk_fp8_f32(v1[2], v1[3], hi, true);
                            if (bj == 0) { o.x = (unsigned)lo; o.y = (unsigned)hi; } else { o.z = (unsigned)lo; o.w = (unsigned)hi; } }
                        *(u32x4*)rowp = o; }
                    asm volatile("" ::: "memory"); }
        }
    }
};
__device__ __forceinline__ unsigned ord_key(float x) { const unsigned b = __float_as_uint(x); return (b & 0x80000000u) ? ~b : (b | 0x80000000u); }

__device__ __forceinline__ void indexer_unit(const Args& args, Frame& F, int b, int q0) {
    const bf16_t* Z = (const bf16_t*)(F.ws + WS_Z) + (size_t)b * SEQ * ZW;
    unsigned* SELM = (unsigned*)(F.ws + WS_SEL) + (size_t)b * SEQ * 128;
    int tid = F.tid; asm volatile("" : "+v"(tid));
    const int lane = tid & 63, kl = lane & 31, hl = lane >> 5, w = F.wave;
    const int qa = q0 + 2 * w;
    const int myq = qa + hl;
    bf16x8 A0, A1;
    { const int aq = (kl >> 2) & 1, ah = 4 * (kl >> 3) + (kl & 3);
      const bf16_t* p = Z + (size_t)(qa + aq) * ZW + ZIQ + ah * 32 + 8 * hl;
      A0 = *(const bf16x8*)p; A1 = *(const bf16x8*)(p + 16); }
    float wq[16];
    { const bf16_t* p = Z + (size_t)myq * ZW + ZIW; const u32x4 a = *(const u32x4*)p, c = *(const u32x4*)(p + 8);
      wq[0] = bf_lo(a.x); wq[1] = bf_hi(a.x); wq[2] = bf_lo(a.y); wq[3] = bf_hi(a.y); wq[4] = bf_lo(a.z); wq[5] = bf_hi(a.z); wq[6] = bf_lo(a.w); wq[7] = bf_hi(a.w);
      wq[8] = bf_lo(c.x); wq[9] = bf_hi(c.x); wq[10] = bf_lo(c.y); wq[11] = bf_hi(c.y); wq[12] = bf_lo(c.z); wq[13] = bf_hi(c.z); wq[14] = bf_lo(c.w); wq[15] = bf_hi(c.w); }
    unsigned key[128];
    const int nchunk = (q0 + 15) / 1024 + 1;
#define IDX_LOAD(ch, buf) do { _Pragma("unroll") for (int _h = 0; _h < 2; ++_h) { u32x4 v_[4]; \
        _Pragma("unroll") for (int _i = 0; _i < 4; ++_i) { const int pc = tid + 512 * (4 * _h + _i); const int kk = pc >> 2, c4 = pc & 3; v_[_i] = *(const u32x4*)(Z + (size_t)((ch) * 1024 + kk) * ZW + ZIK + 8 * c4); } \
        _Pragma("unroll") for (int _i = 0; _i < 4; ++_i) { const int pc = tid + 512 * (4 * _h + _i); const int kk = pc >> 2, c4 = pc & 3; *(LAS u32x4*)(F.lds + (buf) * 65536 + (c4 * 1024 + kk) * 16) = v_[_i]; } \
        asm volatile("" ::: "memory"); } } while (0)
    IDX_LOAD(0, 0);
    __syncthreads();
#pragma unroll
    for (int ch = 0; ch < 4; ++ch) {
        if (ch < nchunk) {
            if (ch + 1 < nchunk) IDX_LOAD(ch + 1, (ch + 1) & 1);
            LAS unsigned char* kbl = F.lds + (ch & 1) * 65536 + hl * 16384 + kl * 16; asm volatile("" : "+v"(kbl));
#pragma unroll
            for (int tt = 0; tt < 32; tt += 2) {
                const int t = ch * 32 + tt;
                if (32 * t <= qa + 1) {
                    bf16x8 B0[2], B1[2]; f32x16 acc[2];
#pragma unroll
                    for (int j = 0; j < 2; ++j) { B0[j] = *(const LAS bf16x8*)(kbl + 512 * (tt + j)); B1[j] = *(const LAS bf16x8*)(kbl + 32768 + 512 * (tt + j)); }
#pragma unroll
                    for (int j = 0; j < 2; ++j) { acc[j] = f32x16{}; acc[j] = __builtin_amdgcn_mfma_f32_32x32x16_bf16(A0, B0[j], acc[j], 0, 0, 0); }
#pragma unroll
                    for (int j = 0; j < 2; ++j) acc[j] = __builtin_amdgcn_mfma_f32_32x32x16_bf16(A1, B1[j], acc[j], 0, 0, 0);
#pragma unroll
                    for (int j = 0; j < 2; ++j) { float s = 0.f;
#pragma unroll
                        for (int i = 0; i < 16; ++i) { const float av_ = acc[j][i]; const int xb_ = __float_as_int(av_); s += __int_as_float(xb_ > 0 ? xb_ : 0) * wq[i]; }
                        key[t + j] = (32 * (t + j) + kl <= myq) ? ord_key(s) : 0u; }
                } else {
#pragma unroll
                    for (int j = 0; j < 2; ++j) key[t + j] = 0u;
                }
            }
            __syncthreads();
        } else {
#pragma unroll
            for (int tt = 0; tt < 32; ++tt) key[ch * 32 + tt] = 0u;
        }
    }
#undef IDX_LOAD
#pragma unroll
    for (int w = 0; w < 4; ++w) {
        if (1024 * w <= qa + 1) {
#pragma unroll
            for (int k = 0; k < 16; ++k) { const unsigned lo = key[32 * w + k], hi_ = key[32 * w + k + 16];
                key[32 * w + k] = __builtin_amdgcn_perm(hi_, lo, 0x05040100u); key[32 * w + k + 16] = __builtin_amdgcn_perm(hi_, lo, 0x07060302u); }
#pragma unroll
            for (int k = 0; k < 32; ++k) if (!(k & 8)) { const unsigned lo = key[32 * w + k], hi_ = key[32 * w + k + 8];
                key[32 * w + k] = __builtin_amdgcn_perm(hi_, lo, 0x06020400u); key[32 * w + k + 8] = __builtin_amdgcn_perm(hi_, lo, 0x07030501u); }
#pragma unroll
            for (int k = 0; k < 32; ++k) if (!(k & 4)) { const unsigned lo = key[32 * w + k], hi_ = key[32 * w + k + 4]; const unsigned m = 0x0F0F0F0Fu;
                key[32 * w + k] = (lo & m) | ((hi_ << 4) & ~m); key[32 * w + k + 4] = ((lo >> 4) & m) | (hi_ & ~m); }
#pragma unroll
            for (int k = 0; k < 32; ++k) if (!(k & 2)) { const unsigned lo = key[32 * w + k], hi_ = key[32 * w + k + 2]; const unsigned m = 0x33333333u;
                key[32 * w + k] = (lo & m) | ((hi_ << 2) & ~m); key[32 * w + k + 2] = ((lo >> 2) & m) | (hi_ & ~m); }
#pragma unroll
            for (int k = 0; k < 32; ++k) if (!(k & 1)) { const unsigned lo = key[32 * w + k], hi_ = key[32 * w + k + 1]; const unsigned m = 0x55555555u;
                key[32 * w + k] = (lo & m) | ((hi_ << 1) & ~m); key[32 * w + k + 1] = ((lo >> 1) & m) | (hi_ & ~m); }
        }
    }
    unsigned Al[4] = {~0u, ~0u, ~0u, ~0u}, Gt[4] = {0u, 0u, 0u, 0u};
    int ab0 = 0, ab1 = 0; unsigned T0 = 0u, T1 = 0u; bool dn0 = false, dn1 = false;
#define IDX_DPP(v, ctrl) __builtin_amdgcn_update_dpp(0, (v), (ctrl), 0xF, 0xF, true)
#pragma unroll
    for (int bit = 31; bit >= 0; --bit) {
        unsigned S_[4]; int c = 0;
#pragma unroll
        for (int w = 0; w < 4; ++w) { S_[w] = Al[w] & key[32 * w + bit]; c += __builtin_popcount(S_[w]); }
        c += IDX_DPP(c, 0xB1); c += IDX_DPP(c, 0x4E); c += IDX_DPP(c, 0x141); c += IDX_DPP(c, 0x140);
        const int cn0 = ab0 + __builtin_amdgcn_readlane(c, 0) + __builtin_amdgcn_readlane(c, 16), cn1 = ab1 + __builtin_amdgcn_readlane(c, 32) + __builtin_amdgcn_readlane(c, 48);
        const bool t0 = cn0 >= 256, t1 = cn1 >= 256;
        if (t0) { T0 |= 1u << bit; dn0 = dn0 || cn0 == 256; } else ab0 = cn0;
        if (t1) { T1 |= 1u << bit; dn1 = dn1 || cn1 == 256; } else ab1 = cn1;
        const unsigned nm = hl ? (t1 ? 0u : ~0u) : (t0 ? 0u : ~0u);
#pragma unroll
        for (int w = 0; w < 4; ++w) { Al[w] &= key[32 * w + bit] ^ nm; Gt[w] |= S_[w] & nm; }
        if (dn0 && dn1) break;
    }
#undef IDX_DPP
    unsigned x[4];
    { const bool nz = hl ? (T1 != 0u) : (T0 != 0u);
#pragma unroll
      for (int w = 0; w < 4; ++w) x[w] = Gt[w] | (nz ? Al[w] : 0u); }
#define IDX_BFLY(d, m) do { const bool up_ = (kl & (d)) != 0; const unsigned km_ = up_ ? ~(m) : (m); const unsigned am_ = up_ ? (unsigned)(d) : 32u - (d); \
        _Pragma("unroll") for (int w = 0; w < 4; ++w) { const unsigned t_ = (unsigned)__builtin_amdgcn_ds_swizzle((int)x[w], 0x1F | ((d) << 10)); \
            const unsigned rot_ = __builtin_amdgcn_alignbit(t_, t_, am_); x[w] = (x[w] & km_) | (rot_ & ~km_); } } while (0)
    IDX_BFLY(16, 0x0000FFFFu); IDX_BFLY(8, 0x00FF00FFu); IDX_BFLY(4, 0x0F0F0F0Fu); IDX_BFLY(2, 0x33333333u); IDX_BFLY(1, 0x55555555u);
#undef IDX_BFLY
#pragma unroll
    for (int j = 0; j < 4; ++j) SELM[(size_t)myq * 128 + kl + 32 * j] = x[j];
}

__device__ __forceinline__ void indexer_phase(const Args& args, Frame& F) {
    const int c = blockIdx.x;
    for (int i = 0; i < 8; ++i) {
        for (int u = c + i * F.G; u < 2048 && i < 8; u += 2048) {
            const int b = u >> 8, pos = u & 255, blk = (b & 1) ? 255 - pos : pos;
            indexer_unit(args, F, b, blk * 16);
        }
    }
}
namespace att {
constexpr int DM = ZW, QB = 256, KVB = 64, SLOTB = 8192;
constexpr int L_K = 0, L_V = 2 * SLOTB, L_MASK = 4 * SLOTB, L_WSF = L_MASK + 8 * 2048, L_OST = L_WSF + 8 * 256, L_BT = L_OST + 8 * 4096, L_END = L_BT + 512;
__device__ __forceinline__ int crow(int r, int hi) { return (r & 3) + 8 * (r >> 2) + 4 * hi; }
__device__ __forceinline__ void glds16(const void* gsrc, unsigned lds_dst) { unsigned keep;
    asm volatile("s_mov_b32 %0, m0\n\ts_mov_b32 m0, %2\n\ts_nop 0\n\tglobal_load_lds_dwordx4 %1, off\n\ts_mov_b32 m0, %0" : "=&s"(keep) : "v"(gsrc), "s"(lds_dst) : "memory"); }
__device__ __forceinline__ unsigned cvtpk(float lo, float hi) { return cvt_pk_bf16(lo, hi); }
typedef short s16x4 __attribute__((ext_vector_type(4)));

__device__ __forceinline__ void attn_unit(const Args& args, Frame& F, int b, int h, int qb) {
    const int lane = F.lane, r32 = lane & 31, hi = lane >> 5, wid = F.wave;
    const bf16_t* Zb = (const bf16_t*)(F.ws + WS_Z) + (size_t)b * SEQ * DM;
    const int q0 = qb * QB;
    const bf16_t* Qw = Zb + (size_t)(q0 + wid * 32) * DM + ZQ + h * 64;
    const bf16_t* Kh = Zb + ZK + h * 64; const bf16_t* Vh = Zb + ZV + h * 64;
    LAS unsigned char* shm = F.lds;
    const unsigned lds0 = (unsigned)(uintptr_t)shm;
    LAS float* wsf = (LAS float*)(shm + L_WSF) + wid * 64;
    LAS float* bt = (LAS float*)(shm + L_BT);
    if (F.tid < 128) { const int rel = F.tid; int bk;
        if (rel < 16) bk = rel; else { bk = 16 + (int)(logf((float)rel / 16.0f) / logf(8.0f) * 16.0f); bk = bk < 31 ? bk : 31; }
        bt[rel] = (AIN(6)[bk * 8 + h] - AIN(6)[31 * 8 + h]) * 1.4426950408889634f; }
    const bf16_t* ksrc = Kh + (size_t)lane * DM + wid * 8;
    const bf16_t* vsrc = Vh + (size_t)(16 * (wid & 3) + (lane >> 2)) * DM + (wid >> 2) * 32 + (lane & 3) * 8;
    const unsigned kdst = lds0 + L_K + wid * 1024, vdst = lds0 + L_V + wid * 1024;
    const unsigned* SELM = (const unsigned*)(F.ws + WS_SEL) + (size_t)(b * SEQ + q0 + wid * 32 + r32) * 128 + 4 * hi;
    const unsigned mdst = lds0 + L_MASK + wid * 2048;
#define DMA_K(t, slot) glds16(ksrc + (size_t)(t) * KVB * DM, (unsigned)__builtin_amdgcn_readfirstlane(kdst + (slot) * SLOTB))
#define DMA_V(t, slot) glds16(vsrc + (size_t)(t) * KVB * DM, (unsigned)__builtin_amdgcn_readfirstlane(vdst + (slot) * SLOTB))
#define DMA_M(g) glds16(SELM + 8 * (g), (unsigned)__builtin_amdgcn_readfirstlane(mdst + ((g) & 1) * 1024))
    const int NT = (q0 + QB) / KVB;
    bf16x8 qr[4];
#pragma unroll
    for (int d0 = 0; d0 < 4; ++d0) qr[d0] = *(const bf16x8*)(Qw + (size_t)r32 * DM + d0 * 16 + hi * 8);
    asm volatile("s_waitcnt vmcnt(0)" ::: "memory");
    __syncthreads();
    DMA_M(0); DMA_K(0, 0); DMA_V(0, 0);
    float m_run = -1e30f, l_run = 0.f; f32x16 o[2]; o[0] = f32x16{}; o[1] = f32x16{};
    const int qpos = q0 + wid * 32 + r32;
    const int vb0 = (int)(lds0 + L_V) + ((lane >> 4) & 1) * 32 + (lane & 3) * 8 + (4 * hi + ((lane & 15) >> 2)) * 64;
    for (int t = 0; t < NT; ++t) {
        const int slot = t & 1, g = t >> 2, tq = t & 3;
        if (t + 1 < NT) {
            DMA_K(t + 1, slot ^ 1); DMA_V(t + 1, slot ^ 1);
            if (tq == 0) { DMA_M(g + 1); asm volatile("s_waitcnt vmcnt(3)" ::: "memory"); }
            else if (tq == 1) asm volatile("s_waitcnt vmcnt(3)" ::: "memory");
            else asm volatile("s_waitcnt vmcnt(2)" ::: "memory");
        } else asm volatile("s_waitcnt vmcnt(0)" ::: "memory");
        __builtin_amdgcn_s_barrier(); asm volatile("" ::: "memory");
        f32x16 p0 = {}, p1 = {};
        { const LAS unsigned char* kb = shm + L_K + slot * SLOTB + hi * 1024 + r32 * 16;
#pragma unroll
          for (int d0 = 0; d0 < 4; ++d0) { const bf16x8 b0 = *(const LAS bf16x8*)(kb + d0 * 2048); const bf16x8 b1 = *(const LAS bf16x8*)(kb + d0 * 2048 + 512);
              p0 = __builtin_amdgcn_mfma_f32_32x32x16_bf16(b0, qr[d0], p0, 0, 0, 0); p1 = __builtin_amdgcn_mfma_f32_32x32x16_bf16(b1, qr[d0], p1, 0, 0, 0); } }
        const u32x2 mwv = *(const LAS u32x2*)(shm + L_MASK + wid * 2048 + (g & 1) * 1024 + (tq >> 1) * 512 + r32 * 16 + (tq & 1) * 8);
        if (64 * t + 63 + 112 >= q0 + wid * 32) {
#pragma unroll
            for (int r = 0; r < 16; ++r) { const int kv = 64 * t + crow(r, hi); int r0 = qpos - kv, r1 = r0 - 32;
                r0 = r0 < 0 ? 0 : (r0 > 127 ? 127 : r0); r1 = r1 < 0 ? 0 : (r1 > 127 ? 127 : r1);
                p0[r] += bt[r0]; p1[r] += bt[r1]; }
        }
        const float NEG = -INFINITY;
#pragma unroll
        for (int r = 0; r < 16; ++r) { const int bitp = crow(r, hi);
            if (!((mwv.x >> bitp) & 1u)) p0[r] = NEG;
            if (!((mwv.y >> bitp) & 1u)) p1[r] = NEG; }
        float rm = p0[0];
#pragma unroll
        for (int r = 1; r < 16; ++r) rm = __builtin_fmaxf(rm, p0[r]);
#pragma unroll
        for (int r = 0; r < 16; ++r) rm = __builtin_fmaxf(rm, p1[r]);
        rm = __builtin_fmaxf(rm, __shfl_xor(rm, 32));
        const float m_new = __builtin_fmaxf(m_run, rm);
        const float f = __builtin_amdgcn_exp2f(m_run - m_new);
        m_run = m_new;
        float sacc = 0.f;
#pragma unroll
        for (int r = 0; r < 16; ++r) { p0[r] = __builtin_amdgcn_exp2f(p0[r] - m_new); p1[r] = __builtin_amdgcn_exp2f(p1[r] - m_new); sacc += p0[r] + p1[r]; }
        l_run = l_run * f + sacc;
        if (hi == 0) wsf[r32] = f;
        asm volatile("s_waitcnt lgkmcnt(0)" ::: "memory");
#pragma unroll
        for (int d = 0; d < 2; ++d)
#pragma unroll
            for (int r = 0; r < 16; ++r) o[d][r] *= wsf[crow(r, hi)];
        u32x4 pw0, pw1, pw2, pw3;
        pw0 = (u32x4){cvtpk(p0[0], p0[1]), cvtpk(p0[2], p0[3]), cvtpk(p0[4], p0[5]), cvtpk(p0[6], p0[7])};
        pw1 = (u32x4){cvtpk(p0[8], p0[9]), cvtpk(p0[10], p0[11]), cvtpk(p0[12], p0[13]), cvtpk(p0[14], p0[15])};
        pw2 = (u32x4){cvtpk(p1[0], p1[1]), cvtpk(p1[2], p1[3]), cvtpk(p1[4], p1[5]), cvtpk(p1[6], p1[7])};
        pw3 = (u32x4){cvtpk(p1[8], p1[9]), cvtpk(p1[10], p1[11]), cvtpk(p1[12], p1[13]), cvtpk(p1[14], p1[15])};
        { const int vb = vb0 + slot * SLOTB;
#pragma unroll
          for (int d0 = 0; d0 < 2; ++d0) { s16x4 lo[4], hh[4];
#pragma unroll
              for (int ks = 0; ks < 4; ++ks) {
                  asm volatile("ds_read_b64_tr_b16 %0,%1 offset:%c2" : "=&v"(lo[ks]) : "v"(vb), "i"(d0 * 4096 + ks * 1024) : "memory");
                  asm volatile("ds_read_b64_tr_b16 %0,%1 offset:%c2" : "=&v"(hh[ks]) : "v"(vb), "i"(d0 * 4096 + ks * 1024 + 512) : "memory"); }
              asm volatile("s_waitcnt lgkmcnt(0)" ::: "memory"); __builtin_amdgcn_sched_barrier(0);
#define PKV(k) (bf16x8){lo[k][0], lo[k][1], lo[k][2], lo[k][3], hh[k][0], hh[k][1], hh[k][2], hh[k][3]}
              o[d0] = __builtin_amdgcn_mfma_f32_32x32x16_bf16(__builtin_bit_cast(bf16x8, pw0), PKV(0), o[d0], 0, 0, 0);
              o[d0] = __builtin_amdgcn_mfma_f32_32x32x16_bf16(__builtin_bit_cast(bf16x8, pw1), PKV(1), o[d0], 0, 0, 0);
              o[d0] = __builtin_amdgcn_mfma_f32_32x32x16_bf16(__builtin_bit_cast(bf16x8, pw2), PKV(2), o[d0], 0, 0, 0);
              o[d0] = __builtin_amdgcn_mfma_f32_32x32x16_bf16(__builtin_bit_cast(bf16x8, pw3), PKV(3), o[d0], 0, 0, 0);
#undef PKV
          } }
        asm volatile("s_waitcnt lgkmcnt(0)" ::: "memory");
        __builtin_amdgcn_s_barrier(); asm volatile("" ::: "memory");
    }
    l_run += __shfl_xor(l_run, 32);
    if (hi == 0) wsf[32 + r32] = l_run;
    asm volatile("s_waitcnt lgkmcnt(0)" ::: "memory");
    bf16_t* Ow = (bf16_t*)(F.ws + WS_R1) + (size_t)(b * SEQ + q0 + wid * 32) * 512 + h * 64;
    { LAS bf16_t* stg = (LAS bf16_t*)(shm + L_OST) + wid * 2048;
#pragma unroll
      for (int r = 0; r < 16; ++r) { const int orow = crow(r, hi); const float rl = __builtin_amdgcn_rcpf(wsf[32 + orow]);
#pragma unroll
          for (int d0 = 0; d0 < 2; ++d0) stg[orow * 64 + d0 * 32 + r32] = (bf16_t)f2bf(o[d0][r] * rl); }
      asm volatile("s_waitcnt lgkmcnt(0)" ::: "memory");
#pragma unroll
      for (int i = 0; i < 4; ++i) { const int row = i * 8 + (lane >> 3), chn = lane & 7; const u32x4 v = *(const LAS u32x4*)(stg + row * 64 + chn * 8); *(u32x4*)(Ow + (size_t)row * 512 + chn * 8) = v; } }
    asm volatile("s_waitcnt lgkmcnt(0)" ::: "memory");
#undef DMA_K
#undef DMA_V
#undef DMA_M
}

__device__ __forceinline__ void attn_phase(const Args& args, Frame& F) {
    const int v = F.vcu;
    for (int i = 0; i < 4; ++i) {
        for (int uu = v; uu < 256; uu += F.G) {
            const int bh = uu >> 2, s = uu & 3; const int qb = (i == 0) ? s : (i == 1) ? 7 - s : (i == 2) ? 8 + s : 15 - s;
            attn_unit(args, F, bh >> 3, bh & 7, qb);
        }
    }
}
}
#ifndef PROBE_NO_STATE
#define PROBE_NO_STATE 0
#endif
#ifndef PROBE_TINV_ID
#define PROBE_TINV_ID 0
#endif
namespace rk {
typedef __bf16 bf16x2_t __attribute__((ext_vector_type(2)));
__device__ __forceinline__ unsigned cvtpk(float lo, float hi) { f32x2 v = {lo, hi}; bf16x2_t b = __builtin_convertvector(v, bf16x2_t); return __builtin_bit_cast(unsigned, b); }
template <int S> __device__ __forceinline__ bf16x8 frag(const f32x16& x) {
    u32x4 o; o.x = cvtpk(x[8 * S + 0], x[8 * S + 1]); o.y = cvtpk(x[8 * S + 2], x[8 * S + 3]); o.z = cvtpk(x[8 * S + 4], x[8 * S + 5]); o.w = cvtpk(x[8 * S + 6], x[8 * S + 7]);
    return __builtin_bit_cast(bf16x8, o); }
template <int S> __device__ __forceinline__ void unfrag(f32x16& x, bf16x8 f) { const u32x4 o = __builtin_bit_cast(u32x4, f);
    x[8 * S + 0] = bf_lo(o.x); x[8 * S + 1] = bf_hi(o.x); x[8 * S + 2] = bf_lo(o.y); x[8 * S + 3] = bf_hi(o.y); x[8 * S + 4] = bf_lo(o.z); x[8 * S + 5] = bf_hi(o.z); x[8 * S + 6] = bf_lo(o.w); x[8 * S + 7] = bf_hi(o.w); }
#define RK_MF(a, b, c) __builtin_amdgcn_mfma_f32_32x32x16_bf16((a), (b), (c), 0, 0, 0)
__device__ __forceinline__ float dppf(float v, const int ctrl_is_const_dummy);
#define RK_DPP(v, ctrl, rmask, bc) __builtin_bit_cast(float, __builtin_amdgcn_update_dpp(0, __builtin_bit_cast(int, (v)), (ctrl), (rmask), 0xF, (bc)))
__device__ __forceinline__ float scan32(float v) {
#ifdef PROBE_SHFL_SCAN
    const int l32 = threadIdx.x & 31;
#pragma unroll
    for (int o = 1; o < 32; o <<= 1) { const float t = __shfl_up(v, o, 32); if (l32 >= o) v += t; }
    return v;
#endif
    v += RK_DPP(v, 0x111, 0xF, true); v += RK_DPP(v, 0x112, 0xF, true); v += RK_DPP(v, 0x114, 0xF, true); v += RK_DPP(v, 0x118, 0xF, true);
    v += RK_DPP(v, 0x142, 0xA, false);
    return v; }
__device__ __forceinline__ float ex2(float x) { return __builtin_amdgcn_exp2f(x); }
constexpr int PZ = 3600;
constexpr size_t SZ_G = 8192, SZ_H = 8192, SZ_Q = 4096, SZ_Y = 4096;
constexpr float L2E = 1.4426950408889634f;

__device__ __forceinline__ void mk_id(bf16x8 (&fId)[2], int r, int h) {
    asm volatile("" : "+v"(r), "+v"(h));
#pragma unroll
    for (int s = 0; s < 2; ++s) { unsigned short e8[8];
#pragma unroll
        for (int jj = 0; jj < 8; ++jj) e8[jj] = (16 * s + 8 * (jj >> 2) + 4 * h + (jj & 3) == r) ? (unsigned short)0x3F80 : (unsigned short)0;
        fId[s] = __builtin_bit_cast(bf16x8, (u32x4){(unsigned)e8[0] | ((unsigned)e8[1] << 16), (unsigned)e8[2] | ((unsigned)e8[3] << 16), (unsigned)e8[4] | ((unsigned)e8[5] << 16), (unsigned)e8[6] | ((unsigned)e8[7] << 16)}); }
}

__device__ __forceinline__ void load_params(const Args& args, Frame& F) {
    LAS float* pra = (LAS float*)(F.lds + LDS_PARA); LAS float* prb = (LAS float*)(F.lds + LDS_PARB);
    const float* mu = AIN(7); const float* w0 = AIN(8); const float* a0 = AIN(10); const float* kk = AIN(13); const float* ka = AIN(14); const float* rk = AIN(15);
    for (int i = F.tid; i < 4096; i += NTHR) { const int a = i >> 9, c = i & 511;
        const float v_ = a < 3 ? mu[a * 512 + c] : (a == 3 ? w0[c] : (a == 4 ? a0[c] : (a == 5 ? kk[c] : (a == 6 ? ka[c] : rk[c]))));
        if (a < 4) pra[c * 4 + a] = v_; else prb[c * 4 + a - 4] = v_; }
    __syncthreads();
}
struct ElemCtx { const LAS unsigned char* rowc; const LAS unsigned char* rowp; const bf16_t* DUt; const bf16_t* IUt; const LAS float* pra; const LAS float* prb; int hd, r, h; float inv; };
template <int MODE> __device__ __forceinline__ void r1_elem(const ElemCtx& C, int jt, bf16x8 (&o0)[2], bf16x8 (&o1)[2], bf16x8 (&o2)[2], bf16x8 (&o3)[2], float& bns, float& pcd) {
    const int r = C.r, h = C.h, hd = C.hd;
    f32x16 lw_ = f32x16{}, la_ = f32x16{};
#pragma unroll
    for (int ks = 0; ks < 4; ++ks) { const int k0 = 16 * ks + 8 * h;
        const bf16x8 bw = *(const LAS bf16x8*)(C.rowc + (1536 + k0) * 2), ba = *(const LAS bf16x8*)(C.rowc + (1600 + k0) * 2);
        const bf16x8 fa = *(const bf16x8*)(C.DUt + (size_t)(32 * jt + r) * 64 + k0), fi = *(const bf16x8*)(C.IUt + (size_t)(32 * jt + r) * 64 + k0);
        lw_ = RK_MF(fa, bw, lw_); la_ = RK_MF(fi, ba, la_); }
    float d = 0.f;
#pragma unroll
    for (int s = 0; s < 2; ++s) { float x0[8], x1[8], x2[8], x3[8];
#pragma unroll
        for (int g2 = 0; g2 < 2; ++g2) { const int g = 2 * s + g2, cj = hd * 64 + 32 * jt + 8 * g + 4 * h;
            float kc[4], kq[4], xc[4], xq[4];
            { const u32x2 a = *(const LAS u32x2*)(C.rowc + (512 + cj) * 2), p = *(const LAS u32x2*)(C.rowp + (512 + cj) * 2);
              kc[0] = bf_lo(a.x); kc[1] = bf_hi(a.x); kc[2] = bf_lo(a.y); kc[3] = bf_hi(a.y); kq[0] = bf_lo(p.x); kq[1] = bf_hi(p.x); kq[2] = bf_lo(p.y); kq[3] = bf_hi(p.y); }
            { const int xo = MODE ? 1024 : 0; const u32x2 a = *(const LAS u32x2*)(C.rowc + (xo + cj) * 2), p = *(const LAS u32x2*)(C.rowp + (xo + cj) * 2);
              xc[0] = bf_lo(a.x); xc[1] = bf_hi(a.x); xc[2] = bf_lo(a.y); xc[3] = bf_hi(a.y); xq[0] = bf_lo(p.x); xq[1] = bf_hi(p.x); xq[2] = bf_lo(p.y); xq[3] = bf_hi(p.y); }
            const LAS f32x4* ppa = (const LAS f32x4*)(C.pra + cj * 4); const LAS f32x4* ppb = (const LAS f32x4*)(C.prb + cj * 4);
#pragma unroll
            for (int q = 0; q < 4; ++q) { const int i = 4 * g + q, o = 4 * g2 + q;
                const f32x4 pa = ppa[q], pb = ppb[q];
                const float e_ = 0.6065306597126334f * fast_sigmoid(pa[3] + lw_[i]); const float L = scan32(e_);
                const float l0 = __builtin_bit_cast(float, __builtin_amdgcn_readlane(__builtin_bit_cast(int, L), 31)), l1 = __builtin_bit_cast(float, __builtin_amdgcn_readlane(__builtin_bit_cast(int, L), 63));
                const float Lend = h ? l1 : l0; if (i == 4 * (r >> 3) + (r & 3)) d = Lend;
                const float x_ = xc[q] + (MODE ? pa[2] : pa[0]) * (xq[q] - xc[q]), k_ = kc[q] + pa[1] * (kq[q] - kc[q]);
                const float ic = fast_sigmoid(pb[0] + la_[i]);
                const float kk = k_ * pb[1] * C.inv, kpn = k_ * (1.0f + (ic - 1.0f) * pb[2]), bv = kk * ic;
                if (MODE) { const float Qe = ex2(L2E * (L - Lend)); x0[o] = bv * Qe; x1[o] = kpn * Qe; x2[o] = x_; x3[o] = 0.f; }
                else { const float P = ex2(-L2E * L), Pi = ex2(L2E * L), Pm = ex2(-L2E * (L - e_)); bns += x_ * kpn * pb[3]; x0[o] = -kk * Pm; x1[o] = x_ * P; x2[o] = bv * Pi; x3[o] = kpn * Pi; } }
            asm volatile("" ::: "memory"); }
        o0[s] = __builtin_bit_cast(bf16x8, (u32x4){cvtpk(x0[0], x0[1]), cvtpk(x0[2], x0[3]), cvtpk(x0[4], x0[5]), cvtpk(x0[6], x0[7])});
        o1[s] = __builtin_bit_cast(bf16x8, (u32x4){cvtpk(x1[0], x1[1]), cvtpk(x1[2], x1[3]), cvtpk(x1[4], x1[5]), cvtpk(x1[6], x1[7])});
        o2[s] = __builtin_bit_cast(bf16x8, (u32x4){cvtpk(x2[0], x2[1]), cvtpk(x2[2], x2[3]), cvtpk(x2[4], x2[5]), cvtpk(x2[6], x2[7])});
        if (!MODE) o3[s] = __builtin_bit_cast(bf16x8, (u32x4){cvtpk(x3[0], x3[1]), cvtpk(x3[2], x3[3]), cvtpk(x3[4], x3[5]), cvtpk(x3[6], x3[7])}); }
    if (MODE) pcd = ex2(-L2E * d);
}


__device__ __forceinline__ void r1_unit(const Args& args, Frame& F, int b, int c) {
    LAS unsigned char* IMG = F.lds;
    const bf16_t* Z = (const bf16_t*)(F.ws + WS_Z);
    const int t0 = 32 * c; const size_t m0 = (size_t)b * SEQ + t0;
    const float* mu = AIN(7);
    int tid = F.tid; asm volatile("" : "+v"(tid));
    __syncthreads();
    for (int p = tid; p < 33 * 224; p += NTHR) { const int rr = p / 224, pc = p - rr * 224; u32x4 v = {0u, 0u, 0u, 0u};
        if (rr > 0 || t0 > 0) v = *(const u32x4*)(Z + (m0 + rr - 1) * ZW + ZR + 8 * pc);
        *(LAS u32x4*)(IMG + rr * PZ + 16 * pc) = v; }
    __syncthreads();
    { u32x4 actv[2];
#pragma unroll
      for (int i = 0; i < 2; ++i) { const int q = tid + NTHR * i, t = q >> 5, kp = q & 31;
          const u32x4 cw = *(const LAS u32x4*)(IMG + (t + 1) * PZ + (1536 + 8 * kp) * 2), pw = *(const LAS u32x4*)(IMG + t * PZ + (1536 + 8 * kp) * 2);
          const f32x4 m0v = *(const f32x4*)(mu + 1536 + 8 * kp), m1v = *(const f32x4*)(mu + 1536 + 8 * kp + 4);
          const unsigned cwa[4] = {cw.x, cw.y, cw.z, cw.w}, pwa[4] = {pw.x, pw.y, pw.z, pw.w}; float x[8];
#pragma unroll
          for (int j = 0; j < 4; ++j) { const float c0 = bf_lo(cwa[j]), c1 = bf_hi(cwa[j]), p0 = bf_lo(pwa[j]), p1 = bf_hi(pwa[j]);
              const float mu0 = j < 2 ? m0v[2 * j] : m1v[2 * j - 4], mu1 = j < 2 ? m0v[2 * j + 1] : m1v[2 * j - 3];
              x[2 * j] = c0 + mu0 * (p0 - c0); x[2 * j + 1] = c1 + mu1 * (p1 - c1); }
#pragma unroll
          for (int j = 0; j < 8; ++j) { if (kp < 8) { const float e2 = ex2(2.885390081777927f * x[j]); x[j] = 1.0f - 2.0f * __builtin_amdgcn_rcpf(e2 + 1.0f); } else if (kp >= 16) x[j] = fast_sigmoid(x[j]); }
          actv[i] = (u32x4){cvtpk(x[0], x[1]), cvtpk(x[2], x[3]), cvtpk(x[4], x[5]), cvtpk(x[6], x[7])}; }
      __syncthreads();
#pragma unroll
      for (int i = 0; i < 2; ++i) { const int q = tid + NTHR * i, t = q >> 5, kp = q & 31; *(LAS u32x4*)(IMG + (t + 1) * PZ + (1536 + 8 * kp) * 2) = actv[i]; }
      __syncthreads(); }
    const int hd = F.wave; int r = tid & 31, h = (tid >> 5) & 1;
    const LAS unsigned char* rowc = IMG + (r + 1) * PZ; const LAS unsigned char* rowp = IMG + r * PZ;
    const bf16_t* DUt = (const bf16_t*)(F.ws + WS_DUT) + (size_t)hd * 4096; const bf16_t* IUt = (const bf16_t*)(F.ws + WS_IUT) + (size_t)hd * 4096;
    const LAS float* pra = (const LAS float*)(F.lds + LDS_PARA); const LAS float* prb = (const LAS float*)(F.lds + LDS_PARB);
    float n2 = 0.f;
#pragma unroll
    for (int jt = 0; jt < 2; ++jt)
#pragma unroll
        for (int g = 0; g < 4; ++g) { const int cj = hd * 64 + 32 * jt + 8 * g + 4 * h;
            const u32x2 a = *(const LAS u32x2*)(rowc + (512 + cj) * 2), p = *(const LAS u32x2*)(rowp + (512 + cj) * 2);
            const float kc[4] = {bf_lo(a.x), bf_hi(a.x), bf_lo(a.y), bf_hi(a.y)}, kq[4] = {bf_lo(p.x), bf_hi(p.x), bf_lo(p.y), bf_hi(p.y)};
            #pragma unroll
            for (int q = 0; q < 4; ++q) { const float muk = pra[(cj + q) * 4 + 1], kkp = prb[(cj + q) * 4 + 1]; const float k_ = kc[q] + muk * (kq[q] - kc[q]); const float kk_ = k_ * kkp; n2 += kk_ * kk_; } }
    n2 += __shfl_xor(n2, 32);
    const float inv = 1.0f / __builtin_fmaxf(sqrtf(n2), 1e-12f);
    float pcd[2] = {0.f, 0.f};
    float bns = 0.f;
    const ElemCtx EC{rowc, rowp, DUt, IUt, pra, prb, hd, r, h, inv};
    f32x16 Aab = f32x16{}, Aak = f32x16{}, Arb = f32x16{}, Ark = f32x16{};
    bf16x8 fRt[2][2], tAt[2][2];
    { bf16x8 fId[2]; mk_id(fId, r, h);
#pragma unroll
    for (int jt = 0; jt < 2; ++jt) { bf16x8 fA[2], fB[2], fK[2]; float pd_ = 0.f;
        r1_elem<0>(EC, jt, fA, fRt[jt], fB, fK, bns, pd_);
        const bf16x8 fA0 = fA[0], fA1 = fA[1], fB0 = fB[0], fB1 = fB[1], fK0 = fK[0], fK1 = fK[1];
        Aab = RK_MF(fB0, fA0, Aab); Aab = RK_MF(fB1, fA1, Aab); Aak = RK_MF(fK0, fA0, Aak); Aak = RK_MF(fK1, fA1, Aak);
        Arb = RK_MF(fB0, fRt[jt][0], Arb); Arb = RK_MF(fB1, fRt[jt][1], Arb); Ark = RK_MF(fK0, fRt[jt][0], Ark); Ark = RK_MF(fK1, fRt[jt][1], Ark);
        { f32x16 t_ = f32x16{}; t_ = RK_MF(fA0, fId[0], t_); t_ = RK_MF(fA1, fId[1], t_); tAt[jt][0] = frag<0>(t_); tAt[jt][1] = frag<1>(t_); } } }
    bns += __shfl_xor(bns, 32);
    if (h == 0) ((float*)(F.ws + WS_TOPW))[(m0 + r) * 8 + hd] = bns;
    LAS unsigned char* stash = IMG + (1 + ((tid & 63) >> 3)) * PZ + hd * 128 + (tid & 7) * 16;
#pragma unroll
    for (int p = 0; p < 4; ++p) *(LAS u32x4*)(stash + 8 * p * PZ) = __builtin_bit_cast(u32x4, fRt[p >> 1][p & 1]);
#pragma unroll
    for (int i = 0; i < 16; ++i) { const int s = 8 * (i >> 2) + 4 * h + (i & 3);
        if (!(s < r)) { Aab[i] = 0.f; Aak[i] = 0.f; } if (!(s <= r)) { Arb[i] = 0.f; Ark[i] = 0.f; } }
    const bf16x8 fAak[2] = {frag<0>(Aak), frag<1>(Aak)}, fArb[2] = {frag<0>(Arb), frag<1>(Arb)}, fArk[2] = {frag<0>(Ark), frag<1>(Ark)};
    bf16x8 fT[2];
    asm volatile("" ::: "memory"); __builtin_amdgcn_sched_barrier(0);
    { float T[32];
#pragma unroll
      for (int s = 31; s >= 0; --s) { float acc = (r == s) ? 1.0f : 0.f; const int is = 4 * (s >> 3) + (s & 3), hs = (s >> 2) & 1;
          const float acol_ = Aab[is]; const int acol_i = __float_as_int(acol_);
#pragma unroll
          for (int u = s + 1; u < (PROBE_TINV_ID ? 0 : 32); ++u) { int sv_; asm volatile("v_readlane_b32 %0, %1, %2" : "=s"(sv_) : "v"(acol_i), "n"(u + 32 * hs)); acc = __builtin_fmaf(T[u], __int_as_float(sv_), acc); }
          T[s] = acc; __builtin_amdgcn_sched_barrier(0); }
#pragma unroll
      for (int s = 0; s < 2; ++s) { float e8[8];
#pragma unroll
          for (int jj = 0; jj < 8; ++jj) { const int i0 = 16 * s + 8 * (jj >> 2) + (jj & 3); float ta = T[i0], tb = T[i0 + 4]; asm volatile("" : "+v"(ta), "+v"(tb)); e8[jj] = h ? tb : ta; }
          fT[s] = __builtin_bit_cast(bf16x8, (u32x4){cvtpk(e8[0], e8[1]), cvtpk(e8[2], e8[3]), cvtpk(e8[4], e8[5]), cvtpk(e8[6], e8[7])}); } }
    asm volatile("" ::: "memory"); __builtin_amdgcn_sched_barrier(0);
    const size_t uid = ((size_t)(b * 8 + hd) * 128 + c);
    unsigned char* gG = F.ws + WS_R0 + uid * SZ_G; unsigned char* gH = F.ws + WS_R2 + uid * SZ_H; unsigned char* gQ = F.ws + WS_H0 + uid * SZ_Q; unsigned char* gY = F.ws + WS_H1 + uid * SZ_Y;
#define RK_ST(base, piece, f) (*(u32x4*)((base) + (piece) * 1024 + (tid & 63) * 16) = __builtin_bit_cast(u32x4, (f)))
    bf16x8 fWt[2][2];
#pragma unroll
    for (int jt = 0; jt < 2; ++jt) { f32x16 w_ = f32x16{}; w_ = RK_MF(fT[0], tAt[jt][0], w_); w_ = RK_MF(fT[1], tAt[jt][1], w_); fWt[jt][0] = frag<0>(w_); fWt[jt][1] = frag<1>(w_);
        f32x16 q_; unfrag<0>(q_, __builtin_bit_cast(bf16x8, *(const LAS u32x4*)(stash + 8 * (2 * jt) * PZ))); unfrag<1>(q_, __builtin_bit_cast(bf16x8, *(const LAS u32x4*)(stash + 8 * (2 * jt + 1) * PZ)));
        q_ = RK_MF(fWt[jt][0], fArb[0], q_); q_ = RK_MF(fWt[jt][1], fArb[1], q_); RK_ST(gQ, 2 * jt, frag<0>(q_)); RK_ST(gQ, 2 * jt + 1, frag<1>(q_)); }
    bf16x8 tBh[2][2], tKh[2][2], tV[2][2];
    { bf16x8 fId[2]; mk_id(fId, r, h);
#pragma unroll
    for (int jt = 0; jt < 2; ++jt) { bf16x8 fBh[2], fKh[2], fV[2], fdum[2]; float bdum = 0.f;
        r1_elem<1>(EC, jt, fBh, fKh, fV, fdum, bdum, pcd[jt]);
        { f32x16 t_ = f32x16{}; t_ = RK_MF(fBh[0], fId[0], t_); t_ = RK_MF(fBh[1], fId[1], t_); tBh[jt][0] = frag<0>(t_); tBh[jt][1] = frag<1>(t_); }
        { f32x16 t_ = f32x16{}; t_ = RK_MF(fKh[0], fId[0], t_); t_ = RK_MF(fKh[1], fId[1], t_); tKh[jt][0] = frag<0>(t_); tKh[jt][1] = frag<1>(t_); }
        { f32x16 t_ = f32x16{}; t_ = RK_MF(fV[0], fId[0], t_); t_ = RK_MF(fV[1], fId[1], t_); tV[jt][0] = frag<0>(t_); tV[jt][1] = frag<1>(t_); } } }
    bf16x8 fUt[2][2];
#pragma unroll
    for (int it = 0; it < 2; ++it) { f32x16 av = f32x16{}; av = RK_MF(fAak[0], tV[it][0], av); av = RK_MF(fAak[1], tV[it][1], av);
        const bf16x8 fav0 = frag<0>(av), fav1 = frag<1>(av); f32x16 u_ = f32x16{}; u_ = RK_MF(fT[0], fav0, u_); u_ = RK_MF(fT[1], fav1, u_); fUt[it][0] = frag<0>(u_); fUt[it][1] = frag<1>(u_); }
#pragma unroll
    for (int it = 0; it < 2; ++it) { f32x16 y_ = f32x16{}; y_ = RK_MF(fUt[it][0], fArb[0], y_); y_ = RK_MF(fUt[it][1], fArb[1], y_); y_ = RK_MF(tV[it][0], fArk[0], y_); y_ = RK_MF(tV[it][1], fArk[1], y_);
        RK_ST(gY, 2 * it, frag<0>(y_)); RK_ST(gY, 2 * it + 1, frag<1>(y_)); }
#pragma unroll
    for (int jt = 0; jt < 2; ++jt)
#pragma unroll
        for (int j2 = 0; j2 < 2; ++j2) { f32x16 g_ = f32x16{}; g_ = RK_MF(fWt[jt][0], tBh[j2][0], g_); g_ = RK_MF(fWt[jt][1], tBh[j2][1], g_);
            if (jt == j2) {
#pragma unroll
                for (int i = 0; i < 16; ++i) if (i == 4 * (r >> 3) + (r & 3) && h == ((r >> 2) & 1)) g_[i] += pcd[jt]; }
            RK_ST(gG, 2 * (jt * 2 + j2), frag<0>(g_)); RK_ST(gG, 2 * (jt * 2 + j2) + 1, frag<1>(g_)); }
#pragma unroll
    for (int j2 = 0; j2 < 2; ++j2)
#pragma unroll
        for (int it = 0; it < 2; ++it) { f32x16 h_ = f32x16{}; h_ = RK_MF(tBh[j2][0], fUt[it][0], h_); h_ = RK_MF(tBh[j2][1], fUt[it][1], h_); h_ = RK_MF(tKh[j2][0], tV[it][0], h_); h_ = RK_MF(tKh[j2][1], tV[it][1], h_);
            RK_ST(gH, 2 * (j2 * 2 + it), frag<0>(h_)); RK_ST(gH, 2 * (j2 * 2 + it) + 1, frag<1>(h_)); }
}

template <int DRY> __device__ __forceinline__ void r2_task(const Args& args, Frame& F, int task) {
    const bool st_ok = !DRY || args.li == 12345;
    const int bh = task >> 1, it = task & 1;
    f32x16 St[2]; St[0] = f32x16{}; St[1] = f32x16{};
    const unsigned char* gG0 = F.ws + WS_R0 + (size_t)bh * 128 * SZ_G + F.lane * 16; unsigned char* gH0 = F.ws + WS_R2 + (size_t)bh * 128 * SZ_H + F.lane * 16;
    bf16x8 G0[2][2][2], H0[2][2], G1[2][2][2], H1[2][2], G2[2][2][2], H2[2][2];
#define R2_LOAD(G_, H_, c_) do { const int cc_ = (c_) < 128 ? (c_) : 127;     \
        _Pragma("unroll") for (int jt = 0; jt < 2; ++jt) _Pragma("unroll") for (int j2 = 0; j2 < 2; ++j2) _Pragma("unroll") for (int s = 0; s < 2; ++s) \
            G_[jt][j2][s] = __builtin_bit_cast(bf16x8, *(const u32x4*)(gG0 + (size_t)cc_ * SZ_G + (2 * (jt * 2 + j2) + s) * 1024)); \
        _Pragma("unroll") for (int j2 = 0; j2 < 2; ++j2) _Pragma("unroll") for (int s = 0; s < 2; ++s) H_[j2][s] = __builtin_bit_cast(bf16x8, *(const u32x4*)(gH0 + (size_t)cc_ * SZ_H + (2 * (j2 * 2 + it) + s) * 1024)); } while (0)
#define R2_STEP(G_, H_, c_, LOADNEXT) do { \
        const bf16x8 fS[2][2] = {{frag<0>(St[0]), frag<1>(St[0])}, {frag<0>(St[1]), frag<1>(St[1])}}; \
        if (st_ok) { _Pragma("unroll") for (int jt = 0; jt < 2; ++jt) _Pragma("unroll") for (int s = 0; s < 2; ++s) \
            *(u32x4*)(gH0 + (size_t)(c_) * SZ_H + (2 * (jt * 2 + it) + s) * 1024) = __builtin_bit_cast(u32x4, fS[jt][s]); }     \
        __builtin_amdgcn_sched_barrier(0); LOADNEXT; __builtin_amdgcn_sched_barrier(0);     \
        _Pragma("unroll") for (int j2 = 0; j2 < 2; ++j2) { unfrag<0>(St[j2], H_[j2][0]); unfrag<1>(St[j2], H_[j2][1]); \
            _Pragma("unroll") for (int jt = 0; jt < 2; ++jt) { St[j2] = RK_MF(G_[jt][j2][0], fS[jt][0], St[j2]); St[j2] = RK_MF(G_[jt][j2][1], fS[jt][1], St[j2]); } } \
        __builtin_amdgcn_sched_barrier(0); \
    } while (0)
    R2_LOAD(G0, H0, 0); R2_LOAD(G1, H1, 1);
#pragma unroll 1
    for (int c = 0; c < 126; c += 3) {
        R2_STEP(G0, H0, c, R2_LOAD(G2, H2, c + 2));
        R2_STEP(G1, H1, c + 1, R2_LOAD(G0, H0, c + 3));
        R2_STEP(G2, H2, c + 2, R2_LOAD(G1, H1, c + 4));
    }
    R2_STEP(G0, H0, 126, (void)0);
    R2_STEP(G1, H1, 127, (void)0);
#undef R2_STEP
#undef R2_LOAD
}

constexpr int PV2 = 1296;
__device__ __forceinline__ void r3_unit(const Args& args, Frame& F, int b, int c) {
    LAS unsigned char* IMG = F.lds;
    const bf16_t* Z = (const bf16_t*)(F.ws + WS_Z);
    const int t0 = 32 * c; const size_t m0 = (size_t)b * SEQ + t0;
    const float* mu = AIN(7);
    int tid = F.tid; asm volatile("" : "+v"(tid));
    __syncthreads();
    for (int p = tid; p < 33 * 80; p += NTHR) { const int rr = p / 80, pc = p - rr * 80; u32x4 v = {0u, 0u, 0u, 0u};
        const int col = pc < 64 ? ZR_V + 8 * pc : ZR_GD + 8 * (pc - 64);
        if (rr > 0 || t0 > 0) v = *(const u32x4*)(Z + (m0 + rr - 1) * ZW + col);
        *(LAS u32x4*)(IMG + rr * PV2 + 16 * pc) = v; }
    __syncthreads();
    { const int t = tid >> 4, kp = tid & 15;
      const u32x4 cw = *(const LAS u32x4*)(IMG + (t + 1) * PV2 + 1024 + 16 * kp), pw = *(const LAS u32x4*)(IMG + t * PV2 + 1024 + 16 * kp);
      const f32x4 m0v = *(const f32x4*)(mu + 1664 + 8 * kp), m1v = *(const f32x4*)(mu + 1664 + 8 * kp + 4);
      const unsigned cwa[4] = {cw.x, cw.y, cw.z, cw.w}, pwa[4] = {pw.x, pw.y, pw.z, pw.w}; float x[8];
#pragma unroll
      for (int j = 0; j < 4; ++j) { const float c0 = bf_lo(cwa[j]), c1 = bf_hi(cwa[j]), p0 = bf_lo(pwa[j]), p1 = bf_hi(pwa[j]);
          const float mu0 = j < 2 ? m0v[2 * j] : m1v[2 * j - 4], mu1 = j < 2 ? m0v[2 * j + 1] : m1v[2 * j - 3];
          x[2 * j] = fast_sigmoid(c0 + mu0 * (p0 - c0)); x[2 * j + 1] = fast_sigmoid(c1 + mu1 * (p1 - c1)); }
      const u32x4 o = {cvtpk(x[0], x[1]), cvtpk(x[2], x[3]), cvtpk(x[4], x[5]), cvtpk(x[6], x[7])};
      __syncthreads();
      *(LAS u32x4*)(IMG + (t + 1) * PV2 + 1024 + 16 * kp) = o;
      __syncthreads(); }
    const int hd = F.wave; int r = tid & 31, h = (tid >> 5) & 1;
    const LAS unsigned char* rowc = IMG + (r + 1) * PV2; const LAS unsigned char* rowp = IMG + r * PV2;
    const size_t uid = ((size_t)(b * 8 + hd) * 128 + c);
    const unsigned char* gS = F.ws + WS_R2 + uid * SZ_H; const unsigned char* gQ = F.ws + WS_H0 + uid * SZ_Q; const unsigned char* gY = F.ws + WS_H1 + uid * SZ_Y;
#define RK_LD(base, piece) __builtin_bit_cast(bf16x8, *(const u32x4*)((base) + (piece) * 1024 + (tid & 63) * 16))
    f32x16 gl[2]; gl[0] = f32x16{}; gl[1] = f32x16{};
    { const bf16_t* GUt = (const bf16_t*)(F.ws + WS_GUT) + (size_t)hd * 64 * 128;
#pragma unroll
      for (int ks = 0; ks < 8; ++ks) { const int k0 = 16 * ks + 8 * h; const bf16x8 bg = *(const LAS bf16x8*)(rowc + 1024 + k0 * 2);
#pragma unroll
          for (int it = 0; it < 2; ++it) { const bf16x8 fg = *(const bf16x8*)(GUt + (size_t)(32 * it + r) * 128 + k0); gl[it] = RK_MF(fg, bg, gl[it]); } } }
    f32x16 Y[2];
    { const bf16x8 fQ[2][2] = {{RK_LD(gQ, 0), RK_LD(gQ, 1)}, {RK_LD(gQ, 2), RK_LD(gQ, 3)}};
#pragma unroll
      for (int it = 0; it < 2; ++it) { unfrag<0>(Y[it], RK_LD(gY, 2 * it)); unfrag<1>(Y[it], RK_LD(gY, 2 * it + 1));
#pragma unroll
          for (int jt = 0; jt < 2; ++jt) { if (PROBE_NO_STATE) continue; Y[it] = RK_MF(RK_LD(gS, 2 * (jt * 2 + it)), fQ[jt][0], Y[it]); Y[it] = RK_MF(RK_LD(gS, 2 * (jt * 2 + it) + 1), fQ[jt][1], Y[it]); } } }
    float s1 = 0.f;
#pragma unroll
    for (int it = 0; it < 2; ++it)
#pragma unroll
        for (int i = 0; i < 16; ++i) s1 += Y[it][i];
    s1 += __shfl_xor(s1, 32); const float mean = s1 * (1.0f / 64.0f); float s2 = 0.f;
#pragma unroll
    for (int it = 0; it < 2; ++it)
#pragma unroll
        for (int i = 0; i < 16; ++i) { const float d = Y[it][i] - mean; s2 += d * d; }
    s2 += __shfl_xor(s2, 32); const float rstd = 1.0f / sqrtf(s2 * (1.0f / 64.0f) + GN_EPS);
    const float bn = ((const float*)(F.ws + WS_TOPW))[(m0 + r) * 8 + hd];
    LAS unsigned char* stg = F.lds + 49152 + F.wave * 4608;
#pragma unroll
    for (int it = 0; it < 2; ++it)
#pragma unroll
        for (int g = 0; g < 4; ++g) { const int cl = 32 * it + 8 * g + 4 * h, cj = hd * 64 + cl;
            const u32x2 a = *(const LAS u32x2*)(rowc + cj * 2), p = *(const LAS u32x2*)(rowp + cj * 2);
            const float vc[4] = {bf_lo(a.x), bf_hi(a.x), bf_lo(a.y), bf_hi(a.y)}, vq[4] = {bf_lo(p.x), bf_hi(p.x), bf_lo(p.y), bf_hi(p.y)};
            const f32x4 muv = *(const f32x4*)(mu + 1024 + cj), lg = *(const f32x4*)(AIN(16) + cj), lb = *(const f32x4*)(AIN(17) + cj);
            float o[4];
#pragma unroll
            for (int q = 0; q < 4; ++q) { const int i = 4 * g + q; const float v_ = vc[q] + muv[q] * (vq[q] - vc[q]);
                o[q] = ((Y[it][i] - mean) * rstd * lg[q] + lb[q] + bn * v_) * gl[it][i]; }
            *(LAS u32x2*)(stg + r * 144 + cl * 2) = (u32x2){cvtpk(o[0], o[1]), cvtpk(o[2], o[3])}; }
    asm volatile("s_waitcnt lgkmcnt(0)" ::: "memory");
    bf16_t* OUT = (bf16_t*)(F.ws + WS_R0) + m0 * 512 + hd * 64;
#pragma unroll
    for (int i = 0; i < 4; ++i) { const int row = i * 8 + ((tid & 63) >> 3), chn = tid & 7; const u32x4 v = *(const LAS u32x4*)(stg + row * 144 + chn * 16); *(u32x4*)(OUT + (size_t)row * 512 + chn * 8) = v; }
#undef RK_LD
#undef RK_ST
}
}
__device__ __forceinline__ void route_phase(const Args& args, Frame& F) {
    LAS unsigned* lcnt = (LAS unsigned*)(F.lds);
    if (F.tid < 128) lcnt[F.tid] = 0u;
    __syncthreads();
    const float* LG = (const float*)(F.ws + WS_LOGIT); int* TE = (int*)(F.ws + WS_TOPE); float* TW = (float*)(F.ws + WS_TOPW);
    const int lane = F.lane; const float bias = AIN(23)[lane];
    for (int tok = F.gw; tok < M; tok += F.NGW) {
        const float lg = LG[(size_t)tok * 64 + lane];
        const float s = 1.0f / (1.0f + expf(-lg));
        const float c = s + bias;
        const unsigned long long kc = ((unsigned long long)ord_key(c) << 6) | (unsigned)(63 - lane);
        int rk = 0;
#pragma unroll 1
        for (int d = 1; d < 8; ++d) { const unsigned long long o = __shfl_xor(kc, d); rk += (o > kc) ? 1 : 0; }
        float gs = rk < 2 ? c : 0.f;
        gs += __shfl_xor(gs, 1); gs += __shfl_xor(gs, 2); gs += __shfl_xor(gs, 4);
        const int grp = lane >> 3;
        const unsigned long long kg = ((unsigned long long)ord_key(gs) << 6) | (unsigned)(63 - grp);
        int grk = 0;
#pragma unroll 1
        for (int d = 1; d < 8; ++d) { const unsigned long long o = __shfl_xor(kg, 8 * d); grk += (o > kg) ? 1 : 0; }
        const unsigned long long km = grk < 4 ? kc : (unsigned long long)(63 - lane);
        int erk = 0;
#pragma unroll 1
        for (int d = 1; d < 64; ++d) { const unsigned long long o = __shfl_xor(km, d); erk += (o > km) ? 1 : 0; }
        const bool sel = erk < 8;
        const float ssum = wave_sum(sel ? s : 0.f);
        if (sel) { TE[(size_t)tok * 8 + erk] = lane; TW[(size_t)tok * 8 + erk] = s / ssum * 2.5f; atomicAdd((unsigned*)&lcnt[(tok >= M / 2 ? 64 : 0) + lane], 1u); }
    }
    __syncthreads();
    if (F.tid < 128 && lcnt[F.tid]) atomicAdd(F.ctl + CW_CNT + F.tid, lcnt[F.tid]);
    __syncthreads();
}

struct MoeTab { int ntiles0, ntiles; };
__device__ __forceinline__ MoeTab build_tiles(const Args& args, Frame& F) {
    LAS unsigned* tab = (LAS unsigned*)(F.lds + LDS_TILETAB);
    LAS unsigned* offs = tab + 2432; LAS unsigned* tpre = tab + 2560;
    if (F.tid == 0) { unsigned o = 0, tp = 0;
        for (int l = 0; l < 128; ++l) { const unsigned c = __hip_atomic_load(F.ctl + CW_CNT + l, RLX_AGENT); offs[l] = o; tpre[l] = tp; o += c; tp += (c + 255u) >> 8; }
        tpre[128] = tp; }
    __syncthreads();
    if (F.tid < 128) { const int l = F.tid; const unsigned c = __hip_atomic_load(F.ctl + CW_CNT + l, RLX_AGENT); const unsigned o = offs[l], t0 = tpre[l], nt = (c + 255u) >> 8;
        for (unsigned i = 0; i < nt; ++i) { const unsigned rows = (c - 256u * i) < 256u ? (c - 256u * i) : 256u; tab[2 * (t0 + i)] = (o + 256u * i) | ((unsigned)(l & 63) << 20); tab[2 * (t0 + i) + 1] = rows; } }
    __syncthreads();
    MoeTab r; r.ntiles0 = (int)tpre[64]; r.ntiles = (int)tpre[128]; return r;
}
__device__ __forceinline__ void scatter_phase(const Args& args, Frame& F) {
    LAS unsigned* tab = (LAS unsigned*)(F.lds + LDS_TILETAB); LAS unsigned* offs = tab + 2432;
    LAS unsigned* lcnt = (LAS unsigned*)(F.lds); LAS unsigned* lbase = lcnt + 128;
    const int* TE = (const int*)(F.ws + WS_TOPE); const float* TW = (const float*)(F.ws + WS_TOPW);
    int* ST = (int*)(F.ws + WS_STOK); float* SW = (float*)(F.ws + WS_SW);
    for (int blk = blockIdx.x; blk < M / 128; blk += F.G) {
        if (F.tid < 128) lcnt[F.tid] = 0u;
        __syncthreads();
        const int tok0 = blk * 128, hf = tok0 >= M / 2 ? 64 : 0;
        int lst[2]; unsigned rnk[2];
#pragma unroll
        for (int i = 0; i < 2; ++i) { const int p = F.tid + 512 * i; lst[i] = hf + TE[(size_t)tok0 * 8 + p]; rnk[i] = atomicAdd((unsigned*)&lcnt[lst[i]], 1u); }
        __syncthreads();
        if (F.tid < 128) lbase[F.tid] = lcnt[F.tid] ? atomicAdd(F.ctl + CW_CUR + F.tid, lcnt[F.tid]) : 0u;
        __syncthreads();
#pragma unroll
        for (int i = 0; i < 2; ++i) { const int p = F.tid + 512 * i; const unsigned pos = offs[lst[i]] + lbase[lst[i]] + rnk[i];
            ST[pos] = tok0 * 8 + p; SW[pos] = TW[(size_t)tok0 * 8 + p]; }
        __syncthreads();
    }
}

__device__ __forceinline__ void final_rows(const Args& args, Frame& F, int row_lo, int row_hi, int tokbase) {
    const unsigned char* SL = (const unsigned char*)(F.ws + WS_SLOT);
    const int cA = 256 * (F.lane >> 4) + 32 * ((F.lane >> 2) & 3) + 8 * (F.lane & 3), cB = cA + 128;
    for (int blk = F.gw; blk < (row_hi - row_lo) / 16; blk += F.NGW) {
        const int r0 = row_lo + blk * 16, b = r0 / SEQ;
        const float* g2 = (const float*)(F.ws + WS_MOD) + b * 6144 + 5120; const float* fgp = AIN(30);
        f32x4 gv[4], fg[4];
#pragma unroll
        for (int j = 0; j < 4; ++j) { const int c = (j < 2 ? cA : cB) + 4 * (j & 1); gv[j] = *(const f32x4*)(g2 + c) * (1.0f / SLOT_SCALE); fg[j] = *(const f32x4*)(fgp + c); }
        for (int r = 0; r < 16; ++r) { const size_t m = (size_t)(r0 + r);
            f32x4 acc[4];
#pragma unroll
            for (int j = 0; j < 4; ++j) acc[j] = (f32x4){0.f, 0.f, 0.f, 0.f};
            const unsigned char* sp = SL + (m - tokbase) * NSLOT * D + 16 * F.lane;
            u32x4 w[NSLOT];
#pragma unroll
            for (int k = 0; k < NSLOT; ++k) w[k] = *(const u32x4*)(sp + (size_t)k * D);
#pragma unroll
            for (int k = 0; k < NSLOT; ++k) { const unsigned ww[4] = {w[k].x, w[k].y, w[k].z, w[k].w};
#pragma unroll
                for (int j = 0; j < 4; ++j) { const f32x2 a = __builtin_amdgcn_cvt_pk_f32_fp8((int)ww[j], false), c = __builtin_amdgcn_cvt_pk_f32_fp8((int)ww[j], true); acc[j] += (f32x4){a.x, a.y, c.x, c.y}; } }
            float* xr = F.out + m * D; f32x4 v[4]; float s = 0.f;
#pragma unroll
            for (int j = 0; j < 4; ++j) { const int c = (j < 2 ? cA : cB) + 4 * (j & 1); v[j] = *(const f32x4*)(xr + c) + gv[j] * acc[j]; s += (v[j].x * v[j].x + v[j].y * v[j].y) + (v[j].z * v[j].z + v[j].w * v[j].w); }
            const float rstd = 1.0f / sqrtf(wave_sum(s) * (1.0f / D) + RMS_EPS);
#pragma unroll
            for (int j = 0; j < 4; ++j) { const int c = (j < 2 ? cA : cB) + 4 * (j & 1); *(f32x4*)(xr + c) = v[j] * rstd * fg[j]; }
        }
    }
}
constexpr int N_PHASES = 15;
#ifndef PROBE_ATT_SCALE
#define PROBE_ATT_SCALE 1.0f
#endif
#ifndef PROBE_IDX_REP
#define PROBE_IDX_REP 1
#endif
#ifndef R2_WGS
#define R2_WGS 32
#endif
#ifndef PROBE_RW_SCALE
#define PROBE_RW_SCALE 1.0f
#endif

__global__ void __launch_bounds__(NTHR, 2) fwd_kernel(Args args) {
    extern __shared__ __attribute__((aligned(16))) unsigned char lds_raw[];
    Frame F;
    F.lds = (LAS unsigned char*)lds_raw;
    F.MISC = (volatile LAS unsigned*)(F.lds + MISC_OFF);
    F.tid = threadIdx.x; F.lane = F.tid & 63; F.wave = __builtin_amdgcn_readfirstlane(F.tid >> 6);
    F.G = gridDim.x; { const int bx = blockIdx.x; F.vcu = (F.G % 8 == 0) ? (bx % 8) * (F.G / 8) + bx / 8 : bx; }
    F.gw = blockIdx.x * NWAVES + F.wave; F.NGW = F.G * NWAVES;
    F.ws = args.ws; F.out = args.out; F.ctl = (unsigned*)(args.ws + WS_CTL);
    for (int u = F.tid; u < (LDS_BYTES - LDSCTL_OFF) / 4; u += NTHR) ((LAS unsigned*)(F.lds + LDSCTL_OFF))[u] = 0u;
    __syncthreads();
    if (F.tid == 0) {
#pragma unroll
        for (int i = 0; i < 31; ++i) *(LAS unsigned long long*)(F.lds + LDS_PTAB + 8 * i) = (unsigned long long)args.in[i];
        *(LAS unsigned long long*)(F.lds + LDS_PTAB + 8 * 31) = (unsigned long long)args.out; *(LAS unsigned long long*)(F.lds + LDS_PTAB + 8 * 32) = (unsigned long long)args.ws; }
    __syncthreads();
    XcdBarrier bar = xcd_barrier_post(F.ctl + CW_BAR + args.li * XCD_BAR_WORDS, F.MISC + 8);
    const int lo = args.ph_lo, hi = args.ph_hi;
#ifndef PHASE_MASK
#define PHASE_MASK 0xFFFFFFFFu
#endif
#define IN(k) ((((PHASE_MASK) >> (k)) & 1u) && lo <= (k) && (k) < hi)
#define PB() do { F.ws = (unsigned char*)ain_ptr(F.lds, 32); F.out = (float*)ain_ptr(F.lds, 31); F.ctl = (unsigned*)(F.ws + WS_CTL); \
        F.lane = (int)__builtin_amdgcn_mbcnt_hi(~0u, __builtin_amdgcn_mbcnt_lo(~0u, 0u)); F.tid = F.wave * 64 + F.lane; } while (0)
#define ZB ((bf16_t*)(F.ws + WS_Z))
#define GATES ((bf16_t*)F.out)
#define MOD ((const float*)(F.ws + WS_MOD))
#define SEAM(k) do { if (IN(k) && IN((k) + 1)) xcd_barrier(bar); } while (0)

    if (IN(0)) { PB(); p0_prologue(args, F); } SEAM(0);
    if (IN(1)) { PB(); norm_mod_rows(args, F, AIN(0), AIN(4), 0, 1024, nullptr, F.ws + WS_H0); } SEAM(1);
    if (IN(2)) { PB(); pg8::StaticOrder S; S.init(M, NIN, F.G, (int)blockIdx.x); pg8::DenseSrcT<1> G{F.ws + WS_H0, F.ws + WS_WIN, 1024};
        EpiInProj E{ZB, GATES}; pg8::gemm_phase<EpiInProj, pg8::StaticOrder, pg8::DenseSrcT<1>>(F.lds, 1024, S, G, E); } SEAM(2);
    if (IN(3)) { PB(); rk::load_params(args, F); for (int u = blockIdx.x; u < 1024; u += F.G) rk::r1_unit(args, F, u >> 7, u & 127); __syncthreads(); } SEAM(3);
    if (IN(4)) { PB();
#ifdef PROBE_R2_DRY
        if (blockIdx.x < R2_WGS && F.wave < 128 / R2_WGS) rk::r2_task<1>(args, F, blockIdx.x * (128 / R2_WGS) + F.wave);
#endif
        if (blockIdx.x < R2_WGS && F.wave < 128 / R2_WGS) rk::r2_task<0>(args, F, blockIdx.x * (128 / R2_WGS) + F.wave);
#pragma unroll 1
        for (int rep = 0; rep < PROBE_IDX_REP; ++rep)
        for (;;) {
            __syncthreads();
            if (F.tid == 0) F.MISC[12] = atomicAdd(F.ctl + CW_Q + rep, 1u);
            __syncthreads();
            const int u = (int)F.MISC[12];
            if (u >= 2048) break;
            indexer_unit(args, F, u & 7, (255 - (u >> 3)) * 16);
        } } SEAM(4);
    if (IN(5)) { PB(); for (int u = blockIdx.x; u < 1024; u += F.G) rk::r3_unit(args, F, u >> 7, u & 127); __syncthreads();
        for (int i = 0; i < 4; ++i) for (int uu = F.vcu; uu < 256; uu += F.G) { const int bh = uu >> 2, s = uu & 3; const int qb = (i == 0) ? s : (i == 1) ? 7 - s : (i == 2) ? 8 + s : 15 - s;
            att::attn_unit(args, F, bh >> 3, bh & 7, qb); } __syncthreads(); } SEAM(5);
    if (IN(6)) { PB(); pg8::StaticOrder S; S.init(M, D, F.G, (int)blockIdx.x);
        { pg8::DenseSrc G{F.ws + WS_R1, F.ws + WS_WA, 512}; EpiMerge<0> E{(bf16_t*)(F.ws + WS_R2), F.ws + WS_H0, GATES, PROBE_ATT_SCALE}; pg8::gemm_phase<EpiMerge<0>, pg8::StaticOrder, pg8::DenseSrc>(F.lds, 512, S, G, E); }
        { pg8::DenseSrc G{F.ws + WS_R0, F.ws + WS_WR, 512}; EpiMerge<1> E{(bf16_t*)(F.ws + WS_R2), F.ws + WS_H0, GATES, PROBE_RW_SCALE}; pg8::gemm_phase<EpiMerge<1>, pg8::StaticOrder, pg8::DenseSrc>(F.lds, 512, S, G, E); } } SEAM(6);
    if (IN(7)) { PB(); pg8::StaticOrder S; S.init(M, D, F.G, (int)blockIdx.x); pg8::DenseSrcT<1> G{F.ws + WS_H0, F.ws + WS_WO, 1024};
        EpiOutProj E{AIN(0), F.out, MOD}; pg8::gemm_phase<EpiOutProj, pg8::StaticOrder, pg8::DenseSrcT<1>>(F.lds, 1024, S, G, E); } SEAM(7);
    if (IN(8)) { PB(); norm_mod_rows(args, F, F.out, AIN(21), 3072, 4096, (bf16_t*)(F.ws + WS_H2), nullptr); convert_experts(args, F); } SEAM(8);
    if (IN(9)) { PB(); pg8::StaticOrder S; S.init(M, 256, F.G, (int)blockIdx.x); pg8::DenseSrc G{(const bf16_t*)(F.ws + WS_H2), (const bf16_t*)(F.ws + WS_WRT), 1024};
        EpiRouter E{(float*)(F.ws + WS_LOGIT)}; pg8::gemm_phase<EpiRouter, pg8::StaticOrder, pg8::DenseSrc>(F.lds, 1024, S, G, E); } SEAM(9);
    if (IN(10)) { PB(); route_phase(args, F); } SEAM(10);
    MoeTab mt{0, 0};
    if (lo <= 13 && hi > 13) { PB(); mt = build_tiles(args, F); scatter_phase(args, F); } else if (hi > 13) { PB(); mt = build_tiles(args, F); }
    SEAM(11);
    const LAS unsigned* tab = (const LAS unsigned*)(F.lds + LDS_TILETAB);
    if (IN(12)) { PB(); MoeSched1 S{tab, mt.ntiles, F.G, (int)blockIdx.x}; MoeSrc1 G{F.ws};
        EpiMoe1 E{F.ws}; pg8::gemm_phase<EpiMoe1, MoeSched1, MoeSrc1>(F.lds, 1024, S, G, E); } SEAM(12);
    if (IN(13)) { PB(); MoeSched2 S{tab, 0, mt.ntiles, 512, F.G, (int)blockIdx.x}; MoeSrc2 G{F.ws}; EpiMoe2 E{F.ws, F.out, 0};
        pg8::gemm_phase<EpiMoe2, MoeSched2, MoeSrc2>(F.lds, 256, S, G, E); } SEAM(13);
    if (IN(14)) { PB(); final_rows(args, F, 0, M, 0); }
#undef IN
#undef SEAM
#undef PB
}

extern "C" void kernel_launch(void* const* d_in, const int* in_sizes, int n_in, void* d_out, int out_size, void* d_ws, size_t ws_size, hipStream_t stream) {
    static int grid = 0;
    if (grid == 0) {
        if (n_in != 31 || out_size != M * D || ws_size < WS_END) { fprintf(stderr, "kernel_launch: unexpected problem (n_in %d, out %d, ws %zu)\n", n_in, out_size, ws_size); grid = -1; return; }
        int dev = 0, cus = 0, per_cu = 0;
        if (hipGetDevice(&dev) != hipSuccess || hipDeviceGetAttribute(&cus, hipDeviceAttributeMultiprocessorCount, dev) != hipSuccess) { grid = -1; return; }
        if (hipFuncSetAttribute((const void*)fwd_kernel, hipFuncAttributeMaxDynamicSharedMemorySize, LDS_BYTES) != hipSuccess) { fprintf(stderr, "kernel_launch: hipFuncSetAttribute failed\n"); grid = -1; return; }
        if (hipOccupancyMaxActiveBlocksPerMultiprocessor(&per_cu, (const void*)fwd_kernel, NTHR, LDS_BYTES) != hipSuccess || per_cu < 1) fprintf(stderr, "kernel_launch: occupancy query reports %d\n", per_cu);
        (void)hipGetLastError();
        grid = cus;
        if (grid != 256) fprintf(stderr, "kernel_launch: %d CUs (built for 256)\n", grid);
    }
    if (grid < 0) return;
    (void)in_sizes;
    if (hipMemsetAsync((char*)d_ws + WS_CTL, 0, CTL_ZERO_BYTES, stream) != hipSuccess) return;
    Args a{};
    for (int i = 0; i < 31; ++i) a.in[i] = (const float*)d_in[i];
    a.out = (float*)d_out; a.ws = (unsigned char*)d_ws;
#ifndef PROBE_REPEAT
#define PROBE_REPEAT -1
#endif
    int li = 0;
    auto go = [&](int lo_, int hi_) { a.ph_lo = lo_; a.ph_hi = hi_; a.li = li++; hipLaunchKernelGGL(fwd_kernel, dim3(grid), dim3(NTHR), LDS_BYTES, stream, a); };
    if (PROBE_REPEAT < 0) go(0, N_PHASES);
    else { go(0, PROBE_REPEAT + 1); go(PROBE_REPEAT, PROBE_REPEAT + 1); if (PROBE_REPEAT + 1 < N_PHASES) go(PROBE_REPEAT + 1, N_PHASES); }
}
```

```cpp
#include <hip/hip_runtime.h>
#include <cstdio>
#include <cstdint>
#include <cmath>

#define GAS __attribute__((address_space(1)))
#define LAS __attribute__((address_space(3)))
typedef unsigned short bf16_t;
typedef short bf16x8 __attribute__((ext_vector_type(8)));
typedef float f32x4 __attribute__((ext_vector_type(4)));
typedef float f32x2 __attribute__((ext_vector_type(2)));
typedef float f32x16 __attribute__((ext_vector_type(16)));
typedef unsigned u32x4 __attribute__((ext_vector_type(4)));
typedef unsigned u32x2 __attribute__((ext_vector_type(2)));
typedef GAS unsigned gu32;

__device__ __forceinline__ unsigned cvt_pk_bf16(float lo, float hi) { unsigned r; asm volatile("v_cvt_pk_bf16_f32 %0, %1, %2" : "=v"(r) : "v"(lo), "v"(hi)); return r; }
__device__ __forceinline__ float bf_lo(unsigned w) { return __uint_as_float(w << 16); }
__device__ __forceinline__ float bf_hi(unsigned w) { return __uint_as_float(w & 0xffff0000u); }
__device__ __forceinline__ float bf2f(bf16_t b) { return __uint_as_float(((unsigned)b) << 16); }
__device__ __forceinline__ unsigned f2bf(float f) { unsigned u = __float_as_uint(f); return (u + 0x7fffu + ((u >> 16) & 1u)) >> 16; }
__device__ __forceinline__ unsigned pk2(float lo, float hi) { return f2bf(lo) | (f2bf(hi) << 16); }
__device__ __forceinline__ float fast_sigmoid(float x) { return __builtin_amdgcn_rcpf(1.0f + __builtin_amdgcn_exp2f(-1.4426950408889634f * x)); }
__device__ __forceinline__ float wave_sum(float v) {
#pragma unroll
    for (int o = 1; o < 64; o <<= 1) v += __shfl_xor(v, o);
    return v;
}

namespace pg8 {
constexpr int BM = 256, BK = 64, HALF = 128, HTB = HALF * BK * 2, STAGE_BYTES = 8 * HTB, NXCD = 8, WGM = 8;
__host__ __device__ __forceinline__ int lds_byte(int r, int c) { const int st = (r >> 4) * 2 + (c >> 5), rr = r & 15, cc = c & 31, ob = rr * 64 + cc * 2; return st * 1024 + (ob ^ (((ob >> 9) & 1) << 5)); }
__host__ __device__ __forceinline__ void stage_rc(int b, int& R, int& C) { const int st = b / 1024, sb = b % 1024, swz = sb ^ (((sb >> 9) & 1) << 5); R = (st >> 1) * 16 + swz / 64; C = (st & 1) * 32 + (swz % 64) / 2; }
__host__ __device__ __forceinline__ int perm32(int rho) { const int n = rho >> 4, i = rho & 15; return 8 * (i >> 2) + 4 * n + (i & 3); }

struct Unit { int pm, pn; int aux0, aux1; };

struct StaticOrder {
    int nM, nN, nwg, G, c;
    __host__ __device__ void init(int M, int N, int G_, int c_) { nM = M / BM; nN = N / BM; nwg = nM * nN; G = G_; c = c_; }
    __host__ __device__ bool next(int i, Unit& u) const {
        const long L = (long)i * G + c; if (L >= nwg) return false;
        int wgid = (int)L; { const int q = nwg / NXCD, r = nwg % NXCD, xcd = wgid % NXCD, off = wgid / NXCD; wgid = (xcd < r ? xcd * (q + 1) : r * (q + 1) + (xcd - r) * q) + off; }
        const int nig = WGM * nN, gid = wgid / nig, fm = gid * WGM, gsz = (nM - fm) < WGM ? (nM - fm) : WGM;
        u.pm = fm + ((wgid % nig) % gsz); u.pn = (wgid % nig) / gsz; u.aux0 = 0; u.aux1 = 0; return true;
    }
};

template <int ESZ_> struct DenseSrcT {
    static constexpr int ESZ = ESZ_; static constexpr bool GATHER = false;
    const void* A; const void* Bt; int K;
    __device__ __forceinline__ const char* b_base(const Unit& u) const { return (const char*)Bt + (size_t)u.pn * 256 * K * ESZ; }
    __device__ __forceinline__ const char* a_base(const Unit& u) const { return (const char*)A + (size_t)u.pm * 256 * K * ESZ; }
    __device__ __forceinline__ unsigned a_off(const Unit&, int R, int C) const { return (unsigned)(R * K * ESZ) + (unsigned)C * 2u; }
};
typedef DenseSrcT<2> DenseSrc;
typedef int v8i32 __attribute__((ext_vector_type(8)));

template <class Epi, class Sched, class Src, bool ALIGN_EPI = true>
__device__ __forceinline__ void gemm_phase(LAS unsigned char* lds, const int K, const Sched& S, const Src& G, const Epi& E) {
    const int tid = threadIdx.x, wid = __builtin_amdgcn_readfirstlane(tid >> 6), lane = tid & 63, wr = wid >> 2, wc = wid & 3, fr = lane & 15, fq = lane >> 4;
    constexpr int ESZ = Src::ESZ; const int Kb = K * ESZ;
    const int nt = Kb / (BK * 2);
    unsigned voffB0;
    { int R, C; stage_rc(tid * 16, R, C); const int Rb = Epi::PERM ? ((R & ~31) + perm32(R & 31)) : R; voffB0 = (unsigned)(Rb * Kb) + (unsigned)C * 2u; }
#define PG8_AOFF(u, h, i) ([&]() { int R_, C_; stage_rc(tid * 16 + (i) * 8192, R_, C_); return G.a_off((u), R_ + (h) * HALF, C_); }())
    const size_t kstep = (size_t)(BK * 2);
    const size_t hstepB = (size_t)HALF * Kb;
    const unsigned ldsw = (unsigned)wid * 1024u;
    const int aoff = lds_byte(wr * 64 + fr, fq * 8), boff = lds_byte(wc * 32 + fr, fq * 8);
#define PG8_SA(b, h) (((b) * 2 + (h)) * HTB)
#define PG8_SB(b, h) ((4 + (b) * 2 + (h)) * HTB)
#define PG8_STAGEB(bufoff, gbase) do { _Pragma("unroll") for (int _i = 0; _i < 2; ++_i) { unsigned o_ = voffB0; asm volatile("" : "+v"(o_)); \
        __builtin_amdgcn_global_load_lds((const unsigned*)((const char*)(gbase) + (size_t)_i * 64 * Kb + o_), (LAS unsigned*)(lds + (bufoff) + ldsw + _i * 8192), 16, 0, 0); } } while (0)
#define PG8_STAGEA(bufoff, gbase, vo, h) do { _Pragma("unroll") for (int _i = 0; _i < 2; ++_i) { unsigned o_ = Src::GATHER ? (vo)[h][_i] : (vo)[0][0]; asm volatile("" : "+v"(o_)); \
        __builtin_amdgcn_global_load_lds((const unsigned*)((const char*)(gbase) + (Src::GATHER ? (size_t)0 : (size_t)((h) * 128 + _i * 64) * Kb) + o_), (LAS unsigned*)(lds + (bufoff) + ldsw + _i * 8192), 16, 0, 0); } } while (0)
#define PG8_STAGEA2(bufoff, gbase, h) do { _Pragma("unroll") for (int _i = 0; _i < 2; ++_i) { unsigned o_ = Src::GATHER ? (last ? vn[h][_i] : vc[h][_i]) : vc[0][0]; asm volatile("" : "+v"(o_)); \
        __builtin_amdgcn_global_load_lds((const unsigned*)((const char*)(gbase) + (Src::GATHER ? (size_t)0 : (size_t)((h) * 128 + _i * 64) * Kb) + o_), (LAS unsigned*)(lds + (bufoff) + ldsw + _i * 8192), 16, 0, 0); } } while (0)
#define PG8_LDA(dst, b, h) do { _Pragma("unroll") for (int m = 0; m < 4; ++m) { const u32x4 lo_ = *(const LAS u32x4*)(lds + PG8_SA(b, h) + aoff + m * 2048), hi_ = *(const LAS u32x4*)(lds + PG8_SA(b, h) + aoff + m * 2048 + 1024); \
        dst[m] = __builtin_shufflevector(lo_, hi_, 0, 1, 2, 3, 4, 5, 6, 7); } } while (0)
#define PG8_LDB(dst, b, h) do { _Pragma("unroll") for (int n = 0; n < 2; ++n) { const u32x4 lo_ = *(const LAS u32x4*)(lds + PG8_SB(b, h) + boff + n * 2048), hi_ = *(const LAS u32x4*)(lds + PG8_SB(b, h) + boff + n * 2048 + 1024); \
        dst[n] = __builtin_shufflevector(lo_, hi_, 0, 1, 2, 3, 4, 5, 6, 7); } } while (0)
#define PG8_LO(x) __builtin_bit_cast(bf16x8, __builtin_shufflevector((x), (x), 0, 1, 2, 3))
#define PG8_HI(x) __builtin_bit_cast(bf16x8, __builtin_shufflevector((x), (x), 4, 5, 6, 7))
#define PG8_MMA(ai, bj, At, Bt) do { __builtin_amdgcn_s_setprio(1); _Pragma("unroll") for (int m = 0; m < 4; ++m) _Pragma("unroll") for (int n = 0; n < 2; ++n) { \
        if constexpr (ESZ == 1) acc[ai][bj][m][n] = __builtin_amdgcn_mfma_scale_f32_16x16x128_f8f6f4(__builtin_bit_cast(v8i32, Bt[n]), __builtin_bit_cast(v8i32, At[m]), acc[ai][bj][m][n], 0, 0, 0, 0, 0, 0); \
        else { acc[ai][bj][m][n] = __builtin_amdgcn_mfma_f32_16x16x32_bf16(PG8_LO(Bt[n]), PG8_LO(At[m]), acc[ai][bj][m][n], 0, 0, 0); \
               acc[ai][bj][m][n] = __builtin_amdgcn_mfma_f32_16x16x32_bf16(PG8_HI(Bt[n]), PG8_HI(At[m]), acc[ai][bj][m][n], 0, 0, 0); } } \
        __builtin_amdgcn_s_setprio(0); } while (0)
#define PG8_WAIT_V(n) asm volatile("s_waitcnt vmcnt(" #n ")" ::: "memory")
#define PG8_WAIT_L(n) asm volatile("s_waitcnt lgkmcnt(" #n ")" ::: "memory")
#define PG8_BAR __builtin_amdgcn_s_barrier()
#define PG8_SCHED __builtin_amdgcn_sched_barrier(0)
    Unit cur, nxt; int ui = 0;
    if (!S.next(0, cur)) return;
    f32x4 acc[2][2][4][2];
#pragma unroll
    for (int a = 0; a < 2; ++a)
#pragma unroll
        for (int b = 0; b < 2; ++b)
#pragma unroll
            for (int m = 0; m < 4; ++m)
#pragma unroll
                for (int n = 0; n < 2; ++n) acc[a][b][m][n] = (f32x4){0.f, 0.f, 0.f, 0.f};
    typedef unsigned u32x8 __attribute__((ext_vector_type(8)));
    u32x8 At[4], B0[2], B1[2];
    unsigned vc[2][2], vn[2][2];
#pragma unroll
    for (int h = 0; h < 2; ++h)
#pragma unroll
        for (int i = 0; i < 2; ++i) vc[h][i] = PG8_AOFF(cur, h, i);
    const char* cA = G.a_base(cur); const char* cB = G.b_base(cur);
    PG8_STAGEB(PG8_SB(0, 0), cB); PG8_STAGEB(PG8_SB(0, 1), cB + hstepB); PG8_STAGEA(PG8_SA(0, 0), cA, vc, 0); PG8_STAGEA(PG8_SA(0, 1), cA, vc, 1);
    if (wr == 1) PG8_BAR;
    PG8_WAIT_V(2); PG8_BAR;
    PG8_STAGEB(PG8_SB(1, 0), cB + kstep); PG8_STAGEA(PG8_SA(1, 0), cA + kstep, vc, 0); PG8_STAGEB(PG8_SB(1, 1), cB + hstepB + kstep);
    PG8_WAIT_V(6); PG8_BAR;
    for (;;) {
        const bool has_next = S.next(ui + 1, nxt);
        const char* nA = has_next ? G.a_base(nxt) : cA; const char* nB = has_next ? G.b_base(nxt) : cB;
        if constexpr (Src::GATHER) {
#pragma unroll
        for (int h = 0; h < 2; ++h)
#pragma unroll
            for (int i = 0; i < 2; ++i) vn[h][i] = has_next ? PG8_AOFF(nxt, h, i) : vc[h][i]; }
#pragma clang loop unroll(disable)
        for (int t = 0; t < nt; t += 2) {
            const bool last = (t == nt - 2);
            const char* a1 = cA + (size_t)(t + 1) * kstep;
            const char* a2 = last ? nA : cA + (size_t)(t + 2) * kstep; const char* b2 = last ? nB : cB + (size_t)(t + 2) * kstep;
            const char* a3 = a2 + kstep; const char* b3 = b2 + kstep;
            PG8_LDB(B0, 0, 0); PG8_LDB(B1, 0, 1); PG8_SCHED; PG8_LDA(At, 0, 0); PG8_STAGEA(PG8_SA(1, 1), a1, vc, 1);
            PG8_WAIT_V(8); PG8_WAIT_L(0); PG8_BAR; PG8_MMA(0, 0, At, B0); PG8_MMA(0, 1, At, B1); PG8_BAR; PG8_SCHED;
            PG8_LDA(At, 0, 1); PG8_STAGEB(PG8_SB(0, 0), b2); PG8_STAGEB(PG8_SB(0, 1), b2 + hstepB); PG8_STAGEA2(PG8_SA(0, 0), a2, 0);
            PG8_WAIT_V(8); PG8_WAIT_L(0); PG8_BAR; PG8_MMA(1, 0, At, B0); PG8_MMA(1, 1, At, B1); PG8_BAR; PG8_SCHED;
            PG8_LDB(B0, 1, 0); PG8_LDB(B1, 1, 1); PG8_SCHED; PG8_LDA(At, 1, 0); PG8_STAGEA2(PG8_SA(0, 1), a2, 1);
            PG8_WAIT_V(8); PG8_WAIT_L(0); PG8_BAR; PG8_MMA(0, 0, At, B0); PG8_MMA(0, 1, At, B1); PG8_BAR; PG8_SCHED;
            PG8_LDA(At, 1, 1); PG8_STAGEB(PG8_SB(1, 0), b3); PG8_STAGEB(PG8_SB(1, 1), b3 + hstepB); PG8_STAGEA2(PG8_SA(1, 0), a3, 0);
            PG8_WAIT_V(8); PG8_WAIT_L(0); PG8_BAR; PG8_MMA(1, 0, At, B0); PG8_MMA(1, 1, At, B1); PG8_BAR; PG8_SCHED;
        }
        if constexpr (ALIGN_EPI) { if (wr == 0) PG8_BAR; }
        { int ln_; asm volatile("v_mbcnt_lo_u32_b32 %0, -1, 0\n\tv_mbcnt_hi_u32_b32 %0, -1, %0" : "=v"(ln_)); E(acc, cur, wr, wc, ln_ & 15, ln_ >> 4); }
        if (!has_next) break;
#pragma unroll
        for (int a = 0; a < 2; ++a)
#pragma unroll
            for (int b = 0; b < 2; ++b)
#pragma unroll
                for (int m = 0; m < 4; ++m)
#pragma unroll
                    for (int n = 0; n < 2; ++n) acc[a][b][m][n] = (f32x4){0.f, 0.f, 0.f, 0.f};
        cur = nxt; cA = nA; cB = nB; ++ui;
        if constexpr (Src::GATHER) {
#pragma unroll
        for (int h = 0; h < 2; ++h)
#pragma unroll
            for (int i = 0; i < 2; ++i) vc[h][i] = vn[h][i]; }
        if constexpr (ALIGN_EPI) { if (wr == 1) PG8_BAR; }
    }
    PG8_WAIT_V(0);
    if constexpr (!ALIGN_EPI) { if (wr == 0) PG8_BAR; }
    PG8_BAR;
#undef PG8_SA
#undef PG8_AOFF
#undef PG8_SB
#undef PG8_STAGEA
#undef PG8_STAGEA2
#undef PG8_STAGEB
#undef PG8_LDA
#undef PG8_LDB
#undef PG8_MMA
#undef PG8_LO
#undef PG8_HI
#undef PG8_WAIT_V
#undef PG8_WAIT_L
#undef PG8_BAR
#undef PG8_SCHED
}
}
#define RLX_AGENT __ATOMIC_RELAXED, __HIP_MEMORY_SCOPE_AGENT
#define LDS_WAIT() asm volatile("s_waitcnt lgkmcnt(0)" ::: "memory")
#define VM_WAIT() asm volatile("s_waitcnt vmcnt(0)" ::: "memory")
#define XB_TMO      128
#define XB_XCNT(j)  (256  + 64 * (j))
#define XB_XSUB(j)  (1280 + 64 * (j))
#define XB_XGEN(j)  (2304 + 64 * (j))
#define XB_TOP      3328
#define XB_TOPGEN   3392
#define XCD_BAR_WORDS 3456
#define XB_SPIN_CAP (1u << 18)

__device__ __forceinline__ unsigned xb_ld(unsigned* p)              { return __hip_atomic_load(p, __ATOMIC_RELAXED, __HIP_MEMORY_SCOPE_AGENT); }
__device__ __forceinline__ unsigned xb_add(unsigned* p, unsigned v) { return __hip_atomic_fetch_add(p, v, __ATOMIC_RELAXED, __HIP_MEMORY_SCOPE_AGENT); }
__device__ __forceinline__ unsigned xb_xcc_id() { return (unsigned)__builtin_amdgcn_s_getreg((3 << 11) | 20) & 0xFu; }
#define XB_SPIN(cond, bar) do { unsigned _sp = 0; while (cond) { __builtin_amdgcn_s_sleep(1); \
    if ((++_sp & 255u) == 0u) { if (xb_ld(&(bar)[XB_TMO])) break; if (_sp > XB_SPIN_CAP) { atomicAdd(&(bar)[XB_TMO], 1u); break; } } } } while (0)

struct XcdBarrier {
    unsigned* bar; unsigned x;
    volatile LAS unsigned* st;
};

__device__ __forceinline__ XcdBarrier xcd_barrier_post(unsigned* bar, volatile LAS unsigned* st) {
    XcdBarrier b; b.bar = bar; b.x = xb_xcc_id(); b.st = st;
    if (threadIdx.x == 0) (void)xb_add(&bar[XB_XCNT(b.x)], 1u);
    return b;
}
__device__ __forceinline__ void xcd_barrier_complete(unsigned* bar, unsigned x, unsigned& nloc, unsigned& nx) {
    const unsigned G = gridDim.x * gridDim.y * gridDim.z;
    unsigned sum, cnt, mine, sp = 0u;
    for (;;) {
        sum = 0u; cnt = 0u; mine = 0u;
#pragma unroll
        for (unsigned j = 0; j < 16; ++j) { const unsigned c = xb_ld(&bar[XB_XCNT(j)]); sum += c; cnt += (c > 0u) ? 1u : 0u; mine = (j == x) ? c : mine; }
        if (sum == G) break;
        __builtin_amdgcn_s_sleep(1);
        if ((++sp & 255u) == 0u) { if (xb_ld(&bar[XB_TMO])) break; if (sp > XB_SPIN_CAP) { atomicAdd(&bar[XB_TMO], 1u); break; } }
    }
    nloc = mine > 0u ? mine : 1u; nx = cnt > 0u ? cnt : 1u;
}

__device__ __forceinline__ void xcd_barrier(const XcdBarrier& b) {
    asm volatile("s_waitcnt vmcnt(0)" ::: "memory");
    __syncthreads();
    if (threadIdx.x == 0) {
        unsigned* bar = b.bar;
        __builtin_amdgcn_s_waitcnt(0);
        unsigned nloc = b.st[0], nx = b.st[1];
        if (nloc == 0u) { xcd_barrier_complete(bar, b.x, nloc, nx); b.st[0] = nloc; b.st[1] = nx; }
        const unsigned old = xb_add(&bar[XB_XSUB(b.x)], 1u);
        const unsigned gen = old / nloc;
        if (old + 1u == (gen + 1u) * nloc) {
            __builtin_amdgcn_fence(__ATOMIC_RELEASE, "agent");
            asm volatile("s_waitcnt vmcnt(0)" ::: "memory");
            const unsigned og = xb_add(&bar[XB_TOP], 1u);
            const unsigned tg = og / nx;
            if (og + 1u == (tg + 1u) * nx) xb_add(&bar[XB_TOPGEN], 1u);
            else XB_SPIN(xb_ld(&bar[XB_TOPGEN]) == tg, bar);
            __builtin_amdgcn_fence(__ATOMIC_ACQUIRE, "agent");
            xb_add(&bar[XB_XGEN(b.x)], 1u);
            asm volatile("s_waitcnt vmcnt(0)" ::: "memory");
        } else {
            XB_SPIN(xb_ld(&bar[XB_XGEN(b.x)]) == gen, bar);
            __builtin_amdgcn_fence(__ATOMIC_ACQUIRE, "agent");
            asm volatile("s_waitcnt vmcnt(0)" ::: "memory");
        }
    }
    __syncthreads();
}
constexpr int NB = 8, SEQ = 4096, D = 1024, M = NB * SEQ;
constexpr int NIN_SRC = 5936, NIN = 6144;
constexpr int ZW = 4096;
constexpr int ZQ = 0, ZK = 512, ZV = 1024, ZIQ = 1536, ZIK = 2048, ZIW = 2080, ZR = 2304;
constexpr int ZR_R = ZR, ZR_K = ZR + 512, ZR_V = ZR + 1024, ZR_WD = ZR + 1536, ZR_AD = ZR + 1600, ZR_GD = ZR + 1664;
constexpr int GW = 2048;
constexpr int NEXP = 64, FF = 256, TOPK = 8;
constexpr float RMS_EPS = 1e-6f, GN_EPS = 64e-5f;
constexpr float QSCALE = 0.125f * 1.4426950408889634f;
constexpr int NWAVES = 8, NTHR = 512;

constexpr size_t MiB = 1u << 20;
constexpr size_t WS_CTL = 0, CTL_ZERO_BYTES = 1 * MiB;
constexpr size_t WS_MOD = 1 * MiB;
constexpr size_t WS_DUT = 1 * MiB + 256 * 1024;
constexpr size_t WS_IUT = WS_DUT + 64 * 1024;
constexpr size_t WS_GUT = WS_IUT + 64 * 1024;
constexpr size_t WS_WIN = 2 * MiB;
constexpr size_t WS_WA = 14 * MiB, WS_WR = 15 * MiB;
constexpr size_t WS_WO = 16 * MiB;
constexpr size_t WS_WRT = 18 * MiB;
constexpr size_t WS_WSH1 = 19 * MiB;
constexpr size_t WS_WSH2 = 20 * MiB;
constexpr size_t WS_BRS = 21 * MiB, WS_KRS = 22 * MiB;
constexpr size_t WS_TOPE = 23 * MiB, WS_TOPW = 24 * MiB;
constexpr size_t WS_LOGIT = 25 * MiB;
constexpr size_t WS_Z = 36 * MiB;
constexpr size_t WS_H0 = 292 * MiB, WS_H1 = 324 * MiB;
constexpr size_t WS_SEL = 356 * MiB;
constexpr size_t WS_R0 = 372 * MiB, WS_R1 = 404 * MiB, WS_R2 = 436 * MiB, WS_R3 = 468 * MiB;
constexpr size_t WS_W2T = 36 * MiB;
constexpr size_t WS_ACT = 68 * MiB;
constexpr size_t WS_ACTS = 196 * MiB;
constexpr size_t WS_STOK = 212 * MiB, WS_SW = 213 * MiB;
constexpr size_t WS_W1T = 214 * MiB;
constexpr size_t WS_H2 = 278 * MiB;
constexpr size_t WS_SLOT = 214 * MiB;
constexpr size_t WS_END = 502 * MiB;
constexpr int CW_TMO = 0, CW_BAR = 4096, CW_CNT = 32768, CW_CUR = 32768 + 128, CW_Q = 32768 + 512;

constexpr int RING_BYTES = 131072;
constexpr int LDSCTL_OFF = RING_BYTES, MISC_OFF = LDSCTL_OFF + 320;
constexpr int LDS_TILETAB = RING_BYTES + 1024;
constexpr int LDS_PTAB = RING_BYTES + 512;
constexpr int LDS_PARA = 118800;
constexpr int LDS_PARB = LDS_TILETAB;
constexpr int LDS_BYTES = 147456;
#define AIN(i) ain_ptr(F.lds, (i))

struct Args { const float* in[31]; float* out; unsigned char* ws; int ph_lo, ph_hi, li, pad; };
struct Frame {
    LAS unsigned char* lds;
    volatile LAS unsigned* MISC;
    unsigned* ctl;
    int tid, lane, wave, vcu, G, gw, NGW;
    float* out; unsigned char* ws;
};

__device__ __forceinline__ const float* ain_ptr(LAS unsigned char* lds, int i) {
    const u32x2 w = *(const LAS u32x2*)(lds + LDS_PTAB + 8 * i);
    const unsigned lo = (unsigned)__builtin_amdgcn_readfirstlane((int)w.x), hi = (unsigned)__builtin_amdgcn_readfirstlane((int)w.y);
    return (const float*)(const GAS float*)(((unsigned long long)hi << 32) | lo);
}
struct TrSrc { const float* base; int nsrc; };
template <int FP8, class ColFn>
__device__ __forceinline__ void transpose_item(const ColFn& colfn, int K, bf16_t* WT, LAS float* scr, int kb, int nb, int lane) {
    const int k0 = 64 * kb, n0 = 32 * nb;
    const TrSrc s = colfn(n0 + (lane & 31));
    float v_[32];
#pragma unroll
    for (int i = 0; i < 32; ++i) { const int kk = 2 * i + (lane >> 5); v_[i] = s.base ? s.base[(size_t)(k0 + kk) * s.nsrc] : 0.f; }
#pragma unroll
    for (int i = 0; i < 32; ++i) { const int kk = 2 * i + (lane >> 5); scr[kk * 33 + (lane & 31)] = v_[i]; }
    LDS_WAIT(); asm volatile("" ::: "memory");
    const int c = lane & 7;
#pragma unroll
    for (int j = 0; j < 4; ++j) { const int n = (lane >> 3) + 8 * j; const LAS float* sp = scr + (8 * c) * 33 + n;
        if constexpr (FP8) { constexpr float S8 = 32.0f;
            int lo = __builtin_amdgcn_cvt_pk_fp8_f32(sp[0 * 33] * S8, sp[1 * 33] * S8, 0, false); lo = __builtin_amdgcn_cvt_pk_fp8_f32(sp[2 * 33] * S8, sp[3 * 33] * S8, lo, true);
            int hi = __builtin_amdgcn_cvt_pk_fp8_f32(sp[4 * 33] * S8, sp[5 * 33] * S8, 0, false); hi = __builtin_amdgcn_cvt_pk_fp8_f32(sp[6 * 33] * S8, sp[7 * 33] * S8, hi, true);
            *(GAS u32x2*)((unsigned char*)WT + (size_t)(n0 + n) * K + k0 + 8 * c) = (u32x2){(unsigned)lo, (unsigned)hi}; }
        else { u32x4 o; o.x = pk2(sp[0 * 33], sp[1 * 33]); o.y = pk2(sp[2 * 33], sp[3 * 33]); o.z = pk2(sp[4 * 33], sp[5 * 33]); o.w = pk2(sp[6 * 33], sp[7 * 33]);
            *(GAS u32x4*)(WT + (size_t)(n0 + n) * K + k0 + 8 * c) = o; } }
    LDS_WAIT(); asm volatile("" ::: "memory");
}

__device__ __forceinline__ void p0_mod(const Args& args, Frame& F, int task) {
    LAS float* sc = (LAS float*)F.lds;
    LAS float* red = (LAS float*)(F.lds + 32768);
    const float* c = AIN(1);
    for (int i = F.tid; i < 8192; i += NTHR) { const float v = c[i]; sc[i] = v * fast_sigmoid(v); }
    __syncthreads();
    const float* aw = AIN(2) + 64 * task + F.lane;
    float acc[8];
#pragma unroll
    for (int b = 0; b < 8; ++b) acc[b] = 0.f;
    const int kb = 128 * F.wave;
#pragma unroll 4
    for (int k = 0; k < 128; ++k) { const float a = aw[(size_t)(kb + k) * 6144];
#pragma unroll
        for (int b = 0; b < 8; ++b) acc[b] += sc[b * 1024 + kb + k] * a; }
#pragma unroll
    for (int b = 0; b < 8; ++b) red[(F.wave * 8 + b) * 64 + F.lane] = acc[b];
    __syncthreads();
    { const int b = F.wave; float s = AIN(3)[64 * task + F.lane];
#pragma unroll
      for (int w = 0; w < 8; ++w) s += red[(w * 8 + b) * 64 + F.lane];
      ((float*)(F.ws + WS_MOD))[b * 6144 + 64 * task + F.lane] = s; }
    __syncthreads();
}

__device__ __forceinline__ void p0_prologue(const Args& args, Frame& F) {
    if (blockIdx.x < 96) p0_mod(args, F, blockIdx.x);
    LAS float* scr = (LAS float*)(F.lds + F.wave * 16384);
    bf16_t* const ws16 = (bf16_t*)F.ws;
    constexpr int I_WIN = 16 * 192, I_WA = 8 * 32, I_WO = 16 * 32, I_WRT = 16 * 8, I_SH1 = 16 * 16, I_SH2 = 4 * 32, I_DU = 16, I_GU = 32;
    constexpr int NIT = I_WIN + 2 * I_WA + I_WO + I_WRT + I_SH1 + I_SH2 + 2 * I_DU + I_GU;
    for (int it = F.gw; it < NIT; it += F.NGW) {
        int r = it;
        if (r < I_WIN) { const float* w = AIN(5);
            transpose_item<1>([=](int n) { TrSrc s; const bool ok = (n < 2096) || (n >= 2304); const int col = n < 2096 ? n : n - 208; s.base = ok ? w + col : nullptr; s.nsrc = NIN_SRC; return s; },
                           1024, (bf16_t*)(F.ws + WS_WIN), scr, r / 192, r % 192, F.lane); continue; } r -= I_WIN;
        if (r < I_WA) { const float* w = AIN(18); transpose_item<0>([=](int n) { TrSrc s; s.base = w + n; s.nsrc = 1024; return s; }, 512, (bf16_t*)(F.ws + WS_WA), scr, r / 32, r % 32, F.lane); continue; } r -= I_WA;
        if (r < I_WA) { const float* w = AIN(19); transpose_item<0>([=](int n) { TrSrc s; s.base = w + n; s.nsrc = 1024; return s; }, 512, (bf16_t*)(F.ws + WS_WR), scr, r / 32, r % 32, F.lane); continue; } r -= I_WA;
        if (r < I_WO) { const float* w = AIN(20); transpose_item<1>([=](int n) { TrSrc s; s.base = w + n; s.nsrc = 1024; return s; }, 1024, (bf16_t*)(F.ws + WS_WO), scr, r / 32, r % 32, F.lane); continue; } r -= I_WO;
        if (r < I_WRT) { const float* w = AIN(22); transpose_item<0>([=](int n) { TrSrc s; s.base = n < 64 ? w + n : nullptr; s.nsrc = 64; return s; }, 1024, (bf16_t*)(F.ws + WS_WRT), scr, r / 8, r % 8, F.lane); continue; } r -= I_WRT;
        if (r < I_SH1) { const float* wg = AIN(27); const float* wu = AIN(28);
            transpose_item<0>([=](int n) { TrSrc s; const int j = n >> 8, sel = (n >> 7) & 1, cc = n & 127; s.base = (sel ? wu : wg) + 128 * j + cc; s.nsrc = 256; return s; }, 1024, (bf16_t*)(F.ws + WS_WSH1), scr, r / 16, r % 16, F.lane); continue; } r -= I_SH1;
        if (r < I_SH2) { const float* w = AIN(29); transpose_item<0>([=](int n) { TrSrc s; s.base = w + n; s.nsrc = 1024; return s; }, 256, (bf16_t*)(F.ws + WS_WSH2), scr, r / 32, r % 32, F.lane); continue; } r -= I_SH2;
        if (r < I_DU) { const float* w = AIN(9); transpose_item<0>([=](int n) { TrSrc s; s.base = w + n; s.nsrc = 512; return s; }, 64, (bf16_t*)(F.ws + WS_DUT), scr, 0, r, F.lane); continue; } r -= I_DU;
        if (r < I_DU) { const float* w = AIN(11); transpose_item<0>([=](int n) { TrSrc s; s.base = w + n; s.nsrc = 512; return s; }, 64, (bf16_t*)(F.ws + WS_IUT), scr, 0, r, F.lane); continue; } r -= I_DU;
        { const float* w = AIN(12); transpose_item<0>([=](int n) { TrSrc s; s.base = w + n; s.nsrc = 512; return s; }, 128, (bf16_t*)(F.ws + WS_GUT), scr, r / 16, r % 16, F.lane); }
    }
    (void)ws16;
}

__device__ __forceinline__ void convert_experts(const Args& args, Frame& F) {
    LAS float* scr = (LAS float*)(F.lds + F.wave * 16384);
    constexpr int I1 = 16 * 16, I2 = 4 * 32, PER = I1 + I2, NIT = 64 * PER;
    for (int it = F.gw; it < NIT; it += F.NGW) {
        const int e = it / PER; int r = it % PER;
        if (r < I1) { const float* wg = AIN(24) + (size_t)e * 1024 * 256; const float* wu = AIN(25) + (size_t)e * 1024 * 256;
            transpose_item<0>([=](int n) { TrSrc s; const int j = n >> 8, sel = (n >> 7) & 1, cc = n & 127; s.base = (sel ? wu : wg) + 128 * j + cc; s.nsrc = 256; return s; }, 1024, (bf16_t*)(F.ws + WS_W1T) + (size_t)e * 512 * 1024, scr, r / 16, r % 16, F.lane); }
        else { r -= I1; const float* w = AIN(26) + (size_t)e * 256 * 1024;
            transpose_item<0>([=](int n) { TrSrc s; s.base = w + n; s.nsrc = 1024; return s; }, 256, (bf16_t*)(F.ws + WS_W2T) + (size_t)e * 1024 * 256, scr, r / 32, r % 32, F.lane); }
    }
}

__device__ __forceinline__ void norm_mod_rows(const Args& args, Frame& F, const float* X, const float* g, int sh_off, int sc_off, bf16_t* O, unsigned char* O8) {
    const int row0 = F.gw * 16, b = row0 / SEQ;
    const float* mod = (const float*)(F.ws + WS_MOD) + b * 6144;
    f32x4 mul[4], add[4];
#pragma unroll
    for (int j = 0; j < 4; ++j) { const int c = 4 * F.lane + 256 * j; const f32x4 gv = *(const f32x4*)(g + c), sc = *(const f32x4*)(mod + sc_off + c); add[j] = *(const f32x4*)(mod + sh_off + c); mul[j] = gv * (sc + 1.0f); }
    for (int r = 0; r < 16; ++r) {
        const GAS f32x4* xr = (const GAS f32x4*)(X + (size_t)(row0 + r) * D) + F.lane;
        f32x4 v[4]; float s = 0.f;
#pragma unroll
        for (int j = 0; j < 4; ++j) { v[j] = xr[64 * j]; s += (v[j].x * v[j].x + v[j].y * v[j].y) + (v[j].z * v[j].z + v[j].w * v[j].w); }
        const float rstd = 1.0f / sqrtf(wave_sum(s) * (1.0f / D) + RMS_EPS);
#pragma unroll
        for (int j = 0; j < 4; ++j) { const f32x4 y = v[j] * rstd * mul[j] + add[j];
            if (O) { u32x2 w; w.x = cvt_pk_bf16(y.x, y.y); w.y = cvt_pk_bf16(y.z, y.w); ((GAS u32x2*)(O + (size_t)(row0 + r) * D) + F.lane)[64 * j] = w; }
            if (O8) { int w8 = __builtin_amdgcn_cvt_pk_fp8_f32(y.x, y.y, 0, false); w8 = __builtin_amdgcn_cvt_pk_fp8_f32(y.z, y.w, w8, true); ((GAS unsigned*)(O8 + (size_t)(row0 + r) * D) + F.lane)[64 * j] = (unsigned)w8; } }
    }
}
using pg8::Unit;
constexpr float WSCALE8 = 32.0f;
typedef const f32x4 (&AccRef)[2][2][4][2];

struct EpiInProj {
    static constexpr bool PERM = true;
    bf16_t* Z; bf16_t* Gt;
    __device__ __forceinline__ void operator()(AccRef acc, const Unit& u, int wr, int wc, int fr, int fq) const {
        asm volatile("" : "+v"(fr), "+v"(fq));
        const int row0 = u.pm * 256 + wr * 64 + fr;
        const bool gate = u.pn >= 16;
        const float sc = ((u.pn < 2) ? QSCALE : 1.0f) * (1.0f / WSCALE8);
        bf16_t* base = gate ? Gt + (size_t)(u.pn - 16) * 256 : Z + (size_t)u.pn * 256;
        const int ldc = gate ? GW : ZW;
#pragma unroll
        for (int ai = 0; ai < 2; ++ai)
#pragma unroll
            for (int m = 0; m < 4; ++m) { bf16_t* rowp = base + (size_t)(row0 + ai * 128 + m * 16) * ldc + wc * 32 + 8 * fq;
#pragma unroll
                for (int bj = 0; bj < 2; ++bj) { f32x4 v0 = acc[ai][bj][m][0], v1 = acc[ai][bj][m][1];
                    if (gate) {
#pragma unroll
                        for (int j = 0; j < 4; ++j) { v0[j] = fast_sigmoid(v0[j] * sc); v1[j] = fast_sigmoid(v1[j] * sc); } }
                    else { v0 = v0 * sc; v1 = v1 * sc; }
                    u32x4 w; w.x = cvt_pk_bf16(v0[0], v0[1]); w.y = cvt_pk_bf16(v0[2], v0[3]); w.z = cvt_pk_bf16(v1[0], v1[1]); w.w = cvt_pk_bf16(v1[2], v1[3]);
                    *(u32x4*)(rowp + bj * 128) = w; } }
    }
};

constexpr float ATT_S8 = 16.0f, RW_S8 = 8.0f, MIX_S8 = 16.0f;
template <int SECOND> struct EpiMerge {
    static constexpr bool PERM = true;
    bf16_t* Mx; unsigned char* Mx8; const bf16_t* Gt; float bs;
    __device__ __forceinline__ void operator()(AccRef acc, const Unit& u, int wr, int wc, int fr, int fq) const {
        asm volatile("" : "+v"(fr), "+v"(fq));
        const int row0 = u.pm * 256 + wr * 64 + fr, col0 = u.pn * 256 + wc * 32 + 8 * fq;
#pragma unroll
        for (int ai = 0; ai < 2; ++ai)
#pragma unroll
            for (int m = 0; m < 4; ++m) { const size_t r = (size_t)(row0 + ai * 128 + m * 16);
#pragma unroll
                for (int bj = 0; bj < 2; ++bj) { const int c = col0 + bj * 128;
                    const u32x4 g = *(const u32x4*)(Gt + r * GW + SECOND * 1024 + c);
                    f32x4 v0 = acc[ai][bj][m][0] * bs, v1 = acc[ai][bj][m][1] * bs;
                    v0[0] *= bf_lo(g.x); v0[1] *= bf_hi(g.x); v0[2] *= bf_lo(g.y); v0[3] *= bf_hi(g.y);
                    v1[0] *= bf_lo(g.z); v1[1] *= bf_hi(g.z); v1[2] *= bf_lo(g.w); v1[3] *= bf_hi(g.w);
                    if (SECOND) { const u32x4 p = *(const u32x4*)(Mx + r * D + c);
                        v0[0] += bf_lo(p.x); v0[1] += bf_hi(p.x); v0[2] += bf_lo(p.y); v0[3] += bf_hi(p.y);
                        v1[0] += bf_lo(p.z); v1[1] += bf_hi(p.z); v1[2] += bf_lo(p.w); v1[3] += bf_hi(p.w);
                        v0 = v0 * MIX_S8; v1 = v1 * MIX_S8;
                        int lo = __builtin_amdgcn_cvt_pk_fp8_f32(v0[0], v0[1], 0, false); lo = __builtin_amdgcn_cvt_pk_fp8_f32(v0[2], v0[3], lo, true);
                        int hi = __builtin_amdgcn_cvt_pk_fp8_f32(v1[0], v1[1], 0, false); hi = __builtin_amdgcn_cvt_pk_fp8_f32(v1[2], v1[3], hi, true);
                        *(u32x2*)(Mx8 + r * D + c) = (u32x2){(unsigned)lo, (unsigned)hi}; }
                    else { u32x4 w; w.x = cvt_pk_bf16(v0[0], v0[1]); w.y = cvt_pk_bf16(v0[2], v0[3]); w.z = cvt_pk_bf16(v1[0], v1[1]); w.w = cvt_pk_bf16(v1[2], v1[3]);
                        *(u32x4*)(Mx + r * D + c) = w; } } }
    }
};

struct EpiOutProj {
    static constexpr bool PERM = false;
    const float* X; float* O; const float* mod;
    __device__ __forceinline__ void operator()(AccRef acc, const Unit& u, int wr, int wc, int fr, int fq) const {
        asm volatile("" : "+v"(fr), "+v"(fq));
        const int row0 = u.pm * 256 + wr * 64 + fr, col0 = u.pn * 256 + wc * 32 + 4 * fq;
        const float* g1 = mod + (size_t)((u.pm * 256) / SEQ) * 6144 + 2048;
        f32x4 gv[2][2];
#pragma unroll
        for (int bj = 0; bj < 2; ++bj)
#pragma unroll
            for (int n = 0; n < 2; ++n) gv[bj][n] = *(const f32x4*)(g1 + col0 + bj * 128 + n * 16);
#pragma unroll
        for (int ai = 0; ai < 2; ++ai)
#pragma unroll
            for (int m = 0; m < 4; ++m) { const size_t off = (size_t)(row0 + ai * 128 + m * 16) * D + col0;
#pragma unroll
                for (int bj = 0; bj < 2; ++bj)
#pragma unroll
                    for (int n = 0; n < 2; ++n) { const f32x4 xv = *(const f32x4*)(X + off + bj * 128 + n * 16);
                        *(f32x4*)(O + off + bj * 128 + n * 16) = xv + gv[bj][n] * acc[ai][bj][m][n] * (1.0f / (MIX_S8 * WSCALE8)); }
                if (m & 1) asm volatile("" ::: "memory"); }
    }
};

struct EpiRouter {
    static constexpr bool PERM = false;
    float* L;
    __device__ __forceinline__ void operator()(AccRef acc, const Unit& u, int wr, int wc, int fr, int fq) const {
        asm volatile("" : "+v"(fr), "+v"(fq));
        if (wc >= 2) return;
        const int row0 = u.pm * 256 + wr * 64 + fr, col0 = wc * 32 + 4 * fq;
#pragma unroll
        for (int ai = 0; ai < 2; ++ai)
#pragma unroll
            for (int m = 0; m < 4; ++m)
#pragma unroll
                for (int n = 0; n < 2; ++n) *(f32x4*)(L + (size_t)(row0 + ai * 128 + m * 16) * 64 + col0 + n * 16) = acc[ai][0][m][n];
    }
};

struct MoeSched1 {
    const LAS unsigned* tab; int ntiles, G, c;
    __device__ __forceinline__ bool next(int i, Unit& u) const {
        const int L = i * G + c; if (L >= 256 + 2 * ntiles) return false;
        u.pn = L & 1;
        if (L < 256) { u.pm = L >> 1; u.aux0 = (u.pm * 256) | (64 << 20); u.aux1 = 256; }
        else { const int t = (L - 256) >> 1; u.pm = t; u.aux0 = __builtin_amdgcn_readfirstlane((int)tab[2 * t]); u.aux1 = __builtin_amdgcn_readfirstlane((int)tab[2 * t + 1]); }
        return true;
    }
};
struct MoeSrc1 {
    static constexpr int ESZ = 2; static constexpr bool GATHER = true;
    const unsigned char* ws;
    __device__ __forceinline__ const char* a_base(const Unit&) const { return (const char*)(ws + WS_H2); }
    __device__ __forceinline__ const char* b_base(const Unit& u) const { const int e = u.aux0 >> 20;
        const size_t off = (e == 64 ? WS_WSH1 : WS_W1T + (size_t)e * 512 * 1024 * 2) + (size_t)u.pn * 256 * 1024 * 2; return (const char*)ws + off; }
    __device__ __forceinline__ unsigned a_off(const Unit& u, int R, int C) const {
        const int e = u.aux0 >> 20, pos0 = u.aux0 & 0xFFFFF; int tok;
        if (e == 64) tok = pos0 + R; else tok = (R < u.aux1) ? (((const int*)(ws + WS_STOK))[pos0 + R] >> 3) : 0;
        return (unsigned)tok * 2048u + (unsigned)C * 2u; }
};
struct EpiMoe1 {
    static constexpr bool PERM = true;
    unsigned char* ws;
    __device__ __forceinline__ void operator()(AccRef acc, const Unit& u, int wr, int wc, int fr, int fq) const {
        asm volatile("" : "+v"(fr), "+v"(fq));
        const int e = u.aux0 >> 20, pos0 = u.aux0 & 0xFFFFF;
        bf16_t* base = (bf16_t*)(ws + (e == 64 ? WS_ACTS : WS_ACT)) + (size_t)pos0 * FF + u.pn * 128 + wc * 32 + 8 * fq;
#pragma unroll
        for (int ai = 0; ai < 2; ++ai)
#pragma unroll
            for (int m = 0; m < 4; ++m) { const int r = ai * 128 + wr * 64 + m * 16 + fr;
                float o[8];
#pragma unroll
                for (int n = 0; n < 2; ++n)
#pragma unroll
                    for (int j = 0; j < 4; ++j) { const float g = acc[ai][0][m][n][j], up = acc[ai][1][m][n][j]; o[4 * n + j] = g * fast_sigmoid(g) * up; }
                u32x4 w; w.x = cvt_pk_bf16(o[0], o[1]); w.y = cvt_pk_bf16(o[2], o[3]); w.z = cvt_pk_bf16(o[4], o[5]); w.w = cvt_pk_bf16(o[6], o[7]);
                if (r < u.aux1) *(u32x4*)(base + (size_t)r * FF) = w; }
    }
};
struct MoeSched2 {
    const LAS unsigned* tab; int t0, ntiles, nsh, G, c;
    __device__ __forceinline__ bool next(int i, Unit& u) const {
        const int L = i * G + c; if (L >= nsh + 4 * ntiles) return false;
        u.pn = L & 3;
        if (L < nsh) { u.pm = L >> 2; u.aux0 = (u.pm * 256) | (64 << 20); u.aux1 = 256; }
        else { const int t = t0 + ((L - nsh) >> 2); u.pm = t; u.aux0 = __builtin_amdgcn_readfirstlane((int)tab[2 * t]); u.aux1 = __builtin_amdgcn_readfirstlane((int)tab[2 * t + 1]); }
        return true;
    }
};
struct MoeSrc2 {
    static constexpr int ESZ = 2; static constexpr bool GATHER = true;
    const unsigned char* ws;
    __device__ __forceinline__ const char* a_base(const Unit& u) const { return (const char*)ws + ((u.aux0 >> 20) == 64 ? WS_ACTS : WS_ACT); }
    __device__ __forceinline__ const char* b_base(const Unit& u) const { const int e = u.aux0 >> 20;
        const size_t off = (e == 64 ? WS_WSH2 : WS_W2T + (size_t)e * 1024 * 256 * 2) + (size_t)u.pn * 256 * 256 * 2; return (const char*)ws + off; }
    __device__ __forceinline__ unsigned a_off(const Unit& u, int R, int C) const {
        const int pos0 = u.aux0 & 0xFFFFF; const int rr = R < u.aux1 ? R : u.aux1 - 1;
        return (unsigned)(pos0 + rr) * 512u + (unsigned)C * 2u; }
};
constexpr float SLOT_SCALE = 16.0f;
constexpr int NSLOT = 9;
struct EpiMoe2 {
    static constexpr bool PERM = true;
    unsigned char* ws; float* X1; int tokbase;
    __device__ __forceinline__ void operator()(AccRef acc, const Unit& u, int wr, int wc, int fr, int fq) const {
        asm volatile("" : "+v"(fr), "+v"(fq));
        const int e = u.aux0 >> 20, pos0 = u.aux0 & 0xFFFFF; const int col0 = u.pn * 256 + wc * 32 + 8 * fq;
        if (e == 64) {
#pragma unroll
            for (int ai = 0; ai < 2; ++ai)
#pragma unroll
                for (int m = 0; m < 4; ++m) { unsigned char* rowp = (unsigned char*)(ws + WS_SLOT) + ((size_t)(pos0 + ai * 128 + wr * 64 + m * 16 + fr) * NSLOT + 8) * D + u.pn * 256 + wc * 64 + fq * 16;
                    u32x4 o;
#pragma unroll
                    for (int bj = 0; bj < 2; ++bj) { const f32x4 v0 = acc[ai][bj][m][0] * SLOT_SCALE, v1 = acc[ai][bj][m][1] * SLOT_SCALE;
                        int lo = __builtin_amdgcn_cvt_pk_fp8_f32(v0[0], v0[1], 0, false); lo = __builtin_amdgcn_cvt_pk_fp8_f32(v0[2], v0[3], lo, true);
                        int hi = __builtin_amdgcn_cvt_pk_fp8_f32(v1[0], v1[1], 0, false); hi = __builtin_amdgcn_cvt_pk_fp8_f32(v1[2], v1[3], hi, true);
                        if (bj == 0) { o.x = (unsigned)lo; o.y = (unsigned)hi; } else { o.z = (unsigned)lo; o.w = (unsigned)hi; } }
                    *(u32x4*)rowp = o;
                    asm volatile("" ::: "memory"); }
        } else {
#pragma unroll
            for (int ai = 0; ai < 2; ++ai)
#pragma unroll
                for (int m = 0; m < 4; ++m) { const int r = ai * 128 + wr * 64 + m * 16 + fr;
                    if (r < u.aux1) { const int tk = ((const int*)(ws + WS_STOK))[pos0 + r]; const float w = ((const float*)(ws + WS_SW))[pos0 + r] * SLOT_SCALE;
                        unsigned char* rowp = (unsigned char*)(ws + WS_SLOT) + ((size_t)(tk >> 3) * NSLOT + (tk & 7)) * D + u.pn * 256 + wc * 64 + fq * 16;
                        u32x4 o;
#pragma unroll
                        for (int bj = 0; bj < 2; ++bj) { const f32x4 v0 = acc[ai][bj][m][0] * w, v1 = acc[ai][bj][m][1] * w;
                            int lo = __builtin_amdgcn_cvt_pk_fp8_f32(v0[0], v0[1], 0, false); lo = __builtin_amdgcn_cvt_pk_fp8_f32(v0[2], v0[3], lo, true);
                            int hi = __builtin_amdgcn_cvt_pk_fp8_f32(v1[0], v1[1], 0, false); hi = __builtin_amdgcn_cvt_pk_fp8_f32(v1[2], v1[3], hi, true);
                            if (bj == 0) { o.x = (unsigned)lo; o.y = (unsigned)hi; } else { o.z = (unsigned)lo; o.w = (unsigned)hi; } }
                        *(u32x4*)rowp = o; }
                    asm volatile("" ::: "memory"); }
        }
    }
};
__device__ __forceinline__ unsigned ord_key(float x) { const unsigned b = __float_as_uint(x); return (b & 0x80000000u) ? ~b : (b | 0x80000000u); }

__device__ __forceinline__ void indexer_unit(const Args& args, Frame& F, int b, int q0) {
    const bf16_t* Z = (const bf16_t*)(F.ws + WS_Z) + (size_t)b * SEQ * ZW;
    unsigned* SELM = (unsigned*)(F.ws + WS_SEL) + (size_t)b * SEQ * 128;
    int tid = F.tid; asm volatile("" : "+v"(tid));
    const int lane = tid & 63, kl = lane & 31, hl = lane >> 5, w = F.wave;
    const int qa = q0 + 2 * w;
    const int myq = qa + hl;
    bf16x8 A0, A1;
    { const int aq = (kl >> 2) & 1, ah = 4 * (kl >> 3) + (kl & 3);
      const bf16_t* p = Z + (size_t)(qa + aq) * ZW + ZIQ + ah * 32 + 8 * hl;
      A0 = *(const bf16x8*)p; A1 = *(const bf16x8*)(p + 16); }
    float wq[16];
    { const bf16_t* p = Z + (size_t)myq * ZW + ZIW; const u32x4 a = *(const u32x4*)p, c = *(const u32x4*)(p + 8);
      wq[0] = bf_lo(a.x); wq[1] = bf_hi(a.x); wq[2] = bf_lo(a.y); wq[3] = bf_hi(a.y); wq[4] = bf_lo(a.z); wq[5] = bf_hi(a.z); wq[6] = bf_lo(a.w); wq[7] = bf_hi(a.w);
      wq[8] = bf_lo(c.x); wq[9] = bf_hi(c.x); wq[10] = bf_lo(c.y); wq[11] = bf_hi(c.y); wq[12] = bf_lo(c.z); wq[13] = bf_hi(c.z); wq[14] = bf_lo(c.w); wq[15] = bf_hi(c.w); }
    unsigned key[128];
    const int nchunk = (q0 + 15) / 1024 + 1;
#define IDX_LOAD(ch, buf) do { _Pragma("unroll") for (int _h = 0; _h < 2; ++_h) { u32x4 v_[4]; \
        _Pragma("unroll") for (int _i = 0; _i < 4; ++_i) { const int pc = tid + 512 * (4 * _h + _i); const int kk = pc >> 2, c4 = pc & 3; v_[_i] = *(const u32x4*)(Z + (size_t)((ch) * 1024 + kk) * ZW + ZIK + 8 * c4); } \
        _Pragma("unroll") for (int _i = 0; _i < 4; ++_i) { const int pc = tid + 512 * (4 * _h + _i); const int kk = pc >> 2, c4 = pc & 3; *(LAS u32x4*)(F.lds + (buf) * 65536 + (c4 * 1024 + kk) * 16) = v_[_i]; } \
        asm volatile("" ::: "memory"); } } while (0)
    IDX_LOAD(0, 0);
    __syncthreads();
#pragma unroll
    for (int ch = 0; ch < 4; ++ch) {
        if (ch < nchunk) {
            if (ch + 1 < nchunk) IDX_LOAD(ch + 1, (ch + 1) & 1);
            LAS unsigned char* kbl = F.lds + (ch & 1) * 65536 + hl * 16384 + kl * 16; asm volatile("" : "+v"(kbl));
#pragma unroll
            for (int tt = 0; tt < 32; tt += 2) {
                const int t = ch * 32 + tt;
                if (32 * t <= qa + 1) {
                    bf16x8 B0[2], B1[2]; f32x16 acc[2];
#pragma unroll
                    for (int j = 0; j < 2; ++j) { B0[j] = *(const LAS bf16x8*)(kbl + 512 * (tt + j)); B1[j] = *(const LAS bf16x8*)(kbl + 32768 + 512 * (tt + j)); }
#pragma unroll
                    for (int j = 0; j < 2; ++j) { acc[j] = f32x16{}; acc[j] = __builtin_amdgcn_mfma_f32_32x32x16_bf16(A0, B0[j], acc[j], 0, 0, 0); }
#pragma unroll
                    for (int j = 0; j < 2; ++j) acc[j] = __builtin_amdgcn_mfma_f32_32x32x16_bf16(A1, B1[j], acc[j], 0, 0, 0);
#pragma unroll
                    for (int j = 0; j < 2; ++j) { float s = 0.f;
#pragma unroll
                        for (int i = 0; i < 16; ++i) { const float av_ = acc[j][i]; const int xb_ = __float_as_int(av_); s += __int_as_float(xb_ > 0 ? xb_ : 0) * wq[i]; }
                        key[t + j] = (32 * (t + j) + kl <= myq) ? ord_key(s) : 0u; }
                } else {
#pragma unroll
                    for (int j = 0; j < 2; ++j) key[t + j] = 0u;
                }
            }
            __syncthreads();
        } else {
#pragma unroll
            for (int tt = 0; tt < 32; ++tt) key[ch * 32 + tt] = 0u;
        }
    }
#undef IDX_LOAD
#pragma unroll
    for (int w = 0; w < 4; ++w) {
        if (1024 * w <= qa + 1) {
#pragma unroll
            for (int k = 0; k < 16; ++k) { const unsigned lo = key[32 * w + k], hi_ = key[32 * w + k + 16];
                key[32 * w + k] = __builtin_amdgcn_perm(hi_, lo, 0x05040100u); key[32 * w + k + 16] = __builtin_amdgcn_perm(hi_, lo, 0x07060302u); }
#pragma unroll
            for (int k = 0; k < 32; ++k) if (!(k & 8)) { const unsigned lo = key[32 * w + k], hi_ = key[32 * w + k + 8];
                key[32 * w + k] = __builtin_amdgcn_perm(hi_, lo, 0x06020400u); key[32 * w + k + 8] = __builtin_amdgcn_perm(hi_, lo, 0x07030501u); }
#pragma unroll
            for (int k = 0; k < 32; ++k) if (!(k & 4)) { const unsigned lo = key[32 * w + k], hi_ = key[32 * w + k + 4]; const unsigned m = 0x0F0F0F0Fu;
                key[32 * w + k] = (lo & m) | ((hi_ << 4) & ~m); key[32 * w + k + 4] = ((lo >> 4) & m) | (hi_ & ~m); }
#pragma unroll
            for (int k = 0; k < 32; ++k) if (!(k & 2)) { const unsigned lo = key[32 * w + k], hi_ = key[32 * w + k + 2]; const unsigned m = 0x33333333u;
                key[32 * w + k] = (lo & m) | ((hi_ << 2) & ~m); key[32 * w + k + 2] = ((lo >> 2) & m) | (hi_ & ~m); }
#pragma unroll
            for (int k = 0; k < 32; ++k) if (!(k & 1)) { const unsigned lo = key[32 * w + k], hi_ = key[32 * w + k + 1]; const unsigned m = 0x55555555u;
                key[32 * w + k] = (lo & m) | ((hi_ << 1) & ~m); key[32 * w + k + 1] = ((lo >> 1) & m) | (hi_ & ~m); }
        }
    }
    unsigned Al[4] = {~0u, ~0u, ~0u, ~0u}, Gt[4] = {0u, 0u, 0u, 0u};
    int ab0 = 0, ab1 = 0; unsigned T0 = 0u, T1 = 0u; bool dn0 = false, dn1 = false;
#define IDX_DPP(v, ctrl) __builtin_amdgcn_update_dpp(0, (v), (ctrl), 0xF, 0xF, true)
#pragma unroll
    for (int bit = 31; bit >= 0; --bit) {
        unsigned S_[4]; int c = 0;
#pragma unroll
        for (int w = 0; w < 4; ++w) { S_[w] = Al[w] & key[32 * w + bit]; c += __builtin_popcount(S_[w]); }
        c += IDX_DPP(c, 0xB1); c += IDX_DPP(c, 0x4E); c += IDX_DPP(c, 0x141); c += IDX_DPP(c, 0x140);
        const int cn0 = ab0 + __builtin_amdgcn_readlane(c, 0) + __builtin_amdgcn_readlane(c, 16), cn1 = ab1 + __builtin_amdgcn_readlane(c, 32) + __builtin_amdgcn_readlane(c, 48);
        const bool t0 = cn0 >= 256, t1 = cn1 >= 256;
        if (t0) { T0 |= 1u << bit; dn0 = dn0 || cn0 == 256; } else ab0 = cn0;
        if (t1) { T1 |= 1u << bit; dn1 = dn1 || cn1 == 256; } else ab1 = cn1;
        const unsigned nm = hl ? (t1 ? 0u : ~0u) : (t0 ? 0u : ~0u);
#pragma unroll
        for (int w = 0; w < 4; ++w) { Al[w] &= key[32 * w + bit] ^ nm; Gt[w] |= S_[w] & nm; }
        if (dn0 && dn1) break;
    }
#undef IDX_DPP
    unsigned x[4];
    { const bool nz = hl ? (T1 != 0u) : (T0 != 0u);
#pragma unroll
      for (int w = 0; w < 4; ++w) x[w] = Gt[w] | (nz ? Al[w] : 0u); }
#define IDX_BFLY(d, m) do { const bool up_ = (kl & (d)) != 0; const unsigned km_ = up_ ? ~(m) : (m); const unsigned am_ = up_ ? (unsigned)(d) : 32u - (d); \
        _Pragma("unroll") for (int w = 0; w < 4; ++w) { const unsigned t_ = (unsigned)__builtin_amdgcn_ds_swizzle((int)x[w], 0x1F | ((d) << 10)); \
            const unsigned rot_ = __builtin_amdgcn_alignbit(t_, t_, am_); x[w] = (x[w] & km_) | (rot_ & ~km_); } } while (0)
    IDX_BFLY(16, 0x0000FFFFu); IDX_BFLY(8, 0x00FF00FFu); IDX_BFLY(4, 0x0F0F0F0Fu); IDX_BFLY(2, 0x33333333u); IDX_BFLY(1, 0x55555555u);
#undef IDX_BFLY
#pragma unroll
    for (int j = 0; j < 4; ++j) SELM[(size_t)myq * 128 + kl + 32 * j] = x[j];
}

__device__ __forceinline__ void indexer_phase(const Args& args, Frame& F) {
    const int c = blockIdx.x;
    for (int i = 0; i < 8; ++i) {
        for (int u = c + i * F.G; u < 2048 && i < 8; u += 2048) {
            const int b = u >> 8, pos = u & 255, blk = (b & 1) ? 255 - pos : pos;
            indexer_unit(args, F, b, blk * 16);
        }
    }
}
namespace att {
constexpr int DM = ZW, QB = 256, KVB = 64, SLOTB = 8192;
constexpr int NS = 4;
constexpr int L_K = 0, L_V = NS * SLOTB, L_MASK = 2 * NS * SLOTB, L_WSF = L_MASK + 8 * 2048, L_OST = L_WSF + 8 * 256, L_BT = L_OST + 8 * 4096, L_END = L_BT + 512;
static_assert(L_END <= RING_BYTES, "attention LDS");
__device__ __forceinline__ int crow(int r, int hi) { return (r & 3) + 8 * (r >> 2) + 4 * hi; }
__device__ __forceinline__ void glds16(const void* gsrc, unsigned lds_dst) { unsigned keep;
    asm volatile("s_mov_b32 %0, m0\n\ts_mov_b32 m0, %2\n\ts_nop 0\n\tglobal_load_lds_dwordx4 %1, off\n\ts_mov_b32 m0, %0" : "=&s"(keep) : "v"(gsrc), "s"(lds_dst) : "memory"); }
__device__ __forceinline__ unsigned cvtpk(float lo, float hi) { return cvt_pk_bf16(lo, hi); }
typedef short s16x4 __attribute__((ext_vector_type(4)));

__device__ __forceinline__ void attn_unit(const Args& args, Frame& F, int b, int h, int qb) {
    const int lane = F.lane, r32 = lane & 31, hi = lane >> 5, wid = F.wave;
    const bf16_t* Zb = (const bf16_t*)(F.ws + WS_Z) + (size_t)b * SEQ * DM;
    const int q0 = qb * QB;
    const bf16_t* Qw = Zb + (size_t)(q0 + wid * 32) * DM + ZQ + h * 64;
    const bf16_t* Kh = Zb + ZK + h * 64; const bf16_t* Vh = Zb + ZV + h * 64;
    LAS unsigned char* shm = F.lds;
    const unsigned lds0 = (unsigned)(uintptr_t)shm;
    LAS float* wsf = (LAS float*)(shm + L_WSF) + wid * 64;
    LAS float* bt = (LAS float*)(shm + L_BT);
    if (F.tid < 128) { const int rel = F.tid; int bk;
        if (rel < 16) bk = rel; else { bk = 16 + (int)(logf((float)rel / 16.0f) / logf(8.0f) * 16.0f); bk = bk < 31 ? bk : 31; }
        bt[rel] = (AIN(6)[bk * 8 + h] - AIN(6)[31 * 8 + h]) * 1.4426950408889634f; }
    const bf16_t* ksrc = Kh + (size_t)lane * DM + wid * 8;
    const bf16_t* vsrc = Vh + (size_t)(16 * (wid & 3) + (lane >> 2)) * DM + (wid >> 2) * 32 + (lane & 3) * 8;
    const unsigned kdst = lds0 + L_K + wid * 1024, vdst = lds0 + L_V + wid * 1024;
    const unsigned* SELM = (const unsigned*)(F.ws + WS_SEL) + (size_t)(b * SEQ + q0 + wid * 32 + r32) * 128 + 4 * hi;
    const unsigned mdst = lds0 + L_MASK + wid * 2048;
#define DMA_K(t, slot) glds16(ksrc + (size_t)(t) * KVB * DM, (unsigned)__builtin_amdgcn_readfirstlane(kdst + (slot) * SLOTB))
#define DMA_V(t, slot) glds16(vsrc + (size_t)(t) * KVB * DM, (unsigned)__builtin_amdgcn_readfirstlane(vdst + (slot) * SLOTB))
#define DMA_M(g) glds16(SELM + 8 * (g), (unsigned)__builtin_amdgcn_readfirstlane(mdst + ((g) & 1) * 1024))
    const int NT = (q0 + QB) / KVB;
    bf16x8 qr[4];
#pragma unroll
    for (int d0 = 0; d0 < 4; ++d0) qr[d0] = *(const bf16x8*)(Qw + (size_t)r32 * DM + d0 * 16 + hi * 8);
    asm volatile("s_waitcnt vmcnt(0)" ::: "memory");
    __syncthreads();
    DMA_M(0); DMA_K(0, 0); DMA_K(1, 1); DMA_V(0, 0); DMA_K(2, 2); DMA_V(1, 1); DMA_K(3, 3); DMA_V(2, 2);
    float m_run = -1e30f, l_run = 0.f; f32x16 o[2]; o[0] = f32x16{}; o[1] = f32x16{};
    const int qpos = q0 + wid * 32 + r32;
    const int vb0 = (int)(lds0 + L_V) + ((lane >> 4) & 1) * 32 + (lane & 3) * 8 + (4 * hi + ((lane & 15) >> 2)) * 64;
#define QK_TILE(P0, P1, slot_) do { const LAS unsigned char* kb = shm + L_K + (slot_) * SLOTB + hi * 1024 + r32 * 16; P0 = f32x16{}; P1 = f32x16{}; \
        _Pragma("unroll") for (int d0 = 0; d0 < 4; ++d0) { const bf16x8 b0 = *(const LAS bf16x8*)(kb + d0 * 2048); const bf16x8 b1 = *(const LAS bf16x8*)(kb + d0 * 2048 + 512); \
            P0 = __builtin_amdgcn_mfma_f32_32x32x16_bf16(b0, qr[d0], P0, 0, 0, 0); P1 = __builtin_amdgcn_mfma_f32_32x32x16_bf16(b1, qr[d0], P1, 0, 0, 0); } } while (0)
    f32x16 pa0, pa1, pb0, pb1;
    asm volatile("s_waitcnt vmcnt(6)" ::: "memory");
    __builtin_amdgcn_s_barrier(); asm volatile("" ::: "memory");
    QK_TILE(pa0, pa1, 0);
    auto step = [&](const int t, f32x16& C0, f32x16& C1, f32x16& N0, f32x16& N1) __attribute__((always_inline)) {
        const int slot = t & (NS - 1), g = t >> 2, tq = t & 3;
        if (t + 4 <= NT) { if (tq == 1 || tq == 2) asm volatile("s_waitcnt vmcnt(5)" ::: "memory"); else asm volatile("s_waitcnt vmcnt(4)" ::: "memory"); }
        else asm volatile("s_waitcnt vmcnt(0)" ::: "memory");
        __builtin_amdgcn_s_barrier(); asm volatile("" ::: "memory");
        if (t + 4 < NT) DMA_K(t + 4, (t + 4) & (NS - 1));
        if (t + 3 < NT) DMA_V(t + 3, (t + 3) & (NS - 1));
        if (tq == 0) DMA_M(g + 1);
        if (t + 1 < NT) QK_TILE(N0, N1, (t + 1) & (NS - 1));
        __builtin_amdgcn_sched_barrier(0);
        const u32x2 mwv = *(const LAS u32x2*)(shm + L_MASK + wid * 2048 + (g & 1) * 1024 + (tq >> 1) * 512 + r32 * 16 + (tq & 1) * 8);
        if (64 * t + 63 + 112 >= q0 + wid * 32) {
#pragma unroll
            for (int r = 0; r < 16; ++r) { const int kv = 64 * t + crow(r, hi); int r0 = qpos - kv, r1 = r0 - 32;
                r0 = r0 < 0 ? 0 : (r0 > 127 ? 127 : r0); r1 = r1 < 0 ? 0 : (r1 > 127 ? 127 : r1);
                C0[r] += bt[r0]; C1[r] += bt[r1]; }
        }
#pragma unroll
        for (int r = 0; r < 16; ++r) { C0[r] -= m_run; C1[r] -= m_run; }
        float rm = __builtin_fmaxf(C0[0], C1[0]);
#pragma unroll
        for (int r = 1; r < 16; ++r) rm = __builtin_fmaxf(rm, __builtin_fmaxf(C0[r], C1[r]));
        if (__builtin_amdgcn_ballot_w64(rm > 8.0f) != 0ull) {
            rm = __builtin_fmaxf(rm, __shfl_xor(rm, 32));
            const float dm = __builtin_fmaxf(rm, 0.f);
            const float f = __builtin_amdgcn_exp2f(-dm);
            m_run += dm; l_run *= f;
#pragma unroll
            for (int r = 0; r < 16; ++r) { C0[r] -= dm; C1[r] -= dm; }
            if (hi == 0) wsf[r32] = f;
            asm volatile("s_waitcnt lgkmcnt(0)" ::: "memory");
#pragma unroll
            for (int d = 0; d < 2; ++d)
#pragma unroll
                for (int r = 0; r < 16; ++r) o[d][r] *= wsf[crow(r, hi)];
        }
        { const unsigned mx_ = mwv.x >> (4 * hi), my_ = mwv.y >> (4 * hi); float sacc = 0.f;
#pragma unroll
          for (int r = 0; r < 16; ++r) { const int bitp = crow(r, 0);
              int k0 = __builtin_amdgcn_sbfe(mx_, bitp, 1), k1 = __builtin_amdgcn_sbfe(my_, bitp, 1);
              asm volatile("" : "+v"(k0), "+v"(k1));
              C0[r] = __int_as_float(__float_as_int(__builtin_amdgcn_exp2f(C0[r])) & k0); C1[r] = __int_as_float(__float_as_int(__builtin_amdgcn_exp2f(C1[r])) & k1);
              sacc += C0[r] + C1[r]; }
          l_run += sacc; }
        u32x4 pw0, pw1, pw2, pw3;
        pw0 = (u32x4){cvtpk(C0[0], C0[1]), cvtpk(C0[2], C0[3]), cvtpk(C0[4], C0[5]), cvtpk(C0[6], C0[7])};
        pw1 = (u32x4){cvtpk(C0[8], C0[9]), cvtpk(C0[10], C0[11]), cvtpk(C0[12], C0[13]), cvtpk(C0[14], C0[15])};
        pw2 = (u32x4){cvtpk(C1[0], C1[1]), cvtpk(C1[2], C1[3]), cvtpk(C1[4], C1[5]), cvtpk(C1[6], C1[7])};
        pw3 = (u32x4){cvtpk(C1[8], C1[9]), cvtpk(C1[10], C1[11]), cvtpk(C1[12], C1[13]), cvtpk(C1[14], C1[15])};
        { const int vb = vb0 + slot * SLOTB;
#pragma unroll
          for (int d0 = 0; d0 < 2; ++d0) { s16x4 lo[4], hh[4];
#pragma unroll
              for (int ks = 0; ks < 4; ++ks) {
                  asm volatile("ds_read_b64_tr_b16 %0,%1 offset:%c2" : "=&v"(lo[ks]) : "v"(vb), "i"(d0 * 4096 + ks * 1024) : "memory");
                  asm volatile("ds_read_b64_tr_b16 %0,%1 offset:%c2" : "=&v"(hh[ks]) : "v"(vb), "i"(d0 * 4096 + ks * 1024 + 512) : "memory"); }
              asm volatile("s_waitcnt lgkmcnt(0)" ::: "memory"); __builtin_amdgcn_sched_barrier(0);
#define PKV(k) (bf16x8){lo[k][0], lo[k][1], lo[k][2], lo[k][3], hh[k][0], hh[k][1], hh[k][2], hh[k][3]}
              o[d0] = __builtin_amdgcn_mfma_f32_32x32x16_bf16(__builtin_bit_cast(bf16x8, pw0), PKV(0), o[d0], 0, 0, 0);
              o[d0] = __builtin_amdgcn_mfma_f32_32x32x16_bf16(__builtin_bit_cast(bf16x8, pw1), PKV(1), o[d0], 0, 0, 0);
              o[d0] = __builtin_amdgcn_mfma_f32_32x32x16_bf16(__builtin_bit_cast(bf16x8, pw2), PKV(2), o[d0], 0, 0, 0);
              o[d0] = __builtin_amdgcn_mfma_f32_32x32x16_bf16(__builtin_bit_cast(bf16x8, pw3), PKV(3), o[d0], 0, 0, 0);
#undef PKV
          } }
        asm volatile("s_waitcnt lgkmcnt(0)" ::: "memory");
    };
    for (int t = 0; t < NT; t += 2) { step(t, pa0, pa1, pb0, pb1); step(t + 1, pb0, pb1, pa0, pa1); }
#undef QK_TILE
    l_run += __shfl_xor(l_run, 32);
    if (hi == 0) wsf[32 + r32] = l_run;
    asm volatile("s_waitcnt lgkmcnt(0)" ::: "memory");
    bf16_t* Ow = (bf16_t*)(F.ws + WS_R1) + (size_t)(b * SEQ + q0 + wid * 32) * 512 + h * 64;
    { LAS bf16_t* stg = (LAS bf16_t*)(shm + L_OST) + wid * 2048;
#pragma unroll
      for (int r = 0; r < 16; ++r) { const int orow = crow(r, hi); const float rl = __builtin_amdgcn_rcpf(wsf[32 + orow]);
#pragma unroll
          for (int d0 = 0; d0 < 2; ++d0) stg[orow * 64 + d0 * 32 + r32] = (bf16_t)f2bf(o[d0][r] * rl); }
      asm volatile("s_waitcnt lgkmcnt(0)" ::: "memory");
#pragma unroll
      for (int i = 0; i < 4; ++i) { const int row = i * 8 + (lane >> 3), chn = lane & 7; const u32x4 v = *(const LAS u32x4*)(stg + row * 64 + chn * 8); *(u32x4*)(Ow + (size_t)row * 512 + chn * 8) = v; } }
    asm volatile("s_waitcnt lgkmcnt(0)" ::: "memory");
#undef DMA_K
#undef DMA_V
#undef DMA_M
}

__device__ __forceinline__ void attn_phase(const Args& args, Frame& F) {
    const int v = F.vcu;
    for (int i = 0; i < 4; ++i) {
        for (int uu = v; uu < 256; uu += F.G) {
            const int bh = uu >> 2, s = uu & 3; const int qb = (i == 0) ? s : (i == 1) ? 7 - s : (i == 2) ? 8 + s : 15 - s;
            attn_unit(args, F, bh >> 3, bh & 7, qb);
        }
    }
}
}
#ifndef PROBE_NO_STATE
#define PROBE_NO_STATE 0
#endif
#ifndef PROBE_TINV_ID
#define PROBE_TINV_ID 0
#endif
namespace rk {
typedef __bf16 bf16x2_t __attribute__((ext_vector_type(2)));
__device__ __forceinline__ unsigned cvtpk(float lo, float hi) { f32x2 v = {lo, hi}; bf16x2_t b = __builtin_convertvector(v, bf16x2_t); return __builtin_bit_cast(unsigned, b); }
template <int S> __device__ __forceinline__ bf16x8 frag(const f32x16& x) {
    u32x4 o; o.x = cvtpk(x[8 * S + 0], x[8 * S + 1]); o.y = cvtpk(x[8 * S + 2], x[8 * S + 3]); o.z = cvtpk(x[8 * S + 4], x[8 * S + 5]); o.w = cvtpk(x[8 * S + 6], x[8 * S + 7]);
    return __builtin_bit_cast(bf16x8, o); }
template <int S> __device__ __forceinline__ void unfrag(f32x16& x, bf16x8 f) { const u32x4 o = __builtin_bit_cast(u32x4, f);
    x[8 * S + 0] = bf_lo(o.x); x[8 * S + 1] = bf_hi(o.x); x[8 * S + 2] = bf_lo(o.y); x[8 * S + 3] = bf_hi(o.y); x[8 * S + 4] = bf_lo(o.z); x[8 * S + 5] = bf_hi(o.z); x[8 * S + 6] = bf_lo(o.w); x[8 * S + 7] = bf_hi(o.w); }
#define RK_MF(a, b, c) __builtin_amdgcn_mfma_f32_32x32x16_bf16((a), (b), (c), 0, 0, 0)
__device__ __forceinline__ float dppf(float v, const int ctrl_is_const_dummy);
#define RK_DPP(v, ctrl, rmask, bc) __builtin_bit_cast(float, __builtin_amdgcn_update_dpp(0, __builtin_bit_cast(int, (v)), (ctrl), (rmask), 0xF, (bc)))
__device__ __forceinline__ float scan32(float v) {
#ifdef PROBE_SHFL_SCAN
    const int l32 = threadIdx.x & 31;
#pragma unroll
    for (int o = 1; o < 32; o <<= 1) { const float t = __shfl_up(v, o, 32); if (l32 >= o) v += t; }
    return v;
#endif
    v += RK_DPP(v, 0x111, 0xF, true); v += RK_DPP(v, 0x112, 0xF, true); v += RK_DPP(v, 0x114, 0xF, true); v += RK_DPP(v, 0x118, 0xF, true);
    v += RK_DPP(v, 0x142, 0xA, false);
    return v; }
__device__ __forceinline__ float ex2(float x) { return __builtin_amdgcn_exp2f(x); }
constexpr int PZ = 3600;
constexpr size_t SZ_G = 8192, SZ_H = 8192, SZ_Q = 4096, SZ_Y = 4096;
constexpr float L2E = 1.4426950408889634f;

__device__ __forceinline__ void mk_id(bf16x8 (&fId)[2], int r, int h) {
    asm volatile("" : "+v"(r), "+v"(h));
#pragma unroll
    for (int s = 0; s < 2; ++s) { unsigned short e8[8];
#pragma unroll
        for (int jj = 0; jj < 8; ++jj) e8[jj] = (16 * s + 8 * (jj >> 2) + 4 * h + (jj & 3) == r) ? (unsigned short)0x3F80 : (unsigned short)0;
        fId[s] = __builtin_bit_cast(bf16x8, (u32x4){(unsigned)e8[0] | ((unsigned)e8[1] << 16), (unsigned)e8[2] | ((unsigned)e8[3] << 16), (unsigned)e8[4] | ((unsigned)e8[5] << 16), (unsigned)e8[6] | ((unsigned)e8[7] << 16)}); }
}

__device__ __forceinline__ void load_params(const Args& args, Frame& F) {
    LAS float* pra = (LAS float*)(F.lds + LDS_PARA); LAS float* prb = (LAS float*)(F.lds + LDS_PARB);
    const float* mu = AIN(7); const float* w0 = AIN(8); const float* a0 = AIN(10); const float* kk = AIN(13); const float* ka = AIN(14); const float* rk = AIN(15);
    for (int i = F.tid; i < 4096; i += NTHR) { const int a = i >> 9, c = i & 511;
        const float v_ = a < 3 ? mu[a * 512 + c] : (a == 3 ? w0[c] : (a == 4 ? a0[c] : (a == 5 ? kk[c] : (a == 6 ? ka[c] : rk[c]))));
        if (a < 4) pra[c * 4 + a] = v_; else prb[c * 4 + a - 4] = v_; }
    __syncthreads();
}
struct ElemCtx { const LAS unsigned char* rowc; const LAS unsigned char* rowp; const bf16_t* DUt; const bf16_t* IUt; const LAS float* pra; const LAS float* prb; int hd, r, h; float inv; };
template <int MODE> __device__ __forceinline__ void r1_elem(const ElemCtx& C, int jt, bf16x8 (&o0)[2], bf16x8 (&o1)[2], bf16x8 (&o2)[2], bf16x8 (&o3)[2], float& bns, float& pcd) {
    const int r = C.r, h = C.h, hd = C.hd;
    f32x16 lw_ = f32x16{}, la_ = f32x16{};
#pragma unroll
    for (int ks = 0; ks < 4; ++ks) { const int k0 = 16 * ks + 8 * h;
        const bf16x8 bw = *(const LAS bf16x8*)(C.rowc + (1536 + k0) * 2), ba = *(const LAS bf16x8*)(C.rowc + (1600 + k0) * 2);
        const bf16x8 fa = *(const bf16x8*)(C.DUt + (size_t)(32 * jt + r) * 64 + k0), fi = *(const bf16x8*)(C.IUt + (size_t)(32 * jt + r) * 64 + k0);
        lw_ = RK_MF(fa, bw, lw_); la_ = RK_MF(fi, ba, la_); }
    float d = 0.f;
#pragma unroll
    for (int s = 0; s < 2; ++s) { float x0[8], x1[8], x2[8], x3[8];
#pragma unroll
        for (int g2 = 0; g2 < 2; ++g2) { const int g = 2 * s + g2, cj = hd * 64 + 32 * jt + 8 * g + 4 * h;
            float kc[4], kq[4], xc[4], xq[4];
            { const u32x2 a = *(const LAS u32x2*)(C.rowc + (512 + cj) * 2), p = *(const LAS u32x2*)(C.rowp + (512 + cj) * 2);
              kc[0] = bf_lo(a.x); kc[1] = bf_hi(a.x); kc[2] = bf_lo(a.y); kc[3] = bf_hi(a.y); kq[0] = bf_lo(p.x); kq[1] = bf_hi(p.x); kq[2] = bf_lo(p.y); kq[3] = bf_hi(p.y); }
            { const int xo = MODE ? 1024 : 0; const u32x2 a = *(const LAS u32x2*)(C.rowc + (xo + cj) * 2), p = *(const LAS u32x2*)(C.rowp + (xo + cj) * 2);
              xc[0] = bf_lo(a.x); xc[1] = bf_hi(a.x); xc[2] = bf_lo(a.y); xc[3] = bf_hi(a.y); xq[0] = bf_lo(p.x); xq[1] = bf_hi(p.x); xq[2] = bf_lo(p.y); xq[3] = bf_hi(p.y); }
            const LAS f32x4* ppa = (const LAS f32x4*)(C.pra + cj * 4); const LAS f32x4* ppb = (const LAS f32x4*)(C.prb + cj * 4);
#pragma unroll
            for (int q = 0; q < 4; ++q) { const int i = 4 * g + q, o = 4 * g2 + q;
                const f32x4 pa = ppa[q], pb = ppb[q];
                const float e_ = 0.6065306597126334f * fast_sigmoid(pa[3] + lw_[i]); const float L = scan32(e_);
                const float l0 = __builtin_bit_cast(float, __builtin_amdgcn_readlane(__builtin_bit_cast(int, L), 31)), l1 = __builtin_bit_cast(float, __builtin_amdgcn_readlane(__builtin_bit_cast(int, L), 63));
                const float Lend = h ? l1 : l0; if (i == 4 * (r >> 3) + (r & 3)) d = Lend;
                const float x_ = xc[q] + (MODE ? pa[2] : pa[0]) * (xq[q] - xc[q]), k_ = kc[q] + pa[1] * (kq[q] - kc[q]);
                const float ic = fast_sigmoid(pb[0] + la_[i]);
                const float kk = k_ * pb[1] * C.inv, kpn = k_ * (1.0f + (ic - 1.0f) * pb[2]), bv = kk * ic;
                if (MODE) { const float Qe = ex2(L2E * (L - Lend)); x0[o] = bv * Qe; x1[o] = kpn * Qe; x2[o] = x_; x3[o] = 0.f; }
                else { const float P = ex2(-L2E * L), Pi = ex2(L2E * L), Pm = ex2(-L2E * (L - e_)); bns += x_ * kpn * pb[3]; x0[o] = -kk * Pm; x1[o] = x_ * P; x2[o] = bv * Pi; x3[o] = kpn * Pi; } }
            asm volatile("" ::: "memory"); }
        o0[s] = __builtin_bit_cast(bf16x8, (u32x4){cvtpk(x0[0], x0[1]), cvtpk(x0[2], x0[3]), cvtpk(x0[4], x0[5]), cvtpk(x0[6], x0[7])});
        o1[s] = __builtin_bit_cast(bf16x8, (u32x4){cvtpk(x1[0], x1[1]), cvtpk(x1[2], x1[3]), cvtpk(x1[4], x1[5]), cvtpk(x1[6], x1[7])});
        o2[s] = __builtin_bit_cast(bf16x8, (u32x4){cvtpk(x2[0], x2[1]), cvtpk(x2[2], x2[3]), cvtpk(x2[4], x2[5]), cvtpk(x2[6], x2[7])});
        if (!MODE) o3[s] = __builtin_bit_cast(bf16x8, (u32x4){cvtpk(x3[0], x3[1]), cvtpk(x3[2], x3[3]), cvtpk(x3[4], x3[5]), cvtpk(x3[6], x3[7])}); }
    if (MODE) pcd = ex2(-L2E * d);
}


__device__ __forceinline__ void r1_unit(const Args& args, Frame& F, int b, int c) {
    LAS unsigned char* IMG = F.lds;
    const bf16_t* Z = (const bf16_t*)(F.ws + WS_Z);
    const int t0 = 32 * c; const size_t m0 = (size_t)b * SEQ + t0;
    const float* mu = AIN(7);
    int tid = F.tid; asm volatile("" : "+v"(tid));
    __syncthreads();
    { const unsigned lds0 = (unsigned)(uintptr_t)IMG; const int ln = tid & 63;
      for (int task = F.wave; task < 33 * 4; task += NWAVES) { const int rr = task >> 2, j = task & 3, pc = 64 * j + ln;
          if (pc < 224) { if (rr > 0 || t0 > 0) att::glds16(Z + (m0 + rr - 1) * ZW + ZR + 8 * pc, (unsigned)__builtin_amdgcn_readfirstlane((int)(lds0 + rr * PZ + 1024 * j)));
                          else *(LAS u32x4*)(IMG + 16 * pc) = (u32x4){0u, 0u, 0u, 0u}; } }
      asm volatile("s_waitcnt vmcnt(0)" ::: "memory"); }
    __syncthreads();
    { u32x4 actv[2];
#pragma unroll
      for (int i = 0; i < 2; ++i) { const int q = tid + NTHR * i, t = q >> 5, kp = q & 31;
          const u32x4 cw = *(const LAS u32x4*)(IMG + (t + 1) * PZ + (1536 + 8 * kp) * 2), pw = *(const LAS u32x4*)(IMG + t * PZ + (1536 + 8 * kp) * 2);
          const f32x4 m0v = *(const f32x4*)(mu + 1536 + 8 * kp), m1v = *(const f32x4*)(mu + 1536 + 8 * kp + 4);
          const unsigned cwa[4] = {cw.x, cw.y, cw.z, cw.w}, pwa[4] = {pw.x, pw.y, pw.z, pw.w}; float x[8];
#pragma unroll
          for (int j = 0; j < 4; ++j) { const float c0 = bf_lo(cwa[j]), c1 = bf_hi(cwa[j]), p0 = bf_lo(pwa[j]), p1 = bf_hi(pwa[j]);
              const float mu0 = j < 2 ? m0v[2 * j] : m1v[2 * j - 4], mu1 = j < 2 ? m0v[2 * j + 1] : m1v[2 * j - 3];
              x[2 * j] = c0 + mu0 * (p0 - c0); x[2 * j + 1] = c1 + mu1 * (p1 - c1); }
#pragma unroll
          for (int j = 0; j < 8; ++j) { if (kp < 8) { const float e2 = ex2(2.885390081777927f * x[j]); x[j] = 1.0f - 2.0f * __builtin_amdgcn_rcpf(e2 + 1.0f); } else if (kp >= 16) x[j] = fast_sigmoid(x[j]); }
          actv[i] = (u32x4){cvtpk(x[0], x[1]), cvtpk(x[2], x[3]), cvtpk(x[4], x[5]), cvtpk(x[6], x[7])}; }
      __syncthreads();
#pragma unroll
      for (int i = 0; i < 2; ++i) { const int q = tid + NTHR * i, t = q >> 5, kp = q & 31; *(LAS u32x4*)(IMG + (t + 1) * PZ + (1536 + 8 * kp) * 2) = actv[i]; }
      __syncthreads(); }
    const int hd = F.wave; int r = tid & 31, h = (tid >> 5) & 1;
    const LAS unsigned char* rowc = IMG + (r + 1) * PZ; const LAS unsigned char* rowp = IMG + r * PZ;
    const bf16_t* DUt = (const bf16_t*)(F.ws + WS_DUT) + (size_t)hd * 4096; const bf16_t* IUt = (const bf16_t*)(F.ws + WS_IUT) + (size_t)hd * 4096;
    const LAS float* pra = (const LAS float*)(F.lds + LDS_PARA); const LAS float* prb = (const LAS float*)(F.lds + LDS_PARB);
    float n2 = 0.f;
#pragma unroll
    for (int jt = 0; jt < 2; ++jt)
#pragma unroll
        for (int g = 0; g < 4; ++g) { const int cj = hd * 64 + 32 * jt + 8 * g + 4 * h;
            const u32x2 a = *(const LAS u32x2*)(rowc + (512 + cj) * 2), p = *(const LAS u32x2*)(rowp + (512 + cj) * 2);
            const float kc[4] = {bf_lo(a.x), bf_hi(a.x), bf_lo(a.y), bf_hi(a.y)}, kq[4] = {bf_lo(p.x), bf_hi(p.x), bf_lo(p.y), bf_hi(p.y)};
            #pragma unroll
            for (int q = 0; q < 4; ++q) { const float muk = pra[(cj + q) * 4 + 1], kkp = prb[(cj + q) * 4 + 1]; const float k_ = kc[q] + muk * (kq[q] - kc[q]); const float kk_ = k_ * kkp; n2 += kk_ * kk_; } }
    n2 += __shfl_xor(n2, 32);
    const float inv = 1.0f / __builtin_fmaxf(sqrtf(n2), 1e-12f);
    float pcd[2] = {0.f, 0.f};
    float bns = 0.f;
    const ElemCtx EC{rowc, rowp, DUt, IUt, pra, prb, hd, r, h, inv};
    f32x16 Aab = f32x16{}, Aak = f32x16{}, Arb = f32x16{}, Ark = f32x16{};
    bf16x8 fRt[2][2], tAt[2][2];
    { bf16x8 fId[2]; mk_id(fId, r, h);
#pragma unroll
    for (int jt = 0; jt < 2; ++jt) { bf16x8 fA[2], fB[2], fK[2]; float pd_ = 0.f;
        r1_elem<0>(EC, jt, fA, fRt[jt], fB, fK, bns, pd_);
        const bf16x8 fA0 = fA[0], fA1 = fA[1], fB0 = fB[0], fB1 = fB[1], fK0 = fK[0], fK1 = fK[1];
        Aab = RK_MF(fB0, fA0, Aab); Aab = RK_MF(fB1, fA1, Aab); Aak = RK_MF(fK0, fA0, Aak); Aak = RK_MF(fK1, fA1, Aak);
        Arb = RK_MF(fB0, fRt[jt][0], Arb); Arb = RK_MF(fB1, fRt[jt][1], Arb); Ark = RK_MF(fK0, fRt[jt][0], Ark); Ark = RK_MF(fK1, fRt[jt][1], Ark);
        { f32x16 t_ = f32x16{}; t_ = RK_MF(fA0, fId[0], t_); t_ = RK_MF(fA1, fId[1], t_); tAt[jt][0] = frag<0>(t_); tAt[jt][1] = frag<1>(t_); } } }
    bns += __shfl_xor(bns, 32);
    if (h == 0) ((float*)(F.ws + WS_TOPW))[(m0 + r) * 8 + hd] = bns;
    LAS unsigned char* stash = IMG + (1 + ((tid & 63) >> 3)) * PZ + hd * 128 + (tid & 7) * 16;
#pragma unroll
    for (int p = 0; p < 4; ++p) *(LAS u32x4*)(stash + 8 * p * PZ) = __builtin_bit_cast(u32x4, fRt[p >> 1][p & 1]);
#pragma unroll
    for (int i = 0; i < 16; ++i) { const int s = 8 * (i >> 2) + 4 * h + (i & 3);
        if (!(s < r)) { Aab[i] = 0.f; Aak[i] = 0.f; } if (!(s <= r)) { Arb[i] = 0.f; Ark[i] = 0.f; } }
    const bf16x8 fAak[2] = {frag<0>(Aak), frag<1>(Aak)}, fArb[2] = {frag<0>(Arb), frag<1>(Arb)}, fArk[2] = {frag<0>(Ark), frag<1>(Ark)};
    bf16x8 fT[2];
    asm volatile("" ::: "memory"); __builtin_amdgcn_sched_barrier(0);
    { float T[32];
#pragma unroll
      for (int s = 31; s >= 0; --s) { float acc = (r == s) ? 1.0f : 0.f; const int is = 4 * (s >> 3) + (s & 3), hs = (s >> 2) & 1;
          const float acol_ = Aab[is]; const int acol_i = __float_as_int(acol_);
#pragma unroll
          for (int u = s + 1; u < (PROBE_TINV_ID ? 0 : 32); ++u) { int sv_; asm volatile("v_readlane_b32 %0, %1, %2" : "=s"(sv_) : "v"(acol_i), "n"(u + 32 * hs)); acc = __builtin_fmaf(T[u], __int_as_float(sv_), acc); }
          T[s] = acc; __builtin_amdgcn_sched_barrier(0); }
#pragma unroll
      for (int s = 0; s < 2; ++s) { float e8[8];
#pragma unroll
          for (int jj = 0; jj < 8; ++jj) { const int i0 = 16 * s + 8 * (jj >> 2) + (jj & 3); float ta = T[i0], tb = T[i0 + 4]; asm volatile("" : "+v"(ta), "+v"(tb)); e8[jj] = h ? tb : ta; }
          fT[s] = __builtin_bit_cast(bf16x8, (u32x4){cvtpk(e8[0], e8[1]), cvtpk(e8[2], e8[3]), cvtpk(e8[4], e8[5]), cvtpk(e8[6], e8[7])}); } }
    asm volatile("" ::: "memory"); __builtin_amdgcn_sched_barrier(0);
    const size_t uid = ((size_t)(b * 8 + hd) * 128 + c);
    unsigned char* gG = F.ws + WS_R0 + uid * SZ_G; unsigned char* gH = F.ws + WS_R2 + uid * SZ_H; unsigned char* gQ = F.ws + WS_H0 + uid * SZ_Q; unsigned char* gY = F.ws + WS_H1 + uid * SZ_Y;
#define RK_ST(base, piece, f) (*(u32x4*)((base) + (piece) * 1024 + (tid & 63) * 16) = __builtin_bit_cast(u32x4, (f)))
    bf16x8 fWt[2][2];
#pragma unroll
    for (int jt = 0; jt < 2; ++jt) { f32x16 w_ = f32x16{}; w_ = RK_MF(fT[0], tAt[jt][0], w_); w_ = RK_MF(fT[1], tAt[jt][1], w_); fWt[jt][0] = frag<0>(w_); fWt[jt][1] = frag<1>(w_);
        f32x16 q_; unfrag<0>(q_, __builtin_bit_cast(bf16x8, *(const LAS u32x4*)(stash + 8 * (2 * jt) * PZ))); unfrag<1>(q_, __builtin_bit_cast(bf16x8, *(const LAS u32x4*)(stash + 8 * (2 * jt + 1) * PZ)));
        q_ = RK_MF(fWt[jt][0], fArb[0], q_); q_ = RK_MF(fWt[jt][1], fArb[1], q_); RK_ST(gQ, 2 * jt, frag<0>(q_)); RK_ST(gQ, 2 * jt + 1, frag<1>(q_)); }
    bf16x8 tBh[2][2], tKh[2][2], tV[2][2];
    { bf16x8 fId[2]; mk_id(fId, r, h);
#pragma unroll
    for (int jt = 0; jt < 2; ++jt) { bf16x8 fBh[2], fKh[2], fV[2], fdum[2]; float bdum = 0.f;
        r1_elem<1>(EC, jt, fBh, fKh, fV, fdum, bdum, pcd[jt]);
        { f32x16 t_ = f32x16{}; t_ = RK_MF(fBh[0], fId[0], t_); t_ = RK_MF(fBh[1], fId[1], t_); tBh[jt][0] = frag<0>(t_); tBh[jt][1] = frag<1>(t_); }
        { f32x16 t_ = f32x16{}; t_ = RK_MF(fKh[0], fId[0], t_); t_ = RK_MF(fKh[1], fId[1], t_); tKh[jt][0] = frag<0>(t_); tKh[jt][1] = frag<1>(t_); }
        { f32x16 t_ = f32x16{}; t_ = RK_MF(fV[0], fId[0], t_); t_ = RK_MF(fV[1], fId[1], t_); tV[jt][0] = frag<0>(t_); tV[jt][1] = frag<1>(t_); } } }
    bf16x8 fUt[2][2];
#pragma unroll
    for (int it = 0; it < 2; ++it) { f32x16 av = f32x16{}; av = RK_MF(fAak[0], tV[it][0], av); av = RK_MF(fAak[1], tV[it][1], av);
        const bf16x8 fav0 = frag<0>(av), fav1 = frag<1>(av); f32x16 u_ = f32x16{}; u_ = RK_MF(fT[0], fav0, u_); u_ = RK_MF(fT[1], fav1, u_); fUt[it][0] = frag<0>(u_); fUt[it][1] = frag<1>(u_); }
#pragma unroll
    for (int it = 0; it < 2; ++it) { f32x16 y_ = f32x16{}; y_ = RK_MF(fUt[it][0], fArb[0], y_); y_ = RK_MF(fUt[it][1], fArb[1], y_); y_ = RK_MF(tV[it][0], fArk[0], y_); y_ = RK_MF(tV[it][1], fArk[1], y_);
        RK_ST(gY, 2 * it, frag<0>(y_)); RK_ST(gY, 2 * it + 1, frag<1>(y_)); }
#pragma unroll
    for (int jt = 0; jt < 2; ++jt)
#pragma unroll
        for (int j2 = 0; j2 < 2; ++j2) { f32x16 g_ = f32x16{}; g_ = RK_MF(fWt[jt][0], tBh[j2][0], g_); g_ = RK_MF(fWt[jt][1], tBh[j2][1], g_);
            if (jt == j2) {
#pragma unroll
                for (int i = 0; i < 16; ++i) if (i == 4 * (r >> 3) + (r & 3) && h == ((r >> 2) & 1)) g_[i] += pcd[jt]; }
            RK_ST(gG, 2 * (jt * 2 + j2), frag<0>(g_)); RK_ST(gG, 2 * (jt * 2 + j2) + 1, frag<1>(g_)); }
#pragma unroll
    for (int j2 = 0; j2 < 2; ++j2)
#pragma unroll
        for (int it = 0; it < 2; ++it) { f32x16 h_ = f32x16{}; h_ = RK_MF(tBh[j2][0], fUt[it][0], h_); h_ = RK_MF(tBh[j2][1], fUt[it][1], h_); h_ = RK_MF(tKh[j2][0], tV[it][0], h_); h_ = RK_MF(tKh[j2][1], tV[it][1], h_);
            RK_ST(gH, 2 * (j2 * 2 + it), frag<0>(h_)); RK_ST(gH, 2 * (j2 * 2 + it) + 1, frag<1>(h_)); }
}

template <int DRY> __device__ __forceinline__ void r2_task(const Args& args, Frame& F, int task) {
    const bool st_ok = !DRY || args.li == 12345;
    const int bh = task >> 1, it = task & 1;
    f32x16 St[2]; St[0] = f32x16{}; St[1] = f32x16{};
    const unsigned char* gG0 = F.ws + WS_R0 + (size_t)bh * 128 * SZ_G + F.lane * 16; unsigned char* gH0 = F.ws + WS_R2 + (size_t)bh * 128 * SZ_H + F.lane * 16;
    bf16x8 G0[2][2][2], H0[2][2], G1[2][2][2], H1[2][2], G2[2][2][2], H2[2][2];
#define R2_LOAD(G_, H_, c_) do { const int cc_ = (c_) < 128 ? (c_) : 127;     \
        _Pragma("unroll") for (int jt = 0; jt < 2; ++jt) _Pragma("unroll") for (int j2 = 0; j2 < 2; ++j2) _Pragma("unroll") for (int s = 0; s < 2; ++s) \
            G_[jt][j2][s] = __builtin_bit_cast(bf16x8, *(const u32x4*)(gG0 + (size_t)cc_ * SZ_G + (2 * (jt * 2 + j2) + s) * 1024)); \
        _Pragma("unroll") for (int j2 = 0; j2 < 2; ++j2) _Pragma("unroll") for (int s = 0; s < 2; ++s) H_[j2][s] = __builtin_bit_cast(bf16x8, *(const u32x4*)(gH0 + (size_t)cc_ * SZ_H + (2 * (j2 * 2 + it) + s) * 1024)); } while (0)
#define R2_STEP(G_, H_, c_, LOADNEXT) do { \
        const bf16x8 fS[2][2] = {{frag<0>(St[0]), frag<1>(St[0])}, {frag<0>(St[1]), frag<1>(St[1])}}; \
        if (st_ok) { _Pragma("unroll") for (int jt = 0; jt < 2; ++jt) _Pragma("unroll") for (int s = 0; s < 2; ++s) \
            *(u32x4*)(gH0 + (size_t)(c_) * SZ_H + (2 * (jt * 2 + it) + s) * 1024) = __builtin_bit_cast(u32x4, fS[jt][s]); }     \
        __builtin_amdgcn_sched_barrier(0); LOADNEXT; __builtin_amdgcn_sched_barrier(0);     \
        _Pragma("unroll") for (int j2 = 0; j2 < 2; ++j2) { unfrag<0>(St[j2], H_[j2][0]); unfrag<1>(St[j2], H_[j2][1]); \
            _Pragma("unroll") for (int jt = 0; jt < 2; ++jt) { St[j2] = RK_MF(G_[jt][j2][0], fS[jt][0], St[j2]); St[j2] = RK_MF(G_[jt][j2][1], fS[jt][1], St[j2]); } } \
        __builtin_amdgcn_sched_barrier(0); \
    } while (0)
    R2_LOAD(G0, H0, 0); R2_LOAD(G1, H1, 1);
#pragma unroll 1
    for (int c = 0; c < 126; c += 3) {
        R2_STEP(G0, H0, c, R2_LOAD(G2, H2, c + 2));
        R2_STEP(G1, H1, c + 1, R2_LOAD(G0, H0, c + 3));
        R2_STEP(G2, H2, c + 2, R2_LOAD(G1, H1, c + 4));
    }
    R2_STEP(G0, H0, 126, (void)0);
    R2_STEP(G1, H1, 127, (void)0);
#undef R2_STEP
#undef R2_LOAD
}

constexpr int PV2 = 1296;
__device__ __forceinline__ void r3_unit(const Args& args, Frame& F, int b, int c) {
    LAS unsigned char* IMG = F.lds;
    const bf16_t* Z = (const bf16_t*)(F.ws + WS_Z);
    const int t0 = 32 * c; const size_t m0 = (size_t)b * SEQ + t0;
    const float* mu = AIN(7);
    int tid = F.tid; asm volatile("" : "+v"(tid));
    __syncthreads();
    { const unsigned lds0 = (unsigned)(uintptr_t)IMG; const int ln = tid & 63;
      for (int task = F.wave; task < 33 * 2; task += NWAVES) { const int rr = task >> 1, j = task & 1, pc = 64 * j + ln;
          if (pc < 80) { const int col = j == 0 ? ZR_V + 8 * ln : ZR_GD + 8 * ln;
              if (rr > 0 || t0 > 0) att::glds16(Z + (m0 + rr - 1) * ZW + col, (unsigned)__builtin_amdgcn_readfirstlane((int)(lds0 + rr * PV2 + 1024 * j)));
              else *(LAS u32x4*)(IMG + 16 * pc) = (u32x4){0u, 0u, 0u, 0u}; } }
      asm volatile("s_waitcnt vmcnt(0)" ::: "memory"); }
    __syncthreads();
    { const int t = tid >> 4, kp = tid & 15;
      const u32x4 cw = *(const LAS u32x4*)(IMG + (t + 1) * PV2 + 1024 + 16 * kp), pw = *(const LAS u32x4*)(IMG + t * PV2 + 1024 + 16 * kp);
      const f32x4 m0v = *(const f32x4*)(mu + 1664 + 8 * kp), m1v = *(const f32x4*)(mu + 1664 + 8 * kp + 4);
      const unsigned cwa[4] = {cw.x, cw.y, cw.z, cw.w}, pwa[4] = {pw.x, pw.y, pw.z, pw.w}; float x[8];
#pragma unroll
      for (int j = 0; j < 4; ++j) { const float c0 = bf_lo(cwa[j]), c1 = bf_hi(cwa[j]), p0 = bf_lo(pwa[j]), p1 = bf_hi(pwa[j]);
          const float mu0 = j < 2 ? m0v[2 * j] : m1v[2 * j - 4], mu1 = j < 2 ? m0v[2 * j + 1] : m1v[2 * j - 3];
          x[2 * j] = fast_sigmoid(c0 + mu0 * (p0 - c0)); x[2 * j + 1] = fast_sigmoid(c1 + mu1 * (p1 - c1)); }
      const u32x4 o = {cvtpk(x[0], x[1]), cvtpk(x[2], x[3]), cvtpk(x[4], x[5]), cvtpk(x[6], x[7])};
      __syncthreads();
      *(LAS u32x4*)(IMG + (t + 1) * PV2 + 1024 + 16 * kp) = o;
      __syncthreads(); }
    const int hd = F.wave; int r = tid & 31, h = (tid >> 5) & 1;
    const LAS unsigned char* rowc = IMG + (r + 1) * PV2; const LAS unsigned char* rowp = IMG + r * PV2;
    const size_t uid = ((size_t)(b * 8 + hd) * 128 + c);
    const unsigned char* gS = F.ws + WS_R2 + uid * SZ_H; const unsigned char* gQ = F.ws + WS_H0 + uid * SZ_Q; const unsigned char* gY = F.ws + WS_H1 + uid * SZ_Y;
#define RK_LD(base, piece) __builtin_bit_cast(bf16x8, *(const u32x4*)((base) + (piece) * 1024 + (tid & 63) * 16))
    f32x16 gl[2]; gl[0] = f32x16{}; gl[1] = f32x16{};
    { const bf16_t* GUt = (const bf16_t*)(F.ws + WS_GUT) + (size_t)hd * 64 * 128;
#pragma unroll
      for (int ks = 0; ks < 8; ++ks) { const int k0 = 16 * ks + 8 * h; const bf16x8 bg = *(const LAS bf16x8*)(rowc + 1024 + k0 * 2);
#pragma unroll
          for (int it = 0; it < 2; ++it) { const bf16x8 fg = *(const bf16x8*)(GUt + (size_t)(32 * it + r) * 128 + k0); gl[it] = RK_MF(fg, bg, gl[it]); } } }
    f32x16 Y[2];
    { const bf16x8 fQ[2][2] = {{RK_LD(gQ, 0), RK_LD(gQ, 1)}, {RK_LD(gQ, 2), RK_LD(gQ, 3)}};
#pragma unroll
      for (int it = 0; it < 2; ++it) { unfrag<0>(Y[it], RK_LD(gY, 2 * it)); unfrag<1>(Y[it], RK_LD(gY, 2 * it + 1));
#pragma unroll
          for (int jt = 0; jt < 2; ++jt) { if (PROBE_NO_STATE) continue; Y[it] = RK_MF(RK_LD(gS, 2 * (jt * 2 + it)), fQ[jt][0], Y[it]); Y[it] = RK_MF(RK_LD(gS, 2 * (jt * 2 + it) + 1), fQ[jt][1], Y[it]); } } }
    float s1 = 0.f;
#pragma unroll
    for (int it = 0; it < 2; ++it)
#pragma unroll
        for (int i = 0; i < 16; ++i) s1 += Y[it][i];
    s1 += __shfl_xor(s1, 32); const float mean = s1 * (1.0f / 64.0f); float s2 = 0.f;
#pragma unroll
    for (int it = 0; it < 2; ++it)
#pragma unroll
        for (int i = 0; i < 16; ++i) { const float d = Y[it][i] - mean; s2 += d * d; }
    s2 += __shfl_xor(s2, 32); const float rstd = 1.0f / sqrtf(s2 * (1.0f / 64.0f) + GN_EPS);
    const float bn = ((const float*)(F.ws + WS_TOPW))[(m0 + r) * 8 + hd];
    LAS unsigned char* stg = F.lds + 49152 + F.wave * 4608;
#pragma unroll
    for (int it = 0; it < 2; ++it)
#pragma unroll
        for (int g = 0; g < 4; ++g) { const int cl = 32 * it + 8 * g + 4 * h, cj = hd * 64 + cl;
            const u32x2 a = *(const LAS u32x2*)(rowc + cj * 2), p = *(const LAS u32x2*)(rowp + cj * 2);
            const float vc[4] = {bf_lo(a.x), bf_hi(a.x), bf_lo(a.y), bf_hi(a.y)}, vq[4] = {bf_lo(p.x), bf_hi(p.x), bf_lo(p.y), bf_hi(p.y)};
            const f32x4 muv = *(const f32x4*)(mu + 1024 + cj), lg = *(const f32x4*)(AIN(16) + cj), lb = *(const f32x4*)(AIN(17) + cj);
            float o[4];
#pragma unroll
            for (int q = 0; q < 4; ++q) { const int i = 4 * g + q; const float v_ = vc[q] + muv[q] * (vq[q] - vc[q]);
                o[q] = ((Y[it][i] - mean) * rstd * lg[q] + lb[q] + bn * v_) * gl[it][i]; }
            *(LAS u32x2*)(stg + r * 144 + cl * 2) = (u32x2){cvtpk(o[0], o[1]), cvtpk(o[2], o[3])}; }
    asm volatile("s_waitcnt lgkmcnt(0)" ::: "memory");
    bf16_t* OUT = (bf16_t*)(F.ws + WS_R0) + m0 * 512 + hd * 64;
#pragma unroll
    for (int i = 0; i < 4; ++i) { const int row = i * 8 + ((tid & 63) >> 3), chn = tid & 7; const u32x4 v = *(const LAS u32x4*)(stg + row * 144 + chn * 16); *(u32x4*)(OUT + (size_t)row * 512 + chn * 8) = v; }
#undef RK_LD
#undef RK_ST
}
}
__device__ __forceinline__ void route_phase(const Args& args, Frame& F) {
    LAS unsigned* lcnt = (LAS unsigned*)(F.lds);
    if (F.tid < 128) lcnt[F.tid] = 0u;
    __syncthreads();
    const float* LG = (const float*)(F.ws + WS_LOGIT); int* TE = (int*)(F.ws + WS_TOPE); float* TW = (float*)(F.ws + WS_TOPW);
    const int lane = F.lane; const float bias = AIN(23)[lane];
    for (int tok = F.gw; tok < M; tok += F.NGW) {
        const float lg = LG[(size_t)tok * 64 + lane];
        const float s = 1.0f / (1.0f + expf(-lg));
        const float c = s + bias;
        const unsigned long long kc = ((unsigned long long)ord_key(c) << 6) | (unsigned)(63 - lane);
        int rk = 0;
#pragma unroll 1
        for (int d = 1; d < 8; ++d) { const unsigned long long o = __shfl_xor(kc, d); rk += (o > kc) ? 1 : 0; }
        float gs = rk < 2 ? c : 0.f;
        gs += __shfl_xor(gs, 1); gs += __shfl_xor(gs, 2); gs += __shfl_xor(gs, 4);
        const int grp = lane >> 3;
        const unsigned long long kg = ((unsigned long long)ord_key(gs) << 6) | (unsigned)(63 - grp);
        int grk = 0;
#pragma unroll 1
        for (int d = 1; d < 8; ++d) { const unsigned long long o = __shfl_xor(kg, 8 * d); grk += (o > kg) ? 1 : 0; }
        const unsigned long long km = grk < 4 ? kc : (unsigned long long)(63 - lane);
        int erk = 0;
#pragma unroll 1
        for (int d = 1; d < 64; ++d) { const unsigned long long o = __shfl_xor(km, d); erk += (o > km) ? 1 : 0; }
        const bool sel = erk < 8;
        const float ssum = wave_sum(sel ? s : 0.f);
        if (sel) { TE[(size_t)tok * 8 + erk] = lane; TW[(size_t)tok * 8 + erk] = s / ssum * 2.5f; atomicAdd((unsigned*)&lcnt[(tok >= M / 2 ? 64 : 0) + lane], 1u); }
    }
    __syncthreads();
    if (F.tid < 128 && lcnt[F.tid]) atomicAdd(F.ctl + CW_CNT + F.tid, lcnt[F.tid]);
    __syncthreads();
}

struct MoeTab { int ntiles0, ntiles; };
__device__ __forceinline__ MoeTab build_tiles(const Args& args, Frame& F) {
    LAS unsigned* tab = (LAS unsigned*)(F.lds + LDS_TILETAB);
    LAS unsigned* offs = tab + 2432; LAS unsigned* tpre = tab + 2560;
    if (F.tid == 0) { unsigned o = 0, tp = 0;
        for (int l = 0; l < 128; ++l) { const unsigned c = __hip_atomic_load(F.ctl + CW_CNT + l, RLX_AGENT); offs[l] = o; tpre[l] = tp; o += c; tp += (c + 255u) >> 8; }
        tpre[128] = tp; }
    __syncthreads();
    if (F.tid < 128) { const int l = F.tid; const unsigned c = __hip_atomic_load(F.ctl + CW_CNT + l, RLX_AGENT); const unsigned o = offs[l], t0 = tpre[l], nt = (c + 255u) >> 8;
        for (unsigned i = 0; i < nt; ++i) { const unsigned rows = (c - 256u * i) < 256u ? (c - 256u * i) : 256u; tab[2 * (t0 + i)] = (o + 256u * i) | ((unsigned)(l & 63) << 20); tab[2 * (t0 + i) + 1] = rows; } }
    __syncthreads();
    MoeTab r; r.ntiles0 = (int)tpre[64]; r.ntiles = (int)tpre[128]; return r;
}
__device__ __forceinline__ void scatter_phase(const Args& args, Frame& F) {
    LAS unsigned* tab = (LAS unsigned*)(F.lds + LDS_TILETAB); LAS unsigned* offs = tab + 2432;
    LAS unsigned* lcnt = (LAS unsigned*)(F.lds); LAS unsigned* lbase = lcnt + 128;
    const int* TE = (const int*)(F.ws + WS_TOPE); const float* TW = (const float*)(F.ws + WS_TOPW);
    int* ST = (int*)(F.ws + WS_STOK); float* SW = (float*)(F.ws + WS_SW);
    for (int blk = blockIdx.x; blk < M / 128; blk += F.G) {
        if (F.tid < 128) lcnt[F.tid] = 0u;
        __syncthreads();
        const int tok0 = blk * 128, hf = tok0 >= M / 2 ? 64 : 0;
        int lst[2]; unsigned rnk[2];
#pragma unroll
        for (int i = 0; i < 2; ++i) { const int p = F.tid + 512 * i; lst[i] = hf + TE[(size_t)tok0 * 8 + p]; rnk[i] = atomicAdd((unsigned*)&lcnt[lst[i]], 1u); }
        __syncthreads();
        if (F.tid < 128) lbase[F.tid] = lcnt[F.tid] ? atomicAdd(F.ctl + CW_CUR + F.tid, lcnt[F.tid]) : 0u;
        __syncthreads();
#pragma unroll
        for (int i = 0; i < 2; ++i) { const int p = F.tid + 512 * i; const unsigned pos = offs[lst[i]] + lbase[lst[i]] + rnk[i];
            ST[pos] = tok0 * 8 + p; SW[pos] = TW[(size_t)tok0 * 8 + p]; }
        __syncthreads();
    }
}

__device__ __forceinline__ void final_rows(const Args& args, Frame& F, int row_lo, int row_hi, int tokbase) {
    const unsigned char* SL = (const unsigned char*)(F.ws + WS_SLOT);
    const int cA = 256 * (F.lane >> 4) + 32 * ((F.lane >> 2) & 3) + 8 * (F.lane & 3), cB = cA + 128;
    for (int blk = F.gw; blk < (row_hi - row_lo) / 16; blk += F.NGW) {
        const int r0 = row_lo + blk * 16, b = r0 / SEQ;
        const float* g2 = (const float*)(F.ws + WS_MOD) + b * 6144 + 5120; const float* fgp = AIN(30);
        f32x4 gv[4], fg[4];
#pragma unroll
        for (int j = 0; j < 4; ++j) { const int c = (j < 2 ? cA : cB) + 4 * (j & 1); gv[j] = *(const f32x4*)(g2 + c) * (1.0f / SLOT_SCALE); fg[j] = *(const f32x4*)(fgp + c); }
        for (int r = 0; r < 16; ++r) { const size_t m = (size_t)(r0 + r);
            f32x4 acc[4];
#pragma unroll
            for (int j = 0; j < 4; ++j) acc[j] = (f32x4){0.f, 0.f, 0.f, 0.f};
            const unsigned char* sp = SL + (m - tokbase) * NSLOT * D + 16 * F.lane;
            u32x4 w[NSLOT];
#pragma unroll
            for (int k = 0; k < NSLOT; ++k) w[k] = *(const u32x4*)(sp + (size_t)k * D);
#pragma unroll
            for (int k = 0; k < NSLOT; ++k) { const unsigned ww[4] = {w[k].x, w[k].y, w[k].z, w[k].w};
#pragma unroll
                for (int j = 0; j < 4; ++j) { const f32x2 a = __builtin_amdgcn_cvt_pk_f32_fp8((int)ww[j], false), c = __builtin_amdgcn_cvt_pk_f32_fp8((int)ww[j], true); acc[j] += (f32x4){a.x, a.y, c.x, c.y}; } }
            float* xr = F.out + m * D; f32x4 v[4]; float s = 0.f;
#pragma unroll
            for (int j = 0; j < 4; ++j) { const int c = (j < 2 ? cA : cB) + 4 * (j & 1); v[j] = *(const f32x4*)(xr + c) + gv[j] * acc[j]; s += (v[j].x * v[j].x + v[j].y * v[j].y) + (v[j].z * v[j].z + v[j].w * v[j].w); }
            const float rstd = 1.0f / sqrtf(wave_sum(s) * (1.0f / D) + RMS_EPS);
#pragma unroll
            for (int j = 0; j < 4; ++j) { const int c = (j < 2 ? cA : cB) + 4 * (j & 1); *(f32x4*)(xr + c) = v[j] * rstd * fg[j]; }
        }
    }
}
constexpr int N_PHASES = 15;
#ifndef PROBE_ATT_SCALE
#define PROBE_ATT_SCALE 1.0f
#endif
#ifndef PROBE_IDX_REP
#define PROBE_IDX_REP 1
#endif
#ifndef R2_WGS
#define R2_WGS 32
#endif
#ifndef PROBE_P5_PART
#define PROBE_P5_PART 0
#endif
#ifndef PROBE_RW_SCALE
#define PROBE_RW_SCALE 1.0f
#endif

__global__ void __launch_bounds__(NTHR, 2) fwd_kernel(Args args) {
    extern __shared__ __attribute__((aligned(16))) unsigned char lds_raw[];
    Frame F;
    F.lds = (LAS unsigned char*)lds_raw;
    F.MISC = (volatile LAS unsigned*)(F.lds + MISC_OFF);
    F.tid = threadIdx.x; F.lane = F.tid & 63; F.wave = __builtin_amdgcn_readfirstlane(F.tid >> 6);
    F.G = gridDim.x; { const int bx = blockIdx.x; F.vcu = (F.G % 8 == 0) ? (bx % 8) * (F.G / 8) + bx / 8 : bx; }
    F.gw = blockIdx.x * NWAVES + F.wave; F.NGW = F.G * NWAVES;
    F.ws = args.ws; F.out = args.out; F.ctl = (unsigned*)(args.ws + WS_CTL);
    for (int u = F.tid; u < (LDS_BYTES - LDSCTL_OFF) / 4; u += NTHR) ((LAS unsigned*)(F.lds + LDSCTL_OFF))[u] = 0u;
    __syncthreads();
    if (F.tid == 0) {
#pragma unroll
        for (int i = 0; i < 31; ++i) *(LAS unsigned long long*)(F.lds + LDS_PTAB + 8 * i) = (unsigned long long)args.in[i];
        *(LAS unsigned long long*)(F.lds + LDS_PTAB + 8 * 31) = (unsigned long long)args.out; *(LAS unsigned long long*)(F.lds + LDS_PTAB + 8 * 32) = (unsigned long long)args.ws; }
    __syncthreads();
    XcdBarrier bar = xcd_barrier_post(F.ctl + CW_BAR + args.li * XCD_BAR_WORDS, F.MISC + 8);
    const int lo = args.ph_lo, hi = args.ph_hi;
#ifndef PHASE_MASK
#define PHASE_MASK 0xFFFFFFFFu
#endif
#define IN(k) ((((PHASE_MASK) >> (k)) & 1u) && lo <= (k) && (k) < hi)
#define PB() do { F.ws = (unsigned char*)ain_ptr(F.lds, 32); F.out = (float*)ain_ptr(F.lds, 31); F.ctl = (unsigned*)(F.ws + WS_CTL); \
        F.lane = (int)__builtin_amdgcn_mbcnt_hi(~0u, __builtin_amdgcn_mbcnt_lo(~0u, 0u)); F.tid = F.wave * 64 + F.lane; } while (0)
#define ZB ((bf16_t*)(F.ws + WS_Z))
#define GATES ((bf16_t*)F.out)
#define MOD ((const float*)(F.ws + WS_MOD))
#define SEAM(k) do { if (IN(k) && IN((k) + 1)) xcd_barrier(bar); } while (0)

    if (IN(0)) { PB(); p0_prologue(args, F); } SEAM(0);
    if (IN(1)) { PB(); norm_mod_rows(args, F, AIN(0), AIN(4), 0, 1024, nullptr, F.ws + WS_H0); } SEAM(1);
    if (IN(2)) { PB(); pg8::StaticOrder S; S.init(M, NIN, F.G, (int)blockIdx.x); pg8::DenseSrcT<1> G{F.ws + WS_H0, F.ws + WS_WIN, 1024};
        EpiInProj E{ZB, GATES}; pg8::gemm_phase<EpiInProj, pg8::StaticOrder, pg8::DenseSrcT<1>>(F.lds, 1024, S, G, E); } SEAM(2);
    if (IN(3)) { PB(); rk::load_params(args, F); for (int u = blockIdx.x; u < 1024; u += F.G) rk::r1_unit(args, F, u >> 7, u & 127); __syncthreads(); } SEAM(3);
    if (IN(4)) { PB();
#ifdef PROBE_R2_DRY
        if (blockIdx.x < R2_WGS && F.wave < 128 / R2_WGS) rk::r2_task<1>(args, F, blockIdx.x * (128 / R2_WGS) + F.wave);
#endif
        if (blockIdx.x < R2_WGS && F.wave < 128 / R2_WGS) rk::r2_task<0>(args, F, blockIdx.x * (128 / R2_WGS) + F.wave);
#pragma unroll 1
        for (int rep = 0; rep < PROBE_IDX_REP; ++rep)
        for (;;) {
            __syncthreads();
            if (F.tid == 0) F.MISC[12] = atomicAdd(F.ctl + CW_Q + rep, 1u);
            __syncthreads();
            const int u = (int)F.MISC[12];
            if (u >= 2048) break;
            indexer_unit(args, F, u & 7, (255 - (u >> 3)) * 16);
        } } SEAM(4);
    if (IN(5)) { PB(); if (!(PROBE_P5_PART == 2 && args.li == 1)) { for (int u = blockIdx.x; u < 1024; u += F.G) rk::r3_unit(args, F, u >> 7, u & 127); } __syncthreads();
        if (!(PROBE_P5_PART == 1 && args.li == 1)) for (int i = 0; i < 4; ++i) for (int uu = F.vcu; uu < 256; uu += F.G) { const int bh = uu >> 2, s = uu & 3; const int qb = (i == 0) ? s : (i == 1) ? 7 - s : (i == 2) ? 8 + s : 15 - s;
            att::attn_unit(args, F, bh >> 3, bh & 7, qb); } __syncthreads(); } SEAM(5);
    if (IN(6)) { PB(); pg8::StaticOrder S; S.init(M, D, F.G, (int)blockIdx.x);
        { pg8::DenseSrc G{F.ws + WS_R1, F.ws + WS_WA, 512}; EpiMerge<0> E{(bf16_t*)(F.ws + WS_R2), F.ws + WS_H0, GATES, PROBE_ATT_SCALE}; pg8::gemm_phase<EpiMerge<0>, pg8::StaticOrder, pg8::DenseSrc>(F.lds, 512, S, G, E); }
        { pg8::DenseSrc G{F.ws + WS_R0, F.ws + WS_WR, 512}; EpiMerge<1> E{(bf16_t*)(F.ws + WS_R2), F.ws + WS_H0, GATES, PROBE_RW_SCALE}; pg8::gemm_phase<EpiMerge<1>, pg8::StaticOrder, pg8::DenseSrc>(F.lds, 512, S, G, E); } } SEAM(6);
    if (IN(7)) { PB(); pg8::StaticOrder S; S.init(M, D, F.G, (int)blockIdx.x); pg8::DenseSrcT<1> G{F.ws + WS_H0, F.ws + WS_WO, 1024};
        EpiOutProj E{AIN(0), F.out, MOD}; pg8::gemm_phase<EpiOutProj, pg8::StaticOrder, pg8::DenseSrcT<1>>(F.lds, 1024, S, G, E); } SEAM(7);
    if (IN(8)) { PB(); norm_mod_rows(args, F, F.out, AIN(21), 3072, 4096, (bf16_t*)(F.ws + WS_H2), nullptr); convert_experts(args, F); } SEAM(8);
    if (IN(9)) { PB(); pg8::StaticOrder S; S.init(M, 256, F.G, (int)blockIdx.x); pg8::DenseSrc G{(const bf16_t*)(F.ws + WS_H2), (const bf16_t*)(F.ws + WS_WRT), 1024};
        EpiRouter E{(float*)(F.ws + WS_LOGIT)}; pg8::gemm_phase<EpiRouter, pg8::StaticOrder, pg8::DenseSrc>(F.lds, 1024, S, G, E); } SEAM(9);
    if (IN(10)) { PB(); route_phase(args, F); } SEAM(10);
    MoeTab mt{0, 0};
    if (lo <= 13 && hi > 13) { PB(); mt = build_tiles(args, F); scatter_phase(args, F); } else if (hi > 13) { PB(); mt = build_tiles(args, F); }
    SEAM(11);
    const LAS unsigned* tab = (const LAS unsigned*)(F.lds + LDS_TILETAB);
    if (IN(12)) { PB(); MoeSched1 S{tab, mt.ntiles, F.G, (int)blockIdx.x}; MoeSrc1 G{F.ws};
        EpiMoe1 E{F.ws}; pg8::gemm_phase<EpiMoe1, MoeSched1, MoeSrc1>(F.lds, 1024, S, G, E); } SEAM(12);
    if (IN(13)) { PB(); MoeSched2 S{tab, 0, mt.ntiles, 512, F.G, (int)blockIdx.x}; MoeSrc2 G{F.ws}; EpiMoe2 E{F.ws, F.out, 0};
        pg8::gemm_phase<EpiMoe2, MoeSched2, MoeSrc2>(F.lds, 256, S, G, E); } SEAM(13);
    if (IN(14)) { PB(); final_rows(args, F, 0, M, 0); }
#undef IN
#undef SEAM
#undef PB
}

extern "C" void kernel_launch(void* const* d_in, const int* in_sizes, int n_in, void* d_out, int out_size, void* d_ws, size_t ws_size, hipStream_t stream) {
    static int grid = 0;
    if (grid == 0) {
        if (n_in != 31 || out_size != M * D || ws_size < WS_END) { fprintf(stderr, "kernel_launch: unexpected problem (n_in %d, out %d, ws %zu)\n", n_in, out_size, ws_size); grid = -1; return; }
        int dev = 0, cus = 0, per_cu = 0;
        if (hipGetDevice(&dev) != hipSuccess || hipDeviceGetAttribute(&cus, hipDeviceAttributeMultiprocessorCount, dev) != hipSuccess) { grid = -1; return; }
        if (hipFuncSetAttribute((const void*)fwd_kernel, hipFuncAttributeMaxDynamicSharedMemorySize, LDS_BYTES) != hipSuccess) { fprintf(stderr, "kernel_launch: hipFuncSetAttribute failed\n"); grid = -1; return; }
        if (hipOccupancyMaxActiveBlocksPerMultiprocessor(&per_cu, (const void*)fwd_kernel, NTHR, LDS_BYTES) != hipSuccess || per_cu < 1) fprintf(stderr, "kernel_launch: occupancy query reports %d\n", per_cu);
        (void)hipGetLastError();
        grid = cus;
        if (grid != 256) fprintf(stderr, "kernel_launch: %d CUs (built for 256)\n", grid);
    }
    if (grid < 0) return;
    (void)in_sizes;
    if (hipMemsetAsync((char*)d_ws + WS_CTL, 0, CTL_ZERO_BYTES, stream) != hipSuccess) return;
    Args a{};
    for (int i = 0; i < 31; ++i) a.in[i] = (const float*)d_in[i];
    a.out = (float*)d_out; a.ws = (unsigned char*)d_ws;
#ifndef PROBE_REPEAT
#define PROBE_REPEAT -1
#endif
    int li = 0;
    auto go = [&](int lo_, int hi_) { a.ph_lo = lo_; a.ph_hi = hi_; a.li = li++; hipLaunchKernelGGL(fwd_kernel, dim3(grid), dim3(NTHR), LDS_BYTES, stream, a); };
    if (PROBE_REPEAT < 0) go(0, N_PHASES);
    else { go(0, PROBE_REPEAT + 1); go(PROBE_REPEAT, PROBE_REPEAT + 1); if (PROBE_REPEAT + 1 < N_PHASES) go(PROBE_REPEAT + 1, N_PHASES); }
}
```

```cpp
#include <hip/hip_runtime.h>
#include <cstdio>
#include <cstdint>
#include <cmath>

#define GAS __attribute__((address_space(1)))
#define LAS __attribute__((address_space(3)))
typedef unsigned short bf16_t;
typedef short bf16x8 __attribute__((ext_vector_type(8)));
typedef float f32x4 __attribute__((ext_vector_type(4)));
typedef float f32x2 __attribute__((ext_vector_type(2)));
typedef float f32x16 __attribute__((ext_vector_type(16)));
typedef unsigned u32x4 __attribute__((ext_vector_type(4)));
typedef unsigned u32x2 __attribute__((ext_vector_type(2)));
typedef GAS unsigned gu32;

__device__ __forceinline__ unsigned cvt_pk_bf16(float lo, float hi) { unsigned r; asm volatile("v_cvt_pk_bf16_f32 %0, %1, %2" : "=v"(r) : "v"(lo), "v"(hi)); return r; }
__device__ __forceinline__ float bf_lo(unsigned w) { return __uint_as_float(w << 16); }
__device__ __forceinline__ float bf_hi(unsigned w) { return __uint_as_float(w & 0xffff0000u); }
__device__ __forceinline__ float bf2f(bf16_t b) { return __uint_as_float(((unsigned)b) << 16); }
__device__ __forceinline__ unsigned f2bf(float f) { unsigned u = __float_as_uint(f); return (u + 0x7fffu + ((u >> 16) & 1u)) >> 16; }
__device__ __forceinline__ unsigned pk2(float lo, float hi) { return f2bf(lo) | (f2bf(hi) << 16); }
__device__ __forceinline__ float fast_sigmoid(float x) { return __builtin_amdgcn_rcpf(1.0f + __builtin_amdgcn_exp2f(-1.4426950408889634f * x)); }
__device__ __forceinline__ float wave_sum(float v) {
#pragma unroll
    for (int o = 1; o < 64; o <<= 1) v += __shfl_xor(v, o);
    return v;
}

namespace pg8 {
constexpr int BM = 256, BK = 64, HALF = 128, HTB = HALF * BK * 2, STAGE_BYTES = 8 * HTB, NXCD = 8, WGM = 8;
__host__ __device__ __forceinline__ int lds_byte(int r, int c) { const int st = (r >> 4) * 2 + (c >> 5), rr = r & 15, cc = c & 31, ob = rr * 64 + cc * 2; return st * 1024 + (ob ^ (((ob >> 9) & 1) << 5)); }
__host__ __device__ __forceinline__ void stage_rc(int b, int& R, int& C) { const int st = b / 1024, sb = b % 1024, swz = sb ^ (((sb >> 9) & 1) << 5); R = (st >> 1) * 16 + swz / 64; C = (st & 1) * 32 + (swz % 64) / 2; }
__host__ __device__ __forceinline__ int perm32(int rho) { const int n = rho >> 4, i = rho & 15; return 8 * (i >> 2) + 4 * n + (i & 3); }

struct Unit { int pm, pn; int aux0, aux1; };

struct StaticOrder {
    int nM, nN, nwg, G, c;
    __host__ __device__ void init(int M, int N, int G_, int c_) { nM = M / BM; nN = N / BM; nwg = nM * nN; G = G_; c = c_; }
    __host__ __device__ bool next(int i, Unit& u) const {
        const long L = (long)i * G + c; if (L >= nwg) return false;
        int wgid = (int)L; { const int q = nwg / NXCD, r = nwg % NXCD, xcd = wgid % NXCD, off = wgid / NXCD; wgid = (xcd < r ? xcd * (q + 1) : r * (q + 1) + (xcd - r) * q) + off; }
        const int nig = WGM * nN, gid = wgid / nig, fm = gid * WGM, gsz = (nM - fm) < WGM ? (nM - fm) : WGM;
        u.pm = fm + ((wgid % nig) % gsz); u.pn = (wgid % nig) / gsz; u.aux0 = 0; u.aux1 = 0; return true;
    }
};

template <int ESZ_> struct DenseSrcT {
    static constexpr int ESZ = ESZ_; static constexpr bool GATHER = false;
    const void* A; const void* Bt; int K;
    __device__ __forceinline__ const char* b_base(const Unit& u) const { return (const char*)Bt + (size_t)u.pn * 256 * K * ESZ; }
    __device__ __forceinline__ const char* a_base(const Unit& u) const { return (const char*)A + (size_t)u.pm * 256 * K * ESZ; }
    __device__ __forceinline__ unsigned a_off(const Unit&, int R, int C) const { return (unsigned)(R * K * ESZ) + (unsigned)C * 2u; }
};
typedef DenseSrcT<2> DenseSrc;
typedef int v8i32 __attribute__((ext_vector_type(8)));

template <class Epi, class Sched, class Src, bool ALIGN_EPI = true>
__device__ __forceinline__ void gemm_phase(LAS unsigned char* lds, const int K, const Sched& S, const Src& G, const Epi& E) {
    const int tid = threadIdx.x, wid = __builtin_amdgcn_readfirstlane(tid >> 6), lane = tid & 63, wr = wid >> 2, wc = wid & 3, fr = lane & 15, fq = lane >> 4;
    constexpr int ESZ = Src::ESZ; const int Kb = K * ESZ;
    const int nt = Kb / (BK * 2);
    unsigned voffB0;
    { int R, C; stage_rc(tid * 16, R, C); const int Rb = Epi::PERM ? ((R & ~31) + perm32(R & 31)) : R; voffB0 = (unsigned)(Rb * Kb) + (unsigned)C * 2u; }
#define PG8_AOFF(u, h, i) ([&]() { int R_, C_; stage_rc(tid * 16 + (i) * 8192, R_, C_); return G.a_off((u), R_ + (h) * HALF, C_); }())
    const size_t kstep = (size_t)(BK * 2);
    const size_t hstepB = (size_t)HALF * Kb;
    const unsigned ldsw = (unsigned)wid * 1024u;
    const int aoff = lds_byte(wr * 64 + fr, fq * 8), boff = lds_byte(wc * 32 + fr, fq * 8);
#define PG8_SA(b, h) (((b) * 2 + (h)) * HTB)
#define PG8_SB(b, h) ((4 + (b) * 2 + (h)) * HTB)
#define PG8_STAGEB(bufoff, gbase) do { _Pragma("unroll") for (int _i = 0; _i < 2; ++_i) { unsigned o_ = voffB0; asm volatile("" : "+v"(o_)); \
        __builtin_amdgcn_global_load_lds((const unsigned*)((const char*)(gbase) + (size_t)_i * 64 * Kb + o_), (LAS unsigned*)(lds + (bufoff) + ldsw + _i * 8192), 16, 0, 0); } } while (0)
#define PG8_STAGEA(bufoff, gbase, vo, h) do { _Pragma("unroll") for (int _i = 0; _i < 2; ++_i) { unsigned o_ = Src::GATHER ? (vo)[h][_i] : (vo)[0][0]; asm volatile("" : "+v"(o_)); \
        __builtin_amdgcn_global_load_lds((const unsigned*)((const char*)(gbase) + (Src::GATHER ? (size_t)0 : (size_t)((h) * 128 + _i * 64) * Kb) + o_), (LAS unsigned*)(lds + (bufoff) + ldsw + _i * 8192), 16, 0, 0); } } while (0)
#define PG8_STAGEA2(bufoff, gbase, h) do { _Pragma("unroll") for (int _i = 0; _i < 2; ++_i) { unsigned o_ = Src::GATHER ? (last ? vn[h][_i] : vc[h][_i]) : vc[0][0]; asm volatile("" : "+v"(o_)); \
        __builtin_amdgcn_global_load_lds((const unsigned*)((const char*)(gbase) + (Src::GATHER ? (size_t)0 : (size_t)((h) * 128 + _i * 64) * Kb) + o_), (LAS unsigned*)(lds + (bufoff) + ldsw + _i * 8192), 16, 0, 0); } } while (0)
#define PG8_LDA(dst, b, h) do { _Pragma("unroll") for (int m = 0; m < 4; ++m) { const u32x4 lo_ = *(const LAS u32x4*)(lds + PG8_SA(b, h) + aoff + m * 2048), hi_ = *(const LAS u32x4*)(lds + PG8_SA(b, h) + aoff + m * 2048 + 1024); \
        dst[m] = __builtin_shufflevector(lo_, hi_, 0, 1, 2, 3, 4, 5, 6, 7); } } while (0)
#define PG8_LDB(dst, b, h) do { _Pragma("unroll") for (int n = 0; n < 2; ++n) { const u32x4 lo_ = *(const LAS u32x4*)(lds + PG8_SB(b, h) + boff + n * 2048), hi_ = *(const LAS u32x4*)(lds + PG8_SB(b, h) + boff + n * 2048 + 1024); \
        dst[n] = __builtin_shufflevector(lo_, hi_, 0, 1, 2, 3, 4, 5, 6, 7); } } while (0)
#define PG8_LO(x) __builtin_bit_cast(bf16x8, __builtin_shufflevector((x), (x), 0, 1, 2, 3))
#define PG8_HI(x) __builtin_bit_cast(bf16x8, __builtin_shufflevector((x), (x), 4, 5, 6, 7))
#define PG8_MMA(ai, bj, At, Bt) do { __builtin_amdgcn_s_setprio(1); _Pragma("unroll") for (int m = 0; m < 4; ++m) _Pragma("unroll") for (int n = 0; n < 2; ++n) { \
        if constexpr (ESZ == 1) acc[ai][bj][m][n] = __builtin_amdgcn_mfma_scale_f32_16x16x128_f8f6f4(__builtin_bit_cast(v8i32, Bt[n]), __builtin_bit_cast(v8i32, At[m]), acc[ai][bj][m][n], 0, 0, 0, 0, 0, 0); \
        else { acc[ai][bj][m][n] = __builtin_amdgcn_mfma_f32_16x16x32_bf16(PG8_LO(Bt[n]), PG8_LO(At[m]), acc[ai][bj][m][n], 0, 0, 0); \
               acc[ai][bj][m][n] = __builtin_amdgcn_mfma_f32_16x16x32_bf16(PG8_HI(Bt[n]), PG8_HI(At[m]), acc[ai][bj][m][n], 0, 0, 0); } } \
        __builtin_amdgcn_s_setprio(0); } while (0)
#define PG8_WAIT_V(n) asm volatile("s_waitcnt vmcnt(" #n ")" ::: "memory")
#define PG8_WAIT_L(n) asm volatile("s_waitcnt lgkmcnt(" #n ")" ::: "memory")
#define PG8_BAR __builtin_amdgcn_s_barrier()
#define PG8_SCHED __builtin_amdgcn_sched_barrier(0)
    Unit cur, nxt; int ui = 0;
    if (!S.next(0, cur)) return;
    f32x4 acc[2][2][4][2];
#pragma unroll
    for (int a = 0; a < 2; ++a)
#pragma unroll
        for (int b = 0; b < 2; ++b)
#pragma unroll
            for (int m = 0; m < 4; ++m)
#pragma unroll
                for (int n = 0; n < 2; ++n) acc[a][b][m][n] = (f32x4){0.f, 0.f, 0.f, 0.f};
    typedef unsigned u32x8 __attribute__((ext_vector_type(8)));
    u32x8 At[4], B0[2], B1[2];
    unsigned vc[2][2], vn[2][2];
#pragma unroll
    for (int h = 0; h < 2; ++h)
#pragma unroll
        for (int i = 0; i < 2; ++i) vc[h][i] = PG8_AOFF(cur, h, i);
    const char* cA = G.a_base(cur); const char* cB = G.b_base(cur);
    PG8_STAGEB(PG8_SB(0, 0), cB); PG8_STAGEB(PG8_SB(0, 1), cB + hstepB); PG8_STAGEA(PG8_SA(0, 0), cA, vc, 0); PG8_STAGEA(PG8_SA(0, 1), cA, vc, 1);
    if (wr == 1) PG8_BAR;
    PG8_WAIT_V(2); PG8_BAR;
    PG8_STAGEB(PG8_SB(1, 0), cB + kstep); PG8_STAGEA(PG8_SA(1, 0), cA + kstep, vc, 0); PG8_STAGEB(PG8_SB(1, 1), cB + hstepB + kstep);
    PG8_WAIT_V(6); PG8_BAR;
    for (;;) {
        const bool has_next = S.next(ui + 1, nxt);
        const char* nA = has_next ? G.a_base(nxt) : cA; const char* nB = has_next ? G.b_base(nxt) : cB;
        if constexpr (Src::GATHER) {
#pragma unroll
        for (int h = 0; h < 2; ++h)
#pragma unroll
            for (int i = 0; i < 2; ++i) vn[h][i] = has_next ? PG8_AOFF(nxt, h, i) : vc[h][i]; }
#pragma clang loop unroll(disable)
        for (int t = 0; t < nt; t += 2) {
            const bool last = (t == nt - 2);
            const char* a1 = cA + (size_t)(t + 1) * kstep;
            const char* a2 = last ? nA : cA + (size_t)(t + 2) * kstep; const char* b2 = last ? nB : cB + (size_t)(t + 2) * kstep;
            const char* a3 = a2 + kstep; const char* b3 = b2 + kstep;
            PG8_LDB(B0, 0, 0); PG8_LDB(B1, 0, 1); PG8_SCHED; PG8_LDA(At, 0, 0); PG8_STAGEA(PG8_SA(1, 1), a1, vc, 1);
            PG8_WAIT_V(8); PG8_WAIT_L(0); PG8_BAR; PG8_MMA(0, 0, At, B0); PG8_MMA(0, 1, At, B1); PG8_BAR; PG8_SCHED;
            PG8_LDA(At, 0, 1); PG8_STAGEB(PG8_SB(0, 0), b2); PG8_STAGEB(PG8_SB(0, 1), b2 + hstepB); PG8_STAGEA2(PG8_SA(0, 0), a2, 0);
            PG8_WAIT_V(8); PG8_WAIT_L(0); PG8_BAR; PG8_MMA(1, 0, At, B0); PG8_MMA(1, 1, At, B1); PG8_BAR; PG8_SCHED;
            PG8_LDB(B0, 1, 0); PG8_LDB(B1, 1, 1); PG8_SCHED; PG8_LDA(At, 1, 0); PG8_STAGEA2(PG8_SA(0, 1), a2, 1);
            PG8_WAIT_V(8); PG8_WAIT_L(0); PG8_BAR; PG8_MMA(0, 0, At, B0); PG8_MMA(0, 1, At, B1); PG8_BAR; PG8_SCHED;
            PG8_LDA(At, 1, 1); PG8_STAGEB(PG8_SB(1, 0), b3); PG8_STAGEB(PG8_SB(1, 1), b3 + hstepB); PG8_STAGEA2(PG8_SA(1, 0), a3, 0);
            PG8_WAIT_V(8); PG8_WAIT_L(0); PG8_BAR; PG8_MMA(1, 0, At, B0); PG8_MMA(1, 1, At, B1); PG8_BAR; PG8_SCHED;
        }
        if constexpr (ALIGN_EPI) { if (wr == 0) PG8_BAR; }
        { int ln_; asm volatile("v_mbcnt_lo_u32_b32 %0, -1, 0\n\tv_mbcnt_hi_u32_b32 %0, -1, %0" : "=v"(ln_)); E(acc, cur, wr, wc, ln_ & 15, ln_ >> 4); }
        if (!has_next) break;
#pragma unroll
        for (int a = 0; a < 2; ++a)
#pragma unroll
            for (int b = 0; b < 2; ++b)
#pragma unroll
                for (int m = 0; m < 4; ++m)
#pragma unroll
                    for (int n = 0; n < 2; ++n) acc[a][b][m][n] = (f32x4){0.f, 0.f, 0.f, 0.f};
        cur = nxt; cA = nA; cB = nB; ++ui;
        if constexpr (Src::GATHER) {
#pragma unroll
        for (int h = 0; h < 2; ++h)
#pragma unroll
            for (int i = 0; i < 2; ++i) vc[h][i] = vn[h][i]; }
        if constexpr (ALIGN_EPI) { if (wr == 1) PG8_BAR; }
    }
    PG8_WAIT_V(0);
    if constexpr (!ALIGN_EPI) { if (wr == 0) PG8_BAR; }
    PG8_BAR;
#undef PG8_SA
#undef PG8_AOFF
#undef PG8_SB
#undef PG8_STAGEA
#undef PG8_STAGEA2
#undef PG8_STAGEB
#undef PG8_LDA
#undef PG8_LDB
#undef PG8_MMA
#undef PG8_LO
#undef PG8_HI
#undef PG8_WAIT_V
#undef PG8_WAIT_L
#undef PG8_BAR
#undef PG8_SCHED
}
}
#define RLX_AGENT __ATOMIC_RELAXED, __HIP_MEMORY_SCOPE_AGENT
#define LDS_WAIT() asm volatile("s_waitcnt lgkmcnt(0)" ::: "memory")
#define VM_WAIT() asm volatile("s_waitcnt vmcnt(0)" ::: "memory")
#define XB_TMO      128
#define XB_XCNT(j)  (256  + 64 * (j))
#define XB_XSUB(j)  (1280 + 64 * (j))
#define XB_XGEN(j)  (2304 + 64 * (j))
#define XB_TOP      3328
#define XB_TOPGEN   3392
#define XCD_BAR_WORDS 3456
#define XB_SPIN_CAP (1u << 18)

__device__ __forceinline__ unsigned xb_ld(unsigned* p)              { return __hip_atomic_load(p, __ATOMIC_RELAXED, __HIP_MEMORY_SCOPE_AGENT); }
__device__ __forceinline__ unsigned xb_add(unsigned* p, unsigned v) { return __hip_atomic_fetch_add(p, v, __ATOMIC_RELAXED, __HIP_MEMORY_SCOPE_AGENT); }
__device__ __forceinline__ unsigned xb_xcc_id() { return (unsigned)__builtin_amdgcn_s_getreg((3 << 11) | 20) & 0xFu; }
#define XB_SPIN(cond, bar) do { unsigned _sp = 0; while (cond) { __builtin_amdgcn_s_sleep(1); \
    if ((++_sp & 255u) == 0u) { if (xb_ld(&(bar)[XB_TMO])) break; if (_sp > XB_SPIN_CAP) { atomicAdd(&(bar)[XB_TMO], 1u); break; } } } } while (0)

struct XcdBarrier {
    unsigned* bar; unsigned x;
    volatile LAS unsigned* st;
};

__device__ __forceinline__ XcdBarrier xcd_barrier_post(unsigned* bar, volatile LAS unsigned* st) {
    XcdBarrier b; b.bar = bar; b.x = xb_xcc_id(); b.st = st;
    if (threadIdx.x == 0) (void)xb_add(&bar[XB_XCNT(b.x)], 1u);
    return b;
}
__device__ __forceinline__ void xcd_barrier_complete(unsigned* bar, unsigned x, unsigned& nloc, unsigned& nx) {
    const unsigned G = gridDim.x * gridDim.y * gridDim.z;
    unsigned sum, cnt, mine, sp = 0u;
    for (;;) {
        sum = 0u; cnt = 0u; mine = 0u;
#pragma unroll
        for (unsigned j = 0; j < 16; ++j) { const unsigned c = xb_ld(&bar[XB_XCNT(j)]); sum += c; cnt += (c > 0u) ? 1u : 0u; mine = (j == x) ? c : mine; }
        if (sum == G) break;
        __builtin_amdgcn_s_sleep(1);
        if ((++sp & 255u) == 0u) { if (xb_ld(&bar[XB_TMO])) break; if (sp > XB_SPIN_CAP) { atomicAdd(&bar[XB_TMO], 1u); break; } }
    }
    nloc = mine > 0u ? mine : 1u; nx = cnt > 0u ? cnt : 1u;
}

__device__ __forceinline__ void xcd_barrier(const XcdBarrier& b) {
    asm volatile("s_waitcnt vmcnt(0)" ::: "memory");
    __syncthreads();
    if (threadIdx.x == 0) {
        unsigned* bar = b.bar;
        __builtin_amdgcn_s_waitcnt(0);
        unsigned nloc = b.st[0], nx = b.st[1];
        if (nloc == 0u) { xcd_barrier_complete(bar, b.x, nloc, nx); b.st[0] = nloc; b.st[1] = nx; }
        const unsigned old = xb_add(&bar[XB_XSUB(b.x)], 1u);
        const unsigned gen = old / nloc;
        if (old + 1u == (gen + 1u) * nloc) {
            __builtin_amdgcn_fence(__ATOMIC_RELEASE, "agent");
            asm volatile("s_waitcnt vmcnt(0)" ::: "memory");
            const unsigned og = xb_add(&bar[XB_TOP], 1u);
            const unsigned tg = og / nx;
            if (og + 1u == (tg + 1u) * nx) xb_add(&bar[XB_TOPGEN], 1u);
            else XB_SPIN(xb_ld(&bar[XB_TOPGEN]) == tg, bar);
            __builtin_amdgcn_fence(__ATOMIC_ACQUIRE, "agent");
            xb_add(&bar[XB_XGEN(b.x)], 1u);
            asm volatile("s_waitcnt vmcnt(0)" ::: "memory");
        } else {
            XB_SPIN(xb_ld(&bar[XB_XGEN(b.x)]) == gen, bar);
            __builtin_amdgcn_fence(__ATOMIC_ACQUIRE, "agent");
            asm volatile("s_waitcnt vmcnt(0)" ::: "memory");
        }
    }
    __syncthreads();
}
constexpr int NB = 8, SEQ = 4096, D = 1024, M = NB * SEQ;
constexpr int NIN_SRC = 5936, NIN = 6144;
constexpr int ZW = 4096;
constexpr int ZQ = 0, ZK = 512, ZV = 1024, ZIQ = 1536, ZIK = 2048, ZIW = 2080, ZR = 2304;
constexpr int ZR_R = ZR, ZR_K = ZR + 512, ZR_V = ZR + 1024, ZR_WD = ZR + 1536, ZR_AD = ZR + 1600, ZR_GD = ZR + 1664;
constexpr int GW = 2048;
constexpr int NEXP = 64, FF = 256, TOPK = 8;
constexpr float RMS_EPS = 1e-6f, GN_EPS = 64e-5f;
constexpr float QSCALE = 0.125f * 1.4426950408889634f;
constexpr int NWAVES = 8, NTHR = 512;

constexpr size_t MiB = 1u << 20;
constexpr size_t WS_CTL = 0, CTL_ZERO_BYTES = 1 * MiB;
constexpr size_t WS_MOD = 1 * MiB;
constexpr size_t WS_DUT = 1 * MiB + 256 * 1024;
constexpr size_t WS_IUT = WS_DUT + 64 * 1024;
constexpr size_t WS_GUT = WS_IUT + 64 * 1024;
constexpr size_t WS_WIN = 2 * MiB;
constexpr size_t WS_WA = 14 * MiB, WS_WR = 15 * MiB;
constexpr size_t WS_WO = 16 * MiB;
constexpr size_t WS_WRT = 18 * MiB;
constexpr size_t WS_WSH1 = 19 * MiB;
constexpr size_t WS_WSH2 = 20 * MiB;
constexpr size_t WS_BRS = 21 * MiB, WS_KRS = 22 * MiB;
constexpr size_t WS_TOPE = 23 * MiB, WS_TOPW = 24 * MiB;
constexpr size_t WS_LOGIT = 25 * MiB;
constexpr size_t WS_Z = 36 * MiB;
constexpr size_t WS_H0 = 292 * MiB, WS_H1 = 324 * MiB;
constexpr size_t WS_SEL = 356 * MiB;
constexpr size_t WS_R0 = 372 * MiB, WS_R1 = 404 * MiB, WS_R2 = 436 * MiB, WS_R3 = 468 * MiB;
constexpr size_t WS_W2T = 36 * MiB;
constexpr size_t WS_ACT = 68 * MiB;
constexpr size_t WS_ACTS = 196 * MiB;
constexpr size_t WS_STOK = 212 * MiB, WS_SW = 213 * MiB;
constexpr size_t WS_W1T = 214 * MiB;
constexpr size_t WS_H2 = 278 * MiB;
constexpr size_t WS_SLOT = 214 * MiB;
constexpr size_t WS_END = 502 * MiB;
constexpr int CW_TMO = 0, CW_BAR = 4096, CW_CNT = 32768, CW_CUR = 32768 + 128, CW_Q = 32768 + 512;

constexpr int RING_BYTES = 131072;
constexpr int LDSCTL_OFF = RING_BYTES, MISC_OFF = LDSCTL_OFF + 320;
constexpr int LDS_TILETAB = RING_BYTES + 1024;
constexpr int LDS_PTAB = RING_BYTES + 512;
constexpr int LDS_PARA = 118800;
constexpr int LDS_PARB = LDS_TILETAB;
constexpr int LDS_BYTES = 147456;
#define AIN(i) ain_ptr(F.lds, (i))

struct Args { const float* in[31]; float* out; unsigned char* ws; int ph_lo, ph_hi, li, pad; };
struct Frame {
    LAS unsigned char* lds;
    volatile LAS unsigned* MISC;
    unsigned* ctl;
    int tid, lane, wave, vcu, G, gw, NGW;
    float* out; unsigned char* ws;
};

__device__ __forceinline__ const float* ain_ptr(LAS unsigned char* lds, int i) {
    const u32x2 w = *(const LAS u32x2*)(lds + LDS_PTAB + 8 * i);
    const unsigned lo = (unsigned)__builtin_amdgcn_readfirstlane((int)w.x), hi = (unsigned)__builtin_amdgcn_readfirstlane((int)w.y);
    return (const float*)(const GAS float*)(((unsigned long long)hi << 32) | lo);
}
struct TrSrc { const float* base; int nsrc; };
template <int FP8, class ColFn>
__device__ __forceinline__ void transpose_item(const ColFn& colfn, int K, bf16_t* WT, LAS float* scr, int kb, int nb, int lane) {
    const int k0 = 64 * kb, n0 = 32 * nb;
    const TrSrc s = colfn(n0 + (lane & 31));
    float v_[32];
#pragma unroll
    for (int i = 0; i < 32; ++i) { const int kk = 2 * i + (lane >> 5); v_[i] = s.base ? s.base[(size_t)(k0 + kk) * s.nsrc] : 0.f; }
#pragma unroll
    for (int i = 0; i < 32; ++i) { const int kk = 2 * i + (lane >> 5); scr[kk * 33 + (lane & 31)] = v_[i]; }
    LDS_WAIT(); asm volatile("" ::: "memory");
    const int c = lane & 7;
#pragma unroll
    for (int j = 0; j < 4; ++j) { const int n = (lane >> 3) + 8 * j; const LAS float* sp = scr + (8 * c) * 33 + n;
        if constexpr (FP8) { constexpr float S8 = 32.0f;
            int lo = __builtin_amdgcn_cvt_pk_fp8_f32(sp[0 * 33] * S8, sp[1 * 33] * S8, 0, false); lo = __builtin_amdgcn_cvt_pk_fp8_f32(sp[2 * 33] * S8, sp[3 * 33] * S8, lo, true);
            int hi = __builtin_amdgcn_cvt_pk_fp8_f32(sp[4 * 33] * S8, sp[5 * 33] * S8, 0, false); hi = __builtin_amdgcn_cvt_pk_fp8_f32(sp[6 * 33] * S8, sp[7 * 33] * S8, hi, true);
            *(GAS u32x2*)((unsigned char*)WT + (size_t)(n0 + n) * K + k0 + 8 * c) = (u32x2){(unsigned)lo, (unsigned)hi}; }
        else { u32x4 o; o.x = pk2(sp[0 * 33], sp[1 * 33]); o.y = pk2(sp[2 * 33], sp[3 * 33]); o.z = pk2(sp[4 * 33], sp[5 * 33]); o.w = pk2(sp[6 * 33], sp[7 * 33]);
            *(GAS u32x4*)(WT + (size_t)(n0 + n) * K + k0 + 8 * c) = o; } }
    LDS_WAIT(); asm volatile("" ::: "memory");
}

__device__ __forceinline__ void p0_mod(const Args& args, Frame& F, int task) {
    LAS float* sc = (LAS float*)F.lds;
    LAS float* red = (LAS float*)(F.lds + 32768);
    const float* c = AIN(1);
    for (int i = F.tid; i < 8192; i += NTHR) { const float v = c[i]; sc[i] = v * fast_sigmoid(v); }
    __syncthreads();
    const float* aw = AIN(2) + 64 * task + F.lane;
    float acc[8];
#pragma unroll
    for (int b = 0; b < 8; ++b) acc[b] = 0.f;
    const int kb = 128 * F.wave;
#pragma unroll 4
    for (int k = 0; k < 128; ++k) { const float a = aw[(size_t)(kb + k) * 6144];
#pragma unroll
        for (int b = 0; b < 8; ++b) acc[b] += sc[b * 1024 + kb + k] * a; }
#pragma unroll
    for (int b = 0; b < 8; ++b) red[(F.wave * 8 + b) * 64 + F.lane] = acc[b];
    __syncthreads();
    { const int b = F.wave; float s = AIN(3)[64 * task + F.lane];
#pragma unroll
      for (int w = 0; w < 8; ++w) s += red[(w * 8 + b) * 64 + F.lane];
      ((float*)(F.ws + WS_MOD))[b * 6144 + 64 * task + F.lane] = s; }
    __syncthreads();
}

__device__ __forceinline__ void p0_prologue(const Args& args, Frame& F) {
    if (blockIdx.x < 96) p0_mod(args, F, blockIdx.x);
    LAS float* scr = (LAS float*)(F.lds + F.wave * 16384);
    bf16_t* const ws16 = (bf16_t*)F.ws;
    constexpr int I_WIN = 16 * 192, I_WA = 8 * 32, I_WO = 16 * 32, I_WRT = 16 * 8, I_SH1 = 16 * 16, I_SH2 = 4 * 32, I_DU = 16, I_GU = 32;
    constexpr int NIT = I_WIN + 2 * I_WA + I_WO + I_WRT + I_SH1 + I_SH2 + 2 * I_DU + I_GU;
    for (int it = F.gw; it < NIT; it += F.NGW) {
        int r = it;
        if (r < I_WIN) { const float* w = AIN(5);
            transpose_item<1>([=](int n) { TrSrc s; const bool ok = (n < 2096) || (n >= 2304); const int col = n < 2096 ? n : n - 208; s.base = ok ? w + col : nullptr; s.nsrc = NIN_SRC; return s; },
                           1024, (bf16_t*)(F.ws + WS_WIN), scr, r / 192, r % 192, F.lane); continue; } r -= I_WIN;
        if (r < I_WA) { const float* w = AIN(18); transpose_item<0>([=](int n) { TrSrc s; s.base = w + n; s.nsrc = 1024; return s; }, 512, (bf16_t*)(F.ws + WS_WA), scr, r / 32, r % 32, F.lane); continue; } r -= I_WA;
        if (r < I_WA) { const float* w = AIN(19); transpose_item<0>([=](int n) { TrSrc s; s.base = w + n; s.nsrc = 1024; return s; }, 512, (bf16_t*)(F.ws + WS_WR), scr, r / 32, r % 32, F.lane); continue; } r -= I_WA;
        if (r < I_WO) { const float* w = AIN(20); transpose_item<1>([=](int n) { TrSrc s; s.base = w + n; s.nsrc = 1024; return s; }, 1024, (bf16_t*)(F.ws + WS_WO), scr, r / 32, r % 32, F.lane); continue; } r -= I_WO;
        if (r < I_WRT) { const float* w = AIN(22); transpose_item<0>([=](int n) { TrSrc s; s.base = n < 64 ? w + n : nullptr; s.nsrc = 64; return s; }, 1024, (bf16_t*)(F.ws + WS_WRT), scr, r / 8, r % 8, F.lane); continue; } r -= I_WRT;
        if (r < I_SH1) { const float* wg = AIN(27); const float* wu = AIN(28);
            transpose_item<0>([=](int n) { TrSrc s; const int j = n >> 8, sel = (n >> 7) & 1, cc = n & 127; s.base = (sel ? wu : wg) + 128 * j + cc; s.nsrc = 256; return s; }, 1024, (bf16_t*)(F.ws + WS_WSH1), scr, r / 16, r % 16, F.lane); continue; } r -= I_SH1;
        if (r < I_SH2) { const float* w = AIN(29); transpose_item<0>([=](int n) { TrSrc s; s.base = w + n; s.nsrc = 1024; return s; }, 256, (bf16_t*)(F.ws + WS_WSH2), scr, r / 32, r % 32, F.lane); continue; } r -= I_SH2;
        if (r < I_DU) { const float* w = AIN(9); transpose_item<0>([=](int n) { TrSrc s; s.base = w + n; s.nsrc = 512; return s; }, 64, (bf16_t*)(F.ws + WS_DUT), scr, 0, r, F.lane); continue; } r -= I_DU;
        if (r < I_DU) { const float* w = AIN(11); transpose_item<0>([=](int n) { TrSrc s; s.base = w + n; s.nsrc = 512; return s; }, 64, (bf16_t*)(F.ws + WS_IUT), scr, 0, r, F.lane); continue; } r -= I_DU;
        { const float* w = AIN(12); transpose_item<0>([=](int n) { TrSrc s; s.base = w + n; s.nsrc = 512; return s; }, 128, (bf16_t*)(F.ws + WS_GUT), scr, r / 16, r % 16, F.lane); }
    }
    (void)ws16;
}

__device__ __forceinline__ void convert_experts(const Args& args, Frame& F, int k0, int k1) {
    LAS float* scr = (LAS float*)(F.lds + F.wave * 16384);
    constexpr int I1 = 16 * 16, I2 = 4 * 32, PER = I1 + I2, NIT = 64 * PER;
    for (int k = k0; k < k1; ++k) { const int it = F.gw + k * F.NGW; if (it >= NIT) break;
        const int e = it / PER; int r = it % PER;
        if (r < I1) { const float* wg = AIN(24) + (size_t)e * 1024 * 256; const float* wu = AIN(25) + (size_t)e * 1024 * 256;
            transpose_item<0>([=](int n) { TrSrc s; const int j = n >> 8, sel = (n >> 7) & 1, cc = n & 127; s.base = (sel ? wu : wg) + 128 * j + cc; s.nsrc = 256; return s; }, 1024, (bf16_t*)(F.ws + WS_W1T) + (size_t)e * 512 * 1024, scr, r / 16, r % 16, F.lane); }
        else { r -= I1; const float* w = AIN(26) + (size_t)e * 256 * 1024;
            transpose_item<0>([=](int n) { TrSrc s; s.base = w + n; s.nsrc = 1024; return s; }, 256, (bf16_t*)(F.ws + WS_W2T) + (size_t)e * 1024 * 256, scr, r / 32, r % 32, F.lane); }
    }
}

__device__ __forceinline__ void norm_mod_rows(const Args& args, Frame& F, const float* X, const float* g, int sh_off, int sc_off, bf16_t* O, unsigned char* O8) {
    const int row0 = F.gw * 16, b = row0 / SEQ;
    const float* mod = (const float*)(F.ws + WS_MOD) + b * 6144;
    f32x4 mul[4], add[4];
#pragma unroll
    for (int j = 0; j < 4; ++j) { const int c = 4 * F.lane + 256 * j; const f32x4 gv = *(const f32x4*)(g + c), sc = *(const f32x4*)(mod + sc_off + c); add[j] = *(const f32x4*)(mod + sh_off + c); mul[j] = gv * (sc + 1.0f); }
    for (int r = 0; r < 16; ++r) {
        const GAS f32x4* xr = (const GAS f32x4*)(X + (size_t)(row0 + r) * D) + F.lane;
        f32x4 v[4]; float s = 0.f;
#pragma unroll
        for (int j = 0; j < 4; ++j) { v[j] = xr[64 * j]; s += (v[j].x * v[j].x + v[j].y * v[j].y) + (v[j].z * v[j].z + v[j].w * v[j].w); }
        const float rstd = 1.0f / sqrtf(wave_sum(s) * (1.0f / D) + RMS_EPS);
#pragma unroll
        for (int j = 0; j < 4; ++j) { const f32x4 y = v[j] * rstd * mul[j] + add[j];
            if (O) { u32x2 w; w.x = cvt_pk_bf16(y.x, y.y); w.y = cvt_pk_bf16(y.z, y.w); ((GAS u32x2*)(O + (size_t)(row0 + r) * D) + F.lane)[64 * j] = w; }
            if (O8) { int w8 = __builtin_amdgcn_cvt_pk_fp8_f32(y.x, y.y, 0, false); w8 = __builtin_amdgcn_cvt_pk_fp8_f32(y.z, y.w, w8, true); ((GAS unsigned*)(O8 + (size_t)(row0 + r) * D) + F.lane)[64 * j] = (unsigned)w8; } }
    }
}
using pg8::Unit;
constexpr float WSCALE8 = 32.0f;
typedef const f32x4 (&AccRef)[2][2][4][2];

struct EpiInProj {
    static constexpr bool PERM = true;
    bf16_t* Z; bf16_t* Gt;
    __device__ __forceinline__ void operator()(AccRef acc, const Unit& u, int wr, int wc, int fr, int fq) const {
        asm volatile("" : "+v"(fr), "+v"(fq));
        const int row0 = u.pm * 256 + wr * 64 + fr;
        const bool gate = u.pn >= 16;
        const float sc = ((u.pn < 2) ? QSCALE : 1.0f) * (1.0f / WSCALE8);
        bf16_t* base = gate ? Gt + (size_t)(u.pn - 16) * 256 : Z + (size_t)u.pn * 256;
        const int ldc = gate ? GW : ZW;
#pragma unroll
        for (int ai = 0; ai < 2; ++ai)
#pragma unroll
            for (int m = 0; m < 4; ++m) { bf16_t* rowp = base + (size_t)(row0 + ai * 128 + m * 16) * ldc + wc * 32 + 8 * fq;
#pragma unroll
                for (int bj = 0; bj < 2; ++bj) { f32x4 v0 = acc[ai][bj][m][0], v1 = acc[ai][bj][m][1];
                    if (gate) {
#pragma unroll
                        for (int j = 0; j < 4; ++j) { v0[j] = fast_sigmoid(v0[j] * sc); v1[j] = fast_sigmoid(v1[j] * sc); } }
                    else { v0 = v0 * sc; v1 = v1 * sc; }
                    u32x4 w; w.x = cvt_pk_bf16(v0[0], v0[1]); w.y = cvt_pk_bf16(v0[2], v0[3]); w.z = cvt_pk_bf16(v1[0], v1[1]); w.w = cvt_pk_bf16(v1[2], v1[3]);
                    *(u32x4*)(rowp + bj * 128) = w; } }
    }
};

constexpr float ATT_S8 = 16.0f, RW_S8 = 8.0f, MIX_S8 = 16.0f;
template <int SECOND> struct EpiMerge {
    static constexpr bool PERM = true;
    bf16_t* Mx; unsigned char* Mx8; const bf16_t* Gt; float bs;
    __device__ __forceinline__ void operator()(AccRef acc, const Unit& u, int wr, int wc, int fr, int fq) const {
        asm volatile("" : "+v"(fr), "+v"(fq));
        const int row0 = u.pm * 256 + wr * 64 + fr, col0 = u.pn * 256 + wc * 32 + 8 * fq;
#pragma unroll
        for (int ai = 0; ai < 2; ++ai)
#pragma unroll
            for (int m = 0; m < 4; ++m) { const size_t r = (size_t)(row0 + ai * 128 + m * 16);
#pragma unroll
                for (int bj = 0; bj < 2; ++bj) { const int c = col0 + bj * 128;
                    const u32x4 g = *(const u32x4*)(Gt + r * GW + SECOND * 1024 + c);
                    f32x4 v0 = acc[ai][bj][m][0] * bs, v1 = acc[ai][bj][m][1] * bs;
                    v0[0] *= bf_lo(g.x); v0[1] *= bf_hi(g.x); v0[2] *= bf_lo(g.y); v0[3] *= bf_hi(g.y);
                    v1[0] *= bf_lo(g.z); v1[1] *= bf_hi(g.z); v1[2] *= bf_lo(g.w); v1[3] *= bf_hi(g.w);
                    if (SECOND) { const u32x4 p = *(const u32x4*)(Mx + r * D + c);
                        v0[0] += bf_lo(p.x); v0[1] += bf_hi(p.x); v0[2] += bf_lo(p.y); v0[3] += bf_hi(p.y);
                        v1[0] += bf_lo(p.z); v1[1] += bf_hi(p.z); v1[2] += bf_lo(p.w); v1[3] += bf_hi(p.w);
                        v0 = v0 * MIX_S8; v1 = v1 * MIX_S8;
                        int lo = __builtin_amdgcn_cvt_pk_fp8_f32(v0[0], v0[1], 0, false); lo = __builtin_amdgcn_cvt_pk_fp8_f32(v0[2], v0[3], lo, true);
                        int hi = __builtin_amdgcn_cvt_pk_fp8_f32(v1[0], v1[1], 0, false); hi = __builtin_amdgcn_cvt_pk_fp8_f32(v1[2], v1[3], hi, true);
                        *(u32x2*)(Mx8 + r * D + c) = (u32x2){(unsigned)lo, (unsigned)hi}; }
                    else { u32x4 w; w.x = cvt_pk_bf16(v0[0], v0[1]); w.y = cvt_pk_bf16(v0[2], v0[3]); w.z = cvt_pk_bf16(v1[0], v1[1]); w.w = cvt_pk_bf16(v1[2], v1[3]);
                        *(u32x4*)(Mx + r * D + c) = w; } } }
    }
};

struct EpiOutProj {
    static constexpr bool PERM = false;
    const float* X; float* O; const float* mod;
    __device__ __forceinline__ void operator()(AccRef acc, const Unit& u, int wr, int wc, int fr, int fq) const {
        asm volatile("" : "+v"(fr), "+v"(fq));
        const int row0 = u.pm * 256 + wr * 64 + fr, col0 = u.pn * 256 + wc * 32 + 4 * fq;
        const float* g1 = mod + (size_t)((u.pm * 256) / SEQ) * 6144 + 2048;
        f32x4 gv[2][2];
#pragma unroll
        for (int bj = 0; bj < 2; ++bj)
#pragma unroll
            for (int n = 0; n < 2; ++n) gv[bj][n] = *(const f32x4*)(g1 + col0 + bj * 128 + n * 16);
#pragma unroll
        for (int ai = 0; ai < 2; ++ai)
#pragma unroll
            for (int m = 0; m < 4; ++m) { const size_t off = (size_t)(row0 + ai * 128 + m * 16) * D + col0;
#pragma unroll
                for (int bj = 0; bj < 2; ++bj)
#pragma unroll
                    for (int n = 0; n < 2; ++n) { const f32x4 xv = *(const f32x4*)(X + off + bj * 128 + n * 16);
                        *(f32x4*)(O + off + bj * 128 + n * 16) = xv + gv[bj][n] * acc[ai][bj][m][n] * (1.0f / (MIX_S8 * WSCALE8)); }
                if (m & 1) asm volatile("" ::: "memory"); }
    }
};

struct EpiRouter {
    static constexpr bool PERM = false;
    float* L;
    __device__ __forceinline__ void operator()(AccRef acc, const Unit& u, int wr, int wc, int fr, int fq) const {
        asm volatile("" : "+v"(fr), "+v"(fq));
        if (wc >= 2) return;
        const int row0 = u.pm * 256 + wr * 64 + fr, col0 = wc * 32 + 4 * fq;
#pragma unroll
        for (int ai = 0; ai < 2; ++ai)
#pragma unroll
            for (int m = 0; m < 4; ++m)
#pragma unroll
                for (int n = 0; n < 2; ++n) *(f32x4*)(L + (size_t)(row0 + ai * 128 + m * 16) * 64 + col0 + n * 16) = acc[ai][0][m][n];
    }
};

struct MoeSched1 {
    const LAS unsigned* tab; int ntiles, G, c;
    __device__ __forceinline__ bool next(int i, Unit& u) const {
        const int L = i * G + c; if (L >= 256 + 2 * ntiles) return false;
        u.pn = L & 1;
        if (L < 256) { u.pm = L >> 1; u.aux0 = (u.pm * 256) | (64 << 20); u.aux1 = 256; }
        else { const int t = (L - 256) >> 1; u.pm = t; u.aux0 = __builtin_amdgcn_readfirstlane((int)tab[2 * t]); u.aux1 = __builtin_amdgcn_readfirstlane((int)tab[2 * t + 1]); }
        return true;
    }
};
struct MoeSrc1 {
    static constexpr int ESZ = 2; static constexpr bool GATHER = true;
    const unsigned char* ws;
    __device__ __forceinline__ const char* a_base(const Unit&) const { return (const char*)(ws + WS_H2); }
    __device__ __forceinline__ const char* b_base(const Unit& u) const { const int e = u.aux0 >> 20;
        const size_t off = (e == 64 ? WS_WSH1 : WS_W1T + (size_t)e * 512 * 1024 * 2) + (size_t)u.pn * 256 * 1024 * 2; return (const char*)ws + off; }
    __device__ __forceinline__ unsigned a_off(const Unit& u, int R, int C) const {
        const int e = u.aux0 >> 20, pos0 = u.aux0 & 0xFFFFF; int tok;
        if (e == 64) tok = pos0 + R; else tok = (R < u.aux1) ? (((const int*)(ws + WS_STOK))[pos0 + R] >> 3) : 0;
        return (unsigned)tok * 2048u + (unsigned)C * 2u; }
};
struct EpiMoe1 {
    static constexpr bool PERM = true;
    unsigned char* ws;
    __device__ __forceinline__ void operator()(AccRef acc, const Unit& u, int wr, int wc, int fr, int fq) const {
        asm volatile("" : "+v"(fr), "+v"(fq));
        const int e = u.aux0 >> 20, pos0 = u.aux0 & 0xFFFFF;
        bf16_t* base = (bf16_t*)(ws + (e == 64 ? WS_ACTS : WS_ACT)) + (size_t)pos0 * FF + u.pn * 128 + wc * 32 + 8 * fq;
#pragma unroll
        for (int ai = 0; ai < 2; ++ai)
#pragma unroll
            for (int m = 0; m < 4; ++m) { const int r = ai * 128 + wr * 64 + m * 16 + fr;
                float o[8];
#pragma unroll
                for (int n = 0; n < 2; ++n)
#pragma unroll
                    for (int j = 0; j < 4; ++j) { const float g = acc[ai][0][m][n][j], up = acc[ai][1][m][n][j]; o[4 * n + j] = g * fast_sigmoid(g) * up; }
                u32x4 w; w.x = cvt_pk_bf16(o[0], o[1]); w.y = cvt_pk_bf16(o[2], o[3]); w.z = cvt_pk_bf16(o[4], o[5]); w.w = cvt_pk_bf16(o[6], o[7]);
                if (r < u.aux1) *(u32x4*)(base + (size_t)r * FF) = w; }
    }
};
struct MoeSched2 {
    const LAS unsigned* tab; int t0, ntiles, nsh, G, c;
    __device__ __forceinline__ bool next(int i, Unit& u) const {
        const int L = i * G + c; if (L >= nsh + 4 * ntiles) return false;
        u.pn = L & 3;
        if (L < nsh) { u.pm = L >> 2; u.aux0 = (u.pm * 256) | (64 << 20); u.aux1 = 256; }
        else { const int t = t0 + ((L - nsh) >> 2); u.pm = t; u.aux0 = __builtin_amdgcn_readfirstlane((int)tab[2 * t]); u.aux1 = __builtin_amdgcn_readfirstlane((int)tab[2 * t + 1]); }
        return true;
    }
};
struct MoeSrc2 {
    static constexpr int ESZ = 2; static constexpr bool GATHER = true;
    const unsigned char* ws;
    __device__ __forceinline__ const char* a_base(const Unit& u) const { return (const char*)ws + ((u.aux0 >> 20) == 64 ? WS_ACTS : WS_ACT); }
    __device__ __forceinline__ const char* b_base(const Unit& u) const { const int e = u.aux0 >> 20;
        const size_t off = (e == 64 ? WS_WSH2 : WS_W2T + (size_t)e * 1024 * 256 * 2) + (size_t)u.pn * 256 * 256 * 2; return (const char*)ws + off; }
    __device__ __forceinline__ unsigned a_off(const Unit& u, int R, int C) const {
        const int pos0 = u.aux0 & 0xFFFFF; const int rr = R < u.aux1 ? R : u.aux1 - 1;
        return (unsigned)(pos0 + rr) * 512u + (unsigned)C * 2u; }
};
constexpr float SLOT_SCALE = 16.0f;
constexpr int NSLOT = 9;
struct EpiMoe2 {
    static constexpr bool PERM = true;
    unsigned char* ws; float* X1; int tokbase;
    __device__ __forceinline__ void operator()(AccRef acc, const Unit& u, int wr, int wc, int fr, int fq) const {
        asm volatile("" : "+v"(fr), "+v"(fq));
        const int e = u.aux0 >> 20, pos0 = u.aux0 & 0xFFFFF; const int col0 = u.pn * 256 + wc * 32 + 8 * fq;
        if (e == 64) {
#pragma unroll
            for (int ai = 0; ai < 2; ++ai)
#pragma unroll
                for (int m = 0; m < 4; ++m) { unsigned char* rowp = (unsigned char*)(ws + WS_SLOT) + ((size_t)(pos0 + ai * 128 + wr * 64 + m * 16 + fr) * NSLOT + 8) * D + u.pn * 256 + wc * 64 + fq * 16;
                    u32x4 o;
#pragma unroll
                    for (int bj = 0; bj < 2; ++bj) { const f32x4 v0 = acc[ai][bj][m][0] * SLOT_SCALE, v1 = acc[ai][bj][m][1] * SLOT_SCALE;
                        int lo = __builtin_amdgcn_cvt_pk_fp8_f32(v0[0], v0[1], 0, false); lo = __builtin_amdgcn_cvt_pk_fp8_f32(v0[2], v0[3], lo, true);
                        int hi = __builtin_amdgcn_cvt_pk_fp8_f32(v1[0], v1[1], 0, false); hi = __builtin_amdgcn_cvt_pk_fp8_f32(v1[2], v1[3], hi, true);
                        if (bj == 0) { o.x = (unsigned)lo; o.y = (unsigned)hi; } else { o.z = (unsigned)lo; o.w = (unsigned)hi; } }
                    *(u32x4*)rowp = o;
                    asm volatile("" ::: "memory"); }
        } else {
#pragma unroll
            for (int ai = 0; ai < 2; ++ai)
#pragma unroll
                for (int m = 0; m < 4; ++m) { const int r = ai * 128 + wr * 64 + m * 16 + fr;
                    if (r < u.aux1) { const int tk = ((const int*)(ws + WS_STOK))[pos0 + r]; const float w = ((const float*)(ws + WS_SW))[pos0 + r] * SLOT_SCALE;
                        unsigned char* rowp = (unsigned char*)(ws + WS_SLOT) + ((size_t)(tk >> 3) * NSLOT + (tk & 7)) * D + u.pn * 256 + wc * 64 + fq * 16;
                        u32x4 o;
#pragma unroll
                        for (int bj = 0; bj < 2; ++bj) { const f32x4 v0 = acc[ai][bj][m][0] * w, v1 = acc[ai][bj][m][1] * w;
                            int lo = __builtin_amdgcn_cvt_pk_fp8_f32(v0[0], v0[1], 0, false); lo = __builtin_amdgcn_cvt_pk_fp8_f32(v0[2], v0[3], lo, true);
                            int hi = __builtin_amdgcn_cvt_pk_fp8_f32(v1[0], v1[1], 0, false); hi = __builtin_amdgcn_cvt_pk_fp8_f32(v1[2], v1[3], hi, true);
                            if (bj == 0) { o.x = (unsigned)lo; o.y = (unsigned)hi; } else { o.z = (unsigned)lo; o.w = (unsigned)hi; } }
                        *(u32x4*)rowp = o; }
                    asm volatile("" ::: "memory"); }
        }
    }
};
__device__ __forceinline__ unsigned ord_key(float x) { const unsigned b = __float_as_uint(x); return (b & 0x80000000u) ? ~b : (b | 0x80000000u); }

__device__ __forceinline__ void indexer_unit(const Args& args, Frame& F, int b, int q0) {
    const bf16_t* Z = (const bf16_t*)(F.ws + WS_Z) + (size_t)b * SEQ * ZW;
    unsigned* SELM = (unsigned*)(F.ws + WS_SEL) + (size_t)b * SEQ * 128;
    int tid = F.tid; asm volatile("" : "+v"(tid));
    const int lane = tid & 63, kl = lane & 31, hl = lane >> 5, w = F.wave;
    const int qa = q0 + 2 * w;
    const int myq = qa + hl;
    bf16x8 A0, A1;
    { const int aq = (kl >> 2) & 1, ah = 4 * (kl >> 3) + (kl & 3);
      const bf16_t* p = Z + (size_t)(qa + aq) * ZW + ZIQ + ah * 32 + 8 * hl;
      A0 = *(const bf16x8*)p; A1 = *(const bf16x8*)(p + 16); }
    float wq[16];
    { const bf16_t* p = Z + (size_t)myq * ZW + ZIW; const u32x4 a = *(const u32x4*)p, c = *(const u32x4*)(p + 8);
      wq[0] = bf_lo(a.x); wq[1] = bf_hi(a.x); wq[2] = bf_lo(a.y); wq[3] = bf_hi(a.y); wq[4] = bf_lo(a.z); wq[5] = bf_hi(a.z); wq[6] = bf_lo(a.w); wq[7] = bf_hi(a.w);
      wq[8] = bf_lo(c.x); wq[9] = bf_hi(c.x); wq[10] = bf_lo(c.y); wq[11] = bf_hi(c.y); wq[12] = bf_lo(c.z); wq[13] = bf_hi(c.z); wq[14] = bf_lo(c.w); wq[15] = bf_hi(c.w); }
    unsigned key[128];
    const int nchunk = (q0 + 15) / 1024 + 1;
#define IDX_LOAD(ch, buf) do { _Pragma("unroll") for (int _h = 0; _h < 2; ++_h) { u32x4 v_[4]; \
        _Pragma("unroll") for (int _i = 0; _i < 4; ++_i) { const int pc = tid + 512 * (4 * _h + _i); const int kk = pc >> 2, c4 = pc & 3; v_[_i] = *(const u32x4*)(Z + (size_t)((ch) * 1024 + kk) * ZW + ZIK + 8 * c4); } \
        _Pragma("unroll") for (int _i = 0; _i < 4; ++_i) { const int pc = tid + 512 * (4 * _h + _i); const int kk = pc >> 2, c4 = pc & 3; *(LAS u32x4*)(F.lds + (buf) * 65536 + (c4 * 1024 + kk) * 16) = v_[_i]; } \
        asm volatile("" ::: "memory"); } } while (0)
    IDX_LOAD(0, 0);
    __syncthreads();
#pragma unroll
    for (int ch = 0; ch < 4; ++ch) {
        if (ch < nchunk) {
            if (ch + 1 < nchunk) IDX_LOAD(ch + 1, (ch + 1) & 1);
            LAS unsigned char* kbl = F.lds + (ch & 1) * 65536 + hl * 16384 + kl * 16; asm volatile("" : "+v"(kbl));
#pragma unroll
            for (int tt = 0; tt < 32; tt += 2) {
                const int t = ch * 32 + tt;
                if (32 * t <= qa + 1) {
                    bf16x8 B0[2], B1[2]; f32x16 acc[2];
#pragma unroll
                    for (int j = 0; j < 2; ++j) { B0[j] = *(const LAS bf16x8*)(kbl + 512 * (tt + j)); B1[j] = *(const LAS bf16x8*)(kbl + 32768 + 512 * (tt + j)); }
#pragma unroll
                    for (int j = 0; j < 2; ++j) { acc[j] = f32x16{}; acc[j] = __builtin_amdgcn_mfma_f32_32x32x16_bf16(A0, B0[j], acc[j], 0, 0, 0); }
#pragma unroll
                    for (int j = 0; j < 2; ++j) acc[j] = __builtin_amdgcn_mfma_f32_32x32x16_bf16(A1, B1[j], acc[j], 0, 0, 0);
#pragma unroll
                    for (int j = 0; j < 2; ++j) { float s = 0.f;
#pragma unroll
                        for (int i = 0; i < 16; ++i) { const float av_ = acc[j][i]; const int xb_ = __float_as_int(av_); s += __int_as_float(xb_ > 0 ? xb_ : 0) * wq[i]; }
                        key[t + j] = (32 * (t + j) + kl <= myq) ? ord_key(s) : 0u; }
                } else {
#pragma unroll
                    for (int j = 0; j < 2; ++j) key[t + j] = 0u;
                }
            }
            __syncthreads();
        } else {
#pragma unroll
            for (int tt = 0; tt < 32; ++tt) key[ch * 32 + tt] = 0u;
        }
    }
#undef IDX_LOAD
#pragma unroll
    for (int w = 0; w < 4; ++w) {
        if (1024 * w <= qa + 1) {
#pragma unroll
            for (int k = 0; k < 16; ++k) { const unsigned lo = key[32 * w + k], hi_ = key[32 * w + k + 16];
                key[32 * w + k] = __builtin_amdgcn_perm(hi_, lo, 0x05040100u); key[32 * w + k + 16] = __builtin_amdgcn_perm(hi_, lo, 0x07060302u); }
#pragma unroll
            for (int k = 0; k < 32; ++k) if (!(k & 8)) { const unsigned lo = key[32 * w + k], hi_ = key[32 * w + k + 8];
                key[32 * w + k] = __builtin_amdgcn_perm(hi_, lo, 0x06020400u); key[32 * w + k + 8] = __builtin_amdgcn_perm(hi_, lo, 0x07030501u); }
#pragma unroll
            for (int k = 0; k < 32; ++k) if (!(k & 4)) { const unsigned lo = key[32 * w + k], hi_ = key[32 * w + k + 4]; const unsigned m = 0x0F0F0F0Fu;
                key[32 * w + k] = (lo & m) | ((hi_ << 4) & ~m); key[32 * w + k + 4] = ((lo >> 4) & m) | (hi_ & ~m); }
#pragma unroll
            for (int k = 0; k < 32; ++k) if (!(k & 2)) { const unsigned lo = key[32 * w + k], hi_ = key[32 * w + k + 2]; const unsigned m = 0x33333333u;
                key[32 * w + k] = (lo & m) | ((hi_ << 2) & ~m); key[32 * w + k + 2] = ((lo >> 2) & m) | (hi_ & ~m); }
#pragma unroll
            for (int k = 0; k < 32; ++k) if (!(k & 1)) { const unsigned lo = key[32 * w + k], hi_ = key[32 * w + k + 1]; const unsigned m = 0x55555555u;
                key[32 * w + k] = (lo & m) | ((hi_ << 1) & ~m); key[32 * w + k + 1] = ((lo >> 1) & m) | (hi_ & ~m); }
        }
    }
    unsigned Al[4] = {~0u, ~0u, ~0u, ~0u}, Gt[4] = {0u, 0u, 0u, 0u};
    int ab0 = 0, ab1 = 0; unsigned T0 = 0u, T1 = 0u; bool dn0 = false, dn1 = false;
#define IDX_DPP(v, ctrl) __builtin_amdgcn_update_dpp(0, (v), (ctrl), 0xF, 0xF, true)
#pragma unroll
    for (int bit = 31; bit >= 0; --bit) {
        unsigned S_[4]; int c = 0;
#pragma unroll
        for (int w = 0; w < 4; ++w) { S_[w] = Al[w] & key[32 * w + bit]; c += __builtin_popcount(S_[w]); }
        c += IDX_DPP(c, 0xB1); c += IDX_DPP(c, 0x4E); c += IDX_DPP(c, 0x141); c += IDX_DPP(c, 0x140);
        const int cn0 = ab0 + __builtin_amdgcn_readlane(c, 0) + __builtin_amdgcn_readlane(c, 16), cn1 = ab1 + __builtin_amdgcn_readlane(c, 32) + __builtin_amdgcn_readlane(c, 48);
        const bool t0 = cn0 >= 256, t1 = cn1 >= 256;
        if (t0) { T0 |= 1u << bit; dn0 = dn0 || cn0 == 256; } else ab0 = cn0;
        if (t1) { T1 |= 1u << bit; dn1 = dn1 || cn1 == 256; } else ab1 = cn1;
        const unsigned nm = hl ? (t1 ? 0u : ~0u) : (t0 ? 0u : ~0u);
#pragma unroll
        for (int w = 0; w < 4; ++w) { Al[w] &= key[32 * w + bit] ^ nm; Gt[w] |= S_[w] & nm; }
        if (dn0 && dn1) break;
    }
#undef IDX_DPP
    unsigned x[4];
    { const bool nz = hl ? (T1 != 0u) : (T0 != 0u);
#pragma unroll
      for (int w = 0; w < 4; ++w) x[w] = Gt[w] | (nz ? Al[w] : 0u); }
#define IDX_BFLY(d, m) do { const bool up_ = (kl & (d)) != 0; const unsigned km_ = up_ ? ~(m) : (m); const unsigned am_ = up_ ? (unsigned)(d) : 32u - (d); \
        _Pragma("unroll") for (int w = 0; w < 4; ++w) { const unsigned t_ = (unsigned)__builtin_amdgcn_ds_swizzle((int)x[w], 0x1F | ((d) << 10)); \
            const unsigned rot_ = __builtin_amdgcn_alignbit(t_, t_, am_); x[w] = (x[w] & km_) | (rot_ & ~km_); } } while (0)
    IDX_BFLY(16, 0x0000FFFFu); IDX_BFLY(8, 0x00FF00FFu); IDX_BFLY(4, 0x0F0F0F0Fu); IDX_BFLY(2, 0x33333333u); IDX_BFLY(1, 0x55555555u);
#undef IDX_BFLY
#pragma unroll
    for (int j = 0; j < 4; ++j) SELM[(size_t)myq * 128 + kl + 32 * j] = x[j];
}

__device__ __forceinline__ void indexer_phase(const Args& args, Frame& F) {
    const int c = blockIdx.x;
    for (int i = 0; i < 8; ++i) {
        for (int u = c + i * F.G; u < 2048 && i < 8; u += 2048) {
            const int b = u >> 8, pos = u & 255, blk = (b & 1) ? 255 - pos : pos;
            indexer_unit(args, F, b, blk * 16);
        }
    }
}
namespace att {
constexpr int DM = ZW, QB = 256, KVB = 64, SLOTB = 8192;
constexpr int NS = 4;
constexpr int L_K = 0, L_V = NS * SLOTB, L_MASK = 2 * NS * SLOTB, L_WSF = L_MASK + 8 * 2048, L_OST = L_WSF + 8 * 256, L_BT = L_OST + 8 * 4096, L_END = L_BT + 512;
static_assert(L_END <= RING_BYTES, "attention LDS");
__device__ __forceinline__ int crow(int r, int hi) { return (r & 3) + 8 * (r >> 2) + 4 * hi; }
__device__ __forceinline__ void glds16(const void* gsrc, unsigned lds_dst) { unsigned keep;
    asm volatile("s_mov_b32 %0, m0\n\ts_mov_b32 m0, %2\n\ts_nop 0\n\tglobal_load_lds_dwordx4 %1, off\n\ts_mov_b32 m0, %0" : "=&s"(keep) : "v"(gsrc), "s"(lds_dst) : "memory"); }
__device__ __forceinline__ unsigned cvtpk(float lo, float hi) { return cvt_pk_bf16(lo, hi); }
typedef short s16x4 __attribute__((ext_vector_type(4)));

__device__ __forceinline__ void attn_unit(const Args& args, Frame& F, int b, int h, int qb) {
    const int lane = F.lane, r32 = lane & 31, hi = lane >> 5, wid = F.wave;
    const bf16_t* Zb = (const bf16_t*)(F.ws + WS_Z) + (size_t)b * SEQ * DM;
    const int q0 = qb * QB;
    const bf16_t* Qw = Zb + (size_t)(q0 + wid * 32) * DM + ZQ + h * 64;
    const bf16_t* Kh = Zb + ZK + h * 64; const bf16_t* Vh = Zb + ZV + h * 64;
    LAS unsigned char* shm = F.lds;
    const unsigned lds0 = (unsigned)(uintptr_t)shm;
    LAS float* wsf = (LAS float*)(shm + L_WSF) + wid * 64;
    LAS float* bt = (LAS float*)(shm + L_BT);
    if (F.tid < 128) { const int rel = F.tid; int bk;
        if (rel < 16) bk = rel; else { bk = 16 + (int)(logf((float)rel / 16.0f) / logf(8.0f) * 16.0f); bk = bk < 31 ? bk : 31; }
        bt[rel] = (AIN(6)[bk * 8 + h] - AIN(6)[31 * 8 + h]) * 1.4426950408889634f; }
    const bf16_t* ksrc = Kh + (size_t)lane * DM + wid * 8;
    const bf16_t* vsrc = Vh + (size_t)(16 * (wid & 3) + (lane >> 2)) * DM + (wid >> 2) * 32 + (lane & 3) * 8;
    const unsigned kdst = lds0 + L_K + wid * 1024, vdst = lds0 + L_V + wid * 1024;
    const unsigned* SELM = (const unsigned*)(F.ws + WS_SEL) + (size_t)(b * SEQ + q0 + wid * 32 + r32) * 128 + 4 * hi;
    const unsigned mdst = lds0 + L_MASK + wid * 2048;
#define DMA_K(t, slot) glds16(ksrc + (size_t)(t) * KVB * DM, (unsigned)__builtin_amdgcn_readfirstlane(kdst + (slot) * SLOTB))
#define DMA_V(t, slot) glds16(vsrc + (size_t)(t) * KVB * DM, (unsigned)__builtin_amdgcn_readfirstlane(vdst + (slot) * SLOTB))
#define DMA_M(g) glds16(SELM + 8 * (g), (unsigned)__builtin_amdgcn_readfirstlane(mdst + ((g) & 1) * 1024))
    const int NT = (q0 + QB) / KVB;
    bf16x8 qr[4];
#pragma unroll
    for (int d0 = 0; d0 < 4; ++d0) qr[d0] = *(const bf16x8*)(Qw + (size_t)r32 * DM + d0 * 16 + hi * 8);
    asm volatile("s_waitcnt vmcnt(0)" ::: "memory");
    __syncthreads();
    DMA_M(0); DMA_K(0, 0); DMA_K(1, 1); DMA_V(0, 0); DMA_K(2, 2); DMA_V(1, 1); DMA_K(3, 3); DMA_V(2, 2);
    float m_run = -1e30f, l_run = 0.f; f32x16 o[2]; o[0] = f32x16{}; o[1] = f32x16{};
    const int qpos = q0 + wid * 32 + r32;
    const int vb0 = (int)(lds0 + L_V) + ((lane >> 4) & 1) * 32 + (lane & 3) * 8 + (4 * hi + ((lane & 15) >> 2)) * 64;
#define QK_TILE(P0, P1, slot_) do { const LAS unsigned char* kb = shm + L_K + (slot_) * SLOTB + hi * 1024 + r32 * 16; P0 = f32x16{}; P1 = f32x16{}; \
        _Pragma("unroll") for (int d0 = 0; d0 < 4; ++d0) { const bf16x8 b0 = *(const LAS bf16x8*)(kb + d0 * 2048); const bf16x8 b1 = *(const LAS bf16x8*)(kb + d0 * 2048 + 512); \
            P0 = __builtin_amdgcn_mfma_f32_32x32x16_bf16(b0, qr[d0], P0, 0, 0, 0); P1 = __builtin_amdgcn_mfma_f32_32x32x16_bf16(b1, qr[d0], P1, 0, 0, 0); } } while (0)
    f32x16 pa0, pa1, pb0, pb1;
    asm volatile("s_waitcnt vmcnt(6)" ::: "memory");
    __builtin_amdgcn_s_barrier(); asm volatile("" ::: "memory");
    QK_TILE(pa0, pa1, 0);
    auto step = [&](const int t, f32x16& C0, f32x16& C1, f32x16& N0, f32x16& N1) __attribute__((always_inline)) {
        const int slot = t & (NS - 1), g = t >> 2, tq = t & 3;
        if (t + 4 <= NT) { if (tq == 1 || tq == 2) asm volatile("s_waitcnt vmcnt(5)" ::: "memory"); else asm volatile("s_waitcnt vmcnt(4)" ::: "memory"); }
        else asm volatile("s_waitcnt vmcnt(0)" ::: "memory");
        __builtin_amdgcn_s_barrier(); asm volatile("" ::: "memory");
        if (t + 4 < NT) DMA_K(t + 4, (t + 4) & (NS - 1));
        if (t + 3 < NT) DMA_V(t + 3, (t + 3) & (NS - 1));
        if (tq == 0) DMA_M(g + 1);
        if (t + 1 < NT) QK_TILE(N0, N1, (t + 1) & (NS - 1));
        __builtin_amdgcn_sched_barrier(0);
        const u32x2 mwv = *(const LAS u32x2*)(shm + L_MASK + wid * 2048 + (g & 1) * 1024 + (tq >> 1) * 512 + r32 * 16 + (tq & 1) * 8);
        if (64 * t + 63 + 112 >= q0 + wid * 32) {
#pragma unroll
            for (int r = 0; r < 16; ++r) { const int kv = 64 * t + crow(r, hi); int r0 = qpos - kv, r1 = r0 - 32;
                r0 = r0 < 0 ? 0 : (r0 > 127 ? 127 : r0); r1 = r1 < 0 ? 0 : (r1 > 127 ? 127 : r1);
                C0[r] += bt[r0]; C1[r] += bt[r1]; }
        }
#pragma unroll
        for (int r = 0; r < 16; ++r) { C0[r] -= m_run; C1[r] -= m_run; }
        float rm = __builtin_fmaxf(C0[0], C1[0]);
#pragma unroll
        for (int r = 1; r < 16; ++r) rm = __builtin_fmaxf(rm, __builtin_fmaxf(C0[r], C1[r]));
        if (__builtin_amdgcn_ballot_w64(rm > 8.0f) != 0ull) {
            rm = __builtin_fmaxf(rm, __shfl_xor(rm, 32));
            const float dm = __builtin_fmaxf(rm, 0.f);
            const float f = __builtin_amdgcn_exp2f(-dm);
            m_run += dm; l_run *= f;
#pragma unroll
            for (int r = 0; r < 16; ++r) { C0[r] -= dm; C1[r] -= dm; }
            if (hi == 0) wsf[r32] = f;
            asm volatile("s_waitcnt lgkmcnt(0)" ::: "memory");
#pragma unroll
            for (int d = 0; d < 2; ++d)
#pragma unroll
                for (int r = 0; r < 16; ++r) o[d][r] *= wsf[crow(r, hi)];
        }
        { const unsigned mx_ = mwv.x >> (4 * hi), my_ = mwv.y >> (4 * hi); float sacc = 0.f;
#pragma unroll
          for (int r = 0; r < 16; ++r) { const int bitp = crow(r, 0);
              int k0 = __builtin_amdgcn_sbfe(mx_, bitp, 1), k1 = __builtin_amdgcn_sbfe(my_, bitp, 1);
              asm volatile("" : "+v"(k0), "+v"(k1));
              C0[r] = __int_as_float(__float_as_int(__builtin_amdgcn_exp2f(C0[r])) & k0); C1[r] = __int_as_float(__float_as_int(__builtin_amdgcn_exp2f(C1[r])) & k1);
              sacc += C0[r] + C1[r]; }
          l_run += sacc; }
        u32x4 pw0, pw1, pw2, pw3;
        pw0 = (u32x4){cvtpk(C0[0], C0[1]), cvtpk(C0[2], C0[3]), cvtpk(C0[4], C0[5]), cvtpk(C0[6], C0[7])};
        pw1 = (u32x4){cvtpk(C0[8], C0[9]), cvtpk(C0[10], C0[11]), cvtpk(C0[12], C0[13]), cvtpk(C0[14], C0[15])};
        pw2 = (u32x4){cvtpk(C1[0], C1[1]), cvtpk(C1[2], C1[3]), cvtpk(C1[4], C1[5]), cvtpk(C1[6], C1[7])};
        pw3 = (u32x4){cvtpk(C1[8], C1[9]), cvtpk(C1[10], C1[11]), cvtpk(C1[12], C1[13]), cvtpk(C1[14], C1[15])};
        { const int vb = vb0 + slot * SLOTB;
#pragma unroll
          for (int d0 = 0; d0 < 2; ++d0) { s16x4 lo[4], hh[4];
#pragma unroll
              for (int ks = 0; ks < 4; ++ks) {
                  asm volatile("ds_read_b64_tr_b16 %0,%1 offset:%c2" : "=&v"(lo[ks]) : "v"(vb), "i"(d0 * 4096 + ks * 1024) : "memory");
                  asm volatile("ds_read_b64_tr_b16 %0,%1 offset:%c2" : "=&v"(hh[ks]) : "v"(vb), "i"(d0 * 4096 + ks * 1024 + 512) : "memory"); }
              asm volatile("s_waitcnt lgkmcnt(0)" ::: "memory"); __builtin_amdgcn_sched_barrier(0);
#define PKV(k) (bf16x8){lo[k][0], lo[k][1], lo[k][2], lo[k][3], hh[k][0], hh[k][1], hh[k][2], hh[k][3]}
              o[d0] = __builtin_amdgcn_mfma_f32_32x32x16_bf16(__builtin_bit_cast(bf16x8, pw0), PKV(0), o[d0], 0, 0, 0);
              o[d0] = __builtin_amdgcn_mfma_f32_32x32x16_bf16(__builtin_bit_cast(bf16x8, pw1), PKV(1), o[d0], 0, 0, 0);
              o[d0] = __builtin_amdgcn_mfma_f32_32x32x16_bf16(__builtin_bit_cast(bf16x8, pw2), PKV(2), o[d0], 0, 0, 0);
              o[d0] = __builtin_amdgcn_mfma_f32_32x32x16_bf16(__builtin_bit_cast(bf16x8, pw3), PKV(3), o[d0], 0, 0, 0);
#undef PKV
          } }
        asm volatile("s_waitcnt lgkmcnt(0)" ::: "memory");
    };
    for (int t = 0; t < NT; t += 2) { step(t, pa0, pa1, pb0, pb1); step(t + 1, pb0, pb1, pa0, pa1); }
#undef QK_TILE
    l_run += __shfl_xor(l_run, 32);
    if (hi == 0) wsf[32 + r32] = l_run;
    asm volatile("s_waitcnt lgkmcnt(0)" ::: "memory");
    bf16_t* Ow = (bf16_t*)(F.ws + WS_R1) + (size_t)(b * SEQ + q0 + wid * 32) * 512 + h * 64;
    { LAS bf16_t* stg = (LAS bf16_t*)(shm + L_OST) + wid * 2048;
#pragma unroll
      for (int r = 0; r < 16; ++r) { const int orow = crow(r, hi); const float rl = __builtin_amdgcn_rcpf(wsf[32 + orow]);
#pragma unroll
          for (int d0 = 0; d0 < 2; ++d0) stg[orow * 64 + d0 * 32 + r32] = (bf16_t)f2bf(o[d0][r] * rl); }
      asm volatile("s_waitcnt lgkmcnt(0)" ::: "memory");
#pragma unroll
      for (int i = 0; i < 4; ++i) { const int row = i * 8 + (lane >> 3), chn = lane & 7; const u32x4 v = *(const LAS u32x4*)(stg + row * 64 + chn * 8); *(u32x4*)(Ow + (size_t)row * 512 + chn * 8) = v; } }
    asm volatile("s_waitcnt lgkmcnt(0)" ::: "memory");
#undef DMA_K
#undef DMA_V
#undef DMA_M
}

__device__ __forceinline__ void attn_phase(const Args& args, Frame& F) {
    const int v = F.vcu;
    for (int i = 0; i < 4; ++i) {
        for (int uu = v; uu < 256; uu += F.G) {
            const int bh = uu >> 2, s = uu & 3; const int qb = (i == 0) ? s : (i == 1) ? 7 - s : (i == 2) ? 8 + s : 15 - s;
            attn_unit(args, F, bh >> 3, bh & 7, qb);
        }
    }
}
}
#ifndef PROBE_NO_STATE
#define PROBE_NO_STATE 0
#endif
#ifndef PROBE_TINV_ID
#define PROBE_TINV_ID 0
#endif
namespace rk {
typedef __bf16 bf16x2_t __attribute__((ext_vector_type(2)));
__device__ __forceinline__ unsigned cvtpk(float lo, float hi) { f32x2 v = {lo, hi}; bf16x2_t b = __builtin_convertvector(v, bf16x2_t); return __builtin_bit_cast(unsigned, b); }
template <int S> __device__ __forceinline__ bf16x8 frag(const f32x16& x) {
    u32x4 o; o.x = cvtpk(x[8 * S + 0], x[8 * S + 1]); o.y = cvtpk(x[8 * S + 2], x[8 * S + 3]); o.z = cvtpk(x[8 * S + 4], x[8 * S + 5]); o.w = cvtpk(x[8 * S + 6], x[8 * S + 7]);
    return __builtin_bit_cast(bf16x8, o); }
template <int S> __device__ __forceinline__ void unfrag(f32x16& x, bf16x8 f) { const u32x4 o = __builtin_bit_cast(u32x4, f);
    x[8 * S + 0] = bf_lo(o.x); x[8 * S + 1] = bf_hi(o.x); x[8 * S + 2] = bf_lo(o.y); x[8 * S + 3] = bf_hi(o.y); x[8 * S + 4] = bf_lo(o.z); x[8 * S + 5] = bf_hi(o.z); x[8 * S + 6] = bf_lo(o.w); x[8 * S + 7] = bf_hi(o.w); }
#define RK_MF(a, b, c) __builtin_amdgcn_mfma_f32_32x32x16_bf16((a), (b), (c), 0, 0, 0)
__device__ __forceinline__ float dppf(float v, const int ctrl_is_const_dummy);
#define RK_DPP(v, ctrl, rmask, bc) __builtin_bit_cast(float, __builtin_amdgcn_update_dpp(0, __builtin_bit_cast(int, (v)), (ctrl), (rmask), 0xF, (bc)))
__device__ __forceinline__ float scan32(float v) {
#ifdef PROBE_SHFL_SCAN
    const int l32 = threadIdx.x & 31;
#pragma unroll
    for (int o = 1; o < 32; o <<= 1) { const float t = __shfl_up(v, o, 32); if (l32 >= o) v += t; }
    return v;
#endif
    v += RK_DPP(v, 0x111, 0xF, true); v += RK_DPP(v, 0x112, 0xF, true); v += RK_DPP(v, 0x114, 0xF, true); v += RK_DPP(v, 0x118, 0xF, true);
    v += RK_DPP(v, 0x142, 0xA, false);
    return v; }
__device__ __forceinline__ float ex2(float x) { return __builtin_amdgcn_exp2f(x); }
constexpr int PZ = 3600;
constexpr size_t SZ_G = 8192, SZ_H = 8192, SZ_Q = 4096, SZ_Y = 4096;
constexpr float L2E = 1.4426950408889634f;

__device__ __forceinline__ void mk_id(bf16x8 (&fId)[2], int r, int h) {
    asm volatile("" : "+v"(r), "+v"(h));
#pragma unroll
    for (int s = 0; s < 2; ++s) { unsigned short e8[8];
#pragma unroll
        for (int jj = 0; jj < 8; ++jj) e8[jj] = (16 * s + 8 * (jj >> 2) + 4 * h + (jj & 3) == r) ? (unsigned short)0x3F80 : (unsigned short)0;
        fId[s] = __builtin_bit_cast(bf16x8, (u32x4){(unsigned)e8[0] | ((unsigned)e8[1] << 16), (unsigned)e8[2] | ((unsigned)e8[3] << 16), (unsigned)e8[4] | ((unsigned)e8[5] << 16), (unsigned)e8[6] | ((unsigned)e8[7] << 16)}); }
}

__device__ __forceinline__ void load_params(const Args& args, Frame& F) {
    LAS float* pra = (LAS float*)(F.lds + LDS_PARA); LAS float* prb = (LAS float*)(F.lds + LDS_PARB);
    const float* mu = AIN(7); const float* w0 = AIN(8); const float* a0 = AIN(10); const float* kk = AIN(13); const float* ka = AIN(14); const float* rk = AIN(15);
    for (int i = F.tid; i < 4096; i += NTHR) { const int a = i >> 9, c = i & 511;
        const float v_ = a < 3 ? mu[a * 512 + c] : (a == 3 ? w0[c] : (a == 4 ? a0[c] : (a == 5 ? kk[c] : (a == 6 ? ka[c] : rk[c]))));
        if (a < 4) pra[c * 4 + a] = v_; else prb[c * 4 + a - 4] = v_; }
    __syncthreads();
}
struct ElemCtx { const LAS unsigned char* rowc; const LAS unsigned char* rowp; const bf16_t* DUt; const bf16_t* IUt; const LAS float* pra; const LAS float* prb; int hd, r, h; float inv; };
template <int MODE> __device__ __forceinline__ void r1_elem(const ElemCtx& C, int jt, bf16x8 (&o0)[2], bf16x8 (&o1)[2], bf16x8 (&o2)[2], bf16x8 (&o3)[2], float& bns, float& pcd) {
    const int r = C.r, h = C.h, hd = C.hd;
    f32x16 lw_ = f32x16{}, la_ = f32x16{};
#pragma unroll
    for (int ks = 0; ks < 4; ++ks) { const int k0 = 16 * ks + 8 * h;
        const bf16x8 bw = *(const LAS bf16x8*)(C.rowc + (1536 + k0) * 2), ba = *(const LAS bf16x8*)(C.rowc + (1600 + k0) * 2);
        const bf16x8 fa = *(const bf16x8*)(C.DUt + (size_t)(32 * jt + r) * 64 + k0), fi = *(const bf16x8*)(C.IUt + (size_t)(32 * jt + r) * 64 + k0);
        lw_ = RK_MF(fa, bw, lw_); la_ = RK_MF(fi, ba, la_); }
    float d = 0.f;
#pragma unroll
    for (int s = 0; s < 2; ++s) { float x0[8], x1[8], x2[8], x3[8];
#pragma unroll
        for (int g2 = 0; g2 < 2; ++g2) { const int g = 2 * s + g2, cj = hd * 64 + 32 * jt + 8 * g + 4 * h;
            float kc[4], kq[4], xc[4], xq[4];
            { const u32x2 a = *(const LAS u32x2*)(C.rowc + (512 + cj) * 2), p = *(const LAS u32x2*)(C.rowp + (512 + cj) * 2);
              kc[0] = bf_lo(a.x); kc[1] = bf_hi(a.x); kc[2] = bf_lo(a.y); kc[3] = bf_hi(a.y); kq[0] = bf_lo(p.x); kq[1] = bf_hi(p.x); kq[2] = bf_lo(p.y); kq[3] = bf_hi(p.y); }
            { const int xo = MODE ? 1024 : 0; const u32x2 a = *(const LAS u32x2*)(C.rowc + (xo + cj) * 2), p = *(const LAS u32x2*)(C.rowp + (xo + cj) * 2);
              xc[0] = bf_lo(a.x); xc[1] = bf_hi(a.x); xc[2] = bf_lo(a.y); xc[3] = bf_hi(a.y); xq[0] = bf_lo(p.x); xq[1] = bf_hi(p.x); xq[2] = bf_lo(p.y); xq[3] = bf_hi(p.y); }
            const LAS f32x4* ppa = (const LAS f32x4*)(C.pra + cj * 4); const LAS f32x4* ppb = (const LAS f32x4*)(C.prb + cj * 4);
#pragma unroll
            for (int q = 0; q < 4; ++q) { const int i = 4 * g + q, o = 4 * g2 + q;
                const f32x4 pa = ppa[q], pb = ppb[q];
                const float e_ = 0.6065306597126334f * fast_sigmoid(pa[3] + lw_[i]); const float L = scan32(e_);
                const float l0 = __builtin_bit_cast(float, __builtin_amdgcn_readlane(__builtin_bit_cast(int, L), 31)), l1 = __builtin_bit_cast(float, __builtin_amdgcn_readlane(__builtin_bit_cast(int, L), 63));
                const float Lend = h ? l1 : l0; if (i == 4 * (r >> 3) + (r & 3)) d = Lend;
                const float x_ = xc[q] + (MODE ? pa[2] : pa[0]) * (xq[q] - xc[q]), k_ = kc[q] + pa[1] * (kq[q] - kc[q]);
                const float ic = fast_sigmoid(pb[0] + la_[i]);
                const float kk = k_ * pb[1] * C.inv, kpn = k_ * (1.0f + (ic - 1.0f) * pb[2]), bv = kk * ic;
                if (MODE) { const float Qe = ex2(L2E * (L - Lend)); x0[o] = bv * Qe; x1[o] = kpn * Qe; x2[o] = x_; x3[o] = 0.f; }
                else { const float P = ex2(-L2E * L), Pi = ex2(L2E * L), Pm = ex2(-L2E * (L - e_)); bns += x_ * kpn * pb[3]; x0[o] = -kk * Pm; x1[o] = x_ * P; x2[o] = bv * Pi; x3[o] = kpn * Pi; } }
            asm volatile("" ::: "memory"); }
        o0[s] = __builtin_bit_cast(bf16x8, (u32x4){cvtpk(x0[0], x0[1]), cvtpk(x0[2], x0[3]), cvtpk(x0[4], x0[5]), cvtpk(x0[6], x0[7])});
        o1[s] = __builtin_bit_cast(bf16x8, (u32x4){cvtpk(x1[0], x1[1]), cvtpk(x1[2], x1[3]), cvtpk(x1[4], x1[5]), cvtpk(x1[6], x1[7])});
        o2[s] = __builtin_bit_cast(bf16x8, (u32x4){cvtpk(x2[0], x2[1]), cvtpk(x2[2], x2[3]), cvtpk(x2[4], x2[5]), cvtpk(x2[6], x2[7])});
        if (!MODE) o3[s] = __builtin_bit_cast(bf16x8, (u32x4){cvtpk(x3[0], x3[1]), cvtpk(x3[2], x3[3]), cvtpk(x3[4], x3[5]), cvtpk(x3[6], x3[7])}); }
    if (MODE) pcd = ex2(-L2E * d);
}


__device__ __forceinline__ void r1_unit(const Args& args, Frame& F, int b, int c) {
    LAS unsigned char* IMG = F.lds;
    const bf16_t* Z = (const bf16_t*)(F.ws + WS_Z);
    const int t0 = 32 * c; const size_t m0 = (size_t)b * SEQ + t0;
    const float* mu = AIN(7);
    int tid = F.tid; asm volatile("" : "+v"(tid));
    __syncthreads();
    { const unsigned lds0 = (unsigned)(uintptr_t)IMG; const int ln = tid & 63;
      for (int task = F.wave; task < 33 * 4; task += NWAVES) { const int rr = task >> 2, j = task & 3, pc = 64 * j + ln;
          if (pc < 224) { if (rr > 0 || t0 > 0) att::glds16(Z + (m0 + rr - 1) * ZW + ZR + 8 * pc, (unsigned)__builtin_amdgcn_readfirstlane((int)(lds0 + rr * PZ + 1024 * j)));
                          else *(LAS u32x4*)(IMG + 16 * pc) = (u32x4){0u, 0u, 0u, 0u}; } }
      asm volatile("s_waitcnt vmcnt(0)" ::: "memory"); }
    __syncthreads();
    { u32x4 actv[2];
#pragma unroll
      for (int i = 0; i < 2; ++i) { const int q = tid + NTHR * i, t = q >> 5, kp = q & 31;
          const u32x4 cw = *(const LAS u32x4*)(IMG + (t + 1) * PZ + (1536 + 8 * kp) * 2), pw = *(const LAS u32x4*)(IMG + t * PZ + (1536 + 8 * kp) * 2);
          const f32x4 m0v = *(const f32x4*)(mu + 1536 + 8 * kp), m1v = *(const f32x4*)(mu + 1536 + 8 * kp + 4);
          const unsigned cwa[4] = {cw.x, cw.y, cw.z, cw.w}, pwa[4] = {pw.x, pw.y, pw.z, pw.w}; float x[8];
#pragma unroll
          for (int j = 0; j < 4; ++j) { const float c0 = bf_lo(cwa[j]), c1 = bf_hi(cwa[j]), p0 = bf_lo(pwa[j]), p1 = bf_hi(pwa[j]);
              const float mu0 = j < 2 ? m0v[2 * j] : m1v[2 * j - 4], mu1 = j < 2 ? m0v[2 * j + 1] : m1v[2 * j - 3];
              x[2 * j] = c0 + mu0 * (p0 - c0); x[2 * j + 1] = c1 + mu1 * (p1 - c1); }
#pragma unroll
          for (int j = 0; j < 8; ++j) { if (kp < 8) { const float e2 = ex2(2.885390081777927f * x[j]); x[j] = 1.0f - 2.0f * __builtin_amdgcn_rcpf(e2 + 1.0f); } else if (kp >= 16) x[j] = fast_sigmoid(x[j]); }
          actv[i] = (u32x4){cvtpk(x[0], x[1]), cvtpk(x[2], x[3]), cvtpk(x[4], x[5]), cvtpk(x[6], x[7])}; }
      __syncthreads();
#pragma unroll
      for (int i = 0; i < 2; ++i) { const int q = tid + NTHR * i, t = q >> 5, kp = q & 31; *(LAS u32x4*)(IMG + (t + 1) * PZ + (1536 + 8 * kp) * 2) = actv[i]; }
      __syncthreads(); }
    const int hd = F.wave; int r = tid & 31, h = (tid >> 5) & 1;
    const LAS unsigned char* rowc = IMG + (r + 1) * PZ; const LAS unsigned char* rowp = IMG + r * PZ;
    const bf16_t* DUt = (const bf16_t*)(F.ws + WS_DUT) + (size_t)hd * 4096; const bf16_t* IUt = (const bf16_t*)(F.ws + WS_IUT) + (size_t)hd * 4096;
    const LAS float* pra = (const LAS float*)(F.lds + LDS_PARA); const LAS float* prb = (const LAS float*)(F.lds + LDS_PARB);
    float n2 = 0.f;
#pragma unroll
    for (int jt = 0; jt < 2; ++jt)
#pragma unroll
        for (int g = 0; g < 4; ++g) { const int cj = hd * 64 + 32 * jt + 8 * g + 4 * h;
            const u32x2 a = *(const LAS u32x2*)(rowc + (512 + cj) * 2), p = *(const LAS u32x2*)(rowp + (512 + cj) * 2);
            const float kc[4] = {bf_lo(a.x), bf_hi(a.x), bf_lo(a.y), bf_hi(a.y)}, kq[4] = {bf_lo(p.x), bf_hi(p.x), bf_lo(p.y), bf_hi(p.y)};
            #pragma unroll
            for (int q = 0; q < 4; ++q) { const float muk = pra[(cj + q) * 4 + 1], kkp = prb[(cj + q) * 4 + 1]; const float k_ = kc[q] + muk * (kq[q] - kc[q]); const float kk_ = k_ * kkp; n2 += kk_ * kk_; } }
    n2 += __shfl_xor(n2, 32);
    const float inv = 1.0f / __builtin_fmaxf(sqrtf(n2), 1e-12f);
    float pcd[2] = {0.f, 0.f};
    float bns = 0.f;
    const ElemCtx EC{rowc, rowp, DUt, IUt, pra, prb, hd, r, h, inv};
    f32x16 Aab = f32x16{}, Aak = f32x16{}, Arb = f32x16{}, Ark = f32x16{};
    bf16x8 fRt[2][2], tAt[2][2];
    { bf16x8 fId[2]; mk_id(fId, r, h);
#pragma unroll
    for (int jt = 0; jt < 2; ++jt) { bf16x8 fA[2], fB[2], fK[2]; float pd_ = 0.f;
        r1_elem<0>(EC, jt, fA, fRt[jt], fB, fK, bns, pd_);
        const bf16x8 fA0 = fA[0], fA1 = fA[1], fB0 = fB[0], fB1 = fB[1], fK0 = fK[0], fK1 = fK[1];
        Aab = RK_MF(fB0, fA0, Aab); Aab = RK_MF(fB1, fA1, Aab); Aak = RK_MF(fK0, fA0, Aak); Aak = RK_MF(fK1, fA1, Aak);
        Arb = RK_MF(fB0, fRt[jt][0], Arb); Arb = RK_MF(fB1, fRt[jt][1], Arb); Ark = RK_MF(fK0, fRt[jt][0], Ark); Ark = RK_MF(fK1, fRt[jt][1], Ark);
        { f32x16 t_ = f32x16{}; t_ = RK_MF(fA0, fId[0], t_); t_ = RK_MF(fA1, fId[1], t_); tAt[jt][0] = frag<0>(t_); tAt[jt][1] = frag<1>(t_); } } }
    bns += __shfl_xor(bns, 32);
    if (h == 0) ((float*)(F.ws + WS_TOPW))[(m0 + r) * 8 + hd] = bns;
    LAS unsigned char* stash = IMG + (1 + ((tid & 63) >> 3)) * PZ + hd * 128 + (tid & 7) * 16;
#pragma unroll
    for (int p = 0; p < 4; ++p) *(LAS u32x4*)(stash + 8 * p * PZ) = __builtin_bit_cast(u32x4, fRt[p >> 1][p & 1]);
#pragma unroll
    for (int i = 0; i < 16; ++i) { const int s = 8 * (i >> 2) + 4 * h + (i & 3);
        if (!(s < r)) { Aab[i] = 0.f; Aak[i] = 0.f; } if (!(s <= r)) { Arb[i] = 0.f; Ark[i] = 0.f; } }
    const bf16x8 fAak[2] = {frag<0>(Aak), frag<1>(Aak)}, fArb[2] = {frag<0>(Arb), frag<1>(Arb)}, fArk[2] = {frag<0>(Ark), frag<1>(Ark)};
    bf16x8 fT[2];
    asm volatile("" ::: "memory"); __builtin_amdgcn_sched_barrier(0);
    { float T[32];
#pragma unroll
      for (int s = 31; s >= 0; --s) { float acc = (r == s) ? 1.0f : 0.f; const int is = 4 * (s >> 3) + (s & 3), hs = (s >> 2) & 1;
          const float acol_ = Aab[is]; const int acol_i = __float_as_int(acol_);
#pragma unroll
          for (int u = s + 1; u < (PROBE_TINV_ID ? 0 : 32); ++u) { int sv_; asm volatile("v_readlane_b32 %0, %1, %2" : "=s"(sv_) : "v"(acol_i), "n"(u + 32 * hs)); acc = __builtin_fmaf(T[u], __int_as_float(sv_), acc); }
          T[s] = acc; __builtin_amdgcn_sched_barrier(0); }
#pragma unroll
      for (int s = 0; s < 2; ++s) { float e8[8];
#pragma unroll
          for (int jj = 0; jj < 8; ++jj) { const int i0 = 16 * s + 8 * (jj >> 2) + (jj & 3); float ta = T[i0], tb = T[i0 + 4]; asm volatile("" : "+v"(ta), "+v"(tb)); e8[jj] = h ? tb : ta; }
          fT[s] = __builtin_bit_cast(bf16x8, (u32x4){cvtpk(e8[0], e8[1]), cvtpk(e8[2], e8[3]), cvtpk(e8[4], e8[5]), cvtpk(e8[6], e8[7])}); } }
    asm volatile("" ::: "memory"); __builtin_amdgcn_sched_barrier(0);
    const size_t uid = ((size_t)(b * 8 + hd) * 128 + c);
    unsigned char* gG = F.ws + WS_R0 + uid * SZ_G; unsigned char* gH = F.ws + WS_R2 + uid * SZ_H; unsigned char* gQ = F.ws + WS_H0 + uid * SZ_Q; unsigned char* gY = F.ws + WS_H1 + uid * SZ_Y;
#define RK_ST(base, piece, f) (*(u32x4*)((base) + (piece) * 1024 + (tid & 63) * 16) = __builtin_bit_cast(u32x4, (f)))
    bf16x8 fWt[2][2];
#pragma unroll
    for (int jt = 0; jt < 2; ++jt) { f32x16 w_ = f32x16{}; w_ = RK_MF(fT[0], tAt[jt][0], w_); w_ = RK_MF(fT[1], tAt[jt][1], w_); fWt[jt][0] = frag<0>(w_); fWt[jt][1] = frag<1>(w_);
        f32x16 q_; unfrag<0>(q_, __builtin_bit_cast(bf16x8, *(const LAS u32x4*)(stash + 8 * (2 * jt) * PZ))); unfrag<1>(q_, __builtin_bit_cast(bf16x8, *(const LAS u32x4*)(stash + 8 * (2 * jt + 1) * PZ)));
        q_ = RK_MF(fWt[jt][0], fArb[0], q_); q_ = RK_MF(fWt[jt][1], fArb[1], q_); RK_ST(gQ, 2 * jt, frag<0>(q_)); RK_ST(gQ, 2 * jt + 1, frag<1>(q_)); }
    bf16x8 tBh[2][2], tKh[2][2], tV[2][2];
    { bf16x8 fId[2]; mk_id(fId, r, h);
#pragma unroll
    for (int jt = 0; jt < 2; ++jt) { bf16x8 fBh[2], fKh[2], fV[2], fdum[2]; float bdum = 0.f;
        r1_elem<1>(EC, jt, fBh, fKh, fV, fdum, bdum, pcd[jt]);
        { f32x16 t_ = f32x16{}; t_ = RK_MF(fBh[0], fId[0], t_); t_ = RK_MF(fBh[1], fId[1], t_); tBh[jt][0] = frag<0>(t_); tBh[jt][1] = frag<1>(t_); }
        { f32x16 t_ = f32x16{}; t_ = RK_MF(fKh[0], fId[0], t_); t_ = RK_MF(fKh[1], fId[1], t_); tKh[jt][0] = frag<0>(t_); tKh[jt][1] = frag<1>(t_); }
        { f32x16 t_ = f32x16{}; t_ = RK_MF(fV[0], fId[0], t_); t_ = RK_MF(fV[1], fId[1], t_); tV[jt][0] = frag<0>(t_); tV[jt][1] = frag<1>(t_); } } }
    bf16x8 fUt[2][2];
#pragma unroll
    for (int it = 0; it < 2; ++it) { f32x16 av = f32x16{}; av = RK_MF(fAak[0], tV[it][0], av); av = RK_MF(fAak[1], tV[it][1], av);
        const bf16x8 fav0 = frag<0>(av), fav1 = frag<1>(av); f32x16 u_ = f32x16{}; u_ = RK_MF(fT[0], fav0, u_); u_ = RK_MF(fT[1], fav1, u_); fUt[it][0] = frag<0>(u_); fUt[it][1] = frag<1>(u_); }
#pragma unroll
    for (int it = 0; it < 2; ++it) { f32x16 y_ = f32x16{}; y_ = RK_MF(fUt[it][0], fArb[0], y_); y_ = RK_MF(fUt[it][1], fArb[1], y_); y_ = RK_MF(tV[it][0], fArk[0], y_); y_ = RK_MF(tV[it][1], fArk[1], y_);
        RK_ST(gY, 2 * it, frag<0>(y_)); RK_ST(gY, 2 * it + 1, frag<1>(y_)); }
#pragma unroll
    for (int jt = 0; jt < 2; ++jt)
#pragma unroll
        for (int j2 = 0; j2 < 2; ++j2) { f32x16 g_ = f32x16{}; g_ = RK_MF(fWt[jt][0], tBh[j2][0], g_); g_ = RK_MF(fWt[jt][1], tBh[j2][1], g_);
            if (jt == j2) {
#pragma unroll
                for (int i = 0; i < 16; ++i) if (i == 4 * (r >> 3) + (r & 3) && h == ((r >> 2) & 1)) g_[i] += pcd[jt]; }
            RK_ST(gG, 2 * (jt * 2 + j2), frag<0>(g_)); RK_ST(gG, 2 * (jt * 2 + j2) + 1, frag<1>(g_)); }
#pragma unroll
    for (int j2 = 0; j2 < 2; ++j2)
#pragma unroll
        for (int it = 0; it < 2; ++it) { f32x16 h_ = f32x16{}; h_ = RK_MF(tBh[j2][0], fUt[it][0], h_); h_ = RK_MF(tBh[j2][1], fUt[it][1], h_); h_ = RK_MF(tKh[j2][0], tV[it][0], h_); h_ = RK_MF(tKh[j2][1], tV[it][1], h_);
            RK_ST(gH, 2 * (j2 * 2 + it), frag<0>(h_)); RK_ST(gH, 2 * (j2 * 2 + it) + 1, frag<1>(h_)); }
}

template <int DRY> __device__ __forceinline__ void r2_task(const Args& args, Frame& F, int task) {
    const bool st_ok = !DRY || args.li == 12345;
    const int bh = task >> 1, it = task & 1;
    f32x16 St[2]; St[0] = f32x16{}; St[1] = f32x16{};
    const unsigned char* gG0 = F.ws + WS_R0 + (size_t)bh * 128 * SZ_G + F.lane * 16; unsigned char* gH0 = F.ws + WS_R2 + (size_t)bh * 128 * SZ_H + F.lane * 16;
    bf16x8 G0[2][2][2], H0[2][2], G1[2][2][2], H1[2][2], G2[2][2][2], H2[2][2];
#define R2_LOAD(G_, H_, c_) do { const int cc_ = (c_) < 128 ? (c_) : 127;     \
        _Pragma("unroll") for (int jt = 0; jt < 2; ++jt) _Pragma("unroll") for (int j2 = 0; j2 < 2; ++j2) _Pragma("unroll") for (int s = 0; s < 2; ++s) \
            G_[jt][j2][s] = __builtin_bit_cast(bf16x8, *(const u32x4*)(gG0 + (size_t)cc_ * SZ_G + (2 * (jt * 2 + j2) + s) * 1024)); \
        _Pragma("unroll") for (int j2 = 0; j2 < 2; ++j2) _Pragma("unroll") for (int s = 0; s < 2; ++s) H_[j2][s] = __builtin_bit_cast(bf16x8, *(const u32x4*)(gH0 + (size_t)cc_ * SZ_H + (2 * (j2 * 2 + it) + s) * 1024)); } while (0)
#define R2_STEP(G_, H_, c_, LOADNEXT) do { \
        const bf16x8 fS[2][2] = {{frag<0>(St[0]), frag<1>(St[0])}, {frag<0>(St[1]), frag<1>(St[1])}}; \
        if (st_ok) { _Pragma("unroll") for (int jt = 0; jt < 2; ++jt) _Pragma("unroll") for (int s = 0; s < 2; ++s) \
            *(u32x4*)(gH0 + (size_t)(c_) * SZ_H + (2 * (jt * 2 + it) + s) * 1024) = __builtin_bit_cast(u32x4, fS[jt][s]); }     \
        __builtin_amdgcn_sched_barrier(0); LOADNEXT; __builtin_amdgcn_sched_barrier(0);     \
        _Pragma("unroll") for (int j2 = 0; j2 < 2; ++j2) { unfrag<0>(St[j2], H_[j2][0]); unfrag<1>(St[j2], H_[j2][1]); \
            _Pragma("unroll") for (int jt = 0; jt < 2; ++jt) { St[j2] = RK_MF(G_[jt][j2][0], fS[jt][0], St[j2]); St[j2] = RK_MF(G_[jt][j2][1], fS[jt][1], St[j2]); } } \
        __builtin_amdgcn_sched_barrier(0); \
    } while (0)
    R2_LOAD(G0, H0, 0); R2_LOAD(G1, H1, 1);
#pragma unroll 1
    for (int c = 0; c < 126; c += 3) {
        R2_STEP(G0, H0, c, R2_LOAD(G2, H2, c + 2));
        R2_STEP(G1, H1, c + 1, R2_LOAD(G0, H0, c + 3));
        R2_STEP(G2, H2, c + 2, R2_LOAD(G1, H1, c + 4));
    }
    R2_STEP(G0, H0, 126, (void)0);
    R2_STEP(G1, H1, 127, (void)0);
#undef R2_STEP
#undef R2_LOAD
}

constexpr int PV2 = 1296;
__device__ __forceinline__ void r3_unit(const Args& args, Frame& F, int b, int c) {
    LAS unsigned char* IMG = F.lds;
    const bf16_t* Z = (const bf16_t*)(F.ws + WS_Z);
    const int t0 = 32 * c; const size_t m0 = (size_t)b * SEQ + t0;
    const float* mu = AIN(7);
    int tid = F.tid; asm volatile("" : "+v"(tid));
    __syncthreads();
    { const unsigned lds0 = (unsigned)(uintptr_t)IMG; const int ln = tid & 63;
      for (int task = F.wave; task < 33 * 2; task += NWAVES) { const int rr = task >> 1, j = task & 1, pc = 64 * j + ln;
          if (pc < 80) { const int col = j == 0 ? ZR_V + 8 * ln : ZR_GD + 8 * ln;
              if (rr > 0 || t0 > 0) att::glds16(Z + (m0 + rr - 1) * ZW + col, (unsigned)__builtin_amdgcn_readfirstlane((int)(lds0 + rr * PV2 + 1024 * j)));
              else *(LAS u32x4*)(IMG + 16 * pc) = (u32x4){0u, 0u, 0u, 0u}; } }
      asm volatile("s_waitcnt vmcnt(0)" ::: "memory"); }
    __syncthreads();
    { const int t = tid >> 4, kp = tid & 15;
      const u32x4 cw = *(const LAS u32x4*)(IMG + (t + 1) * PV2 + 1024 + 16 * kp), pw = *(const LAS u32x4*)(IMG + t * PV2 + 1024 + 16 * kp);
      const f32x4 m0v = *(const f32x4*)(mu + 1664 + 8 * kp), m1v = *(const f32x4*)(mu + 1664 + 8 * kp + 4);
      const unsigned cwa[4] = {cw.x, cw.y, cw.z, cw.w}, pwa[4] = {pw.x, pw.y, pw.z, pw.w}; float x[8];
#pragma unroll
      for (int j = 0; j < 4; ++j) { const float c0 = bf_lo(cwa[j]), c1 = bf_hi(cwa[j]), p0 = bf_lo(pwa[j]), p1 = bf_hi(pwa[j]);
          const float mu0 = j < 2 ? m0v[2 * j] : m1v[2 * j - 4], mu1 = j < 2 ? m0v[2 * j + 1] : m1v[2 * j - 3];
          x[2 * j] = fast_sigmoid(c0 + mu0 * (p0 - c0)); x[2 * j + 1] = fast_sigmoid(c1 + mu1 * (p1 - c1)); }
      const u32x4 o = {cvtpk(x[0], x[1]), cvtpk(x[2], x[3]), cvtpk(x[4], x[5]), cvtpk(x[6], x[7])};
      __syncthreads();
      *(LAS u32x4*)(IMG + (t + 1) * PV2 + 1024 + 16 * kp) = o;
      __syncthreads(); }
    const int hd = F.wave; int r = tid & 31, h = (tid >> 5) & 1;
    const LAS unsigned char* rowc = IMG + (r + 1) * PV2; const LAS unsigned char* rowp = IMG + r * PV2;
    const size_t uid = ((size_t)(b * 8 + hd) * 128 + c);
    const unsigned char* gS = F.ws + WS_R2 + uid * SZ_H; const unsigned char* gQ = F.ws + WS_H0 + uid * SZ_Q; const unsigned char* gY = F.ws + WS_H1 + uid * SZ_Y;
#define RK_LD(base, piece) __builtin_bit_cast(bf16x8, *(const u32x4*)((base) + (piece) * 1024 + (tid & 63) * 16))
    f32x16 gl[2]; gl[0] = f32x16{}; gl[1] = f32x16{};
    { const bf16_t* GUt = (const bf16_t*)(F.ws + WS_GUT) + (size_t)hd * 64 * 128;
#pragma unroll
      for (int ks = 0; ks < 8; ++ks) { const int k0 = 16 * ks + 8 * h; const bf16x8 bg = *(const LAS bf16x8*)(rowc + 1024 + k0 * 2);
#pragma unroll
          for (int it = 0; it < 2; ++it) { const bf16x8 fg = *(const bf16x8*)(GUt + (size_t)(32 * it + r) * 128 + k0); gl[it] = RK_MF(fg, bg, gl[it]); } } }
    f32x16 Y[2];
    { const bf16x8 fQ[2][2] = {{RK_LD(gQ, 0), RK_LD(gQ, 1)}, {RK_LD(gQ, 2), RK_LD(gQ, 3)}};
#pragma unroll
      for (int it = 0; it < 2; ++it) { unfrag<0>(Y[it], RK_LD(gY, 2 * it)); unfrag<1>(Y[it], RK_LD(gY, 2 * it + 1));
#pragma unroll
          for (int jt = 0; jt < 2; ++jt) { if (PROBE_NO_STATE) continue; Y[it] = RK_MF(RK_LD(gS, 2 * (jt * 2 + it)), fQ[jt][0], Y[it]); Y[it] = RK_MF(RK_LD(gS, 2 * (jt * 2 + it) + 1), fQ[jt][1], Y[it]); } } }
    float s1 = 0.f;
#pragma unroll
    for (int it = 0; it < 2; ++it)
#pragma unroll
        for (int i = 0; i < 16; ++i) s1 += Y[it][i];
    s1 += __shfl_xor(s1, 32); const float mean = s1 * (1.0f / 64.0f); float s2 = 0.f;
#pragma unroll
    for (int it = 0; it < 2; ++it)
#pragma unroll
        for (int i = 0; i < 16; ++i) { const float d = Y[it][i] - mean; s2 += d * d; }
    s2 += __shfl_xor(s2, 32); const float rstd = 1.0f / sqrtf(s2 * (1.0f / 64.0f) + GN_EPS);
    const float bn = ((const float*)(F.ws + WS_TOPW))[(m0 + r) * 8 + hd];
    LAS unsigned char* stg = F.lds + 49152 + F.wave * 4608;
#pragma unroll
    for (int it = 0; it < 2; ++it)
#pragma unroll
        for (int g = 0; g < 4; ++g) { const int cl = 32 * it + 8 * g + 4 * h, cj = hd * 64 + cl;
            const u32x2 a = *(const LAS u32x2*)(rowc + cj * 2), p = *(const LAS u32x2*)(rowp + cj * 2);
            const float vc[4] = {bf_lo(a.x), bf_hi(a.x), bf_lo(a.y), bf_hi(a.y)}, vq[4] = {bf_lo(p.x), bf_hi(p.x), bf_lo(p.y), bf_hi(p.y)};
            const f32x4 muv = *(const f32x4*)(mu + 1024 + cj), lg = *(const f32x4*)(AIN(16) + cj), lb = *(const f32x4*)(AIN(17) + cj);
            float o[4];
#pragma unroll
            for (int q = 0; q < 4; ++q) { const int i = 4 * g + q; const float v_ = vc[q] + muv[q] * (vq[q] - vc[q]);
                o[q] = ((Y[it][i] - mean) * rstd * lg[q] + lb[q] + bn * v_) * gl[it][i]; }
            *(LAS u32x2*)(stg + r * 144 + cl * 2) = (u32x2){cvtpk(o[0], o[1]), cvtpk(o[2], o[3])}; }
    asm volatile("s_waitcnt lgkmcnt(0)" ::: "memory");
    bf16_t* OUT = (bf16_t*)(F.ws + WS_R0) + m0 * 512 + hd * 64;
#pragma unroll
    for (int i = 0; i < 4; ++i) { const int row = i * 8 + ((tid & 63) >> 3), chn = tid & 7; const u32x4 v = *(const LAS u32x4*)(stg + row * 144 + chn * 16); *(u32x4*)(OUT + (size_t)row * 512 + chn * 8) = v; }
#undef RK_LD
#undef RK_ST
}
}
__device__ __forceinline__ void route_token(float lg, float bias, int lane, int tok, int* TE, float* TW, LAS unsigned* lcnt) {
    const float s = 1.0f / (1.0f + expf(-lg));
    const float c = s + bias;
    const unsigned long long kc = ((unsigned long long)ord_key(c) << 6) | (unsigned)(63 - lane);
    int rk = 0;
#pragma unroll 1
    for (int d = 1; d < 8; ++d) { const unsigned long long o = __shfl_xor(kc, d); rk += (o > kc) ? 1 : 0; }
    float gs = rk < 2 ? c : 0.f;
    gs += __shfl_xor(gs, 1); gs += __shfl_xor(gs, 2); gs += __shfl_xor(gs, 4);
    const int grp = lane >> 3;
    const unsigned long long kg = ((unsigned long long)ord_key(gs) << 6) | (unsigned)(63 - grp);
    int grk = 0;
#pragma unroll 1
    for (int d = 1; d < 8; ++d) { const unsigned long long o = __shfl_xor(kg, 8 * d); grk += (o > kg) ? 1 : 0; }
    const unsigned long long km = grk < 4 ? kc : (unsigned long long)(63 - lane);
    int erk = 0;
#pragma unroll 1
    for (int d = 1; d < 64; ++d) { const unsigned long long o = __shfl_xor(km, d); erk += (o > km) ? 1 : 0; }
    const bool sel = erk < 8;
    const float ssum = wave_sum(sel ? s : 0.f);
    if (sel) { TE[(size_t)tok * 8 + erk] = lane; TW[(size_t)tok * 8 + erk] = s / ssum * 2.5f; atomicAdd((unsigned*)&lcnt[(tok >= M / 2 ? 64 : 0) + lane], 1u); }
}
__device__ __forceinline__ void norm2_route_wave(const Args& args, Frame& F, LAS unsigned* lcnt) {
    bf16_t* H2 = (bf16_t*)(F.ws + WS_H2);
    norm_mod_rows(args, F, F.out, AIN(21), 3072, 4096, H2, nullptr);
    asm volatile("s_waitcnt vmcnt(0)" ::: "memory");
    const int lane = F.lane, row0 = F.gw * 16;
    const bf16_t* ap = H2 + (size_t)(row0 + (lane & 15)) * D + 8 * (lane >> 4);
    const bf16_t* bp = (const bf16_t*)(F.ws + WS_WRT) + (size_t)(lane & 15) * D + 8 * (lane >> 4);
    f32x4 acc[4] = {f32x4{}, f32x4{}, f32x4{}, f32x4{}};
#pragma unroll 1
    for (int k0 = 0; k0 < 32; k0 += 4) { bf16x8 a_[4], b_[4][4];
#pragma unroll
        for (int i = 0; i < 4; ++i) { a_[i] = *(const bf16x8*)(ap + 32 * (k0 + i));
#pragma unroll
            for (int nt = 0; nt < 4; ++nt) b_[i][nt] = *(const bf16x8*)(bp + (size_t)(16 * nt) * D + 32 * (k0 + i)); }
#pragma unroll
        for (int i = 0; i < 4; ++i)
#pragma unroll
            for (int nt = 0; nt < 4; ++nt) acc[nt] = __builtin_amdgcn_mfma_f32_16x16x32_bf16(a_[i], b_[i][nt], acc[nt], 0, 0, 0); }
    LAS float* scr = (LAS float*)(F.lds + F.wave * 16384);
#pragma unroll
    for (int nt = 0; nt < 4; ++nt)
#pragma unroll
        for (int i = 0; i < 4; ++i) scr[(4 * (lane >> 4) + i) * 65 + 16 * nt + (lane & 15)] = acc[nt][i];
    asm volatile("s_waitcnt lgkmcnt(0)" ::: "memory");
    int* TE = (int*)(F.ws + WS_TOPE); float* TW = (float*)(F.ws + WS_TOPW);
    const float bias = AIN(23)[lane];
#pragma unroll 1
    for (int t = 0; t < 16; ++t) route_token(scr[t * 65 + lane], bias, lane, row0 + t, TE, TW, lcnt);
    asm volatile("s_waitcnt lgkmcnt(0)" ::: "memory");
}
__device__ __forceinline__ void norm2_route_convert(const Args& args, Frame& F) {
    LAS unsigned* lcnt = (LAS unsigned*)(F.lds + LDS_TILETAB);
    if (F.tid < 128) lcnt[F.tid] = 0u;
    __syncthreads();
    constexpr int KIT = (64 * (16 * 16 + 4 * 32) + NWAVES * 256 - 1) / (NWAVES * 256) + 1;
    if (F.wave < 4) { norm2_route_wave(args, F, lcnt); convert_experts(args, F, 0, KIT); }
    else { convert_experts(args, F, 0, KIT / 2); norm2_route_wave(args, F, lcnt); convert_experts(args, F, KIT / 2, KIT); }
    __syncthreads();
    if (F.tid < 128 && lcnt[F.tid]) atomicAdd(F.ctl + CW_CNT + F.tid, lcnt[F.tid]);
    __syncthreads();
}
struct MoeTab { int ntiles0, ntiles; };
__device__ __forceinline__ MoeTab build_tiles(const Args& args, Frame& F) {
    LAS unsigned* tab = (LAS unsigned*)(F.lds + LDS_TILETAB);
    LAS unsigned* offs = tab + 2432; LAS unsigned* tpre = tab + 2560;
    if (F.tid == 0) { unsigned o = 0, tp = 0;
        for (int l = 0; l < 128; ++l) { const unsigned c = __hip_atomic_load(F.ctl + CW_CNT + l, RLX_AGENT); offs[l] = o; tpre[l] = tp; o += c; tp += (c + 255u) >> 8; }
        tpre[128] = tp; }
    __syncthreads();
    if (F.tid < 128) { const int l = F.tid; const unsigned c = __hip_atomic_load(F.ctl + CW_CNT + l, RLX_AGENT); const unsigned o = offs[l], t0 = tpre[l], nt = (c + 255u) >> 8;
        for (unsigned i = 0; i < nt; ++i) { const unsigned rows = (c - 256u * i) < 256u ? (c - 256u * i) : 256u; tab[2 * (t0 + i)] = (o + 256u * i) | ((unsigned)(l & 63) << 20); tab[2 * (t0 + i) + 1] = rows; } }
    __syncthreads();
    MoeTab r; r.ntiles0 = (int)tpre[64]; r.ntiles = (int)tpre[128]; return r;
}
__device__ __forceinline__ void scatter_phase(const Args& args, Frame& F) {
    LAS unsigned* tab = (LAS unsigned*)(F.lds + LDS_TILETAB); LAS unsigned* offs = tab + 2432;
    LAS unsigned* lcnt = (LAS unsigned*)(F.lds); LAS unsigned* lbase = lcnt + 128;
    const int* TE = (const int*)(F.ws + WS_TOPE); const float* TW = (const float*)(F.ws + WS_TOPW);
    int* ST = (int*)(F.ws + WS_STOK); float* SW = (float*)(F.ws + WS_SW);
    for (int blk = blockIdx.x; blk < M / 128; blk += F.G) {
        if (F.tid < 128) lcnt[F.tid] = 0u;
        __syncthreads();
        const int tok0 = blk * 128, hf = tok0 >= M / 2 ? 64 : 0;
        int lst[2]; unsigned rnk[2];
#pragma unroll
        for (int i = 0; i < 2; ++i) { const int p = F.tid + 512 * i; lst[i] = hf + TE[(size_t)tok0 * 8 + p]; rnk[i] = atomicAdd((unsigned*)&lcnt[lst[i]], 1u); }
        __syncthreads();
        if (F.tid < 128) lbase[F.tid] = lcnt[F.tid] ? atomicAdd(F.ctl + CW_CUR + F.tid, lcnt[F.tid]) : 0u;
        __syncthreads();
#pragma unroll
        for (int i = 0; i < 2; ++i) { const int p = F.tid + 512 * i; const unsigned pos = offs[lst[i]] + lbase[lst[i]] + rnk[i];
            ST[pos] = tok0 * 8 + p; SW[pos] = TW[(size_t)tok0 * 8 + p]; }
        __syncthreads();
    }
}

__device__ __forceinline__ void final_rows(const Args& args, Frame& F, int row_lo, int row_hi, int tokbase) {
    const unsigned char* SL = (const unsigned char*)(F.ws + WS_SLOT);
    const int cA = 256 * (F.lane >> 4) + 32 * ((F.lane >> 2) & 3) + 8 * (F.lane & 3), cB = cA + 128;
    for (int blk = F.gw; blk < (row_hi - row_lo) / 16; blk += F.NGW) {
        const int r0 = row_lo + blk * 16, b = r0 / SEQ;
        const float* g2 = (const float*)(F.ws + WS_MOD) + b * 6144 + 5120; const float* fgp = AIN(30);
        f32x4 gv[4], fg[4];
#pragma unroll
        for (int j = 0; j < 4; ++j) { const int c = (j < 2 ? cA : cB) + 4 * (j & 1); gv[j] = *(const f32x4*)(g2 + c) * (1.0f / SLOT_SCALE); fg[j] = *(const f32x4*)(fgp + c); }
        for (int r = 0; r < 16; ++r) { const size_t m = (size_t)(r0 + r);
            f32x4 acc[4];
#pragma unroll
            for (int j = 0; j < 4; ++j) acc[j] = (f32x4){0.f, 0.f, 0.f, 0.f};
            const unsigned char* sp = SL + (m - tokbase) * NSLOT * D + 16 * F.lane;
            u32x4 w[NSLOT];
#pragma unroll
            for (int k = 0; k < NSLOT; ++k) w[k] = *(const u32x4*)(sp + (size_t)k * D);
#pragma unroll
            for (int k = 0; k < NSLOT; ++k) { const unsigned ww[4] = {w[k].x, w[k].y, w[k].z, w[k].w};
#pragma unroll
                for (int j = 0; j < 4; ++j) { const f32x2 a = __builtin_amdgcn_cvt_pk_f32_fp8((int)ww[j], false), c = __builtin_amdgcn_cvt_pk_f32_fp8((int)ww[j], true); acc[j] += (f32x4){a.x, a.y, c.x, c.y}; } }
            float* xr = F.out + m * D; f32x4 v[4]; float s = 0.f;
#pragma unroll
            for (int j = 0; j < 4; ++j) { const int c = (j < 2 ? cA : cB) + 4 * (j & 1); v[j] = *(const f32x4*)(xr + c) + gv[j] * acc[j]; s += (v[j].x * v[j].x + v[j].y * v[j].y) + (v[j].z * v[j].z + v[j].w * v[j].w); }
            const float rstd = 1.0f / sqrtf(wave_sum(s) * (1.0f / D) + RMS_EPS);
#pragma unroll
            for (int j = 0; j < 4; ++j) { const int c = (j < 2 ? cA : cB) + 4 * (j & 1); *(f32x4*)(xr + c) = v[j] * rstd * fg[j]; }
        }
    }
}
constexpr int N_PHASES = 15;
#ifndef PROBE_ATT_SCALE
#define PROBE_ATT_SCALE 1.0f
#endif
#ifndef PROBE_IDX_REP
#define PROBE_IDX_REP 1
#endif
#ifndef R2_WGS
#define R2_WGS 32
#endif
#ifndef PROBE_P5_PART
#define PROBE_P5_PART 0
#endif
#ifndef PROBE_RW_SCALE
#define PROBE_RW_SCALE 1.0f
#endif

__global__ void __launch_bounds__(NTHR, 2) fwd_kernel(Args args) {
    extern __shared__ __attribute__((aligned(16))) unsigned char lds_raw[];
    Frame F;
    F.lds = (LAS unsigned char*)lds_raw;
    F.MISC = (volatile LAS unsigned*)(F.lds + MISC_OFF);
    F.tid = threadIdx.x; F.lane = F.tid & 63; F.wave = __builtin_amdgcn_readfirstlane(F.tid >> 6);
    F.G = gridDim.x; { const int bx = blockIdx.x; F.vcu = (F.G % 8 == 0) ? (bx % 8) * (F.G / 8) + bx / 8 : bx; }
    F.gw = blockIdx.x * NWAVES + F.wave; F.NGW = F.G * NWAVES;
    F.ws = args.ws; F.out = args.out; F.ctl = (unsigned*)(args.ws + WS_CTL);
    for (int u = F.tid; u < (LDS_BYTES - LDSCTL_OFF) / 4; u += NTHR) ((LAS unsigned*)(F.lds + LDSCTL_OFF))[u] = 0u;
    __syncthreads();
    if (F.tid == 0) {
#pragma unroll
        for (int i = 0; i < 31; ++i) *(LAS unsigned long long*)(F.lds + LDS_PTAB + 8 * i) = (unsigned long long)args.in[i];
        *(LAS unsigned long long*)(F.lds + LDS_PTAB + 8 * 31) = (unsigned long long)args.out; *(LAS unsigned long long*)(F.lds + LDS_PTAB + 8 * 32) = (unsigned long long)args.ws; }
    __syncthreads();
    XcdBarrier bar = xcd_barrier_post(F.ctl + CW_BAR + args.li * XCD_BAR_WORDS, F.MISC + 8);
    const int lo = args.ph_lo, hi = args.ph_hi;
#ifndef PHASE_MASK
#define PHASE_MASK 0xFFFFFFFFu
#endif
#define IN(k) ((((PHASE_MASK) >> (k)) & 1u) && lo <= (k) && (k) < hi)
#define PB() do { F.ws = (unsigned char*)ain_ptr(F.lds, 32); F.out = (float*)ain_ptr(F.lds, 31); F.ctl = (unsigned*)(F.ws + WS_CTL); \
        F.lane = (int)__builtin_amdgcn_mbcnt_hi(~0u, __builtin_amdgcn_mbcnt_lo(~0u, 0u)); F.tid = F.wave * 64 + F.lane; } while (0)
#define ZB ((bf16_t*)(F.ws + WS_Z))
#define GATES ((bf16_t*)F.out)
#define MOD ((const float*)(F.ws + WS_MOD))
#define SEAM(k) do { if (IN(k) && IN((k) + 1)) xcd_barrier(bar); } while (0)

    if (IN(0)) { PB(); p0_prologue(args, F); } SEAM(0);
    if (IN(1)) { PB(); norm_mod_rows(args, F, AIN(0), AIN(4), 0, 1024, nullptr, F.ws + WS_H0); } SEAM(1);
    if (IN(2)) { PB(); pg8::StaticOrder S; S.init(M, NIN, F.G, (int)blockIdx.x); pg8::DenseSrcT<1> G{F.ws + WS_H0, F.ws + WS_WIN, 1024};
        EpiInProj E{ZB, GATES}; pg8::gemm_phase<EpiInProj, pg8::StaticOrder, pg8::DenseSrcT<1>>(F.lds, 1024, S, G, E); } SEAM(2);
    if (IN(3)) { PB(); rk::load_params(args, F); for (int u = blockIdx.x; u < 1024; u += F.G) rk::r1_unit(args, F, u >> 7, u & 127); __syncthreads(); } SEAM(3);
    if (IN(4)) { PB();
#ifdef PROBE_R2_DRY
        if (blockIdx.x < R2_WGS && F.wave < 128 / R2_WGS) rk::r2_task<1>(args, F, blockIdx.x * (128 / R2_WGS) + F.wave);
#endif
        if (blockIdx.x < R2_WGS && F.wave < 128 / R2_WGS) rk::r2_task<0>(args, F, blockIdx.x * (128 / R2_WGS) + F.wave);
#pragma unroll 1
        for (int rep = 0; rep < PROBE_IDX_REP; ++rep)
        for (;;) {
            __syncthreads();
            if (F.tid == 0) F.MISC[12] = atomicAdd(F.ctl + CW_Q + rep, 1u);
            __syncthreads();
            const int u = (int)F.MISC[12];
            if (u >= 2048) break;
            indexer_unit(args, F, u & 7, (255 - (u >> 3)) * 16);
        } } SEAM(4);
    if (IN(5)) { PB(); if (!(PROBE_P5_PART == 2 && args.li == 1)) { for (int u = blockIdx.x; u < 1024; u += F.G) rk::r3_unit(args, F, u >> 7, u & 127); } __syncthreads();
        if (!(PROBE_P5_PART == 1 && args.li == 1)) for (int i = 0; i < 4; ++i) for (int uu = F.vcu; uu < 256; uu += F.G) { const int bh = uu >> 2, s = uu & 3; const int qb = (i == 0) ? s : (i == 1) ? 7 - s : (i == 2) ? 8 + s : 15 - s;
            att::attn_unit(args, F, bh >> 3, bh & 7, qb); } __syncthreads(); } SEAM(5);
    if (IN(6)) { PB(); pg8::StaticOrder S; S.init(M, D, F.G, (int)blockIdx.x);
        { pg8::DenseSrc G{F.ws + WS_R1, F.ws + WS_WA, 512}; EpiMerge<0> E{(bf16_t*)(F.ws + WS_R2), F.ws + WS_H0, GATES, PROBE_ATT_SCALE}; pg8::gemm_phase<EpiMerge<0>, pg8::StaticOrder, pg8::DenseSrc>(F.lds, 512, S, G, E); }
        { pg8::DenseSrc G{F.ws + WS_R0, F.ws + WS_WR, 512}; EpiMerge<1> E{(bf16_t*)(F.ws + WS_R2), F.ws + WS_H0, GATES, PROBE_RW_SCALE}; pg8::gemm_phase<EpiMerge<1>, pg8::StaticOrder, pg8::DenseSrc>(F.lds, 512, S, G, E); } } SEAM(6);
    if (IN(7)) { PB(); pg8::StaticOrder S; S.init(M, D, F.G, (int)blockIdx.x); pg8::DenseSrcT<1> G{F.ws + WS_H0, F.ws + WS_WO, 1024};
        EpiOutProj E{AIN(0), F.out, MOD}; pg8::gemm_phase<EpiOutProj, pg8::StaticOrder, pg8::DenseSrcT<1>>(F.lds, 1024, S, G, E); } SEAM(7);
    if (IN(8)) { PB(); norm2_route_convert(args, F); }
    if (IN(8) && IN(11)) xcd_barrier(bar);
    MoeTab mt{0, 0};
    if (lo <= 13 && hi > 13) { PB(); mt = build_tiles(args, F); scatter_phase(args, F); } else if (hi > 13) { PB(); mt = build_tiles(args, F); }
    SEAM(11);
    const LAS unsigned* tab = (const LAS unsigned*)(F.lds + LDS_TILETAB);
    if (IN(12)) { PB(); MoeSched1 S{tab, mt.ntiles, F.G, F.vcu};            MoeSrc1 G{F.ws};
        EpiMoe1 E{F.ws}; pg8::gemm_phase<EpiMoe1, MoeSched1, MoeSrc1>(F.lds, 1024, S, G, E); } SEAM(12);
    if (IN(13)) { PB(); MoeSched2 S{tab, 0, mt.ntiles, 512, F.G, F.vcu}; MoeSrc2 G{F.ws}; EpiMoe2 E{F.ws, F.out, 0};
        pg8::gemm_phase<EpiMoe2, MoeSched2, MoeSrc2>(F.lds, 256, S, G, E); } SEAM(13);
    if (IN(14)) { PB(); final_rows(args, F, 0, M, 0); }
#undef IN
#undef SEAM
#undef PB
}

extern "C" void kernel_launch(void* const* d_in, const int* in_sizes, int n_in, void* d_out, int out_size, void* d_ws, size_t ws_size, hipStream_t stream) {
    static int grid = 0;
    if (grid == 0) {
        if (n_in != 31 || out_size != M * D || ws_size < WS_END) { fprintf(stderr, "kernel_launch: unexpected problem (n_in %d, out %d, ws %zu)\n", n_in, out_size, ws_size); grid = -1; return; }
        int dev = 0, cus = 0, per_cu = 0;
        if (hipGetDevice(&dev) != hipSuccess || hipDeviceGetAttribute(&cus, hipDeviceAttributeMultiprocessorCount, dev) != hipSuccess) { grid = -1; return; }
        if (hipFuncSetAttribute((const void*)fwd_kernel, hipFuncAttributeMaxDynamicSharedMemorySize, LDS_BYTES) != hipSuccess) { fprintf(stderr, "kernel_launch: hipFuncSetAttribute failed\n"); grid = -1; return; }
        if (hipOccupancyMaxActiveBlocksPerMultiprocessor(&per_cu, (const void*)fwd_kernel, NTHR, LDS_BYTES) != hipSuccess || per_cu < 1) fprintf(stderr, "kernel_launch: occupancy query reports %d\n", per_cu);
        (void)hipGetLastError();
        grid = cus;
        if (grid != 256) fprintf(stderr, "kernel_launch: %d CUs (built for 256)\n", grid);
    }
    if (grid < 0) return;
    (void)in_sizes;
    if (hipMemsetAsync((char*)d_ws + WS_CTL, 0, CTL_ZERO_BYTES, stream) != hipSuccess) return;
    Args a{};
    for (int i = 0; i < 31; ++i) a.in[i] = (const float*)d_in[i];
    a.out = (float*)d_out; a.ws = (unsigned char*)d_ws;
#ifndef PROBE_REPEAT
#define PROBE_REPEAT -1
#endif
    int li = 0;
    auto go = [&](int lo_, int hi_) { a.ph_lo = lo_; a.ph_hi = hi_; a.li = li++; hipLaunchKernelGGL(fwd_kernel, dim3(grid), dim3(NTHR), LDS_BYTES, stream, a); };
    if (PROBE_REPEAT < 0) go(0, N_PHASES);
    else { go(0, PROBE_REPEAT + 1); go(PROBE_REPEAT, PROBE_REPEAT + 1); if (PROBE_REPEAT + 1 < N_PHASES) go(PROBE_REPEAT + 1, N_PHASES); }
}
```

```cpp
#include <hip/hip_runtime.h>
#include <cstdio>
#include <cstdint>
#include <cmath>

#define GAS __attribute__((address_space(1)))
#define LAS __attribute__((address_space(3)))
typedef unsigned short bf16_t;
typedef short bf16x8 __attribute__((ext_vector_type(8)));
typedef float f32x4 __attribute__((ext_vector_type(4)));
typedef float f32x2 __attribute__((ext_vector_type(2)));
typedef float f32x16 __attribute__((ext_vector_type(16)));
typedef unsigned u32x4 __attribute__((ext_vector_type(4)));
typedef unsigned u32x2 __attribute__((ext_vector_type(2)));
typedef GAS unsigned gu32;

__device__ __forceinline__ unsigned cvt_pk_bf16(float lo, float hi) { unsigned r; asm volatile("v_cvt_pk_bf16_f32 %0, %1, %2" : "=v"(r) : "v"(lo), "v"(hi)); return r; }
__device__ __forceinline__ float bf_lo(unsigned w) { return __uint_as_float(w << 16); }
__device__ __forceinline__ float bf_hi(unsigned w) { return __uint_as_float(w & 0xffff0000u); }
__device__ __forceinline__ float bf2f(bf16_t b) { return __uint_as_float(((unsigned)b) << 16); }
__device__ __forceinline__ unsigned f2bf(float f) { unsigned u = __float_as_uint(f); return (u + 0x7fffu + ((u >> 16) & 1u)) >> 16; }
__device__ __forceinline__ unsigned pk2(float lo, float hi) { return f2bf(lo) | (f2bf(hi) << 16); }
__device__ __forceinline__ float fast_sigmoid(float x) { return __builtin_amdgcn_rcpf(1.0f + __builtin_amdgcn_exp2f(-1.4426950408889634f * x)); }
__device__ __forceinline__ float wave_sum(float v) {
#pragma unroll
    for (int o = 1; o < 64; o <<= 1) v += __shfl_xor(v, o);
    return v;
}

namespace pg8 {
constexpr int BM = 256, BK = 64, HALF = 128, HTB = HALF * BK * 2, STAGE_BYTES = 8 * HTB, NXCD = 8, WGM = 8;
__host__ __device__ __forceinline__ int lds_byte(int r, int c) { const int st = (r >> 4) * 2 + (c >> 5), rr = r & 15, cc = c & 31, ob = rr * 64 + cc * 2; return st * 1024 + (ob ^ (((ob >> 9) & 1) << 5)); }
__host__ __device__ __forceinline__ void stage_rc(int b, int& R, int& C) { const int st = b / 1024, sb = b % 1024, swz = sb ^ (((sb >> 9) & 1) << 5); R = (st >> 1) * 16 + swz / 64; C = (st & 1) * 32 + (swz % 64) / 2; }
__host__ __device__ __forceinline__ int perm32(int rho) { const int n = rho >> 4, i = rho & 15; return 8 * (i >> 2) + 4 * n + (i & 3); }

struct Unit { int pm, pn; int aux0, aux1; };

struct StaticOrder {
    int nM, nN, nwg, G, c;
    __host__ __device__ void init(int M, int N, int G_, int c_) { nM = M / BM; nN = N / BM; nwg = nM * nN; G = G_; c = c_; }
    __host__ __device__ bool next(int i, Unit& u) const {
        const long L = (long)i * G + c; if (L >= nwg) return false;
        int wgid = (int)L; { const int q = nwg / NXCD, r = nwg % NXCD, xcd = wgid % NXCD, off = wgid / NXCD; wgid = (xcd < r ? xcd * (q + 1) : r * (q + 1) + (xcd - r) * q) + off; }
        const int nig = WGM * nN, gid = wgid / nig, fm = gid * WGM, gsz = (nM - fm) < WGM ? (nM - fm) : WGM;
        u.pm = fm + ((wgid % nig) % gsz); u.pn = (wgid % nig) / gsz; u.aux0 = 0; u.aux1 = 0; return true;
    }
};

template <int ESZ_> struct DenseSrcT {
    static constexpr int ESZ = ESZ_; static constexpr bool GATHER = false;
    const void* A; const void* Bt; int K;
    __device__ __forceinline__ const char* b_base(const Unit& u) const { return (const char*)Bt + (size_t)u.pn * 256 * K * ESZ; }
    __device__ __forceinline__ const char* a_base(const Unit& u) const { return (const char*)A + (size_t)u.pm * 256 * K * ESZ; }
    __device__ __forceinline__ unsigned a_off(const Unit&, int R, int C) const { return (unsigned)(R * K * ESZ) + (unsigned)C * 2u; }
};
typedef DenseSrcT<2> DenseSrc;
typedef int v8i32 __attribute__((ext_vector_type(8)));

template <class T, class = void> struct has_prefetch { static constexpr bool value = false; };
template <class T> struct has_prefetch<T, decltype((void)&T::prefetch)> { static constexpr bool value = true; };
template <class Epi, class Sched, class Src, bool ALIGN_EPI = true>
__device__ __forceinline__ void gemm_phase(LAS unsigned char* lds, const int K, const Sched& S, const Src& G, const Epi& E) {
    const int tid = threadIdx.x, wid = __builtin_amdgcn_readfirstlane(tid >> 6), lane = tid & 63, wr = wid >> 2, wc = wid & 3, fr = lane & 15, fq = lane >> 4;
    constexpr int ESZ = Src::ESZ; const int Kb = K * ESZ;
    const int nt = Kb / (BK * 2);
    unsigned voffB0;
    { int R, C; stage_rc(tid * 16, R, C); const int Rb = Epi::PERM ? ((R & ~31) + perm32(R & 31)) : R; voffB0 = (unsigned)(Rb * Kb) + (unsigned)C * 2u; }
#define PG8_AOFF(u, h, i) ([&]() { int R_, C_; stage_rc(tid * 16 + (i) * 8192, R_, C_); return G.a_off((u), R_ + (h) * HALF, C_); }())
    const size_t kstep = (size_t)(BK * 2);
    const size_t hstepB = (size_t)HALF * Kb;
    const unsigned ldsw = (unsigned)wid * 1024u;
    const int aoff = lds_byte(wr * 64 + fr, fq * 8), boff = lds_byte(wc * 32 + fr, fq * 8);
#define PG8_SA(b, h) (((b) * 2 + (h)) * HTB)
#define PG8_SB(b, h) ((4 + (b) * 2 + (h)) * HTB)
#define PG8_STAGEB(bufoff, gbase) do { _Pragma("unroll") for (int _i = 0; _i < 2; ++_i) { unsigned o_ = voffB0; asm volatile("" : "+v"(o_)); \
        __builtin_amdgcn_global_load_lds((const unsigned*)((const char*)(gbase) + (size_t)_i * 64 * Kb + o_), (LAS unsigned*)(lds + (bufoff) + ldsw + _i * 8192), 16, 0, 0); } } while (0)
#define PG8_STAGEA(bufoff, gbase, vo, h) do { _Pragma("unroll") for (int _i = 0; _i < 2; ++_i) { unsigned o_ = Src::GATHER ? (vo)[h][_i] : (vo)[0][0]; asm volatile("" : "+v"(o_)); \
        __builtin_amdgcn_global_load_lds((const unsigned*)((const char*)(gbase) + (Src::GATHER ? (size_t)0 : (size_t)((h) * 128 + _i * 64) * Kb) + o_), (LAS unsigned*)(lds + (bufoff) + ldsw + _i * 8192), 16, 0, 0); } } while (0)
#define PG8_STAGEA2(bufoff, gbase, h) do { _Pragma("unroll") for (int _i = 0; _i < 2; ++_i) { unsigned o_ = Src::GATHER ? (last ? vn[h][_i] : vc[h][_i]) : vc[0][0]; asm volatile("" : "+v"(o_)); \
        __builtin_amdgcn_global_load_lds((const unsigned*)((const char*)(gbase) + (Src::GATHER ? (size_t)0 : (size_t)((h) * 128 + _i * 64) * Kb) + o_), (LAS unsigned*)(lds + (bufoff) + ldsw + _i * 8192), 16, 0, 0); } } while (0)
#define PG8_LDA(dst, b, h) do { _Pragma("unroll") for (int m = 0; m < 4; ++m) { const u32x4 lo_ = *(const LAS u32x4*)(lds + PG8_SA(b, h) + aoff + m * 2048), hi_ = *(const LAS u32x4*)(lds + PG8_SA(b, h) + aoff + m * 2048 + 1024); \
        dst[m] = __builtin_shufflevector(lo_, hi_, 0, 1, 2, 3, 4, 5, 6, 7); } } while (0)
#define PG8_LDB(dst, b, h) do { _Pragma("unroll") for (int n = 0; n < 2; ++n) { const u32x4 lo_ = *(const LAS u32x4*)(lds + PG8_SB(b, h) + boff + n * 2048), hi_ = *(const LAS u32x4*)(lds + PG8_SB(b, h) + boff + n * 2048 + 1024); \
        dst[n] = __builtin_shufflevector(lo_, hi_, 0, 1, 2, 3, 4, 5, 6, 7); } } while (0)
#define PG8_LO(x) __builtin_bit_cast(bf16x8, __builtin_shufflevector((x), (x), 0, 1, 2, 3))
#define PG8_HI(x) __builtin_bit_cast(bf16x8, __builtin_shufflevector((x), (x), 4, 5, 6, 7))
#define PG8_MMA(ai, bj, At, Bt) do { __builtin_amdgcn_s_setprio(1); _Pragma("unroll") for (int m = 0; m < 4; ++m) _Pragma("unroll") for (int n = 0; n < 2; ++n) { \
        if constexpr (ESZ == 1) acc[ai][bj][m][n] = __builtin_amdgcn_mfma_scale_f32_16x16x128_f8f6f4(__builtin_bit_cast(v8i32, Bt[n]), __builtin_bit_cast(v8i32, At[m]), acc[ai][bj][m][n], 0, 0, 0, 0, 0, 0); \
        else { acc[ai][bj][m][n] = __builtin_amdgcn_mfma_f32_16x16x32_bf16(PG8_LO(Bt[n]), PG8_LO(At[m]), acc[ai][bj][m][n], 0, 0, 0); \
               acc[ai][bj][m][n] = __builtin_amdgcn_mfma_f32_16x16x32_bf16(PG8_HI(Bt[n]), PG8_HI(At[m]), acc[ai][bj][m][n], 0, 0, 0); } } \
        __builtin_amdgcn_s_setprio(0); } while (0)
#define PG8_WAIT_V(n) asm volatile("s_waitcnt vmcnt(" #n ")" ::: "memory")
#define PG8_WAIT_L(n) asm volatile("s_waitcnt lgkmcnt(" #n ")" ::: "memory")
#define PG8_BAR __builtin_amdgcn_s_barrier()
#define PG8_SCHED __builtin_amdgcn_sched_barrier(0)
    Unit cur, nxt; int ui = 0;
    if (!S.next(0, cur)) return;
#define PG8_PREFETCH(u_) do { if constexpr (has_prefetch<Epi>::value) { int ln_; asm volatile("v_mbcnt_lo_u32_b32 %0, -1, 0\n\tv_mbcnt_hi_u32_b32 %0, -1, %0" : "=v"(ln_)); E.prefetch((u_), wr, ln_ & 15); } } while (0)
    PG8_PREFETCH(cur);
    f32x4 acc[2][2][4][2];
#pragma unroll
    for (int a = 0; a < 2; ++a)
#pragma unroll
        for (int b = 0; b < 2; ++b)
#pragma unroll
            for (int m = 0; m < 4; ++m)
#pragma unroll
                for (int n = 0; n < 2; ++n) acc[a][b][m][n] = (f32x4){0.f, 0.f, 0.f, 0.f};
    typedef unsigned u32x8 __attribute__((ext_vector_type(8)));
    u32x8 At[4], B0[2], B1[2];
    unsigned vc[2][2], vn[2][2];
#pragma unroll
    for (int h = 0; h < 2; ++h)
#pragma unroll
        for (int i = 0; i < 2; ++i) vc[h][i] = PG8_AOFF(cur, h, i);
    const char* cA = G.a_base(cur); const char* cB = G.b_base(cur);
    PG8_STAGEB(PG8_SB(0, 0), cB); PG8_STAGEB(PG8_SB(0, 1), cB + hstepB); PG8_STAGEA(PG8_SA(0, 0), cA, vc, 0); PG8_STAGEA(PG8_SA(0, 1), cA, vc, 1);
    if (wr == 1) PG8_BAR;
    PG8_WAIT_V(2); PG8_BAR;
    PG8_STAGEB(PG8_SB(1, 0), cB + kstep); PG8_STAGEA(PG8_SA(1, 0), cA + kstep, vc, 0); PG8_STAGEB(PG8_SB(1, 1), cB + hstepB + kstep);
    PG8_WAIT_V(6); PG8_BAR;
    for (;;) {
        const bool has_next = S.next(ui + 1, nxt);
        const char* nA = has_next ? G.a_base(nxt) : cA; const char* nB = has_next ? G.b_base(nxt) : cB;
        if constexpr (Src::GATHER) {
#pragma unroll
        for (int h = 0; h < 2; ++h)
#pragma unroll
            for (int i = 0; i < 2; ++i) vn[h][i] = has_next ? PG8_AOFF(nxt, h, i) : vc[h][i]; }
#pragma clang loop unroll(disable)
        for (int t = 0; t < nt; t += 2) {
            const bool last = (t == nt - 2);
            const char* a1 = cA + (size_t)(t + 1) * kstep;
            const char* a2 = last ? nA : cA + (size_t)(t + 2) * kstep; const char* b2 = last ? nB : cB + (size_t)(t + 2) * kstep;
            const char* a3 = a2 + kstep; const char* b3 = b2 + kstep;
            PG8_LDB(B0, 0, 0); PG8_LDB(B1, 0, 1); PG8_SCHED; PG8_LDA(At, 0, 0); PG8_STAGEA(PG8_SA(1, 1), a1, vc, 1);
            PG8_WAIT_V(8); PG8_WAIT_L(0); PG8_BAR; PG8_MMA(0, 0, At, B0); PG8_MMA(0, 1, At, B1); PG8_BAR; PG8_SCHED;
            PG8_LDA(At, 0, 1); PG8_STAGEB(PG8_SB(0, 0), b2); PG8_STAGEB(PG8_SB(0, 1), b2 + hstepB); PG8_STAGEA2(PG8_SA(0, 0), a2, 0);
            PG8_WAIT_V(8); PG8_WAIT_L(0); PG8_BAR; PG8_MMA(1, 0, At, B0); PG8_MMA(1, 1, At, B1); PG8_BAR; PG8_SCHED;
            PG8_LDB(B0, 1, 0); PG8_LDB(B1, 1, 1); PG8_SCHED; PG8_LDA(At, 1, 0); PG8_STAGEA2(PG8_SA(0, 1), a2, 1);
            PG8_WAIT_V(8); PG8_WAIT_L(0); PG8_BAR; PG8_MMA(0, 0, At, B0); PG8_MMA(0, 1, At, B1); PG8_BAR; PG8_SCHED;
            PG8_LDA(At, 1, 1); PG8_STAGEB(PG8_SB(1, 0), b3); PG8_STAGEB(PG8_SB(1, 1), b3 + hstepB); PG8_STAGEA2(PG8_SA(1, 0), a3, 0);
            PG8_WAIT_V(8); PG8_WAIT_L(0); PG8_BAR; PG8_MMA(1, 0, At, B0); PG8_MMA(1, 1, At, B1); PG8_BAR; PG8_SCHED;
        }
        if constexpr (ALIGN_EPI) { if (wr == 0) PG8_BAR; }
        { int ln_; asm volatile("v_mbcnt_lo_u32_b32 %0, -1, 0\n\tv_mbcnt_hi_u32_b32 %0, -1, %0" : "=v"(ln_)); E(acc, cur, wr, wc, ln_ & 15, ln_ >> 4); }
        if (!has_next) break;
#pragma unroll
        for (int a = 0; a < 2; ++a)
#pragma unroll
            for (int b = 0; b < 2; ++b)
#pragma unroll
                for (int m = 0; m < 4; ++m)
#pragma unroll
                    for (int n = 0; n < 2; ++n) acc[a][b][m][n] = (f32x4){0.f, 0.f, 0.f, 0.f};
        cur = nxt; cA = nA; cB = nB; ++ui;
        PG8_PREFETCH(cur);
        if constexpr (Src::GATHER) {
#pragma unroll
        for (int h = 0; h < 2; ++h)
#pragma unroll
            for (int i = 0; i < 2; ++i) vc[h][i] = vn[h][i]; }
        if constexpr (ALIGN_EPI) { if (wr == 1) PG8_BAR; }
    }
    PG8_WAIT_V(0);
    if constexpr (!ALIGN_EPI) { if (wr == 0) PG8_BAR; }
    PG8_BAR;
#undef PG8_PREFETCH
#undef PG8_SA
#undef PG8_AOFF
#undef PG8_SB
#undef PG8_STAGEA
#undef PG8_STAGEA2
#undef PG8_STAGEB
#undef PG8_LDA
#undef PG8_LDB
#undef PG8_MMA
#undef PG8_LO
#undef PG8_HI
#undef PG8_WAIT_V
#undef PG8_WAIT_L
#undef PG8_BAR
#undef PG8_SCHED
}
}
#define RLX_AGENT __ATOMIC_RELAXED, __HIP_MEMORY_SCOPE_AGENT
#define LDS_WAIT() asm volatile("s_waitcnt lgkmcnt(0)" ::: "memory")
#define VM_WAIT() asm volatile("s_waitcnt vmcnt(0)" ::: "memory")
#define XB_TMO      128
#define XB_XCNT(j)  (256  + 64 * (j))
#define XB_XSUB(j)  (1280 + 64 * (j))
#define XB_XGEN(j)  (2304 + 64 * (j))
#define XB_TOP      3328
#define XB_TOPGEN   3392
#define XCD_BAR_WORDS 3456
#define XB_SPIN_CAP (1u << 18)

__device__ __forceinline__ unsigned xb_ld(unsigned* p)              { return __hip_atomic_load(p, __ATOMIC_RELAXED, __HIP_MEMORY_SCOPE_AGENT); }
__device__ __forceinline__ unsigned xb_add(unsigned* p, unsigned v) { return __hip_atomic_fetch_add(p, v, __ATOMIC_RELAXED, __HIP_MEMORY_SCOPE_AGENT); }
__device__ __forceinline__ unsigned xb_xcc_id() { return (unsigned)__builtin_amdgcn_s_getreg((3 << 11) | 20) & 0xFu; }
#define XB_SPIN(cond, bar) do { unsigned _sp = 0; while (cond) { __builtin_amdgcn_s_sleep(1); \
    if ((++_sp & 255u) == 0u) { if (xb_ld(&(bar)[XB_TMO])) break; if (_sp > XB_SPIN_CAP) { atomicAdd(&(bar)[XB_TMO], 1u); break; } } } } while (0)

struct XcdBarrier {
    unsigned* bar; unsigned x;
    volatile LAS unsigned* st;
};

__device__ __forceinline__ XcdBarrier xcd_barrier_post(unsigned* bar, volatile LAS unsigned* st) {
    XcdBarrier b; b.bar = bar; b.x = xb_xcc_id(); b.st = st;
    if (threadIdx.x == 0) (void)xb_add(&bar[XB_XCNT(b.x)], 1u);
    return b;
}
__device__ __forceinline__ void xcd_barrier_complete(unsigned* bar, unsigned x, unsigned& nloc, unsigned& nx) {
    const unsigned G = gridDim.x * gridDim.y * gridDim.z;
    unsigned sum, cnt, mine, sp = 0u;
    for (;;) {
        sum = 0u; cnt = 0u; mine = 0u;
#pragma unroll
        for (unsigned j = 0; j < 16; ++j) { const unsigned c = xb_ld(&bar[XB_XCNT(j)]); sum += c; cnt += (c > 0u) ? 1u : 0u; mine = (j == x) ? c : mine; }
        if (sum == G) break;
        __builtin_amdgcn_s_sleep(1);
        if ((++sp & 255u) == 0u) { if (xb_ld(&bar[XB_TMO])) break; if (sp > XB_SPIN_CAP) { atomicAdd(&bar[XB_TMO], 1u); break; } }
    }
    nloc = mine > 0u ? mine : 1u; nx = cnt > 0u ? cnt : 1u;
}

__device__ __forceinline__ void xcd_barrier(const XcdBarrier& b) {
    asm volatile("s_waitcnt vmcnt(0)" ::: "memory");
    __syncthreads();
    if (threadIdx.x == 0) {
        unsigned* bar = b.bar;
        __builtin_amdgcn_s_waitcnt(0);
        unsigned nloc = b.st[0], nx = b.st[1];
        if (nloc == 0u) { xcd_barrier_complete(bar, b.x, nloc, nx); b.st[0] = nloc; b.st[1] = nx; }
        const unsigned old = xb_add(&bar[XB_XSUB(b.x)], 1u);
        const unsigned gen = old / nloc;
        if (old + 1u == (gen + 1u) * nloc) {
            __builtin_amdgcn_fence(__ATOMIC_RELEASE, "agent");
            asm volatile("s_waitcnt vmcnt(0)" ::: "memory");
            const unsigned og = xb_add(&bar[XB_TOP], 1u);
            const unsigned tg = og / nx;
            if (og + 1u == (tg + 1u) * nx) xb_add(&bar[XB_TOPGEN], 1u);
            else XB_SPIN(xb_ld(&bar[XB_TOPGEN]) == tg, bar);
            __builtin_amdgcn_fence(__ATOMIC_ACQUIRE, "agent");
            xb_add(&bar[XB_XGEN(b.x)], 1u);
            asm volatile("s_waitcnt vmcnt(0)" ::: "memory");
        } else {
            XB_SPIN(xb_ld(&bar[XB_XGEN(b.x)]) == gen, bar);
            __builtin_amdgcn_fence(__ATOMIC_ACQUIRE, "agent");
            asm volatile("s_waitcnt vmcnt(0)" ::: "memory");
        }
    }
    __syncthreads();
}
constexpr int NB = 8, SEQ = 4096, D = 1024, M = NB * SEQ;
constexpr int NIN_SRC = 5936, NIN = 6144;
constexpr int ZW = 4096;
constexpr int ZQ = 0, ZK = 512, ZV = 1024, ZIQ = 1536, ZIK = 2048, ZIW = 2080, ZR = 2304;
constexpr int ZR_R = ZR, ZR_K = ZR + 512, ZR_V = ZR + 1024, ZR_WD = ZR + 1536, ZR_AD = ZR + 1600, ZR_GD = ZR + 1664;
constexpr int GW = 2048;
constexpr int NEXP = 64, FF = 256, TOPK = 8;
constexpr float RMS_EPS = 1e-6f, GN_EPS = 64e-5f;
constexpr float QSCALE = 0.125f * 1.4426950408889634f;
constexpr int NWAVES = 8, NTHR = 512;

constexpr size_t MiB = 1u << 20;
constexpr size_t WS_CTL = 0, CTL_ZERO_BYTES = 1 * MiB;
constexpr size_t WS_MOD = 1 * MiB;
constexpr size_t WS_DUT = 1 * MiB + 256 * 1024;
constexpr size_t WS_IUT = WS_DUT + 64 * 1024;
constexpr size_t WS_GUT = WS_IUT + 64 * 1024;
constexpr size_t WS_WIN = 2 * MiB;
constexpr size_t WS_WA = 14 * MiB, WS_WR = 15 * MiB;
constexpr size_t WS_WO = 16 * MiB;
constexpr size_t WS_WRT = 18 * MiB;
constexpr size_t WS_WSH1 = 19 * MiB;
constexpr size_t WS_WSH2 = 20 * MiB;
constexpr size_t WS_BRS = 21 * MiB, WS_KRS = 22 * MiB;
constexpr size_t WS_TOPE = 23 * MiB, WS_TOPW = 24 * MiB;
constexpr size_t WS_LOGIT = 25 * MiB;
constexpr size_t WS_Z = 36 * MiB;
constexpr size_t WS_H0 = 292 * MiB, WS_H1 = 324 * MiB;
constexpr size_t WS_SEL = 356 * MiB;
constexpr size_t WS_R0 = 372 * MiB, WS_R1 = 404 * MiB, WS_R2 = 436 * MiB, WS_R3 = 468 * MiB;
constexpr size_t WS_W2T = 36 * MiB;
constexpr size_t WS_ACT = 68 * MiB;
constexpr size_t WS_ACTS = 196 * MiB;
constexpr size_t WS_STOK = 212 * MiB, WS_SW = 213 * MiB;
constexpr size_t WS_W1T = 214 * MiB;
constexpr size_t WS_H2 = 278 * MiB;
constexpr size_t WS_SLOT = 214 * MiB;
constexpr size_t WS_END = 502 * MiB;
constexpr int CW_TMO = 0, CW_BAR = 4096, CW_CNT = 32768, CW_CUR = 32768 + 128, CW_Q = 32768 + 512;

constexpr int RING_BYTES = 131072;
constexpr int LDSCTL_OFF = RING_BYTES, MISC_OFF = LDSCTL_OFF + 320;
constexpr int LDS_TILETAB = RING_BYTES + 1024;
constexpr int LDS_PTAB = RING_BYTES + 512;
constexpr int LDS_PARA = 118800;
constexpr int LDS_PARB = LDS_TILETAB;
constexpr int LDS_BYTES = 147456;
#define AIN(i) ain_ptr(F.lds, (i))

struct Args { const float* in[31]; float* out; unsigned char* ws; int ph_lo, ph_hi, li, pad; };
struct Frame {
    LAS unsigned char* lds;
    volatile LAS unsigned* MISC;
    unsigned* ctl;
    int tid, lane, wave, vcu, G, gw, NGW;
    float* out; unsigned char* ws;
};

__device__ __forceinline__ const float* ain_ptr(LAS unsigned char* lds, int i) {
    const u32x2 w = *(const LAS u32x2*)(lds + LDS_PTAB + 8 * i);
    const unsigned lo = (unsigned)__builtin_amdgcn_readfirstlane((int)w.x), hi = (unsigned)__builtin_amdgcn_readfirstlane((int)w.y);
    return (const float*)(const GAS float*)(((unsigned long long)hi << 32) | lo);
}
struct TrSrc { const float* base; int nsrc; };
template <int FP8, class ColFn>
__device__ __forceinline__ void transpose_item(const ColFn& colfn, int K, bf16_t* WT, LAS float* scr, int kb, int nb, int lane) {
    const int k0 = 64 * kb, n0 = 32 * nb;
    const TrSrc s = colfn(n0 + (lane & 31));
    float v_[32];
#pragma unroll
    for (int i = 0; i < 32; ++i) { const int kk = 2 * i + (lane >> 5); v_[i] = s.base ? s.base[(size_t)(k0 + kk) * s.nsrc] : 0.f; }
#pragma unroll
    for (int i = 0; i < 32; ++i) { const int kk = 2 * i + (lane >> 5); scr[kk * 33 + (lane & 31)] = v_[i]; }
    LDS_WAIT(); asm volatile("" ::: "memory");
    const int c = lane & 7;
#pragma unroll
    for (int j = 0; j < 4; ++j) { const int n = (lane >> 3) + 8 * j; const LAS float* sp = scr + (8 * c) * 33 + n;
        if constexpr (FP8) { constexpr float S8 = 32.0f;
            int lo = __builtin_amdgcn_cvt_pk_fp8_f32(sp[0 * 33] * S8, sp[1 * 33] * S8, 0, false); lo = __builtin_amdgcn_cvt_pk_fp8_f32(sp[2 * 33] * S8, sp[3 * 33] * S8, lo, true);
            int hi = __builtin_amdgcn_cvt_pk_fp8_f32(sp[4 * 33] * S8, sp[5 * 33] * S8, 0, false); hi = __builtin_amdgcn_cvt_pk_fp8_f32(sp[6 * 33] * S8, sp[7 * 33] * S8, hi, true);
            *(GAS u32x2*)((unsigned char*)WT + (size_t)(n0 + n) * K + k0 + 8 * c) = (u32x2){(unsigned)lo, (unsigned)hi}; }
        else { u32x4 o; o.x = pk2(sp[0 * 33], sp[1 * 33]); o.y = pk2(sp[2 * 33], sp[3 * 33]); o.z = pk2(sp[4 * 33], sp[5 * 33]); o.w = pk2(sp[6 * 33], sp[7 * 33]);
            *(GAS u32x4*)(WT + (size_t)(n0 + n) * K + k0 + 8 * c) = o; } }
    LDS_WAIT(); asm volatile("" ::: "memory");
}

__device__ __forceinline__ void p0_mod(const Args& args, Frame& F, int task) {
    LAS float* sc = (LAS float*)F.lds;
    LAS float* red = (LAS float*)(F.lds + 32768);
    const float* c = AIN(1);
    for (int i = F.tid; i < 8192; i += NTHR) { const float v = c[i]; sc[i] = v * fast_sigmoid(v); }
    __syncthreads();
    const float* aw = AIN(2) + 64 * task + F.lane;
    float acc[8];
#pragma unroll
    for (int b = 0; b < 8; ++b) acc[b] = 0.f;
    const int kb = 128 * F.wave;
#pragma unroll 4
    for (int k = 0; k < 128; ++k) { const float a = aw[(size_t)(kb + k) * 6144];
#pragma unroll
        for (int b = 0; b < 8; ++b) acc[b] += sc[b * 1024 + kb + k] * a; }
#pragma unroll
    for (int b = 0; b < 8; ++b) red[(F.wave * 8 + b) * 64 + F.lane] = acc[b];
    __syncthreads();
    { const int b = F.wave; float s = AIN(3)[64 * task + F.lane];
#pragma unroll
      for (int w = 0; w < 8; ++w) s += red[(w * 8 + b) * 64 + F.lane];
      ((float*)(F.ws + WS_MOD))[b * 6144 + 64 * task + F.lane] = s; }
    __syncthreads();
}

__device__ __forceinline__ void p0_prologue(const Args& args, Frame& F) {
    if (blockIdx.x < 96) p0_mod(args, F, blockIdx.x);
    LAS float* scr = (LAS float*)(F.lds + F.wave * 16384);
    bf16_t* const ws16 = (bf16_t*)F.ws;
    constexpr int I_WIN = 16 * 192, I_WA = 8 * 32, I_WO = 16 * 32, I_WRT = 16 * 8, I_SH1 = 16 * 16, I_SH2 = 4 * 32, I_DU = 16, I_GU = 32;
    constexpr int NIT = I_WIN + 2 * I_WA + I_WO + I_WRT + I_SH1 + I_SH2 + 2 * I_DU + I_GU;
    for (int it = F.gw; it < NIT; it += F.NGW) {
        int r = it;
        if (r < I_WIN) { const float* w = AIN(5);
            transpose_item<1>([=](int n) { TrSrc s; const bool ok = (n < 2096) || (n >= 2304); const int col = n < 2096 ? n : n - 208; s.base = ok ? w + col : nullptr; s.nsrc = NIN_SRC; return s; },
                           1024, (bf16_t*)(F.ws + WS_WIN), scr, r / 192, r % 192, F.lane); continue; } r -= I_WIN;
        if (r < I_WA) { const float* w = AIN(18); transpose_item<0>([=](int n) { TrSrc s; s.base = w + n; s.nsrc = 1024; return s; }, 512, (bf16_t*)(F.ws + WS_WA), scr, r / 32, r % 32, F.lane); continue; } r -= I_WA;
        if (r < I_WA) { const float* w = AIN(19); transpose_item<0>([=](int n) { TrSrc s; s.base = w + n; s.nsrc = 1024; return s; }, 512, (bf16_t*)(F.ws + WS_WR), scr, r / 32, r % 32, F.lane); continue; } r -= I_WA;
        if (r < I_WO) { const float* w = AIN(20); transpose_item<1>([=](int n) { TrSrc s; s.base = w + n; s.nsrc = 1024; return s; }, 1024, (bf16_t*)(F.ws + WS_WO), scr, r / 32, r % 32, F.lane); continue; } r -= I_WO;
        if (r < I_WRT) { const float* w = AIN(22); transpose_item<0>([=](int n) { TrSrc s; s.base = n < 64 ? w + n : nullptr; s.nsrc = 64; return s; }, 1024, (bf16_t*)(F.ws + WS_WRT), scr, r / 8, r % 8, F.lane); continue; } r -= I_WRT;
        if (r < I_SH1) { const float* wg = AIN(27); const float* wu = AIN(28);
            transpose_item<0>([=](int n) { TrSrc s; const int j = n >> 8, sel = (n >> 7) & 1, cc = n & 127; s.base = (sel ? wu : wg) + 128 * j + cc; s.nsrc = 256; return s; }, 1024, (bf16_t*)(F.ws + WS_WSH1), scr, r / 16, r % 16, F.lane); continue; } r -= I_SH1;
        if (r < I_SH2) { const float* w = AIN(29); transpose_item<0>([=](int n) { TrSrc s; s.base = w + n; s.nsrc = 1024; return s; }, 256, (bf16_t*)(F.ws + WS_WSH2), scr, r / 32, r % 32, F.lane); continue; } r -= I_SH2;
        if (r < I_DU) { const float* w = AIN(9); transpose_item<0>([=](int n) { TrSrc s; s.base = w + n; s.nsrc = 512; return s; }, 64, (bf16_t*)(F.ws + WS_DUT), scr, 0, r, F.lane); continue; } r -= I_DU;
        if (r < I_DU) { const float* w = AIN(11); transpose_item<0>([=](int n) { TrSrc s; s.base = w + n; s.nsrc = 512; return s; }, 64, (bf16_t*)(F.ws + WS_IUT), scr, 0, r, F.lane); continue; } r -= I_DU;
        { const float* w = AIN(12); transpose_item<0>([=](int n) { TrSrc s; s.base = w + n; s.nsrc = 512; return s; }, 128, (bf16_t*)(F.ws + WS_GUT), scr, r / 16, r % 16, F.lane); }
    }
    (void)ws16;
}

__device__ __forceinline__ void convert_experts(const Args& args, Frame& F, int k0, int k1) {
    LAS float* scr = (LAS float*)(F.lds + F.wave * 16384);
    constexpr int I1 = 16 * 16, I2 = 4 * 32, PER = I1 + I2, NIT = 64 * PER;
    for (int k = k0; k < k1; ++k) { const int it = F.gw + k * F.NGW; if (it >= NIT) break;
        const int e = it / PER; int r = it % PER;
        if (r < I1) { const float* wg = AIN(24) + (size_t)e * 1024 * 256; const float* wu = AIN(25) + (size_t)e * 1024 * 256;
            transpose_item<0>([=](int n) { TrSrc s; const int j = n >> 8, sel = (n >> 7) & 1, cc = n & 127; s.base = (sel ? wu : wg) + 128 * j + cc; s.nsrc = 256; return s; }, 1024, (bf16_t*)(F.ws + WS_W1T) + (size_t)e * 512 * 1024, scr, r / 16, r % 16, F.lane); }
        else { r -= I1; const float* w = AIN(26) + (size_t)e * 256 * 1024;
            transpose_item<0>([=](int n) { TrSrc s; s.base = w + n; s.nsrc = 1024; return s; }, 256, (bf16_t*)(F.ws + WS_W2T) + (size_t)e * 1024 * 256, scr, r / 32, r % 32, F.lane); }
    }
}

__device__ __forceinline__ void norm_mod_rows(const Args& args, Frame& F, const float* X, const float* g, int sh_off, int sc_off, bf16_t* O, unsigned char* O8) {
    const int row0 = F.gw * 16, b = row0 / SEQ;
    const float* mod = (const float*)(F.ws + WS_MOD) + b * 6144;
    f32x4 mul[4], add[4];
#pragma unroll
    for (int j = 0; j < 4; ++j) { const int c = 4 * F.lane + 256 * j; const f32x4 gv = *(const f32x4*)(g + c), sc = *(const f32x4*)(mod + sc_off + c); add[j] = *(const f32x4*)(mod + sh_off + c); mul[j] = gv * (sc + 1.0f); }
    for (int r = 0; r < 16; ++r) {
        const GAS f32x4* xr = (const GAS f32x4*)(X + (size_t)(row0 + r) * D) + F.lane;
        f32x4 v[4]; float s = 0.f;
#pragma unroll
        for (int j = 0; j < 4; ++j) { v[j] = xr[64 * j]; s += (v[j].x * v[j].x + v[j].y * v[j].y) + (v[j].z * v[j].z + v[j].w * v[j].w); }
        const float rstd = 1.0f / sqrtf(wave_sum(s) * (1.0f / D) + RMS_EPS);
#pragma unroll
        for (int j = 0; j < 4; ++j) { const f32x4 y = v[j] * rstd * mul[j] + add[j];
            if (O) { u32x2 w; w.x = cvt_pk_bf16(y.x, y.y); w.y = cvt_pk_bf16(y.z, y.w); ((GAS u32x2*)(O + (size_t)(row0 + r) * D) + F.lane)[64 * j] = w; }
            if (O8) { int w8 = __builtin_amdgcn_cvt_pk_fp8_f32(y.x, y.y, 0, false); w8 = __builtin_amdgcn_cvt_pk_fp8_f32(y.z, y.w, w8, true); ((GAS unsigned*)(O8 + (size_t)(row0 + r) * D) + F.lane)[64 * j] = (unsigned)w8; } }
    }
}
using pg8::Unit;
constexpr float WSCALE8 = 32.0f;
typedef const f32x4 (&AccRef)[2][2][4][2];

struct EpiInProj {
    static constexpr bool PERM = true;
    bf16_t* Z; bf16_t* Gt;
    __device__ __forceinline__ void operator()(AccRef acc, const Unit& u, int wr, int wc, int fr, int fq) const {
        asm volatile("" : "+v"(fr), "+v"(fq));
        const int row0 = u.pm * 256 + wr * 64 + fr;
        const bool gate = u.pn >= 16;
        const float sc = ((u.pn < 2) ? QSCALE : 1.0f) * (1.0f / WSCALE8);
        bf16_t* base = gate ? Gt + (size_t)(u.pn - 16) * 256 : Z + (size_t)u.pn * 256;
        const int ldc = gate ? GW : ZW;
#pragma unroll
        for (int ai = 0; ai < 2; ++ai)
#pragma unroll
            for (int m = 0; m < 4; ++m) { bf16_t* rowp = base + (size_t)(row0 + ai * 128 + m * 16) * ldc + wc * 32 + 8 * fq;
#pragma unroll
                for (int bj = 0; bj < 2; ++bj) { f32x4 v0 = acc[ai][bj][m][0], v1 = acc[ai][bj][m][1];
                    if (gate) {
#pragma unroll
                        for (int j = 0; j < 4; ++j) { v0[j] = fast_sigmoid(v0[j] * sc); v1[j] = fast_sigmoid(v1[j] * sc); } }
                    else { v0 = v0 * sc; v1 = v1 * sc; }
                    u32x4 w; w.x = cvt_pk_bf16(v0[0], v0[1]); w.y = cvt_pk_bf16(v0[2], v0[3]); w.z = cvt_pk_bf16(v1[0], v1[1]); w.w = cvt_pk_bf16(v1[2], v1[3]);
                    *(u32x4*)(rowp + bj * 128) = w; } }
    }
};

constexpr float ATT_S8 = 16.0f, RW_S8 = 8.0f, MIX_S8 = 16.0f;
template <int SECOND> struct EpiMerge {
    static constexpr bool PERM = true;
    bf16_t* Mx; unsigned char* Mx8; const bf16_t* Gt; float bs;
    __device__ __forceinline__ void operator()(AccRef acc, const Unit& u, int wr, int wc, int fr, int fq) const {
        asm volatile("" : "+v"(fr), "+v"(fq));
        const int row0 = u.pm * 256 + wr * 64 + fr, col0 = u.pn * 256 + wc * 32 + 8 * fq;
#pragma unroll
        for (int ai = 0; ai < 2; ++ai)
#pragma unroll
            for (int m = 0; m < 4; ++m) { const size_t r = (size_t)(row0 + ai * 128 + m * 16);
#pragma unroll
                for (int bj = 0; bj < 2; ++bj) { const int c = col0 + bj * 128;
                    const u32x4 g = *(const u32x4*)(Gt + r * GW + SECOND * 1024 + c);
                    f32x4 v0 = acc[ai][bj][m][0] * bs, v1 = acc[ai][bj][m][1] * bs;
                    v0[0] *= bf_lo(g.x); v0[1] *= bf_hi(g.x); v0[2] *= bf_lo(g.y); v0[3] *= bf_hi(g.y);
                    v1[0] *= bf_lo(g.z); v1[1] *= bf_hi(g.z); v1[2] *= bf_lo(g.w); v1[3] *= bf_hi(g.w);
                    if (SECOND) { const u32x4 p = *(const u32x4*)(Mx + r * D + c);
                        v0[0] += bf_lo(p.x); v0[1] += bf_hi(p.x); v0[2] += bf_lo(p.y); v0[3] += bf_hi(p.y);
                        v1[0] += bf_lo(p.z); v1[1] += bf_hi(p.z); v1[2] += bf_lo(p.w); v1[3] += bf_hi(p.w);
                        v0 = v0 * MIX_S8; v1 = v1 * MIX_S8;
                        int lo = __builtin_amdgcn_cvt_pk_fp8_f32(v0[0], v0[1], 0, false); lo = __builtin_amdgcn_cvt_pk_fp8_f32(v0[2], v0[3], lo, true);
                        int hi = __builtin_amdgcn_cvt_pk_fp8_f32(v1[0], v1[1], 0, false); hi = __builtin_amdgcn_cvt_pk_fp8_f32(v1[2], v1[3], hi, true);
                        *(u32x2*)(Mx8 + r * D + c) = (u32x2){(unsigned)lo, (unsigned)hi}; }
                    else { u32x4 w; w.x = cvt_pk_bf16(v0[0], v0[1]); w.y = cvt_pk_bf16(v0[2], v0[3]); w.z = cvt_pk_bf16(v1[0], v1[1]); w.w = cvt_pk_bf16(v1[2], v1[3]);
                        *(u32x4*)(Mx + r * D + c) = w; } } }
    }
};

struct EpiOutProj {
    static constexpr bool PERM = false;
    const float* X; float* O; const float* mod;
    __device__ __forceinline__ void operator()(AccRef acc, const Unit& u, int wr, int wc, int fr, int fq) const {
        asm volatile("" : "+v"(fr), "+v"(fq));
        const int row0 = u.pm * 256 + wr * 64 + fr, col0 = u.pn * 256 + wc * 32 + 4 * fq;
        const float* g1 = mod + (size_t)((u.pm * 256) / SEQ) * 6144 + 2048;
        f32x4 gv[2][2];
#pragma unroll
        for (int bj = 0; bj < 2; ++bj)
#pragma unroll
            for (int n = 0; n < 2; ++n) gv[bj][n] = *(const f32x4*)(g1 + col0 + bj * 128 + n * 16);
#pragma unroll
        for (int ai = 0; ai < 2; ++ai)
#pragma unroll
            for (int m = 0; m < 4; ++m) { const size_t off = (size_t)(row0 + ai * 128 + m * 16) * D + col0;
#pragma unroll
                for (int bj = 0; bj < 2; ++bj)
#pragma unroll
                    for (int n = 0; n < 2; ++n) { const f32x4 xv = *(const f32x4*)(X + off + bj * 128 + n * 16);
                        *(f32x4*)(O + off + bj * 128 + n * 16) = xv + gv[bj][n] * acc[ai][bj][m][n] * (1.0f / (MIX_S8 * WSCALE8)); }
                if (m & 1) asm volatile("" ::: "memory"); }
    }
};

struct EpiRouter {
    static constexpr bool PERM = false;
    float* L;
    __device__ __forceinline__ void operator()(AccRef acc, const Unit& u, int wr, int wc, int fr, int fq) const {
        asm volatile("" : "+v"(fr), "+v"(fq));
        if (wc >= 2) return;
        const int row0 = u.pm * 256 + wr * 64 + fr, col0 = wc * 32 + 4 * fq;
#pragma unroll
        for (int ai = 0; ai < 2; ++ai)
#pragma unroll
            for (int m = 0; m < 4; ++m)
#pragma unroll
                for (int n = 0; n < 2; ++n) *(f32x4*)(L + (size_t)(row0 + ai * 128 + m * 16) * 64 + col0 + n * 16) = acc[ai][0][m][n];
    }
};

struct MoeSched1 {
    const LAS unsigned* tab; int ntiles, G, c;
    __device__ __forceinline__ bool next(int i, Unit& u) const {
        const int L = i * G + c; if (L >= 256 + 2 * ntiles) return false;
        u.pn = L & 1;
        if (L < 256) { u.pm = L >> 1; u.aux0 = (u.pm * 256) | (64 << 20); u.aux1 = 256; }
        else { const int t = (L - 256) >> 1; u.pm = t; u.aux0 = __builtin_amdgcn_readfirstlane((int)tab[2 * t]); u.aux1 = __builtin_amdgcn_readfirstlane((int)tab[2 * t + 1]); }
        return true;
    }
};
struct MoeSrc1 {
    static constexpr int ESZ = 2; static constexpr bool GATHER = true;
    const unsigned char* ws;
    __device__ __forceinline__ const char* a_base(const Unit&) const { return (const char*)(ws + WS_H2); }
    __device__ __forceinline__ const char* b_base(const Unit& u) const { const int e = u.aux0 >> 20;
        const size_t off = (e == 64 ? WS_WSH1 : WS_W1T + (size_t)e * 512 * 1024 * 2) + (size_t)u.pn * 256 * 1024 * 2; return (const char*)ws + off; }
    __device__ __forceinline__ unsigned a_off(const Unit& u, int R, int C) const {
        const int e = u.aux0 >> 20, pos0 = u.aux0 & 0xFFFFF; int tok;
        if (e == 64) tok = pos0 + R; else tok = (R < u.aux1) ? (((const int*)(ws + WS_STOK))[pos0 + R] >> 3) : 0;
        return (unsigned)tok * 2048u + (unsigned)C * 2u; }
};
struct EpiMoe1 {
    static constexpr bool PERM = true;
    unsigned char* ws;
    __device__ __forceinline__ void operator()(AccRef acc, const Unit& u, int wr, int wc, int fr, int fq) const {
        asm volatile("" : "+v"(fr), "+v"(fq));
        const int e = u.aux0 >> 20, pos0 = u.aux0 & 0xFFFFF;
        bf16_t* base = (bf16_t*)(ws + (e == 64 ? WS_ACTS : WS_ACT)) + (size_t)pos0 * FF + u.pn * 128 + wc * 32 + 8 * fq;
#pragma unroll
        for (int ai = 0; ai < 2; ++ai)
#pragma unroll
            for (int m = 0; m < 4; ++m) { const int r = ai * 128 + wr * 64 + m * 16 + fr;
                float o[8];
#pragma unroll
                for (int n = 0; n < 2; ++n)
#pragma unroll
                    for (int j = 0; j < 4; ++j) { const float g = acc[ai][0][m][n][j], up = acc[ai][1][m][n][j]; o[4 * n + j] = g * fast_sigmoid(g) * up; }
                u32x4 w; w.x = cvt_pk_bf16(o[0], o[1]); w.y = cvt_pk_bf16(o[2], o[3]); w.z = cvt_pk_bf16(o[4], o[5]); w.w = cvt_pk_bf16(o[6], o[7]);
                if (r < u.aux1) *(u32x4*)(base + (size_t)r * FF) = w; }
    }
};
struct MoeSched2 {
    const LAS unsigned* tab; int t0, ntiles, nsh, G, c;
    __device__ __forceinline__ bool next(int i, Unit& u) const {
        const int L = i * G + c; if (L >= nsh + 4 * ntiles) return false;
        u.pn = L & 3;
        if (L < nsh) { u.pm = L >> 2; u.aux0 = (u.pm * 256) | (64 << 20); u.aux1 = 256; }
        else { const int t = t0 + ((L - nsh) >> 2); u.pm = t; u.aux0 = __builtin_amdgcn_readfirstlane((int)tab[2 * t]); u.aux1 = __builtin_amdgcn_readfirstlane((int)tab[2 * t + 1]); }
        return true;
    }
};
struct MoeSrc2 {
    static constexpr int ESZ = 2; static constexpr bool GATHER = true;
    const unsigned char* ws;
    __device__ __forceinline__ const char* a_base(const Unit& u) const { return (const char*)ws + ((u.aux0 >> 20) == 64 ? WS_ACTS : WS_ACT); }
    __device__ __forceinline__ const char* b_base(const Unit& u) const { const int e = u.aux0 >> 20;
        const size_t off = (e == 64 ? WS_WSH2 : WS_W2T + (size_t)e * 1024 * 256 * 2) + (size_t)u.pn * 256 * 256 * 2; return (const char*)ws + off; }
    __device__ __forceinline__ unsigned a_off(const Unit& u, int R, int C) const {
        const int pos0 = u.aux0 & 0xFFFFF; const int rr = R < u.aux1 ? R : u.aux1 - 1;
        return (unsigned)(pos0 + rr) * 512u + (unsigned)C * 2u; }
};
constexpr float SLOT_SCALE = 16.0f;
constexpr int NSLOT = 9;
struct EpiMoe2 {
    static constexpr bool PERM = true;
    unsigned char* ws; float* X1; int tokbase;
    mutable int ptk[8]; mutable float pwt[8];
    __device__ __forceinline__ void prefetch(const Unit& u, int wr, int fr) const {
        const int e = u.aux0 >> 20, pos0 = u.aux0 & 0xFFFFF;
        if (e != 64) {
#pragma unroll
            for (int ai = 0; ai < 2; ++ai)
#pragma unroll
                for (int m = 0; m < 4; ++m) { const int r = ai * 128 + wr * 64 + m * 16 + fr; const int rc = r < u.aux1 ? r : u.aux1 - 1;
                    ptk[ai * 4 + m] = ((const int*)(ws + WS_STOK))[pos0 + rc]; pwt[ai * 4 + m] = ((const float*)(ws + WS_SW))[pos0 + rc]; } }
    }
    __device__ __forceinline__ void operator()(AccRef acc, const Unit& u, int wr, int wc, int fr, int fq) const {
        asm volatile("" : "+v"(fr), "+v"(fq));
        const int e = u.aux0 >> 20, pos0 = u.aux0 & 0xFFFFF; const int col0 = u.pn * 256 + wc * 32 + 8 * fq;
        if (e == 64) {
#pragma unroll
            for (int ai = 0; ai < 2; ++ai)
#pragma unroll
                for (int m = 0; m < 4; ++m) { unsigned char* rowp = (unsigned char*)(ws + WS_SLOT) + ((size_t)(pos0 + ai * 128 + wr * 64 + m * 16 + fr) * NSLOT + 8) * D + u.pn * 256 + wc * 64 + fq * 16;
                    u32x4 o;
#pragma unroll
                    for (int bj = 0; bj < 2; ++bj) { const f32x4 v0 = acc[ai][bj][m][0] * SLOT_SCALE, v1 = acc[ai][bj][m][1] * SLOT_SCALE;
                        int lo = __builtin_amdgcn_cvt_pk_fp8_f32(v0[0], v0[1], 0, false); lo = __builtin_amdgcn_cvt_pk_fp8_f32(v0[2], v0[3], lo, true);
                        int hi = __builtin_amdgcn_cvt_pk_fp8_f32(v1[0], v1[1], 0, false); hi = __builtin_amdgcn_cvt_pk_fp8_f32(v1[2], v1[3], hi, true);
                        if (bj == 0) { o.x = (unsigned)lo; o.y = (unsigned)hi; } else { o.z = (unsigned)lo; o.w = (unsigned)hi; } }
                    *(u32x4*)rowp = o;
                    asm volatile("" ::: "memory"); }
        } else {
#pragma unroll
            for (int ai = 0; ai < 2; ++ai)
#pragma unroll
                for (int m = 0; m < 4; ++m) { const int r = ai * 128 + wr * 64 + m * 16 + fr;
                    if (r < u.aux1) { const int tk = ptk[ai * 4 + m]; const float w = pwt[ai * 4 + m] * SLOT_SCALE;
                        unsigned char* rowp = (unsigned char*)(ws + WS_SLOT) + ((size_t)(tk >> 3) * NSLOT + (tk & 7)) * D + u.pn * 256 + wc * 64 + fq * 16;
                        u32x4 o;
#pragma unroll
                        for (int bj = 0; bj < 2; ++bj) { const f32x4 v0 = acc[ai][bj][m][0] * w, v1 = acc[ai][bj][m][1] * w;
                            int lo = __builtin_amdgcn_cvt_pk_fp8_f32(v0[0], v0[1], 0, false); lo = __builtin_amdgcn_cvt_pk_fp8_f32(v0[2], v0[3], lo, true);
                            int hi = __builtin_amdgcn_cvt_pk_fp8_f32(v1[0], v1[1], 0, false); hi = __builtin_amdgcn_cvt_pk_fp8_f32(v1[2], v1[3], hi, true);
                            if (bj == 0) { o.x = (unsigned)lo; o.y = (unsigned)hi; } else { o.z = (unsigned)lo; o.w = (unsigned)hi; } }
                        *(u32x4*)rowp = o; }
                    asm volatile("" ::: "memory"); }
        }
    }
};
__device__ __forceinline__ unsigned ord_key(float x) { const unsigned b = __float_as_uint(x); return (b & 0x80000000u) ? ~b : (b | 0x80000000u); }

__device__ __forceinline__ void indexer_unit(const Args& args, Frame& F, int b, int q0) {
    const bf16_t* Z = (const bf16_t*)(F.ws + WS_Z) + (size_t)b * SEQ * ZW;
    unsigned* SELM = (unsigned*)(F.ws + WS_SEL) + (size_t)b * SEQ * 128;
    int tid = F.tid; asm volatile("" : "+v"(tid));
    const int lane = tid & 63, kl = lane & 31, hl = lane >> 5, w = F.wave;
    const int qa = q0 + 2 * w;
    const int myq = qa + hl;
    bf16x8 A0, A1;
    { const int aq = (kl >> 2) & 1, ah = 4 * (kl >> 3) + (kl & 3);
      const bf16_t* p = Z + (size_t)(qa + aq) * ZW + ZIQ + ah * 32 + 8 * hl;
      A0 = *(const bf16x8*)p; A1 = *(const bf16x8*)(p + 16); }
    float wq[16];
    { const bf16_t* p = Z + (size_t)myq * ZW + ZIW; const u32x4 a = *(const u32x4*)p, c = *(const u32x4*)(p + 8);
      wq[0] = bf_lo(a.x); wq[1] = bf_hi(a.x); wq[2] = bf_lo(a.y); wq[3] = bf_hi(a.y); wq[4] = bf_lo(a.z); wq[5] = bf_hi(a.z); wq[6] = bf_lo(a.w); wq[7] = bf_hi(a.w);
      wq[8] = bf_lo(c.x); wq[9] = bf_hi(c.x); wq[10] = bf_lo(c.y); wq[11] = bf_hi(c.y); wq[12] = bf_lo(c.z); wq[13] = bf_hi(c.z); wq[14] = bf_lo(c.w); wq[15] = bf_hi(c.w); }
    unsigned key[128];
    const int nchunk = (q0 + 15) / 1024 + 1;
#define IDX_LOAD(ch, buf) do { _Pragma("unroll") for (int _h = 0; _h < 2; ++_h) { u32x4 v_[4]; \
        _Pragma("unroll") for (int _i = 0; _i < 4; ++_i) { const int pc = tid + 512 * (4 * _h + _i); const int kk = pc >> 2, c4 = pc & 3; v_[_i] = *(const u32x4*)(Z + (size_t)((ch) * 1024 + kk) * ZW + ZIK + 8 * c4); } \
        _Pragma("unroll") for (int _i = 0; _i < 4; ++_i) { const int pc = tid + 512 * (4 * _h + _i); const int kk = pc >> 2, c4 = pc & 3; *(LAS u32x4*)(F.lds + (buf) * 65536 + (c4 * 1024 + kk) * 16) = v_[_i]; } \
        asm volatile("" ::: "memory"); } } while (0)
    IDX_LOAD(0, 0);
    __syncthreads();
#pragma unroll
    for (int ch = 0; ch < 4; ++ch) {
        if (ch < nchunk) {
            if (ch + 1 < nchunk) IDX_LOAD(ch + 1, (ch + 1) & 1);
            LAS unsigned char* kbl = F.lds + (ch & 1) * 65536 + hl * 16384 + kl * 16; asm volatile("" : "+v"(kbl));
#pragma unroll
            for (int tt = 0; tt < 32; tt += 2) {
                const int t = ch * 32 + tt;
                if (32 * t <= qa + 1) {
                    bf16x8 B0[2], B1[2]; f32x16 acc[2];
#pragma unroll
                    for (int j = 0; j < 2; ++j) { B0[j] = *(const LAS bf16x8*)(kbl + 512 * (tt + j)); B1[j] = *(const LAS bf16x8*)(kbl + 32768 + 512 * (tt + j)); }
#pragma unroll
                    for (int j = 0; j < 2; ++j) { acc[j] = f32x16{}; acc[j] = __builtin_amdgcn_mfma_f32_32x32x16_bf16(A0, B0[j], acc[j], 0, 0, 0); }
#pragma unroll
                    for (int j = 0; j < 2; ++j) acc[j] = __builtin_amdgcn_mfma_f32_32x32x16_bf16(A1, B1[j], acc[j], 0, 0, 0);
#pragma unroll
                    for (int j = 0; j < 2; ++j) { float s = 0.f;
#pragma unroll
                        for (int i = 0; i < 16; ++i) { const float av_ = acc[j][i]; const int xb_ = __float_as_int(av_); s += __int_as_float(xb_ > 0 ? xb_ : 0) * wq[i]; }
                        key[t + j] = (32 * (t + j) + kl <= myq) ? ord_key(s) : 0u; }
                } else {
#pragma unroll
                    for (int j = 0; j < 2; ++j) key[t + j] = 0u;
                }
            }
            __syncthreads();
        } else {
#pragma unroll
            for (int tt = 0; tt < 32; ++tt) key[ch * 32 + tt] = 0u;
        }
    }
#undef IDX_LOAD
#pragma unroll
    for (int w = 0; w < 4; ++w) {
        if (1024 * w <= qa + 1) {
#pragma unroll
            for (int k = 0; k < 16; ++k) { const unsigned lo = key[32 * w + k], hi_ = key[32 * w + k + 16];
                key[32 * w + k] = __builtin_amdgcn_perm(hi_, lo, 0x05040100u); key[32 * w + k + 16] = __builtin_amdgcn_perm(hi_, lo, 0x07060302u); }
#pragma unroll
            for (int k = 0; k < 32; ++k) if (!(k & 8)) { const unsigned lo = key[32 * w + k], hi_ = key[32 * w + k + 8];
                key[32 * w + k] = __builtin_amdgcn_perm(hi_, lo, 0x06020400u); key[32 * w + k + 8] = __builtin_amdgcn_perm(hi_, lo, 0x07030501u); }
#pragma unroll
            for (int k = 0; k < 32; ++k) if (!(k & 4)) { const unsigned lo = key[32 * w + k], hi_ = key[32 * w + k + 4]; const unsigned m = 0x0F0F0F0Fu;
                key[32 * w + k] = (lo & m) | ((hi_ << 4) & ~m); key[32 * w + k + 4] = ((lo >> 4) & m) | (hi_ & ~m); }
#pragma unroll
            for (int k = 0; k < 32; ++k) if (!(k & 2)) { const unsigned lo = key[32 * w + k], hi_ = key[32 * w + k + 2]; const unsigned m = 0x33333333u;
                key[32 * w + k] = (lo & m) | ((hi_ << 2) & ~m); key[32 * w + k + 2] = ((lo >> 2) & m) | (hi_ & ~m); }
#pragma unroll
            for (int k = 0; k < 32; ++k) if (!(k & 1)) { const unsigned lo = key[32 * w + k], hi_ = key[32 * w + k + 1]; const unsigned m = 0x55555555u;
                key[32 * w + k] = (lo & m) | ((hi_ << 1) & ~m); key[32 * w + k + 1] = ((lo >> 1) & m) | (hi_ & ~m); }
        }
    }
    unsigned Al[4] = {~0u, ~0u, ~0u, ~0u}, Gt[4] = {0u, 0u, 0u, 0u};
    int ab0 = 0, ab1 = 0; unsigned T0 = 0u, T1 = 0u; bool dn0 = false, dn1 = false;
#define IDX_DPP(v, ctrl) __builtin_amdgcn_update_dpp(0, (v), (ctrl), 0xF, 0xF, true)
#pragma unroll
    for (int bit = 31; bit >= 0; --bit) {
        unsigned S_[4]; int c = 0;
#pragma unroll
        for (int w = 0; w < 4; ++w) { S_[w] = Al[w] & key[32 * w + bit]; c += __builtin_popcount(S_[w]); }
        c += IDX_DPP(c, 0xB1); c += IDX_DPP(c, 0x4E); c += IDX_DPP(c, 0x141); c += IDX_DPP(c, 0x140);
        const int cn0 = ab0 + __builtin_amdgcn_readlane(c, 0) + __builtin_amdgcn_readlane(c, 16), cn1 = ab1 + __builtin_amdgcn_readlane(c, 32) + __builtin_amdgcn_readlane(c, 48);
        const bool t0 = cn0 >= 256, t1 = cn1 >= 256;
        if (t0) { T0 |= 1u << bit; dn0 = dn0 || cn0 == 256; } else ab0 = cn0;
        if (t1) { T1 |= 1u << bit; dn1 = dn1 || cn1 == 256; } else ab1 = cn1;
        const unsigned nm = hl ? (t1 ? 0u : ~0u) : (t0 ? 0u : ~0u);
#pragma unroll
        for (int w = 0; w < 4; ++w) { Al[w] &= key[32 * w + bit] ^ nm; Gt[w] |= S_[w] & nm; }
        if (dn0 && dn1) break;
    }
#undef IDX_DPP
    unsigned x[4];
    { const bool nz = hl ? (T1 != 0u) : (T0 != 0u);
#pragma unroll
      for (int w = 0; w < 4; ++w) x[w] = Gt[w] | (nz ? Al[w] : 0u); }
#define IDX_BFLY(d, m) do { const bool up_ = (kl & (d)) != 0; const unsigned km_ = up_ ? ~(m) : (m); const unsigned am_ = up_ ? (unsigned)(d) : 32u - (d); \
        _Pragma("unroll") for (int w = 0; w < 4; ++w) { const unsigned t_ = (unsigned)__builtin_amdgcn_ds_swizzle((int)x[w], 0x1F | ((d) << 10)); \
            const unsigned rot_ = __builtin_amdgcn_alignbit(t_, t_, am_); x[w] = (x[w] & km_) | (rot_ & ~km_); } } while (0)
    IDX_BFLY(16, 0x0000FFFFu); IDX_BFLY(8, 0x00FF00FFu); IDX_BFLY(4, 0x0F0F0F0Fu); IDX_BFLY(2, 0x33333333u); IDX_BFLY(1, 0x55555555u);
#undef IDX_BFLY
#pragma unroll
    for (int j = 0; j < 4; ++j) SELM[(size_t)myq * 128 + kl + 32 * j] = x[j];
}

__device__ __forceinline__ void indexer_phase(const Args& args, Frame& F) {
    const int c = blockIdx.x;
    for (int i = 0; i < 8; ++i) {
        for (int u = c + i * F.G; u < 2048 && i < 8; u += 2048) {
            const int b = u >> 8, pos = u & 255, blk = (b & 1) ? 255 - pos : pos;
            indexer_unit(args, F, b, blk * 16);
        }
    }
}
namespace att {
constexpr int DM = ZW, QB = 256, KVB = 64, SLOTB = 8192;
constexpr int NS = 4;
constexpr int L_K = 0, L_V = NS * SLOTB, L_MASK = 2 * NS * SLOTB, L_WSF = L_MASK + 8 * 2048, L_OST = L_WSF + 8 * 256, L_BT = L_OST + 8 * 4096, L_MT = L_BT + 512, L_END = L_MT + 128;
static_assert(L_END <= RING_BYTES, "attention LDS");
__device__ __forceinline__ int crow(int r, int hi) { return (r & 3) + 8 * (r >> 2) + 4 * hi; }
__device__ __forceinline__ void glds16(const void* gsrc, unsigned lds_dst) { unsigned keep;
    asm volatile("s_mov_b32 %0, m0\n\ts_mov_b32 m0, %2\n\ts_nop 0\n\tglobal_load_lds_dwordx4 %1, off\n\ts_mov_b32 m0, %0" : "=&s"(keep) : "v"(gsrc), "s"(lds_dst) : "memory"); }
__device__ __forceinline__ unsigned cvtpk(float lo, float hi) { return cvt_pk_bf16(lo, hi); }
typedef short s16x4 __attribute__((ext_vector_type(4)));

__device__ __forceinline__ void attn_unit(const Args& args, Frame& F, int b, int h, int qb) {
    const int lane = F.lane, r32 = lane & 31, hi = lane >> 5, wid = F.wave;
    const bf16_t* Zb = (const bf16_t*)(F.ws + WS_Z) + (size_t)b * SEQ * DM;
    const int q0 = qb * QB;
    const bf16_t* Qw = Zb + (size_t)(q0 + wid * 32) * DM + ZQ + h * 64;
    const bf16_t* Kh = Zb + ZK + h * 64; const bf16_t* Vh = Zb + ZV + h * 64;
    LAS unsigned char* shm = F.lds;
    const unsigned lds0 = (unsigned)(uintptr_t)shm;
    LAS float* wsf = (LAS float*)(shm + L_WSF) + wid * 64;
    LAS float* bt = (LAS float*)(shm + L_BT);
    if (F.tid >= 128 && F.tid < 144) { const unsigned n = F.tid - 128;
        *(LAS u32x2*)(shm + L_MT + 8 * n) = (u32x2){((n & 1u) ? 0xFFFFu : 0u) | ((n & 2u) ? 0xFFFF0000u : 0u), ((n & 4u) ? 0xFFFFu : 0u) | ((n & 8u) ? 0xFFFF0000u : 0u)}; }
    if (F.tid < 128) { const int rel = F.tid; int bk;
        if (rel < 16) bk = rel; else { bk = 16 + (int)(logf((float)rel / 16.0f) / logf(8.0f) * 16.0f); bk = bk < 31 ? bk : 31; }
        bt[rel] = (AIN(6)[bk * 8 + h] - AIN(6)[31 * 8 + h]) * 1.4426950408889634f; }
    const bf16_t* ksrc = Kh + (size_t)lane * DM + wid * 8;
    const bf16_t* vsrc = Vh + (size_t)(16 * (wid & 3) + (lane >> 2)) * DM + (wid >> 2) * 32 + (lane & 3) * 8;
    const unsigned kdst = lds0 + L_K + wid * 1024, vdst = lds0 + L_V + wid * 1024;
    const unsigned* SELM = (const unsigned*)(F.ws + WS_SEL) + (size_t)(b * SEQ + q0 + wid * 32 + r32) * 128 + 4 * hi;
    const unsigned mdst = lds0 + L_MASK + wid * 2048;
#define DMA_K(t, slot) glds16(ksrc + (size_t)(t) * KVB * DM, (unsigned)__builtin_amdgcn_readfirstlane(kdst + (slot) * SLOTB))
#define DMA_V(t, slot) glds16(vsrc + (size_t)(t) * KVB * DM, (unsigned)__builtin_amdgcn_readfirstlane(vdst + (slot) * SLOTB))
#define DMA_M(g) glds16(SELM + 8 * (g), (unsigned)__builtin_amdgcn_readfirstlane(mdst + ((g) & 1) * 1024))
    const int NT = (q0 + QB) / KVB;
    bf16x8 qr[4];
#pragma unroll
    for (int d0 = 0; d0 < 4; ++d0) qr[d0] = *(const bf16x8*)(Qw + (size_t)r32 * DM + d0 * 16 + hi * 8);
    asm volatile("s_waitcnt vmcnt(0)" ::: "memory");
    __syncthreads();
    DMA_M(0); DMA_K(0, 0); DMA_K(1, 1); DMA_V(0, 0); DMA_K(2, 2); DMA_V(1, 1); DMA_K(3, 3); DMA_V(2, 2);
    float m_run = -1e30f; f32x16 o[2], lacc = f32x16{}; o[0] = f32x16{}; o[1] = f32x16{};
    const bf16x8 ones8 = __builtin_bit_cast(bf16x8, (u32x4){0x3F803F80u, 0x3F803F80u, 0x3F803F80u, 0x3F803F80u});
    const int qpos = q0 + wid * 32 + r32;
    const int vb0 = (int)(lds0 + L_V) + ((lane >> 4) & 1) * 32 + (lane & 3) * 8 + (4 * hi + ((lane & 15) >> 2)) * 64;
#define QK_TILE(P0, P1, slot_) do { const LAS unsigned char* kb = shm + L_K + (slot_) * SLOTB + hi * 1024 + r32 * 16; P0 = f32x16{}; P1 = f32x16{}; \
        _Pragma("unroll") for (int d0 = 0; d0 < 4; ++d0) { const bf16x8 b0 = *(const LAS bf16x8*)(kb + d0 * 2048); const bf16x8 b1 = *(const LAS bf16x8*)(kb + d0 * 2048 + 512); \
            P0 = __builtin_amdgcn_mfma_f32_32x32x16_bf16(b0, qr[d0], P0, 0, 0, 0); P1 = __builtin_amdgcn_mfma_f32_32x32x16_bf16(b1, qr[d0], P1, 0, 0, 0); } } while (0)
    f32x16 pa0, pa1, pb0, pb1;
    asm volatile("s_waitcnt vmcnt(6)" ::: "memory");
    __builtin_amdgcn_s_barrier(); asm volatile("" ::: "memory");
    QK_TILE(pa0, pa1, 0);
#define ATT_WAITV(n_) do { const int nn_ = (n_); if (nn_ >= 4) asm volatile("s_waitcnt vmcnt(4)" ::: "memory"); else if (nn_ == 3) asm volatile("s_waitcnt vmcnt(3)" ::: "memory"); \
        else if (nn_ == 2) asm volatile("s_waitcnt vmcnt(2)" ::: "memory"); else if (nn_ == 1) asm volatile("s_waitcnt vmcnt(1)" ::: "memory"); else asm volatile("s_waitcnt vmcnt(0)" ::: "memory"); } while (0)
    asm volatile("s_waitcnt lgkmcnt(0)" ::: "memory");
    if (wid >= 4) { __builtin_amdgcn_s_barrier(); asm volatile("" ::: "memory"); }
    auto step = [&](const int t, f32x16& C0, f32x16& C1, f32x16& N0, f32x16& N1) __attribute__((always_inline)) {
        const int slot = t & (NS - 1), g = t >> 2, tq = t & 3;
        ATT_WAITV((t + 1 < NT) + 2 * (t + 2 < NT) + (t + 3 < NT));
        __builtin_amdgcn_s_barrier(); asm volatile("" ::: "memory");
        if (t + 4 < NT) DMA_K(t + 4, (t + 4) & (NS - 1));
        if (tq == 0) DMA_M(g + 1);
        if (t + 1 < NT) QK_TILE(N0, N1, (t + 1) & (NS - 1));
        __builtin_amdgcn_sched_barrier(0);
        const u32x2 mwv = *(const LAS u32x2*)(shm + L_MASK + wid * 2048 + (g & 1) * 1024 + (tq >> 1) * 512 + r32 * 16 + (tq & 1) * 8);
        if (64 * t + 63 + 112 >= q0 + wid * 32) {
#pragma unroll
            for (int r = 0; r < 16; ++r) { const int kv = 64 * t + crow(r, hi); int r0 = qpos - kv, r1 = r0 - 32;
                r0 = r0 < 0 ? 0 : (r0 > 127 ? 127 : r0); r1 = r1 < 0 ? 0 : (r1 > 127 ? 127 : r1);
                C0[r] += bt[r0]; C1[r] += bt[r1]; }
        }
        typedef float f32x2_ __attribute__((ext_vector_type(2)));
        { const f32x2_ mm = {m_run, m_run};
#pragma unroll
          for (int r = 0; r < 16; r += 2) { f32x2_ a = {C0[r], C0[r + 1]}, c = {C1[r], C1[r + 1]}; a -= mm; c -= mm; C0[r] = a.x; C0[r + 1] = a.y; C1[r] = c.x; C1[r + 1] = c.y; } }
        float rm = __builtin_fmaxf(C0[0], C1[0]);
#pragma unroll
        for (int r = 1; r < 16; ++r) rm = __builtin_fmaxf(rm, __builtin_fmaxf(C0[r], C1[r]));
        if (__builtin_amdgcn_ballot_w64(rm > 8.0f) != 0ull) {
            rm = __builtin_fmaxf(rm, __shfl_xor(rm, 32));
            const float dm = __builtin_fmaxf(rm, 0.f);
            const float f = __builtin_amdgcn_exp2f(-dm);
            m_run += dm;
#pragma unroll
            for (int r = 0; r < 16; ++r) { C0[r] -= dm; C1[r] -= dm; }
            if (hi == 0) wsf[r32] = f;
            asm volatile("s_waitcnt lgkmcnt(0)" ::: "memory");
#pragma unroll
            for (int r = 0; r < 16; ++r) { const float fr_ = wsf[crow(r, hi)]; o[0][r] *= fr_; o[1][r] *= fr_; lacc[r] *= fr_; }
        }
#pragma unroll
        for (int r = 0; r < 16; ++r) { C0[r] = __builtin_amdgcn_exp2f(C0[r]); C1[r] = __builtin_amdgcn_exp2f(C1[r]); }
        asm volatile("s_waitcnt lgkmcnt(0)" ::: "memory");
        ATT_WAITV((t + 1 < NT) + (t + 2 < NT) + (t + 3 < NT) + (t + 4 < NT));
        __builtin_amdgcn_s_barrier(); asm volatile("" ::: "memory");
        if (t + 3 < NT) DMA_V(t + 3, (t + 3) & (NS - 1));
        u32x4 pw0, pw1, pw2, pw3;
        pw0 = (u32x4){cvtpk(C0[0], C0[1]), cvtpk(C0[2], C0[3]), cvtpk(C0[4], C0[5]), cvtpk(C0[6], C0[7])};
        pw1 = (u32x4){cvtpk(C0[8], C0[9]), cvtpk(C0[10], C0[11]), cvtpk(C0[12], C0[13]), cvtpk(C0[14], C0[15])};
        pw2 = (u32x4){cvtpk(C1[0], C1[1]), cvtpk(C1[2], C1[3]), cvtpk(C1[4], C1[5]), cvtpk(C1[6], C1[7])};
        pw3 = (u32x4){cvtpk(C1[8], C1[9]), cvtpk(C1[10], C1[11]), cvtpk(C1[12], C1[13]), cvtpk(C1[14], C1[15])};
        { const unsigned mx_ = mwv.x >> (4 * hi), my_ = mwv.y >> (4 * hi); const LAS unsigned char* mt = shm + L_MT;
          const u32x2 a0 = *(const LAS u32x2*)(mt + ((mx_ << 3) & 0x78u)), a1 = *(const LAS u32x2*)(mt + ((mx_ >> 5) & 0x78u)), a2 = *(const LAS u32x2*)(mt + ((mx_ >> 13) & 0x78u)), a3 = *(const LAS u32x2*)(mt + ((mx_ >> 21) & 0x78u));
          const u32x2 b0 = *(const LAS u32x2*)(mt + ((my_ << 3) & 0x78u)), b1 = *(const LAS u32x2*)(mt + ((my_ >> 5) & 0x78u)), b2 = *(const LAS u32x2*)(mt + ((my_ >> 13) & 0x78u)), b3 = *(const LAS u32x2*)(mt + ((my_ >> 21) & 0x78u));
          pw0.x &= a0.x; pw0.y &= a0.y; pw0.z &= a1.x; pw0.w &= a1.y; pw1.x &= a2.x; pw1.y &= a2.y; pw1.z &= a3.x; pw1.w &= a3.y;
          pw2.x &= b0.x; pw2.y &= b0.y; pw2.z &= b1.x; pw2.w &= b1.y; pw3.x &= b2.x; pw3.y &= b2.y; pw3.z &= b3.x; pw3.w &= b3.y; }
        lacc = __builtin_amdgcn_mfma_f32_32x32x16_bf16(__builtin_bit_cast(bf16x8, pw0), ones8, lacc, 0, 0, 0); lacc = __builtin_amdgcn_mfma_f32_32x32x16_bf16(__builtin_bit_cast(bf16x8, pw1), ones8, lacc, 0, 0, 0);
        lacc = __builtin_amdgcn_mfma_f32_32x32x16_bf16(__builtin_bit_cast(bf16x8, pw2), ones8, lacc, 0, 0, 0); lacc = __builtin_amdgcn_mfma_f32_32x32x16_bf16(__builtin_bit_cast(bf16x8, pw3), ones8, lacc, 0, 0, 0);
        { const int vb = vb0 + slot * SLOTB;
#pragma unroll
          for (int d0 = 0; d0 < 2; ++d0) { s16x4 lo[4], hh[4];
#pragma unroll
              for (int ks = 0; ks < 4; ++ks) {
                  asm volatile("ds_read_b64_tr_b16 %0,%1 offset:%c2" : "=&v"(lo[ks]) : "v"(vb), "i"(d0 * 4096 + ks * 1024) : "memory");
                  asm volatile("ds_read_b64_tr_b16 %0,%1 offset:%c2" : "=&v"(hh[ks]) : "v"(vb), "i"(d0 * 4096 + ks * 1024 + 512) : "memory"); }
              asm volatile("s_waitcnt lgkmcnt(0)" ::: "memory"); __builtin_amdgcn_sched_barrier(0);
#define PKV(k) (bf16x8){lo[k][0], lo[k][1], lo[k][2], lo[k][3], hh[k][0], hh[k][1], hh[k][2], hh[k][3]}
              o[d0] = __builtin_amdgcn_mfma_f32_32x32x16_bf16(__builtin_bit_cast(bf16x8, pw0), PKV(0), o[d0], 0, 0, 0);
              o[d0] = __builtin_amdgcn_mfma_f32_32x32x16_bf16(__builtin_bit_cast(bf16x8, pw1), PKV(1), o[d0], 0, 0, 0);
              o[d0] = __builtin_amdgcn_mfma_f32_32x32x16_bf16(__builtin_bit_cast(bf16x8, pw2), PKV(2), o[d0], 0, 0, 0);
              o[d0] = __builtin_amdgcn_mfma_f32_32x32x16_bf16(__builtin_bit_cast(bf16x8, pw3), PKV(3), o[d0], 0, 0, 0);
#undef PKV
          } }
        asm volatile("s_waitcnt lgkmcnt(0)" ::: "memory");
    };
    for (int t = 0; t < NT; t += 2) { step(t, pa0, pa1, pb0, pb1); step(t + 1, pb0, pb1, pa0, pa1); }
    if (wid < 4) { __builtin_amdgcn_s_barrier(); asm volatile("" ::: "memory"); }
#undef QK_TILE
#undef ATT_WAITV
    bf16_t* Ow = (bf16_t*)(F.ws + WS_R1) + (size_t)(b * SEQ + q0 + wid * 32) * 512 + h * 64;
    { LAS bf16_t* stg = (LAS bf16_t*)(shm + L_OST) + wid * 2048;
#pragma unroll
      for (int r = 0; r < 16; ++r) { const int orow = crow(r, hi); const float rl = __builtin_amdgcn_rcpf(lacc[r]);
#pragma unroll
          for (int d0 = 0; d0 < 2; ++d0) stg[orow * 64 + d0 * 32 + r32] = (bf16_t)f2bf(o[d0][r] * rl); }
      asm volatile("s_waitcnt lgkmcnt(0)" ::: "memory");
#pragma unroll
      for (int i = 0; i < 4; ++i) { const int row = i * 8 + (lane >> 3), chn = lane & 7; const u32x4 v = *(const LAS u32x4*)(stg + row * 64 + chn * 8); *(u32x4*)(Ow + (size_t)row * 512 + chn * 8) = v; } }
    asm volatile("s_waitcnt lgkmcnt(0)" ::: "memory");
#undef DMA_K
#undef DMA_V
#undef DMA_M
}

__device__ __forceinline__ void attn_phase(const Args& args, Frame& F) {
    const int v = F.vcu;
    for (int i = 0; i < 4; ++i) {
        for (int uu = v; uu < 256; uu += F.G) {
            const int bh = uu >> 2, s = uu & 3; const int qb = (i == 0) ? s : (i == 1) ? 7 - s : (i == 2) ? 8 + s : 15 - s;
            attn_unit(args, F, bh >> 3, bh & 7, qb);
        }
    }
}
}
#ifndef PROBE_NO_STATE
#define PROBE_NO_STATE 0
#endif
#ifndef PROBE_TINV_ID
#define PROBE_TINV_ID 0
#endif
namespace rk {
typedef __bf16 bf16x2_t __attribute__((ext_vector_type(2)));
__device__ __forceinline__ unsigned cvtpk(float lo, float hi) { f32x2 v = {lo, hi}; bf16x2_t b = __builtin_convertvector(v, bf16x2_t); return __builtin_bit_cast(unsigned, b); }
template <int S> __device__ __forceinline__ bf16x8 frag(const f32x16& x) {
    u32x4 o; o.x = cvtpk(x[8 * S + 0], x[8 * S + 1]); o.y = cvtpk(x[8 * S + 2], x[8 * S + 3]); o.z = cvtpk(x[8 * S + 4], x[8 * S + 5]); o.w = cvtpk(x[8 * S + 6], x[8 * S + 7]);
    return __builtin_bit_cast(bf16x8, o); }
template <int S> __device__ __forceinline__ void unfrag(f32x16& x, bf16x8 f) { const u32x4 o = __builtin_bit_cast(u32x4, f);
    x[8 * S + 0] = bf_lo(o.x); x[8 * S + 1] = bf_hi(o.x); x[8 * S + 2] = bf_lo(o.y); x[8 * S + 3] = bf_hi(o.y); x[8 * S + 4] = bf_lo(o.z); x[8 * S + 5] = bf_hi(o.z); x[8 * S + 6] = bf_lo(o.w); x[8 * S + 7] = bf_hi(o.w); }
#define RK_MF(a, b, c) __builtin_amdgcn_mfma_f32_32x32x16_bf16((a), (b), (c), 0, 0, 0)
__device__ __forceinline__ float dppf(float v, const int ctrl_is_const_dummy);
#define RK_DPP(v, ctrl, rmask, bc) __builtin_bit_cast(float, __builtin_amdgcn_update_dpp(0, __builtin_bit_cast(int, (v)), (ctrl), (rmask), 0xF, (bc)))
__device__ __forceinline__ float scan32(float v) {
#ifdef PROBE_SHFL_SCAN
    const int l32 = threadIdx.x & 31;
#pragma unroll
    for (int o = 1; o < 32; o <<= 1) { const float t = __shfl_up(v, o, 32); if (l32 >= o) v += t; }
    return v;
#endif
    v += RK_DPP(v, 0x111, 0xF, true); v += RK_DPP(v, 0x112, 0xF, true); v += RK_DPP(v, 0x114, 0xF, true); v += RK_DPP(v, 0x118, 0xF, true);
    v += RK_DPP(v, 0x142, 0xA, false);
    return v; }
__device__ __forceinline__ float ex2(float x) { return __builtin_amdgcn_exp2f(x); }
constexpr int PZ = 3600;
constexpr size_t SZ_G = 8192, SZ_H = 8192, SZ_Q = 4096, SZ_Y = 4096;
constexpr float L2E = 1.4426950408889634f;

__device__ __forceinline__ void mk_id(bf16x8 (&fId)[2], int r, int h) {
    asm volatile("" : "+v"(r), "+v"(h));
#pragma unroll
    for (int s = 0; s < 2; ++s) { unsigned short e8[8];
#pragma unroll
        for (int jj = 0; jj < 8; ++jj) e8[jj] = (16 * s + 8 * (jj >> 2) + 4 * h + (jj & 3) == r) ? (unsigned short)0x3F80 : (unsigned short)0;
        fId[s] = __builtin_bit_cast(bf16x8, (u32x4){(unsigned)e8[0] | ((unsigned)e8[1] << 16), (unsigned)e8[2] | ((unsigned)e8[3] << 16), (unsigned)e8[4] | ((unsigned)e8[5] << 16), (unsigned)e8[6] | ((unsigned)e8[7] << 16)}); }
}

__device__ __forceinline__ void load_params(const Args& args, Frame& F) {
    LAS float* pra = (LAS float*)(F.lds + LDS_PARA); LAS float* prb = (LAS float*)(F.lds + LDS_PARB);
    const float* mu = AIN(7); const float* w0 = AIN(8); const float* a0 = AIN(10); const float* kk = AIN(13); const float* ka = AIN(14); const float* rk = AIN(15);
    for (int i = F.tid; i < 4096; i += NTHR) { const int a = i >> 9, c = i & 511;
        const float v_ = a < 3 ? mu[a * 512 + c] : (a == 3 ? w0[c] : (a == 4 ? a0[c] : (a == 5 ? kk[c] : (a == 6 ? ka[c] : rk[c]))));
        if (a < 4) pra[c * 4 + a] = v_; else prb[c * 4 + a - 4] = v_; }
    __syncthreads();
}
struct ElemCtx { const LAS unsigned char* rowc; const LAS unsigned char* rowp; const bf16_t* DUt; const bf16_t* IUt; const LAS float* pra; const LAS float* prb; int hd, r, h; float inv; };
template <int MODE> __device__ __forceinline__ void r1_elem(const ElemCtx& C, int jt, bf16x8 (&o0)[2], bf16x8 (&o1)[2], bf16x8 (&o2)[2], bf16x8 (&o3)[2], float& bns, float& pcd) {
    const int r = C.r, h = C.h, hd = C.hd;
    f32x16 lw_ = f32x16{}, la_ = f32x16{};
#pragma unroll
    for (int ks = 0; ks < 4; ++ks) { const int k0 = 16 * ks + 8 * h;
        const bf16x8 bw = *(const LAS bf16x8*)(C.rowc + (1536 + k0) * 2), ba = *(const LAS bf16x8*)(C.rowc + (1600 + k0) * 2);
        const bf16x8 fa = *(const bf16x8*)(C.DUt + (size_t)(32 * jt + r) * 64 + k0), fi = *(const bf16x8*)(C.IUt + (size_t)(32 * jt + r) * 64 + k0);
        lw_ = RK_MF(fa, bw, lw_); la_ = RK_MF(fi, ba, la_); }
    float d = 0.f;
#pragma unroll
    for (int s = 0; s < 2; ++s) { float x0[8], x1[8], x2[8], x3[8];
#pragma unroll
        for (int g2 = 0; g2 < 2; ++g2) { const int g = 2 * s + g2, cj = hd * 64 + 32 * jt + 8 * g + 4 * h;
            float kc[4], kq[4], xc[4], xq[4];
            { const u32x2 a = *(const LAS u32x2*)(C.rowc + (512 + cj) * 2), p = *(const LAS u32x2*)(C.rowp + (512 + cj) * 2);
              kc[0] = bf_lo(a.x); kc[1] = bf_hi(a.x); kc[2] = bf_lo(a.y); kc[3] = bf_hi(a.y); kq[0] = bf_lo(p.x); kq[1] = bf_hi(p.x); kq[2] = bf_lo(p.y); kq[3] = bf_hi(p.y); }
            { const int xo = MODE ? 1024 : 0; const u32x2 a = *(const LAS u32x2*)(C.rowc + (xo + cj) * 2), p = *(const LAS u32x2*)(C.rowp + (xo + cj) * 2);
              xc[0] = bf_lo(a.x); xc[1] = bf_hi(a.x); xc[2] = bf_lo(a.y); xc[3] = bf_hi(a.y); xq[0] = bf_lo(p.x); xq[1] = bf_hi(p.x); xq[2] = bf_lo(p.y); xq[3] = bf_hi(p.y); }
            const LAS f32x4* ppa = (const LAS f32x4*)(C.pra + cj * 4); const LAS f32x4* ppb = (const LAS f32x4*)(C.prb + cj * 4);
#pragma unroll
            for (int q = 0; q < 4; ++q) { const int i = 4 * g + q, o = 4 * g2 + q;
                const f32x4 pa = ppa[q], pb = ppb[q];
                const float e_ = 0.6065306597126334f * fast_sigmoid(pa[3] + lw_[i]); const float L = scan32(e_);
                const float l0 = __builtin_bit_cast(float, __builtin_amdgcn_readlane(__builtin_bit_cast(int, L), 31)), l1 = __builtin_bit_cast(float, __builtin_amdgcn_readlane(__builtin_bit_cast(int, L), 63));
                const float Lend = h ? l1 : l0; if (i == 4 * (r >> 3) + (r & 3)) d = Lend;
                const float x_ = xc[q] + (MODE ? pa[2] : pa[0]) * (xq[q] - xc[q]), k_ = kc[q] + pa[1] * (kq[q] - kc[q]);
                const float ic = fast_sigmoid(pb[0] + la_[i]);
                const float kk = k_ * pb[1] * C.inv, kpn = k_ * (1.0f + (ic - 1.0f) * pb[2]), bv = kk * ic;
                if (MODE) { const float Qe = ex2(L2E * (L - Lend)); x0[o] = bv * Qe; x1[o] = kpn * Qe; x2[o] = x_; x3[o] = 0.f; }
                else { const float P = ex2(-L2E * L), Pi = ex2(L2E * L), Pm = ex2(-L2E * (L - e_)); bns += x_ * kpn * pb[3]; x0[o] = -kk * Pm; x1[o] = x_ * P; x2[o] = bv * Pi; x3[o] = kpn * Pi; } }
            asm volatile("" ::: "memory"); }
        o0[s] = __builtin_bit_cast(bf16x8, (u32x4){cvtpk(x0[0], x0[1]), cvtpk(x0[2], x0[3]), cvtpk(x0[4], x0[5]), cvtpk(x0[6], x0[7])});
        o1[s] = __builtin_bit_cast(bf16x8, (u32x4){cvtpk(x1[0], x1[1]), cvtpk(x1[2], x1[3]), cvtpk(x1[4], x1[5]), cvtpk(x1[6], x1[7])});
        o2[s] = __builtin_bit_cast(bf16x8, (u32x4){cvtpk(x2[0], x2[1]), cvtpk(x2[2], x2[3]), cvtpk(x2[4], x2[5]), cvtpk(x2[6], x2[7])});
        if (!MODE) o3[s] = __builtin_bit_cast(bf16x8, (u32x4){cvtpk(x3[0], x3[1]), cvtpk(x3[2], x3[3]), cvtpk(x3[4], x3[5]), cvtpk(x3[6], x3[7])}); }
    if (MODE) pcd = ex2(-L2E * d);
}


__device__ __forceinline__ void r1_unit(const Args& args, Frame& F, int b, int c) {
    LAS unsigned char* IMG = F.lds;
    const bf16_t* Z = (const bf16_t*)(F.ws + WS_Z);
    const int t0 = 32 * c; const size_t m0 = (size_t)b * SEQ + t0;
    const float* mu = AIN(7);
    int tid = F.tid; asm volatile("" : "+v"(tid));
    __syncthreads();
    { const unsigned lds0 = (unsigned)(uintptr_t)IMG; const int ln = tid & 63;
      for (int task = F.wave; task < 33 * 4; task += NWAVES) { const int rr = task >> 2, j = task & 3, pc = 64 * j + ln;
          if (pc < 224) { if (rr > 0 || t0 > 0) att::glds16(Z + (m0 + rr - 1) * ZW + ZR + 8 * pc, (unsigned)__builtin_amdgcn_readfirstlane((int)(lds0 + rr * PZ + 1024 * j)));
                          else *(LAS u32x4*)(IMG + 16 * pc) = (u32x4){0u, 0u, 0u, 0u}; } }
      asm volatile("s_waitcnt vmcnt(0)" ::: "memory"); }
    __syncthreads();
    { u32x4 actv[2];
#pragma unroll
      for (int i = 0; i < 2; ++i) { const int q = tid + NTHR * i, t = q >> 5, kp = q & 31;
          const u32x4 cw = *(const LAS u32x4*)(IMG + (t + 1) * PZ + (1536 + 8 * kp) * 2), pw = *(const LAS u32x4*)(IMG + t * PZ + (1536 + 8 * kp) * 2);
          const f32x4 m0v = *(const f32x4*)(mu + 1536 + 8 * kp), m1v = *(const f32x4*)(mu + 1536 + 8 * kp + 4);
          const unsigned cwa[4] = {cw.x, cw.y, cw.z, cw.w}, pwa[4] = {pw.x, pw.y, pw.z, pw.w}; float x[8];
#pragma unroll
          for (int j = 0; j < 4; ++j) { const float c0 = bf_lo(cwa[j]), c1 = bf_hi(cwa[j]), p0 = bf_lo(pwa[j]), p1 = bf_hi(pwa[j]);
              const float mu0 = j < 2 ? m0v[2 * j] : m1v[2 * j - 4], mu1 = j < 2 ? m0v[2 * j + 1] : m1v[2 * j - 3];
              x[2 * j] = c0 + mu0 * (p0 - c0); x[2 * j + 1] = c1 + mu1 * (p1 - c1); }
#pragma unroll
          for (int j = 0; j < 8; ++j) { if (kp < 8) { const float e2 = ex2(2.885390081777927f * x[j]); x[j] = 1.0f - 2.0f * __builtin_amdgcn_rcpf(e2 + 1.0f); } else if (kp >= 16) x[j] = fast_sigmoid(x[j]); }
          actv[i] = (u32x4){cvtpk(x[0], x[1]), cvtpk(x[2], x[3]), cvtpk(x[4], x[5]), cvtpk(x[6], x[7])}; }
      __syncthreads();
#pragma unroll
      for (int i = 0; i < 2; ++i) { const int q = tid + NTHR * i, t = q >> 5, kp = q & 31; *(LAS u32x4*)(IMG + (t + 1) * PZ + (1536 + 8 * kp) * 2) = actv[i]; }
      __syncthreads(); }
    const int hd = F.wave; int r = tid & 31, h = (tid >> 5) & 1;
    const LAS unsigned char* rowc = IMG + (r + 1) * PZ; const LAS unsigned char* rowp = IMG + r * PZ;
    const bf16_t* DUt = (const bf16_t*)(F.ws + WS_DUT) + (size_t)hd * 4096; const bf16_t* IUt = (const bf16_t*)(F.ws + WS_IUT) + (size_t)hd * 4096;
    const LAS float* pra = (const LAS float*)(F.lds + LDS_PARA); const LAS float* prb = (const LAS float*)(F.lds + LDS_PARB);
    float n2 = 0.f;
#pragma unroll
    for (int jt = 0; jt < 2; ++jt)
#pragma unroll
        for (int g = 0; g < 4; ++g) { const int cj = hd * 64 + 32 * jt + 8 * g + 4 * h;
            const u32x2 a = *(const LAS u32x2*)(rowc + (512 + cj) * 2), p = *(const LAS u32x2*)(rowp + (512 + cj) * 2);
            const float kc[4] = {bf_lo(a.x), bf_hi(a.x), bf_lo(a.y), bf_hi(a.y)}, kq[4] = {bf_lo(p.x), bf_hi(p.x), bf_lo(p.y), bf_hi(p.y)};
            #pragma unroll
            for (int q = 0; q < 4; ++q) { const float muk = pra[(cj + q) * 4 + 1], kkp = prb[(cj + q) * 4 + 1]; const float k_ = kc[q] + muk * (kq[q] - kc[q]); const float kk_ = k_ * kkp; n2 += kk_ * kk_; } }
    n2 += __shfl_xor(n2, 32);
    const float inv = 1.0f / __builtin_fmaxf(sqrtf(n2), 1e-12f);
    float pcd[2] = {0.f, 0.f};
    float bns = 0.f;
    const ElemCtx EC{rowc, rowp, DUt, IUt, pra, prb, hd, r, h, inv};
    f32x16 Aab = f32x16{}, Aak = f32x16{}, Arb = f32x16{}, Ark = f32x16{};
    bf16x8 fRt[2][2], tAt[2][2];
    { bf16x8 fId[2]; mk_id(fId, r, h);
#pragma unroll
    for (int jt = 0; jt < 2; ++jt) { bf16x8 fA[2], fB[2], fK[2]; float pd_ = 0.f;
        r1_elem<0>(EC, jt, fA, fRt[jt], fB, fK, bns, pd_);
        const bf16x8 fA0 = fA[0], fA1 = fA[1], fB0 = fB[0], fB1 = fB[1], fK0 = fK[0], fK1 = fK[1];
        Aab = RK_MF(fB0, fA0, Aab); Aab = RK_MF(fB1, fA1, Aab); Aak = RK_MF(fK0, fA0, Aak); Aak = RK_MF(fK1, fA1, Aak);
        Arb = RK_MF(fB0, fRt[jt][0], Arb); Arb = RK_MF(fB1, fRt[jt][1], Arb); Ark = RK_MF(fK0, fRt[jt][0], Ark); Ark = RK_MF(fK1, fRt[jt][1], Ark);
        { f32x16 t_ = f32x16{}; t_ = RK_MF(fA0, fId[0], t_); t_ = RK_MF(fA1, fId[1], t_); tAt[jt][0] = frag<0>(t_); tAt[jt][1] = frag<1>(t_); } } }
    bns += __shfl_xor(bns, 32);
    if (h == 0) ((float*)(F.ws + WS_TOPW))[(m0 + r) * 8 + hd] = bns;
    LAS unsigned char* stash = IMG + (1 + ((tid & 63) >> 3)) * PZ + hd * 128 + (tid & 7) * 16;
#pragma unroll
    for (int p = 0; p < 4; ++p) *(LAS u32x4*)(stash + 8 * p * PZ) = __builtin_bit_cast(u32x4, fRt[p >> 1][p & 1]);
#pragma unroll
    for (int i = 0; i < 16; ++i) { const int s = 8 * (i >> 2) + 4 * h + (i & 3);
        if (!(s < r)) { Aab[i] = 0.f; Aak[i] = 0.f; } if (!(s <= r)) { Arb[i] = 0.f; Ark[i] = 0.f; } }
    const bf16x8 fAak[2] = {frag<0>(Aak), frag<1>(Aak)}, fArb[2] = {frag<0>(Arb), frag<1>(Arb)}, fArk[2] = {frag<0>(Ark), frag<1>(Ark)};
    bf16x8 fT[2];
    asm volatile("" ::: "memory"); __builtin_amdgcn_sched_barrier(0);
    { float T[32];
#pragma unroll
      for (int s = 0; s < 32; ++s) T[s] = (r == s) ? 1.0f : 0.f;
#define TI_RL(k_, is_, ln_) { const float ac_ = Aab[is_]; asm volatile("v_readlane_b32 %0, %1, " #ln_ : "=s"(sv_[k_]) : "v"(__float_as_int(ac_))); }
#define TI_FM(s_, u_, k_) T[s_] = __builtin_fmaf(T[u_], __int_as_float(sv_[k_]), T[s_]);
      if (!PROBE_TINV_ID) { int sv_[8];
        TI_RL(0, 0, 31) TI_RL(1, 1, 31) TI_RL(2, 2, 31) TI_RL(3, 3, 31) TI_RL(4, 0, 63) TI_RL(5, 1, 63) TI_RL(6, 2, 63) TI_RL(7, 3, 63)
        TI_FM(0, 31, 0) TI_FM(1, 31, 1) TI_FM(2, 31, 2) TI_FM(3, 31, 3) TI_FM(4, 31, 4) TI_FM(5, 31, 5) TI_FM(6, 31, 6) TI_FM(7, 31, 7)
        TI_RL(0, 4, 31) TI_RL(1, 5, 31) TI_RL(2, 6, 31) TI_RL(3, 7, 31) TI_RL(4, 4, 63) TI_RL(5, 5, 63) TI_RL(6, 6, 63) TI_RL(7, 7, 63)
        TI_FM(8, 31, 0) TI_FM(9, 31, 1) TI_FM(10, 31, 2) TI_FM(11, 31, 3) TI_FM(12, 31, 4) TI_FM(13, 31, 5) TI_FM(14, 31, 6) TI_FM(15, 31, 7)
        TI_RL(0, 8, 31) TI_RL(1, 9, 31) TI_RL(2, 10, 31) TI_RL(3, 11, 31) TI_RL(4, 8, 63) TI_RL(5, 9, 63) TI_RL(6, 10, 63) TI_RL(7, 11, 63)
        TI_FM(16, 31, 0) TI_FM(17, 31, 1) TI_FM(18, 31, 2) TI_FM(19, 31, 3) TI_FM(20, 31, 4) TI_FM(21, 31, 5) TI_FM(22, 31, 6) TI_FM(23, 31, 7)
        TI_RL(0, 12, 31) TI_RL(1, 13, 31) TI_RL(2, 14, 31) TI_RL(3, 15, 31) TI_RL(4, 12, 63) TI_RL(5, 13, 63) TI_RL(6, 14, 63)
        TI_FM(24, 31, 0) TI_FM(25, 31, 1) TI_FM(26, 31, 2) TI_FM(27, 31, 3) TI_FM(28, 31, 4) TI_FM(29, 31, 5) TI_FM(30, 31, 6)
        TI_RL(0, 0, 30) TI_RL(1, 1, 30) TI_RL(2, 2, 30) TI_RL(3, 3, 30) TI_RL(4, 0, 62) TI_RL(5, 1, 62) TI_RL(6, 2, 62) TI_RL(7, 3, 62)
        TI_FM(0, 30, 0) TI_FM(1, 30, 1) TI_FM(2, 30, 2) TI_FM(3, 30, 3) TI_FM(4, 30, 4) TI_FM(5, 30, 5) TI_FM(6, 30, 6) TI_FM(7, 30, 7)
        TI_RL(0, 4, 30) TI_RL(1, 5, 30) TI_RL(2, 6, 30) TI_RL(3, 7, 30) TI_RL(4, 4, 62) TI_RL(5, 5, 62) TI_RL(6, 6, 62) TI_RL(7, 7, 62)
        TI_FM(8, 30, 0) TI_FM(9, 30, 1) TI_FM(10, 30, 2) TI_FM(11, 30, 3) TI_FM(12, 30, 4) TI_FM(13, 30, 5) TI_FM(14, 30, 6) TI_FM(15, 30, 7)
        TI_RL(0, 8, 30) TI_RL(1, 9, 30) TI_RL(2, 10, 30) TI_RL(3, 11, 30) TI_RL(4, 8, 62) TI_RL(5, 9, 62) TI_RL(6, 10, 62) TI_RL(7, 11, 62)
        TI_FM(16, 30, 0) TI_FM(17, 30, 1) TI_FM(18, 30, 2) TI_FM(19, 30, 3) TI_FM(20, 30, 4) TI_FM(21, 30, 5) TI_FM(22, 30, 6) TI_FM(23, 30, 7)
        TI_RL(0, 12, 30) TI_RL(1, 13, 30) TI_RL(2, 14, 30) TI_RL(3, 15, 30) TI_RL(4, 12, 62) TI_RL(5, 13, 62)
        TI_FM(24, 30, 0) TI_FM(25, 30, 1) TI_FM(26, 30, 2) TI_FM(27, 30, 3) TI_FM(28, 30, 4) TI_FM(29, 30, 5)
        TI_RL(0, 0, 29) TI_RL(1, 1, 29) TI_RL(2, 2, 29) TI_RL(3, 3, 29) TI_RL(4, 0, 61) TI_RL(5, 1, 61) TI_RL(6, 2, 61) TI_RL(7, 3, 61)
        TI_FM(0, 29, 0) TI_FM(1, 29, 1) TI_FM(2, 29, 2) TI_FM(3, 29, 3) TI_FM(4, 29, 4) TI_FM(5, 29, 5) TI_FM(6, 29, 6) TI_FM(7, 29, 7)
        TI_RL(0, 4, 29) TI_RL(1, 5, 29) TI_RL(2, 6, 29) TI_RL(3, 7, 29) TI_RL(4, 4, 61) TI_RL(5, 5, 61) TI_RL(6, 6, 61) TI_RL(7, 7, 61)
        TI_FM(8, 29, 0) TI_FM(9, 29, 1) TI_FM(10, 29, 2) TI_FM(11, 29, 3) TI_FM(12, 29, 4) TI_FM(13, 29, 5) TI_FM(14, 29, 6) TI_FM(15, 29, 7)
        TI_RL(0, 8, 29) TI_RL(1, 9, 29) TI_RL(2, 10, 29) TI_RL(3, 11, 29) TI_RL(4, 8, 61) TI_RL(5, 9, 61) TI_RL(6, 10, 61) TI_RL(7, 11, 61)
        TI_FM(16, 29, 0) TI_FM(17, 29, 1) TI_FM(18, 29, 2) TI_FM(19, 29, 3) TI_FM(20, 29, 4) TI_FM(21, 29, 5) TI_FM(22, 29, 6) TI_FM(23, 29, 7)
        TI_RL(0, 12, 29) TI_RL(1, 13, 29) TI_RL(2, 14, 29) TI_RL(3, 15, 29) TI_RL(4, 12, 61)
        TI_FM(24, 29, 0) TI_FM(25, 29, 1) TI_FM(26, 29, 2) TI_FM(27, 29, 3) TI_FM(28, 29, 4)
        TI_RL(0, 0, 28) TI_RL(1, 1, 28) TI_RL(2, 2, 28) TI_RL(3, 3, 28) TI_RL(4, 0, 60) TI_RL(5, 1, 60) TI_RL(6, 2, 60) TI_RL(7, 3, 60)
        TI_FM(0, 28, 0) TI_FM(1, 28, 1) TI_FM(2, 28, 2) TI_FM(3, 28, 3) TI_FM(4, 28, 4) TI_FM(5, 28, 5) TI_FM(6, 28, 6) TI_FM(7, 28, 7)
        TI_RL(0, 4, 28) TI_RL(1, 5, 28) TI_RL(2, 6, 28) TI_RL(3, 7, 28) TI_RL(4, 4, 60) TI_RL(5, 5, 60) TI_RL(6, 6, 60) TI_RL(7, 7, 60)
        TI_FM(8, 28, 0) TI_FM(9, 28, 1) TI_FM(10, 28, 2) TI_FM(11, 28, 3) TI_FM(12, 28, 4) TI_FM(13, 28, 5) TI_FM(14, 28, 6) TI_FM(15, 28, 7)
        TI_RL(0, 8, 28) TI_RL(1, 9, 28) TI_RL(2, 10, 28) TI_RL(3, 11, 28) TI_RL(4, 8, 60) TI_RL(5, 9, 60) TI_RL(6, 10, 60) TI_RL(7, 11, 60)
        TI_FM(16, 28, 0) TI_FM(17, 28, 1) TI_FM(18, 28, 2) TI_FM(19, 28, 3) TI_FM(20, 28, 4) TI_FM(21, 28, 5) TI_FM(22, 28, 6) TI_FM(23, 28, 7)
        TI_RL(0, 12, 28) TI_RL(1, 13, 28) TI_RL(2, 14, 28) TI_RL(3, 15, 28)
        TI_FM(24, 28, 0) TI_FM(25, 28, 1) TI_FM(26, 28, 2) TI_FM(27, 28, 3)
        TI_RL(0, 0, 27) TI_RL(1, 1, 27) TI_RL(2, 2, 27) TI_RL(3, 3, 27) TI_RL(4, 0, 59) TI_RL(5, 1, 59) TI_RL(6, 2, 59) TI_RL(7, 3, 59)
        TI_FM(0, 27, 0) TI_FM(1, 27, 1) TI_FM(2, 27, 2) TI_FM(3, 27, 3) TI_FM(4, 27, 4) TI_FM(5, 27, 5) TI_FM(6, 27, 6) TI_FM(7, 27, 7)
        TI_RL(0, 4, 27) TI_RL(1, 5, 27) TI_RL(2, 6, 27) TI_RL(3, 7, 27) TI_RL(4, 4, 59) TI_RL(5, 5, 59) TI_RL(6, 6, 59) TI_RL(7, 7, 59)
        TI_FM(8, 27, 0) TI_FM(9, 27, 1) TI_FM(10, 27, 2) TI_FM(11, 27, 3) TI_FM(12, 27, 4) TI_FM(13, 27, 5) TI_FM(14, 27, 6) TI_FM(15, 27, 7)
        TI_RL(0, 8, 27) TI_RL(1, 9, 27) TI_RL(2, 10, 27) TI_RL(3, 11, 27) TI_RL(4, 8, 59) TI_RL(5, 9, 59) TI_RL(6, 10, 59) TI_RL(7, 11, 59)
        TI_FM(16, 27, 0) TI_FM(17, 27, 1) TI_FM(18, 27, 2) TI_FM(19, 27, 3) TI_FM(20, 27, 4) TI_FM(21, 27, 5) TI_FM(22, 27, 6) TI_FM(23, 27, 7)
        TI_RL(0, 12, 27) TI_RL(1, 13, 27) TI_RL(2, 14, 27)
        TI_FM(24, 27, 0) TI_FM(25, 27, 1) TI_FM(26, 27, 2)
        TI_RL(0, 0, 26) TI_RL(1, 1, 26) TI_RL(2, 2, 26) TI_RL(3, 3, 26) TI_RL(4, 0, 58) TI_RL(5, 1, 58) TI_RL(6, 2, 58) TI_RL(7, 3, 58)
        TI_FM(0, 26, 0) TI_FM(1, 26, 1) TI_FM(2, 26, 2) TI_FM(3, 26, 3) TI_FM(4, 26, 4) TI_FM(5, 26, 5) TI_FM(6, 26, 6) TI_FM(7, 26, 7)
        TI_RL(0, 4, 26) TI_RL(1, 5, 26) TI_RL(2, 6, 26) TI_RL(3, 7, 26) TI_RL(4, 4, 58) TI_RL(5, 5, 58) TI_RL(6, 6, 58) TI_RL(7, 7, 58)
        TI_FM(8, 26, 0) TI_FM(9, 26, 1) TI_FM(10, 26, 2) TI_FM(11, 26, 3) TI_FM(12, 26, 4) TI_FM(13, 26, 5) TI_FM(14, 26, 6) TI_FM(15, 26, 7)
        TI_RL(0, 8, 26) TI_RL(1, 9, 26) TI_RL(2, 10, 26) TI_RL(3, 11, 26) TI_RL(4, 8, 58) TI_RL(5, 9, 58) TI_RL(6, 10, 58) TI_RL(7, 11, 58)
        TI_FM(16, 26, 0) TI_FM(17, 26, 1) TI_FM(18, 26, 2) TI_FM(19, 26, 3) TI_FM(20, 26, 4) TI_FM(21, 26, 5) TI_FM(22, 26, 6) TI_FM(23, 26, 7)
        TI_RL(0, 12, 26) TI_RL(1, 13, 26)
        TI_FM(24, 26, 0) TI_FM(25, 26, 1)
        TI_RL(0, 0, 25) TI_RL(1, 1, 25) TI_RL(2, 2, 25) TI_RL(3, 3, 25) TI_RL(4, 0, 57) TI_RL(5, 1, 57) TI_RL(6, 2, 57) TI_RL(7, 3, 57)
        TI_FM(0, 25, 0) TI_FM(1, 25, 1) TI_FM(2, 25, 2) TI_FM(3, 25, 3) TI_FM(4, 25, 4) TI_FM(5, 25, 5) TI_FM(6, 25, 6) TI_FM(7, 25, 7)
        TI_RL(0, 4, 25) TI_RL(1, 5, 25) TI_RL(2, 6, 25) TI_RL(3, 7, 25) TI_RL(4, 4, 57) TI_RL(5, 5, 57) TI_RL(6, 6, 57) TI_RL(7, 7, 57)
        TI_FM(8, 25, 0) TI_FM(9, 25, 1) TI_FM(10, 25, 2) TI_FM(11, 25, 3) TI_FM(12, 25, 4) TI_FM(13, 25, 5) TI_FM(14, 25, 6) TI_FM(15, 25, 7)
        TI_RL(0, 8, 25) TI_RL(1, 9, 25) TI_RL(2, 10, 25) TI_RL(3, 11, 25) TI_RL(4, 8, 57) TI_RL(5, 9, 57) TI_RL(6, 10, 57) TI_RL(7, 11, 57)
        TI_FM(16, 25, 0) TI_FM(17, 25, 1) TI_FM(18, 25, 2) TI_FM(19, 25, 3) TI_FM(20, 25, 4) TI_FM(21, 25, 5) TI_FM(22, 25, 6) TI_FM(23, 25, 7)
        TI_RL(0, 12, 25)
        TI_FM(24, 25, 0)
        TI_RL(0, 0, 24) TI_RL(1, 1, 24) TI_RL(2, 2, 24) TI_RL(3, 3, 24) TI_RL(4, 0, 56) TI_RL(5, 1, 56) TI_RL(6, 2, 56) TI_RL(7, 3, 56)
        TI_FM(0, 24, 0) TI_FM(1, 24, 1) TI_FM(2, 24, 2) TI_FM(3, 24, 3) TI_FM(4, 24, 4) TI_FM(5, 24, 5) TI_FM(6, 24, 6) TI_FM(7, 24, 7)
        TI_RL(0, 4, 24) TI_RL(1, 5, 24) TI_RL(2, 6, 24) TI_RL(3, 7, 24) TI_RL(4, 4, 56) TI_RL(5, 5, 56) TI_RL(6, 6, 56) TI_RL(7, 7, 56)
        TI_FM(8, 24, 0) TI_FM(9, 24, 1) TI_FM(10, 24, 2) TI_FM(11, 24, 3) TI_FM(12, 24, 4) TI_FM(13, 24, 5) TI_FM(14, 24, 6) TI_FM(15, 24, 7)
        TI_RL(0, 8, 24) TI_RL(1, 9, 24) TI_RL(2, 10, 24) TI_RL(3, 11, 24) TI_RL(4, 8, 56) TI_RL(5, 9, 56) TI_RL(6, 10, 56) TI_RL(7, 11, 56)
        TI_FM(16, 24, 0) TI_FM(17, 24, 1) TI_FM(18, 24, 2) TI_FM(19, 24, 3) TI_FM(20, 24, 4) TI_FM(21, 24, 5) TI_FM(22, 24, 6) TI_FM(23, 24, 7)
        TI_RL(0, 0, 23) TI_RL(1, 1, 23) TI_RL(2, 2, 23) TI_RL(3, 3, 23) TI_RL(4, 0, 55) TI_RL(5, 1, 55) TI_RL(6, 2, 55) TI_RL(7, 3, 55)
        TI_FM(0, 23, 0) TI_FM(1, 23, 1) TI_FM(2, 23, 2) TI_FM(3, 23, 3) TI_FM(4, 23, 4) TI_FM(5, 23, 5) TI_FM(6, 23, 6) TI_FM(7, 23, 7)
        TI_RL(0, 4, 23) TI_RL(1, 5, 23) TI_RL(2, 6, 23) TI_RL(3, 7, 23) TI_RL(4, 4, 55) TI_RL(5, 5, 55) TI_RL(6, 6, 55) TI_RL(7, 7, 55)
        TI_FM(8, 23, 0) TI_FM(9, 23, 1) TI_FM(10, 23, 2) TI_FM(11, 23, 3) TI_FM(12, 23, 4) TI_FM(13, 23, 5) TI_FM(14, 23, 6) TI_FM(15, 23, 7)
        TI_RL(0, 8, 23) TI_RL(1, 9, 23) TI_RL(2, 10, 23) TI_RL(3, 11, 23) TI_RL(4, 8, 55) TI_RL(5, 9, 55) TI_RL(6, 10, 55)
        TI_FM(16, 23, 0) TI_FM(17, 23, 1) TI_FM(18, 23, 2) TI_FM(19, 23, 3) TI_FM(20, 23, 4) TI_FM(21, 23, 5) TI_FM(22, 23, 6)
        TI_RL(0, 0, 22) TI_RL(1, 1, 22) TI_RL(2, 2, 22) TI_RL(3, 3, 22) TI_RL(4, 0, 54) TI_RL(5, 1, 54) TI_RL(6, 2, 54) TI_RL(7, 3, 54)
        TI_FM(0, 22, 0) TI_FM(1, 22, 1) TI_FM(2, 22, 2) TI_FM(3, 22, 3) TI_FM(4, 22, 4) TI_FM(5, 22, 5) TI_FM(6, 22, 6) TI_FM(7, 22, 7)
        TI_RL(0, 4, 22) TI_RL(1, 5, 22) TI_RL(2, 6, 22) TI_RL(3, 7, 22) TI_RL(4, 4, 54) TI_RL(5, 5, 54) TI_RL(6, 6, 54) TI_RL(7, 7, 54)
        TI_FM(8, 22, 0) TI_FM(9, 22, 1) TI_FM(10, 22, 2) TI_FM(11, 22, 3) TI_FM(12, 22, 4) TI_FM(13, 22, 5) TI_FM(14, 22, 6) TI_FM(15, 22, 7)
        TI_RL(0, 8, 22) TI_RL(1, 9, 22) TI_RL(2, 10, 22) TI_RL(3, 11, 22) TI_RL(4, 8, 54) TI_RL(5, 9, 54)
        TI_FM(16, 22, 0) TI_FM(17, 22, 1) TI_FM(18, 22, 2) TI_FM(19, 22, 3) TI_FM(20, 22, 4) TI_FM(21, 22, 5)
        TI_RL(0, 0, 21) TI_RL(1, 1, 21) TI_RL(2, 2, 21) TI_RL(3, 3, 21) TI_RL(4, 0, 53) TI_RL(5, 1, 53) TI_RL(6, 2, 53) TI_RL(7, 3, 53)
        TI_FM(0, 21, 0) TI_FM(1, 21, 1) TI_FM(2, 21, 2) TI_FM(3, 21, 3) TI_FM(4, 21, 4) TI_FM(5, 21, 5) TI_FM(6, 21, 6) TI_FM(7, 21, 7)
        TI_RL(0, 4, 21) TI_RL(1, 5, 21) TI_RL(2, 6, 21) TI_RL(3, 7, 21) TI_RL(4, 4, 53) TI_RL(5, 5, 53) TI_RL(6, 6, 53) TI_RL(7, 7, 53)
        TI_FM(8, 21, 0) TI_FM(9, 21, 1) TI_FM(10, 21, 2) TI_FM(11, 21, 3) TI_FM(12, 21, 4) TI_FM(13, 21, 5) TI_FM(14, 21, 6) TI_FM(15, 21, 7)
        TI_RL(0, 8, 21) TI_RL(1, 9, 21) TI_RL(2, 10, 21) TI_RL(3, 11, 21) TI_RL(4, 8, 53)
        TI_FM(16, 21, 0) TI_FM(17, 21, 1) TI_FM(18, 21, 2) TI_FM(19, 21, 3) TI_FM(20, 21, 4)
        TI_RL(0, 0, 20) TI_RL(1, 1, 20) TI_RL(2, 2, 20) TI_RL(3, 3, 20) TI_RL(4, 0, 52) TI_RL(5, 1, 52) TI_RL(6, 2, 52) TI_RL(7, 3, 52)
        TI_FM(0, 20, 0) TI_FM(1, 20, 1) TI_FM(2, 20, 2) TI_FM(3, 20, 3) TI_FM(4, 20, 4) TI_FM(5, 20, 5) TI_FM(6, 20, 6) TI_FM(7, 20, 7)
        TI_RL(0, 4, 20) TI_RL(1, 5, 20) TI_RL(2, 6, 20) TI_RL(3, 7, 20) TI_RL(4, 4, 52) TI_RL(5, 5, 52) TI_RL(6, 6, 52) TI_RL(7, 7, 52)
        TI_FM(8, 20, 0) TI_FM(9, 20, 1) TI_FM(10, 20, 2) TI_FM(11, 20, 3) TI_FM(12, 20, 4) TI_FM(13, 20, 5) TI_FM(14, 20, 6) TI_FM(15, 20, 7)
        TI_RL(0, 8, 20) TI_RL(1, 9, 20) TI_RL(2, 10, 20) TI_RL(3, 11, 20)
        TI_FM(16, 20, 0) TI_FM(17, 20, 1) TI_FM(18, 20, 2) TI_FM(19, 20, 3)
        TI_RL(0, 0, 19) TI_RL(1, 1, 19) TI_RL(2, 2, 19) TI_RL(3, 3, 19) TI_RL(4, 0, 51) TI_RL(5, 1, 51) TI_RL(6, 2, 51) TI_RL(7, 3, 51)
        TI_FM(0, 19, 0) TI_FM(1, 19, 1) TI_FM(2, 19, 2) TI_FM(3, 19, 3) TI_FM(4, 19, 4) TI_FM(5, 19, 5) TI_FM(6, 19, 6) TI_FM(7, 19, 7)
        TI_RL(0, 4, 19) TI_RL(1, 5, 19) TI_RL(2, 6, 19) TI_RL(3, 7, 19) TI_RL(4, 4, 51) TI_RL(5, 5, 51) TI_RL(6, 6, 51) TI_RL(7, 7, 51)
        TI_FM(8, 19, 0) TI_FM(9, 19, 1) TI_FM(10, 19, 2) TI_FM(11, 19, 3) TI_FM(12, 19, 4) TI_FM(13, 19, 5) TI_FM(14, 19, 6) TI_FM(15, 19, 7)
        TI_RL(0, 8, 19) TI_RL(1, 9, 19) TI_RL(2, 10, 19)
        TI_FM(16, 19, 0) TI_FM(17, 19, 1) TI_FM(18, 19, 2)
        TI_RL(0, 0, 18) TI_RL(1, 1, 18) TI_RL(2, 2, 18) TI_RL(3, 3, 18) TI_RL(4, 0, 50) TI_RL(5, 1, 50) TI_RL(6, 2, 50) TI_RL(7, 3, 50)
        TI_FM(0, 18, 0) TI_FM(1, 18, 1) TI_FM(2, 18, 2) TI_FM(3, 18, 3) TI_FM(4, 18, 4) TI_FM(5, 18, 5) TI_FM(6, 18, 6) TI_FM(7, 18, 7)
        TI_RL(0, 4, 18) TI_RL(1, 5, 18) TI_RL(2, 6, 18) TI_RL(3, 7, 18) TI_RL(4, 4, 50) TI_RL(5, 5, 50) TI_RL(6, 6, 50) TI_RL(7, 7, 50)
        TI_FM(8, 18, 0) TI_FM(9, 18, 1) TI_FM(10, 18, 2) TI_FM(11, 18, 3) TI_FM(12, 18, 4) TI_FM(13, 18, 5) TI_FM(14, 18, 6) TI_FM(15, 18, 7)
        TI_RL(0, 8, 18) TI_RL(1, 9, 18)
        TI_FM(16, 18, 0) TI_FM(17, 18, 1)
        TI_RL(0, 0, 17) TI_RL(1, 1, 17) TI_RL(2, 2, 17) TI_RL(3, 3, 17) TI_RL(4, 0, 49) TI_RL(5, 1, 49) TI_RL(6, 2, 49) TI_RL(7, 3, 49)
        TI_FM(0, 17, 0) TI_FM(1, 17, 1) TI_FM(2, 17, 2) TI_FM(3, 17, 3) TI_FM(4, 17, 4) TI_FM(5, 17, 5) TI_FM(6, 17, 6) TI_FM(7, 17, 7)
        TI_RL(0, 4, 17) TI_RL(1, 5, 17) TI_RL(2, 6, 17) TI_RL(3, 7, 17) TI_RL(4, 4, 49) TI_RL(5, 5, 49) TI_RL(6, 6, 49) TI_RL(7, 7, 49)
        TI_FM(8, 17, 0) TI_FM(9, 17, 1) TI_FM(10, 17, 2) TI_FM(11, 17, 3) TI_FM(12, 17, 4) TI_FM(13, 17, 5) TI_FM(14, 17, 6) TI_FM(15, 17, 7)
        TI_RL(0, 8, 17)
        TI_FM(16, 17, 0)
        TI_RL(0, 0, 16) TI_RL(1, 1, 16) TI_RL(2, 2, 16) TI_RL(3, 3, 16) TI_RL(4, 0, 48) TI_RL(5, 1, 48) TI_RL(6, 2, 48) TI_RL(7, 3, 48)
        TI_FM(0, 16, 0) TI_FM(1, 16, 1) TI_FM(2, 16, 2) TI_FM(3, 16, 3) TI_FM(4, 16, 4) TI_FM(5, 16, 5) TI_FM(6, 16, 6) TI_FM(7, 16, 7)
        TI_RL(0, 4, 16) TI_RL(1, 5, 16) TI_RL(2, 6, 16) TI_RL(3, 7, 16) TI_RL(4, 4, 48) TI_RL(5, 5, 48) TI_RL(6, 6, 48) TI_RL(7, 7, 48)
        TI_FM(8, 16, 0) TI_FM(9, 16, 1) TI_FM(10, 16, 2) TI_FM(11, 16, 3) TI_FM(12, 16, 4) TI_FM(13, 16, 5) TI_FM(14, 16, 6) TI_FM(15, 16, 7)
        TI_RL(0, 0, 15) TI_RL(1, 1, 15) TI_RL(2, 2, 15) TI_RL(3, 3, 15) TI_RL(4, 0, 47) TI_RL(5, 1, 47) TI_RL(6, 2, 47) TI_RL(7, 3, 47)
        TI_FM(0, 15, 0) TI_FM(1, 15, 1) TI_FM(2, 15, 2) TI_FM(3, 15, 3) TI_FM(4, 15, 4) TI_FM(5, 15, 5) TI_FM(6, 15, 6) TI_FM(7, 15, 7)
        TI_RL(0, 4, 15) TI_RL(1, 5, 15) TI_RL(2, 6, 15) TI_RL(3, 7, 15) TI_RL(4, 4, 47) TI_RL(5, 5, 47) TI_RL(6, 6, 47)
        TI_FM(8, 15, 0) TI_FM(9, 15, 1) TI_FM(10, 15, 2) TI_FM(11, 15, 3) TI_FM(12, 15, 4) TI_FM(13, 15, 5) TI_FM(14, 15, 6)
        TI_RL(0, 0, 14) TI_RL(1, 1, 14) TI_RL(2, 2, 14) TI_RL(3, 3, 14) TI_RL(4, 0, 46) TI_RL(5, 1, 46) TI_RL(6, 2, 46) TI_RL(7, 3, 46)
        TI_FM(0, 14, 0) TI_FM(1, 14, 1) TI_FM(2, 14, 2) TI_FM(3, 14, 3) TI_FM(4, 14, 4) TI_FM(5, 14, 5) TI_FM(6, 14, 6) TI_FM(7, 14, 7)
        TI_RL(0, 4, 14) TI_RL(1, 5, 14) TI_RL(2, 6, 14) TI_RL(3, 7, 14) TI_RL(4, 4, 46) TI_RL(5, 5, 46)
        TI_FM(8, 14, 0) TI_FM(9, 14, 1) TI_FM(10, 14, 2) TI_FM(11, 14, 3) TI_FM(12, 14, 4) TI_FM(13, 14, 5)
        TI_RL(0, 0, 13) TI_RL(1, 1, 13) TI_RL(2, 2, 13) TI_RL(3, 3, 13) TI_RL(4, 0, 45) TI_RL(5, 1, 45) TI_RL(6, 2, 45) TI_RL(7, 3, 45)
        TI_FM(0, 13, 0) TI_FM(1, 13, 1) TI_FM(2, 13, 2) TI_FM(3, 13, 3) TI_FM(4, 13, 4) TI_FM(5, 13, 5) TI_FM(6, 13, 6) TI_FM(7, 13, 7)
        TI_RL(0, 4, 13) TI_RL(1, 5, 13) TI_RL(2, 6, 13) TI_RL(3, 7, 13) TI_RL(4, 4, 45)
        TI_FM(8, 13, 0) TI_FM(9, 13, 1) TI_FM(10, 13, 2) TI_FM(11, 13, 3) TI_FM(12, 13, 4)
        TI_RL(0, 0, 12) TI_RL(1, 1, 12) TI_RL(2, 2, 12) TI_RL(3, 3, 12) TI_RL(4, 0, 44) TI_RL(5, 1, 44) TI_RL(6, 2, 44) TI_RL(7, 3, 44)
        TI_FM(0, 12, 0) TI_FM(1, 12, 1) TI_FM(2, 12, 2) TI_FM(3, 12, 3) TI_FM(4, 12, 4) TI_FM(5, 12, 5) TI_FM(6, 12, 6) TI_FM(7, 12, 7)
        TI_RL(0, 4, 12) TI_RL(1, 5, 12) TI_RL(2, 6, 12) TI_RL(3, 7, 12)
        TI_FM(8, 12, 0) TI_FM(9, 12, 1) TI_FM(10, 12, 2) TI_FM(11, 12, 3)
        TI_RL(0, 0, 11) TI_RL(1, 1, 11) TI_RL(2, 2, 11) TI_RL(3, 3, 11) TI_RL(4, 0, 43) TI_RL(5, 1, 43) TI_RL(6, 2, 43) TI_RL(7, 3, 43)
        TI_FM(0, 11, 0) TI_FM(1, 11, 1) TI_FM(2, 11, 2) TI_FM(3, 11, 3) TI_FM(4, 11, 4) TI_FM(5, 11, 5) TI_FM(6, 11, 6) TI_FM(7, 11, 7)
        TI_RL(0, 4, 11) TI_RL(1, 5, 11) TI_RL(2, 6, 11)
        TI_FM(8, 11, 0) TI_FM(9, 11, 1) TI_FM(10, 11, 2)
        TI_RL(0, 0, 10) TI_RL(1, 1, 10) TI_RL(2, 2, 10) TI_RL(3, 3, 10) TI_RL(4, 0, 42) TI_RL(5, 1, 42) TI_RL(6, 2, 42) TI_RL(7, 3, 42)
        TI_FM(0, 10, 0) TI_FM(1, 10, 1) TI_FM(2, 10, 2) TI_FM(3, 10, 3) TI_FM(4, 10, 4) TI_FM(5, 10, 5) TI_FM(6, 10, 6) TI_FM(7, 10, 7)
        TI_RL(0, 4, 10) TI_RL(1, 5, 10)
        TI_FM(8, 10, 0) TI_FM(9, 10, 1)
        TI_RL(0, 0, 9) TI_RL(1, 1, 9) TI_RL(2, 2, 9) TI_RL(3, 3, 9) TI_RL(4, 0, 41) TI_RL(5, 1, 41) TI_RL(6, 2, 41) TI_RL(7, 3, 41)
        TI_FM(0, 9, 0) TI_FM(1, 9, 1) TI_FM(2, 9, 2) TI_FM(3, 9, 3) TI_FM(4, 9, 4) TI_FM(5, 9, 5) TI_FM(6, 9, 6) TI_FM(7, 9, 7)
        TI_RL(0, 4, 9)
        TI_FM(8, 9, 0)
        TI_RL(0, 0, 8) TI_RL(1, 1, 8) TI_RL(2, 2, 8) TI_RL(3, 3, 8) TI_RL(4, 0, 40) TI_RL(5, 1, 40) TI_RL(6, 2, 40) TI_RL(7, 3, 40)
        TI_FM(0, 8, 0) TI_FM(1, 8, 1) TI_FM(2, 8, 2) TI_FM(3, 8, 3) TI_FM(4, 8, 4) TI_FM(5, 8, 5) TI_FM(6, 8, 6) TI_FM(7, 8, 7)
        TI_RL(0, 0, 7) TI_RL(1, 1, 7) TI_RL(2, 2, 7) TI_RL(3, 3, 7) TI_RL(4, 0, 39) TI_RL(5, 1, 39) TI_RL(6, 2, 39)
        TI_FM(0, 7, 0) TI_FM(1, 7, 1) TI_FM(2, 7, 2) TI_FM(3, 7, 3) TI_FM(4, 7, 4) TI_FM(5, 7, 5) TI_FM(6, 7, 6)
        TI_RL(0, 0, 6) TI_RL(1, 1, 6) TI_RL(2, 2, 6) TI_RL(3, 3, 6) TI_RL(4, 0, 38) TI_RL(5, 1, 38)
        TI_FM(0, 6, 0) TI_FM(1, 6, 1) TI_FM(2, 6, 2) TI_FM(3, 6, 3) TI_FM(4, 6, 4) TI_FM(5, 6, 5)
        TI_RL(0, 0, 5) TI_RL(1, 1, 5) TI_RL(2, 2, 5) TI_RL(3, 3, 5) TI_RL(4, 0, 37)
        TI_FM(0, 5, 0) TI_FM(1, 5, 1) TI_FM(2, 5, 2) TI_FM(3, 5, 3) TI_FM(4, 5, 4)
        TI_RL(0, 0, 4) TI_RL(1, 1, 4) TI_RL(2, 2, 4) TI_RL(3, 3, 4)
        TI_FM(0, 4, 0) TI_FM(1, 4, 1) TI_FM(2, 4, 2) TI_FM(3, 4, 3)
        TI_RL(0, 0, 3) TI_RL(1, 1, 3) TI_RL(2, 2, 3)
        TI_FM(0, 3, 0) TI_FM(1, 3, 1) TI_FM(2, 3, 2)
        TI_RL(0, 0, 2) TI_RL(1, 1, 2)
        TI_FM(0, 2, 0) TI_FM(1, 2, 1)
        TI_RL(0, 0, 1)
        TI_FM(0, 1, 0)
      }
#undef TI_RL
#undef TI_FM

#pragma unroll
      for (int s = 0; s < 2; ++s) { float e8[8];
#pragma unroll
          for (int jj = 0; jj < 8; ++jj) { const int i0 = 16 * s + 8 * (jj >> 2) + (jj & 3); float ta = T[i0], tb = T[i0 + 4]; asm volatile("" : "+v"(ta), "+v"(tb)); e8[jj] = h ? tb : ta; }
          fT[s] = __builtin_bit_cast(bf16x8, (u32x4){cvtpk(e8[0], e8[1]), cvtpk(e8[2], e8[3]), cvtpk(e8[4], e8[5]), cvtpk(e8[6], e8[7])}); } }
    asm volatile("" ::: "memory"); __builtin_amdgcn_sched_barrier(0);
    const size_t uid = ((size_t)(b * 8 + hd) * 128 + c);
    unsigned char* gG = F.ws + WS_R0 + uid * SZ_G; unsigned char* gH = F.ws + WS_R2 + uid * SZ_H; unsigned char* gQ = F.ws + WS_H0 + uid * SZ_Q; unsigned char* gY = F.ws + WS_H1 + uid * SZ_Y;
#define RK_ST(base, piece, f) (*(u32x4*)((base) + (piece) * 1024 + (tid & 63) * 16) = __builtin_bit_cast(u32x4, (f)))
    bf16x8 fWt[2][2];
#pragma unroll
    for (int jt = 0; jt < 2; ++jt) { f32x16 w_ = f32x16{}; w_ = RK_MF(fT[0], tAt[jt][0], w_); w_ = RK_MF(fT[1], tAt[jt][1], w_); fWt[jt][0] = frag<0>(w_); fWt[jt][1] = frag<1>(w_);
        f32x16 q_; unfrag<0>(q_, __builtin_bit_cast(bf16x8, *(const LAS u32x4*)(stash + 8 * (2 * jt) * PZ))); unfrag<1>(q_, __builtin_bit_cast(bf16x8, *(const LAS u32x4*)(stash + 8 * (2 * jt + 1) * PZ)));
        q_ = RK_MF(fWt[jt][0], fArb[0], q_); q_ = RK_MF(fWt[jt][1], fArb[1], q_); RK_ST(gQ, 2 * jt, frag<0>(q_)); RK_ST(gQ, 2 * jt + 1, frag<1>(q_)); }
    bf16x8 tBh[2][2], tKh[2][2], tV[2][2];
    { bf16x8 fId[2]; mk_id(fId, r, h);
#pragma unroll
    for (int jt = 0; jt < 2; ++jt) { bf16x8 fBh[2], fKh[2], fV[2], fdum[2]; float bdum = 0.f;
        r1_elem<1>(EC, jt, fBh, fKh, fV, fdum, bdum, pcd[jt]);
        { f32x16 t_ = f32x16{}; t_ = RK_MF(fBh[0], fId[0], t_); t_ = RK_MF(fBh[1], fId[1], t_); tBh[jt][0] = frag<0>(t_); tBh[jt][1] = frag<1>(t_); }
        { f32x16 t_ = f32x16{}; t_ = RK_MF(fKh[0], fId[0], t_); t_ = RK_MF(fKh[1], fId[1], t_); tKh[jt][0] = frag<0>(t_); tKh[jt][1] = frag<1>(t_); }
        { f32x16 t_ = f32x16{}; t_ = RK_MF(fV[0], fId[0], t_); t_ = RK_MF(fV[1], fId[1], t_); tV[jt][0] = frag<0>(t_); tV[jt][1] = frag<1>(t_); } } }
    bf16x8 fUt[2][2];
#pragma unroll
    for (int it = 0; it < 2; ++it) { f32x16 av = f32x16{}; av = RK_MF(fAak[0], tV[it][0], av); av = RK_MF(fAak[1], tV[it][1], av);
        const bf16x8 fav0 = frag<0>(av), fav1 = frag<1>(av); f32x16 u_ = f32x16{}; u_ = RK_MF(fT[0], fav0, u_); u_ = RK_MF(fT[1], fav1, u_); fUt[it][0] = frag<0>(u_); fUt[it][1] = frag<1>(u_); }
#pragma unroll
    for (int it = 0; it < 2; ++it) { f32x16 y_ = f32x16{}; y_ = RK_MF(fUt[it][0], fArb[0], y_); y_ = RK_MF(fUt[it][1], fArb[1], y_); y_ = RK_MF(tV[it][0], fArk[0], y_); y_ = RK_MF(tV[it][1], fArk[1], y_);
        RK_ST(gY, 2 * it, frag<0>(y_)); RK_ST(gY, 2 * it + 1, frag<1>(y_)); }
#pragma unroll
    for (int jt = 0; jt < 2; ++jt)
#pragma unroll
        for (int j2 = 0; j2 < 2; ++j2) { f32x16 g_ = f32x16{}; g_ = RK_MF(fWt[jt][0], tBh[j2][0], g_); g_ = RK_MF(fWt[jt][1], tBh[j2][1], g_);
            if (jt == j2) {
#pragma unroll
                for (int i = 0; i < 16; ++i) if (i == 4 * (r >> 3) + (r & 3) && h == ((r >> 2) & 1)) g_[i] += pcd[jt]; }
            RK_ST(gG, 2 * (jt * 2 + j2), frag<0>(g_)); RK_ST(gG, 2 * (jt * 2 + j2) + 1, frag<1>(g_)); }
#pragma unroll
    for (int j2 = 0; j2 < 2; ++j2)
#pragma unroll
        for (int it = 0; it < 2; ++it) { f32x16 h_ = f32x16{}; h_ = RK_MF(tBh[j2][0], fUt[it][0], h_); h_ = RK_MF(tBh[j2][1], fUt[it][1], h_); h_ = RK_MF(tKh[j2][0], tV[it][0], h_); h_ = RK_MF(tKh[j2][1], tV[it][1], h_);
            RK_ST(gH, 2 * (j2 * 2 + it), frag<0>(h_)); RK_ST(gH, 2 * (j2 * 2 + it) + 1, frag<1>(h_)); }
}

template <int DRY> __device__ __forceinline__ void r2_task(const Args& args, Frame& F, int task) {
    const bool st_ok = !DRY || args.li == 12345;
    const int bh = task >> 1, it = task & 1;
    f32x16 St[2]; St[0] = f32x16{}; St[1] = f32x16{};
    const unsigned char* gG0 = F.ws + WS_R0 + (size_t)bh * 128 * SZ_G + F.lane * 16; unsigned char* gH0 = F.ws + WS_R2 + (size_t)bh * 128 * SZ_H + F.lane * 16;
    bf16x8 G0[2][2][2], H0[2][2], G1[2][2][2], H1[2][2], G2[2][2][2], H2[2][2];
#define R2_LOAD(G_, H_, c_) do { const int cc_ = (c_) < 128 ? (c_) : 127;     \
        _Pragma("unroll") for (int jt = 0; jt < 2; ++jt) _Pragma("unroll") for (int j2 = 0; j2 < 2; ++j2) _Pragma("unroll") for (int s = 0; s < 2; ++s) \
            G_[jt][j2][s] = __builtin_bit_cast(bf16x8, *(const u32x4*)(gG0 + (size_t)cc_ * SZ_G + (2 * (jt * 2 + j2) + s) * 1024)); \
        _Pragma("unroll") for (int j2 = 0; j2 < 2; ++j2) _Pragma("unroll") for (int s = 0; s < 2; ++s) H_[j2][s] = __builtin_bit_cast(bf16x8, *(const u32x4*)(gH0 + (size_t)cc_ * SZ_H + (2 * (j2 * 2 + it) + s) * 1024)); } while (0)
#define R2_STEP(G_, H_, c_, LOADNEXT) do { \
        const bf16x8 fS[2][2] = {{frag<0>(St[0]), frag<1>(St[0])}, {frag<0>(St[1]), frag<1>(St[1])}}; \
        if (st_ok) { _Pragma("unroll") for (int jt = 0; jt < 2; ++jt) _Pragma("unroll") for (int s = 0; s < 2; ++s) \
            *(u32x4*)(gH0 + (size_t)(c_) * SZ_H + (2 * (jt * 2 + it) + s) * 1024) = __builtin_bit_cast(u32x4, fS[jt][s]); }     \
        __builtin_amdgcn_sched_barrier(0); LOADNEXT; __builtin_amdgcn_sched_barrier(0);     \
        _Pragma("unroll") for (int j2 = 0; j2 < 2; ++j2) { unfrag<0>(St[j2], H_[j2][0]); unfrag<1>(St[j2], H_[j2][1]); \
            _Pragma("unroll") for (int jt = 0; jt < 2; ++jt) { St[j2] = RK_MF(G_[jt][j2][0], fS[jt][0], St[j2]); St[j2] = RK_MF(G_[jt][j2][1], fS[jt][1], St[j2]); } } \
        __builtin_amdgcn_sched_barrier(0); \
    } while (0)
    R2_LOAD(G0, H0, 0); R2_LOAD(G1, H1, 1);
#pragma unroll 1
    for (int c = 0; c < 126; c += 3) {
        R2_STEP(G0, H0, c, R2_LOAD(G2, H2, c + 2));
        R2_STEP(G1, H1, c + 1, R2_LOAD(G0, H0, c + 3));
        R2_STEP(G2, H2, c + 2, R2_LOAD(G1, H1, c + 4));
    }
    R2_STEP(G0, H0, 126, (void)0);
    R2_STEP(G1, H1, 127, (void)0);
#undef R2_STEP
#undef R2_LOAD
}

constexpr int PV2 = 1296;
__device__ __forceinline__ void r3_unit(const Args& args, Frame& F, int b, int c) {
    LAS unsigned char* IMG = F.lds;
    const bf16_t* Z = (const bf16_t*)(F.ws + WS_Z);
    const int t0 = 32 * c; const size_t m0 = (size_t)b * SEQ + t0;
    const float* mu = AIN(7);
    int tid = F.tid; asm volatile("" : "+v"(tid));
    __syncthreads();
    { const unsigned lds0 = (unsigned)(uintptr_t)IMG; const int ln = tid & 63;
      for (int task = F.wave; task < 33 * 2; task += NWAVES) { const int rr = task >> 1, j = task & 1, pc = 64 * j + ln;
          if (pc < 80) { const int col = j == 0 ? ZR_V + 8 * ln : ZR_GD + 8 * ln;
              if (rr > 0 || t0 > 0) att::glds16(Z + (m0 + rr - 1) * ZW + col, (unsigned)__builtin_amdgcn_readfirstlane((int)(lds0 + rr * PV2 + 1024 * j)));
              else *(LAS u32x4*)(IMG + 16 * pc) = (u32x4){0u, 0u, 0u, 0u}; } }
      asm volatile("s_waitcnt vmcnt(0)" ::: "memory"); }
    __syncthreads();
    { const int t = tid >> 4, kp = tid & 15;
      const u32x4 cw = *(const LAS u32x4*)(IMG + (t + 1) * PV2 + 1024 + 16 * kp), pw = *(const LAS u32x4*)(IMG + t * PV2 + 1024 + 16 * kp);
      const f32x4 m0v = *(const f32x4*)(mu + 1664 + 8 * kp), m1v = *(const f32x4*)(mu + 1664 + 8 * kp + 4);
      const unsigned cwa[4] = {cw.x, cw.y, cw.z, cw.w}, pwa[4] = {pw.x, pw.y, pw.z, pw.w}; float x[8];
#pragma unroll
      for (int j = 0; j < 4; ++j) { const float c0 = bf_lo(cwa[j]), c1 = bf_hi(cwa[j]), p0 = bf_lo(pwa[j]), p1 = bf_hi(pwa[j]);
          const float mu0 = j < 2 ? m0v[2 * j] : m1v[2 * j - 4], mu1 = j < 2 ? m0v[2 * j + 1] : m1v[2 * j - 3];
          x[2 * j] = fast_sigmoid(c0 + mu0 * (p0 - c0)); x[2 * j + 1] = fast_sigmoid(c1 + mu1 * (p1 - c1)); }
      const u32x4 o = {cvtpk(x[0], x[1]), cvtpk(x[2], x[3]), cvtpk(x[4], x[5]), cvtpk(x[6], x[7])};
      __syncthreads();
      *(LAS u32x4*)(IMG + (t + 1) * PV2 + 1024 + 16 * kp) = o;
      __syncthreads(); }
    const int hd = F.wave; int r = tid & 31, h = (tid >> 5) & 1;
    const LAS unsigned char* rowc = IMG + (r + 1) * PV2; const LAS unsigned char* rowp = IMG + r * PV2;
    const size_t uid = ((size_t)(b * 8 + hd) * 128 + c);
    const unsigned char* gS = F.ws + WS_R2 + uid * SZ_H; const unsigned char* gQ = F.ws + WS_H0 + uid * SZ_Q; const unsigned char* gY = F.ws + WS_H1 + uid * SZ_Y;
#define RK_LD(base, piece) __builtin_bit_cast(bf16x8, *(const u32x4*)((base) + (piece) * 1024 + (tid & 63) * 16))
    f32x16 gl[2]; gl[0] = f32x16{}; gl[1] = f32x16{};
    { const bf16_t* GUt = (const bf16_t*)(F.ws + WS_GUT) + (size_t)hd * 64 * 128;
#pragma unroll
      for (int ks = 0; ks < 8; ++ks) { const int k0 = 16 * ks + 8 * h; const bf16x8 bg = *(const LAS bf16x8*)(rowc + 1024 + k0 * 2);
#pragma unroll
          for (int it = 0; it < 2; ++it) { const bf16x8 fg = *(const bf16x8*)(GUt + (size_t)(32 * it + r) * 128 + k0); gl[it] = RK_MF(fg, bg, gl[it]); } } }
    f32x16 Y[2];
    { const bf16x8 fQ[2][2] = {{RK_LD(gQ, 0), RK_LD(gQ, 1)}, {RK_LD(gQ, 2), RK_LD(gQ, 3)}};
#pragma unroll
      for (int it = 0; it < 2; ++it) { unfrag<0>(Y[it], RK_LD(gY, 2 * it)); unfrag<1>(Y[it], RK_LD(gY, 2 * it + 1));
#pragma unroll
          for (int jt = 0; jt < 2; ++jt) { if (PROBE_NO_STATE) continue; Y[it] = RK_MF(RK_LD(gS, 2 * (jt * 2 + it)), fQ[jt][0], Y[it]); Y[it] = RK_MF(RK_LD(gS, 2 * (jt * 2 + it) + 1), fQ[jt][1], Y[it]); } } }
    float s1 = 0.f;
#pragma unroll
    for (int it = 0; it < 2; ++it)
#pragma unroll
        for (int i = 0; i < 16; ++i) s1 += Y[it][i];
    s1 += __shfl_xor(s1, 32); const float mean = s1 * (1.0f / 64.0f); float s2 = 0.f;
#pragma unroll
    for (int it = 0; it < 2; ++it)
#pragma unroll
        for (int i = 0; i < 16; ++i) { const float d = Y[it][i] - mean; s2 += d * d; }
    s2 += __shfl_xor(s2, 32); const float rstd = 1.0f / sqrtf(s2 * (1.0f / 64.0f) + GN_EPS);
    const float bn = ((const float*)(F.ws + WS_TOPW))[(m0 + r) * 8 + hd];
    LAS unsigned char* stg = F.lds + 49152 + F.wave * 4608;
#pragma unroll
    for (int it = 0; it < 2; ++it)
#pragma unroll
        for (int g = 0; g < 4; ++g) { const int cl = 32 * it + 8 * g + 4 * h, cj = hd * 64 + cl;
            const u32x2 a = *(const LAS u32x2*)(rowc + cj * 2), p = *(const LAS u32x2*)(rowp + cj * 2);
            const float vc[4] = {bf_lo(a.x), bf_hi(a.x), bf_lo(a.y), bf_hi(a.y)}, vq[4] = {bf_lo(p.x), bf_hi(p.x), bf_lo(p.y), bf_hi(p.y)};
            const f32x4 muv = *(const f32x4*)(mu + 1024 + cj), lg = *(const f32x4*)(AIN(16) + cj), lb = *(const f32x4*)(AIN(17) + cj);
            float o[4];
#pragma unroll
            for (int q = 0; q < 4; ++q) { const int i = 4 * g + q; const float v_ = vc[q] + muv[q] * (vq[q] - vc[q]);
                o[q] = ((Y[it][i] - mean) * rstd * lg[q] + lb[q] + bn * v_) * gl[it][i]; }
            *(LAS u32x2*)(stg + r * 144 + cl * 2) = (u32x2){cvtpk(o[0], o[1]), cvtpk(o[2], o[3])}; }
    asm volatile("s_waitcnt lgkmcnt(0)" ::: "memory");
    bf16_t* OUT = (bf16_t*)(F.ws + WS_R0) + m0 * 512 + hd * 64;
#pragma unroll
    for (int i = 0; i < 4; ++i) { const int row = i * 8 + ((tid & 63) >> 3), chn = tid & 7; const u32x4 v = *(const LAS u32x4*)(stg + row * 144 + chn * 16); *(u32x4*)(OUT + (size_t)row * 512 + chn * 8) = v; }
#undef RK_LD
#undef RK_ST
}
}
__device__ __forceinline__ void route_token(float lg, float bias, int lane, int tok, int* TE, float* TW, LAS unsigned* lcnt) {
    const float s = 1.0f / (1.0f + expf(-lg));
    const float c = s + bias;
    const unsigned long long kc = ((unsigned long long)ord_key(c) << 6) | (unsigned)(63 - lane);
    int rk = 0;
#pragma unroll 1
    for (int d = 1; d < 8; ++d) { const unsigned long long o = __shfl_xor(kc, d); rk += (o > kc) ? 1 : 0; }
    float gs = rk < 2 ? c : 0.f;
    gs += __shfl_xor(gs, 1); gs += __shfl_xor(gs, 2); gs += __shfl_xor(gs, 4);
    const int grp = lane >> 3;
    const unsigned long long kg = ((unsigned long long)ord_key(gs) << 6) | (unsigned)(63 - grp);
    int grk = 0;
#pragma unroll 1
    for (int d = 1; d < 8; ++d) { const unsigned long long o = __shfl_xor(kg, 8 * d); grk += (o > kg) ? 1 : 0; }
    const unsigned long long km = grk < 4 ? kc : (unsigned long long)(63 - lane);
    int erk = 0;
#pragma unroll 1
    for (int d = 1; d < 64; ++d) { const unsigned long long o = __shfl_xor(km, d); erk += (o > km) ? 1 : 0; }
    const bool sel = erk < 8;
    const float ssum = wave_sum(sel ? s : 0.f);
    if (sel) { TE[(size_t)tok * 8 + erk] = lane; TW[(size_t)tok * 8 + erk] = s / ssum * 2.5f; atomicAdd((unsigned*)&lcnt[(tok >= M / 2 ? 64 : 0) + lane], 1u); }
}
__device__ __forceinline__ void norm2_route_wave(const Args& args, Frame& F, LAS unsigned* lcnt) {
    bf16_t* H2 = (bf16_t*)(F.ws + WS_H2);
    norm_mod_rows(args, F, F.out, AIN(21), 3072, 4096, H2, nullptr);
    asm volatile("s_waitcnt vmcnt(0)" ::: "memory");
    const int lane = F.lane, row0 = F.gw * 16;
    const bf16_t* ap = H2 + (size_t)(row0 + (lane & 15)) * D + 8 * (lane >> 4);
    const bf16_t* bp = (const bf16_t*)(F.ws + WS_WRT) + (size_t)(lane & 15) * D + 8 * (lane >> 4);
    f32x4 acc[4] = {f32x4{}, f32x4{}, f32x4{}, f32x4{}};
#pragma unroll 1
    for (int k0 = 0; k0 < 32; k0 += 4) { bf16x8 a_[4], b_[4][4];
#pragma unroll
        for (int i = 0; i < 4; ++i) { a_[i] = *(const bf16x8*)(ap + 32 * (k0 + i));
#pragma unroll
            for (int nt = 0; nt < 4; ++nt) b_[i][nt] = *(const bf16x8*)(bp + (size_t)(16 * nt) * D + 32 * (k0 + i)); }
#pragma unroll
        for (int i = 0; i < 4; ++i)
#pragma unroll
            for (int nt = 0; nt < 4; ++nt) acc[nt] = __builtin_amdgcn_mfma_f32_16x16x32_bf16(a_[i], b_[i][nt], acc[nt], 0, 0, 0); }
    LAS float* scr = (LAS float*)(F.lds + F.wave * 16384);
#pragma unroll
    for (int nt = 0; nt < 4; ++nt)
#pragma unroll
        for (int i = 0; i < 4; ++i) scr[(4 * (lane >> 4) + i) * 65 + 16 * nt + (lane & 15)] = acc[nt][i];
    asm volatile("s_waitcnt lgkmcnt(0)" ::: "memory");
    int* TE = (int*)(F.ws + WS_TOPE); float* TW = (float*)(F.ws + WS_TOPW);
    const float bias = AIN(23)[lane];
#pragma unroll 1
    for (int t = 0; t < 16; ++t) route_token(scr[t * 65 + lane], bias, lane, row0 + t, TE, TW, lcnt);
    asm volatile("s_waitcnt lgkmcnt(0)" ::: "memory");
}
__device__ __forceinline__ void norm2_route_convert(const Args& args, Frame& F) {
    LAS unsigned* lcnt = (LAS unsigned*)(F.lds + LDS_TILETAB);
    if (F.tid < 128) lcnt[F.tid] = 0u;
    __syncthreads();
    constexpr int KIT = (64 * (16 * 16 + 4 * 32) + NWAVES * 256 - 1) / (NWAVES * 256) + 1;
    if (F.wave < 4) { norm2_route_wave(args, F, lcnt); convert_experts(args, F, 0, KIT); }
    else { convert_experts(args, F, 0, KIT / 2); norm2_route_wave(args, F, lcnt); convert_experts(args, F, KIT / 2, KIT); }
    __syncthreads();
    if (F.tid < 128 && lcnt[F.tid]) atomicAdd(F.ctl + CW_CNT + F.tid, lcnt[F.tid]);
    __syncthreads();
}
struct MoeTab { int ntiles0, ntiles; };
__device__ __forceinline__ MoeTab build_tiles(const Args& args, Frame& F) {
    LAS unsigned* tab = (LAS unsigned*)(F.lds + LDS_TILETAB);
    LAS unsigned* offs = tab + 2432; LAS unsigned* tpre = tab + 2560;
    if (F.tid == 0) { unsigned o = 0, tp = 0;
        for (int l = 0; l < 128; ++l) { const unsigned c = __hip_atomic_load(F.ctl + CW_CNT + l, RLX_AGENT); offs[l] = o; tpre[l] = tp; o += c; tp += (c + 255u) >> 8; }
        tpre[128] = tp; }
    __syncthreads();
    if (F.tid < 128) { const int l = F.tid; const unsigned c = __hip_atomic_load(F.ctl + CW_CNT + l, RLX_AGENT); const unsigned o = offs[l], t0 = tpre[l], nt = (c + 255u) >> 8;
        for (unsigned i = 0; i < nt; ++i) { const unsigned rows = (c - 256u * i) < 256u ? (c - 256u * i) : 256u; tab[2 * (t0 + i)] = (o + 256u * i) | ((unsigned)(l & 63) << 20); tab[2 * (t0 + i) + 1] = rows; } }
    __syncthreads();
    MoeTab r; r.ntiles0 = (int)tpre[64]; r.ntiles = (int)tpre[128]; return r;
}
__device__ __forceinline__ void scatter_phase(const Args& args, Frame& F) {
    LAS unsigned* tab = (LAS unsigned*)(F.lds + LDS_TILETAB); LAS unsigned* offs = tab + 2432;
    LAS unsigned* lcnt = (LAS unsigned*)(F.lds); LAS unsigned* lbase = lcnt + 128;
    const int* TE = (const int*)(F.ws + WS_TOPE); const float* TW = (const float*)(F.ws + WS_TOPW);
    int* ST = (int*)(F.ws + WS_STOK); float* SW = (float*)(F.ws + WS_SW);
    for (int blk = blockIdx.x; blk < M / 128; blk += F.G) {
        if (F.tid < 128) lcnt[F.tid] = 0u;
        __syncthreads();
        const int tok0 = blk * 128, hf = tok0 >= M / 2 ? 64 : 0;
        int lst[2]; unsigned rnk[2];
#pragma unroll
        for (int i = 0; i < 2; ++i) { const int p = F.tid + 512 * i; lst[i] = hf + TE[(size_t)tok0 * 8 + p]; rnk[i] = atomicAdd((unsigned*)&lcnt[lst[i]], 1u); }
        __syncthreads();
        if (F.tid < 128) lbase[F.tid] = lcnt[F.tid] ? atomicAdd(F.ctl + CW_CUR + F.tid, lcnt[F.tid]) : 0u;
        __syncthreads();
#pragma unroll
        for (int i = 0; i < 2; ++i) { const int p = F.tid + 512 * i; const unsigned pos = offs[lst[i]] + lbase[lst[i]] + rnk[i];
            ST[pos] = tok0 * 8 + p; SW[pos] = TW[(size_t)tok0 * 8 + p]; }
        __syncthreads();
    }
}

__device__ __forceinline__ void final_rows(const Args& args, Frame& F, int row_lo, int row_hi, int tokbase) {
    const unsigned char* SL = (const unsigned char*)(F.ws + WS_SLOT);
    const int cA = 256 * (F.lane >> 4) + 32 * ((F.lane >> 2) & 3) + 8 * (F.lane & 3), cB = cA + 128;
    for (int blk = F.gw; blk < (row_hi - row_lo) / 16; blk += F.NGW) {
        const int r0 = row_lo + blk * 16, b = r0 / SEQ;
        const float* g2 = (const float*)(F.ws + WS_MOD) + b * 6144 + 5120; const float* fgp = AIN(30);
        f32x4 gv[4], fg[4];
#pragma unroll
        for (int j = 0; j < 4; ++j) { const int c = (j < 2 ? cA : cB) + 4 * (j & 1); gv[j] = *(const f32x4*)(g2 + c) * (1.0f / SLOT_SCALE); fg[j] = *(const f32x4*)(fgp + c); }
        for (int r = 0; r < 16; ++r) { const size_t m = (size_t)(r0 + r);
            f32x4 acc[4];
#pragma unroll
            for (int j = 0; j < 4; ++j) acc[j] = (f32x4){0.f, 0.f, 0.f, 0.f};
            const unsigned char* sp = SL + (m - tokbase) * NSLOT * D + 16 * F.lane;
            u32x4 w[NSLOT];
#pragma unroll
            for (int k = 0; k < NSLOT; ++k) w[k] = *(const u32x4*)(sp + (size_t)k * D);
#pragma unroll
            for (int k = 0; k < NSLOT; ++k) { const unsigned ww[4] = {w[k].x, w[k].y, w[k].z, w[k].w};
#pragma unroll
                for (int j = 0; j < 4; ++j) { const f32x2 a = __builtin_amdgcn_cvt_pk_f32_fp8((int)ww[j], false), c = __builtin_amdgcn_cvt_pk_f32_fp8((int)ww[j], true); acc[j] += (f32x4){a.x, a.y, c.x, c.y}; } }
            float* xr = F.out + m * D; f32x4 v[4]; float s = 0.f;
#pragma unroll
            for (int j = 0; j < 4; ++j) { const int c = (j < 2 ? cA : cB) + 4 * (j & 1); v[j] = *(const f32x4*)(xr + c) + gv[j] * acc[j]; s += (v[j].x * v[j].x + v[j].y * v[j].y) + (v[j].z * v[j].z + v[j].w * v[j].w); }
            const float rstd = 1.0f / sqrtf(wave_sum(s) * (1.0f / D) + RMS_EPS);
#pragma unroll
            for (int j = 0; j < 4; ++j) { const int c = (j < 2 ? cA : cB) + 4 * (j & 1); *(f32x4*)(xr + c) = v[j] * rstd * fg[j]; }
        }
    }
}
constexpr int N_PHASES = 15;
#ifndef PROBE_ATT_SCALE
#define PROBE_ATT_SCALE 1.0f
#endif
#ifndef PROBE_IDX_REP
#define PROBE_IDX_REP 1
#endif
#ifndef R2_WGS
#define R2_WGS 32
#endif
#ifndef PROBE_P5_PART
#define PROBE_P5_PART 0
#endif
#ifndef PROBE_RW_SCALE
#define PROBE_RW_SCALE 1.0f
#endif

__global__ void __launch_bounds__(NTHR, 2) fwd_kernel(Args args) {
    extern __shared__ __attribute__((aligned(16))) unsigned char lds_raw[];
    Frame F;
    F.lds = (LAS unsigned char*)lds_raw;
    F.MISC = (volatile LAS unsigned*)(F.lds + MISC_OFF);
    F.tid = threadIdx.x; F.lane = F.tid & 63; F.wave = __builtin_amdgcn_readfirstlane(F.tid >> 6);
    F.G = gridDim.x; { const int bx = blockIdx.x; F.vcu = (F.G % 8 == 0) ? (bx % 8) * (F.G / 8) + bx / 8 : bx; }
    F.gw = blockIdx.x * NWAVES + F.wave; F.NGW = F.G * NWAVES;
    F.ws = args.ws; F.out = args.out; F.ctl = (unsigned*)(args.ws + WS_CTL);
    for (int u = F.tid; u < (LDS_BYTES - LDSCTL_OFF) / 4; u += NTHR) ((LAS unsigned*)(F.lds + LDSCTL_OFF))[u] = 0u;
    __syncthreads();
    if (F.tid == 0) {
#pragma unroll
        for (int i = 0; i < 31; ++i) *(LAS unsigned long long*)(F.lds + LDS_PTAB + 8 * i) = (unsigned long long)args.in[i];
        *(LAS unsigned long long*)(F.lds + LDS_PTAB + 8 * 31) = (unsigned long long)args.out; *(LAS unsigned long long*)(F.lds + LDS_PTAB + 8 * 32) = (unsigned long long)args.ws; }
    __syncthreads();
    XcdBarrier bar = xcd_barrier_post(F.ctl + CW_BAR + args.li * XCD_BAR_WORDS, F.MISC + 8);
    const int lo = args.ph_lo, hi = args.ph_hi;
#ifndef PHASE_MASK
#define PHASE_MASK 0xFFFFFFFFu
#endif
#define IN(k) ((((PHASE_MASK) >> (k)) & 1u) && lo <= (k) && (k) < hi)
#define PB() do { F.ws = (unsigned char*)ain_ptr(F.lds, 32); F.out = (float*)ain_ptr(F.lds, 31); F.ctl = (unsigned*)(F.ws + WS_CTL); \
        F.lane = (int)__builtin_amdgcn_mbcnt_hi(~0u, __builtin_amdgcn_mbcnt_lo(~0u, 0u)); F.tid = F.wave * 64 + F.lane; } while (0)
#define ZB ((bf16_t*)(F.ws + WS_Z))
#define GATES ((bf16_t*)F.out)
#define MOD ((const float*)(F.ws + WS_MOD))
#define SEAM(k) do { if (IN(k) && IN((k) + 1)) xcd_barrier(bar); } while (0)

    if (IN(0)) { PB(); p0_prologue(args, F); } SEAM(0);
    if (IN(1)) { PB(); norm_mod_rows(args, F, AIN(0), AIN(4), 0, 1024, nullptr, F.ws + WS_H0); } SEAM(1);
    if (IN(2)) { PB(); pg8::StaticOrder S; S.init(M, NIN, F.G, (int)blockIdx.x); pg8::DenseSrcT<1> G{F.ws + WS_H0, F.ws + WS_WIN, 1024};
        EpiInProj E{ZB, GATES}; pg8::gemm_phase<EpiInProj, pg8::StaticOrder, pg8::DenseSrcT<1>>(F.lds, 1024, S, G, E); } SEAM(2);
    if (IN(3)) { PB(); rk::load_params(args, F); for (int u = blockIdx.x; u < 1024; u += F.G) rk::r1_unit(args, F, u >> 7, u & 127); __syncthreads(); } SEAM(3);
    if (IN(4)) { PB();
#ifdef PROBE_R2_DRY
        if (blockIdx.x < R2_WGS && F.wave < 128 / R2_WGS) rk::r2_task<1>(args, F, blockIdx.x * (128 / R2_WGS) + F.wave);
#endif
        if (blockIdx.x < R2_WGS && F.wave < 128 / R2_WGS) rk::r2_task<0>(args, F, blockIdx.x * (128 / R2_WGS) + F.wave);
#pragma unroll 1
        for (int rep = 0; rep < PROBE_IDX_REP; ++rep)
        for (;;) {
            __syncthreads();
            if (F.tid == 0) F.MISC[12] = atomicAdd(F.ctl + CW_Q + rep, 1u);
            __syncthreads();
            const int u = (int)F.MISC[12];
            if (u >= 2048) break;
            indexer_unit(args, F, u & 7, (255 - (u >> 3)) * 16);
        } } SEAM(4);
    if (IN(5)) { PB(); if (!(PROBE_P5_PART == 2 && args.li == 1)) { for (int u = blockIdx.x; u < 1024; u += F.G) rk::r3_unit(args, F, u >> 7, u & 127); } __syncthreads();
        if (!(PROBE_P5_PART == 1 && args.li == 1)) for (int i = 0; i < 4; ++i) for (int uu = F.vcu; uu < 256; uu += F.G) { const int bh = uu >> 2, s = uu & 3; const int qb = (i == 0) ? s : (i == 1) ? 7 - s : (i == 2) ? 8 + s : 15 - s;
            att::attn_unit(args, F, bh >> 3, bh & 7, qb); } __syncthreads(); } SEAM(5);
    if (IN(6)) { PB(); pg8::StaticOrder S; S.init(M, D, F.G, (int)blockIdx.x);
        { pg8::DenseSrc G{F.ws + WS_R1, F.ws + WS_WA, 512}; EpiMerge<0> E{(bf16_t*)(F.ws + WS_R2), F.ws + WS_H0, GATES, PROBE_ATT_SCALE}; pg8::gemm_phase<EpiMerge<0>, pg8::StaticOrder, pg8::DenseSrc>(F.lds, 512, S, G, E); }
        { pg8::DenseSrc G{F.ws + WS_R0, F.ws + WS_WR, 512}; EpiMerge<1> E{(bf16_t*)(F.ws + WS_R2), F.ws + WS_H0, GATES, PROBE_RW_SCALE}; pg8::gemm_phase<EpiMerge<1>, pg8::StaticOrder, pg8::DenseSrc>(F.lds, 512, S, G, E); } } SEAM(6);
    if (IN(7)) { PB(); pg8::StaticOrder S; S.init(M, D, F.G, (int)blockIdx.x); pg8::DenseSrcT<1> G{F.ws + WS_H0, F.ws + WS_WO, 1024};
        EpiOutProj E{AIN(0), F.out, MOD}; pg8::gemm_phase<EpiOutProj, pg8::StaticOrder, pg8::DenseSrcT<1>>(F.lds, 1024, S, G, E); } SEAM(7);
    if (IN(8)) { PB(); norm2_route_convert(args, F); }
    if (IN(8) && IN(11)) xcd_barrier(bar);
    MoeTab mt{0, 0};
    if (lo <= 13 && hi > 13) { PB(); mt = build_tiles(args, F); scatter_phase(args, F); } else if (hi > 13) { PB(); mt = build_tiles(args, F); }
    SEAM(11);
    const LAS unsigned* tab = (const LAS unsigned*)(F.lds + LDS_TILETAB);
    if (IN(12)) { PB(); MoeSched1 S{tab, mt.ntiles, F.G, F.vcu};            MoeSrc1 G{F.ws};
        EpiMoe1 E{F.ws}; pg8::gemm_phase<EpiMoe1, MoeSched1, MoeSrc1>(F.lds, 1024, S, G, E); } SEAM(12);
    if (IN(13)) { PB(); MoeSched2 S{tab, 0, mt.ntiles, 512, F.G, F.vcu}; MoeSrc2 G{F.ws}; EpiMoe2 E; E.ws = F.ws; E.X1 = F.out; E.tokbase = 0;
        pg8::gemm_phase<EpiMoe2, MoeSched2, MoeSrc2>(F.lds, 256, S, G, E); } SEAM(13);
    if (IN(14)) { PB(); final_rows(args, F, 0, M, 0); }
#undef IN
#undef SEAM
#undef PB
}

extern "C" void kernel_launch(void* const* d_in, const int* in_sizes, int n_in, void* d_out, int out_size, void* d_ws, size_t ws_size, hipStream_t stream) {
    static int grid = 0;
    if (grid == 0) {
        if (n_in != 31 || out_size != M * D || ws_size < WS_END) { fprintf(stderr, "kernel_launch: unexpected problem (n_in %d, out %d, ws %zu)\n", n_in, out_size, ws_size); grid = -1; return; }
        int dev = 0, cus = 0, per_cu = 0;
        if (hipGetDevice(&dev) != hipSuccess || hipDeviceGetAttribute(&cus, hipDeviceAttributeMultiprocessorCount, dev) != hipSuccess) { grid = -1; return; }
        if (hipFuncSetAttribute((const void*)fwd_kernel, hipFuncAttributeMaxDynamicSharedMemorySize, LDS_BYTES) != hipSuccess) { fprintf(stderr, "kernel_launch: hipFuncSetAttribute failed\n"); grid = -1; return; }
        if (hipOccupancyMaxActiveBlocksPerMultiprocessor(&per_cu, (const void*)fwd_kernel, NTHR, LDS_BYTES) != hipSuccess || per_cu < 1) fprintf(stderr, "kernel_launch: occupancy query reports %d\n", per_cu);
        (void)hipGetLastError();
        grid = cus;
        if (grid != 256) fprintf(stderr, "kernel_launch: %d CUs (built for 256)\n", grid);
    }
    if (grid < 0) return;
    (void)in_sizes;
    if (hipMemsetAsync((char*)d_ws + WS_CTL, 0, CTL_ZERO_BYTES, stream) != hipSuccess) return;
    Args a{};
    for (int i = 0; i < 31; ++i) a.in[i] = (const float*)d_in[i];
    a.out = (float*)d_out; a.ws = (unsigned char*)d_ws;
#ifndef PROBE_REPEAT
#define PROBE_REPEAT -1
#endif
    int li = 0;
    auto go = [&](int lo_, int hi_) { a.ph_lo = lo_; a.ph_hi = hi_; a.li = li++; hipLaunchKernelGGL(fwd_kernel, dim3(grid), dim3(NTHR), LDS_BYTES, stream, a); };
    if (PROBE_REPEAT < 0) go(0, N_PHASES);
    else { go(0, PROBE_REPEAT + 1); go(PROBE_REPEAT, PROBE_REPEAT + 1); if (PROBE_REPEAT + 1 < N_PHASES) go(PROBE_REPEAT + 1, N_PHASES); }
}
```

```cpp
#include <hip/hip_runtime.h>
#include <cstdio>
#include <cstdint>
#include <cmath>

#define GAS __attribute__((address_space(1)))
#define LAS __attribute__((address_space(3)))
typedef unsigned short bf16_t;
typedef short bf16x8 __attribute__((ext_vector_type(8)));
typedef float f32x4 __attribute__((ext_vector_type(4)));
typedef float f32x2 __attribute__((ext_vector_type(2)));
typedef float f32x16 __attribute__((ext_vector_type(16)));
typedef unsigned u32x4 __attribute__((ext_vector_type(4)));
typedef unsigned u32x2 __attribute__((ext_vector_type(2)));
typedef GAS unsigned gu32;

__device__ __forceinline__ unsigned cvt_pk_bf16(float lo, float hi) { unsigned r; asm volatile("v_cvt_pk_bf16_f32 %0, %1, %2" : "=v"(r) : "v"(lo), "v"(hi)); return r; }
__device__ __forceinline__ float bf_lo(unsigned w) { return __uint_as_float(w << 16); }
__device__ __forceinline__ float bf_hi(unsigned w) { return __uint_as_float(w & 0xffff0000u); }
__device__ __forceinline__ float bf2f(bf16_t b) { return __uint_as_float(((unsigned)b) << 16); }
__device__ __forceinline__ unsigned f2bf(float f) { unsigned u = __float_as_uint(f); return (u + 0x7fffu + ((u >> 16) & 1u)) >> 16; }
__device__ __forceinline__ unsigned pk2(float lo, float hi) { return f2bf(lo) | (f2bf(hi) << 16); }
__device__ __forceinline__ float fast_sigmoid(float x) { return __builtin_amdgcn_rcpf(1.0f + __builtin_amdgcn_exp2f(-1.4426950408889634f * x)); }
__device__ __forceinline__ float wave_sum(float v) {
#pragma unroll
    for (int o = 1; o < 64; o <<= 1) v += __shfl_xor(v, o);
    return v;
}

namespace pg8 {
constexpr int BM = 256, BK = 64, HALF = 128, HTB = HALF * BK * 2, STAGE_BYTES = 8 * HTB, NXCD = 8, WGM = 8;
__host__ __device__ __forceinline__ int lds_byte(int r, int c) { const int st = (r >> 4) * 2 + (c >> 5), rr = r & 15, cc = c & 31, ob = rr * 64 + cc * 2; return st * 1024 + (ob ^ (((ob >> 9) & 1) << 5)); }
__host__ __device__ __forceinline__ void stage_rc(int b, int& R, int& C) { const int st = b / 1024, sb = b % 1024, swz = sb ^ (((sb >> 9) & 1) << 5); R = (st >> 1) * 16 + swz / 64; C = (st & 1) * 32 + (swz % 64) / 2; }
__host__ __device__ __forceinline__ int perm32(int rho) { const int n = rho >> 4, i = rho & 15; return 8 * (i >> 2) + 4 * n + (i & 3); }

struct Unit { int pm, pn; int aux0, aux1; };

struct StaticOrder {
    int nM, nN, nwg, G, c;
    __host__ __device__ void init(int M, int N, int G_, int c_) { nM = M / BM; nN = N / BM; nwg = nM * nN; G = G_; c = c_; }
    __host__ __device__ bool next(int i, Unit& u) const {
        const long L = (long)i * G + c; if (L >= nwg) return false;
        int wgid = (int)L; { const int q = nwg / NXCD, r = nwg % NXCD, xcd = wgid % NXCD, off = wgid / NXCD; wgid = (xcd < r ? xcd * (q + 1) : r * (q + 1) + (xcd - r) * q) + off; }
        const int nig = WGM * nN, gid = wgid / nig, fm = gid * WGM, gsz = (nM - fm) < WGM ? (nM - fm) : WGM;
        u.pm = fm + ((wgid % nig) % gsz); u.pn = (wgid % nig) / gsz; u.aux0 = 0; u.aux1 = 0; return true;
    }
};

template <int ESZ_> struct DenseSrcT {
    static constexpr int ESZ = ESZ_; static constexpr bool GATHER = false;
    const void* A; const void* Bt; int K;
    __device__ __forceinline__ const char* b_base(const Unit& u) const { return (const char*)Bt + (size_t)u.pn * 256 * K * ESZ; }
    __device__ __forceinline__ const char* a_base(const Unit& u) const { return (const char*)A + (size_t)u.pm * 256 * K * ESZ; }
    __device__ __forceinline__ unsigned a_off(const Unit&, int R, int C) const { return (unsigned)(R * K * ESZ) + (unsigned)C * 2u; }
};
typedef DenseSrcT<2> DenseSrc;
typedef int v8i32 __attribute__((ext_vector_type(8)));

template <class T, class = void> struct has_prefetch { static constexpr bool value = false; };
template <class T> struct has_prefetch<T, decltype((void)&T::prefetch)> { static constexpr bool value = true; };
template <class Epi, class Sched, class Src, bool ALIGN_EPI = true>
__device__ __forceinline__ void gemm_phase(LAS unsigned char* lds, const int K, const Sched& S, const Src& G, const Epi& E) {
    const int tid = threadIdx.x, wid = __builtin_amdgcn_readfirstlane(tid >> 6), lane = tid & 63, wr = wid >> 2, wc = wid & 3, fr = lane & 15, fq = lane >> 4;
    constexpr int ESZ = Src::ESZ; const int Kb = K * ESZ;
    const int nt = Kb / (BK * 2);
    unsigned voffB0;
    { int R, C; stage_rc(tid * 16, R, C); const int Rb = Epi::PERM ? ((R & ~31) + perm32(R & 31)) : R; voffB0 = (unsigned)(Rb * Kb) + (unsigned)C * 2u; }
#define PG8_AOFF(u, h, i) ([&]() { int R_, C_; stage_rc(tid * 16 + (i) * 8192, R_, C_); return G.a_off((u), R_ + (h) * HALF, C_); }())
    const size_t kstep = (size_t)(BK * 2);
    const size_t hstepB = (size_t)HALF * Kb;
    const unsigned ldsw = (unsigned)wid * 1024u;
    const int aoff = lds_byte(wr * 64 + fr, fq * 8), boff = lds_byte(wc * 32 + fr, fq * 8);
#define PG8_SA(b, h) (((b) * 2 + (h)) * HTB)
#define PG8_SB(b, h) ((4 + (b) * 2 + (h)) * HTB)
#define PG8_STAGEB(bufoff, gbase) do { _Pragma("unroll") for (int _i = 0; _i < 2; ++_i) { unsigned o_ = voffB0; asm volatile("" : "+v"(o_)); \
        __builtin_amdgcn_global_load_lds((const unsigned*)((const char*)(gbase) + (size_t)_i * 64 * Kb + o_), (LAS unsigned*)(lds + (bufoff) + ldsw + _i * 8192), 16, 0, 0); } } while (0)
#define PG8_STAGEA(bufoff, gbase, vo, h) do { _Pragma("unroll") for (int _i = 0; _i < 2; ++_i) { unsigned o_ = Src::GATHER ? (vo)[h][_i] : (vo)[0][0]; asm volatile("" : "+v"(o_)); \
        __builtin_amdgcn_global_load_lds((const unsigned*)((const char*)(gbase) + (Src::GATHER ? (size_t)0 : (size_t)((h) * 128 + _i * 64) * Kb) + o_), (LAS unsigned*)(lds + (bufoff) + ldsw + _i * 8192), 16, 0, 0); } } while (0)
#define PG8_STAGEA2(bufoff, gbase, h) do { _Pragma("unroll") for (int _i = 0; _i < 2; ++_i) { unsigned o_ = Src::GATHER ? (last ? vn[h][_i] : vc[h][_i]) : vc[0][0]; asm volatile("" : "+v"(o_)); \
        __builtin_amdgcn_global_load_lds((const unsigned*)((const char*)(gbase) + (Src::GATHER ? (size_t)0 : (size_t)((h) * 128 + _i * 64) * Kb) + o_), (LAS unsigned*)(lds + (bufoff) + ldsw + _i * 8192), 16, 0, 0); } } while (0)
#define PG8_LDA(dst, b, h) do { _Pragma("unroll") for (int m = 0; m < 4; ++m) { const u32x4 lo_ = *(const LAS u32x4*)(lds + PG8_SA(b, h) + aoff + m * 2048), hi_ = *(const LAS u32x4*)(lds + PG8_SA(b, h) + aoff + m * 2048 + 1024); \
        dst[m] = __builtin_shufflevector(lo_, hi_, 0, 1, 2, 3, 4, 5, 6, 7); } } while (0)
#define PG8_LDB(dst, b, h) do { _Pragma("unroll") for (int n = 0; n < 2; ++n) { const u32x4 lo_ = *(const LAS u32x4*)(lds + PG8_SB(b, h) + boff + n * 2048), hi_ = *(const LAS u32x4*)(lds + PG8_SB(b, h) + boff + n * 2048 + 1024); \
        dst[n] = __builtin_shufflevector(lo_, hi_, 0, 1, 2, 3, 4, 5, 6, 7); } } while (0)
#define PG8_LO(x) __builtin_bit_cast(bf16x8, __builtin_shufflevector((x), (x), 0, 1, 2, 3))
#define PG8_HI(x) __builtin_bit_cast(bf16x8, __builtin_shufflevector((x), (x), 4, 5, 6, 7))
#define PG8_MMA(ai, bj, At, Bt) do { __builtin_amdgcn_s_setprio(1); _Pragma("unroll") for (int m = 0; m < 4; ++m) _Pragma("unroll") for (int n = 0; n < 2; ++n) { \
        if constexpr (ESZ == 1) acc[ai][bj][m][n] = __builtin_amdgcn_mfma_scale_f32_16x16x128_f8f6f4(__builtin_bit_cast(v8i32, Bt[n]), __builtin_bit_cast(v8i32, At[m]), acc[ai][bj][m][n], 0, 0, 0, 0, 0, 0); \
        else { acc[ai][bj][m][n] = __builtin_amdgcn_mfma_f32_16x16x32_bf16(PG8_LO(Bt[n]), PG8_LO(At[m]), acc[ai][bj][m][n], 0, 0, 0); \
               acc[ai][bj][m][n] = __builtin_amdgcn_mfma_f32_16x16x32_bf16(PG8_HI(Bt[n]), PG8_HI(At[m]), acc[ai][bj][m][n], 0, 0, 0); } } \
        __builtin_amdgcn_s_setprio(0); } while (0)
#define PG8_WAIT_V(n) asm volatile("s_waitcnt vmcnt(" #n ")" ::: "memory")
#define PG8_WAIT_L(n) asm volatile("s_waitcnt lgkmcnt(" #n ")" ::: "memory")
#define PG8_BAR __builtin_amdgcn_s_barrier()
#define PG8_SCHED __builtin_amdgcn_sched_barrier(0)
    Unit cur, nxt; int ui = 0;
    if (!S.next(0, cur)) return;
#define PG8_PREFETCH(u_) do { if constexpr (has_prefetch<Epi>::value) { int ln_; asm volatile("v_mbcnt_lo_u32_b32 %0, -1, 0\n\tv_mbcnt_hi_u32_b32 %0, -1, %0" : "=v"(ln_)); E.prefetch((u_), wr, ln_ & 15); } } while (0)
    PG8_PREFETCH(cur);
    f32x4 acc[2][2][4][2];
#pragma unroll
    for (int a = 0; a < 2; ++a)
#pragma unroll
        for (int b = 0; b < 2; ++b)
#pragma unroll
            for (int m = 0; m < 4; ++m)
#pragma unroll
                for (int n = 0; n < 2; ++n) acc[a][b][m][n] = (f32x4){0.f, 0.f, 0.f, 0.f};
    typedef unsigned u32x8 __attribute__((ext_vector_type(8)));
    u32x8 At[4], B0[2], B1[2];
    unsigned vc[2][2], vn[2][2];
#pragma unroll
    for (int h = 0; h < 2; ++h)
#pragma unroll
        for (int i = 0; i < 2; ++i) vc[h][i] = PG8_AOFF(cur, h, i);
    const char* cA = G.a_base(cur); const char* cB = G.b_base(cur);
    PG8_STAGEB(PG8_SB(0, 0), cB); PG8_STAGEB(PG8_SB(0, 1), cB + hstepB); PG8_STAGEA(PG8_SA(0, 0), cA, vc, 0); PG8_STAGEA(PG8_SA(0, 1), cA, vc, 1);
    if (wr == 1) PG8_BAR;
    PG8_WAIT_V(2); PG8_BAR;
    PG8_STAGEB(PG8_SB(1, 0), cB + kstep); PG8_STAGEA(PG8_SA(1, 0), cA + kstep, vc, 0); PG8_STAGEB(PG8_SB(1, 1), cB + hstepB + kstep);
    PG8_WAIT_V(6); PG8_BAR;
    for (;;) {
        const bool has_next = S.next(ui + 1, nxt);
        const char* nA = has_next ? G.a_base(nxt) : cA; const char* nB = has_next ? G.b_base(nxt) : cB;
        if constexpr (Src::GATHER) {
#pragma unroll
        for (int h = 0; h < 2; ++h)
#pragma unroll
            for (int i = 0; i < 2; ++i) vn[h][i] = has_next ? PG8_AOFF(nxt, h, i) : vc[h][i]; }
#pragma clang loop unroll(disable)
        for (int t = 0; t < nt; t += 2) {
            const bool last = (t == nt - 2);
            const char* a1 = cA + (size_t)(t + 1) * kstep;
            const char* a2 = last ? nA : cA + (size_t)(t + 2) * kstep; const char* b2 = last ? nB : cB + (size_t)(t + 2) * kstep;
            const char* a3 = a2 + kstep; const char* b3 = b2 + kstep;
            PG8_LDB(B0, 0, 0); PG8_LDB(B1, 0, 1); PG8_SCHED; PG8_LDA(At, 0, 0); PG8_STAGEA(PG8_SA(1, 1), a1, vc, 1);
            PG8_WAIT_V(8); PG8_WAIT_L(0); PG8_BAR; PG8_MMA(0, 0, At, B0); PG8_MMA(0, 1, At, B1); PG8_BAR; PG8_SCHED;
            PG8_LDA(At, 0, 1); PG8_STAGEB(PG8_SB(0, 0), b2); PG8_STAGEB(PG8_SB(0, 1), b2 + hstepB); PG8_STAGEA2(PG8_SA(0, 0), a2, 0);
            PG8_WAIT_V(8); PG8_WAIT_L(0); PG8_BAR; PG8_MMA(1, 0, At, B0); PG8_MMA(1, 1, At, B1); PG8_BAR; PG8_SCHED;
            PG8_LDB(B0, 1, 0); PG8_LDB(B1, 1, 1); PG8_SCHED; PG8_LDA(At, 1, 0); PG8_STAGEA2(PG8_SA(0, 1), a2, 1);
            PG8_WAIT_V(8); PG8_WAIT_L(0); PG8_BAR; PG8_MMA(0, 0, At, B0); PG8_MMA(0, 1, At, B1); PG8_BAR; PG8_SCHED;
            PG8_LDA(At, 1, 1); PG8_STAGEB(PG8_SB(1, 0), b3); PG8_STAGEB(PG8_SB(1, 1), b3 + hstepB); PG8_STAGEA2(PG8_SA(1, 0), a3, 0);
            PG8_WAIT_V(8); PG8_WAIT_L(0); PG8_BAR; PG8_MMA(1, 0, At, B0); PG8_MMA(1, 1, At, B1); PG8_BAR; PG8_SCHED;
        }
        if constexpr (ALIGN_EPI) { if (wr == 0) PG8_BAR; }
        { int ln_; asm volatile("v_mbcnt_lo_u32_b32 %0, -1, 0\n\tv_mbcnt_hi_u32_b32 %0, -1, %0" : "=v"(ln_)); E(acc, cur, wr, wc, ln_ & 15, ln_ >> 4); }
        if (!has_next) break;
#pragma unroll
        for (int a = 0; a < 2; ++a)
#pragma unroll
            for (int b = 0; b < 2; ++b)
#pragma unroll
                for (int m = 0; m < 4; ++m)
#pragma unroll
                    for (int n = 0; n < 2; ++n) acc[a][b][m][n] = (f32x4){0.f, 0.f, 0.f, 0.f};
        cur = nxt; cA = nA; cB = nB; ++ui;
        PG8_PREFETCH(cur);
        if constexpr (Src::GATHER) {
#pragma unroll
        for (int h = 0; h < 2; ++h)
#pragma unroll
            for (int i = 0; i < 2; ++i) vc[h][i] = vn[h][i]; }
        if constexpr (ALIGN_EPI) { if (wr == 1) PG8_BAR; }
    }
    PG8_WAIT_V(0);
    if constexpr (!ALIGN_EPI) { if (wr == 0) PG8_BAR; }
    PG8_BAR;
#undef PG8_PREFETCH
#undef PG8_SA
#undef PG8_AOFF
#undef PG8_SB
#undef PG8_STAGEA
#undef PG8_STAGEA2
#undef PG8_STAGEB
#undef PG8_LDA
#undef PG8_LDB
#undef PG8_MMA
#undef PG8_LO
#undef PG8_HI
#undef PG8_WAIT_V
#undef PG8_WAIT_L
#undef PG8_BAR
#undef PG8_SCHED
}
}
#define RLX_AGENT __ATOMIC_RELAXED, __HIP_MEMORY_SCOPE_AGENT
#define LDS_WAIT() asm volatile("s_waitcnt lgkmcnt(0)" ::: "memory")
#define VM_WAIT() asm volatile("s_waitcnt vmcnt(0)" ::: "memory")
#define XB_TMO      128
#define XB_XCNT(j)  (256  + 64 * (j))
#define XB_XSUB(j)  (1280 + 64 * (j))
#define XB_XGEN(j)  (2304 + 64 * (j))
#define XB_TOP      3328
#define XB_TOPGEN   3392
#define XCD_BAR_WORDS 3456
#define XB_SPIN_CAP (1u << 18)

__device__ __forceinline__ unsigned xb_ld(unsigned* p)              { return __hip_atomic_load(p, __ATOMIC_RELAXED, __HIP_MEMORY_SCOPE_AGENT); }
__device__ __forceinline__ unsigned xb_add(unsigned* p, unsigned v) { return __hip_atomic_fetch_add(p, v, __ATOMIC_RELAXED, __HIP_MEMORY_SCOPE_AGENT); }
__device__ __forceinline__ unsigned xb_xcc_id() { return (unsigned)__builtin_amdgcn_s_getreg((3 << 11) | 20) & 0xFu; }
#define XB_SPIN(cond, bar) do { unsigned _sp = 0; while (cond) { __builtin_amdgcn_s_sleep(1); \
    if ((++_sp & 255u) == 0u) { if (xb_ld(&(bar)[XB_TMO])) break; if (_sp > XB_SPIN_CAP) { atomicAdd(&(bar)[XB_TMO], 1u); break; } } } } while (0)

struct XcdBarrier {
    unsigned* bar; unsigned x;
    volatile LAS unsigned* st;
};

__device__ __forceinline__ XcdBarrier xcd_barrier_post(unsigned* bar, volatile LAS unsigned* st) {
    XcdBarrier b; b.bar = bar; b.x = xb_xcc_id(); b.st = st;
    if (threadIdx.x == 0) (void)xb_add(&bar[XB_XCNT(b.x)], 1u);
    return b;
}
__device__ __forceinline__ void xcd_barrier_complete(unsigned* bar, unsigned x, unsigned& nloc, unsigned& nx) {
    const unsigned G = gridDim.x * gridDim.y * gridDim.z;
    unsigned sum, cnt, mine, sp = 0u;
    for (;;) {
        sum = 0u; cnt = 0u; mine = 0u;
#pragma unroll
        for (unsigned j = 0; j < 16; ++j) { const unsigned c = xb_ld(&bar[XB_XCNT(j)]); sum += c; cnt += (c > 0u) ? 1u : 0u; mine = (j == x) ? c : mine; }
        if (sum == G) break;
        __builtin_amdgcn_s_sleep(1);
        if ((++sp & 255u) == 0u) { if (xb_ld(&bar[XB_TMO])) break; if (sp > XB_SPIN_CAP) { atomicAdd(&bar[XB_TMO], 1u); break; } }
    }
    nloc = mine > 0u ? mine : 1u; nx = cnt > 0u ? cnt : 1u;
}

__device__ __forceinline__ void xcd_barrier(const XcdBarrier& b) {
    asm volatile("s_waitcnt vmcnt(0)" ::: "memory");
    __syncthreads();
    if (threadIdx.x == 0) {
        unsigned* bar = b.bar;
        __builtin_amdgcn_s_waitcnt(0);
        unsigned nloc = b.st[0], nx = b.st[1];
        if (nloc == 0u) { xcd_barrier_complete(bar, b.x, nloc, nx); b.st[0] = nloc; b.st[1] = nx; }
        const unsigned old = xb_add(&bar[XB_XSUB(b.x)], 1u);
        const unsigned gen = old / nloc;
        if (old + 1u == (gen + 1u) * nloc) {
            __builtin_amdgcn_fence(__ATOMIC_RELEASE, "agent");
            asm volatile("s_waitcnt vmcnt(0)" ::: "memory");
            const unsigned og = xb_add(&bar[XB_TOP], 1u);
            const unsigned tg = og / nx;
            if (og + 1u == (tg + 1u) * nx) xb_add(&bar[XB_TOPGEN], 1u);
            else XB_SPIN(xb_ld(&bar[XB_TOPGEN]) == tg, bar);
            __builtin_amdgcn_fence(__ATOMIC_ACQUIRE, "agent");
            xb_add(&bar[XB_XGEN(b.x)], 1u);
            asm volatile("s_waitcnt vmcnt(0)" ::: "memory");
        } else {
            XB_SPIN(xb_ld(&bar[XB_XGEN(b.x)]) == gen, bar);
            __builtin_amdgcn_fence(__ATOMIC_ACQUIRE, "agent");
            asm volatile("s_waitcnt vmcnt(0)" ::: "memory");
        }
    }
    __syncthreads();
}
constexpr int NB = 8, SEQ = 4096, D = 1024, M = NB * SEQ;
constexpr int NIN_SRC = 5936, NIN = 6144;
constexpr int ZW = 4096;
constexpr int ZQ = 0, ZK = 512, ZV = 1024, ZIQ = 1536, ZIK = 2048, ZIW = 2080, ZR = 2304;
constexpr int ZR_R = ZR, ZR_K = ZR + 512, ZR_V = ZR + 1024, ZR_WD = ZR + 1536, ZR_AD = ZR + 1600, ZR_GD = ZR + 1664;
constexpr int GW = 2048;
constexpr int NEXP = 64, FF = 256, TOPK = 8;
constexpr float RMS_EPS = 1e-6f, GN_EPS = 64e-5f;
constexpr float QSCALE = 0.125f * 1.4426950408889634f;
constexpr int NWAVES = 8, NTHR = 512;

constexpr size_t MiB = 1u << 20;
constexpr size_t WS_CTL = 0, CTL_ZERO_BYTES = 1 * MiB;
constexpr size_t WS_MOD = 1 * MiB;
constexpr size_t WS_DUT = 1 * MiB + 256 * 1024;
constexpr size_t WS_IUT = WS_DUT + 64 * 1024;
constexpr size_t WS_GUT = WS_IUT + 64 * 1024;
constexpr size_t WS_WIN = 2 * MiB;
constexpr size_t WS_WA = 14 * MiB, WS_WR = 15 * MiB;
constexpr size_t WS_WO = 16 * MiB;
constexpr size_t WS_WRT = 18 * MiB;
constexpr size_t WS_WSH1 = 19 * MiB;
constexpr size_t WS_WSH2 = 20 * MiB;
constexpr size_t WS_BRS = 21 * MiB, WS_KRS = 22 * MiB;
constexpr size_t WS_TOPE = 23 * MiB, WS_TOPW = 24 * MiB;
constexpr size_t WS_LOGIT = 25 * MiB;
constexpr size_t WS_Z = 36 * MiB;
constexpr size_t WS_H0 = 292 * MiB, WS_H1 = 324 * MiB;
constexpr size_t WS_SEL = 356 * MiB;
constexpr size_t WS_R0 = 372 * MiB, WS_R1 = 404 * MiB, WS_R2 = 436 * MiB, WS_R3 = 468 * MiB;
constexpr size_t WS_W2T = 36 * MiB;
constexpr size_t WS_ACT = 68 * MiB;
constexpr size_t WS_ACTS = 196 * MiB;
constexpr size_t WS_STOK = 212 * MiB, WS_SW = 213 * MiB;
constexpr size_t WS_W1T = 214 * MiB;
constexpr size_t WS_H2 = 278 * MiB;
constexpr size_t WS_SLOT = 214 * MiB;
constexpr size_t WS_END = 502 * MiB;
constexpr int CW_TMO = 0, CW_BAR = 4096, CW_CNT = 32768, CW_CUR = 32768 + 128, CW_Q = 32768 + 512;

constexpr int RING_BYTES = 131072;
constexpr int LDSCTL_OFF = RING_BYTES, MISC_OFF = LDSCTL_OFF + 320;
constexpr int LDS_TILETAB = RING_BYTES + 1024;
constexpr int LDS_PTAB = RING_BYTES + 512;
constexpr int LDS_PARA = 118800;
constexpr int LDS_PARB = LDS_TILETAB;
constexpr int LDS_BYTES = 147456;
#define AIN(i) ain_ptr(F.lds, (i))

struct Args { const float* in[31]; float* out; unsigned char* ws; int ph_lo, ph_hi, li, pad; };
struct Frame {
    LAS unsigned char* lds;
    volatile LAS unsigned* MISC;
    unsigned* ctl;
    int tid, lane, wave, vcu, G, gw, NGW;
    float* out; unsigned char* ws;
};

__device__ __forceinline__ const float* ain_ptr(LAS unsigned char* lds, int i) {
    const u32x2 w = *(const LAS u32x2*)(lds + LDS_PTAB + 8 * i);
    const unsigned lo = (unsigned)__builtin_amdgcn_readfirstlane((int)w.x), hi = (unsigned)__builtin_amdgcn_readfirstlane((int)w.y);
    return (const float*)(const GAS float*)(((unsigned long long)hi << 32) | lo);
}
struct TrSrc { const float* base; int nsrc; };
template <int FP8, class ColFn>
__device__ __forceinline__ void transpose_item(const ColFn& colfn, int K, bf16_t* WT, LAS float* scr, int kb, int nb, int lane) {
    const int k0 = 64 * kb, n0 = 32 * nb;
    const TrSrc s = colfn(n0 + (lane & 31));
    float v_[32];
#pragma unroll
    for (int i = 0; i < 32; ++i) { const int kk = 2 * i + (lane >> 5); v_[i] = s.base ? s.base[(size_t)(k0 + kk) * s.nsrc] : 0.f; }
#pragma unroll
    for (int i = 0; i < 32; ++i) { const int kk = 2 * i + (lane >> 5); scr[kk * 33 + (lane & 31)] = v_[i]; }
    LDS_WAIT(); asm volatile("" ::: "memory");
    const int c = lane & 7;
#pragma unroll
    for (int j = 0; j < 4; ++j) { const int n = (lane >> 3) + 8 * j; const LAS float* sp = scr + (8 * c) * 33 + n;
        if constexpr (FP8) { constexpr float S8 = 32.0f;
            int lo = __builtin_amdgcn_cvt_pk_fp8_f32(sp[0 * 33] * S8, sp[1 * 33] * S8, 0, false); lo = __builtin_amdgcn_cvt_pk_fp8_f32(sp[2 * 33] * S8, sp[3 * 33] * S8, lo, true);
            int hi = __builtin_amdgcn_cvt_pk_fp8_f32(sp[4 * 33] * S8, sp[5 * 33] * S8, 0, false); hi = __builtin_amdgcn_cvt_pk_fp8_f32(sp[6 * 33] * S8, sp[7 * 33] * S8, hi, true);
            *(GAS u32x2*)((unsigned char*)WT + (size_t)(n0 + n) * K + k0 + 8 * c) = (u32x2){(unsigned)lo, (unsigned)hi}; }
        else { u32x4 o; o.x = pk2(sp[0 * 33], sp[1 * 33]); o.y = pk2(sp[2 * 33], sp[3 * 33]); o.z = pk2(sp[4 * 33], sp[5 * 33]); o.w = pk2(sp[6 * 33], sp[7 * 33]);
            *(GAS u32x4*)(WT + (size_t)(n0 + n) * K + k0 + 8 * c) = o; } }
    LDS_WAIT(); asm volatile("" ::: "memory");
}

__device__ __forceinline__ void p0_mod(const Args& args, Frame& F, int task) {
    LAS float* sc = (LAS float*)F.lds;
    LAS float* red = (LAS float*)(F.lds + 32768);
    const float* c = AIN(1);
    for (int i = F.tid; i < 8192; i += NTHR) { const float v = c[i]; sc[i] = v * fast_sigmoid(v); }
    __syncthreads();
    const float* aw = AIN(2) + 64 * task + F.lane;
    float acc[8];
#pragma unroll
    for (int b = 0; b < 8; ++b) acc[b] = 0.f;
    const int kb = 128 * F.wave;
#pragma unroll 1
    for (int k0 = 0; k0 < 128; k0 += 16) { float a_[16];
#pragma unroll
        for (int k = 0; k < 16; ++k) a_[k] = aw[(size_t)(kb + k0 + k) * 6144];
#pragma unroll
        for (int k = 0; k < 16; ++k) {
#pragma unroll
            for (int b = 0; b < 8; ++b) acc[b] += sc[b * 1024 + kb + k0 + k] * a_[k];
            if ((k & 3) == 3) asm volatile("" ::: "memory"); } }
#pragma unroll
    for (int b = 0; b < 8; ++b) red[(F.wave * 8 + b) * 64 + F.lane] = acc[b];
    __syncthreads();
    { const int b = F.wave; float s = AIN(3)[64 * task + F.lane];
#pragma unroll
      for (int w = 0; w < 8; ++w) s += red[(w * 8 + b) * 64 + F.lane];
      ((float*)(F.ws + WS_MOD))[b * 6144 + 64 * task + F.lane] = s; }
    __syncthreads();
}

__device__ __forceinline__ void p0_prologue(const Args& args, Frame& F) {
    if (blockIdx.x < 96) p0_mod(args, F, blockIdx.x);
    LAS float* scr = (LAS float*)(F.lds + F.wave * 16384);
    bf16_t* const ws16 = (bf16_t*)F.ws;
    constexpr int I_WIN = 16 * 192, I_WA = 8 * 32, I_WO = 16 * 32, I_WRT = 16 * 8, I_SH1 = 16 * 16, I_SH2 = 4 * 32, I_DU = 16, I_GU = 32;
    constexpr int NIT = I_WIN + 2 * I_WA + I_WO + I_WRT + I_SH1 + I_SH2 + 2 * I_DU + I_GU;
    for (int it = F.gw; it < NIT; it += F.NGW) {
        int r = it;
        if (r < I_WIN) { const float* w = AIN(5);
            transpose_item<1>([=](int n) { TrSrc s; const bool ok = (n < 2096) || (n >= 2304); const int col = n < 2096 ? n : n - 208; s.base = ok ? w + col : nullptr; s.nsrc = NIN_SRC; return s; },
                           1024, (bf16_t*)(F.ws + WS_WIN), scr, r / 192, r % 192, F.lane); continue; } r -= I_WIN;
        if (r < I_WA) { const float* w = AIN(18); transpose_item<0>([=](int n) { TrSrc s; s.base = w + n; s.nsrc = 1024; return s; }, 512, (bf16_t*)(F.ws + WS_WA), scr, r / 32, r % 32, F.lane); continue; } r -= I_WA;
        if (r < I_WA) { const float* w = AIN(19); transpose_item<0>([=](int n) { TrSrc s; s.base = w + n; s.nsrc = 1024; return s; }, 512, (bf16_t*)(F.ws + WS_WR), scr, r / 32, r % 32, F.lane); continue; } r -= I_WA;
        if (r < I_WO) { const float* w = AIN(20); transpose_item<1>([=](int n) { TrSrc s; s.base = w + n; s.nsrc = 1024; return s; }, 1024, (bf16_t*)(F.ws + WS_WO), scr, r / 32, r % 32, F.lane); continue; } r -= I_WO;
        if (r < I_WRT) { const float* w = AIN(22); transpose_item<0>([=](int n) { TrSrc s; s.base = n < 64 ? w + n : nullptr; s.nsrc = 64; return s; }, 1024, (bf16_t*)(F.ws + WS_WRT), scr, r / 8, r % 8, F.lane); continue; } r -= I_WRT;
        if (r < I_SH1) { const float* wg = AIN(27); const float* wu = AIN(28);
            transpose_item<0>([=](int n) { TrSrc s; const int j = n >> 8, sel = (n >> 7) & 1, cc = n & 127; s.base = (sel ? wu : wg) + 128 * j + cc; s.nsrc = 256; return s; }, 1024, (bf16_t*)(F.ws + WS_WSH1), scr, r / 16, r % 16, F.lane); continue; } r -= I_SH1;
        if (r < I_SH2) { const float* w = AIN(29); transpose_item<0>([=](int n) { TrSrc s; s.base = w + n; s.nsrc = 1024; return s; }, 256, (bf16_t*)(F.ws + WS_WSH2), scr, r / 32, r % 32, F.lane); continue; } r -= I_SH2;
        if (r < I_DU) { const float* w = AIN(9); transpose_item<0>([=](int n) { TrSrc s; s.base = w + n; s.nsrc = 512; return s; }, 64, (bf16_t*)(F.ws + WS_DUT), scr, 0, r, F.lane); continue; } r -= I_DU;
        if (r < I_DU) { const float* w = AIN(11); transpose_item<0>([=](int n) { TrSrc s; s.base = w + n; s.nsrc = 512; return s; }, 64, (bf16_t*)(F.ws + WS_IUT), scr, 0, r, F.lane); continue; } r -= I_DU;
        { const float* w = AIN(12); transpose_item<0>([=](int n) { TrSrc s; s.base = w + n; s.nsrc = 512; return s; }, 128, (bf16_t*)(F.ws + WS_GUT), scr, r / 16, r % 16, F.lane); }
    }
    (void)ws16;
}

__device__ __forceinline__ void convert_experts(const Args& args, Frame& F, int k0, int k1) {
    LAS float* scr = (LAS float*)(F.lds + F.wave * 16384);
    constexpr int I1 = 16 * 16, I2 = 4 * 32, PER = I1 + I2, NIT = 64 * PER;
    for (int k = k0; k < k1; ++k) { const int it = F.gw + k * F.NGW; if (it >= NIT) break;
        const int e = it / PER; int r = it % PER;
        if (r < I1) { const float* wg = AIN(24) + (size_t)e * 1024 * 256; const float* wu = AIN(25) + (size_t)e * 1024 * 256;
            transpose_item<0>([=](int n) { TrSrc s; const int j = n >> 8, sel = (n >> 7) & 1, cc = n & 127; s.base = (sel ? wu : wg) + 128 * j + cc; s.nsrc = 256; return s; }, 1024, (bf16_t*)(F.ws + WS_W1T) + (size_t)e * 512 * 1024, scr, r / 16, r % 16, F.lane); }
        else { r -= I1; const float* w = AIN(26) + (size_t)e * 256 * 1024;
            transpose_item<0>([=](int n) { TrSrc s; s.base = w + n; s.nsrc = 1024; return s; }, 256, (bf16_t*)(F.ws + WS_W2T) + (size_t)e * 1024 * 256, scr, r / 32, r % 32, F.lane); }
    }
}

__device__ __forceinline__ void norm_mod_rows(const Args& args, Frame& F, const float* X, const float* g, int sh_off, int sc_off, bf16_t* O, unsigned char* O8) {
    const int row0 = F.gw * 16, b = row0 / SEQ;
    const float* mod = (const float*)(F.ws + WS_MOD) + b * 6144;
    f32x4 mul[4], add[4];
#pragma unroll
    for (int j = 0; j < 4; ++j) { const int c = 4 * F.lane + 256 * j; const f32x4 gv = *(const f32x4*)(g + c), sc = *(const f32x4*)(mod + sc_off + c); add[j] = *(const f32x4*)(mod + sh_off + c); mul[j] = gv * (sc + 1.0f); }
    for (int r0 = 0; r0 < 16; r0 += 4) {
        f32x4 v[4][4]; float s[4];
#pragma unroll
        for (int q = 0; q < 4; ++q) { const GAS f32x4* xr = (const GAS f32x4*)(X + (size_t)(row0 + r0 + q) * D) + F.lane;
#pragma unroll
            for (int j = 0; j < 4; ++j) v[q][j] = xr[64 * j]; }
#pragma unroll
        for (int q = 0; q < 4; ++q) { s[q] = 0.f;
#pragma unroll
            for (int j = 0; j < 4; ++j) s[q] += (v[q][j].x * v[q][j].x + v[q][j].y * v[q][j].y) + (v[q][j].z * v[q][j].z + v[q][j].w * v[q][j].w); }
#pragma unroll
        for (int q = 0; q < 4; ++q) { const int r = r0 + q;
            const float rstd = 1.0f / sqrtf(wave_sum(s[q]) * (1.0f / D) + RMS_EPS);
#pragma unroll
            for (int j = 0; j < 4; ++j) { const f32x4 y = v[q][j] * rstd * mul[j] + add[j];
                if (O) { u32x2 w; w.x = cvt_pk_bf16(y.x, y.y); w.y = cvt_pk_bf16(y.z, y.w); ((GAS u32x2*)(O + (size_t)(row0 + r) * D) + F.lane)[64 * j] = w; }
                if (O8) { int w8 = __builtin_amdgcn_cvt_pk_fp8_f32(y.x, y.y, 0, false); w8 = __builtin_amdgcn_cvt_pk_fp8_f32(y.z, y.w, w8, true); ((GAS unsigned*)(O8 + (size_t)(row0 + r) * D) + F.lane)[64 * j] = (unsigned)w8; } } }
    }
}
using pg8::Unit;
constexpr float WSCALE8 = 32.0f;
typedef const f32x4 (&AccRef)[2][2][4][2];

struct EpiInProj {
    static constexpr bool PERM = true;
    bf16_t* Z; bf16_t* Gt;
    __device__ __forceinline__ void operator()(AccRef acc, const Unit& u, int wr, int wc, int fr, int fq) const {
        asm volatile("" : "+v"(fr), "+v"(fq));
        const int row0 = u.pm * 256 + wr * 64 + fr;
        const bool gate = u.pn >= 16;
        const float sc = ((u.pn < 2) ? QSCALE : 1.0f) * (1.0f / WSCALE8);
        bf16_t* base = gate ? Gt + (size_t)(u.pn - 16) * 256 : Z + (size_t)u.pn * 256;
        const int ldc = gate ? GW : ZW;
#pragma unroll
        for (int ai = 0; ai < 2; ++ai)
#pragma unroll
            for (int m = 0; m < 4; ++m) { bf16_t* rowp = base + (size_t)(row0 + ai * 128 + m * 16) * ldc + wc * 32 + 8 * fq;
#pragma unroll
                for (int bj = 0; bj < 2; ++bj) { f32x4 v0 = acc[ai][bj][m][0], v1 = acc[ai][bj][m][1];
                    if (gate) {
#pragma unroll
                        for (int j = 0; j < 4; ++j) { v0[j] = fast_sigmoid(v0[j] * sc); v1[j] = fast_sigmoid(v1[j] * sc); } }
                    else { v0 = v0 * sc; v1 = v1 * sc; }
                    u32x4 w; w.x = cvt_pk_bf16(v0[0], v0[1]); w.y = cvt_pk_bf16(v0[2], v0[3]); w.z = cvt_pk_bf16(v1[0], v1[1]); w.w = cvt_pk_bf16(v1[2], v1[3]);
                    *(u32x4*)(rowp + bj * 128) = w; } }
    }
};

constexpr float ATT_S8 = 16.0f, RW_S8 = 8.0f, MIX_S8 = 16.0f;
template <int SECOND> struct EpiMerge {
    static constexpr bool PERM = true;
    bf16_t* Mx; unsigned char* Mx8; const bf16_t* Gt; float bs;
    __device__ __forceinline__ void operator()(AccRef acc, const Unit& u, int wr, int wc, int fr, int fq) const {
        asm volatile("" : "+v"(fr), "+v"(fq));
        const int row0 = u.pm * 256 + wr * 64 + fr, col0 = u.pn * 256 + wc * 32 + 8 * fq;
#pragma unroll
        for (int ai = 0; ai < 2; ++ai)
#pragma unroll
            for (int m = 0; m < 4; ++m) { const size_t r = (size_t)(row0 + ai * 128 + m * 16);
#pragma unroll
                for (int bj = 0; bj < 2; ++bj) { const int c = col0 + bj * 128;
                    const u32x4 g = *(const u32x4*)(Gt + r * GW + SECOND * 1024 + c);
                    f32x4 v0 = acc[ai][bj][m][0] * bs, v1 = acc[ai][bj][m][1] * bs;
                    v0[0] *= bf_lo(g.x); v0[1] *= bf_hi(g.x); v0[2] *= bf_lo(g.y); v0[3] *= bf_hi(g.y);
                    v1[0] *= bf_lo(g.z); v1[1] *= bf_hi(g.z); v1[2] *= bf_lo(g.w); v1[3] *= bf_hi(g.w);
                    if (SECOND) { const u32x4 p = *(const u32x4*)(Mx + r * D + c);
                        v0[0] += bf_lo(p.x); v0[1] += bf_hi(p.x); v0[2] += bf_lo(p.y); v0[3] += bf_hi(p.y);
                        v1[0] += bf_lo(p.z); v1[1] += bf_hi(p.z); v1[2] += bf_lo(p.w); v1[3] += bf_hi(p.w);
                        v0 = v0 * MIX_S8; v1 = v1 * MIX_S8;
                        int lo = __builtin_amdgcn_cvt_pk_fp8_f32(v0[0], v0[1], 0, false); lo = __builtin_amdgcn_cvt_pk_fp8_f32(v0[2], v0[3], lo, true);
                        int hi = __builtin_amdgcn_cvt_pk_fp8_f32(v1[0], v1[1], 0, false); hi = __builtin_amdgcn_cvt_pk_fp8_f32(v1[2], v1[3], hi, true);
                        *(u32x2*)(Mx8 + r * D + c) = (u32x2){(unsigned)lo, (unsigned)hi}; }
                    else { u32x4 w; w.x = cvt_pk_bf16(v0[0], v0[1]); w.y = cvt_pk_bf16(v0[2], v0[3]); w.z = cvt_pk_bf16(v1[0], v1[1]); w.w = cvt_pk_bf16(v1[2], v1[3]);
                        *(u32x4*)(Mx + r * D + c) = w; }
                    asm volatile("" ::: "memory"); } }
    }
};

struct EpiOutProj {
    static constexpr bool PERM = false;
    const float* X; float* O; const float* mod;
    __device__ __forceinline__ void operator()(AccRef acc, const Unit& u, int wr, int wc, int fr, int fq) const {
        asm volatile("" : "+v"(fr), "+v"(fq));
        const int row0 = u.pm * 256 + wr * 64 + fr, col0 = u.pn * 256 + wc * 32 + 4 * fq;
        const float* g1 = mod + (size_t)((u.pm * 256) / SEQ) * 6144 + 2048;
        f32x4 gv[2][2];
#pragma unroll
        for (int bj = 0; bj < 2; ++bj)
#pragma unroll
            for (int n = 0; n < 2; ++n) gv[bj][n] = *(const f32x4*)(g1 + col0 + bj * 128 + n * 16);
#pragma unroll
        for (int ai = 0; ai < 2; ++ai)
#pragma unroll
            for (int m = 0; m < 4; ++m) { const size_t off = (size_t)(row0 + ai * 128 + m * 16) * D + col0;
#pragma unroll
                for (int bj = 0; bj < 2; ++bj)
#pragma unroll
                    for (int n = 0; n < 2; ++n) { const f32x4 xv = *(const f32x4*)(X + off + bj * 128 + n * 16);
                        *(f32x4*)(O + off + bj * 128 + n * 16) = xv + gv[bj][n] * acc[ai][bj][m][n] * (1.0f / (MIX_S8 * WSCALE8)); }
                if (m & 1) asm volatile("" ::: "memory"); }
    }
};

struct EpiRouter {
    static constexpr bool PERM = false;
    float* L;
    __device__ __forceinline__ void operator()(AccRef acc, const Unit& u, int wr, int wc, int fr, int fq) const {
        asm volatile("" : "+v"(fr), "+v"(fq));
        if (wc >= 2) return;
        const int row0 = u.pm * 256 + wr * 64 + fr, col0 = wc * 32 + 4 * fq;
#pragma unroll
        for (int ai = 0; ai < 2; ++ai)
#pragma unroll
            for (int m = 0; m < 4; ++m)
#pragma unroll
                for (int n = 0; n < 2; ++n) *(f32x4*)(L + (size_t)(row0 + ai * 128 + m * 16) * 64 + col0 + n * 16) = acc[ai][0][m][n];
    }
};

struct MoeSched1 {
    const LAS unsigned* tab; int ntiles, G, c;
    __device__ __forceinline__ bool next(int i, Unit& u) const {
        const int L = i * G + c; if (L >= 256 + 2 * ntiles) return false;
        u.pn = L & 1;
        if (L < 256) { u.pm = L >> 1; u.aux0 = (u.pm * 256) | (64 << 20); u.aux1 = 256; }
        else { const int t = (L - 256) >> 1; u.pm = t; u.aux0 = __builtin_amdgcn_readfirstlane((int)tab[2 * t]); u.aux1 = __builtin_amdgcn_readfirstlane((int)tab[2 * t + 1]); }
        return true;
    }
};
struct MoeSrc1 {
    static constexpr int ESZ = 2; static constexpr bool GATHER = true;
    const unsigned char* ws;
    __device__ __forceinline__ const char* a_base(const Unit&) const { return (const char*)(ws + WS_H2); }
    __device__ __forceinline__ const char* b_base(const Unit& u) const { const int e = u.aux0 >> 20;
        const size_t off = (e == 64 ? WS_WSH1 : WS_W1T + (size_t)e * 512 * 1024 * 2) + (size_t)u.pn * 256 * 1024 * 2; return (const char*)ws + off; }
    __device__ __forceinline__ unsigned a_off(const Unit& u, int R, int C) const {
        const int e = u.aux0 >> 20, pos0 = u.aux0 & 0xFFFFF; int tok;
        if (e == 64) tok = pos0 + R; else tok = (R < u.aux1) ? (((const int*)(ws + WS_STOK))[pos0 + R] >> 3) : 0;
        return (unsigned)tok * 2048u + (unsigned)C * 2u; }
};
struct EpiMoe1 {
    static constexpr bool PERM = true;
    unsigned char* ws;
    __device__ __forceinline__ void operator()(AccRef acc, const Unit& u, int wr, int wc, int fr, int fq) const {
        asm volatile("" : "+v"(fr), "+v"(fq));
        const int e = u.aux0 >> 20, pos0 = u.aux0 & 0xFFFFF;
        bf16_t* base = (bf16_t*)(ws + (e == 64 ? WS_ACTS : WS_ACT)) + (size_t)pos0 * FF + u.pn * 128 + wc * 32 + 8 * fq;
#pragma unroll
        for (int ai = 0; ai < 2; ++ai)
#pragma unroll
            for (int m = 0; m < 4; ++m) { const int r = ai * 128 + wr * 64 + m * 16 + fr;
                float o[8];
#pragma unroll
                for (int n = 0; n < 2; ++n)
#pragma unroll
                    for (int j = 0; j < 4; ++j) { const float g = acc[ai][0][m][n][j], up = acc[ai][1][m][n][j]; o[4 * n + j] = g * fast_sigmoid(g) * up; }
                u32x4 w; w.x = cvt_pk_bf16(o[0], o[1]); w.y = cvt_pk_bf16(o[2], o[3]); w.z = cvt_pk_bf16(o[4], o[5]); w.w = cvt_pk_bf16(o[6], o[7]);
                if (r < u.aux1) *(u32x4*)(base + (size_t)r * FF) = w; }
    }
};
struct MoeSched2 {
    const LAS unsigned* tab; int t0, ntiles, nsh, G, c;
    __device__ __forceinline__ bool next(int i, Unit& u) const {
        const int L = i * G + c; if (L >= nsh + 4 * ntiles) return false;
        u.pn = L & 3;
        if (L < nsh) { u.pm = L >> 2; u.aux0 = (u.pm * 256) | (64 << 20); u.aux1 = 256; }
        else { const int t = t0 + ((L - nsh) >> 2); u.pm = t; u.aux0 = __builtin_amdgcn_readfirstlane((int)tab[2 * t]); u.aux1 = __builtin_amdgcn_readfirstlane((int)tab[2 * t + 1]); }
        return true;
    }
};
struct MoeSrc2 {
    static constexpr int ESZ = 2; static constexpr bool GATHER = true;
    const unsigned char* ws;
    __device__ __forceinline__ const char* a_base(const Unit& u) const { return (const char*)ws + ((u.aux0 >> 20) == 64 ? WS_ACTS : WS_ACT); }
    __device__ __forceinline__ const char* b_base(const Unit& u) const { const int e = u.aux0 >> 20;
        const size_t off = (e == 64 ? WS_WSH2 : WS_W2T + (size_t)e * 1024 * 256 * 2) + (size_t)u.pn * 256 * 256 * 2; return (const char*)ws + off; }
    __device__ __forceinline__ unsigned a_off(const Unit& u, int R, int C) const {
        const int pos0 = u.aux0 & 0xFFFFF; const int rr = R < u.aux1 ? R : u.aux1 - 1;
        return (unsigned)(pos0 + rr) * 512u + (unsigned)C * 2u; }
};
constexpr float SLOT_SCALE = 16.0f;
constexpr int NSLOT = 9;
struct EpiMoe2 {
    static constexpr bool PERM = true;
    unsigned char* ws; float* X1; int tokbase;
    mutable int ptk[8]; mutable float pwt[8];
    __device__ __forceinline__ void prefetch(const Unit& u, int wr, int fr) const {
        const int e = u.aux0 >> 20, pos0 = u.aux0 & 0xFFFFF;
        if (e != 64) {
#pragma unroll
            for (int ai = 0; ai < 2; ++ai)
#pragma unroll
                for (int m = 0; m < 4; ++m) { const int r = ai * 128 + wr * 64 + m * 16 + fr; const int rc = r < u.aux1 ? r : u.aux1 - 1;
                    ptk[ai * 4 + m] = ((const int*)(ws + WS_STOK))[pos0 + rc]; pwt[ai * 4 + m] = ((const float*)(ws + WS_SW))[pos0 + rc]; } }
    }
    __device__ __forceinline__ void operator()(AccRef acc, const Unit& u, int wr, int wc, int fr, int fq) const {
        asm volatile("" : "+v"(fr), "+v"(fq));
        const int e = u.aux0 >> 20, pos0 = u.aux0 & 0xFFFFF; const int col0 = u.pn * 256 + wc * 32 + 8 * fq;
        if (e == 64) {
#pragma unroll
            for (int ai = 0; ai < 2; ++ai)
#pragma unroll
                for (int m = 0; m < 4; ++m) { unsigned char* rowp = (unsigned char*)(ws + WS_SLOT) + ((size_t)(pos0 + ai * 128 + wr * 64 + m * 16 + fr) * NSLOT + 8) * D + u.pn * 256 + wc * 64 + fq * 16;
                    u32x4 o;
#pragma unroll
                    for (int bj = 0; bj < 2; ++bj) { const f32x4 v0 = acc[ai][bj][m][0] * SLOT_SCALE, v1 = acc[ai][bj][m][1] * SLOT_SCALE;
                        int lo = __builtin_amdgcn_cvt_pk_fp8_f32(v0[0], v0[1], 0, false); lo = __builtin_amdgcn_cvt_pk_fp8_f32(v0[2], v0[3], lo, true);
                        int hi = __builtin_amdgcn_cvt_pk_fp8_f32(v1[0], v1[1], 0, false); hi = __builtin_amdgcn_cvt_pk_fp8_f32(v1[2], v1[3], hi, true);
                        if (bj == 0) { o.x = (unsigned)lo; o.y = (unsigned)hi; } else { o.z = (unsigned)lo; o.w = (unsigned)hi; } }
                    *(u32x4*)rowp = o;
                    asm volatile("" ::: "memory"); }
        } else {
#pragma unroll
            for (int ai = 0; ai < 2; ++ai)
#pragma unroll
                for (int m = 0; m < 4; ++m) { const int r = ai * 128 + wr * 64 + m * 16 + fr;
                    if (r < u.aux1) { const int tk = ptk[ai * 4 + m]; const float w = pwt[ai * 4 + m] * SLOT_SCALE;
                        unsigned char* rowp = (unsigned char*)(ws + WS_SLOT) + ((size_t)(tk >> 3) * NSLOT + (tk & 7)) * D + u.pn * 256 + wc * 64 + fq * 16;
                        u32x4 o;
#pragma unroll
                        for (int bj = 0; bj < 2; ++bj) { const f32x4 v0 = acc[ai][bj][m][0] * w, v1 = acc[ai][bj][m][1] * w;
                            int lo = __builtin_amdgcn_cvt_pk_fp8_f32(v0[0], v0[1], 0, false); lo = __builtin_amdgcn_cvt_pk_fp8_f32(v0[2], v0[3], lo, true);
                            int hi = __builtin_amdgcn_cvt_pk_fp8_f32(v1[0], v1[1], 0, false); hi = __builtin_amdgcn_cvt_pk_fp8_f32(v1[2], v1[3], hi, true);
                            if (bj == 0) { o.x = (unsigned)lo; o.y = (unsigned)hi; } else { o.z = (unsigned)lo; o.w = (unsigned)hi; } }
                        *(u32x4*)rowp = o; }
                    asm volatile("" ::: "memory"); }
        }
    }
};
__device__ __forceinline__ unsigned ord_key(float x) { const unsigned b = __float_as_uint(x); return (b & 0x80000000u) ? ~b : (b | 0x80000000u); }

__device__ __forceinline__ void idx_glds16(const void* gsrc, unsigned lds_dst) { unsigned keep;
    asm volatile("s_mov_b32 %0, m0\n\ts_mov_b32 m0, %2\n\ts_nop 0\n\tglobal_load_lds_dwordx4 %1, off\n\ts_mov_b32 m0, %0" : "=&s"(keep) : "v"(gsrc), "s"(lds_dst) : "memory"); }

__device__ __forceinline__ void indexer_unit(const Args& args, Frame& F, int b, int q0, bool have0, int b_next) {
    const bf16_t* Z = (const bf16_t*)(F.ws + WS_Z) + (size_t)b * SEQ * ZW;
    unsigned* SELM = (unsigned*)(F.ws + WS_SEL) + (size_t)b * SEQ * 128;
    int tid = F.tid; asm volatile("" : "+v"(tid));
    const int lane = tid & 63, kl = lane & 31, hl = lane >> 5, w = F.wave;
    const int qa = q0 + 2 * w;
    const int myq = qa + hl;
    bf16x8 A0, A1;
    { const int aq = (kl >> 2) & 1, ah = 4 * (kl >> 3) + (kl & 3);
      const bf16_t* p = Z + (size_t)(qa + aq) * ZW + ZIQ + ah * 32 + 8 * hl;
      A0 = *(const bf16x8*)p; A1 = *(const bf16x8*)(p + 16); }
    float wq[16];
    { const bf16_t* p = Z + (size_t)myq * ZW + ZIW; const u32x4 a = *(const u32x4*)p, c = *(const u32x4*)(p + 8);
      wq[0] = bf_lo(a.x); wq[1] = bf_hi(a.x); wq[2] = bf_lo(a.y); wq[3] = bf_hi(a.y); wq[4] = bf_lo(a.z); wq[5] = bf_hi(a.z); wq[6] = bf_lo(a.w); wq[7] = bf_hi(a.w);
      wq[8] = bf_lo(c.x); wq[9] = bf_hi(c.x); wq[10] = bf_lo(c.y); wq[11] = bf_hi(c.y); wq[12] = bf_lo(c.z); wq[13] = bf_hi(c.z); wq[14] = bf_lo(c.w); wq[15] = bf_hi(c.w); }
    unsigned key[128];
    const int nchunk = (q0 + 15) / 1024 + 1;
    const unsigned idx_lds0 = (unsigned)(uintptr_t)F.lds;
#define IDX_LOADZ(Zb_, ch, buf) do { _Pragma("unroll") for (int _i = 0; _i < 8; ++_i) { const int kg_ = w * 8 + _i; const int key_ = 16 * kg_ + (lane >> 2); \
        idx_glds16((Zb_) + (size_t)((ch) * 1024 + key_) * ZW + ZIK + 8 * ((lane & 3) ^ ((key_ >> 2) & 3)), (unsigned)__builtin_amdgcn_readfirstlane((int)(idx_lds0 + (buf) * 65536 + kg_ * 1024))); } } while (0)
#define IDX_LOAD(ch, buf) IDX_LOADZ(Z, ch, buf)
    if (!have0) IDX_LOAD(0, 0);
    asm volatile("s_waitcnt vmcnt(0)" ::: "memory");
    __syncthreads();
#pragma unroll
    for (int ch = 0; ch < 4; ++ch) {
        if (ch < nchunk) {
            if (ch + 1 < nchunk) IDX_LOAD(ch + 1, (ch + 1) & 1);
            LAS unsigned char* kbl = F.lds + (ch & 1) * 65536 + kl * 64 + ((hl ^ ((kl >> 2) & 3)) * 16); asm volatile("" : "+v"(kbl));
            LAS unsigned char* kbl2 = F.lds + (ch & 1) * 65536 + kl * 64 + (((hl + 2) ^ ((kl >> 2) & 3)) * 16); asm volatile("" : "+v"(kbl2));
#pragma unroll
            for (int tt = 0; tt < 32; tt += 2) {
                const int t = ch * 32 + tt;
                if (32 * t <= qa + 1) {
                    bf16x8 B0[2], B1[2]; f32x16 acc[2];
#pragma unroll
                    for (int j = 0; j < 2; ++j) { B0[j] = *(const LAS bf16x8*)(kbl + 2048 * (tt + j)); B1[j] = *(const LAS bf16x8*)(kbl2 + 2048 * (tt + j)); }
#pragma unroll
                    for (int j = 0; j < 2; ++j) { acc[j] = f32x16{}; acc[j] = __builtin_amdgcn_mfma_f32_32x32x16_bf16(A0, B0[j], acc[j], 0, 0, 0); }
#pragma unroll
                    for (int j = 0; j < 2; ++j) acc[j] = __builtin_amdgcn_mfma_f32_32x32x16_bf16(A1, B1[j], acc[j], 0, 0, 0);
#pragma unroll
                    for (int j = 0; j < 2; ++j) { float s = 0.f;
#pragma unroll
                        for (int i = 0; i < 16; ++i) { const float av_ = acc[j][i]; const int xb_ = __float_as_int(av_); s += __int_as_float(xb_ > 0 ? xb_ : 0) * wq[i]; }
                        key[t + j] = (32 * (t + j) + kl <= myq) ? ord_key(s) : 0u; }
                } else {
#pragma unroll
                    for (int j = 0; j < 2; ++j) key[t + j] = 0u;
                }
            }
            asm volatile("s_waitcnt vmcnt(0)" ::: "memory");
            __syncthreads();
        } else {
#pragma unroll
            for (int tt = 0; tt < 32; ++tt) key[ch * 32 + tt] = 0u;
        }
    }
    if (b_next >= 0) IDX_LOADZ((const bf16_t*)(F.ws + WS_Z) + (size_t)b_next * SEQ * ZW, 0, 0);
#undef IDX_LOAD
#undef IDX_LOADZ
#pragma unroll
    for (int w = 0; w < 4; ++w) {
        if (1024 * w <= qa + 1) {
#pragma unroll
            for (int k = 0; k < 16; ++k) { const unsigned lo = key[32 * w + k], hi_ = key[32 * w + k + 16];
                key[32 * w + k] = __builtin_amdgcn_perm(hi_, lo, 0x05040100u); key[32 * w + k + 16] = __builtin_amdgcn_perm(hi_, lo, 0x07060302u); }
#pragma unroll
            for (int k = 0; k < 32; ++k) if (!(k & 8)) { const unsigned lo = key[32 * w + k], hi_ = key[32 * w + k + 8];
                key[32 * w + k] = __builtin_amdgcn_perm(hi_, lo, 0x06020400u); key[32 * w + k + 8] = __builtin_amdgcn_perm(hi_, lo, 0x07030501u); }
#pragma unroll
            for (int k = 0; k < 32; ++k) if (!(k & 4)) { const unsigned lo = key[32 * w + k], hi_ = key[32 * w + k + 4]; const unsigned m = 0x0F0F0F0Fu;
                key[32 * w + k] = (lo & m) | ((hi_ << 4) & ~m); key[32 * w + k + 4] = ((lo >> 4) & m) | (hi_ & ~m); }
#pragma unroll
            for (int k = 0; k < 32; ++k) if (!(k & 2)) { const unsigned lo = key[32 * w + k], hi_ = key[32 * w + k + 2]; const unsigned m = 0x33333333u;
                key[32 * w + k] = (lo & m) | ((hi_ << 2) & ~m); key[32 * w + k + 2] = ((lo >> 2) & m) | (hi_ & ~m); }
#pragma unroll
            for (int k = 0; k < 32; ++k) if (!(k & 1)) { const unsigned lo = key[32 * w + k], hi_ = key[32 * w + k + 1]; const unsigned m = 0x55555555u;
                key[32 * w + k] = (lo & m) | ((hi_ << 1) & ~m); key[32 * w + k + 1] = ((lo >> 1) & m) | (hi_ & ~m); }
        }
    }
    unsigned Al[4] = {~0u, ~0u, ~0u, ~0u}, Gt[4] = {0u, 0u, 0u, 0u};
    int ab0 = 0, ab1 = 0; unsigned T0 = 0u, T1 = 0u; bool dn0 = false, dn1 = false;
#define IDX_DPP(v, ctrl) __builtin_amdgcn_update_dpp(0, (v), (ctrl), 0xF, 0xF, true)
#pragma unroll
    for (int bit = 31; bit >= 0; --bit) {
        unsigned S_[4]; int c = 0;
#pragma unroll
        for (int w = 0; w < 4; ++w) { S_[w] = Al[w] & key[32 * w + bit]; c += __builtin_popcount(S_[w]); }
        c += IDX_DPP(c, 0xB1); c += IDX_DPP(c, 0x4E); c += IDX_DPP(c, 0x141); c += IDX_DPP(c, 0x140);
        const int cn0 = ab0 + __builtin_amdgcn_readlane(c, 0) + __builtin_amdgcn_readlane(c, 16), cn1 = ab1 + __builtin_amdgcn_readlane(c, 32) + __builtin_amdgcn_readlane(c, 48);
        const bool t0 = cn0 >= 256, t1 = cn1 >= 256;
        if (t0) { T0 |= 1u << bit; dn0 = dn0 || cn0 == 256; } else ab0 = cn0;
        if (t1) { T1 |= 1u << bit; dn1 = dn1 || cn1 == 256; } else ab1 = cn1;
        const unsigned nm = hl ? (t1 ? 0u : ~0u) : (t0 ? 0u : ~0u);
#pragma unroll
        for (int w = 0; w < 4; ++w) { Al[w] &= key[32 * w + bit] ^ nm; Gt[w] |= S_[w] & nm; }
        if (dn0 && dn1) break;
    }
#undef IDX_DPP
    unsigned x[4];
    { const bool nz = hl ? (T1 != 0u) : (T0 != 0u);
#pragma unroll
      for (int w = 0; w < 4; ++w) x[w] = Gt[w] | (nz ? Al[w] : 0u); }
#define IDX_BFLY(d, m) do { const bool up_ = (kl & (d)) != 0; const unsigned km_ = up_ ? ~(m) : (m); const unsigned am_ = up_ ? (unsigned)(d) : 32u - (d); \
        _Pragma("unroll") for (int w = 0; w < 4; ++w) { const unsigned t_ = (unsigned)__builtin_amdgcn_ds_swizzle((int)x[w], 0x1F | ((d) << 10)); \
            const unsigned rot_ = __builtin_amdgcn_alignbit(t_, t_, am_); x[w] = (x[w] & km_) | (rot_ & ~km_); } } while (0)
    IDX_BFLY(16, 0x0000FFFFu); IDX_BFLY(8, 0x00FF00FFu); IDX_BFLY(4, 0x0F0F0F0Fu); IDX_BFLY(2, 0x33333333u); IDX_BFLY(1, 0x55555555u);
#undef IDX_BFLY
#pragma unroll
    for (int j = 0; j < 4; ++j) SELM[(size_t)myq * 128 + kl + 32 * j] = x[j];
}

__device__ __forceinline__ void indexer_phase(const Args& args, Frame& F) {
    const int c = blockIdx.x;
    for (int i = 0; i < 8; ++i) {
        for (int u = c + i * F.G; u < 2048 && i < 8; u += 2048) {
            const int b = u >> 8, pos = u & 255, blk = (b & 1) ? 255 - pos : pos;
            indexer_unit(args, F, b, blk * 16, false, -1);
        }
    }
}
namespace att {
constexpr int DM = ZW, QB = 256, KVB = 64, SLOTB = 8192;
constexpr int NS = 4;
constexpr int L_K = 0, L_V = NS * SLOTB, L_MASK = 2 * NS * SLOTB, L_WSF = L_MASK + 8 * 2048, L_OST = L_WSF + 8 * 256, L_BT = L_OST + 8 * 4096, L_MT = L_BT + 512, L_END = L_MT + 128;
static_assert(L_END <= RING_BYTES, "attention LDS");
__device__ __forceinline__ int crow(int r, int hi) { return (r & 3) + 8 * (r >> 2) + 4 * hi; }
__device__ __forceinline__ void glds16(const void* gsrc, unsigned lds_dst) { unsigned keep;
    asm volatile("s_mov_b32 %0, m0\n\ts_mov_b32 m0, %2\n\ts_nop 0\n\tglobal_load_lds_dwordx4 %1, off\n\ts_mov_b32 m0, %0" : "=&s"(keep) : "v"(gsrc), "s"(lds_dst) : "memory"); }
__device__ __forceinline__ unsigned cvtpk(float lo, float hi) { return cvt_pk_bf16(lo, hi); }
typedef short s16x4 __attribute__((ext_vector_type(4)));

#ifdef PROBE_CYC
#define CYC_DECL unsigned cyc_t0_ = 0, cyc_a_ = 0; asm volatile("" : "+v"(cyc_t0_), "+v"(cyc_a_)); const bool cyc_on_ = (F.vcu == PROBE_CYC_WG) && (F.wave == PROBE_CYC_WAVE)
#define CYC_START() do { unsigned n_ = (unsigned)__builtin_readcyclecounter(); asm volatile("" : "+v"(n_)); cyc_t0_ = n_; } while (0)
#define CYC_MARK(k_) do { unsigned n_ = (unsigned)__builtin_readcyclecounter(); asm volatile("" : "+v"(n_)); if ((k_) == PROBE_CYC_SEL) cyc_a_ += n_ - cyc_t0_; cyc_t0_ = n_; } while (0)
#define CYC_FLUSH() do { if (cyc_on_ && F.lane == 0) atomicAdd(F.ctl + CW_Q + 64, cyc_a_); } while (0)
#else
#define CYC_DECL
#define CYC_START()
#define CYC_MARK(k_)
#define CYC_FLUSH()
#endif
__device__ __forceinline__ void attn_unit(const Args& args, Frame& F, int b, int h, int qb) {
    const int lane = F.lane, r32 = lane & 31, hi = lane >> 5, wid = F.wave;
    CYC_DECL;
#ifndef PROBE_ATT_VAR
#define PROBE_ATT_VAR 0
#endif
    const bool alt_ = (PROBE_ATT_VAR != 0) && (args.li == 1);
#define ALT(bit_) (alt_ && ((PROBE_ATT_VAR) & (bit_)))
    const bf16_t* Zb = (const bf16_t*)(F.ws + WS_Z) + (size_t)b * SEQ * DM;
    const int q0 = qb * QB;
    const bf16_t* Qw = Zb + (size_t)(q0 + wid * 32) * DM + ZQ + h * 64;
    const bf16_t* Kh = Zb + ZK + h * 64; const bf16_t* Vh = Zb + ZV + h * 64;
    LAS unsigned char* shm = F.lds;
    const unsigned lds0 = (unsigned)(uintptr_t)shm;
    LAS float* wsf = (LAS float*)(shm + L_WSF) + wid * 64;
    LAS float* bt = (LAS float*)(shm + L_BT);
    if (F.tid >= 128 && F.tid < 144) { const unsigned n = F.tid - 128;
        *(LAS u32x2*)(shm + L_MT + 8 * n) = (u32x2){((n & 1u) ? 0xFFFFu : 0u) | ((n & 2u) ? 0xFFFF0000u : 0u), ((n & 4u) ? 0xFFFFu : 0u) | ((n & 8u) ? 0xFFFF0000u : 0u)}; }
    if (F.tid < 128) { const int rel = F.tid; int bk;
        if (rel < 16) bk = rel; else { bk = 16 + (int)(logf((float)rel / 16.0f) / logf(8.0f) * 16.0f); bk = bk < 31 ? bk : 31; }
        bt[rel] = (AIN(6)[bk * 8 + h] - AIN(6)[31 * 8 + h]) * 1.4426950408889634f; }
    const bf16_t* ksrc = Kh + (size_t)lane * DM + wid * 8;
    const bf16_t* vsrc = Vh + (size_t)(16 * (wid & 3) + (lane >> 2)) * DM + (wid >> 2) * 32 + (lane & 3) * 8;
    const unsigned kdst = lds0 + L_K + wid * 1024, vdst = lds0 + L_V + wid * 1024;
    const unsigned* SELM = (const unsigned*)(F.ws + WS_SEL) + (size_t)(b * SEQ + q0 + wid * 32 + r32) * 128 + 4 * hi;
    const unsigned mdst = lds0 + L_MASK + wid * 2048;
#define DMA_K(t, slot) glds16(ksrc + (size_t)(t) * KVB * DM, (unsigned)__builtin_amdgcn_readfirstlane(kdst + (slot) * SLOTB))
#define DMA_V(t, slot) glds16(vsrc + (size_t)(t) * KVB * DM, (unsigned)__builtin_amdgcn_readfirstlane(vdst + (slot) * SLOTB))
#define DMA_M(g) glds16(SELM + 8 * (g), (unsigned)__builtin_amdgcn_readfirstlane(mdst + ((g) & 1) * 1024))
    const int NT = ALT(1024) ? 4 : (q0 + QB) / KVB;
    bf16x8 qr[4];
#pragma unroll
    for (int d0 = 0; d0 < 4; ++d0) qr[d0] = *(const bf16x8*)(Qw + (size_t)r32 * DM + d0 * 16 + hi * 8);
    asm volatile("s_waitcnt vmcnt(0)" ::: "memory");
    __syncthreads();
    DMA_M(0); DMA_K(0, 0); DMA_K(1, 1); DMA_V(0, 0); DMA_K(2, 2); DMA_V(1, 1); DMA_K(3, 3); DMA_V(2, 2);
    float m_run = 0.f; f32x16 o[2], lacc = f32x16{}; o[0] = f32x16{}; o[1] = f32x16{};
    const bf16x8 ones8 = __builtin_bit_cast(bf16x8, (u32x4){0x3F803F80u, 0x3F803F80u, 0x3F803F80u, 0x3F803F80u});
    const int qpos = q0 + wid * 32 + r32;
    const int vb0 = (int)(lds0 + L_V) + ((lane >> 4) & 1) * 32 + (lane & 3) * 8 + (4 * hi + ((lane & 15) >> 2)) * 64;
#define QK_TILE(P0, P1, slot_) do { const LAS unsigned char* kb = shm + L_K + (slot_) * SLOTB + hi * 1024 + r32 * 16; P0 = f32x16{}; P1 = f32x16{}; \
        _Pragma("unroll") for (int d0 = 0; d0 < 4; ++d0) { const bf16x8 b0 = *(const LAS bf16x8*)(kb + d0 * 2048); const bf16x8 b1 = *(const LAS bf16x8*)(kb + d0 * 2048 + 512); \
            P0 = __builtin_amdgcn_mfma_f32_32x32x16_bf16(b0, qr[d0], P0, 0, 0, 0); P1 = __builtin_amdgcn_mfma_f32_32x32x16_bf16(b1, qr[d0], P1, 0, 0, 0); } } while (0)
    f32x16 pa0, pa1, pb0, pb1;
    asm volatile("s_waitcnt vmcnt(6)" ::: "memory");
    __builtin_amdgcn_s_barrier(); asm volatile("" ::: "memory");
    QK_TILE(pa0, pa1, 0);
#define ATT_WAITV(n_) do { const int nn_ = (n_); if (nn_ >= 4) asm volatile("s_waitcnt vmcnt(4)" ::: "memory"); else if (nn_ == 3) asm volatile("s_waitcnt vmcnt(3)" ::: "memory"); \
        else if (nn_ == 2) asm volatile("s_waitcnt vmcnt(2)" ::: "memory"); else if (nn_ == 1) asm volatile("s_waitcnt vmcnt(1)" ::: "memory"); else asm volatile("s_waitcnt vmcnt(0)" ::: "memory"); } while (0)
    asm volatile("s_waitcnt lgkmcnt(0)" ::: "memory");
    if (wid >= 4) { __builtin_amdgcn_s_barrier(); asm volatile("" ::: "memory"); }
    auto step = [&](const int t, f32x16& C0, f32x16& C1, f32x16& N0, f32x16& N1) __attribute__((always_inline)) {
        const int slot = t & (NS - 1), g = t >> 2, tq = t & 3;
        CYC_START();
        if (!ALT(32)) ATT_WAITV((t + 1 < NT) + 2 * (t + 2 < NT) + (t + 3 < NT));
        if (!ALT(16)) __builtin_amdgcn_s_barrier(); asm volatile("" ::: "memory");
        CYC_MARK(0);
        if (t + 4 < NT && !ALT(32)) DMA_K(t + 4, (t + 4) & (NS - 1));
        if (tq == 0 && !ALT(32)) DMA_M(g + 1);
        if (t + 1 < NT) { if (ALT(4)) { N0 = f32x16{}; N1 = f32x16{}; } else QK_TILE(N0, N1, (t + 1) & (NS - 1)); }
        __builtin_amdgcn_sched_barrier(0);
        const u32x2 mwv = *(const LAS u32x2*)(shm + L_MASK + wid * 2048 + (g & 1) * 1024 + (tq >> 1) * 512 + r32 * 16 + (tq & 1) * 8);
        if (64 * t + 63 + 112 >= q0 + wid * 32 && !ALT(256)) {
#pragma unroll
            for (int r = 0; r < 16; ++r) { const int kv = 64 * t + crow(r, hi); int r0 = qpos - kv, r1 = r0 - 32;
                r0 = r0 < 0 ? 0 : (r0 > 127 ? 127 : r0); r1 = r1 < 0 ? 0 : (r1 > 127 ? 127 : r1);
                C0[r] += bt[r0]; C1[r] += bt[r1]; }
        }
        if (!ALT(128)) {
        typedef float f32x2_ __attribute__((ext_vector_type(2)));
        { const f32x2_ mm = {m_run, m_run};
#pragma unroll
          for (int r = 0; r < 16; r += 2) { f32x2_ a = {C0[r], C0[r + 1]}, c = {C1[r], C1[r + 1]}; a -= mm; c -= mm; C0[r] = a.x; C0[r + 1] = a.y; C1[r] = c.x; C1[r + 1] = c.y; } }
        float rm = __builtin_fmaxf(C0[0], C1[0]);
#pragma unroll
        for (int r = 1; r < 16; ++r) rm = __builtin_fmaxf(rm, __builtin_fmaxf(C0[r], C1[r]));
        if (t == 0 || __builtin_amdgcn_ballot_w64(rm > 8.0f) != 0ull) {
            rm = __builtin_fmaxf(rm, __shfl_xor(rm, 32));
            const float dm = t == 0 ? rm : __builtin_fmaxf(rm, 0.f);
            const float f = t == 0 ? 1.0f : __builtin_amdgcn_exp2f(-dm);
            m_run += dm;
#pragma unroll
            for (int r = 0; r < 16; ++r) { C0[r] -= dm; C1[r] -= dm; }
            if (hi == 0) wsf[r32] = f;
            asm volatile("s_waitcnt lgkmcnt(0)" ::: "memory");
#pragma unroll
            for (int r = 0; r < 16; ++r) { const float fr_ = wsf[crow(r, hi)]; o[0][r] *= fr_; o[1][r] *= fr_; lacc[r] *= fr_; }
        }
        }
        if (!ALT(2)) {
#pragma unroll
        for (int r = 0; r < 16; ++r) { C0[r] = __builtin_amdgcn_exp2f(C0[r]); C1[r] = __builtin_amdgcn_exp2f(C1[r]); } }
        asm volatile("s_waitcnt lgkmcnt(0)" ::: "memory");
        CYC_MARK(1);
        if (!ALT(32)) ATT_WAITV((t + 1 < NT) + (t + 2 < NT) + (t + 3 < NT) + (t + 4 < NT));
        if (!ALT(16)) __builtin_amdgcn_s_barrier(); asm volatile("" ::: "memory");
        CYC_MARK(2);
        if (t + 3 < NT && !ALT(32)) DMA_V(t + 3, (t + 3) & (NS - 1));
        u32x4 pw0, pw1, pw2, pw3;
        pw0 = (u32x4){cvtpk(C0[0], C0[1]), cvtpk(C0[2], C0[3]), cvtpk(C0[4], C0[5]), cvtpk(C0[6], C0[7])};
        pw1 = (u32x4){cvtpk(C0[8], C0[9]), cvtpk(C0[10], C0[11]), cvtpk(C0[12], C0[13]), cvtpk(C0[14], C0[15])};
        pw2 = (u32x4){cvtpk(C1[0], C1[1]), cvtpk(C1[2], C1[3]), cvtpk(C1[4], C1[5]), cvtpk(C1[6], C1[7])};
        pw3 = (u32x4){cvtpk(C1[8], C1[9]), cvtpk(C1[10], C1[11]), cvtpk(C1[12], C1[13]), cvtpk(C1[14], C1[15])};
        if (!ALT(64))
        { const unsigned mx_ = mwv.x >> (4 * hi), my_ = mwv.y >> (4 * hi); const LAS unsigned char* mt = shm + L_MT;
          const u32x2 a0 = *(const LAS u32x2*)(mt + ((mx_ << 3) & 0x78u)), a1 = *(const LAS u32x2*)(mt + ((mx_ >> 5) & 0x78u)), a2 = *(const LAS u32x2*)(mt + ((mx_ >> 13) & 0x78u)), a3 = *(const LAS u32x2*)(mt + ((mx_ >> 21) & 0x78u));
          const u32x2 b0 = *(const LAS u32x2*)(mt + ((my_ << 3) & 0x78u)), b1 = *(const LAS u32x2*)(mt + ((my_ >> 5) & 0x78u)), b2 = *(const LAS u32x2*)(mt + ((my_ >> 13) & 0x78u)), b3 = *(const LAS u32x2*)(mt + ((my_ >> 21) & 0x78u));
          pw0.x &= a0.x; pw0.y &= a0.y; pw0.z &= a1.x; pw0.w &= a1.y; pw1.x &= a2.x; pw1.y &= a2.y; pw1.z &= a3.x; pw1.w &= a3.y;
          pw2.x &= b0.x; pw2.y &= b0.y; pw2.z &= b1.x; pw2.w &= b1.y; pw3.x &= b2.x; pw3.y &= b2.y; pw3.z &= b3.x; pw3.w &= b3.y; }
        if (!ALT(8)) {
        lacc = __builtin_amdgcn_mfma_f32_32x32x16_bf16(__builtin_bit_cast(bf16x8, pw0), ones8, lacc, 0, 0, 0); lacc = __builtin_amdgcn_mfma_f32_32x32x16_bf16(__builtin_bit_cast(bf16x8, pw1), ones8, lacc, 0, 0, 0);
        lacc = __builtin_amdgcn_mfma_f32_32x32x16_bf16(__builtin_bit_cast(bf16x8, pw2), ones8, lacc, 0, 0, 0); lacc = __builtin_amdgcn_mfma_f32_32x32x16_bf16(__builtin_bit_cast(bf16x8, pw3), ones8, lacc, 0, 0, 0);
        { const int vb = vb0 + slot * SLOTB;
#pragma unroll
          for (int d0 = 0; d0 < 2; ++d0) { s16x4 lo[4], hh[4];
#pragma unroll
              for (int ks = 0; ks < 4; ++ks) {
                  asm volatile("ds_read_b64_tr_b16 %0,%1 offset:%c2" : "=&v"(lo[ks]) : "v"(vb), "i"(d0 * 4096 + ks * 1024) : "memory");
                  asm volatile("ds_read_b64_tr_b16 %0,%1 offset:%c2" : "=&v"(hh[ks]) : "v"(vb), "i"(d0 * 4096 + ks * 1024 + 512) : "memory"); }
              asm volatile("s_waitcnt lgkmcnt(0)" ::: "memory"); __builtin_amdgcn_sched_barrier(0);
#define PKV(k) (bf16x8){lo[k][0], lo[k][1], lo[k][2], lo[k][3], hh[k][0], hh[k][1], hh[k][2], hh[k][3]}
              o[d0] = __builtin_amdgcn_mfma_f32_32x32x16_bf16(__builtin_bit_cast(bf16x8, pw0), PKV(0), o[d0], 0, 0, 0);
              o[d0] = __builtin_amdgcn_mfma_f32_32x32x16_bf16(__builtin_bit_cast(bf16x8, pw1), PKV(1), o[d0], 0, 0, 0);
              o[d0] = __builtin_amdgcn_mfma_f32_32x32x16_bf16(__builtin_bit_cast(bf16x8, pw2), PKV(2), o[d0], 0, 0, 0);
              o[d0] = __builtin_amdgcn_mfma_f32_32x32x16_bf16(__builtin_bit_cast(bf16x8, pw3), PKV(3), o[d0], 0, 0, 0);
#undef PKV
          } }
        }
        asm volatile("s_waitcnt lgkmcnt(0)" ::: "memory");
        CYC_MARK(3);
    };
    for (int t = 0; t < NT; t += 2) { step(t, pa0, pa1, pb0, pb1); step(t + 1, pb0, pb1, pa0, pa1); }
    if (wid < 4) { __builtin_amdgcn_s_barrier(); asm volatile("" ::: "memory"); }
#undef QK_TILE
#undef ATT_WAITV
    CYC_FLUSH();
    bf16_t* Ow = (bf16_t*)(F.ws + (alt_ ? WS_R2 : WS_R1)) + (size_t)(b * SEQ + q0 + wid * 32) * 512 + h * 64;
    { LAS bf16_t* stg = (LAS bf16_t*)(shm + L_OST) + wid * 2048;
#pragma unroll
      for (int r = 0; r < 16; ++r) { const int orow = crow(r, hi); const float rl = __builtin_amdgcn_rcpf(lacc[r]);
#pragma unroll
          for (int d0 = 0; d0 < 2; ++d0) stg[orow * 64 + d0 * 32 + r32] = (bf16_t)f2bf(o[d0][r] * rl); }
      asm volatile("s_waitcnt lgkmcnt(0)" ::: "memory");
#pragma unroll
      for (int i = 0; i < 4; ++i) { const int row = i * 8 + (lane >> 3), chn = lane & 7; const u32x4 v = *(const LAS u32x4*)(stg + row * 64 + chn * 8); *(u32x4*)(Ow + (size_t)row * 512 + chn * 8) = v; } }
    asm volatile("s_waitcnt lgkmcnt(0)" ::: "memory");
#undef DMA_K
#undef DMA_V
#undef DMA_M
}

__device__ __forceinline__ void attn_phase(const Args& args, Frame& F) {
    const int v = F.vcu;
    for (int i = 0; i < 4; ++i) {
        for (int uu = v; uu < 256; uu += F.G) {
            const int bh = uu >> 2, s = uu & 3; const int qb = (i == 0) ? s : (i == 1) ? 7 - s : (i == 2) ? 8 + s : 15 - s;
            attn_unit(args, F, bh >> 3, bh & 7, qb);
        }
    }
}
}
#ifndef PROBE_NO_STATE
#define PROBE_NO_STATE 0
#endif
#ifndef PROBE_TINV_ID
#define PROBE_TINV_ID 0
#endif
namespace rk {
typedef __bf16 bf16x2_t __attribute__((ext_vector_type(2)));
__device__ __forceinline__ unsigned cvtpk(float lo, float hi) { f32x2 v = {lo, hi}; bf16x2_t b = __builtin_convertvector(v, bf16x2_t); return __builtin_bit_cast(unsigned, b); }
template <int S> __device__ __forceinline__ bf16x8 frag(const f32x16& x) {
    u32x4 o; o.x = cvtpk(x[8 * S + 0], x[8 * S + 1]); o.y = cvtpk(x[8 * S + 2], x[8 * S + 3]); o.z = cvtpk(x[8 * S + 4], x[8 * S + 5]); o.w = cvtpk(x[8 * S + 6], x[8 * S + 7]);
    return __builtin_bit_cast(bf16x8, o); }
template <int S> __device__ __forceinline__ void unfrag(f32x16& x, bf16x8 f) { const u32x4 o = __builtin_bit_cast(u32x4, f);
    x[8 * S + 0] = bf_lo(o.x); x[8 * S + 1] = bf_hi(o.x); x[8 * S + 2] = bf_lo(o.y); x[8 * S + 3] = bf_hi(o.y); x[8 * S + 4] = bf_lo(o.z); x[8 * S + 5] = bf_hi(o.z); x[8 * S + 6] = bf_lo(o.w); x[8 * S + 7] = bf_hi(o.w); }
#define RK_MF(a, b, c) __builtin_amdgcn_mfma_f32_32x32x16_bf16((a), (b), (c), 0, 0, 0)
__device__ __forceinline__ float dppf(float v, const int ctrl_is_const_dummy);
#define RK_DPP(v, ctrl, rmask, bc) __builtin_bit_cast(float, __builtin_amdgcn_update_dpp(0, __builtin_bit_cast(int, (v)), (ctrl), (rmask), 0xF, (bc)))
__device__ __forceinline__ float scan32(float v) {
#ifdef PROBE_SHFL_SCAN
    const int l32 = threadIdx.x & 31;
#pragma unroll
    for (int o = 1; o < 32; o <<= 1) { const float t = __shfl_up(v, o, 32); if (l32 >= o) v += t; }
    return v;
#endif
    v += RK_DPP(v, 0x111, 0xF, true); v += RK_DPP(v, 0x112, 0xF, true); v += RK_DPP(v, 0x114, 0xF, true); v += RK_DPP(v, 0x118, 0xF, true);
    v += RK_DPP(v, 0x142, 0xA, false);
    return v; }
__device__ __forceinline__ float ex2(float x) { return __builtin_amdgcn_exp2f(x); }
constexpr int PZ = 3600;
constexpr size_t SZ_G = 8192, SZ_H = 8192, SZ_Q = 4096, SZ_Y = 4096;
constexpr float L2E = 1.4426950408889634f;

__device__ __forceinline__ void mk_id(bf16x8 (&fId)[2], int r, int h) {
    asm volatile("" : "+v"(r), "+v"(h));
#pragma unroll
    for (int s = 0; s < 2; ++s) { unsigned short e8[8];
#pragma unroll
        for (int jj = 0; jj < 8; ++jj) e8[jj] = (16 * s + 8 * (jj >> 2) + 4 * h + (jj & 3) == r) ? (unsigned short)0x3F80 : (unsigned short)0;
        fId[s] = __builtin_bit_cast(bf16x8, (u32x4){(unsigned)e8[0] | ((unsigned)e8[1] << 16), (unsigned)e8[2] | ((unsigned)e8[3] << 16), (unsigned)e8[4] | ((unsigned)e8[5] << 16), (unsigned)e8[6] | ((unsigned)e8[7] << 16)}); }
}

__device__ __forceinline__ void load_params(const Args& args, Frame& F) {
    LAS float* pra = (LAS float*)(F.lds + LDS_PARA); LAS float* prb = (LAS float*)(F.lds + LDS_PARB);
    const float* mu = AIN(7); const float* w0 = AIN(8); const float* a0 = AIN(10); const float* kk = AIN(13); const float* ka = AIN(14); const float* rk = AIN(15);
    for (int i = F.tid; i < 4096; i += NTHR) { const int a = i >> 9, c = i & 511;
        const float v_ = a < 3 ? mu[a * 512 + c] : (a == 3 ? w0[c] : (a == 4 ? a0[c] : (a == 5 ? kk[c] : (a == 6 ? ka[c] : rk[c]))));
        if (a < 4) pra[c * 4 + a] = v_; else prb[c * 4 + a - 4] = v_; }
    __syncthreads();
}
struct ElemCtx { const LAS unsigned char* rowc; const LAS unsigned char* rowp; const bf16_t* DUt; const bf16_t* IUt; const LAS float* pra; const LAS float* prb; int hd, r, h; float inv; };
template <int MODE> __device__ __forceinline__ void r1_elem(const ElemCtx& C, int jt, bf16x8 (&o0)[2], bf16x8 (&o1)[2], bf16x8 (&o2)[2], bf16x8 (&o3)[2], float& bns, float& pcd) {
    const int r = C.r, h = C.h, hd = C.hd;
    f32x16 lw_ = f32x16{}, la_ = f32x16{};
#pragma unroll
    for (int ks = 0; ks < 4; ++ks) { const int k0 = 16 * ks + 8 * h;
        const bf16x8 bw = *(const LAS bf16x8*)(C.rowc + (1536 + k0) * 2), ba = *(const LAS bf16x8*)(C.rowc + (1600 + k0) * 2);
        const bf16x8 fa = *(const bf16x8*)(C.DUt + (size_t)(32 * jt + r) * 64 + k0), fi = *(const bf16x8*)(C.IUt + (size_t)(32 * jt + r) * 64 + k0);
        lw_ = RK_MF(fa, bw, lw_); la_ = RK_MF(fi, ba, la_); }
    float d = 0.f;
#pragma unroll
    for (int s = 0; s < 2; ++s) { float x0[8], x1[8], x2[8], x3[8];
#pragma unroll
        for (int g2 = 0; g2 < 2; ++g2) { const int g = 2 * s + g2, cj = hd * 64 + 32 * jt + 8 * g + 4 * h;
            float kc[4], kq[4], xc[4], xq[4];
            { const u32x2 a = *(const LAS u32x2*)(C.rowc + (512 + cj) * 2), p = *(const LAS u32x2*)(C.rowp + (512 + cj) * 2);
              kc[0] = bf_lo(a.x); kc[1] = bf_hi(a.x); kc[2] = bf_lo(a.y); kc[3] = bf_hi(a.y); kq[0] = bf_lo(p.x); kq[1] = bf_hi(p.x); kq[2] = bf_lo(p.y); kq[3] = bf_hi(p.y); }
            { const int xo = MODE ? 1024 : 0; const u32x2 a = *(const LAS u32x2*)(C.rowc + (xo + cj) * 2), p = *(const LAS u32x2*)(C.rowp + (xo + cj) * 2);
              xc[0] = bf_lo(a.x); xc[1] = bf_hi(a.x); xc[2] = bf_lo(a.y); xc[3] = bf_hi(a.y); xq[0] = bf_lo(p.x); xq[1] = bf_hi(p.x); xq[2] = bf_lo(p.y); xq[3] = bf_hi(p.y); }
            const LAS f32x4* ppa = (const LAS f32x4*)(C.pra + cj * 4); const LAS f32x4* ppb = (const LAS f32x4*)(C.prb + cj * 4);
#pragma unroll
            for (int q = 0; q < 4; ++q) { const int i = 4 * g + q, o = 4 * g2 + q;
                const f32x4 pa = ppa[q], pb = ppb[q];
                const float e_ = 0.6065306597126334f * fast_sigmoid(pa[3] + lw_[i]); const float L = scan32(e_);
                const float l0 = __builtin_bit_cast(float, __builtin_amdgcn_readlane(__builtin_bit_cast(int, L), 31)), l1 = __builtin_bit_cast(float, __builtin_amdgcn_readlane(__builtin_bit_cast(int, L), 63));
                const float Lend = h ? l1 : l0; if (i == 4 * (r >> 3) + (r & 3)) d = Lend;
                const float x_ = xc[q] + (MODE ? pa[2] : pa[0]) * (xq[q] - xc[q]), k_ = kc[q] + pa[1] * (kq[q] - kc[q]);
                const float ic = fast_sigmoid(pb[0] + la_[i]);
                const float kk = k_ * pb[1] * C.inv, kpn = k_ * (1.0f + (ic - 1.0f) * pb[2]), bv = kk * ic;
                if (MODE) { const float Qe = ex2(L2E * (L - Lend)); x0[o] = bv * Qe; x1[o] = kpn * Qe; x2[o] = x_; x3[o] = 0.f; }
                else { const float P = ex2(-L2E * L), Pi = ex2(L2E * L), Pm = ex2(-L2E * (L - e_)); bns += x_ * kpn * pb[3]; x0[o] = -kk * Pm; x1[o] = x_ * P; x2[o] = bv * Pi; x3[o] = kpn * Pi; } }
            asm volatile("" ::: "memory"); }
        o0[s] = __builtin_bit_cast(bf16x8, (u32x4){cvtpk(x0[0], x0[1]), cvtpk(x0[2], x0[3]), cvtpk(x0[4], x0[5]), cvtpk(x0[6], x0[7])});
        o1[s] = __builtin_bit_cast(bf16x8, (u32x4){cvtpk(x1[0], x1[1]), cvtpk(x1[2], x1[3]), cvtpk(x1[4], x1[5]), cvtpk(x1[6], x1[7])});
        o2[s] = __builtin_bit_cast(bf16x8, (u32x4){cvtpk(x2[0], x2[1]), cvtpk(x2[2], x2[3]), cvtpk(x2[4], x2[5]), cvtpk(x2[6], x2[7])});
        if (!MODE) o3[s] = __builtin_bit_cast(bf16x8, (u32x4){cvtpk(x3[0], x3[1]), cvtpk(x3[2], x3[3]), cvtpk(x3[4], x3[5]), cvtpk(x3[6], x3[7])}); }
    if (MODE) pcd = ex2(-L2E * d);
}


__device__ __forceinline__ void r1_unit(const Args& args, Frame& F, int b, int c) {
    LAS unsigned char* IMG = F.lds;
    const bf16_t* Z = (const bf16_t*)(F.ws + WS_Z);
    const int t0 = 32 * c; const size_t m0 = (size_t)b * SEQ + t0;
    const float* mu = AIN(7);
    int tid = F.tid; asm volatile("" : "+v"(tid));
    __syncthreads();
    { const unsigned lds0 = (unsigned)(uintptr_t)IMG; const int ln = tid & 63;
      for (int task = F.wave; task < 33 * 4; task += NWAVES) { const int rr = task >> 2, j = task & 3, pc = 64 * j + ln;
          if (pc < 224) { if (rr > 0 || t0 > 0) att::glds16(Z + (m0 + rr - 1) * ZW + ZR + 8 * pc, (unsigned)__builtin_amdgcn_readfirstlane((int)(lds0 + rr * PZ + 1024 * j)));
                          else *(LAS u32x4*)(IMG + 16 * pc) = (u32x4){0u, 0u, 0u, 0u}; } }
      asm volatile("s_waitcnt vmcnt(0)" ::: "memory"); }
    __syncthreads();
    { u32x4 actv[2];
#pragma unroll
      for (int i = 0; i < 2; ++i) { const int q = tid + NTHR * i, t = q >> 5, kp = q & 31;
          const u32x4 cw = *(const LAS u32x4*)(IMG + (t + 1) * PZ + (1536 + 8 * kp) * 2), pw = *(const LAS u32x4*)(IMG + t * PZ + (1536 + 8 * kp) * 2);
          const f32x4 m0v = *(const f32x4*)(mu + 1536 + 8 * kp), m1v = *(const f32x4*)(mu + 1536 + 8 * kp + 4);
          const unsigned cwa[4] = {cw.x, cw.y, cw.z, cw.w}, pwa[4] = {pw.x, pw.y, pw.z, pw.w}; float x[8];
#pragma unroll
          for (int j = 0; j < 4; ++j) { const float c0 = bf_lo(cwa[j]), c1 = bf_hi(cwa[j]), p0 = bf_lo(pwa[j]), p1 = bf_hi(pwa[j]);
              const float mu0 = j < 2 ? m0v[2 * j] : m1v[2 * j - 4], mu1 = j < 2 ? m0v[2 * j + 1] : m1v[2 * j - 3];
              x[2 * j] = c0 + mu0 * (p0 - c0); x[2 * j + 1] = c1 + mu1 * (p1 - c1); }
#pragma unroll
          for (int j = 0; j < 8; ++j) { if (kp < 8) { const float e2 = ex2(2.885390081777927f * x[j]); x[j] = 1.0f - 2.0f * __builtin_amdgcn_rcpf(e2 + 1.0f); } else if (kp >= 16) x[j] = fast_sigmoid(x[j]); }
          actv[i] = (u32x4){cvtpk(x[0], x[1]), cvtpk(x[2], x[3]), cvtpk(x[4], x[5]), cvtpk(x[6], x[7])}; }
      __syncthreads();
#pragma unroll
      for (int i = 0; i < 2; ++i) { const int q = tid + NTHR * i, t = q >> 5, kp = q & 31; *(LAS u32x4*)(IMG + (t + 1) * PZ + (1536 + 8 * kp) * 2) = actv[i]; }
      __syncthreads(); }
    const int hd = F.wave; int r = tid & 31, h = (tid >> 5) & 1;
    const LAS unsigned char* rowc = IMG + (r + 1) * PZ; const LAS unsigned char* rowp = IMG + r * PZ;
    const bf16_t* DUt = (const bf16_t*)(F.ws + WS_DUT) + (size_t)hd * 4096; const bf16_t* IUt = (const bf16_t*)(F.ws + WS_IUT) + (size_t)hd * 4096;
    const LAS float* pra = (const LAS float*)(F.lds + LDS_PARA); const LAS float* prb = (const LAS float*)(F.lds + LDS_PARB);
    float n2 = 0.f;
#pragma unroll
    for (int jt = 0; jt < 2; ++jt)
#pragma unroll
        for (int g = 0; g < 4; ++g) { const int cj = hd * 64 + 32 * jt + 8 * g + 4 * h;
            const u32x2 a = *(const LAS u32x2*)(rowc + (512 + cj) * 2), p = *(const LAS u32x2*)(rowp + (512 + cj) * 2);
            const float kc[4] = {bf_lo(a.x), bf_hi(a.x), bf_lo(a.y), bf_hi(a.y)}, kq[4] = {bf_lo(p.x), bf_hi(p.x), bf_lo(p.y), bf_hi(p.y)};
            #pragma unroll
            for (int q = 0; q < 4; ++q) { const float muk = pra[(cj + q) * 4 + 1], kkp = prb[(cj + q) * 4 + 1]; const float k_ = kc[q] + muk * (kq[q] - kc[q]); const float kk_ = k_ * kkp; n2 += kk_ * kk_; } }
    n2 += __shfl_xor(n2, 32);
    const float inv = 1.0f / __builtin_fmaxf(sqrtf(n2), 1e-12f);
    float pcd[2] = {0.f, 0.f};
    float bns = 0.f;
    const ElemCtx EC{rowc, rowp, DUt, IUt, pra, prb, hd, r, h, inv};
    f32x16 Aab = f32x16{}, Aak = f32x16{}, Arb = f32x16{}, Ark = f32x16{};
    bf16x8 fRt[2][2], tAt[2][2];
    { bf16x8 fId[2]; mk_id(fId, r, h);
#pragma unroll
    for (int jt = 0; jt < 2; ++jt) { bf16x8 fA[2], fB[2], fK[2]; float pd_ = 0.f;
        r1_elem<0>(EC, jt, fA, fRt[jt], fB, fK, bns, pd_);
        const bf16x8 fA0 = fA[0], fA1 = fA[1], fB0 = fB[0], fB1 = fB[1], fK0 = fK[0], fK1 = fK[1];
        Aab = RK_MF(fB0, fA0, Aab); Aab = RK_MF(fB1, fA1, Aab); Aak = RK_MF(fK0, fA0, Aak); Aak = RK_MF(fK1, fA1, Aak);
        Arb = RK_MF(fB0, fRt[jt][0], Arb); Arb = RK_MF(fB1, fRt[jt][1], Arb); Ark = RK_MF(fK0, fRt[jt][0], Ark); Ark = RK_MF(fK1, fRt[jt][1], Ark);
        { f32x16 t_ = f32x16{}; t_ = RK_MF(fA0, fId[0], t_); t_ = RK_MF(fA1, fId[1], t_); tAt[jt][0] = frag<0>(t_); tAt[jt][1] = frag<1>(t_); } } }
    bns += __shfl_xor(bns, 32);
    if (h == 0) ((float*)(F.ws + WS_TOPW))[(m0 + r) * 8 + hd] = bns;
    LAS unsigned char* stash = IMG + (1 + ((tid & 63) >> 3)) * PZ + hd * 128 + (tid & 7) * 16;
#pragma unroll
    for (int p = 0; p < 4; ++p) *(LAS u32x4*)(stash + 8 * p * PZ) = __builtin_bit_cast(u32x4, fRt[p >> 1][p & 1]);
#pragma unroll
    for (int i = 0; i < 16; ++i) { const int s = 8 * (i >> 2) + 4 * h + (i & 3);
        if (!(s < r)) { Aab[i] = 0.f; Aak[i] = 0.f; } if (!(s <= r)) { Arb[i] = 0.f; Ark[i] = 0.f; } }
    const bf16x8 fAak[2] = {frag<0>(Aak), frag<1>(Aak)}, fArb[2] = {frag<0>(Arb), frag<1>(Arb)}, fArk[2] = {frag<0>(Ark), frag<1>(Ark)};
    bf16x8 fT[2];
    asm volatile("" ::: "memory"); __builtin_amdgcn_sched_barrier(0);
    { float T[32];
#pragma unroll
      for (int s = 0; s < 32; ++s) T[s] = (r == s) ? 1.0f : 0.f;
#define TI_RL(k_, is_, ln_) { const float ac_ = Aab[is_]; asm volatile("v_readlane_b32 %0, %1, " #ln_ : "=s"(sv_[k_]) : "v"(__float_as_int(ac_))); }
#define TI_FM(s_, u_, k_) T[s_] = __builtin_fmaf(T[u_], __int_as_float(sv_[k_]), T[s_]);
      if (!PROBE_TINV_ID) { int sv_[8];
        TI_RL(0, 0, 31) TI_RL(1, 1, 31) TI_RL(2, 2, 31) TI_RL(3, 3, 31) TI_RL(4, 0, 63) TI_RL(5, 1, 63) TI_RL(6, 2, 63) TI_RL(7, 3, 63)
        TI_FM(0, 31, 0) TI_FM(1, 31, 1) TI_FM(2, 31, 2) TI_FM(3, 31, 3) TI_FM(4, 31, 4) TI_FM(5, 31, 5) TI_FM(6, 31, 6) TI_FM(7, 31, 7)
        TI_RL(0, 4, 31) TI_RL(1, 5, 31) TI_RL(2, 6, 31) TI_RL(3, 7, 31) TI_RL(4, 4, 63) TI_RL(5, 5, 63) TI_RL(6, 6, 63) TI_RL(7, 7, 63)
        TI_FM(8, 31, 0) TI_FM(9, 31, 1) TI_FM(10, 31, 2) TI_FM(11, 31, 3) TI_FM(12, 31, 4) TI_FM(13, 31, 5) TI_FM(14, 31, 6) TI_FM(15, 31, 7)
        TI_RL(0, 8, 31) TI_RL(1, 9, 31) TI_RL(2, 10, 31) TI_RL(3, 11, 31) TI_RL(4, 8, 63) TI_RL(5, 9, 63) TI_RL(6, 10, 63) TI_RL(7, 11, 63)
        TI_FM(16, 31, 0) TI_FM(17, 31, 1) TI_FM(18, 31, 2) TI_FM(19, 31, 3) TI_FM(20, 31, 4) TI_FM(21, 31, 5) TI_FM(22, 31, 6) TI_FM(23, 31, 7)
        TI_RL(0, 12, 31) TI_RL(1, 13, 31) TI_RL(2, 14, 31) TI_RL(3, 15, 31) TI_RL(4, 12, 63) TI_RL(5, 13, 63) TI_RL(6, 14, 63)
        TI_FM(24, 31, 0) TI_FM(25, 31, 1) TI_FM(26, 31, 2) TI_FM(27, 31, 3) TI_FM(28, 31, 4) TI_FM(29, 31, 5) TI_FM(30, 31, 6)
        TI_RL(0, 0, 30) TI_RL(1, 1, 30) TI_RL(2, 2, 30) TI_RL(3, 3, 30) TI_RL(4, 0, 62) TI_RL(5, 1, 62) TI_RL(6, 2, 62) TI_RL(7, 3, 62)
        TI_FM(0, 30, 0) TI_FM(1, 30, 1) TI_FM(2, 30, 2) TI_FM(3, 30, 3) TI_FM(4, 30, 4) TI_FM(5, 30, 5) TI_FM(6, 30, 6) TI_FM(7, 30, 7)
        TI_RL(0, 4, 30) TI_RL(1, 5, 30) TI_RL(2, 6, 30) TI_RL(3, 7, 30) TI_RL(4, 4, 62) TI_RL(5, 5, 62) TI_RL(6, 6, 62) TI_RL(7, 7, 62)
        TI_FM(8, 30, 0) TI_FM(9, 30, 1) TI_FM(10, 30, 2) TI_FM(11, 30, 3) TI_FM(12, 30, 4) TI_FM(13, 30, 5) TI_FM(14, 30, 6) TI_FM(15, 30, 7)
        TI_RL(0, 8, 30) TI_RL(1, 9, 30) TI_RL(2, 10, 30) TI_RL(3, 11, 30) TI_RL(4, 8, 62) TI_RL(5, 9, 62) TI_RL(6, 10, 62) TI_RL(7, 11, 62)
        TI_FM(16, 30, 0) TI_FM(17, 30, 1) TI_FM(18, 30, 2) TI_FM(19, 30, 3) TI_FM(20, 30, 4) TI_FM(21, 30, 5) TI_FM(22, 30, 6) TI_FM(23, 30, 7)
        TI_RL(0, 12, 30) TI_RL(1, 13, 30) TI_RL(2, 14, 30) TI_RL(3, 15, 30) TI_RL(4, 12, 62) TI_RL(5, 13, 62)
        TI_FM(24, 30, 0) TI_FM(25, 30, 1) TI_FM(26, 30, 2) TI_FM(27, 30, 3) TI_FM(28, 30, 4) TI_FM(29, 30, 5)
        TI_RL(0, 0, 29) TI_RL(1, 1, 29) TI_RL(2, 2, 29) TI_RL(3, 3, 29) TI_RL(4, 0, 61) TI_RL(5, 1, 61) TI_RL(6, 2, 61) TI_RL(7, 3, 61)
        TI_FM(0, 29, 0) TI_FM(1, 29, 1) TI_FM(2, 29, 2) TI_FM(3, 29, 3) TI_FM(4, 29, 4) TI_FM(5, 29, 5) TI_FM(6, 29, 6) TI_FM(7, 29, 7)
        TI_RL(0, 4, 29) TI_RL(1, 5, 29) TI_RL(2, 6, 29) TI_RL(3, 7, 29) TI_RL(4, 4, 61) TI_RL(5, 5, 61) TI_RL(6, 6, 61) TI_RL(7, 7, 61)
        TI_FM(8, 29, 0) TI_FM(9, 29, 1) TI_FM(10, 29, 2) TI_FM(11, 29, 3) TI_FM(12, 29, 4) TI_FM(13, 29, 5) TI_FM(14, 29, 6) TI_FM(15, 29, 7)
        TI_RL(0, 8, 29) TI_RL(1, 9, 29) TI_RL(2, 10, 29) TI_RL(3, 11, 29) TI_RL(4, 8, 61) TI_RL(5, 9, 61) TI_RL(6, 10, 61) TI_RL(7, 11, 61)
        TI_FM(16, 29, 0) TI_FM(17, 29, 1) TI_FM(18, 29, 2) TI_FM(19, 29, 3) TI_FM(20, 29, 4) TI_FM(21, 29, 5) TI_FM(22, 29, 6) TI_FM(23, 29, 7)
        TI_RL(0, 12, 29) TI_RL(1, 13, 29) TI_RL(2, 14, 29) TI_RL(3, 15, 29) TI_RL(4, 12, 61)
        TI_FM(24, 29, 0) TI_FM(25, 29, 1) TI_FM(26, 29, 2) TI_FM(27, 29, 3) TI_FM(28, 29, 4)
        TI_RL(0, 0, 28) TI_RL(1, 1, 28) TI_RL(2, 2, 28) TI_RL(3, 3, 28) TI_RL(4, 0, 60) TI_RL(5, 1, 60) TI_RL(6, 2, 60) TI_RL(7, 3, 60)
        TI_FM(0, 28, 0) TI_FM(1, 28, 1) TI_FM(2, 28, 2) TI_FM(3, 28, 3) TI_FM(4, 28, 4) TI_FM(5, 28, 5) TI_FM(6, 28, 6) TI_FM(7, 28, 7)
        TI_RL(0, 4, 28) TI_RL(1, 5, 28) TI_RL(2, 6, 28) TI_RL(3, 7, 28) TI_RL(4, 4, 60) TI_RL(5, 5, 60) TI_RL(6, 6, 60) TI_RL(7, 7, 60)
        TI_FM(8, 28, 0) TI_FM(9, 28, 1) TI_FM(10, 28, 2) TI_FM(11, 28, 3) TI_FM(12, 28, 4) TI_FM(13, 28, 5) TI_FM(14, 28, 6) TI_FM(15, 28, 7)
        TI_RL(0, 8, 28) TI_RL(1, 9, 28) TI_RL(2, 10, 28) TI_RL(3, 11, 28) TI_RL(4, 8, 60) TI_RL(5, 9, 60) TI_RL(6, 10, 60) TI_RL(7, 11, 60)
        TI_FM(16, 28, 0) TI_FM(17, 28, 1) TI_FM(18, 28, 2) TI_FM(19, 28, 3) TI_FM(20, 28, 4) TI_FM(21, 28, 5) TI_FM(22, 28, 6) TI_FM(23, 28, 7)
        TI_RL(0, 12, 28) TI_RL(1, 13, 28) TI_RL(2, 14, 28) TI_RL(3, 15, 28)
        TI_FM(24, 28, 0) TI_FM(25, 28, 1) TI_FM(26, 28, 2) TI_FM(27, 28, 3)
        TI_RL(0, 0, 27) TI_RL(1, 1, 27) TI_RL(2, 2, 27) TI_RL(3, 3, 27) TI_RL(4, 0, 59) TI_RL(5, 1, 59) TI_RL(6, 2, 59) TI_RL(7, 3, 59)
        TI_FM(0, 27, 0) TI_FM(1, 27, 1) TI_FM(2, 27, 2) TI_FM(3, 27, 3) TI_FM(4, 27, 4) TI_FM(5, 27, 5) TI_FM(6, 27, 6) TI_FM(7, 27, 7)
        TI_RL(0, 4, 27) TI_RL(1, 5, 27) TI_RL(2, 6, 27) TI_RL(3, 7, 27) TI_RL(4, 4, 59) TI_RL(5, 5, 59) TI_RL(6, 6, 59) TI_RL(7, 7, 59)
        TI_FM(8, 27, 0) TI_FM(9, 27, 1) TI_FM(10, 27, 2) TI_FM(11, 27, 3) TI_FM(12, 27, 4) TI_FM(13, 27, 5) TI_FM(14, 27, 6) TI_FM(15, 27, 7)
        TI_RL(0, 8, 27) TI_RL(1, 9, 27) TI_RL(2, 10, 27) TI_RL(3, 11, 27) TI_RL(4, 8, 59) TI_RL(5, 9, 59) TI_RL(6, 10, 59) TI_RL(7, 11, 59)
        TI_FM(16, 27, 0) TI_FM(17, 27, 1) TI_FM(18, 27, 2) TI_FM(19, 27, 3) TI_FM(20, 27, 4) TI_FM(21, 27, 5) TI_FM(22, 27, 6) TI_FM(23, 27, 7)
        TI_RL(0, 12, 27) TI_RL(1, 13, 27) TI_RL(2, 14, 27)
        TI_FM(24, 27, 0) TI_FM(25, 27, 1) TI_FM(26, 27, 2)
        TI_RL(0, 0, 26) TI_RL(1, 1, 26) TI_RL(2, 2, 26) TI_RL(3, 3, 26) TI_RL(4, 0, 58) TI_RL(5, 1, 58) TI_RL(6, 2, 58) TI_RL(7, 3, 58)
        TI_FM(0, 26, 0) TI_FM(1, 26, 1) TI_FM(2, 26, 2) TI_FM(3, 26, 3) TI_FM(4, 26, 4) TI_FM(5, 26, 5) TI_FM(6, 26, 6) TI_FM(7, 26, 7)
        TI_RL(0, 4, 26) TI_RL(1, 5, 26) TI_RL(2, 6, 26) TI_RL(3, 7, 26) TI_RL(4, 4, 58) TI_RL(5, 5, 58) TI_RL(6, 6, 58) TI_RL(7, 7, 58)
        TI_FM(8, 26, 0) TI_FM(9, 26, 1) TI_FM(10, 26, 2) TI_FM(11, 26, 3) TI_FM(12, 26, 4) TI_FM(13, 26, 5) TI_FM(14, 26, 6) TI_FM(15, 26, 7)
        TI_RL(0, 8, 26) TI_RL(1, 9, 26) TI_RL(2, 10, 26) TI_RL(3, 11, 26) TI_RL(4, 8, 58) TI_RL(5, 9, 58) TI_RL(6, 10, 58) TI_RL(7, 11, 58)
        TI_FM(16, 26, 0) TI_FM(17, 26, 1) TI_FM(18, 26, 2) TI_FM(19, 26, 3) TI_FM(20, 26, 4) TI_FM(21, 26, 5) TI_FM(22, 26, 6) TI_FM(23, 26, 7)
        TI_RL(0, 12, 26) TI_RL(1, 13, 26)
        TI_FM(24, 26, 0) TI_FM(25, 26, 1)
        TI_RL(0, 0, 25) TI_RL(1, 1, 25) TI_RL(2, 2, 25) TI_RL(3, 3, 25) TI_RL(4, 0, 57) TI_RL(5, 1, 57) TI_RL(6, 2, 57) TI_RL(7, 3, 57)
        TI_FM(0, 25, 0) TI_FM(1, 25, 1) TI_FM(2, 25, 2) TI_FM(3, 25, 3) TI_FM(4, 25, 4) TI_FM(5, 25, 5) TI_FM(6, 25, 6) TI_FM(7, 25, 7)
        TI_RL(0, 4, 25) TI_RL(1, 5, 25) TI_RL(2, 6, 25) TI_RL(3, 7, 25) TI_RL(4, 4, 57) TI_RL(5, 5, 57) TI_RL(6, 6, 57) TI_RL(7, 7, 57)
        TI_FM(8, 25, 0) TI_FM(9, 25, 1) TI_FM(10, 25, 2) TI_FM(11, 25, 3) TI_FM(12, 25, 4) TI_FM(13, 25, 5) TI_FM(14, 25, 6) TI_FM(15, 25, 7)
        TI_RL(0, 8, 25) TI_RL(1, 9, 25) TI_RL(2, 10, 25) TI_RL(3, 11, 25) TI_RL(4, 8, 57) TI_RL(5, 9, 57) TI_RL(6, 10, 57) TI_RL(7, 11, 57)
        TI_FM(16, 25, 0) TI_FM(17, 25, 1) TI_FM(18, 25, 2) TI_FM(19, 25, 3) TI_FM(20, 25, 4) TI_FM(21, 25, 5) TI_FM(22, 25, 6) TI_FM(23, 25, 7)
        TI_RL(0, 12, 25)
        TI_FM(24, 25, 0)
        TI_RL(0, 0, 24) TI_RL(1, 1, 24) TI_RL(2, 2, 24) TI_RL(3, 3, 24) TI_RL(4, 0, 56) TI_RL(5, 1, 56) TI_RL(6, 2, 56) TI_RL(7, 3, 56)
        TI_FM(0, 24, 0) TI_FM(1, 24, 1) TI_FM(2, 24, 2) TI_FM(3, 24, 3) TI_FM(4, 24, 4) TI_FM(5, 24, 5) TI_FM(6, 24, 6) TI_FM(7, 24, 7)
        TI_RL(0, 4, 24) TI_RL(1, 5, 24) TI_RL(2, 6, 24) TI_RL(3, 7, 24) TI_RL(4, 4, 56) TI_RL(5, 5, 56) TI_RL(6, 6, 56) TI_RL(7, 7, 56)
        TI_FM(8, 24, 0) TI_FM(9, 24, 1) TI_FM(10, 24, 2) TI_FM(11, 24, 3) TI_FM(12, 24, 4) TI_FM(13, 24, 5) TI_FM(14, 24, 6) TI_FM(15, 24, 7)
        TI_RL(0, 8, 24) TI_RL(1, 9, 24) TI_RL(2, 10, 24) TI_RL(3, 11, 24) TI_RL(4, 8, 56) TI_RL(5, 9, 56) TI_RL(6, 10, 56) TI_RL(7, 11, 56)
        TI_FM(16, 24, 0) TI_FM(17, 24, 1) TI_FM(18, 24, 2) TI_FM(19, 24, 3) TI_FM(20, 24, 4) TI_FM(21, 24, 5) TI_FM(22, 24, 6) TI_FM(23, 24, 7)
        TI_RL(0, 0, 23) TI_RL(1, 1, 23) TI_RL(2, 2, 23) TI_RL(3, 3, 23) TI_RL(4, 0, 55) TI_RL(5, 1, 55) TI_RL(6, 2, 55) TI_RL(7, 3, 55)
        TI_FM(0, 23, 0) TI_FM(1, 23, 1) TI_FM(2, 23, 2) TI_FM(3, 23, 3) TI_FM(4, 23, 4) TI_FM(5, 23, 5) TI_FM(6, 23, 6) TI_FM(7, 23, 7)
        TI_RL(0, 4, 23) TI_RL(1, 5, 23) TI_RL(2, 6, 23) TI_RL(3, 7, 23) TI_RL(4, 4, 55) TI_RL(5, 5, 55) TI_RL(6, 6, 55) TI_RL(7, 7, 55)
        TI_FM(8, 23, 0) TI_FM(9, 23, 1) TI_FM(10, 23, 2) TI_FM(11, 23, 3) TI_FM(12, 23, 4) TI_FM(13, 23, 5) TI_FM(14, 23, 6) TI_FM(15, 23, 7)
        TI_RL(0, 8, 23) TI_RL(1, 9, 23) TI_RL(2, 10, 23) TI_RL(3, 11, 23) TI_RL(4, 8, 55) TI_RL(5, 9, 55) TI_RL(6, 10, 55)
        TI_FM(16, 23, 0) TI_FM(17, 23, 1) TI_FM(18, 23, 2) TI_FM(19, 23, 3) TI_FM(20, 23, 4) TI_FM(21, 23, 5) TI_FM(22, 23, 6)
        TI_RL(0, 0, 22) TI_RL(1, 1, 22) TI_RL(2, 2, 22) TI_RL(3, 3, 22) TI_RL(4, 0, 54) TI_RL(5, 1, 54) TI_RL(6, 2, 54) TI_RL(7, 3, 54)
        TI_FM(0, 22, 0) TI_FM(1, 22, 1) TI_FM(2, 22, 2) TI_FM(3, 22, 3) TI_FM(4, 22, 4) TI_FM(5, 22, 5) TI_FM(6, 22, 6) TI_FM(7, 22, 7)
        TI_RL(0, 4, 22) TI_RL(1, 5, 22) TI_RL(2, 6, 22) TI_RL(3, 7, 22) TI_RL(4, 4, 54) TI_RL(5, 5, 54) TI_RL(6, 6, 54) TI_RL(7, 7, 54)
        TI_FM(8, 22, 0) TI_FM(9, 22, 1) TI_FM(10, 22, 2) TI_FM(11, 22, 3) TI_FM(12, 22, 4) TI_FM(13, 22, 5) TI_FM(14, 22, 6) TI_FM(15, 22, 7)
        TI_RL(0, 8, 22) TI_RL(1, 9, 22) TI_RL(2, 10, 22) TI_RL(3, 11, 22) TI_RL(4, 8, 54) TI_RL(5, 9, 54)
        TI_FM(16, 22, 0) TI_FM(17, 22, 1) TI_FM(18, 22, 2) TI_FM(19, 22, 3) TI_FM(20, 22, 4) TI_FM(21, 22, 5)
        TI_RL(0, 0, 21) TI_RL(1, 1, 21) TI_RL(2, 2, 21) TI_RL(3, 3, 21) TI_RL(4, 0, 53) TI_RL(5, 1, 53) TI_RL(6, 2, 53) TI_RL(7, 3, 53)
        TI_FM(0, 21, 0) TI_FM(1, 21, 1) TI_FM(2, 21, 2) TI_FM(3, 21, 3) TI_FM(4, 21, 4) TI_FM(5, 21, 5) TI_FM(6, 21, 6) TI_FM(7, 21, 7)
        TI_RL(0, 4, 21) TI_RL(1, 5, 21) TI_RL(2, 6, 21) TI_RL(3, 7, 21) TI_RL(4, 4, 53) TI_RL(5, 5, 53) TI_RL(6, 6, 53) TI_RL(7, 7, 53)
        TI_FM(8, 21, 0) TI_FM(9, 21, 1) TI_FM(10, 21, 2) TI_FM(11, 21, 3) TI_FM(12, 21, 4) TI_FM(13, 21, 5) TI_FM(14, 21, 6) TI_FM(15, 21, 7)
        TI_RL(0, 8, 21) TI_RL(1, 9, 21) TI_RL(2, 10, 21) TI_RL(3, 11, 21) TI_RL(4, 8, 53)
        TI_FM(16, 21, 0) TI_FM(17, 21, 1) TI_FM(18, 21, 2) TI_FM(19, 21, 3) TI_FM(20, 21, 4)
        TI_RL(0, 0, 20) TI_RL(1, 1, 20) TI_RL(2, 2, 20) TI_RL(3, 3, 20) TI_RL(4, 0, 52) TI_RL(5, 1, 52) TI_RL(6, 2, 52) TI_RL(7, 3, 52)
        TI_FM(0, 20, 0) TI_FM(1, 20, 1) TI_FM(2, 20, 2) TI_FM(3, 20, 3) TI_FM(4, 20, 4) TI_FM(5, 20, 5) TI_FM(6, 20, 6) TI_FM(7, 20, 7)
        TI_RL(0, 4, 20) TI_RL(1, 5, 20) TI_RL(2, 6, 20) TI_RL(3, 7, 20) TI_RL(4, 4, 52) TI_RL(5, 5, 52) TI_RL(6, 6, 52) TI_RL(7, 7, 52)
        TI_FM(8, 20, 0) TI_FM(9, 20, 1) TI_FM(10, 20, 2) TI_FM(11, 20, 3) TI_FM(12, 20, 4) TI_FM(13, 20, 5) TI_FM(14, 20, 6) TI_FM(15, 20, 7)
        TI_RL(0, 8, 20) TI_RL(1, 9, 20) TI_RL(2, 10, 20) TI_RL(3, 11, 20)
        TI_FM(16, 20, 0) TI_FM(17, 20, 1) TI_FM(18, 20, 2) TI_FM(19, 20, 3)
        TI_RL(0, 0, 19) TI_RL(1, 1, 19) TI_RL(2, 2, 19) TI_RL(3, 3, 19) TI_RL(4, 0, 51) TI_RL(5, 1, 51) TI_RL(6, 2, 51) TI_RL(7, 3, 51)
        TI_FM(0, 19, 0) TI_FM(1, 19, 1) TI_FM(2, 19, 2) TI_FM(3, 19, 3) TI_FM(4, 19, 4) TI_FM(5, 19, 5) TI_FM(6, 19, 6) TI_FM(7, 19, 7)
        TI_RL(0, 4, 19) TI_RL(1, 5, 19) TI_RL(2, 6, 19) TI_RL(3, 7, 19) TI_RL(4, 4, 51) TI_RL(5, 5, 51) TI_RL(6, 6, 51) TI_RL(7, 7, 51)
        TI_FM(8, 19, 0) TI_FM(9, 19, 1) TI_FM(10, 19, 2) TI_FM(11, 19, 3) TI_FM(12, 19, 4) TI_FM(13, 19, 5) TI_FM(14, 19, 6) TI_FM(15, 19, 7)
        TI_RL(0, 8, 19) TI_RL(1, 9, 19) TI_RL(2, 10, 19)
        TI_FM(16, 19, 0) TI_FM(17, 19, 1) TI_FM(18, 19, 2)
        TI_RL(0, 0, 18) TI_RL(1, 1, 18) TI_RL(2, 2, 18) TI_RL(3, 3, 18) TI_RL(4, 0, 50) TI_RL(5, 1, 50) TI_RL(6, 2, 50) TI_RL(7, 3, 50)
        TI_FM(0, 18, 0) TI_FM(1, 18, 1) TI_FM(2, 18, 2) TI_FM(3, 18, 3) TI_FM(4, 18, 4) TI_FM(5, 18, 5) TI_FM(6, 18, 6) TI_FM(7, 18, 7)
        TI_RL(0, 4, 18) TI_RL(1, 5, 18) TI_RL(2, 6, 18) TI_RL(3, 7, 18) TI_RL(4, 4, 50) TI_RL(5, 5, 50) TI_RL(6, 6, 50) TI_RL(7, 7, 50)
        TI_FM(8, 18, 0) TI_FM(9, 18, 1) TI_FM(10, 18, 2) TI_FM(11, 18, 3) TI_FM(12, 18, 4) TI_FM(13, 18, 5) TI_FM(14, 18, 6) TI_FM(15, 18, 7)
        TI_RL(0, 8, 18) TI_RL(1, 9, 18)
        TI_FM(16, 18, 0) TI_FM(17, 18, 1)
        TI_RL(0, 0, 17) TI_RL(1, 1, 17) TI_RL(2, 2, 17) TI_RL(3, 3, 17) TI_RL(4, 0, 49) TI_RL(5, 1, 49) TI_RL(6, 2, 49) TI_RL(7, 3, 49)
        TI_FM(0, 17, 0) TI_FM(1, 17, 1) TI_FM(2, 17, 2) TI_FM(3, 17, 3) TI_FM(4, 17, 4) TI_FM(5, 17, 5) TI_FM(6, 17, 6) TI_FM(7, 17, 7)
        TI_RL(0, 4, 17) TI_RL(1, 5, 17) TI_RL(2, 6, 17) TI_RL(3, 7, 17) TI_RL(4, 4, 49) TI_RL(5, 5, 49) TI_RL(6, 6, 49) TI_RL(7, 7, 49)
        TI_FM(8, 17, 0) TI_FM(9, 17, 1) TI_FM(10, 17, 2) TI_FM(11, 17, 3) TI_FM(12, 17, 4) TI_FM(13, 17, 5) TI_FM(14, 17, 6) TI_FM(15, 17, 7)
        TI_RL(0, 8, 17)
        TI_FM(16, 17, 0)
        TI_RL(0, 0, 16) TI_RL(1, 1, 16) TI_RL(2, 2, 16) TI_RL(3, 3, 16) TI_RL(4, 0, 48) TI_RL(5, 1, 48) TI_RL(6, 2, 48) TI_RL(7, 3, 48)
        TI_FM(0, 16, 0) TI_FM(1, 16, 1) TI_FM(2, 16, 2) TI_FM(3, 16, 3) TI_FM(4, 16, 4) TI_FM(5, 16, 5) TI_FM(6, 16, 6) TI_FM(7, 16, 7)
        TI_RL(0, 4, 16) TI_RL(1, 5, 16) TI_RL(2, 6, 16) TI_RL(3, 7, 16) TI_RL(4, 4, 48) TI_RL(5, 5, 48) TI_RL(6, 6, 48) TI_RL(7, 7, 48)
        TI_FM(8, 16, 0) TI_FM(9, 16, 1) TI_FM(10, 16, 2) TI_FM(11, 16, 3) TI_FM(12, 16, 4) TI_FM(13, 16, 5) TI_FM(14, 16, 6) TI_FM(15, 16, 7)
        TI_RL(0, 0, 15) TI_RL(1, 1, 15) TI_RL(2, 2, 15) TI_RL(3, 3, 15) TI_RL(4, 0, 47) TI_RL(5, 1, 47) TI_RL(6, 2, 47) TI_RL(7, 3, 47)
        TI_FM(0, 15, 0) TI_FM(1, 15, 1) TI_FM(2, 15, 2) TI_FM(3, 15, 3) TI_FM(4, 15, 4) TI_FM(5, 15, 5) TI_FM(6, 15, 6) TI_FM(7, 15, 7)
        TI_RL(0, 4, 15) TI_RL(1, 5, 15) TI_RL(2, 6, 15) TI_RL(3, 7, 15) TI_RL(4, 4, 47) TI_RL(5, 5, 47) TI_RL(6, 6, 47)
        TI_FM(8, 15, 0) TI_FM(9, 15, 1) TI_FM(10, 15, 2) TI_FM(11, 15, 3) TI_FM(12, 15, 4) TI_FM(13, 15, 5) TI_FM(14, 15, 6)
        TI_RL(0, 0, 14) TI_RL(1, 1, 14) TI_RL(2, 2, 14) TI_RL(3, 3, 14) TI_RL(4, 0, 46) TI_RL(5, 1, 46) TI_RL(6, 2, 46) TI_RL(7, 3, 46)
        TI_FM(0, 14, 0) TI_FM(1, 14, 1) TI_FM(2, 14, 2) TI_FM(3, 14, 3) TI_FM(4, 14, 4) TI_FM(5, 14, 5) TI_FM(6, 14, 6) TI_FM(7, 14, 7)
        TI_RL(0, 4, 14) TI_RL(1, 5, 14) TI_RL(2, 6, 14) TI_RL(3, 7, 14) TI_RL(4, 4, 46) TI_RL(5, 5, 46)
        TI_FM(8, 14, 0) TI_FM(9, 14, 1) TI_FM(10, 14, 2) TI_FM(11, 14, 3) TI_FM(12, 14, 4) TI_FM(13, 14, 5)
        TI_RL(0, 0, 13) TI_RL(1, 1, 13) TI_RL(2, 2, 13) TI_RL(3, 3, 13) TI_RL(4, 0, 45) TI_RL(5, 1, 45) TI_RL(6, 2, 45) TI_RL(7, 3, 45)
        TI_FM(0, 13, 0) TI_FM(1, 13, 1) TI_FM(2, 13, 2) TI_FM(3, 13, 3) TI_FM(4, 13, 4) TI_FM(5, 13, 5) TI_FM(6, 13, 6) TI_FM(7, 13, 7)
        TI_RL(0, 4, 13) TI_RL(1, 5, 13) TI_RL(2, 6, 13) TI_RL(3, 7, 13) TI_RL(4, 4, 45)
        TI_FM(8, 13, 0) TI_FM(9, 13, 1) TI_FM(10, 13, 2) TI_FM(11, 13, 3) TI_FM(12, 13, 4)
        TI_RL(0, 0, 12) TI_RL(1, 1, 12) TI_RL(2, 2, 12) TI_RL(3, 3, 12) TI_RL(4, 0, 44) TI_RL(5, 1, 44) TI_RL(6, 2, 44) TI_RL(7, 3, 44)
        TI_FM(0, 12, 0) TI_FM(1, 12, 1) TI_FM(2, 12, 2) TI_FM(3, 12, 3) TI_FM(4, 12, 4) TI_FM(5, 12, 5) TI_FM(6, 12, 6) TI_FM(7, 12, 7)
        TI_RL(0, 4, 12) TI_RL(1, 5, 12) TI_RL(2, 6, 12) TI_RL(3, 7, 12)
        TI_FM(8, 12, 0) TI_FM(9, 12, 1) TI_FM(10, 12, 2) TI_FM(11, 12, 3)
        TI_RL(0, 0, 11) TI_RL(1, 1, 11) TI_RL(2, 2, 11) TI_RL(3, 3, 11) TI_RL(4, 0, 43) TI_RL(5, 1, 43) TI_RL(6, 2, 43) TI_RL(7, 3, 43)
        TI_FM(0, 11, 0) TI_FM(1, 11, 1) TI_FM(2, 11, 2) TI_FM(3, 11, 3) TI_FM(4, 11, 4) TI_FM(5, 11, 5) TI_FM(6, 11, 6) TI_FM(7, 11, 7)
        TI_RL(0, 4, 11) TI_RL(1, 5, 11) TI_RL(2, 6, 11)
        TI_FM(8, 11, 0) TI_FM(9, 11, 1) TI_FM(10, 11, 2)
        TI_RL(0, 0, 10) TI_RL(1, 1, 10) TI_RL(2, 2, 10) TI_RL(3, 3, 10) TI_RL(4, 0, 42) TI_RL(5, 1, 42) TI_RL(6, 2, 42) TI_RL(7, 3, 42)
        TI_FM(0, 10, 0) TI_FM(1, 10, 1) TI_FM(2, 10, 2) TI_FM(3, 10, 3) TI_FM(4, 10, 4) TI_FM(5, 10, 5) TI_FM(6, 10, 6) TI_FM(7, 10, 7)
        TI_RL(0, 4, 10) TI_RL(1, 5, 10)
        TI_FM(8, 10, 0) TI_FM(9, 10, 1)
        TI_RL(0, 0, 9) TI_RL(1, 1, 9) TI_RL(2, 2, 9) TI_RL(3, 3, 9) TI_RL(4, 0, 41) TI_RL(5, 1, 41) TI_RL(6, 2, 41) TI_RL(7, 3, 41)
        TI_FM(0, 9, 0) TI_FM(1, 9, 1) TI_FM(2, 9, 2) TI_FM(3, 9, 3) TI_FM(4, 9, 4) TI_FM(5, 9, 5) TI_FM(6, 9, 6) TI_FM(7, 9, 7)
        TI_RL(0, 4, 9)
        TI_FM(8, 9, 0)
        TI_RL(0, 0, 8) TI_RL(1, 1, 8) TI_RL(2, 2, 8) TI_RL(3, 3, 8) TI_RL(4, 0, 40) TI_RL(5, 1, 40) TI_RL(6, 2, 40) TI_RL(7, 3, 40)
        TI_FM(0, 8, 0) TI_FM(1, 8, 1) TI_FM(2, 8, 2) TI_FM(3, 8, 3) TI_FM(4, 8, 4) TI_FM(5, 8, 5) TI_FM(6, 8, 6) TI_FM(7, 8, 7)
        TI_RL(0, 0, 7) TI_RL(1, 1, 7) TI_RL(2, 2, 7) TI_RL(3, 3, 7) TI_RL(4, 0, 39) TI_RL(5, 1, 39) TI_RL(6, 2, 39)
        TI_FM(0, 7, 0) TI_FM(1, 7, 1) TI_FM(2, 7, 2) TI_FM(3, 7, 3) TI_FM(4, 7, 4) TI_FM(5, 7, 5) TI_FM(6, 7, 6)
        TI_RL(0, 0, 6) TI_RL(1, 1, 6) TI_RL(2, 2, 6) TI_RL(3, 3, 6) TI_RL(4, 0, 38) TI_RL(5, 1, 38)
        TI_FM(0, 6, 0) TI_FM(1, 6, 1) TI_FM(2, 6, 2) TI_FM(3, 6, 3) TI_FM(4, 6, 4) TI_FM(5, 6, 5)
        TI_RL(0, 0, 5) TI_RL(1, 1, 5) TI_RL(2, 2, 5) TI_RL(3, 3, 5) TI_RL(4, 0, 37)
        TI_FM(0, 5, 0) TI_FM(1, 5, 1) TI_FM(2, 5, 2) TI_FM(3, 5, 3) TI_FM(4, 5, 4)
        TI_RL(0, 0, 4) TI_RL(1, 1, 4) TI_RL(2, 2, 4) TI_RL(3, 3, 4)
        TI_FM(0, 4, 0) TI_FM(1, 4, 1) TI_FM(2, 4, 2) TI_FM(3, 4, 3)
        TI_RL(0, 0, 3) TI_RL(1, 1, 3) TI_RL(2, 2, 3)
        TI_FM(0, 3, 0) TI_FM(1, 3, 1) TI_FM(2, 3, 2)
        TI_RL(0, 0, 2) TI_RL(1, 1, 2)
        TI_FM(0, 2, 0) TI_FM(1, 2, 1)
        TI_RL(0, 0, 1)
        TI_FM(0, 1, 0)
      }
#undef TI_RL
#undef TI_FM

#pragma unroll
      for (int s = 0; s < 2; ++s) { float e8[8];
#pragma unroll
          for (int jj = 0; jj < 8; ++jj) { const int i0 = 16 * s + 8 * (jj >> 2) + (jj & 3); float ta = T[i0], tb = T[i0 + 4]; asm volatile("" : "+v"(ta), "+v"(tb)); e8[jj] = h ? tb : ta; }
          fT[s] = __builtin_bit_cast(bf16x8, (u32x4){cvtpk(e8[0], e8[1]), cvtpk(e8[2], e8[3]), cvtpk(e8[4], e8[5]), cvtpk(e8[6], e8[7])}); } }
    asm volatile("" ::: "memory"); __builtin_amdgcn_sched_barrier(0);
    const size_t uid = ((size_t)(b * 8 + hd) * 128 + c);
    unsigned char* gG = F.ws + WS_R0 + uid * SZ_G; unsigned char* gH = F.ws + WS_R2 + uid * SZ_H; unsigned char* gQ = F.ws + WS_H0 + uid * SZ_Q; unsigned char* gY = F.ws + WS_H1 + uid * SZ_Y;
#define RK_ST(base, piece, f) (*(u32x4*)((base) + (piece) * 1024 + (tid & 63) * 16) = __builtin_bit_cast(u32x4, (f)))
    bf16x8 fWt[2][2];
#pragma unroll
    for (int jt = 0; jt < 2; ++jt) { f32x16 w_ = f32x16{}; w_ = RK_MF(fT[0], tAt[jt][0], w_); w_ = RK_MF(fT[1], tAt[jt][1], w_); fWt[jt][0] = frag<0>(w_); fWt[jt][1] = frag<1>(w_);
        f32x16 q_; unfrag<0>(q_, __builtin_bit_cast(bf16x8, *(const LAS u32x4*)(stash + 8 * (2 * jt) * PZ))); unfrag<1>(q_, __builtin_bit_cast(bf16x8, *(const LAS u32x4*)(stash + 8 * (2 * jt + 1) * PZ)));
        q_ = RK_MF(fWt[jt][0], fArb[0], q_); q_ = RK_MF(fWt[jt][1], fArb[1], q_); RK_ST(gQ, 2 * jt, frag<0>(q_)); RK_ST(gQ, 2 * jt + 1, frag<1>(q_)); }
    bf16x8 tBh[2][2], tKh[2][2], tV[2][2];
    { bf16x8 fId[2]; mk_id(fId, r, h);
#pragma unroll
    for (int jt = 0; jt < 2; ++jt) { bf16x8 fBh[2], fKh[2], fV[2], fdum[2]; float bdum = 0.f;
        r1_elem<1>(EC, jt, fBh, fKh, fV, fdum, bdum, pcd[jt]);
        { f32x16 t_ = f32x16{}; t_ = RK_MF(fBh[0], fId[0], t_); t_ = RK_MF(fBh[1], fId[1], t_); tBh[jt][0] = frag<0>(t_); tBh[jt][1] = frag<1>(t_); }
        { f32x16 t_ = f32x16{}; t_ = RK_MF(fKh[0], fId[0], t_); t_ = RK_MF(fKh[1], fId[1], t_); tKh[jt][0] = frag<0>(t_); tKh[jt][1] = frag<1>(t_); }
        { f32x16 t_ = f32x16{}; t_ = RK_MF(fV[0], fId[0], t_); t_ = RK_MF(fV[1], fId[1], t_); tV[jt][0] = frag<0>(t_); tV[jt][1] = frag<1>(t_); } } }
    bf16x8 fUt[2][2];
#pragma unroll
    for (int it = 0; it < 2; ++it) { f32x16 av = f32x16{}; av = RK_MF(fAak[0], tV[it][0], av); av = RK_MF(fAak[1], tV[it][1], av);
        const bf16x8 fav0 = frag<0>(av), fav1 = frag<1>(av); f32x16 u_ = f32x16{}; u_ = RK_MF(fT[0], fav0, u_); u_ = RK_MF(fT[1], fav1, u_); fUt[it][0] = frag<0>(u_); fUt[it][1] = frag<1>(u_); }
#pragma unroll
    for (int it = 0; it < 2; ++it) { f32x16 y_ = f32x16{}; y_ = RK_MF(fUt[it][0], fArb[0], y_); y_ = RK_MF(fUt[it][1], fArb[1], y_); y_ = RK_MF(tV[it][0], fArk[0], y_); y_ = RK_MF(tV[it][1], fArk[1], y_);
        RK_ST(gY, 2 * it, frag<0>(y_)); RK_ST(gY, 2 * it + 1, frag<1>(y_)); }
#pragma unroll
    for (int jt = 0; jt < 2; ++jt)
#pragma unroll
        for (int j2 = 0; j2 < 2; ++j2) { f32x16 g_ = f32x16{}; g_ = RK_MF(fWt[jt][0], tBh[j2][0], g_); g_ = RK_MF(fWt[jt][1], tBh[j2][1], g_);
            if (jt == j2) {
#pragma unroll
                for (int i = 0; i < 16; ++i) if (i == 4 * (r >> 3) + (r & 3) && h == ((r >> 2) & 1)) g_[i] += pcd[jt]; }
            RK_ST(gG, 2 * (jt * 2 + j2), frag<0>(g_)); RK_ST(gG, 2 * (jt * 2 + j2) + 1, frag<1>(g_)); }
#pragma unroll
    for (int j2 = 0; j2 < 2; ++j2)
#pragma unroll
        for (int it = 0; it < 2; ++it) { f32x16 h_ = f32x16{}; h_ = RK_MF(tBh[j2][0], fUt[it][0], h_); h_ = RK_MF(tBh[j2][1], fUt[it][1], h_); h_ = RK_MF(tKh[j2][0], tV[it][0], h_); h_ = RK_MF(tKh[j2][1], tV[it][1], h_);
            RK_ST(gH, 2 * (j2 * 2 + it), frag<0>(h_)); RK_ST(gH, 2 * (j2 * 2 + it) + 1, frag<1>(h_)); }
}

template <int DRY> __device__ __forceinline__ void r2_task(const Args& args, Frame& F, int task) {
    const bool st_ok = !DRY || args.li == 12345;
    const int bh = task >> 1, it = task & 1;
    f32x16 St[2]; St[0] = f32x16{}; St[1] = f32x16{};
    const unsigned char* gG0 = F.ws + WS_R0 + (size_t)bh * 128 * SZ_G + F.lane * 16; unsigned char* gH0 = F.ws + WS_R2 + (size_t)bh * 128 * SZ_H + F.lane * 16;
    bf16x8 G0[2][2][2], H0[2][2], G1[2][2][2], H1[2][2], G2[2][2][2], H2[2][2];
#define R2_LOAD(G_, H_, c_) do { const int cc_ = (c_) < 128 ? (c_) : 127;     \
        _Pragma("unroll") for (int jt = 0; jt < 2; ++jt) _Pragma("unroll") for (int j2 = 0; j2 < 2; ++j2) _Pragma("unroll") for (int s = 0; s < 2; ++s) \
            G_[jt][j2][s] = __builtin_bit_cast(bf16x8, *(const u32x4*)(gG0 + (size_t)cc_ * SZ_G + (2 * (jt * 2 + j2) + s) * 1024)); \
        _Pragma("unroll") for (int j2 = 0; j2 < 2; ++j2) _Pragma("unroll") for (int s = 0; s < 2; ++s) H_[j2][s] = __builtin_bit_cast(bf16x8, *(const u32x4*)(gH0 + (size_t)cc_ * SZ_H + (2 * (j2 * 2 + it) + s) * 1024)); } while (0)
#define R2_STEP(G_, H_, c_, LOADNEXT) do { \
        const bf16x8 fS[2][2] = {{frag<0>(St[0]), frag<1>(St[0])}, {frag<0>(St[1]), frag<1>(St[1])}}; \
        if (st_ok) { _Pragma("unroll") for (int jt = 0; jt < 2; ++jt) _Pragma("unroll") for (int s = 0; s < 2; ++s) \
            *(u32x4*)(gH0 + (size_t)(c_) * SZ_H + (2 * (jt * 2 + it) + s) * 1024) = __builtin_bit_cast(u32x4, fS[jt][s]); }     \
        __builtin_amdgcn_sched_barrier(0); LOADNEXT; __builtin_amdgcn_sched_barrier(0);     \
        _Pragma("unroll") for (int j2 = 0; j2 < 2; ++j2) { unfrag<0>(St[j2], H_[j2][0]); unfrag<1>(St[j2], H_[j2][1]); \
            _Pragma("unroll") for (int jt = 0; jt < 2; ++jt) { St[j2] = RK_MF(G_[jt][j2][0], fS[jt][0], St[j2]); St[j2] = RK_MF(G_[jt][j2][1], fS[jt][1], St[j2]); } } \
        __builtin_amdgcn_sched_barrier(0); \
    } while (0)
    R2_LOAD(G0, H0, 0); R2_LOAD(G1, H1, 1);
#pragma unroll 1
    for (int c = 0; c < 126; c += 3) {
        R2_STEP(G0, H0, c, R2_LOAD(G2, H2, c + 2));
        R2_STEP(G1, H1, c + 1, R2_LOAD(G0, H0, c + 3));
        R2_STEP(G2, H2, c + 2, R2_LOAD(G1, H1, c + 4));
    }
    R2_STEP(G0, H0, 126, (void)0);
    R2_STEP(G1, H1, 127, (void)0);
#undef R2_STEP
#undef R2_LOAD
}

constexpr int PV2 = 1296;
__device__ __forceinline__ void r3_unit(const Args& args, Frame& F, int b, int c) {
    LAS unsigned char* IMG = F.lds;
    const bf16_t* Z = (const bf16_t*)(F.ws + WS_Z);
    const int t0 = 32 * c; const size_t m0 = (size_t)b * SEQ + t0;
    const float* mu = AIN(7);
    int tid = F.tid; asm volatile("" : "+v"(tid));
    __syncthreads();
    { const unsigned lds0 = (unsigned)(uintptr_t)IMG; const int ln = tid & 63;
      for (int task = F.wave; task < 33 * 2; task += NWAVES) { const int rr = task >> 1, j = task & 1, pc = 64 * j + ln;
          if (pc < 80) { const int col = j == 0 ? ZR_V + 8 * ln : ZR_GD + 8 * ln;
              if (rr > 0 || t0 > 0) att::glds16(Z + (m0 + rr - 1) * ZW + col, (unsigned)__builtin_amdgcn_readfirstlane((int)(lds0 + rr * PV2 + 1024 * j)));
              else *(LAS u32x4*)(IMG + 16 * pc) = (u32x4){0u, 0u, 0u, 0u}; } }
      asm volatile("s_waitcnt vmcnt(0)" ::: "memory"); }
    __syncthreads();
    { const int t = tid >> 4, kp = tid & 15;
      const u32x4 cw = *(const LAS u32x4*)(IMG + (t + 1) * PV2 + 1024 + 16 * kp), pw = *(const LAS u32x4*)(IMG + t * PV2 + 1024 + 16 * kp);
      const f32x4 m0v = *(const f32x4*)(mu + 1664 + 8 * kp), m1v = *(const f32x4*)(mu + 1664 + 8 * kp + 4);
      const unsigned cwa[4] = {cw.x, cw.y, cw.z, cw.w}, pwa[4] = {pw.x, pw.y, pw.z, pw.w}; float x[8];
#pragma unroll
      for (int j = 0; j < 4; ++j) { const float c0 = bf_lo(cwa[j]), c1 = bf_hi(cwa[j]), p0 = bf_lo(pwa[j]), p1 = bf_hi(pwa[j]);
          const float mu0 = j < 2 ? m0v[2 * j] : m1v[2 * j - 4], mu1 = j < 2 ? m0v[2 * j + 1] : m1v[2 * j - 3];
          x[2 * j] = fast_sigmoid(c0 + mu0 * (p0 - c0)); x[2 * j + 1] = fast_sigmoid(c1 + mu1 * (p1 - c1)); }
      const u32x4 o = {cvtpk(x[0], x[1]), cvtpk(x[2], x[3]), cvtpk(x[4], x[5]), cvtpk(x[6], x[7])};
      __syncthreads();
      *(LAS u32x4*)(IMG + (t + 1) * PV2 + 1024 + 16 * kp) = o;
      __syncthreads(); }
    const int hd = F.wave; int r = tid & 31, h = (tid >> 5) & 1;
    const LAS unsigned char* rowc = IMG + (r + 1) * PV2; const LAS unsigned char* rowp = IMG + r * PV2;
    const size_t uid = ((size_t)(b * 8 + hd) * 128 + c);
    const unsigned char* gS = F.ws + WS_R2 + uid * SZ_H; const unsigned char* gQ = F.ws + WS_H0 + uid * SZ_Q; const unsigned char* gY = F.ws + WS_H1 + uid * SZ_Y;
#define RK_LD(base, piece) __builtin_bit_cast(bf16x8, *(const u32x4*)((base) + (piece) * 1024 + (tid & 63) * 16))
    f32x16 gl[2]; gl[0] = f32x16{}; gl[1] = f32x16{};
    { const bf16_t* GUt = (const bf16_t*)(F.ws + WS_GUT) + (size_t)hd * 64 * 128;
#pragma unroll
      for (int ks = 0; ks < 8; ++ks) { const int k0 = 16 * ks + 8 * h; const bf16x8 bg = *(const LAS bf16x8*)(rowc + 1024 + k0 * 2);
#pragma unroll
          for (int it = 0; it < 2; ++it) { const bf16x8 fg = *(const bf16x8*)(GUt + (size_t)(32 * it + r) * 128 + k0); gl[it] = RK_MF(fg, bg, gl[it]); } } }
    f32x16 Y[2];
    { const bf16x8 fQ[2][2] = {{RK_LD(gQ, 0), RK_LD(gQ, 1)}, {RK_LD(gQ, 2), RK_LD(gQ, 3)}};
#pragma unroll
      for (int it = 0; it < 2; ++it) { unfrag<0>(Y[it], RK_LD(gY, 2 * it)); unfrag<1>(Y[it], RK_LD(gY, 2 * it + 1));
#pragma unroll
          for (int jt = 0; jt < 2; ++jt) { if (PROBE_NO_STATE) continue; Y[it] = RK_MF(RK_LD(gS, 2 * (jt * 2 + it)), fQ[jt][0], Y[it]); Y[it] = RK_MF(RK_LD(gS, 2 * (jt * 2 + it) + 1), fQ[jt][1], Y[it]); } } }
    float s1 = 0.f;
#pragma unroll
    for (int it = 0; it < 2; ++it)
#pragma unroll
        for (int i = 0; i < 16; ++i) s1 += Y[it][i];
    s1 += __shfl_xor(s1, 32); const float mean = s1 * (1.0f / 64.0f); float s2 = 0.f;
#pragma unroll
    for (int it = 0; it < 2; ++it)
#pragma unroll
        for (int i = 0; i < 16; ++i) { const float d = Y[it][i] - mean; s2 += d * d; }
    s2 += __shfl_xor(s2, 32); const float rstd = 1.0f / sqrtf(s2 * (1.0f / 64.0f) + GN_EPS);
    const float bn = ((const float*)(F.ws + WS_TOPW))[(m0 + r) * 8 + hd];
    LAS unsigned char* stg = F.lds + 49152 + F.wave * 4608;
#pragma unroll
    for (int it = 0; it < 2; ++it)
#pragma unroll
        for (int g = 0; g < 4; ++g) { const int cl = 32 * it + 8 * g + 4 * h, cj = hd * 64 + cl;
            const u32x2 a = *(const LAS u32x2*)(rowc + cj * 2), p = *(const LAS u32x2*)(rowp + cj * 2);
            const float vc[4] = {bf_lo(a.x), bf_hi(a.x), bf_lo(a.y), bf_hi(a.y)}, vq[4] = {bf_lo(p.x), bf_hi(p.x), bf_lo(p.y), bf_hi(p.y)};
            const f32x4 muv = *(const f32x4*)(mu + 1024 + cj), lg = *(const f32x4*)(AIN(16) + cj), lb = *(const f32x4*)(AIN(17) + cj);
            float o[4];
#pragma unroll
            for (int q = 0; q < 4; ++q) { const int i = 4 * g + q; const float v_ = vc[q] + muv[q] * (vq[q] - vc[q]);
                o[q] = ((Y[it][i] - mean) * rstd * lg[q] + lb[q] + bn * v_) * gl[it][i]; }
            *(LAS u32x2*)(stg + r * 144 + cl * 2) = (u32x2){cvtpk(o[0], o[1]), cvtpk(o[2], o[3])}; }
    asm volatile("s_waitcnt lgkmcnt(0)" ::: "memory");
    bf16_t* OUT = (bf16_t*)(F.ws + WS_R0) + m0 * 512 + hd * 64;
#pragma unroll
    for (int i = 0; i < 4; ++i) { const int row = i * 8 + ((tid & 63) >> 3), chn = tid & 7; const u32x4 v = *(const LAS u32x4*)(stg + row * 144 + chn * 16); *(u32x4*)(OUT + (size_t)row * 512 + chn * 8) = v; }
#undef RK_LD
#undef RK_ST
}
}
__device__ __forceinline__ void route_token(float lg, float bias, int lane, int tok, int* TE, float* TW, LAS unsigned* lcnt) {
    const float s = 1.0f / (1.0f + expf(-lg));
    const float c = s + bias;
    const unsigned long long kc = ((unsigned long long)ord_key(c) << 6) | (unsigned)(63 - lane);
    int rk = 0;
#pragma unroll 1
    for (int d = 1; d < 8; ++d) { const unsigned long long o = __shfl_xor(kc, d); rk += (o > kc) ? 1 : 0; }
    float gs = rk < 2 ? c : 0.f;
    gs += __shfl_xor(gs, 1); gs += __shfl_xor(gs, 2); gs += __shfl_xor(gs, 4);
    const int grp = lane >> 3;
    const unsigned long long kg = ((unsigned long long)ord_key(gs) << 6) | (unsigned)(63 - grp);
    int grk = 0;
#pragma unroll 1
    for (int d = 1; d < 8; ++d) { const unsigned long long o = __shfl_xor(kg, 8 * d); grk += (o > kg) ? 1 : 0; }
    const unsigned long long km = grk < 4 ? kc : (unsigned long long)(63 - lane);
    int erk = 0;
#pragma unroll 1
    for (int d = 1; d < 64; ++d) { const unsigned long long o = __shfl_xor(km, d); erk += (o > km) ? 1 : 0; }
    const bool sel = erk < 8;
    const float ssum = wave_sum(sel ? s : 0.f);
    if (sel) { TE[(size_t)tok * 8 + erk] = lane; TW[(size_t)tok * 8 + erk] = s / ssum * 2.5f; atomicAdd((unsigned*)&lcnt[(tok >= M / 2 ? 64 : 0) + lane], 1u); }
}
__device__ __forceinline__ void norm2_route_wave(const Args& args, Frame& F, LAS unsigned* lcnt) {
    bf16_t* H2 = (bf16_t*)(F.ws + WS_H2);
    norm_mod_rows(args, F, F.out, AIN(21), 3072, 4096, H2, nullptr);
    asm volatile("s_waitcnt vmcnt(0)" ::: "memory");
    const int lane = F.lane, row0 = F.gw * 16;
    const bf16_t* ap = H2 + (size_t)(row0 + (lane & 15)) * D + 8 * (lane >> 4);
    const bf16_t* bp = (const bf16_t*)(F.ws + WS_WRT) + (size_t)(lane & 15) * D + 8 * (lane >> 4);
    f32x4 acc[4] = {f32x4{}, f32x4{}, f32x4{}, f32x4{}};
#pragma unroll 1
    for (int k0 = 0; k0 < 32; k0 += 4) { bf16x8 a_[4], b_[4][4];
#pragma unroll
        for (int i = 0; i < 4; ++i) { a_[i] = *(const bf16x8*)(ap + 32 * (k0 + i));
#pragma unroll
            for (int nt = 0; nt < 4; ++nt) b_[i][nt] = *(const bf16x8*)(bp + (size_t)(16 * nt) * D + 32 * (k0 + i)); }
#pragma unroll
        for (int i = 0; i < 4; ++i)
#pragma unroll
            for (int nt = 0; nt < 4; ++nt) acc[nt] = __builtin_amdgcn_mfma_f32_16x16x32_bf16(a_[i], b_[i][nt], acc[nt], 0, 0, 0); }
    LAS float* scr = (LAS float*)(F.lds + F.wave * 16384);
#pragma unroll
    for (int nt = 0; nt < 4; ++nt)
#pragma unroll
        for (int i = 0; i < 4; ++i) scr[(4 * (lane >> 4) + i) * 65 + 16 * nt + (lane & 15)] = acc[nt][i];
    asm volatile("s_waitcnt lgkmcnt(0)" ::: "memory");
    int* TE = (int*)(F.ws + WS_TOPE); float* TW = (float*)(F.ws + WS_TOPW);
    const float bias = AIN(23)[lane];
#pragma unroll 1
    for (int t = 0; t < 16; ++t) route_token(scr[t * 65 + lane], bias, lane, row0 + t, TE, TW, lcnt);
    asm volatile("s_waitcnt lgkmcnt(0)" ::: "memory");
}
__device__ __forceinline__ void norm2_route_convert(const Args& args, Frame& F) {
    LAS unsigned* lcnt = (LAS unsigned*)(F.lds + LDS_TILETAB);
    if (F.tid < 128) lcnt[F.tid] = 0u;
    __syncthreads();
    constexpr int KIT = (64 * (16 * 16 + 4 * 32) + NWAVES * 256 - 1) / (NWAVES * 256) + 1;
    if (F.wave < 4) { norm2_route_wave(args, F, lcnt); convert_experts(args, F, 0, KIT); }
    else { convert_experts(args, F, 0, KIT / 2); norm2_route_wave(args, F, lcnt); convert_experts(args, F, KIT / 2, KIT); }
    __syncthreads();
    if (F.tid < 128 && lcnt[F.tid]) atomicAdd(F.ctl + CW_CNT + F.tid, lcnt[F.tid]);
    __syncthreads();
}
struct MoeTab { int ntiles0, ntiles; };
__device__ __forceinline__ MoeTab build_tiles(const Args& args, Frame& F) {
    LAS unsigned* tab = (LAS unsigned*)(F.lds + LDS_TILETAB);
    LAS unsigned* offs = tab + 2432; LAS unsigned* tpre = tab + 2560;
    LAS unsigned* cnts = tab + 2700;
    if (F.tid < 128) cnts[F.tid] = __hip_atomic_load(F.ctl + CW_CNT + F.tid, RLX_AGENT);
    __syncthreads();
    if (F.tid == 0) { unsigned o = 0, tp = 0;
        for (int l = 0; l < 128; ++l) { const unsigned c = cnts[l]; offs[l] = o; tpre[l] = tp; o += c; tp += (c + 255u) >> 8; }
        tpre[128] = tp; }
    __syncthreads();
    if (F.tid < 128) { const int l = F.tid; const unsigned c = cnts[l]; const unsigned o = offs[l], t0 = tpre[l], nt = (c + 255u) >> 8;
        for (unsigned i = 0; i < nt; ++i) { const unsigned rows = (c - 256u * i) < 256u ? (c - 256u * i) : 256u; tab[2 * (t0 + i)] = (o + 256u * i) | ((unsigned)(l & 63) << 20); tab[2 * (t0 + i) + 1] = rows; } }
    __syncthreads();
    MoeTab r; r.ntiles0 = (int)tpre[64]; r.ntiles = (int)tpre[128]; return r;
}
__device__ __forceinline__ void scatter_phase(const Args& args, Frame& F) {
    LAS unsigned* tab = (LAS unsigned*)(F.lds + LDS_TILETAB); LAS unsigned* offs = tab + 2432;
    LAS unsigned* lcnt = (LAS unsigned*)(F.lds); LAS unsigned* lbase = lcnt + 128;
    const int* TE = (const int*)(F.ws + WS_TOPE); const float* TW = (const float*)(F.ws + WS_TOPW);
    int* ST = (int*)(F.ws + WS_STOK); float* SW = (float*)(F.ws + WS_SW);
    for (int blk = blockIdx.x; blk < M / 128; blk += F.G) {
        if (F.tid < 128) lcnt[F.tid] = 0u;
        __syncthreads();
        const int tok0 = blk * 128, hf = tok0 >= M / 2 ? 64 : 0;
        int lst[2]; unsigned rnk[2];
#pragma unroll
        for (int i = 0; i < 2; ++i) { const int p = F.tid + 512 * i; lst[i] = hf + TE[(size_t)tok0 * 8 + p]; rnk[i] = atomicAdd((unsigned*)&lcnt[lst[i]], 1u); }
        __syncthreads();
        if (F.tid < 128) lbase[F.tid] = lcnt[F.tid] ? atomicAdd(F.ctl + CW_CUR + F.tid, lcnt[F.tid]) : 0u;
        __syncthreads();
#pragma unroll
        for (int i = 0; i < 2; ++i) { const int p = F.tid + 512 * i; const unsigned pos = offs[lst[i]] + lbase[lst[i]] + rnk[i];
            ST[pos] = tok0 * 8 + p; SW[pos] = TW[(size_t)tok0 * 8 + p]; }
        __syncthreads();
    }
}

__device__ __forceinline__ void final_rows(const Args& args, Frame& F, int row_lo, int row_hi, int tokbase) {
    const unsigned char* SL = (const unsigned char*)(F.ws + WS_SLOT);
    const int cA = 256 * (F.lane >> 4) + 32 * ((F.lane >> 2) & 3) + 8 * (F.lane & 3), cB = cA + 128;
    for (int blk = F.gw; blk < (row_hi - row_lo) / 16; blk += F.NGW) {
        const int r0 = row_lo + blk * 16, b = r0 / SEQ;
        const float* g2 = (const float*)(F.ws + WS_MOD) + b * 6144 + 5120; const float* fgp = AIN(30);
        f32x4 gv[4], fg[4];
#pragma unroll
        for (int j = 0; j < 4; ++j) { const int c = (j < 2 ? cA : cB) + 4 * (j & 1); gv[j] = *(const f32x4*)(g2 + c) * (1.0f / SLOT_SCALE); fg[j] = *(const f32x4*)(fgp + c); }
        for (int r = 0; r < 16; ++r) { const size_t m = (size_t)(r0 + r);
            f32x4 acc[4];
#pragma unroll
            for (int j = 0; j < 4; ++j) acc[j] = (f32x4){0.f, 0.f, 0.f, 0.f};
            const unsigned char* sp = SL + (m - tokbase) * NSLOT * D + 16 * F.lane;
            u32x4 w[NSLOT];
#pragma unroll
            for (int k = 0; k < NSLOT; ++k) w[k] = *(const u32x4*)(sp + (size_t)k * D);
#pragma unroll
            for (int k = 0; k < NSLOT; ++k) { const unsigned ww[4] = {w[k].x, w[k].y, w[k].z, w[k].w};
#pragma unroll
                for (int j = 0; j < 4; ++j) { const f32x2 a = __builtin_amdgcn_cvt_pk_f32_fp8((int)ww[j], false), c = __builtin_amdgcn_cvt_pk_f32_fp8((int)ww[j], true); acc[j] += (f32x4){a.x, a.y, c.x, c.y}; } }
            float* xr = F.out + m * D; f32x4 v[4]; float s = 0.f;
#pragma unroll
            for (int j = 0; j < 4; ++j) { const int c = (j < 2 ? cA : cB) + 4 * (j & 1); v[j] = *(const f32x4*)(xr + c) + gv[j] * acc[j]; s += (v[j].x * v[j].x + v[j].y * v[j].y) + (v[j].z * v[j].z + v[j].w * v[j].w); }
            const float rstd = 1.0f / sqrtf(wave_sum(s) * (1.0f / D) + RMS_EPS);
#pragma unroll
            for (int j = 0; j < 4; ++j) { const int c = (j < 2 ? cA : cB) + 4 * (j & 1); *(f32x4*)(xr + c) = v[j] * rstd * fg[j]; }
        }
    }
}
constexpr int N_PHASES = 15;
#ifndef PROBE_ATT_SCALE
#define PROBE_ATT_SCALE 1.0f
#endif
#ifndef PROBE_IDX_REP
#define PROBE_IDX_REP 1
#endif
#ifndef R2_WGS
#define R2_WGS 32
#endif
#ifndef PROBE_P5_PART
#define PROBE_P5_PART 0
#endif
#ifndef PROBE_RW_SCALE
#define PROBE_RW_SCALE 1.0f
#endif

__global__ void __launch_bounds__(NTHR, 2) fwd_kernel(Args args) {
    extern __shared__ __attribute__((aligned(16))) unsigned char lds_raw[];
    Frame F;
    F.lds = (LAS unsigned char*)lds_raw;
    F.MISC = (volatile LAS unsigned*)(F.lds + MISC_OFF);
    F.tid = threadIdx.x; F.lane = F.tid & 63; F.wave = __builtin_amdgcn_readfirstlane(F.tid >> 6);
    F.G = gridDim.x; { const int bx = blockIdx.x; F.vcu = (F.G % 8 == 0) ? (bx % 8) * (F.G / 8) + bx / 8 : bx; }
    F.gw = blockIdx.x * NWAVES + F.wave; F.NGW = F.G * NWAVES;
    F.ws = args.ws; F.out = args.out; F.ctl = (unsigned*)(args.ws + WS_CTL);
    for (int u = F.tid; u < (LDS_BYTES - LDSCTL_OFF) / 4; u += NTHR) ((LAS unsigned*)(F.lds + LDSCTL_OFF))[u] = 0u;
    __syncthreads();
    if (F.tid == 0) {
#pragma unroll
        for (int i = 0; i < 31; ++i) *(LAS unsigned long long*)(F.lds + LDS_PTAB + 8 * i) = (unsigned long long)args.in[i];
        *(LAS unsigned long long*)(F.lds + LDS_PTAB + 8 * 31) = (unsigned long long)args.out; *(LAS unsigned long long*)(F.lds + LDS_PTAB + 8 * 32) = (unsigned long long)args.ws; }
    __syncthreads();
    XcdBarrier bar = xcd_barrier_post(F.ctl + CW_BAR + args.li * XCD_BAR_WORDS, F.MISC + 8);
    const int lo = args.ph_lo, hi = args.ph_hi;
#ifndef PHASE_MASK
#define PHASE_MASK 0xFFFFFFFFu
#endif
#define IN(k) ((((PHASE_MASK) >> (k)) & 1u) && lo <= (k) && (k) < hi)
#define PB() do { F.ws = (unsigned char*)ain_ptr(F.lds, 32); F.out = (float*)ain_ptr(F.lds, 31); F.ctl = (unsigned*)(F.ws + WS_CTL); \
        F.lane = (int)__builtin_amdgcn_mbcnt_hi(~0u, __builtin_amdgcn_mbcnt_lo(~0u, 0u)); F.tid = F.wave * 64 + F.lane; } while (0)
#define ZB ((bf16_t*)(F.ws + WS_Z))
#define GATES ((bf16_t*)F.out)
#define MOD ((const float*)(F.ws + WS_MOD))
#define SEAM(k) do { if (IN(k) && IN((k) + 1)) xcd_barrier(bar); } while (0)

    if (IN(0)) { PB(); p0_prologue(args, F); } SEAM(0);
    if (IN(1)) { PB(); norm_mod_rows(args, F, AIN(0), AIN(4), 0, 1024, nullptr, F.ws + WS_H0); } SEAM(1);
    if (IN(2)) { PB(); pg8::StaticOrder S; S.init(M, NIN, F.G, (int)blockIdx.x); pg8::DenseSrcT<1> G{F.ws + WS_H0, F.ws + WS_WIN, 1024};
        EpiInProj E{ZB, GATES}; pg8::gemm_phase<EpiInProj, pg8::StaticOrder, pg8::DenseSrcT<1>>(F.lds, 1024, S, G, E); } SEAM(2);
    if (IN(3)) { PB(); rk::load_params(args, F); for (int u = blockIdx.x; u < 1024; u += F.G) rk::r1_unit(args, F, u >> 7, u & 127); __syncthreads(); } SEAM(3);
    if (IN(4)) { PB();
#ifdef PROBE_R2_DRY
        if (blockIdx.x < R2_WGS && F.wave < 128 / R2_WGS) rk::r2_task<1>(args, F, blockIdx.x * (128 / R2_WGS) + F.wave);
#endif
        if (blockIdx.x < R2_WGS && F.wave < 128 / R2_WGS) rk::r2_task<0>(args, F, blockIdx.x * (128 / R2_WGS) + F.wave);
#pragma unroll 1
        for (int rep = 0; rep < PROBE_IDX_REP; ++rep)
        {
#define IDX_POP(dst_) do { __syncthreads(); if (F.tid == 0) F.MISC[12] = atomicAdd(F.ctl + CW_Q + rep, 1u); __syncthreads(); dst_ = (int)F.MISC[12]; } while (0)
            int u, un; bool have0 = false; IDX_POP(u);
            while (u < 2048) { IDX_POP(un);
                indexer_unit(args, F, u & 7, (255 - (u >> 3)) * 16, have0, un < 2048 ? (un & 7) : -1);
                have0 = un < 2048; u = un; }
#undef IDX_POP
        } } SEAM(4);
    if (IN(5)) { PB(); if (!((PROBE_P5_PART & 2) && args.li == 1)) { for (int u = blockIdx.x; u < 1024; u += F.G) rk::r3_unit(args, F, u >> 7, u & 127); } __syncthreads();
        if (!((PROBE_P5_PART & 1) && args.li == 1)) for (int i = 0; i < 4; ++i) for (int uu = F.vcu; uu < 256; uu += F.G) { const int bh = uu >> 2, s = uu & 3; const int qb = (i == 0) ? s : (i == 1) ? 7 - s : (i == 2) ? 8 + s : 15 - s;
            att::attn_unit(args, F, bh >> 3, bh & 7, qb); } __syncthreads(); } SEAM(5);
    if (IN(6)) { PB(); pg8::StaticOrder S; S.init(M, D, F.G, (int)blockIdx.x);
        { pg8::DenseSrc G{F.ws + WS_R1, F.ws + WS_WA, 512}; EpiMerge<0> E{(bf16_t*)(F.ws + WS_R2), F.ws + WS_H0, GATES, PROBE_ATT_SCALE}; pg8::gemm_phase<EpiMerge<0>, pg8::StaticOrder, pg8::DenseSrc>(F.lds, 512, S, G, E); }
        { pg8::DenseSrc G{F.ws + WS_R0, F.ws + WS_WR, 512}; EpiMerge<1> E{(bf16_t*)(F.ws + WS_R2), F.ws + WS_H0, GATES, PROBE_RW_SCALE}; pg8::gemm_phase<EpiMerge<1>, pg8::StaticOrder, pg8::DenseSrc>(F.lds, 512, S, G, E); } } SEAM(6);
    if (IN(7)) { PB(); pg8::StaticOrder S; S.init(M, D, F.G, (int)blockIdx.x); pg8::DenseSrcT<1> G{F.ws + WS_H0, F.ws + WS_WO, 1024};
        EpiOutProj E{AIN(0), F.out, MOD}; pg8::gemm_phase<EpiOutProj, pg8::StaticOrder, pg8::DenseSrcT<1>>(F.lds, 1024, S, G, E); } SEAM(7);
    if (IN(8)) { PB(); norm2_route_convert(args, F); }
    if (IN(8) && IN(11)) xcd_barrier(bar);
    MoeTab mt{0, 0};
    if (lo <= 13 && hi > 13) { PB(); mt = build_tiles(args, F); scatter_phase(args, F); } else if (hi > 13) { PB(); mt = build_tiles(args, F); }
    SEAM(11);
    const LAS unsigned* tab = (const LAS unsigned*)(F.lds + LDS_TILETAB);
    if (IN(12)) { PB(); MoeSched1 S{tab, mt.ntiles, F.G, F.vcu};            MoeSrc1 G{F.ws};
        EpiMoe1 E{F.ws}; pg8::gemm_phase<EpiMoe1, MoeSched1, MoeSrc1>(F.lds, 1024, S, G, E); } SEAM(12);
    if (IN(13)) { PB(); MoeSched2 S{tab, 0, mt.ntiles, 512, F.G, F.vcu}; MoeSrc2 G{F.ws}; EpiMoe2 E; E.ws = F.ws; E.X1 = F.out; E.tokbase = 0;
        pg8::gemm_phase<EpiMoe2, MoeSched2, MoeSrc2>(F.lds, 256, S, G, E); } SEAM(13);
    if (IN(14)) { PB(); final_rows(args, F, 0, M, 0); }
#ifdef PROBE_CYC
    __syncthreads();
    if (blockIdx.x == 0 && F.tid == 0) { asm volatile("s_waitcnt vmcnt(0)" ::: "memory"); F.out[0] = (float)(F.ctl[CW_Q + 64]); }
#endif
#undef IN
#undef SEAM
#undef PB
}

extern "C" void kernel_launch(void* const* d_in, const int* in_sizes, int n_in, void* d_out, int out_size, void* d_ws, size_t ws_size, hipStream_t stream) {
    static int grid = 0;
    if (grid == 0) {
        if (n_in != 31 || out_size != M * D || ws_size < WS_END) { fprintf(stderr, "kernel_launch: unexpected problem (n_in %d, out %d, ws %zu)\n", n_in, out_size, ws_size); grid = -1; return; }
        int dev = 0, cus = 0, per_cu = 0;
        if (hipGetDevice(&dev) != hipSuccess || hipDeviceGetAttribute(&cus, hipDeviceAttributeMultiprocessorCount, dev) != hipSuccess) { grid = -1; return; }
        if (hipFuncSetAttribute((const void*)fwd_kernel, hipFuncAttributeMaxDynamicSharedMemorySize, LDS_BYTES) != hipSuccess) { fprintf(stderr, "kernel_launch: hipFuncSetAttribute failed\n"); grid = -1; return; }
        if (hipOccupancyMaxActiveBlocksPerMultiprocessor(&per_cu, (const void*)fwd_kernel, NTHR, LDS_BYTES) != hipSuccess || per_cu < 1) fprintf(stderr, "kernel_launch: occupancy query reports %d\n", per_cu);
        (void)hipGetLastError();
        grid = cus;
        if (grid != 256) fprintf(stderr, "kernel_launch: %d CUs (built for 256)\n", grid);
    }
    if (grid < 0) return;
    (void)in_sizes;
    if (hipMemsetAsync((char*)d_ws + WS_CTL, 0, CTL_ZERO_BYTES, stream) != hipSuccess) return;
    Args a{};
    for (int i = 0; i < 31; ++i) a.in[i] = (const float*)d_in[i];
    a.out = (float*)d_out; a.ws = (unsigned char*)d_ws;
#ifndef PROBE_REPEAT
#define PROBE_REPEAT -1
#endif
    int li = 0;
    auto go = [&](int lo_, int hi_) { a.ph_lo = lo_; a.ph_hi = hi_; a.li = li++; hipLaunchKernelGGL(fwd_kernel, dim3(grid), dim3(NTHR), LDS_BYTES, stream, a); };
    if (PROBE_REPEAT < 0) go(0, N_PHASES);
    else { go(0, PROBE_REPEAT + 1); go(PROBE_REPEAT, PROBE_REPEAT + 1); if (PROBE_REPEAT + 1 < N_PHASES) go(PROBE_REPEAT + 1, N_PHASES); }
}
```

```cpp
#include <hip/hip_runtime.h>
#include <cstdio>
#include <cstdint>
#include <cmath>

#define GAS __attribute__((address_space(1)))
#define LAS __attribute__((address_space(3)))
typedef unsigned short bf16_t;
typedef short bf16x8 __attribute__((ext_vector_type(8)));
typedef float f32x4 __attribute__((ext_vector_type(4)));
typedef float f32x2 __attribute__((ext_vector_type(2)));
typedef float f32x16 __attribute__((ext_vector_type(16)));
typedef unsigned u32x4 __attribute__((ext_vector_type(4)));
typedef unsigned u32x2 __attribute__((ext_vector_type(2)));
typedef GAS unsigned gu32;

__device__ __forceinline__ unsigned cvt_pk_bf16(float lo, float hi) { unsigned r; asm volatile("v_cvt_pk_bf16_f32 %0, %1, %2" : "=v"(r) : "v"(lo), "v"(hi)); return r; }
__device__ __forceinline__ float bf_lo(unsigned w) { return __uint_as_float(w << 16); }
__device__ __forceinline__ float bf_hi(unsigned w) { return __uint_as_float(w & 0xffff0000u); }
__device__ __forceinline__ float bf2f(bf16_t b) { return __uint_as_float(((unsigned)b) << 16); }
__device__ __forceinline__ unsigned f2bf(float f) { unsigned u = __float_as_uint(f); return (u + 0x7fffu + ((u >> 16) & 1u)) >> 16; }
__device__ __forceinline__ unsigned pk2(float lo, float hi) { return f2bf(lo) | (f2bf(hi) << 16); }
__device__ __forceinline__ float fast_sigmoid(float x) { return __builtin_amdgcn_rcpf(1.0f + __builtin_amdgcn_exp2f(-1.4426950408889634f * x)); }
__device__ __forceinline__ float wave_sum(float v) {
#pragma unroll
    for (int o = 1; o < 64; o <<= 1) v += __shfl_xor(v, o);
    return v;
}

namespace pg8 {
constexpr int BM = 256, BK = 64, HALF = 128, HTB = HALF * BK * 2, STAGE_BYTES = 8 * HTB, NXCD = 8, WGM = 8;
__host__ __device__ __forceinline__ int lds_byte(int r, int c) { const int st = (r >> 4) * 2 + (c >> 5), rr = r & 15, cc = c & 31, ob = rr * 64 + cc * 2; return st * 1024 + (ob ^ (((ob >> 9) & 1) << 5)); }
__host__ __device__ __forceinline__ void stage_rc(int b, int& R, int& C) { const int st = b / 1024, sb = b % 1024, swz = sb ^ (((sb >> 9) & 1) << 5); R = (st >> 1) * 16 + swz / 64; C = (st & 1) * 32 + (swz % 64) / 2; }
__host__ __device__ __forceinline__ int perm32(int rho) { const int n = rho >> 4, i = rho & 15; return 8 * (i >> 2) + 4 * n + (i & 3); }

struct Unit { int pm, pn; int aux0, aux1; };

struct StaticOrder {
    int nM, nN, nwg, G, c;
    __host__ __device__ void init(int M, int N, int G_, int c_) { nM = M / BM; nN = N / BM; nwg = nM * nN; G = G_; c = c_; }
    __host__ __device__ bool next(int i, Unit& u) const {
        const long L = (long)i * G + c; if (L >= nwg) return false;
        int wgid = (int)L; { const int q = nwg / NXCD, r = nwg % NXCD, xcd = wgid % NXCD, off = wgid / NXCD; wgid = (xcd < r ? xcd * (q + 1) : r * (q + 1) + (xcd - r) * q) + off; }
        const int nig = WGM * nN, gid = wgid / nig, fm = gid * WGM, gsz = (nM - fm) < WGM ? (nM - fm) : WGM;
        u.pm = fm + ((wgid % nig) % gsz); u.pn = (wgid % nig) / gsz; u.aux0 = 0; u.aux1 = 0; return true;
    }
};

template <int ESZ_> struct DenseSrcT {
    static constexpr int ESZ = ESZ_; static constexpr bool GATHER = false;
    const void* A; const void* Bt; int K;
    __device__ __forceinline__ const char* b_base(const Unit& u) const { return (const char*)Bt + (size_t)u.pn * 256 * K * ESZ; }
    __device__ __forceinline__ const char* a_base(const Unit& u) const { return (const char*)A + (size_t)u.pm * 256 * K * ESZ; }
    __device__ __forceinline__ unsigned a_off(const Unit&, int R, int C) const { return (unsigned)(R * K * ESZ) + (unsigned)C * 2u; }
};
typedef DenseSrcT<2> DenseSrc;
typedef int v8i32 __attribute__((ext_vector_type(8)));

template <class T, class = void> struct has_prefetch { static constexpr bool value = false; };
template <class T> struct has_prefetch<T, decltype((void)&T::prefetch)> { static constexpr bool value = true; };
template <class Epi, class Sched, class Src, bool ALIGN_EPI = true>
__device__ __forceinline__ void gemm_phase(LAS unsigned char* lds, const int K, const Sched& S, const Src& G, const Epi& E) {
    const int tid = threadIdx.x, wid = __builtin_amdgcn_readfirstlane(tid >> 6), lane = tid & 63, wr = wid >> 2, wc = wid & 3, fr = lane & 15, fq = lane >> 4;
    constexpr int ESZ = Src::ESZ; const int Kb = K * ESZ;
    const int nt = Kb / (BK * 2);
    unsigned voffB0;
    { int R, C; stage_rc(tid * 16, R, C); const int Rb = Epi::PERM ? ((R & ~31) + perm32(R & 31)) : R; voffB0 = (unsigned)(Rb * Kb) + (unsigned)C * 2u; }
#define PG8_AOFF(u, h, i) ([&]() { int R_, C_; stage_rc(tid * 16 + (i) * 8192, R_, C_); return G.a_off((u), R_ + (h) * HALF, C_); }())
    const size_t kstep = (size_t)(BK * 2);
    const size_t hstepB = (size_t)HALF * Kb;
    const unsigned ldsw = (unsigned)wid * 1024u;
    const int aoff = lds_byte(wr * 64 + fr, fq * 8), boff = lds_byte(wc * 32 + fr, fq * 8);
#define PG8_SA(b, h) (((b) * 2 + (h)) * HTB)
#define PG8_SB(b, h) ((4 + (b) * 2 + (h)) * HTB)
#define PG8_STAGEB(bufoff, gbase) do { _Pragma("unroll") for (int _i = 0; _i < 2; ++_i) { unsigned o_ = voffB0; asm volatile("" : "+v"(o_)); \
        __builtin_amdgcn_global_load_lds((const unsigned*)((const char*)(gbase) + (size_t)_i * 64 * Kb + o_), (LAS unsigned*)(lds + (bufoff) + ldsw + _i * 8192), 16, 0, 0); } } while (0)
#define PG8_STAGEA(bufoff, gbase, vo, h) do { _Pragma("unroll") for (int _i = 0; _i < 2; ++_i) { unsigned o_ = Src::GATHER ? (vo)[h][_i] : (vo)[0][0]; asm volatile("" : "+v"(o_)); \
        __builtin_amdgcn_global_load_lds((const unsigned*)((const char*)(gbase) + (Src::GATHER ? (size_t)0 : (size_t)((h) * 128 + _i * 64) * Kb) + o_), (LAS unsigned*)(lds + (bufoff) + ldsw + _i * 8192), 16, 0, 0); } } while (0)
#define PG8_STAGEA2(bufoff, gbase, h) do { _Pragma("unroll") for (int _i = 0; _i < 2; ++_i) { unsigned o_ = Src::GATHER ? (last ? vn[h][_i] : vc[h][_i]) : vc[0][0]; asm volatile("" : "+v"(o_)); \
        __builtin_amdgcn_global_load_lds((const unsigned*)((const char*)(gbase) + (Src::GATHER ? (size_t)0 : (size_t)((h) * 128 + _i * 64) * Kb) + o_), (LAS unsigned*)(lds + (bufoff) + ldsw + _i * 8192), 16, 0, 0); } } while (0)
#define PG8_LDA(dst, b, h) do { _Pragma("unroll") for (int m = 0; m < 4; ++m) { const u32x4 lo_ = *(const LAS u32x4*)(lds + PG8_SA(b, h) + aoff + m * 2048), hi_ = *(const LAS u32x4*)(lds + PG8_SA(b, h) + aoff + m * 2048 + 1024); \
        dst[m] = __builtin_shufflevector(lo_, hi_, 0, 1, 2, 3, 4, 5, 6, 7); } } while (0)
#define PG8_LDB(dst, b, h) do { _Pragma("unroll") for (int n = 0; n < 2; ++n) { const u32x4 lo_ = *(const LAS u32x4*)(lds + PG8_SB(b, h) + boff + n * 2048), hi_ = *(const LAS u32x4*)(lds + PG8_SB(b, h) + boff + n * 2048 + 1024); \
        dst[n] = __builtin_shufflevector(lo_, hi_, 0, 1, 2, 3, 4, 5, 6, 7); } } while (0)
#define PG8_LO(x) __builtin_bit_cast(bf16x8, __builtin_shufflevector((x), (x), 0, 1, 2, 3))
#define PG8_HI(x) __builtin_bit_cast(bf16x8, __builtin_shufflevector((x), (x), 4, 5, 6, 7))
#define PG8_MMA(ai, bj, At, Bt) do { __builtin_amdgcn_s_setprio(1); _Pragma("unroll") for (int m = 0; m < 4; ++m) _Pragma("unroll") for (int n = 0; n < 2; ++n) { \
        if constexpr (ESZ == 1) acc[ai][bj][m][n] = __builtin_amdgcn_mfma_scale_f32_16x16x128_f8f6f4(__builtin_bit_cast(v8i32, Bt[n]), __builtin_bit_cast(v8i32, At[m]), acc[ai][bj][m][n], 0, 0, 0, 0, 0, 0); \
        else { acc[ai][bj][m][n] = __builtin_amdgcn_mfma_f32_16x16x32_bf16(PG8_LO(Bt[n]), PG8_LO(At[m]), acc[ai][bj][m][n], 0, 0, 0); \
               acc[ai][bj][m][n] = __builtin_amdgcn_mfma_f32_16x16x32_bf16(PG8_HI(Bt[n]), PG8_HI(At[m]), acc[ai][bj][m][n], 0, 0, 0); } } \
        __builtin_amdgcn_s_setprio(0); } while (0)
#define PG8_WAIT_V(n) asm volatile("s_waitcnt vmcnt(" #n ")" ::: "memory")
#define PG8_WAIT_L(n) asm volatile("s_waitcnt lgkmcnt(" #n ")" ::: "memory")
#define PG8_BAR __builtin_amdgcn_s_barrier()
#define PG8_SCHED __builtin_amdgcn_sched_barrier(0)
    Unit cur, nxt; int ui = 0;
    if (!S.next(0, cur)) return;
#define PG8_PREFETCH(u_) do { if constexpr (has_prefetch<Epi>::value) { int ln_; asm volatile("v_mbcnt_lo_u32_b32 %0, -1, 0\n\tv_mbcnt_hi_u32_b32 %0, -1, %0" : "=v"(ln_)); E.prefetch((u_), wr, ln_ & 15); } } while (0)
    PG8_PREFETCH(cur);
    f32x4 acc[2][2][4][2];
#pragma unroll
    for (int a = 0; a < 2; ++a)
#pragma unroll
        for (int b = 0; b < 2; ++b)
#pragma unroll
            for (int m = 0; m < 4; ++m)
#pragma unroll
                for (int n = 0; n < 2; ++n) acc[a][b][m][n] = (f32x4){0.f, 0.f, 0.f, 0.f};
    typedef unsigned u32x8 __attribute__((ext_vector_type(8)));
    u32x8 At[4], B0[2], B1[2];
    unsigned vc[2][2], vn[2][2];
#pragma unroll
    for (int h = 0; h < 2; ++h)
#pragma unroll
        for (int i = 0; i < 2; ++i) vc[h][i] = PG8_AOFF(cur, h, i);
    const char* cA = G.a_base(cur); const char* cB = G.b_base(cur);
    PG8_STAGEB(PG8_SB(0, 0), cB); PG8_STAGEB(PG8_SB(0, 1), cB + hstepB); PG8_STAGEA(PG8_SA(0, 0), cA, vc, 0); PG8_STAGEA(PG8_SA(0, 1), cA, vc, 1);
    if (wr == 1) PG8_BAR;
    PG8_WAIT_V(2); PG8_BAR;
    PG8_STAGEB(PG8_SB(1, 0), cB + kstep); PG8_STAGEA(PG8_SA(1, 0), cA + kstep, vc, 0); PG8_STAGEB(PG8_SB(1, 1), cB + hstepB + kstep);
    PG8_WAIT_V(6); PG8_BAR;
    for (;;) {
        const bool has_next = S.next(ui + 1, nxt);
        const char* nA = has_next ? G.a_base(nxt) : cA; const char* nB = has_next ? G.b_base(nxt) : cB;
        if constexpr (Src::GATHER) {
#pragma unroll
        for (int h = 0; h < 2; ++h)
#pragma unroll
            for (int i = 0; i < 2; ++i) vn[h][i] = has_next ? PG8_AOFF(nxt, h, i) : vc[h][i]; }
#pragma clang loop unroll(disable)
        for (int t = 0; t < nt; t += 2) {
            const bool last = (t == nt - 2);
            const char* a1 = cA + (size_t)(t + 1) * kstep;
            const char* a2 = last ? nA : cA + (size_t)(t + 2) * kstep; const char* b2 = last ? nB : cB + (size_t)(t + 2) * kstep;
            const char* a3 = a2 + kstep; const char* b3 = b2 + kstep;
            PG8_LDB(B0, 0, 0); PG8_LDB(B1, 0, 1); PG8_SCHED; PG8_LDA(At, 0, 0); PG8_STAGEA(PG8_SA(1, 1), a1, vc, 1);
            PG8_WAIT_V(8); PG8_WAIT_L(0); PG8_BAR; PG8_MMA(0, 0, At, B0); PG8_MMA(0, 1, At, B1); PG8_BAR; PG8_SCHED;
            PG8_LDA(At, 0, 1); PG8_STAGEB(PG8_SB(0, 0), b2); PG8_STAGEB(PG8_SB(0, 1), b2 + hstepB); PG8_STAGEA2(PG8_SA(0, 0), a2, 0);
            PG8_WAIT_V(8); PG8_WAIT_L(0); PG8_BAR; PG8_MMA(1, 0, At, B0); PG8_MMA(1, 1, At, B1); PG8_BAR; PG8_SCHED;
            PG8_LDB(B0, 1, 0); PG8_LDB(B1, 1, 1); PG8_SCHED; PG8_LDA(At, 1, 0); PG8_STAGEA2(PG8_SA(0, 1), a2, 1);
            PG8_WAIT_V(8); PG8_WAIT_L(0); PG8_BAR; PG8_MMA(0, 0, At, B0); PG8_MMA(0, 1, At, B1); PG8_BAR; PG8_SCHED;
            PG8_LDA(At, 1, 1); PG8_STAGEB(PG8_SB(1, 0), b3); PG8_STAGEB(PG8_SB(1, 1), b3 + hstepB); PG8_STAGEA2(PG8_SA(1, 0), a3, 0);
            PG8_WAIT_V(8); PG8_WAIT_L(0); PG8_BAR; PG8_MMA(1, 0, At, B0); PG8_MMA(1, 1, At, B1); PG8_BAR; PG8_SCHED;
        }
        if constexpr (ALIGN_EPI) { if (wr == 0) PG8_BAR; }
        { int ln_; asm volatile("v_mbcnt_lo_u32_b32 %0, -1, 0\n\tv_mbcnt_hi_u32_b32 %0, -1, %0" : "=v"(ln_)); E(acc, cur, wr, wc, ln_ & 15, ln_ >> 4); }
        if (!has_next) break;
#pragma unroll
        for (int a = 0; a < 2; ++a)
#pragma unroll
            for (int b = 0; b < 2; ++b)
#pragma unroll
                for (int m = 0; m < 4; ++m)
#pragma unroll
                    for (int n = 0; n < 2; ++n) acc[a][b][m][n] = (f32x4){0.f, 0.f, 0.f, 0.f};
        cur = nxt; cA = nA; cB = nB; ++ui;
        PG8_PREFETCH(cur);
        if constexpr (Src::GATHER) {
#pragma unroll
        for (int h = 0; h < 2; ++h)
#pragma unroll
            for (int i = 0; i < 2; ++i) vc[h][i] = vn[h][i]; }
        if constexpr (ALIGN_EPI) { if (wr == 1) PG8_BAR; }
    }
    PG8_WAIT_V(0);
    if constexpr (!ALIGN_EPI) { if (wr == 0) PG8_BAR; }
    PG8_BAR;
#undef PG8_PREFETCH
#undef PG8_SA
#undef PG8_AOFF
#undef PG8_SB
#undef PG8_STAGEA
#undef PG8_STAGEA2
#undef PG8_STAGEB
#undef PG8_LDA
#undef PG8_LDB
#undef PG8_MMA
#undef PG8_LO
#undef PG8_HI
#undef PG8_WAIT_V
#undef PG8_WAIT_L
#undef PG8_BAR
#undef PG8_SCHED
}
}
#define RLX_AGENT __ATOMIC_RELAXED, __HIP_MEMORY_SCOPE_AGENT
#define LDS_WAIT() asm volatile("s_waitcnt lgkmcnt(0)" ::: "memory")
#define VM_WAIT() asm volatile("s_waitcnt vmcnt(0)" ::: "memory")
#define XB_TMO      128
#define XB_XCNT(j)  (256  + 64 * (j))
#define XB_XSUB(j)  (1280 + 64 * (j))
#define XB_XGEN(j)  (2304 + 64 * (j))
#define XB_TOP      3328
#define XB_TOPGEN   3392
#define XCD_BAR_WORDS 3456
#define XB_SPIN_CAP (1u << 18)

__device__ __forceinline__ unsigned xb_ld(unsigned* p)              { return __hip_atomic_load(p, __ATOMIC_RELAXED, __HIP_MEMORY_SCOPE_AGENT); }
__device__ __forceinline__ unsigned xb_add(unsigned* p, unsigned v) { return __hip_atomic_fetch_add(p, v, __ATOMIC_RELAXED, __HIP_MEMORY_SCOPE_AGENT); }
__device__ __forceinline__ unsigned xb_xcc_id() { return (unsigned)__builtin_amdgcn_s_getreg((3 << 11) | 20) & 0xFu; }
#define XB_SPIN(cond, bar) do { unsigned _sp = 0; while (cond) { __builtin_amdgcn_s_sleep(1); \
    if ((++_sp & 255u) == 0u) { if (xb_ld(&(bar)[XB_TMO])) break; if (_sp > XB_SPIN_CAP) { atomicAdd(&(bar)[XB_TMO], 1u); break; } } } } while (0)

struct XcdBarrier {
    unsigned* bar; unsigned x;
    volatile LAS unsigned* st;
};

__device__ __forceinline__ XcdBarrier xcd_barrier_post(unsigned* bar, volatile LAS unsigned* st) {
    XcdBarrier b; b.bar = bar; b.x = xb_xcc_id(); b.st = st;
    if (threadIdx.x == 0) (void)xb_add(&bar[XB_XCNT(b.x)], 1u);
    return b;
}
__device__ __forceinline__ void xcd_barrier_complete(unsigned* bar, unsigned x, unsigned& nloc, unsigned& nx) {
    const unsigned G = gridDim.x * gridDim.y * gridDim.z;
    unsigned sum, cnt, mine, sp = 0u;
    for (;;) {
        sum = 0u; cnt = 0u; mine = 0u;
#pragma unroll
        for (unsigned j = 0; j < 16; ++j) { const unsigned c = xb_ld(&bar[XB_XCNT(j)]); sum += c; cnt += (c > 0u) ? 1u : 0u; mine = (j == x) ? c : mine; }
        if (sum == G) break;
        __builtin_amdgcn_s_sleep(1);
        if ((++sp & 255u) == 0u) { if (xb_ld(&bar[XB_TMO])) break; if (sp > XB_SPIN_CAP) { atomicAdd(&bar[XB_TMO], 1u); break; } }
    }
    nloc = mine > 0u ? mine : 1u; nx = cnt > 0u ? cnt : 1u;
}

__device__ __forceinline__ void xcd_barrier(const XcdBarrier& b) {
    asm volatile("s_waitcnt vmcnt(0)" ::: "memory");
    __syncthreads();
    if (threadIdx.x == 0) {
        unsigned* bar = b.bar;
        __builtin_amdgcn_s_waitcnt(0);
        unsigned nloc = b.st[0], nx = b.st[1];
        if (nloc == 0u) { xcd_barrier_complete(bar, b.x, nloc, nx); b.st[0] = nloc; b.st[1] = nx; }
        const unsigned old = xb_add(&bar[XB_XSUB(b.x)], 1u);
        const unsigned gen = old / nloc;
        if (old + 1u == (gen + 1u) * nloc) {
            __builtin_amdgcn_fence(__ATOMIC_RELEASE, "agent");
            asm volatile("s_waitcnt vmcnt(0)" ::: "memory");
            const unsigned og = xb_add(&bar[XB_TOP], 1u);
            const unsigned tg = og / nx;
            if (og + 1u == (tg + 1u) * nx) xb_add(&bar[XB_TOPGEN], 1u);
            else XB_SPIN(xb_ld(&bar[XB_TOPGEN]) == tg, bar);
            __builtin_amdgcn_fence(__ATOMIC_ACQUIRE, "agent");
            xb_add(&bar[XB_XGEN(b.x)], 1u);
            asm volatile("s_waitcnt vmcnt(0)" ::: "memory");
        } else {
            XB_SPIN(xb_ld(&bar[XB_XGEN(b.x)]) == gen, bar);
            __builtin_amdgcn_fence(__ATOMIC_ACQUIRE, "agent");
            asm volatile("s_waitcnt vmcnt(0)" ::: "memory");
        }
    }
    __syncthreads();
}
constexpr int NB = 8, SEQ = 4096, D = 1024, M = NB * SEQ;
constexpr int NIN_SRC = 5936, NIN = 6144;
constexpr int ZW = 4096;
constexpr int ZQ = 0, ZK = 512, ZV = 1024, ZIQ = 1536, ZIK = 2048, ZIW = 2080, ZR = 2304;
constexpr int ZR_R = ZR, ZR_K = ZR + 512, ZR_V = ZR + 1024, ZR_WD = ZR + 1536, ZR_AD = ZR + 1600, ZR_GD = ZR + 1664;
constexpr int GW = 2048;
constexpr int NEXP = 64, FF = 256, TOPK = 8;
constexpr float RMS_EPS = 1e-6f, GN_EPS = 64e-5f;
constexpr float QSCALE = 0.125f * 1.4426950408889634f;
constexpr int NWAVES = 8, NTHR = 512;

constexpr size_t MiB = 1u << 20;
constexpr size_t WS_CTL = 0, CTL_ZERO_BYTES = 1 * MiB;
constexpr size_t WS_MOD = 1 * MiB;
constexpr size_t WS_DUT = 1 * MiB + 256 * 1024;
constexpr size_t WS_IUT = WS_DUT + 64 * 1024;
constexpr size_t WS_GUT = WS_IUT + 64 * 1024;
constexpr size_t WS_WIN = 2 * MiB;
constexpr size_t WS_WA = 14 * MiB, WS_WR = 15 * MiB;
constexpr size_t WS_WO = 16 * MiB;
constexpr size_t WS_WRT = 18 * MiB;
constexpr size_t WS_WSH1 = 19 * MiB;
constexpr size_t WS_WSH2 = 20 * MiB;
constexpr size_t WS_BRS = 21 * MiB, WS_KRS = 22 * MiB;
constexpr size_t WS_TOPE = 23 * MiB, WS_TOPW = 24 * MiB;
constexpr size_t WS_LOGIT = 25 * MiB;
constexpr size_t WS_Z = 36 * MiB;
constexpr size_t WS_H0 = 292 * MiB, WS_H1 = 324 * MiB;
constexpr size_t WS_SEL = 356 * MiB;
constexpr size_t WS_R0 = 372 * MiB, WS_R1 = 404 * MiB, WS_R2 = 436 * MiB, WS_R3 = 468 * MiB;
constexpr size_t WS_W2T = 36 * MiB;
constexpr size_t WS_ACT = 68 * MiB;
constexpr size_t WS_ACTS = 196 * MiB;
constexpr size_t WS_STOK = 212 * MiB, WS_SW = 213 * MiB;
constexpr size_t WS_W1T = 214 * MiB;
constexpr size_t WS_H2 = 278 * MiB;
constexpr size_t WS_SLOT = 214 * MiB;
constexpr size_t WS_END = 502 * MiB;
constexpr int CW_TMO = 0, CW_BAR = 4096, CW_CNT = 32768, CW_CUR = 32768 + 128, CW_Q = 32768 + 512;

constexpr int RING_BYTES = 131072;
constexpr int LDSCTL_OFF = RING_BYTES, MISC_OFF = LDSCTL_OFF + 320;
constexpr int LDS_TILETAB = RING_BYTES + 1024;
constexpr int LDS_PTAB = RING_BYTES + 512;
constexpr int LDS_PARA = 118800;
constexpr int LDS_PARB = LDS_TILETAB;
constexpr int LDS_BYTES = 147456;
#define AIN(i) ain_ptr(F.lds, (i))

struct Args { const float* in[31]; float* out; unsigned char* ws; int ph_lo, ph_hi, li, pad; };
struct Frame {
    LAS unsigned char* lds;
    volatile LAS unsigned* MISC;
    unsigned* ctl;
    int tid, lane, wave, vcu, G, gw, NGW;
    float* out; unsigned char* ws;
};

__device__ __forceinline__ const float* ain_ptr(LAS unsigned char* lds, int i) {
    const u32x2 w = *(const LAS u32x2*)(lds + LDS_PTAB + 8 * i);
    const unsigned lo = (unsigned)__builtin_amdgcn_readfirstlane((int)w.x), hi = (unsigned)__builtin_amdgcn_readfirstlane((int)w.y);
    return (const float*)(const GAS float*)(((unsigned long long)hi << 32) | lo);
}
struct TrSrc { const float* base; int nsrc; };
template <int FP8, class ColFn>
__device__ __forceinline__ void transpose_item(const ColFn& colfn, int K, bf16_t* WT, LAS float* scr, int kb, int nb, int lane) {
    const int k0 = 64 * kb, n0 = 32 * nb;
    const TrSrc s = colfn(n0 + (lane & 31));
    float v_[32];
#pragma unroll
    for (int i = 0; i < 32; ++i) { const int kk = 2 * i + (lane >> 5); v_[i] = s.base ? s.base[(size_t)(k0 + kk) * s.nsrc] : 0.f; }
#pragma unroll
    for (int i = 0; i < 32; ++i) { const int kk = 2 * i + (lane >> 5); scr[kk * 33 + (lane & 31)] = v_[i]; }
    LDS_WAIT(); asm volatile("" ::: "memory");
    const int c = lane & 7;
#pragma unroll
    for (int j = 0; j < 4; ++j) { const int n = (lane >> 3) + 8 * j; const LAS float* sp = scr + (8 * c) * 33 + n;
        if constexpr (FP8) { constexpr float S8 = 32.0f;
            int lo = __builtin_amdgcn_cvt_pk_fp8_f32(sp[0 * 33] * S8, sp[1 * 33] * S8, 0, false); lo = __builtin_amdgcn_cvt_pk_fp8_f32(sp[2 * 33] * S8, sp[3 * 33] * S8, lo, true);
            int hi = __builtin_amdgcn_cvt_pk_fp8_f32(sp[4 * 33] * S8, sp[5 * 33] * S8, 0, false); hi = __builtin_amdgcn_cvt_pk_fp8_f32(sp[6 * 33] * S8, sp[7 * 33] * S8, hi, true);
            *(GAS u32x2*)((unsigned char*)WT + (size_t)(n0 + n) * K + k0 + 8 * c) = (u32x2){(unsigned)lo, (unsigned)hi}; }
        else { u32x4 o; o.x = pk2(sp[0 * 33], sp[1 * 33]); o.y = pk2(sp[2 * 33], sp[3 * 33]); o.z = pk2(sp[4 * 33], sp[5 * 33]); o.w = pk2(sp[6 * 33], sp[7 * 33]);
            *(GAS u32x4*)(WT + (size_t)(n0 + n) * K + k0 + 8 * c) = o; } }
    LDS_WAIT(); asm volatile("" ::: "memory");
}

__device__ __forceinline__ void p0_mod(const Args& args, Frame& F, int task) {
    LAS float* sc = (LAS float*)F.lds;
    LAS float* red = (LAS float*)(F.lds + 32768);
    const float* c = AIN(1);
    for (int i = F.tid; i < 8192; i += NTHR) { const float v = c[i]; sc[i] = v * fast_sigmoid(v); }
    __syncthreads();
    const float* aw = AIN(2) + 64 * task + F.lane;
    float acc[8];
#pragma unroll
    for (int b = 0; b < 8; ++b) acc[b] = 0.f;
    const int kb = 128 * F.wave;
#pragma unroll 1
    for (int k0 = 0; k0 < 128; k0 += 16) { float a_[16];
#pragma unroll
        for (int k = 0; k < 16; ++k) a_[k] = aw[(size_t)(kb + k0 + k) * 6144];
#pragma unroll
        for (int k = 0; k < 16; ++k) {
#pragma unroll
            for (int b = 0; b < 8; ++b) acc[b] += sc[b * 1024 + kb + k0 + k] * a_[k];
            if ((k & 3) == 3) asm volatile("" ::: "memory"); } }
#pragma unroll
    for (int b = 0; b < 8; ++b) red[(F.wave * 8 + b) * 64 + F.lane] = acc[b];
    __syncthreads();
    { const int b = F.wave; float s = AIN(3)[64 * task + F.lane];
#pragma unroll
      for (int w = 0; w < 8; ++w) s += red[(w * 8 + b) * 64 + F.lane];
      ((float*)(F.ws + WS_MOD))[b * 6144 + 64 * task + F.lane] = s; }
    __syncthreads();
}

__device__ __forceinline__ void p0_prologue(const Args& args, Frame& F) {
    if (blockIdx.x < 96) p0_mod(args, F, blockIdx.x);
    LAS float* scr = (LAS float*)(F.lds + F.wave * 16384);
    bf16_t* const ws16 = (bf16_t*)F.ws;
    constexpr int I_WIN = 16 * 192, I_WA = 8 * 32, I_WO = 16 * 32, I_WRT = 16 * 8, I_SH1 = 16 * 16, I_SH2 = 4 * 32, I_DU = 16, I_GU = 32;
    constexpr int NIT = I_WIN + 2 * I_WA + I_WO + I_WRT + I_SH1 + I_SH2 + 2 * I_DU + I_GU;
    for (int it = F.gw; it < NIT; it += F.NGW) {
        int r = it;
        if (r < I_WIN) { const float* w = AIN(5);
            transpose_item<1>([=](int n) { TrSrc s; const bool ok = (n < 2096) || (n >= 2304); const int col = n < 2096 ? n : n - 208; s.base = ok ? w + col : nullptr; s.nsrc = NIN_SRC; return s; },
                           1024, (bf16_t*)(F.ws + WS_WIN), scr, r / 192, r % 192, F.lane); continue; } r -= I_WIN;
        if (r < I_WA) { const float* w = AIN(18); transpose_item<0>([=](int n) { TrSrc s; s.base = w + n; s.nsrc = 1024; return s; }, 512, (bf16_t*)(F.ws + WS_WA), scr, r / 32, r % 32, F.lane); continue; } r -= I_WA;
        if (r < I_WA) { const float* w = AIN(19); transpose_item<0>([=](int n) { TrSrc s; s.base = w + n; s.nsrc = 1024; return s; }, 512, (bf16_t*)(F.ws + WS_WR), scr, r / 32, r % 32, F.lane); continue; } r -= I_WA;
        if (r < I_WO) { const float* w = AIN(20); transpose_item<1>([=](int n) { TrSrc s; s.base = w + n; s.nsrc = 1024; return s; }, 1024, (bf16_t*)(F.ws + WS_WO), scr, r / 32, r % 32, F.lane); continue; } r -= I_WO;
        if (r < I_WRT) { const float* w = AIN(22); transpose_item<0>([=](int n) { TrSrc s; s.base = n < 64 ? w + n : nullptr; s.nsrc = 64; return s; }, 1024, (bf16_t*)(F.ws + WS_WRT), scr, r / 8, r % 8, F.lane); continue; } r -= I_WRT;
        if (r < I_SH1) { const float* wg = AIN(27); const float* wu = AIN(28);
            transpose_item<0>([=](int n) { TrSrc s; const int j = n >> 8, sel = (n >> 7) & 1, cc = n & 127; s.base = (sel ? wu : wg) + 128 * j + cc; s.nsrc = 256; return s; }, 1024, (bf16_t*)(F.ws + WS_WSH1), scr, r / 16, r % 16, F.lane); continue; } r -= I_SH1;
        if (r < I_SH2) { const float* w = AIN(29); transpose_item<0>([=](int n) { TrSrc s; s.base = w + n; s.nsrc = 1024; return s; }, 256, (bf16_t*)(F.ws + WS_WSH2), scr, r / 32, r % 32, F.lane); continue; } r -= I_SH2;
        if (r < I_DU) { const float* w = AIN(9); transpose_item<0>([=](int n) { TrSrc s; s.base = w + n; s.nsrc = 512; return s; }, 64, (bf16_t*)(F.ws + WS_DUT), scr, 0, r, F.lane); continue; } r -= I_DU;
        if (r < I_DU) { const float* w = AIN(11); transpose_item<0>([=](int n) { TrSrc s; s.base = w + n; s.nsrc = 512; return s; }, 64, (bf16_t*)(F.ws + WS_IUT), scr, 0, r, F.lane); continue; } r -= I_DU;
        { const float* w = AIN(12); transpose_item<0>([=](int n) { TrSrc s; s.base = w + n; s.nsrc = 512; return s; }, 128, (bf16_t*)(F.ws + WS_GUT), scr, r / 16, r % 16, F.lane); }
    }
    (void)ws16;
}

__device__ __forceinline__ void convert_experts(const Args& args, Frame& F, int k0, int k1) {
    LAS float* scr = (LAS float*)(F.lds + F.wave * 16384);
    constexpr int I1 = 16 * 16, I2 = 4 * 32, PER = I1 + I2, NIT = 64 * PER;
    for (int k = k0; k < k1; ++k) { const int it = F.gw + k * F.NGW; if (it >= NIT) break;
        const int e = it / PER; int r = it % PER;
        if (r < I1) { const float* wg = AIN(24) + (size_t)e * 1024 * 256; const float* wu = AIN(25) + (size_t)e * 1024 * 256;
            transpose_item<0>([=](int n) { TrSrc s; const int j = n >> 8, sel = (n >> 7) & 1, cc = n & 127; s.base = (sel ? wu : wg) + 128 * j + cc; s.nsrc = 256; return s; }, 1024, (bf16_t*)(F.ws + WS_W1T) + (size_t)e * 512 * 1024, scr, r / 16, r % 16, F.lane); }
        else { r -= I1; const float* w = AIN(26) + (size_t)e * 256 * 1024;
            transpose_item<0>([=](int n) { TrSrc s; s.base = w + n; s.nsrc = 1024; return s; }, 256, (bf16_t*)(F.ws + WS_W2T) + (size_t)e * 1024 * 256, scr, r / 32, r % 32, F.lane); }
    }
}

__device__ __forceinline__ void norm_mod_rows(const Args& args, Frame& F, const float* X, const float* g, int sh_off, int sc_off, bf16_t* O, unsigned char* O8) {
    const int row0 = F.gw * 16, b = row0 / SEQ;
    const float* mod = (const float*)(F.ws + WS_MOD) + b * 6144;
    f32x4 mul[4], add[4];
#pragma unroll
    for (int j = 0; j < 4; ++j) { const int c = 4 * F.lane + 256 * j; const f32x4 gv = *(const f32x4*)(g + c), sc = *(const f32x4*)(mod + sc_off + c); add[j] = *(const f32x4*)(mod + sh_off + c); mul[j] = gv * (sc + 1.0f); }
    for (int r0 = 0; r0 < 16; r0 += 4) {
        f32x4 v[4][4]; float s[4];
#pragma unroll
        for (int q = 0; q < 4; ++q) { const GAS f32x4* xr = (const GAS f32x4*)(X + (size_t)(row0 + r0 + q) * D) + F.lane;
#pragma unroll
            for (int j = 0; j < 4; ++j) v[q][j] = xr[64 * j]; }
#pragma unroll
        for (int q = 0; q < 4; ++q) { s[q] = 0.f;
#pragma unroll
            for (int j = 0; j < 4; ++j) s[q] += (v[q][j].x * v[q][j].x + v[q][j].y * v[q][j].y) + (v[q][j].z * v[q][j].z + v[q][j].w * v[q][j].w); }
#pragma unroll
        for (int q = 0; q < 4; ++q) { const int r = r0 + q;
            const float rstd = 1.0f / sqrtf(wave_sum(s[q]) * (1.0f / D) + RMS_EPS);
#pragma unroll
            for (int j = 0; j < 4; ++j) { const f32x4 y = v[q][j] * rstd * mul[j] + add[j];
                if (O) { u32x2 w; w.x = cvt_pk_bf16(y.x, y.y); w.y = cvt_pk_bf16(y.z, y.w); ((GAS u32x2*)(O + (size_t)(row0 + r) * D) + F.lane)[64 * j] = w; }
                if (O8) { int w8 = __builtin_amdgcn_cvt_pk_fp8_f32(y.x, y.y, 0, false); w8 = __builtin_amdgcn_cvt_pk_fp8_f32(y.z, y.w, w8, true); ((GAS unsigned*)(O8 + (size_t)(row0 + r) * D) + F.lane)[64 * j] = (unsigned)w8; } } }
    }
}
using pg8::Unit;
constexpr float WSCALE8 = 32.0f;
typedef const f32x4 (&AccRef)[2][2][4][2];

struct EpiInProj {
    static constexpr bool PERM = true;
    bf16_t* Z; bf16_t* Gt;
    __device__ __forceinline__ void operator()(AccRef acc, const Unit& u, int wr, int wc, int fr, int fq) const {
        asm volatile("" : "+v"(fr), "+v"(fq));
        const int row0 = u.pm * 256 + wr * 64 + fr;
        const bool gate = u.pn >= 16;
        const float sc = ((u.pn < 2) ? QSCALE : 1.0f) * (1.0f / WSCALE8);
        bf16_t* base = gate ? Gt + (size_t)(u.pn - 16) * 256 : Z + (size_t)u.pn * 256;
        const int ldc = gate ? GW : ZW;
#pragma unroll
        for (int ai = 0; ai < 2; ++ai)
#pragma unroll
            for (int m = 0; m < 4; ++m) { bf16_t* rowp = base + (size_t)(row0 + ai * 128 + m * 16) * ldc + wc * 32 + 8 * fq;
#pragma unroll
                for (int bj = 0; bj < 2; ++bj) { f32x4 v0 = acc[ai][bj][m][0], v1 = acc[ai][bj][m][1];
                    if (gate) {
#pragma unroll
                        for (int j = 0; j < 4; ++j) { v0[j] = fast_sigmoid(v0[j] * sc); v1[j] = fast_sigmoid(v1[j] * sc); } }
                    else { v0 = v0 * sc; v1 = v1 * sc; }
                    u32x4 w; w.x = cvt_pk_bf16(v0[0], v0[1]); w.y = cvt_pk_bf16(v0[2], v0[3]); w.z = cvt_pk_bf16(v1[0], v1[1]); w.w = cvt_pk_bf16(v1[2], v1[3]);
                    *(u32x4*)(rowp + bj * 128) = w; } }
    }
};

constexpr float ATT_S8 = 16.0f, RW_S8 = 8.0f, MIX_S8 = 16.0f;
template <int SECOND> struct EpiMerge {
    static constexpr bool PERM = true;
    bf16_t* Mx; unsigned char* Mx8; const bf16_t* Gt; float bs;
    __device__ __forceinline__ void operator()(AccRef acc, const Unit& u, int wr, int wc, int fr, int fq) const {
        asm volatile("" : "+v"(fr), "+v"(fq));
        const int row0 = u.pm * 256 + wr * 64 + fr, col0 = u.pn * 256 + wc * 32 + 8 * fq;
#pragma unroll
        for (int ai = 0; ai < 2; ++ai)
#pragma unroll
            for (int m = 0; m < 4; ++m) { const size_t r = (size_t)(row0 + ai * 128 + m * 16);
#pragma unroll
                for (int bj = 0; bj < 2; ++bj) { const int c = col0 + bj * 128;
                    const u32x4 g = *(const u32x4*)(Gt + r * GW + SECOND * 1024 + c);
                    f32x4 v0 = acc[ai][bj][m][0] * bs, v1 = acc[ai][bj][m][1] * bs;
                    v0[0] *= bf_lo(g.x); v0[1] *= bf_hi(g.x); v0[2] *= bf_lo(g.y); v0[3] *= bf_hi(g.y);
                    v1[0] *= bf_lo(g.z); v1[1] *= bf_hi(g.z); v1[2] *= bf_lo(g.w); v1[3] *= bf_hi(g.w);
                    if (SECOND) { const u32x4 p = *(const u32x4*)(Mx + r * D + c);
                        v0[0] += bf_lo(p.x); v0[1] += bf_hi(p.x); v0[2] += bf_lo(p.y); v0[3] += bf_hi(p.y);
                        v1[0] += bf_lo(p.z); v1[1] += bf_hi(p.z); v1[2] += bf_lo(p.w); v1[3] += bf_hi(p.w);
                        v0 = v0 * MIX_S8; v1 = v1 * MIX_S8;
                        int lo = __builtin_amdgcn_cvt_pk_fp8_f32(v0[0], v0[1], 0, false); lo = __builtin_amdgcn_cvt_pk_fp8_f32(v0[2], v0[3], lo, true);
                        int hi = __builtin_amdgcn_cvt_pk_fp8_f32(v1[0], v1[1], 0, false); hi = __builtin_amdgcn_cvt_pk_fp8_f32(v1[2], v1[3], hi, true);
                        *(u32x2*)(Mx8 + r * D + c) = (u32x2){(unsigned)lo, (unsigned)hi}; }
                    else { u32x4 w; w.x = cvt_pk_bf16(v0[0], v0[1]); w.y = cvt_pk_bf16(v0[2], v0[3]); w.z = cvt_pk_bf16(v1[0], v1[1]); w.w = cvt_pk_bf16(v1[2], v1[3]);
                        *(u32x4*)(Mx + r * D + c) = w; }
                    asm volatile("" ::: "memory"); } }
    }
};

struct EpiOutProj {
    static constexpr bool PERM = false;
    const float* X; float* O; const float* mod;
    __device__ __forceinline__ void operator()(AccRef acc, const Unit& u, int wr, int wc, int fr, int fq) const {
        asm volatile("" : "+v"(fr), "+v"(fq));
        const int row0 = u.pm * 256 + wr * 64 + fr, col0 = u.pn * 256 + wc * 32 + 4 * fq;
        const float* g1 = mod + (size_t)((u.pm * 256) / SEQ) * 6144 + 2048;
        f32x4 gv[2][2];
#pragma unroll
        for (int bj = 0; bj < 2; ++bj)
#pragma unroll
            for (int n = 0; n < 2; ++n) gv[bj][n] = *(const f32x4*)(g1 + col0 + bj * 128 + n * 16);
#pragma unroll
        for (int ai = 0; ai < 2; ++ai)
#pragma unroll
            for (int m = 0; m < 4; ++m) { const size_t off = (size_t)(row0 + ai * 128 + m * 16) * D + col0;
#pragma unroll
                for (int bj = 0; bj < 2; ++bj)
#pragma unroll
                    for (int n = 0; n < 2; ++n) { const f32x4 xv = *(const f32x4*)(X + off + bj * 128 + n * 16);
                        *(f32x4*)(O + off + bj * 128 + n * 16) = xv + gv[bj][n] * acc[ai][bj][m][n] * (1.0f / (MIX_S8 * WSCALE8)); }
                if (m & 1) asm volatile("" ::: "memory"); }
    }
};

struct EpiRouter {
    static constexpr bool PERM = false;
    float* L;
    __device__ __forceinline__ void operator()(AccRef acc, const Unit& u, int wr, int wc, int fr, int fq) const {
        asm volatile("" : "+v"(fr), "+v"(fq));
        if (wc >= 2) return;
        const int row0 = u.pm * 256 + wr * 64 + fr, col0 = wc * 32 + 4 * fq;
#pragma unroll
        for (int ai = 0; ai < 2; ++ai)
#pragma unroll
            for (int m = 0; m < 4; ++m)
#pragma unroll
                for (int n = 0; n < 2; ++n) *(f32x4*)(L + (size_t)(row0 + ai * 128 + m * 16) * 64 + col0 + n * 16) = acc[ai][0][m][n];
    }
};

struct MoeSched1 {
    const LAS unsigned* tab; int ntiles, G, c;
    __device__ __forceinline__ bool next(int i, Unit& u) const {
        const int L = i * G + c; if (L >= 256 + 2 * ntiles) return false;
        u.pn = L & 1;
        if (L < 256) { u.pm = L >> 1; u.aux0 = (u.pm * 256) | (64 << 20); u.aux1 = 256; }
        else { const int t = (L - 256) >> 1; u.pm = t; u.aux0 = __builtin_amdgcn_readfirstlane((int)tab[2 * t]); u.aux1 = __builtin_amdgcn_readfirstlane((int)tab[2 * t + 1]); }
        return true;
    }
};
struct MoeSrc1 {
    static constexpr int ESZ = 2; static constexpr bool GATHER = true;
    const unsigned char* ws;
    __device__ __forceinline__ const char* a_base(const Unit&) const { return (const char*)(ws + WS_H2); }
    __device__ __forceinline__ const char* b_base(const Unit& u) const { const int e = u.aux0 >> 20;
        const size_t off = (e == 64 ? WS_WSH1 : WS_W1T + (size_t)e * 512 * 1024 * 2) + (size_t)u.pn * 256 * 1024 * 2; return (const char*)ws + off; }
    __device__ __forceinline__ unsigned a_off(const Unit& u, int R, int C) const {
        const int e = u.aux0 >> 20, pos0 = u.aux0 & 0xFFFFF; int tok;
        if (e == 64) tok = pos0 + R; else tok = (R < u.aux1) ? (((const int*)(ws + WS_STOK))[pos0 + R] >> 3) : 0;
        return (unsigned)tok * 2048u + (unsigned)C * 2u; }
};
struct EpiMoe1 {
    static constexpr bool PERM = true;
    unsigned char* ws;
    __device__ __forceinline__ void operator()(AccRef acc, const Unit& u, int wr, int wc, int fr, int fq) const {
        asm volatile("" : "+v"(fr), "+v"(fq));
        const int e = u.aux0 >> 20, pos0 = u.aux0 & 0xFFFFF;
        bf16_t* base = (bf16_t*)(ws + (e == 64 ? WS_ACTS : WS_ACT)) + (size_t)pos0 * FF + u.pn * 128 + wc * 32 + 8 * fq;
#pragma unroll
        for (int ai = 0; ai < 2; ++ai)
#pragma unroll
            for (int m = 0; m < 4; ++m) { const int r = ai * 128 + wr * 64 + m * 16 + fr;
                float o[8];
#pragma unroll
                for (int n = 0; n < 2; ++n)
#pragma unroll
                    for (int j = 0; j < 4; ++j) { const float g = acc[ai][0][m][n][j], up = acc[ai][1][m][n][j]; o[4 * n + j] = g * fast_sigmoid(g) * up; }
                u32x4 w; w.x = cvt_pk_bf16(o[0], o[1]); w.y = cvt_pk_bf16(o[2], o[3]); w.z = cvt_pk_bf16(o[4], o[5]); w.w = cvt_pk_bf16(o[6], o[7]);
                if (r < u.aux1) *(u32x4*)(base + (size_t)r * FF) = w; }
    }
};
struct MoeSched2 {
    const LAS unsigned* tab; int t0, ntiles, nsh, G, c;
    __device__ __forceinline__ bool next(int i, Unit& u) const {
        const int L = i * G + c; if (L >= nsh + 4 * ntiles) return false;
        u.pn = L & 3;
        if (L < nsh) { u.pm = L >> 2; u.aux0 = (u.pm * 256) | (64 << 20); u.aux1 = 256; }
        else { const int t = t0 + ((L - nsh) >> 2); u.pm = t; u.aux0 = __builtin_amdgcn_readfirstlane((int)tab[2 * t]); u.aux1 = __builtin_amdgcn_readfirstlane((int)tab[2 * t + 1]); }
        return true;
    }
};
struct MoeSrc2 {
    static constexpr int ESZ = 2; static constexpr bool GATHER = true;
    const unsigned char* ws;
    __device__ __forceinline__ const char* a_base(const Unit& u) const { return (const char*)ws + ((u.aux0 >> 20) == 64 ? WS_ACTS : WS_ACT); }
    __device__ __forceinline__ const char* b_base(const Unit& u) const { const int e = u.aux0 >> 20;
        const size_t off = (e == 64 ? WS_WSH2 : WS_W2T + (size_t)e * 1024 * 256 * 2) + (size_t)u.pn * 256 * 256 * 2; return (const char*)ws + off; }
    __device__ __forceinline__ unsigned a_off(const Unit& u, int R, int C) const {
        const int pos0 = u.aux0 & 0xFFFFF; const int rr = R < u.aux1 ? R : u.aux1 - 1;
        return (unsigned)(pos0 + rr) * 512u + (unsigned)C * 2u; }
};
constexpr float SLOT_SCALE = 16.0f;
constexpr int NSLOT = 9;
struct EpiMoe2 {
    static constexpr bool PERM = true;
    unsigned char* ws; float* X1; int tokbase;
    mutable int ptk[8]; mutable float pwt[8];
    __device__ __forceinline__ void prefetch(const Unit& u, int wr, int fr) const {
        const int e = u.aux0 >> 20, pos0 = u.aux0 & 0xFFFFF;
        if (e != 64) {
#pragma unroll
            for (int ai = 0; ai < 2; ++ai)
#pragma unroll
                for (int m = 0; m < 4; ++m) { const int r = ai * 128 + wr * 64 + m * 16 + fr; const int rc = r < u.aux1 ? r : u.aux1 - 1;
                    ptk[ai * 4 + m] = ((const int*)(ws + WS_STOK))[pos0 + rc]; pwt[ai * 4 + m] = ((const float*)(ws + WS_SW))[pos0 + rc]; } }
    }
    __device__ __forceinline__ void operator()(AccRef acc, const Unit& u, int wr, int wc, int fr, int fq) const {
        asm volatile("" : "+v"(fr), "+v"(fq));
        const int e = u.aux0 >> 20, pos0 = u.aux0 & 0xFFFFF; const int col0 = u.pn * 256 + wc * 32 + 8 * fq;
        if (e == 64) {
#pragma unroll
            for (int ai = 0; ai < 2; ++ai)
#pragma unroll
                for (int m = 0; m < 4; ++m) { unsigned char* rowp = (unsigned char*)(ws + WS_SLOT) + ((size_t)(pos0 + ai * 128 + wr * 64 + m * 16 + fr) * NSLOT + 8) * D + u.pn * 256 + wc * 64 + fq * 16;
                    u32x4 o;
#pragma unroll
                    for (int bj = 0; bj < 2; ++bj) { const f32x4 v0 = acc[ai][bj][m][0] * SLOT_SCALE, v1 = acc[ai][bj][m][1] * SLOT_SCALE;
                        int lo = __builtin_amdgcn_cvt_pk_fp8_f32(v0[0], v0[1], 0, false); lo = __builtin_amdgcn_cvt_pk_fp8_f32(v0[2], v0[3], lo, true);
                        int hi = __builtin_amdgcn_cvt_pk_fp8_f32(v1[0], v1[1], 0, false); hi = __builtin_amdgcn_cvt_pk_fp8_f32(v1[2], v1[3], hi, true);
                        if (bj == 0) { o.x = (unsigned)lo; o.y = (unsigned)hi; } else { o.z = (unsigned)lo; o.w = (unsigned)hi; } }
                    *(u32x4*)rowp = o;
                    asm volatile("" ::: "memory"); }
        } else {
#pragma unroll
            for (int ai = 0; ai < 2; ++ai)
#pragma unroll
                for (int m = 0; m < 4; ++m) { const int r = ai * 128 + wr * 64 + m * 16 + fr;
                    if (r < u.aux1) { const int tk = ptk[ai * 4 + m]; const float w = pwt[ai * 4 + m] * SLOT_SCALE;
                        unsigned char* rowp = (unsigned char*)(ws + WS_SLOT) + ((size_t)(tk >> 3) * NSLOT + (tk & 7)) * D + u.pn * 256 + wc * 64 + fq * 16;
                        u32x4 o;
#pragma unroll
                        for (int bj = 0; bj < 2; ++bj) { const f32x4 v0 = acc[ai][bj][m][0] * w, v1 = acc[ai][bj][m][1] * w;
                            int lo = __builtin_amdgcn_cvt_pk_fp8_f32(v0[0], v0[1], 0, false); lo = __builtin_amdgcn_cvt_pk_fp8_f32(v0[2], v0[3], lo, true);
                            int hi = __builtin_amdgcn_cvt_pk_fp8_f32(v1[0], v1[1], 0, false); hi = __builtin_amdgcn_cvt_pk_fp8_f32(v1[2], v1[3], hi, true);
                            if (bj == 0) { o.x = (unsigned)lo; o.y = (unsigned)hi; } else { o.z = (unsigned)lo; o.w = (unsigned)hi; } }
                        *(u32x4*)rowp = o; }
                    asm volatile("" ::: "memory"); }
        }
    }
};
__device__ __forceinline__ unsigned ord_key(float x) { const unsigned b = __float_as_uint(x); return (b & 0x80000000u) ? ~b : (b | 0x80000000u); }

__device__ __forceinline__ void idx_glds16(const void* gsrc, unsigned lds_dst) { unsigned keep;
    asm volatile("s_mov_b32 %0, m0\n\ts_mov_b32 m0, %2\n\ts_nop 0\n\tglobal_load_lds_dwordx4 %1, off\n\ts_mov_b32 m0, %0" : "=&s"(keep) : "v"(gsrc), "s"(lds_dst) : "memory"); }

__device__ __forceinline__ void indexer_unit(const Args& args, Frame& F, int b, int q0) {
    const bf16_t* Z = (const bf16_t*)(F.ws + WS_Z) + (size_t)b * SEQ * ZW;
    unsigned* SELM = (unsigned*)(F.ws + WS_SEL) + (size_t)b * SEQ * 128;
    int tid = F.tid; asm volatile("" : "+v"(tid));
    const int lane = tid & 63, kl = lane & 31, hl = lane >> 5, w = F.wave;
    const int qa = q0 + 2 * w;
    const int myq = qa + hl;
    bf16x8 A0, A1;
    { const int aq = (kl >> 2) & 1, ah = 4 * (kl >> 3) + (kl & 3);
      const bf16_t* p = Z + (size_t)(qa + aq) * ZW + ZIQ + ah * 32 + 8 * hl;
      A0 = *(const bf16x8*)p; A1 = *(const bf16x8*)(p + 16); }
    float wq[16];
    { const bf16_t* p = Z + (size_t)myq * ZW + ZIW; const u32x4 a = *(const u32x4*)p, c = *(const u32x4*)(p + 8);
      wq[0] = bf_lo(a.x); wq[1] = bf_hi(a.x); wq[2] = bf_lo(a.y); wq[3] = bf_hi(a.y); wq[4] = bf_lo(a.z); wq[5] = bf_hi(a.z); wq[6] = bf_lo(a.w); wq[7] = bf_hi(a.w);
      wq[8] = bf_lo(c.x); wq[9] = bf_hi(c.x); wq[10] = bf_lo(c.y); wq[11] = bf_hi(c.y); wq[12] = bf_lo(c.z); wq[13] = bf_hi(c.z); wq[14] = bf_lo(c.w); wq[15] = bf_hi(c.w); }
    unsigned key[128];
    const int nchunk = (q0 + 15) / 1024 + 1;
    const unsigned idx_lds0 = (unsigned)(uintptr_t)F.lds;
#define IDX_LOAD(ch, buf) do { _Pragma("unroll") for (int _i = 0; _i < 8; ++_i) { const int kg_ = w * 8 + _i; const int key_ = 16 * kg_ + (lane >> 2); \
        idx_glds16(Z + (size_t)((ch) * 1024 + key_) * ZW + ZIK + 8 * ((lane & 3) ^ ((key_ >> 2) & 3)), (unsigned)__builtin_amdgcn_readfirstlane((int)(idx_lds0 + (buf) * 65536 + kg_ * 1024))); } } while (0)
    IDX_LOAD(0, 0);
    asm volatile("s_waitcnt vmcnt(0)" ::: "memory");
    __syncthreads();
#pragma unroll
    for (int ch = 0; ch < 4; ++ch) {
        if (ch < nchunk) {
            if (ch + 1 < nchunk) IDX_LOAD(ch + 1, (ch + 1) & 1);
            LAS unsigned char* kbl = F.lds + (ch & 1) * 65536 + kl * 64 + ((hl ^ ((kl >> 2) & 3)) * 16); asm volatile("" : "+v"(kbl));
            LAS unsigned char* kbl2 = F.lds + (ch & 1) * 65536 + kl * 64 + (((hl + 2) ^ ((kl >> 2) & 3)) * 16); asm volatile("" : "+v"(kbl2));
#pragma unroll
            for (int tt = 0; tt < 32; tt += 2) {
                const int t = ch * 32 + tt;
                if (32 * t <= qa + 1) {
                    bf16x8 B0[2], B1[2]; f32x16 acc[2];
#pragma unroll
                    for (int j = 0; j < 2; ++j) { B0[j] = *(const LAS bf16x8*)(kbl + 2048 * (tt + j)); B1[j] = *(const LAS bf16x8*)(kbl2 + 2048 * (tt + j)); }
#pragma unroll
                    for (int j = 0; j < 2; ++j) { acc[j] = f32x16{}; acc[j] = __builtin_amdgcn_mfma_f32_32x32x16_bf16(A0, B0[j], acc[j], 0, 0, 0); }
#pragma unroll
                    for (int j = 0; j < 2; ++j) acc[j] = __builtin_amdgcn_mfma_f32_32x32x16_bf16(A1, B1[j], acc[j], 0, 0, 0);
#pragma unroll
                    for (int j = 0; j < 2; ++j) { float s = 0.f;
#pragma unroll
                        for (int i = 0; i < 16; ++i) { const float av_ = acc[j][i]; const int xb_ = __float_as_int(av_); s += __int_as_float(xb_ > 0 ? xb_ : 0) * wq[i]; }
                        key[t + j] = (32 * (t + j) + kl <= myq) ? ord_key(s) : 0u; }
                } else {
#pragma unroll
                    for (int j = 0; j < 2; ++j) key[t + j] = 0u;
                }
            }
            asm volatile("s_waitcnt vmcnt(0)" ::: "memory");
            __syncthreads();
        } else {
#pragma unroll
            for (int tt = 0; tt < 32; ++tt) key[ch * 32 + tt] = 0u;
        }
    }
#undef IDX_LOAD
#pragma unroll
    for (int w = 0; w < 4; ++w) {
        if (1024 * w <= qa + 1) {
#pragma unroll
            for (int k = 0; k < 16; ++k) { const unsigned lo = key[32 * w + k], hi_ = key[32 * w + k + 16];
                key[32 * w + k] = __builtin_amdgcn_perm(hi_, lo, 0x05040100u); key[32 * w + k + 16] = __builtin_amdgcn_perm(hi_, lo, 0x07060302u); }
#pragma unroll
            for (int k = 0; k < 32; ++k) if (!(k & 8)) { const unsigned lo = key[32 * w + k], hi_ = key[32 * w + k + 8];
                key[32 * w + k] = __builtin_amdgcn_perm(hi_, lo, 0x06020400u); key[32 * w + k + 8] = __builtin_amdgcn_perm(hi_, lo, 0x07030501u); }
#pragma unroll
            for (int k = 0; k < 32; ++k) if (!(k & 4)) { const unsigned lo = key[32 * w + k], hi_ = key[32 * w + k + 4]; const unsigned m = 0x0F0F0F0Fu;
                key[32 * w + k] = (lo & m) | ((hi_ << 4) & ~m); key[32 * w + k + 4] = ((lo >> 4) & m) | (hi_ & ~m); }
#pragma unroll
            for (int k = 0; k < 32; ++k) if (!(k & 2)) { const unsigned lo = key[32 * w + k], hi_ = key[32 * w + k + 2]; const unsigned m = 0x33333333u;
                key[32 * w + k] = (lo & m) | ((hi_ << 2) & ~m); key[32 * w + k + 2] = ((lo >> 2) & m) | (hi_ & ~m); }
#pragma unroll
            for (int k = 0; k < 32; ++k) if (!(k & 1)) { const unsigned lo = key[32 * w + k], hi_ = key[32 * w + k + 1]; const unsigned m = 0x55555555u;
                key[32 * w + k] = (lo & m) | ((hi_ << 1) & ~m); key[32 * w + k + 1] = ((lo >> 1) & m) | (hi_ & ~m); }
        }
    }
    unsigned Al[4] = {~0u, ~0u, ~0u, ~0u}, Gt[4] = {0u, 0u, 0u, 0u};
    int ab0 = 0, ab1 = 0; unsigned T0 = 0u, T1 = 0u; bool dn0 = false, dn1 = false;
#define IDX_DPP(v, ctrl) __builtin_amdgcn_update_dpp(0, (v), (ctrl), 0xF, 0xF, true)
#pragma unroll
    for (int bit = 31; bit >= 0; --bit) {
        unsigned S_[4]; int c = 0;
#pragma unroll
        for (int w = 0; w < 4; ++w) { S_[w] = Al[w] & key[32 * w + bit]; c += __builtin_popcount(S_[w]); }
        c += IDX_DPP(c, 0xB1); c += IDX_DPP(c, 0x4E); c += IDX_DPP(c, 0x141); c += IDX_DPP(c, 0x140);
        const int cn0 = ab0 + __builtin_amdgcn_readlane(c, 0) + __builtin_amdgcn_readlane(c, 16), cn1 = ab1 + __builtin_amdgcn_readlane(c, 32) + __builtin_amdgcn_readlane(c, 48);
        const bool t0 = cn0 >= 256, t1 = cn1 >= 256;
        if (t0) { T0 |= 1u << bit; dn0 = dn0 || cn0 == 256; } else ab0 = cn0;
        if (t1) { T1 |= 1u << bit; dn1 = dn1 || cn1 == 256; } else ab1 = cn1;
        const unsigned nm = hl ? (t1 ? 0u : ~0u) : (t0 ? 0u : ~0u);
#pragma unroll
        for (int w = 0; w < 4; ++w) { Al[w] &= key[32 * w + bit] ^ nm; Gt[w] |= S_[w] & nm; }
        if (dn0 && dn1) break;
    }
#undef IDX_DPP
    unsigned x[4];
    { const bool nz = hl ? (T1 != 0u) : (T0 != 0u);
#pragma unroll
      for (int w = 0; w < 4; ++w) x[w] = Gt[w] | (nz ? Al[w] : 0u); }
#define IDX_BFLY(d, m) do { const bool up_ = (kl & (d)) != 0; const unsigned km_ = up_ ? ~(m) : (m); const unsigned am_ = up_ ? (unsigned)(d) : 32u - (d); \
        _Pragma("unroll") for (int w = 0; w < 4; ++w) { const unsigned t_ = (unsigned)__builtin_amdgcn_ds_swizzle((int)x[w], 0x1F | ((d) << 10)); \
            const unsigned rot_ = __builtin_amdgcn_alignbit(t_, t_, am_); x[w] = (x[w] & km_) | (rot_ & ~km_); } } while (0)
    IDX_BFLY(16, 0x0000FFFFu); IDX_BFLY(8, 0x00FF00FFu); IDX_BFLY(4, 0x0F0F0F0Fu); IDX_BFLY(2, 0x33333333u); IDX_BFLY(1, 0x55555555u);
#undef IDX_BFLY
#pragma unroll
    for (int j = 0; j < 4; ++j) SELM[(size_t)myq * 128 + kl + 32 * j] = x[j];
}

__device__ __forceinline__ void indexer_phase(const Args& args, Frame& F) {
    const int c = blockIdx.x;
    for (int i = 0; i < 8; ++i) {
        for (int u = c + i * F.G; u < 2048 && i < 8; u += 2048) {
            const int b = u >> 8, pos = u & 255, blk = (b & 1) ? 255 - pos : pos;
            indexer_unit(args, F, b, blk * 16);
        }
    }
}
namespace att {
constexpr int DM = ZW, QB = 256, KVB = 64, SLOTB = 8192;
constexpr int NS = 4;
constexpr int L_K = 0, L_V = NS * SLOTB, L_MASK = 2 * NS * SLOTB, L_WSF = L_MASK + 8 * 2048, L_OST = L_WSF + 8 * 256, L_BT = L_OST + 8 * 4096, L_MT = L_BT + 512, L_END = L_MT + 128;
static_assert(L_END <= RING_BYTES, "attention LDS");
__device__ __forceinline__ int crow(int r, int hi) { return (r & 3) + 8 * (r >> 2) + 4 * hi; }
__device__ __forceinline__ void glds16(const void* gsrc, unsigned lds_dst) { unsigned keep;
    asm volatile("s_mov_b32 %0, m0\n\ts_mov_b32 m0, %2\n\ts_nop 0\n\tglobal_load_lds_dwordx4 %1, off\n\ts_mov_b32 m0, %0" : "=&s"(keep) : "v"(gsrc), "s"(lds_dst) : "memory"); }
__device__ __forceinline__ unsigned cvtpk(float lo, float hi) { return cvt_pk_bf16(lo, hi); }
typedef short s16x4 __attribute__((ext_vector_type(4)));

#ifdef PROBE_CYC
#define CYC_DECL unsigned cyc_t0_ = 0, cyc_a_ = 0; asm volatile("" : "+v"(cyc_t0_), "+v"(cyc_a_)); const bool cyc_on_ = (F.vcu == PROBE_CYC_WG) && (F.wave == PROBE_CYC_WAVE)
#define CYC_START() do { unsigned n_ = (unsigned)__builtin_readcyclecounter(); asm volatile("" : "+v"(n_)); cyc_t0_ = n_; } while (0)
#define CYC_MARK(k_) do { unsigned n_ = (unsigned)__builtin_readcyclecounter(); asm volatile("" : "+v"(n_)); if ((k_) == PROBE_CYC_SEL) cyc_a_ += n_ - cyc_t0_; cyc_t0_ = n_; } while (0)
#define CYC_FLUSH() do { if (cyc_on_ && F.lane == 0) atomicAdd(F.ctl + CW_Q + 64, cyc_a_); } while (0)
#else
#define CYC_DECL
#define CYC_START()
#define CYC_MARK(k_)
#define CYC_FLUSH()
#endif
__device__ __forceinline__ void attn_unit(const Args& args, Frame& F, int b, int h, int qb) {
    const int lane = F.lane, r32 = lane & 31, hi = lane >> 5, wid = F.wave;
    CYC_DECL;
#ifndef PROBE_ATT_VAR
#define PROBE_ATT_VAR 0
#endif
    const bool alt_ = (PROBE_ATT_VAR != 0) && (args.li == 1);
#define ALT(bit_) (alt_ && ((PROBE_ATT_VAR) & (bit_)))
    const bf16_t* Zb = (const bf16_t*)(F.ws + WS_Z) + (size_t)b * SEQ * DM;
    const int q0 = qb * QB;
    const bf16_t* Qw = Zb + (size_t)(q0 + wid * 32) * DM + ZQ + h * 64;
    const bf16_t* Kh = Zb + ZK + h * 64; const bf16_t* Vh = Zb + ZV + h * 64;
    LAS unsigned char* shm = F.lds;
    const unsigned lds0 = (unsigned)(uintptr_t)shm;
    LAS float* wsf = (LAS float*)(shm + L_WSF) + wid * 64;
    LAS float* bt = (LAS float*)(shm + L_BT);
    if (F.tid >= 128 && F.tid < 144) { const unsigned n = F.tid - 128;
        *(LAS u32x2*)(shm + L_MT + 8 * n) = (u32x2){((n & 1u) ? 0xFFFFu : 0u) | ((n & 2u) ? 0xFFFF0000u : 0u), ((n & 4u) ? 0xFFFFu : 0u) | ((n & 8u) ? 0xFFFF0000u : 0u)}; }
    if (F.tid < 128) { const int rel = F.tid; int bk;
        if (rel < 16) bk = rel; else { bk = 16 + (int)(logf((float)rel / 16.0f) / logf(8.0f) * 16.0f); bk = bk < 31 ? bk : 31; }
        bt[rel] = (AIN(6)[bk * 8 + h] - AIN(6)[31 * 8 + h]) * 1.4426950408889634f; }
    const bf16_t* ksrc = Kh + (size_t)lane * DM + wid * 8;
    const bf16_t* vsrc = Vh + (size_t)(16 * (wid & 3) + (lane >> 2)) * DM + (wid >> 2) * 32 + (lane & 3) * 8;
    const unsigned kdst = lds0 + L_K + wid * 1024, vdst = lds0 + L_V + wid * 1024;
    const unsigned* SELM = (const unsigned*)(F.ws + WS_SEL) + (size_t)(b * SEQ + q0 + wid * 32 + r32) * 128 + 4 * hi;
    const unsigned mdst = lds0 + L_MASK + wid * 2048;
#define DMA_K(t, slot) glds16(ksrc + (size_t)(t) * KVB * DM, (unsigned)__builtin_amdgcn_readfirstlane(kdst + (slot) * SLOTB))
#define DMA_V(t, slot) glds16(vsrc + (size_t)(t) * KVB * DM, (unsigned)__builtin_amdgcn_readfirstlane(vdst + (slot) * SLOTB))
#define DMA_M(g) glds16(SELM + 8 * (g), (unsigned)__builtin_amdgcn_readfirstlane(mdst + ((g) & 1) * 1024))
    const int NT = ALT(1024) ? 4 : (q0 + QB) / KVB;
    bf16x8 qr[4];
#pragma unroll
    for (int d0 = 0; d0 < 4; ++d0) qr[d0] = *(const bf16x8*)(Qw + (size_t)r32 * DM + d0 * 16 + hi * 8);
    asm volatile("s_waitcnt vmcnt(0)" ::: "memory");
    __syncthreads();
    DMA_M(0); DMA_K(0, 0); DMA_K(1, 1); DMA_V(0, 0); DMA_K(2, 2); DMA_V(1, 1); DMA_K(3, 3); DMA_V(2, 2);
    float m_run = 0.f; f32x16 o[2], lacc = f32x16{}; o[0] = f32x16{}; o[1] = f32x16{};
    const bf16x8 ones8 = __builtin_bit_cast(bf16x8, (u32x4){0x3F803F80u, 0x3F803F80u, 0x3F803F80u, 0x3F803F80u});
    const int qpos = q0 + wid * 32 + r32;
    const int vb0 = (int)(lds0 + L_V) + ((lane >> 4) & 1) * 32 + (lane & 3) * 8 + (4 * hi + ((lane & 15) >> 2)) * 64;
#define QK_TILE(P0, P1, slot_) do { const LAS unsigned char* kb = shm + L_K + (slot_) * SLOTB + hi * 1024 + r32 * 16; P0 = f32x16{}; P1 = f32x16{}; \
        _Pragma("unroll") for (int d0 = 0; d0 < 4; ++d0) { const bf16x8 b0 = *(const LAS bf16x8*)(kb + d0 * 2048); const bf16x8 b1 = *(const LAS bf16x8*)(kb + d0 * 2048 + 512); \
            P0 = __builtin_amdgcn_mfma_f32_32x32x16_bf16(b0, qr[d0], P0, 0, 0, 0); P1 = __builtin_amdgcn_mfma_f32_32x32x16_bf16(b1, qr[d0], P1, 0, 0, 0); } } while (0)
    f32x16 pa0, pa1, pb0, pb1;
    asm volatile("s_waitcnt vmcnt(6)" ::: "memory");
    __builtin_amdgcn_s_barrier(); asm volatile("" ::: "memory");
    QK_TILE(pa0, pa1, 0);
#define ATT_WAITV(n_) do { const int nn_ = (n_); if (nn_ >= 4) asm volatile("s_waitcnt vmcnt(4)" ::: "memory"); else if (nn_ == 3) asm volatile("s_waitcnt vmcnt(3)" ::: "memory"); \
        else if (nn_ == 2) asm volatile("s_waitcnt vmcnt(2)" ::: "memory"); else if (nn_ == 1) asm volatile("s_waitcnt vmcnt(1)" ::: "memory"); else asm volatile("s_waitcnt vmcnt(0)" ::: "memory"); } while (0)
    asm volatile("s_waitcnt lgkmcnt(0)" ::: "memory");
    if (wid >= 4) { __builtin_amdgcn_s_barrier(); asm volatile("" ::: "memory"); }
    auto step = [&](const int t, f32x16& C0, f32x16& C1, f32x16& N0, f32x16& N1) __attribute__((always_inline)) {
        const int slot = t & (NS - 1), g = t >> 2, tq = t & 3;
        CYC_START();
        if (!ALT(32)) ATT_WAITV((t + 1 < NT) + 2 * (t + 2 < NT) + (t + 3 < NT));
        if (!ALT(16)) __builtin_amdgcn_s_barrier(); asm volatile("" ::: "memory");
        CYC_MARK(0);
        if (t + 4 < NT && !ALT(32)) DMA_K(t + 4, (t + 4) & (NS - 1));
        if (tq == 0 && !ALT(32)) DMA_M(g + 1);
        if (t + 1 < NT) { if (ALT(4)) { N0 = f32x16{}; N1 = f32x16{}; } else QK_TILE(N0, N1, (t + 1) & (NS - 1)); }
        __builtin_amdgcn_sched_barrier(0);
        const u32x2 mwv = *(const LAS u32x2*)(shm + L_MASK + wid * 2048 + (g & 1) * 1024 + (tq >> 1) * 512 + r32 * 16 + (tq & 1) * 8);
        if (64 * t + 63 + 112 >= q0 + wid * 32 && !ALT(256)) {
#pragma unroll
            for (int r = 0; r < 16; ++r) { const int kv = 64 * t + crow(r, hi); int r0 = qpos - kv, r1 = r0 - 32;
                r0 = r0 < 0 ? 0 : (r0 > 127 ? 127 : r0); r1 = r1 < 0 ? 0 : (r1 > 127 ? 127 : r1);
                C0[r] += bt[r0]; C1[r] += bt[r1]; }
        }
        if (!ALT(128)) {
        typedef float f32x2_ __attribute__((ext_vector_type(2)));
        { const f32x2_ mm = {m_run, m_run};
#pragma unroll
          for (int r = 0; r < 16; r += 2) { f32x2_ a = {C0[r], C0[r + 1]}, c = {C1[r], C1[r + 1]}; a -= mm; c -= mm; C0[r] = a.x; C0[r + 1] = a.y; C1[r] = c.x; C1[r + 1] = c.y; } }
        float rm = __builtin_fmaxf(C0[0], C1[0]);
#pragma unroll
        for (int r = 1; r < 16; ++r) rm = __builtin_fmaxf(rm, __builtin_fmaxf(C0[r], C1[r]));
        if (t == 0 || __builtin_amdgcn_ballot_w64(rm > 8.0f) != 0ull) {
            rm = __builtin_fmaxf(rm, __shfl_xor(rm, 32));
            const float dm = t == 0 ? rm : __builtin_fmaxf(rm, 0.f);
            const float f = t == 0 ? 1.0f : __builtin_amdgcn_exp2f(-dm);
            m_run += dm;
#pragma unroll
            for (int r = 0; r < 16; ++r) { C0[r] -= dm; C1[r] -= dm; }
            if (hi == 0) wsf[r32] = f;
            asm volatile("s_waitcnt lgkmcnt(0)" ::: "memory");
#pragma unroll
            for (int r = 0; r < 16; ++r) { const float fr_ = wsf[crow(r, hi)]; o[0][r] *= fr_; o[1][r] *= fr_; lacc[r] *= fr_; }
        }
        }
        if (!ALT(2)) {
#pragma unroll
        for (int r = 0; r < 16; ++r) { C0[r] = __builtin_amdgcn_exp2f(C0[r]); C1[r] = __builtin_amdgcn_exp2f(C1[r]); } }
        asm volatile("s_waitcnt lgkmcnt(0)" ::: "memory");
        CYC_MARK(1);
        if (!ALT(32)) ATT_WAITV((t + 1 < NT) + (t + 2 < NT) + (t + 3 < NT) + (t + 4 < NT));
        if (!ALT(16)) __builtin_amdgcn_s_barrier(); asm volatile("" ::: "memory");
        CYC_MARK(2);
        if (t + 3 < NT && !ALT(32)) DMA_V(t + 3, (t + 3) & (NS - 1));
        u32x4 pw0, pw1, pw2, pw3;
        pw0 = (u32x4){cvtpk(C0[0], C0[1]), cvtpk(C0[2], C0[3]), cvtpk(C0[4], C0[5]), cvtpk(C0[6], C0[7])};
        pw1 = (u32x4){cvtpk(C0[8], C0[9]), cvtpk(C0[10], C0[11]), cvtpk(C0[12], C0[13]), cvtpk(C0[14], C0[15])};
        pw2 = (u32x4){cvtpk(C1[0], C1[1]), cvtpk(C1[2], C1[3]), cvtpk(C1[4], C1[5]), cvtpk(C1[6], C1[7])};
        pw3 = (u32x4){cvtpk(C1[8], C1[9]), cvtpk(C1[10], C1[11]), cvtpk(C1[12], C1[13]), cvtpk(C1[14], C1[15])};
        if (!ALT(64))
        { const unsigned mx_ = mwv.x >> (4 * hi), my_ = mwv.y >> (4 * hi); const LAS unsigned char* mt = shm + L_MT;
          const u32x2 a0 = *(const LAS u32x2*)(mt + ((mx_ << 3) & 0x78u)), a1 = *(const LAS u32x2*)(mt + ((mx_ >> 5) & 0x78u)), a2 = *(const LAS u32x2*)(mt + ((mx_ >> 13) & 0x78u)), a3 = *(const LAS u32x2*)(mt + ((mx_ >> 21) & 0x78u));
          const u32x2 b0 = *(const LAS u32x2*)(mt + ((my_ << 3) & 0x78u)), b1 = *(const LAS u32x2*)(mt + ((my_ >> 5) & 0x78u)), b2 = *(const LAS u32x2*)(mt + ((my_ >> 13) & 0x78u)), b3 = *(const LAS u32x2*)(mt + ((my_ >> 21) & 0x78u));
          pw0.x &= a0.x; pw0.y &= a0.y; pw0.z &= a1.x; pw0.w &= a1.y; pw1.x &= a2.x; pw1.y &= a2.y; pw1.z &= a3.x; pw1.w &= a3.y;
          pw2.x &= b0.x; pw2.y &= b0.y; pw2.z &= b1.x; pw2.w &= b1.y; pw3.x &= b2.x; pw3.y &= b2.y; pw3.z &= b3.x; pw3.w &= b3.y; }
        if (!ALT(8)) {
        lacc = __builtin_amdgcn_mfma_f32_32x32x16_bf16(__builtin_bit_cast(bf16x8, pw0), ones8, lacc, 0, 0, 0); lacc = __builtin_amdgcn_mfma_f32_32x32x16_bf16(__builtin_bit_cast(bf16x8, pw1), ones8, lacc, 0, 0, 0);
        lacc = __builtin_amdgcn_mfma_f32_32x32x16_bf16(__builtin_bit_cast(bf16x8, pw2), ones8, lacc, 0, 0, 0); lacc = __builtin_amdgcn_mfma_f32_32x32x16_bf16(__builtin_bit_cast(bf16x8, pw3), ones8, lacc, 0, 0, 0);
        { const int vb = vb0 + slot * SLOTB;
#pragma unroll
          for (int d0 = 0; d0 < 2; ++d0) { s16x4 lo[4], hh[4];
#pragma unroll
              for (int ks = 0; ks < 4; ++ks) {
                  asm volatile("ds_read_b64_tr_b16 %0,%1 offset:%c2" : "=&v"(lo[ks]) : "v"(vb), "i"(d0 * 4096 + ks * 1024) : "memory");
                  asm volatile("ds_read_b64_tr_b16 %0,%1 offset:%c2" : "=&v"(hh[ks]) : "v"(vb), "i"(d0 * 4096 + ks * 1024 + 512) : "memory"); }
              asm volatile("s_waitcnt lgkmcnt(0)" ::: "memory"); __builtin_amdgcn_sched_barrier(0);
#define PKV(k) (bf16x8){lo[k][0], lo[k][1], lo[k][2], lo[k][3], hh[k][0], hh[k][1], hh[k][2], hh[k][3]}
              o[d0] = __builtin_amdgcn_mfma_f32_32x32x16_bf16(__builtin_bit_cast(bf16x8, pw0), PKV(0), o[d0], 0, 0, 0);
              o[d0] = __builtin_amdgcn_mfma_f32_32x32x16_bf16(__builtin_bit_cast(bf16x8, pw1), PKV(1), o[d0], 0, 0, 0);
              o[d0] = __builtin_amdgcn_mfma_f32_32x32x16_bf16(__builtin_bit_cast(bf16x8, pw2), PKV(2), o[d0], 0, 0, 0);
              o[d0] = __builtin_amdgcn_mfma_f32_32x32x16_bf16(__builtin_bit_cast(bf16x8, pw3), PKV(3), o[d0], 0, 0, 0);
#undef PKV
          } }
        }
        asm volatile("s_waitcnt lgkmcnt(0)" ::: "memory");
        CYC_MARK(3);
    };
    for (int t = 0; t < NT; t += 2) { step(t, pa0, pa1, pb0, pb1); step(t + 1, pb0, pb1, pa0, pa1); }
    if (wid < 4) { __builtin_amdgcn_s_barrier(); asm volatile("" ::: "memory"); }
#undef QK_TILE
#undef ATT_WAITV
    CYC_FLUSH();
    bf16_t* Ow = (bf16_t*)(F.ws + (alt_ ? WS_R2 : WS_R1)) + (size_t)(b * SEQ + q0 + wid * 32) * 512 + h * 64;
    { LAS bf16_t* stg = (LAS bf16_t*)(shm + L_OST) + wid * 2048;
#pragma unroll
      for (int r = 0; r < 16; ++r) { const int orow = crow(r, hi); const float rl = __builtin_amdgcn_rcpf(lacc[r]);
#pragma unroll
          for (int d0 = 0; d0 < 2; ++d0) stg[orow * 64 + d0 * 32 + r32] = (bf16_t)f2bf(o[d0][r] * rl); }
      asm volatile("s_waitcnt lgkmcnt(0)" ::: "memory");
#pragma unroll
      for (int i = 0; i < 4; ++i) { const int row = i * 8 + (lane >> 3), chn = lane & 7; const u32x4 v = *(const LAS u32x4*)(stg + row * 64 + chn * 8); *(u32x4*)(Ow + (size_t)row * 512 + chn * 8) = v; } }
    asm volatile("s_waitcnt lgkmcnt(0)" ::: "memory");
#undef DMA_K
#undef DMA_V
#undef DMA_M
}

__device__ __forceinline__ void attn_phase(const Args& args, Frame& F) {
    const int v = F.vcu;
    for (int i = 0; i < 4; ++i) {
        for (int uu = v; uu < 256; uu += F.G) {
            const int bh = uu >> 2, s = uu & 3; const int qb = (i == 0) ? s : (i == 1) ? 7 - s : (i == 2) ? 8 + s : 15 - s;
            attn_unit(args, F, bh >> 3, bh & 7, qb);
        }
    }
}
}
#ifndef PROBE_NO_STATE
#define PROBE_NO_STATE 0
#endif
#ifndef PROBE_TINV_ID
#define PROBE_TINV_ID 0
#endif
namespace rk {
typedef __bf16 bf16x2_t __attribute__((ext_vector_type(2)));
__device__ __forceinline__ unsigned cvtpk(float lo, float hi) { f32x2 v = {lo, hi}; bf16x2_t b = __builtin_convertvector(v, bf16x2_t); return __builtin_bit_cast(unsigned, b); }
template <int S> __device__ __forceinline__ bf16x8 frag(const f32x16& x) {
    u32x4 o; o.x = cvtpk(x[8 * S + 0], x[8 * S + 1]); o.y = cvtpk(x[8 * S + 2], x[8 * S + 3]); o.z = cvtpk(x[8 * S + 4], x[8 * S + 5]); o.w = cvtpk(x[8 * S + 6], x[8 * S + 7]);
    return __builtin_bit_cast(bf16x8, o); }
template <int S> __device__ __forceinline__ void unfrag(f32x16& x, bf16x8 f) { const u32x4 o = __builtin_bit_cast(u32x4, f);
    x[8 * S + 0] = bf_lo(o.x); x[8 * S + 1] = bf_hi(o.x); x[8 * S + 2] = bf_lo(o.y); x[8 * S + 3] = bf_hi(o.y); x[8 * S + 4] = bf_lo(o.z); x[8 * S + 5] = bf_hi(o.z); x[8 * S + 6] = bf_lo(o.w); x[8 * S + 7] = bf_hi(o.w); }
#define RK_MF(a, b, c) __builtin_amdgcn_mfma_f32_32x32x16_bf16((a), (b), (c), 0, 0, 0)
__device__ __forceinline__ float dppf(float v, const int ctrl_is_const_dummy);
#define RK_DPP(v, ctrl, rmask, bc) __builtin_bit_cast(float, __builtin_amdgcn_update_dpp(0, __builtin_bit_cast(int, (v)), (ctrl), (rmask), 0xF, (bc)))
__device__ __forceinline__ float scan32(float v) {
#ifdef PROBE_SHFL_SCAN
    const int l32 = threadIdx.x & 31;
#pragma unroll
    for (int o = 1; o < 32; o <<= 1) { const float t = __shfl_up(v, o, 32); if (l32 >= o) v += t; }
    return v;
#endif
    v += RK_DPP(v, 0x111, 0xF, true); v += RK_DPP(v, 0x112, 0xF, true); v += RK_DPP(v, 0x114, 0xF, true); v += RK_DPP(v, 0x118, 0xF, true);
    v += RK_DPP(v, 0x142, 0xA, false);
    return v; }
__device__ __forceinline__ float ex2(float x) { return __builtin_amdgcn_exp2f(x); }
constexpr int PZ = 3600;
constexpr size_t SZ_G = 8192, SZ_H = 8192, SZ_Q = 4096, SZ_Y = 4096;
constexpr float L2E = 1.4426950408889634f;

__device__ __forceinline__ void mk_id(bf16x8 (&fId)[2], int r, int h) {
    asm volatile("" : "+v"(r), "+v"(h));
#pragma unroll
    for (int s = 0; s < 2; ++s) { unsigned short e8[8];
#pragma unroll
        for (int jj = 0; jj < 8; ++jj) e8[jj] = (16 * s + 8 * (jj >> 2) + 4 * h + (jj & 3) == r) ? (unsigned short)0x3F80 : (unsigned short)0;
        fId[s] = __builtin_bit_cast(bf16x8, (u32x4){(unsigned)e8[0] | ((unsigned)e8[1] << 16), (unsigned)e8[2] | ((unsigned)e8[3] << 16), (unsigned)e8[4] | ((unsigned)e8[5] << 16), (unsigned)e8[6] | ((unsigned)e8[7] << 16)}); }
}

__device__ __forceinline__ void load_params(const Args& args, Frame& F) {
    LAS float* pra = (LAS float*)(F.lds + LDS_PARA); LAS float* prb = (LAS float*)(F.lds + LDS_PARB);
    const float* mu = AIN(7); const float* w0 = AIN(8); const float* a0 = AIN(10); const float* kk = AIN(13); const float* ka = AIN(14); const float* rk = AIN(15);
    for (int i = F.tid; i < 4096; i += NTHR) { const int a = i >> 9, c = i & 511;
        const float v_ = a < 3 ? mu[a * 512 + c] : (a == 3 ? w0[c] : (a == 4 ? a0[c] : (a == 5 ? kk[c] : (a == 6 ? ka[c] : rk[c]))));
        if (a < 4) pra[c * 4 + a] = v_; else prb[c * 4 + a - 4] = v_; }
    __syncthreads();
}
struct ElemCtx { const LAS unsigned char* rowc; const LAS unsigned char* rowp; const bf16_t* DUt; const bf16_t* IUt; const LAS float* pra; const LAS float* prb; int hd, r, h; float inv; };
template <int MODE> __device__ __forceinline__ void r1_elem(const ElemCtx& C, int jt, bf16x8 (&o0)[2], bf16x8 (&o1)[2], bf16x8 (&o2)[2], bf16x8 (&o3)[2], float& bns, float& pcd) {
    const int r = C.r, h = C.h, hd = C.hd;
    f32x16 lw_ = f32x16{}, la_ = f32x16{};
#pragma unroll
    for (int ks = 0; ks < 4; ++ks) { const int k0 = 16 * ks + 8 * h;
        const bf16x8 bw = *(const LAS bf16x8*)(C.rowc + (1536 + k0) * 2), ba = *(const LAS bf16x8*)(C.rowc + (1600 + k0) * 2);
        const bf16x8 fa = *(const bf16x8*)(C.DUt + (size_t)(32 * jt + r) * 64 + k0), fi = *(const bf16x8*)(C.IUt + (size_t)(32 * jt + r) * 64 + k0);
        lw_ = RK_MF(fa, bw, lw_); la_ = RK_MF(fi, ba, la_); }
    float d = 0.f;
#pragma unroll
    for (int s = 0; s < 2; ++s) { float x0[8], x1[8], x2[8], x3[8];
#pragma unroll
        for (int g2 = 0; g2 < 2; ++g2) { const int g = 2 * s + g2, cj = hd * 64 + 32 * jt + 8 * g + 4 * h;
            float kc[4], kq[4], xc[4], xq[4];
            { const u32x2 a = *(const LAS u32x2*)(C.rowc + (512 + cj) * 2), p = *(const LAS u32x2*)(C.rowp + (512 + cj) * 2);
              kc[0] = bf_lo(a.x); kc[1] = bf_hi(a.x); kc[2] = bf_lo(a.y); kc[3] = bf_hi(a.y); kq[0] = bf_lo(p.x); kq[1] = bf_hi(p.x); kq[2] = bf_lo(p.y); kq[3] = bf_hi(p.y); }
            { const int xo = MODE ? 1024 : 0; const u32x2 a = *(const LAS u32x2*)(C.rowc + (xo + cj) * 2), p = *(const LAS u32x2*)(C.rowp + (xo + cj) * 2);
              xc[0] = bf_lo(a.x); xc[1] = bf_hi(a.x); xc[2] = bf_lo(a.y); xc[3] = bf_hi(a.y); xq[0] = bf_lo(p.x); xq[1] = bf_hi(p.x); xq[2] = bf_lo(p.y); xq[3] = bf_hi(p.y); }
            const LAS f32x4* ppa = (const LAS f32x4*)(C.pra + cj * 4); const LAS f32x4* ppb = (const LAS f32x4*)(C.prb + cj * 4);
#pragma unroll
            for (int q = 0; q < 4; ++q) { const int i = 4 * g + q, o = 4 * g2 + q;
                const f32x4 pa = ppa[q], pb = ppb[q];
                const float e_ = 0.6065306597126334f * fast_sigmoid(pa[3] + lw_[i]); const float L = scan32(e_);
                const float l0 = __builtin_bit_cast(float, __builtin_amdgcn_readlane(__builtin_bit_cast(int, L), 31)), l1 = __builtin_bit_cast(float, __builtin_amdgcn_readlane(__builtin_bit_cast(int, L), 63));
                const float Lend = h ? l1 : l0; if (i == 4 * (r >> 3) + (r & 3)) d = Lend;
                const float x_ = xc[q] + (MODE ? pa[2] : pa[0]) * (xq[q] - xc[q]), k_ = kc[q] + pa[1] * (kq[q] - kc[q]);
                const float ic = fast_sigmoid(pb[0] + la_[i]);
                const float kk = k_ * pb[1] * C.inv, kpn = k_ * (1.0f + (ic - 1.0f) * pb[2]), bv = kk * ic;
                if (MODE) { const float Qe = ex2(L2E * (L - Lend)); x0[o] = bv * Qe; x1[o] = kpn * Qe; x2[o] = x_; x3[o] = 0.f; }
                else { const float P = ex2(-L2E * L), Pi = ex2(L2E * L), Pm = ex2(-L2E * (L - e_)); bns += x_ * kpn * pb[3]; x0[o] = -kk * Pm; x1[o] = x_ * P; x2[o] = bv * Pi; x3[o] = kpn * Pi; } }
            asm volatile("" ::: "memory"); }
        o0[s] = __builtin_bit_cast(bf16x8, (u32x4){cvtpk(x0[0], x0[1]), cvtpk(x0[2], x0[3]), cvtpk(x0[4], x0[5]), cvtpk(x0[6], x0[7])});
        o1[s] = __builtin_bit_cast(bf16x8, (u32x4){cvtpk(x1[0], x1[1]), cvtpk(x1[2], x1[3]), cvtpk(x1[4], x1[5]), cvtpk(x1[6], x1[7])});
        o2[s] = __builtin_bit_cast(bf16x8, (u32x4){cvtpk(x2[0], x2[1]), cvtpk(x2[2], x2[3]), cvtpk(x2[4], x2[5]), cvtpk(x2[6], x2[7])});
        if (!MODE) o3[s] = __builtin_bit_cast(bf16x8, (u32x4){cvtpk(x3[0], x3[1]), cvtpk(x3[2], x3[3]), cvtpk(x3[4], x3[5]), cvtpk(x3[6], x3[7])}); }
    if (MODE) pcd = ex2(-L2E * d);
}


__device__ __forceinline__ void r1_unit(const Args& args, Frame& F, int b, int c) {
    LAS unsigned char* IMG = F.lds;
    const bf16_t* Z = (const bf16_t*)(F.ws + WS_Z);
    const int t0 = 32 * c; const size_t m0 = (size_t)b * SEQ + t0;
    const float* mu = AIN(7);
    int tid = F.tid; asm volatile("" : "+v"(tid));
    __syncthreads();
    { const unsigned lds0 = (unsigned)(uintptr_t)IMG; const int ln = tid & 63;
      for (int task = F.wave; task < 33 * 4; task += NWAVES) { const int rr = task >> 2, j = task & 3, pc = 64 * j + ln;
          if (pc < 224) { if (rr > 0 || t0 > 0) att::glds16(Z + (m0 + rr - 1) * ZW + ZR + 8 * pc, (unsigned)__builtin_amdgcn_readfirstlane((int)(lds0 + rr * PZ + 1024 * j)));
                          else *(LAS u32x4*)(IMG + 16 * pc) = (u32x4){0u, 0u, 0u, 0u}; } }
      asm volatile("s_waitcnt vmcnt(0)" ::: "memory"); }
    __syncthreads();
    { u32x4 actv[2];
#pragma unroll
      for (int i = 0; i < 2; ++i) { const int q = tid + NTHR * i, t = q >> 5, kp = q & 31;
          const u32x4 cw = *(const LAS u32x4*)(IMG + (t + 1) * PZ + (1536 + 8 * kp) * 2), pw = *(const LAS u32x4*)(IMG + t * PZ + (1536 + 8 * kp) * 2);
          const f32x4 m0v = *(const f32x4*)(mu + 1536 + 8 * kp), m1v = *(const f32x4*)(mu + 1536 + 8 * kp + 4);
          const unsigned cwa[4] = {cw.x, cw.y, cw.z, cw.w}, pwa[4] = {pw.x, pw.y, pw.z, pw.w}; float x[8];
#pragma unroll
          for (int j = 0; j < 4; ++j) { const float c0 = bf_lo(cwa[j]), c1 = bf_hi(cwa[j]), p0 = bf_lo(pwa[j]), p1 = bf_hi(pwa[j]);
              const float mu0 = j < 2 ? m0v[2 * j] : m1v[2 * j - 4], mu1 = j < 2 ? m0v[2 * j + 1] : m1v[2 * j - 3];
              x[2 * j] = c0 + mu0 * (p0 - c0); x[2 * j + 1] = c1 + mu1 * (p1 - c1); }
#pragma unroll
          for (int j = 0; j < 8; ++j) { if (kp < 8) { const float e2 = ex2(2.885390081777927f * x[j]); x[j] = 1.0f - 2.0f * __builtin_amdgcn_rcpf(e2 + 1.0f); } else if (kp >= 16) x[j] = fast_sigmoid(x[j]); }
          actv[i] = (u32x4){cvtpk(x[0], x[1]), cvtpk(x[2], x[3]), cvtpk(x[4], x[5]), cvtpk(x[6], x[7])}; }
      __syncthreads();
#pragma unroll
      for (int i = 0; i < 2; ++i) { const int q = tid + NTHR * i, t = q >> 5, kp = q & 31; *(LAS u32x4*)(IMG + (t + 1) * PZ + (1536 + 8 * kp) * 2) = actv[i]; }
      __syncthreads(); }
    const int hd = F.wave; int r = tid & 31, h = (tid >> 5) & 1;
    const LAS unsigned char* rowc = IMG + (r + 1) * PZ; const LAS unsigned char* rowp = IMG + r * PZ;
    const bf16_t* DUt = (const bf16_t*)(F.ws + WS_DUT) + (size_t)hd * 4096; const bf16_t* IUt = (const bf16_t*)(F.ws + WS_IUT) + (size_t)hd * 4096;
    const LAS float* pra = (const LAS float*)(F.lds + LDS_PARA); const LAS float* prb = (const LAS float*)(F.lds + LDS_PARB);
    float n2 = 0.f;
#pragma unroll
    for (int jt = 0; jt < 2; ++jt)
#pragma unroll
        for (int g = 0; g < 4; ++g) { const int cj = hd * 64 + 32 * jt + 8 * g + 4 * h;
            const u32x2 a = *(const LAS u32x2*)(rowc + (512 + cj) * 2), p = *(const LAS u32x2*)(rowp + (512 + cj) * 2);
            const float kc[4] = {bf_lo(a.x), bf_hi(a.x), bf_lo(a.y), bf_hi(a.y)}, kq[4] = {bf_lo(p.x), bf_hi(p.x), bf_lo(p.y), bf_hi(p.y)};
            #pragma unroll
            for (int q = 0; q < 4; ++q) { const float muk = pra[(cj + q) * 4 + 1], kkp = prb[(cj + q) * 4 + 1]; const float k_ = kc[q] + muk * (kq[q] - kc[q]); const float kk_ = k_ * kkp; n2 += kk_ * kk_; } }
    n2 += __shfl_xor(n2, 32);
    const float inv = 1.0f / __builtin_fmaxf(sqrtf(n2), 1e-12f);
    float pcd[2] = {0.f, 0.f};
    float bns = 0.f;
    const ElemCtx EC{rowc, rowp, DUt, IUt, pra, prb, hd, r, h, inv};
    f32x16 Aab = f32x16{}, Aak = f32x16{}, Arb = f32x16{}, Ark = f32x16{};
    bf16x8 fRt[2][2], tAt[2][2];
    { bf16x8 fId[2]; mk_id(fId, r, h);
#pragma unroll
    for (int jt = 0; jt < 2; ++jt) { bf16x8 fA[2], fB[2], fK[2]; float pd_ = 0.f;
        r1_elem<0>(EC, jt, fA, fRt[jt], fB, fK, bns, pd_);
        const bf16x8 fA0 = fA[0], fA1 = fA[1], fB0 = fB[0], fB1 = fB[1], fK0 = fK[0], fK1 = fK[1];
        Aab = RK_MF(fB0, fA0, Aab); Aab = RK_MF(fB1, fA1, Aab); Aak = RK_MF(fK0, fA0, Aak); Aak = RK_MF(fK1, fA1, Aak);
        Arb = RK_MF(fB0, fRt[jt][0], Arb); Arb = RK_MF(fB1, fRt[jt][1], Arb); Ark = RK_MF(fK0, fRt[jt][0], Ark); Ark = RK_MF(fK1, fRt[jt][1], Ark);
        { f32x16 t_ = f32x16{}; t_ = RK_MF(fA0, fId[0], t_); t_ = RK_MF(fA1, fId[1], t_); tAt[jt][0] = frag<0>(t_); tAt[jt][1] = frag<1>(t_); } } }
    bns += __shfl_xor(bns, 32);
    if (h == 0) ((float*)(F.ws + WS_TOPW))[(m0 + r) * 8 + hd] = bns;
    LAS unsigned char* stash = IMG + (1 + ((tid & 63) >> 3)) * PZ + hd * 128 + (tid & 7) * 16;
#pragma unroll
    for (int p = 0; p < 4; ++p) *(LAS u32x4*)(stash + 8 * p * PZ) = __builtin_bit_cast(u32x4, fRt[p >> 1][p & 1]);
#pragma unroll
    for (int i = 0; i < 16; ++i) { const int s = 8 * (i >> 2) + 4 * h + (i & 3);
        if (!(s < r)) { Aab[i] = 0.f; Aak[i] = 0.f; } if (!(s <= r)) { Arb[i] = 0.f; Ark[i] = 0.f; } }
    const bf16x8 fAak[2] = {frag<0>(Aak), frag<1>(Aak)}, fArb[2] = {frag<0>(Arb), frag<1>(Arb)}, fArk[2] = {frag<0>(Ark), frag<1>(Ark)};
    bf16x8 fT[2];
    asm volatile("" ::: "memory"); __builtin_amdgcn_sched_barrier(0);
    { float T[32];
#pragma unroll
      for (int s = 0; s < 32; ++s) T[s] = (r == s) ? 1.0f : 0.f;
#define TI_RL(k_, is_, ln_) { const float ac_ = Aab[is_]; asm volatile("v_readlane_b32 %0, %1, " #ln_ : "=s"(sv_[k_]) : "v"(__float_as_int(ac_))); }
#define TI_FM(s_, u_, k_) T[s_] = __builtin_fmaf(T[u_], __int_as_float(sv_[k_]), T[s_]);
      if (!PROBE_TINV_ID) { int sv_[8];
        TI_RL(0, 0, 31) TI_RL(1, 1, 31) TI_RL(2, 2, 31) TI_RL(3, 3, 31) TI_RL(4, 0, 63) TI_RL(5, 1, 63) TI_RL(6, 2, 63) TI_RL(7, 3, 63)
        TI_FM(0, 31, 0) TI_FM(1, 31, 1) TI_FM(2, 31, 2) TI_FM(3, 31, 3) TI_FM(4, 31, 4) TI_FM(5, 31, 5) TI_FM(6, 31, 6) TI_FM(7, 31, 7)
        TI_RL(0, 4, 31) TI_RL(1, 5, 31) TI_RL(2, 6, 31) TI_RL(3, 7, 31) TI_RL(4, 4, 63) TI_RL(5, 5, 63) TI_RL(6, 6, 63) TI_RL(7, 7, 63)
        TI_FM(8, 31, 0) TI_FM(9, 31, 1) TI_FM(10, 31, 2) TI_FM(11, 31, 3) TI_FM(12, 31, 4) TI_FM(13, 31, 5) TI_FM(14, 31, 6) TI_FM(15, 31, 7)
        TI_RL(0, 8, 31) TI_RL(1, 9, 31) TI_RL(2, 10, 31) TI_RL(3, 11, 31) TI_RL(4, 8, 63) TI_RL(5, 9, 63) TI_RL(6, 10, 63) TI_RL(7, 11, 63)
        TI_FM(16, 31, 0) TI_FM(17, 31, 1) TI_FM(18, 31, 2) TI_FM(19, 31, 3) TI_FM(20, 31, 4) TI_FM(21, 31, 5) TI_FM(22, 31, 6) TI_FM(23, 31, 7)
        TI_RL(0, 12, 31) TI_RL(1, 13, 31) TI_RL(2, 14, 31) TI_RL(3, 15, 31) TI_RL(4, 12, 63) TI_RL(5, 13, 63) TI_RL(6, 14, 63)
        TI_FM(24, 31, 0) TI_FM(25, 31, 1) TI_FM(26, 31, 2) TI_FM(27, 31, 3) TI_FM(28, 31, 4) TI_FM(29, 31, 5) TI_FM(30, 31, 6)
        TI_RL(0, 0, 30) TI_RL(1, 1, 30) TI_RL(2, 2, 30) TI_RL(3, 3, 30) TI_RL(4, 0, 62) TI_RL(5, 1, 62) TI_RL(6, 2, 62) TI_RL(7, 3, 62)
        TI_FM(0, 30, 0) TI_FM(1, 30, 1) TI_FM(2, 30, 2) TI_FM(3, 30, 3) TI_FM(4, 30, 4) TI_FM(5, 30, 5) TI_FM(6, 30, 6) TI_FM(7, 30, 7)
        TI_RL(0, 4, 30) TI_RL(1, 5, 30) TI_RL(2, 6, 30) TI_RL(3, 7, 30) TI_RL(4, 4, 62) TI_RL(5, 5, 62) TI_RL(6, 6, 62) TI_RL(7, 7, 62)
        TI_FM(8, 30, 0) TI_FM(9, 30, 1) TI_FM(10, 30, 2) TI_FM(11, 30, 3) TI_FM(12, 30, 4) TI_FM(13, 30, 5) TI_FM(14, 30, 6) TI_FM(15, 30, 7)
        TI_RL(0, 8, 30) TI_RL(1, 9, 30) TI_RL(2, 10, 30) TI_RL(3, 11, 30) TI_RL(4, 8, 62) TI_RL(5, 9, 62) TI_RL(6, 10, 62) TI_RL(7, 11, 62)
        TI_FM(16, 30, 0) TI_FM(17, 30, 1) TI_FM(18, 30, 2) TI_FM(19, 30, 3) TI_FM(20, 30, 4) TI_FM(21, 30, 5) TI_FM(22, 30, 6) TI_FM(23, 30, 7)
        TI_RL(0, 12, 30) TI_RL(1, 13, 30) TI_RL(2, 14, 30) TI_RL(3, 15, 30) TI_RL(4, 12, 62) TI_RL(5, 13, 62)
        TI_FM(24, 30, 0) TI_FM(25, 30, 1) TI_FM(26, 30, 2) TI_FM(27, 30, 3) TI_FM(28, 30, 4) TI_FM(29, 30, 5)
        TI_RL(0, 0, 29) TI_RL(1, 1, 29) TI_RL(2, 2, 29) TI_RL(3, 3, 29) TI_RL(4, 0, 61) TI_RL(5, 1, 61) TI_RL(6, 2, 61) TI_RL(7, 3, 61)
        TI_FM(0, 29, 0) TI_FM(1, 29, 1) TI_FM(2, 29, 2) TI_FM(3, 29, 3) TI_FM(4, 29, 4) TI_FM(5, 29, 5) TI_FM(6, 29, 6) TI_FM(7, 29, 7)
        TI_RL(0, 4, 29) TI_RL(1, 5, 29) TI_RL(2, 6, 29) TI_RL(3, 7, 29) TI_RL(4, 4, 61) TI_RL(5, 5, 61) TI_RL(6, 6, 61) TI_RL(7, 7, 61)
        TI_FM(8, 29, 0) TI_FM(9, 29, 1) TI_FM(10, 29, 2) TI_FM(11, 29, 3) TI_FM(12, 29, 4) TI_FM(13, 29, 5) TI_FM(14, 29, 6) TI_FM(15, 29, 7)
        TI_RL(0, 8, 29) TI_RL(1, 9, 29) TI_RL(2, 10, 29) TI_RL(3, 11, 29) TI_RL(4, 8, 61) TI_RL(5, 9, 61) TI_RL(6, 10, 61) TI_RL(7, 11, 61)
        TI_FM(16, 29, 0) TI_FM(17, 29, 1) TI_FM(18, 29, 2) TI_FM(19, 29, 3) TI_FM(20, 29, 4) TI_FM(21, 29, 5) TI_FM(22, 29, 6) TI_FM(23, 29, 7)
        TI_RL(0, 12, 29) TI_RL(1, 13, 29) TI_RL(2, 14, 29) TI_RL(3, 15, 29) TI_RL(4, 12, 61)
        TI_FM(24, 29, 0) TI_FM(25, 29, 1) TI_FM(26, 29, 2) TI_FM(27, 29, 3) TI_FM(28, 29, 4)
        TI_RL(0, 0, 28) TI_RL(1, 1, 28) TI_RL(2, 2, 28) TI_RL(3, 3, 28) TI_RL(4, 0, 60) TI_RL(5, 1, 60) TI_RL(6, 2, 60) TI_RL(7, 3, 60)
        TI_FM(0, 28, 0) TI_FM(1, 28, 1) TI_FM(2, 28, 2) TI_FM(3, 28, 3) TI_FM(4, 28, 4) TI_FM(5, 28, 5) TI_FM(6, 28, 6) TI_FM(7, 28, 7)
        TI_RL(0, 4, 28) TI_RL(1, 5, 28) TI_RL(2, 6, 28) TI_RL(3, 7, 28) TI_RL(4, 4, 60) TI_RL(5, 5, 60) TI_RL(6, 6, 60) TI_RL(7, 7, 60)
        TI_FM(8, 28, 0) TI_FM(9, 28, 1) TI_FM(10, 28, 2) TI_FM(11, 28, 3) TI_FM(12, 28, 4) TI_FM(13, 28, 5) TI_FM(14, 28, 6) TI_FM(15, 28, 7)
        TI_RL(0, 8, 28) TI_RL(1, 9, 28) TI_RL(2, 10, 28) TI_RL(3, 11, 28) TI_RL(4, 8, 60) TI_RL(5, 9, 60) TI_RL(6, 10, 60) TI_RL(7, 11, 60)
        TI_FM(16, 28, 0) TI_FM(17, 28, 1) TI_FM(18, 28, 2) TI_FM(19, 28, 3) TI_FM(20, 28, 4) TI_FM(21, 28, 5) TI_FM(22, 28, 6) TI_FM(23, 28, 7)
        TI_RL(0, 12, 28) TI_RL(1, 13, 28) TI_RL(2, 14, 28) TI_RL(3, 15, 28)
        TI_FM(24, 28, 0) TI_FM(25, 28, 1) TI_FM(26, 28, 2) TI_FM(27, 28, 3)
        TI_RL(0, 0, 27) TI_RL(1, 1, 27) TI_RL(2, 2, 27) TI_RL(3, 3, 27) TI_RL(4, 0, 59) TI_RL(5, 1, 59) TI_RL(6, 2, 59) TI_RL(7, 3, 59)
        TI_FM(0, 27, 0) TI_FM(1, 27, 1) TI_FM(2, 27, 2) TI_FM(3, 27, 3) TI_FM(4, 27, 4) TI_FM(5, 27, 5) TI_FM(6, 27, 6) TI_FM(7, 27, 7)
        TI_RL(0, 4, 27) TI_RL(1, 5, 27) TI_RL(2, 6, 27) TI_RL(3, 7, 27) TI_RL(4, 4, 59) TI_RL(5, 5, 59) TI_RL(6, 6, 59) TI_RL(7, 7, 59)
        TI_FM(8, 27, 0) TI_FM(9, 27, 1) TI_FM(10, 27, 2) TI_FM(11, 27, 3) TI_FM(12, 27, 4) TI_FM(13, 27, 5) TI_FM(14, 27, 6) TI_FM(15, 27, 7)
        TI_RL(0, 8, 27) TI_RL(1, 9, 27) TI_RL(2, 10, 27) TI_RL(3, 11, 27) TI_RL(4, 8, 59) TI_RL(5, 9, 59) TI_RL(6, 10, 59) TI_RL(7, 11, 59)
        TI_FM(16, 27, 0) TI_FM(17, 27, 1) TI_FM(18, 27, 2) TI_FM(19, 27, 3) TI_FM(20, 27, 4) TI_FM(21, 27, 5) TI_FM(22, 27, 6) TI_FM(23, 27, 7)
        TI_RL(0, 12, 27) TI_RL(1, 13, 27) TI_RL(2, 14, 27)
        TI_FM(24, 27, 0) TI_FM(25, 27, 1) TI_FM(26, 27, 2)
        TI_RL(0, 0, 26) TI_RL(1, 1, 26) TI_RL(2, 2, 26) TI_RL(3, 3, 26) TI_RL(4, 0, 58) TI_RL(5, 1, 58) TI_RL(6, 2, 58) TI_RL(7, 3, 58)
        TI_FM(0, 26, 0) TI_FM(1, 26, 1) TI_FM(2, 26, 2) TI_FM(3, 26, 3) TI_FM(4, 26, 4) TI_FM(5, 26, 5) TI_FM(6, 26, 6) TI_FM(7, 26, 7)
        TI_RL(0, 4, 26) TI_RL(1, 5, 26) TI_RL(2, 6, 26) TI_RL(3, 7, 26) TI_RL(4, 4, 58) TI_RL(5, 5, 58) TI_RL(6, 6, 58) TI_RL(7, 7, 58)
        TI_FM(8, 26, 0) TI_FM(9, 26, 1) TI_FM(10, 26, 2) TI_FM(11, 26, 3) TI_FM(12, 26, 4) TI_FM(13, 26, 5) TI_FM(14, 26, 6) TI_FM(15, 26, 7)
        TI_RL(0, 8, 26) TI_RL(1, 9, 26) TI_RL(2, 10, 26) TI_RL(3, 11, 26) TI_RL(4, 8, 58) TI_RL(5, 9, 58) TI_RL(6, 10, 58) TI_RL(7, 11, 58)
        TI_FM(16, 26, 0) TI_FM(17, 26, 1) TI_FM(18, 26, 2) TI_FM(19, 26, 3) TI_FM(20, 26, 4) TI_FM(21, 26, 5) TI_FM(22, 26, 6) TI_FM(23, 26, 7)
        TI_RL(0, 12, 26) TI_RL(1, 13, 26)
        TI_FM(24, 26, 0) TI_FM(25, 26, 1)
        TI_RL(0, 0, 25) TI_RL(1, 1, 25) TI_RL(2, 2, 25) TI_RL(3, 3, 25) TI_RL(4, 0, 57) TI_RL(5, 1, 57) TI_RL(6, 2, 57) TI_RL(7, 3, 57)
        TI_FM(0, 25, 0) TI_FM(1, 25, 1) TI_FM(2, 25, 2) TI_FM(3, 25, 3) TI_FM(4, 25, 4) TI_FM(5, 25, 5) TI_FM(6, 25, 6) TI_FM(7, 25, 7)
        TI_RL(0, 4, 25) TI_RL(1, 5, 25) TI_RL(2, 6, 25) TI_RL(3, 7, 25) TI_RL(4, 4, 57) TI_RL(5, 5, 57) TI_RL(6, 6, 57) TI_RL(7, 7, 57)
        TI_FM(8, 25, 0) TI_FM(9, 25, 1) TI_FM(10, 25, 2) TI_FM(11, 25, 3) TI_FM(12, 25, 4) TI_FM(13, 25, 5) TI_FM(14, 25, 6) TI_FM(15, 25, 7)
        TI_RL(0, 8, 25) TI_RL(1, 9, 25) TI_RL(2, 10, 25) TI_RL(3, 11, 25) TI_RL(4, 8, 57) TI_RL(5, 9, 57) TI_RL(6, 10, 57) TI_RL(7, 11, 57)
        TI_FM(16, 25, 0) TI_FM(17, 25, 1) TI_FM(18, 25, 2) TI_FM(19, 25, 3) TI_FM(20, 25, 4) TI_FM(21, 25, 5) TI_FM(22, 25, 6) TI_FM(23, 25, 7)
        TI_RL(0, 12, 25)
        TI_FM(24, 25, 0)
        TI_RL(0, 0, 24) TI_RL(1, 1, 24) TI_RL(2, 2, 24) TI_RL(3, 3, 24) TI_RL(4, 0, 56) TI_RL(5, 1, 56) TI_RL(6, 2, 56) TI_RL(7, 3, 56)
        TI_FM(0, 24, 0) TI_FM(1, 24, 1) TI_FM(2, 24, 2) TI_FM(3, 24, 3) TI_FM(4, 24, 4) TI_FM(5, 24, 5) TI_FM(6, 24, 6) TI_FM(7, 24, 7)
        TI_RL(0, 4, 24) TI_RL(1, 5, 24) TI_RL(2, 6, 24) TI_RL(3, 7, 24) TI_RL(4, 4, 56) TI_RL(5, 5, 56) TI_RL(6, 6, 56) TI_RL(7, 7, 56)
        TI_FM(8, 24, 0) TI_FM(9, 24, 1) TI_FM(10, 24, 2) TI_FM(11, 24, 3) TI_FM(12, 24, 4) TI_FM(13, 24, 5) TI_FM(14, 24, 6) TI_FM(15, 24, 7)
        TI_RL(0, 8, 24) TI_RL(1, 9, 24) TI_RL(2, 10, 24) TI_RL(3, 11, 24) TI_RL(4, 8, 56) TI_RL(5, 9, 56) TI_RL(6, 10, 56) TI_RL(7, 11, 56)
        TI_FM(16, 24, 0) TI_FM(17, 24, 1) TI_FM(18, 24, 2) TI_FM(19, 24, 3) TI_FM(20, 24, 4) TI_FM(21, 24, 5) TI_FM(22, 24, 6) TI_FM(23, 24, 7)
        TI_RL(0, 0, 23) TI_RL(1, 1, 23) TI_RL(2, 2, 23) TI_RL(3, 3, 23) TI_RL(4, 0, 55) TI_RL(5, 1, 55) TI_RL(6, 2, 55) TI_RL(7, 3, 55)
        TI_FM(0, 23, 0) TI_FM(1, 23, 1) TI_FM(2, 23, 2) TI_FM(3, 23, 3) TI_FM(4, 23, 4) TI_FM(5, 23, 5) TI_FM(6, 23, 6) TI_FM(7, 23, 7)
        TI_RL(0, 4, 23) TI_RL(1, 5, 23) TI_RL(2, 6, 23) TI_RL(3, 7, 23) TI_RL(4, 4, 55) TI_RL(5, 5, 55) TI_RL(6, 6, 55) TI_RL(7, 7, 55)
        TI_FM(8, 23, 0) TI_FM(9, 23, 1) TI_FM(10, 23, 2) TI_FM(11, 23, 3) TI_FM(12, 23, 4) TI_FM(13, 23, 5) TI_FM(14, 23, 6) TI_FM(15, 23, 7)
        TI_RL(0, 8, 23) TI_RL(1, 9, 23) TI_RL(2, 10, 23) TI_RL(3, 11, 23) TI_RL(4, 8, 55) TI_RL(5, 9, 55) TI_RL(6, 10, 55)
        TI_FM(16, 23, 0) TI_FM(17, 23, 1) TI_FM(18, 23, 2) TI_FM(19, 23, 3) TI_FM(20, 23, 4) TI_FM(21, 23, 5) TI_FM(22, 23, 6)
        TI_RL(0, 0, 22) TI_RL(1, 1, 22) TI_RL(2, 2, 22) TI_RL(3, 3, 22) TI_RL(4, 0, 54) TI_RL(5, 1, 54) TI_RL(6, 2, 54) TI_RL(7, 3, 54)
        TI_FM(0, 22, 0) TI_FM(1, 22, 1) TI_FM(2, 22, 2) TI_FM(3, 22, 3) TI_FM(4, 22, 4) TI_FM(5, 22, 5) TI_FM(6, 22, 6) TI_FM(7, 22, 7)
        TI_RL(0, 4, 22) TI_RL(1, 5, 22) TI_RL(2, 6, 22) TI_RL(3, 7, 22) TI_RL(4, 4, 54) TI_RL(5, 5, 54) TI_RL(6, 6, 54) TI_RL(7, 7, 54)
        TI_FM(8, 22, 0) TI_FM(9, 22, 1) TI_FM(10, 22, 2) TI_FM(11, 22, 3) TI_FM(12, 22, 4) TI_FM(13, 22, 5) TI_FM(14, 22, 6) TI_FM(15, 22, 7)
        TI_RL(0, 8, 22) TI_RL(1, 9, 22) TI_RL(2, 10, 22) TI_RL(3, 11, 22) TI_RL(4, 8, 54) TI_RL(5, 9, 54)
        TI_FM(16, 22, 0) TI_FM(17, 22, 1) TI_FM(18, 22, 2) TI_FM(19, 22, 3) TI_FM(20, 22, 4) TI_FM(21, 22, 5)
        TI_RL(0, 0, 21) TI_RL(1, 1, 21) TI_RL(2, 2, 21) TI_RL(3, 3, 21) TI_RL(4, 0, 53) TI_RL(5, 1, 53) TI_RL(6, 2, 53) TI_RL(7, 3, 53)
        TI_FM(0, 21, 0) TI_FM(1, 21, 1) TI_FM(2, 21, 2) TI_FM(3, 21, 3) TI_FM(4, 21, 4) TI_FM(5, 21, 5) TI_FM(6, 21, 6) TI_FM(7, 21, 7)
        TI_RL(0, 4, 21) TI_RL(1, 5, 21) TI_RL(2, 6, 21) TI_RL(3, 7, 21) TI_RL(4, 4, 53) TI_RL(5, 5, 53) TI_RL(6, 6, 53) TI_RL(7, 7, 53)
        TI_FM(8, 21, 0) TI_FM(9, 21, 1) TI_FM(10, 21, 2) TI_FM(11, 21, 3) TI_FM(12, 21, 4) TI_FM(13, 21, 5) TI_FM(14, 21, 6) TI_FM(15, 21, 7)
        TI_RL(0, 8, 21) TI_RL(1, 9, 21) TI_RL(2, 10, 21) TI_RL(3, 11, 21) TI_RL(4, 8, 53)
        TI_FM(16, 21, 0) TI_FM(17, 21, 1) TI_FM(18, 21, 2) TI_FM(19, 21, 3) TI_FM(20, 21, 4)
        TI_RL(0, 0, 20) TI_RL(1, 1, 20) TI_RL(2, 2, 20) TI_RL(3, 3, 20) TI_RL(4, 0, 52) TI_RL(5, 1, 52) TI_RL(6, 2, 52) TI_RL(7, 3, 52)
        TI_FM(0, 20, 0) TI_FM(1, 20, 1) TI_FM(2, 20, 2) TI_FM(3, 20, 3) TI_FM(4, 20, 4) TI_FM(5, 20, 5) TI_FM(6, 20, 6) TI_FM(7, 20, 7)
        TI_RL(0, 4, 20) TI_RL(1, 5, 20) TI_RL(2, 6, 20) TI_RL(3, 7, 20) TI_RL(4, 4, 52) TI_RL(5, 5, 52) TI_RL(6, 6, 52) TI_RL(7, 7, 52)
        TI_FM(8, 20, 0) TI_FM(9, 20, 1) TI_FM(10, 20, 2) TI_FM(11, 20, 3) TI_FM(12, 20, 4) TI_FM(13, 20, 5) TI_FM(14, 20, 6) TI_FM(15, 20, 7)
        TI_RL(0, 8, 20) TI_RL(1, 9, 20) TI_RL(2, 10, 20) TI_RL(3, 11, 20)
        TI_FM(16, 20, 0) TI_FM(17, 20, 1) TI_FM(18, 20, 2) TI_FM(19, 20, 3)
        TI_RL(0, 0, 19) TI_RL(1, 1, 19) TI_RL(2, 2, 19) TI_RL(3, 3, 19) TI_RL(4, 0, 51) TI_RL(5, 1, 51) TI_RL(6, 2, 51) TI_RL(7, 3, 51)
        TI_FM(0, 19, 0) TI_FM(1, 19, 1) TI_FM(2, 19, 2) TI_FM(3, 19, 3) TI_FM(4, 19, 4) TI_FM(5, 19, 5) TI_FM(6, 19, 6) TI_FM(7, 19, 7)
        TI_RL(0, 4, 19) TI_RL(1, 5, 19) TI_RL(2, 6, 19) TI_RL(3, 7, 19) TI_RL(4, 4, 51) TI_RL(5, 5, 51) TI_RL(6, 6, 51) TI_RL(7, 7, 51)
        TI_FM(8, 19, 0) TI_FM(9, 19, 1) TI_FM(10, 19, 2) TI_FM(11, 19, 3) TI_FM(12, 19, 4) TI_FM(13, 19, 5) TI_FM(14, 19, 6) TI_FM(15, 19, 7)
        TI_RL(0, 8, 19) TI_RL(1, 9, 19) TI_RL(2, 10, 19)
        TI_FM(16, 19, 0) TI_FM(17, 19, 1) TI_FM(18, 19, 2)
        TI_RL(0, 0, 18) TI_RL(1, 1, 18) TI_RL(2, 2, 18) TI_RL(3, 3, 18) TI_RL(4, 0, 50) TI_RL(5, 1, 50) TI_RL(6, 2, 50) TI_RL(7, 3, 50)
        TI_FM(0, 18, 0) TI_FM(1, 18, 1) TI_FM(2, 18, 2) TI_FM(3, 18, 3) TI_FM(4, 18, 4) TI_FM(5, 18, 5) TI_FM(6, 18, 6) TI_FM(7, 18, 7)
        TI_RL(0, 4, 18) TI_RL(1, 5, 18) TI_RL(2, 6, 18) TI_RL(3, 7, 18) TI_RL(4, 4, 50) TI_RL(5, 5, 50) TI_RL(6, 6, 50) TI_RL(7, 7, 50)
        TI_FM(8, 18, 0) TI_FM(9, 18, 1) TI_FM(10, 18, 2) TI_FM(11, 18, 3) TI_FM(12, 18, 4) TI_FM(13, 18, 5) TI_FM(14, 18, 6) TI_FM(15, 18, 7)
        TI_RL(0, 8, 18) TI_RL(1, 9, 18)
        TI_FM(16, 18, 0) TI_FM(17, 18, 1)
        TI_RL(0, 0, 17) TI_RL(1, 1, 17) TI_RL(2, 2, 17) TI_RL(3, 3, 17) TI_RL(4, 0, 49) TI_RL(5, 1, 49) TI_RL(6, 2, 49) TI_RL(7, 3, 49)
        TI_FM(0, 17, 0) TI_FM(1, 17, 1) TI_FM(2, 17, 2) TI_FM(3, 17, 3) TI_FM(4, 17, 4) TI_FM(5, 17, 5) TI_FM(6, 17, 6) TI_FM(7, 17, 7)
        TI_RL(0, 4, 17) TI_RL(1, 5, 17) TI_RL(2, 6, 17) TI_RL(3, 7, 17) TI_RL(4, 4, 49) TI_RL(5, 5, 49) TI_RL(6, 6, 49) TI_RL(7, 7, 49)
        TI_FM(8, 17, 0) TI_FM(9, 17, 1) TI_FM(10, 17, 2) TI_FM(11, 17, 3) TI_FM(12, 17, 4) TI_FM(13, 17, 5) TI_FM(14, 17, 6) TI_FM(15, 17, 7)
        TI_RL(0, 8, 17)
        TI_FM(16, 17, 0)
        TI_RL(0, 0, 16) TI_RL(1, 1, 16) TI_RL(2, 2, 16) TI_RL(3, 3, 16) TI_RL(4, 0, 48) TI_RL(5, 1, 48) TI_RL(6, 2, 48) TI_RL(7, 3, 48)
        TI_FM(0, 16, 0) TI_FM(1, 16, 1) TI_FM(2, 16, 2) TI_FM(3, 16, 3) TI_FM(4, 16, 4) TI_FM(5, 16, 5) TI_FM(6, 16, 6) TI_FM(7, 16, 7)
        TI_RL(0, 4, 16) TI_RL(1, 5, 16) TI_RL(2, 6, 16) TI_RL(3, 7, 16) TI_RL(4, 4, 48) TI_RL(5, 5, 48) TI_RL(6, 6, 48) TI_RL(7, 7, 48)
        TI_FM(8, 16, 0) TI_FM(9, 16, 1) TI_FM(10, 16, 2) TI_FM(11, 16, 3) TI_FM(12, 16, 4) TI_FM(13, 16, 5) TI_FM(14, 16, 6) TI_FM(15, 16, 7)
        TI_RL(0, 0, 15) TI_RL(1, 1, 15) TI_RL(2, 2, 15) TI_RL(3, 3, 15) TI_RL(4, 0, 47) TI_RL(5, 1, 47) TI_RL(6, 2, 47) TI_RL(7, 3, 47)
        TI_FM(0, 15, 0) TI_FM(1, 15, 1) TI_FM(2, 15, 2) TI_FM(3, 15, 3) TI_FM(4, 15, 4) TI_FM(5, 15, 5) TI_FM(6, 15, 6) TI_FM(7, 15, 7)
        TI_RL(0, 4, 15) TI_RL(1, 5, 15) TI_RL(2, 6, 15) TI_RL(3, 7, 15) TI_RL(4, 4, 47) TI_RL(5, 5, 47) TI_RL(6, 6, 47)
        TI_FM(8, 15, 0) TI_FM(9, 15, 1) TI_FM(10, 15, 2) TI_FM(11, 15, 3) TI_FM(12, 15, 4) TI_FM(13, 15, 5) TI_FM(14, 15, 6)
        TI_RL(0, 0, 14) TI_RL(1, 1, 14) TI_RL(2, 2, 14) TI_RL(3, 3, 14) TI_RL(4, 0, 46) TI_RL(5, 1, 46) TI_RL(6, 2, 46) TI_RL(7, 3, 46)
        TI_FM(0, 14, 0) TI_FM(1, 14, 1) TI_FM(2, 14, 2) TI_FM(3, 14, 3) TI_FM(4, 14, 4) TI_FM(5, 14, 5) TI_FM(6, 14, 6) TI_FM(7, 14, 7)
        TI_RL(0, 4, 14) TI_RL(1, 5, 14) TI_RL(2, 6, 14) TI_RL(3, 7, 14) TI_RL(4, 4, 46) TI_RL(5, 5, 46)
        TI_FM(8, 14, 0) TI_FM(9, 14, 1) TI_FM(10, 14, 2) TI_FM(11, 14, 3) TI_FM(12, 14, 4) TI_FM(13, 14, 5)
        TI_RL(0, 0, 13) TI_RL(1, 1, 13) TI_RL(2, 2, 13) TI_RL(3, 3, 13) TI_RL(4, 0, 45) TI_RL(5, 1, 45) TI_RL(6, 2, 45) TI_RL(7, 3, 45)
        TI_FM(0, 13, 0) TI_FM(1, 13, 1) TI_FM(2, 13, 2) TI_FM(3, 13, 3) TI_FM(4, 13, 4) TI_FM(5, 13, 5) TI_FM(6, 13, 6) TI_FM(7, 13, 7)
        TI_RL(0, 4, 13) TI_RL(1, 5, 13) TI_RL(2, 6, 13) TI_RL(3, 7, 13) TI_RL(4, 4, 45)
        TI_FM(8, 13, 0) TI_FM(9, 13, 1) TI_FM(10, 13, 2) TI_FM(11, 13, 3) TI_FM(12, 13, 4)
        TI_RL(0, 0, 12) TI_RL(1, 1, 12) TI_RL(2, 2, 12) TI_RL(3, 3, 12) TI_RL(4, 0, 44) TI_RL(5, 1, 44) TI_RL(6, 2, 44) TI_RL(7, 3, 44)
        TI_FM(0, 12, 0) TI_FM(1, 12, 1) TI_FM(2, 12, 2) TI_FM(3, 12, 3) TI_FM(4, 12, 4) TI_FM(5, 12, 5) TI_FM(6, 12, 6) TI_FM(7, 12, 7)
        TI_RL(0, 4, 12) TI_RL(1, 5, 12) TI_RL(2, 6, 12) TI_RL(3, 7, 12)
        TI_FM(8, 12, 0) TI_FM(9, 12, 1) TI_FM(10, 12, 2) TI_FM(11, 12, 3)
        TI_RL(0, 0, 11) TI_RL(1, 1, 11) TI_RL(2, 2, 11) TI_RL(3, 3, 11) TI_RL(4, 0, 43) TI_RL(5, 1, 43) TI_RL(6, 2, 43) TI_RL(7, 3, 43)
        TI_FM(0, 11, 0) TI_FM(1, 11, 1) TI_FM(2, 11, 2) TI_FM(3, 11, 3) TI_FM(4, 11, 4) TI_FM(5, 11, 5) TI_FM(6, 11, 6) TI_FM(7, 11, 7)
        TI_RL(0, 4, 11) TI_RL(1, 5, 11) TI_RL(2, 6, 11)
        TI_FM(8, 11, 0) TI_FM(9, 11, 1) TI_FM(10, 11, 2)
        TI_RL(0, 0, 10) TI_RL(1, 1, 10) TI_RL(2, 2, 10) TI_RL(3, 3, 10) TI_RL(4, 0, 42) TI_RL(5, 1, 42) TI_RL(6, 2, 42) TI_RL(7, 3, 42)
        TI_FM(0, 10, 0) TI_FM(1, 10, 1) TI_FM(2, 10, 2) TI_FM(3, 10, 3) TI_FM(4, 10, 4) TI_FM(5, 10, 5) TI_FM(6, 10, 6) TI_FM(7, 10, 7)
        TI_RL(0, 4, 10) TI_RL(1, 5, 10)
        TI_FM(8, 10, 0) TI_FM(9, 10, 1)
        TI_RL(0, 0, 9) TI_RL(1, 1, 9) TI_RL(2, 2, 9) TI_RL(3, 3, 9) TI_RL(4, 0, 41) TI_RL(5, 1, 41) TI_RL(6, 2, 41) TI_RL(7, 3, 41)
        TI_FM(0, 9, 0) TI_FM(1, 9, 1) TI_FM(2, 9, 2) TI_FM(3, 9, 3) TI_FM(4, 9, 4) TI_FM(5, 9, 5) TI_FM(6, 9, 6) TI_FM(7, 9, 7)
        TI_RL(0, 4, 9)
        TI_FM(8, 9, 0)
        TI_RL(0, 0, 8) TI_RL(1, 1, 8) TI_RL(2, 2, 8) TI_RL(3, 3, 8) TI_RL(4, 0, 40) TI_RL(5, 1, 40) TI_RL(6, 2, 40) TI_RL(7, 3, 40)
        TI_FM(0, 8, 0) TI_FM(1, 8, 1) TI_FM(2, 8, 2) TI_FM(3, 8, 3) TI_FM(4, 8, 4) TI_FM(5, 8, 5) TI_FM(6, 8, 6) TI_FM(7, 8, 7)
        TI_RL(0, 0, 7) TI_RL(1, 1, 7) TI_RL(2, 2, 7) TI_RL(3, 3, 7) TI_RL(4, 0, 39) TI_RL(5, 1, 39) TI_RL(6, 2, 39)
        TI_FM(0, 7, 0) TI_FM(1, 7, 1) TI_FM(2, 7, 2) TI_FM(3, 7, 3) TI_FM(4, 7, 4) TI_FM(5, 7, 5) TI_FM(6, 7, 6)
        TI_RL(0, 0, 6) TI_RL(1, 1, 6) TI_RL(2, 2, 6) TI_RL(3, 3, 6) TI_RL(4, 0, 38) TI_RL(5, 1, 38)
        TI_FM(0, 6, 0) TI_FM(1, 6, 1) TI_FM(2, 6, 2) TI_FM(3, 6, 3) TI_FM(4, 6, 4) TI_FM(5, 6, 5)
        TI_RL(0, 0, 5) TI_RL(1, 1, 5) TI_RL(2, 2, 5) TI_RL(3, 3, 5) TI_RL(4, 0, 37)
        TI_FM(0, 5, 0) TI_FM(1, 5, 1) TI_FM(2, 5, 2) TI_FM(3, 5, 3) TI_FM(4, 5, 4)
        TI_RL(0, 0, 4) TI_RL(1, 1, 4) TI_RL(2, 2, 4) TI_RL(3, 3, 4)
        TI_FM(0, 4, 0) TI_FM(1, 4, 1) TI_FM(2, 4, 2) TI_FM(3, 4, 3)
        TI_RL(0, 0, 3) TI_RL(1, 1, 3) TI_RL(2, 2, 3)
        TI_FM(0, 3, 0) TI_FM(1, 3, 1) TI_FM(2, 3, 2)
        TI_RL(0, 0, 2) TI_RL(1, 1, 2)
        TI_FM(0, 2, 0) TI_FM(1, 2, 1)
        TI_RL(0, 0, 1)
        TI_FM(0, 1, 0)
      }
#undef TI_RL
#undef TI_FM

#pragma unroll
      for (int s = 0; s < 2; ++s) { float e8[8];
#pragma unroll
          for (int jj = 0; jj < 8; ++jj) { const int i0 = 16 * s + 8 * (jj >> 2) + (jj & 3); float ta = T[i0], tb = T[i0 + 4]; asm volatile("" : "+v"(ta), "+v"(tb)); e8[jj] = h ? tb : ta; }
          fT[s] = __builtin_bit_cast(bf16x8, (u32x4){cvtpk(e8[0], e8[1]), cvtpk(e8[2], e8[3]), cvtpk(e8[4], e8[5]), cvtpk(e8[6], e8[7])}); } }
    asm volatile("" ::: "memory"); __builtin_amdgcn_sched_barrier(0);
    const size_t uid = ((size_t)(b * 8 + hd) * 128 + c);
    unsigned char* gG = F.ws + WS_R0 + uid * SZ_G; unsigned char* gH = F.ws + WS_R2 + uid * SZ_H; unsigned char* gQ = F.ws + WS_H0 + uid * SZ_Q; unsigned char* gY = F.ws + WS_H1 + uid * SZ_Y;
#define RK_ST(base, piece, f) (*(u32x4*)((base) + (piece) * 1024 + (tid & 63) * 16) = __builtin_bit_cast(u32x4, (f)))
    bf16x8 fWt[2][2];
#pragma unroll
    for (int jt = 0; jt < 2; ++jt) { f32x16 w_ = f32x16{}; w_ = RK_MF(fT[0], tAt[jt][0], w_); w_ = RK_MF(fT[1], tAt[jt][1], w_); fWt[jt][0] = frag<0>(w_); fWt[jt][1] = frag<1>(w_);
        f32x16 q_; unfrag<0>(q_, __builtin_bit_cast(bf16x8, *(const LAS u32x4*)(stash + 8 * (2 * jt) * PZ))); unfrag<1>(q_, __builtin_bit_cast(bf16x8, *(const LAS u32x4*)(stash + 8 * (2 * jt + 1) * PZ)));
        q_ = RK_MF(fWt[jt][0], fArb[0], q_); q_ = RK_MF(fWt[jt][1], fArb[1], q_); RK_ST(gQ, 2 * jt, frag<0>(q_)); RK_ST(gQ, 2 * jt + 1, frag<1>(q_)); }
    bf16x8 tBh[2][2], tKh[2][2], tV[2][2];
    { bf16x8 fId[2]; mk_id(fId, r, h);
#pragma unroll
    for (int jt = 0; jt < 2; ++jt) { bf16x8 fBh[2], fKh[2], fV[2], fdum[2]; float bdum = 0.f;
        r1_elem<1>(EC, jt, fBh, fKh, fV, fdum, bdum, pcd[jt]);
        { f32x16 t_ = f32x16{}; t_ = RK_MF(fBh[0], fId[0], t_); t_ = RK_MF(fBh[1], fId[1], t_); tBh[jt][0] = frag<0>(t_); tBh[jt][1] = frag<1>(t_); }
        { f32x16 t_ = f32x16{}; t_ = RK_MF(fKh[0], fId[0], t_); t_ = RK_MF(fKh[1], fId[1], t_); tKh[jt][0] = frag<0>(t_); tKh[jt][1] = frag<1>(t_); }
        { f32x16 t_ = f32x16{}; t_ = RK_MF(fV[0], fId[0], t_); t_ = RK_MF(fV[1], fId[1], t_); tV[jt][0] = frag<0>(t_); tV[jt][1] = frag<1>(t_); } } }
    bf16x8 fUt[2][2];
#pragma unroll
    for (int it = 0; it < 2; ++it) { f32x16 av = f32x16{}; av = RK_MF(fAak[0], tV[it][0], av); av = RK_MF(fAak[1], tV[it][1], av);
        const bf16x8 fav0 = frag<0>(av), fav1 = frag<1>(av); f32x16 u_ = f32x16{}; u_ = RK_MF(fT[0], fav0, u_); u_ = RK_MF(fT[1], fav1, u_); fUt[it][0] = frag<0>(u_); fUt[it][1] = frag<1>(u_); }
#pragma unroll
    for (int it = 0; it < 2; ++it) { f32x16 y_ = f32x16{}; y_ = RK_MF(fUt[it][0], fArb[0], y_); y_ = RK_MF(fUt[it][1], fArb[1], y_); y_ = RK_MF(tV[it][0], fArk[0], y_); y_ = RK_MF(tV[it][1], fArk[1], y_);
        RK_ST(gY, 2 * it, frag<0>(y_)); RK_ST(gY, 2 * it + 1, frag<1>(y_)); }
#pragma unroll
    for (int jt = 0; jt < 2; ++jt)
#pragma unroll
        for (int j2 = 0; j2 < 2; ++j2) { f32x16 g_ = f32x16{}; g_ = RK_MF(fWt[jt][0], tBh[j2][0], g_); g_ = RK_MF(fWt[jt][1], tBh[j2][1], g_);
            if (jt == j2) {
#pragma unroll
                for (int i = 0; i < 16; ++i) if (i == 4 * (r >> 3) + (r & 3) && h == ((r >> 2) & 1)) g_[i] += pcd[jt]; }
            RK_ST(gG, 2 * (jt * 2 + j2), frag<0>(g_)); RK_ST(gG, 2 * (jt * 2 + j2) + 1, frag<1>(g_)); }
#pragma unroll
    for (int j2 = 0; j2 < 2; ++j2)
#pragma unroll
        for (int it = 0; it < 2; ++it) { f32x16 h_ = f32x16{}; h_ = RK_MF(tBh[j2][0], fUt[it][0], h_); h_ = RK_MF(tBh[j2][1], fUt[it][1], h_); h_ = RK_MF(tKh[j2][0], tV[it][0], h_); h_ = RK_MF(tKh[j2][1], tV[it][1], h_);
            RK_ST(gH, 2 * (j2 * 2 + it), frag<0>(h_)); RK_ST(gH, 2 * (j2 * 2 + it) + 1, frag<1>(h_)); }
}

template <int DRY> __device__ __forceinline__ void r2_task(const Args& args, Frame& F, int task) {
    const bool st_ok = !DRY || args.li == 12345;
    const int bh = task >> 1, it = task & 1;
    f32x16 St[2]; St[0] = f32x16{}; St[1] = f32x16{};
    const unsigned char* gG0 = F.ws + WS_R0 + (size_t)bh * 128 * SZ_G + F.lane * 16; unsigned char* gH0 = F.ws + WS_R2 + (size_t)bh * 128 * SZ_H + F.lane * 16;
    bf16x8 G0[2][2][2], H0[2][2], G1[2][2][2], H1[2][2], G2[2][2][2], H2[2][2];
#define R2_LOAD(G_, H_, c_) do { const int cc_ = (c_) < 128 ? (c_) : 127;     \
        _Pragma("unroll") for (int jt = 0; jt < 2; ++jt) _Pragma("unroll") for (int j2 = 0; j2 < 2; ++j2) _Pragma("unroll") for (int s = 0; s < 2; ++s) \
            G_[jt][j2][s] = __builtin_bit_cast(bf16x8, *(const u32x4*)(gG0 + (size_t)cc_ * SZ_G + (2 * (jt * 2 + j2) + s) * 1024)); \
        _Pragma("unroll") for (int j2 = 0; j2 < 2; ++j2) _Pragma("unroll") for (int s = 0; s < 2; ++s) H_[j2][s] = __builtin_bit_cast(bf16x8, *(const u32x4*)(gH0 + (size_t)cc_ * SZ_H + (2 * (j2 * 2 + it) + s) * 1024)); } while (0)
#define R2_STEP(G_, H_, c_, LOADNEXT) do { \
        const bf16x8 fS[2][2] = {{frag<0>(St[0]), frag<1>(St[0])}, {frag<0>(St[1]), frag<1>(St[1])}}; \
        if (st_ok) { _Pragma("unroll") for (int jt = 0; jt < 2; ++jt) _Pragma("unroll") for (int s = 0; s < 2; ++s) \
            *(u32x4*)(gH0 + (size_t)(c_) * SZ_H + (2 * (jt * 2 + it) + s) * 1024) = __builtin_bit_cast(u32x4, fS[jt][s]); }     \
        __builtin_amdgcn_sched_barrier(0); LOADNEXT; __builtin_amdgcn_sched_barrier(0);     \
        _Pragma("unroll") for (int j2 = 0; j2 < 2; ++j2) { unfrag<0>(St[j2], H_[j2][0]); unfrag<1>(St[j2], H_[j2][1]); \
            _Pragma("unroll") for (int jt = 0; jt < 2; ++jt) { St[j2] = RK_MF(G_[jt][j2][0], fS[jt][0], St[j2]); St[j2] = RK_MF(G_[jt][j2][1], fS[jt][1], St[j2]); } } \
        __builtin_amdgcn_sched_barrier(0); \
    } while (0)
    R2_LOAD(G0, H0, 0); R2_LOAD(G1, H1, 1);
#pragma unroll 1
    for (int c = 0; c < 126; c += 3) {
        R2_STEP(G0, H0, c, R2_LOAD(G2, H2, c + 2));
        R2_STEP(G1, H1, c + 1, R2_LOAD(G0, H0, c + 3));
        R2_STEP(G2, H2, c + 2, R2_LOAD(G1, H1, c + 4));
    }
    R2_STEP(G0, H0, 126, (void)0);
    R2_STEP(G1, H1, 127, (void)0);
#undef R2_STEP
#undef R2_LOAD
}

constexpr int PV2 = 1296;
__device__ __forceinline__ void r3_unit(const Args& args, Frame& F, int b, int c) {
    LAS unsigned char* IMG = F.lds;
    const bf16_t* Z = (const bf16_t*)(F.ws + WS_Z);
    const int t0 = 32 * c; const size_t m0 = (size_t)b * SEQ + t0;
    const float* mu = AIN(7);
    int tid = F.tid; asm volatile("" : "+v"(tid));
    __syncthreads();
    { const unsigned lds0 = (unsigned)(uintptr_t)IMG; const int ln = tid & 63;
      for (int task = F.wave; task < 33 * 2; task += NWAVES) { const int rr = task >> 1, j = task & 1, pc = 64 * j + ln;
          if (pc < 80) { const int col = j == 0 ? ZR_V + 8 * ln : ZR_GD + 8 * ln;
              if (rr > 0 || t0 > 0) att::glds16(Z + (m0 + rr - 1) * ZW + col, (unsigned)__builtin_amdgcn_readfirstlane((int)(lds0 + rr * PV2 + 1024 * j)));
              else *(LAS u32x4*)(IMG + 16 * pc) = (u32x4){0u, 0u, 0u, 0u}; } }
      asm volatile("s_waitcnt vmcnt(0)" ::: "memory"); }
    __syncthreads();
    { const int t = tid >> 4, kp = tid & 15;
      const u32x4 cw = *(const LAS u32x4*)(IMG + (t + 1) * PV2 + 1024 + 16 * kp), pw = *(const LAS u32x4*)(IMG + t * PV2 + 1024 + 16 * kp);
      const f32x4 m0v = *(const f32x4*)(mu + 1664 + 8 * kp), m1v = *(const f32x4*)(mu + 1664 + 8 * kp + 4);
      const unsigned cwa[4] = {cw.x, cw.y, cw.z, cw.w}, pwa[4] = {pw.x, pw.y, pw.z, pw.w}; float x[8];
#pragma unroll
      for (int j = 0; j < 4; ++j) { const float c0 = bf_lo(cwa[j]), c1 = bf_hi(cwa[j]), p0 = bf_lo(pwa[j]), p1 = bf_hi(pwa[j]);
          const float mu0 = j < 2 ? m0v[2 * j] : m1v[2 * j - 4], mu1 = j < 2 ? m0v[2 * j + 1] : m1v[2 * j - 3];
          x[2 * j] = fast_sigmoid(c0 + mu0 * (p0 - c0)); x[2 * j + 1] = fast_sigmoid(c1 + mu1 * (p1 - c1)); }
      const u32x4 o = {cvtpk(x[0], x[1]), cvtpk(x[2], x[3]), cvtpk(x[4], x[5]), cvtpk(x[6], x[7])};
      __syncthreads();
      *(LAS u32x4*)(IMG + (t + 1) * PV2 + 1024 + 16 * kp) = o;
      __syncthreads(); }
    const int hd = F.wave; int r = tid & 31, h = (tid >> 5) & 1;
    const LAS unsigned char* rowc = IMG + (r + 1) * PV2; const LAS unsigned char* rowp = IMG + r * PV2;
    const size_t uid = ((size_t)(b * 8 + hd) * 128 + c);
    const unsigned char* gS = F.ws + WS_R2 + uid * SZ_H; const unsigned char* gQ = F.ws + WS_H0 + uid * SZ_Q; const unsigned char* gY = F.ws + WS_H1 + uid * SZ_Y;
#define RK_LD(base, piece) __builtin_bit_cast(bf16x8, *(const u32x4*)((base) + (piece) * 1024 + (tid & 63) * 16))
    f32x16 gl[2]; gl[0] = f32x16{}; gl[1] = f32x16{};
    { const bf16_t* GUt = (const bf16_t*)(F.ws + WS_GUT) + (size_t)hd * 64 * 128;
#pragma unroll
      for (int ks = 0; ks < 8; ++ks) { const int k0 = 16 * ks + 8 * h; const bf16x8 bg = *(const LAS bf16x8*)(rowc + 1024 + k0 * 2);
#pragma unroll
          for (int it = 0; it < 2; ++it) { const bf16x8 fg = *(const bf16x8*)(GUt + (size_t)(32 * it + r) * 128 + k0); gl[it] = RK_MF(fg, bg, gl[it]); } } }
    f32x16 Y[2];
    { const bf16x8 fQ[2][2] = {{RK_LD(gQ, 0), RK_LD(gQ, 1)}, {RK_LD(gQ, 2), RK_LD(gQ, 3)}};
#pragma unroll
      for (int it = 0; it < 2; ++it) { unfrag<0>(Y[it], RK_LD(gY, 2 * it)); unfrag<1>(Y[it], RK_LD(gY, 2 * it + 1));
#pragma unroll
          for (int jt = 0; jt < 2; ++jt) { if (PROBE_NO_STATE) continue; Y[it] = RK_MF(RK_LD(gS, 2 * (jt * 2 + it)), fQ[jt][0], Y[it]); Y[it] = RK_MF(RK_LD(gS, 2 * (jt * 2 + it) + 1), fQ[jt][1], Y[it]); } } }
    float s1 = 0.f;
#pragma unroll
    for (int it = 0; it < 2; ++it)
#pragma unroll
        for (int i = 0; i < 16; ++i) s1 += Y[it][i];
    s1 += __shfl_xor(s1, 32); const float mean = s1 * (1.0f / 64.0f); float s2 = 0.f;
#pragma unroll
    for (int it = 0; it < 2; ++it)
#pragma unroll
        for (int i = 0; i < 16; ++i) { const float d = Y[it][i] - mean; s2 += d * d; }
    s2 += __shfl_xor(s2, 32); const float rstd = 1.0f / sqrtf(s2 * (1.0f / 64.0f) + GN_EPS);
    const float bn = ((const float*)(F.ws + WS_TOPW))[(m0 + r) * 8 + hd];
    LAS unsigned char* stg = F.lds + 49152 + F.wave * 4608;
#pragma unroll
    for (int it = 0; it < 2; ++it)
#pragma unroll
        for (int g = 0; g < 4; ++g) { const int cl = 32 * it + 8 * g + 4 * h, cj = hd * 64 + cl;
            const u32x2 a = *(const LAS u32x2*)(rowc + cj * 2), p = *(const LAS u32x2*)(rowp + cj * 2);
            const float vc[4] = {bf_lo(a.x), bf_hi(a.x), bf_lo(a.y), bf_hi(a.y)}, vq[4] = {bf_lo(p.x), bf_hi(p.x), bf_lo(p.y), bf_hi(p.y)};
            const f32x4 muv = *(const f32x4*)(mu + 1024 + cj), lg = *(const f32x4*)(AIN(16) + cj), lb = *(const f32x4*)(AIN(17) + cj);
            float o[4];
#pragma unroll
            for (int q = 0; q < 4; ++q) { const int i = 4 * g + q; const float v_ = vc[q] + muv[q] * (vq[q] - vc[q]);
                o[q] = ((Y[it][i] - mean) * rstd * lg[q] + lb[q] + bn * v_) * gl[it][i]; }
            *(LAS u32x2*)(stg + r * 144 + cl * 2) = (u32x2){cvtpk(o[0], o[1]), cvtpk(o[2], o[3])}; }
    asm volatile("s_waitcnt lgkmcnt(0)" ::: "memory");
    bf16_t* OUT = (bf16_t*)(F.ws + WS_R0) + m0 * 512 + hd * 64;
#pragma unroll
    for (int i = 0; i < 4; ++i) { const int row = i * 8 + ((tid & 63) >> 3), chn = tid & 7; const u32x4 v = *(const LAS u32x4*)(stg + row * 144 + chn * 16); *(u32x4*)(OUT + (size_t)row * 512 + chn * 8) = v; }
#undef RK_LD
#undef RK_ST
}
}
__device__ __forceinline__ void route_token(float lg, float bias, int lane, int tok, int* TE, float* TW, LAS unsigned* lcnt) {
    const float s = 1.0f / (1.0f + expf(-lg));
    const float c = s + bias;
    const unsigned long long kc = ((unsigned long long)ord_key(c) << 6) | (unsigned)(63 - lane);
    int rk = 0;
#pragma unroll 1
    for (int d = 1; d < 8; ++d) { const unsigned long long o = __shfl_xor(kc, d); rk += (o > kc) ? 1 : 0; }
    float gs = rk < 2 ? c : 0.f;
    gs += __shfl_xor(gs, 1); gs += __shfl_xor(gs, 2); gs += __shfl_xor(gs, 4);
    const int grp = lane >> 3;
    const unsigned long long kg = ((unsigned long long)ord_key(gs) << 6) | (unsigned)(63 - grp);
    int grk = 0;
#pragma unroll 1
    for (int d = 1; d < 8; ++d) { const unsigned long long o = __shfl_xor(kg, 8 * d); grk += (o > kg) ? 1 : 0; }
    unsigned cur = grk < 4 ? ord_key(c) : 0u; int erk = 64;
#pragma unroll
    for (int j = 0; j < 8; ++j) {
        int v = (int)cur;
#define RT_MAXD(ctrl) { const unsigned o_ = (unsigned)__builtin_amdgcn_update_dpp(0, v, (ctrl), 0xF, 0xF, true); v = (int)((unsigned)v > o_ ? (unsigned)v : o_); }
        RT_MAXD(0xB1) RT_MAXD(0x4E) RT_MAXD(0x141) RT_MAXD(0x140)
#undef RT_MAXD
        const unsigned m0_ = (unsigned)__builtin_amdgcn_readlane(v, 0), m1_ = (unsigned)__builtin_amdgcn_readlane(v, 16), m2_ = (unsigned)__builtin_amdgcn_readlane(v, 32), m3_ = (unsigned)__builtin_amdgcn_readlane(v, 48);
        const unsigned ma_ = m0_ > m1_ ? m0_ : m1_, mb_ = m2_ > m3_ ? m2_ : m3_; const unsigned m_ = ma_ > mb_ ? ma_ : mb_;
        const unsigned long long bal = __builtin_amdgcn_ballot_w64(cur == m_);
        const int win = __builtin_ctzll(bal);
        if (lane == win) { erk = j; cur = 0u; }
    }
    const bool sel = erk < 8;
    const float ssum = wave_sum(sel ? s : 0.f);
    if (sel) { TE[(size_t)tok * 8 + erk] = lane; TW[(size_t)tok * 8 + erk] = s / ssum * 2.5f; atomicAdd((unsigned*)&lcnt[(tok >= M / 2 ? 64 : 0) + lane], 1u); }
}
__device__ __forceinline__ void norm2_route_wave(const Args& args, Frame& F, LAS unsigned* lcnt) {
    bf16_t* H2 = (bf16_t*)(F.ws + WS_H2);
    norm_mod_rows(args, F, F.out, AIN(21), 3072, 4096, H2, nullptr);
    asm volatile("s_waitcnt vmcnt(0)" ::: "memory");
    const int lane = F.lane, row0 = F.gw * 16;
    const bf16_t* ap = H2 + (size_t)(row0 + (lane & 15)) * D + 8 * (lane >> 4);
    const bf16_t* bp = (const bf16_t*)(F.ws + WS_WRT) + (size_t)(lane & 15) * D + 8 * (lane >> 4);
    f32x4 acc[4] = {f32x4{}, f32x4{}, f32x4{}, f32x4{}};
#pragma unroll 1
    for (int k0 = 0; k0 < 32; k0 += 4) { bf16x8 a_[4], b_[4][4];
#pragma unroll
        for (int i = 0; i < 4; ++i) { a_[i] = *(const bf16x8*)(ap + 32 * (k0 + i));
#pragma unroll
            for (int nt = 0; nt < 4; ++nt) b_[i][nt] = *(const bf16x8*)(bp + (size_t)(16 * nt) * D + 32 * (k0 + i)); }
#pragma unroll
        for (int i = 0; i < 4; ++i)
#pragma unroll
            for (int nt = 0; nt < 4; ++nt) acc[nt] = __builtin_amdgcn_mfma_f32_16x16x32_bf16(a_[i], b_[i][nt], acc[nt], 0, 0, 0); }
    LAS float* scr = (LAS float*)(F.lds + F.wave * 16384);
#pragma unroll
    for (int nt = 0; nt < 4; ++nt)
#pragma unroll
        for (int i = 0; i < 4; ++i) scr[(4 * (lane >> 4) + i) * 65 + 16 * nt + (lane & 15)] = acc[nt][i];
    asm volatile("s_waitcnt lgkmcnt(0)" ::: "memory");
    int* TE = (int*)(F.ws + WS_TOPE); float* TW = (float*)(F.ws + WS_TOPW);
    const float bias = AIN(23)[lane];
#pragma unroll 1
    for (int t = 0; t < 16; ++t) route_token(scr[t * 65 + lane], bias, lane, row0 + t, TE, TW, lcnt);
    asm volatile("s_waitcnt lgkmcnt(0)" ::: "memory");
}
__device__ __forceinline__ void norm2_route_convert(const Args& args, Frame& F) {
    LAS unsigned* lcnt = (LAS unsigned*)(F.lds + LDS_TILETAB);
    if (F.tid < 128) lcnt[F.tid] = 0u;
    __syncthreads();
    constexpr int KIT = (64 * (16 * 16 + 4 * 32) + NWAVES * 256 - 1) / (NWAVES * 256) + 1;
    if (F.wave < 4) { norm2_route_wave(args, F, lcnt); convert_experts(args, F, 0, KIT); }
    else { convert_experts(args, F, 0, KIT / 2); norm2_route_wave(args, F, lcnt); convert_experts(args, F, KIT / 2, KIT); }
    __syncthreads();
    if (F.tid < 128 && lcnt[F.tid]) atomicAdd(F.ctl + CW_CNT + F.tid, lcnt[F.tid]);
    __syncthreads();
}
struct MoeTab { int ntiles0, ntiles; };
__device__ __forceinline__ MoeTab build_tiles(const Args& args, Frame& F) {
    LAS unsigned* tab = (LAS unsigned*)(F.lds + LDS_TILETAB);
    LAS unsigned* offs = tab + 2432; LAS unsigned* tpre = tab + 2560;
    if (F.tid == 0) { unsigned o = 0, tp = 0;
        for (int l = 0; l < 128; ++l) { const unsigned c = __hip_atomic_load(F.ctl + CW_CNT + l, RLX_AGENT); offs[l] = o; tpre[l] = tp; o += c; tp += (c + 255u) >> 8; }
        tpre[128] = tp; }
    __syncthreads();
    if (F.tid < 128) { const int l = F.tid; const unsigned c = __hip_atomic_load(F.ctl + CW_CNT + l, RLX_AGENT); const unsigned o = offs[l], t0 = tpre[l], nt = (c + 255u) >> 8;
        for (unsigned i = 0; i < nt; ++i) { const unsigned rows = (c - 256u * i) < 256u ? (c - 256u * i) : 256u; tab[2 * (t0 + i)] = (o + 256u * i) | ((unsigned)(l & 63) << 20); tab[2 * (t0 + i) + 1] = rows; } }
    __syncthreads();
    MoeTab r; r.ntiles0 = (int)tpre[64]; r.ntiles = (int)tpre[128]; return r;
}
__device__ __forceinline__ void scatter_phase(const Args& args, Frame& F) {
    LAS unsigned* tab = (LAS unsigned*)(F.lds + LDS_TILETAB); LAS unsigned* offs = tab + 2432;
    LAS unsigned* lcnt = (LAS unsigned*)(F.lds); LAS unsigned* lbase = lcnt + 128;
    const int* TE = (const int*)(F.ws + WS_TOPE); const float* TW = (const float*)(F.ws + WS_TOPW);
    int* ST = (int*)(F.ws + WS_STOK); float* SW = (float*)(F.ws + WS_SW);
    for (int blk = blockIdx.x; blk < M / 128; blk += F.G) {
        if (F.tid < 128) lcnt[F.tid] = 0u;
        __syncthreads();
        const int tok0 = blk * 128, hf = tok0 >= M / 2 ? 64 : 0;
        int lst[2]; unsigned rnk[2];
#pragma unroll
        for (int i = 0; i < 2; ++i) { const int p = F.tid + 512 * i; lst[i] = hf + TE[(size_t)tok0 * 8 + p]; rnk[i] = atomicAdd((unsigned*)&lcnt[lst[i]], 1u); }
        __syncthreads();
        if (F.tid < 128) lbase[F.tid] = lcnt[F.tid] ? atomicAdd(F.ctl + CW_CUR + F.tid, lcnt[F.tid]) : 0u;
        __syncthreads();
#pragma unroll
        for (int i = 0; i < 2; ++i) { const int p = F.tid + 512 * i; const unsigned pos = offs[lst[i]] + lbase[lst[i]] + rnk[i];
            ST[pos] = tok0 * 8 + p; SW[pos] = TW[(size_t)tok0 * 8 + p]; }
        __syncthreads();
    }
}

__device__ __forceinline__ void final_rows(const Args& args, Frame& F, int row_lo, int row_hi, int tokbase) {
    const unsigned char* SL = (const unsigned char*)(F.ws + WS_SLOT);
    const int cA = 256 * (F.lane >> 4) + 32 * ((F.lane >> 2) & 3) + 8 * (F.lane & 3), cB = cA + 128;
    for (int blk = F.gw; blk < (row_hi - row_lo) / 16; blk += F.NGW) {
        const int r0 = row_lo + blk * 16, b = r0 / SEQ;
        const float* g2 = (const float*)(F.ws + WS_MOD) + b * 6144 + 5120; const float* fgp = AIN(30);
        f32x4 gv[4], fg[4];
#pragma unroll
        for (int j = 0; j < 4; ++j) { const int c = (j < 2 ? cA : cB) + 4 * (j & 1); gv[j] = *(const f32x4*)(g2 + c) * (1.0f / SLOT_SCALE); fg[j] = *(const f32x4*)(fgp + c); }
        for (int r = 0; r < 16; ++r) { const size_t m = (size_t)(r0 + r);
            f32x4 acc[4];
#pragma unroll
            for (int j = 0; j < 4; ++j) acc[j] = (f32x4){0.f, 0.f, 0.f, 0.f};
            const unsigned char* sp = SL + (m - tokbase) * NSLOT * D + 16 * F.lane;
            u32x4 w[NSLOT];
#pragma unroll
            for (int k = 0; k < NSLOT; ++k) w[k] = *(const u32x4*)(sp + (size_t)k * D);
#pragma unroll
            for (int k = 0; k < NSLOT; ++k) { const unsigned ww[4] = {w[k].x, w[k].y, w[k].z, w[k].w};
#pragma unroll
                for (int j = 0; j < 4; ++j) { const f32x2 a = __builtin_amdgcn_cvt_pk_f32_fp8((int)ww[j], false), c = __builtin_amdgcn_cvt_pk_f32_fp8((int)ww[j], true); acc[j] += (f32x4){a.x, a.y, c.x, c.y}; } }
            float* xr = F.out + m * D; f32x4 v[4]; float s = 0.f;
#pragma unroll
            for (int j = 0; j < 4; ++j) { const int c = (j < 2 ? cA : cB) + 4 * (j & 1); v[j] = *(const f32x4*)(xr + c) + gv[j] * acc[j]; s += (v[j].x * v[j].x + v[j].y * v[j].y) + (v[j].z * v[j].z + v[j].w * v[j].w); }
            const float rstd = 1.0f / sqrtf(wave_sum(s) * (1.0f / D) + RMS_EPS);
#pragma unroll
            for (int j = 0; j < 4; ++j) { const int c = (j < 2 ? cA : cB) + 4 * (j & 1); *(f32x4*)(xr + c) = v[j] * rstd * fg[j]; }
        }
    }
}
constexpr int N_PHASES = 15;
#ifndef PROBE_ATT_SCALE
#define PROBE_ATT_SCALE 1.0f
#endif
#ifndef PROBE_IDX_REP
#define PROBE_IDX_REP 1
#endif
#ifndef R2_WGS
#define R2_WGS 32
#endif
#ifndef PROBE_P5_PART
#define PROBE_P5_PART 0
#endif
#ifndef PROBE_RW_SCALE
#define PROBE_RW_SCALE 1.0f
#endif

__global__ void __launch_bounds__(NTHR, 2) fwd_kernel(Args args) {
    extern __shared__ __attribute__((aligned(16))) unsigned char lds_raw[];
    Frame F;
    F.lds = (LAS unsigned char*)lds_raw;
    F.MISC = (volatile LAS unsigned*)(F.lds + MISC_OFF);
    F.tid = threadIdx.x; F.lane = F.tid & 63; F.wave = __builtin_amdgcn_readfirstlane(F.tid >> 6);
    F.G = gridDim.x; { const int bx = blockIdx.x; F.vcu = (F.G % 8 == 0) ? (bx % 8) * (F.G / 8) + bx / 8 : bx; }
    F.gw = blockIdx.x * NWAVES + F.wave; F.NGW = F.G * NWAVES;
    F.ws = args.ws; F.out = args.out; F.ctl = (unsigned*)(args.ws + WS_CTL);
    for (int u = F.tid; u < (LDS_BYTES - LDSCTL_OFF) / 4; u += NTHR) ((LAS unsigned*)(F.lds + LDSCTL_OFF))[u] = 0u;
    __syncthreads();
    if (F.tid == 0) {
#pragma unroll
        for (int i = 0; i < 31; ++i) *(LAS unsigned long long*)(F.lds + LDS_PTAB + 8 * i) = (unsigned long long)args.in[i];
        *(LAS unsigned long long*)(F.lds + LDS_PTAB + 8 * 31) = (unsigned long long)args.out; *(LAS unsigned long long*)(F.lds + LDS_PTAB + 8 * 32) = (unsigned long long)args.ws; }
    __syncthreads();
    XcdBarrier bar = xcd_barrier_post(F.ctl + CW_BAR + args.li * XCD_BAR_WORDS, F.MISC + 8);
    const int lo = args.ph_lo, hi = args.ph_hi;
#ifndef PHASE_MASK
#define PHASE_MASK 0xFFFFFFFFu
#endif
#define IN(k) ((((PHASE_MASK) >> (k)) & 1u) && lo <= (k) && (k) < hi)
#define PB() do { F.ws = (unsigned char*)ain_ptr(F.lds, 32); F.out = (float*)ain_ptr(F.lds, 31); F.ctl = (unsigned*)(F.ws + WS_CTL); \
        F.lane = (int)__builtin_amdgcn_mbcnt_hi(~0u, __builtin_amdgcn_mbcnt_lo(~0u, 0u)); F.tid = F.wave * 64 + F.lane; } while (0)
#define ZB ((bf16_t*)(F.ws + WS_Z))
#define GATES ((bf16_t*)F.out)
#define MOD ((const float*)(F.ws + WS_MOD))
#define SEAM(k) do { if (IN(k) && IN((k) + 1)) xcd_barrier(bar); } while (0)

    if (IN(0)) { PB(); p0_prologue(args, F); } SEAM(0);
    if (IN(1)) { PB(); norm_mod_rows(args, F, AIN(0), AIN(4), 0, 1024, nullptr, F.ws + WS_H0); } SEAM(1);
    if (IN(2)) { PB(); pg8::StaticOrder S; S.init(M, NIN, F.G, (int)blockIdx.x); pg8::DenseSrcT<1> G{F.ws + WS_H0, F.ws + WS_WIN, 1024};
        EpiInProj E{ZB, GATES}; pg8::gemm_phase<EpiInProj, pg8::StaticOrder, pg8::DenseSrcT<1>>(F.lds, 1024, S, G, E); } SEAM(2);
    if (IN(3)) { PB(); rk::load_params(args, F); for (int u = blockIdx.x; u < 1024; u += F.G) rk::r1_unit(args, F, u >> 7, u & 127); __syncthreads(); } SEAM(3);
    if (IN(4)) { PB();
#ifdef PROBE_R2_DRY
        if (blockIdx.x < R2_WGS && F.wave < 128 / R2_WGS) rk::r2_task<1>(args, F, blockIdx.x * (128 / R2_WGS) + F.wave);
#endif
        if (blockIdx.x < R2_WGS && F.wave < 128 / R2_WGS) rk::r2_task<0>(args, F, blockIdx.x * (128 / R2_WGS) + F.wave);
#pragma unroll 1
        for (int rep = 0; rep < PROBE_IDX_REP; ++rep)
        for (;;) {
            __syncthreads();
            if (F.tid == 0) F.MISC[12] = atomicAdd(F.ctl + CW_Q + rep, 1u);
            __syncthreads();
            const int u = (int)F.MISC[12];
            if (u >= 2048) break;
            indexer_unit(args, F, u & 7, (255 - (u >> 3)) * 16);
        } } SEAM(4);
    if (IN(5)) { PB(); if (!((PROBE_P5_PART & 2) && args.li == 1)) { for (int u = blockIdx.x; u < 1024; u += F.G) rk::r3_unit(args, F, u >> 7, u & 127); } __syncthreads();
        if (!((PROBE_P5_PART & 1) && args.li == 1)) for (int i = 0; i < 4; ++i) for (int uu = F.vcu; uu < 256; uu += F.G) { const int bh = uu >> 2, s = uu & 3; const int qb = (i == 0) ? s : (i == 1) ? 7 - s : (i == 2) ? 8 + s : 15 - s;
            att::attn_unit(args, F, bh >> 3, bh & 7, qb); } __syncthreads(); } SEAM(5);
    if (IN(6)) { PB(); pg8::StaticOrder S; S.init(M, D, F.G, (int)blockIdx.x);
        { pg8::DenseSrc G{F.ws + WS_R1, F.ws + WS_WA, 512}; EpiMerge<0> E{(bf16_t*)(F.ws + WS_R2), F.ws + WS_H0, GATES, PROBE_ATT_SCALE}; pg8::gemm_phase<EpiMerge<0>, pg8::StaticOrder, pg8::DenseSrc>(F.lds, 512, S, G, E); }
        { pg8::DenseSrc G{F.ws + WS_R0, F.ws + WS_WR, 512}; EpiMerge<1> E{(bf16_t*)(F.ws + WS_R2), F.ws + WS_H0, GATES, PROBE_RW_SCALE}; pg8::gemm_phase<EpiMerge<1>, pg8::StaticOrder, pg8::DenseSrc>(F.lds, 512, S, G, E); } } SEAM(6);
    if (IN(7)) { PB(); pg8::StaticOrder S; S.init(M, D, F.G, (int)blockIdx.x); pg8::DenseSrcT<1> G{F.ws + WS_H0, F.ws + WS_WO, 1024};
        EpiOutProj E{AIN(0), F.out, MOD}; pg8::gemm_phase<EpiOutProj, pg8::StaticOrder, pg8::DenseSrcT<1>>(F.lds, 1024, S, G, E); } SEAM(7);
    if (IN(8)) { PB(); norm2_route_convert(args, F); }
    if (IN(8) && IN(11)) xcd_barrier(bar);
    MoeTab mt{0, 0};
    if (lo <= 13 && hi > 13) { PB(); mt = build_tiles(args, F); scatter_phase(args, F); } else if (hi > 13) { PB(); mt = build_tiles(args, F); }
    SEAM(11);
    const LAS unsigned* tab = (const LAS unsigned*)(F.lds + LDS_TILETAB);
    if (IN(12)) { PB(); MoeSched1 S{tab, mt.ntiles, F.G, F.vcu};            MoeSrc1 G{F.ws};
        EpiMoe1 E{F.ws}; pg8::gemm_phase<EpiMoe1, MoeSched1, MoeSrc1>(F.lds, 1024, S, G, E); } SEAM(12);
    if (IN(13)) { PB(); MoeSched2 S{tab, 0, mt.ntiles, 512, F.G, F.vcu}; MoeSrc2 G{F.ws}; EpiMoe2 E; E.ws = F.ws; E.X1 = F.out; E.tokbase = 0;
        pg8::gemm_phase<EpiMoe2, MoeSched2, MoeSrc2>(F.lds, 256, S, G, E); } SEAM(13);
    if (IN(14)) { PB(); final_rows(args, F, 0, M, 0); }
#ifdef PROBE_CYC
    __syncthreads();
    if (blockIdx.x == 0 && F.tid == 0) { asm volatile("s_waitcnt vmcnt(0)" ::: "memory"); F.out[0] = (float)(F.ctl[CW_Q + 64]); }
#endif
#undef IN
#undef SEAM
#undef PB
}

extern "C" void kernel_launch(void* const* d_in, const int* in_sizes, int n_in, void* d_out, int out_size, void* d_ws, size_t ws_size, hipStream_t stream) {
    static int grid = 0;
    if (grid == 0) {
        if (n_in != 31 || out_size != M * D || ws_size < WS_END) { fprintf(stderr, "kernel_launch: unexpected problem (n_in %d, out %d, ws %zu)\n", n_in, out_size, ws_size); grid = -1; return; }
        int dev = 0, cus = 0, per_cu = 0;
        if (hipGetDevice(&dev) != hipSuccess || hipDeviceGetAttribute(&cus, hipDeviceAttributeMultiprocessorCount, dev) != hipSuccess) { grid = -1; return; }
        if (hipFuncSetAttribute((const void*)fwd_kernel, hipFuncAttributeMaxDynamicSharedMemorySize, LDS_BYTES) != hipSuccess) { fprintf(stderr, "kernel_launch: hipFuncSetAttribute failed\n"); grid = -1; return; }
        if (hipOccupancyMaxActiveBlocksPerMultiprocessor(&per_cu, (const void*)fwd_kernel, NTHR, LDS_BYTES) != hipSuccess || per_cu < 1) fprintf(stderr, "kernel_launch: occupancy query reports %d\n", per_cu);
        (void)hipGetLastError();
        grid = cus;
        if (grid != 256) fprintf(stderr, "kernel_launch: %d CUs (built for 256)\n", grid);
    }
    if (grid < 0) return;
    (void)in_sizes;
    if (hipMemsetAsync((char*)d_ws + WS_CTL, 0, CTL_ZERO_BYTES, stream) != hipSuccess) return;
    Args a{};
    for (int i = 0; i < 31; ++i) a.in[i] = (const float*)d_in[i];
    a.out = (float*)d_out; a.ws = (unsigned char*)d_ws;
#ifndef PROBE_REPEAT
#define PROBE_REPEAT -1
#endif
    int li = 0;
    auto go = [&](int lo_, int hi_) { a.ph_lo = lo_; a.ph_hi = hi_; a.li = li++; hipLaunchKernelGGL(fwd_kernel, dim3(grid), dim3(NTHR), LDS_BYTES, stream, a); };
    if (PROBE_REPEAT < 0) go(0, N_PHASES);
    else { go(0, PROBE_REPEAT + 1); go(PROBE_REPEAT, PROBE_REPEAT + 1); if (PROBE_REPEAT + 1 < N_PHASES) go(PROBE_REPEAT + 1, N_PHASES); }
}
```

```cpp
#include <hip/hip_runtime.h>
#include <cstdio>
#include <cstdint>
#include <cmath>

#define GAS __attribute__((address_space(1)))
#define LAS __attribute__((address_space(3)))
typedef unsigned short bf16_t;
typedef short bf16x8 __attribute__((ext_vector_type(8)));
typedef float f32x4 __attribute__((ext_vector_type(4)));
typedef float f32x2 __attribute__((ext_vector_type(2)));
typedef float f32x16 __attribute__((ext_vector_type(16)));
typedef unsigned u32x4 __attribute__((ext_vector_type(4)));
typedef unsigned u32x2 __attribute__((ext_vector_type(2)));
typedef GAS unsigned gu32;

__device__ __forceinline__ unsigned cvt_pk_bf16(float lo, float hi) { unsigned r; asm volatile("v_cvt_pk_bf16_f32 %0, %1, %2" : "=v"(r) : "v"(lo), "v"(hi)); return r; }
__device__ __forceinline__ float bf_lo(unsigned w) { return __uint_as_float(w << 16); }
__device__ __forceinline__ float bf_hi(unsigned w) { return __uint_as_float(w & 0xffff0000u); }
__device__ __forceinline__ float bf2f(bf16_t b) { return __uint_as_float(((unsigned)b) << 16); }
__device__ __forceinline__ unsigned f2bf(float f) { unsigned u = __float_as_uint(f); return (u + 0x7fffu + ((u >> 16) & 1u)) >> 16; }
__device__ __forceinline__ unsigned pk2(float lo, float hi) { return f2bf(lo) | (f2bf(hi) << 16); }
__device__ __forceinline__ float fast_sigmoid(float x) { return __builtin_amdgcn_rcpf(1.0f + __builtin_amdgcn_exp2f(-1.4426950408889634f * x)); }
__device__ __forceinline__ float wave_sum(float v) {
#define WS_DPP(ctrl) v += __int_as_float(__builtin_amdgcn_update_dpp(0, __float_as_int(v), (ctrl), 0xF, 0xF, true));
    WS_DPP(0xB1) WS_DPP(0x4E) WS_DPP(0x141) WS_DPP(0x140)
#undef WS_DPP
    const int vi = __float_as_int(v);
    return (__int_as_float(__builtin_amdgcn_readlane(vi, 0)) + __int_as_float(__builtin_amdgcn_readlane(vi, 16))) + (__int_as_float(__builtin_amdgcn_readlane(vi, 32)) + __int_as_float(__builtin_amdgcn_readlane(vi, 48)));
}

namespace pg8 {
constexpr int BM = 256, BK = 64, HALF = 128, HTB = HALF * BK * 2, STAGE_BYTES = 8 * HTB, NXCD = 8, WGM = 8;
__host__ __device__ __forceinline__ int lds_byte(int r, int c) { const int st = (r >> 4) * 2 + (c >> 5), rr = r & 15, cc = c & 31, ob = rr * 64 + cc * 2; return st * 1024 + (ob ^ (((ob >> 9) & 1) << 5)); }
__host__ __device__ __forceinline__ void stage_rc(int b, int& R, int& C) { const int st = b / 1024, sb = b % 1024, swz = sb ^ (((sb >> 9) & 1) << 5); R = (st >> 1) * 16 + swz / 64; C = (st & 1) * 32 + (swz % 64) / 2; }
__host__ __device__ __forceinline__ int perm32(int rho) { const int n = rho >> 4, i = rho & 15; return 8 * (i >> 2) + 4 * n + (i & 3); }

struct Unit { int pm, pn; int aux0, aux1; };

struct StaticOrder {
    int nM, nN, nwg, G, c;
    __host__ __device__ void init(int M, int N, int G_, int c_) { nM = M / BM; nN = N / BM; nwg = nM * nN; G = G_; c = c_; }
    __host__ __device__ bool next(int i, Unit& u) const {
        const long L = (long)i * G + c; if (L >= nwg) return false;
        int wgid = (int)L; { const int q = nwg / NXCD, r = nwg % NXCD, xcd = wgid % NXCD, off = wgid / NXCD; wgid = (xcd < r ? xcd * (q + 1) : r * (q + 1) + (xcd - r) * q) + off; }
        const int nig = WGM * nN, gid = wgid / nig, fm = gid * WGM, gsz = (nM - fm) < WGM ? (nM - fm) : WGM;
        u.pm = fm + ((wgid % nig) % gsz); u.pn = (wgid % nig) / gsz; u.aux0 = 0; u.aux1 = 0; return true;
    }
};

template <int ESZ_> struct DenseSrcT {
    static constexpr int ESZ = ESZ_; static constexpr bool GATHER = false;
    const void* A; const void* Bt; int K;
    __device__ __forceinline__ const char* b_base(const Unit& u) const { return (const char*)Bt + (size_t)u.pn * 256 * K * ESZ; }
    __device__ __forceinline__ const char* a_base(const Unit& u) const { return (const char*)A + (size_t)u.pm * 256 * K * ESZ; }
    __device__ __forceinline__ unsigned a_off(const Unit&, int R, int C) const { return (unsigned)(R * K * ESZ) + (unsigned)C * 2u; }
};
typedef DenseSrcT<2> DenseSrc;
typedef int v8i32 __attribute__((ext_vector_type(8)));

template <class T, class = void> struct has_prefetch { static constexpr bool value = false; };
template <class T> struct has_prefetch<T, decltype((void)&T::prefetch)> { static constexpr bool value = true; };
template <class Epi, class Sched, class Src, bool ALIGN_EPI = true>
__device__ __forceinline__ void gemm_phase(LAS unsigned char* lds, const int K, const Sched& S, const Src& G, const Epi& E) {
    const int tid = threadIdx.x, wid = __builtin_amdgcn_readfirstlane(tid >> 6), lane = tid & 63, wr = wid >> 2, wc = wid & 3, fr = lane & 15, fq = lane >> 4;
    constexpr int ESZ = Src::ESZ; const int Kb = K * ESZ;
    const int nt = Kb / (BK * 2);
    unsigned voffB0;
    { int R, C; stage_rc(tid * 16, R, C); const int Rb = Epi::PERM ? ((R & ~31) + perm32(R & 31)) : R; voffB0 = (unsigned)(Rb * Kb) + (unsigned)C * 2u; }
#define PG8_AOFF(u, h, i) ([&]() { int R_, C_; stage_rc(tid * 16 + (i) * 8192, R_, C_); return G.a_off((u), R_ + (h) * HALF, C_); }())
    const size_t kstep = (size_t)(BK * 2);
    const size_t hstepB = (size_t)HALF * Kb;
    const unsigned ldsw = (unsigned)wid * 1024u;
    const int aoff = lds_byte(wr * 64 + fr, fq * 8), boff = lds_byte(wc * 32 + fr, fq * 8);
#define PG8_SA(b, h) (((b) * 2 + (h)) * HTB)
#define PG8_SB(b, h) ((4 + (b) * 2 + (h)) * HTB)
#define PG8_STAGEB(bufoff, gbase) do { _Pragma("unroll") for (int _i = 0; _i < 2; ++_i) { unsigned o_ = voffB0; asm volatile("" : "+v"(o_)); \
        __builtin_amdgcn_global_load_lds((const unsigned*)((const char*)(gbase) + (size_t)_i * 64 * Kb + o_), (LAS unsigned*)(lds + (bufoff) + ldsw + _i * 8192), 16, 0, 0); } } while (0)
#define PG8_STAGEA(bufoff, gbase, vo, h) do { _Pragma("unroll") for (int _i = 0; _i < 2; ++_i) { unsigned o_ = Src::GATHER ? (vo)[h][_i] : (vo)[0][0]; asm volatile("" : "+v"(o_)); \
        __builtin_amdgcn_global_load_lds((const unsigned*)((const char*)(gbase) + (Src::GATHER ? (size_t)0 : (size_t)((h) * 128 + _i * 64) * Kb) + o_), (LAS unsigned*)(lds + (bufoff) + ldsw + _i * 8192), 16, 0, 0); } } while (0)
#define PG8_STAGEA2(bufoff, gbase, h) do { _Pragma("unroll") for (int _i = 0; _i < 2; ++_i) { unsigned o_ = Src::GATHER ? (last ? vn[h][_i] : vc[h][_i]) : vc[0][0]; asm volatile("" : "+v"(o_)); \
        __builtin_amdgcn_global_load_lds((const unsigned*)((const char*)(gbase) + (Src::GATHER ? (size_t)0 : (size_t)((h) * 128 + _i * 64) * Kb) + o_), (LAS unsigned*)(lds + (bufoff) + ldsw + _i * 8192), 16, 0, 0); } } while (0)
#define PG8_LDA(dst, b, h) do { _Pragma("unroll") for (int m = 0; m < 4; ++m) { const u32x4 lo_ = *(const LAS u32x4*)(lds + PG8_SA(b, h) + aoff + m * 2048), hi_ = *(const LAS u32x4*)(lds + PG8_SA(b, h) + aoff + m * 2048 + 1024); \
        dst[m] = __builtin_shufflevector(lo_, hi_, 0, 1, 2, 3, 4, 5, 6, 7); } } while (0)
#define PG8_LDB(dst, b, h) do { _Pragma("unroll") for (int n = 0; n < 2; ++n) { const u32x4 lo_ = *(const LAS u32x4*)(lds + PG8_SB(b, h) + boff + n * 2048), hi_ = *(const LAS u32x4*)(lds + PG8_SB(b, h) + boff + n * 2048 + 1024); \
        dst[n] = __builtin_shufflevector(lo_, hi_, 0, 1, 2, 3, 4, 5, 6, 7); } } while (0)
#define PG8_LO(x) __builtin_bit_cast(bf16x8, __builtin_shufflevector((x), (x), 0, 1, 2, 3))
#define PG8_HI(x) __builtin_bit_cast(bf16x8, __builtin_shufflevector((x), (x), 4, 5, 6, 7))
#define PG8_MMA(ai, bj, At, Bt) do { __builtin_amdgcn_s_setprio(1); _Pragma("unroll") for (int m = 0; m < 4; ++m) _Pragma("unroll") for (int n = 0; n < 2; ++n) { \
        if constexpr (ESZ == 1) acc[ai][bj][m][n] = __builtin_amdgcn_mfma_scale_f32_16x16x128_f8f6f4(__builtin_bit_cast(v8i32, Bt[n]), __builtin_bit_cast(v8i32, At[m]), acc[ai][bj][m][n], 0, 0, 0, 0, 0, 0); \
        else { acc[ai][bj][m][n] = __builtin_amdgcn_mfma_f32_16x16x32_bf16(PG8_LO(Bt[n]), PG8_LO(At[m]), acc[ai][bj][m][n], 0, 0, 0); \
               acc[ai][bj][m][n] = __builtin_amdgcn_mfma_f32_16x16x32_bf16(PG8_HI(Bt[n]), PG8_HI(At[m]), acc[ai][bj][m][n], 0, 0, 0); } } \
        __builtin_amdgcn_s_setprio(0); } while (0)
#define PG8_WAIT_V(n) asm volatile("s_waitcnt vmcnt(" #n ")" ::: "memory")
#define PG8_WAIT_L(n) asm volatile("s_waitcnt lgkmcnt(" #n ")" ::: "memory")
#define PG8_BAR __builtin_amdgcn_s_barrier()
#define PG8_SCHED __builtin_amdgcn_sched_barrier(0)
    Unit cur, nxt; int ui = 0;
    if (!S.next(0, cur)) return;
#define PG8_PREFETCH(u_) do { if constexpr (has_prefetch<Epi>::value) { int ln_; asm volatile("v_mbcnt_lo_u32_b32 %0, -1, 0\n\tv_mbcnt_hi_u32_b32 %0, -1, %0" : "=v"(ln_)); E.prefetch((u_), wr, ln_ & 15); } } while (0)
    PG8_PREFETCH(cur);
    f32x4 acc[2][2][4][2];
#pragma unroll
    for (int a = 0; a < 2; ++a)
#pragma unroll
        for (int b = 0; b < 2; ++b)
#pragma unroll
            for (int m = 0; m < 4; ++m)
#pragma unroll
                for (int n = 0; n < 2; ++n) acc[a][b][m][n] = (f32x4){0.f, 0.f, 0.f, 0.f};
    typedef unsigned u32x8 __attribute__((ext_vector_type(8)));
    u32x8 At[4], B0[2], B1[2];
    unsigned vc[2][2], vn[2][2];
#pragma unroll
    for (int h = 0; h < 2; ++h)
#pragma unroll
        for (int i = 0; i < 2; ++i) vc[h][i] = PG8_AOFF(cur, h, i);
    const char* cA = G.a_base(cur); const char* cB = G.b_base(cur);
    PG8_STAGEB(PG8_SB(0, 0), cB); PG8_STAGEB(PG8_SB(0, 1), cB + hstepB); PG8_STAGEA(PG8_SA(0, 0), cA, vc, 0); PG8_STAGEA(PG8_SA(0, 1), cA, vc, 1);
    if (wr == 1) PG8_BAR;
    PG8_WAIT_V(2); PG8_BAR;
    PG8_STAGEB(PG8_SB(1, 0), cB + kstep); PG8_STAGEA(PG8_SA(1, 0), cA + kstep, vc, 0); PG8_STAGEB(PG8_SB(1, 1), cB + hstepB + kstep);
    PG8_WAIT_V(6); PG8_BAR;
    for (;;) {
        const bool has_next = S.next(ui + 1, nxt);
        const char* nA = has_next ? G.a_base(nxt) : cA; const char* nB = has_next ? G.b_base(nxt) : cB;
        if constexpr (Src::GATHER) {
#pragma unroll
        for (int h = 0; h < 2; ++h)
#pragma unroll
            for (int i = 0; i < 2; ++i) vn[h][i] = has_next ? PG8_AOFF(nxt, h, i) : vc[h][i]; }
#pragma clang loop unroll(disable)
        for (int t = 0; t < nt; t += 2) {
            const bool last = (t == nt - 2);
            const char* a1 = cA + (size_t)(t + 1) * kstep;
            const char* a2 = last ? nA : cA + (size_t)(t + 2) * kstep; const char* b2 = last ? nB : cB + (size_t)(t + 2) * kstep;
            const char* a3 = a2 + kstep; const char* b3 = b2 + kstep;
            PG8_LDB(B0, 0, 0); PG8_LDB(B1, 0, 1); PG8_SCHED; PG8_LDA(At, 0, 0); PG8_STAGEA(PG8_SA(1, 1), a1, vc, 1);
            PG8_WAIT_V(8); PG8_WAIT_L(0); PG8_BAR; PG8_MMA(0, 0, At, B0); PG8_MMA(0, 1, At, B1); PG8_BAR; PG8_SCHED;
            PG8_LDA(At, 0, 1); PG8_STAGEB(PG8_SB(0, 0), b2); PG8_STAGEB(PG8_SB(0, 1), b2 + hstepB); PG8_STAGEA2(PG8_SA(0, 0), a2, 0);
            PG8_WAIT_V(8); PG8_WAIT_L(0); PG8_BAR; PG8_MMA(1, 0, At, B0); PG8_MMA(1, 1, At, B1); PG8_BAR; PG8_SCHED;
            PG8_LDB(B0, 1, 0); PG8_LDB(B1, 1, 1); PG8_SCHED; PG8_LDA(At, 1, 0); PG8_STAGEA2(PG8_SA(0, 1), a2, 1);
            PG8_WAIT_V(8); PG8_WAIT_L(0); PG8_BAR; PG8_MMA(0, 0, At, B0); PG8_MMA(0, 1, At, B1); PG8_BAR; PG8_SCHED;
            PG8_LDA(At, 1, 1); PG8_STAGEB(PG8_SB(1, 0), b3); PG8_STAGEB(PG8_SB(1, 1), b3 + hstepB); PG8_STAGEA2(PG8_SA(1, 0), a3, 0);
            PG8_WAIT_V(8); PG8_WAIT_L(0); PG8_BAR; PG8_MMA(1, 0, At, B0); PG8_MMA(1, 1, At, B1); PG8_BAR; PG8_SCHED;
        }
        if constexpr (ALIGN_EPI) { if (wr == 0) PG8_BAR; }
        { int ln_; asm volatile("v_mbcnt_lo_u32_b32 %0, -1, 0\n\tv_mbcnt_hi_u32_b32 %0, -1, %0" : "=v"(ln_)); E(acc, cur, wr, wc, ln_ & 15, ln_ >> 4); }
        if (!has_next) break;
#pragma unroll
        for (int a = 0; a < 2; ++a)
#pragma unroll
            for (int b = 0; b < 2; ++b)
#pragma unroll
                for (int m = 0; m < 4; ++m)
#pragma unroll
                    for (int n = 0; n < 2; ++n) acc[a][b][m][n] = (f32x4){0.f, 0.f, 0.f, 0.f};
        cur = nxt; cA = nA; cB = nB; ++ui;
        PG8_PREFETCH(cur);
        if constexpr (Src::GATHER) {
#pragma unroll
        for (int h = 0; h < 2; ++h)
#pragma unroll
            for (int i = 0; i < 2; ++i) vc[h][i] = vn[h][i]; }
        if constexpr (ALIGN_EPI) { if (wr == 1) PG8_BAR; }
    }
    PG8_WAIT_V(0);
    if constexpr (!ALIGN_EPI) { if (wr == 0) PG8_BAR; }
    PG8_BAR;
#undef PG8_PREFETCH
#undef PG8_SA
#undef PG8_AOFF
#undef PG8_SB
#undef PG8_STAGEA
#undef PG8_STAGEA2
#undef PG8_STAGEB
#undef PG8_LDA
#undef PG8_LDB
#undef PG8_MMA
#undef PG8_LO
#undef PG8_HI
#undef PG8_WAIT_V
#undef PG8_WAIT_L
#undef PG8_BAR
#undef PG8_SCHED
}
}
#define RLX_AGENT __ATOMIC_RELAXED, __HIP_MEMORY_SCOPE_AGENT
#define LDS_WAIT() asm volatile("s_waitcnt lgkmcnt(0)" ::: "memory")
#define VM_WAIT() asm volatile("s_waitcnt vmcnt(0)" ::: "memory")
#define XB_TMO      128
#define XB_XCNT(j)  (256  + 64 * (j))
#define XB_XSUB(j)  (1280 + 64 * (j))
#define XB_XGEN(j)  (2304 + 64 * (j))
#define XB_TOP      3328
#define XB_TOPGEN   3392
#define XCD_BAR_WORDS 3456
#define XB_SPIN_CAP (1u << 18)

__device__ __forceinline__ unsigned xb_ld(unsigned* p)              { return __hip_atomic_load(p, __ATOMIC_RELAXED, __HIP_MEMORY_SCOPE_AGENT); }
__device__ __forceinline__ unsigned xb_add(unsigned* p, unsigned v) { return __hip_atomic_fetch_add(p, v, __ATOMIC_RELAXED, __HIP_MEMORY_SCOPE_AGENT); }
__device__ __forceinline__ unsigned xb_xcc_id() { return (unsigned)__builtin_amdgcn_s_getreg((3 << 11) | 20) & 0xFu; }
#define XB_SPIN(cond, bar) do { unsigned _sp = 0; while (cond) { __builtin_amdgcn_s_sleep(1); \
    if ((++_sp & 255u) == 0u) { if (xb_ld(&(bar)[XB_TMO])) break; if (_sp > XB_SPIN_CAP) { atomicAdd(&(bar)[XB_TMO], 1u); break; } } } } while (0)

struct XcdBarrier {
    unsigned* bar; unsigned x;
    volatile LAS unsigned* st;
};

__device__ __forceinline__ XcdBarrier xcd_barrier_post(unsigned* bar, volatile LAS unsigned* st) {
    XcdBarrier b; b.bar = bar; b.x = xb_xcc_id(); b.st = st;
    if (threadIdx.x == 0) (void)xb_add(&bar[XB_XCNT(b.x)], 1u);
    return b;
}
__device__ __forceinline__ void xcd_barrier_complete(unsigned* bar, unsigned x, unsigned& nloc, unsigned& nx) {
    const unsigned G = gridDim.x * gridDim.y * gridDim.z;
    unsigned sum, cnt, mine, sp = 0u;
    for (;;) {
        sum = 0u; cnt = 0u; mine = 0u;
#pragma unroll
        for (unsigned j = 0; j < 16; ++j) { const unsigned c = xb_ld(&bar[XB_XCNT(j)]); sum += c; cnt += (c > 0u) ? 1u : 0u; mine = (j == x) ? c : mine; }
        if (sum == G) break;
        __builtin_amdgcn_s_sleep(1);
        if ((++sp & 255u) == 0u) { if (xb_ld(&bar[XB_TMO])) break; if (sp > XB_SPIN_CAP) { atomicAdd(&bar[XB_TMO], 1u); break; } }
    }
    nloc = mine > 0u ? mine : 1u; nx = cnt > 0u ? cnt : 1u;
}

__device__ __forceinline__ void xcd_barrier(const XcdBarrier& b) {
    asm volatile("s_waitcnt vmcnt(0)" ::: "memory");
    __syncthreads();
    if (threadIdx.x == 0) {
        unsigned* bar = b.bar;
        __builtin_amdgcn_s_waitcnt(0);
        unsigned nloc = b.st[0], nx = b.st[1];
        if (nloc == 0u) { xcd_barrier_complete(bar, b.x, nloc, nx); b.st[0] = nloc; b.st[1] = nx; }
        const unsigned old = xb_add(&bar[XB_XSUB(b.x)], 1u);
        const unsigned gen = old / nloc;
        if (old + 1u == (gen + 1u) * nloc) {
            __builtin_amdgcn_fence(__ATOMIC_RELEASE, "agent");
            asm volatile("s_waitcnt vmcnt(0)" ::: "memory");
            const unsigned og = xb_add(&bar[XB_TOP], 1u);
            const unsigned tg = og / nx;
            if (og + 1u == (tg + 1u) * nx) xb_add(&bar[XB_TOPGEN], 1u);
            else XB_SPIN(xb_ld(&bar[XB_TOPGEN]) == tg, bar);
            __builtin_amdgcn_fence(__ATOMIC_ACQUIRE, "agent");
            xb_add(&bar[XB_XGEN(b.x)], 1u);
            asm volatile("s_waitcnt vmcnt(0)" ::: "memory");
        } else {
            XB_SPIN(xb_ld(&bar[XB_XGEN(b.x)]) == gen, bar);
            __builtin_amdgcn_fence(__ATOMIC_ACQUIRE, "agent");
            asm volatile("s_waitcnt vmcnt(0)" ::: "memory");
        }
    }
    __syncthreads();
}
constexpr int NB = 8, SEQ = 4096, D = 1024, M = NB * SEQ;
constexpr int NIN_SRC = 5936, NIN = 6144;
constexpr int ZW = 4096;
constexpr int ZQ = 0, ZK = 512, ZV = 1024, ZIQ = 1536, ZIK = 2048, ZIW = 2080, ZR = 2304;
constexpr int ZR_R = ZR, ZR_K = ZR + 512, ZR_V = ZR + 1024, ZR_WD = ZR + 1536, ZR_AD = ZR + 1600, ZR_GD = ZR + 1664;
constexpr int GW = 2048;
constexpr int NEXP = 64, FF = 256, TOPK = 8;
constexpr float RMS_EPS = 1e-6f, GN_EPS = 64e-5f;
constexpr float QSCALE = 0.125f * 1.4426950408889634f;
constexpr int NWAVES = 8, NTHR = 512;

constexpr size_t MiB = 1u << 20;
constexpr size_t WS_CTL = 0, CTL_ZERO_BYTES = 1 * MiB;
constexpr size_t WS_MOD = 1 * MiB;
constexpr size_t WS_DUT = 1 * MiB + 256 * 1024;
constexpr size_t WS_IUT = WS_DUT + 64 * 1024;
constexpr size_t WS_GUT = WS_IUT + 64 * 1024;
constexpr size_t WS_WIN = 2 * MiB;
constexpr size_t WS_WA = 14 * MiB, WS_WR = 15 * MiB;
constexpr size_t WS_WO = 16 * MiB;
constexpr size_t WS_WRT = 18 * MiB;
constexpr size_t WS_WSH1 = 19 * MiB;
constexpr size_t WS_WSH2 = 20 * MiB;
constexpr size_t WS_BRS = 21 * MiB, WS_KRS = 22 * MiB;
constexpr size_t WS_TOPE = 23 * MiB, WS_TOPW = 24 * MiB;
constexpr size_t WS_LOGIT = 25 * MiB;
constexpr size_t WS_Z = 36 * MiB;
constexpr size_t WS_H0 = 292 * MiB, WS_H1 = 324 * MiB;
constexpr size_t WS_SEL = 356 * MiB;
constexpr size_t WS_R0 = 372 * MiB, WS_R1 = 404 * MiB, WS_R2 = 436 * MiB, WS_R3 = 468 * MiB;
constexpr size_t WS_W2T = 36 * MiB;
constexpr size_t WS_ACT = 68 * MiB;
constexpr size_t WS_ACTS = 196 * MiB;
constexpr size_t WS_STOK = 212 * MiB, WS_SW = 213 * MiB;
constexpr size_t WS_W1T = 214 * MiB;
constexpr size_t WS_H2 = 278 * MiB;
constexpr size_t WS_SLOT = 214 * MiB;
constexpr size_t WS_END = 502 * MiB;
constexpr int CW_TMO = 0, CW_BAR = 4096, CW_CNT = 32768, CW_CUR = 32768 + 128, CW_Q = 32768 + 512;

constexpr int RING_BYTES = 131072;
constexpr int LDSCTL_OFF = RING_BYTES, MISC_OFF = LDSCTL_OFF + 320;
constexpr int LDS_TILETAB = RING_BYTES + 1024;
constexpr int LDS_PTAB = RING_BYTES + 512;
constexpr int LDS_PARA = 118800;
constexpr int LDS_PARB = LDS_TILETAB;
constexpr int LDS_BYTES = 147456;
#define AIN(i) ain_ptr(F.lds, (i))

struct Args { const float* in[31]; float* out; unsigned char* ws; int ph_lo, ph_hi, li, pad; };
struct Frame {
    LAS unsigned char* lds;
    volatile LAS unsigned* MISC;
    unsigned* ctl;
    int tid, lane, wave, vcu, G, gw, NGW;
    float* out; unsigned char* ws;
};

__device__ __forceinline__ const float* ain_ptr(LAS unsigned char* lds, int i) {
    const u32x2 w = *(const LAS u32x2*)(lds + LDS_PTAB + 8 * i);
    const unsigned lo = (unsigned)__builtin_amdgcn_readfirstlane((int)w.x), hi = (unsigned)__builtin_amdgcn_readfirstlane((int)w.y);
    return (const float*)(const GAS float*)(((unsigned long long)hi << 32) | lo);
}
struct TrSrc { const float* base; int nsrc; };
template <int FP8, class ColFn>
__device__ __forceinline__ void transpose_item(const ColFn& colfn, int K, bf16_t* WT, LAS float* scr, int kb, int nb, int lane) {
    const int k0 = 64 * kb, n0 = 32 * nb;
    const TrSrc s = colfn(n0 + (lane & 31));
    float v_[32];
#pragma unroll
    for (int i = 0; i < 32; ++i) { const int kk = 2 * i + (lane >> 5); v_[i] = s.base ? s.base[(size_t)(k0 + kk) * s.nsrc] : 0.f; }
#pragma unroll
    for (int i = 0; i < 32; ++i) { const int kk = 2 * i + (lane >> 5); scr[kk * 33 + (lane & 31)] = v_[i]; }
    LDS_WAIT(); asm volatile("" ::: "memory");
    const int c = lane & 7;
#pragma unroll
    for (int j = 0; j < 4; ++j) { const int n = (lane >> 3) + 8 * j; const LAS float* sp = scr + (8 * c) * 33 + n;
        if constexpr (FP8) { constexpr float S8 = 32.0f;
            int lo = __builtin_amdgcn_cvt_pk_fp8_f32(sp[0 * 33] * S8, sp[1 * 33] * S8, 0, false); lo = __builtin_amdgcn_cvt_pk_fp8_f32(sp[2 * 33] * S8, sp[3 * 33] * S8, lo, true);
            int hi = __builtin_amdgcn_cvt_pk_fp8_f32(sp[4 * 33] * S8, sp[5 * 33] * S8, 0, false); hi = __builtin_amdgcn_cvt_pk_fp8_f32(sp[6 * 33] * S8, sp[7 * 33] * S8, hi, true);
            *(GAS u32x2*)((unsigned char*)WT + (size_t)(n0 + n) * K + k0 + 8 * c) = (u32x2){(unsigned)lo, (unsigned)hi}; }
        else { u32x4 o; o.x = pk2(sp[0 * 33], sp[1 * 33]); o.y = pk2(sp[2 * 33], sp[3 * 33]); o.z = pk2(sp[4 * 33], sp[5 * 33]); o.w = pk2(sp[6 * 33], sp[7 * 33]);
            *(GAS u32x4*)(WT + (size_t)(n0 + n) * K + k0 + 8 * c) = o; } }
    LDS_WAIT(); asm volatile("" ::: "memory");
}

__device__ __forceinline__ void p0_mod(const Args& args, Frame& F, int task) {
    LAS float* sc = (LAS float*)F.lds;
    LAS float* red = (LAS float*)(F.lds + 32768);
    const float* c = AIN(1);
    for (int i = F.tid; i < 8192; i += NTHR) { const float v = c[i]; sc[i] = v * fast_sigmoid(v); }
    __syncthreads();
    const float* aw = AIN(2) + 64 * task + F.lane;
    float acc[8];
#pragma unroll
    for (int b = 0; b < 8; ++b) acc[b] = 0.f;
    const int kb = 128 * F.wave;
#pragma unroll 1
    for (int k0 = 0; k0 < 128; k0 += 16) { float a_[16];
#pragma unroll
        for (int k = 0; k < 16; ++k) a_[k] = aw[(size_t)(kb + k0 + k) * 6144];
#pragma unroll
        for (int k = 0; k < 16; ++k) {
#pragma unroll
            for (int b = 0; b < 8; ++b) acc[b] += sc[b * 1024 + kb + k0 + k] * a_[k];
            if ((k & 3) == 3) asm volatile("" ::: "memory"); } }
#pragma unroll
    for (int b = 0; b < 8; ++b) red[(F.wave * 8 + b) * 64 + F.lane] = acc[b];
    __syncthreads();
    { const int b = F.wave; float s = AIN(3)[64 * task + F.lane];
#pragma unroll
      for (int w = 0; w < 8; ++w) s += red[(w * 8 + b) * 64 + F.lane];
      ((float*)(F.ws + WS_MOD))[b * 6144 + 64 * task + F.lane] = s; }
    __syncthreads();
}

__device__ __forceinline__ void p0_prologue(const Args& args, Frame& F) {
    if (blockIdx.x < 96) p0_mod(args, F, blockIdx.x);
    LAS float* scr = (LAS float*)(F.lds + F.wave * 16384);
    bf16_t* const ws16 = (bf16_t*)F.ws;
    constexpr int I_WIN = 16 * 192, I_WA = 8 * 32, I_WO = 16 * 32, I_WRT = 16 * 8, I_SH1 = 16 * 16, I_SH2 = 4 * 32, I_DU = 16, I_GU = 32;
    constexpr int NIT = I_WIN + 2 * I_WA + I_WO + I_WRT + I_SH1 + I_SH2 + 2 * I_DU + I_GU;
    for (int it = F.gw; it < NIT; it += F.NGW) {
        int r = it;
        if (r < I_WIN) { const float* w = AIN(5);
            transpose_item<1>([=](int n) { TrSrc s; const bool ok = (n < 2096) || (n >= 2304); const int col = n < 2096 ? n : n - 208; s.base = ok ? w + col : nullptr; s.nsrc = NIN_SRC; return s; },
                           1024, (bf16_t*)(F.ws + WS_WIN), scr, r / 192, r % 192, F.lane); continue; } r -= I_WIN;
        if (r < I_WA) { const float* w = AIN(18); transpose_item<0>([=](int n) { TrSrc s; s.base = w + n; s.nsrc = 1024; return s; }, 512, (bf16_t*)(F.ws + WS_WA), scr, r / 32, r % 32, F.lane); continue; } r -= I_WA;
        if (r < I_WA) { const float* w = AIN(19); transpose_item<0>([=](int n) { TrSrc s; s.base = w + n; s.nsrc = 1024; return s; }, 512, (bf16_t*)(F.ws + WS_WR), scr, r / 32, r % 32, F.lane); continue; } r -= I_WA;
        if (r < I_WO) { const float* w = AIN(20); transpose_item<1>([=](int n) { TrSrc s; s.base = w + n; s.nsrc = 1024; return s; }, 1024, (bf16_t*)(F.ws + WS_WO), scr, r / 32, r % 32, F.lane); continue; } r -= I_WO;
        if (r < I_WRT) { const float* w = AIN(22); transpose_item<0>([=](int n) { TrSrc s; s.base = n < 64 ? w + n : nullptr; s.nsrc = 64; return s; }, 1024, (bf16_t*)(F.ws + WS_WRT), scr, r / 8, r % 8, F.lane); continue; } r -= I_WRT;
        if (r < I_SH1) { const float* wg = AIN(27); const float* wu = AIN(28);
            transpose_item<0>([=](int n) { TrSrc s; const int j = n >> 8, sel = (n >> 7) & 1, cc = n & 127; s.base = (sel ? wu : wg) + 128 * j + cc; s.nsrc = 256; return s; }, 1024, (bf16_t*)(F.ws + WS_WSH1), scr, r / 16, r % 16, F.lane); continue; } r -= I_SH1;
        if (r < I_SH2) { const float* w = AIN(29); transpose_item<0>([=](int n) { TrSrc s; s.base = w + n; s.nsrc = 1024; return s; }, 256, (bf16_t*)(F.ws + WS_WSH2), scr, r / 32, r % 32, F.lane); continue; } r -= I_SH2;
        if (r < I_DU) { const float* w = AIN(9); transpose_item<0>([=](int n) { TrSrc s; s.base = w + n; s.nsrc = 512; return s; }, 64, (bf16_t*)(F.ws + WS_DUT), scr, 0, r, F.lane); continue; } r -= I_DU;
        if (r < I_DU) { const float* w = AIN(11); transpose_item<0>([=](int n) { TrSrc s; s.base = w + n; s.nsrc = 512; return s; }, 64, (bf16_t*)(F.ws + WS_IUT), scr, 0, r, F.lane); continue; } r -= I_DU;
        { const float* w = AIN(12); transpose_item<0>([=](int n) { TrSrc s; s.base = w + n; s.nsrc = 512; return s; }, 128, (bf16_t*)(F.ws + WS_GUT), scr, r / 16, r % 16, F.lane); }
    }
    (void)ws16;
}

__device__ __forceinline__ void convert_experts(const Args& args, Frame& F, int k0, int k1) {
    LAS float* scr = (LAS float*)(F.lds + F.wave * 16384);
    constexpr int I1 = 16 * 16, I2 = 4 * 32, PER = I1 + I2, NIT = 64 * PER;
    for (int k = k0; k < k1; ++k) { const int it = F.gw + k * F.NGW; if (it >= NIT) break;
        const int e = it / PER; int r = it % PER;
        if (r < I1) { const float* wg = AIN(24) + (size_t)e * 1024 * 256; const float* wu = AIN(25) + (size_t)e * 1024 * 256;
            transpose_item<0>([=](int n) { TrSrc s; const int j = n >> 8, sel = (n >> 7) & 1, cc = n & 127; s.base = (sel ? wu : wg) + 128 * j + cc; s.nsrc = 256; return s; }, 1024, (bf16_t*)(F.ws + WS_W1T) + (size_t)e * 512 * 1024, scr, r / 16, r % 16, F.lane); }
        else { r -= I1; const float* w = AIN(26) + (size_t)e * 256 * 1024;
            transpose_item<0>([=](int n) { TrSrc s; s.base = w + n; s.nsrc = 1024; return s; }, 256, (bf16_t*)(F.ws + WS_W2T) + (size_t)e * 1024 * 256, scr, r / 32, r % 32, F.lane); }
    }
}

__device__ __forceinline__ void norm_mod_rows(const Args& args, Frame& F, const float* X, const float* g, int sh_off, int sc_off, bf16_t* O, unsigned char* O8) {
    const int row0 = F.gw * 16, b = row0 / SEQ;
    const float* mod = (const float*)(F.ws + WS_MOD) + b * 6144;
    f32x4 mul[4], add[4];
#pragma unroll
    for (int j = 0; j < 4; ++j) { const int c = 4 * F.lane + 256 * j; const f32x4 gv = *(const f32x4*)(g + c), sc = *(const f32x4*)(mod + sc_off + c); add[j] = *(const f32x4*)(mod + sh_off + c); mul[j] = gv * (sc + 1.0f); }
    for (int r0 = 0; r0 < 16; r0 += 4) {
        f32x4 v[4][4]; float s[4];
#pragma unroll
        for (int q = 0; q < 4; ++q) { const GAS f32x4* xr = (const GAS f32x4*)(X + (size_t)(row0 + r0 + q) * D) + F.lane;
#pragma unroll
            for (int j = 0; j < 4; ++j) v[q][j] = xr[64 * j]; }
#pragma unroll
        for (int q = 0; q < 4; ++q) { s[q] = 0.f;
#pragma unroll
            for (int j = 0; j < 4; ++j) s[q] += (v[q][j].x * v[q][j].x + v[q][j].y * v[q][j].y) + (v[q][j].z * v[q][j].z + v[q][j].w * v[q][j].w); }
#pragma unroll
        for (int q = 0; q < 4; ++q) { const int r = r0 + q;
            const float rstd = 1.0f / sqrtf(wave_sum(s[q]) * (1.0f / D) + RMS_EPS);
#pragma unroll
            for (int j = 0; j < 4; ++j) { const f32x4 y = v[q][j] * rstd * mul[j] + add[j];
                if (O) { u32x2 w; w.x = cvt_pk_bf16(y.x, y.y); w.y = cvt_pk_bf16(y.z, y.w); ((GAS u32x2*)(O + (size_t)(row0 + r) * D) + F.lane)[64 * j] = w; }
                if (O8) { int w8 = __builtin_amdgcn_cvt_pk_fp8_f32(y.x, y.y, 0, false); w8 = __builtin_amdgcn_cvt_pk_fp8_f32(y.z, y.w, w8, true); ((GAS unsigned*)(O8 + (size_t)(row0 + r) * D) + F.lane)[64 * j] = (unsigned)w8; } } }
    }
}
using pg8::Unit;
constexpr float WSCALE8 = 32.0f;
typedef const f32x4 (&AccRef)[2][2][4][2];

struct EpiInProj {
    static constexpr bool PERM = true;
    bf16_t* Z; bf16_t* Gt;
    __device__ __forceinline__ void operator()(AccRef acc, const Unit& u, int wr, int wc, int fr, int fq) const {
        asm volatile("" : "+v"(fr), "+v"(fq));
        const int row0 = u.pm * 256 + wr * 64 + fr;
        const bool gate = u.pn >= 16;
        const float sc = ((u.pn < 2) ? QSCALE : 1.0f) * (1.0f / WSCALE8);
        bf16_t* base = gate ? Gt + (size_t)(u.pn - 16) * 256 : Z + (size_t)u.pn * 256;
        const int ldc = gate ? GW : ZW;
#pragma unroll
        for (int ai = 0; ai < 2; ++ai)
#pragma unroll
            for (int m = 0; m < 4; ++m) { bf16_t* rowp = base + (size_t)(row0 + ai * 128 + m * 16) * ldc + wc * 32 + 8 * fq;
#pragma unroll
                for (int bj = 0; bj < 2; ++bj) { f32x4 v0 = acc[ai][bj][m][0], v1 = acc[ai][bj][m][1];
                    if (gate) {
#pragma unroll
                        for (int j = 0; j < 4; ++j) { v0[j] = fast_sigmoid(v0[j] * sc); v1[j] = fast_sigmoid(v1[j] * sc); } }
                    else { v0 = v0 * sc; v1 = v1 * sc; }
                    u32x4 w; w.x = cvt_pk_bf16(v0[0], v0[1]); w.y = cvt_pk_bf16(v0[2], v0[3]); w.z = cvt_pk_bf16(v1[0], v1[1]); w.w = cvt_pk_bf16(v1[2], v1[3]);
                    *(u32x4*)(rowp + bj * 128) = w; } }
    }
};

constexpr float ATT_S8 = 16.0f, RW_S8 = 8.0f, MIX_S8 = 16.0f;
template <int SECOND> struct EpiMerge {
    static constexpr bool PERM = true;
    bf16_t* Mx; unsigned char* Mx8; const bf16_t* Gt; float bs;
    __device__ __forceinline__ void operator()(AccRef acc, const Unit& u, int wr, int wc, int fr, int fq) const {
        asm volatile("" : "+v"(fr), "+v"(fq));
        const int row0 = u.pm * 256 + wr * 64 + fr, col0 = u.pn * 256 + wc * 32 + 8 * fq;
#pragma unroll
        for (int ai = 0; ai < 2; ++ai)
#pragma unroll
            for (int m = 0; m < 4; ++m) { const size_t r = (size_t)(row0 + ai * 128 + m * 16);
#pragma unroll
                for (int bj = 0; bj < 2; ++bj) { const int c = col0 + bj * 128;
                    const u32x4 g = *(const u32x4*)(Gt + r * GW + SECOND * 1024 + c);
                    f32x4 v0 = acc[ai][bj][m][0] * bs, v1 = acc[ai][bj][m][1] * bs;
                    v0[0] *= bf_lo(g.x); v0[1] *= bf_hi(g.x); v0[2] *= bf_lo(g.y); v0[3] *= bf_hi(g.y);
                    v1[0] *= bf_lo(g.z); v1[1] *= bf_hi(g.z); v1[2] *= bf_lo(g.w); v1[3] *= bf_hi(g.w);
                    if (SECOND) { const u32x4 p = *(const u32x4*)(Mx + r * D + c);
                        v0[0] += bf_lo(p.x); v0[1] += bf_hi(p.x); v0[2] += bf_lo(p.y); v0[3] += bf_hi(p.y);
                        v1[0] += bf_lo(p.z); v1[1] += bf_hi(p.z); v1[2] += bf_lo(p.w); v1[3] += bf_hi(p.w);
                        v0 = v0 * MIX_S8; v1 = v1 * MIX_S8;
                        int lo = __builtin_amdgcn_cvt_pk_fp8_f32(v0[0], v0[1], 0, false); lo = __builtin_amdgcn_cvt_pk_fp8_f32(v0[2], v0[3], lo, true);
                        int hi = __builtin_amdgcn_cvt_pk_fp8_f32(v1[0], v1[1], 0, false); hi = __builtin_amdgcn_cvt_pk_fp8_f32(v1[2], v1[3], hi, true);
                        *(u32x2*)(Mx8 + r * D + c) = (u32x2){(unsigned)lo, (unsigned)hi}; }
                    else { u32x4 w; w.x = cvt_pk_bf16(v0[0], v0[1]); w.y = cvt_pk_bf16(v0[2], v0[3]); w.z = cvt_pk_bf16(v1[0], v1[1]); w.w = cvt_pk_bf16(v1[2], v1[3]);
                        *(u32x4*)(Mx + r * D + c) = w; }
                    asm volatile("" ::: "memory"); } }
    }
};

struct EpiOutProj {
    static constexpr bool PERM = false;
    const float* X; float* O; const float* mod;
    __device__ __forceinline__ void operator()(AccRef acc, const Unit& u, int wr, int wc, int fr, int fq) const {
        asm volatile("" : "+v"(fr), "+v"(fq));
        const int row0 = u.pm * 256 + wr * 64 + fr, col0 = u.pn * 256 + wc * 32 + 4 * fq;
        const float* g1 = mod + (size_t)((u.pm * 256) / SEQ) * 6144 + 2048;
        f32x4 gv[2][2];
#pragma unroll
        for (int bj = 0; bj < 2; ++bj)
#pragma unroll
            for (int n = 0; n < 2; ++n) gv[bj][n] = *(const f32x4*)(g1 + col0 + bj * 128 + n * 16);
#pragma unroll
        for (int ai = 0; ai < 2; ++ai)
#pragma unroll
            for (int m = 0; m < 4; ++m) { const size_t off = (size_t)(row0 + ai * 128 + m * 16) * D + col0;
#pragma unroll
                for (int bj = 0; bj < 2; ++bj)
#pragma unroll
                    for (int n = 0; n < 2; ++n) { const f32x4 xv = *(const f32x4*)(X + off + bj * 128 + n * 16);
                        *(f32x4*)(O + off + bj * 128 + n * 16) = xv + gv[bj][n] * acc[ai][bj][m][n] * (1.0f / (MIX_S8 * WSCALE8)); }
                if (m & 1) asm volatile("" ::: "memory"); }
    }
};

struct EpiRouter {
    static constexpr bool PERM = false;
    float* L;
    __device__ __forceinline__ void operator()(AccRef acc, const Unit& u, int wr, int wc, int fr, int fq) const {
        asm volatile("" : "+v"(fr), "+v"(fq));
        if (wc >= 2) return;
        const int row0 = u.pm * 256 + wr * 64 + fr, col0 = wc * 32 + 4 * fq;
#pragma unroll
        for (int ai = 0; ai < 2; ++ai)
#pragma unroll
            for (int m = 0; m < 4; ++m)
#pragma unroll
                for (int n = 0; n < 2; ++n) *(f32x4*)(L + (size_t)(row0 + ai * 128 + m * 16) * 64 + col0 + n * 16) = acc[ai][0][m][n];
    }
};

struct MoeSched1 {
    const LAS unsigned* tab; int ntiles, G, c;
    __device__ __forceinline__ bool next(int i, Unit& u) const {
        const int L = i * G + c; if (L >= 256 + 2 * ntiles) return false;
        u.pn = L & 1;
        if (L < 256) { u.pm = L >> 1; u.aux0 = (u.pm * 256) | (64 << 20); u.aux1 = 256; }
        else { const int t = (L - 256) >> 1; u.pm = t; u.aux0 = __builtin_amdgcn_readfirstlane((int)tab[2 * t]); u.aux1 = __builtin_amdgcn_readfirstlane((int)tab[2 * t + 1]); }
        return true;
    }
};
struct MoeSrc1 {
    static constexpr int ESZ = 2; static constexpr bool GATHER = true;
    const unsigned char* ws;
    __device__ __forceinline__ const char* a_base(const Unit&) const { return (const char*)(ws + WS_H2); }
    __device__ __forceinline__ const char* b_base(const Unit& u) const { const int e = u.aux0 >> 20;
        const size_t off = (e == 64 ? WS_WSH1 : WS_W1T + (size_t)e * 512 * 1024 * 2) + (size_t)u.pn * 256 * 1024 * 2; return (const char*)ws + off; }
    __device__ __forceinline__ unsigned a_off(const Unit& u, int R, int C) const {
        const int e = u.aux0 >> 20, pos0 = u.aux0 & 0xFFFFF; int tok;
        if (e == 64) tok = pos0 + R; else tok = (R < u.aux1) ? (((const int*)(ws + WS_STOK))[pos0 + R] >> 3) : 0;
        return (unsigned)tok * 2048u + (unsigned)C * 2u; }
};
struct EpiMoe1 {
    static constexpr bool PERM = true;
    unsigned char* ws;
    __device__ __forceinline__ void operator()(AccRef acc, const Unit& u, int wr, int wc, int fr, int fq) const {
        asm volatile("" : "+v"(fr), "+v"(fq));
        const int e = u.aux0 >> 20, pos0 = u.aux0 & 0xFFFFF;
        bf16_t* base = (bf16_t*)(ws + (e == 64 ? WS_ACTS : WS_ACT)) + (size_t)pos0 * FF + u.pn * 128 + wc * 32 + 8 * fq;
#pragma unroll
        for (int ai = 0; ai < 2; ++ai)
#pragma unroll
            for (int m = 0; m < 4; ++m) { const int r = ai * 128 + wr * 64 + m * 16 + fr;
                float o[8];
#pragma unroll
                for (int n = 0; n < 2; ++n)
#pragma unroll
                    for (int j = 0; j < 4; ++j) { const float g = acc[ai][0][m][n][j], up = acc[ai][1][m][n][j]; o[4 * n + j] = g * fast_sigmoid(g) * up; }
                u32x4 w; w.x = cvt_pk_bf16(o[0], o[1]); w.y = cvt_pk_bf16(o[2], o[3]); w.z = cvt_pk_bf16(o[4], o[5]); w.w = cvt_pk_bf16(o[6], o[7]);
                if (r < u.aux1) *(u32x4*)(base + (size_t)r * FF) = w; }
    }
};
struct MoeSched2 {
    const LAS unsigned* tab; int t0, ntiles, nsh, G, c;
    __device__ __forceinline__ bool next(int i, Unit& u) const {
        const int L = i * G + c; if (L >= nsh + 4 * ntiles) return false;
        u.pn = L & 3;
        if (L < nsh) { u.pm = L >> 2; u.aux0 = (u.pm * 256) | (64 << 20); u.aux1 = 256; }
        else { const int t = t0 + ((L - nsh) >> 2); u.pm = t; u.aux0 = __builtin_amdgcn_readfirstlane((int)tab[2 * t]); u.aux1 = __builtin_amdgcn_readfirstlane((int)tab[2 * t + 1]); }
        return true;
    }
};
struct MoeSrc2 {
    static constexpr int ESZ = 2; static constexpr bool GATHER = true;
    const unsigned char* ws;
    __device__ __forceinline__ const char* a_base(const Unit& u) const { return (const char*)ws + ((u.aux0 >> 20) == 64 ? WS_ACTS : WS_ACT); }
    __device__ __forceinline__ const char* b_base(const Unit& u) const { const int e = u.aux0 >> 20;
        const size_t off = (e == 64 ? WS_WSH2 : WS_W2T + (size_t)e * 1024 * 256 * 2) + (size_t)u.pn * 256 * 256 * 2; return (const char*)ws + off; }
    __device__ __forceinline__ unsigned a_off(const Unit& u, int R, int C) const {
        const int pos0 = u.aux0 & 0xFFFFF; const int rr = R < u.aux1 ? R : u.aux1 - 1;
        return (unsigned)(pos0 + rr) * 512u + (unsigned)C * 2u; }
};
constexpr float SLOT_SCALE = 16.0f;
constexpr int NSLOT = 9;
struct EpiMoe2 {
    static constexpr bool PERM = true;
    unsigned char* ws; float* X1; int tokbase;
    mutable int ptk[8]; mutable float pwt[8];
    __device__ __forceinline__ void prefetch(const Unit& u, int wr, int fr) const {
        const int e = u.aux0 >> 20, pos0 = u.aux0 & 0xFFFFF;
        if (e != 64) {
#pragma unroll
            for (int ai = 0; ai < 2; ++ai)
#pragma unroll
                for (int m = 0; m < 4; ++m) { const int r = ai * 128 + wr * 64 + m * 16 + fr; const int rc = r < u.aux1 ? r : u.aux1 - 1;
                    ptk[ai * 4 + m] = ((const int*)(ws + WS_STOK))[pos0 + rc]; pwt[ai * 4 + m] = ((const float*)(ws + WS_SW))[pos0 + rc]; } }
    }
    __device__ __forceinline__ void operator()(AccRef acc, const Unit& u, int wr, int wc, int fr, int fq) const {
        asm volatile("" : "+v"(fr), "+v"(fq));
        const int e = u.aux0 >> 20, pos0 = u.aux0 & 0xFFFFF; const int col0 = u.pn * 256 + wc * 32 + 8 * fq;
        if (e == 64) {
#pragma unroll
            for (int ai = 0; ai < 2; ++ai)
#pragma unroll
                for (int m = 0; m < 4; ++m) { unsigned char* rowp = (unsigned char*)(ws + WS_SLOT) + ((size_t)(pos0 + ai * 128 + wr * 64 + m * 16 + fr) * NSLOT + 8) * D + u.pn * 256 + wc * 64 + fq * 16;
                    u32x4 o;
#pragma unroll
                    for (int bj = 0; bj < 2; ++bj) { const f32x4 v0 = acc[ai][bj][m][0] * SLOT_SCALE, v1 = acc[ai][bj][m][1] * SLOT_SCALE;
                        int lo = __builtin_amdgcn_cvt_pk_fp8_f32(v0[0], v0[1], 0, false); lo = __builtin_amdgcn_cvt_pk_fp8_f32(v0[2], v0[3], lo, true);
                        int hi = __builtin_amdgcn_cvt_pk_fp8_f32(v1[0], v1[1], 0, false); hi = __builtin_amdgcn_cvt_pk_fp8_f32(v1[2], v1[3], hi, true);
                        if (bj == 0) { o.x = (unsigned)lo; o.y = (unsigned)hi; } else { o.z = (unsigned)lo; o.w = (unsigned)hi; } }
                    *(u32x4*)rowp = o;
                    asm volatile("" ::: "memory"); }
        } else {
#pragma unroll
            for (int ai = 0; ai < 2; ++ai)
#pragma unroll
                for (int m = 0; m < 4; ++m) { const int r = ai * 128 + wr * 64 + m * 16 + fr;
                    if (r < u.aux1) { const int tk = ptk[ai * 4 + m]; const float w = pwt[ai * 4 + m] * SLOT_SCALE;
                        unsigned char* rowp = (unsigned char*)(ws + WS_SLOT) + ((size_t)(tk >> 3) * NSLOT + (tk & 7)) * D + u.pn * 256 + wc * 64 + fq * 16;
                        u32x4 o;
#pragma unroll
                        for (int bj = 0; bj < 2; ++bj) { const f32x4 v0 = acc[ai][bj][m][0] * w, v1 = acc[ai][bj][m][1] * w;
                            int lo = __builtin_amdgcn_cvt_pk_fp8_f32(v0[0], v0[1], 0, false); lo = __builtin_amdgcn_cvt_pk_fp8_f32(v0[2], v0[3], lo, true);
                            int hi = __builtin_amdgcn_cvt_pk_fp8_f32(v1[0], v1[1], 0, false); hi = __builtin_amdgcn_cvt_pk_fp8_f32(v1[2], v1[3], hi, true);
                            if (bj == 0) { o.x = (unsigned)lo; o.y = (unsigned)hi; } else { o.z = (unsigned)lo; o.w = (unsigned)hi; } }
                        *(u32x4*)rowp = o; }
                    asm volatile("" ::: "memory"); }
        }
    }
};
__device__ __forceinline__ unsigned ord_key(float x) { const unsigned b = __float_as_uint(x); return (b & 0x80000000u) ? ~b : (b | 0x80000000u); }

__device__ __forceinline__ void idx_glds16(const void* gsrc, unsigned lds_dst) { unsigned keep;
    asm volatile("s_mov_b32 %0, m0\n\ts_mov_b32 m0, %2\n\ts_nop 0\n\tglobal_load_lds_dwordx4 %1, off\n\ts_mov_b32 m0, %0" : "=&s"(keep) : "v"(gsrc), "s"(lds_dst) : "memory"); }

__device__ __forceinline__ void indexer_unit(const Args& args, Frame& F, int b, int q0) {
    const bf16_t* Z = (const bf16_t*)(F.ws + WS_Z) + (size_t)b * SEQ * ZW;
    unsigned* SELM = (unsigned*)(F.ws + WS_SEL) + (size_t)b * SEQ * 128;
    int tid = F.tid; asm volatile("" : "+v"(tid));
    const int lane = tid & 63, kl = lane & 31, hl = lane >> 5, w = F.wave;
    const int qa = q0 + 2 * w;
    const int myq = qa + hl;
    bf16x8 A0, A1;
    { const int aq = (kl >> 2) & 1, ah = 4 * (kl >> 3) + (kl & 3);
      const bf16_t* p = Z + (size_t)(qa + aq) * ZW + ZIQ + ah * 32 + 8 * hl;
      A0 = *(const bf16x8*)p; A1 = *(const bf16x8*)(p + 16); }
    float wq[16];
    { const bf16_t* p = Z + (size_t)myq * ZW + ZIW; const u32x4 a = *(const u32x4*)p, c = *(const u32x4*)(p + 8);
      wq[0] = bf_lo(a.x); wq[1] = bf_hi(a.x); wq[2] = bf_lo(a.y); wq[3] = bf_hi(a.y); wq[4] = bf_lo(a.z); wq[5] = bf_hi(a.z); wq[6] = bf_lo(a.w); wq[7] = bf_hi(a.w);
      wq[8] = bf_lo(c.x); wq[9] = bf_hi(c.x); wq[10] = bf_lo(c.y); wq[11] = bf_hi(c.y); wq[12] = bf_lo(c.z); wq[13] = bf_hi(c.z); wq[14] = bf_lo(c.w); wq[15] = bf_hi(c.w); }
    unsigned key[128];
    const int nchunk = (q0 + 15) / 1024 + 1;
    const unsigned idx_lds0 = (unsigned)(uintptr_t)F.lds;
#define IDX_LOAD(ch, buf) do { _Pragma("unroll") for (int _i = 0; _i < 8; ++_i) { const int kg_ = w * 8 + _i; const int key_ = 16 * kg_ + (lane >> 2); \
        idx_glds16(Z + (size_t)((ch) * 1024 + key_) * ZW + ZIK + 8 * ((lane & 3) ^ ((key_ >> 2) & 3)), (unsigned)__builtin_amdgcn_readfirstlane((int)(idx_lds0 + (buf) * 65536 + kg_ * 1024))); } } while (0)
    IDX_LOAD(0, 0);
    asm volatile("s_waitcnt vmcnt(0)" ::: "memory");
    __syncthreads();
#pragma unroll
    for (int ch = 0; ch < 4; ++ch) {
        if (ch < nchunk) {
            if (ch + 1 < nchunk) IDX_LOAD(ch + 1, (ch + 1) & 1);
            LAS unsigned char* kbl = F.lds + (ch & 1) * 65536 + kl * 64 + ((hl ^ ((kl >> 2) & 3)) * 16); asm volatile("" : "+v"(kbl));
            LAS unsigned char* kbl2 = F.lds + (ch & 1) * 65536 + kl * 64 + (((hl + 2) ^ ((kl >> 2) & 3)) * 16); asm volatile("" : "+v"(kbl2));
#pragma unroll
            for (int tt = 0; tt < 32; tt += 2) {
                const int t = ch * 32 + tt;
                if (32 * t <= qa + 1) {
                    bf16x8 B0[2], B1[2]; f32x16 acc[2];
#pragma unroll
                    for (int j = 0; j < 2; ++j) { B0[j] = *(const LAS bf16x8*)(kbl + 2048 * (tt + j)); B1[j] = *(const LAS bf16x8*)(kbl2 + 2048 * (tt + j)); }
#pragma unroll
                    for (int j = 0; j < 2; ++j) { acc[j] = f32x16{}; acc[j] = __builtin_amdgcn_mfma_f32_32x32x16_bf16(A0, B0[j], acc[j], 0, 0, 0); }
#pragma unroll
                    for (int j = 0; j < 2; ++j) acc[j] = __builtin_amdgcn_mfma_f32_32x32x16_bf16(A1, B1[j], acc[j], 0, 0, 0);
#pragma unroll
                    for (int j = 0; j < 2; ++j) { float s = 0.f;
#pragma unroll
                        for (int i = 0; i < 16; ++i) { const float av_ = acc[j][i]; const int xb_ = __float_as_int(av_); s += __int_as_float(xb_ > 0 ? xb_ : 0) * wq[i]; }
                        key[t + j] = (32 * (t + j) + kl <= myq) ? ord_key(s) : 0u; }
                } else {
#pragma unroll
                    for (int j = 0; j < 2; ++j) key[t + j] = 0u;
                }
            }
            asm volatile("s_waitcnt vmcnt(0)" ::: "memory");
            __syncthreads();
        } else {
#pragma unroll
            for (int tt = 0; tt < 32; ++tt) key[ch * 32 + tt] = 0u;
        }
    }
#undef IDX_LOAD
#pragma unroll
    for (int w = 0; w < 4; ++w) {
        if (1024 * w <= qa + 1) {
#pragma unroll
            for (int k = 0; k < 16; ++k) { const unsigned lo = key[32 * w + k], hi_ = key[32 * w + k + 16];
                key[32 * w + k] = __builtin_amdgcn_perm(hi_, lo, 0x05040100u); key[32 * w + k + 16] = __builtin_amdgcn_perm(hi_, lo, 0x07060302u); }
#pragma unroll
            for (int k = 0; k < 32; ++k) if (!(k & 8)) { const unsigned lo = key[32 * w + k], hi_ = key[32 * w + k + 8];
                key[32 * w + k] = __builtin_amdgcn_perm(hi_, lo, 0x06020400u); key[32 * w + k + 8] = __builtin_amdgcn_perm(hi_, lo, 0x07030501u); }
#pragma unroll
            for (int k = 0; k < 32; ++k) if (!(k & 4)) { const unsigned lo = key[32 * w + k], hi_ = key[32 * w + k + 4]; const unsigned m = 0x0F0F0F0Fu;
                key[32 * w + k] = (lo & m) | ((hi_ << 4) & ~m); key[32 * w + k + 4] = ((lo >> 4) & m) | (hi_ & ~m); }
#pragma unroll
            for (int k = 0; k < 32; ++k) if (!(k & 2)) { const unsigned lo = key[32 * w + k], hi_ = key[32 * w + k + 2]; const unsigned m = 0x33333333u;
                key[32 * w + k] = (lo & m) | ((hi_ << 2) & ~m); key[32 * w + k + 2] = ((lo >> 2) & m) | (hi_ & ~m); }
#pragma unroll
            for (int k = 0; k < 32; ++k) if (!(k & 1)) { const unsigned lo = key[32 * w + k], hi_ = key[32 * w + k + 1]; const unsigned m = 0x55555555u;
                key[32 * w + k] = (lo & m) | ((hi_ << 1) & ~m); key[32 * w + k + 1] = ((lo >> 1) & m) | (hi_ & ~m); }
        }
    }
    unsigned Al[4] = {~0u, ~0u, ~0u, ~0u}, Gt[4] = {0u, 0u, 0u, 0u};
    int ab0 = 0, ab1 = 0; unsigned T0 = 0u, T1 = 0u; bool dn0 = false, dn1 = false;
#define IDX_DPP(v, ctrl) __builtin_amdgcn_update_dpp(0, (v), (ctrl), 0xF, 0xF, true)
#pragma unroll
    for (int bit = 31; bit >= 0; --bit) {
        unsigned S_[4]; int c = 0;
#pragma unroll
        for (int w = 0; w < 4; ++w) { S_[w] = Al[w] & key[32 * w + bit]; c += __builtin_popcount(S_[w]); }
        c += IDX_DPP(c, 0xB1); c += IDX_DPP(c, 0x4E); c += IDX_DPP(c, 0x141); c += IDX_DPP(c, 0x140);
        const int cn0 = ab0 + __builtin_amdgcn_readlane(c, 0) + __builtin_amdgcn_readlane(c, 16), cn1 = ab1 + __builtin_amdgcn_readlane(c, 32) + __builtin_amdgcn_readlane(c, 48);
        const bool t0 = cn0 >= 256, t1 = cn1 >= 256;
        if (t0) { T0 |= 1u << bit; dn0 = dn0 || cn0 == 256; } else ab0 = cn0;
        if (t1) { T1 |= 1u << bit; dn1 = dn1 || cn1 == 256; } else ab1 = cn1;
        const unsigned nm = hl ? (t1 ? 0u : ~0u) : (t0 ? 0u : ~0u);
#pragma unroll
        for (int w = 0; w < 4; ++w) { Al[w] &= key[32 * w + bit] ^ nm; Gt[w] |= S_[w] & nm; }
        if (dn0 && dn1) break;
    }
#undef IDX_DPP
    unsigned x[4];
    { const bool nz = hl ? (T1 != 0u) : (T0 != 0u);
#pragma unroll
      for (int w = 0; w < 4; ++w) x[w] = Gt[w] | (nz ? Al[w] : 0u); }
#define IDX_BFLY(d, m) do { const bool up_ = (kl & (d)) != 0; const unsigned km_ = up_ ? ~(m) : (m); const unsigned am_ = up_ ? (unsigned)(d) : 32u - (d); \
        _Pragma("unroll") for (int w = 0; w < 4; ++w) { const unsigned t_ = (unsigned)__builtin_amdgcn_ds_swizzle((int)x[w], 0x1F | ((d) << 10)); \
            const unsigned rot_ = __builtin_amdgcn_alignbit(t_, t_, am_); x[w] = (x[w] & km_) | (rot_ & ~km_); } } while (0)
    IDX_BFLY(16, 0x0000FFFFu); IDX_BFLY(8, 0x00FF00FFu); IDX_BFLY(4, 0x0F0F0F0Fu); IDX_BFLY(2, 0x33333333u); IDX_BFLY(1, 0x55555555u);
#undef IDX_BFLY
#pragma unroll
    for (int j = 0; j < 4; ++j) SELM[(size_t)myq * 128 + kl + 32 * j] = x[j];
}

__device__ __forceinline__ void indexer_phase(const Args& args, Frame& F) {
    const int c = blockIdx.x;
    for (int i = 0; i < 8; ++i) {
        for (int u = c + i * F.G; u < 2048 && i < 8; u += 2048) {
            const int b = u >> 8, pos = u & 255, blk = (b & 1) ? 255 - pos : pos;
            indexer_unit(args, F, b, blk * 16);
        }
    }
}
namespace att {
constexpr int DM = ZW, QB = 256, KVB = 64, SLOTB = 8192;
constexpr int NS = 4;
constexpr int L_K = 0, L_V = NS * SLOTB, L_MASK = 2 * NS * SLOTB, L_WSF = L_MASK + 8 * 2048, L_OST = L_WSF + 8 * 256, L_BT = L_OST + 8 * 4096, L_MT = L_BT + 512, L_END = L_MT + 128;
static_assert(L_END <= RING_BYTES, "attention LDS");
__device__ __forceinline__ int crow(int r, int hi) { return (r & 3) + 8 * (r >> 2) + 4 * hi; }
__device__ __forceinline__ void glds16(const void* gsrc, unsigned lds_dst) { unsigned keep;
    asm volatile("s_mov_b32 %0, m0\n\ts_mov_b32 m0, %2\n\ts_nop 0\n\tglobal_load_lds_dwordx4 %1, off\n\ts_mov_b32 m0, %0" : "=&s"(keep) : "v"(gsrc), "s"(lds_dst) : "memory"); }
__device__ __forceinline__ unsigned cvtpk(float lo, float hi) { return cvt_pk_bf16(lo, hi); }
typedef short s16x4 __attribute__((ext_vector_type(4)));

#ifdef PROBE_CYC
#define CYC_DECL unsigned cyc_t0_ = 0, cyc_a_ = 0; asm volatile("" : "+v"(cyc_t0_), "+v"(cyc_a_)); const bool cyc_on_ = (F.vcu == PROBE_CYC_WG) && (F.wave == PROBE_CYC_WAVE)
#define CYC_START() do { unsigned n_ = (unsigned)__builtin_readcyclecounter(); asm volatile("" : "+v"(n_)); cyc_t0_ = n_; } while (0)
#define CYC_MARK(k_) do { unsigned n_ = (unsigned)__builtin_readcyclecounter(); asm volatile("" : "+v"(n_)); if ((k_) == PROBE_CYC_SEL) cyc_a_ += n_ - cyc_t0_; cyc_t0_ = n_; } while (0)
#define CYC_FLUSH() do { if (cyc_on_ && F.lane == 0) atomicAdd(F.ctl + CW_Q + 64, cyc_a_); } while (0)
#else
#define CYC_DECL
#define CYC_START()
#define CYC_MARK(k_)
#define CYC_FLUSH()
#endif
__device__ __forceinline__ void attn_unit(const Args& args, Frame& F, int b, int h, int qb) {
    const int lane = F.lane, r32 = lane & 31, hi = lane >> 5, wid = F.wave;
    CYC_DECL;
#ifndef PROBE_ATT_VAR
#define PROBE_ATT_VAR 0
#endif
    const bool alt_ = (PROBE_ATT_VAR != 0) && (args.li == 1);
#define ALT(bit_) (alt_ && ((PROBE_ATT_VAR) & (bit_)))
    const bf16_t* Zb = (const bf16_t*)(F.ws + WS_Z) + (size_t)b * SEQ * DM;
    const int q0 = qb * QB;
    const bf16_t* Qw = Zb + (size_t)(q0 + wid * 32) * DM + ZQ + h * 64;
    const bf16_t* Kh = Zb + ZK + h * 64; const bf16_t* Vh = Zb + ZV + h * 64;
    LAS unsigned char* shm = F.lds;
    const unsigned lds0 = (unsigned)(uintptr_t)shm;
    LAS float* wsf = (LAS float*)(shm + L_WSF) + wid * 64;
    LAS float* bt = (LAS float*)(shm + L_BT);
    if (F.tid >= 128 && F.tid < 144) { const unsigned n = F.tid - 128;
        *(LAS u32x2*)(shm + L_MT + 8 * n) = (u32x2){((n & 1u) ? 0xFFFFu : 0u) | ((n & 2u) ? 0xFFFF0000u : 0u), ((n & 4u) ? 0xFFFFu : 0u) | ((n & 8u) ? 0xFFFF0000u : 0u)}; }
    if (F.tid < 128) { const int rel = F.tid; int bk;
        if (rel < 16) bk = rel; else { bk = 16 + (int)(logf((float)rel / 16.0f) / logf(8.0f) * 16.0f); bk = bk < 31 ? bk : 31; }
        bt[rel] = (AIN(6)[bk * 8 + h] - AIN(6)[31 * 8 + h]) * 1.4426950408889634f; }
    const bf16_t* ksrc = Kh + (size_t)lane * DM + wid * 8;
    const bf16_t* vsrc = Vh + (size_t)(16 * (wid & 3) + (lane >> 2)) * DM + (wid >> 2) * 32 + (lane & 3) * 8;
    const unsigned kdst = lds0 + L_K + wid * 1024, vdst = lds0 + L_V + wid * 1024;
    const unsigned* SELM = (const unsigned*)(F.ws + WS_SEL) + (size_t)(b * SEQ + q0 + wid * 32 + r32) * 128 + 4 * hi;
    const unsigned mdst = lds0 + L_MASK + wid * 2048;
#define DMA_K(t, slot) glds16(ksrc + (size_t)(t) * KVB * DM, (unsigned)__builtin_amdgcn_readfirstlane(kdst + (slot) * SLOTB))
#define DMA_V(t, slot) glds16(vsrc + (size_t)(t) * KVB * DM, (unsigned)__builtin_amdgcn_readfirstlane(vdst + (slot) * SLOTB))
#define DMA_M(g) glds16(SELM + 8 * (g), (unsigned)__builtin_amdgcn_readfirstlane(mdst + ((g) & 1) * 1024))
    const int NT = ALT(1024) ? 4 : (q0 + QB) / KVB;
    bf16x8 qr[4];
#pragma unroll
    for (int d0 = 0; d0 < 4; ++d0) qr[d0] = *(const bf16x8*)(Qw + (size_t)r32 * DM + d0 * 16 + hi * 8);
    asm volatile("s_waitcnt vmcnt(0)" ::: "memory");
    __syncthreads();
    DMA_M(0); DMA_K(0, 0); DMA_K(1, 1); DMA_V(0, 0); DMA_K(2, 2); DMA_V(1, 1); DMA_K(3, 3); DMA_V(2, 2);
    float m_run = 0.f; f32x16 o[2], lacc = f32x16{}; o[0] = f32x16{}; o[1] = f32x16{};
    const bf16x8 ones8 = __builtin_bit_cast(bf16x8, (u32x4){0x3F803F80u, 0x3F803F80u, 0x3F803F80u, 0x3F803F80u});
    const int qpos = q0 + wid * 32 + r32;
    const int vb0 = (int)(lds0 + L_V) + ((lane >> 4) & 1) * 32 + (lane & 3) * 8 + (4 * hi + ((lane & 15) >> 2)) * 64;
#define QK_TILE(P0, P1, slot_) do { const LAS unsigned char* kb = shm + L_K + (slot_) * SLOTB + hi * 1024 + r32 * 16; P0 = f32x16{}; P1 = f32x16{}; \
        _Pragma("unroll") for (int d0 = 0; d0 < 4; ++d0) { const bf16x8 b0 = *(const LAS bf16x8*)(kb + d0 * 2048); const bf16x8 b1 = *(const LAS bf16x8*)(kb + d0 * 2048 + 512); \
            P0 = __builtin_amdgcn_mfma_f32_32x32x16_bf16(b0, qr[d0], P0, 0, 0, 0); P1 = __builtin_amdgcn_mfma_f32_32x32x16_bf16(b1, qr[d0], P1, 0, 0, 0); } } while (0)
    f32x16 pa0, pa1, pb0, pb1;
    asm volatile("s_waitcnt vmcnt(6)" ::: "memory");
    __builtin_amdgcn_s_barrier(); asm volatile("" ::: "memory");
    QK_TILE(pa0, pa1, 0);
#define ATT_WAITV(n_) do { const int nn_ = (n_); if (nn_ >= 4) asm volatile("s_waitcnt vmcnt(4)" ::: "memory"); else if (nn_ == 3) asm volatile("s_waitcnt vmcnt(3)" ::: "memory"); \
        else if (nn_ == 2) asm volatile("s_waitcnt vmcnt(2)" ::: "memory"); else if (nn_ == 1) asm volatile("s_waitcnt vmcnt(1)" ::: "memory"); else asm volatile("s_waitcnt vmcnt(0)" ::: "memory"); } while (0)
    asm volatile("s_waitcnt lgkmcnt(0)" ::: "memory");
    if (wid >= 4) { __builtin_amdgcn_s_barrier(); asm volatile("" ::: "memory"); }
    auto step = [&](const int t, f32x16& C0, f32x16& C1, f32x16& N0, f32x16& N1) __attribute__((always_inline)) {
        const int slot = t & (NS - 1), g = t >> 2, tq = t & 3;
        CYC_START();
        if (!ALT(32)) ATT_WAITV((t + 1 < NT) + 2 * (t + 2 < NT) + (t + 3 < NT));
        if (!ALT(16)) __builtin_amdgcn_s_barrier(); asm volatile("" ::: "memory");
        CYC_MARK(0);
        if (t + 4 < NT && !ALT(32)) DMA_K(t + 4, (t + 4) & (NS - 1));
        if (tq == 0 && !ALT(32)) DMA_M(g + 1);
        if (t + 1 < NT) { if (ALT(4)) { N0 = f32x16{}; N1 = f32x16{}; } else QK_TILE(N0, N1, (t + 1) & (NS - 1)); }
        __builtin_amdgcn_sched_barrier(0);
        const u32x2 mwv = *(const LAS u32x2*)(shm + L_MASK + wid * 2048 + (g & 1) * 1024 + (tq >> 1) * 512 + r32 * 16 + (tq & 1) * 8);
        if (64 * t + 63 + 112 >= q0 + wid * 32 && !ALT(256)) {
#pragma unroll
            for (int r = 0; r < 16; ++r) { const int kv = 64 * t + crow(r, hi); int r0 = qpos - kv, r1 = r0 - 32;
                r0 = r0 < 0 ? 0 : (r0 > 127 ? 127 : r0); r1 = r1 < 0 ? 0 : (r1 > 127 ? 127 : r1);
                C0[r] += bt[r0]; C1[r] += bt[r1]; }
        }
        if (!ALT(128)) {
        typedef float f32x2_ __attribute__((ext_vector_type(2)));
        { const f32x2_ mm = {m_run, m_run};
#pragma unroll
          for (int r = 0; r < 16; r += 2) { f32x2_ a = {C0[r], C0[r + 1]}, c = {C1[r], C1[r + 1]}; a -= mm; c -= mm; C0[r] = a.x; C0[r + 1] = a.y; C1[r] = c.x; C1[r + 1] = c.y; } }
        float rm = __builtin_fmaxf(C0[0], C1[0]);
#pragma unroll
        for (int r = 1; r < 16; ++r) rm = __builtin_fmaxf(rm, __builtin_fmaxf(C0[r], C1[r]));
        if (t == 0 || __builtin_amdgcn_ballot_w64(rm > 8.0f) != 0ull) {
            rm = __builtin_fmaxf(rm, __shfl_xor(rm, 32));
            const float dm = t == 0 ? rm : __builtin_fmaxf(rm, 0.f);
            const float f = t == 0 ? 1.0f : __builtin_amdgcn_exp2f(-dm);
            m_run += dm;
#pragma unroll
            for (int r = 0; r < 16; ++r) { C0[r] -= dm; C1[r] -= dm; }
            if (hi == 0) wsf[r32] = f;
            asm volatile("s_waitcnt lgkmcnt(0)" ::: "memory");
#pragma unroll
            for (int r = 0; r < 16; ++r) { const float fr_ = wsf[crow(r, hi)]; o[0][r] *= fr_; o[1][r] *= fr_; lacc[r] *= fr_; }
        }
        }
        if (!ALT(2)) {
#pragma unroll
        for (int r = 0; r < 16; ++r) { C0[r] = __builtin_amdgcn_exp2f(C0[r]); C1[r] = __builtin_amdgcn_exp2f(C1[r]); } }
        asm volatile("s_waitcnt lgkmcnt(0)" ::: "memory");
        CYC_MARK(1);
        if (!ALT(32)) ATT_WAITV((t + 1 < NT) + (t + 2 < NT) + (t + 3 < NT) + (t + 4 < NT));
        if (!ALT(16)) __builtin_amdgcn_s_barrier(); asm volatile("" ::: "memory");
        CYC_MARK(2);
        if (t + 3 < NT && !ALT(32)) DMA_V(t + 3, (t + 3) & (NS - 1));
        u32x4 pw0, pw1, pw2, pw3;
        pw0 = (u32x4){cvtpk(C0[0], C0[1]), cvtpk(C0[2], C0[3]), cvtpk(C0[4], C0[5]), cvtpk(C0[6], C0[7])};
        pw1 = (u32x4){cvtpk(C0[8], C0[9]), cvtpk(C0[10], C0[11]), cvtpk(C0[12], C0[13]), cvtpk(C0[14], C0[15])};
        pw2 = (u32x4){cvtpk(C1[0], C1[1]), cvtpk(C1[2], C1[3]), cvtpk(C1[4], C1[5]), cvtpk(C1[6], C1[7])};
        pw3 = (u32x4){cvtpk(C1[8], C1[9]), cvtpk(C1[10], C1[11]), cvtpk(C1[12], C1[13]), cvtpk(C1[14], C1[15])};
        if (!ALT(64))
        { const unsigned mx_ = mwv.x >> (4 * hi), my_ = mwv.y >> (4 * hi); const LAS unsigned char* mt = shm + L_MT;
          const u32x2 a0 = *(const LAS u32x2*)(mt + ((mx_ << 3) & 0x78u)), a1 = *(const LAS u32x2*)(mt + ((mx_ >> 5) & 0x78u)), a2 = *(const LAS u32x2*)(mt + ((mx_ >> 13) & 0x78u)), a3 = *(const LAS u32x2*)(mt + ((mx_ >> 21) & 0x78u));
          const u32x2 b0 = *(const LAS u32x2*)(mt + ((my_ << 3) & 0x78u)), b1 = *(const LAS u32x2*)(mt + ((my_ >> 5) & 0x78u)), b2 = *(const LAS u32x2*)(mt + ((my_ >> 13) & 0x78u)), b3 = *(const LAS u32x2*)(mt + ((my_ >> 21) & 0x78u));
          pw0.x &= a0.x; pw0.y &= a0.y; pw0.z &= a1.x; pw0.w &= a1.y; pw1.x &= a2.x; pw1.y &= a2.y; pw1.z &= a3.x; pw1.w &= a3.y;
          pw2.x &= b0.x; pw2.y &= b0.y; pw2.z &= b1.x; pw2.w &= b1.y; pw3.x &= b2.x; pw3.y &= b2.y; pw3.z &= b3.x; pw3.w &= b3.y; }
        if (!ALT(8)) {
        lacc = __builtin_amdgcn_mfma_f32_32x32x16_bf16(__builtin_bit_cast(bf16x8, pw0), ones8, lacc, 0, 0, 0); lacc = __builtin_amdgcn_mfma_f32_32x32x16_bf16(__builtin_bit_cast(bf16x8, pw1), ones8, lacc, 0, 0, 0);
        lacc = __builtin_amdgcn_mfma_f32_32x32x16_bf16(__builtin_bit_cast(bf16x8, pw2), ones8, lacc, 0, 0, 0); lacc = __builtin_amdgcn_mfma_f32_32x32x16_bf16(__builtin_bit_cast(bf16x8, pw3), ones8, lacc, 0, 0, 0);
        { const int vb = vb0 + slot * SLOTB;
#pragma unroll
          for (int d0 = 0; d0 < 2; ++d0) { s16x4 lo[4], hh[4];
#pragma unroll
              for (int ks = 0; ks < 4; ++ks) {
                  asm volatile("ds_read_b64_tr_b16 %0,%1 offset:%c2" : "=&v"(lo[ks]) : "v"(vb), "i"(d0 * 4096 + ks * 1024) : "memory");
                  asm volatile("ds_read_b64_tr_b16 %0,%1 offset:%c2" : "=&v"(hh[ks]) : "v"(vb), "i"(d0 * 4096 + ks * 1024 + 512) : "memory"); }
              asm volatile("s_waitcnt lgkmcnt(0)" ::: "memory"); __builtin_amdgcn_sched_barrier(0);
#define PKV(k) (bf16x8){lo[k][0], lo[k][1], lo[k][2], lo[k][3], hh[k][0], hh[k][1], hh[k][2], hh[k][3]}
              o[d0] = __builtin_amdgcn_mfma_f32_32x32x16_bf16(__builtin_bit_cast(bf16x8, pw0), PKV(0), o[d0], 0, 0, 0);
              o[d0] = __builtin_amdgcn_mfma_f32_32x32x16_bf16(__builtin_bit_cast(bf16x8, pw1), PKV(1), o[d0], 0, 0, 0);
              o[d0] = __builtin_amdgcn_mfma_f32_32x32x16_bf16(__builtin_bit_cast(bf16x8, pw2), PKV(2), o[d0], 0, 0, 0);
              o[d0] = __builtin_amdgcn_mfma_f32_32x32x16_bf16(__builtin_bit_cast(bf16x8, pw3), PKV(3), o[d0], 0, 0, 0);
#undef PKV
          } }
        }
        asm volatile("s_waitcnt lgkmcnt(0)" ::: "memory");
        CYC_MARK(3);
    };
    for (int t = 0; t < NT; t += 2) { step(t, pa0, pa1, pb0, pb1); step(t + 1, pb0, pb1, pa0, pa1); }
    if (wid < 4) { __builtin_amdgcn_s_barrier(); asm volatile("" ::: "memory"); }
#undef QK_TILE
#undef ATT_WAITV
    CYC_FLUSH();
    bf16_t* Ow = (bf16_t*)(F.ws + (alt_ ? WS_R2 : WS_R1)) + (size_t)(b * SEQ + q0 + wid * 32) * 512 + h * 64;
    { LAS bf16_t* stg = (LAS bf16_t*)(shm + L_OST) + wid * 2048;
#pragma unroll
      for (int r = 0; r < 16; ++r) { const int orow = crow(r, hi); const float rl = __builtin_amdgcn_rcpf(lacc[r]);
#pragma unroll
          for (int d0 = 0; d0 < 2; ++d0) stg[orow * 64 + d0 * 32 + r32] = (bf16_t)f2bf(o[d0][r] * rl); }
      asm volatile("s_waitcnt lgkmcnt(0)" ::: "memory");
#pragma unroll
      for (int i = 0; i < 4; ++i) { const int row = i * 8 + (lane >> 3), chn = lane & 7; const u32x4 v = *(const LAS u32x4*)(stg + row * 64 + chn * 8); *(u32x4*)(Ow + (size_t)row * 512 + chn * 8) = v; } }
    asm volatile("s_waitcnt lgkmcnt(0)" ::: "memory");
#undef DMA_K
#undef DMA_V
#undef DMA_M
}

__device__ __forceinline__ void attn_phase(const Args& args, Frame& F) {
    const int v = F.vcu;
    for (int i = 0; i < 4; ++i) {
        for (int uu = v; uu < 256; uu += F.G) {
            const int bh = uu >> 2, s = uu & 3; const int qb = (i == 0) ? s : (i == 1) ? 7 - s : (i == 2) ? 8 + s : 15 - s;
            attn_unit(args, F, bh >> 3, bh & 7, qb);
        }
    }
}
}
#ifndef PROBE_NO_STATE
#define PROBE_NO_STATE 0
#endif
#ifndef PROBE_TINV_ID
#define PROBE_TINV_ID 0
#endif
namespace rk {
typedef __bf16 bf16x2_t __attribute__((ext_vector_type(2)));
__device__ __forceinline__ unsigned cvtpk(float lo, float hi) { f32x2 v = {lo, hi}; bf16x2_t b = __builtin_convertvector(v, bf16x2_t); return __builtin_bit_cast(unsigned, b); }
template <int S> __device__ __forceinline__ bf16x8 frag(const f32x16& x) {
    u32x4 o; o.x = cvtpk(x[8 * S + 0], x[8 * S + 1]); o.y = cvtpk(x[8 * S + 2], x[8 * S + 3]); o.z = cvtpk(x[8 * S + 4], x[8 * S + 5]); o.w = cvtpk(x[8 * S + 6], x[8 * S + 7]);
    return __builtin_bit_cast(bf16x8, o); }
template <int S> __device__ __forceinline__ void unfrag(f32x16& x, bf16x8 f) { const u32x4 o = __builtin_bit_cast(u32x4, f);
    x[8 * S + 0] = bf_lo(o.x); x[8 * S + 1] = bf_hi(o.x); x[8 * S + 2] = bf_lo(o.y); x[8 * S + 3] = bf_hi(o.y); x[8 * S + 4] = bf_lo(o.z); x[8 * S + 5] = bf_hi(o.z); x[8 * S + 6] = bf_lo(o.w); x[8 * S + 7] = bf_hi(o.w); }
#define RK_MF(a, b, c) __builtin_amdgcn_mfma_f32_32x32x16_bf16((a), (b), (c), 0, 0, 0)
__device__ __forceinline__ float dppf(float v, const int ctrl_is_const_dummy);
#define RK_DPP(v, ctrl, rmask, bc) __builtin_bit_cast(float, __builtin_amdgcn_update_dpp(0, __builtin_bit_cast(int, (v)), (ctrl), (rmask), 0xF, (bc)))
__device__ __forceinline__ float scan32(float v) {
#ifdef PROBE_SHFL_SCAN
    const int l32 = threadIdx.x & 31;
#pragma unroll
    for (int o = 1; o < 32; o <<= 1) { const float t = __shfl_up(v, o, 32); if (l32 >= o) v += t; }
    return v;
#endif
    v += RK_DPP(v, 0x111, 0xF, true); v += RK_DPP(v, 0x112, 0xF, true); v += RK_DPP(v, 0x114, 0xF, true); v += RK_DPP(v, 0x118, 0xF, true);
    v += RK_DPP(v, 0x142, 0xA, false);
    return v; }
__device__ __forceinline__ float ex2(float x) { return __builtin_amdgcn_exp2f(x); }
constexpr int PZ = 3600;
constexpr size_t SZ_G = 8192, SZ_H = 8192, SZ_Q = 4096, SZ_Y = 4096;
constexpr float L2E = 1.4426950408889634f;

__device__ __forceinline__ void mk_id(bf16x8 (&fId)[2], int r, int h) {
    asm volatile("" : "+v"(r), "+v"(h));
#pragma unroll
    for (int s = 0; s < 2; ++s) { unsigned short e8[8];
#pragma unroll
        for (int jj = 0; jj < 8; ++jj) e8[jj] = (16 * s + 8 * (jj >> 2) + 4 * h + (jj & 3) == r) ? (unsigned short)0x3F80 : (unsigned short)0;
        fId[s] = __builtin_bit_cast(bf16x8, (u32x4){(unsigned)e8[0] | ((unsigned)e8[1] << 16), (unsigned)e8[2] | ((unsigned)e8[3] << 16), (unsigned)e8[4] | ((unsigned)e8[5] << 16), (unsigned)e8[6] | ((unsigned)e8[7] << 16)}); }
}

__device__ __forceinline__ void load_params(const Args& args, Frame& F) {
    LAS float* pra = (LAS float*)(F.lds + LDS_PARA); LAS float* prb = (LAS float*)(F.lds + LDS_PARB);
    const float* mu = AIN(7); const float* w0 = AIN(8); const float* a0 = AIN(10); const float* kk = AIN(13); const float* ka = AIN(14); const float* rk = AIN(15);
    for (int i = F.tid; i < 4096; i += NTHR) { const int a = i >> 9, c = i & 511;
        const float v_ = a < 3 ? mu[a * 512 + c] : (a == 3 ? w0[c] : (a == 4 ? a0[c] : (a == 5 ? kk[c] : (a == 6 ? ka[c] : rk[c]))));
        if (a < 4) pra[c * 4 + a] = v_; else prb[c * 4 + a - 4] = v_; }
    __syncthreads();
}
struct ElemCtx { const LAS unsigned char* rowc; const LAS unsigned char* rowp; const bf16_t* DUt; const bf16_t* IUt; const LAS float* pra; const LAS float* prb; int hd, r, h; float inv; };
template <int MODE> __device__ __forceinline__ void r1_elem(const ElemCtx& C, int jt, bf16x8 (&o0)[2], bf16x8 (&o1)[2], bf16x8 (&o2)[2], bf16x8 (&o3)[2], float& bns, float& pcd) {
    const int r = C.r, h = C.h, hd = C.hd;
    f32x16 lw_ = f32x16{}, la_ = f32x16{};
#pragma unroll
    for (int ks = 0; ks < 4; ++ks) { const int k0 = 16 * ks + 8 * h;
        const bf16x8 bw = *(const LAS bf16x8*)(C.rowc + (1536 + k0) * 2), ba = *(const LAS bf16x8*)(C.rowc + (1600 + k0) * 2);
        const bf16x8 fa = *(const bf16x8*)(C.DUt + (size_t)(32 * jt + r) * 64 + k0), fi = *(const bf16x8*)(C.IUt + (size_t)(32 * jt + r) * 64 + k0);
        lw_ = RK_MF(fa, bw, lw_); la_ = RK_MF(fi, ba, la_); }
    float d = 0.f;
#pragma unroll
    for (int s = 0; s < 2; ++s) { float x0[8], x1[8], x2[8], x3[8];
#pragma unroll
        for (int g2 = 0; g2 < 2; ++g2) { const int g = 2 * s + g2, cj = hd * 64 + 32 * jt + 8 * g + 4 * h;
            float kc[4], kq[4], xc[4], xq[4];
            { const u32x2 a = *(const LAS u32x2*)(C.rowc + (512 + cj) * 2), p = *(const LAS u32x2*)(C.rowp + (512 + cj) * 2);
              kc[0] = bf_lo(a.x); kc[1] = bf_hi(a.x); kc[2] = bf_lo(a.y); kc[3] = bf_hi(a.y); kq[0] = bf_lo(p.x); kq[1] = bf_hi(p.x); kq[2] = bf_lo(p.y); kq[3] = bf_hi(p.y); }
            { const int xo = MODE ? 1024 : 0; const u32x2 a = *(const LAS u32x2*)(C.rowc + (xo + cj) * 2), p = *(const LAS u32x2*)(C.rowp + (xo + cj) * 2);
              xc[0] = bf_lo(a.x); xc[1] = bf_hi(a.x); xc[2] = bf_lo(a.y); xc[3] = bf_hi(a.y); xq[0] = bf_lo(p.x); xq[1] = bf_hi(p.x); xq[2] = bf_lo(p.y); xq[3] = bf_hi(p.y); }
            const LAS f32x4* ppa = (const LAS f32x4*)(C.pra + cj * 4); const LAS f32x4* ppb = (const LAS f32x4*)(C.prb + cj * 4);
#pragma unroll
            for (int q = 0; q < 4; ++q) { const int i = 4 * g + q, o = 4 * g2 + q;
                const f32x4 pa = ppa[q], pb = ppb[q];
                const float e_ = 0.6065306597126334f * fast_sigmoid(pa[3] + lw_[i]); const float L = scan32(e_);
                const float l0 = __builtin_bit_cast(float, __builtin_amdgcn_readlane(__builtin_bit_cast(int, L), 31)), l1 = __builtin_bit_cast(float, __builtin_amdgcn_readlane(__builtin_bit_cast(int, L), 63));
                const float Lend = h ? l1 : l0; if (i == 4 * (r >> 3) + (r & 3)) d = Lend;
                const float x_ = xc[q] + (MODE ? pa[2] : pa[0]) * (xq[q] - xc[q]), k_ = kc[q] + pa[1] * (kq[q] - kc[q]);
                const float ic = fast_sigmoid(pb[0] + la_[i]);
                const float kk = k_ * pb[1] * C.inv, kpn = k_ * (1.0f + (ic - 1.0f) * pb[2]), bv = kk * ic;
                if (MODE) { const float Qe = ex2(L2E * (L - Lend)); x0[o] = bv * Qe; x1[o] = kpn * Qe; x2[o] = x_; x3[o] = 0.f; }
                else { const float P = ex2(-L2E * L), Pi = ex2(L2E * L), Pm = ex2(-L2E * (L - e_)); bns += x_ * kpn * pb[3]; x0[o] = -kk * Pm; x1[o] = x_ * P; x2[o] = bv * Pi; x3[o] = kpn * Pi; } }
            asm volatile("" ::: "memory"); }
        o0[s] = __builtin_bit_cast(bf16x8, (u32x4){cvtpk(x0[0], x0[1]), cvtpk(x0[2], x0[3]), cvtpk(x0[4], x0[5]), cvtpk(x0[6], x0[7])});
        o1[s] = __builtin_bit_cast(bf16x8, (u32x4){cvtpk(x1[0], x1[1]), cvtpk(x1[2], x1[3]), cvtpk(x1[4], x1[5]), cvtpk(x1[6], x1[7])});
        o2[s] = __builtin_bit_cast(bf16x8, (u32x4){cvtpk(x2[0], x2[1]), cvtpk(x2[2], x2[3]), cvtpk(x2[4], x2[5]), cvtpk(x2[6], x2[7])});
        if (!MODE) o3[s] = __builtin_bit_cast(bf16x8, (u32x4){cvtpk(x3[0], x3[1]), cvtpk(x3[2], x3[3]), cvtpk(x3[4], x3[5]), cvtpk(x3[6], x3[7])}); }
    if (MODE) pcd = ex2(-L2E * d);
}


__device__ __forceinline__ void r1_unit(const Args& args, Frame& F, int b, int c) {
    LAS unsigned char* IMG = F.lds;
    const bf16_t* Z = (const bf16_t*)(F.ws + WS_Z);
    const int t0 = 32 * c; const size_t m0 = (size_t)b * SEQ + t0;
    const float* mu = AIN(7);
    int tid = F.tid; asm volatile("" : "+v"(tid));
    __syncthreads();
    { const unsigned lds0 = (unsigned)(uintptr_t)IMG; const int ln = tid & 63;
      for (int task = F.wave; task < 33 * 4; task += NWAVES) { const int rr = task >> 2, j = task & 3, pc = 64 * j + ln;
          if (pc < 224) { if (rr > 0 || t0 > 0) att::glds16(Z + (m0 + rr - 1) * ZW + ZR + 8 * pc, (unsigned)__builtin_amdgcn_readfirstlane((int)(lds0 + rr * PZ + 1024 * j)));
                          else *(LAS u32x4*)(IMG + 16 * pc) = (u32x4){0u, 0u, 0u, 0u}; } }
      asm volatile("s_waitcnt vmcnt(0)" ::: "memory"); }
    __syncthreads();
    { u32x4 actv[2];
#pragma unroll
      for (int i = 0; i < 2; ++i) { const int q = tid + NTHR * i, t = q >> 5, kp = q & 31;
          const u32x4 cw = *(const LAS u32x4*)(IMG + (t + 1) * PZ + (1536 + 8 * kp) * 2), pw = *(const LAS u32x4*)(IMG + t * PZ + (1536 + 8 * kp) * 2);
          const f32x4 m0v = *(const f32x4*)(mu + 1536 + 8 * kp), m1v = *(const f32x4*)(mu + 1536 + 8 * kp + 4);
          const unsigned cwa[4] = {cw.x, cw.y, cw.z, cw.w}, pwa[4] = {pw.x, pw.y, pw.z, pw.w}; float x[8];
#pragma unroll
          for (int j = 0; j < 4; ++j) { const float c0 = bf_lo(cwa[j]), c1 = bf_hi(cwa[j]), p0 = bf_lo(pwa[j]), p1 = bf_hi(pwa[j]);
              const float mu0 = j < 2 ? m0v[2 * j] : m1v[2 * j - 4], mu1 = j < 2 ? m0v[2 * j + 1] : m1v[2 * j - 3];
              x[2 * j] = c0 + mu0 * (p0 - c0); x[2 * j + 1] = c1 + mu1 * (p1 - c1); }
#pragma unroll
          for (int j = 0; j < 8; ++j) { if (kp < 8) { const float e2 = ex2(2.885390081777927f * x[j]); x[j] = 1.0f - 2.0f * __builtin_amdgcn_rcpf(e2 + 1.0f); } else if (kp >= 16) x[j] = fast_sigmoid(x[j]); }
          actv[i] = (u32x4){cvtpk(x[0], x[1]), cvtpk(x[2], x[3]), cvtpk(x[4], x[5]), cvtpk(x[6], x[7])}; }
      __syncthreads();
#pragma unroll
      for (int i = 0; i < 2; ++i) { const int q = tid + NTHR * i, t = q >> 5, kp = q & 31; *(LAS u32x4*)(IMG + (t + 1) * PZ + (1536 + 8 * kp) * 2) = actv[i]; }
      __syncthreads(); }
    const int hd = F.wave; int r = tid & 31, h = (tid >> 5) & 1;
    const LAS unsigned char* rowc = IMG + (r + 1) * PZ; const LAS unsigned char* rowp = IMG + r * PZ;
    const bf16_t* DUt = (const bf16_t*)(F.ws + WS_DUT) + (size_t)hd * 4096; const bf16_t* IUt = (const bf16_t*)(F.ws + WS_IUT) + (size_t)hd * 4096;
    const LAS float* pra = (const LAS float*)(F.lds + LDS_PARA); const LAS float* prb = (const LAS float*)(F.lds + LDS_PARB);
    float n2 = 0.f;
#pragma unroll
    for (int jt = 0; jt < 2; ++jt)
#pragma unroll
        for (int g = 0; g < 4; ++g) { const int cj = hd * 64 + 32 * jt + 8 * g + 4 * h;
            const u32x2 a = *(const LAS u32x2*)(rowc + (512 + cj) * 2), p = *(const LAS u32x2*)(rowp + (512 + cj) * 2);
            const float kc[4] = {bf_lo(a.x), bf_hi(a.x), bf_lo(a.y), bf_hi(a.y)}, kq[4] = {bf_lo(p.x), bf_hi(p.x), bf_lo(p.y), bf_hi(p.y)};
            #pragma unroll
            for (int q = 0; q < 4; ++q) { const float muk = pra[(cj + q) * 4 + 1], kkp = prb[(cj + q) * 4 + 1]; const float k_ = kc[q] + muk * (kq[q] - kc[q]); const float kk_ = k_ * kkp; n2 += kk_ * kk_; } }
    n2 += __shfl_xor(n2, 32);
    const float inv = 1.0f / __builtin_fmaxf(sqrtf(n2), 1e-12f);
    float pcd[2] = {0.f, 0.f};
    float bns = 0.f;
    const ElemCtx EC{rowc, rowp, DUt, IUt, pra, prb, hd, r, h, inv};
    f32x16 Aab = f32x16{}, Aak = f32x16{}, Arb = f32x16{}, Ark = f32x16{};
    bf16x8 fRt[2][2], tAt[2][2];
    { bf16x8 fId[2]; mk_id(fId, r, h);
#pragma unroll
    for (int jt = 0; jt < 2; ++jt) { bf16x8 fA[2], fB[2], fK[2]; float pd_ = 0.f;
        r1_elem<0>(EC, jt, fA, fRt[jt], fB, fK, bns, pd_);
        const bf16x8 fA0 = fA[0], fA1 = fA[1], fB0 = fB[0], fB1 = fB[1], fK0 = fK[0], fK1 = fK[1];
        Aab = RK_MF(fB0, fA0, Aab); Aab = RK_MF(fB1, fA1, Aab); Aak = RK_MF(fK0, fA0, Aak); Aak = RK_MF(fK1, fA1, Aak);
        Arb = RK_MF(fB0, fRt[jt][0], Arb); Arb = RK_MF(fB1, fRt[jt][1], Arb); Ark = RK_MF(fK0, fRt[jt][0], Ark); Ark = RK_MF(fK1, fRt[jt][1], Ark);
        { f32x16 t_ = f32x16{}; t_ = RK_MF(fA0, fId[0], t_); t_ = RK_MF(fA1, fId[1], t_); tAt[jt][0] = frag<0>(t_); tAt[jt][1] = frag<1>(t_); } } }
    bns += __shfl_xor(bns, 32);
    if (h == 0) ((float*)(F.ws + WS_TOPW))[(m0 + r) * 8 + hd] = bns;
    LAS unsigned char* stash = IMG + (1 + ((tid & 63) >> 3)) * PZ + hd * 128 + (tid & 7) * 16;
#pragma unroll
    for (int p = 0; p < 4; ++p) *(LAS u32x4*)(stash + 8 * p * PZ) = __builtin_bit_cast(u32x4, fRt[p >> 1][p & 1]);
#pragma unroll
    for (int i = 0; i < 16; ++i) { const int s = 8 * (i >> 2) + 4 * h + (i & 3);
        if (!(s < r)) { Aab[i] = 0.f; Aak[i] = 0.f; } if (!(s <= r)) { Arb[i] = 0.f; Ark[i] = 0.f; } }
    const bf16x8 fAak[2] = {frag<0>(Aak), frag<1>(Aak)}, fArb[2] = {frag<0>(Arb), frag<1>(Arb)}, fArk[2] = {frag<0>(Ark), frag<1>(Ark)};
    bf16x8 fT[2];
    asm volatile("" ::: "memory"); __builtin_amdgcn_sched_barrier(0);
    { float T[32];
#pragma unroll
      for (int s = 0; s < 32; ++s) T[s] = (r == s) ? 1.0f : 0.f;
#define TI_RL(k_, is_, ln_) { const float ac_ = Aab[is_]; asm volatile("v_readlane_b32 %0, %1, " #ln_ : "=s"(sv_[k_]) : "v"(__float_as_int(ac_))); }
#define TI_FM(s_, u_, k_) T[s_] = __builtin_fmaf(T[u_], __int_as_float(sv_[k_]), T[s_]);
      if (!PROBE_TINV_ID) { int sv_[8];
        TI_RL(0, 0, 31) TI_RL(1, 1, 31) TI_RL(2, 2, 31) TI_RL(3, 3, 31) TI_RL(4, 0, 63) TI_RL(5, 1, 63) TI_RL(6, 2, 63) TI_RL(7, 3, 63)
        TI_FM(0, 31, 0) TI_FM(1, 31, 1) TI_FM(2, 31, 2) TI_FM(3, 31, 3) TI_FM(4, 31, 4) TI_FM(5, 31, 5) TI_FM(6, 31, 6) TI_FM(7, 31, 7)
        TI_RL(0, 4, 31) TI_RL(1, 5, 31) TI_RL(2, 6, 31) TI_RL(3, 7, 31) TI_RL(4, 4, 63) TI_RL(5, 5, 63) TI_RL(6, 6, 63) TI_RL(7, 7, 63)
        TI_FM(8, 31, 0) TI_FM(9, 31, 1) TI_FM(10, 31, 2) TI_FM(11, 31, 3) TI_FM(12, 31, 4) TI_FM(13, 31, 5) TI_FM(14, 31, 6) TI_FM(15, 31, 7)
        TI_RL(0, 8, 31) TI_RL(1, 9, 31) TI_RL(2, 10, 31) TI_RL(3, 11, 31) TI_RL(4, 8, 63) TI_RL(5, 9, 63) TI_RL(6, 10, 63) TI_RL(7, 11, 63)
        TI_FM(16, 31, 0) TI_FM(17, 31, 1) TI_FM(18, 31, 2) TI_FM(19, 31, 3) TI_FM(20, 31, 4) TI_FM(21, 31, 5) TI_FM(22, 31, 6) TI_FM(23, 31, 7)
        TI_RL(0, 12, 31) TI_RL(1, 13, 31) TI_RL(2, 14, 31) TI_RL(3, 15, 31) TI_RL(4, 12, 63) TI_RL(5, 13, 63) TI_RL(6, 14, 63)
        TI_FM(24, 31, 0) TI_FM(25, 31, 1) TI_FM(26, 31, 2) TI_FM(27, 31, 3) TI_FM(28, 31, 4) TI_FM(29, 31, 5) TI_FM(30, 31, 6)
        TI_RL(0, 0, 30) TI_RL(1, 1, 30) TI_RL(2, 2, 30) TI_RL(3, 3, 30) TI_RL(4, 0, 62) TI_RL(5, 1, 62) TI_RL(6, 2, 62) TI_RL(7, 3, 62)
        TI_FM(0, 30, 0) TI_FM(1, 30, 1) TI_FM(2, 30, 2) TI_FM(3, 30, 3) TI_FM(4, 30, 4) TI_FM(5, 30, 5) TI_FM(6, 30, 6) TI_FM(7, 30, 7)
        TI_RL(0, 4, 30) TI_RL(1, 5, 30) TI_RL(2, 6, 30) TI_RL(3, 7, 30) TI_RL(4, 4, 62) TI_RL(5, 5, 62) TI_RL(6, 6, 62) TI_RL(7, 7, 62)
        TI_FM(8, 30, 0) TI_FM(9, 30, 1) TI_FM(10, 30, 2) TI_FM(11, 30, 3) TI_FM(12, 30, 4) TI_FM(13, 30, 5) TI_FM(14, 30, 6) TI_FM(15, 30, 7)
        TI_RL(0, 8, 30) TI_RL(1, 9, 30) TI_RL(2, 10, 30) TI_RL(3, 11, 30) TI_RL(4, 8, 62) TI_RL(5, 9, 62) TI_RL(6, 10, 62) TI_RL(7, 11, 62)
        TI_FM(16, 30, 0) TI_FM(17, 30, 1) TI_FM(18, 30, 2) TI_FM(19, 30, 3) TI_FM(20, 30, 4) TI_FM(21, 30, 5) TI_FM(22, 30, 6) TI_FM(23, 30, 7)
        TI_RL(0, 12, 30) TI_RL(1, 13, 30) TI_RL(2, 14, 30) TI_RL(3, 15, 30) TI_RL(4, 12, 62) TI_RL(5, 13, 62)
        TI_FM(24, 30, 0) TI_FM(25, 30, 1) TI_FM(26, 30, 2) TI_FM(27, 30, 3) TI_FM(28, 30, 4) TI_FM(29, 30, 5)
        TI_RL(0, 0, 29) TI_RL(1, 1, 29) TI_RL(2, 2, 29) TI_RL(3, 3, 29) TI_RL(4, 0, 61) TI_RL(5, 1, 61) TI_RL(6, 2, 61) TI_RL(7, 3, 61)
        TI_FM(0, 29, 0) TI_FM(1, 29, 1) TI_FM(2, 29, 2) TI_FM(3, 29, 3) TI_FM(4, 29, 4) TI_FM(5, 29, 5) TI_FM(6, 29, 6) TI_FM(7, 29, 7)
        TI_RL(0, 4, 29) TI_RL(1, 5, 29) TI_RL(2, 6, 29) TI_RL(3, 7, 29) TI_RL(4, 4, 61) TI_RL(5, 5, 61) TI_RL(6, 6, 61) TI_RL(7, 7, 61)
        TI_FM(8, 29, 0) TI_FM(9, 29, 1) TI_FM(10, 29, 2) TI_FM(11, 29, 3) TI_FM(12, 29, 4) TI_FM(13, 29, 5) TI_FM(14, 29, 6) TI_FM(15, 29, 7)
        TI_RL(0, 8, 29) TI_RL(1, 9, 29) TI_RL(2, 10, 29) TI_RL(3, 11, 29) TI_RL(4, 8, 61) TI_RL(5, 9, 61) TI_RL(6, 10, 61) TI_RL(7, 11, 61)
        TI_FM(16, 29, 0) TI_FM(17, 29, 1) TI_FM(18, 29, 2) TI_FM(19, 29, 3) TI_FM(20, 29, 4) TI_FM(21, 29, 5) TI_FM(22, 29, 6) TI_FM(23, 29, 7)
        TI_RL(0, 12, 29) TI_RL(1, 13, 29) TI_RL(2, 14, 29) TI_RL(3, 15, 29) TI_RL(4, 12, 61)
        TI_FM(24, 29, 0) TI_FM(25, 29, 1) TI_FM(26, 29, 2) TI_FM(27, 29, 3) TI_FM(28, 29, 4)
        TI_RL(0, 0, 28) TI_RL(1, 1, 28) TI_RL(2, 2, 28) TI_RL(3, 3, 28) TI_RL(4, 0, 60) TI_RL(5, 1, 60) TI_RL(6, 2, 60) TI_RL(7, 3, 60)
        TI_FM(0, 28, 0) TI_FM(1, 28, 1) TI_FM(2, 28, 2) TI_FM(3, 28, 3) TI_FM(4, 28, 4) TI_FM(5, 28, 5) TI_FM(6, 28, 6) TI_FM(7, 28, 7)
        TI_RL(0, 4, 28) TI_RL(1, 5, 28) TI_RL(2, 6, 28) TI_RL(3, 7, 28) TI_RL(4, 4, 60) TI_RL(5, 5, 60) TI_RL(6, 6, 60) TI_RL(7, 7, 60)
        TI_FM(8, 28, 0) TI_FM(9, 28, 1) TI_FM(10, 28, 2) TI_FM(11, 28, 3) TI_FM(12, 28, 4) TI_FM(13, 28, 5) TI_FM(14, 28, 6) TI_FM(15, 28, 7)
        TI_RL(0, 8, 28) TI_RL(1, 9, 28) TI_RL(2, 10, 28) TI_RL(3, 11, 28) TI_RL(4, 8, 60) TI_RL(5, 9, 60) TI_RL(6, 10, 60) TI_RL(7, 11, 60)
        TI_FM(16, 28, 0) TI_FM(17, 28, 1) TI_FM(18, 28, 2) TI_FM(19, 28, 3) TI_FM(20, 28, 4) TI_FM(21, 28, 5) TI_FM(22, 28, 6) TI_FM(23, 28, 7)
        TI_RL(0, 12, 28) TI_RL(1, 13, 28) TI_RL(2, 14, 28) TI_RL(3, 15, 28)
        TI_FM(24, 28, 0) TI_FM(25, 28, 1) TI_FM(26, 28, 2) TI_FM(27, 28, 3)
        TI_RL(0, 0, 27) TI_RL(1, 1, 27) TI_RL(2, 2, 27) TI_RL(3, 3, 27) TI_RL(4, 0, 59) TI_RL(5, 1, 59) TI_RL(6, 2, 59) TI_RL(7, 3, 59)
        TI_FM(0, 27, 0) TI_FM(1, 27, 1) TI_FM(2, 27, 2) TI_FM(3, 27, 3) TI_FM(4, 27, 4) TI_FM(5, 27, 5) TI_FM(6, 27, 6) TI_FM(7, 27, 7)
        TI_RL(0, 4, 27) TI_RL(1, 5, 27) TI_RL(2, 6, 27) TI_RL(3, 7, 27) TI_RL(4, 4, 59) TI_RL(5, 5, 59) TI_RL(6, 6, 59) TI_RL(7, 7, 59)
        TI_FM(8, 27, 0) TI_FM(9, 27, 1) TI_FM(10, 27, 2) TI_FM(11, 27, 3) TI_FM(12, 27, 4) TI_FM(13, 27, 5) TI_FM(14, 27, 6) TI_FM(15, 27, 7)
        TI_RL(0, 8, 27) TI_RL(1, 9, 27) TI_RL(2, 10, 27) TI_RL(3, 11, 27) TI_RL(4, 8, 59) TI_RL(5, 9, 59) TI_RL(6, 10, 59) TI_RL(7, 11, 59)
        TI_FM(16, 27, 0) TI_FM(17, 27, 1) TI_FM(18, 27, 2) TI_FM(19, 27, 3) TI_FM(20, 27, 4) TI_FM(21, 27, 5) TI_FM(22, 27, 6) TI_FM(23, 27, 7)
        TI_RL(0, 12, 27) TI_RL(1, 13, 27) TI_RL(2, 14, 27)
        TI_FM(24, 27, 0) TI_FM(25, 27, 1) TI_FM(26, 27, 2)
        TI_RL(0, 0, 26) TI_RL(1, 1, 26) TI_RL(2, 2, 26) TI_RL(3, 3, 26) TI_RL(4, 0, 58) TI_RL(5, 1, 58) TI_RL(6, 2, 58) TI_RL(7, 3, 58)
        TI_FM(0, 26, 0) TI_FM(1, 26, 1) TI_FM(2, 26, 2) TI_FM(3, 26, 3) TI_FM(4, 26, 4) TI_FM(5, 26, 5) TI_FM(6, 26, 6) TI_FM(7, 26, 7)
        TI_RL(0, 4, 26) TI_RL(1, 5, 26) TI_RL(2, 6, 26) TI_RL(3, 7, 26) TI_RL(4, 4, 58) TI_RL(5, 5, 58) TI_RL(6, 6, 58) TI_RL(7, 7, 58)
        TI_FM(8, 26, 0) TI_FM(9, 26, 1) TI_FM(10, 26, 2) TI_FM(11, 26, 3) TI_FM(12, 26, 4) TI_FM(13, 26, 5) TI_FM(14, 26, 6) TI_FM(15, 26, 7)
        TI_RL(0, 8, 26) TI_RL(1, 9, 26) TI_RL(2, 10, 26) TI_RL(3, 11, 26) TI_RL(4, 8, 58) TI_RL(5, 9, 58) TI_RL(6, 10, 58) TI_RL(7, 11, 58)
        TI_FM(16, 26, 0) TI_FM(17, 26, 1) TI_FM(18, 26, 2) TI_FM(19, 26, 3) TI_FM(20, 26, 4) TI_FM(21, 26, 5) TI_FM(22, 26, 6) TI_FM(23, 26, 7)
        TI_RL(0, 12, 26) TI_RL(1, 13, 26)
        TI_FM(24, 26, 0) TI_FM(25, 26, 1)
        TI_RL(0, 0, 25) TI_RL(1, 1, 25) TI_RL(2, 2, 25) TI_RL(3, 3, 25) TI_RL(4, 0, 57) TI_RL(5, 1, 57) TI_RL(6, 2, 57) TI_RL(7, 3, 57)
        TI_FM(0, 25, 0) TI_FM(1, 25, 1) TI_FM(2, 25, 2) TI_FM(3, 25, 3) TI_FM(4, 25, 4) TI_FM(5, 25, 5) TI_FM(6, 25, 6) TI_FM(7, 25, 7)
        TI_RL(0, 4, 25) TI_RL(1, 5, 25) TI_RL(2, 6, 25) TI_RL(3, 7, 25) TI_RL(4, 4, 57) TI_RL(5, 5, 57) TI_RL(6, 6, 57) TI_RL(7, 7, 57)
        TI_FM(8, 25, 0) TI_FM(9, 25, 1) TI_FM(10, 25, 2) TI_FM(11, 25, 3) TI_FM(12, 25, 4) TI_FM(13, 25, 5) TI_FM(14, 25, 6) TI_FM(15, 25, 7)
        TI_RL(0, 8, 25) TI_RL(1, 9, 25) TI_RL(2, 10, 25) TI_RL(3, 11, 25) TI_RL(4, 8, 57) TI_RL(5, 9, 57) TI_RL(6, 10, 57) TI_RL(7, 11, 57)
        TI_FM(16, 25, 0) TI_FM(17, 25, 1) TI_FM(18, 25, 2) TI_FM(19, 25, 3) TI_FM(20, 25, 4) TI_FM(21, 25, 5) TI_FM(22, 25, 6) TI_FM(23, 25, 7)
        TI_RL(0, 12, 25)
        TI_FM(24, 25, 0)
        TI_RL(0, 0, 24) TI_RL(1, 1, 24) TI_RL(2, 2, 24) TI_RL(3, 3, 24) TI_RL(4, 0, 56) TI_RL(5, 1, 56) TI_RL(6, 2, 56) TI_RL(7, 3, 56)
        TI_FM(0, 24, 0) TI_FM(1, 24, 1) TI_FM(2, 24, 2) TI_FM(3, 24, 3) TI_FM(4, 24, 4) TI_FM(5, 24, 5) TI_FM(6, 24, 6) TI_FM(7, 24, 7)
        TI_RL(0, 4, 24) TI_RL(1, 5, 24) TI_RL(2, 6, 24) TI_RL(3, 7, 24) TI_RL(4, 4, 56) TI_RL(5, 5, 56) TI_RL(6, 6, 56) TI_RL(7, 7, 56)
        TI_FM(8, 24, 0) TI_FM(9, 24, 1) TI_FM(10, 24, 2) TI_FM(11, 24, 3) TI_FM(12, 24, 4) TI_FM(13, 24, 5) TI_FM(14, 24, 6) TI_FM(15, 24, 7)
        TI_RL(0, 8, 24) TI_RL(1, 9, 24) TI_RL(2, 10, 24) TI_RL(3, 11, 24) TI_RL(4, 8, 56) TI_RL(5, 9, 56) TI_RL(6, 10, 56) TI_RL(7, 11, 56)
        TI_FM(16, 24, 0) TI_FM(17, 24, 1) TI_FM(18, 24, 2) TI_FM(19, 24, 3) TI_FM(20, 24, 4) TI_FM(21, 24, 5) TI_FM(22, 24, 6) TI_FM(23, 24, 7)
        TI_RL(0, 0, 23) TI_RL(1, 1, 23) TI_RL(2, 2, 23) TI_RL(3, 3, 23) TI_RL(4, 0, 55) TI_RL(5, 1, 55) TI_RL(6, 2, 55) TI_RL(7, 3, 55)
        TI_FM(0, 23, 0) TI_FM(1, 23, 1) TI_FM(2, 23, 2) TI_FM(3, 23, 3) TI_FM(4, 23, 4) TI_FM(5, 23, 5) TI_FM(6, 23, 6) TI_FM(7, 23, 7)
        TI_RL(0, 4, 23) TI_RL(1, 5, 23) TI_RL(2, 6, 23) TI_RL(3, 7, 23) TI_RL(4, 4, 55) TI_RL(5, 5, 55) TI_RL(6, 6, 55) TI_RL(7, 7, 55)
        TI_FM(8, 23, 0) TI_FM(9, 23, 1) TI_FM(10, 23, 2) TI_FM(11, 23, 3) TI_FM(12, 23, 4) TI_FM(13, 23, 5) TI_FM(14, 23, 6) TI_FM(15, 23, 7)
        TI_RL(0, 8, 23) TI_RL(1, 9, 23) TI_RL(2, 10, 23) TI_RL(3, 11, 23) TI_RL(4, 8, 55) TI_RL(5, 9, 55) TI_RL(6, 10, 55)
        TI_FM(16, 23, 0) TI_FM(17, 23, 1) TI_FM(18, 23, 2) TI_FM(19, 23, 3) TI_FM(20, 23, 4) TI_FM(21, 23, 5) TI_FM(22, 23, 6)
        TI_RL(0, 0, 22) TI_RL(1, 1, 22) TI_RL(2, 2, 22) TI_RL(3, 3, 22) TI_RL(4, 0, 54) TI_RL(5, 1, 54) TI_RL(6, 2, 54) TI_RL(7, 3, 54)
        TI_FM(0, 22, 0) TI_FM(1, 22, 1) TI_FM(2, 22, 2) TI_FM(3, 22, 3) TI_FM(4, 22, 4) TI_FM(5, 22, 5) TI_FM(6, 22, 6) TI_FM(7, 22, 7)
        TI_RL(0, 4, 22) TI_RL(1, 5, 22) TI_RL(2, 6, 22) TI_RL(3, 7, 22) TI_RL(4, 4, 54) TI_RL(5, 5, 54) TI_RL(6, 6, 54) TI_RL(7, 7, 54)
        TI_FM(8, 22, 0) TI_FM(9, 22, 1) TI_FM(10, 22, 2) TI_FM(11, 22, 3) TI_FM(12, 22, 4) TI_FM(13, 22, 5) TI_FM(14, 22, 6) TI_FM(15, 22, 7)
        TI_RL(0, 8, 22) TI_RL(1, 9, 22) TI_RL(2, 10, 22) TI_RL(3, 11, 22) TI_RL(4, 8, 54) TI_RL(5, 9, 54)
        TI_FM(16, 22, 0) TI_FM(17, 22, 1) TI_FM(18, 22, 2) TI_FM(19, 22, 3) TI_FM(20, 22, 4) TI_FM(21, 22, 5)
        TI_RL(0, 0, 21) TI_RL(1, 1, 21) TI_RL(2, 2, 21) TI_RL(3, 3, 21) TI_RL(4, 0, 53) TI_RL(5, 1, 53) TI_RL(6, 2, 53) TI_RL(7, 3, 53)
        TI_FM(0, 21, 0) TI_FM(1, 21, 1) TI_FM(2, 21, 2) TI_FM(3, 21, 3) TI_FM(4, 21, 4) TI_FM(5, 21, 5) TI_FM(6, 21, 6) TI_FM(7, 21, 7)
        TI_RL(0, 4, 21) TI_RL(1, 5, 21) TI_RL(2, 6, 21) TI_RL(3, 7, 21) TI_RL(4, 4, 53) TI_RL(5, 5, 53) TI_RL(6, 6, 53) TI_RL(7, 7, 53)
        TI_FM(8, 21, 0) TI_FM(9, 21, 1) TI_FM(10, 21, 2) TI_FM(11, 21, 3) TI_FM(12, 21, 4) TI_FM(13, 21, 5) TI_FM(14, 21, 6) TI_FM(15, 21, 7)
        TI_RL(0, 8, 21) TI_RL(1, 9, 21) TI_RL(2, 10, 21) TI_RL(3, 11, 21) TI_RL(4, 8, 53)
        TI_FM(16, 21, 0) TI_FM(17, 21, 1) TI_FM(18, 21, 2) TI_FM(19, 21, 3) TI_FM(20, 21, 4)
        TI_RL(0, 0, 20) TI_RL(1, 1, 20) TI_RL(2, 2, 20) TI_RL(3, 3, 20) TI_RL(4, 0, 52) TI_RL(5, 1, 52) TI_RL(6, 2, 52) TI_RL(7, 3, 52)
        TI_FM(0, 20, 0) TI_FM(1, 20, 1) TI_FM(2, 20, 2) TI_FM(3, 20, 3) TI_FM(4, 20, 4) TI_FM(5, 20, 5) TI_FM(6, 20, 6) TI_FM(7, 20, 7)
        TI_RL(0, 4, 20) TI_RL(1, 5, 20) TI_RL(2, 6, 20) TI_RL(3, 7, 20) TI_RL(4, 4, 52) TI_RL(5, 5, 52) TI_RL(6, 6, 52) TI_RL(7, 7, 52)
        TI_FM(8, 20, 0) TI_FM(9, 20, 1) TI_FM(10, 20, 2) TI_FM(11, 20, 3) TI_FM(12, 20, 4) TI_FM(13, 20, 5) TI_FM(14, 20, 6) TI_FM(15, 20, 7)
        TI_RL(0, 8, 20) TI_RL(1, 9, 20) TI_RL(2, 10, 20) TI_RL(3, 11, 20)
        TI_FM(16, 20, 0) TI_FM(17, 20, 1) TI_FM(18, 20, 2) TI_FM(19, 20, 3)
        TI_RL(0, 0, 19) TI_RL(1, 1, 19) TI_RL(2, 2, 19) TI_RL(3, 3, 19) TI_RL(4, 0, 51) TI_RL(5, 1, 51) TI_RL(6, 2, 51) TI_RL(7, 3, 51)
        TI_FM(0, 19, 0) TI_FM(1, 19, 1) TI_FM(2, 19, 2) TI_FM(3, 19, 3) TI_FM(4, 19, 4) TI_FM(5, 19, 5) TI_FM(6, 19, 6) TI_FM(7, 19, 7)
        TI_RL(0, 4, 19) TI_RL(1, 5, 19) TI_RL(2, 6, 19) TI_RL(3, 7, 19) TI_RL(4, 4, 51) TI_RL(5, 5, 51) TI_RL(6, 6, 51) TI_RL(7, 7, 51)
        TI_FM(8, 19, 0) TI_FM(9, 19, 1) TI_FM(10, 19, 2) TI_FM(11, 19, 3) TI_FM(12, 19, 4) TI_FM(13, 19, 5) TI_FM(14, 19, 6) TI_FM(15, 19, 7)
        TI_RL(0, 8, 19) TI_RL(1, 9, 19) TI_RL(2, 10, 19)
        TI_FM(16, 19, 0) TI_FM(17, 19, 1) TI_FM(18, 19, 2)
        TI_RL(0, 0, 18) TI_RL(1, 1, 18) TI_RL(2, 2, 18) TI_RL(3, 3, 18) TI_RL(4, 0, 50) TI_RL(5, 1, 50) TI_RL(6, 2, 50) TI_RL(7, 3, 50)
        TI_FM(0, 18, 0) TI_FM(1, 18, 1) TI_FM(2, 18, 2) TI_FM(3, 18, 3) TI_FM(4, 18, 4) TI_FM(5, 18, 5) TI_FM(6, 18, 6) TI_FM(7, 18, 7)
        TI_RL(0, 4, 18) TI_RL(1, 5, 18) TI_RL(2, 6, 18) TI_RL(3, 7, 18) TI_RL(4, 4, 50) TI_RL(5, 5, 50) TI_RL(6, 6, 50) TI_RL(7, 7, 50)
        TI_FM(8, 18, 0) TI_FM(9, 18, 1) TI_FM(10, 18, 2) TI_FM(11, 18, 3) TI_FM(12, 18, 4) TI_FM(13, 18, 5) TI_FM(14, 18, 6) TI_FM(15, 18, 7)
        TI_RL(0, 8, 18) TI_RL(1, 9, 18)
        TI_FM(16, 18, 0) TI_FM(17, 18, 1)
        TI_RL(0, 0, 17) TI_RL(1, 1, 17) TI_RL(2, 2, 17) TI_RL(3, 3, 17) TI_RL(4, 0, 49) TI_RL(5, 1, 49) TI_RL(6, 2, 49) TI_RL(7, 3, 49)
        TI_FM(0, 17, 0) TI_FM(1, 17, 1) TI_FM(2, 17, 2) TI_FM(3, 17, 3) TI_FM(4, 17, 4) TI_FM(5, 17, 5) TI_FM(6, 17, 6) TI_FM(7, 17, 7)
        TI_RL(0, 4, 17) TI_RL(1, 5, 17) TI_RL(2, 6, 17) TI_RL(3, 7, 17) TI_RL(4, 4, 49) TI_RL(5, 5, 49) TI_RL(6, 6, 49) TI_RL(7, 7, 49)
        TI_FM(8, 17, 0) TI_FM(9, 17, 1) TI_FM(10, 17, 2) TI_FM(11, 17, 3) TI_FM(12, 17, 4) TI_FM(13, 17, 5) TI_FM(14, 17, 6) TI_FM(15, 17, 7)
        TI_RL(0, 8, 17)
        TI_FM(16, 17, 0)
        TI_RL(0, 0, 16) TI_RL(1, 1, 16) TI_RL(2, 2, 16) TI_RL(3, 3, 16) TI_RL(4, 0, 48) TI_RL(5, 1, 48) TI_RL(6, 2, 48) TI_RL(7, 3, 48)
        TI_FM(0, 16, 0) TI_FM(1, 16, 1) TI_FM(2, 16, 2) TI_FM(3, 16, 3) TI_FM(4, 16, 4) TI_FM(5, 16, 5) TI_FM(6, 16, 6) TI_FM(7, 16, 7)
        TI_RL(0, 4, 16) TI_RL(1, 5, 16) TI_RL(2, 6, 16) TI_RL(3, 7, 16) TI_RL(4, 4, 48) TI_RL(5, 5, 48) TI_RL(6, 6, 48) TI_RL(7, 7, 48)
        TI_FM(8, 16, 0) TI_FM(9, 16, 1) TI_FM(10, 16, 2) TI_FM(11, 16, 3) TI_FM(12, 16, 4) TI_FM(13, 16, 5) TI_FM(14, 16, 6) TI_FM(15, 16, 7)
        TI_RL(0, 0, 15) TI_RL(1, 1, 15) TI_RL(2, 2, 15) TI_RL(3, 3, 15) TI_RL(4, 0, 47) TI_RL(5, 1, 47) TI_RL(6, 2, 47) TI_RL(7, 3, 47)
        TI_FM(0, 15, 0) TI_FM(1, 15, 1) TI_FM(2, 15, 2) TI_FM(3, 15, 3) TI_FM(4, 15, 4) TI_FM(5, 15, 5) TI_FM(6, 15, 6) TI_FM(7, 15, 7)
        TI_RL(0, 4, 15) TI_RL(1, 5, 15) TI_RL(2, 6, 15) TI_RL(3, 7, 15) TI_RL(4, 4, 47) TI_RL(5, 5, 47) TI_RL(6, 6, 47)
        TI_FM(8, 15, 0) TI_FM(9, 15, 1) TI_FM(10, 15, 2) TI_FM(11, 15, 3) TI_FM(12, 15, 4) TI_FM(13, 15, 5) TI_FM(14, 15, 6)
        TI_RL(0, 0, 14) TI_RL(1, 1, 14) TI_RL(2, 2, 14) TI_RL(3, 3, 14) TI_RL(4, 0, 46) TI_RL(5, 1, 46) TI_RL(6, 2, 46) TI_RL(7, 3, 46)
        TI_FM(0, 14, 0) TI_FM(1, 14, 1) TI_FM(2, 14, 2) TI_FM(3, 14, 3) TI_FM(4, 14, 4) TI_FM(5, 14, 5) TI_FM(6, 14, 6) TI_FM(7, 14, 7)
        TI_RL(0, 4, 14) TI_RL(1, 5, 14) TI_RL(2, 6, 14) TI_RL(3, 7, 14) TI_RL(4, 4, 46) TI_RL(5, 5, 46)
        TI_FM(8, 14, 0) TI_FM(9, 14, 1) TI_FM(10, 14, 2) TI_FM(11, 14, 3) TI_FM(12, 14, 4) TI_FM(13, 14, 5)
        TI_RL(0, 0, 13) TI_RL(1, 1, 13) TI_RL(2, 2, 13) TI_RL(3, 3, 13) TI_RL(4, 0, 45) TI_RL(5, 1, 45) TI_RL(6, 2, 45) TI_RL(7, 3, 45)
        TI_FM(0, 13, 0) TI_FM(1, 13, 1) TI_FM(2, 13, 2) TI_FM(3, 13, 3) TI_FM(4, 13, 4) TI_FM(5, 13, 5) TI_FM(6, 13, 6) TI_FM(7, 13, 7)
        TI_RL(0, 4, 13) TI_RL(1, 5, 13) TI_RL(2, 6, 13) TI_RL(3, 7, 13) TI_RL(4, 4, 45)
        TI_FM(8, 13, 0) TI_FM(9, 13, 1) TI_FM(10, 13, 2) TI_FM(11, 13, 3) TI_FM(12, 13, 4)
        TI_RL(0, 0, 12) TI_RL(1, 1, 12) TI_RL(2, 2, 12) TI_RL(3, 3, 12) TI_RL(4, 0, 44) TI_RL(5, 1, 44) TI_RL(6, 2, 44) TI_RL(7, 3, 44)
        TI_FM(0, 12, 0) TI_FM(1, 12, 1) TI_FM(2, 12, 2) TI_FM(3, 12, 3) TI_FM(4, 12, 4) TI_FM(5, 12, 5) TI_FM(6, 12, 6) TI_FM(7, 12, 7)
        TI_RL(0, 4, 12) TI_RL(1, 5, 12) TI_RL(2, 6, 12) TI_RL(3, 7, 12)
        TI_FM(8, 12, 0) TI_FM(9, 12, 1) TI_FM(10, 12, 2) TI_FM(11, 12, 3)
        TI_RL(0, 0, 11) TI_RL(1, 1, 11) TI_RL(2, 2, 11) TI_RL(3, 3, 11) TI_RL(4, 0, 43) TI_RL(5, 1, 43) TI_RL(6, 2, 43) TI_RL(7, 3, 43)
        TI_FM(0, 11, 0) TI_FM(1, 11, 1) TI_FM(2, 11, 2) TI_FM(3, 11, 3) TI_FM(4, 11, 4) TI_FM(5, 11, 5) TI_FM(6, 11, 6) TI_FM(7, 11, 7)
        TI_RL(0, 4, 11) TI_RL(1, 5, 11) TI_RL(2, 6, 11)
        TI_FM(8, 11, 0) TI_FM(9, 11, 1) TI_FM(10, 11, 2)
        TI_RL(0, 0, 10) TI_RL(1, 1, 10) TI_RL(2, 2, 10) TI_RL(3, 3, 10) TI_RL(4, 0, 42) TI_RL(5, 1, 42) TI_RL(6, 2, 42) TI_RL(7, 3, 42)
        TI_FM(0, 10, 0) TI_FM(1, 10, 1) TI_FM(2, 10, 2) TI_FM(3, 10, 3) TI_FM(4, 10, 4) TI_FM(5, 10, 5) TI_FM(6, 10, 6) TI_FM(7, 10, 7)
        TI_RL(0, 4, 10) TI_RL(1, 5, 10)
        TI_FM(8, 10, 0) TI_FM(9, 10, 1)
        TI_RL(0, 0, 9) TI_RL(1, 1, 9) TI_RL(2, 2, 9) TI_RL(3, 3, 9) TI_RL(4, 0, 41) TI_RL(5, 1, 41) TI_RL(6, 2, 41) TI_RL(7, 3, 41)
        TI_FM(0, 9, 0) TI_FM(1, 9, 1) TI_FM(2, 9, 2) TI_FM(3, 9, 3) TI_FM(4, 9, 4) TI_FM(5, 9, 5) TI_FM(6, 9, 6) TI_FM(7, 9, 7)
        TI_RL(0, 4, 9)
        TI_FM(8, 9, 0)
        TI_RL(0, 0, 8) TI_RL(1, 1, 8) TI_RL(2, 2, 8) TI_RL(3, 3, 8) TI_RL(4, 0, 40) TI_RL(5, 1, 40) TI_RL(6, 2, 40) TI_RL(7, 3, 40)
        TI_FM(0, 8, 0) TI_FM(1, 8, 1) TI_FM(2, 8, 2) TI_FM(3, 8, 3) TI_FM(4, 8, 4) TI_FM(5, 8, 5) TI_FM(6, 8, 6) TI_FM(7, 8, 7)
        TI_RL(0, 0, 7) TI_RL(1, 1, 7) TI_RL(2, 2, 7) TI_RL(3, 3, 7) TI_RL(4, 0, 39) TI_RL(5, 1, 39) TI_RL(6, 2, 39)
        TI_FM(0, 7, 0) TI_FM(1, 7, 1) TI_FM(2, 7, 2) TI_FM(3, 7, 3) TI_FM(4, 7, 4) TI_FM(5, 7, 5) TI_FM(6, 7, 6)
        TI_RL(0, 0, 6) TI_RL(1, 1, 6) TI_RL(2, 2, 6) TI_RL(3, 3, 6) TI_RL(4, 0, 38) TI_RL(5, 1, 38)
        TI_FM(0, 6, 0) TI_FM(1, 6, 1) TI_FM(2, 6, 2) TI_FM(3, 6, 3) TI_FM(4, 6, 4) TI_FM(5, 6, 5)
        TI_RL(0, 0, 5) TI_RL(1, 1, 5) TI_RL(2, 2, 5) TI_RL(3, 3, 5) TI_RL(4, 0, 37)
        TI_FM(0, 5, 0) TI_FM(1, 5, 1) TI_FM(2, 5, 2) TI_FM(3, 5, 3) TI_FM(4, 5, 4)
        TI_RL(0, 0, 4) TI_RL(1, 1, 4) TI_RL(2, 2, 4) TI_RL(3, 3, 4)
        TI_FM(0, 4, 0) TI_FM(1, 4, 1) TI_FM(2, 4, 2) TI_FM(3, 4, 3)
        TI_RL(0, 0, 3) TI_RL(1, 1, 3) TI_RL(2, 2, 3)
        TI_FM(0, 3, 0) TI_FM(1, 3, 1) TI_FM(2, 3, 2)
        TI_RL(0, 0, 2) TI_RL(1, 1, 2)
        TI_FM(0, 2, 0) TI_FM(1, 2, 1)
        TI_RL(0, 0, 1)
        TI_FM(0, 1, 0)
      }
#undef TI_RL
#undef TI_FM

#pragma unroll
      for (int s = 0; s < 2; ++s) { float e8[8];
#pragma unroll
          for (int jj = 0; jj < 8; ++jj) { const int i0 = 16 * s + 8 * (jj >> 2) + (jj & 3); float ta = T[i0], tb = T[i0 + 4]; asm volatile("" : "+v"(ta), "+v"(tb)); e8[jj] = h ? tb : ta; }
          fT[s] = __builtin_bit_cast(bf16x8, (u32x4){cvtpk(e8[0], e8[1]), cvtpk(e8[2], e8[3]), cvtpk(e8[4], e8[5]), cvtpk(e8[6], e8[7])}); } }
    asm volatile("" ::: "memory"); __builtin_amdgcn_sched_barrier(0);
    const size_t uid = ((size_t)(b * 8 + hd) * 128 + c);
    unsigned char* gG = F.ws + WS_R0 + uid * SZ_G; unsigned char* gH = F.ws + WS_R2 + uid * SZ_H; unsigned char* gQ = F.ws + WS_H0 + uid * SZ_Q; unsigned char* gY = F.ws + WS_H1 + uid * SZ_Y;
#define RK_ST(base, piece, f) (*(u32x4*)((base) + (piece) * 1024 + (tid & 63) * 16) = __builtin_bit_cast(u32x4, (f)))
    bf16x8 fWt[2][2];
#pragma unroll
    for (int jt = 0; jt < 2; ++jt) { f32x16 w_ = f32x16{}; w_ = RK_MF(fT[0], tAt[jt][0], w_); w_ = RK_MF(fT[1], tAt[jt][1], w_); fWt[jt][0] = frag<0>(w_); fWt[jt][1] = frag<1>(w_);
        f32x16 q_; unfrag<0>(q_, __builtin_bit_cast(bf16x8, *(const LAS u32x4*)(stash + 8 * (2 * jt) * PZ))); unfrag<1>(q_, __builtin_bit_cast(bf16x8, *(const LAS u32x4*)(stash + 8 * (2 * jt + 1) * PZ)));
        q_ = RK_MF(fWt[jt][0], fArb[0], q_); q_ = RK_MF(fWt[jt][1], fArb[1], q_); RK_ST(gQ, 2 * jt, frag<0>(q_)); RK_ST(gQ, 2 * jt + 1, frag<1>(q_)); }
    bf16x8 tBh[2][2], tKh[2][2], tV[2][2];
    { bf16x8 fId[2]; mk_id(fId, r, h);
#pragma unroll
    for (int jt = 0; jt < 2; ++jt) { bf16x8 fBh[2], fKh[2], fV[2], fdum[2]; float bdum = 0.f;
        r1_elem<1>(EC, jt, fBh, fKh, fV, fdum, bdum, pcd[jt]);
        { f32x16 t_ = f32x16{}; t_ = RK_MF(fBh[0], fId[0], t_); t_ = RK_MF(fBh[1], fId[1], t_); tBh[jt][0] = frag<0>(t_); tBh[jt][1] = frag<1>(t_); }
        { f32x16 t_ = f32x16{}; t_ = RK_MF(fKh[0], fId[0], t_); t_ = RK_MF(fKh[1], fId[1], t_); tKh[jt][0] = frag<0>(t_); tKh[jt][1] = frag<1>(t_); }
        { f32x16 t_ = f32x16{}; t_ = RK_MF(fV[0], fId[0], t_); t_ = RK_MF(fV[1], fId[1], t_); tV[jt][0] = frag<0>(t_); tV[jt][1] = frag<1>(t_); } } }
    bf16x8 fUt[2][2];
#pragma unroll
    for (int it = 0; it < 2; ++it) { f32x16 av = f32x16{}; av = RK_MF(fAak[0], tV[it][0], av); av = RK_MF(fAak[1], tV[it][1], av);
        const bf16x8 fav0 = frag<0>(av), fav1 = frag<1>(av); f32x16 u_ = f32x16{}; u_ = RK_MF(fT[0], fav0, u_); u_ = RK_MF(fT[1], fav1, u_); fUt[it][0] = frag<0>(u_); fUt[it][1] = frag<1>(u_); }
#pragma unroll
    for (int it = 0; it < 2; ++it) { f32x16 y_ = f32x16{}; y_ = RK_MF(fUt[it][0], fArb[0], y_); y_ = RK_MF(fUt[it][1], fArb[1], y_); y_ = RK_MF(tV[it][0], fArk[0], y_); y_ = RK_MF(tV[it][1], fArk[1], y_);
        RK_ST(gY, 2 * it, frag<0>(y_)); RK_ST(gY, 2 * it + 1, frag<1>(y_)); }
#pragma unroll
    for (int jt = 0; jt < 2; ++jt)
#pragma unroll
        for (int j2 = 0; j2 < 2; ++j2) { f32x16 g_ = f32x16{}; g_ = RK_MF(fWt[jt][0], tBh[j2][0], g_); g_ = RK_MF(fWt[jt][1], tBh[j2][1], g_);
            if (jt == j2) {
#pragma unroll
                for (int i = 0; i < 16; ++i) if (i == 4 * (r >> 3) + (r & 3) && h == ((r >> 2) & 1)) g_[i] += pcd[jt]; }
            RK_ST(gG, 2 * (jt * 2 + j2), frag<0>(g_)); RK_ST(gG, 2 * (jt * 2 + j2) + 1, frag<1>(g_)); }
#pragma unroll
    for (int j2 = 0; j2 < 2; ++j2)
#pragma unroll
        for (int it = 0; it < 2; ++it) { f32x16 h_ = f32x16{}; h_ = RK_MF(tBh[j2][0], fUt[it][0], h_); h_ = RK_MF(tBh[j2][1], fUt[it][1], h_); h_ = RK_MF(tKh[j2][0], tV[it][0], h_); h_ = RK_MF(tKh[j2][1], tV[it][1], h_);
            RK_ST(gH, 2 * (j2 * 2 + it), frag<0>(h_)); RK_ST(gH, 2 * (j2 * 2 + it) + 1, frag<1>(h_)); }
}

template <int DRY> __device__ __forceinline__ void r2_task(const Args& args, Frame& F, int task) {
    const bool st_ok = !DRY || args.li == 12345;
    const int bh = task >> 1, it = task & 1;
    f32x16 St[2]; St[0] = f32x16{}; St[1] = f32x16{};
    const unsigned char* gG0 = F.ws + WS_R0 + (size_t)bh * 128 * SZ_G + F.lane * 16; unsigned char* gH0 = F.ws + WS_R2 + (size_t)bh * 128 * SZ_H + F.lane * 16;
    bf16x8 G0[2][2][2], H0[2][2], G1[2][2][2], H1[2][2], G2[2][2][2], H2[2][2];
#define R2_LOAD(G_, H_, c_) do { const int cc_ = (c_) < 128 ? (c_) : 127;     \
        _Pragma("unroll") for (int jt = 0; jt < 2; ++jt) _Pragma("unroll") for (int j2 = 0; j2 < 2; ++j2) _Pragma("unroll") for (int s = 0; s < 2; ++s) \
            G_[jt][j2][s] = __builtin_bit_cast(bf16x8, *(const u32x4*)(gG0 + (size_t)cc_ * SZ_G + (2 * (jt * 2 + j2) + s) * 1024)); \
        _Pragma("unroll") for (int j2 = 0; j2 < 2; ++j2) _Pragma("unroll") for (int s = 0; s < 2; ++s) H_[j2][s] = __builtin_bit_cast(bf16x8, *(const u32x4*)(gH0 + (size_t)cc_ * SZ_H + (2 * (j2 * 2 + it) + s) * 1024)); } while (0)
#define R2_STEP(G_, H_, c_, LOADNEXT) do { \
        const bf16x8 fS[2][2] = {{frag<0>(St[0]), frag<1>(St[0])}, {frag<0>(St[1]), frag<1>(St[1])}}; \
        if (st_ok) { _Pragma("unroll") for (int jt = 0; jt < 2; ++jt) _Pragma("unroll") for (int s = 0; s < 2; ++s) \
            *(u32x4*)(gH0 + (size_t)(c_) * SZ_H + (2 * (jt * 2 + it) + s) * 1024) = __builtin_bit_cast(u32x4, fS[jt][s]); }     \
        __builtin_amdgcn_sched_barrier(0); LOADNEXT; __builtin_amdgcn_sched_barrier(0);     \
        _Pragma("unroll") for (int j2 = 0; j2 < 2; ++j2) { unfrag<0>(St[j2], H_[j2][0]); unfrag<1>(St[j2], H_[j2][1]); \
            _Pragma("unroll") for (int jt = 0; jt < 2; ++jt) { St[j2] = RK_MF(G_[jt][j2][0], fS[jt][0], St[j2]); St[j2] = RK_MF(G_[jt][j2][1], fS[jt][1], St[j2]); } } \
        __builtin_amdgcn_sched_barrier(0); \
    } while (0)
    R2_LOAD(G0, H0, 0); R2_LOAD(G1, H1, 1);
#pragma unroll 1
    for (int c = 0; c < 126; c += 3) {
        R2_STEP(G0, H0, c, R2_LOAD(G2, H2, c + 2));
        R2_STEP(G1, H1, c + 1, R2_LOAD(G0, H0, c + 3));
        R2_STEP(G2, H2, c + 2, R2_LOAD(G1, H1, c + 4));
    }
    R2_STEP(G0, H0, 126, (void)0);
    R2_STEP(G1, H1, 127, (void)0);
#undef R2_STEP
#undef R2_LOAD
}

constexpr int PV2 = 1296;
__device__ __forceinline__ void r3_unit(const Args& args, Frame& F, int b, int c) {
    LAS unsigned char* IMG = F.lds;
    const bf16_t* Z = (const bf16_t*)(F.ws + WS_Z);
    const int t0 = 32 * c; const size_t m0 = (size_t)b * SEQ + t0;
    const float* mu = AIN(7);
    int tid = F.tid; asm volatile("" : "+v"(tid));
    __syncthreads();
    { const unsigned lds0 = (unsigned)(uintptr_t)IMG; const int ln = tid & 63;
      for (int task = F.wave; task < 33 * 2; task += NWAVES) { const int rr = task >> 1, j = task & 1, pc = 64 * j + ln;
          if (pc < 80) { const int col = j == 0 ? ZR_V + 8 * ln : ZR_GD + 8 * ln;
              if (rr > 0 || t0 > 0) att::glds16(Z + (m0 + rr - 1) * ZW + col, (unsigned)__builtin_amdgcn_readfirstlane((int)(lds0 + rr * PV2 + 1024 * j)));
              else *(LAS u32x4*)(IMG + 16 * pc) = (u32x4){0u, 0u, 0u, 0u}; } }
      asm volatile("s_waitcnt vmcnt(0)" ::: "memory"); }
    __syncthreads();
    { const int t = tid >> 4, kp = tid & 15;
      const u32x4 cw = *(const LAS u32x4*)(IMG + (t + 1) * PV2 + 1024 + 16 * kp), pw = *(const LAS u32x4*)(IMG + t * PV2 + 1024 + 16 * kp);
      const f32x4 m0v = *(const f32x4*)(mu + 1664 + 8 * kp), m1v = *(const f32x4*)(mu + 1664 + 8 * kp + 4);
      const unsigned cwa[4] = {cw.x, cw.y, cw.z, cw.w}, pwa[4] = {pw.x, pw.y, pw.z, pw.w}; float x[8];
#pragma unroll
      for (int j = 0; j < 4; ++j) { const float c0 = bf_lo(cwa[j]), c1 = bf_hi(cwa[j]), p0 = bf_lo(pwa[j]), p1 = bf_hi(pwa[j]);
          const float mu0 = j < 2 ? m0v[2 * j] : m1v[2 * j - 4], mu1 = j < 2 ? m0v[2 * j + 1] : m1v[2 * j - 3];
          x[2 * j] = fast_sigmoid(c0 + mu0 * (p0 - c0)); x[2 * j + 1] = fast_sigmoid(c1 + mu1 * (p1 - c1)); }
      const u32x4 o = {cvtpk(x[0], x[1]), cvtpk(x[2], x[3]), cvtpk(x[4], x[5]), cvtpk(x[6], x[7])};
      __syncthreads();
      *(LAS u32x4*)(IMG + (t + 1) * PV2 + 1024 + 16 * kp) = o;
      __syncthreads(); }
    const int hd = F.wave; int r = tid & 31, h = (tid >> 5) & 1;
    const LAS unsigned char* rowc = IMG + (r + 1) * PV2; const LAS unsigned char* rowp = IMG + r * PV2;
    const size_t uid = ((size_t)(b * 8 + hd) * 128 + c);
    const unsigned char* gS = F.ws + WS_R2 + uid * SZ_H; const unsigned char* gQ = F.ws + WS_H0 + uid * SZ_Q; const unsigned char* gY = F.ws + WS_H1 + uid * SZ_Y;
#define RK_LD(base, piece) __builtin_bit_cast(bf16x8, *(const u32x4*)((base) + (piece) * 1024 + (tid & 63) * 16))
    f32x16 gl[2]; gl[0] = f32x16{}; gl[1] = f32x16{};
    { const bf16_t* GUt = (const bf16_t*)(F.ws + WS_GUT) + (size_t)hd * 64 * 128;
#pragma unroll
      for (int ks = 0; ks < 8; ++ks) { const int k0 = 16 * ks + 8 * h; const bf16x8 bg = *(const LAS bf16x8*)(rowc + 1024 + k0 * 2);
#pragma unroll
          for (int it = 0; it < 2; ++it) { const bf16x8 fg = *(const bf16x8*)(GUt + (size_t)(32 * it + r) * 128 + k0); gl[it] = RK_MF(fg, bg, gl[it]); } } }
    f32x16 Y[2];
    { const bf16x8 fQ[2][2] = {{RK_LD(gQ, 0), RK_LD(gQ, 1)}, {RK_LD(gQ, 2), RK_LD(gQ, 3)}};
#pragma unroll
      for (int it = 0; it < 2; ++it) { unfrag<0>(Y[it], RK_LD(gY, 2 * it)); unfrag<1>(Y[it], RK_LD(gY, 2 * it + 1));
#pragma unroll
          for (int jt = 0; jt < 2; ++jt) { if (PROBE_NO_STATE) continue; Y[it] = RK_MF(RK_LD(gS, 2 * (jt * 2 + it)), fQ[jt][0], Y[it]); Y[it] = RK_MF(RK_LD(gS, 2 * (jt * 2 + it) + 1), fQ[jt][1], Y[it]); } } }
    float s1 = 0.f;
#pragma unroll
    for (int it = 0; it < 2; ++it)
#pragma unroll
        for (int i = 0; i < 16; ++i) s1 += Y[it][i];
    s1 += __shfl_xor(s1, 32); const float mean = s1 * (1.0f / 64.0f); float s2 = 0.f;
#pragma unroll
    for (int it = 0; it < 2; ++it)
#pragma unroll
        for (int i = 0; i < 16; ++i) { const float d = Y[it][i] - mean; s2 += d * d; }
    s2 += __shfl_xor(s2, 32); const float rstd = 1.0f / sqrtf(s2 * (1.0f / 64.0f) + GN_EPS);
    const float bn = ((const float*)(F.ws + WS_TOPW))[(m0 + r) * 8 + hd];
    LAS unsigned char* stg = F.lds + 49152 + F.wave * 4608;
#pragma unroll
    for (int it = 0; it < 2; ++it)
#pragma unroll
        for (int g = 0; g < 4; ++g) { const int cl = 32 * it + 8 * g + 4 * h, cj = hd * 64 + cl;
            const u32x2 a = *(const LAS u32x2*)(rowc + cj * 2), p = *(const LAS u32x2*)(rowp + cj * 2);
            const float vc[4] = {bf_lo(a.x), bf_hi(a.x), bf_lo(a.y), bf_hi(a.y)}, vq[4] = {bf_lo(p.x), bf_hi(p.x), bf_lo(p.y), bf_hi(p.y)};
            const f32x4 muv = *(const f32x4*)(mu + 1024 + cj), lg = *(const f32x4*)(AIN(16) + cj), lb = *(const f32x4*)(AIN(17) + cj);
            float o[4];
#pragma unroll
            for (int q = 0; q < 4; ++q) { const int i = 4 * g + q; const float v_ = vc[q] + muv[q] * (vq[q] - vc[q]);
                o[q] = ((Y[it][i] - mean) * rstd * lg[q] + lb[q] + bn * v_) * gl[it][i]; }
            *(LAS u32x2*)(stg + r * 144 + cl * 2) = (u32x2){cvtpk(o[0], o[1]), cvtpk(o[2], o[3])}; }
    asm volatile("s_waitcnt lgkmcnt(0)" ::: "memory");
    bf16_t* OUT = (bf16_t*)(F.ws + WS_R0) + m0 * 512 + hd * 64;
#pragma unroll
    for (int i = 0; i < 4; ++i) { const int row = i * 8 + ((tid & 63) >> 3), chn = tid & 7; const u32x4 v = *(const LAS u32x4*)(stg + row * 144 + chn * 16); *(u32x4*)(OUT + (size_t)row * 512 + chn * 8) = v; }
#undef RK_LD
#undef RK_ST
}
}
__device__ __forceinline__ void route_token(float lg, float bias, int lane, int tok, int* TE, float* TW, LAS unsigned* lcnt) {
    const float s = 1.0f / (1.0f + expf(-lg));
    const float c = s + bias;
    const unsigned kc = ord_key(c);
#define RT_MAXD(v_, ctrl) { const unsigned o_ = (unsigned)__builtin_amdgcn_update_dpp(0, (int)(v_), (ctrl), 0xF, 0xF, true); v_ = (v_) > o_ ? (v_) : o_; }
#define RT_INV(k_) (((k_) & 0x80000000u) ? __uint_as_float((k_) & 0x7FFFFFFFu) : __uint_as_float(~(k_)))
    unsigned m1 = kc; RT_MAXD(m1, 0xB1) RT_MAXD(m1, 0x4E) RT_MAXD(m1, 0x141)
    const unsigned long long b1 = __builtin_amdgcn_ballot_w64(kc == m1);
    const unsigned gb = (unsigned)(b1 >> (lane & 56)) & 0xFFu;
    unsigned m2 = ((lane & 7) == __builtin_ctz(gb)) ? 0u : kc; RT_MAXD(m2, 0xB1) RT_MAXD(m2, 0x4E) RT_MAXD(m2, 0x141)
    const float gs = RT_INV(m1) + RT_INV(m2);
    unsigned gcur = ord_key(gs); bool gsel = false;
#pragma unroll
    for (int j = 0; j < 4; ++j) { unsigned v = gcur; RT_MAXD(v, 0xB1) RT_MAXD(v, 0x4E) RT_MAXD(v, 0x141) RT_MAXD(v, 0x140)
        const unsigned a0_ = (unsigned)__builtin_amdgcn_readlane((int)v, 0), a1_ = (unsigned)__builtin_amdgcn_readlane((int)v, 16), a2_ = (unsigned)__builtin_amdgcn_readlane((int)v, 32), a3_ = (unsigned)__builtin_amdgcn_readlane((int)v, 48);
        const unsigned x_ = a0_ > a1_ ? a0_ : a1_, y_ = a2_ > a3_ ? a2_ : a3_; const unsigned m_ = x_ > y_ ? x_ : y_;
        const int win = __builtin_ctzll(__builtin_amdgcn_ballot_w64(gcur == m_));
        if ((lane >> 3) == (win >> 3)) { gsel = true; gcur = 0u; } }
    unsigned cur = gsel ? kc : 0u; int erk = 64;
#pragma unroll
    for (int j = 0; j < 8; ++j) { unsigned v = cur; RT_MAXD(v, 0xB1) RT_MAXD(v, 0x4E) RT_MAXD(v, 0x141) RT_MAXD(v, 0x140)
        const unsigned a0_ = (unsigned)__builtin_amdgcn_readlane((int)v, 0), a1_ = (unsigned)__builtin_amdgcn_readlane((int)v, 16), a2_ = (unsigned)__builtin_amdgcn_readlane((int)v, 32), a3_ = (unsigned)__builtin_amdgcn_readlane((int)v, 48);
        const unsigned x_ = a0_ > a1_ ? a0_ : a1_, y_ = a2_ > a3_ ? a2_ : a3_; const unsigned m_ = x_ > y_ ? x_ : y_;
        const int win = __builtin_ctzll(__builtin_amdgcn_ballot_w64(cur == m_));
        if (lane == win) { erk = j; cur = 0u; } }
#undef RT_MAXD
#undef RT_INV
    const bool sel = erk < 8;
    const float ssum = wave_sum(sel ? s : 0.f);
    if (sel) { TE[(size_t)tok * 8 + erk] = lane; TW[(size_t)tok * 8 + erk] = s / ssum * 2.5f; atomicAdd((unsigned*)&lcnt[(tok >= M / 2 ? 64 : 0) + lane], 1u); }
}
__device__ __forceinline__ void norm2_route_wave(const Args& args, Frame& F, LAS unsigned* lcnt) {
    bf16_t* H2 = (bf16_t*)(F.ws + WS_H2);
    norm_mod_rows(args, F, F.out, AIN(21), 3072, 4096, H2, nullptr);
    asm volatile("s_waitcnt vmcnt(0)" ::: "memory");
    const int lane = F.lane, row0 = F.gw * 16;
    const bf16_t* ap = H2 + (size_t)(row0 + (lane & 15)) * D + 8 * (lane >> 4);
    const bf16_t* bp = (const bf16_t*)(F.ws + WS_WRT) + (size_t)(lane & 15) * D + 8 * (lane >> 4);
    f32x4 acc[4] = {f32x4{}, f32x4{}, f32x4{}, f32x4{}};
#pragma unroll 1
    for (int k0 = 0; k0 < 32; k0 += 4) { bf16x8 a_[4], b_[4][4];
#pragma unroll
        for (int i = 0; i < 4; ++i) { a_[i] = *(const bf16x8*)(ap + 32 * (k0 + i));
#pragma unroll
            for (int nt = 0; nt < 4; ++nt) b_[i][nt] = *(const bf16x8*)(bp + (size_t)(16 * nt) * D + 32 * (k0 + i)); }
#pragma unroll
        for (int i = 0; i < 4; ++i)
#pragma unroll
            for (int nt = 0; nt < 4; ++nt) acc[nt] = __builtin_amdgcn_mfma_f32_16x16x32_bf16(a_[i], b_[i][nt], acc[nt], 0, 0, 0); }
    LAS float* scr = (LAS float*)(F.lds + F.wave * 16384);
#pragma unroll
    for (int nt = 0; nt < 4; ++nt)
#pragma unroll
        for (int i = 0; i < 4; ++i) scr[(4 * (lane >> 4) + i) * 65 + 16 * nt + (lane & 15)] = acc[nt][i];
    asm volatile("s_waitcnt lgkmcnt(0)" ::: "memory");
    int* TE = (int*)(F.ws + WS_TOPE); float* TW = (float*)(F.ws + WS_TOPW);
    const float bias = AIN(23)[lane];
#pragma unroll 1
    for (int t = 0; t < 16; ++t) route_token(scr[t * 65 + lane], bias, lane, row0 + t, TE, TW, lcnt);
    asm volatile("s_waitcnt lgkmcnt(0)" ::: "memory");
}
__device__ __forceinline__ void norm2_route_convert(const Args& args, Frame& F) {
    LAS unsigned* lcnt = (LAS unsigned*)(F.lds + LDS_TILETAB);
    if (F.tid < 128) lcnt[F.tid] = 0u;
    __syncthreads();
    constexpr int KIT = (64 * (16 * 16 + 4 * 32) + NWAVES * 256 - 1) / (NWAVES * 256) + 1;
    if (F.wave < 4) { norm2_route_wave(args, F, lcnt); convert_experts(args, F, 0, KIT); }
    else { convert_experts(args, F, 0, KIT / 2); norm2_route_wave(args, F, lcnt); convert_experts(args, F, KIT / 2, KIT); }
    __syncthreads();
    if (F.tid < 128 && lcnt[F.tid]) atomicAdd(F.ctl + CW_CNT + F.tid, lcnt[F.tid]);
    __syncthreads();
}
struct MoeTab { int ntiles0, ntiles; };
__device__ __forceinline__ MoeTab build_tiles(const Args& args, Frame& F) {
    LAS unsigned* tab = (LAS unsigned*)(F.lds + LDS_TILETAB);
    LAS unsigned* offs = tab + 2432; LAS unsigned* tpre = tab + 2560;
    if (F.tid == 0) { unsigned o = 0, tp = 0;
        for (int l = 0; l < 128; ++l) { const unsigned c = __hip_atomic_load(F.ctl + CW_CNT + l, RLX_AGENT); offs[l] = o; tpre[l] = tp; o += c; tp += (c + 255u) >> 8; }
        tpre[128] = tp; }
    __syncthreads();
    if (F.tid < 128) { const int l = F.tid; const unsigned c = __hip_atomic_load(F.ctl + CW_CNT + l, RLX_AGENT); const unsigned o = offs[l], t0 = tpre[l], nt = (c + 255u) >> 8;
        for (unsigned i = 0; i < nt; ++i) { const unsigned rows = (c - 256u * i) < 256u ? (c - 256u * i) : 256u; tab[2 * (t0 + i)] = (o + 256u * i) | ((unsigned)(l & 63) << 20); tab[2 * (t0 + i) + 1] = rows; } }
    __syncthreads();
    MoeTab r; r.ntiles0 = (int)tpre[64]; r.ntiles = (int)tpre[128]; return r;
}
__device__ __forceinline__ void scatter_phase(const Args& args, Frame& F) {
    LAS unsigned* tab = (LAS unsigned*)(F.lds + LDS_TILETAB); LAS unsigned* offs = tab + 2432;
    LAS unsigned* lcnt = (LAS unsigned*)(F.lds); LAS unsigned* lbase = lcnt + 128;
    const int* TE = (const int*)(F.ws + WS_TOPE); const float* TW = (const float*)(F.ws + WS_TOPW);
    int* ST = (int*)(F.ws + WS_STOK); float* SW = (float*)(F.ws + WS_SW);
    for (int blk = blockIdx.x; blk < M / 128; blk += F.G) {
        if (F.tid < 128) lcnt[F.tid] = 0u;
        __syncthreads();
        const int tok0 = blk * 128, hf = tok0 >= M / 2 ? 64 : 0;
        int lst[2]; unsigned rnk[2];
#pragma unroll
        for (int i = 0; i < 2; ++i) { const int p = F.tid + 512 * i; lst[i] = hf + TE[(size_t)tok0 * 8 + p]; rnk[i] = atomicAdd((unsigned*)&lcnt[lst[i]], 1u); }
        __syncthreads();
        if (F.tid < 128) lbase[F.tid] = lcnt[F.tid] ? atomicAdd(F.ctl + CW_CUR + F.tid, lcnt[F.tid]) : 0u;
        __syncthreads();
#pragma unroll
        for (int i = 0; i < 2; ++i) { const int p = F.tid + 512 * i; const unsigned pos = offs[lst[i]] + lbase[lst[i]] + rnk[i];
            ST[pos] = tok0 * 8 + p; SW[pos] = TW[(size_t)tok0 * 8 + p]; }
        __syncthreads();
    }
}

__device__ __forceinline__ void final_rows(const Args& args, Frame& F, int row_lo, int row_hi, int tokbase) {
    const unsigned char* SL = (const unsigned char*)(F.ws + WS_SLOT);
    const int cA = 256 * (F.lane >> 4) + 32 * ((F.lane >> 2) & 3) + 8 * (F.lane & 3), cB = cA + 128;
    for (int blk = F.gw; blk < (row_hi - row_lo) / 16; blk += F.NGW) {
        const int r0 = row_lo + blk * 16, b = r0 / SEQ;
        const float* g2 = (const float*)(F.ws + WS_MOD) + b * 6144 + 5120; const float* fgp = AIN(30);
        f32x4 gv[4], fg[4];
#pragma unroll
        for (int j = 0; j < 4; ++j) { const int c = (j < 2 ? cA : cB) + 4 * (j & 1); gv[j] = *(const f32x4*)(g2 + c) * (1.0f / SLOT_SCALE); fg[j] = *(const f32x4*)(fgp + c); }
        for (int r = 0; r < 16; ++r) { const size_t m = (size_t)(r0 + r);
            f32x4 acc[4];
#pragma unroll
            for (int j = 0; j < 4; ++j) acc[j] = (f32x4){0.f, 0.f, 0.f, 0.f};
            const unsigned char* sp = SL + (m - tokbase) * NSLOT * D + 16 * F.lane;
            u32x4 w[NSLOT];
#pragma unroll
            for (int k = 0; k < NSLOT; ++k) w[k] = *(const u32x4*)(sp + (size_t)k * D);
#pragma unroll
            for (int k = 0; k < NSLOT; ++k) { const unsigned ww[4] = {w[k].x, w[k].y, w[k].z, w[k].w};
#pragma unroll
                for (int j = 0; j < 4; ++j) { const f32x2 a = __builtin_amdgcn_cvt_pk_f32_fp8((int)ww[j], false), c = __builtin_amdgcn_cvt_pk_f32_fp8((int)ww[j], true); acc[j] += (f32x4){a.x, a.y, c.x, c.y}; } }
            float* xr = F.out + m * D; f32x4 v[4]; float s = 0.f;
#pragma unroll
            for (int j = 0; j < 4; ++j) { const int c = (j < 2 ? cA : cB) + 4 * (j & 1); v[j] = *(const f32x4*)(xr + c) + gv[j] * acc[j]; s += (v[j].x * v[j].x + v[j].y * v[j].y) + (v[j].z * v[j].z + v[j].w * v[j].w); }
            const float rstd = 1.0f / sqrtf(wave_sum(s) * (1.0f / D) + RMS_EPS);
#pragma unroll
            for (int j = 0; j < 4; ++j) { const int c = (j < 2 ? cA : cB) + 4 * (j & 1); *(f32x4*)(xr + c) = v[j] * rstd * fg[j]; }
        }
    }
}
constexpr int N_PHASES = 15;
#ifndef PROBE_ATT_SCALE
#define PROBE_ATT_SCALE 1.0f
#endif
#ifndef PROBE_IDX_REP
#define PROBE_IDX_REP 1
#endif
#ifndef R2_WGS
#define R2_WGS 32
#endif
#ifndef PROBE_P5_PART
#define PROBE_P5_PART 0
#endif
#ifndef PROBE_RW_SCALE
#define PROBE_RW_SCALE 1.0f
#endif

__global__ void __launch_bounds__(NTHR, 2) fwd_kernel(Args args) {
    extern __shared__ __attribute__((aligned(16))) unsigned char lds_raw[];
    Frame F;
    F.lds = (LAS unsigned char*)lds_raw;
    F.MISC = (volatile LAS unsigned*)(F.lds + MISC_OFF);
    F.tid = threadIdx.x; F.lane = F.tid & 63; F.wave = __builtin_amdgcn_readfirstlane(F.tid >> 6);
    F.G = gridDim.x; { const int bx = blockIdx.x; F.vcu = (F.G % 8 == 0) ? (bx % 8) * (F.G / 8) + bx / 8 : bx; }
    F.gw = blockIdx.x * NWAVES + F.wave; F.NGW = F.G * NWAVES;
    F.ws = args.ws; F.out = args.out; F.ctl = (unsigned*)(args.ws + WS_CTL);
    for (int u = F.tid; u < (LDS_BYTES - LDSCTL_OFF) / 4; u += NTHR) ((LAS unsigned*)(F.lds + LDSCTL_OFF))[u] = 0u;
    __syncthreads();
    if (F.tid == 0) {
#pragma unroll
        for (int i = 0; i < 31; ++i) *(LAS unsigned long long*)(F.lds + LDS_PTAB + 8 * i) = (unsigned long long)args.in[i];
        *(LAS unsigned long long*)(F.lds + LDS_PTAB + 8 * 31) = (unsigned long long)args.out; *(LAS unsigned long long*)(F.lds + LDS_PTAB + 8 * 32) = (unsigned long long)args.ws; }
    __syncthreads();
    XcdBarrier bar = xcd_barrier_post(F.ctl + CW_BAR + args.li * XCD_BAR_WORDS, F.MISC + 8);
    const int lo = args.ph_lo, hi = args.ph_hi;
#ifndef PHASE_MASK
#define PHASE_MASK 0xFFFFFFFFu
#endif
#define IN(k) ((((PHASE_MASK) >> (k)) & 1u) && lo <= (k) && (k) < hi)
#define PB() do { F.ws = (unsigned char*)ain_ptr(F.lds, 32); F.out = (float*)ain_ptr(F.lds, 31); F.ctl = (unsigned*)(F.ws + WS_CTL); \
        F.lane = (int)__builtin_amdgcn_mbcnt_hi(~0u, __builtin_amdgcn_mbcnt_lo(~0u, 0u)); F.tid = F.wave * 64 + F.lane; } while (0)
#define ZB ((bf16_t*)(F.ws + WS_Z))
#define GATES ((bf16_t*)F.out)
#define MOD ((const float*)(F.ws + WS_MOD))
#define SEAM(k) do { if (IN(k) && IN((k) + 1)) xcd_barrier(bar); } while (0)

    if (IN(0)) { PB(); p0_prologue(args, F); } SEAM(0);
    if (IN(1)) { PB(); norm_mod_rows(args, F, AIN(0), AIN(4), 0, 1024, nullptr, F.ws + WS_H0); } SEAM(1);
    if (IN(2)) { PB(); pg8::StaticOrder S; S.init(M, NIN, F.G, (int)blockIdx.x); pg8::DenseSrcT<1> G{F.ws + WS_H0, F.ws + WS_WIN, 1024};
        EpiInProj E{ZB, GATES}; pg8::gemm_phase<EpiInProj, pg8::StaticOrder, pg8::DenseSrcT<1>>(F.lds, 1024, S, G, E); } SEAM(2);
    if (IN(3)) { PB(); rk::load_params(args, F); for (int u = blockIdx.x; u < 1024; u += F.G) rk::r1_unit(args, F, u >> 7, u & 127); __syncthreads(); } SEAM(3);
    if (IN(4)) { PB();
#ifdef PROBE_R2_DRY
        if (blockIdx.x < R2_WGS && F.wave < 128 / R2_WGS) rk::r2_task<1>(args, F, blockIdx.x * (128 / R2_WGS) + F.wave);
#endif
        if (blockIdx.x < R2_WGS && F.wave < 128 / R2_WGS) rk::r2_task<0>(args, F, blockIdx.x * (128 / R2_WGS) + F.wave);
#pragma unroll 1
        for (int rep = 0; rep < PROBE_IDX_REP; ++rep)
        for (;;) {
            __syncthreads();
            if (F.tid == 0) F.MISC[12] = atomicAdd(F.ctl + CW_Q + rep, 1u);
            __syncthreads();
            const int u = (int)F.MISC[12];
            if (u >= 2048) break;
            indexer_unit(args, F, u & 7, (255 - (u >> 3)) * 16);
        } } SEAM(4);
    if (IN(5)) { PB(); if (!((PROBE_P5_PART & 2) && args.li == 1)) { for (int u = blockIdx.x; u < 1024; u += F.G) rk::r3_unit(args, F, u >> 7, u & 127); } __syncthreads();
        if (!((PROBE_P5_PART & 1) && args.li == 1)) for (int i = 0; i < 4; ++i) for (int uu = F.vcu; uu < 256; uu += F.G) { const int bh = uu >> 2, s = uu & 3; const int qb = (i == 0) ? s : (i == 1) ? 7 - s : (i == 2) ? 8 + s : 15 - s;
            att::attn_unit(args, F, bh >> 3, bh & 7, qb); } __syncthreads(); } SEAM(5);
    if (IN(6)) { PB(); pg8::StaticOrder S; S.init(M, D, F.G, (int)blockIdx.x);
        { pg8::DenseSrc G{F.ws + WS_R1, F.ws + WS_WA, 512}; EpiMerge<0> E{(bf16_t*)(F.ws + WS_R2), F.ws + WS_H0, GATES, PROBE_ATT_SCALE}; pg8::gemm_phase<EpiMerge<0>, pg8::StaticOrder, pg8::DenseSrc>(F.lds, 512, S, G, E); }
        { pg8::DenseSrc G{F.ws + WS_R0, F.ws + WS_WR, 512}; EpiMerge<1> E{(bf16_t*)(F.ws + WS_R2), F.ws + WS_H0, GATES, PROBE_RW_SCALE}; pg8::gemm_phase<EpiMerge<1>, pg8::StaticOrder, pg8::DenseSrc>(F.lds, 512, S, G, E); } } SEAM(6);
    if (IN(7)) { PB(); pg8::StaticOrder S; S.init(M, D, F.G, (int)blockIdx.x); pg8::DenseSrcT<1> G{F.ws + WS_H0, F.ws + WS_WO, 1024};
        EpiOutProj E{AIN(0), F.out, MOD}; pg8::gemm_phase<EpiOutProj, pg8::StaticOrder, pg8::DenseSrcT<1>>(F.lds, 1024, S, G, E); } SEAM(7);
    if (IN(8)) { PB(); norm2_route_convert(args, F); }
    if (IN(8) && IN(11)) xcd_barrier(bar);
    MoeTab mt{0, 0};
    if (lo <= 13 && hi > 13) { PB(); mt = build_tiles(args, F); scatter_phase(args, F); } else if (hi > 13) { PB(); mt = build_tiles(args, F); }
    SEAM(11);
    const LAS unsigned* tab = (const LAS unsigned*)(F.lds + LDS_TILETAB);
    if (IN(12)) { PB(); MoeSched1 S{tab, mt.ntiles, F.G, F.vcu};            MoeSrc1 G{F.ws};
        EpiMoe1 E{F.ws}; pg8::gemm_phase<EpiMoe1, MoeSched1, MoeSrc1>(F.lds, 1024, S, G, E); } SEAM(12);
    if (IN(13)) { PB(); MoeSched2 S{tab, 0, mt.ntiles, 512, F.G, F.vcu}; MoeSrc2 G{F.ws}; EpiMoe2 E; E.ws = F.ws; E.X1 = F.out; E.tokbase = 0;
        pg8::gemm_phase<EpiMoe2, MoeSched2, MoeSrc2>(F.lds, 256, S, G, E); } SEAM(13);
    if (IN(14)) { PB(); final_rows(args, F, 0, M, 0); }
#ifdef PROBE_CYC
    __syncthreads();
    if (blockIdx.x == 0 && F.tid == 0) { asm volatile("s_waitcnt vmcnt(0)" ::: "memory"); F.out[0] = (float)(F.ctl[CW_Q + 64]); }
#endif
#undef IN
#undef SEAM
#undef PB
}

extern "C" void kernel_launch(void* const* d_in, const int* in_sizes, int n_in, void* d_out, int out_size, void* d_ws, size_t ws_size, hipStream_t stream) {
    static int grid = 0;
    if (grid == 0) {
        if (n_in != 31 || out_size != M * D || ws_size < WS_END) { fprintf(stderr, "kernel_launch: unexpected problem (n_in %d, out %d, ws %zu)\n", n_in, out_size, ws_size); grid = -1; return; }
        int dev = 0, cus = 0, per_cu = 0;
        if (hipGetDevice(&dev) != hipSuccess || hipDeviceGetAttribute(&cus, hipDeviceAttributeMultiprocessorCount, dev) != hipSuccess) { grid = -1; return; }
        if (hipFuncSetAttribute((const void*)fwd_kernel, hipFuncAttributeMaxDynamicSharedMemorySize, LDS_BYTES) != hipSuccess) { fprintf(stderr, "kernel_launch: hipFuncSetAttribute failed\n"); grid = -1; return; }
        if (hipOccupancyMaxActiveBlocksPerMultiprocessor(&per_cu, (const void*)fwd_kernel, NTHR, LDS_BYTES) != hipSuccess || per_cu < 1) fprintf(stderr, "kernel_launch: occupancy query reports %d\n", per_cu);
        (void)hipGetLastError();
        grid = cus;
        if (grid != 256) fprintf(stderr, "kernel_launch: %d CUs (built for 256)\n", grid);
    }
    if (grid < 0) return;
    (void)in_sizes;
    if (hipMemsetAsync((char*)d_ws + WS_CTL, 0, CTL_ZERO_BYTES, stream) != hipSuccess) return;
    Args a{};
    for (int i = 0; i < 31; ++i) a.in[i] = (const float*)d_in[i];
    a.out = (float*)d_out; a.ws = (unsigned char*)d_ws;
#ifndef PROBE_REPEAT
#define PROBE_REPEAT -1
#endif
    int li = 0;
    auto go = [&](int lo_, int hi_) { a.ph_lo = lo_; a.ph_hi = hi_; a.li = li++; hipLaunchKernelGGL(fwd_kernel, dim3(grid), dim3(NTHR), LDS_BYTES, stream, a); };
    if (PROBE_REPEAT < 0) go(0, N_PHASES);
    else { go(0, PROBE_REPEAT + 1); go(PROBE_REPEAT, PROBE_REPEAT + 1); if (PROBE_REPEAT + 1 < N_PHASES) go(PROBE_REPEAT + 1, N_PHASES); }
}
```

```cpp
#include <hip/hip_runtime.h>
#include <cstdio>
#include <cstdint>
#include <cmath>

#define GAS __attribute__((address_space(1)))
#define LAS __attribute__((address_space(3)))
typedef unsigned short bf16_t;
typedef short bf16x8 __attribute__((ext_vector_type(8)));
typedef float f32x4 __attribute__((ext_vector_type(4)));
typedef float f32x2 __attribute__((ext_vector_type(2)));
typedef float f32x16 __attribute__((ext_vector_type(16)));
typedef unsigned u32x4 __attribute__((ext_vector_type(4)));
typedef unsigned u32x2 __attribute__((ext_vector_type(2)));
typedef GAS unsigned gu32;

__device__ __forceinline__ unsigned cvt_pk_bf16(float lo, float hi) { unsigned r; asm volatile("v_cvt_pk_bf16_f32 %0, %1, %2" : "=v"(r) : "v"(lo), "v"(hi)); return r; }
__device__ __forceinline__ float bf_lo(unsigned w) { return __uint_as_float(w << 16); }
__device__ __forceinline__ float bf_hi(unsigned w) { return __uint_as_float(w & 0xffff0000u); }
__device__ __forceinline__ float bf2f(bf16_t b) { return __uint_as_float(((unsigned)b) << 16); }
__device__ __forceinline__ unsigned f2bf(float f) { unsigned u = __float_as_uint(f); return (u + 0x7fffu + ((u >> 16) & 1u)) >> 16; }
__device__ __forceinline__ unsigned pk2(float lo, float hi) { return f2bf(lo) | (f2bf(hi) << 16); }
__device__ __forceinline__ float fast_sigmoid(float x) { return __builtin_amdgcn_rcpf(1.0f + __builtin_amdgcn_exp2f(-1.4426950408889634f * x)); }
__device__ __forceinline__ float wave_sum(float v) {
#define WS_DPP(ctrl) v += __int_as_float(__builtin_amdgcn_update_dpp(0, __float_as_int(v), (ctrl), 0xF, 0xF, true));
    WS_DPP(0xB1) WS_DPP(0x4E) WS_DPP(0x141) WS_DPP(0x140)
#undef WS_DPP
    const int vi = __float_as_int(v);
    return (__int_as_float(__builtin_amdgcn_readlane(vi, 0)) + __int_as_float(__builtin_amdgcn_readlane(vi, 16))) + (__int_as_float(__builtin_amdgcn_readlane(vi, 32)) + __int_as_float(__builtin_amdgcn_readlane(vi, 48)));
}

namespace pg8 {
constexpr int BM = 256, BK = 64, HALF = 128, HTB = HALF * BK * 2, STAGE_BYTES = 8 * HTB, NXCD = 8, WGM = 8;
__host__ __device__ __forceinline__ int lds_byte(int r, int c) { const int st = (r >> 4) * 2 + (c >> 5), rr = r & 15, cc = c & 31, ob = rr * 64 + cc * 2; return st * 1024 + (ob ^ (((ob >> 9) & 1) << 5)); }
__host__ __device__ __forceinline__ void stage_rc(int b, int& R, int& C) { const int st = b / 1024, sb = b % 1024, swz = sb ^ (((sb >> 9) & 1) << 5); R = (st >> 1) * 16 + swz / 64; C = (st & 1) * 32 + (swz % 64) / 2; }
__host__ __device__ __forceinline__ int perm32(int rho) { const int n = rho >> 4, i = rho & 15; return 8 * (i >> 2) + 4 * n + (i & 3); }

struct Unit { int pm, pn; int aux0, aux1; };

struct StaticOrder {
    int nM, nN, nwg, G, c;
    __host__ __device__ void init(int M, int N, int G_, int c_) { nM = M / BM; nN = N / BM; nwg = nM * nN; G = G_; c = c_; }
    __host__ __device__ bool next(int i, Unit& u) const {
        const long L = (long)i * G + c; if (L >= nwg) return false;
        int wgid = (int)L; { const int q = nwg / NXCD, r = nwg % NXCD, xcd = wgid % NXCD, off = wgid / NXCD; wgid = (xcd < r ? xcd * (q + 1) : r * (q + 1) + (xcd - r) * q) + off; }
        const int nig = WGM * nN, gid = wgid / nig, fm = gid * WGM, gsz = (nM - fm) < WGM ? (nM - fm) : WGM;
        u.pm = fm + ((wgid % nig) % gsz); u.pn = (wgid % nig) / gsz; u.aux0 = 0; u.aux1 = 0; return true;
    }
};

template <int ESZ_> struct DenseSrcT {
    static constexpr int ESZ = ESZ_; static constexpr bool GATHER = false;
    const void* A; const void* Bt; int K;
    __device__ __forceinline__ const char* b_base(const Unit& u) const { return (const char*)Bt + (size_t)u.pn * 256 * K * ESZ; }
    __device__ __forceinline__ const char* a_base(const Unit& u) const { return (const char*)A + (size_t)u.pm * 256 * K * ESZ; }
    __device__ __forceinline__ unsigned a_off(const Unit&, int R, int C) const { return (unsigned)(R * K * ESZ) + (unsigned)C * 2u; }
};
typedef DenseSrcT<2> DenseSrc;
typedef int v8i32 __attribute__((ext_vector_type(8)));

template <class T, class = void> struct has_prefetch { static constexpr bool value = false; };
template <class T> struct has_prefetch<T, decltype((void)&T::prefetch)> { static constexpr bool value = true; };
template <class Epi, class Sched, class Src, bool ALIGN_EPI = true>
__device__ __forceinline__ void gemm_phase(LAS unsigned char* lds, const int K, const Sched& S, const Src& G, const Epi& E) {
    const int tid = threadIdx.x, wid = __builtin_amdgcn_readfirstlane(tid >> 6), lane = tid & 63, wr = wid >> 2, wc = wid & 3, fr = lane & 15, fq = lane >> 4;
    constexpr int ESZ = Src::ESZ; const int Kb = K * ESZ;
    const int nt = Kb / (BK * 2);
    unsigned voffB0;
    { int R, C; stage_rc(tid * 16, R, C); const int Rb = Epi::PERM ? ((R & ~31) + perm32(R & 31)) : R; voffB0 = (unsigned)(Rb * Kb) + (unsigned)C * 2u; }
#define PG8_AOFF(u, h, i) ([&]() { int R_, C_; stage_rc(tid * 16 + (i) * 8192, R_, C_); return G.a_off((u), R_ + (h) * HALF, C_); }())
    const size_t kstep = (size_t)(BK * 2);
    const size_t hstepB = (size_t)HALF * Kb;
    const unsigned ldsw = (unsigned)wid * 1024u;
    const int aoff = lds_byte(wr * 64 + fr, fq * 8), boff = lds_byte(wc * 32 + fr, fq * 8);
#define PG8_SA(b, h) (((b) * 2 + (h)) * HTB)
#define PG8_SB(b, h) ((4 + (b) * 2 + (h)) * HTB)
#define PG8_STAGEB(bufoff, gbase) do { _Pragma("unroll") for (int _i = 0; _i < 2; ++_i) { unsigned o_ = voffB0; asm volatile("" : "+v"(o_)); \
        __builtin_amdgcn_global_load_lds((const unsigned*)((const char*)(gbase) + (size_t)_i * 64 * Kb + o_), (LAS unsigned*)(lds + (bufoff) + ldsw + _i * 8192), 16, 0, 0); } } while (0)
#define PG8_STAGEA(bufoff, gbase, vo, h) do { _Pragma("unroll") for (int _i = 0; _i < 2; ++_i) { unsigned o_ = Src::GATHER ? (vo)[h][_i] : (vo)[0][0]; asm volatile("" : "+v"(o_)); \
        __builtin_amdgcn_global_load_lds((const unsigned*)((const char*)(gbase) + (Src::GATHER ? (size_t)0 : (size_t)((h) * 128 + _i * 64) * Kb) + o_), (LAS unsigned*)(lds + (bufoff) + ldsw + _i * 8192), 16, 0, 0); } } while (0)
#define PG8_STAGEA2(bufoff, gbase, h) do { _Pragma("unroll") for (int _i = 0; _i < 2; ++_i) { unsigned o_ = Src::GATHER ? (last ? vn[h][_i] : vc[h][_i]) : vc[0][0]; asm volatile("" : "+v"(o_)); \
        __builtin_amdgcn_global_load_lds((const unsigned*)((const char*)(gbase) + (Src::GATHER ? (size_t)0 : (size_t)((h) * 128 + _i * 64) * Kb) + o_), (LAS unsigned*)(lds + (bufoff) + ldsw + _i * 8192), 16, 0, 0); } } while (0)
#define PG8_LDA(dst, b, h) do { _Pragma("unroll") for (int m = 0; m < 4; ++m) { const u32x4 lo_ = *(const LAS u32x4*)(lds + PG8_SA(b, h) + aoff + m * 2048), hi_ = *(const LAS u32x4*)(lds + PG8_SA(b, h) + aoff + m * 2048 + 1024); \
        dst[m] = __builtin_shufflevector(lo_, hi_, 0, 1, 2, 3, 4, 5, 6, 7); } } while (0)
#define PG8_LDB(dst, b, h) do { _Pragma("unroll") for (int n = 0; n < 2; ++n) { const u32x4 lo_ = *(const LAS u32x4*)(lds + PG8_SB(b, h) + boff + n * 2048), hi_ = *(const LAS u32x4*)(lds + PG8_SB(b, h) + boff + n * 2048 + 1024); \
        dst[n] = __builtin_shufflevector(lo_, hi_, 0, 1, 2, 3, 4, 5, 6, 7); } } while (0)
#define PG8_LO(x) __builtin_bit_cast(bf16x8, __builtin_shufflevector((x), (x), 0, 1, 2, 3))
#define PG8_HI(x) __builtin_bit_cast(bf16x8, __builtin_shufflevector((x), (x), 4, 5, 6, 7))
#define PG8_MMA(ai, bj, At, Bt) do { __builtin_amdgcn_s_setprio(1); _Pragma("unroll") for (int m = 0; m < 4; ++m) _Pragma("unroll") for (int n = 0; n < 2; ++n) { \
        if constexpr (ESZ == 1) acc[ai][bj][m][n] = __builtin_amdgcn_mfma_scale_f32_16x16x128_f8f6f4(__builtin_bit_cast(v8i32, Bt[n]), __builtin_bit_cast(v8i32, At[m]), acc[ai][bj][m][n], 0, 0, 0, 0, 0, 0); \
        else { acc[ai][bj][m][n] = __builtin_amdgcn_mfma_f32_16x16x32_bf16(PG8_LO(Bt[n]), PG8_LO(At[m]), acc[ai][bj][m][n], 0, 0, 0); \
               acc[ai][bj][m][n] = __builtin_amdgcn_mfma_f32_16x16x32_bf16(PG8_HI(Bt[n]), PG8_HI(At[m]), acc[ai][bj][m][n], 0, 0, 0); } } \
        __builtin_amdgcn_s_setprio(0); } while (0)
#define PG8_WAIT_V(n) asm volatile("s_waitcnt vmcnt(" #n ")" ::: "memory")
#define PG8_WAIT_L(n) asm volatile("s_waitcnt lgkmcnt(" #n ")" ::: "memory")
#define PG8_BAR __builtin_amdgcn_s_barrier()
#define PG8_SCHED __builtin_amdgcn_sched_barrier(0)
    Unit cur, nxt; int ui = 0;
    if (!S.next(0, cur)) return;
#define PG8_PREFETCH(u_) do { if constexpr (has_prefetch<Epi>::value) { int ln_; asm volatile("v_mbcnt_lo_u32_b32 %0, -1, 0\n\tv_mbcnt_hi_u32_b32 %0, -1, %0" : "=v"(ln_)); E.prefetch((u_), wr, ln_ & 15); } } while (0)
    PG8_PREFETCH(cur);
    f32x4 acc[2][2][4][2];
#pragma unroll
    for (int a = 0; a < 2; ++a)
#pragma unroll
        for (int b = 0; b < 2; ++b)
#pragma unroll
            for (int m = 0; m < 4; ++m)
#pragma unroll
                for (int n = 0; n < 2; ++n) acc[a][b][m][n] = (f32x4){0.f, 0.f, 0.f, 0.f};
    typedef unsigned u32x8 __attribute__((ext_vector_type(8)));
    u32x8 At[4], B0[2], B1[2];
    unsigned vc[2][2], vn[2][2];
#pragma unroll
    for (int h = 0; h < 2; ++h)
#pragma unroll
        for (int i = 0; i < 2; ++i) vc[h][i] = PG8_AOFF(cur, h, i);
    const char* cA = G.a_base(cur); const char* cB = G.b_base(cur);
    PG8_STAGEB(PG8_SB(0, 0), cB); PG8_STAGEB(PG8_SB(0, 1), cB + hstepB); PG8_STAGEA(PG8_SA(0, 0), cA, vc, 0); PG8_STAGEA(PG8_SA(0, 1), cA, vc, 1);
    if (wr == 1) PG8_BAR;
    PG8_WAIT_V(2); PG8_BAR;
    PG8_STAGEB(PG8_SB(1, 0), cB + kstep); PG8_STAGEA(PG8_SA(1, 0), cA + kstep, vc, 0); PG8_STAGEB(PG8_SB(1, 1), cB + hstepB + kstep);
    PG8_WAIT_V(6); PG8_BAR;
    for (;;) {
        const bool has_next = S.next(ui + 1, nxt);
        const char* nA = has_next ? G.a_base(nxt) : cA; const char* nB = has_next ? G.b_base(nxt) : cB;
        if constexpr (Src::GATHER) {
#pragma unroll
        for (int h = 0; h < 2; ++h)
#pragma unroll
            for (int i = 0; i < 2; ++i) vn[h][i] = has_next ? PG8_AOFF(nxt, h, i) : vc[h][i]; }
#pragma clang loop unroll(disable)
        for (int t = 0; t < nt; t += 2) {
            const bool last = (t == nt - 2);
            const char* a1 = cA + (size_t)(t + 1) * kstep;
            const char* a2 = last ? nA : cA + (size_t)(t + 2) * kstep; const char* b2 = last ? nB : cB + (size_t)(t + 2) * kstep;
            const char* a3 = a2 + kstep; const char* b3 = b2 + kstep;
            PG8_LDB(B0, 0, 0); PG8_LDB(B1, 0, 1); PG8_SCHED; PG8_LDA(At, 0, 0); PG8_STAGEA(PG8_SA(1, 1), a1, vc, 1);
            PG8_WAIT_V(8); PG8_WAIT_L(0); PG8_BAR; PG8_MMA(0, 0, At, B0); PG8_MMA(0, 1, At, B1); PG8_BAR; PG8_SCHED;
            PG8_LDA(At, 0, 1); PG8_STAGEB(PG8_SB(0, 0), b2); PG8_STAGEB(PG8_SB(0, 1), b2 + hstepB); PG8_STAGEA2(PG8_SA(0, 0), a2, 0);
            PG8_WAIT_V(8); PG8_WAIT_L(0); PG8_BAR; PG8_MMA(1, 0, At, B0); PG8_MMA(1, 1, At, B1); PG8_BAR; PG8_SCHED;
            PG8_LDB(B0, 1, 0); PG8_LDB(B1, 1, 1); PG8_SCHED; PG8_LDA(At, 1, 0); PG8_STAGEA2(PG8_SA(0, 1), a2, 1);
            PG8_WAIT_V(8); PG8_WAIT_L(0); PG8_BAR; PG8_MMA(0, 0, At, B0); PG8_MMA(0, 1, At, B1); PG8_BAR; PG8_SCHED;
            PG8_LDA(At, 1, 1); PG8_STAGEB(PG8_SB(1, 0), b3); PG8_STAGEB(PG8_SB(1, 1), b3 + hstepB); PG8_STAGEA2(PG8_SA(1, 0), a3, 0);
            PG8_WAIT_V(8); PG8_WAIT_L(0); PG8_BAR; PG8_MMA(1, 0, At, B0); PG8_MMA(1, 1, At, B1); PG8_BAR; PG8_SCHED;
        }
        if constexpr (ALIGN_EPI) { if (wr == 0) PG8_BAR; }
        { int ln_; asm volatile("v_mbcnt_lo_u32_b32 %0, -1, 0\n\tv_mbcnt_hi_u32_b32 %0, -1, %0" : "=v"(ln_)); E(acc, cur, wr, wc, ln_ & 15, ln_ >> 4); }
        if (!has_next) break;
#pragma unroll
        for (int a = 0; a < 2; ++a)
#pragma unroll
            for (int b = 0; b < 2; ++b)
#pragma unroll
                for (int m = 0; m < 4; ++m)
#pragma unroll
                    for (int n = 0; n < 2; ++n) acc[a][b][m][n] = (f32x4){0.f, 0.f, 0.f, 0.f};
        cur = nxt; cA = nA; cB = nB; ++ui;
        PG8_PREFETCH(cur);
        if constexpr (Src::GATHER) {
#pragma unroll
        for (int h = 0; h < 2; ++h)
#pragma unroll
            for (int i = 0; i < 2; ++i) vc[h][i] = vn[h][i]; }
        if constexpr (ALIGN_EPI) { if (wr == 1) PG8_BAR; }
    }
    PG8_WAIT_V(0);
    if constexpr (!ALIGN_EPI) { if (wr == 0) PG8_BAR; }
    PG8_BAR;
#undef PG8_PREFETCH
#undef PG8_SA
#undef PG8_AOFF
#undef PG8_SB
#undef PG8_STAGEA
#undef PG8_STAGEA2
#undef PG8_STAGEB
#undef PG8_LDA
#undef PG8_LDB
#undef PG8_MMA
#undef PG8_LO
#undef PG8_HI
#undef PG8_WAIT_V
#undef PG8_WAIT_L
#undef PG8_BAR
#undef PG8_SCHED
}
}
#define RLX_AGENT __ATOMIC_RELAXED, __HIP_MEMORY_SCOPE_AGENT
#define LDS_WAIT() asm volatile("s_waitcnt lgkmcnt(0)" ::: "memory")
#define VM_WAIT() asm volatile("s_waitcnt vmcnt(0)" ::: "memory")
#define XB_TMO      128
#define XB_XCNT(j)  (256  + 64 * (j))
#define XB_XSUB(j)  (1280 + 64 * (j))
#define XB_XGEN(j)  (2304 + 64 * (j))
#define XB_TOP      3328
#define XB_TOPGEN   3392
#define XCD_BAR_WORDS 3456
#define XB_SPIN_CAP (1u << 18)

__device__ __forceinline__ unsigned xb_ld(unsigned* p)              { return __hip_atomic_load(p, __ATOMIC_RELAXED, __HIP_MEMORY_SCOPE_AGENT); }
__device__ __forceinline__ unsigned xb_add(unsigned* p, unsigned v) { return __hip_atomic_fetch_add(p, v, __ATOMIC_RELAXED, __HIP_MEMORY_SCOPE_AGENT); }
__device__ __forceinline__ unsigned xb_xcc_id() { return (unsigned)__builtin_amdgcn_s_getreg((3 << 11) | 20) & 0xFu; }
#define XB_SPIN(cond, bar) do { unsigned _sp = 0; while (cond) { __builtin_amdgcn_s_sleep(1); \
    if ((++_sp & 255u) == 0u) { if (xb_ld(&(bar)[XB_TMO])) break; if (_sp > XB_SPIN_CAP) { atomicAdd(&(bar)[XB_TMO], 1u); break; } } } } while (0)

struct XcdBarrier {
    unsigned* bar; unsigned x;
    volatile LAS unsigned* st;
};

__device__ __forceinline__ XcdBarrier xcd_barrier_post(unsigned* bar, volatile LAS unsigned* st) {
    XcdBarrier b; b.bar = bar; b.x = xb_xcc_id(); b.st = st;
    if (threadIdx.x == 0) (void)xb_add(&bar[XB_XCNT(b.x)], 1u);
    return b;
}
__device__ __forceinline__ void xcd_barrier_complete(unsigned* bar, unsigned x, unsigned& nloc, unsigned& nx) {
    const unsigned G = gridDim.x * gridDim.y * gridDim.z;
    unsigned sum, cnt, mine, sp = 0u;
    for (;;) {
        sum = 0u; cnt = 0u; mine = 0u;
#pragma unroll
        for (unsigned j = 0; j < 16; ++j) { const unsigned c = xb_ld(&bar[XB_XCNT(j)]); sum += c; cnt += (c > 0u) ? 1u : 0u; mine = (j == x) ? c : mine; }
        if (sum == G) break;
        __builtin_amdgcn_s_sleep(1);
        if ((++sp & 255u) == 0u) { if (xb_ld(&bar[XB_TMO])) break; if (sp > XB_SPIN_CAP) { atomicAdd(&bar[XB_TMO], 1u); break; } }
    }
    nloc = mine > 0u ? mine : 1u; nx = cnt > 0u ? cnt : 1u;
}

__device__ __forceinline__ void xcd_barrier(const XcdBarrier& b) {
    asm volatile("s_waitcnt vmcnt(0)" ::: "memory");
    __syncthreads();
    if (threadIdx.x == 0) {
        unsigned* bar = b.bar;
        __builtin_amdgcn_s_waitcnt(0);
        unsigned nloc = b.st[0], nx = b.st[1];
        if (nloc == 0u) { xcd_barrier_complete(bar, b.x, nloc, nx); b.st[0] = nloc; b.st[1] = nx; }
        const unsigned old = xb_add(&bar[XB_XSUB(b.x)], 1u);
        const unsigned gen = old / nloc;
        if (old + 1u == (gen + 1u) * nloc) {
            __builtin_amdgcn_fence(__ATOMIC_RELEASE, "agent");
            asm volatile("s_waitcnt vmcnt(0)" ::: "memory");
            const unsigned og = xb_add(&bar[XB_TOP], 1u);
            const unsigned tg = og / nx;
            if (og + 1u == (tg + 1u) * nx) xb_add(&bar[XB_TOPGEN], 1u);
            else XB_SPIN(xb_ld(&bar[XB_TOPGEN]) == tg, bar);
            __builtin_amdgcn_fence(__ATOMIC_ACQUIRE, "agent");
            xb_add(&bar[XB_XGEN(b.x)], 1u);
            asm volatile("s_waitcnt vmcnt(0)" ::: "memory");
        } else {
            XB_SPIN(xb_ld(&bar[XB_XGEN(b.x)]) == gen, bar);
            __builtin_amdgcn_fence(__ATOMIC_ACQUIRE, "agent");
            asm volatile("s_waitcnt vmcnt(0)" ::: "memory");
        }
    }
    __syncthreads();
}
constexpr int NB = 8, SEQ = 4096, D = 1024, M = NB * SEQ;
constexpr int NIN_SRC = 5936, NIN = 6144;
constexpr int ZW = 4096;
constexpr int ZQ = 0, ZK = 512, ZV = 1024, ZIQ = 1536, ZIK = 2048, ZIW = 2080, ZR = 2304;
constexpr int ZR_R = ZR, ZR_K = ZR + 512, ZR_V = ZR + 1024, ZR_WD = ZR + 1536, ZR_AD = ZR + 1600, ZR_GD = ZR + 1664;
constexpr int GW = 2048;
constexpr int NEXP = 64, FF = 256, TOPK = 8;
constexpr float RMS_EPS = 1e-6f, GN_EPS = 64e-5f;
constexpr float QSCALE = 0.125f * 1.4426950408889634f;
constexpr int NWAVES = 8, NTHR = 512;

constexpr size_t MiB = 1u << 20;
constexpr size_t WS_CTL = 0, CTL_ZERO_BYTES = 1 * MiB;
constexpr size_t WS_MOD = 1 * MiB;
constexpr size_t WS_DUT = 1 * MiB + 256 * 1024;
constexpr size_t WS_IUT = WS_DUT + 64 * 1024;
constexpr size_t WS_GUT = WS_IUT + 64 * 1024;
constexpr size_t WS_WIN = 2 * MiB;
constexpr size_t WS_WA = 14 * MiB, WS_WR = 15 * MiB;
constexpr size_t WS_WO = 16 * MiB;
constexpr size_t WS_WRT = 18 * MiB;
constexpr size_t WS_WSH1 = 19 * MiB;
constexpr size_t WS_WSH2 = 20 * MiB;
constexpr size_t WS_BRS = 21 * MiB, WS_KRS = 22 * MiB;
constexpr size_t WS_TOPE = 23 * MiB, WS_TOPW = 24 * MiB;
constexpr size_t WS_LOGIT = 25 * MiB;
constexpr size_t WS_Z = 36 * MiB;
constexpr size_t WS_H0 = 292 * MiB, WS_H1 = 324 * MiB;
constexpr size_t WS_SEL = 356 * MiB;
constexpr size_t WS_R0 = 372 * MiB, WS_R1 = 404 * MiB, WS_R2 = 436 * MiB, WS_R3 = 468 * MiB;
constexpr size_t WS_W2T = 36 * MiB;
constexpr size_t WS_ACT = 68 * MiB;
constexpr size_t WS_ACTS = 196 * MiB;
constexpr size_t WS_STOK = 212 * MiB, WS_SW = 213 * MiB;
constexpr size_t WS_W1T = 214 * MiB;
constexpr size_t WS_H2 = 278 * MiB;
constexpr size_t WS_SLOT = 214 * MiB;
constexpr size_t WS_END = 502 * MiB;
constexpr int CW_TMO = 0, CW_BAR = 4096, CW_CNT = 32768, CW_CUR = 32768 + 128, CW_Q = 32768 + 512;

constexpr int RING_BYTES = 131072;
constexpr int LDSCTL_OFF = RING_BYTES, MISC_OFF = LDSCTL_OFF + 320;
constexpr int LDS_TILETAB = RING_BYTES + 1024;
constexpr int LDS_PTAB = RING_BYTES + 512;
constexpr int LDS_PARA = 118800;
constexpr int LDS_PARB = LDS_TILETAB;
constexpr int LDS_BYTES = 147456;
#define AIN(i) ain_ptr(F.lds, (i))

struct Args { const float* in[31]; float* out; unsigned char* ws; int ph_lo, ph_hi, li, pad; };
struct Frame {
    LAS unsigned char* lds;
    volatile LAS unsigned* MISC;
    unsigned* ctl;
    int tid, lane, wave, vcu, G, gw, NGW;
    float* out; unsigned char* ws;
};

__device__ __forceinline__ const float* ain_ptr(LAS unsigned char* lds, int i) {
    const u32x2 w = *(const LAS u32x2*)(lds + LDS_PTAB + 8 * i);
    const unsigned lo = (unsigned)__builtin_amdgcn_readfirstlane((int)w.x), hi = (unsigned)__builtin_amdgcn_readfirstlane((int)w.y);
    return (const float*)(const GAS float*)(((unsigned long long)hi << 32) | lo);
}
struct TrSrc { const float* base; int nsrc; };
template <int FP8, class ColFn>
__device__ __forceinline__ void transpose_item(const ColFn& colfn, int K, bf16_t* WT, LAS float* scr, int kb, int nb, int lane) {
    const int k0 = 64 * kb, n0 = 32 * nb;
    const TrSrc s = colfn(n0 + (lane & 31));
    float v_[32];
#pragma unroll
    for (int i = 0; i < 32; ++i) { const int kk = 2 * i + (lane >> 5); v_[i] = s.base ? s.base[(size_t)(k0 + kk) * s.nsrc] : 0.f; }
#pragma unroll
    for (int i = 0; i < 32; ++i) { const int kk = 2 * i + (lane >> 5); scr[kk * 33 + (lane & 31)] = v_[i]; }
    LDS_WAIT(); asm volatile("" ::: "memory");
    const int c = lane & 7;
#pragma unroll
    for (int j = 0; j < 4; ++j) { const int n = (lane >> 3) + 8 * j; const LAS float* sp = scr + (8 * c) * 33 + n;
        if constexpr (FP8) { constexpr float S8 = 32.0f;
            int lo = __builtin_amdgcn_cvt_pk_fp8_f32(sp[0 * 33] * S8, sp[1 * 33] * S8, 0, false); lo = __builtin_amdgcn_cvt_pk_fp8_f32(sp[2 * 33] * S8, sp[3 * 33] * S8, lo, true);
            int hi = __builtin_amdgcn_cvt_pk_fp8_f32(sp[4 * 33] * S8, sp[5 * 33] * S8, 0, false); hi = __builtin_amdgcn_cvt_pk_fp8_f32(sp[6 * 33] * S8, sp[7 * 33] * S8, hi, true);
            *(GAS u32x2*)((unsigned char*)WT + (size_t)(n0 + n) * K + k0 + 8 * c) = (u32x2){(unsigned)lo, (unsigned)hi}; }
        else { u32x4 o; o.x = pk2(sp[0 * 33], sp[1 * 33]); o.y = pk2(sp[2 * 33], sp[3 * 33]); o.z = pk2(sp[4 * 33], sp[5 * 33]); o.w = pk2(sp[6 * 33], sp[7 * 33]);
            *(GAS u32x4*)(WT + (size_t)(n0 + n) * K + k0 + 8 * c) = o; } }
    LDS_WAIT(); asm volatile("" ::: "memory");
}

__device__ __forceinline__ void p0_mod(const Args& args, Frame& F, int task) {
    LAS float* sc = (LAS float*)F.lds;
    LAS float* red = (LAS float*)(F.lds + 32768);
    const float* c = AIN(1);
    for (int i = F.tid; i < 8192; i += NTHR) { const float v = c[i]; sc[i] = v * fast_sigmoid(v); }
    __syncthreads();
    const float* aw = AIN(2) + 64 * task + F.lane;
    float acc[8];
#pragma unroll
    for (int b = 0; b < 8; ++b) acc[b] = 0.f;
    const int kb = 128 * F.wave;
#pragma unroll 1
    for (int k0 = 0; k0 < 128; k0 += 16) { float a_[16];
#pragma unroll
        for (int k = 0; k < 16; ++k) a_[k] = aw[(size_t)(kb + k0 + k) * 6144];
#pragma unroll
        for (int k = 0; k < 16; ++k) {
#pragma unroll
            for (int b = 0; b < 8; ++b) acc[b] += sc[b * 1024 + kb + k0 + k] * a_[k];
            if ((k & 3) == 3) asm volatile("" ::: "memory"); } }
#pragma unroll
    for (int b = 0; b < 8; ++b) red[(F.wave * 8 + b) * 64 + F.lane] = acc[b];
    __syncthreads();
    { const int b = F.wave; float s = AIN(3)[64 * task + F.lane];
#pragma unroll
      for (int w = 0; w < 8; ++w) s += red[(w * 8 + b) * 64 + F.lane];
      ((float*)(F.ws + WS_MOD))[b * 6144 + 64 * task + F.lane] = s; }
    __syncthreads();
}

__device__ __forceinline__ void p0_prologue(const Args& args, Frame& F) {
    if (blockIdx.x < 96) p0_mod(args, F, blockIdx.x);
    LAS float* scr = (LAS float*)(F.lds + F.wave * 16384);
    bf16_t* const ws16 = (bf16_t*)F.ws;
    constexpr int I_WIN = 16 * 192, I_WA = 8 * 32, I_WO = 16 * 32, I_WRT = 16 * 8, I_SH1 = 16 * 16, I_SH2 = 4 * 32, I_DU = 16, I_GU = 32;
    constexpr int NIT = I_WIN + 2 * I_WA + I_WO + I_WRT + I_SH1 + I_SH2 + 2 * I_DU + I_GU;
    for (int it = F.gw; it < NIT; it += F.NGW) {
        int r = it;
        if (r < I_WIN) { const float* w = AIN(5);
            transpose_item<1>([=](int n) { TrSrc s; const bool ok = (n < 2096) || (n >= 2304); const int col = n < 2096 ? n : n - 208; s.base = ok ? w + col : nullptr; s.nsrc = NIN_SRC; return s; },
                           1024, (bf16_t*)(F.ws + WS_WIN), scr, r / 192, r % 192, F.lane); continue; } r -= I_WIN;
        if (r < I_WA) { const float* w = AIN(18); transpose_item<0>([=](int n) { TrSrc s; s.base = w + n; s.nsrc = 1024; return s; }, 512, (bf16_t*)(F.ws + WS_WA), scr, r / 32, r % 32, F.lane); continue; } r -= I_WA;
        if (r < I_WA) { const float* w = AIN(19); transpose_item<0>([=](int n) { TrSrc s; s.base = w + n; s.nsrc = 1024; return s; }, 512, (bf16_t*)(F.ws + WS_WR), scr, r / 32, r % 32, F.lane); continue; } r -= I_WA;
        if (r < I_WO) { const float* w = AIN(20); transpose_item<1>([=](int n) { TrSrc s; s.base = w + n; s.nsrc = 1024; return s; }, 1024, (bf16_t*)(F.ws + WS_WO), scr, r / 32, r % 32, F.lane); continue; } r -= I_WO;
        if (r < I_WRT) { const float* w = AIN(22); transpose_item<0>([=](int n) { TrSrc s; s.base = n < 64 ? w + n : nullptr; s.nsrc = 64; return s; }, 1024, (bf16_t*)(F.ws + WS_WRT), scr, r / 8, r % 8, F.lane); continue; } r -= I_WRT;
        if (r < I_SH1) { const float* wg = AIN(27); const float* wu = AIN(28);
            transpose_item<0>([=](int n) { TrSrc s; const int j = n >> 8, sel = (n >> 7) & 1, cc = n & 127; s.base = (sel ? wu : wg) + 128 * j + cc; s.nsrc = 256; return s; }, 1024, (bf16_t*)(F.ws + WS_WSH1), scr, r / 16, r % 16, F.lane); continue; } r -= I_SH1;
        if (r < I_SH2) { const float* w = AIN(29); transpose_item<0>([=](int n) { TrSrc s; s.base = w + n; s.nsrc = 1024; return s; }, 256, (bf16_t*)(F.ws + WS_WSH2), scr, r / 32, r % 32, F.lane); continue; } r -= I_SH2;
        if (r < I_DU) { const float* w = AIN(9); transpose_item<0>([=](int n) { TrSrc s; s.base = w + n; s.nsrc = 512; return s; }, 64, (bf16_t*)(F.ws + WS_DUT), scr, 0, r, F.lane); continue; } r -= I_DU;
        if (r < I_DU) { const float* w = AIN(11); transpose_item<0>([=](int n) { TrSrc s; s.base = w + n; s.nsrc = 512; return s; }, 64, (bf16_t*)(F.ws + WS_IUT), scr, 0, r, F.lane); continue; } r -= I_DU;
        { const float* w = AIN(12); transpose_item<0>([=](int n) { TrSrc s; s.base = w + n; s.nsrc = 512; return s; }, 128, (bf16_t*)(F.ws + WS_GUT), scr, r / 16, r % 16, F.lane); }
    }
    (void)ws16;
}

__device__ __forceinline__ void convert_experts(const Args& args, Frame& F, int k0, int k1) {
    LAS float* scr = (LAS float*)(F.lds + F.wave * 16384);
    constexpr int I1 = 16 * 16, I2 = 4 * 32, PER = I1 + I2, NIT = 64 * PER;
    for (int k = k0; k < k1; ++k) { const int it = F.gw + k * F.NGW; if (it >= NIT) break;
        const int e = it / PER; int r = it % PER;
        if (r < I1) { const float* wg = AIN(24) + (size_t)e * 1024 * 256; const float* wu = AIN(25) + (size_t)e * 1024 * 256;
            transpose_item<0>([=](int n) { TrSrc s; const int j = n >> 8, sel = (n >> 7) & 1, cc = n & 127; s.base = (sel ? wu : wg) + 128 * j + cc; s.nsrc = 256; return s; }, 1024, (bf16_t*)(F.ws + WS_W1T) + (size_t)e * 512 * 1024, scr, r / 16, r % 16, F.lane); }
        else { r -= I1; const float* w = AIN(26) + (size_t)e * 256 * 1024;
            transpose_item<0>([=](int n) { TrSrc s; s.base = w + n; s.nsrc = 1024; return s; }, 256, (bf16_t*)(F.ws + WS_W2T) + (size_t)e * 1024 * 256, scr, r / 32, r % 32, F.lane); }
    }
}

__device__ __forceinline__ void norm_mod_rows(const Args& args, Frame& F, const float* X, const float* g, int sh_off, int sc_off, bf16_t* O, unsigned char* O8) {
    const int row0 = F.gw * 16, b = row0 / SEQ;
    const float* mod = (const float*)(F.ws + WS_MOD) + b * 6144;
    f32x4 mul[4], add[4];
#pragma unroll
    for (int j = 0; j < 4; ++j) { const int c = 4 * F.lane + 256 * j; const f32x4 gv = *(const f32x4*)(g + c), sc = *(const f32x4*)(mod + sc_off + c); add[j] = *(const f32x4*)(mod + sh_off + c); mul[j] = gv * (sc + 1.0f); }
    for (int r0 = 0; r0 < 16; r0 += 4) {
        f32x4 v[4][4]; float s[4];
#pragma unroll
        for (int q = 0; q < 4; ++q) { const GAS f32x4* xr = (const GAS f32x4*)(X + (size_t)(row0 + r0 + q) * D) + F.lane;
#pragma unroll
            for (int j = 0; j < 4; ++j) v[q][j] = xr[64 * j]; }
#pragma unroll
        for (int q = 0; q < 4; ++q) { s[q] = 0.f;
#pragma unroll
            for (int j = 0; j < 4; ++j) s[q] += (v[q][j].x * v[q][j].x + v[q][j].y * v[q][j].y) + (v[q][j].z * v[q][j].z + v[q][j].w * v[q][j].w); }
#pragma unroll
        for (int q = 0; q < 4; ++q) { const int r = r0 + q;
            const float rstd = 1.0f / sqrtf(wave_sum(s[q]) * (1.0f / D) + RMS_EPS);
#pragma unroll
            for (int j = 0; j < 4; ++j) { const f32x4 y = v[q][j] * rstd * mul[j] + add[j];
                if (O) { u32x2 w; w.x = cvt_pk_bf16(y.x, y.y); w.y = cvt_pk_bf16(y.z, y.w); ((GAS u32x2*)(O + (size_t)(row0 + r) * D) + F.lane)[64 * j] = w; }
                if (O8) { int w8 = __builtin_amdgcn_cvt_pk_fp8_f32(y.x, y.y, 0, false); w8 = __builtin_amdgcn_cvt_pk_fp8_f32(y.z, y.w, w8, true); ((GAS unsigned*)(O8 + (size_t)(row0 + r) * D) + F.lane)[64 * j] = (unsigned)w8; } } }
    }
}
using pg8::Unit;
constexpr float WSCALE8 = 32.0f;
typedef const f32x4 (&AccRef)[2][2][4][2];

struct EpiInProj {
    static constexpr bool PERM = true;
    bf16_t* Z; bf16_t* Gt;
    __device__ __forceinline__ void operator()(AccRef acc, const Unit& u, int wr, int wc, int fr, int fq) const {
        asm volatile("" : "+v"(fr), "+v"(fq));
        const int row0 = u.pm * 256 + wr * 64 + fr;
        const bool gate = u.pn >= 16;
        const float sc = ((u.pn < 2) ? QSCALE : 1.0f) * (1.0f / WSCALE8);
        bf16_t* base = gate ? Gt + (size_t)(u.pn - 16) * 256 : Z + (size_t)u.pn * 256;
        const int ldc = gate ? GW : ZW;
#pragma unroll
        for (int ai = 0; ai < 2; ++ai)
#pragma unroll
            for (int m = 0; m < 4; ++m) { bf16_t* rowp = base + (size_t)(row0 + ai * 128 + m * 16) * ldc + wc * 32 + 8 * fq;
#pragma unroll
                for (int bj = 0; bj < 2; ++bj) { f32x4 v0 = acc[ai][bj][m][0], v1 = acc[ai][bj][m][1];
                    if (gate) {
#pragma unroll
                        for (int j = 0; j < 4; ++j) { v0[j] = fast_sigmoid(v0[j] * sc); v1[j] = fast_sigmoid(v1[j] * sc); } }
                    else { v0 = v0 * sc; v1 = v1 * sc; }
                    u32x4 w; w.x = cvt_pk_bf16(v0[0], v0[1]); w.y = cvt_pk_bf16(v0[2], v0[3]); w.z = cvt_pk_bf16(v1[0], v1[1]); w.w = cvt_pk_bf16(v1[2], v1[3]);
                    *(u32x4*)(rowp + bj * 128) = w; } }
    }
};

constexpr float ATT_S8 = 16.0f, RW_S8 = 8.0f, MIX_S8 = 16.0f;
template <int SECOND> struct EpiMerge {
    static constexpr bool PERM = true;
    bf16_t* Mx; unsigned char* Mx8; const bf16_t* Gt; float bs;
    __device__ __forceinline__ void operator()(AccRef acc, const Unit& u, int wr, int wc, int fr, int fq) const {
        asm volatile("" : "+v"(fr), "+v"(fq));
        const int row0 = u.pm * 256 + wr * 64 + fr, col0 = u.pn * 256 + wc * 32 + 8 * fq;
#pragma unroll
        for (int ai = 0; ai < 2; ++ai)
#pragma unroll
            for (int m = 0; m < 4; ++m) { const size_t r = (size_t)(row0 + ai * 128 + m * 16);
#pragma unroll
                for (int bj = 0; bj < 2; ++bj) { const int c = col0 + bj * 128;
                    const u32x4 g = *(const u32x4*)(Gt + r * GW + SECOND * 1024 + c);
                    f32x4 v0 = acc[ai][bj][m][0] * bs, v1 = acc[ai][bj][m][1] * bs;
                    v0[0] *= bf_lo(g.x); v0[1] *= bf_hi(g.x); v0[2] *= bf_lo(g.y); v0[3] *= bf_hi(g.y);
                    v1[0] *= bf_lo(g.z); v1[1] *= bf_hi(g.z); v1[2] *= bf_lo(g.w); v1[3] *= bf_hi(g.w);
                    if (SECOND) { const u32x4 p = *(const u32x4*)(Mx + r * D + c);
                        v0[0] += bf_lo(p.x); v0[1] += bf_hi(p.x); v0[2] += bf_lo(p.y); v0[3] += bf_hi(p.y);
                        v1[0] += bf_lo(p.z); v1[1] += bf_hi(p.z); v1[2] += bf_lo(p.w); v1[3] += bf_hi(p.w);
                        v0 = v0 * MIX_S8; v1 = v1 * MIX_S8;
                        int lo = __builtin_amdgcn_cvt_pk_fp8_f32(v0[0], v0[1], 0, false); lo = __builtin_amdgcn_cvt_pk_fp8_f32(v0[2], v0[3], lo, true);
                        int hi = __builtin_amdgcn_cvt_pk_fp8_f32(v1[0], v1[1], 0, false); hi = __builtin_amdgcn_cvt_pk_fp8_f32(v1[2], v1[3], hi, true);
                        *(u32x2*)(Mx8 + r * D + c) = (u32x2){(unsigned)lo, (unsigned)hi}; }
                    else { u32x4 w; w.x = cvt_pk_bf16(v0[0], v0[1]); w.y = cvt_pk_bf16(v0[2], v0[3]); w.z = cvt_pk_bf16(v1[0], v1[1]); w.w = cvt_pk_bf16(v1[2], v1[3]);
                        *(u32x4*)(Mx + r * D + c) = w; }
                    asm volatile("" ::: "memory"); } }
    }
};

struct EpiOutProj {
    static constexpr bool PERM = false;
    const float* X; float* O; const float* mod;
    __device__ __forceinline__ void operator()(AccRef acc, const Unit& u, int wr, int wc, int fr, int fq) const {
        asm volatile("" : "+v"(fr), "+v"(fq));
        const int row0 = u.pm * 256 + wr * 64 + fr, col0 = u.pn * 256 + wc * 32 + 4 * fq;
        const float* g1 = mod + (size_t)((u.pm * 256) / SEQ) * 6144 + 2048;
        f32x4 gv[2][2];
#pragma unroll
        for (int bj = 0; bj < 2; ++bj)
#pragma unroll
            for (int n = 0; n < 2; ++n) gv[bj][n] = *(const f32x4*)(g1 + col0 + bj * 128 + n * 16);
#pragma unroll
        for (int ai = 0; ai < 2; ++ai)
#pragma unroll
            for (int m = 0; m < 4; ++m) { const size_t off = (size_t)(row0 + ai * 128 + m * 16) * D + col0;
#pragma unroll
                for (int bj = 0; bj < 2; ++bj)
#pragma unroll
                    for (int n = 0; n < 2; ++n) { const f32x4 xv = *(const f32x4*)(X + off + bj * 128 + n * 16);
                        *(f32x4*)(O + off + bj * 128 + n * 16) = xv + gv[bj][n] * acc[ai][bj][m][n] * (1.0f / (MIX_S8 * WSCALE8)); }
                if (m & 1) asm volatile("" ::: "memory"); }
    }
};

struct EpiRouter {
    static constexpr bool PERM = false;
    float* L;
    __device__ __forceinline__ void operator()(AccRef acc, const Unit& u, int wr, int wc, int fr, int fq) const {
        asm volatile("" : "+v"(fr), "+v"(fq));
        if (wc >= 2) return;
        const int row0 = u.pm * 256 + wr * 64 + fr, col0 = wc * 32 + 4 * fq;
#pragma unroll
        for (int ai = 0; ai < 2; ++ai)
#pragma unroll
            for (int m = 0; m < 4; ++m)
#pragma unroll
                for (int n = 0; n < 2; ++n) *(f32x4*)(L + (size_t)(row0 + ai * 128 + m * 16) * 64 + col0 + n * 16) = acc[ai][0][m][n];
    }
};

struct MoeSched1 {
    const LAS unsigned* tab; int ntiles, G, c;
    __device__ __forceinline__ bool next(int i, Unit& u) const {
        const int L = i * G + c; if (L >= 256 + 2 * ntiles) return false;
        u.pn = L & 1;
        if (L < 256) { u.pm = L >> 1; u.aux0 = (u.pm * 256) | (64 << 20); u.aux1 = 256; }
        else { const int t = (L - 256) >> 1; u.pm = t; u.aux0 = __builtin_amdgcn_readfirstlane((int)tab[2 * t]); u.aux1 = __builtin_amdgcn_readfirstlane((int)tab[2 * t + 1]); }
        return true;
    }
};
struct MoeSrc1 {
    static constexpr int ESZ = 2; static constexpr bool GATHER = true;
    const unsigned char* ws;
    __device__ __forceinline__ const char* a_base(const Unit&) const { return (const char*)(ws + WS_H2); }
    __device__ __forceinline__ const char* b_base(const Unit& u) const { const int e = u.aux0 >> 20;
        const size_t off = (e == 64 ? WS_WSH1 : WS_W1T + (size_t)e * 512 * 1024 * 2) + (size_t)u.pn * 256 * 1024 * 2; return (const char*)ws + off; }
    __device__ __forceinline__ unsigned a_off(const Unit& u, int R, int C) const {
        const int e = u.aux0 >> 20, pos0 = u.aux0 & 0xFFFFF; int tok;
        if (e == 64) tok = pos0 + R; else tok = (R < u.aux1) ? (((const int*)(ws + WS_STOK))[pos0 + R] >> 3) : 0;
        return (unsigned)tok * 2048u + (unsigned)C * 2u; }
};
struct EpiMoe1 {
    static constexpr bool PERM = true;
    unsigned char* ws;
    __device__ __forceinline__ void operator()(AccRef acc, const Unit& u, int wr, int wc, int fr, int fq) const {
        asm volatile("" : "+v"(fr), "+v"(fq));
        const int e = u.aux0 >> 20, pos0 = u.aux0 & 0xFFFFF;
        bf16_t* base = (bf16_t*)(ws + (e == 64 ? WS_ACTS : WS_ACT)) + (size_t)pos0 * FF + u.pn * 128 + wc * 32 + 8 * fq;
#pragma unroll
        for (int ai = 0; ai < 2; ++ai)
#pragma unroll
            for (int m = 0; m < 4; ++m) { const int r = ai * 128 + wr * 64 + m * 16 + fr;
                float o[8];
#pragma unroll
                for (int n = 0; n < 2; ++n)
#pragma unroll
                    for (int j = 0; j < 4; ++j) { const float g = acc[ai][0][m][n][j], up = acc[ai][1][m][n][j]; o[4 * n + j] = g * fast_sigmoid(g) * up; }
                u32x4 w; w.x = cvt_pk_bf16(o[0], o[1]); w.y = cvt_pk_bf16(o[2], o[3]); w.z = cvt_pk_bf16(o[4], o[5]); w.w = cvt_pk_bf16(o[6], o[7]);
                if (r < u.aux1) *(u32x4*)(base + (size_t)r * FF) = w; }
    }
};
struct MoeSched2 {
    const LAS unsigned* tab; int t0, ntiles, nsh, G, c;
    __device__ __forceinline__ bool next(int i, Unit& u) const {
        const int L = i * G + c; if (L >= nsh + 4 * ntiles) return false;
        u.pn = L & 3;
        if (L < nsh) { u.pm = L >> 2; u.aux0 = (u.pm * 256) | (64 << 20); u.aux1 = 256; }
        else { const int t = t0 + ((L - nsh) >> 2); u.pm = t; u.aux0 = __builtin_amdgcn_readfirstlane((int)tab[2 * t]); u.aux1 = __builtin_amdgcn_readfirstlane((int)tab[2 * t + 1]); }
        return true;
    }
};
struct MoeSrc2 {
    static constexpr int ESZ = 2; static constexpr bool GATHER = true;
    const unsigned char* ws;
    __device__ __forceinline__ const char* a_base(const Unit& u) const { return (const char*)ws + ((u.aux0 >> 20) == 64 ? WS_ACTS : WS_ACT); }
    __device__ __forceinline__ const char* b_base(const Unit& u) const { const int e = u.aux0 >> 20;
        const size_t off = (e == 64 ? WS_WSH2 : WS_W2T + (size_t)e * 1024 * 256 * 2) + (size_t)u.pn * 256 * 256 * 2; return (const char*)ws + off; }
    __device__ __forceinline__ unsigned a_off(const Unit& u, int R, int C) const {
        const int pos0 = u.aux0 & 0xFFFFF; const int rr = R < u.aux1 ? R : u.aux1 - 1;
        return (unsigned)(pos0 + rr) * 512u + (unsigned)C * 2u; }
};
constexpr float SLOT_SCALE = 16.0f;
constexpr int NSLOT = 9;
struct EpiMoe2 {
    static constexpr bool PERM = true;
    unsigned char* ws; float* X1; int tokbase;
    mutable int ptk[8]; mutable float pwt[8];
    __device__ __forceinline__ void prefetch(const Unit& u, int wr, int fr) const {
        const int e = u.aux0 >> 20, pos0 = u.aux0 & 0xFFFFF;
        if (e != 64) {
#pragma unroll
            for (int ai = 0; ai < 2; ++ai)
#pragma unroll
                for (int m = 0; m < 4; ++m) { const int r = ai * 128 + wr * 64 + m * 16 + fr; const int rc = r < u.aux1 ? r : u.aux1 - 1;
                    ptk[ai * 4 + m] = ((const int*)(ws + WS_STOK))[pos0 + rc]; pwt[ai * 4 + m] = ((const float*)(ws + WS_SW))[pos0 + rc]; } }
    }
    __device__ __forceinline__ void operator()(AccRef acc, const Unit& u, int wr, int wc, int fr, int fq) const {
        asm volatile("" : "+v"(fr), "+v"(fq));
        const int e = u.aux0 >> 20, pos0 = u.aux0 & 0xFFFFF; const int col0 = u.pn * 256 + wc * 32 + 8 * fq;
        if (e == 64) {
#pragma unroll
            for (int ai = 0; ai < 2; ++ai)
#pragma unroll
                for (int m = 0; m < 4; ++m) { unsigned char* rowp = (unsigned char*)(ws + WS_SLOT) + ((size_t)(pos0 + ai * 128 + wr * 64 + m * 16 + fr) * NSLOT + 8) * D + u.pn * 256 + wc * 64 + fq * 16;
                    u32x4 o;
#pragma unroll
                    for (int bj = 0; bj < 2; ++bj) { const f32x4 v0 = acc[ai][bj][m][0] * SLOT_SCALE, v1 = acc[ai][bj][m][1] * SLOT_SCALE;
                        int lo = __builtin_amdgcn_cvt_pk_fp8_f32(v0[0], v0[1], 0, false); lo = __builtin_amdgcn_cvt_pk_fp8_f32(v0[2], v0[3], lo, true);
                        int hi = __builtin_amdgcn_cvt_pk_fp8_f32(v1[0], v1[1], 0, false); hi = __builtin_amdgcn_cvt_pk_fp8_f32(v1[2], v1[3], hi, true);
                        if (bj == 0) { o.x = (unsigned)lo; o.y = (unsigned)hi; } else { o.z = (unsigned)lo; o.w = (unsigned)hi; } }
                    *(u32x4*)rowp = o;
                    asm volatile("" ::: "memory"); }
        } else {
#pragma unroll
            for (int ai = 0; ai < 2; ++ai)
#pragma unroll
                for (int m = 0; m < 4; ++m) { const int r = ai * 128 + wr * 64 + m * 16 + fr;
                    if (r < u.aux1) { const int tk = ptk[ai * 4 + m]; const float w = pwt[ai * 4 + m] * SLOT_SCALE;
                        unsigned char* rowp = (unsigned char*)(ws + WS_SLOT) + ((size_t)(tk >> 3) * NSLOT + (tk & 7)) * D + u.pn * 256 + wc * 64 + fq * 16;
                        u32x4 o;
#pragma unroll
                        for (int bj = 0; bj < 2; ++bj) { const f32x4 v0 = acc[ai][bj][m][0] * w, v1 = acc[ai][bj][m][1] * w;
                            int lo = __builtin_amdgcn_cvt_pk_fp8_f32(v0[0], v0[1], 0, false); lo = __builtin_amdgcn_cvt_pk_fp8_f32(v0[2], v0[3], lo, true);
                            int hi = __builtin_amdgcn_cvt_pk_fp8_f32(v1[0], v1[1], 0, false); hi = __builtin_amdgcn_cvt_pk_fp8_f32(v1[2], v1[3], hi, true);
                            if (bj == 0) { o.x = (unsigned)lo; o.y = (unsigned)hi; } else { o.z = (unsigned)lo; o.w = (unsigned)hi; } }
                        *(u32x4*)rowp = o; }
                    asm volatile("" ::: "memory"); }
        }
    }
};
__device__ __forceinline__ unsigned ord_key(float x) { const unsigned b = __float_as_uint(x); return (b & 0x80000000u) ? ~b : (b | 0x80000000u); }

__device__ __forceinline__ void idx_glds16(const void* gsrc, unsigned lds_dst) { unsigned keep;
    asm volatile("s_mov_b32 %0, m0\n\ts_mov_b32 m0, %2\n\ts_nop 0\n\tglobal_load_lds_dwordx4 %1, off\n\ts_mov_b32 m0, %0" : "=&s"(keep) : "v"(gsrc), "s"(lds_dst) : "memory"); }

__device__ __forceinline__ void indexer_unit(const Args& args, Frame& F, int b, int q0) {
    const bf16_t* Z = (const bf16_t*)(F.ws + WS_Z) + (size_t)b * SEQ * ZW;
    unsigned* SELM = (unsigned*)(F.ws + WS_SEL) + (size_t)b * SEQ * 128;
    int tid = F.tid; asm volatile("" : "+v"(tid));
    const int lane = tid & 63, kl = lane & 31, hl = lane >> 5, w = F.wave;
    const int qa = q0 + 2 * w;
    const int myq = qa + hl;
    bf16x8 A0, A1;
    { const int aq = (kl >> 2) & 1, ah = 4 * (kl >> 3) + (kl & 3);
      const bf16_t* p = Z + (size_t)(qa + aq) * ZW + ZIQ + ah * 32 + 8 * hl;
      A0 = *(const bf16x8*)p; A1 = *(const bf16x8*)(p + 16); }
    float wq[16];
    { const bf16_t* p = Z + (size_t)myq * ZW + ZIW; const u32x4 a = *(const u32x4*)p, c = *(const u32x4*)(p + 8);
      wq[0] = bf_lo(a.x); wq[1] = bf_hi(a.x); wq[2] = bf_lo(a.y); wq[3] = bf_hi(a.y); wq[4] = bf_lo(a.z); wq[5] = bf_hi(a.z); wq[6] = bf_lo(a.w); wq[7] = bf_hi(a.w);
      wq[8] = bf_lo(c.x); wq[9] = bf_hi(c.x); wq[10] = bf_lo(c.y); wq[11] = bf_hi(c.y); wq[12] = bf_lo(c.z); wq[13] = bf_hi(c.z); wq[14] = bf_lo(c.w); wq[15] = bf_hi(c.w); }
    unsigned key[128];
    const int nchunk = (q0 + 15) / 1024 + 1;
    const unsigned idx_lds0 = (unsigned)(uintptr_t)F.lds;
#define IDX_LOAD(ch, buf) do { _Pragma("unroll") for (int _i = 0; _i < 8; ++_i) { const int kg_ = w * 8 + _i; const int key_ = 16 * kg_ + (lane >> 2); \
        idx_glds16(Z + (size_t)((ch) * 1024 + key_) * ZW + ZIK + 8 * ((lane & 3) ^ ((key_ >> 2) & 3)), (unsigned)__builtin_amdgcn_readfirstlane((int)(idx_lds0 + (buf) * 65536 + kg_ * 1024))); } } while (0)
    IDX_LOAD(0, 0);
    asm volatile("s_waitcnt vmcnt(0)" ::: "memory");
    __syncthreads();
#pragma unroll
    for (int ch = 0; ch < 4; ++ch) {
        if (ch < nchunk) {
            if (ch + 1 < nchunk) IDX_LOAD(ch + 1, (ch + 1) & 1);
            LAS unsigned char* kbl = F.lds + (ch & 1) * 65536 + kl * 64 + ((hl ^ ((kl >> 2) & 3)) * 16); asm volatile("" : "+v"(kbl));
            LAS unsigned char* kbl2 = F.lds + (ch & 1) * 65536 + kl * 64 + (((hl + 2) ^ ((kl >> 2) & 3)) * 16); asm volatile("" : "+v"(kbl2));
#pragma unroll
            for (int tt = 0; tt < 32; tt += 2) {
                const int t = ch * 32 + tt;
                if (32 * t <= qa + 1) {
                    bf16x8 B0[2], B1[2]; f32x16 acc[2];
#pragma unroll
                    for (int j = 0; j < 2; ++j) { B0[j] = *(const LAS bf16x8*)(kbl + 2048 * (tt + j)); B1[j] = *(const LAS bf16x8*)(kbl2 + 2048 * (tt + j)); }
#pragma unroll
                    for (int j = 0; j < 2; ++j) { acc[j] = f32x16{}; acc[j] = __builtin_amdgcn_mfma_f32_32x32x16_bf16(A0, B0[j], acc[j], 0, 0, 0); }
#pragma unroll
                    for (int j = 0; j < 2; ++j) acc[j] = __builtin_amdgcn_mfma_f32_32x32x16_bf16(A1, B1[j], acc[j], 0, 0, 0);
#pragma unroll
                    for (int j = 0; j < 2; ++j) { float s = 0.f;
#pragma unroll
                        for (int i = 0; i < 16; ++i) { const float av_ = acc[j][i]; const int xb_ = __float_as_int(av_); s += __int_as_float(xb_ > 0 ? xb_ : 0) * wq[i]; }
                        key[t + j] = (32 * (t + j) + kl <= myq) ? ord_key(s) : 0u; }
                } else {
#pragma unroll
                    for (int j = 0; j < 2; ++j) key[t + j] = 0u;
                }
            }
            asm volatile("s_waitcnt vmcnt(0)" ::: "memory");
            __syncthreads();
        } else {
#pragma unroll
            for (int tt = 0; tt < 32; ++tt) key[ch * 32 + tt] = 0u;
        }
    }
#undef IDX_LOAD
#pragma unroll
    for (int w = 0; w < 4; ++w) {
        if (1024 * w <= qa + 1) {
#pragma unroll
            for (int k = 0; k < 16; ++k) { const unsigned lo = key[32 * w + k], hi_ = key[32 * w + k + 16];
                key[32 * w + k] = __builtin_amdgcn_perm(hi_, lo, 0x05040100u); key[32 * w + k + 16] = __builtin_amdgcn_perm(hi_, lo, 0x07060302u); }
#pragma unroll
            for (int k = 0; k < 32; ++k) if (!(k & 8)) { const unsigned lo = key[32 * w + k], hi_ = key[32 * w + k + 8];
                key[32 * w + k] = __builtin_amdgcn_perm(hi_, lo, 0x06020400u); key[32 * w + k + 8] = __builtin_amdgcn_perm(hi_, lo, 0x07030501u); }
#pragma unroll
            for (int k = 0; k < 32; ++k) if (!(k & 4)) { const unsigned lo = key[32 * w + k], hi_ = key[32 * w + k + 4]; const unsigned m = 0x0F0F0F0Fu;
                key[32 * w + k] = (lo & m) | ((hi_ << 4) & ~m); key[32 * w + k + 4] = ((lo >> 4) & m) | (hi_ & ~m); }
#pragma unroll
            for (int k = 0; k < 32; ++k) if (!(k & 2)) { const unsigned lo = key[32 * w + k], hi_ = key[32 * w + k + 2]; const unsigned m = 0x33333333u;
                key[32 * w + k] = (lo & m) | ((hi_ << 2) & ~m); key[32 * w + k + 2] = ((lo >> 2) & m) | (hi_ & ~m); }
#pragma unroll
            for (int k = 0; k < 32; ++k) if (!(k & 1)) { const unsigned lo = key[32 * w + k], hi_ = key[32 * w + k + 1]; const unsigned m = 0x55555555u;
                key[32 * w + k] = (lo & m) | ((hi_ << 1) & ~m); key[32 * w + k + 1] = ((lo >> 1) & m) | (hi_ & ~m); }
        }
    }
    unsigned Al[4] = {~0u, ~0u, ~0u, ~0u}, Gt[4] = {0u, 0u, 0u, 0u};
    int ab0 = 0, ab1 = 0; unsigned T0 = 0u, T1 = 0u; bool dn0 = false, dn1 = false;
#define IDX_DPP(v, ctrl) __builtin_amdgcn_update_dpp(0, (v), (ctrl), 0xF, 0xF, true)
#pragma unroll
    for (int bit = 31; bit >= 0; --bit) {
        unsigned S_[4]; int c = 0;
#pragma unroll
        for (int w = 0; w < 4; ++w) { S_[w] = Al[w] & key[32 * w + bit]; c += __builtin_popcount(S_[w]); }
        c += IDX_DPP(c, 0xB1); c += IDX_DPP(c, 0x4E); c += IDX_DPP(c, 0x141); c += IDX_DPP(c, 0x140);
        const int cn0 = ab0 + __builtin_amdgcn_readlane(c, 0) + __builtin_amdgcn_readlane(c, 16), cn1 = ab1 + __builtin_amdgcn_readlane(c, 32) + __builtin_amdgcn_readlane(c, 48);
        const bool t0 = cn0 >= 256, t1 = cn1 >= 256;
        if (t0) { T0 |= 1u << bit; dn0 = dn0 || cn0 == 256; } else ab0 = cn0;
        if (t1) { T1 |= 1u << bit; dn1 = dn1 || cn1 == 256; } else ab1 = cn1;
        const unsigned nm = hl ? (t1 ? 0u : ~0u) : (t0 ? 0u : ~0u);
#pragma unroll
        for (int w = 0; w < 4; ++w) { Al[w] &= key[32 * w + bit] ^ nm; Gt[w] |= S_[w] & nm; }
        if (dn0 && dn1) break;
    }
#undef IDX_DPP
    unsigned x[4];
    { const bool nz = hl ? (T1 != 0u) : (T0 != 0u);
#pragma unroll
      for (int w = 0; w < 4; ++w) x[w] = Gt[w] | (nz ? Al[w] : 0u); }
#define IDX_BFLY(d, m) do { const bool up_ = (kl & (d)) != 0; const unsigned km_ = up_ ? ~(m) : (m); const unsigned am_ = up_ ? (unsigned)(d) : 32u - (d); \
        _Pragma("unroll") for (int w = 0; w < 4; ++w) { const unsigned t_ = (unsigned)__builtin_amdgcn_ds_swizzle((int)x[w], 0x1F | ((d) << 10)); \
            const unsigned rot_ = __builtin_amdgcn_alignbit(t_, t_, am_); x[w] = (x[w] & km_) | (rot_ & ~km_); } } while (0)
    IDX_BFLY(16, 0x0000FFFFu); IDX_BFLY(8, 0x00FF00FFu); IDX_BFLY(4, 0x0F0F0F0Fu); IDX_BFLY(2, 0x33333333u); IDX_BFLY(1, 0x55555555u);
#undef IDX_BFLY
#pragma unroll
    for (int j = 0; j < 4; ++j) SELM[(size_t)myq * 128 + kl + 32 * j] = x[j];
}

__device__ __forceinline__ void indexer_phase(const Args& args, Frame& F) {
    const int c = blockIdx.x;
    for (int i = 0; i < 8; ++i) {
        for (int u = c + i * F.G; u < 2048 && i < 8; u += 2048) {
            const int b = u >> 8, pos = u & 255, blk = (b & 1) ? 255 - pos : pos;
            indexer_unit(args, F, b, blk * 16);
        }
    }
}
namespace att {
constexpr int DM = ZW, QB = 256, KVB = 64, SLOTB = 8192;
constexpr int NS = 4;
constexpr int L_K = 0, L_V = NS * SLOTB, L_MASK = 2 * NS * SLOTB, L_WSF = L_MASK + 8 * 2048, L_OST = L_WSF + 8 * 256, L_BT = L_OST + 8 * 4096, L_MT = L_BT + 512, L_BT4 = L_MT + 128, L_END = L_BT4 + 4 * 1280;
static_assert(L_END <= RING_BYTES, "attention LDS");
__device__ __forceinline__ int crow(int r, int hi) { return (r & 3) + 8 * (r >> 2) + 4 * hi; }
__device__ __forceinline__ void glds16(const void* gsrc, unsigned lds_dst) { unsigned keep;
    asm volatile("s_mov_b32 %0, m0\n\ts_mov_b32 m0, %2\n\ts_nop 0\n\tglobal_load_lds_dwordx4 %1, off\n\ts_mov_b32 m0, %0" : "=&s"(keep) : "v"(gsrc), "s"(lds_dst) : "memory"); }
__device__ __forceinline__ unsigned cvtpk(float lo, float hi) { return cvt_pk_bf16(lo, hi); }
typedef short s16x4 __attribute__((ext_vector_type(4)));

#ifdef PROBE_CYC
#define CYC_DECL unsigned cyc_t0_ = 0, cyc_a_ = 0; asm volatile("" : "+v"(cyc_t0_), "+v"(cyc_a_)); const bool cyc_on_ = (F.vcu == PROBE_CYC_WG) && (F.wave == PROBE_CYC_WAVE)
#define CYC_START() do { unsigned n_ = (unsigned)__builtin_readcyclecounter(); asm volatile("" : "+v"(n_)); cyc_t0_ = n_; } while (0)
#define CYC_MARK(k_) do { unsigned n_ = (unsigned)__builtin_readcyclecounter(); asm volatile("" : "+v"(n_)); if ((k_) == PROBE_CYC_SEL) cyc_a_ += n_ - cyc_t0_; cyc_t0_ = n_; } while (0)
#define CYC_FLUSH() do { if (cyc_on_ && F.lane == 0) atomicAdd(F.ctl + CW_Q + 64, cyc_a_); } while (0)
#else
#define CYC_DECL
#define CYC_START()
#define CYC_MARK(k_)
#define CYC_FLUSH()
#endif
__device__ __forceinline__ void attn_unit(const Args& args, Frame& F, int b, int h, int qb) {
    const int lane = F.lane, r32 = lane & 31, hi = lane >> 5, wid = F.wave;
    CYC_DECL;
#ifndef PROBE_ATT_VAR
#define PROBE_ATT_VAR 0
#endif
    const bool alt_ = (PROBE_ATT_VAR != 0) && (args.li == 1);
#define ALT(bit_) (alt_ && ((PROBE_ATT_VAR) & (bit_)))
    const bf16_t* Zb = (const bf16_t*)(F.ws + WS_Z) + (size_t)b * SEQ * DM;
    const int q0 = qb * QB;
    const bf16_t* Qw = Zb + (size_t)(q0 + wid * 32) * DM + ZQ + h * 64;
    const bf16_t* Kh = Zb + ZK + h * 64; const bf16_t* Vh = Zb + ZV + h * 64;
    LAS unsigned char* shm = F.lds;
    const unsigned lds0 = (unsigned)(uintptr_t)shm;
    LAS float* wsf = (LAS float*)(shm + L_WSF) + wid * 64;
    LAS float* bt = (LAS float*)(shm + L_BT);
    if (F.tid >= 128 && F.tid < 144) { const unsigned n = F.tid - 128;
        *(LAS u32x2*)(shm + L_MT + 8 * n) = (u32x2){((n & 1u) ? 0xFFFFu : 0u) | ((n & 2u) ? 0xFFFF0000u : 0u), ((n & 4u) ? 0xFFFFu : 0u) | ((n & 8u) ? 0xFFFF0000u : 0u)}; }
    if (F.tid < 128) { const int rel = F.tid; int bk;
        if (rel < 16) bk = rel; else { bk = 16 + (int)(logf((float)rel / 16.0f) / logf(8.0f) * 16.0f); bk = bk < 31 ? bk : 31; }
        bt[rel] = (AIN(6)[bk * 8 + h] - AIN(6)[31 * 8 + h]) * 1.4426950408889634f; }
    for (int e = F.tid; e < 4 * 320; e += NTHR) { const int s_ = e / 320, i_ = e - 320 * s_; int rel = i_ - 96 + s_; rel = rel < 0 ? 0 : (rel > 127 ? 127 : rel); int bk;
        if (rel < 16) bk = rel; else { bk = 16 + (int)(logf((float)rel / 16.0f) / logf(8.0f) * 16.0f); bk = bk < 31 ? bk : 31; }
        ((LAS float*)(shm + L_BT4))[e] = (AIN(6)[bk * 8 + h] - AIN(6)[31 * 8 + h]) * 1.4426950408889634f; }
    const bf16_t* ksrc = Kh + (size_t)lane * DM + wid * 8;
    const bf16_t* vsrc = Vh + (size_t)(16 * (wid & 3) + (lane >> 2)) * DM + (wid >> 2) * 32 + (lane & 3) * 8;
    const unsigned kdst = lds0 + L_K + wid * 1024, vdst = lds0 + L_V + wid * 1024;
    const unsigned* SELM = (const unsigned*)(F.ws + WS_SEL) + (size_t)(b * SEQ + q0 + wid * 32 + r32) * 128 + 4 * hi;
    const unsigned mdst = lds0 + L_MASK + wid * 2048;
#define DMA_K(t, slot) glds16(ksrc + (size_t)(t) * KVB * DM, (unsigned)__builtin_amdgcn_readfirstlane(kdst + (slot) * SLOTB))
#define DMA_V(t, slot) glds16(vsrc + (size_t)(t) * KVB * DM, (unsigned)__builtin_amdgcn_readfirstlane(vdst + (slot) * SLOTB))
#define DMA_M(g) glds16(SELM + 8 * (g), (unsigned)__builtin_amdgcn_readfirstlane(mdst + ((g) & 1) * 1024))
    const int NT = ALT(1024) ? 4 : (q0 + QB) / KVB;
    bf16x8 qr[4];
#pragma unroll
    for (int d0 = 0; d0 < 4; ++d0) qr[d0] = *(const bf16x8*)(Qw + (size_t)r32 * DM + d0 * 16 + hi * 8);
    asm volatile("s_waitcnt vmcnt(0)" ::: "memory");
    __syncthreads();
    DMA_M(0); DMA_K(0, 0); DMA_K(1, 1); DMA_V(0, 0); DMA_K(2, 2); DMA_V(1, 1); DMA_K(3, 3); DMA_V(2, 2);
    float m_run = 0.f; f32x16 o[2], lacc = f32x16{}; o[0] = f32x16{}; o[1] = f32x16{};
    const bf16x8 ones8 = __builtin_bit_cast(bf16x8, (u32x4){0x3F803F80u, 0x3F803F80u, 0x3F803F80u, 0x3F803F80u});
    const int qpos = q0 + wid * 32 + r32;
    const int vb0 = (int)(lds0 + L_V) + ((lane >> 4) & 1) * 32 + (lane & 3) * 8 + (4 * hi + ((lane & 15) >> 2)) * 64;
#define QK_TILE(P0, P1, slot_) do { const LAS unsigned char* kb = shm + L_K + (slot_) * SLOTB + hi * 1024 + r32 * 16; P0 = f32x16{}; P1 = f32x16{}; \
        _Pragma("unroll") for (int d0 = 0; d0 < 4; ++d0) { const bf16x8 b0 = *(const LAS bf16x8*)(kb + d0 * 2048); const bf16x8 b1 = *(const LAS bf16x8*)(kb + d0 * 2048 + 512); \
            P0 = __builtin_amdgcn_mfma_f32_32x32x16_bf16(b0, qr[d0], P0, 0, 0, 0); P1 = __builtin_amdgcn_mfma_f32_32x32x16_bf16(b1, qr[d0], P1, 0, 0, 0); } } while (0)
    f32x16 pa0, pa1, pb0, pb1;
    asm volatile("s_waitcnt vmcnt(6)" ::: "memory");
    __builtin_amdgcn_s_barrier(); asm volatile("" ::: "memory");
    QK_TILE(pa0, pa1, 0);
#define ATT_WAITV(n_) do { const int nn_ = (n_); if (nn_ >= 4) asm volatile("s_waitcnt vmcnt(4)" ::: "memory"); else if (nn_ == 3) asm volatile("s_waitcnt vmcnt(3)" ::: "memory"); \
        else if (nn_ == 2) asm volatile("s_waitcnt vmcnt(2)" ::: "memory"); else if (nn_ == 1) asm volatile("s_waitcnt vmcnt(1)" ::: "memory"); else asm volatile("s_waitcnt vmcnt(0)" ::: "memory"); } while (0)
    asm volatile("s_waitcnt lgkmcnt(0)" ::: "memory");
    if (wid >= 4) { __builtin_amdgcn_s_barrier(); asm volatile("" ::: "memory"); }
    auto step = [&](const int t, f32x16& C0, f32x16& C1, f32x16& N0, f32x16& N1) __attribute__((always_inline)) {
        const int slot = t & (NS - 1), g = t >> 2, tq = t & 3;
        CYC_START();
        if (!ALT(32)) ATT_WAITV((t + 1 < NT) + 2 * (t + 2 < NT) + (t + 3 < NT));
        if (!ALT(16)) __builtin_amdgcn_s_barrier(); asm volatile("" ::: "memory");
        CYC_MARK(0);
        if (t + 4 < NT && !ALT(32)) DMA_K(t + 4, (t + 4) & (NS - 1));
        if (tq == 0 && !ALT(32)) DMA_M(g + 1);
        if (t + 1 < NT) { if (ALT(4)) { N0 = f32x16{}; N1 = f32x16{}; } else QK_TILE(N0, N1, (t + 1) & (NS - 1)); }
        __builtin_amdgcn_sched_barrier(0);
        const u32x2 mwv = *(const LAS u32x2*)(shm + L_MASK + wid * 2048 + (g & 1) * 1024 + (tq >> 1) * 512 + r32 * 16 + (tq & 1) * 8);
        if (64 * t + 63 + 112 >= q0 + wid * 32 && 64 * t <= q0 + wid * 32 + 31 && !ALT(256)) {
            const int ib_ = qpos - 64 * t - 4 * hi - 3 + 96;
#pragma unroll
            for (int g4 = 0; g4 < 4; ++g4) { const int i0 = ib_ - 8 * g4, i1 = i0 - 32;
                const f32x4 e0 = *(const LAS f32x4*)(shm + L_BT4 + (i0 & 3) * 1280 + (i0 & ~3) * 4), e1 = *(const LAS f32x4*)(shm + L_BT4 + (i1 & 3) * 1280 + (i1 & ~3) * 4);
                C0[4 * g4 + 3] += e0.x; C0[4 * g4 + 2] += e0.y; C0[4 * g4 + 1] += e0.z; C0[4 * g4] += e0.w;
                C1[4 * g4 + 3] += e1.x; C1[4 * g4 + 2] += e1.y; C1[4 * g4 + 1] += e1.z; C1[4 * g4] += e1.w; }
        }
        if (!ALT(128)) {
        typedef float f32x2_ __attribute__((ext_vector_type(2)));
        { const f32x2_ mm = {m_run, m_run};
#pragma unroll
          for (int r = 0; r < 16; r += 2) { f32x2_ a = {C0[r], C0[r + 1]}, c = {C1[r], C1[r + 1]}; a -= mm; c -= mm; C0[r] = a.x; C0[r + 1] = a.y; C1[r] = c.x; C1[r + 1] = c.y; } }
        float rm = __builtin_fmaxf(C0[0], C1[0]);
#pragma unroll
        for (int r = 1; r < 16; ++r) rm = __builtin_fmaxf(rm, __builtin_fmaxf(C0[r], C1[r]));
        if (t == 0 || __builtin_amdgcn_ballot_w64(rm > 8.0f) != 0ull) {
            rm = __builtin_fmaxf(rm, __shfl_xor(rm, 32));
            const float dm = t == 0 ? rm : __builtin_fmaxf(rm, 0.f);
            const float f = t == 0 ? 1.0f : __builtin_amdgcn_exp2f(-dm);
            m_run += dm;
#pragma unroll
            for (int r = 0; r < 16; ++r) { C0[r] -= dm; C1[r] -= dm; }
            if (hi == 0) wsf[r32] = f;
            asm volatile("s_waitcnt lgkmcnt(0)" ::: "memory");
#pragma unroll
            for (int r = 0; r < 16; ++r) { const float fr_ = wsf[crow(r, hi)]; o[0][r] *= fr_; o[1][r] *= fr_; lacc[r] *= fr_; }
        }
        }
        if (!ALT(2)) {
#pragma unroll
        for (int r = 0; r < 16; ++r) { C0[r] = __builtin_amdgcn_exp2f(C0[r]); C1[r] = __builtin_amdgcn_exp2f(C1[r]); } }
        asm volatile("s_waitcnt lgkmcnt(0)" ::: "memory");
        CYC_MARK(1);
        if (!ALT(32)) ATT_WAITV((t + 1 < NT) + (t + 2 < NT) + (t + 3 < NT) + (t + 4 < NT));
        if (!ALT(16)) __builtin_amdgcn_s_barrier(); asm volatile("" ::: "memory");
        CYC_MARK(2);
        if (t + 3 < NT && !ALT(32)) DMA_V(t + 3, (t + 3) & (NS - 1));
        u32x4 pw0, pw1, pw2, pw3;
        pw0 = (u32x4){cvtpk(C0[0], C0[1]), cvtpk(C0[2], C0[3]), cvtpk(C0[4], C0[5]), cvtpk(C0[6], C0[7])};
        pw1 = (u32x4){cvtpk(C0[8], C0[9]), cvtpk(C0[10], C0[11]), cvtpk(C0[12], C0[13]), cvtpk(C0[14], C0[15])};
        pw2 = (u32x4){cvtpk(C1[0], C1[1]), cvtpk(C1[2], C1[3]), cvtpk(C1[4], C1[5]), cvtpk(C1[6], C1[7])};
        pw3 = (u32x4){cvtpk(C1[8], C1[9]), cvtpk(C1[10], C1[11]), cvtpk(C1[12], C1[13]), cvtpk(C1[14], C1[15])};
        if (!ALT(64))
        { const unsigned mx_ = mwv.x >> (4 * hi), my_ = mwv.y >> (4 * hi); const LAS unsigned char* mt = shm + L_MT;
          const u32x2 a0 = *(const LAS u32x2*)(mt + ((mx_ << 3) & 0x78u)), a1 = *(const LAS u32x2*)(mt + ((mx_ >> 5) & 0x78u)), a2 = *(const LAS u32x2*)(mt + ((mx_ >> 13) & 0x78u)), a3 = *(const LAS u32x2*)(mt + ((mx_ >> 21) & 0x78u));
          const u32x2 b0 = *(const LAS u32x2*)(mt + ((my_ << 3) & 0x78u)), b1 = *(const LAS u32x2*)(mt + ((my_ >> 5) & 0x78u)), b2 = *(const LAS u32x2*)(mt + ((my_ >> 13) & 0x78u)), b3 = *(const LAS u32x2*)(mt + ((my_ >> 21) & 0x78u));
          pw0.x &= a0.x; pw0.y &= a0.y; pw0.z &= a1.x; pw0.w &= a1.y; pw1.x &= a2.x; pw1.y &= a2.y; pw1.z &= a3.x; pw1.w &= a3.y;
          pw2.x &= b0.x; pw2.y &= b0.y; pw2.z &= b1.x; pw2.w &= b1.y; pw3.x &= b2.x; pw3.y &= b2.y; pw3.z &= b3.x; pw3.w &= b3.y; }
        if (!ALT(8)) {
        lacc = __builtin_amdgcn_mfma_f32_32x32x16_bf16(__builtin_bit_cast(bf16x8, pw0), ones8, lacc, 0, 0, 0); lacc = __builtin_amdgcn_mfma_f32_32x32x16_bf16(__builtin_bit_cast(bf16x8, pw1), ones8, lacc, 0, 0, 0);
        lacc = __builtin_amdgcn_mfma_f32_32x32x16_bf16(__builtin_bit_cast(bf16x8, pw2), ones8, lacc, 0, 0, 0); lacc = __builtin_amdgcn_mfma_f32_32x32x16_bf16(__builtin_bit_cast(bf16x8, pw3), ones8, lacc, 0, 0, 0);
        { const int vb = vb0 + slot * SLOTB;
#pragma unroll
          for (int d0 = 0; d0 < 2; ++d0) { s16x4 lo[4], hh[4];
#pragma unroll
              for (int ks = 0; ks < 4; ++ks) {
                  asm volatile("ds_read_b64_tr_b16 %0,%1 offset:%c2" : "=&v"(lo[ks]) : "v"(vb), "i"(d0 * 4096 + ks * 1024) : "memory");
                  asm volatile("ds_read_b64_tr_b16 %0,%1 offset:%c2" : "=&v"(hh[ks]) : "v"(vb), "i"(d0 * 4096 + ks * 1024 + 512) : "memory"); }
              asm volatile("s_waitcnt lgkmcnt(0)" ::: "memory"); __builtin_amdgcn_sched_barrier(0);
#define PKV(k) (bf16x8){lo[k][0], lo[k][1], lo[k][2], lo[k][3], hh[k][0], hh[k][1], hh[k][2], hh[k][3]}
              o[d0] = __builtin_amdgcn_mfma_f32_32x32x16_bf16(__builtin_bit_cast(bf16x8, pw0), PKV(0), o[d0], 0, 0, 0);
              o[d0] = __builtin_amdgcn_mfma_f32_32x32x16_bf16(__builtin_bit_cast(bf16x8, pw1), PKV(1), o[d0], 0, 0, 0);
              o[d0] = __builtin_amdgcn_mfma_f32_32x32x16_bf16(__builtin_bit_cast(bf16x8, pw2), PKV(2), o[d0], 0, 0, 0);
              o[d0] = __builtin_amdgcn_mfma_f32_32x32x16_bf16(__builtin_bit_cast(bf16x8, pw3), PKV(3), o[d0], 0, 0, 0);
#undef PKV
          } }
        }
        asm volatile("s_waitcnt lgkmcnt(0)" ::: "memory");
        CYC_MARK(3);
    };
    for (int t = 0; t < NT; t += 2) { step(t, pa0, pa1, pb0, pb1); step(t + 1, pb0, pb1, pa0, pa1); }
    if (wid < 4) { __builtin_amdgcn_s_barrier(); asm volatile("" ::: "memory"); }
#undef QK_TILE
#undef ATT_WAITV
    CYC_FLUSH();
    bf16_t* Ow = (bf16_t*)(F.ws + (alt_ ? WS_R2 : WS_R1)) + (size_t)(b * SEQ + q0 + wid * 32) * 512 + h * 64;
    { LAS bf16_t* stg = (LAS bf16_t*)(shm + L_OST) + wid * 2048;
#pragma unroll
      for (int r = 0; r < 16; ++r) { const int orow = crow(r, hi); const float rl = __builtin_amdgcn_rcpf(lacc[r]);
#pragma unroll
          for (int d0 = 0; d0 < 2; ++d0) stg[orow * 64 + d0 * 32 + r32] = (bf16_t)f2bf(o[d0][r] * rl); }
      asm volatile("s_waitcnt lgkmcnt(0)" ::: "memory");
#pragma unroll
      for (int i = 0; i < 4; ++i) { const int row = i * 8 + (lane >> 3), chn = lane & 7; const u32x4 v = *(const LAS u32x4*)(stg + row * 64 + chn * 8); *(u32x4*)(Ow + (size_t)row * 512 + chn * 8) = v; } }
    asm volatile("s_waitcnt lgkmcnt(0)" ::: "memory");
#undef DMA_K
#undef DMA_V
#undef DMA_M
}

__device__ __forceinline__ void attn_phase(const Args& args, Frame& F) {
    const int v = F.vcu;
    for (int i = 0; i < 4; ++i) {
        for (int uu = v; uu < 256; uu += F.G) {
            const int bh = uu >> 2, s = uu & 3; const int qb = (i == 0) ? s : (i == 1) ? 7 - s : (i == 2) ? 8 + s : 15 - s;
            attn_unit(args, F, bh >> 3, bh & 7, qb);
        }
    }
}
}
#ifndef PROBE_NO_STATE
#define PROBE_NO_STATE 0
#endif
#ifndef PROBE_TINV_ID
#define PROBE_TINV_ID 0
#endif
namespace rk {
typedef __bf16 bf16x2_t __attribute__((ext_vector_type(2)));
__device__ __forceinline__ unsigned cvtpk(float lo, float hi) { f32x2 v = {lo, hi}; bf16x2_t b = __builtin_convertvector(v, bf16x2_t); return __builtin_bit_cast(unsigned, b); }
template <int S> __device__ __forceinline__ bf16x8 frag(const f32x16& x) {
    u32x4 o; o.x = cvtpk(x[8 * S + 0], x[8 * S + 1]); o.y = cvtpk(x[8 * S + 2], x[8 * S + 3]); o.z = cvtpk(x[8 * S + 4], x[8 * S + 5]); o.w = cvtpk(x[8 * S + 6], x[8 * S + 7]);
    return __builtin_bit_cast(bf16x8, o); }
template <int S> __device__ __forceinline__ void unfrag(f32x16& x, bf16x8 f) { const u32x4 o = __builtin_bit_cast(u32x4, f);
    x[8 * S + 0] = bf_lo(o.x); x[8 * S + 1] = bf_hi(o.x); x[8 * S + 2] = bf_lo(o.y); x[8 * S + 3] = bf_hi(o.y); x[8 * S + 4] = bf_lo(o.z); x[8 * S + 5] = bf_hi(o.z); x[8 * S + 6] = bf_lo(o.w); x[8 * S + 7] = bf_hi(o.w); }
#define RK_MF(a, b, c) __builtin_amdgcn_mfma_f32_32x32x16_bf16((a), (b), (c), 0, 0, 0)
__device__ __forceinline__ float dppf(float v, const int ctrl_is_const_dummy);
#define RK_DPP(v, ctrl, rmask, bc) __builtin_bit_cast(float, __builtin_amdgcn_update_dpp(0, __builtin_bit_cast(int, (v)), (ctrl), (rmask), 0xF, (bc)))
__device__ __forceinline__ float scan32(float v) {
#ifdef PROBE_SHFL_SCAN
    const int l32 = threadIdx.x & 31;
#pragma unroll
    for (int o = 1; o < 32; o <<= 1) { const float t = __shfl_up(v, o, 32); if (l32 >= o) v += t; }
    return v;
#endif
    v += RK_DPP(v, 0x111, 0xF, true); v += RK_DPP(v, 0x112, 0xF, true); v += RK_DPP(v, 0x114, 0xF, true); v += RK_DPP(v, 0x118, 0xF, true);
    v += RK_DPP(v, 0x142, 0xA, false);
    return v; }
__device__ __forceinline__ float ex2(float x) { return __builtin_amdgcn_exp2f(x); }
constexpr int PZ = 3600;
constexpr size_t SZ_G = 8192, SZ_H = 8192, SZ_Q = 4096, SZ_Y = 4096;
constexpr float L2E = 1.4426950408889634f;

__device__ __forceinline__ void mk_id(bf16x8 (&fId)[2], int r, int h) {
    asm volatile("" : "+v"(r), "+v"(h));
#pragma unroll
    for (int s = 0; s < 2; ++s) { unsigned short e8[8];
#pragma unroll
        for (int jj = 0; jj < 8; ++jj) e8[jj] = (16 * s + 8 * (jj >> 2) + 4 * h + (jj & 3) == r) ? (unsigned short)0x3F80 : (unsigned short)0;
        fId[s] = __builtin_bit_cast(bf16x8, (u32x4){(unsigned)e8[0] | ((unsigned)e8[1] << 16), (unsigned)e8[2] | ((unsigned)e8[3] << 16), (unsigned)e8[4] | ((unsigned)e8[5] << 16), (unsigned)e8[6] | ((unsigned)e8[7] << 16)}); }
}

__device__ __forceinline__ void load_params(const Args& args, Frame& F) {
    LAS float* pra = (LAS float*)(F.lds + LDS_PARA); LAS float* prb = (LAS float*)(F.lds + LDS_PARB);
    const float* mu = AIN(7); const float* w0 = AIN(8); const float* a0 = AIN(10); const float* kk = AIN(13); const float* ka = AIN(14); const float* rk = AIN(15);
    for (int i = F.tid; i < 4096; i += NTHR) { const int a = i >> 9, c = i & 511;
        const float v_ = a < 3 ? mu[a * 512 + c] : (a == 3 ? w0[c] : (a == 4 ? a0[c] : (a == 5 ? kk[c] : (a == 6 ? ka[c] : rk[c]))));
        if (a < 4) pra[c * 4 + a] = v_; else prb[c * 4 + a - 4] = v_; }
    __syncthreads();
}
struct ElemCtx { const LAS unsigned char* rowc; const LAS unsigned char* rowp; const bf16_t* DUt; const bf16_t* IUt; const LAS float* pra; const LAS float* prb; int hd, r, h; float inv; };
template <int MODE> __device__ __forceinline__ void r1_elem(const ElemCtx& C, int jt, bf16x8 (&o0)[2], bf16x8 (&o1)[2], bf16x8 (&o2)[2], bf16x8 (&o3)[2], float& bns, float& pcd) {
    const int r = C.r, h = C.h, hd = C.hd;
    f32x16 lw_ = f32x16{}, la_ = f32x16{};
#pragma unroll
    for (int ks = 0; ks < 4; ++ks) { const int k0 = 16 * ks + 8 * h;
        const bf16x8 bw = *(const LAS bf16x8*)(C.rowc + (1536 + k0) * 2), ba = *(const LAS bf16x8*)(C.rowc + (1600 + k0) * 2);
        const bf16x8 fa = *(const bf16x8*)(C.DUt + (size_t)(32 * jt + r) * 64 + k0), fi = *(const bf16x8*)(C.IUt + (size_t)(32 * jt + r) * 64 + k0);
        lw_ = RK_MF(fa, bw, lw_); la_ = RK_MF(fi, ba, la_); }
    float d = 0.f;
#pragma unroll
    for (int s = 0; s < 2; ++s) { float x0[8], x1[8], x2[8], x3[8];
#pragma unroll
        for (int g2 = 0; g2 < 2; ++g2) { const int g = 2 * s + g2, cj = hd * 64 + 32 * jt + 8 * g + 4 * h;
            float kc[4], kq[4], xc[4], xq[4];
            { const u32x2 a = *(const LAS u32x2*)(C.rowc + (512 + cj) * 2), p = *(const LAS u32x2*)(C.rowp + (512 + cj) * 2);
              kc[0] = bf_lo(a.x); kc[1] = bf_hi(a.x); kc[2] = bf_lo(a.y); kc[3] = bf_hi(a.y); kq[0] = bf_lo(p.x); kq[1] = bf_hi(p.x); kq[2] = bf_lo(p.y); kq[3] = bf_hi(p.y); }
            { const int xo = MODE ? 1024 : 0; const u32x2 a = *(const LAS u32x2*)(C.rowc + (xo + cj) * 2), p = *(const LAS u32x2*)(C.rowp + (xo + cj) * 2);
              xc[0] = bf_lo(a.x); xc[1] = bf_hi(a.x); xc[2] = bf_lo(a.y); xc[3] = bf_hi(a.y); xq[0] = bf_lo(p.x); xq[1] = bf_hi(p.x); xq[2] = bf_lo(p.y); xq[3] = bf_hi(p.y); }
            const LAS f32x4* ppa = (const LAS f32x4*)(C.pra + cj * 4); const LAS f32x4* ppb = (const LAS f32x4*)(C.prb + cj * 4);
#pragma unroll
            for (int q = 0; q < 4; ++q) { const int i = 4 * g + q, o = 4 * g2 + q;
                const f32x4 pa = ppa[q], pb = ppb[q];
                const float e_ = 0.6065306597126334f * fast_sigmoid(pa[3] + lw_[i]); const float L = scan32(e_);
                const float l0 = __builtin_bit_cast(float, __builtin_amdgcn_readlane(__builtin_bit_cast(int, L), 31)), l1 = __builtin_bit_cast(float, __builtin_amdgcn_readlane(__builtin_bit_cast(int, L), 63));
                const float Lend = h ? l1 : l0; if (i == 4 * (r >> 3) + (r & 3)) d = Lend;
                const float x_ = xc[q] + (MODE ? pa[2] : pa[0]) * (xq[q] - xc[q]), k_ = kc[q] + pa[1] * (kq[q] - kc[q]);
                const float ic = fast_sigmoid(pb[0] + la_[i]);
                const float kk = k_ * pb[1] * C.inv, kpn = k_ * (1.0f + (ic - 1.0f) * pb[2]), bv = kk * ic;
                if (MODE) { const float Qe = ex2(L2E * (L - Lend)); x0[o] = bv * Qe; x1[o] = kpn * Qe; x2[o] = x_; x3[o] = 0.f; }
                else { const float P = ex2(-L2E * L), Pi = ex2(L2E * L), Pm = ex2(-L2E * (L - e_)); bns += x_ * kpn * pb[3]; x0[o] = -kk * Pm; x1[o] = x_ * P; x2[o] = bv * Pi; x3[o] = kpn * Pi; } }
            asm volatile("" ::: "memory"); }
        o0[s] = __builtin_bit_cast(bf16x8, (u32x4){cvtpk(x0[0], x0[1]), cvtpk(x0[2], x0[3]), cvtpk(x0[4], x0[5]), cvtpk(x0[6], x0[7])});
        o1[s] = __builtin_bit_cast(bf16x8, (u32x4){cvtpk(x1[0], x1[1]), cvtpk(x1[2], x1[3]), cvtpk(x1[4], x1[5]), cvtpk(x1[6], x1[7])});
        o2[s] = __builtin_bit_cast(bf16x8, (u32x4){cvtpk(x2[0], x2[1]), cvtpk(x2[2], x2[3]), cvtpk(x2[4], x2[5]), cvtpk(x2[6], x2[7])});
        if (!MODE) o3[s] = __builtin_bit_cast(bf16x8, (u32x4){cvtpk(x3[0], x3[1]), cvtpk(x3[2], x3[3]), cvtpk(x3[4], x3[5]), cvtpk(x3[6], x3[7])}); }
    if (MODE) pcd = ex2(-L2E * d);
}


__device__ __forceinline__ void r1_unit(const Args& args, Frame& F, int b, int c) {
    LAS unsigned char* IMG = F.lds;
    const bf16_t* Z = (const bf16_t*)(F.ws + WS_Z);
    const int t0 = 32 * c; const size_t m0 = (size_t)b * SEQ + t0;
    const float* mu = AIN(7);
    int tid = F.tid; asm volatile("" : "+v"(tid));
    __syncthreads();
    { const unsigned lds0 = (unsigned)(uintptr_t)IMG; const int ln = tid & 63;
      for (int task = F.wave; task < 33 * 4; task += NWAVES) { const int rr = task >> 2, j = task & 3, pc = 64 * j + ln;
          if (pc < 224) { if (rr > 0 || t0 > 0) att::glds16(Z + (m0 + rr - 1) * ZW + ZR + 8 * pc, (unsigned)__builtin_amdgcn_readfirstlane((int)(lds0 + rr * PZ + 1024 * j)));
                          else *(LAS u32x4*)(IMG + 16 * pc) = (u32x4){0u, 0u, 0u, 0u}; } }
      asm volatile("s_waitcnt vmcnt(0)" ::: "memory"); }
    __syncthreads();
    { u32x4 actv[2];
#pragma unroll
      for (int i = 0; i < 2; ++i) { const int q = tid + NTHR * i, t = q >> 5, kp = q & 31;
          const u32x4 cw = *(const LAS u32x4*)(IMG + (t + 1) * PZ + (1536 + 8 * kp) * 2), pw = *(const LAS u32x4*)(IMG + t * PZ + (1536 + 8 * kp) * 2);
          const f32x4 m0v = *(const f32x4*)(mu + 1536 + 8 * kp), m1v = *(const f32x4*)(mu + 1536 + 8 * kp + 4);
          const unsigned cwa[4] = {cw.x, cw.y, cw.z, cw.w}, pwa[4] = {pw.x, pw.y, pw.z, pw.w}; float x[8];
#pragma unroll
          for (int j = 0; j < 4; ++j) { const float c0 = bf_lo(cwa[j]), c1 = bf_hi(cwa[j]), p0 = bf_lo(pwa[j]), p1 = bf_hi(pwa[j]);
              const float mu0 = j < 2 ? m0v[2 * j] : m1v[2 * j - 4], mu1 = j < 2 ? m0v[2 * j + 1] : m1v[2 * j - 3];
              x[2 * j] = c0 + mu0 * (p0 - c0); x[2 * j + 1] = c1 + mu1 * (p1 - c1); }
#pragma unroll
          for (int j = 0; j < 8; ++j) { if (kp < 8) { const float e2 = ex2(2.885390081777927f * x[j]); x[j] = 1.0f - 2.0f * __builtin_amdgcn_rcpf(e2 + 1.0f); } else if (kp >= 16) x[j] = fast_sigmoid(x[j]); }
          actv[i] = (u32x4){cvtpk(x[0], x[1]), cvtpk(x[2], x[3]), cvtpk(x[4], x[5]), cvtpk(x[6], x[7])}; }
      __syncthreads();
#pragma unroll
      for (int i = 0; i < 2; ++i) { const int q = tid + NTHR * i, t = q >> 5, kp = q & 31; *(LAS u32x4*)(IMG + (t + 1) * PZ + (1536 + 8 * kp) * 2) = actv[i]; }
      __syncthreads(); }
    const int hd = F.wave; int r = tid & 31, h = (tid >> 5) & 1;
    const LAS unsigned char* rowc = IMG + (r + 1) * PZ; const LAS unsigned char* rowp = IMG + r * PZ;
    const bf16_t* DUt = (const bf16_t*)(F.ws + WS_DUT) + (size_t)hd * 4096; const bf16_t* IUt = (const bf16_t*)(F.ws + WS_IUT) + (size_t)hd * 4096;
    const LAS float* pra = (const LAS float*)(F.lds + LDS_PARA); const LAS float* prb = (const LAS float*)(F.lds + LDS_PARB);
    float n2 = 0.f;
#pragma unroll
    for (int jt = 0; jt < 2; ++jt)
#pragma unroll
        for (int g = 0; g < 4; ++g) { const int cj = hd * 64 + 32 * jt + 8 * g + 4 * h;
            const u32x2 a = *(const LAS u32x2*)(rowc + (512 + cj) * 2), p = *(const LAS u32x2*)(rowp + (512 + cj) * 2);
            const float kc[4] = {bf_lo(a.x), bf_hi(a.x), bf_lo(a.y), bf_hi(a.y)}, kq[4] = {bf_lo(p.x), bf_hi(p.x), bf_lo(p.y), bf_hi(p.y)};
            #pragma unroll
            for (int q = 0; q < 4; ++q) { const float muk = pra[(cj + q) * 4 + 1], kkp = prb[(cj + q) * 4 + 1]; const float k_ = kc[q] + muk * (kq[q] - kc[q]); const float kk_ = k_ * kkp; n2 += kk_ * kk_; } }
    n2 += __shfl_xor(n2, 32);
    const float inv = 1.0f / __builtin_fmaxf(sqrtf(n2), 1e-12f);
    float pcd[2] = {0.f, 0.f};
    float bns = 0.f;
    const ElemCtx EC{rowc, rowp, DUt, IUt, pra, prb, hd, r, h, inv};
    f32x16 Aab = f32x16{}, Aak = f32x16{}, Arb = f32x16{}, Ark = f32x16{};
    bf16x8 fRt[2][2], tAt[2][2];
    { bf16x8 fId[2]; mk_id(fId, r, h);
#pragma unroll
    for (int jt = 0; jt < 2; ++jt) { bf16x8 fA[2], fB[2], fK[2]; float pd_ = 0.f;
        r1_elem<0>(EC, jt, fA, fRt[jt], fB, fK, bns, pd_);
        const bf16x8 fA0 = fA[0], fA1 = fA[1], fB0 = fB[0], fB1 = fB[1], fK0 = fK[0], fK1 = fK[1];
        Aab = RK_MF(fB0, fA0, Aab); Aab = RK_MF(fB1, fA1, Aab); Aak = RK_MF(fK0, fA0, Aak); Aak = RK_MF(fK1, fA1, Aak);
        Arb = RK_MF(fB0, fRt[jt][0], Arb); Arb = RK_MF(fB1, fRt[jt][1], Arb); Ark = RK_MF(fK0, fRt[jt][0], Ark); Ark = RK_MF(fK1, fRt[jt][1], Ark);
        { f32x16 t_ = f32x16{}; t_ = RK_MF(fA0, fId[0], t_); t_ = RK_MF(fA1, fId[1], t_); tAt[jt][0] = frag<0>(t_); tAt[jt][1] = frag<1>(t_); } } }
    bns += __shfl_xor(bns, 32);
    if (h == 0) ((float*)(F.ws + WS_TOPW))[(m0 + r) * 8 + hd] = bns;
    LAS unsigned char* stash = IMG + (1 + ((tid & 63) >> 3)) * PZ + hd * 128 + (tid & 7) * 16;
#pragma unroll
    for (int p = 0; p < 4; ++p) *(LAS u32x4*)(stash + 8 * p * PZ) = __builtin_bit_cast(u32x4, fRt[p >> 1][p & 1]);
#pragma unroll
    for (int i = 0; i < 16; ++i) { const int s = 8 * (i >> 2) + 4 * h + (i & 3);
        if (!(s < r)) { Aab[i] = 0.f; Aak[i] = 0.f; } if (!(s <= r)) { Arb[i] = 0.f; Ark[i] = 0.f; } }
    const bf16x8 fAak[2] = {frag<0>(Aak), frag<1>(Aak)}, fArb[2] = {frag<0>(Arb), frag<1>(Arb)}, fArk[2] = {frag<0>(Ark), frag<1>(Ark)};
    bf16x8 fT[2];
    asm volatile("" ::: "memory"); __builtin_amdgcn_sched_barrier(0);
    { float T[32];
#pragma unroll
      for (int s = 0; s < 32; ++s) T[s] = (r == s) ? 1.0f : 0.f;
#define TI_RL(k_, is_, ln_) { const float ac_ = Aab[is_]; asm volatile("v_readlane_b32 %0, %1, " #ln_ : "=s"(sv_[k_]) : "v"(__float_as_int(ac_))); }
#define TI_FM(s_, u_, k_) T[s_] = __builtin_fmaf(T[u_], __int_as_float(sv_[k_]), T[s_]);
      if (!PROBE_TINV_ID) { int sv_[8];
        TI_RL(0, 0, 31) TI_RL(1, 1, 31) TI_RL(2, 2, 31) TI_RL(3, 3, 31) TI_RL(4, 0, 63) TI_RL(5, 1, 63) TI_RL(6, 2, 63) TI_RL(7, 3, 63)
        TI_FM(0, 31, 0) TI_FM(1, 31, 1) TI_FM(2, 31, 2) TI_FM(3, 31, 3) TI_FM(4, 31, 4) TI_FM(5, 31, 5) TI_FM(6, 31, 6) TI_FM(7, 31, 7)
        TI_RL(0, 4, 31) TI_RL(1, 5, 31) TI_RL(2, 6, 31) TI_RL(3, 7, 31) TI_RL(4, 4, 63) TI_RL(5, 5, 63) TI_RL(6, 6, 63) TI_RL(7, 7, 63)
        TI_FM(8, 31, 0) TI_FM(9, 31, 1) TI_FM(10, 31, 2) TI_FM(11, 31, 3) TI_FM(12, 31, 4) TI_FM(13, 31, 5) TI_FM(14, 31, 6) TI_FM(15, 31, 7)
        TI_RL(0, 8, 31) TI_RL(1, 9, 31) TI_RL(2, 10, 31) TI_RL(3, 11, 31) TI_RL(4, 8, 63) TI_RL(5, 9, 63) TI_RL(6, 10, 63) TI_RL(7, 11, 63)
        TI_FM(16, 31, 0) TI_FM(17, 31, 1) TI_FM(18, 31, 2) TI_FM(19, 31, 3) TI_FM(20, 31, 4) TI_FM(21, 31, 5) TI_FM(22, 31, 6) TI_FM(23, 31, 7)
        TI_RL(0, 12, 31) TI_RL(1, 13, 31) TI_RL(2, 14, 31) TI_RL(3, 15, 31) TI_RL(4, 12, 63) TI_RL(5, 13, 63) TI_RL(6, 14, 63)
        TI_FM(24, 31, 0) TI_FM(25, 31, 1) TI_FM(26, 31, 2) TI_FM(27, 31, 3) TI_FM(28, 31, 4) TI_FM(29, 31, 5) TI_FM(30, 31, 6)
        TI_RL(0, 0, 30) TI_RL(1, 1, 30) TI_RL(2, 2, 30) TI_RL(3, 3, 30) TI_RL(4, 0, 62) TI_RL(5, 1, 62) TI_RL(6, 2, 62) TI_RL(7, 3, 62)
        TI_FM(0, 30, 0) TI_FM(1, 30, 1) TI_FM(2, 30, 2) TI_FM(3, 30, 3) TI_FM(4, 30, 4) TI_FM(5, 30, 5) TI_FM(6, 30, 6) TI_FM(7, 30, 7)
        TI_RL(0, 4, 30) TI_RL(1, 5, 30) TI_RL(2, 6, 30) TI_RL(3, 7, 30) TI_RL(4, 4, 62) TI_RL(5, 5, 62) TI_RL(6, 6, 62) TI_RL(7, 7, 62)
        TI_FM(8, 30, 0) TI_FM(9, 30, 1) TI_FM(10, 30, 2) TI_FM(11, 30, 3) TI_FM(12, 30, 4) TI_FM(13, 30, 5) TI_FM(14, 30, 6) TI_FM(15, 30, 7)
        TI_RL(0, 8, 30) TI_RL(1, 9, 30) TI_RL(2, 10, 30) TI_RL(3, 11, 30) TI_RL(4, 8, 62) TI_RL(5, 9, 62) TI_RL(6, 10, 62) TI_RL(7, 11, 62)
        TI_FM(16, 30, 0) TI_FM(17, 30, 1) TI_FM(18, 30, 2) TI_FM(19, 30, 3) TI_FM(20, 30, 4) TI_FM(21, 30, 5) TI_FM(22, 30, 6) TI_FM(23, 30, 7)
        TI_RL(0, 12, 30) TI_RL(1, 13, 30) TI_RL(2, 14, 30) TI_RL(3, 15, 30) TI_RL(4, 12, 62) TI_RL(5, 13, 62)
        TI_FM(24, 30, 0) TI_FM(25, 30, 1) TI_FM(26, 30, 2) TI_FM(27, 30, 3) TI_FM(28, 30, 4) TI_FM(29, 30, 5)
        TI_RL(0, 0, 29) TI_RL(1, 1, 29) TI_RL(2, 2, 29) TI_RL(3, 3, 29) TI_RL(4, 0, 61) TI_RL(5, 1, 61) TI_RL(6, 2, 61) TI_RL(7, 3, 61)
        TI_FM(0, 29, 0) TI_FM(1, 29, 1) TI_FM(2, 29, 2) TI_FM(3, 29, 3) TI_FM(4, 29, 4) TI_FM(5, 29, 5) TI_FM(6, 29, 6) TI_FM(7, 29, 7)
        TI_RL(0, 4, 29) TI_RL(1, 5, 29) TI_RL(2, 6, 29) TI_RL(3, 7, 29) TI_RL(4, 4, 61) TI_RL(5, 5, 61) TI_RL(6, 6, 61) TI_RL(7, 7, 61)
        TI_FM(8, 29, 0) TI_FM(9, 29, 1) TI_FM(10, 29, 2) TI_FM(11, 29, 3) TI_FM(12, 29, 4) TI_FM(13, 29, 5) TI_FM(14, 29, 6) TI_FM(15, 29, 7)
        TI_RL(0, 8, 29) TI_RL(1, 9, 29) TI_RL(2, 10, 29) TI_RL(3, 11, 29) TI_RL(4, 8, 61) TI_RL(5, 9, 61) TI_RL(6, 10, 61) TI_RL(7, 11, 61)
        TI_FM(16, 29, 0) TI_FM(17, 29, 1) TI_FM(18, 29, 2) TI_FM(19, 29, 3) TI_FM(20, 29, 4) TI_FM(21, 29, 5) TI_FM(22, 29, 6) TI_FM(23, 29, 7)
        TI_RL(0, 12, 29) TI_RL(1, 13, 29) TI_RL(2, 14, 29) TI_RL(3, 15, 29) TI_RL(4, 12, 61)
        TI_FM(24, 29, 0) TI_FM(25, 29, 1) TI_FM(26, 29, 2) TI_FM(27, 29, 3) TI_FM(28, 29, 4)
        TI_RL(0, 0, 28) TI_RL(1, 1, 28) TI_RL(2, 2, 28) TI_RL(3, 3, 28) TI_RL(4, 0, 60) TI_RL(5, 1, 60) TI_RL(6, 2, 60) TI_RL(7, 3, 60)
        TI_FM(0, 28, 0) TI_FM(1, 28, 1) TI_FM(2, 28, 2) TI_FM(3, 28, 3) TI_FM(4, 28, 4) TI_FM(5, 28, 5) TI_FM(6, 28, 6) TI_FM(7, 28, 7)
        TI_RL(0, 4, 28) TI_RL(1, 5, 28) TI_RL(2, 6, 28) TI_RL(3, 7, 28) TI_RL(4, 4, 60) TI_RL(5, 5, 60) TI_RL(6, 6, 60) TI_RL(7, 7, 60)
        TI_FM(8, 28, 0) TI_FM(9, 28, 1) TI_FM(10, 28, 2) TI_FM(11, 28, 3) TI_FM(12, 28, 4) TI_FM(13, 28, 5) TI_FM(14, 28, 6) TI_FM(15, 28, 7)
        TI_RL(0, 8, 28) TI_RL(1, 9, 28) TI_RL(2, 10, 28) TI_RL(3, 11, 28) TI_RL(4, 8, 60) TI_RL(5, 9, 60) TI_RL(6, 10, 60) TI_RL(7, 11, 60)
        TI_FM(16, 28, 0) TI_FM(17, 28, 1) TI_FM(18, 28, 2) TI_FM(19, 28, 3) TI_FM(20, 28, 4) TI_FM(21, 28, 5) TI_FM(22, 28, 6) TI_FM(23, 28, 7)
        TI_RL(0, 12, 28) TI_RL(1, 13, 28) TI_RL(2, 14, 28) TI_RL(3, 15, 28)
        TI_FM(24, 28, 0) TI_FM(25, 28, 1) TI_FM(26, 28, 2) TI_FM(27, 28, 3)
        TI_RL(0, 0, 27) TI_RL(1, 1, 27) TI_RL(2, 2, 27) TI_RL(3, 3, 27) TI_RL(4, 0, 59) TI_RL(5, 1, 59) TI_RL(6, 2, 59) TI_RL(7, 3, 59)
        TI_FM(0, 27, 0) TI_FM(1, 27, 1) TI_FM(2, 27, 2) TI_FM(3, 27, 3) TI_FM(4, 27, 4) TI_FM(5, 27, 5) TI_FM(6, 27, 6) TI_FM(7, 27, 7)
        TI_RL(0, 4, 27) TI_RL(1, 5, 27) TI_RL(2, 6, 27) TI_RL(3, 7, 27) TI_RL(4, 4, 59) TI_RL(5, 5, 59) TI_RL(6, 6, 59) TI_RL(7, 7, 59)
        TI_FM(8, 27, 0) TI_FM(9, 27, 1) TI_FM(10, 27, 2) TI_FM(11, 27, 3) TI_FM(12, 27, 4) TI_FM(13, 27, 5) TI_FM(14, 27, 6) TI_FM(15, 27, 7)
        TI_RL(0, 8, 27) TI_RL(1, 9, 27) TI_RL(2, 10, 27) TI_RL(3, 11, 27) TI_RL(4, 8, 59) TI_RL(5, 9, 59) TI_RL(6, 10, 59) TI_RL(7, 11, 59)
        TI_FM(16, 27, 0) TI_FM(17, 27, 1) TI_FM(18, 27, 2) TI_FM(19, 27, 3) TI_FM(20, 27, 4) TI_FM(21, 27, 5) TI_FM(22, 27, 6) TI_FM(23, 27, 7)
        TI_RL(0, 12, 27) TI_RL(1, 13, 27) TI_RL(2, 14, 27)
        TI_FM(24, 27, 0) TI_FM(25, 27, 1) TI_FM(26, 27, 2)
        TI_RL(0, 0, 26) TI_RL(1, 1, 26) TI_RL(2, 2, 26) TI_RL(3, 3, 26) TI_RL(4, 0, 58) TI_RL(5, 1, 58) TI_RL(6, 2, 58) TI_RL(7, 3, 58)
        TI_FM(0, 26, 0) TI_FM(1, 26, 1) TI_FM(2, 26, 2) TI_FM(3, 26, 3) TI_FM(4, 26, 4) TI_FM(5, 26, 5) TI_FM(6, 26, 6) TI_FM(7, 26, 7)
        TI_RL(0, 4, 26) TI_RL(1, 5, 26) TI_RL(2, 6, 26) TI_RL(3, 7, 26) TI_RL(4, 4, 58) TI_RL(5, 5, 58) TI_RL(6, 6, 58) TI_RL(7, 7, 58)
        TI_FM(8, 26, 0) TI_FM(9, 26, 1) TI_FM(10, 26, 2) TI_FM(11, 26, 3) TI_FM(12, 26, 4) TI_FM(13, 26, 5) TI_FM(14, 26, 6) TI_FM(15, 26, 7)
        TI_RL(0, 8, 26) TI_RL(1, 9, 26) TI_RL(2, 10, 26) TI_RL(3, 11, 26) TI_RL(4, 8, 58) TI_RL(5, 9, 58) TI_RL(6, 10, 58) TI_RL(7, 11, 58)
        TI_FM(16, 26, 0) TI_FM(17, 26, 1) TI_FM(18, 26, 2) TI_FM(19, 26, 3) TI_FM(20, 26, 4) TI_FM(21, 26, 5) TI_FM(22, 26, 6) TI_FM(23, 26, 7)
        TI_RL(0, 12, 26) TI_RL(1, 13, 26)
        TI_FM(24, 26, 0) TI_FM(25, 26, 1)
        TI_RL(0, 0, 25) TI_RL(1, 1, 25) TI_RL(2, 2, 25) TI_RL(3, 3, 25) TI_RL(4, 0, 57) TI_RL(5, 1, 57) TI_RL(6, 2, 57) TI_RL(7, 3, 57)
        TI_FM(0, 25, 0) TI_FM(1, 25, 1) TI_FM(2, 25, 2) TI_FM(3, 25, 3) TI_FM(4, 25, 4) TI_FM(5, 25, 5) TI_FM(6, 25, 6) TI_FM(7, 25, 7)
        TI_RL(0, 4, 25) TI_RL(1, 5, 25) TI_RL(2, 6, 25) TI_RL(3, 7, 25) TI_RL(4, 4, 57) TI_RL(5, 5, 57) TI_RL(6, 6, 57) TI_RL(7, 7, 57)
        TI_FM(8, 25, 0) TI_FM(9, 25, 1) TI_FM(10, 25, 2) TI_FM(11, 25, 3) TI_FM(12, 25, 4) TI_FM(13, 25, 5) TI_FM(14, 25, 6) TI_FM(15, 25, 7)
        TI_RL(0, 8, 25) TI_RL(1, 9, 25) TI_RL(2, 10, 25) TI_RL(3, 11, 25) TI_RL(4, 8, 57) TI_RL(5, 9, 57) TI_RL(6, 10, 57) TI_RL(7, 11, 57)
        TI_FM(16, 25, 0) TI_FM(17, 25, 1) TI_FM(18, 25, 2) TI_FM(19, 25, 3) TI_FM(20, 25, 4) TI_FM(21, 25, 5) TI_FM(22, 25, 6) TI_FM(23, 25, 7)
        TI_RL(0, 12, 25)
        TI_FM(24, 25, 0)
        TI_RL(0, 0, 24) TI_RL(1, 1, 24) TI_RL(2, 2, 24) TI_RL(3, 3, 24) TI_RL(4, 0, 56) TI_RL(5, 1, 56) TI_RL(6, 2, 56) TI_RL(7, 3, 56)
        TI_FM(0, 24, 0) TI_FM(1, 24, 1) TI_FM(2, 24, 2) TI_FM(3, 24, 3) TI_FM(4, 24, 4) TI_FM(5, 24, 5) TI_FM(6, 24, 6) TI_FM(7, 24, 7)
        TI_RL(0, 4, 24) TI_RL(1, 5, 24) TI_RL(2, 6, 24) TI_RL(3, 7, 24) TI_RL(4, 4, 56) TI_RL(5, 5, 56) TI_RL(6, 6, 56) TI_RL(7, 7, 56)
        TI_FM(8, 24, 0) TI_FM(9, 24, 1) TI_FM(10, 24, 2) TI_FM(11, 24, 3) TI_FM(12, 24, 4) TI_FM(13, 24, 5) TI_FM(14, 24, 6) TI_FM(15, 24, 7)
        TI_RL(0, 8, 24) TI_RL(1, 9, 24) TI_RL(2, 10, 24) TI_RL(3, 11, 24) TI_RL(4, 8, 56) TI_RL(5, 9, 56) TI_RL(6, 10, 56) TI_RL(7, 11, 56)
        TI_FM(16, 24, 0) TI_FM(17, 24, 1) TI_FM(18, 24, 2) TI_FM(19, 24, 3) TI_FM(20, 24, 4) TI_FM(21, 24, 5) TI_FM(22, 24, 6) TI_FM(23, 24, 7)
        TI_RL(0, 0, 23) TI_RL(1, 1, 23) TI_RL(2, 2, 23) TI_RL(3, 3, 23) TI_RL(4, 0, 55) TI_RL(5, 1, 55) TI_RL(6, 2, 55) TI_RL(7, 3, 55)
        TI_FM(0, 23, 0) TI_FM(1, 23, 1) TI_FM(2, 23, 2) TI_FM(3, 23, 3) TI_FM(4, 23, 4) TI_FM(5, 23, 5) TI_FM(6, 23, 6) TI_FM(7, 23, 7)
        TI_RL(0, 4, 23) TI_RL(1, 5, 23) TI_RL(2, 6, 23) TI_RL(3, 7, 23) TI_RL(4, 4, 55) TI_RL(5, 5, 55) TI_RL(6, 6, 55) TI_RL(7, 7, 55)
        TI_FM(8, 23, 0) TI_FM(9, 23, 1) TI_FM(10, 23, 2) TI_FM(11, 23, 3) TI_FM(12, 23, 4) TI_FM(13, 23, 5) TI_FM(14, 23, 6) TI_FM(15, 23, 7)
        TI_RL(0, 8, 23) TI_RL(1, 9, 23) TI_RL(2, 10, 23) TI_RL(3, 11, 23) TI_RL(4, 8, 55) TI_RL(5, 9, 55) TI_RL(6, 10, 55)
        TI_FM(16, 23, 0) TI_FM(17, 23, 1) TI_FM(18, 23, 2) TI_FM(19, 23, 3) TI_FM(20, 23, 4) TI_FM(21, 23, 5) TI_FM(22, 23, 6)
        TI_RL(0, 0, 22) TI_RL(1, 1, 22) TI_RL(2, 2, 22) TI_RL(3, 3, 22) TI_RL(4, 0, 54) TI_RL(5, 1, 54) TI_RL(6, 2, 54) TI_RL(7, 3, 54)
        TI_FM(0, 22, 0) TI_FM(1, 22, 1) TI_FM(2, 22, 2) TI_FM(3, 22, 3) TI_FM(4, 22, 4) TI_FM(5, 22, 5) TI_FM(6, 22, 6) TI_FM(7, 22, 7)
        TI_RL(0, 4, 22) TI_RL(1, 5, 22) TI_RL(2, 6, 22) TI_RL(3, 7, 22) TI_RL(4, 4, 54) TI_RL(5, 5, 54) TI_RL(6, 6, 54) TI_RL(7, 7, 54)
        TI_FM(8, 22, 0) TI_FM(9, 22, 1) TI_FM(10, 22, 2) TI_FM(11, 22, 3) TI_FM(12, 22, 4) TI_FM(13, 22, 5) TI_FM(14, 22, 6) TI_FM(15, 22, 7)
        TI_RL(0, 8, 22) TI_RL(1, 9, 22) TI_RL(2, 10, 22) TI_RL(3, 11, 22) TI_RL(4, 8, 54) TI_RL(5, 9, 54)
        TI_FM(16, 22, 0) TI_FM(17, 22, 1) TI_FM(18, 22, 2) TI_FM(19, 22, 3) TI_FM(20, 22, 4) TI_FM(21, 22, 5)
        TI_RL(0, 0, 21) TI_RL(1, 1, 21) TI_RL(2, 2, 21) TI_RL(3, 3, 21) TI_RL(4, 0, 53) TI_RL(5, 1, 53) TI_RL(6, 2, 53) TI_RL(7, 3, 53)
        TI_FM(0, 21, 0) TI_FM(1, 21, 1) TI_FM(2, 21, 2) TI_FM(3, 21, 3) TI_FM(4, 21, 4) TI_FM(5, 21, 5) TI_FM(6, 21, 6) TI_FM(7, 21, 7)
        TI_RL(0, 4, 21) TI_RL(1, 5, 21) TI_RL(2, 6, 21) TI_RL(3, 7, 21) TI_RL(4, 4, 53) TI_RL(5, 5, 53) TI_RL(6, 6, 53) TI_RL(7, 7, 53)
        TI_FM(8, 21, 0) TI_FM(9, 21, 1) TI_FM(10, 21, 2) TI_FM(11, 21, 3) TI_FM(12, 21, 4) TI_FM(13, 21, 5) TI_FM(14, 21, 6) TI_FM(15, 21, 7)
        TI_RL(0, 8, 21) TI_RL(1, 9, 21) TI_RL(2, 10, 21) TI_RL(3, 11, 21) TI_RL(4, 8, 53)
        TI_FM(16, 21, 0) TI_FM(17, 21, 1) TI_FM(18, 21, 2) TI_FM(19, 21, 3) TI_FM(20, 21, 4)
        TI_RL(0, 0, 20) TI_RL(1, 1, 20) TI_RL(2, 2, 20) TI_RL(3, 3, 20) TI_RL(4, 0, 52) TI_RL(5, 1, 52) TI_RL(6, 2, 52) TI_RL(7, 3, 52)
        TI_FM(0, 20, 0) TI_FM(1, 20, 1) TI_FM(2, 20, 2) TI_FM(3, 20, 3) TI_FM(4, 20, 4) TI_FM(5, 20, 5) TI_FM(6, 20, 6) TI_FM(7, 20, 7)
        TI_RL(0, 4, 20) TI_RL(1, 5, 20) TI_RL(2, 6, 20) TI_RL(3, 7, 20) TI_RL(4, 4, 52) TI_RL(5, 5, 52) TI_RL(6, 6, 52) TI_RL(7, 7, 52)
        TI_FM(8, 20, 0) TI_FM(9, 20, 1) TI_FM(10, 20, 2) TI_FM(11, 20, 3) TI_FM(12, 20, 4) TI_FM(13, 20, 5) TI_FM(14, 20, 6) TI_FM(15, 20, 7)
        TI_RL(0, 8, 20) TI_RL(1, 9, 20) TI_RL(2, 10, 20) TI_RL(3, 11, 20)
        TI_FM(16, 20, 0) TI_FM(17, 20, 1) TI_FM(18, 20, 2) TI_FM(19, 20, 3)
        TI_RL(0, 0, 19) TI_RL(1, 1, 19) TI_RL(2, 2, 19) TI_RL(3, 3, 19) TI_RL(4, 0, 51) TI_RL(5, 1, 51) TI_RL(6, 2, 51) TI_RL(7, 3, 51)
        TI_FM(0, 19, 0) TI_FM(1, 19, 1) TI_FM(2, 19, 2) TI_FM(3, 19, 3) TI_FM(4, 19, 4) TI_FM(5, 19, 5) TI_FM(6, 19, 6) TI_FM(7, 19, 7)
        TI_RL(0, 4, 19) TI_RL(1, 5, 19) TI_RL(2, 6, 19) TI_RL(3, 7, 19) TI_RL(4, 4, 51) TI_RL(5, 5, 51) TI_RL(6, 6, 51) TI_RL(7, 7, 51)
        TI_FM(8, 19, 0) TI_FM(9, 19, 1) TI_FM(10, 19, 2) TI_FM(11, 19, 3) TI_FM(12, 19, 4) TI_FM(13, 19, 5) TI_FM(14, 19, 6) TI_FM(15, 19, 7)
        TI_RL(0, 8, 19) TI_RL(1, 9, 19) TI_RL(2, 10, 19)
        TI_FM(16, 19, 0) TI_FM(17, 19, 1) TI_FM(18, 19, 2)
        TI_RL(0, 0, 18) TI_RL(1, 1, 18) TI_RL(2, 2, 18) TI_RL(3, 3, 18) TI_RL(4, 0, 50) TI_RL(5, 1, 50) TI_RL(6, 2, 50) TI_RL(7, 3, 50)
        TI_FM(0, 18, 0) TI_FM(1, 18, 1) TI_FM(2, 18, 2) TI_FM(3, 18, 3) TI_FM(4, 18, 4) TI_FM(5, 18, 5) TI_FM(6, 18, 6) TI_FM(7, 18, 7)
        TI_RL(0, 4, 18) TI_RL(1, 5, 18) TI_RL(2, 6, 18) TI_RL(3, 7, 18) TI_RL(4, 4, 50) TI_RL(5, 5, 50) TI_RL(6, 6, 50) TI_RL(7, 7, 50)
        TI_FM(8, 18, 0) TI_FM(9, 18, 1) TI_FM(10, 18, 2) TI_FM(11, 18, 3) TI_FM(12, 18, 4) TI_FM(13, 18, 5) TI_FM(14, 18, 6) TI_FM(15, 18, 7)
        TI_RL(0, 8, 18) TI_RL(1, 9, 18)
        TI_FM(16, 18, 0) TI_FM(17, 18, 1)
        TI_RL(0, 0, 17) TI_RL(1, 1, 17) TI_RL(2, 2, 17) TI_RL(3, 3, 17) TI_RL(4, 0, 49) TI_RL(5, 1, 49) TI_RL(6, 2, 49) TI_RL(7, 3, 49)
        TI_FM(0, 17, 0) TI_FM(1, 17, 1) TI_FM(2, 17, 2) TI_FM(3, 17, 3) TI_FM(4, 17, 4) TI_FM(5, 17, 5) TI_FM(6, 17, 6) TI_FM(7, 17, 7)
        TI_RL(0, 4, 17) TI_RL(1, 5, 17) TI_RL(2, 6, 17) TI_RL(3, 7, 17) TI_RL(4, 4, 49) TI_RL(5, 5, 49) TI_RL(6, 6, 49) TI_RL(7, 7, 49)
        TI_FM(8, 17, 0) TI_FM(9, 17, 1) TI_FM(10, 17, 2) TI_FM(11, 17, 3) TI_FM(12, 17, 4) TI_FM(13, 17, 5) TI_FM(14, 17, 6) TI_FM(15, 17, 7)
        TI_RL(0, 8, 17)
        TI_FM(16, 17, 0)
        TI_RL(0, 0, 16) TI_RL(1, 1, 16) TI_RL(2, 2, 16) TI_RL(3, 3, 16) TI_RL(4, 0, 48) TI_RL(5, 1, 48) TI_RL(6, 2, 48) TI_RL(7, 3, 48)
        TI_FM(0, 16, 0) TI_FM(1, 16, 1) TI_FM(2, 16, 2) TI_FM(3, 16, 3) TI_FM(4, 16, 4) TI_FM(5, 16, 5) TI_FM(6, 16, 6) TI_FM(7, 16, 7)
        TI_RL(0, 4, 16) TI_RL(1, 5, 16) TI_RL(2, 6, 16) TI_RL(3, 7, 16) TI_RL(4, 4, 48) TI_RL(5, 5, 48) TI_RL(6, 6, 48) TI_RL(7, 7, 48)
        TI_FM(8, 16, 0) TI_FM(9, 16, 1) TI_FM(10, 16, 2) TI_FM(11, 16, 3) TI_FM(12, 16, 4) TI_FM(13, 16, 5) TI_FM(14, 16, 6) TI_FM(15, 16, 7)
        TI_RL(0, 0, 15) TI_RL(1, 1, 15) TI_RL(2, 2, 15) TI_RL(3, 3, 15) TI_RL(4, 0, 47) TI_RL(5, 1, 47) TI_RL(6, 2, 47) TI_RL(7, 3, 47)
        TI_FM(0, 15, 0) TI_FM(1, 15, 1) TI_FM(2, 15, 2) TI_FM(3, 15, 3) TI_FM(4, 15, 4) TI_FM(5, 15, 5) TI_FM(6, 15, 6) TI_FM(7, 15, 7)
        TI_RL(0, 4, 15) TI_RL(1, 5, 15) TI_RL(2, 6, 15) TI_RL(3, 7, 15) TI_RL(4, 4, 47) TI_RL(5, 5, 47) TI_RL(6, 6, 47)
        TI_FM(8, 15, 0) TI_FM(9, 15, 1) TI_FM(10, 15, 2) TI_FM(11, 15, 3) TI_FM(12, 15, 4) TI_FM(13, 15, 5) TI_FM(14, 15, 6)
        TI_RL(0, 0, 14) TI_RL(1, 1, 14) TI_RL(2, 2, 14) TI_RL(3, 3, 14) TI_RL(4, 0, 46) TI_RL(5, 1, 46) TI_RL(6, 2, 46) TI_RL(7, 3, 46)
        TI_FM(0, 14, 0) TI_FM(1, 14, 1) TI_FM(2, 14, 2) TI_FM(3, 14, 3) TI_FM(4, 14, 4) TI_FM(5, 14, 5) TI_FM(6, 14, 6) TI_FM(7, 14, 7)
        TI_RL(0, 4, 14) TI_RL(1, 5, 14) TI_RL(2, 6, 14) TI_RL(3, 7, 14) TI_RL(4, 4, 46) TI_RL(5, 5, 46)
        TI_FM(8, 14, 0) TI_FM(9, 14, 1) TI_FM(10, 14, 2) TI_FM(11, 14, 3) TI_FM(12, 14, 4) TI_FM(13, 14, 5)
        TI_RL(0, 0, 13) TI_RL(1, 1, 13) TI_RL(2, 2, 13) TI_RL(3, 3, 13) TI_RL(4, 0, 45) TI_RL(5, 1, 45) TI_RL(6, 2, 45) TI_RL(7, 3, 45)
        TI_FM(0, 13, 0) TI_FM(1, 13, 1) TI_FM(2, 13, 2) TI_FM(3, 13, 3) TI_FM(4, 13, 4) TI_FM(5, 13, 5) TI_FM(6, 13, 6) TI_FM(7, 13, 7)
        TI_RL(0, 4, 13) TI_RL(1, 5, 13) TI_RL(2, 6, 13) TI_RL(3, 7, 13) TI_RL(4, 4, 45)
        TI_FM(8, 13, 0) TI_FM(9, 13, 1) TI_FM(10, 13, 2) TI_FM(11, 13, 3) TI_FM(12, 13, 4)
        TI_RL(0, 0, 12) TI_RL(1, 1, 12) TI_RL(2, 2, 12) TI_RL(3, 3, 12) TI_RL(4, 0, 44) TI_RL(5, 1, 44) TI_RL(6, 2, 44) TI_RL(7, 3, 44)
        TI_FM(0, 12, 0) TI_FM(1, 12, 1) TI_FM(2, 12, 2) TI_FM(3, 12, 3) TI_FM(4, 12, 4) TI_FM(5, 12, 5) TI_FM(6, 12, 6) TI_FM(7, 12, 7)
        TI_RL(0, 4, 12) TI_RL(1, 5, 12) TI_RL(2, 6, 12) TI_RL(3, 7, 12)
        TI_FM(8, 12, 0) TI_FM(9, 12, 1) TI_FM(10, 12, 2) TI_FM(11, 12, 3)
        TI_RL(0, 0, 11) TI_RL(1, 1, 11) TI_RL(2, 2, 11) TI_RL(3, 3, 11) TI_RL(4, 0, 43) TI_RL(5, 1, 43) TI_RL(6, 2, 43) TI_RL(7, 3, 43)
        TI_FM(0, 11, 0) TI_FM(1, 11, 1) TI_FM(2, 11, 2) TI_FM(3, 11, 3) TI_FM(4, 11, 4) TI_FM(5, 11, 5) TI_FM(6, 11, 6) TI_FM(7, 11, 7)
        TI_RL(0, 4, 11) TI_RL(1, 5, 11) TI_RL(2, 6, 11)
        TI_FM(8, 11, 0) TI_FM(9, 11, 1) TI_FM(10, 11, 2)
        TI_RL(0, 0, 10) TI_RL(1, 1, 10) TI_RL(2, 2, 10) TI_RL(3, 3, 10) TI_RL(4, 0, 42) TI_RL(5, 1, 42) TI_RL(6, 2, 42) TI_RL(7, 3, 42)
        TI_FM(0, 10, 0) TI_FM(1, 10, 1) TI_FM(2, 10, 2) TI_FM(3, 10, 3) TI_FM(4, 10, 4) TI_FM(5, 10, 5) TI_FM(6, 10, 6) TI_FM(7, 10, 7)
        TI_RL(0, 4, 10) TI_RL(1, 5, 10)
        TI_FM(8, 10, 0) TI_FM(9, 10, 1)
        TI_RL(0, 0, 9) TI_RL(1, 1, 9) TI_RL(2, 2, 9) TI_RL(3, 3, 9) TI_RL(4, 0, 41) TI_RL(5, 1, 41) TI_RL(6, 2, 41) TI_RL(7, 3, 41)
        TI_FM(0, 9, 0) TI_FM(1, 9, 1) TI_FM(2, 9, 2) TI_FM(3, 9, 3) TI_FM(4, 9, 4) TI_FM(5, 9, 5) TI_FM(6, 9, 6) TI_FM(7, 9, 7)
        TI_RL(0, 4, 9)
        TI_FM(8, 9, 0)
        TI_RL(0, 0, 8) TI_RL(1, 1, 8) TI_RL(2, 2, 8) TI_RL(3, 3, 8) TI_RL(4, 0, 40) TI_RL(5, 1, 40) TI_RL(6, 2, 40) TI_RL(7, 3, 40)
        TI_FM(0, 8, 0) TI_FM(1, 8, 1) TI_FM(2, 8, 2) TI_FM(3, 8, 3) TI_FM(4, 8, 4) TI_FM(5, 8, 5) TI_FM(6, 8, 6) TI_FM(7, 8, 7)
        TI_RL(0, 0, 7) TI_RL(1, 1, 7) TI_RL(2, 2, 7) TI_RL(3, 3, 7) TI_RL(4, 0, 39) TI_RL(5, 1, 39) TI_RL(6, 2, 39)
        TI_FM(0, 7, 0) TI_FM(1, 7, 1) TI_FM(2, 7, 2) TI_FM(3, 7, 3) TI_FM(4, 7, 4) TI_FM(5, 7, 5) TI_FM(6, 7, 6)
        TI_RL(0, 0, 6) TI_RL(1, 1, 6) TI_RL(2, 2, 6) TI_RL(3, 3, 6) TI_RL(4, 0, 38) TI_RL(5, 1, 38)
        TI_FM(0, 6, 0) TI_FM(1, 6, 1) TI_FM(2, 6, 2) TI_FM(3, 6, 3) TI_FM(4, 6, 4) TI_FM(5, 6, 5)
        TI_RL(0, 0, 5) TI_RL(1, 1, 5) TI_RL(2, 2, 5) TI_RL(3, 3, 5) TI_RL(4, 0, 37)
        TI_FM(0, 5, 0) TI_FM(1, 5, 1) TI_FM(2, 5, 2) TI_FM(3, 5, 3) TI_FM(4, 5, 4)
        TI_RL(0, 0, 4) TI_RL(1, 1, 4) TI_RL(2, 2, 4) TI_RL(3, 3, 4)
        TI_FM(0, 4, 0) TI_FM(1, 4, 1) TI_FM(2, 4, 2) TI_FM(3, 4, 3)
        TI_RL(0, 0, 3) TI_RL(1, 1, 3) TI_RL(2, 2, 3)
        TI_FM(0, 3, 0) TI_FM(1, 3, 1) TI_FM(2, 3, 2)
        TI_RL(0, 0, 2) TI_RL(1, 1, 2)
        TI_FM(0, 2, 0) TI_FM(1, 2, 1)
        TI_RL(0, 0, 1)
        TI_FM(0, 1, 0)
      }
#undef TI_RL
#undef TI_FM

#pragma unroll
      for (int s = 0; s < 2; ++s) { float e8[8];
#pragma unroll
          for (int jj = 0; jj < 8; ++jj) { const int i0 = 16 * s + 8 * (jj >> 2) + (jj & 3); float ta = T[i0], tb = T[i0 + 4]; asm volatile("" : "+v"(ta), "+v"(tb)); e8[jj] = h ? tb : ta; }
          fT[s] = __builtin_bit_cast(bf16x8, (u32x4){cvtpk(e8[0], e8[1]), cvtpk(e8[2], e8[3]), cvtpk(e8[4], e8[5]), cvtpk(e8[6], e8[7])}); } }
    asm volatile("" ::: "memory"); __builtin_amdgcn_sched_barrier(0);
    const size_t uid = ((size_t)(b * 8 + hd) * 128 + c);
    unsigned char* gG = F.ws + WS_R0 + uid * SZ_G; unsigned char* gH = F.ws + WS_R2 + uid * SZ_H; unsigned char* gQ = F.ws + WS_H0 + uid * SZ_Q; unsigned char* gY = F.ws + WS_H1 + uid * SZ_Y;
#define RK_ST(base, piece, f) (*(u32x4*)((base) + (piece) * 1024 + (tid & 63) * 16) = __builtin_bit_cast(u32x4, (f)))
    bf16x8 fWt[2][2];
#pragma unroll
    for (int jt = 0; jt < 2; ++jt) { f32x16 w_ = f32x16{}; w_ = RK_MF(fT[0], tAt[jt][0], w_); w_ = RK_MF(fT[1], tAt[jt][1], w_); fWt[jt][0] = frag<0>(w_); fWt[jt][1] = frag<1>(w_);
        f32x16 q_; unfrag<0>(q_, __builtin_bit_cast(bf16x8, *(const LAS u32x4*)(stash + 8 * (2 * jt) * PZ))); unfrag<1>(q_, __builtin_bit_cast(bf16x8, *(const LAS u32x4*)(stash + 8 * (2 * jt + 1) * PZ)));
        q_ = RK_MF(fWt[jt][0], fArb[0], q_); q_ = RK_MF(fWt[jt][1], fArb[1], q_); RK_ST(gQ, 2 * jt, frag<0>(q_)); RK_ST(gQ, 2 * jt + 1, frag<1>(q_)); }
    bf16x8 tBh[2][2], tKh[2][2], tV[2][2];
    { bf16x8 fId[2]; mk_id(fId, r, h);
#pragma unroll
    for (int jt = 0; jt < 2; ++jt) { bf16x8 fBh[2], fKh[2], fV[2], fdum[2]; float bdum = 0.f;
        r1_elem<1>(EC, jt, fBh, fKh, fV, fdum, bdum, pcd[jt]);
        { f32x16 t_ = f32x16{}; t_ = RK_MF(fBh[0], fId[0], t_); t_ = RK_MF(fBh[1], fId[1], t_); tBh[jt][0] = frag<0>(t_); tBh[jt][1] = frag<1>(t_); }
        { f32x16 t_ = f32x16{}; t_ = RK_MF(fKh[0], fId[0], t_); t_ = RK_MF(fKh[1], fId[1], t_); tKh[jt][0] = frag<0>(t_); tKh[jt][1] = frag<1>(t_); }
        { f32x16 t_ = f32x16{}; t_ = RK_MF(fV[0], fId[0], t_); t_ = RK_MF(fV[1], fId[1], t_); tV[jt][0] = frag<0>(t_); tV[jt][1] = frag<1>(t_); } } }
    bf16x8 fUt[2][2];
#pragma unroll
    for (int it = 0; it < 2; ++it) { f32x16 av = f32x16{}; av = RK_MF(fAak[0], tV[it][0], av); av = RK_MF(fAak[1], tV[it][1], av);
        const bf16x8 fav0 = frag<0>(av), fav1 = frag<1>(av); f32x16 u_ = f32x16{}; u_ = RK_MF(fT[0], fav0, u_); u_ = RK_MF(fT[1], fav1, u_); fUt[it][0] = frag<0>(u_); fUt[it][1] = frag<1>(u_); }
#pragma unroll
    for (int it = 0; it < 2; ++it) { f32x16 y_ = f32x16{}; y_ = RK_MF(fUt[it][0], fArb[0], y_); y_ = RK_MF(fUt[it][1], fArb[1], y_); y_ = RK_MF(tV[it][0], fArk[0], y_); y_ = RK_MF(tV[it][1], fArk[1], y_);
        RK_ST(gY, 2 * it, frag<0>(y_)); RK_ST(gY, 2 * it + 1, frag<1>(y_)); }
#pragma unroll
    for (int jt = 0; jt < 2; ++jt)
#pragma unroll
        for (int j2 = 0; j2 < 2; ++j2) { f32x16 g_ = f32x16{}; g_ = RK_MF(fWt[jt][0], tBh[j2][0], g_); g_ = RK_MF(fWt[jt][1], tBh[j2][1], g_);
            if (jt == j2) {
#pragma unroll
                for (int i = 0; i < 16; ++i) if (i == 4 * (r >> 3) + (r & 3) && h == ((r >> 2) & 1)) g_[i] += pcd[jt]; }
            RK_ST(gG, 2 * (jt * 2 + j2), frag<0>(g_)); RK_ST(gG, 2 * (jt * 2 + j2) + 1, frag<1>(g_)); }
#pragma unroll
    for (int j2 = 0; j2 < 2; ++j2)
#pragma unroll
        for (int it = 0; it < 2; ++it) { f32x16 h_ = f32x16{}; h_ = RK_MF(tBh[j2][0], fUt[it][0], h_); h_ = RK_MF(tBh[j2][1], fUt[it][1], h_); h_ = RK_MF(tKh[j2][0], tV[it][0], h_); h_ = RK_MF(tKh[j2][1], tV[it][1], h_);
            RK_ST(gH, 2 * (j2 * 2 + it), frag<0>(h_)); RK_ST(gH, 2 * (j2 * 2 + it) + 1, frag<1>(h_)); }
}

template <int DRY> __device__ __forceinline__ void r2_task(const Args& args, Frame& F, int task) {
    const bool st_ok = !DRY || args.li == 12345;
    const int bh = task >> 1, it = task & 1;
    f32x16 St[2]; St[0] = f32x16{}; St[1] = f32x16{};
    const unsigned char* gG0 = F.ws + WS_R0 + (size_t)bh * 128 * SZ_G + F.lane * 16; unsigned char* gH0 = F.ws + WS_R2 + (size_t)bh * 128 * SZ_H + F.lane * 16;
    bf16x8 G0[2][2][2], H0[2][2], G1[2][2][2], H1[2][2], G2[2][2][2], H2[2][2];
#define R2_LOAD(G_, H_, c_) do { const int cc_ = (c_) < 128 ? (c_) : 127;     \
        _Pragma("unroll") for (int jt = 0; jt < 2; ++jt) _Pragma("unroll") for (int j2 = 0; j2 < 2; ++j2) _Pragma("unroll") for (int s = 0; s < 2; ++s) \
            G_[jt][j2][s] = __builtin_bit_cast(bf16x8, *(const u32x4*)(gG0 + (size_t)cc_ * SZ_G + (2 * (jt * 2 + j2) + s) * 1024)); \
        _Pragma("unroll") for (int j2 = 0; j2 < 2; ++j2) _Pragma("unroll") for (int s = 0; s < 2; ++s) H_[j2][s] = __builtin_bit_cast(bf16x8, *(const u32x4*)(gH0 + (size_t)cc_ * SZ_H + (2 * (j2 * 2 + it) + s) * 1024)); } while (0)
#define R2_STEP(G_, H_, c_, LOADNEXT) do { \
        const bf16x8 fS[2][2] = {{frag<0>(St[0]), frag<1>(St[0])}, {frag<0>(St[1]), frag<1>(St[1])}}; \
        if (st_ok) { _Pragma("unroll") for (int jt = 0; jt < 2; ++jt) _Pragma("unroll") for (int s = 0; s < 2; ++s) \
            *(u32x4*)(gH0 + (size_t)(c_) * SZ_H + (2 * (jt * 2 + it) + s) * 1024) = __builtin_bit_cast(u32x4, fS[jt][s]); }     \
        __builtin_amdgcn_sched_barrier(0); LOADNEXT; __builtin_amdgcn_sched_barrier(0);     \
        _Pragma("unroll") for (int j2 = 0; j2 < 2; ++j2) { unfrag<0>(St[j2], H_[j2][0]); unfrag<1>(St[j2], H_[j2][1]); \
            _Pragma("unroll") for (int jt = 0; jt < 2; ++jt) { St[j2] = RK_MF(G_[jt][j2][0], fS[jt][0], St[j2]); St[j2] = RK_MF(G_[jt][j2][1], fS[jt][1], St[j2]); } } \
        __builtin_amdgcn_sched_barrier(0); \
    } while (0)
    R2_LOAD(G0, H0, 0); R2_LOAD(G1, H1, 1);
#pragma unroll 1
    for (int c = 0; c < 126; c += 3) {
        R2_STEP(G0, H0, c, R2_LOAD(G2, H2, c + 2));
        R2_STEP(G1, H1, c + 1, R2_LOAD(G0, H0, c + 3));
        R2_STEP(G2, H2, c + 2, R2_LOAD(G1, H1, c + 4));
    }
    R2_STEP(G0, H0, 126, (void)0);
    R2_STEP(G1, H1, 127, (void)0);
#undef R2_STEP
#undef R2_LOAD
}

constexpr int PV2 = 1296;
__device__ __forceinline__ void r3_unit(const Args& args, Frame& F, int b, int c) {
    LAS unsigned char* IMG = F.lds;
    const bf16_t* Z = (const bf16_t*)(F.ws + WS_Z);
    const int t0 = 32 * c; const size_t m0 = (size_t)b * SEQ + t0;
    const float* mu = AIN(7);
    int tid = F.tid; asm volatile("" : "+v"(tid));
    __syncthreads();
    { const unsigned lds0 = (unsigned)(uintptr_t)IMG; const int ln = tid & 63;
      for (int task = F.wave; task < 33 * 2; task += NWAVES) { const int rr = task >> 1, j = task & 1, pc = 64 * j + ln;
          if (pc < 80) { const int col = j == 0 ? ZR_V + 8 * ln : ZR_GD + 8 * ln;
              if (rr > 0 || t0 > 0) att::glds16(Z + (m0 + rr - 1) * ZW + col, (unsigned)__builtin_amdgcn_readfirstlane((int)(lds0 + rr * PV2 + 1024 * j)));
              else *(LAS u32x4*)(IMG + 16 * pc) = (u32x4){0u, 0u, 0u, 0u}; } }
      asm volatile("s_waitcnt vmcnt(0)" ::: "memory"); }
    __syncthreads();
    { const int t = tid >> 4, kp = tid & 15;
      const u32x4 cw = *(const LAS u32x4*)(IMG + (t + 1) * PV2 + 1024 + 16 * kp), pw = *(const LAS u32x4*)(IMG + t * PV2 + 1024 + 16 * kp);
      const f32x4 m0v = *(const f32x4*)(mu + 1664 + 8 * kp), m1v = *(const f32x4*)(mu + 1664 + 8 * kp + 4);
      const unsigned cwa[4] = {cw.x, cw.y, cw.z, cw.w}, pwa[4] = {pw.x, pw.y, pw.z, pw.w}; float x[8];
#pragma unroll
      for (int j = 0; j < 4; ++j) { const float c0 = bf_lo(cwa[j]), c1 = bf_hi(cwa[j]), p0 = bf_lo(pwa[j]), p1 = bf_hi(pwa[j]);
          const float mu0 = j < 2 ? m0v[2 * j] : m1v[2 * j - 4], mu1 = j < 2 ? m0v[2 * j + 1] : m1v[2 * j - 3];
          x[2 * j] = fast_sigmoid(c0 + mu0 * (p0 - c0)); x[2 * j + 1] = fast_sigmoid(c1 + mu1 * (p1 - c1)); }
      const u32x4 o = {cvtpk(x[0], x[1]), cvtpk(x[2], x[3]), cvtpk(x[4], x[5]), cvtpk(x[6], x[7])};
      __syncthreads();
      *(LAS u32x4*)(IMG + (t + 1) * PV2 + 1024 + 16 * kp) = o;
      __syncthreads(); }
    const int hd = F.wave; int r = tid & 31, h = (tid >> 5) & 1;
    const LAS unsigned char* rowc = IMG + (r + 1) * PV2; const LAS unsigned char* rowp = IMG + r * PV2;
    const size_t uid = ((size_t)(b * 8 + hd) * 128 + c);
    const unsigned char* gS = F.ws + WS_R2 + uid * SZ_H; const unsigned char* gQ = F.ws + WS_H0 + uid * SZ_Q; const unsigned char* gY = F.ws + WS_H1 + uid * SZ_Y;
#define RK_LD(base, piece) __builtin_bit_cast(bf16x8, *(const u32x4*)((base) + (piece) * 1024 + (tid & 63) * 16))
    f32x16 gl[2]; gl[0] = f32x16{}; gl[1] = f32x16{};
    { const bf16_t* GUt = (const bf16_t*)(F.ws + WS_GUT) + (size_t)hd * 64 * 128;
#pragma unroll
      for (int ks = 0; ks < 8; ++ks) { const int k0 = 16 * ks + 8 * h; const bf16x8 bg = *(const LAS bf16x8*)(rowc + 1024 + k0 * 2);
#pragma unroll
          for (int it = 0; it < 2; ++it) { const bf16x8 fg = *(const bf16x8*)(GUt + (size_t)(32 * it + r) * 128 + k0); gl[it] = RK_MF(fg, bg, gl[it]); } } }
    f32x16 Y[2];
    { const bf16x8 fQ[2][2] = {{RK_LD(gQ, 0), RK_LD(gQ, 1)}, {RK_LD(gQ, 2), RK_LD(gQ, 3)}};
#pragma unroll
      for (int it = 0; it < 2; ++it) { unfrag<0>(Y[it], RK_LD(gY, 2 * it)); unfrag<1>(Y[it], RK_LD(gY, 2 * it + 1));
#pragma unroll
          for (int jt = 0; jt < 2; ++jt) { if (PROBE_NO_STATE) continue; Y[it] = RK_MF(RK_LD(gS, 2 * (jt * 2 + it)), fQ[jt][0], Y[it]); Y[it] = RK_MF(RK_LD(gS, 2 * (jt * 2 + it) + 1), fQ[jt][1], Y[it]); } } }
    float s1 = 0.f;
#pragma unroll
    for (int it = 0; it < 2; ++it)
#pragma unroll
        for (int i = 0; i < 16; ++i) s1 += Y[it][i];
    s1 += __shfl_xor(s1, 32); const float mean = s1 * (1.0f / 64.0f); float s2 = 0.f;
#pragma unroll
    for (int it = 0; it < 2; ++it)
#pragma unroll
        for (int i = 0; i < 16; ++i) { const float d = Y[it][i] - mean; s2 += d * d; }
    s2 += __shfl_xor(s2, 32); const float rstd = 1.0f / sqrtf(s2 * (1.0f / 64.0f) + GN_EPS);
    const float bn = ((const float*)(F.ws + WS_TOPW))[(m0 + r) * 8 + hd];
    LAS unsigned char* stg = F.lds + 49152 + F.wave * 4608;
#pragma unroll
    for (int it = 0; it < 2; ++it)
#pragma unroll
        for (int g = 0; g < 4; ++g) { const int cl = 32 * it + 8 * g + 4 * h, cj = hd * 64 + cl;
            const u32x2 a = *(const LAS u32x2*)(rowc + cj * 2), p = *(const LAS u32x2*)(rowp + cj * 2);
            const float vc[4] = {bf_lo(a.x), bf_hi(a.x), bf_lo(a.y), bf_hi(a.y)}, vq[4] = {bf_lo(p.x), bf_hi(p.x), bf_lo(p.y), bf_hi(p.y)};
            const f32x4 muv = *(const f32x4*)(mu + 1024 + cj), lg = *(const f32x4*)(AIN(16) + cj), lb = *(const f32x4*)(AIN(17) + cj);
            float o[4];
#pragma unroll
            for (int q = 0; q < 4; ++q) { const int i = 4 * g + q; const float v_ = vc[q] + muv[q] * (vq[q] - vc[q]);
                o[q] = ((Y[it][i] - mean) * rstd * lg[q] + lb[q] + bn * v_) * gl[it][i]; }
            *(LAS u32x2*)(stg + r * 144 + cl * 2) = (u32x2){cvtpk(o[0], o[1]), cvtpk(o[2], o[3])}; }
    asm volatile("s_waitcnt lgkmcnt(0)" ::: "memory");
    bf16_t* OUT = (bf16_t*)(F.ws + WS_R0) + m0 * 512 + hd * 64;
#pragma unroll
    for (int i = 0; i < 4; ++i) { const int row = i * 8 + ((tid & 63) >> 3), chn = tid & 7; const u32x4 v = *(const LAS u32x4*)(stg + row * 144 + chn * 16); *(u32x4*)(OUT + (size_t)row * 512 + chn * 8) = v; }
#undef RK_LD
#undef RK_ST
}
}
__device__ __forceinline__ void route_token(float lg, float bias, int lane, int tok, int* TE, float* TW, LAS unsigned* lcnt) {
    const float s = 1.0f / (1.0f + expf(-lg));
    const float c = s + bias;
    const unsigned kc = ord_key(c);
#define RT_MAXD(v_, ctrl) { const unsigned o_ = (unsigned)__builtin_amdgcn_update_dpp(0, (int)(v_), (ctrl), 0xF, 0xF, true); v_ = (v_) > o_ ? (v_) : o_; }
#define RT_INV(k_) (((k_) & 0x80000000u) ? __uint_as_float((k_) & 0x7FFFFFFFu) : __uint_as_float(~(k_)))
    unsigned m1 = kc; RT_MAXD(m1, 0xB1) RT_MAXD(m1, 0x4E) RT_MAXD(m1, 0x141)
    const unsigned long long b1 = __builtin_amdgcn_ballot_w64(kc == m1);
    const unsigned gb = (unsigned)(b1 >> (lane & 56)) & 0xFFu;
    unsigned m2 = ((lane & 7) == __builtin_ctz(gb)) ? 0u : kc; RT_MAXD(m2, 0xB1) RT_MAXD(m2, 0x4E) RT_MAXD(m2, 0x141)
    const float gs = RT_INV(m1) + RT_INV(m2);
    unsigned gcur = ord_key(gs); bool gsel = false;
#pragma unroll
    for (int j = 0; j < 4; ++j) { unsigned v = gcur; RT_MAXD(v, 0xB1) RT_MAXD(v, 0x4E) RT_MAXD(v, 0x141) RT_MAXD(v, 0x140)
        const unsigned a0_ = (unsigned)__builtin_amdgcn_readlane((int)v, 0), a1_ = (unsigned)__builtin_amdgcn_readlane((int)v, 16), a2_ = (unsigned)__builtin_amdgcn_readlane((int)v, 32), a3_ = (unsigned)__builtin_amdgcn_readlane((int)v, 48);
        const unsigned x_ = a0_ > a1_ ? a0_ : a1_, y_ = a2_ > a3_ ? a2_ : a3_; const unsigned m_ = x_ > y_ ? x_ : y_;
        const int win = __builtin_ctzll(__builtin_amdgcn_ballot_w64(gcur == m_));
        if ((lane >> 3) == (win >> 3)) { gsel = true; gcur = 0u; } }
    unsigned cur = gsel ? kc : 0u; int erk = 64;
#pragma unroll
    for (int j = 0; j < 8; ++j) { unsigned v = cur; RT_MAXD(v, 0xB1) RT_MAXD(v, 0x4E) RT_MAXD(v, 0x141) RT_MAXD(v, 0x140)
        const unsigned a0_ = (unsigned)__builtin_amdgcn_readlane((int)v, 0), a1_ = (unsigned)__builtin_amdgcn_readlane((int)v, 16), a2_ = (unsigned)__builtin_amdgcn_readlane((int)v, 32), a3_ = (unsigned)__builtin_amdgcn_readlane((int)v, 48);
        const unsigned x_ = a0_ > a1_ ? a0_ : a1_, y_ = a2_ > a3_ ? a2_ : a3_; const unsigned m_ = x_ > y_ ? x_ : y_;
        const int win = __builtin_ctzll(__builtin_amdgcn_ballot_w64(cur == m_));
        if (lane == win) { erk = j; cur = 0u; } }
#undef RT_MAXD
#undef RT_INV
    const bool sel = erk < 8;
    const float ssum = wave_sum(sel ? s : 0.f);
    if (sel) { TE[(size_t)tok * 8 + erk] = lane; TW[(size_t)tok * 8 + erk] = s / ssum * 2.5f; atomicAdd((unsigned*)&lcnt[(tok >= M / 2 ? 64 : 0) + lane], 1u); }
}
__device__ __forceinline__ void norm2_route_wave(const Args& args, Frame& F, LAS unsigned* lcnt) {
    bf16_t* H2 = (bf16_t*)(F.ws + WS_H2);
    norm_mod_rows(args, F, F.out, AIN(21), 3072, 4096, H2, nullptr);
    asm volatile("s_waitcnt vmcnt(0)" ::: "memory");
    const int lane = F.lane, row0 = F.gw * 16;
    const bf16_t* ap = H2 + (size_t)(row0 + (lane & 15)) * D + 8 * (lane >> 4);
    const bf16_t* bp = (const bf16_t*)(F.ws + WS_WRT) + (size_t)(lane & 15) * D + 8 * (lane >> 4);
    f32x4 acc[4] = {f32x4{}, f32x4{}, f32x4{}, f32x4{}};
#pragma unroll 1
    for (int k0 = 0; k0 < 32; k0 += 4) { bf16x8 a_[4], b_[4][4];
#pragma unroll
        for (int i = 0; i < 4; ++i) { a_[i] = *(const bf16x8*)(ap + 32 * (k0 + i));
#pragma unroll
            for (int nt = 0; nt < 4; ++nt) b_[i][nt] = *(const bf16x8*)(bp + (size_t)(16 * nt) * D + 32 * (k0 + i)); }
#pragma unroll
        for (int i = 0; i < 4; ++i)
#pragma unroll
            for (int nt = 0; nt < 4; ++nt) acc[nt] = __builtin_amdgcn_mfma_f32_16x16x32_bf16(a_[i], b_[i][nt], acc[nt], 0, 0, 0); }
    LAS float* scr = (LAS float*)(F.lds + F.wave * 16384);
#pragma unroll
    for (int nt = 0; nt < 4; ++nt)
#pragma unroll
        for (int i = 0; i < 4; ++i) scr[(4 * (lane >> 4) + i) * 65 + 16 * nt + (lane & 15)] = acc[nt][i];
    asm volatile("s_waitcnt lgkmcnt(0)" ::: "memory");
    int* TE = (int*)(F.ws + WS_TOPE); float* TW = (float*)(F.ws + WS_TOPW);
    const float bias = AIN(23)[lane];
#pragma unroll 1
    for (int t = 0; t < 16; ++t) route_token(scr[t * 65 + lane], bias, lane, row0 + t, TE, TW, lcnt);
    asm volatile("s_waitcnt lgkmcnt(0)" ::: "memory");
}
__device__ __forceinline__ void norm2_route_convert(const Args& args, Frame& F) {
    LAS unsigned* lcnt = (LAS unsigned*)(F.lds + LDS_TILETAB);
    if (F.tid < 128) lcnt[F.tid] = 0u;
    __syncthreads();
    constexpr int KIT = (64 * (16 * 16 + 4 * 32) + NWAVES * 256 - 1) / (NWAVES * 256) + 1;
    if (F.wave < 4) { norm2_route_wave(args, F, lcnt); convert_experts(args, F, 0, KIT); }
    else { convert_experts(args, F, 0, KIT / 2); norm2_route_wave(args, F, lcnt); convert_experts(args, F, KIT / 2, KIT); }
    __syncthreads();
    if (F.tid < 128 && lcnt[F.tid]) atomicAdd(F.ctl + CW_CNT + F.tid, lcnt[F.tid]);
    __syncthreads();
}
struct MoeTab { int ntiles0, ntiles; };
__device__ __forceinline__ MoeTab build_tiles(const Args& args, Frame& F) {
    LAS unsigned* tab = (LAS unsigned*)(F.lds + LDS_TILETAB);
    LAS unsigned* offs = tab + 2432; LAS unsigned* tpre = tab + 2560;
    if (F.tid == 0) { unsigned o = 0, tp = 0;
        for (int l = 0; l < 128; ++l) { const unsigned c = __hip_atomic_load(F.ctl + CW_CNT + l, RLX_AGENT); offs[l] = o; tpre[l] = tp; o += c; tp += (c + 255u) >> 8; }
        tpre[128] = tp; }
    __syncthreads();
    if (F.tid < 128) { const int l = F.tid; const unsigned c = __hip_atomic_load(F.ctl + CW_CNT + l, RLX_AGENT); const unsigned o = offs[l], t0 = tpre[l], nt = (c + 255u) >> 8;
        for (unsigned i = 0; i < nt; ++i) { const unsigned rows = (c - 256u * i) < 256u ? (c - 256u * i) : 256u; tab[2 * (t0 + i)] = (o + 256u * i) | ((unsigned)(l & 63) << 20); tab[2 * (t0 + i) + 1] = rows; } }
    __syncthreads();
    MoeTab r; r.ntiles0 = (int)tpre[64]; r.ntiles = (int)tpre[128]; return r;
}
__device__ __forceinline__ void scatter_phase(const Args& args, Frame& F) {
    LAS unsigned* tab = (LAS unsigned*)(F.lds + LDS_TILETAB); LAS unsigned* offs = tab + 2432;
    LAS unsigned* lcnt = (LAS unsigned*)(F.lds); LAS unsigned* lbase = lcnt + 128;
    const int* TE = (const int*)(F.ws + WS_TOPE); const float* TW = (const float*)(F.ws + WS_TOPW);
    int* ST = (int*)(F.ws + WS_STOK); float* SW = (float*)(F.ws + WS_SW);
    for (int blk = blockIdx.x; blk < M / 128; blk += F.G) {
        if (F.tid < 128) lcnt[F.tid] = 0u;
        __syncthreads();
        const int tok0 = blk * 128, hf = tok0 >= M / 2 ? 64 : 0;
        int lst[2]; unsigned rnk[2];
#pragma unroll
        for (int i = 0; i < 2; ++i) { const int p = F.tid + 512 * i; lst[i] = hf + TE[(size_t)tok0 * 8 + p]; rnk[i] = atomicAdd((unsigned*)&lcnt[lst[i]], 1u); }
        __syncthreads();
        if (F.tid < 128) lbase[F.tid] = lcnt[F.tid] ? atomicAdd(F.ctl + CW_CUR + F.tid, lcnt[F.tid]) : 0u;
        __syncthreads();
#pragma unroll
        for (int i = 0; i < 2; ++i) { const int p = F.tid + 512 * i; const unsigned pos = offs[lst[i]] + lbase[lst[i]] + rnk[i];
            ST[pos] = tok0 * 8 + p; SW[pos] = TW[(size_t)tok0 * 8 + p]; }
        __syncthreads();
    }
}

__device__ __forceinline__ void final_rows(const Args& args, Frame& F, int row_lo, int row_hi, int tokbase) {
    const unsigned char* SL = (const unsigned char*)(F.ws + WS_SLOT);
    const int cA = 256 * (F.lane >> 4) + 32 * ((F.lane >> 2) & 3) + 8 * (F.lane & 3), cB = cA + 128;
    for (int blk = F.gw; blk < (row_hi - row_lo) / 16; blk += F.NGW) {
        const int r0 = row_lo + blk * 16, b = r0 / SEQ;
        const float* g2 = (const float*)(F.ws + WS_MOD) + b * 6144 + 5120; const float* fgp = AIN(30);
        f32x4 gv[4], fg[4];
#pragma unroll
        for (int j = 0; j < 4; ++j) { const int c = (j < 2 ? cA : cB) + 4 * (j & 1); gv[j] = *(const f32x4*)(g2 + c) * (1.0f / SLOT_SCALE); fg[j] = *(const f32x4*)(fgp + c); }
        for (int r = 0; r < 16; ++r) { const size_t m = (size_t)(r0 + r);
            f32x4 acc[4];
#pragma unroll
            for (int j = 0; j < 4; ++j) acc[j] = (f32x4){0.f, 0.f, 0.f, 0.f};
            const unsigned char* sp = SL + (m - tokbase) * NSLOT * D + 16 * F.lane;
            u32x4 w[NSLOT];
#pragma unroll
            for (int k = 0; k < NSLOT; ++k) w[k] = *(const u32x4*)(sp + (size_t)k * D);
#pragma unroll
            for (int k = 0; k < NSLOT; ++k) { const unsigned ww[4] = {w[k].x, w[k].y, w[k].z, w[k].w};
#pragma unroll
                for (int j = 0; j < 4; ++j) { const f32x2 a = __builtin_amdgcn_cvt_pk_f32_fp8((int)ww[j], false), c = __builtin_amdgcn_cvt_pk_f32_fp8((int)ww[j], true); acc[j] += (f32x4){a.x, a.y, c.x, c.y}; } }
            float* xr = F.out + m * D; f32x4 v[4]; float s = 0.f;
#pragma unroll
            for (int j = 0; j < 4; ++j) { const int c = (j < 2 ? cA : cB) + 4 * (j & 1); v[j] = *(const f32x4*)(xr + c) + gv[j] * acc[j]; s += (v[j].x * v[j].x + v[j].y * v[j].y) + (v[j].z * v[j].z + v[j].w * v[j].w); }
            const float rstd = 1.0f / sqrtf(wave_sum(s) * (1.0f / D) + RMS_EPS);
#pragma unroll
            for (int j = 0; j < 4; ++j) { const int c = (j < 2 ? cA : cB) + 4 * (j & 1); *(f32x4*)(xr + c) = v[j] * rstd * fg[j]; }
        }
    }
}
constexpr int N_PHASES = 15;
#ifndef PROBE_ATT_SCALE
#define PROBE_ATT_SCALE 1.0f
#endif
#ifndef PROBE_IDX_REP
#define PROBE_IDX_REP 1
#endif
#ifndef R2_WGS
#define R2_WGS 32
#endif
#ifndef PROBE_P5_PART
#define PROBE_P5_PART 0
#endif
#ifndef PROBE_RW_SCALE
#define PROBE_RW_SCALE 1.0f
#endif

__global__ void __launch_bounds__(NTHR, 2) fwd_kernel(Args args) {
    extern __shared__ __attribute__((aligned(16))) unsigned char lds_raw[];
    Frame F;
    F.lds = (LAS unsigned char*)lds_raw;
    F.MISC = (volatile LAS unsigned*)(F.lds + MISC_OFF);
    F.tid = threadIdx.x; F.lane = F.tid & 63; F.wave = __builtin_amdgcn_readfirstlane(F.tid >> 6);
    F.G = gridDim.x; { const int bx = blockIdx.x; F.vcu = (F.G % 8 == 0) ? (bx % 8) * (F.G / 8) + bx / 8 : bx; }
    F.gw = blockIdx.x * NWAVES + F.wave; F.NGW = F.G * NWAVES;
    F.ws = args.ws; F.out = args.out; F.ctl = (unsigned*)(args.ws + WS_CTL);
    for (int u = F.tid; u < (LDS_BYTES - LDSCTL_OFF) / 4; u += NTHR) ((LAS unsigned*)(F.lds + LDSCTL_OFF))[u] = 0u;
    __syncthreads();
    if (F.tid == 0) {
#pragma unroll
        for (int i = 0; i < 31; ++i) *(LAS unsigned long long*)(F.lds + LDS_PTAB + 8 * i) = (unsigned long long)args.in[i];
        *(LAS unsigned long long*)(F.lds + LDS_PTAB + 8 * 31) = (unsigned long long)args.out; *(LAS unsigned long long*)(F.lds + LDS_PTAB + 8 * 32) = (unsigned long long)args.ws; }
    __syncthreads();
    XcdBarrier bar = xcd_barrier_post(F.ctl + CW_BAR + args.li * XCD_BAR_WORDS, F.MISC + 8);
    const int lo = args.ph_lo, hi = args.ph_hi;
#ifndef PHASE_MASK
#define PHASE_MASK 0xFFFFFFFFu
#endif
#define IN(k) ((((PHASE_MASK) >> (k)) & 1u) && lo <= (k) && (k) < hi)
#define PB() do { F.ws = (unsigned char*)ain_ptr(F.lds, 32); F.out = (float*)ain_ptr(F.lds, 31); F.ctl = (unsigned*)(F.ws + WS_CTL); \
        F.lane = (int)__builtin_amdgcn_mbcnt_hi(~0u, __builtin_amdgcn_mbcnt_lo(~0u, 0u)); F.tid = F.wave * 64 + F.lane; } while (0)
#define ZB ((bf16_t*)(F.ws + WS_Z))
#define GATES ((bf16_t*)F.out)
#define MOD ((const float*)(F.ws + WS_MOD))
#define SEAM(k) do { if (IN(k) && IN((k) + 1)) xcd_barrier(bar); } while (0)

    if (IN(0)) { PB(); p0_prologue(args, F); } SEAM(0);
    if (IN(1)) { PB(); norm_mod_rows(args, F, AIN(0), AIN(4), 0, 1024, nullptr, F.ws + WS_H0); } SEAM(1);
    if (IN(2)) { PB(); pg8::StaticOrder S; S.init(M, NIN, F.G, (int)blockIdx.x); pg8::DenseSrcT<1> G{F.ws + WS_H0, F.ws + WS_WIN, 1024};
        EpiInProj E{ZB, GATES}; pg8::gemm_phase<EpiInProj, pg8::StaticOrder, pg8::DenseSrcT<1>>(F.lds, 1024, S, G, E); } SEAM(2);
    if (IN(3)) { PB(); rk::load_params(args, F); for (int u = blockIdx.x; u < 1024; u += F.G) rk::r1_unit(args, F, u >> 7, u & 127); __syncthreads(); } SEAM(3);
    if (IN(4)) { PB();
#ifdef PROBE_R2_DRY
        if (blockIdx.x < R2_WGS && F.wave < 128 / R2_WGS) rk::r2_task<1>(args, F, blockIdx.x * (128 / R2_WGS) + F.wave);
#endif
        if (blockIdx.x < R2_WGS && F.wave < 128 / R2_WGS) rk::r2_task<0>(args, F, blockIdx.x * (128 / R2_WGS) + F.wave);
#pragma unroll 1
        for (int rep = 0; rep < PROBE_IDX_REP; ++rep)
        for (;;) {
            __syncthreads();
            if (F.tid == 0) F.MISC[12] = atomicAdd(F.ctl + CW_Q + rep, 1u);
            __syncthreads();
            const int u = (int)F.MISC[12];
            if (u >= 2048) break;
            indexer_unit(args, F, u & 7, (255 - (u >> 3)) * 16);
        } } SEAM(4);
    if (IN(5)) { PB(); if (!((PROBE_P5_PART & 2) && args.li == 1)) { for (int u = blockIdx.x; u < 1024; u += F.G) rk::r3_unit(args, F, u >> 7, u & 127); } __syncthreads();
        if (!((PROBE_P5_PART & 1) && args.li == 1)) for (int i = 0; i < 4; ++i) for (int uu = F.vcu; uu < 256; uu += F.G) { const int bh = uu >> 2, s = uu & 3; const int qb = (i == 0) ? s : (i == 1) ? 7 - s : (i == 2) ? 8 + s : 15 - s;
            att::attn_unit(args, F, bh >> 3, bh & 7, qb); } __syncthreads(); } SEAM(5);
    if (IN(6)) { PB(); pg8::StaticOrder S; S.init(M, D, F.G, (int)blockIdx.x);
        { pg8::DenseSrc G{F.ws + WS_R1, F.ws + WS_WA, 512}; EpiMerge<0> E{(bf16_t*)(F.ws + WS_R2), F.ws + WS_H0, GATES, PROBE_ATT_SCALE}; pg8::gemm_phase<EpiMerge<0>, pg8::StaticOrder, pg8::DenseSrc>(F.lds, 512, S, G, E); }
        { pg8::DenseSrc G{F.ws + WS_R0, F.ws + WS_WR, 512}; EpiMerge<1> E{(bf16_t*)(F.ws + WS_R2), F.ws + WS_H0, GATES, PROBE_RW_SCALE}; pg8::gemm_phase<EpiMerge<1>, pg8::StaticOrder, pg8::DenseSrc>(F.lds, 512, S, G, E); } } SEAM(6);
    if (IN(7)) { PB(); pg8::StaticOrder S; S.init(M, D, F.G, (int)blockIdx.x); pg8::DenseSrcT<1> G{F.ws + WS_H0, F.ws + WS_WO, 1024};
        EpiOutProj E{AIN(0), F.out, MOD}; pg8::gemm_phase<EpiOutProj, pg8::StaticOrder, pg8::DenseSrcT<1>>(F.lds, 1024, S, G, E); } SEAM(7);
    if (IN(8)) { PB(); norm2_route_convert(args, F); }
    if (IN(8) && IN(11)) xcd_barrier(bar);
    MoeTab mt{0, 0};
    if (lo <= 13 && hi > 13) { PB(); mt = build_tiles(args, F); scatter_phase(args, F); } else if (hi > 13) { PB(); mt = build_tiles(args, F); }
    SEAM(11);
    const LAS unsigned* tab = (const LAS unsigned*)(F.lds + LDS_TILETAB);
    if (IN(12)) { PB(); MoeSched1 S{tab, mt.ntiles, F.G, F.vcu};            MoeSrc1 G{F.ws};
        EpiMoe1 E{F.ws}; pg8::gemm_phase<EpiMoe1, MoeSched1, MoeSrc1>(F.lds, 1024, S, G, E); } SEAM(12);
    if (IN(13)) { PB(); MoeSched2 S{tab, 0, mt.ntiles, 512, F.G, F.vcu}; MoeSrc2 G{F.ws}; EpiMoe2 E; E.ws = F.ws; E.X1 = F.out; E.tokbase = 0;
        pg8::gemm_phase<EpiMoe2, MoeSched2, MoeSrc2>(F.lds, 256, S, G, E); } SEAM(13);
    if (IN(14)) { PB(); final_rows(args, F, 0, M, 0); }
#ifdef PROBE_CYC
    __syncthreads();
    if (blockIdx.x == 0 && F.tid == 0) { asm volatile("s_waitcnt vmcnt(0)" ::: "memory"); F.out[0] = (float)(F.ctl[CW_Q + 64]); }
#endif
#undef IN
#undef SEAM
#undef PB
}

extern "C" void kernel_launch(void* const* d_in, const int* in_sizes, int n_in, void* d_out, int out_size, void* d_ws, size_t ws_size, hipStream_t stream) {
    static int grid = 0;
    if (grid == 0) {
        if (n_in != 31 || out_size != M * D || ws_size < WS_END) { fprintf(stderr, "kernel_launch: unexpected problem (n_in %d, out %d, ws %zu)\n", n_in, out_size, ws_size); grid = -1; return; }
        int dev = 0, cus = 0, per_cu = 0;
        if (hipGetDevice(&dev) != hipSuccess || hipDeviceGetAttribute(&cus, hipDeviceAttributeMultiprocessorCount, dev) != hipSuccess) { grid = -1; return; }
        if (hipFuncSetAttribute((const void*)fwd_kernel, hipFuncAttributeMaxDynamicSharedMemorySize, LDS_BYTES) != hipSuccess) { fprintf(stderr, "kernel_launch: hipFuncSetAttribute failed\n"); grid = -1; return; }
        if (hipOccupancyMaxActiveBlocksPerMultiprocessor(&per_cu, (const void*)fwd_kernel, NTHR, LDS_BYTES) != hipSuccess || per_cu < 1) fprintf(stderr, "kernel_launch: occupancy query reports %d\n", per_cu);
        (void)hipGetLastError();
        grid = cus;
        if (grid != 256) fprintf(stderr, "kernel_launch: %d CUs (built for 256)\n", grid);
    }
    if (grid < 0) return;
    (void)in_sizes;
    if (hipMemsetAsync((char*)d_ws + WS_CTL, 0, CTL_ZERO_BYTES, stream) != hipSuccess) return;
    Args a{};
    for (int i = 0; i < 31; ++i) a.in[i] = (const float*)d_in[i];
    a.out = (float*)d_out; a.ws = (unsigned char*)d_ws;
#ifndef PROBE_REPEAT
#define PROBE_REPEAT -1
#endif
    int li = 0;
    auto go = [&](int lo_, int hi_) { a.ph_lo = lo_; a.ph_hi = hi_; a.li = li++; hipLaunchKernelGGL(fwd_kernel, dim3(grid), dim3(NTHR), LDS_BYTES, stream, a); };
    if (PROBE_REPEAT < 0) go(0, N_PHASES);
    else { go(0, PROBE_REPEAT + 1); go(PROBE_REPEAT, PROBE_REPEAT + 1); if (PROBE_REPEAT + 1 < N_PHASES) go(PROBE_REPEAT + 1, N_PHASES); }
}
```

```cpp
#include <hip/hip_runtime.h>
#include <cstdio>
#include <cstdint>
#include <cmath>

#define GAS __attribute__((address_space(1)))
#define LAS __attribute__((address_space(3)))
typedef unsigned short bf16_t;
typedef short bf16x8 __attribute__((ext_vector_type(8)));
typedef float f32x4 __attribute__((ext_vector_type(4)));
typedef float f32x2 __attribute__((ext_vector_type(2)));
typedef float f32x16 __attribute__((ext_vector_type(16)));
typedef unsigned u32x4 __attribute__((ext_vector_type(4)));
typedef unsigned u32x2 __attribute__((ext_vector_type(2)));
typedef GAS unsigned gu32;

__device__ __forceinline__ unsigned cvt_pk_bf16(float lo, float hi) { unsigned r; asm volatile("v_cvt_pk_bf16_f32 %0, %1, %2" : "=v"(r) : "v"(lo), "v"(hi)); return r; }
__device__ __forceinline__ float bf_lo(unsigned w) { return __uint_as_float(w << 16); }
__device__ __forceinline__ float bf_hi(unsigned w) { return __uint_as_float(w & 0xffff0000u); }
__device__ __forceinline__ float bf2f(bf16_t b) { return __uint_as_float(((unsigned)b) << 16); }
__device__ __forceinline__ unsigned f2bf(float f) { unsigned u = __float_as_uint(f); return (u + 0x7fffu + ((u >> 16) & 1u)) >> 16; }
__device__ __forceinline__ unsigned pk2(float lo, float hi) { return f2bf(lo) | (f2bf(hi) << 16); }
__device__ __forceinline__ float fast_sigmoid(float x) { return __builtin_amdgcn_rcpf(1.0f + __builtin_amdgcn_exp2f(-1.4426950408889634f * x)); }
__device__ __forceinline__ float wave_sum(float v) {
#define WS_DPP(ctrl) v += __int_as_float(__builtin_amdgcn_update_dpp(0, __float_as_int(v), (ctrl), 0xF, 0xF, true));
    WS_DPP(0xB1) WS_DPP(0x4E) WS_DPP(0x141) WS_DPP(0x140)
#undef WS_DPP
    const int vi = __float_as_int(v);
    return (__int_as_float(__builtin_amdgcn_readlane(vi, 0)) + __int_as_float(__builtin_amdgcn_readlane(vi, 16))) + (__int_as_float(__builtin_amdgcn_readlane(vi, 32)) + __int_as_float(__builtin_amdgcn_readlane(vi, 48)));
}

namespace pg8 {
constexpr int BM = 256, BK = 64, HALF = 128, HTB = HALF * BK * 2, STAGE_BYTES = 8 * HTB, NXCD = 8, WGM = 8;
__host__ __device__ __forceinline__ int lds_byte(int r, int c) { const int st = (r >> 4) * 2 + (c >> 5), rr = r & 15, cc = c & 31, ob = rr * 64 + cc * 2; return st * 1024 + (ob ^ (((ob >> 9) & 1) << 5)); }
__host__ __device__ __forceinline__ void stage_rc(int b, int& R, int& C) { const int st = b / 1024, sb = b % 1024, swz = sb ^ (((sb >> 9) & 1) << 5); R = (st >> 1) * 16 + swz / 64; C = (st & 1) * 32 + (swz % 64) / 2; }
__host__ __device__ __forceinline__ int perm32(int rho) { const int n = rho >> 4, i = rho & 15; return 8 * (i >> 2) + 4 * n + (i & 3); }

struct Unit { int pm, pn; int aux0, aux1; };

struct StaticOrder {
    int nM, nN, nwg, G, c;
    __host__ __device__ void init(int M, int N, int G_, int c_) { nM = M / BM; nN = N / BM; nwg = nM * nN; G = G_; c = c_; }
    __host__ __device__ bool next(int i, Unit& u) const {
        const long L = (long)i * G + c; if (L >= nwg) return false;
        int wgid = (int)L; { const int q = nwg / NXCD, r = nwg % NXCD, xcd = wgid % NXCD, off = wgid / NXCD; wgid = (xcd < r ? xcd * (q + 1) : r * (q + 1) + (xcd - r) * q) + off; }
        const int nig = WGM * nN, gid = wgid / nig, fm = gid * WGM, gsz = (nM - fm) < WGM ? (nM - fm) : WGM;
        u.pm = fm + ((wgid % nig) % gsz); u.pn = (wgid % nig) / gsz; u.aux0 = 0; u.aux1 = 0; return true;
    }
};

template <int ESZ_> struct DenseSrcT {
    static constexpr int ESZ = ESZ_; static constexpr bool GATHER = false;
    const void* A; const void* Bt; int K;
    __device__ __forceinline__ const char* b_base(const Unit& u) const { return (const char*)Bt + (size_t)u.pn * 256 * K * ESZ; }
    __device__ __forceinline__ const char* a_base(const Unit& u) const { return (const char*)A + (size_t)u.pm * 256 * K * ESZ; }
    __device__ __forceinline__ unsigned a_off(const Unit&, int R, int C) const { return (unsigned)(R * K * ESZ) + (unsigned)C * 2u; }
};
typedef DenseSrcT<2> DenseSrc;
typedef int v8i32 __attribute__((ext_vector_type(8)));

template <class T, class = void> struct has_prefetch { static constexpr bool value = false; };
template <class T> struct has_prefetch<T, decltype((void)&T::prefetch)> { static constexpr bool value = true; };
template <class Epi, class Sched, class Src, bool ALIGN_EPI = true>
__device__ __forceinline__ void gemm_phase(LAS unsigned char* lds, const int K, const Sched& S, const Src& G, const Epi& E) {
    const int tid = threadIdx.x, wid = __builtin_amdgcn_readfirstlane(tid >> 6), lane = tid & 63, wr = wid >> 2, wc = wid & 3, fr = lane & 15, fq = lane >> 4;
    constexpr int ESZ = Src::ESZ; const int Kb = K * ESZ;
    const int nt = Kb / (BK * 2);
    unsigned voffB0;
    { int R, C; stage_rc(tid * 16, R, C); const int Rb = Epi::PERM ? ((R & ~31) + perm32(R & 31)) : R; voffB0 = (unsigned)(Rb * Kb) + (unsigned)C * 2u; }
#define PG8_AOFF(u, h, i) ([&]() { int R_, C_; stage_rc(tid * 16 + (i) * 8192, R_, C_); return G.a_off((u), R_ + (h) * HALF, C_); }())
    const size_t kstep = (size_t)(BK * 2);
    const size_t hstepB = (size_t)HALF * Kb;
    const unsigned ldsw = (unsigned)wid * 1024u;
    const int aoff = lds_byte(wr * 64 + fr, fq * 8), boff = lds_byte(wc * 32 + fr, fq * 8);
#define PG8_SA(b, h) (((b) * 2 + (h)) * HTB)
#define PG8_SB(b, h) ((4 + (b) * 2 + (h)) * HTB)
#define PG8_STAGEB(bufoff, gbase) do { _Pragma("unroll") for (int _i = 0; _i < 2; ++_i) { unsigned o_ = voffB0; asm volatile("" : "+v"(o_)); \
        __builtin_amdgcn_global_load_lds((const unsigned*)((const char*)(gbase) + (size_t)_i * 64 * Kb + o_), (LAS unsigned*)(lds + (bufoff) + ldsw + _i * 8192), 16, 0, 0); } } while (0)
#define PG8_STAGEA(bufoff, gbase, vo, h) do { _Pragma("unroll") for (int _i = 0; _i < 2; ++_i) { unsigned o_ = Src::GATHER ? (vo)[h][_i] : (vo)[0][0]; asm volatile("" : "+v"(o_)); \
        __builtin_amdgcn_global_load_lds((const unsigned*)((const char*)(gbase) + (Src::GATHER ? (size_t)0 : (size_t)((h) * 128 + _i * 64) * Kb) + o_), (LAS unsigned*)(lds + (bufoff) + ldsw + _i * 8192), 16, 0, 0); } } while (0)
#define PG8_STAGEA2(bufoff, gbase, h) do { _Pragma("unroll") for (int _i = 0; _i < 2; ++_i) { unsigned o_ = Src::GATHER ? (last ? vn[h][_i] : vc[h][_i]) : vc[0][0]; asm volatile("" : "+v"(o_)); \
        __builtin_amdgcn_global_load_lds((const unsigned*)((const char*)(gbase) + (Src::GATHER ? (size_t)0 : (size_t)((h) * 128 + _i * 64) * Kb) + o_), (LAS unsigned*)(lds + (bufoff) + ldsw + _i * 8192), 16, 0, 0); } } while (0)
#define PG8_LDA(dst, b, h) do { _Pragma("unroll") for (int m = 0; m < 4; ++m) { const u32x4 lo_ = *(const LAS u32x4*)(lds + PG8_SA(b, h) + aoff + m * 2048), hi_ = *(const LAS u32x4*)(lds + PG8_SA(b, h) + aoff + m * 2048 + 1024); \
        dst[m] = __builtin_shufflevector(lo_, hi_, 0, 1, 2, 3, 4, 5, 6, 7); } } while (0)
#define PG8_LDB(dst, b, h) do { _Pragma("unroll") for (int n = 0; n < 2; ++n) { const u32x4 lo_ = *(const LAS u32x4*)(lds + PG8_SB(b, h) + boff + n * 2048), hi_ = *(const LAS u32x4*)(lds + PG8_SB(b, h) + boff + n * 2048 + 1024); \
        dst[n] = __builtin_shufflevector(lo_, hi_, 0, 1, 2, 3, 4, 5, 6, 7); } } while (0)
#define PG8_LO(x) __builtin_bit_cast(bf16x8, __builtin_shufflevector((x), (x), 0, 1, 2, 3))
#define PG8_HI(x) __builtin_bit_cast(bf16x8, __builtin_shufflevector((x), (x), 4, 5, 6, 7))
#define PG8_MMA(ai, bj, At, Bt) do { __builtin_amdgcn_s_setprio(1); _Pragma("unroll") for (int m = 0; m < 4; ++m) _Pragma("unroll") for (int n = 0; n < 2; ++n) { \
        if constexpr (ESZ == 1) acc[ai][bj][m][n] = __builtin_amdgcn_mfma_scale_f32_16x16x128_f8f6f4(__builtin_bit_cast(v8i32, Bt[n]), __builtin_bit_cast(v8i32, At[m]), acc[ai][bj][m][n], 0, 0, 0, 0, 0, 0); \
        else { acc[ai][bj][m][n] = __builtin_amdgcn_mfma_f32_16x16x32_bf16(PG8_LO(Bt[n]), PG8_LO(At[m]), acc[ai][bj][m][n], 0, 0, 0); \
               acc[ai][bj][m][n] = __builtin_amdgcn_mfma_f32_16x16x32_bf16(PG8_HI(Bt[n]), PG8_HI(At[m]), acc[ai][bj][m][n], 0, 0, 0); } } \
        __builtin_amdgcn_s_setprio(0); } while (0)
#define PG8_WAIT_V(n) asm volatile("s_waitcnt vmcnt(" #n ")" ::: "memory")
#define PG8_WAIT_L(n) asm volatile("s_waitcnt lgkmcnt(" #n ")" ::: "memory")
#define PG8_BAR __builtin_amdgcn_s_barrier()
#define PG8_SCHED __builtin_amdgcn_sched_barrier(0)
    Unit cur, nxt; int ui = 0;
    if (!S.next(0, cur)) return;
#define PG8_PREFETCH(u_) do { if constexpr (has_prefetch<Epi>::value) { int ln_; asm volatile("v_mbcnt_lo_u32_b32 %0, -1, 0\n\tv_mbcnt_hi_u32_b32 %0, -1, %0" : "=v"(ln_)); E.prefetch((u_), wr, ln_ & 15); } } while (0)
    PG8_PREFETCH(cur);
    f32x4 acc[2][2][4][2];
#pragma unroll
    for (int a = 0; a < 2; ++a)
#pragma unroll
        for (int b = 0; b < 2; ++b)
#pragma unroll
            for (int m = 0; m < 4; ++m)
#pragma unroll
                for (int n = 0; n < 2; ++n) acc[a][b][m][n] = (f32x4){0.f, 0.f, 0.f, 0.f};
    typedef unsigned u32x8 __attribute__((ext_vector_type(8)));
    u32x8 At[4], B0[2], B1[2];
    unsigned vc[2][2], vn[2][2];
#pragma unroll
    for (int h = 0; h < 2; ++h)
#pragma unroll
        for (int i = 0; i < 2; ++i) vc[h][i] = PG8_AOFF(cur, h, i);
    const char* cA = G.a_base(cur); const char* cB = G.b_base(cur);
    PG8_STAGEB(PG8_SB(0, 0), cB); PG8_STAGEB(PG8_SB(0, 1), cB + hstepB); PG8_STAGEA(PG8_SA(0, 0), cA, vc, 0); PG8_STAGEA(PG8_SA(0, 1), cA, vc, 1);
    if (wr == 1) PG8_BAR;
    PG8_WAIT_V(2); PG8_BAR;
    PG8_STAGEB(PG8_SB(1, 0), cB + kstep); PG8_STAGEA(PG8_SA(1, 0), cA + kstep, vc, 0); PG8_STAGEB(PG8_SB(1, 1), cB + hstepB + kstep);
    PG8_WAIT_V(6); PG8_BAR;
    for (;;) {
        const bool has_next = S.next(ui + 1, nxt);
        const char* nA = has_next ? G.a_base(nxt) : cA; const char* nB = has_next ? G.b_base(nxt) : cB;
        if constexpr (Src::GATHER) {
#pragma unroll
        for (int h = 0; h < 2; ++h)
#pragma unroll
            for (int i = 0; i < 2; ++i) vn[h][i] = has_next ? PG8_AOFF(nxt, h, i) : vc[h][i]; }
#pragma clang loop unroll(disable)
        for (int t = 0; t < nt; t += 2) {
            const bool last = (t == nt - 2);
            const char* a1 = cA + (size_t)(t + 1) * kstep;
            const char* a2 = last ? nA : cA + (size_t)(t + 2) * kstep; const char* b2 = last ? nB : cB + (size_t)(t + 2) * kstep;
            const char* a3 = a2 + kstep; const char* b3 = b2 + kstep;
            PG8_LDB(B0, 0, 0); PG8_LDB(B1, 0, 1); PG8_SCHED; PG8_LDA(At, 0, 0); PG8_STAGEA(PG8_SA(1, 1), a1, vc, 1);
            PG8_WAIT_V(8); PG8_WAIT_L(0); PG8_BAR; PG8_MMA(0, 0, At, B0); PG8_MMA(0, 1, At, B1); PG8_BAR; PG8_SCHED;
            PG8_LDA(At, 0, 1); PG8_STAGEB(PG8_SB(0, 0), b2); PG8_STAGEB(PG8_SB(0, 1), b2 + hstepB); PG8_STAGEA2(PG8_SA(0, 0), a2, 0);
            PG8_WAIT_V(8); PG8_WAIT_L(0); PG8_BAR; PG8_MMA(1, 0, At, B0); PG8_MMA(1, 1, At, B1); PG8_BAR; PG8_SCHED;
            PG8_LDB(B0, 1, 0); PG8_LDB(B1, 1, 1); PG8_SCHED; PG8_LDA(At, 1, 0); PG8_STAGEA2(PG8_SA(0, 1), a2, 1);
            PG8_WAIT_V(8); PG8_WAIT_L(0); PG8_BAR; PG8_MMA(0, 0, At, B0); PG8_MMA(0, 1, At, B1); PG8_BAR; PG8_SCHED;
            PG8_LDA(At, 1, 1); PG8_STAGEB(PG8_SB(1, 0), b3); PG8_STAGEB(PG8_SB(1, 1), b3 + hstepB); PG8_STAGEA2(PG8_SA(1, 0), a3, 0);
            PG8_WAIT_V(8); PG8_WAIT_L(0); PG8_BAR; PG8_MMA(1, 0, At, B0); PG8_MMA(1, 1, At, B1); PG8_BAR; PG8_SCHED;
        }
        if constexpr (ALIGN_EPI) { if (wr == 0) PG8_BAR; }
        { int ln_; asm volatile("v_mbcnt_lo_u32_b32 %0, -1, 0\n\tv_mbcnt_hi_u32_b32 %0, -1, %0" : "=v"(ln_)); E(acc, cur, wr, wc, ln_ & 15, ln_ >> 4); }
        if (!has_next) break;
#pragma unroll
        for (int a = 0; a < 2; ++a)
#pragma unroll
            for (int b = 0; b < 2; ++b)
#pragma unroll
                for (int m = 0; m < 4; ++m)
#pragma unroll
                    for (int n = 0; n < 2; ++n) acc[a][b][m][n] = (f32x4){0.f, 0.f, 0.f, 0.f};
        cur = nxt; cA = nA; cB = nB; ++ui;
        PG8_PREFETCH(cur);
        if constexpr (Src::GATHER) {
#pragma unroll
        for (int h = 0; h < 2; ++h)
#pragma unroll
            for (int i = 0; i < 2; ++i) vc[h][i] = vn[h][i]; }
        if constexpr (ALIGN_EPI) { if (wr == 1) PG8_BAR; }
    }
    PG8_WAIT_V(0);
    if constexpr (!ALIGN_EPI) { if (wr == 0) PG8_BAR; }
    PG8_BAR;
#undef PG8_PREFETCH
#undef PG8_SA
#undef PG8_AOFF
#undef PG8_SB
#undef PG8_STAGEA
#undef PG8_STAGEA2
#undef PG8_STAGEB
#undef PG8_LDA
#undef PG8_LDB
#undef PG8_MMA
#undef PG8_LO
#undef PG8_HI
#undef PG8_WAIT_V
#undef PG8_WAIT_L
#undef PG8_BAR
#undef PG8_SCHED
}
}
#define RLX_AGENT __ATOMIC_RELAXED, __HIP_MEMORY_SCOPE_AGENT
#define LDS_WAIT() asm volatile("s_waitcnt lgkmcnt(0)" ::: "memory")
#define VM_WAIT() asm volatile("s_waitcnt vmcnt(0)" ::: "memory")
#define XB_TMO      128
#define XB_XCNT(j)  (256  + 64 * (j))
#define XB_XSUB(j)  (1280 + 64 * (j))
#define XB_XGEN(j)  (2304 + 64 * (j))
#define XB_TOP      3328
#define XB_TOPGEN   3392
#define XCD_BAR_WORDS 3456
#define XB_SPIN_CAP (1u << 18)

__device__ __forceinline__ unsigned xb_ld(unsigned* p)              { return __hip_atomic_load(p, __ATOMIC_RELAXED, __HIP_MEMORY_SCOPE_AGENT); }
__device__ __forceinline__ unsigned xb_add(unsigned* p, unsigned v) { return __hip_atomic_fetch_add(p, v, __ATOMIC_RELAXED, __HIP_MEMORY_SCOPE_AGENT); }
__device__ __forceinline__ unsigned xb_xcc_id() { return (unsigned)__builtin_amdgcn_s_getreg((3 << 11) | 20) & 0xFu; }
#define XB_SPIN(cond, bar) do { unsigned _sp = 0; while (cond) { __builtin_amdgcn_s_sleep(1); \
    if ((++_sp & 255u) == 0u) { if (xb_ld(&(bar)[XB_TMO])) break; if (_sp > XB_SPIN_CAP) { atomicAdd(&(bar)[XB_TMO], 1u); break; } } } } while (0)

struct XcdBarrier {
    unsigned* bar; unsigned x;
    volatile LAS unsigned* st;
};

__device__ __forceinline__ XcdBarrier xcd_barrier_post(unsigned* bar, volatile LAS unsigned* st) {
    XcdBarrier b; b.bar = bar; b.x = xb_xcc_id(); b.st = st;
    if (threadIdx.x == 0) (void)xb_add(&bar[XB_XCNT(b.x)], 1u);
    return b;
}
__device__ __forceinline__ void xcd_barrier_complete(unsigned* bar, unsigned x, unsigned& nloc, unsigned& nx) {
    const unsigned G = gridDim.x * gridDim.y * gridDim.z;
    unsigned sum, cnt, mine, sp = 0u;
    for (;;) {
        sum = 0u; cnt = 0u; mine = 0u;
#pragma unroll
        for (unsigned j = 0; j < 16; ++j) { const unsigned c = xb_ld(&bar[XB_XCNT(j)]); sum += c; cnt += (c > 0u) ? 1u : 0u; mine = (j == x) ? c : mine; }
        if (sum == G) break;
        __builtin_amdgcn_s_sleep(1);
        if ((++sp & 255u) == 0u) { if (xb_ld(&bar[XB_TMO])) break; if (sp > XB_SPIN_CAP) { atomicAdd(&bar[XB_TMO], 1u); break; } }
    }
    nloc = mine > 0u ? mine : 1u; nx = cnt > 0u ? cnt : 1u;
}

__device__ __forceinline__ void xcd_barrier(const XcdBarrier& b) {
    asm volatile("s_waitcnt vmcnt(0)" ::: "memory");
    __syncthreads();
    if (threadIdx.x == 0) {
        unsigned* bar = b.bar;
        __builtin_amdgcn_s_waitcnt(0);
        unsigned nloc = b.st[0], nx = b.st[1];
        if (nloc == 0u) { xcd_barrier_complete(bar, b.x, nloc, nx); b.st[0] = nloc; b.st[1] = nx; }
        const unsigned old = xb_add(&bar[XB_XSUB(b.x)], 1u);
        const unsigned gen = old / nloc;
        if (old + 1u == (gen + 1u) * nloc) {
            __builtin_amdgcn_fence(__ATOMIC_RELEASE, "agent");
            asm volatile("s_waitcnt vmcnt(0)" ::: "memory");
            const unsigned og = xb_add(&bar[XB_TOP], 1u);
            const unsigned tg = og / nx;
            if (og + 1u == (tg + 1u) * nx) xb_add(&bar[XB_TOPGEN], 1u);
            else XB_SPIN(xb_ld(&bar[XB_TOPGEN]) == tg, bar);
            __builtin_amdgcn_fence(__ATOMIC_ACQUIRE, "agent");
            xb_add(&bar[XB_XGEN(b.x)], 1u);
            asm volatile("s_waitcnt vmcnt(0)" ::: "memory");
        } else {
            XB_SPIN(xb_ld(&bar[XB_XGEN(b.x)]) == gen, bar);
            __builtin_amdgcn_fence(__ATOMIC_ACQUIRE, "agent");
            asm volatile("s_waitcnt vmcnt(0)" ::: "memory");
        }
    }
    __syncthreads();
}
constexpr int NB = 8, SEQ = 4096, D = 1024, M = NB * SEQ;
constexpr int NIN_SRC = 5936, NIN = 6144;
constexpr int ZW = 4096;
constexpr int ZQ = 0, ZK = 512, ZV = 1024, ZIQ = 1536, ZIK = 2048, ZIW = 2080, ZR = 2304;
constexpr int ZR_R = ZR, ZR_K = ZR + 512, ZR_V = ZR + 1024, ZR_WD = ZR + 1536, ZR_AD = ZR + 1600, ZR_GD = ZR + 1664;
constexpr int GW = 2048;
constexpr int NEXP = 64, FF = 256, TOPK = 8;
constexpr float RMS_EPS = 1e-6f, GN_EPS = 64e-5f;
constexpr float QSCALE = 0.125f * 1.4426950408889634f;
constexpr int NWAVES = 8, NTHR = 512;

constexpr size_t MiB = 1u << 20;
constexpr size_t WS_CTL = 0, CTL_ZERO_BYTES = 1 * MiB;
constexpr size_t WS_MOD = 1 * MiB;
constexpr size_t WS_DUT = 1 * MiB + 256 * 1024;
constexpr size_t WS_IUT = WS_DUT + 64 * 1024;
constexpr size_t WS_GUT = WS_IUT + 64 * 1024;
constexpr size_t WS_WIN = 2 * MiB;
constexpr size_t WS_WA = 14 * MiB, WS_WR = 15 * MiB;
constexpr size_t WS_WO = 16 * MiB;
constexpr size_t WS_WRT = 18 * MiB;
constexpr size_t WS_WSH1 = 19 * MiB;
constexpr size_t WS_WSH2 = 20 * MiB;
constexpr size_t WS_BRS = 21 * MiB, WS_KRS = 22 * MiB;
constexpr size_t WS_TOPE = 23 * MiB, WS_TOPW = 24 * MiB;
constexpr size_t WS_LOGIT = 25 * MiB;
constexpr size_t WS_Z = 36 * MiB;
constexpr size_t WS_H0 = 292 * MiB, WS_H1 = 324 * MiB;
constexpr size_t WS_SEL = 356 * MiB;
constexpr size_t WS_R0 = 372 * MiB, WS_R1 = 404 * MiB, WS_R2 = 436 * MiB, WS_R3 = 468 * MiB;
constexpr size_t WS_W2T = 36 * MiB;
constexpr size_t WS_ACT = 68 * MiB;
constexpr size_t WS_ACTS = 196 * MiB;
constexpr size_t WS_STOK = 212 * MiB, WS_SW = 213 * MiB;
constexpr size_t WS_W1T = 214 * MiB;
constexpr size_t WS_H2 = 278 * MiB;
constexpr size_t WS_SLOT = 214 * MiB;
constexpr size_t WS_END = 502 * MiB;
constexpr int CW_TMO = 0, CW_BAR = 4096, CW_CNT = 32768, CW_CUR = 32768 + 128, CW_Q = 32768 + 512;

constexpr int RING_BYTES = 131072;
constexpr int LDSCTL_OFF = RING_BYTES, MISC_OFF = LDSCTL_OFF + 320;
constexpr int LDS_TILETAB = RING_BYTES + 1024;
constexpr int LDS_PTAB = RING_BYTES + 512;
constexpr int LDS_PARA = 118800;
constexpr int LDS_PARB = LDS_TILETAB;
constexpr int LDS_BYTES = 147456;
#define AIN(i) ain_ptr(F.lds, (i))

struct Args { const float* in[31]; float* out; unsigned char* ws; int ph_lo, ph_hi, li, pad; };
struct Frame {
    LAS unsigned char* lds;
    volatile LAS unsigned* MISC;
    unsigned* ctl;
    int tid, lane, wave, vcu, G, gw, NGW;
    float* out; unsigned char* ws;
};

__device__ __forceinline__ const float* ain_ptr(LAS unsigned char* lds, int i) {
    const u32x2 w = *(const LAS u32x2*)(lds + LDS_PTAB + 8 * i);
    const unsigned lo = (unsigned)__builtin_amdgcn_readfirstlane((int)w.x), hi = (unsigned)__builtin_amdgcn_readfirstlane((int)w.y);
    return (const float*)(const GAS float*)(((unsigned long long)hi << 32) | lo);
}
struct TrSrc { const float* base; int nsrc; };
template <int FP8, class ColFn>
__device__ __forceinline__ void transpose_item(const ColFn& colfn, int K, bf16_t* WT, LAS float* scr, int kb, int nb, int lane) {
    const int k0 = 64 * kb, n0 = 32 * nb;
    const TrSrc s = colfn(n0 + (lane & 31));
    float v_[32];
#pragma unroll
    for (int i = 0; i < 32; ++i) { const int kk = 2 * i + (lane >> 5); v_[i] = s.base ? s.base[(size_t)(k0 + kk) * s.nsrc] : 0.f; }
#pragma unroll
    for (int i = 0; i < 32; ++i) { const int kk = 2 * i + (lane >> 5); scr[kk * 33 + (lane & 31)] = v_[i]; }
    LDS_WAIT(); asm volatile("" ::: "memory");
    const int c = lane & 7;
#pragma unroll
    for (int j = 0; j < 4; ++j) { const int n = (lane >> 3) + 8 * j; const LAS float* sp = scr + (8 * c) * 33 + n;
        if constexpr (FP8) { constexpr float S8 = 32.0f;
            int lo = __builtin_amdgcn_cvt_pk_fp8_f32(sp[0 * 33] * S8, sp[1 * 33] * S8, 0, false); lo = __builtin_amdgcn_cvt_pk_fp8_f32(sp[2 * 33] * S8, sp[3 * 33] * S8, lo, true);
            int hi = __builtin_amdgcn_cvt_pk_fp8_f32(sp[4 * 33] * S8, sp[5 * 33] * S8, 0, false); hi = __builtin_amdgcn_cvt_pk_fp8_f32(sp[6 * 33] * S8, sp[7 * 33] * S8, hi, true);
            *(GAS u32x2*)((unsigned char*)WT + (size_t)(n0 + n) * K + k0 + 8 * c) = (u32x2){(unsigned)lo, (unsigned)hi}; }
        else { u32x4 o; o.x = pk2(sp[0 * 33], sp[1 * 33]); o.y = pk2(sp[2 * 33], sp[3 * 33]); o.z = pk2(sp[4 * 33], sp[5 * 33]); o.w = pk2(sp[6 * 33], sp[7 * 33]);
            *(GAS u32x4*)(WT + (size_t)(n0 + n) * K + k0 + 8 * c) = o; } }
    LDS_WAIT(); asm volatile("" ::: "memory");
}

__device__ __forceinline__ void p0_mod(const Args& args, Frame& F, int task) {
    LAS float* sc = (LAS float*)F.lds;
    LAS float* red = (LAS float*)(F.lds + 32768);
    const float* c = AIN(1);
    for (int i = F.tid; i < 8192; i += NTHR) { const float v = c[i]; sc[i] = v * fast_sigmoid(v); }
    __syncthreads();
    const float* aw = AIN(2) + 64 * task + F.lane;
    float acc[8];
#pragma unroll
    for (int b = 0; b < 8; ++b) acc[b] = 0.f;
    const int kb = 128 * F.wave;
#pragma unroll 1
    for (int k0 = 0; k0 < 128; k0 += 16) { float a_[16];
#pragma unroll
        for (int k = 0; k < 16; ++k) a_[k] = aw[(size_t)(kb + k0 + k) * 6144];
#pragma unroll
        for (int k = 0; k < 16; ++k) {
#pragma unroll
            for (int b = 0; b < 8; ++b) acc[b] += sc[b * 1024 + kb + k0 + k] * a_[k];
            if ((k & 3) == 3) asm volatile("" ::: "memory"); } }
#pragma unroll
    for (int b = 0; b < 8; ++b) red[(F.wave * 8 + b) * 64 + F.lane] = acc[b];
    __syncthreads();
    { const int b = F.wave; float s = AIN(3)[64 * task + F.lane];
#pragma unroll
      for (int w = 0; w < 8; ++w) s += red[(w * 8 + b) * 64 + F.lane];
      ((float*)(F.ws + WS_MOD))[b * 6144 + 64 * task + F.lane] = s; }
    __syncthreads();
}

__device__ __forceinline__ void p0_prologue(const Args& args, Frame& F) {
    if (blockIdx.x < 96) p0_mod(args, F, blockIdx.x);
    LAS float* scr = (LAS float*)(F.lds + F.wave * 16384);
    bf16_t* const ws16 = (bf16_t*)F.ws;
    constexpr int I_WIN = 16 * 192, I_WA = 8 * 32, I_WO = 16 * 32, I_WRT = 16 * 8, I_SH1 = 16 * 16, I_SH2 = 4 * 32, I_DU = 16, I_GU = 32;
    constexpr int NIT = I_WIN + 2 * I_WA + I_WO + I_WRT + I_SH1 + I_SH2 + 2 * I_DU + I_GU;
    for (int it = F.gw; it < NIT; it += F.NGW) {
        int r = it;
        if (r < I_WIN) { const float* w = AIN(5);
            transpose_item<1>([=](int n) { TrSrc s; const bool ok = (n < 2096) || (n >= 2304); const int col = n < 2096 ? n : n - 208; s.base = ok ? w + col : nullptr; s.nsrc = NIN_SRC; return s; },
                           1024, (bf16_t*)(F.ws + WS_WIN), scr, r / 192, r % 192, F.lane); continue; } r -= I_WIN;
        if (r < I_WA) { const float* w = AIN(18); transpose_item<0>([=](int n) { TrSrc s; s.base = w + n; s.nsrc = 1024; return s; }, 512, (bf16_t*)(F.ws + WS_WA), scr, r / 32, r % 32, F.lane); continue; } r -= I_WA;
        if (r < I_WA) { const float* w = AIN(19); transpose_item<0>([=](int n) { TrSrc s; s.base = w + n; s.nsrc = 1024; return s; }, 512, (bf16_t*)(F.ws + WS_WR), scr, r / 32, r % 32, F.lane); continue; } r -= I_WA;
        if (r < I_WO) { const float* w = AIN(20); transpose_item<1>([=](int n) { TrSrc s; s.base = w + n; s.nsrc = 1024; return s; }, 1024, (bf16_t*)(F.ws + WS_WO), scr, r / 32, r % 32, F.lane); continue; } r -= I_WO;
        if (r < I_WRT) { const float* w = AIN(22); transpose_item<0>([=](int n) { TrSrc s; s.base = n < 64 ? w + n : nullptr; s.nsrc = 64; return s; }, 1024, (bf16_t*)(F.ws + WS_WRT), scr, r / 8, r % 8, F.lane); continue; } r -= I_WRT;
        if (r < I_SH1) { const float* wg = AIN(27); const float* wu = AIN(28);
            transpose_item<0>([=](int n) { TrSrc s; const int j = n >> 8, sel = (n >> 7) & 1, cc = n & 127; s.base = (sel ? wu : wg) + 128 * j + cc; s.nsrc = 256; return s; }, 1024, (bf16_t*)(F.ws + WS_WSH1), scr, r / 16, r % 16, F.lane); continue; } r -= I_SH1;
        if (r < I_SH2) { const float* w = AIN(29); transpose_item<1>([=](int n) { TrSrc s; s.base = w + n; s.nsrc = 1024; return s; }, 256, (bf16_t*)(F.ws + WS_WSH2), scr, r / 32, r % 32, F.lane); continue; } r -= I_SH2;
        if (r < I_DU) { const float* w = AIN(9); transpose_item<0>([=](int n) { TrSrc s; s.base = w + n; s.nsrc = 512; return s; }, 64, (bf16_t*)(F.ws + WS_DUT), scr, 0, r, F.lane); continue; } r -= I_DU;
        if (r < I_DU) { const float* w = AIN(11); transpose_item<0>([=](int n) { TrSrc s; s.base = w + n; s.nsrc = 512; return s; }, 64, (bf16_t*)(F.ws + WS_IUT), scr, 0, r, F.lane); continue; } r -= I_DU;
        { const float* w = AIN(12); transpose_item<0>([=](int n) { TrSrc s; s.base = w + n; s.nsrc = 512; return s; }, 128, (bf16_t*)(F.ws + WS_GUT), scr, r / 16, r % 16, F.lane); }
    }
    (void)ws16;
}

__device__ __forceinline__ void convert_experts(const Args& args, Frame& F, int k0, int k1) {
    LAS float* scr = (LAS float*)(F.lds + F.wave * 16384);
    constexpr int I1 = 16 * 16, I2 = 4 * 32, PER = I1 + I2, NIT = 64 * PER;
    for (int k = k0; k < k1; ++k) { const int it = F.gw + k * F.NGW; if (it >= NIT) break;
        const int e = it / PER; int r = it % PER;
        if (r < I1) { const float* wg = AIN(24) + (size_t)e * 1024 * 256; const float* wu = AIN(25) + (size_t)e * 1024 * 256;
            transpose_item<0>([=](int n) { TrSrc s; const int j = n >> 8, sel = (n >> 7) & 1, cc = n & 127; s.base = (sel ? wu : wg) + 128 * j + cc; s.nsrc = 256; return s; }, 1024, (bf16_t*)(F.ws + WS_W1T) + (size_t)e * 512 * 1024, scr, r / 16, r % 16, F.lane); }
        else { r -= I1; const float* w = AIN(26) + (size_t)e * 256 * 1024;
            transpose_item<1>([=](int n) { TrSrc s; s.base = w + n; s.nsrc = 1024; return s; }, 256, (bf16_t*)(F.ws + WS_W2T + (size_t)e * 1024 * 256), scr, r / 32, r % 32, F.lane); }
    }
}

__device__ __forceinline__ void norm_mod_rows(const Args& args, Frame& F, const float* X, const float* g, int sh_off, int sc_off, bf16_t* O, unsigned char* O8) {
    const int row0 = F.gw * 16, b = row0 / SEQ;
    const float* mod = (const float*)(F.ws + WS_MOD) + b * 6144;
    f32x4 mul[4], add[4];
#pragma unroll
    for (int j = 0; j < 4; ++j) { const int c = 4 * F.lane + 256 * j; const f32x4 gv = *(const f32x4*)(g + c), sc = *(const f32x4*)(mod + sc_off + c); add[j] = *(const f32x4*)(mod + sh_off + c); mul[j] = gv * (sc + 1.0f); }
    for (int r0 = 0; r0 < 16; r0 += 4) {
        f32x4 v[4][4]; float s[4];
#pragma unroll
        for (int q = 0; q < 4; ++q) { const GAS f32x4* xr = (const GAS f32x4*)(X + (size_t)(row0 + r0 + q) * D) + F.lane;
#pragma unroll
            for (int j = 0; j < 4; ++j) v[q][j] = xr[64 * j]; }
#pragma unroll
        for (int q = 0; q < 4; ++q) { s[q] = 0.f;
#pragma unroll
            for (int j = 0; j < 4; ++j) s[q] += (v[q][j].x * v[q][j].x + v[q][j].y * v[q][j].y) + (v[q][j].z * v[q][j].z + v[q][j].w * v[q][j].w); }
#pragma unroll
        for (int q = 0; q < 4; ++q) { const int r = r0 + q;
            const float rstd = 1.0f / sqrtf(wave_sum(s[q]) * (1.0f / D) + RMS_EPS);
#pragma unroll
            for (int j = 0; j < 4; ++j) { const f32x4 y = v[q][j] * rstd * mul[j] + add[j];
                if (O) { u32x2 w; w.x = cvt_pk_bf16(y.x, y.y); w.y = cvt_pk_bf16(y.z, y.w); ((GAS u32x2*)(O + (size_t)(row0 + r) * D) + F.lane)[64 * j] = w; }
                if (O8) { int w8 = __builtin_amdgcn_cvt_pk_fp8_f32(y.x, y.y, 0, false); w8 = __builtin_amdgcn_cvt_pk_fp8_f32(y.z, y.w, w8, true); ((GAS unsigned*)(O8 + (size_t)(row0 + r) * D) + F.lane)[64 * j] = (unsigned)w8; } } }
    }
}
using pg8::Unit;
constexpr float WSCALE8 = 32.0f;
typedef const f32x4 (&AccRef)[2][2][4][2];

struct EpiInProj {
    static constexpr bool PERM = true;
    bf16_t* Z; bf16_t* Gt;
    __device__ __forceinline__ void operator()(AccRef acc, const Unit& u, int wr, int wc, int fr, int fq) const {
        asm volatile("" : "+v"(fr), "+v"(fq));
        const int row0 = u.pm * 256 + wr * 64 + fr;
        const bool gate = u.pn >= 16;
        const float sc = ((u.pn < 2) ? QSCALE : 1.0f) * (1.0f / WSCALE8);
        bf16_t* base = gate ? Gt + (size_t)(u.pn - 16) * 256 : Z + (size_t)u.pn * 256;
        const int ldc = gate ? GW : ZW;
#pragma unroll
        for (int ai = 0; ai < 2; ++ai)
#pragma unroll
            for (int m = 0; m < 4; ++m) { bf16_t* rowp = base + (size_t)(row0 + ai * 128 + m * 16) * ldc + wc * 32 + 8 * fq;
#pragma unroll
                for (int bj = 0; bj < 2; ++bj) { f32x4 v0 = acc[ai][bj][m][0], v1 = acc[ai][bj][m][1];
                    if (gate) {
#pragma unroll
                        for (int j = 0; j < 4; ++j) { v0[j] = fast_sigmoid(v0[j] * sc); v1[j] = fast_sigmoid(v1[j] * sc); } }
                    else { v0 = v0 * sc; v1 = v1 * sc; }
                    u32x4 w; w.x = cvt_pk_bf16(v0[0], v0[1]); w.y = cvt_pk_bf16(v0[2], v0[3]); w.z = cvt_pk_bf16(v1[0], v1[1]); w.w = cvt_pk_bf16(v1[2], v1[3]);
                    *(u32x4*)(rowp + bj * 128) = w; } }
    }
};

constexpr float ATT_S8 = 16.0f, RW_S8 = 8.0f, MIX_S8 = 16.0f;
template <int SECOND> struct EpiMerge {
    static constexpr bool PERM = true;
    bf16_t* Mx; unsigned char* Mx8; const bf16_t* Gt; float bs;
    __device__ __forceinline__ void operator()(AccRef acc, const Unit& u, int wr, int wc, int fr, int fq) const {
        asm volatile("" : "+v"(fr), "+v"(fq));
        const int row0 = u.pm * 256 + wr * 64 + fr, col0 = u.pn * 256 + wc * 32 + 8 * fq;
#pragma unroll
        for (int ai = 0; ai < 2; ++ai)
#pragma unroll
            for (int m = 0; m < 4; ++m) { const size_t r = (size_t)(row0 + ai * 128 + m * 16);
#pragma unroll
                for (int bj = 0; bj < 2; ++bj) { const int c = col0 + bj * 128;
                    const u32x4 g = *(const u32x4*)(Gt + r * GW + SECOND * 1024 + c);
                    f32x4 v0 = acc[ai][bj][m][0] * bs, v1 = acc[ai][bj][m][1] * bs;
                    v0[0] *= bf_lo(g.x); v0[1] *= bf_hi(g.x); v0[2] *= bf_lo(g.y); v0[3] *= bf_hi(g.y);
                    v1[0] *= bf_lo(g.z); v1[1] *= bf_hi(g.z); v1[2] *= bf_lo(g.w); v1[3] *= bf_hi(g.w);
                    if (SECOND) { const u32x4 p = *(const u32x4*)(Mx + r * D + c);
                        v0[0] += bf_lo(p.x); v0[1] += bf_hi(p.x); v0[2] += bf_lo(p.y); v0[3] += bf_hi(p.y);
                        v1[0] += bf_lo(p.z); v1[1] += bf_hi(p.z); v1[2] += bf_lo(p.w); v1[3] += bf_hi(p.w);
                        v0 = v0 * MIX_S8; v1 = v1 * MIX_S8;
                        int lo = __builtin_amdgcn_cvt_pk_fp8_f32(v0[0], v0[1], 0, false); lo = __builtin_amdgcn_cvt_pk_fp8_f32(v0[2], v0[3], lo, true);
                        int hi = __builtin_amdgcn_cvt_pk_fp8_f32(v1[0], v1[1], 0, false); hi = __builtin_amdgcn_cvt_pk_fp8_f32(v1[2], v1[3], hi, true);
                        *(u32x2*)(Mx8 + r * D + c) = (u32x2){(unsigned)lo, (unsigned)hi}; }
                    else { u32x4 w; w.x = cvt_pk_bf16(v0[0], v0[1]); w.y = cvt_pk_bf16(v0[2], v0[3]); w.z = cvt_pk_bf16(v1[0], v1[1]); w.w = cvt_pk_bf16(v1[2], v1[3]);
                        *(u32x4*)(Mx + r * D + c) = w; }
                    asm volatile("" ::: "memory"); } }
    }
};

struct EpiOutProj {
    static constexpr bool PERM = false;
    const float* X; float* O; const float* mod;
    __device__ __forceinline__ void operator()(AccRef acc, const Unit& u, int wr, int wc, int fr, int fq) const {
        asm volatile("" : "+v"(fr), "+v"(fq));
        const int row0 = u.pm * 256 + wr * 64 + fr, col0 = u.pn * 256 + wc * 32 + 4 * fq;
        const float* g1 = mod + (size_t)((u.pm * 256) / SEQ) * 6144 + 2048;
        f32x4 gv[2][2];
#pragma unroll
        for (int bj = 0; bj < 2; ++bj)
#pragma unroll
            for (int n = 0; n < 2; ++n) gv[bj][n] = *(const f32x4*)(g1 + col0 + bj * 128 + n * 16);
#pragma unroll
        for (int ai = 0; ai < 2; ++ai)
#pragma unroll
            for (int m = 0; m < 4; ++m) { const size_t off = (size_t)(row0 + ai * 128 + m * 16) * D + col0;
#pragma unroll
                for (int bj = 0; bj < 2; ++bj)
#pragma unroll
                    for (int n = 0; n < 2; ++n) { const f32x4 xv = *(const f32x4*)(X + off + bj * 128 + n * 16);
                        *(f32x4*)(O + off + bj * 128 + n * 16) = xv + gv[bj][n] * acc[ai][bj][m][n] * (1.0f / (MIX_S8 * WSCALE8)); }
                if (m & 1) asm volatile("" ::: "memory"); }
    }
};

struct EpiRouter {
    static constexpr bool PERM = false;
    float* L;
    __device__ __forceinline__ void operator()(AccRef acc, const Unit& u, int wr, int wc, int fr, int fq) const {
        asm volatile("" : "+v"(fr), "+v"(fq));
        if (wc >= 2) return;
        const int row0 = u.pm * 256 + wr * 64 + fr, col0 = wc * 32 + 4 * fq;
#pragma unroll
        for (int ai = 0; ai < 2; ++ai)
#pragma unroll
            for (int m = 0; m < 4; ++m)
#pragma unroll
                for (int n = 0; n < 2; ++n) *(f32x4*)(L + (size_t)(row0 + ai * 128 + m * 16) * 64 + col0 + n * 16) = acc[ai][0][m][n];
    }
};

struct MoeSched1 {
    const LAS unsigned* tab; int ntiles, G, c;
    __device__ __forceinline__ bool next(int i, Unit& u) const {
        const int L = i * G + c; if (L >= 256 + 2 * ntiles) return false;
        u.pn = L & 1;
        if (L < 256) { u.pm = L >> 1; u.aux0 = (u.pm * 256) | (64 << 20); u.aux1 = 256; }
        else { const int t = (L - 256) >> 1; u.pm = t; u.aux0 = __builtin_amdgcn_readfirstlane((int)tab[2 * t]); u.aux1 = __builtin_amdgcn_readfirstlane((int)tab[2 * t + 1]); }
        return true;
    }
};
struct MoeSrc1 {
    static constexpr int ESZ = 2; static constexpr bool GATHER = true;
    const unsigned char* ws;
    __device__ __forceinline__ const char* a_base(const Unit&) const { return (const char*)(ws + WS_H2); }
    __device__ __forceinline__ const char* b_base(const Unit& u) const { const int e = u.aux0 >> 20;
        const size_t off = (e == 64 ? WS_WSH1 : WS_W1T + (size_t)e * 512 * 1024 * 2) + (size_t)u.pn * 256 * 1024 * 2; return (const char*)ws + off; }
    __device__ __forceinline__ unsigned a_off(const Unit& u, int R, int C) const {
        const int e = u.aux0 >> 20, pos0 = u.aux0 & 0xFFFFF; int tok;
        if (e == 64) tok = pos0 + R; else tok = (R < u.aux1) ? (((const int*)(ws + WS_STOK))[pos0 + R] >> 3) : 0;
        return (unsigned)tok * 2048u + (unsigned)C * 2u; }
};
constexpr float ACT_S8 = 8.0f;
struct EpiMoe1 {
    static constexpr bool PERM = true;
    unsigned char* ws;
    __device__ __forceinline__ void operator()(AccRef acc, const Unit& u, int wr, int wc, int fr, int fq) const {
        asm volatile("" : "+v"(fr), "+v"(fq));
        const int e = u.aux0 >> 20, pos0 = u.aux0 & 0xFFFFF;
        unsigned char* base = ws + (e == 64 ? WS_ACTS : WS_ACT) + (size_t)pos0 * FF + u.pn * 128 + wc * 32 + 8 * fq;
#pragma unroll
        for (int ai = 0; ai < 2; ++ai)
#pragma unroll
            for (int m = 0; m < 4; ++m) { const int r = ai * 128 + wr * 64 + m * 16 + fr;
                float o[8];
#pragma unroll
                for (int n = 0; n < 2; ++n)
#pragma unroll
                    for (int j = 0; j < 4; ++j) { const float g = acc[ai][0][m][n][j], up = acc[ai][1][m][n][j]; o[4 * n + j] = g * fast_sigmoid(g) * up * ACT_S8; }
                int lo = __builtin_amdgcn_cvt_pk_fp8_f32(o[0], o[1], 0, false); lo = __builtin_amdgcn_cvt_pk_fp8_f32(o[2], o[3], lo, true);
                int hi = __builtin_amdgcn_cvt_pk_fp8_f32(o[4], o[5], 0, false); hi = __builtin_amdgcn_cvt_pk_fp8_f32(o[6], o[7], hi, true);
                if (r < u.aux1) *(u32x2*)(base + (size_t)r * FF) = (u32x2){(unsigned)lo, (unsigned)hi}; }
    }
};
struct MoeSched2 {
    const LAS unsigned* tab; int t0, ntiles, nsh, G, c;
    __device__ __forceinline__ bool next(int i, Unit& u) const {
        const int L = i * G + c; if (L >= nsh + 4 * ntiles) return false;
        u.pn = L & 3;
        if (L < nsh) { u.pm = L >> 2; u.aux0 = (u.pm * 256) | (64 << 20); u.aux1 = 256; }
        else { const int t = t0 + ((L - nsh) >> 2); u.pm = t; u.aux0 = __builtin_amdgcn_readfirstlane((int)tab[2 * t]); u.aux1 = __builtin_amdgcn_readfirstlane((int)tab[2 * t + 1]); }
        return true;
    }
};
struct MoeSrc2 {
    static constexpr int ESZ = 1; static constexpr bool GATHER = false;
    const unsigned char* ws;
    __device__ __forceinline__ const char* a_base(const Unit& u) const { return (const char*)ws + ((u.aux0 >> 20) == 64 ? WS_ACTS : WS_ACT) + (size_t)(u.aux0 & 0xFFFFF) * 256; }
    __device__ __forceinline__ const char* b_base(const Unit& u) const { const int e = u.aux0 >> 20;
        const size_t off = (e == 64 ? WS_WSH2 : WS_W2T + (size_t)e * 1024 * 256) + (size_t)u.pn * 256 * 256; return (const char*)ws + off; }
    __device__ __forceinline__ unsigned a_off(const Unit&, int R, int C) const { return (unsigned)(R * 256) + (unsigned)C * 2u; }
};
constexpr float SLOT_SCALE = 16.0f;
constexpr int NSLOT = 9;
struct EpiMoe2 {
    static constexpr bool PERM = true;
    unsigned char* ws; float* X1; int tokbase;
    __device__ __forceinline__ void operator()(AccRef acc, const Unit& u, int wr, int wc, int fr, int fq) const {
        asm volatile("" : "+v"(fr), "+v"(fq));
        const int e = u.aux0 >> 20, pos0 = u.aux0 & 0xFFFFF; const int col0 = u.pn * 256 + wc * 32 + 8 * fq;
        if (e == 64) {
#pragma unroll
            for (int ai = 0; ai < 2; ++ai)
#pragma unroll
                for (int m = 0; m < 4; ++m) { unsigned char* rowp = (unsigned char*)(ws + WS_SLOT) + ((size_t)(pos0 + ai * 128 + wr * 64 + m * 16 + fr) * NSLOT + 8) * D + u.pn * 256 + wc * 64 + fq * 16;
                    u32x4 o;
#pragma unroll
                    for (int bj = 0; bj < 2; ++bj) { const f32x4 v0 = acc[ai][bj][m][0] * (SLOT_SCALE / (ACT_S8 * WSCALE8)), v1 = acc[ai][bj][m][1] * (SLOT_SCALE / (ACT_S8 * WSCALE8));
                        int lo = __builtin_amdgcn_cvt_pk_fp8_f32(v0[0], v0[1], 0, false); lo = __builtin_amdgcn_cvt_pk_fp8_f32(v0[2], v0[3], lo, true);
                        int hi = __builtin_amdgcn_cvt_pk_fp8_f32(v1[0], v1[1], 0, false); hi = __builtin_amdgcn_cvt_pk_fp8_f32(v1[2], v1[3], hi, true);
                        if (bj == 0) { o.x = (unsigned)lo; o.y = (unsigned)hi; } else { o.z = (unsigned)lo; o.w = (unsigned)hi; } }
                    *(u32x4*)rowp = o;
                    asm volatile("" ::: "memory"); }
        } else {
#pragma unroll
            for (int ai = 0; ai < 2; ++ai)
#pragma unroll
                for (int m = 0; m < 4; ++m) { const int r = ai * 128 + wr * 64 + m * 16 + fr;
                    if (r < u.aux1) { const int tk = ((const int*)(ws + WS_STOK))[pos0 + r]; const float w = ((const float*)(ws + WS_SW))[pos0 + r] * (SLOT_SCALE / (ACT_S8 * WSCALE8));
                        unsigned char* rowp = (unsigned char*)(ws + WS_SLOT) + ((size_t)(tk >> 3) * NSLOT + (tk & 7)) * D + u.pn * 256 + wc * 64 + fq * 16;
                        u32x4 o;
#pragma unroll
                        for (int bj = 0; bj < 2; ++bj) { const f32x4 v0 = acc[ai][bj][m][0] * w, v1 = acc[ai][bj][m][1] * w;
                            int lo = __builtin_amdgcn_cvt_pk_fp8_f32(v0[0], v0[1], 0, false); lo = __builtin_amdgcn_cvt_pk_fp8_f32(v0[2], v0[3], lo, true);
                            int hi = __builtin_amdgcn_cvt_pk_fp8_f32(v1[0], v1[1], 0, false); hi = __builtin_amdgcn_cvt_pk_fp8_f32(v1[2], v1[3], hi, true);
                            if (bj == 0) { o.x = (unsigned)lo; o.y = (unsigned)hi; } else { o.z = (unsigned)lo; o.w = (unsigned)hi; } }
                        *(u32x4*)rowp = o; }
                    asm volatile("" ::: "memory"); }
        }
    }
};
__device__ __forceinline__ unsigned ord_key(float x) { const unsigned b = __float_as_uint(x); return (b & 0x80000000u) ? ~b : (b | 0x80000000u); }

__device__ __forceinline__ void idx_glds16(const void* gsrc, unsigned lds_dst) { unsigned keep;
    asm volatile("s_mov_b32 %0, m0\n\ts_mov_b32 m0, %2\n\ts_nop 0\n\tglobal_load_lds_dwordx4 %1, off\n\ts_mov_b32 m0, %0" : "=&s"(keep) : "v"(gsrc), "s"(lds_dst) : "memory"); }

__device__ __forceinline__ void indexer_unit(const Args& args, Frame& F, int b, int q0) {
    const bf16_t* Z = (const bf16_t*)(F.ws + WS_Z) + (size_t)b * SEQ * ZW;
    unsigned* SELM = (unsigned*)(F.ws + WS_SEL) + (size_t)b * SEQ * 128;
    int tid = F.tid; asm volatile("" : "+v"(tid));
    const int lane = tid & 63, kl = lane & 31, hl = lane >> 5, w = F.wave;
    const int qa = q0 + 2 * w;
    const int myq = qa + hl;
    bf16x8 A0, A1;
    { const int aq = (kl >> 2) & 1, ah = 4 * (kl >> 3) + (kl & 3);
      const bf16_t* p = Z + (size_t)(qa + aq) * ZW + ZIQ + ah * 32 + 8 * hl;
      A0 = *(const bf16x8*)p; A1 = *(const bf16x8*)(p + 16); }
    float wq[16];
    { const bf16_t* p = Z + (size_t)myq * ZW + ZIW; const u32x4 a = *(const u32x4*)p, c = *(const u32x4*)(p + 8);
      wq[0] = bf_lo(a.x); wq[1] = bf_hi(a.x); wq[2] = bf_lo(a.y); wq[3] = bf_hi(a.y); wq[4] = bf_lo(a.z); wq[5] = bf_hi(a.z); wq[6] = bf_lo(a.w); wq[7] = bf_hi(a.w);
      wq[8] = bf_lo(c.x); wq[9] = bf_hi(c.x); wq[10] = bf_lo(c.y); wq[11] = bf_hi(c.y); wq[12] = bf_lo(c.z); wq[13] = bf_hi(c.z); wq[14] = bf_lo(c.w); wq[15] = bf_hi(c.w); }
    unsigned key[128];
    const int nchunk = (q0 + 15) / 1024 + 1;
    const unsigned idx_lds0 = (unsigned)(uintptr_t)F.lds;
#define IDX_LOAD(ch, buf) do { _Pragma("unroll") for (int _i = 0; _i < 8; ++_i) { const int kg_ = w * 8 + _i; const int key_ = 16 * kg_ + (lane >> 2); \
        idx_glds16(Z + (size_t)((ch) * 1024 + key_) * ZW + ZIK + 8 * ((lane & 3) ^ ((key_ >> 2) & 3)), (unsigned)__builtin_amdgcn_readfirstlane((int)(idx_lds0 + (buf) * 65536 + kg_ * 1024))); } } while (0)
    IDX_LOAD(0, 0);
    asm volatile("s_waitcnt vmcnt(0)" ::: "memory");
    __syncthreads();
#pragma unroll
    for (int ch = 0; ch < 4; ++ch) {
        if (ch < nchunk) {
            if (ch + 1 < nchunk) IDX_LOAD(ch + 1, (ch + 1) & 1);
            LAS unsigned char* kbl = F.lds + (ch & 1) * 65536 + kl * 64 + ((hl ^ ((kl >> 2) & 3)) * 16); asm volatile("" : "+v"(kbl));
            LAS unsigned char* kbl2 = F.lds + (ch & 1) * 65536 + kl * 64 + (((hl + 2) ^ ((kl >> 2) & 3)) * 16); asm volatile("" : "+v"(kbl2));
#pragma unroll
            for (int tt = 0; tt < 32; tt += 2) {
                const int t = ch * 32 + tt;
                if (32 * t <= qa + 1) {
                    bf16x8 B0[2], B1[2]; f32x16 acc[2];
#pragma unroll
                    for (int j = 0; j < 2; ++j) { B0[j] = *(const LAS bf16x8*)(kbl + 2048 * (tt + j)); B1[j] = *(const LAS bf16x8*)(kbl2 + 2048 * (tt + j)); }
#pragma unroll
                    for (int j = 0; j < 2; ++j) { acc[j] = f32x16{}; acc[j] = __builtin_amdgcn_mfma_f32_32x32x16_bf16(A0, B0[j], acc[j], 0, 0, 0); }
#pragma unroll
                    for (int j = 0; j < 2; ++j) acc[j] = __builtin_amdgcn_mfma_f32_32x32x16_bf16(A1, B1[j], acc[j], 0, 0, 0);
#pragma unroll
                    for (int j = 0; j < 2; ++j) { float s = 0.f;
#pragma unroll
                        for (int i = 0; i < 16; ++i) { const float av_ = acc[j][i]; const int xb_ = __float_as_int(av_); s += __int_as_float(xb_ > 0 ? xb_ : 0) * wq[i]; }
                        key[t + j] = (32 * (t + j) + kl <= myq) ? ord_key(s) : 0u; }
                } else {
#pragma unroll
                    for (int j = 0; j < 2; ++j) key[t + j] = 0u;
                }
            }
            asm volatile("s_waitcnt vmcnt(0)" ::: "memory");
            __syncthreads();
        } else {
#pragma unroll
            for (int tt = 0; tt < 32; ++tt) key[ch * 32 + tt] = 0u;
        }
    }
#undef IDX_LOAD
#pragma unroll
    for (int w = 0; w < 4; ++w) {
        if (1024 * w <= qa + 1) {
#pragma unroll
            for (int k = 0; k < 16; ++k) { const unsigned lo = key[32 * w + k], hi_ = key[32 * w + k + 16];
                key[32 * w + k] = __builtin_amdgcn_perm(hi_, lo, 0x05040100u); key[32 * w + k + 16] = __builtin_amdgcn_perm(hi_, lo, 0x07060302u); }
#pragma unroll
            for (int k = 0; k < 32; ++k) if (!(k & 8)) { const unsigned lo = key[32 * w + k], hi_ = key[32 * w + k + 8];
                key[32 * w + k] = __builtin_amdgcn_perm(hi_, lo, 0x06020400u); key[32 * w + k + 8] = __builtin_amdgcn_perm(hi_, lo, 0x07030501u); }
#pragma unroll
            for (int k = 0; k < 32; ++k) if (!(k & 4)) { const unsigned lo = key[32 * w + k], hi_ = key[32 * w + k + 4]; const unsigned m = 0x0F0F0F0Fu;
                key[32 * w + k] = (lo & m) | ((hi_ << 4) & ~m); key[32 * w + k + 4] = ((lo >> 4) & m) | (hi_ & ~m); }
#pragma unroll
            for (int k = 0; k < 32; ++k) if (!(k & 2)) { const unsigned lo = key[32 * w + k], hi_ = key[32 * w + k + 2]; const unsigned m = 0x33333333u;
                key[32 * w + k] = (lo & m) | ((hi_ << 2) & ~m); key[32 * w + k + 2] = ((lo >> 2) & m) | (hi_ & ~m); }
#pragma unroll
            for (int k = 0; k < 32; ++k) if (!(k & 1)) { const unsigned lo = key[32 * w + k], hi_ = key[32 * w + k + 1]; const unsigned m = 0x55555555u;
                key[32 * w + k] = (lo & m) | ((hi_ << 1) & ~m); key[32 * w + k + 1] = ((lo >> 1) & m) | (hi_ & ~m); }
        }
    }
    unsigned Al[4] = {~0u, ~0u, ~0u, ~0u}, Gt[4] = {0u, 0u, 0u, 0u};
    int ab0 = 0, ab1 = 0; unsigned T0 = 0u, T1 = 0u; bool dn0 = false, dn1 = false;
#define IDX_DPP(v, ctrl) __builtin_amdgcn_update_dpp(0, (v), (ctrl), 0xF, 0xF, true)
#pragma unroll
    for (int bit = 31; bit >= 0; --bit) {
        unsigned S_[4]; int c = 0;
#pragma unroll
        for (int w = 0; w < 4; ++w) { S_[w] = Al[w] & key[32 * w + bit]; c += __builtin_popcount(S_[w]); }
        c += IDX_DPP(c, 0xB1); c += IDX_DPP(c, 0x4E); c += IDX_DPP(c, 0x141); c += IDX_DPP(c, 0x140);
        const int cn0 = ab0 + __builtin_amdgcn_readlane(c, 0) + __builtin_amdgcn_readlane(c, 16), cn1 = ab1 + __builtin_amdgcn_readlane(c, 32) + __builtin_amdgcn_readlane(c, 48);
        const bool t0 = cn0 >= 256, t1 = cn1 >= 256;
        if (t0) { T0 |= 1u << bit; dn0 = dn0 || cn0 == 256; } else ab0 = cn0;
        if (t1) { T1 |= 1u << bit; dn1 = dn1 || cn1 == 256; } else ab1 = cn1;
        const unsigned nm = hl ? (t1 ? 0u : ~0u) : (t0 ? 0u : ~0u);
#pragma unroll
        for (int w = 0; w < 4; ++w) { Al[w] &= key[32 * w + bit] ^ nm; Gt[w] |= S_[w] & nm; }
        if (dn0 && dn1) break;
    }
#undef IDX_DPP
    unsigned x[4];
    { const bool nz = hl ? (T1 != 0u) : (T0 != 0u);
#pragma unroll
      for (int w = 0; w < 4; ++w) x[w] = Gt[w] | (nz ? Al[w] : 0u); }
#define IDX_BFLY(d, m) do { const bool up_ = (kl & (d)) != 0; const unsigned km_ = up_ ? ~(m) : (m); const unsigned am_ = up_ ? (unsigned)(d) : 32u - (d); \
        _Pragma("unroll") for (int w = 0; w < 4; ++w) { const unsigned t_ = (unsigned)__builtin_amdgcn_ds_swizzle((int)x[w], 0x1F | ((d) << 10)); \
            const unsigned rot_ = __builtin_amdgcn_alignbit(t_, t_, am_); x[w] = (x[w] & km_) | (rot_ & ~km_); } } while (0)
    IDX_BFLY(16, 0x0000FFFFu); IDX_BFLY(8, 0x00FF00FFu); IDX_BFLY(4, 0x0F0F0F0Fu); IDX_BFLY(2, 0x33333333u); IDX_BFLY(1, 0x55555555u);
#undef IDX_BFLY
#pragma unroll
    for (int j = 0; j < 4; ++j) SELM[(size_t)myq * 128 + kl + 32 * j] = x[j];
}

__device__ __forceinline__ void indexer_phase(const Args& args, Frame& F) {
    const int c = blockIdx.x;
    for (int i = 0; i < 8; ++i) {
        for (int u = c + i * F.G; u < 2048 && i < 8; u += 2048) {
            const int b = u >> 8, pos = u & 255, blk = (b & 1) ? 255 - pos : pos;
            indexer_unit(args, F, b, blk * 16);
        }
    }
}
namespace att {
constexpr int DM = ZW, QB = 256, KVB = 64, SLOTB = 8192;
constexpr int NS = 4;
constexpr int L_K = 0, L_V = NS * SLOTB, L_MASK = 2 * NS * SLOTB, L_WSF = L_MASK + 8 * 2048, L_OST = L_WSF + 8 * 256, L_BT = L_OST + 8 * 4096, L_MT = L_BT + 512, L_BT4 = L_MT + 128, L_END = L_BT4 + 4 * 1280;
static_assert(L_END <= RING_BYTES, "attention LDS");
__device__ __forceinline__ int crow(int r, int hi) { return (r & 3) + 8 * (r >> 2) + 4 * hi; }
__device__ __forceinline__ void glds16(const void* gsrc, unsigned lds_dst) { unsigned keep;
    asm volatile("s_mov_b32 %0, m0\n\ts_mov_b32 m0, %2\n\ts_nop 0\n\tglobal_load_lds_dwordx4 %1, off\n\ts_mov_b32 m0, %0" : "=&s"(keep) : "v"(gsrc), "s"(lds_dst) : "memory"); }
__device__ __forceinline__ unsigned cvtpk(float lo, float hi) { return cvt_pk_bf16(lo, hi); }
typedef short s16x4 __attribute__((ext_vector_type(4)));

#ifdef PROBE_CYC
#define CYC_DECL unsigned cyc_t0_ = 0, cyc_a_ = 0; asm volatile("" : "+v"(cyc_t0_), "+v"(cyc_a_)); const bool cyc_on_ = (F.vcu == PROBE_CYC_WG) && (F.wave == PROBE_CYC_WAVE)
#define CYC_START() do { unsigned n_ = (unsigned)__builtin_readcyclecounter(); asm volatile("" : "+v"(n_)); cyc_t0_ = n_; } while (0)
#define CYC_MARK(k_) do { unsigned n_ = (unsigned)__builtin_readcyclecounter(); asm volatile("" : "+v"(n_)); if ((k_) == PROBE_CYC_SEL) cyc_a_ += n_ - cyc_t0_; cyc_t0_ = n_; } while (0)
#define CYC_FLUSH() do { if (cyc_on_ && F.lane == 0) atomicAdd(F.ctl + CW_Q + 64, cyc_a_); } while (0)
#else
#define CYC_DECL
#define CYC_START()
#define CYC_MARK(k_)
#define CYC_FLUSH()
#endif
__device__ __forceinline__ void attn_unit(const Args& args, Frame& F, int b, int h, int qb) {
    const int lane = F.lane, r32 = lane & 31, hi = lane >> 5, wid = F.wave;
    CYC_DECL;
#ifndef PROBE_ATT_VAR
#define PROBE_ATT_VAR 0
#endif
    const bool alt_ = (PROBE_ATT_VAR != 0) && (args.li == 1);
#define ALT(bit_) (alt_ && ((PROBE_ATT_VAR) & (bit_)))
    const bf16_t* Zb = (const bf16_t*)(F.ws + WS_Z) + (size_t)b * SEQ * DM;
    const int q0 = qb * QB;
    const bf16_t* Qw = Zb + (size_t)(q0 + wid * 32) * DM + ZQ + h * 64;
    const bf16_t* Kh = Zb + ZK + h * 64; const bf16_t* Vh = Zb + ZV + h * 64;
    LAS unsigned char* shm = F.lds;
    const unsigned lds0 = (unsigned)(uintptr_t)shm;
    LAS float* wsf = (LAS float*)(shm + L_WSF) + wid * 64;
    LAS float* bt = (LAS float*)(shm + L_BT);
    if (F.tid >= 128 && F.tid < 144) { const unsigned n = F.tid - 128;
        *(LAS u32x2*)(shm + L_MT + 8 * n) = (u32x2){((n & 1u) ? 0xFFFFu : 0u) | ((n & 2u) ? 0xFFFF0000u : 0u), ((n & 4u) ? 0xFFFFu : 0u) | ((n & 8u) ? 0xFFFF0000u : 0u)}; }
    if (F.tid < 128) { const int rel = F.tid; int bk;
        if (rel < 16) bk = rel; else { bk = 16 + (int)(logf((float)rel / 16.0f) / logf(8.0f) * 16.0f); bk = bk < 31 ? bk : 31; }
        bt[rel] = (AIN(6)[bk * 8 + h] - AIN(6)[31 * 8 + h]) * 1.4426950408889634f; }
    for (int e = F.tid; e < 4 * 320; e += NTHR) { const int s_ = e / 320, i_ = e - 320 * s_; int rel = i_ - 96 + s_; rel = rel < 0 ? 0 : (rel > 127 ? 127 : rel); int bk;
        if (rel < 16) bk = rel; else { bk = 16 + (int)(logf((float)rel / 16.0f) / logf(8.0f) * 16.0f); bk = bk < 31 ? bk : 31; }
        ((LAS float*)(shm + L_BT4))[e] = (AIN(6)[bk * 8 + h] - AIN(6)[31 * 8 + h]) * 1.4426950408889634f; }
    const bf16_t* ksrc = Kh + (size_t)lane * DM + wid * 8;
    const bf16_t* vsrc = Vh + (size_t)(16 * (wid & 3) + (lane >> 2)) * DM + (wid >> 2) * 32 + (lane & 3) * 8;
    const unsigned kdst = lds0 + L_K + wid * 1024, vdst = lds0 + L_V + wid * 1024;
    const unsigned* SELM = (const unsigned*)(F.ws + WS_SEL) + (size_t)(b * SEQ + q0 + wid * 32 + r32) * 128 + 4 * hi;
    const unsigned mdst = lds0 + L_MASK + wid * 2048;
#define DMA_K(t, slot) glds16(ksrc + (size_t)(t) * KVB * DM, (unsigned)__builtin_amdgcn_readfirstlane(kdst + (slot) * SLOTB))
#define DMA_V(t, slot) glds16(vsrc + (size_t)(t) * KVB * DM, (unsigned)__builtin_amdgcn_readfirstlane(vdst + (slot) * SLOTB))
#define DMA_M(g) glds16(SELM + 8 * (g), (unsigned)__builtin_amdgcn_readfirstlane(mdst + ((g) & 1) * 1024))
    const int NT = ALT(1024) ? 4 : (q0 + QB) / KVB;
    bf16x8 qr[4];
#pragma unroll
    for (int d0 = 0; d0 < 4; ++d0) qr[d0] = *(const bf16x8*)(Qw + (size_t)r32 * DM + d0 * 16 + hi * 8);
    asm volatile("s_waitcnt vmcnt(0)" ::: "memory");
    __syncthreads();
    DMA_M(0); DMA_K(0, 0); DMA_K(1, 1); DMA_V(0, 0); DMA_K(2, 2); DMA_V(1, 1); DMA_K(3, 3); DMA_V(2, 2);
    float m_run = 0.f; f32x16 o[2], lacc = f32x16{}; o[0] = f32x16{}; o[1] = f32x16{};
    const bf16x8 ones8 = __builtin_bit_cast(bf16x8, (u32x4){0x3F803F80u, 0x3F803F80u, 0x3F803F80u, 0x3F803F80u});
    const int qpos = q0 + wid * 32 + r32;
    const int vb0 = (int)(lds0 + L_V) + ((lane >> 4) & 1) * 32 + (lane & 3) * 8 + (4 * hi + ((lane & 15) >> 2)) * 64;
#define QK_TILE(P0, P1, slot_) do { const LAS unsigned char* kb = shm + L_K + (slot_) * SLOTB + hi * 1024 + r32 * 16; P0 = f32x16{}; P1 = f32x16{}; \
        _Pragma("unroll") for (int d0 = 0; d0 < 4; ++d0) { const bf16x8 b0 = *(const LAS bf16x8*)(kb + d0 * 2048); const bf16x8 b1 = *(const LAS bf16x8*)(kb + d0 * 2048 + 512); \
            P0 = __builtin_amdgcn_mfma_f32_32x32x16_bf16(b0, qr[d0], P0, 0, 0, 0); P1 = __builtin_amdgcn_mfma_f32_32x32x16_bf16(b1, qr[d0], P1, 0, 0, 0); } } while (0)
    f32x16 pa0, pa1, pb0, pb1;
    asm volatile("s_waitcnt vmcnt(6)" ::: "memory");
    __builtin_amdgcn_s_barrier(); asm volatile("" ::: "memory");
    QK_TILE(pa0, pa1, 0);
#define ATT_WAITV(n_) do { const int nn_ = (n_); if (nn_ >= 4) asm volatile("s_waitcnt vmcnt(4)" ::: "memory"); else if (nn_ == 3) asm volatile("s_waitcnt vmcnt(3)" ::: "memory"); \
        else if (nn_ == 2) asm volatile("s_waitcnt vmcnt(2)" ::: "memory"); else if (nn_ == 1) asm volatile("s_waitcnt vmcnt(1)" ::: "memory"); else asm volatile("s_waitcnt vmcnt(0)" ::: "memory"); } while (0)
    asm volatile("s_waitcnt lgkmcnt(0)" ::: "memory");
    if (wid >= 4) { __builtin_amdgcn_s_barrier(); asm volatile("" ::: "memory"); }
    auto step = [&](const int t, f32x16& C0, f32x16& C1, f32x16& N0, f32x16& N1) __attribute__((always_inline)) {
        const int slot = t & (NS - 1), g = t >> 2, tq = t & 3;
        CYC_START();
        if (!ALT(32)) ATT_WAITV((t + 1 < NT) + 2 * (t + 2 < NT) + (t + 3 < NT));
        if (!ALT(16)) __builtin_amdgcn_s_barrier(); asm volatile("" ::: "memory");
        CYC_MARK(0);
        if (t + 4 < NT && !ALT(32)) DMA_K(t + 4, (t + 4) & (NS - 1));
        if (tq == 0 && !ALT(32)) DMA_M(g + 1);
        if (t + 1 < NT) { if (ALT(4)) { N0 = f32x16{}; N1 = f32x16{}; } else QK_TILE(N0, N1, (t + 1) & (NS - 1)); }
        __builtin_amdgcn_sched_barrier(0);
        const u32x2 mwv = *(const LAS u32x2*)(shm + L_MASK + wid * 2048 + (g & 1) * 1024 + (tq >> 1) * 512 + r32 * 16 + (tq & 1) * 8);
        if (64 * t + 63 + 112 >= q0 + wid * 32 && 64 * t <= q0 + wid * 32 + 31 && !ALT(256)) {
            const int ib_ = qpos - 64 * t - 4 * hi - 3 + 96;
#pragma unroll
            for (int g4 = 0; g4 < 4; ++g4) { const int i0 = ib_ - 8 * g4, i1 = i0 - 32;
                const f32x4 e0 = *(const LAS f32x4*)(shm + L_BT4 + (i0 & 3) * 1280 + (i0 & ~3) * 4), e1 = *(const LAS f32x4*)(shm + L_BT4 + (i1 & 3) * 1280 + (i1 & ~3) * 4);
                C0[4 * g4 + 3] += e0.x; C0[4 * g4 + 2] += e0.y; C0[4 * g4 + 1] += e0.z; C0[4 * g4] += e0.w;
                C1[4 * g4 + 3] += e1.x; C1[4 * g4 + 2] += e1.y; C1[4 * g4 + 1] += e1.z; C1[4 * g4] += e1.w; }
        }
        if (!ALT(128)) {
        typedef float f32x2_ __attribute__((ext_vector_type(2)));
        { const f32x2_ mm = {m_run, m_run};
#pragma unroll
          for (int r = 0; r < 16; r += 2) { f32x2_ a = {C0[r], C0[r + 1]}, c = {C1[r], C1[r + 1]}; a -= mm; c -= mm; C0[r] = a.x; C0[r + 1] = a.y; C1[r] = c.x; C1[r + 1] = c.y; } }
        float rm = __builtin_fmaxf(C0[0], C1[0]);
#pragma unroll
        for (int r = 1; r < 16; ++r) rm = __builtin_fmaxf(rm, __builtin_fmaxf(C0[r], C1[r]));
        if (t == 0 || __builtin_amdgcn_ballot_w64(rm > 8.0f) != 0ull) {
            rm = __builtin_fmaxf(rm, __shfl_xor(rm, 32));
            const float dm = t == 0 ? rm : __builtin_fmaxf(rm, 0.f);
            const float f = t == 0 ? 1.0f : __builtin_amdgcn_exp2f(-dm);
            m_run += dm;
#pragma unroll
            for (int r = 0; r < 16; ++r) { C0[r] -= dm; C1[r] -= dm; }
            if (hi == 0) wsf[r32] = f;
            asm volatile("s_waitcnt lgkmcnt(0)" ::: "memory");
#pragma unroll
            for (int r = 0; r < 16; ++r) { const float fr_ = wsf[crow(r, hi)]; o[0][r] *= fr_; o[1][r] *= fr_; lacc[r] *= fr_; }
        }
        }
        if (!ALT(2)) {
#pragma unroll
        for (int r = 0; r < 16; ++r) { C0[r] = __builtin_amdgcn_exp2f(C0[r]); C1[r] = __builtin_amdgcn_exp2f(C1[r]); } }
        asm volatile("s_waitcnt lgkmcnt(0)" ::: "memory");
        CYC_MARK(1);
        if (!ALT(32)) ATT_WAITV((t + 1 < NT) + (t + 2 < NT) + (t + 3 < NT) + (t + 4 < NT));
        if (!ALT(16)) __builtin_amdgcn_s_barrier(); asm volatile("" ::: "memory");
        CYC_MARK(2);
        if (t + 3 < NT && !ALT(32)) DMA_V(t + 3, (t + 3) & (NS - 1));
        u32x4 pw0, pw1, pw2, pw3;
        pw0 = (u32x4){cvtpk(C0[0], C0[1]), cvtpk(C0[2], C0[3]), cvtpk(C0[4], C0[5]), cvtpk(C0[6], C0[7])};
        pw1 = (u32x4){cvtpk(C0[8], C0[9]), cvtpk(C0[10], C0[11]), cvtpk(C0[12], C0[13]), cvtpk(C0[14], C0[15])};
        pw2 = (u32x4){cvtpk(C1[0], C1[1]), cvtpk(C1[2], C1[3]), cvtpk(C1[4], C1[5]), cvtpk(C1[6], C1[7])};
        pw3 = (u32x4){cvtpk(C1[8], C1[9]), cvtpk(C1[10], C1[11]), cvtpk(C1[12], C1[13]), cvtpk(C1[14], C1[15])};
        if (!ALT(64))
        { const unsigned mx_ = mwv.x >> (4 * hi), my_ = mwv.y >> (4 * hi); const LAS unsigned char* mt = shm + L_MT;
          const u32x2 a0 = *(const LAS u32x2*)(mt + ((mx_ << 3) & 0x78u)), a1 = *(const LAS u32x2*)(mt + ((mx_ >> 5) & 0x78u)), a2 = *(const LAS u32x2*)(mt + ((mx_ >> 13) & 0x78u)), a3 = *(const LAS u32x2*)(mt + ((mx_ >> 21) & 0x78u));
          const u32x2 b0 = *(const LAS u32x2*)(mt + ((my_ << 3) & 0x78u)), b1 = *(const LAS u32x2*)(mt + ((my_ >> 5) & 0x78u)), b2 = *(const LAS u32x2*)(mt + ((my_ >> 13) & 0x78u)), b3 = *(const LAS u32x2*)(mt + ((my_ >> 21) & 0x78u));
          pw0.x &= a0.x; pw0.y &= a0.y; pw0.z &= a1.x; pw0.w &= a1.y; pw1.x &= a2.x; pw1.y &= a2.y; pw1.z &= a3.x; pw1.w &= a3.y;
          pw2.x &= b0.x; pw2.y &= b0.y; pw2.z &= b1.x; pw2.w &= b1.y; pw3.x &= b2.x; pw3.y &= b2.y; pw3.z &= b3.x; pw3.w &= b3.y; }
        if (!ALT(8)) {
        lacc = __builtin_amdgcn_mfma_f32_32x32x16_bf16(__builtin_bit_cast(bf16x8, pw0), ones8, lacc, 0, 0, 0); lacc = __builtin_amdgcn_mfma_f32_32x32x16_bf16(__builtin_bit_cast(bf16x8, pw1), ones8, lacc, 0, 0, 0);
        lacc = __builtin_amdgcn_mfma_f32_32x32x16_bf16(__builtin_bit_cast(bf16x8, pw2), ones8, lacc, 0, 0, 0); lacc = __builtin_amdgcn_mfma_f32_32x32x16_bf16(__builtin_bit_cast(bf16x8, pw3), ones8, lacc, 0, 0, 0);
        { const int vb = vb0 + slot * SLOTB;
#pragma unroll
          for (int d0 = 0; d0 < 2; ++d0) { s16x4 lo[4], hh[4];
#pragma unroll
              for (int ks = 0; ks < 4; ++ks) {
                  asm volatile("ds_read_b64_tr_b16 %0,%1 offset:%c2" : "=&v"(lo[ks]) : "v"(vb), "i"(d0 * 4096 + ks * 1024) : "memory");
                  asm volatile("ds_read_b64_tr_b16 %0,%1 offset:%c2" : "=&v"(hh[ks]) : "v"(vb), "i"(d0 * 4096 + ks * 1024 + 512) : "memory"); }
              asm volatile("s_waitcnt lgkmcnt(0)" ::: "memory"); __builtin_amdgcn_sched_barrier(0);
#define PKV(k) (bf16x8){lo[k][0], lo[k][1], lo[k][2], lo[k][3], hh[k][0], hh[k][1], hh[k][2], hh[k][3]}
              o[d0] = __builtin_amdgcn_mfma_f32_32x32x16_bf16(__builtin_bit_cast(bf16x8, pw0), PKV(0), o[d0], 0, 0, 0);
              o[d0] = __builtin_amdgcn_mfma_f32_32x32x16_bf16(__builtin_bit_cast(bf16x8, pw1), PKV(1), o[d0], 0, 0, 0);
              o[d0] = __builtin_amdgcn_mfma_f32_32x32x16_bf16(__builtin_bit_cast(bf16x8, pw2), PKV(2), o[d0], 0, 0, 0);
              o[d0] = __builtin_amdgcn_mfma_f32_32x32x16_bf16(__builtin_bit_cast(bf16x8, pw3), PKV(3), o[d0], 0, 0, 0);
#undef PKV
          } }
        }
        asm volatile("s_waitcnt lgkmcnt(0)" ::: "memory");
        CYC_MARK(3);
    };
    for (int t = 0; t < NT; t += 2) { step(t, pa0, pa1, pb0, pb1); step(t + 1, pb0, pb1, pa0, pa1); }
    if (wid < 4) { __builtin_amdgcn_s_barrier(); asm volatile("" ::: "memory"); }
#undef QK_TILE
#undef ATT_WAITV
    CYC_FLUSH();
    bf16_t* Ow = (bf16_t*)(F.ws + (alt_ ? WS_R2 : WS_R1)) + (size_t)(b * SEQ + q0 + wid * 32) * 512 + h * 64;
    { LAS bf16_t* stg = (LAS bf16_t*)(shm + L_OST) + wid * 2048;
#pragma unroll
      for (int r = 0; r < 16; ++r) { const int orow = crow(r, hi); const float rl = __builtin_amdgcn_rcpf(lacc[r]);
#pragma unroll
          for (int d0 = 0; d0 < 2; ++d0) stg[orow * 64 + d0 * 32 + r32] = (bf16_t)f2bf(o[d0][r] * rl); }
      asm volatile("s_waitcnt lgkmcnt(0)" ::: "memory");
#pragma unroll
      for (int i = 0; i < 4; ++i) { const int row = i * 8 + (lane >> 3), chn = lane & 7; const u32x4 v = *(const LAS u32x4*)(stg + row * 64 + chn * 8); *(u32x4*)(Ow + (size_t)row * 512 + chn * 8) = v; } }
    asm volatile("s_waitcnt lgkmcnt(0)" ::: "memory");
#undef DMA_K
#undef DMA_V
#undef DMA_M
}

__device__ __forceinline__ void attn_phase(const Args& args, Frame& F) {
    const int v = F.vcu;
    for (int i = 0; i < 4; ++i) {
        for (int uu = v; uu < 256; uu += F.G) {
            const int bh = uu >> 2, s = uu & 3; const int qb = (i == 0) ? s : (i == 1) ? 7 - s : (i == 2) ? 8 + s : 15 - s;
            attn_unit(args, F, bh >> 3, bh & 7, qb);
        }
    }
}
}
#ifndef PROBE_NO_STATE
#define PROBE_NO_STATE 0
#endif
#ifndef PROBE_TINV_ID
#define PROBE_TINV_ID 0
#endif
namespace rk {
typedef __bf16 bf16x2_t __attribute__((ext_vector_type(2)));
__device__ __forceinline__ unsigned cvtpk(float lo, float hi) { f32x2 v = {lo, hi}; bf16x2_t b = __builtin_convertvector(v, bf16x2_t); return __builtin_bit_cast(unsigned, b); }
template <int S> __device__ __forceinline__ bf16x8 frag(const f32x16& x) {
    u32x4 o; o.x = cvtpk(x[8 * S + 0], x[8 * S + 1]); o.y = cvtpk(x[8 * S + 2], x[8 * S + 3]); o.z = cvtpk(x[8 * S + 4], x[8 * S + 5]); o.w = cvtpk(x[8 * S + 6], x[8 * S + 7]);
    return __builtin_bit_cast(bf16x8, o); }
template <int S> __device__ __forceinline__ void unfrag(f32x16& x, bf16x8 f) { const u32x4 o = __builtin_bit_cast(u32x4, f);
    x[8 * S + 0] = bf_lo(o.x); x[8 * S + 1] = bf_hi(o.x); x[8 * S + 2] = bf_lo(o.y); x[8 * S + 3] = bf_hi(o.y); x[8 * S + 4] = bf_lo(o.z); x[8 * S + 5] = bf_hi(o.z); x[8 * S + 6] = bf_lo(o.w); x[8 * S + 7] = bf_hi(o.w); }
#define RK_MF(a, b, c) __builtin_amdgcn_mfma_f32_32x32x16_bf16((a), (b), (c), 0, 0, 0)
__device__ __forceinline__ float dppf(float v, const int ctrl_is_const_dummy);
#define RK_DPP(v, ctrl, rmask, bc) __builtin_bit_cast(float, __builtin_amdgcn_update_dpp(0, __builtin_bit_cast(int, (v)), (ctrl), (rmask), 0xF, (bc)))
__device__ __forceinline__ float scan32(float v) {
#ifdef PROBE_SHFL_SCAN
    const int l32 = threadIdx.x & 31;
#pragma unroll
    for (int o = 1; o < 32; o <<= 1) { const float t = __shfl_up(v, o, 32); if (l32 >= o) v += t; }
    return v;
#endif
    v += RK_DPP(v, 0x111, 0xF, true); v += RK_DPP(v, 0x112, 0xF, true); v += RK_DPP(v, 0x114, 0xF, true); v += RK_DPP(v, 0x118, 0xF, true);
    v += RK_DPP(v, 0x142, 0xA, false);
    return v; }
__device__ __forceinline__ float ex2(float x) { return __builtin_amdgcn_exp2f(x); }
constexpr int PZ = 3600;
constexpr size_t SZ_G = 8192, SZ_H = 8192, SZ_Q = 4096, SZ_Y = 4096;
constexpr float L2E = 1.4426950408889634f;

__device__ __forceinline__ void mk_id(bf16x8 (&fId)[2], int r, int h) {
    asm volatile("" : "+v"(r), "+v"(h));
#pragma unroll
    for (int s = 0; s < 2; ++s) { unsigned short e8[8];
#pragma unroll
        for (int jj = 0; jj < 8; ++jj) e8[jj] = (16 * s + 8 * (jj >> 2) + 4 * h + (jj & 3) == r) ? (unsigned short)0x3F80 : (unsigned short)0;
        fId[s] = __builtin_bit_cast(bf16x8, (u32x4){(unsigned)e8[0] | ((unsigned)e8[1] << 16), (unsigned)e8[2] | ((unsigned)e8[3] << 16), (unsigned)e8[4] | ((unsigned)e8[5] << 16), (unsigned)e8[6] | ((unsigned)e8[7] << 16)}); }
}

__device__ __forceinline__ void load_params(const Args& args, Frame& F) {
    LAS float* pra = (LAS float*)(F.lds + LDS_PARA); LAS float* prb = (LAS float*)(F.lds + LDS_PARB);
    const float* mu = AIN(7); const float* w0 = AIN(8); const float* a0 = AIN(10); const float* kk = AIN(13); const float* ka = AIN(14); const float* rk = AIN(15);
    for (int i = F.tid; i < 4096; i += NTHR) { const int a = i >> 9, c = i & 511;
        const float v_ = a < 3 ? mu[a * 512 + c] : (a == 3 ? w0[c] : (a == 4 ? a0[c] : (a == 5 ? kk[c] : (a == 6 ? ka[c] : rk[c]))));
        if (a < 4) pra[c * 4 + a] = v_; else prb[c * 4 + a - 4] = v_; }
    __syncthreads();
}
struct ElemCtx { const LAS unsigned char* rowc; const LAS unsigned char* rowp; const bf16_t* DUt; const bf16_t* IUt; const LAS float* pra; const LAS float* prb; int hd, r, h; float inv; };
template <int MODE> __device__ __forceinline__ void r1_elem(const ElemCtx& C, int jt, bf16x8 (&o0)[2], bf16x8 (&o1)[2], bf16x8 (&o2)[2], bf16x8 (&o3)[2], float& bns, float& pcd) {
    const int r = C.r, h = C.h, hd = C.hd;
    f32x16 lw_ = f32x16{}, la_ = f32x16{};
#pragma unroll
    for (int ks = 0; ks < 4; ++ks) { const int k0 = 16 * ks + 8 * h;
        const bf16x8 bw = *(const LAS bf16x8*)(C.rowc + (1536 + k0) * 2), ba = *(const LAS bf16x8*)(C.rowc + (1600 + k0) * 2);
        const bf16x8 fa = *(const bf16x8*)(C.DUt + (size_t)(32 * jt + r) * 64 + k0), fi = *(const bf16x8*)(C.IUt + (size_t)(32 * jt + r) * 64 + k0);
        lw_ = RK_MF(fa, bw, lw_); la_ = RK_MF(fi, ba, la_); }
    float d = 0.f;
#pragma unroll
    for (int s = 0; s < 2; ++s) { float x0[8], x1[8], x2[8], x3[8];
#pragma unroll
        for (int g2 = 0; g2 < 2; ++g2) { const int g = 2 * s + g2, cj = hd * 64 + 32 * jt + 8 * g + 4 * h;
            float kc[4], kq[4], xc[4], xq[4];
            { const u32x2 a = *(const LAS u32x2*)(C.rowc + (512 + cj) * 2), p = *(const LAS u32x2*)(C.rowp + (512 + cj) * 2);
              kc[0] = bf_lo(a.x); kc[1] = bf_hi(a.x); kc[2] = bf_lo(a.y); kc[3] = bf_hi(a.y); kq[0] = bf_lo(p.x); kq[1] = bf_hi(p.x); kq[2] = bf_lo(p.y); kq[3] = bf_hi(p.y); }
            { const int xo = MODE ? 1024 : 0; const u32x2 a = *(const LAS u32x2*)(C.rowc + (xo + cj) * 2), p = *(const LAS u32x2*)(C.rowp + (xo + cj) * 2);
              xc[0] = bf_lo(a.x); xc[1] = bf_hi(a.x); xc[2] = bf_lo(a.y); xc[3] = bf_hi(a.y); xq[0] = bf_lo(p.x); xq[1] = bf_hi(p.x); xq[2] = bf_lo(p.y); xq[3] = bf_hi(p.y); }
            const LAS f32x4* ppa = (const LAS f32x4*)(C.pra + cj * 4); const LAS f32x4* ppb = (const LAS f32x4*)(C.prb + cj * 4);
#pragma unroll
            for (int q = 0; q < 4; ++q) { const int i = 4 * g + q, o = 4 * g2 + q;
                const f32x4 pa = ppa[q], pb = ppb[q];
                const float e_ = 0.6065306597126334f * fast_sigmoid(pa[3] + lw_[i]); const float L = scan32(e_);
                const float l0 = __builtin_bit_cast(float, __builtin_amdgcn_readlane(__builtin_bit_cast(int, L), 31)), l1 = __builtin_bit_cast(float, __builtin_amdgcn_readlane(__builtin_bit_cast(int, L), 63));
                const float Lend = h ? l1 : l0; if (i == 4 * (r >> 3) + (r & 3)) d = Lend;
                const float x_ = xc[q] + (MODE ? pa[2] : pa[0]) * (xq[q] - xc[q]), k_ = kc[q] + pa[1] * (kq[q] - kc[q]);
                const float ic = fast_sigmoid(pb[0] + la_[i]);
                const float kk = k_ * pb[1] * C.inv, kpn = k_ * (1.0f + (ic - 1.0f) * pb[2]), bv = kk * ic;
                if (MODE) { const float Qe = ex2(L2E * (L - Lend)); x0[o] = bv * Qe; x1[o] = kpn * Qe; x2[o] = x_; x3[o] = 0.f; }
                else { const float P = ex2(-L2E * L), Pi = ex2(L2E * L), Pm = ex2(-L2E * (L - e_)); bns += x_ * kpn * pb[3]; x0[o] = -kk * Pm; x1[o] = x_ * P; x2[o] = bv * Pi; x3[o] = kpn * Pi; } }
            asm volatile("" ::: "memory"); }
        o0[s] = __builtin_bit_cast(bf16x8, (u32x4){cvtpk(x0[0], x0[1]), cvtpk(x0[2], x0[3]), cvtpk(x0[4], x0[5]), cvtpk(x0[6], x0[7])});
        o1[s] = __builtin_bit_cast(bf16x8, (u32x4){cvtpk(x1[0], x1[1]), cvtpk(x1[2], x1[3]), cvtpk(x1[4], x1[5]), cvtpk(x1[6], x1[7])});
        o2[s] = __builtin_bit_cast(bf16x8, (u32x4){cvtpk(x2[0], x2[1]), cvtpk(x2[2], x2[3]), cvtpk(x2[4], x2[5]), cvtpk(x2[6], x2[7])});
        if (!MODE) o3[s] = __builtin_bit_cast(bf16x8, (u32x4){cvtpk(x3[0], x3[1]), cvtpk(x3[2], x3[3]), cvtpk(x3[4], x3[5]), cvtpk(x3[6], x3[7])}); }
    if (MODE) pcd = ex2(-L2E * d);
}


__device__ __forceinline__ void r1_unit(const Args& args, Frame& F, int b, int c) {
    LAS unsigned char* IMG = F.lds;
    const bf16_t* Z = (const bf16_t*)(F.ws + WS_Z);
    const int t0 = 32 * c; const size_t m0 = (size_t)b * SEQ + t0;
    const float* mu = AIN(7);
    int tid = F.tid; asm volatile("" : "+v"(tid));
    __syncthreads();
    { const unsigned lds0 = (unsigned)(uintptr_t)IMG; const int ln = tid & 63;
      for (int task = F.wave; task < 33 * 4; task += NWAVES) { const int rr = task >> 2, j = task & 3, pc = 64 * j + ln;
          if (pc < 224) { if (rr > 0 || t0 > 0) att::glds16(Z + (m0 + rr - 1) * ZW + ZR + 8 * pc, (unsigned)__builtin_amdgcn_readfirstlane((int)(lds0 + rr * PZ + 1024 * j)));
                          else *(LAS u32x4*)(IMG + 16 * pc) = (u32x4){0u, 0u, 0u, 0u}; } }
      asm volatile("s_waitcnt vmcnt(0)" ::: "memory"); }
    __syncthreads();
    { u32x4 actv[2];
#pragma unroll
      for (int i = 0; i < 2; ++i) { const int q = tid + NTHR * i, t = q >> 5, kp = q & 31;
          const u32x4 cw = *(const LAS u32x4*)(IMG + (t + 1) * PZ + (1536 + 8 * kp) * 2), pw = *(const LAS u32x4*)(IMG + t * PZ + (1536 + 8 * kp) * 2);
          const f32x4 m0v = *(const f32x4*)(mu + 1536 + 8 * kp), m1v = *(const f32x4*)(mu + 1536 + 8 * kp + 4);
          const unsigned cwa[4] = {cw.x, cw.y, cw.z, cw.w}, pwa[4] = {pw.x, pw.y, pw.z, pw.w}; float x[8];
#pragma unroll
          for (int j = 0; j < 4; ++j) { const float c0 = bf_lo(cwa[j]), c1 = bf_hi(cwa[j]), p0 = bf_lo(pwa[j]), p1 = bf_hi(pwa[j]);
              const float mu0 = j < 2 ? m0v[2 * j] : m1v[2 * j - 4], mu1 = j < 2 ? m0v[2 * j + 1] : m1v[2 * j - 3];
              x[2 * j] = c0 + mu0 * (p0 - c0); x[2 * j + 1] = c1 + mu1 * (p1 - c1); }
#pragma unroll
          for (int j = 0; j < 8; ++j) { if (kp < 8) { const float e2 = ex2(2.885390081777927f * x[j]); x[j] = 1.0f - 2.0f * __builtin_amdgcn_rcpf(e2 + 1.0f); } else if (kp >= 16) x[j] = fast_sigmoid(x[j]); }
          actv[i] = (u32x4){cvtpk(x[0], x[1]), cvtpk(x[2], x[3]), cvtpk(x[4], x[5]), cvtpk(x[6], x[7])}; }
      __syncthreads();
#pragma unroll
      for (int i = 0; i < 2; ++i) { const int q = tid + NTHR * i, t = q >> 5, kp = q & 31; *(LAS u32x4*)(IMG + (t + 1) * PZ + (1536 + 8 * kp) * 2) = actv[i]; }
      __syncthreads(); }
    const int hd = F.wave; int r = tid & 31, h = (tid >> 5) & 1;
    const LAS unsigned char* rowc = IMG + (r + 1) * PZ; const LAS unsigned char* rowp = IMG + r * PZ;
    const bf16_t* DUt = (const bf16_t*)(F.ws + WS_DUT) + (size_t)hd * 4096; const bf16_t* IUt = (const bf16_t*)(F.ws + WS_IUT) + (size_t)hd * 4096;
    const LAS float* pra = (const LAS float*)(F.lds + LDS_PARA); const LAS float* prb = (const LAS float*)(F.lds + LDS_PARB);
    float n2 = 0.f;
#pragma unroll
    for (int jt = 0; jt < 2; ++jt)
#pragma unroll
        for (int g = 0; g < 4; ++g) { const int cj = hd * 64 + 32 * jt + 8 * g + 4 * h;
            const u32x2 a = *(const LAS u32x2*)(rowc + (512 + cj) * 2), p = *(const LAS u32x2*)(rowp + (512 + cj) * 2);
            const float kc[4] = {bf_lo(a.x), bf_hi(a.x), bf_lo(a.y), bf_hi(a.y)}, kq[4] = {bf_lo(p.x), bf_hi(p.x), bf_lo(p.y), bf_hi(p.y)};
            #pragma unroll
            for (int q = 0; q < 4; ++q) { const float muk = pra[(cj + q) * 4 + 1], kkp = prb[(cj + q) * 4 + 1]; const float k_ = kc[q] + muk * (kq[q] - kc[q]); const float kk_ = k_ * kkp; n2 += kk_ * kk_; } }
    n2 += __shfl_xor(n2, 32);
    const float inv = 1.0f / __builtin_fmaxf(sqrtf(n2), 1e-12f);
    float pcd[2] = {0.f, 0.f};
    float bns = 0.f;
    const ElemCtx EC{rowc, rowp, DUt, IUt, pra, prb, hd, r, h, inv};
    f32x16 Aab = f32x16{}, Aak = f32x16{}, Arb = f32x16{}, Ark = f32x16{};
    bf16x8 fRt[2][2], tAt[2][2];
    { bf16x8 fId[2]; mk_id(fId, r, h);
#pragma unroll
    for (int jt = 0; jt < 2; ++jt) { bf16x8 fA[2], fB[2], fK[2]; float pd_ = 0.f;
        r1_elem<0>(EC, jt, fA, fRt[jt], fB, fK, bns, pd_);
        const bf16x8 fA0 = fA[0], fA1 = fA[1], fB0 = fB[0], fB1 = fB[1], fK0 = fK[0], fK1 = fK[1];
        Aab = RK_MF(fB0, fA0, Aab); Aab = RK_MF(fB1, fA1, Aab); Aak = RK_MF(fK0, fA0, Aak); Aak = RK_MF(fK1, fA1, Aak);
        Arb = RK_MF(fB0, fRt[jt][0], Arb); Arb = RK_MF(fB1, fRt[jt][1], Arb); Ark = RK_MF(fK0, fRt[jt][0], Ark); Ark = RK_MF(fK1, fRt[jt][1], Ark);
        { f32x16 t_ = f32x16{}; t_ = RK_MF(fA0, fId[0], t_); t_ = RK_MF(fA1, fId[1], t_); tAt[jt][0] = frag<0>(t_); tAt[jt][1] = frag<1>(t_); } } }
    bns += __shfl_xor(bns, 32);
    if (h == 0) ((float*)(F.ws + WS_TOPW))[(m0 + r) * 8 + hd] = bns;
    LAS unsigned char* stash = IMG + (1 + ((tid & 63) >> 3)) * PZ + hd * 128 + (tid & 7) * 16;
#pragma unroll
    for (int p = 0; p < 4; ++p) *(LAS u32x4*)(stash + 8 * p * PZ) = __builtin_bit_cast(u32x4, fRt[p >> 1][p & 1]);
#pragma unroll
    for (int i = 0; i < 16; ++i) { const int s = 8 * (i >> 2) + 4 * h + (i & 3);
        if (!(s < r)) { Aab[i] = 0.f; Aak[i] = 0.f; } if (!(s <= r)) { Arb[i] = 0.f; Ark[i] = 0.f; } }
    const bf16x8 fAak[2] = {frag<0>(Aak), frag<1>(Aak)}, fArb[2] = {frag<0>(Arb), frag<1>(Arb)}, fArk[2] = {frag<0>(Ark), frag<1>(Ark)};
    bf16x8 fT[2];
    asm volatile("" ::: "memory"); __builtin_amdgcn_sched_barrier(0);
    { float T[32];
#pragma unroll
      for (int s = 0; s < 32; ++s) T[s] = (r == s) ? 1.0f : 0.f;
#define TI_RL(k_, is_, ln_) { const float ac_ = Aab[is_]; asm volatile("v_readlane_b32 %0, %1, " #ln_ : "=s"(sv_[k_]) : "v"(__float_as_int(ac_))); }
#define TI_FM(s_, u_, k_) T[s_] = __builtin_fmaf(T[u_], __int_as_float(sv_[k_]), T[s_]);
      if (!PROBE_TINV_ID) { int sv_[8];
        TI_RL(0, 0, 31) TI_RL(1, 1, 31) TI_RL(2, 2, 31) TI_RL(3, 3, 31) TI_RL(4, 0, 63) TI_RL(5, 1, 63) TI_RL(6, 2, 63) TI_RL(7, 3, 63)
        TI_FM(0, 31, 0) TI_FM(1, 31, 1) TI_FM(2, 31, 2) TI_FM(3, 31, 3) TI_FM(4, 31, 4) TI_FM(5, 31, 5) TI_FM(6, 31, 6) TI_FM(7, 31, 7)
        TI_RL(0, 4, 31) TI_RL(1, 5, 31) TI_RL(2, 6, 31) TI_RL(3, 7, 31) TI_RL(4, 4, 63) TI_RL(5, 5, 63) TI_RL(6, 6, 63) TI_RL(7, 7, 63)
        TI_FM(8, 31, 0) TI_FM(9, 31, 1) TI_FM(10, 31, 2) TI_FM(11, 31, 3) TI_FM(12, 31, 4) TI_FM(13, 31, 5) TI_FM(14, 31, 6) TI_FM(15, 31, 7)
        TI_RL(0, 8, 31) TI_RL(1, 9, 31) TI_RL(2, 10, 31) TI_RL(3, 11, 31) TI_RL(4, 8, 63) TI_RL(5, 9, 63) TI_RL(6, 10, 63) TI_RL(7, 11, 63)
        TI_FM(16, 31, 0) TI_FM(17, 31, 1) TI_FM(18, 31, 2) TI_FM(19, 31, 3) TI_FM(20, 31, 4) TI_FM(21, 31, 5) TI_FM(22, 31, 6) TI_FM(23, 31, 7)
        TI_RL(0, 12, 31) TI_RL(1, 13, 31) TI_RL(2, 14, 31) TI_RL(3, 15, 31) TI_RL(4, 12, 63) TI_RL(5, 13, 63) TI_RL(6, 14, 63)
        TI_FM(24, 31, 0) TI_FM(25, 31, 1) TI_FM(26, 31, 2) TI_FM(27, 31, 3) TI_FM(28, 31, 4) TI_FM(29, 31, 5) TI_FM(30, 31, 6)
        TI_RL(0, 0, 30) TI_RL(1, 1, 30) TI_RL(2, 2, 30) TI_RL(3, 3, 30) TI_RL(4, 0, 62) TI_RL(5, 1, 62) TI_RL(6, 2, 62) TI_RL(7, 3, 62)
        TI_FM(0, 30, 0) TI_FM(1, 30, 1) TI_FM(2, 30, 2) TI_FM(3, 30, 3) TI_FM(4, 30, 4) TI_FM(5, 30, 5) TI_FM(6, 30, 6) TI_FM(7, 30, 7)
        TI_RL(0, 4, 30) TI_RL(1, 5, 30) TI_RL(2, 6, 30) TI_RL(3, 7, 30) TI_RL(4, 4, 62) TI_RL(5, 5, 62) TI_RL(6, 6, 62) TI_RL(7, 7, 62)
        TI_FM(8, 30, 0) TI_FM(9, 30, 1) TI_FM(10, 30, 2) TI_FM(11, 30, 3) TI_FM(12, 30, 4) TI_FM(13, 30, 5) TI_FM(14, 30, 6) TI_FM(15, 30, 7)
        TI_RL(0, 8, 30) TI_RL(1, 9, 30) TI_RL(2, 10, 30) TI_RL(3, 11, 30) TI_RL(4, 8, 62) TI_RL(5, 9, 62) TI_RL(6, 10, 62) TI_RL(7, 11, 62)
        TI_FM(16, 30, 0) TI_FM(17, 30, 1) TI_FM(18, 30, 2) TI_FM(19, 30, 3) TI_FM(20, 30, 4) TI_FM(21, 30, 5) TI_FM(22, 30, 6) TI_FM(23, 30, 7)
        TI_RL(0, 12, 30) TI_RL(1, 13, 30) TI_RL(2, 14, 30) TI_RL(3, 15, 30) TI_RL(4, 12, 62) TI_RL(5, 13, 62)
        TI_FM(24, 30, 0) TI_FM(25, 30, 1) TI_FM(26, 30, 2) TI_FM(27, 30, 3) TI_FM(28, 30, 4) TI_FM(29, 30, 5)
        TI_RL(0, 0, 29) TI_RL(1, 1, 29) TI_RL(2, 2, 29) TI_RL(3, 3, 29) TI_RL(4, 0, 61) TI_RL(5, 1, 61) TI_RL(6, 2, 61) TI_RL(7, 3, 61)
        TI_FM(0, 29, 0) TI_FM(1, 29, 1) TI_FM(2, 29, 2) TI_FM(3, 29, 3) TI_FM(4, 29, 4) TI_FM(5, 29, 5) TI_FM(6, 29, 6) TI_FM(7, 29, 7)
        TI_RL(0, 4, 29) TI_RL(1, 5, 29) TI_RL(2, 6, 29) TI_RL(3, 7, 29) TI_RL(4, 4, 61) TI_RL(5, 5, 61) TI_RL(6, 6, 61) TI_RL(7, 7, 61)
        TI_FM(8, 29, 0) TI_FM(9, 29, 1) TI_FM(10, 29, 2) TI_FM(11, 29, 3) TI_FM(12, 29, 4) TI_FM(13, 29, 5) TI_FM(14, 29, 6) TI_FM(15, 29, 7)
        TI_RL(0, 8, 29) TI_RL(1, 9, 29) TI_RL(2, 10, 29) TI_RL(3, 11, 29) TI_RL(4, 8, 61) TI_RL(5, 9, 61) TI_RL(6, 10, 61) TI_RL(7, 11, 61)
        TI_FM(16, 29, 0) TI_FM(17, 29, 1) TI_FM(18, 29, 2) TI_FM(19, 29, 3) TI_FM(20, 29, 4) TI_FM(21, 29, 5) TI_FM(22, 29, 6) TI_FM(23, 29, 7)
        TI_RL(0, 12, 29) TI_RL(1, 13, 29) TI_RL(2, 14, 29) TI_RL(3, 15, 29) TI_RL(4, 12, 61)
        TI_FM(24, 29, 0) TI_FM(25, 29, 1) TI_FM(26, 29, 2) TI_FM(27, 29, 3) TI_FM(28, 29, 4)
        TI_RL(0, 0, 28) TI_RL(1, 1, 28) TI_RL(2, 2, 28) TI_RL(3, 3, 28) TI_RL(4, 0, 60) TI_RL(5, 1, 60) TI_RL(6, 2, 60) TI_RL(7, 3, 60)
        TI_FM(0, 28, 0) TI_FM(1, 28, 1) TI_FM(2, 28, 2) TI_FM(3, 28, 3) TI_FM(4, 28, 4) TI_FM(5, 28, 5) TI_FM(6, 28, 6) TI_FM(7, 28, 7)
        TI_RL(0, 4, 28) TI_RL(1, 5, 28) TI_RL(2, 6, 28) TI_RL(3, 7, 28) TI_RL(4, 4, 60) TI_RL(5, 5, 60) TI_RL(6, 6, 60) TI_RL(7, 7, 60)
        TI_FM(8, 28, 0) TI_FM(9, 28, 1) TI_FM(10, 28, 2) TI_FM(11, 28, 3) TI_FM(12, 28, 4) TI_FM(13, 28, 5) TI_FM(14, 28, 6) TI_FM(15, 28, 7)
        TI_RL(0, 8, 28) TI_RL(1, 9, 28) TI_RL(2, 10, 28) TI_RL(3, 11, 28) TI_RL(4, 8, 60) TI_RL(5, 9, 60) TI_RL(6, 10, 60) TI_RL(7, 11, 60)
        TI_FM(16, 28, 0) TI_FM(17, 28, 1) TI_FM(18, 28, 2) TI_FM(19, 28, 3) TI_FM(20, 28, 4) TI_FM(21, 28, 5) TI_FM(22, 28, 6) TI_FM(23, 28, 7)
        TI_RL(0, 12, 28) TI_RL(1, 13, 28) TI_RL(2, 14, 28) TI_RL(3, 15, 28)
        TI_FM(24, 28, 0) TI_FM(25, 28, 1) TI_FM(26, 28, 2) TI_FM(27, 28, 3)
        TI_RL(0, 0, 27) TI_RL(1, 1, 27) TI_RL(2, 2, 27) TI_RL(3, 3, 27) TI_RL(4, 0, 59) TI_RL(5, 1, 59) TI_RL(6, 2, 59) TI_RL(7, 3, 59)
        TI_FM(0, 27, 0) TI_FM(1, 27, 1) TI_FM(2, 27, 2) TI_FM(3, 27, 3) TI_FM(4, 27, 4) TI_FM(5, 27, 5) TI_FM(6, 27, 6) TI_FM(7, 27, 7)
        TI_RL(0, 4, 27) TI_RL(1, 5, 27) TI_RL(2, 6, 27) TI_RL(3, 7, 27) TI_RL(4, 4, 59) TI_RL(5, 5, 59) TI_RL(6, 6, 59) TI_RL(7, 7, 59)
        TI_FM(8, 27, 0) TI_FM(9, 27, 1) TI_FM(10, 27, 2) TI_FM(11, 27, 3) TI_FM(12, 27, 4) TI_FM(13, 27, 5) TI_FM(14, 27, 6) TI_FM(15, 27, 7)
        TI_RL(0, 8, 27) TI_RL(1, 9, 27) TI_RL(2, 10, 27) TI_RL(3, 11, 27) TI_RL(4, 8, 59) TI_RL(5, 9, 59) TI_RL(6, 10, 59) TI_RL(7, 11, 59)
        TI_FM(16, 27, 0) TI_FM(17, 27, 1) TI_FM(18, 27, 2) TI_FM(19, 27, 3) TI_FM(20, 27, 4) TI_FM(21, 27, 5) TI_FM(22, 27, 6) TI_FM(23, 27, 7)
        TI_RL(0, 12, 27) TI_RL(1, 13, 27) TI_RL(2, 14, 27)
        TI_FM(24, 27, 0) TI_FM(25, 27, 1) TI_FM(26, 27, 2)
        TI_RL(0, 0, 26) TI_RL(1, 1, 26) TI_RL(2, 2, 26) TI_RL(3, 3, 26) TI_RL(4, 0, 58) TI_RL(5, 1, 58) TI_RL(6, 2, 58) TI_RL(7, 3, 58)
        TI_FM(0, 26, 0) TI_FM(1, 26, 1) TI_FM(2, 26, 2) TI_FM(3, 26, 3) TI_FM(4, 26, 4) TI_FM(5, 26, 5) TI_FM(6, 26, 6) TI_FM(7, 26, 7)
        TI_RL(0, 4, 26) TI_RL(1, 5, 26) TI_RL(2, 6, 26) TI_RL(3, 7, 26) TI_RL(4, 4, 58) TI_RL(5, 5, 58) TI_RL(6, 6, 58) TI_RL(7, 7, 58)
        TI_FM(8, 26, 0) TI_FM(9, 26, 1) TI_FM(10, 26, 2) TI_FM(11, 26, 3) TI_FM(12, 26, 4) TI_FM(13, 26, 5) TI_FM(14, 26, 6) TI_FM(15, 26, 7)
        TI_RL(0, 8, 26) TI_RL(1, 9, 26) TI_RL(2, 10, 26) TI_RL(3, 11, 26) TI_RL(4, 8, 58) TI_RL(5, 9, 58) TI_RL(6, 10, 58) TI_RL(7, 11, 58)
        TI_FM(16, 26, 0) TI_FM(17, 26, 1) TI_FM(18, 26, 2) TI_FM(19, 26, 3) TI_FM(20, 26, 4) TI_FM(21, 26, 5) TI_FM(22, 26, 6) TI_FM(23, 26, 7)
        TI_RL(0, 12, 26) TI_RL(1, 13, 26)
        TI_FM(24, 26, 0) TI_FM(25, 26, 1)
        TI_RL(0, 0, 25) TI_RL(1, 1, 25) TI_RL(2, 2, 25) TI_RL(3, 3, 25) TI_RL(4, 0, 57) TI_RL(5, 1, 57) TI_RL(6, 2, 57) TI_RL(7, 3, 57)
        TI_FM(0, 25, 0) TI_FM(1, 25, 1) TI_FM(2, 25, 2) TI_FM(3, 25, 3) TI_FM(4, 25, 4) TI_FM(5, 25, 5) TI_FM(6, 25, 6) TI_FM(7, 25, 7)
        TI_RL(0, 4, 25) TI_RL(1, 5, 25) TI_RL(2, 6, 25) TI_RL(3, 7, 25) TI_RL(4, 4, 57) TI_RL(5, 5, 57) TI_RL(6, 6, 57) TI_RL(7, 7, 57)
        TI_FM(8, 25, 0) TI_FM(9, 25, 1) TI_FM(10, 25, 2) TI_FM(11, 25, 3) TI_FM(12, 25, 4) TI_FM(13, 25, 5) TI_FM(14, 25, 6) TI_FM(15, 25, 7)
        TI_RL(0, 8, 25) TI_RL(1, 9, 25) TI_RL(2, 10, 25) TI_RL(3, 11, 25) TI_RL(4, 8, 57) TI_RL(5, 9, 57) TI_RL(6, 10, 57) TI_RL(7, 11, 57)
        TI_FM(16, 25, 0) TI_FM(17, 25, 1) TI_FM(18, 25, 2) TI_FM(19, 25, 3) TI_FM(20, 25, 4) TI_FM(21, 25, 5) TI_FM(22, 25, 6) TI_FM(23, 25, 7)
        TI_RL(0, 12, 25)
        TI_FM(24, 25, 0)
        TI_RL(0, 0, 24) TI_RL(1, 1, 24) TI_RL(2, 2, 24) TI_RL(3, 3, 24) TI_RL(4, 0, 56) TI_RL(5, 1, 56) TI_RL(6, 2, 56) TI_RL(7, 3, 56)
        TI_FM(0, 24, 0) TI_FM(1, 24, 1) TI_FM(2, 24, 2) TI_FM(3, 24, 3) TI_FM(4, 24, 4) TI_FM(5, 24, 5) TI_FM(6, 24, 6) TI_FM(7, 24, 7)
        TI_RL(0, 4, 24) TI_RL(1, 5, 24) TI_RL(2, 6, 24) TI_RL(3, 7, 24) TI_RL(4, 4, 56) TI_RL(5, 5, 56) TI_RL(6, 6, 56) TI_RL(7, 7, 56)
        TI_FM(8, 24, 0) TI_FM(9, 24, 1) TI_FM(10, 24, 2) TI_FM(11, 24, 3) TI_FM(12, 24, 4) TI_FM(13, 24, 5) TI_FM(14, 24, 6) TI_FM(15, 24, 7)
        TI_RL(0, 8, 24) TI_RL(1, 9, 24) TI_RL(2, 10, 24) TI_RL(3, 11, 24) TI_RL(4, 8, 56) TI_RL(5, 9, 56) TI_RL(6, 10, 56) TI_RL(7, 11, 56)
        TI_FM(16, 24, 0) TI_FM(17, 24, 1) TI_FM(18, 24, 2) TI_FM(19, 24, 3) TI_FM(20, 24, 4) TI_FM(21, 24, 5) TI_FM(22, 24, 6) TI_FM(23, 24, 7)
        TI_RL(0, 0, 23) TI_RL(1, 1, 23) TI_RL(2, 2, 23) TI_RL(3, 3, 23) TI_RL(4, 0, 55) TI_RL(5, 1, 55) TI_RL(6, 2, 55) TI_RL(7, 3, 55)
        TI_FM(0, 23, 0) TI_FM(1, 23, 1) TI_FM(2, 23, 2) TI_FM(3, 23, 3) TI_FM(4, 23, 4) TI_FM(5, 23, 5) TI_FM(6, 23, 6) TI_FM(7, 23, 7)
        TI_RL(0, 4, 23) TI_RL(1, 5, 23) TI_RL(2, 6, 23) TI_RL(3, 7, 23) TI_RL(4, 4, 55) TI_RL(5, 5, 55) TI_RL(6, 6, 55) TI_RL(7, 7, 55)
        TI_FM(8, 23, 0) TI_FM(9, 23, 1) TI_FM(10, 23, 2) TI_FM(11, 23, 3) TI_FM(12, 23, 4) TI_FM(13, 23, 5) TI_FM(14, 23, 6) TI_FM(15, 23, 7)
        TI_RL(0, 8, 23) TI_RL(1, 9, 23) TI_RL(2, 10, 23) TI_RL(3, 11, 23) TI_RL(4, 8, 55) TI_RL(5, 9, 55) TI_RL(6, 10, 55)
        TI_FM(16, 23, 0) TI_FM(17, 23, 1) TI_FM(18, 23, 2) TI_FM(19, 23, 3) TI_FM(20, 23, 4) TI_FM(21, 23, 5) TI_FM(22, 23, 6)
        TI_RL(0, 0, 22) TI_RL(1, 1, 22) TI_RL(2, 2, 22) TI_RL(3, 3, 22) TI_RL(4, 0, 54) TI_RL(5, 1, 54) TI_RL(6, 2, 54) TI_RL(7, 3, 54)
        TI_FM(0, 22, 0) TI_FM(1, 22, 1) TI_FM(2, 22, 2) TI_FM(3, 22, 3) TI_FM(4, 22, 4) TI_FM(5, 22, 5) TI_FM(6, 22, 6) TI_FM(7, 22, 7)
        TI_RL(0, 4, 22) TI_RL(1, 5, 22) TI_RL(2, 6, 22) TI_RL(3, 7, 22) TI_RL(4, 4, 54) TI_RL(5, 5, 54) TI_RL(6, 6, 54) TI_RL(7, 7, 54)
        TI_FM(8, 22, 0) TI_FM(9, 22, 1) TI_FM(10, 22, 2) TI_FM(11, 22, 3) TI_FM(12, 22, 4) TI_FM(13, 22, 5) TI_FM(14, 22, 6) TI_FM(15, 22, 7)
        TI_RL(0, 8, 22) TI_RL(1, 9, 22) TI_RL(2, 10, 22) TI_RL(3, 11, 22) TI_RL(4, 8, 54) TI_RL(5, 9, 54)
        TI_FM(16, 22, 0) TI_FM(17, 22, 1) TI_FM(18, 22, 2) TI_FM(19, 22, 3) TI_FM(20, 22, 4) TI_FM(21, 22, 5)
        TI_RL(0, 0, 21) TI_RL(1, 1, 21) TI_RL(2, 2, 21) TI_RL(3, 3, 21) TI_RL(4, 0, 53) TI_RL(5, 1, 53) TI_RL(6, 2, 53) TI_RL(7, 3, 53)
        TI_FM(0, 21, 0) TI_FM(1, 21, 1) TI_FM(2, 21, 2) TI_FM(3, 21, 3) TI_FM(4, 21, 4) TI_FM(5, 21, 5) TI_FM(6, 21, 6) TI_FM(7, 21, 7)
        TI_RL(0, 4, 21) TI_RL(1, 5, 21) TI_RL(2, 6, 21) TI_RL(3, 7, 21) TI_RL(4, 4, 53) TI_RL(5, 5, 53) TI_RL(6, 6, 53) TI_RL(7, 7, 53)
        TI_FM(8, 21, 0) TI_FM(9, 21, 1) TI_FM(10, 21, 2) TI_FM(11, 21, 3) TI_FM(12, 21, 4) TI_FM(13, 21, 5) TI_FM(14, 21, 6) TI_FM(15, 21, 7)
        TI_RL(0, 8, 21) TI_RL(1, 9, 21) TI_RL(2, 10, 21) TI_RL(3, 11, 21) TI_RL(4, 8, 53)
        TI_FM(16, 21, 0) TI_FM(17, 21, 1) TI_FM(18, 21, 2) TI_FM(19, 21, 3) TI_FM(20, 21, 4)
        TI_RL(0, 0, 20) TI_RL(1, 1, 20) TI_RL(2, 2, 20) TI_RL(3, 3, 20) TI_RL(4, 0, 52) TI_RL(5, 1, 52) TI_RL(6, 2, 52) TI_RL(7, 3, 52)
        TI_FM(0, 20, 0) TI_FM(1, 20, 1) TI_FM(2, 20, 2) TI_FM(3, 20, 3) TI_FM(4, 20, 4) TI_FM(5, 20, 5) TI_FM(6, 20, 6) TI_FM(7, 20, 7)
        TI_RL(0, 4, 20) TI_RL(1, 5, 20) TI_RL(2, 6, 20) TI_RL(3, 7, 20) TI_RL(4, 4, 52) TI_RL(5, 5, 52) TI_RL(6, 6, 52) TI_RL(7, 7, 52)
        TI_FM(8, 20, 0) TI_FM(9, 20, 1) TI_FM(10, 20, 2) TI_FM(11, 20, 3) TI_FM(12, 20, 4) TI_FM(13, 20, 5) TI_FM(14, 20, 6) TI_FM(15, 20, 7)
        TI_RL(0, 8, 20) TI_RL(1, 9, 20) TI_RL(2, 10, 20) TI_RL(3, 11, 20)
        TI_FM(16, 20, 0) TI_FM(17, 20, 1) TI_FM(18, 20, 2) TI_FM(19, 20, 3)
        TI_RL(0, 0, 19) TI_RL(1, 1, 19) TI_RL(2, 2, 19) TI_RL(3, 3, 19) TI_RL(4, 0, 51) TI_RL(5, 1, 51) TI_RL(6, 2, 51) TI_RL(7, 3, 51)
        TI_FM(0, 19, 0) TI_FM(1, 19, 1) TI_FM(2, 19, 2) TI_FM(3, 19, 3) TI_FM(4, 19, 4) TI_FM(5, 19, 5) TI_FM(6, 19, 6) TI_FM(7, 19, 7)
        TI_RL(0, 4, 19) TI_RL(1, 5, 19) TI_RL(2, 6, 19) TI_RL(3, 7, 19) TI_RL(4, 4, 51) TI_RL(5, 5, 51) TI_RL(6, 6, 51) TI_RL(7, 7, 51)
        TI_FM(8, 19, 0) TI_FM(9, 19, 1) TI_FM(10, 19, 2) TI_FM(11, 19, 3) TI_FM(12, 19, 4) TI_FM(13, 19, 5) TI_FM(14, 19, 6) TI_FM(15, 19, 7)
        TI_RL(0, 8, 19) TI_RL(1, 9, 19) TI_RL(2, 10, 19)
        TI_FM(16, 19, 0) TI_FM(17, 19, 1) TI_FM(18, 19, 2)
        TI_RL(0, 0, 18) TI_RL(1, 1, 18) TI_RL(2, 2, 18) TI_RL(3, 3, 18) TI_RL(4, 0, 50) TI_RL(5, 1, 50) TI_RL(6, 2, 50) TI_RL(7, 3, 50)
        TI_FM(0, 18, 0) TI_FM(1, 18, 1) TI_FM(2, 18, 2) TI_FM(3, 18, 3) TI_FM(4, 18, 4) TI_FM(5, 18, 5) TI_FM(6, 18, 6) TI_FM(7, 18, 7)
        TI_RL(0, 4, 18) TI_RL(1, 5, 18) TI_RL(2, 6, 18) TI_RL(3, 7, 18) TI_RL(4, 4, 50) TI_RL(5, 5, 50) TI_RL(6, 6, 50) TI_RL(7, 7, 50)
        TI_FM(8, 18, 0) TI_FM(9, 18, 1) TI_FM(10, 18, 2) TI_FM(11, 18, 3) TI_FM(12, 18, 4) TI_FM(13, 18, 5) TI_FM(14, 18, 6) TI_FM(15, 18, 7)
        TI_RL(0, 8, 18) TI_RL(1, 9, 18)
        TI_FM(16, 18, 0) TI_FM(17, 18, 1)
        TI_RL(0, 0, 17) TI_RL(1, 1, 17) TI_RL(2, 2, 17) TI_RL(3, 3, 17) TI_RL(4, 0, 49) TI_RL(5, 1, 49) TI_RL(6, 2, 49) TI_RL(7, 3, 49)
        TI_FM(0, 17, 0) TI_FM(1, 17, 1) TI_FM(2, 17, 2) TI_FM(3, 17, 3) TI_FM(4, 17, 4) TI_FM(5, 17, 5) TI_FM(6, 17, 6) TI_FM(7, 17, 7)
        TI_RL(0, 4, 17) TI_RL(1, 5, 17) TI_RL(2, 6, 17) TI_RL(3, 7, 17) TI_RL(4, 4, 49) TI_RL(5, 5, 49) TI_RL(6, 6, 49) TI_RL(7, 7, 49)
        TI_FM(8, 17, 0) TI_FM(9, 17, 1) TI_FM(10, 17, 2) TI_FM(11, 17, 3) TI_FM(12, 17, 4) TI_FM(13, 17, 5) TI_FM(14, 17, 6) TI_FM(15, 17, 7)
        TI_RL(0, 8, 17)
        TI_FM(16, 17, 0)
        TI_RL(0, 0, 16) TI_RL(1, 1, 16) TI_RL(2, 2, 16) TI_RL(3, 3, 16) TI_RL(4, 0, 48) TI_RL(5, 1, 48) TI_RL(6, 2, 48) TI_RL(7, 3, 48)
        TI_FM(0, 16, 0) TI_FM(1, 16, 1) TI_FM(2, 16, 2) TI_FM(3, 16, 3) TI_FM(4, 16, 4) TI_FM(5, 16, 5) TI_FM(6, 16, 6) TI_FM(7, 16, 7)
        TI_RL(0, 4, 16) TI_RL(1, 5, 16) TI_RL(2, 6, 16) TI_RL(3, 7, 16) TI_RL(4, 4, 48) TI_RL(5, 5, 48) TI_RL(6, 6, 48) TI_RL(7, 7, 48)
        TI_FM(8, 16, 0) TI_FM(9, 16, 1) TI_FM(10, 16, 2) TI_FM(11, 16, 3) TI_FM(12, 16, 4) TI_FM(13, 16, 5) TI_FM(14, 16, 6) TI_FM(15, 16, 7)
        TI_RL(0, 0, 15) TI_RL(1, 1, 15) TI_RL(2, 2, 15) TI_RL(3, 3, 15) TI_RL(4, 0, 47) TI_RL(5, 1, 47) TI_RL(6, 2, 47) TI_RL(7, 3, 47)
        TI_FM(0, 15, 0) TI_FM(1, 15, 1) TI_FM(2, 15, 2) TI_FM(3, 15, 3) TI_FM(4, 15, 4) TI_FM(5, 15, 5) TI_FM(6, 15, 6) TI_FM(7, 15, 7)
        TI_RL(0, 4, 15) TI_RL(1, 5, 15) TI_RL(2, 6, 15) TI_RL(3, 7, 15) TI_RL(4, 4, 47) TI_RL(5, 5, 47) TI_RL(6, 6, 47)
        TI_FM(8, 15, 0) TI_FM(9, 15, 1) TI_FM(10, 15, 2) TI_FM(11, 15, 3) TI_FM(12, 15, 4) TI_FM(13, 15, 5) TI_FM(14, 15, 6)
        TI_RL(0, 0, 14) TI_RL(1, 1, 14) TI_RL(2, 2, 14) TI_RL(3, 3, 14) TI_RL(4, 0, 46) TI_RL(5, 1, 46) TI_RL(6, 2, 46) TI_RL(7, 3, 46)
        TI_FM(0, 14, 0) TI_FM(1, 14, 1) TI_FM(2, 14, 2) TI_FM(3, 14, 3) TI_FM(4, 14, 4) TI_FM(5, 14, 5) TI_FM(6, 14, 6) TI_FM(7, 14, 7)
        TI_RL(0, 4, 14) TI_RL(1, 5, 14) TI_RL(2, 6, 14) TI_RL(3, 7, 14) TI_RL(4, 4, 46) TI_RL(5, 5, 46)
        TI_FM(8, 14, 0) TI_FM(9, 14, 1) TI_FM(10, 14, 2) TI_FM(11, 14, 3) TI_FM(12, 14, 4) TI_FM(13, 14, 5)
        TI_RL(0, 0, 13) TI_RL(1, 1, 13) TI_RL(2, 2, 13) TI_RL(3, 3, 13) TI_RL(4, 0, 45) TI_RL(5, 1, 45) TI_RL(6, 2, 45) TI_RL(7, 3, 45)
        TI_FM(0, 13, 0) TI_FM(1, 13, 1) TI_FM(2, 13, 2) TI_FM(3, 13, 3) TI_FM(4, 13, 4) TI_FM(5, 13, 5) TI_FM(6, 13, 6) TI_FM(7, 13, 7)
        TI_RL(0, 4, 13) TI_RL(1, 5, 13) TI_RL(2, 6, 13) TI_RL(3, 7, 13) TI_RL(4, 4, 45)
        TI_FM(8, 13, 0) TI_FM(9, 13, 1) TI_FM(10, 13, 2) TI_FM(11, 13, 3) TI_FM(12, 13, 4)
        TI_RL(0, 0, 12) TI_RL(1, 1, 12) TI_RL(2, 2, 12) TI_RL(3, 3, 12) TI_RL(4, 0, 44) TI_RL(5, 1, 44) TI_RL(6, 2, 44) TI_RL(7, 3, 44)
        TI_FM(0, 12, 0) TI_FM(1, 12, 1) TI_FM(2, 12, 2) TI_FM(3, 12, 3) TI_FM(4, 12, 4) TI_FM(5, 12, 5) TI_FM(6, 12, 6) TI_FM(7, 12, 7)
        TI_RL(0, 4, 12) TI_RL(1, 5, 12) TI_RL(2, 6, 12) TI_RL(3, 7, 12)
        TI_FM(8, 12, 0) TI_FM(9, 12, 1) TI_FM(10, 12, 2) TI_FM(11, 12, 3)
        TI_RL(0, 0, 11) TI_RL(1, 1, 11) TI_RL(2, 2, 11) TI_RL(3, 3, 11) TI_RL(4, 0, 43) TI_RL(5, 1, 43) TI_RL(6, 2, 43) TI_RL(7, 3, 43)
        TI_FM(0, 11, 0) TI_FM(1, 11, 1) TI_FM(2, 11, 2) TI_FM(3, 11, 3) TI_FM(4, 11, 4) TI_FM(5, 11, 5) TI_FM(6, 11, 6) TI_FM(7, 11, 7)
        TI_RL(0, 4, 11) TI_RL(1, 5, 11) TI_RL(2, 6, 11)
        TI_FM(8, 11, 0) TI_FM(9, 11, 1) TI_FM(10, 11, 2)
        TI_RL(0, 0, 10) TI_RL(1, 1, 10) TI_RL(2, 2, 10) TI_RL(3, 3, 10) TI_RL(4, 0, 42) TI_RL(5, 1, 42) TI_RL(6, 2, 42) TI_RL(7, 3, 42)
        TI_FM(0, 10, 0) TI_FM(1, 10, 1) TI_FM(2, 10, 2) TI_FM(3, 10, 3) TI_FM(4, 10, 4) TI_FM(5, 10, 5) TI_FM(6, 10, 6) TI_FM(7, 10, 7)
        TI_RL(0, 4, 10) TI_RL(1, 5, 10)
        TI_FM(8, 10, 0) TI_FM(9, 10, 1)
        TI_RL(0, 0, 9) TI_RL(1, 1, 9) TI_RL(2, 2, 9) TI_RL(3, 3, 9) TI_RL(4, 0, 41) TI_RL(5, 1, 41) TI_RL(6, 2, 41) TI_RL(7, 3, 41)
        TI_FM(0, 9, 0) TI_FM(1, 9, 1) TI_FM(2, 9, 2) TI_FM(3, 9, 3) TI_FM(4, 9, 4) TI_FM(5, 9, 5) TI_FM(6, 9, 6) TI_FM(7, 9, 7)
        TI_RL(0, 4, 9)
        TI_FM(8, 9, 0)
        TI_RL(0, 0, 8) TI_RL(1, 1, 8) TI_RL(2, 2, 8) TI_RL(3, 3, 8) TI_RL(4, 0, 40) TI_RL(5, 1, 40) TI_RL(6, 2, 40) TI_RL(7, 3, 40)
        TI_FM(0, 8, 0) TI_FM(1, 8, 1) TI_FM(2, 8, 2) TI_FM(3, 8, 3) TI_FM(4, 8, 4) TI_FM(5, 8, 5) TI_FM(6, 8, 6) TI_FM(7, 8, 7)
        TI_RL(0, 0, 7) TI_RL(1, 1, 7) TI_RL(2, 2, 7) TI_RL(3, 3, 7) TI_RL(4, 0, 39) TI_RL(5, 1, 39) TI_RL(6, 2, 39)
        TI_FM(0, 7, 0) TI_FM(1, 7, 1) TI_FM(2, 7, 2) TI_FM(3, 7, 3) TI_FM(4, 7, 4) TI_FM(5, 7, 5) TI_FM(6, 7, 6)
        TI_RL(0, 0, 6) TI_RL(1, 1, 6) TI_RL(2, 2, 6) TI_RL(3, 3, 6) TI_RL(4, 0, 38) TI_RL(5, 1, 38)
        TI_FM(0, 6, 0) TI_FM(1, 6, 1) TI_FM(2, 6, 2) TI_FM(3, 6, 3) TI_FM(4, 6, 4) TI_FM(5, 6, 5)
        TI_RL(0, 0, 5) TI_RL(1, 1, 5) TI_RL(2, 2, 5) TI_RL(3, 3, 5) TI_RL(4, 0, 37)
        TI_FM(0, 5, 0) TI_FM(1, 5, 1) TI_FM(2, 5, 2) TI_FM(3, 5, 3) TI_FM(4, 5, 4)
        TI_RL(0, 0, 4) TI_RL(1, 1, 4) TI_RL(2, 2, 4) TI_RL(3, 3, 4)
        TI_FM(0, 4, 0) TI_FM(1, 4, 1) TI_FM(2, 4, 2) TI_FM(3, 4, 3)
        TI_RL(0, 0, 3) TI_RL(1, 1, 3) TI_RL(2, 2, 3)
        TI_FM(0, 3, 0) TI_FM(1, 3, 1) TI_FM(2, 3, 2)
        TI_RL(0, 0, 2) TI_RL(1, 1, 2)
        TI_FM(0, 2, 0) TI_FM(1, 2, 1)
        TI_RL(0, 0, 1)
        TI_FM(0, 1, 0)
      }
#undef TI_RL
#undef TI_FM

#pragma unroll
      for (int s = 0; s < 2; ++s) { float e8[8];
#pragma unroll
          for (int jj = 0; jj < 8; ++jj) { const int i0 = 16 * s + 8 * (jj >> 2) + (jj & 3); float ta = T[i0], tb = T[i0 + 4]; asm volatile("" : "+v"(ta), "+v"(tb)); e8[jj] = h ? tb : ta; }
          fT[s] = __builtin_bit_cast(bf16x8, (u32x4){cvtpk(e8[0], e8[1]), cvtpk(e8[2], e8[3]), cvtpk(e8[4], e8[5]), cvtpk(e8[6], e8[7])}); } }
    asm volatile("" ::: "memory"); __builtin_amdgcn_sched_barrier(0);
    const size_t uid = ((size_t)(b * 8 + hd) * 128 + c);
    unsigned char* gG = F.ws + WS_R0 + uid * SZ_G; unsigned char* gH = F.ws + WS_R2 + uid * SZ_H; unsigned char* gQ = F.ws + WS_H0 + uid * SZ_Q; unsigned char* gY = F.ws + WS_H1 + uid * SZ_Y;
#define RK_ST(base, piece, f) (*(u32x4*)((base) + (piece) * 1024 + (tid & 63) * 16) = __builtin_bit_cast(u32x4, (f)))
    bf16x8 fWt[2][2];
#pragma unroll
    for (int jt = 0; jt < 2; ++jt) { f32x16 w_ = f32x16{}; w_ = RK_MF(fT[0], tAt[jt][0], w_); w_ = RK_MF(fT[1], tAt[jt][1], w_); fWt[jt][0] = frag<0>(w_); fWt[jt][1] = frag<1>(w_);
        f32x16 q_; unfrag<0>(q_, __builtin_bit_cast(bf16x8, *(const LAS u32x4*)(stash + 8 * (2 * jt) * PZ))); unfrag<1>(q_, __builtin_bit_cast(bf16x8, *(const LAS u32x4*)(stash + 8 * (2 * jt + 1) * PZ)));
        q_ = RK_MF(fWt[jt][0], fArb[0], q_); q_ = RK_MF(fWt[jt][1], fArb[1], q_); RK_ST(gQ, 2 * jt, frag<0>(q_)); RK_ST(gQ, 2 * jt + 1, frag<1>(q_)); }
    bf16x8 tBh[2][2], tKh[2][2], tV[2][2];
    { bf16x8 fId[2]; mk_id(fId, r, h);
#pragma unroll
    for (int jt = 0; jt < 2; ++jt) { bf16x8 fBh[2], fKh[2], fV[2], fdum[2]; float bdum = 0.f;
        r1_elem<1>(EC, jt, fBh, fKh, fV, fdum, bdum, pcd[jt]);
        { f32x16 t_ = f32x16{}; t_ = RK_MF(fBh[0], fId[0], t_); t_ = RK_MF(fBh[1], fId[1], t_); tBh[jt][0] = frag<0>(t_); tBh[jt][1] = frag<1>(t_); }
        { f32x16 t_ = f32x16{}; t_ = RK_MF(fKh[0], fId[0], t_); t_ = RK_MF(fKh[1], fId[1], t_); tKh[jt][0] = frag<0>(t_); tKh[jt][1] = frag<1>(t_); }
        { f32x16 t_ = f32x16{}; t_ = RK_MF(fV[0], fId[0], t_); t_ = RK_MF(fV[1], fId[1], t_); tV[jt][0] = frag<0>(t_); tV[jt][1] = frag<1>(t_); } } }
    bf16x8 fUt[2][2];
#pragma unroll
    for (int it = 0; it < 2; ++it) { f32x16 av = f32x16{}; av = RK_MF(fAak[0], tV[it][0], av); av = RK_MF(fAak[1], tV[it][1], av);
        const bf16x8 fav0 = frag<0>(av), fav1 = frag<1>(av); f32x16 u_ = f32x16{}; u_ = RK_MF(fT[0], fav0, u_); u_ = RK_MF(fT[1], fav1, u_); fUt[it][0] = frag<0>(u_); fUt[it][1] = frag<1>(u_); }
#pragma unroll
    for (int it = 0; it < 2; ++it) { f32x16 y_ = f32x16{}; y_ = RK_MF(fUt[it][0], fArb[0], y_); y_ = RK_MF(fUt[it][1], fArb[1], y_); y_ = RK_MF(tV[it][0], fArk[0], y_); y_ = RK_MF(tV[it][1], fArk[1], y_);
        RK_ST(gY, 2 * it, frag<0>(y_)); RK_ST(gY, 2 * it + 1, frag<1>(y_)); }
#pragma unroll
    for (int jt = 0; jt < 2; ++jt)
#pragma unroll
        for (int j2 = 0; j2 < 2; ++j2) { f32x16 g_ = f32x16{}; g_ = RK_MF(fWt[jt][0], tBh[j2][0], g_); g_ = RK_MF(fWt[jt][1], tBh[j2][1], g_);
            if (jt == j2) {
#pragma unroll
                for (int i = 0; i < 16; ++i) if (i == 4 * (r >> 3) + (r & 3) && h == ((r >> 2) & 1)) g_[i] += pcd[jt]; }
            RK_ST(gG, 2 * (jt * 2 + j2), frag<0>(g_)); RK_ST(gG, 2 * (jt * 2 + j2) + 1, frag<1>(g_)); }
#pragma unroll
    for (int j2 = 0; j2 < 2; ++j2)
#pragma unroll
        for (int it = 0; it < 2; ++it) { f32x16 h_ = f32x16{}; h_ = RK_MF(tBh[j2][0], fUt[it][0], h_); h_ = RK_MF(tBh[j2][1], fUt[it][1], h_); h_ = RK_MF(tKh[j2][0], tV[it][0], h_); h_ = RK_MF(tKh[j2][1], tV[it][1], h_);
            RK_ST(gH, 2 * (j2 * 2 + it), frag<0>(h_)); RK_ST(gH, 2 * (j2 * 2 + it) + 1, frag<1>(h_)); }
}

template <int DRY> __device__ __forceinline__ void r2_task(const Args& args, Frame& F, int task) {
    const bool st_ok = !DRY || args.li == 12345;
    const int bh = task >> 1, it = task & 1;
    f32x16 St[2]; St[0] = f32x16{}; St[1] = f32x16{};
    const unsigned char* gG0 = F.ws + WS_R0 + (size_t)bh * 128 * SZ_G + F.lane * 16; unsigned char* gH0 = F.ws + WS_R2 + (size_t)bh * 128 * SZ_H + F.lane * 16;
    bf16x8 G0[2][2][2], H0[2][2], G1[2][2][2], H1[2][2], G2[2][2][2], H2[2][2];
#define R2_LOAD(G_, H_, c_) do { const int cc_ = (c_) < 128 ? (c_) : 127;     \
        _Pragma("unroll") for (int jt = 0; jt < 2; ++jt) _Pragma("unroll") for (int j2 = 0; j2 < 2; ++j2) _Pragma("unroll") for (int s = 0; s < 2; ++s) \
            G_[jt][j2][s] = __builtin_bit_cast(bf16x8, *(const u32x4*)(gG0 + (size_t)cc_ * SZ_G + (2 * (jt * 2 + j2) + s) * 1024)); \
        _Pragma("unroll") for (int j2 = 0; j2 < 2; ++j2) _Pragma("unroll") for (int s = 0; s < 2; ++s) H_[j2][s] = __builtin_bit_cast(bf16x8, *(const u32x4*)(gH0 + (size_t)cc_ * SZ_H + (2 * (j2 * 2 + it) + s) * 1024)); } while (0)
#define R2_STEP(G_, H_, c_, LOADNEXT) do { \
        const bf16x8 fS[2][2] = {{frag<0>(St[0]), frag<1>(St[0])}, {frag<0>(St[1]), frag<1>(St[1])}}; \
        if (st_ok) { _Pragma("unroll") for (int jt = 0; jt < 2; ++jt) _Pragma("unroll") for (int s = 0; s < 2; ++s) \
            *(u32x4*)(gH0 + (size_t)(c_) * SZ_H + (2 * (jt * 2 + it) + s) * 1024) = __builtin_bit_cast(u32x4, fS[jt][s]); }     \
        __builtin_amdgcn_sched_barrier(0); LOADNEXT; __builtin_amdgcn_sched_barrier(0);     \
        _Pragma("unroll") for (int j2 = 0; j2 < 2; ++j2) { unfrag<0>(St[j2], H_[j2][0]); unfrag<1>(St[j2], H_[j2][1]); \
            _Pragma("unroll") for (int jt = 0; jt < 2; ++jt) { St[j2] = RK_MF(G_[jt][j2][0], fS[jt][0], St[j2]); St[j2] = RK_MF(G_[jt][j2][1], fS[jt][1], St[j2]); } } \
        __builtin_amdgcn_sched_barrier(0); \
    } while (0)
    R2_LOAD(G0, H0, 0); R2_LOAD(G1, H1, 1);
#pragma unroll 1
    for (int c = 0; c < 126; c += 3) {
        R2_STEP(G0, H0, c, R2_LOAD(G2, H2, c + 2));
        R2_STEP(G1, H1, c + 1, R2_LOAD(G0, H0, c + 3));
        R2_STEP(G2, H2, c + 2, R2_LOAD(G1, H1, c + 4));
    }
    R2_STEP(G0, H0, 126, (void)0);
    R2_STEP(G1, H1, 127, (void)0);
#undef R2_STEP
#undef R2_LOAD
}

constexpr int PV2 = 1296;
__device__ __forceinline__ void r3_unit(const Args& args, Frame& F, int b, int c) {
    LAS unsigned char* IMG = F.lds;
    const bf16_t* Z = (const bf16_t*)(F.ws + WS_Z);
    const int t0 = 32 * c; const size_t m0 = (size_t)b * SEQ + t0;
    const float* mu = AIN(7);
    int tid = F.tid; asm volatile("" : "+v"(tid));
    __syncthreads();
    { const unsigned lds0 = (unsigned)(uintptr_t)IMG; const int ln = tid & 63;
      for (int task = F.wave; task < 33 * 2; task += NWAVES) { const int rr = task >> 1, j = task & 1, pc = 64 * j + ln;
          if (pc < 80) { const int col = j == 0 ? ZR_V + 8 * ln : ZR_GD + 8 * ln;
              if (rr > 0 || t0 > 0) att::glds16(Z + (m0 + rr - 1) * ZW + col, (unsigned)__builtin_amdgcn_readfirstlane((int)(lds0 + rr * PV2 + 1024 * j)));
              else *(LAS u32x4*)(IMG + 16 * pc) = (u32x4){0u, 0u, 0u, 0u}; } }
      asm volatile("s_waitcnt vmcnt(0)" ::: "memory"); }
    __syncthreads();
    { const int t = tid >> 4, kp = tid & 15;
      const u32x4 cw = *(const LAS u32x4*)(IMG + (t + 1) * PV2 + 1024 + 16 * kp), pw = *(const LAS u32x4*)(IMG + t * PV2 + 1024 + 16 * kp);
      const f32x4 m0v = *(const f32x4*)(mu + 1664 + 8 * kp), m1v = *(const f32x4*)(mu + 1664 + 8 * kp + 4);
      const unsigned cwa[4] = {cw.x, cw.y, cw.z, cw.w}, pwa[4] = {pw.x, pw.y, pw.z, pw.w}; float x[8];
#pragma unroll
      for (int j = 0; j < 4; ++j) { const float c0 = bf_lo(cwa[j]), c1 = bf_hi(cwa[j]), p0 = bf_lo(pwa[j]), p1 = bf_hi(pwa[j]);
          const float mu0 = j < 2 ? m0v[2 * j] : m1v[2 * j - 4], mu1 = j < 2 ? m0v[2 * j + 1] : m1v[2 * j - 3];
          x[2 * j] = fast_sigmoid(c0 + mu0 * (p0 - c0)); x[2 * j + 1] = fast_sigmoid(c1 + mu1 * (p1 - c1)); }
      const u32x4 o = {cvtpk(x[0], x[1]), cvtpk(x[2], x[3]), cvtpk(x[4], x[5]), cvtpk(x[6], x[7])};
      __syncthreads();
      *(LAS u32x4*)(IMG + (t + 1) * PV2 + 1024 + 16 * kp) = o;
      __syncthreads(); }
    const int hd = F.wave; int r = tid & 31, h = (tid >> 5) & 1;
    const LAS unsigned char* rowc = IMG + (r + 1) * PV2; const LAS unsigned char* rowp = IMG + r * PV2;
    const size_t uid = ((size_t)(b * 8 + hd) * 128 + c);
    const unsigned char* gS = F.ws + WS_R2 + uid * SZ_H; const unsigned char* gQ = F.ws + WS_H0 + uid * SZ_Q; const unsigned char* gY = F.ws + WS_H1 + uid * SZ_Y;
#define RK_LD(base, piece) __builtin_bit_cast(bf16x8, *(const u32x4*)((base) + (piece) * 1024 + (tid & 63) * 16))
    f32x16 gl[2]; gl[0] = f32x16{}; gl[1] = f32x16{};
    { const bf16_t* GUt = (const bf16_t*)(F.ws + WS_GUT) + (size_t)hd * 64 * 128;
#pragma unroll
      for (int ks = 0; ks < 8; ++ks) { const int k0 = 16 * ks + 8 * h; const bf16x8 bg = *(const LAS bf16x8*)(rowc + 1024 + k0 * 2);
#pragma unroll
          for (int it = 0; it < 2; ++it) { const bf16x8 fg = *(const bf16x8*)(GUt + (size_t)(32 * it + r) * 128 + k0); gl[it] = RK_MF(fg, bg, gl[it]); } } }
    f32x16 Y[2];
    { const bf16x8 fQ[2][2] = {{RK_LD(gQ, 0), RK_LD(gQ, 1)}, {RK_LD(gQ, 2), RK_LD(gQ, 3)}};
#pragma unroll
      for (int it = 0; it < 2; ++it) { unfrag<0>(Y[it], RK_LD(gY, 2 * it)); unfrag<1>(Y[it], RK_LD(gY, 2 * it + 1));
#pragma unroll
          for (int jt = 0; jt < 2; ++jt) { if (PROBE_NO_STATE) continue; Y[it] = RK_MF(RK_LD(gS, 2 * (jt * 2 + it)), fQ[jt][0], Y[it]); Y[it] = RK_MF(RK_LD(gS, 2 * (jt * 2 + it) + 1), fQ[jt][1], Y[it]); } } }
    float s1 = 0.f;
#pragma unroll
    for (int it = 0; it < 2; ++it)
#pragma unroll
        for (int i = 0; i < 16; ++i) s1 += Y[it][i];
    s1 += __shfl_xor(s1, 32); const float mean = s1 * (1.0f / 64.0f); float s2 = 0.f;
#pragma unroll
    for (int it = 0; it < 2; ++it)
#pragma unroll
        for (int i = 0; i < 16; ++i) { const float d = Y[it][i] - mean; s2 += d * d; }
    s2 += __shfl_xor(s2, 32); const float rstd = 1.0f / sqrtf(s2 * (1.0f / 64.0f) + GN_EPS);
    const float bn = ((const float*)(F.ws + WS_TOPW))[(m0 + r) * 8 + hd];
    LAS unsigned char* stg = F.lds + 49152 + F.wave * 4608;
#pragma unroll
    for (int it = 0; it < 2; ++it)
#pragma unroll
        for (int g = 0; g < 4; ++g) { const int cl = 32 * it + 8 * g + 4 * h, cj = hd * 64 + cl;
            const u32x2 a = *(const LAS u32x2*)(rowc + cj * 2), p = *(const LAS u32x2*)(rowp + cj * 2);
            const float vc[4] = {bf_lo(a.x), bf_hi(a.x), bf_lo(a.y), bf_hi(a.y)}, vq[4] = {bf_lo(p.x), bf_hi(p.x), bf_lo(p.y), bf_hi(p.y)};
            const f32x4 muv = *(const f32x4*)(mu + 1024 + cj), lg = *(const f32x4*)(AIN(16) + cj), lb = *(const f32x4*)(AIN(17) + cj);
            float o[4];
#pragma unroll
            for (int q = 0; q < 4; ++q) { const int i = 4 * g + q; const float v_ = vc[q] + muv[q] * (vq[q] - vc[q]);
                o[q] = ((Y[it][i] - mean) * rstd * lg[q] + lb[q] + bn * v_) * gl[it][i]; }
            *(LAS u32x2*)(stg + r * 144 + cl * 2) = (u32x2){cvtpk(o[0], o[1]), cvtpk(o[2], o[3])}; }
    asm volatile("s_waitcnt lgkmcnt(0)" ::: "memory");
    bf16_t* OUT = (bf16_t*)(F.ws + WS_R0) + m0 * 512 + hd * 64;
#pragma unroll
    for (int i = 0; i < 4; ++i) { const int row = i * 8 + ((tid & 63) >> 3), chn = tid & 7; const u32x4 v = *(const LAS u32x4*)(stg + row * 144 + chn * 16); *(u32x4*)(OUT + (size_t)row * 512 + chn * 8) = v; }
#undef RK_LD
#undef RK_ST
}
}
__device__ __forceinline__ void route_token(float lg, float bias, int lane, int tok, int* TE, float* TW, LAS unsigned* lcnt) {
    const float s = 1.0f / (1.0f + expf(-lg));
    const float c = s + bias;
    const unsigned kc = ord_key(c);
#define RT_MAXD(v_, ctrl) { const unsigned o_ = (unsigned)__builtin_amdgcn_update_dpp(0, (int)(v_), (ctrl), 0xF, 0xF, true); v_ = (v_) > o_ ? (v_) : o_; }
#define RT_INV(k_) (((k_) & 0x80000000u) ? __uint_as_float((k_) & 0x7FFFFFFFu) : __uint_as_float(~(k_)))
    unsigned m1 = kc; RT_MAXD(m1, 0xB1) RT_MAXD(m1, 0x4E) RT_MAXD(m1, 0x141)
    const unsigned long long b1 = __builtin_amdgcn_ballot_w64(kc == m1);
    const unsigned gb = (unsigned)(b1 >> (lane & 56)) & 0xFFu;
    unsigned m2 = ((lane & 7) == __builtin_ctz(gb)) ? 0u : kc; RT_MAXD(m2, 0xB1) RT_MAXD(m2, 0x4E) RT_MAXD(m2, 0x141)
    const float gs = RT_INV(m1) + RT_INV(m2);
    unsigned gcur = ord_key(gs); bool gsel = false;
#pragma unroll
    for (int j = 0; j < 4; ++j) { unsigned v = gcur; RT_MAXD(v, 0xB1) RT_MAXD(v, 0x4E) RT_MAXD(v, 0x141) RT_MAXD(v, 0x140)
        const unsigned a0_ = (unsigned)__builtin_amdgcn_readlane((int)v, 0), a1_ = (unsigned)__builtin_amdgcn_readlane((int)v, 16), a2_ = (unsigned)__builtin_amdgcn_readlane((int)v, 32), a3_ = (unsigned)__builtin_amdgcn_readlane((int)v, 48);
        const unsigned x_ = a0_ > a1_ ? a0_ : a1_, y_ = a2_ > a3_ ? a2_ : a3_; const unsigned m_ = x_ > y_ ? x_ : y_;
        const int win = __builtin_ctzll(__builtin_amdgcn_ballot_w64(gcur == m_));
        if ((lane >> 3) == (win >> 3)) { gsel = true; gcur = 0u; } }
    unsigned cur = gsel ? kc : 0u; int erk = 64;
#pragma unroll
    for (int j = 0; j < 8; ++j) { unsigned v = cur; RT_MAXD(v, 0xB1) RT_MAXD(v, 0x4E) RT_MAXD(v, 0x141) RT_MAXD(v, 0x140)
        const unsigned a0_ = (unsigned)__builtin_amdgcn_readlane((int)v, 0), a1_ = (unsigned)__builtin_amdgcn_readlane((int)v, 16), a2_ = (unsigned)__builtin_amdgcn_readlane((int)v, 32), a3_ = (unsigned)__builtin_amdgcn_readlane((int)v, 48);
        const unsigned x_ = a0_ > a1_ ? a0_ : a1_, y_ = a2_ > a3_ ? a2_ : a3_; const unsigned m_ = x_ > y_ ? x_ : y_;
        const int win = __builtin_ctzll(__builtin_amdgcn_ballot_w64(cur == m_));
        if (lane == win) { erk = j; cur = 0u; } }
#undef RT_MAXD
#undef RT_INV
    const bool sel = erk < 8;
    const float ssum = wave_sum(sel ? s : 0.f);
    if (sel) { TE[(size_t)tok * 8 + erk] = lane; TW[(size_t)tok * 8 + erk] = s / ssum * 2.5f; atomicAdd((unsigned*)&lcnt[(tok >= M / 2 ? 64 : 0) + lane], 1u); }
}
__device__ __forceinline__ void norm2_route_wave(const Args& args, Frame& F, LAS unsigned* lcnt) {
    bf16_t* H2 = (bf16_t*)(F.ws + WS_H2);
    norm_mod_rows(args, F, F.out, AIN(21), 3072, 4096, H2, nullptr);
    asm volatile("s_waitcnt vmcnt(0)" ::: "memory");
    const int lane = F.lane, row0 = F.gw * 16;
    const bf16_t* ap = H2 + (size_t)(row0 + (lane & 15)) * D + 8 * (lane >> 4);
    const bf16_t* bp = (const bf16_t*)(F.ws + WS_WRT) + (size_t)(lane & 15) * D + 8 * (lane >> 4);
    f32x4 acc[4] = {f32x4{}, f32x4{}, f32x4{}, f32x4{}};
#pragma unroll 1
    for (int k0 = 0; k0 < 32; k0 += 4) { bf16x8 a_[4], b_[4][4];
#pragma unroll
        for (int i = 0; i < 4; ++i) { a_[i] = *(const bf16x8*)(ap + 32 * (k0 + i));
#pragma unroll
            for (int nt = 0; nt < 4; ++nt) b_[i][nt] = *(const bf16x8*)(bp + (size_t)(16 * nt) * D + 32 * (k0 + i)); }
#pragma unroll
        for (int i = 0; i < 4; ++i)
#pragma unroll
            for (int nt = 0; nt < 4; ++nt) acc[nt] = __builtin_amdgcn_mfma_f32_16x16x32_bf16(a_[i], b_[i][nt], acc[nt], 0, 0, 0); }
    LAS float* scr = (LAS float*)(F.lds + F.wave * 16384);
#pragma unroll
    for (int nt = 0; nt < 4; ++nt)
#pragma unroll
        for (int i = 0; i < 4; ++i) scr[(4 * (lane >> 4) + i) * 65 + 16 * nt + (lane & 15)] = acc[nt][i];
    asm volatile("s_waitcnt lgkmcnt(0)" ::: "memory");
    int* TE = (int*)(F.ws + WS_TOPE); float* TW = (float*)(F.ws + WS_TOPW);
    const float bias = AIN(23)[lane];
#pragma unroll 1
    for (int t = 0; t < 16; ++t) route_token(scr[t * 65 + lane], bias, lane, row0 + t, TE, TW, lcnt);
    asm volatile("s_waitcnt lgkmcnt(0)" ::: "memory");
}
__device__ __forceinline__ void norm2_route_convert(const Args& args, Frame& F) {
    LAS unsigned* lcnt = (LAS unsigned*)(F.lds + LDS_TILETAB);
    if (F.tid < 128) lcnt[F.tid] = 0u;
    __syncthreads();
    constexpr int KIT = (64 * (16 * 16 + 4 * 32) + NWAVES * 256 - 1) / (NWAVES * 256) + 1;
    if (F.wave < 4) { norm2_route_wave(args, F, lcnt); convert_experts(args, F, 0, KIT); }
    else { convert_experts(args, F, 0, KIT / 2); norm2_route_wave(args, F, lcnt); convert_experts(args, F, KIT / 2, KIT); }
    __syncthreads();
    if (F.tid < 128 && lcnt[F.tid]) atomicAdd(F.ctl + CW_CNT + F.tid, lcnt[F.tid]);
    __syncthreads();
}
struct MoeTab { int ntiles0, ntiles; };
__device__ __forceinline__ MoeTab build_tiles(const Args& args, Frame& F) {
    LAS unsigned* tab = (LAS unsigned*)(F.lds + LDS_TILETAB);
    LAS unsigned* offs = tab + 2432; LAS unsigned* tpre = tab + 2560;
    if (F.tid == 0) { unsigned o = 0, tp = 0;
        for (int l = 0; l < 128; ++l) { const unsigned c = __hip_atomic_load(F.ctl + CW_CNT + l, RLX_AGENT); offs[l] = o; tpre[l] = tp; o += c; tp += (c + 255u) >> 8; }
        tpre[128] = tp; }
    __syncthreads();
    if (F.tid < 128) { const int l = F.tid; const unsigned c = __hip_atomic_load(F.ctl + CW_CNT + l, RLX_AGENT); const unsigned o = offs[l], t0 = tpre[l], nt = (c + 255u) >> 8;
        for (unsigned i = 0; i < nt; ++i) { const unsigned rows = (c - 256u * i) < 256u ? (c - 256u * i) : 256u; tab[2 * (t0 + i)] = (o + 256u * i) | ((unsigned)(l & 63) << 20); tab[2 * (t0 + i) + 1] = rows; } }
    __syncthreads();
    MoeTab r; r.ntiles0 = (int)tpre[64]; r.ntiles = (int)tpre[128]; return r;
}
__device__ __forceinline__ void scatter_phase(const Args& args, Frame& F) {
    LAS unsigned* tab = (LAS unsigned*)(F.lds + LDS_TILETAB); LAS unsigned* offs = tab + 2432;
    LAS unsigned* lcnt = (LAS unsigned*)(F.lds); LAS unsigned* lbase = lcnt + 128;
    const int* TE = (const int*)(F.ws + WS_TOPE); const float* TW = (const float*)(F.ws + WS_TOPW);
    int* ST = (int*)(F.ws + WS_STOK); float* SW = (float*)(F.ws + WS_SW);
    for (int blk = blockIdx.x; blk < M / 128; blk += F.G) {
        if (F.tid < 128) lcnt[F.tid] = 0u;
        __syncthreads();
        const int tok0 = blk * 128, hf = tok0 >= M / 2 ? 64 : 0;
        int lst[2]; unsigned rnk[2];
#pragma unroll
        for (int i = 0; i < 2; ++i) { const int p = F.tid + 512 * i; lst[i] = hf + TE[(size_t)tok0 * 8 + p]; rnk[i] = atomicAdd((unsigned*)&lcnt[lst[i]], 1u); }
        __syncthreads();
        if (F.tid < 128) lbase[F.tid] = lcnt[F.tid] ? atomicAdd(F.ctl + CW_CUR + F.tid, lcnt[F.tid]) : 0u;
        __syncthreads();
#pragma unroll
        for (int i = 0; i < 2; ++i) { const int p = F.tid + 512 * i; const unsigned pos = offs[lst[i]] + lbase[lst[i]] + rnk[i];
            ST[pos] = tok0 * 8 + p; SW[pos] = TW[(size_t)tok0 * 8 + p]; }
        __syncthreads();
    }
}

__device__ __forceinline__ void final_rows(const Args& args, Frame& F, int row_lo, int row_hi, int tokbase) {
    const unsigned char* SL = (const unsigned char*)(F.ws + WS_SLOT);
    const int cA = 256 * (F.lane >> 4) + 32 * ((F.lane >> 2) & 3) + 8 * (F.lane & 3), cB = cA + 128;
    for (int blk = F.gw; blk < (row_hi - row_lo) / 16; blk += F.NGW) {
        const int r0 = row_lo + blk * 16, b = r0 / SEQ;
        const float* g2 = (const float*)(F.ws + WS_MOD) + b * 6144 + 5120; const float* fgp = AIN(30);
        f32x4 gv[4], fg[4];
#pragma unroll
        for (int j = 0; j < 4; ++j) { const int c = (j < 2 ? cA : cB) + 4 * (j & 1); gv[j] = *(const f32x4*)(g2 + c) * (1.0f / SLOT_SCALE); fg[j] = *(const f32x4*)(fgp + c); }
        for (int r = 0; r < 16; ++r) { const size_t m = (size_t)(r0 + r);
            f32x4 acc[4];
#pragma unroll
            for (int j = 0; j < 4; ++j) acc[j] = (f32x4){0.f, 0.f, 0.f, 0.f};
            const unsigned char* sp = SL + (m - tokbase) * NSLOT * D + 16 * F.lane;
            u32x4 w[NSLOT];
#pragma unroll
            for (int k = 0; k < NSLOT; ++k) w[k] = *(const u32x4*)(sp + (size_t)k * D);
#pragma unroll
            for (int k = 0; k < NSLOT; ++k) { const unsigned ww[4] = {w[k].x, w[k].y, w[k].z, w[k].w};
#pragma unroll
                for (int j = 0; j < 4; ++j) { const f32x2 a = __builtin_amdgcn_cvt_pk_f32_fp8((int)ww[j], false), c = __builtin_amdgcn_cvt_pk_f32_fp8((int)ww[j], true); acc[j] += (f32x4){a.x, a.y, c.x, c.y}; } }
            float* xr = F.out + m * D; f32x4 v[4]; float s = 0.f;
#pragma unroll
            for (int j = 0; j < 4; ++j) { const int c = (j < 2 ? cA : cB) + 4 * (j & 1); v[j] = *(const f32x4*)(xr + c) + gv[j] * acc[j]; s += (v[j].x * v[j].x + v[j].y * v[j].y) + (v[j].z * v[j].z + v[j].w * v[j].w); }
            const float rstd = 1.0f / sqrtf(wave_sum(s) * (1.0f / D) + RMS_EPS);
#pragma unroll
            for (int j = 0; j < 4; ++j) { const int c = (j < 2 ? cA : cB) + 4 * (j & 1); *(f32x4*)(xr + c) = v[j] * rstd * fg[j]; }
        }
    }
}
constexpr int N_PHASES = 15;
#ifndef PROBE_ATT_SCALE
#define PROBE_ATT_SCALE 1.0f
#endif
#ifndef PROBE_IDX_REP
#define PROBE_IDX_REP 1
#endif
#ifndef R2_WGS
#define R2_WGS 32
#endif
#ifndef PROBE_P5_PART
#define PROBE_P5_PART 0
#endif
#ifndef PROBE_RW_SCALE
#define PROBE_RW_SCALE 1.0f
#endif

__global__ void __launch_bounds__(NTHR, 2) fwd_kernel(Args args) {
    extern __shared__ __attribute__((aligned(16))) unsigned char lds_raw[];
    Frame F;
    F.lds = (LAS unsigned char*)lds_raw;
    F.MISC = (volatile LAS unsigned*)(F.lds + MISC_OFF);
    F.tid = threadIdx.x; F.lane = F.tid & 63; F.wave = __builtin_amdgcn_readfirstlane(F.tid >> 6);
    F.G = gridDim.x; { const int bx = blockIdx.x; F.vcu = (F.G % 8 == 0) ? (bx % 8) * (F.G / 8) + bx / 8 : bx; }
    F.gw = blockIdx.x * NWAVES + F.wave; F.NGW = F.G * NWAVES;
    F.ws = args.ws; F.out = args.out; F.ctl = (unsigned*)(args.ws + WS_CTL);
    for (int u = F.tid; u < (LDS_BYTES - LDSCTL_OFF) / 4; u += NTHR) ((LAS unsigned*)(F.lds + LDSCTL_OFF))[u] = 0u;
    __syncthreads();
    if (F.tid == 0) {
#pragma unroll
        for (int i = 0; i < 31; ++i) *(LAS unsigned long long*)(F.lds + LDS_PTAB + 8 * i) = (unsigned long long)args.in[i];
        *(LAS unsigned long long*)(F.lds + LDS_PTAB + 8 * 31) = (unsigned long long)args.out; *(LAS unsigned long long*)(F.lds + LDS_PTAB + 8 * 32) = (unsigned long long)args.ws; }
    __syncthreads();
    XcdBarrier bar = xcd_barrier_post(F.ctl + CW_BAR + args.li * XCD_BAR_WORDS, F.MISC + 8);
    const int lo = args.ph_lo, hi = args.ph_hi;
#ifndef PHASE_MASK
#define PHASE_MASK 0xFFFFFFFFu
#endif
#define IN(k) ((((PHASE_MASK) >> (k)) & 1u) && lo <= (k) && (k) < hi)
#define PB() do { F.ws = (unsigned char*)ain_ptr(F.lds, 32); F.out = (float*)ain_ptr(F.lds, 31); F.ctl = (unsigned*)(F.ws + WS_CTL); \
        F.lane = (int)__builtin_amdgcn_mbcnt_hi(~0u, __builtin_amdgcn_mbcnt_lo(~0u, 0u)); F.tid = F.wave * 64 + F.lane; } while (0)
#define ZB ((bf16_t*)(F.ws + WS_Z))
#define GATES ((bf16_t*)F.out)
#define MOD ((const float*)(F.ws + WS_MOD))
#define SEAM(k) do { if (IN(k) && IN((k) + 1)) xcd_barrier(bar); } while (0)

    if (IN(0)) { PB(); p0_prologue(args, F); } SEAM(0);
    if (IN(1)) { PB(); norm_mod_rows(args, F, AIN(0), AIN(4), 0, 1024, nullptr, F.ws + WS_H0); } SEAM(1);
    if (IN(2)) { PB(); pg8::StaticOrder S; S.init(M, NIN, F.G, (int)blockIdx.x); pg8::DenseSrcT<1> G{F.ws + WS_H0, F.ws + WS_WIN, 1024};
        EpiInProj E{ZB, GATES}; pg8::gemm_phase<EpiInProj, pg8::StaticOrder, pg8::DenseSrcT<1>>(F.lds, 1024, S, G, E); } SEAM(2);
    if (IN(3)) { PB(); rk::load_params(args, F); for (int u = blockIdx.x; u < 1024; u += F.G) rk::r1_unit(args, F, u >> 7, u & 127); __syncthreads(); } SEAM(3);
    if (IN(4)) { PB();
#ifdef PROBE_R2_DRY
        if (blockIdx.x < R2_WGS && F.wave < 128 / R2_WGS) rk::r2_task<1>(args, F, blockIdx.x * (128 / R2_WGS) + F.wave);
#endif
        if (blockIdx.x < R2_WGS && F.wave < 128 / R2_WGS) rk::r2_task<0>(args, F, blockIdx.x * (128 / R2_WGS) + F.wave);
#pragma unroll 1
        for (int rep = 0; rep < PROBE_IDX_REP; ++rep)
        for (;;) {
            __syncthreads();
            if (F.tid == 0) F.MISC[12] = atomicAdd(F.ctl + CW_Q + rep, 1u);
            __syncthreads();
            const int u = (int)F.MISC[12];
            if (u >= 2048) break;
            indexer_unit(args, F, u & 7, (255 - (u >> 3)) * 16);
        } } SEAM(4);
    if (IN(5)) { PB(); if (!((PROBE_P5_PART & 2) && args.li == 1)) { for (int u = blockIdx.x; u < 1024; u += F.G) rk::r3_unit(args, F, u >> 7, u & 127); } __syncthreads();
        if (!((PROBE_P5_PART & 1) && args.li == 1)) for (int i = 0; i < 4; ++i) for (int uu = F.vcu; uu < 256; uu += F.G) { const int bh = uu >> 2, s = uu & 3; const int qb = (i == 0) ? s : (i == 1) ? 7 - s : (i == 2) ? 8 + s : 15 - s;
            att::attn_unit(args, F, bh >> 3, bh & 7, qb); } __syncthreads(); } SEAM(5);
    if (IN(6)) { PB(); pg8::StaticOrder S; S.init(M, D, F.G, (int)blockIdx.x);
        { pg8::DenseSrc G{F.ws + WS_R1, F.ws + WS_WA, 512}; EpiMerge<0> E{(bf16_t*)(F.ws + WS_R2), F.ws + WS_H0, GATES, PROBE_ATT_SCALE}; pg8::gemm_phase<EpiMerge<0>, pg8::StaticOrder, pg8::DenseSrc>(F.lds, 512, S, G, E); }
        { pg8::DenseSrc G{F.ws + WS_R0, F.ws + WS_WR, 512}; EpiMerge<1> E{(bf16_t*)(F.ws + WS_R2), F.ws + WS_H0, GATES, PROBE_RW_SCALE}; pg8::gemm_phase<EpiMerge<1>, pg8::StaticOrder, pg8::DenseSrc>(F.lds, 512, S, G, E); } } SEAM(6);
    if (IN(7)) { PB(); pg8::StaticOrder S; S.init(M, D, F.G, (int)blockIdx.x); pg8::DenseSrcT<1> G{F.ws + WS_H0, F.ws + WS_WO, 1024};
        EpiOutProj E{AIN(0), F.out, MOD}; pg8::gemm_phase<EpiOutProj, pg8::StaticOrder, pg8::DenseSrcT<1>>(F.lds, 1024, S, G, E); } SEAM(7);
    if (IN(8)) { PB(); norm2_route_convert(args, F); }
    if (IN(8) && IN(11)) xcd_barrier(bar);
    MoeTab mt{0, 0};
    if (lo <= 13 && hi > 13) { PB(); mt = build_tiles(args, F); scatter_phase(args, F); } else if (hi > 13) { PB(); mt = build_tiles(args, F); }
    SEAM(11);
    const LAS unsigned* tab = (const LAS unsigned*)(F.lds + LDS_TILETAB);
    if (IN(12)) { PB(); MoeSched1 S{tab, mt.ntiles, F.G, F.vcu};            MoeSrc1 G{F.ws};
        EpiMoe1 E{F.ws}; pg8::gemm_phase<EpiMoe1, MoeSched1, MoeSrc1>(F.lds, 1024, S, G, E); } SEAM(12);
    if (IN(13)) { PB(); MoeSched2 S{tab, 0, mt.ntiles, 512, F.G, F.vcu}; MoeSrc2 G{F.ws}; EpiMoe2 E; E.ws = F.ws; E.X1 = F.out; E.tokbase = 0;
        pg8::gemm_phase<EpiMoe2, MoeSched2, MoeSrc2>(F.lds, 256, S, G, E); } SEAM(13);
    if (IN(14)) { PB(); final_rows(args, F, 0, M, 0); }
#ifdef PROBE_CYC
    __syncthreads();
    if (blockIdx.x == 0 && F.tid == 0) { asm volatile("s_waitcnt vmcnt(0)" ::: "memory"); F.out[0] = (float)(F.ctl[CW_Q + 64]); }
#endif
#undef IN
#undef SEAM
#undef PB
}

extern "C" void kernel_launch(void* const* d_in, const int* in_sizes, int n_in, void* d_out, int out_size, void* d_ws, size_t ws_size, hipStream_t stream) {
    static int grid = 0;
    if (grid == 0) {
        if (n_in != 31 || out_size != M * D || ws_size < WS_END) { fprintf(stderr, "kernel_launch: unexpected problem (n_in %d, out %d, ws %zu)\n", n_in, out_size, ws_size); grid = -1; return; }
        int dev = 0, cus = 0, per_cu = 0;
        if (hipGetDevice(&dev) != hipSuccess || hipDeviceGetAttribute(&cus, hipDeviceAttributeMultiprocessorCount, dev) != hipSuccess) { grid = -1; return; }
        if (hipFuncSetAttribute((const void*)fwd_kernel, hipFuncAttributeMaxDynamicSharedMemorySize, LDS_BYTES) != hipSuccess) { fprintf(stderr, "kernel_launch: hipFuncSetAttribute failed\n"); grid = -1; return; }
        if (hipOccupancyMaxActiveBlocksPerMultiprocessor(&per_cu, (const void*)fwd_kernel, NTHR, LDS_BYTES) != hipSuccess || per_cu < 1) fprintf(stderr, "kernel_launch: occupancy query reports %d\n", per_cu);
        (void)hipGetLastError();
        grid = cus;
        if (grid != 256) fprintf(stderr, "kernel_launch: %d CUs (built for 256)\n", grid);
    }
    if (grid < 0) return;
    (void)in_sizes;
    if (hipMemsetAsync((char*)d_ws + WS_CTL, 0, CTL_ZERO_BYTES, stream) != hipSuccess) return;
    Args a{};
    for (int i = 0; i < 31; ++i) a.in[i] = (const float*)d_in[i];
    a.out = (float*)d_out; a.ws = (unsigned char*)d_ws;
#ifndef PROBE_REPEAT
#define PROBE_REPEAT -1
#endif
    int li = 0;
    auto go = [&](int lo_, int hi_) { a.ph_lo = lo_; a.ph_hi = hi_; a.li = li++; hipLaunchKernelGGL(fwd_kernel, dim3(grid), dim3(NTHR), LDS_BYTES, stream, a); };
    if (PROBE_REPEAT < 0) go(0, N_PHASES);
    else { go(0, PROBE_REPEAT + 1); go(PROBE_REPEAT, PROBE_REPEAT + 1); if (PROBE_REPEAT + 1 < N_PHASES) go(PROBE_REPEAT + 1, N_PHASES); }
}
```

```cpp
#include <hip/hip_runtime.h>
#include <cstdio>
#include <cstdint>
#include <cmath>

#define GAS __attribute__((address_space(1)))
#define LAS __attribute__((address_space(3)))
typedef unsigned short bf16_t;
typedef short bf16x8 __attribute__((ext_vector_type(8)));
typedef float f32x4 __attribute__((ext_vector_type(4)));
typedef float f32x2 __attribute__((ext_vector_type(2)));
typedef float f32x16 __attribute__((ext_vector_type(16)));
typedef unsigned u32x4 __attribute__((ext_vector_type(4)));
typedef unsigned u32x2 __attribute__((ext_vector_type(2)));
typedef GAS unsigned gu32;

__device__ __forceinline__ unsigned cvt_pk_bf16(float lo, float hi) { unsigned r; asm volatile("v_cvt_pk_bf16_f32 %0, %1, %2" : "=v"(r) : "v"(lo), "v"(hi)); return r; }
__device__ __forceinline__ float bf_lo(unsigned w) { return __uint_as_float(w << 16); }
__device__ __forceinline__ float bf_hi(unsigned w) { return __uint_as_float(w & 0xffff0000u); }
__device__ __forceinline__ float bf2f(bf16_t b) { return __uint_as_float(((unsigned)b) << 16); }
__device__ __forceinline__ unsigned f2bf(float f) { unsigned u = __float_as_uint(f); return (u + 0x7fffu + ((u >> 16) & 1u)) >> 16; }
__device__ __forceinline__ unsigned pk2(float lo, float hi) { return f2bf(lo) | (f2bf(hi) << 16); }
__device__ __forceinline__ float fast_sigmoid(float x) { return __builtin_amdgcn_rcpf(1.0f + __builtin_amdgcn_exp2f(-1.4426950408889634f * x)); }
__device__ __forceinline__ float wave_sum(float v) {
#define WS_DPP(ctrl) v += __int_as_float(__builtin_amdgcn_update_dpp(0, __float_as_int(v), (ctrl), 0xF, 0xF, true));
    WS_DPP(0xB1) WS_DPP(0x4E) WS_DPP(0x141) WS_DPP(0x140)
#undef WS_DPP
    const int vi = __float_as_int(v);
    return (__int_as_float(__builtin_amdgcn_readlane(vi, 0)) + __int_as_float(__builtin_amdgcn_readlane(vi, 16))) + (__int_as_float(__builtin_amdgcn_readlane(vi, 32)) + __int_as_float(__builtin_amdgcn_readlane(vi, 48)));
}

namespace pg8 {
constexpr int BM = 256, BK = 64, HALF = 128, HTB = HALF * BK * 2, STAGE_BYTES = 8 * HTB, NXCD = 8, WGM = 8;
__host__ __device__ __forceinline__ int lds_byte(int r, int c) { const int st = (r >> 4) * 2 + (c >> 5), rr = r & 15, cc = c & 31, ob = rr * 64 + cc * 2; return st * 1024 + (ob ^ (((ob >> 9) & 1) << 5)); }
__host__ __device__ __forceinline__ void stage_rc(int b, int& R, int& C) { const int st = b / 1024, sb = b % 1024, swz = sb ^ (((sb >> 9) & 1) << 5); R = (st >> 1) * 16 + swz / 64; C = (st & 1) * 32 + (swz % 64) / 2; }
__host__ __device__ __forceinline__ int perm32(int rho) { const int n = rho >> 4, i = rho & 15; return 8 * (i >> 2) + 4 * n + (i & 3); }

struct Unit { int pm, pn; int aux0, aux1; };

struct StaticOrder {
    int nM, nN, nwg, G, c;
    __host__ __device__ void init(int M, int N, int G_, int c_) { nM = M / BM; nN = N / BM; nwg = nM * nN; G = G_; c = c_; }
    __host__ __device__ bool next(int i, Unit& u) const {
        const long L = (long)i * G + c; if (L >= nwg) return false;
        int wgid = (int)L; { const int q = nwg / NXCD, r = nwg % NXCD, xcd = wgid % NXCD, off = wgid / NXCD; wgid = (xcd < r ? xcd * (q + 1) : r * (q + 1) + (xcd - r) * q) + off; }
        const int nig = WGM * nN, gid = wgid / nig, fm = gid * WGM, gsz = (nM - fm) < WGM ? (nM - fm) : WGM;
        u.pm = fm + ((wgid % nig) % gsz); u.pn = (wgid % nig) / gsz; u.aux0 = 0; u.aux1 = 0; return true;
    }
};

template <int ESZ_> struct DenseSrcT {
    static constexpr int ESZ = ESZ_; static constexpr bool GATHER = false;
    const void* A; const void* Bt; int K;
    __device__ __forceinline__ const char* b_base(const Unit& u) const { return (const char*)Bt + (size_t)u.pn * 256 * K * ESZ; }
    __device__ __forceinline__ const char* a_base(const Unit& u) const { return (const char*)A + (size_t)u.pm * 256 * K * ESZ; }
    __device__ __forceinline__ unsigned a_off(const Unit&, int R, int C) const { return (unsigned)(R * K * ESZ) + (unsigned)C * 2u; }
};
typedef DenseSrcT<2> DenseSrc;
typedef int v8i32 __attribute__((ext_vector_type(8)));

template <class T, class = void> struct has_prefetch { static constexpr bool value = false; };
template <class T> struct has_prefetch<T, decltype((void)&T::prefetch)> { static constexpr bool value = true; };
template <class Epi, class Sched, class Src, bool ALIGN_EPI = true>
__device__ __forceinline__ void gemm_phase(LAS unsigned char* lds, const int K, const Sched& S, const Src& G, const Epi& E) {
    const int tid = threadIdx.x, wid = __builtin_amdgcn_readfirstlane(tid >> 6), lane = tid & 63, wr = wid >> 2, wc = wid & 3, fr = lane & 15, fq = lane >> 4;
    constexpr int ESZ = Src::ESZ; const int Kb = K * ESZ;
    const int nt = Kb / (BK * 2);
    unsigned voffB0;
    { int R, C; stage_rc(tid * 16, R, C); const int Rb = Epi::PERM ? ((R & ~31) + perm32(R & 31)) : R; voffB0 = (unsigned)(Rb * Kb) + (unsigned)C * 2u; }
#define PG8_AOFF(u, h, i) ([&]() { int R_, C_; stage_rc(tid * 16 + (i) * 8192, R_, C_); return G.a_off((u), R_ + (h) * HALF, C_); }())
    const size_t kstep = (size_t)(BK * 2);
    const size_t hstepB = (size_t)HALF * Kb;
    const unsigned ldsw = (unsigned)wid * 1024u;
    const int aoff = lds_byte(wr * 64 + fr, fq * 8), boff = lds_byte(wc * 32 + fr, fq * 8);
#define PG8_SA(b, h) (((b) * 2 + (h)) * HTB)
#define PG8_SB(b, h) ((4 + (b) * 2 + (h)) * HTB)
#define PG8_STAGEB(bufoff, gbase) do { _Pragma("unroll") for (int _i = 0; _i < 2; ++_i) { unsigned o_ = voffB0; asm volatile("" : "+v"(o_)); \
        __builtin_amdgcn_global_load_lds((const unsigned*)((const char*)(gbase) + (size_t)_i * 64 * Kb + o_), (LAS unsigned*)(lds + (bufoff) + ldsw + _i * 8192), 16, 0, 0); } } while (0)
#define PG8_STAGEA(bufoff, gbase, vo, h) do { _Pragma("unroll") for (int _i = 0; _i < 2; ++_i) { unsigned o_ = Src::GATHER ? (vo)[h][_i] : (vo)[0][0]; asm volatile("" : "+v"(o_)); \
        __builtin_amdgcn_global_load_lds((const unsigned*)((const char*)(gbase) + (Src::GATHER ? (size_t)0 : (size_t)((h) * 128 + _i * 64) * Kb) + o_), (LAS unsigned*)(lds + (bufoff) + ldsw + _i * 8192), 16, 0, 0); } } while (0)
#define PG8_STAGEA2(bufoff, gbase, h) do { _Pragma("unroll") for (int _i = 0; _i < 2; ++_i) { unsigned o_ = Src::GATHER ? (last ? vn[h][_i] : vc[h][_i]) : vc[0][0]; asm volatile("" : "+v"(o_)); \
        __builtin_amdgcn_global_load_lds((const unsigned*)((const char*)(gbase) + (Src::GATHER ? (size_t)0 : (size_t)((h) * 128 + _i * 64) * Kb) + o_), (LAS unsigned*)(lds + (bufoff) + ldsw + _i * 8192), 16, 0, 0); } } while (0)
#define PG8_LDA(dst, b, h) do { _Pragma("unroll") for (int m = 0; m < 4; ++m) { const u32x4 lo_ = *(const LAS u32x4*)(lds + PG8_SA(b, h) + aoff + m * 2048), hi_ = *(const LAS u32x4*)(lds + PG8_SA(b, h) + aoff + m * 2048 + 1024); \
        dst[m] = __builtin_shufflevector(lo_, hi_, 0, 1, 2, 3, 4, 5, 6, 7); } } while (0)
#define PG8_LDB(dst, b, h) do { _Pragma("unroll") for (int n = 0; n < 2; ++n) { const u32x4 lo_ = *(const LAS u32x4*)(lds + PG8_SB(b, h) + boff + n * 2048), hi_ = *(const LAS u32x4*)(lds + PG8_SB(b, h) + boff + n * 2048 + 1024); \
        dst[n] = __builtin_shufflevector(lo_, hi_, 0, 1, 2, 3, 4, 5, 6, 7); } } while (0)
#define PG8_LO(x) __builtin_bit_cast(bf16x8, __builtin_shufflevector((x), (x), 0, 1, 2, 3))
#define PG8_HI(x) __builtin_bit_cast(bf16x8, __builtin_shufflevector((x), (x), 4, 5, 6, 7))
#define PG8_MMA(ai, bj, At, Bt) do { __builtin_amdgcn_s_setprio(1); _Pragma("unroll") for (int m = 0; m < 4; ++m) _Pragma("unroll") for (int n = 0; n < 2; ++n) { \
        if constexpr (ESZ == 1) acc[ai][bj][m][n] = __builtin_amdgcn_mfma_scale_f32_16x16x128_f8f6f4(__builtin_bit_cast(v8i32, Bt[n]), __builtin_bit_cast(v8i32, At[m]), acc[ai][bj][m][n], 0, 0, 0, 0, 0, 0); \
        else { acc[ai][bj][m][n] = __builtin_amdgcn_mfma_f32_16x16x32_bf16(PG8_LO(Bt[n]), PG8_LO(At[m]), acc[ai][bj][m][n], 0, 0, 0); \
               acc[ai][bj][m][n] = __builtin_amdgcn_mfma_f32_16x16x32_bf16(PG8_HI(Bt[n]), PG8_HI(At[m]), acc[ai][bj][m][n], 0, 0, 0); } } \
        __builtin_amdgcn_s_setprio(0); } while (0)
#define PG8_WAIT_V(n) asm volatile("s_waitcnt vmcnt(" #n ")" ::: "memory")
#define PG8_WAIT_L(n) asm volatile("s_waitcnt lgkmcnt(" #n ")" ::: "memory")
#define PG8_BAR __builtin_amdgcn_s_barrier()
#define PG8_SCHED __builtin_amdgcn_sched_barrier(0)
    Unit cur, nxt; int ui = 0;
    if (!S.next(0, cur)) return;
#define PG8_PREFETCH(u_) do { if constexpr (has_prefetch<Epi>::value) { int ln_; asm volatile("v_mbcnt_lo_u32_b32 %0, -1, 0\n\tv_mbcnt_hi_u32_b32 %0, -1, %0" : "=v"(ln_)); E.prefetch((u_), wr, ln_ & 15); } } while (0)
    PG8_PREFETCH(cur);
    f32x4 acc[2][2][4][2];
#pragma unroll
    for (int a = 0; a < 2; ++a)
#pragma unroll
        for (int b = 0; b < 2; ++b)
#pragma unroll
            for (int m = 0; m < 4; ++m)
#pragma unroll
                for (int n = 0; n < 2; ++n) acc[a][b][m][n] = (f32x4){0.f, 0.f, 0.f, 0.f};
    typedef unsigned u32x8 __attribute__((ext_vector_type(8)));
    u32x8 At[4], B0[2], B1[2];
    unsigned vc[2][2], vn[2][2];
#pragma unroll
    for (int h = 0; h < 2; ++h)
#pragma unroll
        for (int i = 0; i < 2; ++i) vc[h][i] = PG8_AOFF(cur, h, i);
    const char* cA = G.a_base(cur); const char* cB = G.b_base(cur);
    PG8_STAGEB(PG8_SB(0, 0), cB); PG8_STAGEB(PG8_SB(0, 1), cB + hstepB); PG8_STAGEA(PG8_SA(0, 0), cA, vc, 0); PG8_STAGEA(PG8_SA(0, 1), cA, vc, 1);
    if (wr == 1) PG8_BAR;
    PG8_WAIT_V(2); PG8_BAR;
    PG8_STAGEB(PG8_SB(1, 0), cB + kstep); PG8_STAGEA(PG8_SA(1, 0), cA + kstep, vc, 0); PG8_STAGEB(PG8_SB(1, 1), cB + hstepB + kstep);
    PG8_WAIT_V(6); PG8_BAR;
    for (;;) {
        const bool has_next = S.next(ui + 1, nxt);
        const char* nA = has_next ? G.a_base(nxt) : cA; const char* nB = has_next ? G.b_base(nxt) : cB;
        if constexpr (Src::GATHER) {
#pragma unroll
        for (int h = 0; h < 2; ++h)
#pragma unroll
            for (int i = 0; i < 2; ++i) vn[h][i] = has_next ? PG8_AOFF(nxt, h, i) : vc[h][i]; }
#pragma clang loop unroll(disable)
        for (int t = 0; t < nt; t += 2) {
            const bool last = (t == nt - 2);
            const char* a1 = cA + (size_t)(t + 1) * kstep;
            const char* a2 = last ? nA : cA + (size_t)(t + 2) * kstep; const char* b2 = last ? nB : cB + (size_t)(t + 2) * kstep;
            const char* a3 = a2 + kstep; const char* b3 = b2 + kstep;
            PG8_LDB(B0, 0, 0); PG8_LDB(B1, 0, 1); PG8_SCHED; PG8_LDA(At, 0, 0); PG8_STAGEA(PG8_SA(1, 1), a1, vc, 1);
            PG8_WAIT_V(8); PG8_WAIT_L(0); PG8_BAR; PG8_MMA(0, 0, At, B0); PG8_MMA(0, 1, At, B1); PG8_BAR; PG8_SCHED;
            PG8_LDA(At, 0, 1); PG8_STAGEB(PG8_SB(0, 0), b2); PG8_STAGEB(PG8_SB(0, 1), b2 + hstepB); PG8_STAGEA2(PG8_SA(0, 0), a2, 0);
            PG8_WAIT_V(8); PG8_WAIT_L(0); PG8_BAR; PG8_MMA(1, 0, At, B0); PG8_MMA(1, 1, At, B1); PG8_BAR; PG8_SCHED;
            PG8_LDB(B0, 1, 0); PG8_LDB(B1, 1, 1); PG8_SCHED; PG8_LDA(At, 1, 0); PG8_STAGEA2(PG8_SA(0, 1), a2, 1);
            PG8_WAIT_V(8); PG8_WAIT_L(0); PG8_BAR; PG8_MMA(0, 0, At, B0); PG8_MMA(0, 1, At, B1); PG8_BAR; PG8_SCHED;
            PG8_LDA(At, 1, 1); PG8_STAGEB(PG8_SB(1, 0), b3); PG8_STAGEB(PG8_SB(1, 1), b3 + hstepB); PG8_STAGEA2(PG8_SA(1, 0), a3, 0);
            PG8_WAIT_V(8); PG8_WAIT_L(0); PG8_BAR; PG8_MMA(1, 0, At, B0); PG8_MMA(1, 1, At, B1); PG8_BAR; PG8_SCHED;
        }
        if constexpr (ALIGN_EPI) { if (wr == 0) PG8_BAR; }
        { int ln_; asm volatile("v_mbcnt_lo_u32_b32 %0, -1, 0\n\tv_mbcnt_hi_u32_b32 %0, -1, %0" : "=v"(ln_)); E(acc, cur, wr, wc, ln_ & 15, ln_ >> 4); }
        if (!has_next) break;
#pragma unroll
        for (int a = 0; a < 2; ++a)
#pragma unroll
            for (int b = 0; b < 2; ++b)
#pragma unroll
                for (int m = 0; m < 4; ++m)
#pragma unroll
                    for (int n = 0; n < 2; ++n) acc[a][b][m][n] = (f32x4){0.f, 0.f, 0.f, 0.f};
        cur = nxt; cA = nA; cB = nB; ++ui;
        PG8_PREFETCH(cur);
        if constexpr (Src::GATHER) {
#pragma unroll
        for (int h = 0; h < 2; ++h)
#pragma unroll
            for (int i = 0; i < 2; ++i) vc[h][i] = vn[h][i]; }
        if constexpr (ALIGN_EPI) { if (wr == 1) PG8_BAR; }
    }
    PG8_WAIT_V(0);
    if constexpr (!ALIGN_EPI) { if (wr == 0) PG8_BAR; }
    PG8_BAR;
#undef PG8_PREFETCH
#undef PG8_SA
#undef PG8_AOFF
#undef PG8_SB
#undef PG8_STAGEA
#undef PG8_STAGEA2
#undef PG8_STAGEB
#undef PG8_LDA
#undef PG8_LDB
#undef PG8_MMA
#undef PG8_LO
#undef PG8_HI
#undef PG8_WAIT_V
#undef PG8_WAIT_L
#undef PG8_BAR
#undef PG8_SCHED
}
}
#define RLX_AGENT __ATOMIC_RELAXED, __HIP_MEMORY_SCOPE_AGENT
#define LDS_WAIT() asm volatile("s_waitcnt lgkmcnt(0)" ::: "memory")
#define VM_WAIT() asm volatile("s_waitcnt vmcnt(0)" ::: "memory")
#define XB_TMO      128
#define XB_XCNT(j)  (256  + 64 * (j))
#define XB_XSUB(j)  (1280 + 64 * (j))
#define XB_XGEN(j)  (2304 + 64 * (j))
#define XB_TOP      3328
#define XB_TOPGEN   3392
#define XCD_BAR_WORDS 3456
#define XB_SPIN_CAP (1u << 18)

__device__ __forceinline__ unsigned xb_ld(unsigned* p)              { return __hip_atomic_load(p, __ATOMIC_RELAXED, __HIP_MEMORY_SCOPE_AGENT); }
__device__ __forceinline__ unsigned xb_add(unsigned* p, unsigned v) { return __hip_atomic_fetch_add(p, v, __ATOMIC_RELAXED, __HIP_MEMORY_SCOPE_AGENT); }
__device__ __forceinline__ unsigned xb_xcc_id() { return (unsigned)__builtin_amdgcn_s_getreg((3 << 11) | 20) & 0xFu; }
#define XB_SPIN(cond, bar) do { unsigned _sp = 0; while (cond) { __builtin_amdgcn_s_sleep(1); \
    if ((++_sp & 255u) == 0u) { if (xb_ld(&(bar)[XB_TMO])) break; if (_sp > XB_SPIN_CAP) { atomicAdd(&(bar)[XB_TMO], 1u); break; } } } } while (0)

struct XcdBarrier {
    unsigned* bar; unsigned x;
    volatile LAS unsigned* st;
};

__device__ __forceinline__ XcdBarrier xcd_barrier_post(unsigned* bar, volatile LAS unsigned* st) {
    XcdBarrier b; b.bar = bar; b.x = xb_xcc_id(); b.st = st;
    if (threadIdx.x == 0) (void)xb_add(&bar[XB_XCNT(b.x)], 1u);
    return b;
}
__device__ __forceinline__ void xcd_barrier_complete(unsigned* bar, unsigned x, unsigned& nloc, unsigned& nx) {
    const unsigned G = gridDim.x * gridDim.y * gridDim.z;
    unsigned sum, cnt, mine, sp = 0u;
    for (;;) {
        sum = 0u; cnt = 0u; mine = 0u;
#pragma unroll
        for (unsigned j = 0; j < 16; ++j) { const unsigned c = xb_ld(&bar[XB_XCNT(j)]); sum += c; cnt += (c > 0u) ? 1u : 0u; mine = (j == x) ? c : mine; }
        if (sum == G) break;
        __builtin_amdgcn_s_sleep(1);
        if ((++sp & 255u) == 0u) { if (xb_ld(&bar[XB_TMO])) break; if (sp > XB_SPIN_CAP) { atomicAdd(&bar[XB_TMO], 1u); break; } }
    }
    nloc = mine > 0u ? mine : 1u; nx = cnt > 0u ? cnt : 1u;
}

__device__ __forceinline__ void xcd_barrier(const XcdBarrier& b) {
    asm volatile("s_waitcnt vmcnt(0)" ::: "memory");
    __syncthreads();
    if (threadIdx.x == 0) {
        unsigned* bar = b.bar;
        __builtin_amdgcn_s_waitcnt(0);
        unsigned nloc = b.st[0], nx = b.st[1];
        if (nloc == 0u) { xcd_barrier_complete(bar, b.x, nloc, nx); b.st[0] = nloc; b.st[1] = nx; }
        const unsigned old = xb_add(&bar[XB_XSUB(b.x)], 1u);
        const unsigned gen = old / nloc;
        if (old + 1u == (gen + 1u) * nloc) {
            __builtin_amdgcn_fence(__ATOMIC_RELEASE, "agent");
            asm volatile("s_waitcnt vmcnt(0)" ::: "memory");
            const unsigned og = xb_add(&bar[XB_TOP], 1u);
            const unsigned tg = og / nx;
            if (og + 1u == (tg + 1u) * nx) xb_add(&bar[XB_TOPGEN], 1u);
            else XB_SPIN(xb_ld(&bar[XB_TOPGEN]) == tg, bar);
            __builtin_amdgcn_fence(__ATOMIC_ACQUIRE, "agent");
            xb_add(&bar[XB_XGEN(b.x)], 1u);
            asm volatile("s_waitcnt vmcnt(0)" ::: "memory");
        } else {
            XB_SPIN(xb_ld(&bar[XB_XGEN(b.x)]) == gen, bar);
            __builtin_amdgcn_fence(__ATOMIC_ACQUIRE, "agent");
            asm volatile("s_waitcnt vmcnt(0)" ::: "memory");
        }
    }
    __syncthreads();
}
constexpr int NB = 8, SEQ = 4096, D = 1024, M = NB * SEQ;
constexpr int NIN_SRC = 5936, NIN = 6144;
constexpr int ZW = 4096;
constexpr int ZQ = 0, ZK = 512, ZV = 1024, ZIQ = 1536, ZIK = 2048, ZIW = 2080, ZR = 2304;
constexpr int ZR_R = ZR, ZR_K = ZR + 512, ZR_V = ZR + 1024, ZR_WD = ZR + 1536, ZR_AD = ZR + 1600, ZR_GD = ZR + 1664;
constexpr int GW = 2048;
constexpr int NEXP = 64, FF = 256, TOPK = 8;
constexpr float RMS_EPS = 1e-6f, GN_EPS = 64e-5f;
constexpr float QSCALE = 0.125f * 1.4426950408889634f;
constexpr int NWAVES = 8, NTHR = 512;

constexpr size_t MiB = 1u << 20;
constexpr size_t WS_CTL = 0, CTL_ZERO_BYTES = 1 * MiB;
constexpr size_t WS_MOD = 1 * MiB;
constexpr size_t WS_DUT = 1 * MiB + 256 * 1024;
constexpr size_t WS_IUT = WS_DUT + 64 * 1024;
constexpr size_t WS_GUT = WS_IUT + 64 * 1024;
constexpr size_t WS_WIN = 2 * MiB;
constexpr size_t WS_WA = 14 * MiB, WS_WR = 15 * MiB;
constexpr size_t WS_WO = 16 * MiB;
constexpr size_t WS_WRT = 18 * MiB;
constexpr size_t WS_WSH1 = 19 * MiB;
constexpr size_t WS_WSH2 = 20 * MiB;
constexpr size_t WS_BRS = 21 * MiB, WS_KRS = 22 * MiB;
constexpr size_t WS_TOPE = 23 * MiB, WS_TOPW = 24 * MiB;
constexpr size_t WS_LOGIT = 25 * MiB;
constexpr size_t WS_Z = 36 * MiB;
constexpr size_t WS_H0 = 292 * MiB, WS_H1 = 324 * MiB;
constexpr size_t WS_SEL = 356 * MiB;
constexpr size_t WS_R0 = 372 * MiB, WS_R1 = 404 * MiB, WS_R2 = 436 * MiB, WS_R3 = 468 * MiB;
constexpr size_t WS_W2T = 36 * MiB;
constexpr size_t WS_ACT = 68 * MiB;
constexpr size_t WS_ACTS = 196 * MiB;
constexpr size_t WS_STOK = 212 * MiB, WS_SW = 213 * MiB;
constexpr size_t WS_W1T = 214 * MiB;
constexpr size_t WS_H2 = 278 * MiB;
constexpr size_t WS_H2F8 = 132 * MiB;
constexpr size_t WS_HS = 246 * MiB;
constexpr size_t WS_SLOT = 214 * MiB;
constexpr size_t WS_END = 502 * MiB;
constexpr int CW_TMO = 0, CW_BAR = 4096, CW_CNT = 32768, CW_CUR = 32768 + 128, CW_Q = 32768 + 512;

constexpr int RING_BYTES = 131072;
constexpr int LDSCTL_OFF = RING_BYTES, MISC_OFF = LDSCTL_OFF + 320;
constexpr int LDS_TILETAB = RING_BYTES + 1024;
constexpr int LDS_PTAB = RING_BYTES + 512;
constexpr int LDS_PARA = 118800;
constexpr int LDS_PARB = LDS_TILETAB;
constexpr int LDS_BYTES = 147456;
#define AIN(i) ain_ptr(F.lds, (i))

struct Args { const float* in[31]; float* out; unsigned char* ws; int ph_lo, ph_hi, li, pad; };
struct Frame {
    LAS unsigned char* lds;
    volatile LAS unsigned* MISC;
    unsigned* ctl;
    int tid, lane, wave, vcu, G, gw, NGW;
    float* out; unsigned char* ws;
};

__device__ __forceinline__ const float* ain_ptr(LAS unsigned char* lds, int i) {
    const u32x2 w = *(const LAS u32x2*)(lds + LDS_PTAB + 8 * i);
    const unsigned lo = (unsigned)__builtin_amdgcn_readfirstlane((int)w.x), hi = (unsigned)__builtin_amdgcn_readfirstlane((int)w.y);
    return (const float*)(const GAS float*)(((unsigned long long)hi << 32) | lo);
}
struct TrSrc { const float* base; int nsrc; };
template <int FP8, class ColFn>
__device__ __forceinline__ void transpose_item(const ColFn& colfn, int K, bf16_t* WT, LAS float* scr, int kb, int nb, int lane) {
    const int k0 = 64 * kb, n0 = 32 * nb;
    const TrSrc s = colfn(n0 + (lane & 31));
    float v_[32];
#pragma unroll
    for (int i = 0; i < 32; ++i) { const int kk = 2 * i + (lane >> 5); v_[i] = s.base ? s.base[(size_t)(k0 + kk) * s.nsrc] : 0.f; }
#pragma unroll
    for (int i = 0; i < 32; ++i) { const int kk = 2 * i + (lane >> 5); scr[kk * 33 + (lane & 31)] = v_[i]; }
    LDS_WAIT(); asm volatile("" ::: "memory");
    const int c = lane & 7;
#pragma unroll
    for (int j = 0; j < 4; ++j) { const int n = (lane >> 3) + 8 * j; const LAS float* sp = scr + (8 * c) * 33 + n;
        if constexpr (FP8) { constexpr float S8 = 32.0f;
            int lo = __builtin_amdgcn_cvt_pk_fp8_f32(sp[0 * 33] * S8, sp[1 * 33] * S8, 0, false); lo = __builtin_amdgcn_cvt_pk_fp8_f32(sp[2 * 33] * S8, sp[3 * 33] * S8, lo, true);
            int hi = __builtin_amdgcn_cvt_pk_fp8_f32(sp[4 * 33] * S8, sp[5 * 33] * S8, 0, false); hi = __builtin_amdgcn_cvt_pk_fp8_f32(sp[6 * 33] * S8, sp[7 * 33] * S8, hi, true);
            *(GAS u32x2*)((unsigned char*)WT + (size_t)(n0 + n) * K + k0 + 8 * c) = (u32x2){(unsigned)lo, (unsigned)hi}; }
        else { u32x4 o; o.x = pk2(sp[0 * 33], sp[1 * 33]); o.y = pk2(sp[2 * 33], sp[3 * 33]); o.z = pk2(sp[4 * 33], sp[5 * 33]); o.w = pk2(sp[6 * 33], sp[7 * 33]);
            *(GAS u32x4*)(WT + (size_t)(n0 + n) * K + k0 + 8 * c) = o; } }
    LDS_WAIT(); asm volatile("" ::: "memory");
}

__device__ __forceinline__ void p0_mod(const Args& args, Frame& F, int task) {
    LAS float* sc = (LAS float*)F.lds;
    LAS float* red = (LAS float*)(F.lds + 32768);
    const float* c = AIN(1);
    for (int i = F.tid; i < 8192; i += NTHR) { const float v = c[i]; sc[i] = v * fast_sigmoid(v); }
    __syncthreads();
    const float* aw = AIN(2) + 64 * task + F.lane;
    float acc[8];
#pragma unroll
    for (int b = 0; b < 8; ++b) acc[b] = 0.f;
    const int kb = 128 * F.wave;
#pragma unroll 1
    for (int k0 = 0; k0 < 128; k0 += 16) { float a_[16];
#pragma unroll
        for (int k = 0; k < 16; ++k) a_[k] = aw[(size_t)(kb + k0 + k) * 6144];
#pragma unroll
        for (int k = 0; k < 16; ++k) {
#pragma unroll
            for (int b = 0; b < 8; ++b) acc[b] += sc[b * 1024 + kb + k0 + k] * a_[k];
            if ((k & 3) == 3) asm volatile("" ::: "memory"); } }
#pragma unroll
    for (int b = 0; b < 8; ++b) red[(F.wave * 8 + b) * 64 + F.lane] = acc[b];
    __syncthreads();
    { const int b = F.wave; float s = AIN(3)[64 * task + F.lane];
#pragma unroll
      for (int w = 0; w < 8; ++w) s += red[(w * 8 + b) * 64 + F.lane];
      ((float*)(F.ws + WS_MOD))[b * 6144 + 64 * task + F.lane] = s; }
    __syncthreads();
}

__device__ __forceinline__ void p0_prologue(const Args& args, Frame& F) {
    if (blockIdx.x < 96) p0_mod(args, F, blockIdx.x);
    LAS float* scr = (LAS float*)(F.lds + F.wave * 16384);
    bf16_t* const ws16 = (bf16_t*)F.ws;
    constexpr int I_WIN = 16 * 192, I_WA = 8 * 32, I_WO = 16 * 32, I_WRT = 16 * 8, I_SH1 = 16 * 16, I_SH2 = 4 * 32, I_DU = 16, I_GU = 32;
    constexpr int NIT = I_WIN + 2 * I_WA + I_WO + I_WRT + I_SH1 + I_SH2 + 2 * I_DU + I_GU;
    for (int it = F.gw; it < NIT; it += F.NGW) {
        int r = it;
        if (r < I_WIN) { const float* w = AIN(5);
            transpose_item<1>([=](int n) { TrSrc s; const bool ok = (n < 2096) || (n >= 2304); const int col = n < 2096 ? n : n - 208; s.base = ok ? w + col : nullptr; s.nsrc = NIN_SRC; return s; },
                           1024, (bf16_t*)(F.ws + WS_WIN), scr, r / 192, r % 192, F.lane); continue; } r -= I_WIN;
        if (r < I_WA) { const float* w = AIN(18); transpose_item<0>([=](int n) { TrSrc s; s.base = w + n; s.nsrc = 1024; return s; }, 512, (bf16_t*)(F.ws + WS_WA), scr, r / 32, r % 32, F.lane); continue; } r -= I_WA;
        if (r < I_WA) { const float* w = AIN(19); transpose_item<0>([=](int n) { TrSrc s; s.base = w + n; s.nsrc = 1024; return s; }, 512, (bf16_t*)(F.ws + WS_WR), scr, r / 32, r % 32, F.lane); continue; } r -= I_WA;
        if (r < I_WO) { const float* w = AIN(20); transpose_item<1>([=](int n) { TrSrc s; s.base = w + n; s.nsrc = 1024; return s; }, 1024, (bf16_t*)(F.ws + WS_WO), scr, r / 32, r % 32, F.lane); continue; } r -= I_WO;
        if (r < I_WRT) { const float* w = AIN(22); transpose_item<0>([=](int n) { TrSrc s; s.base = n < 64 ? w + n : nullptr; s.nsrc = 64; return s; }, 1024, (bf16_t*)(F.ws + WS_WRT), scr, r / 8, r % 8, F.lane); continue; } r -= I_WRT;
        if (r < I_SH1) { const float* wg = AIN(27); const float* wu = AIN(28);
            transpose_item<1>([=](int n) { TrSrc s; const int j = n >> 8, sel = (n >> 7) & 1, cc = n & 127; s.base = (sel ? wu : wg) + 128 * j + cc; s.nsrc = 256; return s; }, 1024, (bf16_t*)(F.ws + WS_WSH1), scr, r / 16, r % 16, F.lane); continue; } r -= I_SH1;
        if (r < I_SH2) { const float* w = AIN(29); transpose_item<1>([=](int n) { TrSrc s; s.base = w + n; s.nsrc = 1024; return s; }, 256, (bf16_t*)(F.ws + WS_WSH2), scr, r / 32, r % 32, F.lane); continue; } r -= I_SH2;
        if (r < I_DU) { const float* w = AIN(9); transpose_item<0>([=](int n) { TrSrc s; s.base = w + n; s.nsrc = 512; return s; }, 64, (bf16_t*)(F.ws + WS_DUT), scr, 0, r, F.lane); continue; } r -= I_DU;
        if (r < I_DU) { const float* w = AIN(11); transpose_item<0>([=](int n) { TrSrc s; s.base = w + n; s.nsrc = 512; return s; }, 64, (bf16_t*)(F.ws + WS_IUT), scr, 0, r, F.lane); continue; } r -= I_DU;
        { const float* w = AIN(12); transpose_item<0>([=](int n) { TrSrc s; s.base = w + n; s.nsrc = 512; return s; }, 128, (bf16_t*)(F.ws + WS_GUT), scr, r / 16, r % 16, F.lane); }
    }
    (void)ws16;
}

__device__ __forceinline__ void convert_experts(const Args& args, Frame& F, int k0, int k1) {
    LAS float* scr = (LAS float*)(F.lds + F.wave * 16384);
    constexpr int I1 = 16 * 16, I2 = 4 * 32, PER = I1 + I2, NIT = 64 * PER;
    for (int k = k0; k < k1; ++k) { const int it = F.gw + k * F.NGW; if (it >= NIT) break;
        const int e = it / PER; int r = it % PER;
        if (r < I1) { const float* wg = AIN(24) + (size_t)e * 1024 * 256; const float* wu = AIN(25) + (size_t)e * 1024 * 256;
            transpose_item<1>([=](int n) { TrSrc s; const int j = n >> 8, sel = (n >> 7) & 1, cc = n & 127; s.base = (sel ? wu : wg) + 128 * j + cc; s.nsrc = 256; return s; }, 1024, (bf16_t*)(F.ws + WS_W1T + (size_t)e * 512 * 1024), scr, r / 16, r % 16, F.lane); }
        else { r -= I1; const float* w = AIN(26) + (size_t)e * 256 * 1024;
            transpose_item<1>([=](int n) { TrSrc s; s.base = w + n; s.nsrc = 1024; return s; }, 256, (bf16_t*)(F.ws + WS_W2T + (size_t)e * 1024 * 256), scr, r / 32, r % 32, F.lane); }
    }
}

__device__ __forceinline__ void norm_mod_rows(const Args& args, Frame& F, const float* X, const float* g, int sh_off, int sc_off, bf16_t* O, unsigned char* O8) {
    const int row0 = F.gw * 16, b = row0 / SEQ;
    const float* mod = (const float*)(F.ws + WS_MOD) + b * 6144;
    f32x4 mul[4], add[4];
#pragma unroll
    for (int j = 0; j < 4; ++j) { const int c = 4 * F.lane + 256 * j; const f32x4 gv = *(const f32x4*)(g + c), sc = *(const f32x4*)(mod + sc_off + c); add[j] = *(const f32x4*)(mod + sh_off + c); mul[j] = gv * (sc + 1.0f); }
    for (int r0 = 0; r0 < 16; r0 += 4) {
        f32x4 v[4][4]; float s[4];
#pragma unroll
        for (int q = 0; q < 4; ++q) { const GAS f32x4* xr = (const GAS f32x4*)(X + (size_t)(row0 + r0 + q) * D) + F.lane;
#pragma unroll
            for (int j = 0; j < 4; ++j) v[q][j] = xr[64 * j]; }
#pragma unroll
        for (int q = 0; q < 4; ++q) { s[q] = 0.f;
#pragma unroll
            for (int j = 0; j < 4; ++j) s[q] += (v[q][j].x * v[q][j].x + v[q][j].y * v[q][j].y) + (v[q][j].z * v[q][j].z + v[q][j].w * v[q][j].w); }
#pragma unroll
        for (int q = 0; q < 4; ++q) { const int r = r0 + q;
            const float rstd = 1.0f / sqrtf(wave_sum(s[q]) * (1.0f / D) + RMS_EPS);
#pragma unroll
            for (int j = 0; j < 4; ++j) { const f32x4 y = v[q][j] * rstd * mul[j] + add[j];
                if (O) { u32x2 w; w.x = cvt_pk_bf16(y.x, y.y); w.y = cvt_pk_bf16(y.z, y.w); ((GAS u32x2*)(O + (size_t)(row0 + r) * D) + F.lane)[64 * j] = w; }
                if (O8) { int w8 = __builtin_amdgcn_cvt_pk_fp8_f32(y.x, y.y, 0, false); w8 = __builtin_amdgcn_cvt_pk_fp8_f32(y.z, y.w, w8, true); ((GAS unsigned*)(O8 + (size_t)(row0 + r) * D) + F.lane)[64 * j] = (unsigned)w8; } } }
    }
}
using pg8::Unit;
constexpr float WSCALE8 = 32.0f;
typedef const f32x4 (&AccRef)[2][2][4][2];

struct EpiInProj {
    static constexpr bool PERM = true;
    bf16_t* Z; bf16_t* Gt;
    __device__ __forceinline__ void operator()(AccRef acc, const Unit& u, int wr, int wc, int fr, int fq) const {
        asm volatile("" : "+v"(fr), "+v"(fq));
        const int row0 = u.pm * 256 + wr * 64 + fr;
        const bool gate = u.pn >= 16;
        const float sc = ((u.pn < 2) ? QSCALE : 1.0f) * (1.0f / WSCALE8);
        bf16_t* base = gate ? Gt + (size_t)(u.pn - 16) * 256 : Z + (size_t)u.pn * 256;
        const int ldc = gate ? GW : ZW;
#pragma unroll
        for (int ai = 0; ai < 2; ++ai)
#pragma unroll
            for (int m = 0; m < 4; ++m) { bf16_t* rowp = base + (size_t)(row0 + ai * 128 + m * 16) * ldc + wc * 32 + 8 * fq;
#pragma unroll
                for (int bj = 0; bj < 2; ++bj) { f32x4 v0 = acc[ai][bj][m][0], v1 = acc[ai][bj][m][1];
                    if (gate) {
#pragma unroll
                        for (int j = 0; j < 4; ++j) { v0[j] = fast_sigmoid(v0[j] * sc); v1[j] = fast_sigmoid(v1[j] * sc); } }
                    else { v0 = v0 * sc; v1 = v1 * sc; }
                    u32x4 w; w.x = cvt_pk_bf16(v0[0], v0[1]); w.y = cvt_pk_bf16(v0[2], v0[3]); w.z = cvt_pk_bf16(v1[0], v1[1]); w.w = cvt_pk_bf16(v1[2], v1[3]);
                    *(u32x4*)(rowp + bj * 128) = w; } }
    }
};

constexpr float ATT_S8 = 16.0f, RW_S8 = 8.0f, MIX_S8 = 16.0f;
template <int SECOND> struct EpiMerge {
    static constexpr bool PERM = true;
    bf16_t* Mx; unsigned char* Mx8; const bf16_t* Gt; float bs;
    __device__ __forceinline__ void operator()(AccRef acc, const Unit& u, int wr, int wc, int fr, int fq) const {
        asm volatile("" : "+v"(fr), "+v"(fq));
        const int row0 = u.pm * 256 + wr * 64 + fr, col0 = u.pn * 256 + wc * 32 + 8 * fq;
#pragma unroll
        for (int ai = 0; ai < 2; ++ai)
#pragma unroll
            for (int m = 0; m < 4; ++m) { const size_t r = (size_t)(row0 + ai * 128 + m * 16);
#pragma unroll
                for (int bj = 0; bj < 2; ++bj) { const int c = col0 + bj * 128;
                    const u32x4 g = *(const u32x4*)(Gt + r * GW + SECOND * 1024 + c);
                    f32x4 v0 = acc[ai][bj][m][0] * bs, v1 = acc[ai][bj][m][1] * bs;
                    v0[0] *= bf_lo(g.x); v0[1] *= bf_hi(g.x); v0[2] *= bf_lo(g.y); v0[3] *= bf_hi(g.y);
                    v1[0] *= bf_lo(g.z); v1[1] *= bf_hi(g.z); v1[2] *= bf_lo(g.w); v1[3] *= bf_hi(g.w);
                    if (SECOND) { const u32x4 p = *(const u32x4*)(Mx + r * D + c);
                        v0[0] += bf_lo(p.x); v0[1] += bf_hi(p.x); v0[2] += bf_lo(p.y); v0[3] += bf_hi(p.y);
                        v1[0] += bf_lo(p.z); v1[1] += bf_hi(p.z); v1[2] += bf_lo(p.w); v1[3] += bf_hi(p.w);
                        v0 = v0 * MIX_S8; v1 = v1 * MIX_S8;
                        int lo = __builtin_amdgcn_cvt_pk_fp8_f32(v0[0], v0[1], 0, false); lo = __builtin_amdgcn_cvt_pk_fp8_f32(v0[2], v0[3], lo, true);
                        int hi = __builtin_amdgcn_cvt_pk_fp8_f32(v1[0], v1[1], 0, false); hi = __builtin_amdgcn_cvt_pk_fp8_f32(v1[2], v1[3], hi, true);
                        *(u32x2*)(Mx8 + r * D + c) = (u32x2){(unsigned)lo, (unsigned)hi}; }
                    else { u32x4 w; w.x = cvt_pk_bf16(v0[0], v0[1]); w.y = cvt_pk_bf16(v0[2], v0[3]); w.z = cvt_pk_bf16(v1[0], v1[1]); w.w = cvt_pk_bf16(v1[2], v1[3]);
                        *(u32x4*)(Mx + r * D + c) = w; }
                    asm volatile("" ::: "memory"); } }
    }
};

struct EpiOutProj {
    static constexpr bool PERM = false;
    const float* X; float* O; const float* mod;
    __device__ __forceinline__ void operator()(AccRef acc, const Unit& u, int wr, int wc, int fr, int fq) const {
        asm volatile("" : "+v"(fr), "+v"(fq));
        const int row0 = u.pm * 256 + wr * 64 + fr, col0 = u.pn * 256 + wc * 32 + 4 * fq;
        const float* g1 = mod + (size_t)((u.pm * 256) / SEQ) * 6144 + 2048;
        f32x4 gv[2][2];
#pragma unroll
        for (int bj = 0; bj < 2; ++bj)
#pragma unroll
            for (int n = 0; n < 2; ++n) gv[bj][n] = *(const f32x4*)(g1 + col0 + bj * 128 + n * 16);
#pragma unroll
        for (int ai = 0; ai < 2; ++ai)
#pragma unroll
            for (int m = 0; m < 4; ++m) { const size_t off = (size_t)(row0 + ai * 128 + m * 16) * D + col0;
#pragma unroll
                for (int bj = 0; bj < 2; ++bj)
#pragma unroll
                    for (int n = 0; n < 2; ++n) { const f32x4 xv = *(const f32x4*)(X + off + bj * 128 + n * 16);
                        *(f32x4*)(O + off + bj * 128 + n * 16) = xv + gv[bj][n] * acc[ai][bj][m][n] * (1.0f / (MIX_S8 * WSCALE8)); }
                if (m & 1) asm volatile("" ::: "memory"); }
    }
};

struct EpiRouter {
    static constexpr bool PERM = false;
    float* L;
    __device__ __forceinline__ void operator()(AccRef acc, const Unit& u, int wr, int wc, int fr, int fq) const {
        asm volatile("" : "+v"(fr), "+v"(fq));
        if (wc >= 2) return;
        const int row0 = u.pm * 256 + wr * 64 + fr, col0 = wc * 32 + 4 * fq;
#pragma unroll
        for (int ai = 0; ai < 2; ++ai)
#pragma unroll
            for (int m = 0; m < 4; ++m)
#pragma unroll
                for (int n = 0; n < 2; ++n) *(f32x4*)(L + (size_t)(row0 + ai * 128 + m * 16) * 64 + col0 + n * 16) = acc[ai][0][m][n];
    }
};

struct MoeSched1 {
    const LAS unsigned* tab; int ntiles, G, c;
    __device__ __forceinline__ bool next(int i, Unit& u) const {
        const int L = i * G + c; if (L >= 256 + 2 * ntiles) return false;
        u.pn = L & 1;
        if (L < 256) { u.pm = L >> 1; u.aux0 = (u.pm * 256) | (64 << 20); u.aux1 = 256; }
        else { const int t = (L - 256) >> 1; u.pm = t; u.aux0 = __builtin_amdgcn_readfirstlane((int)tab[2 * t]); u.aux1 = __builtin_amdgcn_readfirstlane((int)tab[2 * t + 1]); }
        return true;
    }
};
struct MoeSrc1 {
    static constexpr int ESZ = 1; static constexpr bool GATHER = false;
    const unsigned char* ws;
    __device__ __forceinline__ const char* a_base(const Unit& u) const { return (const char*)ws + ((u.aux0 >> 20) == 64 ? WS_H2F8 : WS_HS) + (size_t)(u.aux0 & 0xFFFFF) * 1024; }
    __device__ __forceinline__ const char* b_base(const Unit& u) const { const int e = u.aux0 >> 20;
        const size_t off = (e == 64 ? WS_WSH1 : WS_W1T + (size_t)e * 512 * 1024) + (size_t)u.pn * 256 * 1024; return (const char*)ws + off; }
    __device__ __forceinline__ unsigned a_off(const Unit&, int R, int C) const { return (unsigned)(R * 1024) + (unsigned)C * 2u; }
};
constexpr float ACT_S8 = 8.0f;
struct EpiMoe1 {
    static constexpr bool PERM = true;
    unsigned char* ws;
    __device__ __forceinline__ void operator()(AccRef acc, const Unit& u, int wr, int wc, int fr, int fq) const {
        asm volatile("" : "+v"(fr), "+v"(fq));
        const int e = u.aux0 >> 20, pos0 = u.aux0 & 0xFFFFF;
        unsigned char* base = ws + (e == 64 ? WS_ACTS : WS_ACT) + (size_t)pos0 * FF + u.pn * 128 + wc * 32 + 8 * fq;
#pragma unroll
        for (int ai = 0; ai < 2; ++ai)
#pragma unroll
            for (int m = 0; m < 4; ++m) { const int r = ai * 128 + wr * 64 + m * 16 + fr;
                float o[8];
#pragma unroll
                for (int n = 0; n < 2; ++n)
#pragma unroll
                    for (int j = 0; j < 4; ++j) { const float g = acc[ai][0][m][n][j] * (1.0f / WSCALE8), up = acc[ai][1][m][n][j] * (ACT_S8 / WSCALE8); o[4 * n + j] = g * fast_sigmoid(g) * up; }
                int lo = __builtin_amdgcn_cvt_pk_fp8_f32(o[0], o[1], 0, false); lo = __builtin_amdgcn_cvt_pk_fp8_f32(o[2], o[3], lo, true);
                int hi = __builtin_amdgcn_cvt_pk_fp8_f32(o[4], o[5], 0, false); hi = __builtin_amdgcn_cvt_pk_fp8_f32(o[6], o[7], hi, true);
                if (r < u.aux1) *(u32x2*)(base + (size_t)r * FF) = (u32x2){(unsigned)lo, (unsigned)hi}; }
    }
};
struct MoeSched2 {
    const LAS unsigned* tab; int t0, ntiles, nsh, G, c;
    __device__ __forceinline__ bool next(int i, Unit& u) const {
        const int L = i * G + c; if (L >= nsh + 4 * ntiles) return false;
        u.pn = L & 3;
        if (L < nsh) { u.pm = L >> 2; u.aux0 = (u.pm * 256) | (64 << 20); u.aux1 = 256; }
        else { const int t = t0 + ((L - nsh) >> 2); u.pm = t; u.aux0 = __builtin_amdgcn_readfirstlane((int)tab[2 * t]); u.aux1 = __builtin_amdgcn_readfirstlane((int)tab[2 * t + 1]); }
        return true;
    }
};
struct MoeSrc2 {
    static constexpr int ESZ = 1; static constexpr bool GATHER = false;
    const unsigned char* ws;
    __device__ __forceinline__ const char* a_base(const Unit& u) const { return (const char*)ws + ((u.aux0 >> 20) == 64 ? WS_ACTS : WS_ACT) + (size_t)(u.aux0 & 0xFFFFF) * 256; }
    __device__ __forceinline__ const char* b_base(const Unit& u) const { const int e = u.aux0 >> 20;
        const size_t off = (e == 64 ? WS_WSH2 : WS_W2T + (size_t)e * 1024 * 256) + (size_t)u.pn * 256 * 256; return (const char*)ws + off; }
    __device__ __forceinline__ unsigned a_off(const Unit&, int R, int C) const { return (unsigned)(R * 256) + (unsigned)C * 2u; }
};
constexpr float SLOT_SCALE = 16.0f;
constexpr int NSLOT = 9;
struct EpiMoe2 {
    static constexpr bool PERM = true;
    unsigned char* ws; float* X1; int tokbase;
    __device__ __forceinline__ void operator()(AccRef acc, const Unit& u, int wr, int wc, int fr, int fq) const {
        asm volatile("" : "+v"(fr), "+v"(fq));
        const int e = u.aux0 >> 20, pos0 = u.aux0 & 0xFFFFF; const int col0 = u.pn * 256 + wc * 32 + 8 * fq;
        if (e == 64) {
#pragma unroll
            for (int ai = 0; ai < 2; ++ai)
#pragma unroll
                for (int m = 0; m < 4; ++m) { unsigned char* rowp = (unsigned char*)(ws + WS_SLOT) + ((size_t)(pos0 + ai * 128 + wr * 64 + m * 16 + fr) * NSLOT + 8) * D + u.pn * 256 + wc * 64 + fq * 16;
                    u32x4 o;
#pragma unroll
                    for (int bj = 0; bj < 2; ++bj) { const f32x4 v0 = acc[ai][bj][m][0] * (SLOT_SCALE / (ACT_S8 * WSCALE8)), v1 = acc[ai][bj][m][1] * (SLOT_SCALE / (ACT_S8 * WSCALE8));
                        int lo = __builtin_amdgcn_cvt_pk_fp8_f32(v0[0], v0[1], 0, false); lo = __builtin_amdgcn_cvt_pk_fp8_f32(v0[2], v0[3], lo, true);
                        int hi = __builtin_amdgcn_cvt_pk_fp8_f32(v1[0], v1[1], 0, false); hi = __builtin_amdgcn_cvt_pk_fp8_f32(v1[2], v1[3], hi, true);
                        if (bj == 0) { o.x = (unsigned)lo; o.y = (unsigned)hi; } else { o.z = (unsigned)lo; o.w = (unsigned)hi; } }
                    *(u32x4*)rowp = o;
                    asm volatile("" ::: "memory"); }
        } else {
#pragma unroll
            for (int ai = 0; ai < 2; ++ai)
#pragma unroll
                for (int m = 0; m < 4; ++m) { const int r = ai * 128 + wr * 64 + m * 16 + fr;
                    if (r < u.aux1) { const int tk = ((const int*)(ws + WS_STOK))[pos0 + r]; const float w = ((const float*)(ws + WS_SW))[pos0 + r] * (SLOT_SCALE / (ACT_S8 * WSCALE8));
                        unsigned char* rowp = (unsigned char*)(ws + WS_SLOT) + ((size_t)(tk >> 3) * NSLOT + (tk & 7)) * D + u.pn * 256 + wc * 64 + fq * 16;
                        u32x4 o;
#pragma unroll
                        for (int bj = 0; bj < 2; ++bj) { const f32x4 v0 = acc[ai][bj][m][0] * w, v1 = acc[ai][bj][m][1] * w;
                            int lo = __builtin_amdgcn_cvt_pk_fp8_f32(v0[0], v0[1], 0, false); lo = __builtin_amdgcn_cvt_pk_fp8_f32(v0[2], v0[3], lo, true);
                            int hi = __builtin_amdgcn_cvt_pk_fp8_f32(v1[0], v1[1], 0, false); hi = __builtin_amdgcn_cvt_pk_fp8_f32(v1[2], v1[3], hi, true);
                            if (bj == 0) { o.x = (unsigned)lo; o.y = (unsigned)hi; } else { o.z = (unsigned)lo; o.w = (unsigned)hi; } }
                        *(u32x4*)rowp = o; }
                    asm volatile("" ::: "memory"); }
        }
    }
};
__device__ __forceinline__ unsigned ord_key(float x) { const unsigned b = __float_as_uint(x); return (b & 0x80000000u) ? ~b : (b | 0x80000000u); }

__device__ __forceinline__ void idx_glds16(const void* gsrc, unsigned lds_dst) { unsigned keep;
    asm volatile("s_mov_b32 %0, m0\n\ts_mov_b32 m0, %2\n\ts_nop 0\n\tglobal_load_lds_dwordx4 %1, off\n\ts_mov_b32 m0, %0" : "=&s"(keep) : "v"(gsrc), "s"(lds_dst) : "memory"); }

__device__ __forceinline__ void indexer_unit(const Args& args, Frame& F, int b, int q0) {
    const bf16_t* Z = (const bf16_t*)(F.ws + WS_Z) + (size_t)b * SEQ * ZW;
    unsigned* SELM = (unsigned*)(F.ws + WS_SEL) + (size_t)b * SEQ * 128;
    int tid = F.tid; asm volatile("" : "+v"(tid));
    const int lane = tid & 63, kl = lane & 31, hl = lane >> 5, w = F.wave;
    const int qa = q0 + 2 * w;
    const int myq = qa + hl;
    bf16x8 A0, A1;
    { const int aq = (kl >> 2) & 1, ah = 4 * (kl >> 3) + (kl & 3);
      const bf16_t* p = Z + (size_t)(qa + aq) * ZW + ZIQ + ah * 32 + 8 * hl;
      A0 = *(const bf16x8*)p; A1 = *(const bf16x8*)(p + 16); }
    float wq[16];
    { const bf16_t* p = Z + (size_t)myq * ZW + ZIW; const u32x4 a = *(const u32x4*)p, c = *(const u32x4*)(p + 8);
      wq[0] = bf_lo(a.x); wq[1] = bf_hi(a.x); wq[2] = bf_lo(a.y); wq[3] = bf_hi(a.y); wq[4] = bf_lo(a.z); wq[5] = bf_hi(a.z); wq[6] = bf_lo(a.w); wq[7] = bf_hi(a.w);
      wq[8] = bf_lo(c.x); wq[9] = bf_hi(c.x); wq[10] = bf_lo(c.y); wq[11] = bf_hi(c.y); wq[12] = bf_lo(c.z); wq[13] = bf_hi(c.z); wq[14] = bf_lo(c.w); wq[15] = bf_hi(c.w); }
    unsigned key[128];
    const int nchunk = (q0 + 15) / 1024 + 1;
    const unsigned idx_lds0 = (unsigned)(uintptr_t)F.lds;
#define IDX_LOAD(ch, buf) do { _Pragma("unroll") for (int _i = 0; _i < 8; ++_i) { const int kg_ = w * 8 + _i; const int key_ = 16 * kg_ + (lane >> 2); \
        idx_glds16(Z + (size_t)((ch) * 1024 + key_) * ZW + ZIK + 8 * ((lane & 3) ^ ((key_ >> 2) & 3)), (unsigned)__builtin_amdgcn_readfirstlane((int)(idx_lds0 + (buf) * 65536 + kg_ * 1024))); } } while (0)
    IDX_LOAD(0, 0);
    asm volatile("s_waitcnt vmcnt(0)" ::: "memory");
    __syncthreads();
#pragma unroll
    for (int ch = 0; ch < 4; ++ch) {
        if (ch < nchunk) {
            if (ch + 1 < nchunk) IDX_LOAD(ch + 1, (ch + 1) & 1);
            LAS unsigned char* kbl = F.lds + (ch & 1) * 65536 + kl * 64 + ((hl ^ ((kl >> 2) & 3)) * 16); asm volatile("" : "+v"(kbl));
            LAS unsigned char* kbl2 = F.lds + (ch & 1) * 65536 + kl * 64 + (((hl + 2) ^ ((kl >> 2) & 3)) * 16); asm volatile("" : "+v"(kbl2));
#pragma unroll
            for (int tt = 0; tt < 32; tt += 2) {
                const int t = ch * 32 + tt;
                if (32 * t <= qa + 1) {
                    bf16x8 B0[2], B1[2]; f32x16 acc[2];
#pragma unroll
                    for (int j = 0; j < 2; ++j) { B0[j] = *(const LAS bf16x8*)(kbl + 2048 * (tt + j)); B1[j] = *(const LAS bf16x8*)(kbl2 + 2048 * (tt + j)); }
#pragma unroll
                    for (int j = 0; j < 2; ++j) { acc[j] = f32x16{}; acc[j] = __builtin_amdgcn_mfma_f32_32x32x16_bf16(A0, B0[j], acc[j], 0, 0, 0); }
#pragma unroll
                    for (int j = 0; j < 2; ++j) acc[j] = __builtin_amdgcn_mfma_f32_32x32x16_bf16(A1, B1[j], acc[j], 0, 0, 0);
#pragma unroll
                    for (int j = 0; j < 2; ++j) { float s = 0.f;
#pragma unroll
                        for (int i = 0; i < 16; ++i) { const float av_ = acc[j][i]; const int xb_ = __float_as_int(av_); s += __int_as_float(xb_ > 0 ? xb_ : 0) * wq[i]; }
                        key[t + j] = (32 * (t + j) + kl <= myq) ? ord_key(s) : 0u; }
                } else {
#pragma unroll
                    for (int j = 0; j < 2; ++j) key[t + j] = 0u;
                }
            }
            asm volatile("s_waitcnt vmcnt(0)" ::: "memory");
            __syncthreads();
        } else {
#pragma unroll
            for (int tt = 0; tt < 32; ++tt) key[ch * 32 + tt] = 0u;
        }
    }
#undef IDX_LOAD
#pragma unroll
    for (int w = 0; w < 4; ++w) {
        if (1024 * w <= qa + 1) {
#pragma unroll
            for (int k = 0; k < 16; ++k) { const unsigned lo = key[32 * w + k], hi_ = key[32 * w + k + 16];
                key[32 * w + k] = __builtin_amdgcn_perm(hi_, lo, 0x05040100u); key[32 * w + k + 16] = __builtin_amdgcn_perm(hi_, lo, 0x07060302u); }
#pragma unroll
            for (int k = 0; k < 32; ++k) if (!(k & 8)) { const unsigned lo = key[32 * w + k], hi_ = key[32 * w + k + 8];
                key[32 * w + k] = __builtin_amdgcn_perm(hi_, lo, 0x06020400u); key[32 * w + k + 8] = __builtin_amdgcn_perm(hi_, lo, 0x07030501u); }
#pragma unroll
            for (int k = 0; k < 32; ++k) if (!(k & 4)) { const unsigned lo = key[32 * w + k], hi_ = key[32 * w + k + 4]; const unsigned m = 0x0F0F0F0Fu;
                key[32 * w + k] = (lo & m) | ((hi_ << 4) & ~m); key[32 * w + k + 4] = ((lo >> 4) & m) | (hi_ & ~m); }
#pragma unroll
            for (int k = 0; k < 32; ++k) if (!(k & 2)) { const unsigned lo = key[32 * w + k], hi_ = key[32 * w + k + 2]; const unsigned m = 0x33333333u;
                key[32 * w + k] = (lo & m) | ((hi_ << 2) & ~m); key[32 * w + k + 2] = ((lo >> 2) & m) | (hi_ & ~m); }
#pragma unroll
            for (int k = 0; k < 32; ++k) if (!(k & 1)) { const unsigned lo = key[32 * w + k], hi_ = key[32 * w + k + 1]; const unsigned m = 0x55555555u;
                key[32 * w + k] = (lo & m) | ((hi_ << 1) & ~m); key[32 * w + k + 1] = ((lo >> 1) & m) | (hi_ & ~m); }
        }
    }
    unsigned Al[4] = {~0u, ~0u, ~0u, ~0u}, Gt[4] = {0u, 0u, 0u, 0u};
    int ab0 = 0, ab1 = 0; unsigned T0 = 0u, T1 = 0u; bool dn0 = false, dn1 = false;
#define IDX_DPP(v, ctrl) __builtin_amdgcn_update_dpp(0, (v), (ctrl), 0xF, 0xF, true)
#pragma unroll
    for (int bit = 31; bit >= 0; --bit) {
        unsigned S_[4]; int c = 0;
#pragma unroll
        for (int w = 0; w < 4; ++w) { S_[w] = Al[w] & key[32 * w + bit]; c += __builtin_popcount(S_[w]); }
        c += IDX_DPP(c, 0xB1); c += IDX_DPP(c, 0x4E); c += IDX_DPP(c, 0x141); c += IDX_DPP(c, 0x140);
        const int cn0 = ab0 + __builtin_amdgcn_readlane(c, 0) + __builtin_amdgcn_readlane(c, 16), cn1 = ab1 + __builtin_amdgcn_readlane(c, 32) + __builtin_amdgcn_readlane(c, 48);
        const bool t0 = cn0 >= 256, t1 = cn1 >= 256;
        if (t0) { T0 |= 1u << bit; dn0 = dn0 || cn0 == 256; } else ab0 = cn0;
        if (t1) { T1 |= 1u << bit; dn1 = dn1 || cn1 == 256; } else ab1 = cn1;
        const unsigned nm = hl ? (t1 ? 0u : ~0u) : (t0 ? 0u : ~0u);
#pragma unroll
        for (int w = 0; w < 4; ++w) { Al[w] &= key[32 * w + bit] ^ nm; Gt[w] |= S_[w] & nm; }
        if (dn0 && dn1) break;
    }
#undef IDX_DPP
    unsigned x[4];
    { const bool nz = hl ? (T1 != 0u) : (T0 != 0u);
#pragma unroll
      for (int w = 0; w < 4; ++w) x[w] = Gt[w] | (nz ? Al[w] : 0u); }
#define IDX_BFLY(d, m) do { const bool up_ = (kl & (d)) != 0; const unsigned km_ = up_ ? ~(m) : (m); const unsigned am_ = up_ ? (unsigned)(d) : 32u - (d); \
        _Pragma("unroll") for (int w = 0; w < 4; ++w) { const unsigned t_ = (unsigned)__builtin_amdgcn_ds_swizzle((int)x[w], 0x1F | ((d) << 10)); \
            const unsigned rot_ = __builtin_amdgcn_alignbit(t_, t_, am_); x[w] = (x[w] & km_) | (rot_ & ~km_); } } while (0)
    IDX_BFLY(16, 0x0000FFFFu); IDX_BFLY(8, 0x00FF00FFu); IDX_BFLY(4, 0x0F0F0F0Fu); IDX_BFLY(2, 0x33333333u); IDX_BFLY(1, 0x55555555u);
#undef IDX_BFLY
#pragma unroll
    for (int j = 0; j < 4; ++j) SELM[(size_t)myq * 128 + kl + 32 * j] = x[j];
}

__device__ __forceinline__ void indexer_phase(const Args& args, Frame& F) {
    const int c = blockIdx.x;
    for (int i = 0; i < 8; ++i) {
        for (int u = c + i * F.G; u < 2048 && i < 8; u += 2048) {
            const int b = u >> 8, pos = u & 255, blk = (b & 1) ? 255 - pos : pos;
            indexer_unit(args, F, b, blk * 16);
        }
    }
}
namespace att {
constexpr int DM = ZW, QB = 256, KVB = 64, SLOTB = 8192;
constexpr int NS = 4;
constexpr int L_K = 0, L_V = NS * SLOTB, L_MASK = 2 * NS * SLOTB, L_WSF = L_MASK + 8 * 2048, L_OST = L_WSF + 8 * 256, L_BT = L_OST + 8 * 4096, L_MT = L_BT + 512, L_BT4 = L_MT + 128, L_END = L_BT4 + 4 * 1280;
static_assert(L_END <= RING_BYTES, "attention LDS");
__device__ __forceinline__ int crow(int r, int hi) { return (r & 3) + 8 * (r >> 2) + 4 * hi; }
__device__ __forceinline__ void glds16(const void* gsrc, unsigned lds_dst) { unsigned keep;
    asm volatile("s_mov_b32 %0, m0\n\ts_mov_b32 m0, %2\n\ts_nop 0\n\tglobal_load_lds_dwordx4 %1, off\n\ts_mov_b32 m0, %0" : "=&s"(keep) : "v"(gsrc), "s"(lds_dst) : "memory"); }
__device__ __forceinline__ unsigned cvtpk(float lo, float hi) { return cvt_pk_bf16(lo, hi); }
typedef short s16x4 __attribute__((ext_vector_type(4)));

#ifdef PROBE_CYC
#define CYC_DECL unsigned cyc_t0_ = 0, cyc_a_ = 0; asm volatile("" : "+v"(cyc_t0_), "+v"(cyc_a_)); const bool cyc_on_ = (F.vcu == PROBE_CYC_WG) && (F.wave == PROBE_CYC_WAVE)
#define CYC_START() do { unsigned n_ = (unsigned)__builtin_readcyclecounter(); asm volatile("" : "+v"(n_)); cyc_t0_ = n_; } while (0)
#define CYC_MARK(k_) do { unsigned n_ = (unsigned)__builtin_readcyclecounter(); asm volatile("" : "+v"(n_)); if ((k_) == PROBE_CYC_SEL) cyc_a_ += n_ - cyc_t0_; cyc_t0_ = n_; } while (0)
#define CYC_FLUSH() do { if (cyc_on_ && F.lane == 0) atomicAdd(F.ctl + CW_Q + 64, cyc_a_); } while (0)
#else
#define CYC_DECL
#define CYC_START()
#define CYC_MARK(k_)
#define CYC_FLUSH()
#endif
__device__ __forceinline__ void attn_unit(const Args& args, Frame& F, int b, int h, int qb) {
    const int lane = F.lane, r32 = lane & 31, hi = lane >> 5, wid = F.wave;
    CYC_DECL;
#ifndef PROBE_ATT_VAR
#define PROBE_ATT_VAR 0
#endif
    const bool alt_ = (PROBE_ATT_VAR != 0) && (args.li == 1);
#define ALT(bit_) (alt_ && ((PROBE_ATT_VAR) & (bit_)))
    const bf16_t* Zb = (const bf16_t*)(F.ws + WS_Z) + (size_t)b * SEQ * DM;
    const int q0 = qb * QB;
    const bf16_t* Qw = Zb + (size_t)(q0 + wid * 32) * DM + ZQ + h * 64;
    const bf16_t* Kh = Zb + ZK + h * 64; const bf16_t* Vh = Zb + ZV + h * 64;
    LAS unsigned char* shm = F.lds;
    const unsigned lds0 = (unsigned)(uintptr_t)shm;
    LAS float* wsf = (LAS float*)(shm + L_WSF) + wid * 64;
    LAS float* bt = (LAS float*)(shm + L_BT);
    if (F.tid >= 128 && F.tid < 144) { const unsigned n = F.tid - 128;
        *(LAS u32x2*)(shm + L_MT + 8 * n) = (u32x2){((n & 1u) ? 0xFFFFu : 0u) | ((n & 2u) ? 0xFFFF0000u : 0u), ((n & 4u) ? 0xFFFFu : 0u) | ((n & 8u) ? 0xFFFF0000u : 0u)}; }
    if (F.tid < 128) { const int rel = F.tid; int bk;
        if (rel < 16) bk = rel; else { bk = 16 + (int)(logf((float)rel / 16.0f) / logf(8.0f) * 16.0f); bk = bk < 31 ? bk : 31; }
        bt[rel] = (AIN(6)[bk * 8 + h] - AIN(6)[31 * 8 + h]) * 1.4426950408889634f; }
    for (int e = F.tid; e < 4 * 320; e += NTHR) { const int s_ = e / 320, i_ = e - 320 * s_; int rel = i_ - 96 + s_; rel = rel < 0 ? 0 : (rel > 127 ? 127 : rel); int bk;
        if (rel < 16) bk = rel; else { bk = 16 + (int)(logf((float)rel / 16.0f) / logf(8.0f) * 16.0f); bk = bk < 31 ? bk : 31; }
        ((LAS float*)(shm + L_BT4))[e] = (AIN(6)[bk * 8 + h] - AIN(6)[31 * 8 + h]) * 1.4426950408889634f; }
    const bf16_t* ksrc = Kh + (size_t)lane * DM + wid * 8;
    const bf16_t* vsrc = Vh + (size_t)(16 * (wid & 3) + (lane >> 2)) * DM + (wid >> 2) * 32 + (lane & 3) * 8;
    const unsigned kdst = lds0 + L_K + wid * 1024, vdst = lds0 + L_V + wid * 1024;
    const unsigned* SELM = (const unsigned*)(F.ws + WS_SEL) + (size_t)(b * SEQ + q0 + wid * 32 + r32) * 128 + 4 * hi;
    const unsigned mdst = lds0 + L_MASK + wid * 2048;
#define DMA_K(t, slot) glds16(ksrc + (size_t)(t) * KVB * DM, (unsigned)__builtin_amdgcn_readfirstlane(kdst + (slot) * SLOTB))
#define DMA_V(t, slot) glds16(vsrc + (size_t)(t) * KVB * DM, (unsigned)__builtin_amdgcn_readfirstlane(vdst + (slot) * SLOTB))
#define DMA_M(g) glds16(SELM + 8 * (g), (unsigned)__builtin_amdgcn_readfirstlane(mdst + ((g) & 1) * 1024))
    const int NT = ALT(1024) ? 4 : (q0 + QB) / KVB;
    bf16x8 qr[4];
#pragma unroll
    for (int d0 = 0; d0 < 4; ++d0) qr[d0] = *(const bf16x8*)(Qw + (size_t)r32 * DM + d0 * 16 + hi * 8);
    asm volatile("s_waitcnt vmcnt(0)" ::: "memory");
    __syncthreads();
    DMA_M(0); DMA_K(0, 0); DMA_K(1, 1); DMA_V(0, 0); DMA_K(2, 2); DMA_V(1, 1); DMA_K(3, 3); DMA_V(2, 2);
    float m_run = 0.f; f32x16 o[2], lacc = f32x16{}; o[0] = f32x16{}; o[1] = f32x16{};
    const bf16x8 ones8 = __builtin_bit_cast(bf16x8, (u32x4){0x3F803F80u, 0x3F803F80u, 0x3F803F80u, 0x3F803F80u});
    const int qpos = q0 + wid * 32 + r32;
    const int vb0 = (int)(lds0 + L_V) + ((lane >> 4) & 1) * 32 + (lane & 3) * 8 + (4 * hi + ((lane & 15) >> 2)) * 64;
#define QK_TILE(P0, P1, slot_) do { const LAS unsigned char* kb = shm + L_K + (slot_) * SLOTB + hi * 1024 + r32 * 16; P0 = f32x16{}; P1 = f32x16{}; \
        _Pragma("unroll") for (int d0 = 0; d0 < 4; ++d0) { const bf16x8 b0 = *(const LAS bf16x8*)(kb + d0 * 2048); const bf16x8 b1 = *(const LAS bf16x8*)(kb + d0 * 2048 + 512); \
            P0 = __builtin_amdgcn_mfma_f32_32x32x16_bf16(b0, qr[d0], P0, 0, 0, 0); P1 = __builtin_amdgcn_mfma_f32_32x32x16_bf16(b1, qr[d0], P1, 0, 0, 0); } } while (0)
    f32x16 pa0, pa1, pb0, pb1;
    asm volatile("s_waitcnt vmcnt(6)" ::: "memory");
    __builtin_amdgcn_s_barrier(); asm volatile("" ::: "memory");
    QK_TILE(pa0, pa1, 0);
#define ATT_WAITV(n_) do { const int nn_ = (n_); if (nn_ >= 4) asm volatile("s_waitcnt vmcnt(4)" ::: "memory"); else if (nn_ == 3) asm volatile("s_waitcnt vmcnt(3)" ::: "memory"); \
        else if (nn_ == 2) asm volatile("s_waitcnt vmcnt(2)" ::: "memory"); else if (nn_ == 1) asm volatile("s_waitcnt vmcnt(1)" ::: "memory"); else asm volatile("s_waitcnt vmcnt(0)" ::: "memory"); } while (0)
    asm volatile("s_waitcnt lgkmcnt(0)" ::: "memory");
    if (wid >= 4) { __builtin_amdgcn_s_barrier(); asm volatile("" ::: "memory"); }
    auto step = [&](const int t, f32x16& C0, f32x16& C1, f32x16& N0, f32x16& N1) __attribute__((always_inline)) {
        const int slot = t & (NS - 1), g = t >> 2, tq = t & 3;
        CYC_START();
        if (!ALT(32)) ATT_WAITV((t + 1 < NT) + 2 * (t + 2 < NT) + (t + 3 < NT));
        if (!ALT(16)) __builtin_amdgcn_s_barrier(); asm volatile("" ::: "memory");
        CYC_MARK(0);
        if (t + 4 < NT && !ALT(32)) DMA_K(t + 4, (t + 4) & (NS - 1));
        if (tq == 0 && !ALT(32)) DMA_M(g + 1);
        if (t + 1 < NT) { if (ALT(4)) { N0 = f32x16{}; N1 = f32x16{}; } else QK_TILE(N0, N1, (t + 1) & (NS - 1)); }
        __builtin_amdgcn_sched_barrier(0);
        const u32x2 mwv = *(const LAS u32x2*)(shm + L_MASK + wid * 2048 + (g & 1) * 1024 + (tq >> 1) * 512 + r32 * 16 + (tq & 1) * 8);
        if (64 * t + 63 + 112 >= q0 + wid * 32 && 64 * t <= q0 + wid * 32 + 31 && !ALT(256)) {
            const int ib_ = qpos - 64 * t - 4 * hi - 3 + 96;
#pragma unroll
            for (int g4 = 0; g4 < 4; ++g4) { const int i0 = ib_ - 8 * g4, i1 = i0 - 32;
                const f32x4 e0 = *(const LAS f32x4*)(shm + L_BT4 + (i0 & 3) * 1280 + (i0 & ~3) * 4), e1 = *(const LAS f32x4*)(shm + L_BT4 + (i1 & 3) * 1280 + (i1 & ~3) * 4);
                C0[4 * g4 + 3] += e0.x; C0[4 * g4 + 2] += e0.y; C0[4 * g4 + 1] += e0.z; C0[4 * g4] += e0.w;
                C1[4 * g4 + 3] += e1.x; C1[4 * g4 + 2] += e1.y; C1[4 * g4 + 1] += e1.z; C1[4 * g4] += e1.w; }
        }
        if (!ALT(128)) {
        typedef float f32x2_ __attribute__((ext_vector_type(2)));
        { const f32x2_ mm = {m_run, m_run};
#pragma unroll
          for (int r = 0; r < 16; r += 2) { f32x2_ a = {C0[r], C0[r + 1]}, c = {C1[r], C1[r + 1]}; a -= mm; c -= mm; C0[r] = a.x; C0[r + 1] = a.y; C1[r] = c.x; C1[r + 1] = c.y; } }
        float rm = __builtin_fmaxf(C0[0], C1[0]);
#pragma unroll
        for (int r = 1; r < 16; ++r) rm = __builtin_fmaxf(rm, __builtin_fmaxf(C0[r], C1[r]));
        if (t == 0 || __builtin_amdgcn_ballot_w64(rm > 8.0f) != 0ull) {
            rm = __builtin_fmaxf(rm, __shfl_xor(rm, 32));
            const float dm = t == 0 ? rm : __builtin_fmaxf(rm, 0.f);
            const float f = t == 0 ? 1.0f : __builtin_amdgcn_exp2f(-dm);
            m_run += dm;
#pragma unroll
            for (int r = 0; r < 16; ++r) { C0[r] -= dm; C1[r] -= dm; }
            if (hi == 0) wsf[r32] = f;
            asm volatile("s_waitcnt lgkmcnt(0)" ::: "memory");
#pragma unroll
            for (int r = 0; r < 16; ++r) { const float fr_ = wsf[crow(r, hi)]; o[0][r] *= fr_; o[1][r] *= fr_; lacc[r] *= fr_; }
        }
        }
        if (!ALT(2)) {
#pragma unroll
        for (int r = 0; r < 16; ++r) { C0[r] = __builtin_amdgcn_exp2f(C0[r]); C1[r] = __builtin_amdgcn_exp2f(C1[r]); } }
        asm volatile("s_waitcnt lgkmcnt(0)" ::: "memory");
        CYC_MARK(1);
        if (!ALT(32)) ATT_WAITV((t + 1 < NT) + (t + 2 < NT) + (t + 3 < NT) + (t + 4 < NT));
        if (!ALT(16)) __builtin_amdgcn_s_barrier(); asm volatile("" ::: "memory");
        CYC_MARK(2);
        if (t + 3 < NT && !ALT(32)) DMA_V(t + 3, (t + 3) & (NS - 1));
        u32x4 pw0, pw1, pw2, pw3;
        pw0 = (u32x4){cvtpk(C0[0], C0[1]), cvtpk(C0[2], C0[3]), cvtpk(C0[4], C0[5]), cvtpk(C0[6], C0[7])};
        pw1 = (u32x4){cvtpk(C0[8], C0[9]), cvtpk(C0[10], C0[11]), cvtpk(C0[12], C0[13]), cvtpk(C0[14], C0[15])};
        pw2 = (u32x4){cvtpk(C1[0], C1[1]), cvtpk(C1[2], C1[3]), cvtpk(C1[4], C1[5]), cvtpk(C1[6], C1[7])};
        pw3 = (u32x4){cvtpk(C1[8], C1[9]), cvtpk(C1[10], C1[11]), cvtpk(C1[12], C1[13]), cvtpk(C1[14], C1[15])};
        if (!ALT(64))
        { const unsigned mx_ = mwv.x >> (4 * hi), my_ = mwv.y >> (4 * hi); const LAS unsigned char* mt = shm + L_MT;
          const u32x2 a0 = *(const LAS u32x2*)(mt + ((mx_ << 3) & 0x78u)), a1 = *(const LAS u32x2*)(mt + ((mx_ >> 5) & 0x78u)), a2 = *(const LAS u32x2*)(mt + ((mx_ >> 13) & 0x78u)), a3 = *(const LAS u32x2*)(mt + ((mx_ >> 21) & 0x78u));
          const u32x2 b0 = *(const LAS u32x2*)(mt + ((my_ << 3) & 0x78u)), b1 = *(const LAS u32x2*)(mt + ((my_ >> 5) & 0x78u)), b2 = *(const LAS u32x2*)(mt + ((my_ >> 13) & 0x78u)), b3 = *(const LAS u32x2*)(mt + ((my_ >> 21) & 0x78u));
          pw0.x &= a0.x; pw0.y &= a0.y; pw0.z &= a1.x; pw0.w &= a1.y; pw1.x &= a2.x; pw1.y &= a2.y; pw1.z &= a3.x; pw1.w &= a3.y;
          pw2.x &= b0.x; pw2.y &= b0.y; pw2.z &= b1.x; pw2.w &= b1.y; pw3.x &= b2.x; pw3.y &= b2.y; pw3.z &= b3.x; pw3.w &= b3.y; }
        if (!ALT(8)) {
        lacc = __builtin_amdgcn_mfma_f32_32x32x16_bf16(__builtin_bit_cast(bf16x8, pw0), ones8, lacc, 0, 0, 0); lacc = __builtin_amdgcn_mfma_f32_32x32x16_bf16(__builtin_bit_cast(bf16x8, pw1), ones8, lacc, 0, 0, 0);
        lacc = __builtin_amdgcn_mfma_f32_32x32x16_bf16(__builtin_bit_cast(bf16x8, pw2), ones8, lacc, 0, 0, 0); lacc = __builtin_amdgcn_mfma_f32_32x32x16_bf16(__builtin_bit_cast(bf16x8, pw3), ones8, lacc, 0, 0, 0);
        { const int vb = vb0 + slot * SLOTB;
#pragma unroll
          for (int d0 = 0; d0 < 2; ++d0) { s16x4 lo[4], hh[4];
#pragma unroll
              for (int ks = 0; ks < 4; ++ks) {
                  asm volatile("ds_read_b64_tr_b16 %0,%1 offset:%c2" : "=&v"(lo[ks]) : "v"(vb), "i"(d0 * 4096 + ks * 1024) : "memory");
                  asm volatile("ds_read_b64_tr_b16 %0,%1 offset:%c2" : "=&v"(hh[ks]) : "v"(vb), "i"(d0 * 4096 + ks * 1024 + 512) : "memory"); }
              asm volatile("s_waitcnt lgkmcnt(0)" ::: "memory"); __builtin_amdgcn_sched_barrier(0);
#define PKV(k) (bf16x8){lo[k][0], lo[k][1], lo[k][2], lo[k][3], hh[k][0], hh[k][1], hh[k][2], hh[k][3]}
              o[d0] = __builtin_amdgcn_mfma_f32_32x32x16_bf16(__builtin_bit_cast(bf16x8, pw0), PKV(0), o[d0], 0, 0, 0);
              o[d0] = __builtin_amdgcn_mfma_f32_32x32x16_bf16(__builtin_bit_cast(bf16x8, pw1), PKV(1), o[d0], 0, 0, 0);
              o[d0] = __builtin_amdgcn_mfma_f32_32x32x16_bf16(__builtin_bit_cast(bf16x8, pw2), PKV(2), o[d0], 0, 0, 0);
              o[d0] = __builtin_amdgcn_mfma_f32_32x32x16_bf16(__builtin_bit_cast(bf16x8, pw3), PKV(3), o[d0], 0, 0, 0);
#undef PKV
          } }
        }
        asm volatile("s_waitcnt lgkmcnt(0)" ::: "memory");
        CYC_MARK(3);
    };
    for (int t = 0; t < NT; t += 2) { step(t, pa0, pa1, pb0, pb1); step(t + 1, pb0, pb1, pa0, pa1); }
    if (wid < 4) { __builtin_amdgcn_s_barrier(); asm volatile("" ::: "memory"); }
#undef QK_TILE
#undef ATT_WAITV
    CYC_FLUSH();
    bf16_t* Ow = (bf16_t*)(F.ws + (alt_ ? WS_R2 : WS_R1)) + (size_t)(b * SEQ + q0 + wid * 32) * 512 + h * 64;
    { LAS bf16_t* stg = (LAS bf16_t*)(shm + L_OST) + wid * 2048;
#pragma unroll
      for (int r = 0; r < 16; ++r) { const int orow = crow(r, hi); const float rl = __builtin_amdgcn_rcpf(lacc[r]);
#pragma unroll
          for (int d0 = 0; d0 < 2; ++d0) stg[orow * 64 + d0 * 32 + r32] = (bf16_t)f2bf(o[d0][r] * rl); }
      asm volatile("s_waitcnt lgkmcnt(0)" ::: "memory");
#pragma unroll
      for (int i = 0; i < 4; ++i) { const int row = i * 8 + (lane >> 3), chn = lane & 7; const u32x4 v = *(const LAS u32x4*)(stg + row * 64 + chn * 8); *(u32x4*)(Ow + (size_t)row * 512 + chn * 8) = v; } }
    asm volatile("s_waitcnt lgkmcnt(0)" ::: "memory");
#undef DMA_K
#undef DMA_V
#undef DMA_M
}

__device__ __forceinline__ void attn_phase(const Args& args, Frame& F) {
    const int v = F.vcu;
    for (int i = 0; i < 4; ++i) {
        for (int uu = v; uu < 256; uu += F.G) {
            const int bh = uu >> 2, s = uu & 3; const int qb = (i == 0) ? s : (i == 1) ? 7 - s : (i == 2) ? 8 + s : 15 - s;
            attn_unit(args, F, bh >> 3, bh & 7, qb);
        }
    }
}
}
#ifndef PROBE_NO_STATE
#define PROBE_NO_STATE 0
#endif
#ifndef PROBE_TINV_ID
#define PROBE_TINV_ID 0
#endif
namespace rk {
typedef __bf16 bf16x2_t __attribute__((ext_vector_type(2)));
__device__ __forceinline__ unsigned cvtpk(float lo, float hi) { f32x2 v = {lo, hi}; bf16x2_t b = __builtin_convertvector(v, bf16x2_t); return __builtin_bit_cast(unsigned, b); }
template <int S> __device__ __forceinline__ bf16x8 frag(const f32x16& x) {
    u32x4 o; o.x = cvtpk(x[8 * S + 0], x[8 * S + 1]); o.y = cvtpk(x[8 * S + 2], x[8 * S + 3]); o.z = cvtpk(x[8 * S + 4], x[8 * S + 5]); o.w = cvtpk(x[8 * S + 6], x[8 * S + 7]);
    return __builtin_bit_cast(bf16x8, o); }
template <int S> __device__ __forceinline__ void unfrag(f32x16& x, bf16x8 f) { const u32x4 o = __builtin_bit_cast(u32x4, f);
    x[8 * S + 0] = bf_lo(o.x); x[8 * S + 1] = bf_hi(o.x); x[8 * S + 2] = bf_lo(o.y); x[8 * S + 3] = bf_hi(o.y); x[8 * S + 4] = bf_lo(o.z); x[8 * S + 5] = bf_hi(o.z); x[8 * S + 6] = bf_lo(o.w); x[8 * S + 7] = bf_hi(o.w); }
#define RK_MF(a, b, c) __builtin_amdgcn_mfma_f32_32x32x16_bf16((a), (b), (c), 0, 0, 0)
__device__ __forceinline__ float dppf(float v, const int ctrl_is_const_dummy);
#define RK_DPP(v, ctrl, rmask, bc) __builtin_bit_cast(float, __builtin_amdgcn_update_dpp(0, __builtin_bit_cast(int, (v)), (ctrl), (rmask), 0xF, (bc)))
__device__ __forceinline__ float scan32(float v) {
#ifdef PROBE_SHFL_SCAN
    const int l32 = threadIdx.x & 31;
#pragma unroll
    for (int o = 1; o < 32; o <<= 1) { const float t = __shfl_up(v, o, 32); if (l32 >= o) v += t; }
    return v;
#endif
    v += RK_DPP(v, 0x111, 0xF, true); v += RK_DPP(v, 0x112, 0xF, true); v += RK_DPP(v, 0x114, 0xF, true); v += RK_DPP(v, 0x118, 0xF, true);
    v += RK_DPP(v, 0x142, 0xA, false);
    return v; }
__device__ __forceinline__ float ex2(float x) { return __builtin_amdgcn_exp2f(x); }
constexpr int PZ = 3600;
constexpr size_t SZ_G = 8192, SZ_H = 8192, SZ_Q = 4096, SZ_Y = 4096;
constexpr float L2E = 1.4426950408889634f;

__device__ __forceinline__ void mk_id(bf16x8 (&fId)[2], int r, int h) {
    asm volatile("" : "+v"(r), "+v"(h));
#pragma unroll
    for (int s = 0; s < 2; ++s) { unsigned short e8[8];
#pragma unroll
        for (int jj = 0; jj < 8; ++jj) e8[jj] = (16 * s + 8 * (jj >> 2) + 4 * h + (jj & 3) == r) ? (unsigned short)0x3F80 : (unsigned short)0;
        fId[s] = __builtin_bit_cast(bf16x8, (u32x4){(unsigned)e8[0] | ((unsigned)e8[1] << 16), (unsigned)e8[2] | ((unsigned)e8[3] << 16), (unsigned)e8[4] | ((unsigned)e8[5] << 16), (unsigned)e8[6] | ((unsigned)e8[7] << 16)}); }
}

__device__ __forceinline__ void load_params(const Args& args, Frame& F) {
    LAS float* pra = (LAS float*)(F.lds + LDS_PARA); LAS float* prb = (LAS float*)(F.lds + LDS_PARB);
    const float* mu = AIN(7); const float* w0 = AIN(8); const float* a0 = AIN(10); const float* kk = AIN(13); const float* ka = AIN(14); const float* rk = AIN(15);
    for (int i = F.tid; i < 4096; i += NTHR) { const int a = i >> 9, c = i & 511;
        const float v_ = a < 3 ? mu[a * 512 + c] : (a == 3 ? w0[c] : (a == 4 ? a0[c] : (a == 5 ? kk[c] : (a == 6 ? ka[c] : rk[c]))));
        if (a < 4) pra[c * 4 + a] = v_; else prb[c * 4 + a - 4] = v_; }
    __syncthreads();
}
struct ElemCtx { const LAS unsigned char* rowc; const LAS unsigned char* rowp; const bf16_t* DUt; const bf16_t* IUt; const LAS float* pra; const LAS float* prb; int hd, r, h; float inv; };
template <int MODE> __device__ __forceinline__ void r1_elem(const ElemCtx& C, int jt, bf16x8 (&o0)[2], bf16x8 (&o1)[2], bf16x8 (&o2)[2], bf16x8 (&o3)[2], float& bns, float& pcd) {
    const int r = C.r, h = C.h, hd = C.hd;
    f32x16 lw_ = f32x16{}, la_ = f32x16{};
#pragma unroll
    for (int ks = 0; ks < 4; ++ks) { const int k0 = 16 * ks + 8 * h;
        const bf16x8 bw = *(const LAS bf16x8*)(C.rowc + (1536 + k0) * 2), ba = *(const LAS bf16x8*)(C.rowc + (1600 + k0) * 2);
        const bf16x8 fa = *(const bf16x8*)(C.DUt + (size_t)(32 * jt + r) * 64 + k0), fi = *(const bf16x8*)(C.IUt + (size_t)(32 * jt + r) * 64 + k0);
        lw_ = RK_MF(fa, bw, lw_); la_ = RK_MF(fi, ba, la_); }
    float d = 0.f;
#pragma unroll
    for (int s = 0; s < 2; ++s) { float x0[8], x1[8], x2[8], x3[8];
#pragma unroll
        for (int g2 = 0; g2 < 2; ++g2) { const int g = 2 * s + g2, cj = hd * 64 + 32 * jt + 8 * g + 4 * h;
            float kc[4], kq[4], xc[4], xq[4];
            { const u32x2 a = *(const LAS u32x2*)(C.rowc + (512 + cj) * 2), p = *(const LAS u32x2*)(C.rowp + (512 + cj) * 2);
              kc[0] = bf_lo(a.x); kc[1] = bf_hi(a.x); kc[2] = bf_lo(a.y); kc[3] = bf_hi(a.y); kq[0] = bf_lo(p.x); kq[1] = bf_hi(p.x); kq[2] = bf_lo(p.y); kq[3] = bf_hi(p.y); }
            { const int xo = MODE ? 1024 : 0; const u32x2 a = *(const LAS u32x2*)(C.rowc + (xo + cj) * 2), p = *(const LAS u32x2*)(C.rowp + (xo + cj) * 2);
              xc[0] = bf_lo(a.x); xc[1] = bf_hi(a.x); xc[2] = bf_lo(a.y); xc[3] = bf_hi(a.y); xq[0] = bf_lo(p.x); xq[1] = bf_hi(p.x); xq[2] = bf_lo(p.y); xq[3] = bf_hi(p.y); }
            const LAS f32x4* ppa = (const LAS f32x4*)(C.pra + cj * 4); const LAS f32x4* ppb = (const LAS f32x4*)(C.prb + cj * 4);
#pragma unroll
            for (int q = 0; q < 4; ++q) { const int i = 4 * g + q, o = 4 * g2 + q;
                const f32x4 pa = ppa[q], pb = ppb[q];
                const float e_ = 0.6065306597126334f * fast_sigmoid(pa[3] + lw_[i]); const float L = scan32(e_);
                const float l0 = __builtin_bit_cast(float, __builtin_amdgcn_readlane(__builtin_bit_cast(int, L), 31)), l1 = __builtin_bit_cast(float, __builtin_amdgcn_readlane(__builtin_bit_cast(int, L), 63));
                const float Lend = h ? l1 : l0; if (i == 4 * (r >> 3) + (r & 3)) d = Lend;
                const float x_ = xc[q] + (MODE ? pa[2] : pa[0]) * (xq[q] - xc[q]), k_ = kc[q] + pa[1] * (kq[q] - kc[q]);
                const float ic = fast_sigmoid(pb[0] + la_[i]);
                const float kk = k_ * pb[1] * C.inv, kpn = k_ * (1.0f + (ic - 1.0f) * pb[2]), bv = kk * ic;
                if (MODE) { const float Qe = ex2(L2E * (L - Lend)); x0[o] = bv * Qe; x1[o] = kpn * Qe; x2[o] = x_; x3[o] = 0.f; }
                else { const float P = ex2(-L2E * L), Pi = ex2(L2E * L), Pm = ex2(-L2E * (L - e_)); bns += x_ * kpn * pb[3]; x0[o] = -kk * Pm; x1[o] = x_ * P; x2[o] = bv * Pi; x3[o] = kpn * Pi; } }
            asm volatile("" ::: "memory"); }
        o0[s] = __builtin_bit_cast(bf16x8, (u32x4){cvtpk(x0[0], x0[1]), cvtpk(x0[2], x0[3]), cvtpk(x0[4], x0[5]), cvtpk(x0[6], x0[7])});
        o1[s] = __builtin_bit_cast(bf16x8, (u32x4){cvtpk(x1[0], x1[1]), cvtpk(x1[2], x1[3]), cvtpk(x1[4], x1[5]), cvtpk(x1[6], x1[7])});
        o2[s] = __builtin_bit_cast(bf16x8, (u32x4){cvtpk(x2[0], x2[1]), cvtpk(x2[2], x2[3]), cvtpk(x2[4], x2[5]), cvtpk(x2[6], x2[7])});
        if (!MODE) o3[s] = __builtin_bit_cast(bf16x8, (u32x4){cvtpk(x3[0], x3[1]), cvtpk(x3[2], x3[3]), cvtpk(x3[4], x3[5]), cvtpk(x3[6], x3[7])}); }
    if (MODE) pcd = ex2(-L2E * d);
}


__device__ __forceinline__ void r1_unit(const Args& args, Frame& F, int b, int c) {
    LAS unsigned char* IMG = F.lds;
    const bf16_t* Z = (const bf16_t*)(F.ws + WS_Z);
    const int t0 = 32 * c; const size_t m0 = (size_t)b * SEQ + t0;
    const float* mu = AIN(7);
    int tid = F.tid; asm volatile("" : "+v"(tid));
    __syncthreads();
    { const unsigned lds0 = (unsigned)(uintptr_t)IMG; const int ln = tid & 63;
      for (int task = F.wave; task < 33 * 4; task += NWAVES) { const int rr = task >> 2, j = task & 3, pc = 64 * j + ln;
          if (pc < 224) { if (rr > 0 || t0 > 0) att::glds16(Z + (m0 + rr - 1) * ZW + ZR + 8 * pc, (unsigned)__builtin_amdgcn_readfirstlane((int)(lds0 + rr * PZ + 1024 * j)));
                          else *(LAS u32x4*)(IMG + 16 * pc) = (u32x4){0u, 0u, 0u, 0u}; } }
      asm volatile("s_waitcnt vmcnt(0)" ::: "memory"); }
    __syncthreads();
    { u32x4 actv[2];
#pragma unroll
      for (int i = 0; i < 2; ++i) { const int q = tid + NTHR * i, t = q >> 5, kp = q & 31;
          const u32x4 cw = *(const LAS u32x4*)(IMG + (t + 1) * PZ + (1536 + 8 * kp) * 2), pw = *(const LAS u32x4*)(IMG + t * PZ + (1536 + 8 * kp) * 2);
          const f32x4 m0v = *(const f32x4*)(mu + 1536 + 8 * kp), m1v = *(const f32x4*)(mu + 1536 + 8 * kp + 4);
          const unsigned cwa[4] = {cw.x, cw.y, cw.z, cw.w}, pwa[4] = {pw.x, pw.y, pw.z, pw.w}; float x[8];
#pragma unroll
          for (int j = 0; j < 4; ++j) { const float c0 = bf_lo(cwa[j]), c1 = bf_hi(cwa[j]), p0 = bf_lo(pwa[j]), p1 = bf_hi(pwa[j]);
              const float mu0 = j < 2 ? m0v[2 * j] : m1v[2 * j - 4], mu1 = j < 2 ? m0v[2 * j + 1] : m1v[2 * j - 3];
              x[2 * j] = c0 + mu0 * (p0 - c0); x[2 * j + 1] = c1 + mu1 * (p1 - c1); }
#pragma unroll
          for (int j = 0; j < 8; ++j) { if (kp < 8) { const float e2 = ex2(2.885390081777927f * x[j]); x[j] = 1.0f - 2.0f * __builtin_amdgcn_rcpf(e2 + 1.0f); } else if (kp >= 16) x[j] = fast_sigmoid(x[j]); }
          actv[i] = (u32x4){cvtpk(x[0], x[1]), cvtpk(x[2], x[3]), cvtpk(x[4], x[5]), cvtpk(x[6], x[7])}; }
      __syncthreads();
#pragma unroll
      for (int i = 0; i < 2; ++i) { const int q = tid + NTHR * i, t = q >> 5, kp = q & 31; *(LAS u32x4*)(IMG + (t + 1) * PZ + (1536 + 8 * kp) * 2) = actv[i]; }
      __syncthreads(); }
    const int hd = F.wave; int r = tid & 31, h = (tid >> 5) & 1;
    const LAS unsigned char* rowc = IMG + (r + 1) * PZ; const LAS unsigned char* rowp = IMG + r * PZ;
    const bf16_t* DUt = (const bf16_t*)(F.ws + WS_DUT) + (size_t)hd * 4096; const bf16_t* IUt = (const bf16_t*)(F.ws + WS_IUT) + (size_t)hd * 4096;
    const LAS float* pra = (const LAS float*)(F.lds + LDS_PARA); const LAS float* prb = (const LAS float*)(F.lds + LDS_PARB);
    float n2 = 0.f;
#pragma unroll
    for (int jt = 0; jt < 2; ++jt)
#pragma unroll
        for (int g = 0; g < 4; ++g) { const int cj = hd * 64 + 32 * jt + 8 * g + 4 * h;
            const u32x2 a = *(const LAS u32x2*)(rowc + (512 + cj) * 2), p = *(const LAS u32x2*)(rowp + (512 + cj) * 2);
            const float kc[4] = {bf_lo(a.x), bf_hi(a.x), bf_lo(a.y), bf_hi(a.y)}, kq[4] = {bf_lo(p.x), bf_hi(p.x), bf_lo(p.y), bf_hi(p.y)};
            #pragma unroll
            for (int q = 0; q < 4; ++q) { const float muk = pra[(cj + q) * 4 + 1], kkp = prb[(cj + q) * 4 + 1]; const float k_ = kc[q] + muk * (kq[q] - kc[q]); const float kk_ = k_ * kkp; n2 += kk_ * kk_; } }
    n2 += __shfl_xor(n2, 32);
    const float inv = 1.0f / __builtin_fmaxf(sqrtf(n2), 1e-12f);
    float pcd[2] = {0.f, 0.f};
    float bns = 0.f;
    const ElemCtx EC{rowc, rowp, DUt, IUt, pra, prb, hd, r, h, inv};
    f32x16 Aab = f32x16{}, Aak = f32x16{}, Arb = f32x16{}, Ark = f32x16{};
    bf16x8 fRt[2][2], tAt[2][2];
    { bf16x8 fId[2]; mk_id(fId, r, h);
#pragma unroll
    for (int jt = 0; jt < 2; ++jt) { bf16x8 fA[2], fB[2], fK[2]; float pd_ = 0.f;
        r1_elem<0>(EC, jt, fA, fRt[jt], fB, fK, bns, pd_);
        const bf16x8 fA0 = fA[0], fA1 = fA[1], fB0 = fB[0], fB1 = fB[1], fK0 = fK[0], fK1 = fK[1];
        Aab = RK_MF(fB0, fA0, Aab); Aab = RK_MF(fB1, fA1, Aab); Aak = RK_MF(fK0, fA0, Aak); Aak = RK_MF(fK1, fA1, Aak);
        Arb = RK_MF(fB0, fRt[jt][0], Arb); Arb = RK_MF(fB1, fRt[jt][1], Arb); Ark = RK_MF(fK0, fRt[jt][0], Ark); Ark = RK_MF(fK1, fRt[jt][1], Ark);
        { f32x16 t_ = f32x16{}; t_ = RK_MF(fA0, fId[0], t_); t_ = RK_MF(fA1, fId[1], t_); tAt[jt][0] = frag<0>(t_); tAt[jt][1] = frag<1>(t_); } } }
    bns += __shfl_xor(bns, 32);
    if (h == 0) ((float*)(F.ws + WS_TOPW))[(m0 + r) * 8 + hd] = bns;
    LAS unsigned char* stash = IMG + (1 + ((tid & 63) >> 3)) * PZ + hd * 128 + (tid & 7) * 16;
#pragma unroll
    for (int p = 0; p < 4; ++p) *(LAS u32x4*)(stash + 8 * p * PZ) = __builtin_bit_cast(u32x4, fRt[p >> 1][p & 1]);
#pragma unroll
    for (int i = 0; i < 16; ++i) { const int s = 8 * (i >> 2) + 4 * h + (i & 3);
        if (!(s < r)) { Aab[i] = 0.f; Aak[i] = 0.f; } if (!(s <= r)) { Arb[i] = 0.f; Ark[i] = 0.f; } }
    const bf16x8 fAak[2] = {frag<0>(Aak), frag<1>(Aak)}, fArb[2] = {frag<0>(Arb), frag<1>(Arb)}, fArk[2] = {frag<0>(Ark), frag<1>(Ark)};
    bf16x8 fT[2];
    asm volatile("" ::: "memory"); __builtin_amdgcn_sched_barrier(0);
    { float T[32];
#pragma unroll
      for (int s = 0; s < 32; ++s) T[s] = (r == s) ? 1.0f : 0.f;
#define TI_RL(k_, is_, ln_) { const float ac_ = Aab[is_]; asm volatile("v_readlane_b32 %0, %1, " #ln_ : "=s"(sv_[k_]) : "v"(__float_as_int(ac_))); }
#define TI_FM(s_, u_, k_) T[s_] = __builtin_fmaf(T[u_], __int_as_float(sv_[k_]), T[s_]);
      if (!PROBE_TINV_ID) { int sv_[8];
        TI_RL(0, 0, 31) TI_RL(1, 1, 31) TI_RL(2, 2, 31) TI_RL(3, 3, 31) TI_RL(4, 0, 63) TI_RL(5, 1, 63) TI_RL(6, 2, 63) TI_RL(7, 3, 63)
        TI_FM(0, 31, 0) TI_FM(1, 31, 1) TI_FM(2, 31, 2) TI_FM(3, 31, 3) TI_FM(4, 31, 4) TI_FM(5, 31, 5) TI_FM(6, 31, 6) TI_FM(7, 31, 7)
        TI_RL(0, 4, 31) TI_RL(1, 5, 31) TI_RL(2, 6, 31) TI_RL(3, 7, 31) TI_RL(4, 4, 63) TI_RL(5, 5, 63) TI_RL(6, 6, 63) TI_RL(7, 7, 63)
        TI_FM(8, 31, 0) TI_FM(9, 31, 1) TI_FM(10, 31, 2) TI_FM(11, 31, 3) TI_FM(12, 31, 4) TI_FM(13, 31, 5) TI_FM(14, 31, 6) TI_FM(15, 31, 7)
        TI_RL(0, 8, 31) TI_RL(1, 9, 31) TI_RL(2, 10, 31) TI_RL(3, 11, 31) TI_RL(4, 8, 63) TI_RL(5, 9, 63) TI_RL(6, 10, 63) TI_RL(7, 11, 63)
        TI_FM(16, 31, 0) TI_FM(17, 31, 1) TI_FM(18, 31, 2) TI_FM(19, 31, 3) TI_FM(20, 31, 4) TI_FM(21, 31, 5) TI_FM(22, 31, 6) TI_FM(23, 31, 7)
        TI_RL(0, 12, 31) TI_RL(1, 13, 31) TI_RL(2, 14, 31) TI_RL(3, 15, 31) TI_RL(4, 12, 63) TI_RL(5, 13, 63) TI_RL(6, 14, 63)
        TI_FM(24, 31, 0) TI_FM(25, 31, 1) TI_FM(26, 31, 2) TI_FM(27, 31, 3) TI_FM(28, 31, 4) TI_FM(29, 31, 5) TI_FM(30, 31, 6)
        TI_RL(0, 0, 30) TI_RL(1, 1, 30) TI_RL(2, 2, 30) TI_RL(3, 3, 30) TI_RL(4, 0, 62) TI_RL(5, 1, 62) TI_RL(6, 2, 62) TI_RL(7, 3, 62)
        TI_FM(0, 30, 0) TI_FM(1, 30, 1) TI_FM(2, 30, 2) TI_FM(3, 30, 3) TI_FM(4, 30, 4) TI_FM(5, 30, 5) TI_FM(6, 30, 6) TI_FM(7, 30, 7)
        TI_RL(0, 4, 30) TI_RL(1, 5, 30) TI_RL(2, 6, 30) TI_RL(3, 7, 30) TI_RL(4, 4, 62) TI_RL(5, 5, 62) TI_RL(6, 6, 62) TI_RL(7, 7, 62)
        TI_FM(8, 30, 0) TI_FM(9, 30, 1) TI_FM(10, 30, 2) TI_FM(11, 30, 3) TI_FM(12, 30, 4) TI_FM(13, 30, 5) TI_FM(14, 30, 6) TI_FM(15, 30, 7)
        TI_RL(0, 8, 30) TI_RL(1, 9, 30) TI_RL(2, 10, 30) TI_RL(3, 11, 30) TI_RL(4, 8, 62) TI_RL(5, 9, 62) TI_RL(6, 10, 62) TI_RL(7, 11, 62)
        TI_FM(16, 30, 0) TI_FM(17, 30, 1) TI_FM(18, 30, 2) TI_FM(19, 30, 3) TI_FM(20, 30, 4) TI_FM(21, 30, 5) TI_FM(22, 30, 6) TI_FM(23, 30, 7)
        TI_RL(0, 12, 30) TI_RL(1, 13, 30) TI_RL(2, 14, 30) TI_RL(3, 15, 30) TI_RL(4, 12, 62) TI_RL(5, 13, 62)
        TI_FM(24, 30, 0) TI_FM(25, 30, 1) TI_FM(26, 30, 2) TI_FM(27, 30, 3) TI_FM(28, 30, 4) TI_FM(29, 30, 5)
        TI_RL(0, 0, 29) TI_RL(1, 1, 29) TI_RL(2, 2, 29) TI_RL(3, 3, 29) TI_RL(4, 0, 61) TI_RL(5, 1, 61) TI_RL(6, 2, 61) TI_RL(7, 3, 61)
        TI_FM(0, 29, 0) TI_FM(1, 29, 1) TI_FM(2, 29, 2) TI_FM(3, 29, 3) TI_FM(4, 29, 4) TI_FM(5, 29, 5) TI_FM(6, 29, 6) TI_FM(7, 29, 7)
        TI_RL(0, 4, 29) TI_RL(1, 5, 29) TI_RL(2, 6, 29) TI_RL(3, 7, 29) TI_RL(4, 4, 61) TI_RL(5, 5, 61) TI_RL(6, 6, 61) TI_RL(7, 7, 61)
        TI_FM(8, 29, 0) TI_FM(9, 29, 1) TI_FM(10, 29, 2) TI_FM(11, 29, 3) TI_FM(12, 29, 4) TI_FM(13, 29, 5) TI_FM(14, 29, 6) TI_FM(15, 29, 7)
        TI_RL(0, 8, 29) TI_RL(1, 9, 29) TI_RL(2, 10, 29) TI_RL(3, 11, 29) TI_RL(4, 8, 61) TI_RL(5, 9, 61) TI_RL(6, 10, 61) TI_RL(7, 11, 61)
        TI_FM(16, 29, 0) TI_FM(17, 29, 1) TI_FM(18, 29, 2) TI_FM(19, 29, 3) TI_FM(20, 29, 4) TI_FM(21, 29, 5) TI_FM(22, 29, 6) TI_FM(23, 29, 7)
        TI_RL(0, 12, 29) TI_RL(1, 13, 29) TI_RL(2, 14, 29) TI_RL(3, 15, 29) TI_RL(4, 12, 61)
        TI_FM(24, 29, 0) TI_FM(25, 29, 1) TI_FM(26, 29, 2) TI_FM(27, 29, 3) TI_FM(28, 29, 4)
        TI_RL(0, 0, 28) TI_RL(1, 1, 28) TI_RL(2, 2, 28) TI_RL(3, 3, 28) TI_RL(4, 0, 60) TI_RL(5, 1, 60) TI_RL(6, 2, 60) TI_RL(7, 3, 60)
        TI_FM(0, 28, 0) TI_FM(1, 28, 1) TI_FM(2, 28, 2) TI_FM(3, 28, 3) TI_FM(4, 28, 4) TI_FM(5, 28, 5) TI_FM(6, 28, 6) TI_FM(7, 28, 7)
        TI_RL(0, 4, 28) TI_RL(1, 5, 28) TI_RL(2, 6, 28) TI_RL(3, 7, 28) TI_RL(4, 4, 60) TI_RL(5, 5, 60) TI_RL(6, 6, 60) TI_RL(7, 7, 60)
        TI_FM(8, 28, 0) TI_FM(9, 28, 1) TI_FM(10, 28, 2) TI_FM(11, 28, 3) TI_FM(12, 28, 4) TI_FM(13, 28, 5) TI_FM(14, 28, 6) TI_FM(15, 28, 7)
        TI_RL(0, 8, 28) TI_RL(1, 9, 28) TI_RL(2, 10, 28) TI_RL(3, 11, 28) TI_RL(4, 8, 60) TI_RL(5, 9, 60) TI_RL(6, 10, 60) TI_RL(7, 11, 60)
        TI_FM(16, 28, 0) TI_FM(17, 28, 1) TI_FM(18, 28, 2) TI_FM(19, 28, 3) TI_FM(20, 28, 4) TI_FM(21, 28, 5) TI_FM(22, 28, 6) TI_FM(23, 28, 7)
        TI_RL(0, 12, 28) TI_RL(1, 13, 28) TI_RL(2, 14, 28) TI_RL(3, 15, 28)
        TI_FM(24, 28, 0) TI_FM(25, 28, 1) TI_FM(26, 28, 2) TI_FM(27, 28, 3)
        TI_RL(0, 0, 27) TI_RL(1, 1, 27) TI_RL(2, 2, 27) TI_RL(3, 3, 27) TI_RL(4, 0, 59) TI_RL(5, 1, 59) TI_RL(6, 2, 59) TI_RL(7, 3, 59)
        TI_FM(0, 27, 0) TI_FM(1, 27, 1) TI_FM(2, 27, 2) TI_FM(3, 27, 3) TI_FM(4, 27, 4) TI_FM(5, 27, 5) TI_FM(6, 27, 6) TI_FM(7, 27, 7)
        TI_RL(0, 4, 27) TI_RL(1, 5, 27) TI_RL(2, 6, 27) TI_RL(3, 7, 27) TI_RL(4, 4, 59) TI_RL(5, 5, 59) TI_RL(6, 6, 59) TI_RL(7, 7, 59)
        TI_FM(8, 27, 0) TI_FM(9, 27, 1) TI_FM(10, 27, 2) TI_FM(11, 27, 3) TI_FM(12, 27, 4) TI_FM(13, 27, 5) TI_FM(14, 27, 6) TI_FM(15, 27, 7)
        TI_RL(0, 8, 27) TI_RL(1, 9, 27) TI_RL(2, 10, 27) TI_RL(3, 11, 27) TI_RL(4, 8, 59) TI_RL(5, 9, 59) TI_RL(6, 10, 59) TI_RL(7, 11, 59)
        TI_FM(16, 27, 0) TI_FM(17, 27, 1) TI_FM(18, 27, 2) TI_FM(19, 27, 3) TI_FM(20, 27, 4) TI_FM(21, 27, 5) TI_FM(22, 27, 6) TI_FM(23, 27, 7)
        TI_RL(0, 12, 27) TI_RL(1, 13, 27) TI_RL(2, 14, 27)
        TI_FM(24, 27, 0) TI_FM(25, 27, 1) TI_FM(26, 27, 2)
        TI_RL(0, 0, 26) TI_RL(1, 1, 26) TI_RL(2, 2, 26) TI_RL(3, 3, 26) TI_RL(4, 0, 58) TI_RL(5, 1, 58) TI_RL(6, 2, 58) TI_RL(7, 3, 58)
        TI_FM(0, 26, 0) TI_FM(1, 26, 1) TI_FM(2, 26, 2) TI_FM(3, 26, 3) TI_FM(4, 26, 4) TI_FM(5, 26, 5) TI_FM(6, 26, 6) TI_FM(7, 26, 7)
        TI_RL(0, 4, 26) TI_RL(1, 5, 26) TI_RL(2, 6, 26) TI_RL(3, 7, 26) TI_RL(4, 4, 58) TI_RL(5, 5, 58) TI_RL(6, 6, 58) TI_RL(7, 7, 58)
        TI_FM(8, 26, 0) TI_FM(9, 26, 1) TI_FM(10, 26, 2) TI_FM(11, 26, 3) TI_FM(12, 26, 4) TI_FM(13, 26, 5) TI_FM(14, 26, 6) TI_FM(15, 26, 7)
        TI_RL(0, 8, 26) TI_RL(1, 9, 26) TI_RL(2, 10, 26) TI_RL(3, 11, 26) TI_RL(4, 8, 58) TI_RL(5, 9, 58) TI_RL(6, 10, 58) TI_RL(7, 11, 58)
        TI_FM(16, 26, 0) TI_FM(17, 26, 1) TI_FM(18, 26, 2) TI_FM(19, 26, 3) TI_FM(20, 26, 4) TI_FM(21, 26, 5) TI_FM(22, 26, 6) TI_FM(23, 26, 7)
        TI_RL(0, 12, 26) TI_RL(1, 13, 26)
        TI_FM(24, 26, 0) TI_FM(25, 26, 1)
        TI_RL(0, 0, 25) TI_RL(1, 1, 25) TI_RL(2, 2, 25) TI_RL(3, 3, 25) TI_RL(4, 0, 57) TI_RL(5, 1, 57) TI_RL(6, 2, 57) TI_RL(7, 3, 57)
        TI_FM(0, 25, 0) TI_FM(1, 25, 1) TI_FM(2, 25, 2) TI_FM(3, 25, 3) TI_FM(4, 25, 4) TI_FM(5, 25, 5) TI_FM(6, 25, 6) TI_FM(7, 25, 7)
        TI_RL(0, 4, 25) TI_RL(1, 5, 25) TI_RL(2, 6, 25) TI_RL(3, 7, 25) TI_RL(4, 4, 57) TI_RL(5, 5, 57) TI_RL(6, 6, 57) TI_RL(7, 7, 57)
        TI_FM(8, 25, 0) TI_FM(9, 25, 1) TI_FM(10, 25, 2) TI_FM(11, 25, 3) TI_FM(12, 25, 4) TI_FM(13, 25, 5) TI_FM(14, 25, 6) TI_FM(15, 25, 7)
        TI_RL(0, 8, 25) TI_RL(1, 9, 25) TI_RL(2, 10, 25) TI_RL(3, 11, 25) TI_RL(4, 8, 57) TI_RL(5, 9, 57) TI_RL(6, 10, 57) TI_RL(7, 11, 57)
        TI_FM(16, 25, 0) TI_FM(17, 25, 1) TI_FM(18, 25, 2) TI_FM(19, 25, 3) TI_FM(20, 25, 4) TI_FM(21, 25, 5) TI_FM(22, 25, 6) TI_FM(23, 25, 7)
        TI_RL(0, 12, 25)
        TI_FM(24, 25, 0)
        TI_RL(0, 0, 24) TI_RL(1, 1, 24) TI_RL(2, 2, 24) TI_RL(3, 3, 24) TI_RL(4, 0, 56) TI_RL(5, 1, 56) TI_RL(6, 2, 56) TI_RL(7, 3, 56)
        TI_FM(0, 24, 0) TI_FM(1, 24, 1) TI_FM(2, 24, 2) TI_FM(3, 24, 3) TI_FM(4, 24, 4) TI_FM(5, 24, 5) TI_FM(6, 24, 6) TI_FM(7, 24, 7)
        TI_RL(0, 4, 24) TI_RL(1, 5, 24) TI_RL(2, 6, 24) TI_RL(3, 7, 24) TI_RL(4, 4, 56) TI_RL(5, 5, 56) TI_RL(6, 6, 56) TI_RL(7, 7, 56)
        TI_FM(8, 24, 0) TI_FM(9, 24, 1) TI_FM(10, 24, 2) TI_FM(11, 24, 3) TI_FM(12, 24, 4) TI_FM(13, 24, 5) TI_FM(14, 24, 6) TI_FM(15, 24, 7)
        TI_RL(0, 8, 24) TI_RL(1, 9, 24) TI_RL(2, 10, 24) TI_RL(3, 11, 24) TI_RL(4, 8, 56) TI_RL(5, 9, 56) TI_RL(6, 10, 56) TI_RL(7, 11, 56)
        TI_FM(16, 24, 0) TI_FM(17, 24, 1) TI_FM(18, 24, 2) TI_FM(19, 24, 3) TI_FM(20, 24, 4) TI_FM(21, 24, 5) TI_FM(22, 24, 6) TI_FM(23, 24, 7)
        TI_RL(0, 0, 23) TI_RL(1, 1, 23) TI_RL(2, 2, 23) TI_RL(3, 3, 23) TI_RL(4, 0, 55) TI_RL(5, 1, 55) TI_RL(6, 2, 55) TI_RL(7, 3, 55)
        TI_FM(0, 23, 0) TI_FM(1, 23, 1) TI_FM(2, 23, 2) TI_FM(3, 23, 3) TI_FM(4, 23, 4) TI_FM(5, 23, 5) TI_FM(6, 23, 6) TI_FM(7, 23, 7)
        TI_RL(0, 4, 23) TI_RL(1, 5, 23) TI_RL(2, 6, 23) TI_RL(3, 7, 23) TI_RL(4, 4, 55) TI_RL(5, 5, 55) TI_RL(6, 6, 55) TI_RL(7, 7, 55)
        TI_FM(8, 23, 0) TI_FM(9, 23, 1) TI_FM(10, 23, 2) TI_FM(11, 23, 3) TI_FM(12, 23, 4) TI_FM(13, 23, 5) TI_FM(14, 23, 6) TI_FM(15, 23, 7)
        TI_RL(0, 8, 23) TI_RL(1, 9, 23) TI_RL(2, 10, 23) TI_RL(3, 11, 23) TI_RL(4, 8, 55) TI_RL(5, 9, 55) TI_RL(6, 10, 55)
        TI_FM(16, 23, 0) TI_FM(17, 23, 1) TI_FM(18, 23, 2) TI_FM(19, 23, 3) TI_FM(20, 23, 4) TI_FM(21, 23, 5) TI_FM(22, 23, 6)
        TI_RL(0, 0, 22) TI_RL(1, 1, 22) TI_RL(2, 2, 22) TI_RL(3, 3, 22) TI_RL(4, 0, 54) TI_RL(5, 1, 54) TI_RL(6, 2, 54) TI_RL(7, 3, 54)
        TI_FM(0, 22, 0) TI_FM(1, 22, 1) TI_FM(2, 22, 2) TI_FM(3, 22, 3) TI_FM(4, 22, 4) TI_FM(5, 22, 5) TI_FM(6, 22, 6) TI_FM(7, 22, 7)
        TI_RL(0, 4, 22) TI_RL(1, 5, 22) TI_RL(2, 6, 22) TI_RL(3, 7, 22) TI_RL(4, 4, 54) TI_RL(5, 5, 54) TI_RL(6, 6, 54) TI_RL(7, 7, 54)
        TI_FM(8, 22, 0) TI_FM(9, 22, 1) TI_FM(10, 22, 2) TI_FM(11, 22, 3) TI_FM(12, 22, 4) TI_FM(13, 22, 5) TI_FM(14, 22, 6) TI_FM(15, 22, 7)
        TI_RL(0, 8, 22) TI_RL(1, 9, 22) TI_RL(2, 10, 22) TI_RL(3, 11, 22) TI_RL(4, 8, 54) TI_RL(5, 9, 54)
        TI_FM(16, 22, 0) TI_FM(17, 22, 1) TI_FM(18, 22, 2) TI_FM(19, 22, 3) TI_FM(20, 22, 4) TI_FM(21, 22, 5)
        TI_RL(0, 0, 21) TI_RL(1, 1, 21) TI_RL(2, 2, 21) TI_RL(3, 3, 21) TI_RL(4, 0, 53) TI_RL(5, 1, 53) TI_RL(6, 2, 53) TI_RL(7, 3, 53)
        TI_FM(0, 21, 0) TI_FM(1, 21, 1) TI_FM(2, 21, 2) TI_FM(3, 21, 3) TI_FM(4, 21, 4) TI_FM(5, 21, 5) TI_FM(6, 21, 6) TI_FM(7, 21, 7)
        TI_RL(0, 4, 21) TI_RL(1, 5, 21) TI_RL(2, 6, 21) TI_RL(3, 7, 21) TI_RL(4, 4, 53) TI_RL(5, 5, 53) TI_RL(6, 6, 53) TI_RL(7, 7, 53)
        TI_FM(8, 21, 0) TI_FM(9, 21, 1) TI_FM(10, 21, 2) TI_FM(11, 21, 3) TI_FM(12, 21, 4) TI_FM(13, 21, 5) TI_FM(14, 21, 6) TI_FM(15, 21, 7)
        TI_RL(0, 8, 21) TI_RL(1, 9, 21) TI_RL(2, 10, 21) TI_RL(3, 11, 21) TI_RL(4, 8, 53)
        TI_FM(16, 21, 0) TI_FM(17, 21, 1) TI_FM(18, 21, 2) TI_FM(19, 21, 3) TI_FM(20, 21, 4)
        TI_RL(0, 0, 20) TI_RL(1, 1, 20) TI_RL(2, 2, 20) TI_RL(3, 3, 20) TI_RL(4, 0, 52) TI_RL(5, 1, 52) TI_RL(6, 2, 52) TI_RL(7, 3, 52)
        TI_FM(0, 20, 0) TI_FM(1, 20, 1) TI_FM(2, 20, 2) TI_FM(3, 20, 3) TI_FM(4, 20, 4) TI_FM(5, 20, 5) TI_FM(6, 20, 6) TI_FM(7, 20, 7)
        TI_RL(0, 4, 20) TI_RL(1, 5, 20) TI_RL(2, 6, 20) TI_RL(3, 7, 20) TI_RL(4, 4, 52) TI_RL(5, 5, 52) TI_RL(6, 6, 52) TI_RL(7, 7, 52)
        TI_FM(8, 20, 0) TI_FM(9, 20, 1) TI_FM(10, 20, 2) TI_FM(11, 20, 3) TI_FM(12, 20, 4) TI_FM(13, 20, 5) TI_FM(14, 20, 6) TI_FM(15, 20, 7)
        TI_RL(0, 8, 20) TI_RL(1, 9, 20) TI_RL(2, 10, 20) TI_RL(3, 11, 20)
        TI_FM(16, 20, 0) TI_FM(17, 20, 1) TI_FM(18, 20, 2) TI_FM(19, 20, 3)
        TI_RL(0, 0, 19) TI_RL(1, 1, 19) TI_RL(2, 2, 19) TI_RL(3, 3, 19) TI_RL(4, 0, 51) TI_RL(5, 1, 51) TI_RL(6, 2, 51) TI_RL(7, 3, 51)
        TI_FM(0, 19, 0) TI_FM(1, 19, 1) TI_FM(2, 19, 2) TI_FM(3, 19, 3) TI_FM(4, 19, 4) TI_FM(5, 19, 5) TI_FM(6, 19, 6) TI_FM(7, 19, 7)
        TI_RL(0, 4, 19) TI_RL(1, 5, 19) TI_RL(2, 6, 19) TI_RL(3, 7, 19) TI_RL(4, 4, 51) TI_RL(5, 5, 51) TI_RL(6, 6, 51) TI_RL(7, 7, 51)
        TI_FM(8, 19, 0) TI_FM(9, 19, 1) TI_FM(10, 19, 2) TI_FM(11, 19, 3) TI_FM(12, 19, 4) TI_FM(13, 19, 5) TI_FM(14, 19, 6) TI_FM(15, 19, 7)
        TI_RL(0, 8, 19) TI_RL(1, 9, 19) TI_RL(2, 10, 19)
        TI_FM(16, 19, 0) TI_FM(17, 19, 1) TI_FM(18, 19, 2)
        TI_RL(0, 0, 18) TI_RL(1, 1, 18) TI_RL(2, 2, 18) TI_RL(3, 3, 18) TI_RL(4, 0, 50) TI_RL(5, 1, 50) TI_RL(6, 2, 50) TI_RL(7, 3, 50)
        TI_FM(0, 18, 0) TI_FM(1, 18, 1) TI_FM(2, 18, 2) TI_FM(3, 18, 3) TI_FM(4, 18, 4) TI_FM(5, 18, 5) TI_FM(6, 18, 6) TI_FM(7, 18, 7)
        TI_RL(0, 4, 18) TI_RL(1, 5, 18) TI_RL(2, 6, 18) TI_RL(3, 7, 18) TI_RL(4, 4, 50) TI_RL(5, 5, 50) TI_RL(6, 6, 50) TI_RL(7, 7, 50)
        TI_FM(8, 18, 0) TI_FM(9, 18, 1) TI_FM(10, 18, 2) TI_FM(11, 18, 3) TI_FM(12, 18, 4) TI_FM(13, 18, 5) TI_FM(14, 18, 6) TI_FM(15, 18, 7)
        TI_RL(0, 8, 18) TI_RL(1, 9, 18)
        TI_FM(16, 18, 0) TI_FM(17, 18, 1)
        TI_RL(0, 0, 17) TI_RL(1, 1, 17) TI_RL(2, 2, 17) TI_RL(3, 3, 17) TI_RL(4, 0, 49) TI_RL(5, 1, 49) TI_RL(6, 2, 49) TI_RL(7, 3, 49)
        TI_FM(0, 17, 0) TI_FM(1, 17, 1) TI_FM(2, 17, 2) TI_FM(3, 17, 3) TI_FM(4, 17, 4) TI_FM(5, 17, 5) TI_FM(6, 17, 6) TI_FM(7, 17, 7)
        TI_RL(0, 4, 17) TI_RL(1, 5, 17) TI_RL(2, 6, 17) TI_RL(3, 7, 17) TI_RL(4, 4, 49) TI_RL(5, 5, 49) TI_RL(6, 6, 49) TI_RL(7, 7, 49)
        TI_FM(8, 17, 0) TI_FM(9, 17, 1) TI_FM(10, 17, 2) TI_FM(11, 17, 3) TI_FM(12, 17, 4) TI_FM(13, 17, 5) TI_FM(14, 17, 6) TI_FM(15, 17, 7)
        TI_RL(0, 8, 17)
        TI_FM(16, 17, 0)
        TI_RL(0, 0, 16) TI_RL(1, 1, 16) TI_RL(2, 2, 16) TI_RL(3, 3, 16) TI_RL(4, 0, 48) TI_RL(5, 1, 48) TI_RL(6, 2, 48) TI_RL(7, 3, 48)
        TI_FM(0, 16, 0) TI_FM(1, 16, 1) TI_FM(2, 16, 2) TI_FM(3, 16, 3) TI_FM(4, 16, 4) TI_FM(5, 16, 5) TI_FM(6, 16, 6) TI_FM(7, 16, 7)
        TI_RL(0, 4, 16) TI_RL(1, 5, 16) TI_RL(2, 6, 16) TI_RL(3, 7, 16) TI_RL(4, 4, 48) TI_RL(5, 5, 48) TI_RL(6, 6, 48) TI_RL(7, 7, 48)
        TI_FM(8, 16, 0) TI_FM(9, 16, 1) TI_FM(10, 16, 2) TI_FM(11, 16, 3) TI_FM(12, 16, 4) TI_FM(13, 16, 5) TI_FM(14, 16, 6) TI_FM(15, 16, 7)
        TI_RL(0, 0, 15) TI_RL(1, 1, 15) TI_RL(2, 2, 15) TI_RL(3, 3, 15) TI_RL(4, 0, 47) TI_RL(5, 1, 47) TI_RL(6, 2, 47) TI_RL(7, 3, 47)
        TI_FM(0, 15, 0) TI_FM(1, 15, 1) TI_FM(2, 15, 2) TI_FM(3, 15, 3) TI_FM(4, 15, 4) TI_FM(5, 15, 5) TI_FM(6, 15, 6) TI_FM(7, 15, 7)
        TI_RL(0, 4, 15) TI_RL(1, 5, 15) TI_RL(2, 6, 15) TI_RL(3, 7, 15) TI_RL(4, 4, 47) TI_RL(5, 5, 47) TI_RL(6, 6, 47)
        TI_FM(8, 15, 0) TI_FM(9, 15, 1) TI_FM(10, 15, 2) TI_FM(11, 15, 3) TI_FM(12, 15, 4) TI_FM(13, 15, 5) TI_FM(14, 15, 6)
        TI_RL(0, 0, 14) TI_RL(1, 1, 14) TI_RL(2, 2, 14) TI_RL(3, 3, 14) TI_RL(4, 0, 46) TI_RL(5, 1, 46) TI_RL(6, 2, 46) TI_RL(7, 3, 46)
        TI_FM(0, 14, 0) TI_FM(1, 14, 1) TI_FM(2, 14, 2) TI_FM(3, 14, 3) TI_FM(4, 14, 4) TI_FM(5, 14, 5) TI_FM(6, 14, 6) TI_FM(7, 14, 7)
        TI_RL(0, 4, 14) TI_RL(1, 5, 14) TI_RL(2, 6, 14) TI_RL(3, 7, 14) TI_RL(4, 4, 46) TI_RL(5, 5, 46)
        TI_FM(8, 14, 0) TI_FM(9, 14, 1) TI_FM(10, 14, 2) TI_FM(11, 14, 3) TI_FM(12, 14, 4) TI_FM(13, 14, 5)
        TI_RL(0, 0, 13) TI_RL(1, 1, 13) TI_RL(2, 2, 13) TI_RL(3, 3, 13) TI_RL(4, 0, 45) TI_RL(5, 1, 45) TI_RL(6, 2, 45) TI_RL(7, 3, 45)
        TI_FM(0, 13, 0) TI_FM(1, 13, 1) TI_FM(2, 13, 2) TI_FM(3, 13, 3) TI_FM(4, 13, 4) TI_FM(5, 13, 5) TI_FM(6, 13, 6) TI_FM(7, 13, 7)
        TI_RL(0, 4, 13) TI_RL(1, 5, 13) TI_RL(2, 6, 13) TI_RL(3, 7, 13) TI_RL(4, 4, 45)
        TI_FM(8, 13, 0) TI_FM(9, 13, 1) TI_FM(10, 13, 2) TI_FM(11, 13, 3) TI_FM(12, 13, 4)
        TI_RL(0, 0, 12) TI_RL(1, 1, 12) TI_RL(2, 2, 12) TI_RL(3, 3, 12) TI_RL(4, 0, 44) TI_RL(5, 1, 44) TI_RL(6, 2, 44) TI_RL(7, 3, 44)
        TI_FM(0, 12, 0) TI_FM(1, 12, 1) TI_FM(2, 12, 2) TI_FM(3, 12, 3) TI_FM(4, 12, 4) TI_FM(5, 12, 5) TI_FM(6, 12, 6) TI_FM(7, 12, 7)
        TI_RL(0, 4, 12) TI_RL(1, 5, 12) TI_RL(2, 6, 12) TI_RL(3, 7, 12)
        TI_FM(8, 12, 0) TI_FM(9, 12, 1) TI_FM(10, 12, 2) TI_FM(11, 12, 3)
        TI_RL(0, 0, 11) TI_RL(1, 1, 11) TI_RL(2, 2, 11) TI_RL(3, 3, 11) TI_RL(4, 0, 43) TI_RL(5, 1, 43) TI_RL(6, 2, 43) TI_RL(7, 3, 43)
        TI_FM(0, 11, 0) TI_FM(1, 11, 1) TI_FM(2, 11, 2) TI_FM(3, 11, 3) TI_FM(4, 11, 4) TI_FM(5, 11, 5) TI_FM(6, 11, 6) TI_FM(7, 11, 7)
        TI_RL(0, 4, 11) TI_RL(1, 5, 11) TI_RL(2, 6, 11)
        TI_FM(8, 11, 0) TI_FM(9, 11, 1) TI_FM(10, 11, 2)
        TI_RL(0, 0, 10) TI_RL(1, 1, 10) TI_RL(2, 2, 10) TI_RL(3, 3, 10) TI_RL(4, 0, 42) TI_RL(5, 1, 42) TI_RL(6, 2, 42) TI_RL(7, 3, 42)
        TI_FM(0, 10, 0) TI_FM(1, 10, 1) TI_FM(2, 10, 2) TI_FM(3, 10, 3) TI_FM(4, 10, 4) TI_FM(5, 10, 5) TI_FM(6, 10, 6) TI_FM(7, 10, 7)
        TI_RL(0, 4, 10) TI_RL(1, 5, 10)
        TI_FM(8, 10, 0) TI_FM(9, 10, 1)
        TI_RL(0, 0, 9) TI_RL(1, 1, 9) TI_RL(2, 2, 9) TI_RL(3, 3, 9) TI_RL(4, 0, 41) TI_RL(5, 1, 41) TI_RL(6, 2, 41) TI_RL(7, 3, 41)
        TI_FM(0, 9, 0) TI_FM(1, 9, 1) TI_FM(2, 9, 2) TI_FM(3, 9, 3) TI_FM(4, 9, 4) TI_FM(5, 9, 5) TI_FM(6, 9, 6) TI_FM(7, 9, 7)
        TI_RL(0, 4, 9)
        TI_FM(8, 9, 0)
        TI_RL(0, 0, 8) TI_RL(1, 1, 8) TI_RL(2, 2, 8) TI_RL(3, 3, 8) TI_RL(4, 0, 40) TI_RL(5, 1, 40) TI_RL(6, 2, 40) TI_RL(7, 3, 40)
        TI_FM(0, 8, 0) TI_FM(1, 8, 1) TI_FM(2, 8, 2) TI_FM(3, 8, 3) TI_FM(4, 8, 4) TI_FM(5, 8, 5) TI_FM(6, 8, 6) TI_FM(7, 8, 7)
        TI_RL(0, 0, 7) TI_RL(1, 1, 7) TI_RL(2, 2, 7) TI_RL(3, 3, 7) TI_RL(4, 0, 39) TI_RL(5, 1, 39) TI_RL(6, 2, 39)
        TI_FM(0, 7, 0) TI_FM(1, 7, 1) TI_FM(2, 7, 2) TI_FM(3, 7, 3) TI_FM(4, 7, 4) TI_FM(5, 7, 5) TI_FM(6, 7, 6)
        TI_RL(0, 0, 6) TI_RL(1, 1, 6) TI_RL(2, 2, 6) TI_RL(3, 3, 6) TI_RL(4, 0, 38) TI_RL(5, 1, 38)
        TI_FM(0, 6, 0) TI_FM(1, 6, 1) TI_FM(2, 6, 2) TI_FM(3, 6, 3) TI_FM(4, 6, 4) TI_FM(5, 6, 5)
        TI_RL(0, 0, 5) TI_RL(1, 1, 5) TI_RL(2, 2, 5) TI_RL(3, 3, 5) TI_RL(4, 0, 37)
        TI_FM(0, 5, 0) TI_FM(1, 5, 1) TI_FM(2, 5, 2) TI_FM(3, 5, 3) TI_FM(4, 5, 4)
        TI_RL(0, 0, 4) TI_RL(1, 1, 4) TI_RL(2, 2, 4) TI_RL(3, 3, 4)
        TI_FM(0, 4, 0) TI_FM(1, 4, 1) TI_FM(2, 4, 2) TI_FM(3, 4, 3)
        TI_RL(0, 0, 3) TI_RL(1, 1, 3) TI_RL(2, 2, 3)
        TI_FM(0, 3, 0) TI_FM(1, 3, 1) TI_FM(2, 3, 2)
        TI_RL(0, 0, 2) TI_RL(1, 1, 2)
        TI_FM(0, 2, 0) TI_FM(1, 2, 1)
        TI_RL(0, 0, 1)
        TI_FM(0, 1, 0)
      }
#undef TI_RL
#undef TI_FM

#pragma unroll
      for (int s = 0; s < 2; ++s) { float e8[8];
#pragma unroll
          for (int jj = 0; jj < 8; ++jj) { const int i0 = 16 * s + 8 * (jj >> 2) + (jj & 3); float ta = T[i0], tb = T[i0 + 4]; asm volatile("" : "+v"(ta), "+v"(tb)); e8[jj] = h ? tb : ta; }
          fT[s] = __builtin_bit_cast(bf16x8, (u32x4){cvtpk(e8[0], e8[1]), cvtpk(e8[2], e8[3]), cvtpk(e8[4], e8[5]), cvtpk(e8[6], e8[7])}); } }
    asm volatile("" ::: "memory"); __builtin_amdgcn_sched_barrier(0);
    const size_t uid = ((size_t)(b * 8 + hd) * 128 + c);
    unsigned char* gG = F.ws + WS_R0 + uid * SZ_G; unsigned char* gH = F.ws + WS_R2 + uid * SZ_H; unsigned char* gQ = F.ws + WS_H0 + uid * SZ_Q; unsigned char* gY = F.ws + WS_H1 + uid * SZ_Y;
#define RK_ST(base, piece, f) (*(u32x4*)((base) + (piece) * 1024 + (tid & 63) * 16) = __builtin_bit_cast(u32x4, (f)))
    bf16x8 fWt[2][2];
#pragma unroll
    for (int jt = 0; jt < 2; ++jt) { f32x16 w_ = f32x16{}; w_ = RK_MF(fT[0], tAt[jt][0], w_); w_ = RK_MF(fT[1], tAt[jt][1], w_); fWt[jt][0] = frag<0>(w_); fWt[jt][1] = frag<1>(w_);
        f32x16 q_; unfrag<0>(q_, __builtin_bit_cast(bf16x8, *(const LAS u32x4*)(stash + 8 * (2 * jt) * PZ))); unfrag<1>(q_, __builtin_bit_cast(bf16x8, *(const LAS u32x4*)(stash + 8 * (2 * jt + 1) * PZ)));
        q_ = RK_MF(fWt[jt][0], fArb[0], q_); q_ = RK_MF(fWt[jt][1], fArb[1], q_); RK_ST(gQ, 2 * jt, frag<0>(q_)); RK_ST(gQ, 2 * jt + 1, frag<1>(q_)); }
    bf16x8 tBh[2][2], tKh[2][2], tV[2][2];
    { bf16x8 fId[2]; mk_id(fId, r, h);
#pragma unroll
    for (int jt = 0; jt < 2; ++jt) { bf16x8 fBh[2], fKh[2], fV[2], fdum[2]; float bdum = 0.f;
        r1_elem<1>(EC, jt, fBh, fKh, fV, fdum, bdum, pcd[jt]);
        { f32x16 t_ = f32x16{}; t_ = RK_MF(fBh[0], fId[0], t_); t_ = RK_MF(fBh[1], fId[1], t_); tBh[jt][0] = frag<0>(t_); tBh[jt][1] = frag<1>(t_); }
        { f32x16 t_ = f32x16{}; t_ = RK_MF(fKh[0], fId[0], t_); t_ = RK_MF(fKh[1], fId[1], t_); tKh[jt][0] = frag<0>(t_); tKh[jt][1] = frag<1>(t_); }
        { f32x16 t_ = f32x16{}; t_ = RK_MF(fV[0], fId[0], t_); t_ = RK_MF(fV[1], fId[1], t_); tV[jt][0] = frag<0>(t_); tV[jt][1] = frag<1>(t_); } } }
    bf16x8 fUt[2][2];
#pragma unroll
    for (int it = 0; it < 2; ++it) { f32x16 av = f32x16{}; av = RK_MF(fAak[0], tV[it][0], av); av = RK_MF(fAak[1], tV[it][1], av);
        const bf16x8 fav0 = frag<0>(av), fav1 = frag<1>(av); f32x16 u_ = f32x16{}; u_ = RK_MF(fT[0], fav0, u_); u_ = RK_MF(fT[1], fav1, u_); fUt[it][0] = frag<0>(u_); fUt[it][1] = frag<1>(u_); }
#pragma unroll
    for (int it = 0; it < 2; ++it) { f32x16 y_ = f32x16{}; y_ = RK_MF(fUt[it][0], fArb[0], y_); y_ = RK_MF(fUt[it][1], fArb[1], y_); y_ = RK_MF(tV[it][0], fArk[0], y_); y_ = RK_MF(tV[it][1], fArk[1], y_);
        RK_ST(gY, 2 * it, frag<0>(y_)); RK_ST(gY, 2 * it + 1, frag<1>(y_)); }
#pragma unroll
    for (int jt = 0; jt < 2; ++jt)
#pragma unroll
        for (int j2 = 0; j2 < 2; ++j2) { f32x16 g_ = f32x16{}; g_ = RK_MF(fWt[jt][0], tBh[j2][0], g_); g_ = RK_MF(fWt[jt][1], tBh[j2][1], g_);
            if (jt == j2) {
#pragma unroll
                for (int i = 0; i < 16; ++i) if (i == 4 * (r >> 3) + (r & 3) && h == ((r >> 2) & 1)) g_[i] += pcd[jt]; }
            RK_ST(gG, 2 * (jt * 2 + j2), frag<0>(g_)); RK_ST(gG, 2 * (jt * 2 + j2) + 1, frag<1>(g_)); }
#pragma unroll
    for (int j2 = 0; j2 < 2; ++j2)
#pragma unroll
        for (int it = 0; it < 2; ++it) { f32x16 h_ = f32x16{}; h_ = RK_MF(tBh[j2][0], fUt[it][0], h_); h_ = RK_MF(tBh[j2][1], fUt[it][1], h_); h_ = RK_MF(tKh[j2][0], tV[it][0], h_); h_ = RK_MF(tKh[j2][1], tV[it][1], h_);
            RK_ST(gH, 2 * (j2 * 2 + it), frag<0>(h_)); RK_ST(gH, 2 * (j2 * 2 + it) + 1, frag<1>(h_)); }
}

template <int DRY> __device__ __forceinline__ void r2_task(const Args& args, Frame& F, int task) {
    const bool st_ok = !DRY || args.li == 12345;
    const int bh = task >> 1, it = task & 1;
    f32x16 St[2]; St[0] = f32x16{}; St[1] = f32x16{};
    const unsigned char* gG0 = F.ws + WS_R0 + (size_t)bh * 128 * SZ_G + F.lane * 16; unsigned char* gH0 = F.ws + WS_R2 + (size_t)bh * 128 * SZ_H + F.lane * 16;
    bf16x8 G0[2][2][2], H0[2][2], G1[2][2][2], H1[2][2], G2[2][2][2], H2[2][2];
#define R2_LOAD(G_, H_, c_) do { const int cc_ = (c_) < 128 ? (c_) : 127;     \
        _Pragma("unroll") for (int jt = 0; jt < 2; ++jt) _Pragma("unroll") for (int j2 = 0; j2 < 2; ++j2) _Pragma("unroll") for (int s = 0; s < 2; ++s) \
            G_[jt][j2][s] = __builtin_bit_cast(bf16x8, *(const u32x4*)(gG0 + (size_t)cc_ * SZ_G + (2 * (jt * 2 + j2) + s) * 1024)); \
        _Pragma("unroll") for (int j2 = 0; j2 < 2; ++j2) _Pragma("unroll") for (int s = 0; s < 2; ++s) H_[j2][s] = __builtin_bit_cast(bf16x8, *(const u32x4*)(gH0 + (size_t)cc_ * SZ_H + (2 * (j2 * 2 + it) + s) * 1024)); } while (0)
#define R2_STEP(G_, H_, c_, LOADNEXT) do { \
        const bf16x8 fS[2][2] = {{frag<0>(St[0]), frag<1>(St[0])}, {frag<0>(St[1]), frag<1>(St[1])}}; \
        if (st_ok) { _Pragma("unroll") for (int jt = 0; jt < 2; ++jt) _Pragma("unroll") for (int s = 0; s < 2; ++s) \
            *(u32x4*)(gH0 + (size_t)(c_) * SZ_H + (2 * (jt * 2 + it) + s) * 1024) = __builtin_bit_cast(u32x4, fS[jt][s]); }     \
        __builtin_amdgcn_sched_barrier(0); LOADNEXT; __builtin_amdgcn_sched_barrier(0);     \
        _Pragma("unroll") for (int j2 = 0; j2 < 2; ++j2) { unfrag<0>(St[j2], H_[j2][0]); unfrag<1>(St[j2], H_[j2][1]); \
            _Pragma("unroll") for (int jt = 0; jt < 2; ++jt) { St[j2] = RK_MF(G_[jt][j2][0], fS[jt][0], St[j2]); St[j2] = RK_MF(G_[jt][j2][1], fS[jt][1], St[j2]); } } \
        __builtin_amdgcn_sched_barrier(0); \
    } while (0)
    R2_LOAD(G0, H0, 0); R2_LOAD(G1, H1, 1);
#pragma unroll 1
    for (int c = 0; c < 126; c += 3) {
        R2_STEP(G0, H0, c, R2_LOAD(G2, H2, c + 2));
        R2_STEP(G1, H1, c + 1, R2_LOAD(G0, H0, c + 3));
        R2_STEP(G2, H2, c + 2, R2_LOAD(G1, H1, c + 4));
    }
    R2_STEP(G0, H0, 126, (void)0);
    R2_STEP(G1, H1, 127, (void)0);
#undef R2_STEP
#undef R2_LOAD
}

constexpr int PV2 = 1296;
__device__ __forceinline__ void r3_unit(const Args& args, Frame& F, int b, int c) {
    LAS unsigned char* IMG = F.lds;
    const bf16_t* Z = (const bf16_t*)(F.ws + WS_Z);
    const int t0 = 32 * c; const size_t m0 = (size_t)b * SEQ + t0;
    const float* mu = AIN(7);
    int tid = F.tid; asm volatile("" : "+v"(tid));
    __syncthreads();
    { const unsigned lds0 = (unsigned)(uintptr_t)IMG; const int ln = tid & 63;
      for (int task = F.wave; task < 33 * 2; task += NWAVES) { const int rr = task >> 1, j = task & 1, pc = 64 * j + ln;
          if (pc < 80) { const int col = j == 0 ? ZR_V + 8 * ln : ZR_GD + 8 * ln;
              if (rr > 0 || t0 > 0) att::glds16(Z + (m0 + rr - 1) * ZW + col, (unsigned)__builtin_amdgcn_readfirstlane((int)(lds0 + rr * PV2 + 1024 * j)));
              else *(LAS u32x4*)(IMG + 16 * pc) = (u32x4){0u, 0u, 0u, 0u}; } }
      asm volatile("s_waitcnt vmcnt(0)" ::: "memory"); }
    __syncthreads();
    { const int t = tid >> 4, kp = tid & 15;
      const u32x4 cw = *(const LAS u32x4*)(IMG + (t + 1) * PV2 + 1024 + 16 * kp), pw = *(const LAS u32x4*)(IMG + t * PV2 + 1024 + 16 * kp);
      const f32x4 m0v = *(const f32x4*)(mu + 1664 + 8 * kp), m1v = *(const f32x4*)(mu + 1664 + 8 * kp + 4);
      const unsigned cwa[4] = {cw.x, cw.y, cw.z, cw.w}, pwa[4] = {pw.x, pw.y, pw.z, pw.w}; float x[8];
#pragma unroll
      for (int j = 0; j < 4; ++j) { const float c0 = bf_lo(cwa[j]), c1 = bf_hi(cwa[j]), p0 = bf_lo(pwa[j]), p1 = bf_hi(pwa[j]);
          const float mu0 = j < 2 ? m0v[2 * j] : m1v[2 * j - 4], mu1 = j < 2 ? m0v[2 * j + 1] : m1v[2 * j - 3];
          x[2 * j] = fast_sigmoid(c0 + mu0 * (p0 - c0)); x[2 * j + 1] = fast_sigmoid(c1 + mu1 * (p1 - c1)); }
      const u32x4 o = {cvtpk(x[0], x[1]), cvtpk(x[2], x[3]), cvtpk(x[4], x[5]), cvtpk(x[6], x[7])};
      __syncthreads();
      *(LAS u32x4*)(IMG + (t + 1) * PV2 + 1024 + 16 * kp) = o;
      __syncthreads(); }
    const int hd = F.wave; int r = tid & 31, h = (tid >> 5) & 1;
    const LAS unsigned char* rowc = IMG + (r + 1) * PV2; const LAS unsigned char* rowp = IMG + r * PV2;
    const size_t uid = ((size_t)(b * 8 + hd) * 128 + c);
    const unsigned char* gS = F.ws + WS_R2 + uid * SZ_H; const unsigned char* gQ = F.ws + WS_H0 + uid * SZ_Q; const unsigned char* gY = F.ws + WS_H1 + uid * SZ_Y;
#define RK_LD(base, piece) __builtin_bit_cast(bf16x8, *(const u32x4*)((base) + (piece) * 1024 + (tid & 63) * 16))
    f32x16 gl[2]; gl[0] = f32x16{}; gl[1] = f32x16{};
    { const bf16_t* GUt = (const bf16_t*)(F.ws + WS_GUT) + (size_t)hd * 64 * 128;
#pragma unroll
      for (int ks = 0; ks < 8; ++ks) { const int k0 = 16 * ks + 8 * h; const bf16x8 bg = *(const LAS bf16x8*)(rowc + 1024 + k0 * 2);
#pragma unroll
          for (int it = 0; it < 2; ++it) { const bf16x8 fg = *(const bf16x8*)(GUt + (size_t)(32 * it + r) * 128 + k0); gl[it] = RK_MF(fg, bg, gl[it]); } } }
    f32x16 Y[2];
    { const bf16x8 fQ[2][2] = {{RK_LD(gQ, 0), RK_LD(gQ, 1)}, {RK_LD(gQ, 2), RK_LD(gQ, 3)}};
#pragma unroll
      for (int it = 0; it < 2; ++it) { unfrag<0>(Y[it], RK_LD(gY, 2 * it)); unfrag<1>(Y[it], RK_LD(gY, 2 * it + 1));
#pragma unroll
          for (int jt = 0; jt < 2; ++jt) { if (PROBE_NO_STATE) continue; Y[it] = RK_MF(RK_LD(gS, 2 * (jt * 2 + it)), fQ[jt][0], Y[it]); Y[it] = RK_MF(RK_LD(gS, 2 * (jt * 2 + it) + 1), fQ[jt][1], Y[it]); } } }
    float s1 = 0.f;
#pragma unroll
    for (int it = 0; it < 2; ++it)
#pragma unroll
        for (int i = 0; i < 16; ++i) s1 += Y[it][i];
    s1 += __shfl_xor(s1, 32); const float mean = s1 * (1.0f / 64.0f); float s2 = 0.f;
#pragma unroll
    for (int it = 0; it < 2; ++it)
#pragma unroll
        for (int i = 0; i < 16; ++i) { const float d = Y[it][i] - mean; s2 += d * d; }
    s2 += __shfl_xor(s2, 32); const float rstd = 1.0f / sqrtf(s2 * (1.0f / 64.0f) + GN_EPS);
    const float bn = ((const float*)(F.ws + WS_TOPW))[(m0 + r) * 8 + hd];
    LAS unsigned char* stg = F.lds + 49152 + F.wave * 4608;
#pragma unroll
    for (int it = 0; it < 2; ++it)
#pragma unroll
        for (int g = 0; g < 4; ++g) { const int cl = 32 * it + 8 * g + 4 * h, cj = hd * 64 + cl;
            const u32x2 a = *(const LAS u32x2*)(rowc + cj * 2), p = *(const LAS u32x2*)(rowp + cj * 2);
            const float vc[4] = {bf_lo(a.x), bf_hi(a.x), bf_lo(a.y), bf_hi(a.y)}, vq[4] = {bf_lo(p.x), bf_hi(p.x), bf_lo(p.y), bf_hi(p.y)};
            const f32x4 muv = *(const f32x4*)(mu + 1024 + cj), lg = *(const f32x4*)(AIN(16) + cj), lb = *(const f32x4*)(AIN(17) + cj);
            float o[4];
#pragma unroll
            for (int q = 0; q < 4; ++q) { const int i = 4 * g + q; const float v_ = vc[q] + muv[q] * (vq[q] - vc[q]);
                o[q] = ((Y[it][i] - mean) * rstd * lg[q] + lb[q] + bn * v_) * gl[it][i]; }
            *(LAS u32x2*)(stg + r * 144 + cl * 2) = (u32x2){cvtpk(o[0], o[1]), cvtpk(o[2], o[3])}; }
    asm volatile("s_waitcnt lgkmcnt(0)" ::: "memory");
    bf16_t* OUT = (bf16_t*)(F.ws + WS_R0) + m0 * 512 + hd * 64;
#pragma unroll
    for (int i = 0; i < 4; ++i) { const int row = i * 8 + ((tid & 63) >> 3), chn = tid & 7; const u32x4 v = *(const LAS u32x4*)(stg + row * 144 + chn * 16); *(u32x4*)(OUT + (size_t)row * 512 + chn * 8) = v; }
#undef RK_LD
#undef RK_ST
}
}
__device__ __forceinline__ void route_token(float lg, float bias, int lane, int tok, int* TE, float* TW, LAS unsigned* lcnt) {
    const float s = 1.0f / (1.0f + expf(-lg));
    const float c = s + bias;
    const unsigned kc = ord_key(c);
#define RT_MAXD(v_, ctrl) { const unsigned o_ = (unsigned)__builtin_amdgcn_update_dpp(0, (int)(v_), (ctrl), 0xF, 0xF, true); v_ = (v_) > o_ ? (v_) : o_; }
#define RT_INV(k_) (((k_) & 0x80000000u) ? __uint_as_float((k_) & 0x7FFFFFFFu) : __uint_as_float(~(k_)))
    unsigned m1 = kc; RT_MAXD(m1, 0xB1) RT_MAXD(m1, 0x4E) RT_MAXD(m1, 0x141)
    const unsigned long long b1 = __builtin_amdgcn_ballot_w64(kc == m1);
    const unsigned gb = (unsigned)(b1 >> (lane & 56)) & 0xFFu;
    unsigned m2 = ((lane & 7) == __builtin_ctz(gb)) ? 0u : kc; RT_MAXD(m2, 0xB1) RT_MAXD(m2, 0x4E) RT_MAXD(m2, 0x141)
    const float gs = RT_INV(m1) + RT_INV(m2);
    unsigned gcur = ord_key(gs); bool gsel = false;
#pragma unroll
    for (int j = 0; j < 4; ++j) { unsigned v = gcur; RT_MAXD(v, 0xB1) RT_MAXD(v, 0x4E) RT_MAXD(v, 0x141) RT_MAXD(v, 0x140)
        const unsigned a0_ = (unsigned)__builtin_amdgcn_readlane((int)v, 0), a1_ = (unsigned)__builtin_amdgcn_readlane((int)v, 16), a2_ = (unsigned)__builtin_amdgcn_readlane((int)v, 32), a3_ = (unsigned)__builtin_amdgcn_readlane((int)v, 48);
        const unsigned x_ = a0_ > a1_ ? a0_ : a1_, y_ = a2_ > a3_ ? a2_ : a3_; const unsigned m_ = x_ > y_ ? x_ : y_;
        const int win = __builtin_ctzll(__builtin_amdgcn_ballot_w64(gcur == m_));
        if ((lane >> 3) == (win >> 3)) { gsel = true; gcur = 0u; } }
    unsigned cur = gsel ? kc : 0u; int erk = 64;
#pragma unroll
    for (int j = 0; j < 8; ++j) { unsigned v = cur; RT_MAXD(v, 0xB1) RT_MAXD(v, 0x4E) RT_MAXD(v, 0x141) RT_MAXD(v, 0x140)
        const unsigned a0_ = (unsigned)__builtin_amdgcn_readlane((int)v, 0), a1_ = (unsigned)__builtin_amdgcn_readlane((int)v, 16), a2_ = (unsigned)__builtin_amdgcn_readlane((int)v, 32), a3_ = (unsigned)__builtin_amdgcn_readlane((int)v, 48);
        const unsigned x_ = a0_ > a1_ ? a0_ : a1_, y_ = a2_ > a3_ ? a2_ : a3_; const unsigned m_ = x_ > y_ ? x_ : y_;
        const int win = __builtin_ctzll(__builtin_amdgcn_ballot_w64(cur == m_));
        if (lane == win) { erk = j; cur = 0u; } }
#undef RT_MAXD
#undef RT_INV
    const bool sel = erk < 8;
    const float ssum = wave_sum(sel ? s : 0.f);
    if (sel) { TE[(size_t)tok * 8 + erk] = lane; TW[(size_t)tok * 8 + erk] = s / ssum * 2.5f; atomicAdd((unsigned*)&lcnt[(tok >= M / 2 ? 64 : 0) + lane], 1u); }
}
__device__ __forceinline__ void norm2_route_wave(const Args& args, Frame& F, LAS unsigned* lcnt) {
    bf16_t* H2 = (bf16_t*)(F.ws + WS_H2);
    norm_mod_rows(args, F, F.out, AIN(21), 3072, 4096, H2, F.ws + WS_H2F8);
    asm volatile("s_waitcnt vmcnt(0)" ::: "memory");
    const int lane = F.lane, row0 = F.gw * 16;
    const bf16_t* ap = H2 + (size_t)(row0 + (lane & 15)) * D + 8 * (lane >> 4);
    const bf16_t* bp = (const bf16_t*)(F.ws + WS_WRT) + (size_t)(lane & 15) * D + 8 * (lane >> 4);
    f32x4 acc[4] = {f32x4{}, f32x4{}, f32x4{}, f32x4{}};
#pragma unroll 1
    for (int k0 = 0; k0 < 32; k0 += 4) { bf16x8 a_[4], b_[4][4];
#pragma unroll
        for (int i = 0; i < 4; ++i) { a_[i] = *(const bf16x8*)(ap + 32 * (k0 + i));
#pragma unroll
            for (int nt = 0; nt < 4; ++nt) b_[i][nt] = *(const bf16x8*)(bp + (size_t)(16 * nt) * D + 32 * (k0 + i)); }
#pragma unroll
        for (int i = 0; i < 4; ++i)
#pragma unroll
            for (int nt = 0; nt < 4; ++nt) acc[nt] = __builtin_amdgcn_mfma_f32_16x16x32_bf16(a_[i], b_[i][nt], acc[nt], 0, 0, 0); }
    LAS float* scr = (LAS float*)(F.lds + F.wave * 16384);
#pragma unroll
    for (int nt = 0; nt < 4; ++nt)
#pragma unroll
        for (int i = 0; i < 4; ++i) scr[(4 * (lane >> 4) + i) * 65 + 16 * nt + (lane & 15)] = acc[nt][i];
    asm volatile("s_waitcnt lgkmcnt(0)" ::: "memory");
    int* TE = (int*)(F.ws + WS_TOPE); float* TW = (float*)(F.ws + WS_TOPW);
    const float bias = AIN(23)[lane];
#pragma unroll 1
    for (int t = 0; t < 16; ++t) route_token(scr[t * 65 + lane], bias, lane, row0 + t, TE, TW, lcnt);
    asm volatile("s_waitcnt lgkmcnt(0)" ::: "memory");
}
__device__ __forceinline__ void norm2_route_convert(const Args& args, Frame& F) {
    LAS unsigned* lcnt = (LAS unsigned*)(F.lds + LDS_TILETAB);
    if (F.tid < 128) lcnt[F.tid] = 0u;
    __syncthreads();
    constexpr int KIT = (64 * (16 * 16 + 4 * 32) + NWAVES * 256 - 1) / (NWAVES * 256) + 1;
    if (F.wave < 4) { norm2_route_wave(args, F, lcnt); convert_experts(args, F, 0, KIT); }
    else { convert_experts(args, F, 0, KIT / 2); norm2_route_wave(args, F, lcnt); convert_experts(args, F, KIT / 2, KIT); }
    __syncthreads();
    if (F.tid < 128 && lcnt[F.tid]) atomicAdd(F.ctl + CW_CNT + F.tid, lcnt[F.tid]);
    __syncthreads();
}
struct MoeTab { int ntiles0, ntiles; };
__device__ __forceinline__ MoeTab build_tiles(const Args& args, Frame& F) {
    LAS unsigned* tab = (LAS unsigned*)(F.lds + LDS_TILETAB);
    LAS unsigned* offs = tab + 2432; LAS unsigned* tpre = tab + 2560;
    if (F.tid == 0) { unsigned o = 0, tp = 0;
        for (int l = 0; l < 128; ++l) { const unsigned c = __hip_atomic_load(F.ctl + CW_CNT + l, RLX_AGENT); offs[l] = o; tpre[l] = tp; o += c; tp += (c + 255u) >> 8; }
        tpre[128] = tp; }
    __syncthreads();
    if (F.tid < 128) { const int l = F.tid; const unsigned c = __hip_atomic_load(F.ctl + CW_CNT + l, RLX_AGENT); const unsigned o = offs[l], t0 = tpre[l], nt = (c + 255u) >> 8;
        for (unsigned i = 0; i < nt; ++i) { const unsigned rows = (c - 256u * i) < 256u ? (c - 256u * i) : 256u; tab[2 * (t0 + i)] = (o + 256u * i) | ((unsigned)(l & 63) << 20); tab[2 * (t0 + i) + 1] = rows; } }
    __syncthreads();
    MoeTab r; r.ntiles0 = (int)tpre[64]; r.ntiles = (int)tpre[128]; return r;
}
__device__ __forceinline__ void scatter_phase(const Args& args, Frame& F) {
    LAS unsigned* tab = (LAS unsigned*)(F.lds + LDS_TILETAB); LAS unsigned* offs = tab + 2432;
    LAS unsigned* lcnt = (LAS unsigned*)(F.lds); LAS unsigned* lbase = lcnt + 128; LAS unsigned* posl = lcnt + 256;
    const int* TE = (const int*)(F.ws + WS_TOPE); const float* TW = (const float*)(F.ws + WS_TOPW);
    int* ST = (int*)(F.ws + WS_STOK); float* SW = (float*)(F.ws + WS_SW);
    for (int blk = blockIdx.x; blk < M / 128; blk += F.G) {
        if (F.tid < 128) lcnt[F.tid] = 0u;
        __syncthreads();
        const int tok0 = blk * 128, hf = tok0 >= M / 2 ? 64 : 0;
        int lst[2]; unsigned rnk[2];
#pragma unroll
        for (int i = 0; i < 2; ++i) { const int p = F.tid + 512 * i; lst[i] = hf + TE[(size_t)tok0 * 8 + p]; rnk[i] = atomicAdd((unsigned*)&lcnt[lst[i]], 1u); }
        __syncthreads();
        if (F.tid < 128) lbase[F.tid] = lcnt[F.tid] ? atomicAdd(F.ctl + CW_CUR + F.tid, lcnt[F.tid]) : 0u;
        __syncthreads();
#pragma unroll
        for (int i = 0; i < 2; ++i) { const int p = F.tid + 512 * i; const unsigned pos = offs[lst[i]] + lbase[lst[i]] + rnk[i];
            ST[pos] = tok0 * 8 + p; SW[pos] = TW[(size_t)tok0 * 8 + p]; posl[p] = pos; }
        __syncthreads();
        { const unsigned char* H8 = F.ws + WS_H2F8 + (size_t)tok0 * D + 16 * F.lane; unsigned char* HS = F.ws + WS_HS + 16 * F.lane;
#pragma unroll 1
          for (int i0 = 0; i0 < 128; i0 += 8) { u32x4 v_[8]; unsigned ps_[8];
#pragma unroll
              for (int i = 0; i < 8; ++i) { const int p = F.wave * 128 + i0 + i; ps_[i] = posl[p]; v_[i] = *(const u32x4*)(H8 + (size_t)(p >> 3) * D); }
#pragma unroll
              for (int i = 0; i < 8; ++i) *(u32x4*)(HS + (size_t)ps_[i] * D) = v_[i]; } }
        __syncthreads();
    }
}

__device__ __forceinline__ void final_rows(const Args& args, Frame& F, int row_lo, int row_hi, int tokbase) {
    const unsigned char* SL = (const unsigned char*)(F.ws + WS_SLOT);
    const int cA = 256 * (F.lane >> 4) + 32 * ((F.lane >> 2) & 3) + 8 * (F.lane & 3), cB = cA + 128;
    for (int blk = F.gw; blk < (row_hi - row_lo) / 16; blk += F.NGW) {
        const int r0 = row_lo + blk * 16, b = r0 / SEQ;
        const float* g2 = (const float*)(F.ws + WS_MOD) + b * 6144 + 5120; const float* fgp = AIN(30);
        f32x4 gv[4], fg[4];
#pragma unroll
        for (int j = 0; j < 4; ++j) { const int c = (j < 2 ? cA : cB) + 4 * (j & 1); gv[j] = *(const f32x4*)(g2 + c) * (1.0f / SLOT_SCALE); fg[j] = *(const f32x4*)(fgp + c); }
        for (int r = 0; r < 16; ++r) { const size_t m = (size_t)(r0 + r);
            f32x4 acc[4];
#pragma unroll
            for (int j = 0; j < 4; ++j) acc[j] = (f32x4){0.f, 0.f, 0.f, 0.f};
            const unsigned char* sp = SL + (m - tokbase) * NSLOT * D + 16 * F.lane;
            u32x4 w[NSLOT];
#pragma unroll
            for (int k = 0; k < NSLOT; ++k) w[k] = *(const u32x4*)(sp + (size_t)k * D);
#pragma unroll
            for (int k = 0; k < NSLOT; ++k) { const unsigned ww[4] = {w[k].x, w[k].y, w[k].z, w[k].w};
#pragma unroll
                for (int j = 0; j < 4; ++j) { const f32x2 a = __builtin_amdgcn_cvt_pk_f32_fp8((int)ww[j], false), c = __builtin_amdgcn_cvt_pk_f32_fp8((int)ww[j], true); acc[j] += (f32x4){a.x, a.y, c.x, c.y}; } }
            float* xr = F.out + m * D; f32x4 v[4]; float s = 0.f;
#pragma unroll
            for (int j = 0; j < 4; ++j) { const int c = (j < 2 ? cA : cB) + 4 * (j & 1); v[j] = *(const f32x4*)(xr + c) + gv[j] * acc[j]; s += (v[j].x * v[j].x + v[j].y * v[j].y) + (v[j].z * v[j].z + v[j].w * v[j].w); }
            const float rstd = 1.0f / sqrtf(wave_sum(s) * (1.0f / D) + RMS_EPS);
#pragma unroll
            for (int j = 0; j < 4; ++j) { const int c = (j < 2 ? cA : cB) + 4 * (j & 1); *(f32x4*)(xr + c) = v[j] * rstd * fg[j]; }
        }
    }
}
constexpr int N_PHASES = 15;
#ifndef PROBE_ATT_SCALE
#define PROBE_ATT_SCALE 1.0f
#endif
#ifndef PROBE_IDX_REP
#define PROBE_IDX_REP 1
#endif
#ifndef R2_WGS
#define R2_WGS 32
#endif
#ifndef PROBE_P5_PART
#define PROBE_P5_PART 0
#endif
#ifndef PROBE_RW_SCALE
#define PROBE_RW_SCALE 1.0f
#endif

__global__ void __launch_bounds__(NTHR, 2) fwd_kernel(Args args) {
    extern __shared__ __attribute__((aligned(16))) unsigned char lds_raw[];
    Frame F;
    F.lds = (LAS unsigned char*)lds_raw;
    F.MISC = (volatile LAS unsigned*)(F.lds + MISC_OFF);
    F.tid = threadIdx.x; F.lane = F.tid & 63; F.wave = __builtin_amdgcn_readfirstlane(F.tid >> 6);
    F.G = gridDim.x; { const int bx = blockIdx.x; F.vcu = (F.G % 8 == 0) ? (bx % 8) * (F.G / 8) + bx / 8 : bx; }
    F.gw = blockIdx.x * NWAVES + F.wave; F.NGW = F.G * NWAVES;
    F.ws = args.ws; F.out = args.out; F.ctl = (unsigned*)(args.ws + WS_CTL);
    for (int u = F.tid; u < (LDS_BYTES - LDSCTL_OFF) / 4; u += NTHR) ((LAS unsigned*)(F.lds + LDSCTL_OFF))[u] = 0u;
    __syncthreads();
    if (F.tid == 0) {
#pragma unroll
        for (int i = 0; i < 31; ++i) *(LAS unsigned long long*)(F.lds + LDS_PTAB + 8 * i) = (unsigned long long)args.in[i];
        *(LAS unsigned long long*)(F.lds + LDS_PTAB + 8 * 31) = (unsigned long long)args.out; *(LAS unsigned long long*)(F.lds + LDS_PTAB + 8 * 32) = (unsigned long long)args.ws; }
    __syncthreads();
    XcdBarrier bar = xcd_barrier_post(F.ctl + CW_BAR + args.li * XCD_BAR_WORDS, F.MISC + 8);
    const int lo = args.ph_lo, hi = args.ph_hi;
#ifndef PHASE_MASK
#define PHASE_MASK 0xFFFFFFFFu
#endif
#define IN(k) ((((PHASE_MASK) >> (k)) & 1u) && lo <= (k) && (k) < hi)
#define PB() do { F.ws = (unsigned char*)ain_ptr(F.lds, 32); F.out = (float*)ain_ptr(F.lds, 31); F.ctl = (unsigned*)(F.ws + WS_CTL); \
        F.lane = (int)__builtin_amdgcn_mbcnt_hi(~0u, __builtin_amdgcn_mbcnt_lo(~0u, 0u)); F.tid = F.wave * 64 + F.lane; } while (0)
#define ZB ((bf16_t*)(F.ws + WS_Z))
#define GATES ((bf16_t*)F.out)
#define MOD ((const float*)(F.ws + WS_MOD))
#define SEAM(k) do { if (IN(k) && IN((k) + 1)) xcd_barrier(bar); } while (0)

    if (IN(0)) { PB(); p0_prologue(args, F); } SEAM(0);
    if (IN(1)) { PB(); norm_mod_rows(args, F, AIN(0), AIN(4), 0, 1024, nullptr, F.ws + WS_H0); } SEAM(1);
    if (IN(2)) { PB(); pg8::StaticOrder S; S.init(M, NIN, F.G, (int)blockIdx.x); pg8::DenseSrcT<1> G{F.ws + WS_H0, F.ws + WS_WIN, 1024};
        EpiInProj E{ZB, GATES}; pg8::gemm_phase<EpiInProj, pg8::StaticOrder, pg8::DenseSrcT<1>>(F.lds, 1024, S, G, E); } SEAM(2);
    if (IN(3)) { PB(); rk::load_params(args, F); for (int u = blockIdx.x; u < 1024; u += F.G) rk::r1_unit(args, F, u >> 7, u & 127); __syncthreads(); } SEAM(3);
    if (IN(4)) { PB();
#ifdef PROBE_R2_DRY
        if (blockIdx.x < R2_WGS && F.wave < 128 / R2_WGS) rk::r2_task<1>(args, F, blockIdx.x * (128 / R2_WGS) + F.wave);
#endif
        if (blockIdx.x < R2_WGS && F.wave < 128 / R2_WGS) rk::r2_task<0>(args, F, blockIdx.x * (128 / R2_WGS) + F.wave);
#pragma unroll 1
        for (int rep = 0; rep < PROBE_IDX_REP; ++rep)
        for (;;) {
            __syncthreads();
            if (F.tid == 0) F.MISC[12] = atomicAdd(F.ctl + CW_Q + rep, 1u);
            __syncthreads();
            const int u = (int)F.MISC[12];
            if (u >= 2048) break;
            indexer_unit(args, F, u & 7, (255 - (u >> 3)) * 16);
        } } SEAM(4);
    if (IN(5)) { PB(); if (!((PROBE_P5_PART & 2) && args.li == 1)) { for (int u = blockIdx.x; u < 1024; u += F.G) rk::r3_unit(args, F, u >> 7, u & 127); } __syncthreads();
        if (!((PROBE_P5_PART & 1) && args.li == 1)) for (int i = 0; i < 4; ++i) for (int uu = F.vcu; uu < 256; uu += F.G) { const int bh = uu >> 2, s = uu & 3; const int qb = (i == 0) ? s : (i == 1) ? 7 - s : (i == 2) ? 8 + s : 15 - s;
            att::attn_unit(args, F, bh >> 3, bh & 7, qb); } __syncthreads(); } SEAM(5);
    if (IN(6)) { PB(); pg8::StaticOrder S; S.init(M, D, F.G, (int)blockIdx.x);
        { pg8::DenseSrc G{F.ws + WS_R1, F.ws + WS_WA, 512}; EpiMerge<0> E{(bf16_t*)(F.ws + WS_R2), F.ws + WS_H0, GATES, PROBE_ATT_SCALE}; pg8::gemm_phase<EpiMerge<0>, pg8::StaticOrder, pg8::DenseSrc>(F.lds, 512, S, G, E); }
        { pg8::DenseSrc G{F.ws + WS_R0, F.ws + WS_WR, 512}; EpiMerge<1> E{(bf16_t*)(F.ws + WS_R2), F.ws + WS_H0, GATES, PROBE_RW_SCALE}; pg8::gemm_phase<EpiMerge<1>, pg8::StaticOrder, pg8::DenseSrc>(F.lds, 512, S, G, E); } } SEAM(6);
    if (IN(7)) { PB(); pg8::StaticOrder S; S.init(M, D, F.G, (int)blockIdx.x); pg8::DenseSrcT<1> G{F.ws + WS_H0, F.ws + WS_WO, 1024};
        EpiOutProj E{AIN(0), F.out, MOD}; pg8::gemm_phase<EpiOutProj, pg8::StaticOrder, pg8::DenseSrcT<1>>(F.lds, 1024, S, G, E); } SEAM(7);
    if (IN(8)) { PB(); norm2_route_convert(args, F); }
    if (IN(8) && IN(11)) xcd_barrier(bar);
    MoeTab mt{0, 0};
    if (lo <= 13 && hi > 13) { PB(); mt = build_tiles(args, F); scatter_phase(args, F); } else if (hi > 13) { PB(); mt = build_tiles(args, F); }
    SEAM(11);
    const LAS unsigned* tab = (const LAS unsigned*)(F.lds + LDS_TILETAB);
    if (IN(12)) { PB(); MoeSched1 S{tab, mt.ntiles, F.G, F.vcu};            MoeSrc1 G{F.ws};
        EpiMoe1 E{F.ws}; pg8::gemm_phase<EpiMoe1, MoeSched1, MoeSrc1>(F.lds, 1024, S, G, E); } SEAM(12);
    if (IN(13)) { PB(); MoeSched2 S{tab, 0, mt.ntiles, 512, F.G, F.vcu}; MoeSrc2 G{F.ws}; EpiMoe2 E; E.ws = F.ws; E.X1 = F.out; E.tokbase = 0;
        pg8::gemm_phase<EpiMoe2, MoeSched2, MoeSrc2>(F.lds, 256, S, G, E); } SEAM(13);
    if (IN(14)) { PB(); final_rows(args, F, 0, M, 0); }
#ifdef PROBE_CYC
    __syncthreads();
    if (blockIdx.x == 0 && F.tid == 0) { asm volatile("s_waitcnt vmcnt(0)" ::: "memory"); F.out[0] = (float)(F.ctl[CW_Q + 64]); }
#endif
#undef IN
#undef SEAM
#undef PB
}

extern "C" void kernel_launch(void* const* d_in, const int* in_sizes, int n_in, void* d_out, int out_size, void* d_ws, size_t ws_size, hipStream_t stream) {
    static int grid = 0;
    if (grid == 0) {
        if (n_in != 31 || out_size != M * D || ws_size < WS_END) { fprintf(stderr, "kernel_launch: unexpected problem (n_in %d, out %d, ws %zu)\n", n_in, out_size, ws_size); grid = -1; return; }
        int dev = 0, cus = 0, per_cu = 0;
        if (hipGetDevice(&dev) != hipSuccess || hipDeviceGetAttribute(&cus, hipDeviceAttributeMultiprocessorCount, dev) != hipSuccess) { grid = -1; return; }
        if (hipFuncSetAttribute((const void*)fwd_kernel, hipFuncAttributeMaxDynamicSharedMemorySize, LDS_BYTES) != hipSuccess) { fprintf(stderr, "kernel_launch: hipFuncSetAttribute failed\n"); grid = -1; return; }
        if (hipOccupancyMaxActiveBlocksPerMultiprocessor(&per_cu, (const void*)fwd_kernel, NTHR, LDS_BYTES) != hipSuccess || per_cu < 1) fprintf(stderr, "kernel_launch: occupancy query reports %d\n", per_cu);
        (void)hipGetLastError();
        grid = cus;
        if (grid != 256) fprintf(stderr, "kernel_launch: %d CUs (built for 256)\n", grid);
    }
    if (grid < 0) return;
    (void)in_sizes;
    if (hipMemsetAsync((char*)d_ws + WS_CTL, 0, CTL_ZERO_BYTES, stream) != hipSuccess) return;
    Args a{};
    for (int i = 0; i < 31; ++i) a.in[i] = (const float*)d_in[i];
    a.out = (float*)d_out; a.ws = (unsigned char*)d_ws;
#ifndef PROBE_REPEAT
#define PROBE_REPEAT -1
#endif
    int li = 0;
    auto go = [&](int lo_, int hi_) { a.ph_lo = lo_; a.ph_hi = hi_; a.li = li++; hipLaunchKernelGGL(fwd_kernel, dim3(grid), dim3(NTHR), LDS_BYTES, stream, a); };
    if (PROBE_REPEAT < 0) go(0, N_PHASES);
    else { go(0, PROBE_REPEAT + 1); go(PROBE_REPEAT, PROBE_REPEAT + 1); if (PROBE_REPEAT + 1 < N_PHASES) go(PROBE_REPEAT + 1, N_PHASES); }
}
```
